# Optimizing an MI355X kernel written in HIP

```python
import math
import jax, jax.numpy as jnp
from jax import lax
import numpy as np

D_MODEL = 1024
BATCH = 16
SEQ = 2048
DEPTH = 4

GRID_W = 64
CTX_LEN = 256
N_EVEN = (DEPTH + 1) // 2
N_ODD = DEPTH // 2
MIX_WIDTH = D_MODEL

RW_HEAD_DIM = 64
RW_WIDTH = MIX_WIDTH // 2
RW_HEADS = RW_WIDTH // RW_HEAD_DIM
DECAY_LORA = 64
ICLR_LORA = 64
GATE_LORA = 128
RW_SPLITS = [RW_WIDTH, 2 * RW_WIDTH, 3 * RW_WIDTH, 3 * RW_WIDTH + 2 * DECAY_LORA,
             3 * RW_WIDTH + 2 * DECAY_LORA + 2 * ICLR_LORA]
RW_COLS = 3 * RW_WIDTH + 2 * DECAY_LORA + 2 * ICLR_LORA + GATE_LORA
RW_GN_EPS = 64e-5

DF_HEAD_DIM = 64
DF_V_DIM = 2 * DF_HEAD_DIM
DF_WIDTH = MIX_WIDTH - RW_WIDTH
DF_HEADS = DF_WIDTH // DF_V_DIM
DF_QK = DF_HEADS * 2 * DF_HEAD_DIM
DF_COLS = 2 * DF_QK + DF_WIDTH
Q_BLOCK = 128
ROPE_THETA = 10000.0
EVEN_COLS = RW_COLS + DF_COLS

SGU_CHUNK = 128
SGU_WIDTH = D_MODEL
SGU_GROUPS = 8
SGU_GROUP_DIM = SGU_WIDTH // SGU_GROUPS

N_EXPERTS = 32
TOP_K = 4
D_EXPERT = D_MODEL
SWIGLU_LIMIT = 7.0
SWIGLU_ALPHA = 1.702

RMS_EPS = 1e-6
LN_EPS = 1e-5

kernel_name = "hybrid_rwkv7_diffattn_sgu_moe_dit"


def rms_norm(x, g):
    xf = x.astype(jnp.float32)
    y = xf * lax.rsqrt(jnp.mean(xf * xf, axis=-1, keepdims=True) + RMS_EPS)
    return (y * g.astype(jnp.float32)).astype(x.dtype)


def layer_norm(x, g, b):
    xf = x.astype(jnp.float32)
    mu = jnp.mean(xf, axis=-1, keepdims=True)
    var = jnp.mean(jnp.square(xf - mu), axis=-1, keepdims=True)
    return ((xf - mu) * lax.rsqrt(var + LN_EPS) * g + b).astype(x.dtype)


def modulate(xn, shift, scale):
    return xn * (1.0 + scale) + shift


def axial_rope_tables(n_tokens):
    rows = n_tokens // GRID_W
    row = jnp.repeat(jnp.arange(rows, dtype=jnp.float32), GRID_W)
    col = jnp.tile(jnp.arange(GRID_W, dtype=jnp.float32), rows)
    axis_dim = DF_HEAD_DIM // 2
    inv_freq = ROPE_THETA ** (-jnp.arange(0, axis_dim, 2, dtype=jnp.float32) / axis_dim)
    ar = row[:, None] * inv_freq
    ac = col[:, None] * inv_freq
    ang = jnp.concatenate([ar, ar, ac, ac], axis=-1)
    return jnp.cos(ang), jnp.sin(ang)


def apply_axial_rope(x, cos, sin):
    xf = x.astype(jnp.float32)
    xr = xf.reshape(xf.shape[:-1] + (2, 2, DF_HEAD_DIM // 4))
    rot = jnp.stack([-xr[..., 1, :], xr[..., 0, :]], axis=-2).reshape(xf.shape)
    return (xf * cos[None, :, None, None, :] + rot * sin[None, :, None, None, :]).astype(x.dtype)


def token_shift(z, mu):
    zp = jnp.pad(z, ((0, 0), (1, 0), (0, 0)))[:, :-1]
    zn = jnp.pad(z, ((0, 0), (0, 1), (0, 0)))[:, 1:]
    return z + mu[0] * (zp - z) + mu[1] * (zn - z)


def rwkv_features(za, p):
    B, T, _ = za.shape
    r, k, v, wl, al, gl = jnp.split(za.astype(jnp.float32), RW_SPLITS, axis=-1)
    wl = wl.reshape(B, T, 2, DECAY_LORA)
    al = al.reshape(B, T, 2, ICLR_LORA)
    w = -jax.nn.softplus(-(p["w0"] + jnp.einsum('btdr,drc->btdc', jnp.tanh(wl), p["w2"]))) - 0.5
    decay = jnp.exp(-jnp.exp(w))
    a = jax.nn.sigmoid(p["a0"] + jnp.einsum('btdr,drc->btdc', al, p["a2"]))
    g = jax.nn.sigmoid(gl) @ p["g2"]
    kk = (k * p["k_k"]).reshape(B, T, RW_HEADS, RW_HEAD_DIM)
    kk = kk / jnp.maximum(jnp.sqrt(jnp.sum(kk * kk, axis=-1, keepdims=True)), 1e-12)
    kd = k[:, :, None] * (1.0 + (a - 1.0) * p["k_a"])
    hd = lambda t: t.reshape(t.shape[:-1] + (RW_HEADS, RW_HEAD_DIM))
    return {"r": hd(r), "v": hd(v), "kk": kk, "k": hd(kd), "w": hd(decay), "a": hd(a), "g": g}


def wkv7_scan(state0, r, w, k, v, a, b, reverse):
    def step(S, inp):
        r_t, w_t, k_t, v_t, a_t, b_t = inp
        sa = jnp.einsum('bhvk,bhk->bhv', S, a_t)
        S = S * w_t[:, :, None, :] + sa[..., None] * b_t[:, :, None, :] + v_t[..., None] * k_t[:, :, None, :]
        return S, jnp.einsum('bhvk,bhk->bhv', S, r_t)
    return lax.scan(step, state0, (r, w, k, v, a, b), reverse=reverse)


def rwkv_scans(f, s0_fwd, s0_bwd):
    tm = lambda t: jnp.swapaxes(t, 0, 1)
    r, v, kk = tm(f["r"]), tm(f["v"]), tm(f["kk"])
    s_fwd, y_fwd = wkv7_scan(s0_fwd, r, tm(f["w"][:, :, 0]), tm(f["k"][:, :, 0]), v, -kk,
                             kk * tm(f["a"][:, :, 0]), False)
    s_bwd, y_bwd = wkv7_scan(s0_bwd, r, tm(f["w"][:, :, 1]), tm(f["k"][:, :, 1]), v, -kk,
                             kk * tm(f["a"][:, :, 1]), True)
    return s_fwd, s_bwd, tm(y_fwd + y_bwd)


def rwkv_output(f, y, p):
    B, T = y.shape[:2]
    mu = jnp.mean(y, axis=-1, keepdims=True)
    var = jnp.mean(jnp.square(y - mu), axis=-1, keepdims=True)
    yn = ((y - mu) * lax.rsqrt(var + RW_GN_EPS)).reshape(B, T, RW_WIDTH) * p["gn_w"] + p["gn_b"]
    bonus = jnp.sum(f["r"][:, :, None] * f["k"] * p["r_k"], axis=-1, keepdims=True) * f["v"][:, :, None]
    return (yn + jnp.sum(bonus, axis=2).reshape(B, T, RW_WIDTH)) * f["g"]


def diff_qkv(zb, p, rope):
    B, T, _ = zb.shape
    q, k, v = jnp.split(zb, [DF_QK, 2 * DF_QK], axis=-1)
    q = rms_norm(q.reshape(B, T, DF_HEADS, 2, DF_HEAD_DIM), p["qn"])
    k = rms_norm(k.reshape(B, T, DF_HEADS, 2, DF_HEAD_DIM), p["kn"])
    if rope is not None:
        q = apply_axial_rope(q, rope[0], rope[1])
        k = apply_axial_rope(k, rope[0], rope[1])
    return q, k, v.reshape(B, T, DF_HEADS, DF_V_DIM)


def diff_attend(q, K, V, lam):
    s = jnp.einsum('bqhme,bshme->bhmqs', q, K).astype(jnp.float32) * (DF_HEAD_DIM ** -0.5)
    pr = jax.nn.softmax(s, axis=-1)
    attn = pr[:, :, 0] - lam * pr[:, :, 1]
    return jnp.einsum('bhqs,bshe->bqhe', attn.astype(V.dtype), V)


def diff_attend_blocks(q, K, V, lam):
    B, T = q.shape[:2]
    qb = jnp.swapaxes(q.reshape((B, T // Q_BLOCK, Q_BLOCK) + q.shape[2:]), 0, 1)
    out = lax.map(lambda qq: diff_attend(qq, K, V, lam), qb)
    return jnp.swapaxes(out, 0, 1).reshape((B, T) + out.shape[3:])


def even_mixer(hl, hc, p, li, rope, want_ctx):
    B = hl.shape[0]
    zl = hl @ p["w_in"]
    zc = hc @ p["w_in"]
    fl = rwkv_features(token_shift(zl[..., :RW_COLS], p["mu"]), p)
    fc = rwkv_features(token_shift(zc[..., :RW_COLS], p["mu"]), p)
    zero = jnp.zeros((B, RW_HEADS, RW_HEAD_DIM, RW_HEAD_DIM), jnp.float32)
    s_fwd, s_bwd, yc_scan = rwkv_scans(fc, zero, zero)
    _, _, yl_scan = rwkv_scans(fl, s_fwd, s_bwd)
    lam_init = 0.8 - 0.6 * math.exp(-0.3 * li)
    lp = p["lam"].astype(jnp.float32)
    lam = jnp.exp(jnp.sum(lp[0] * lp[1])) - jnp.exp(jnp.sum(lp[2] * lp[3])) + lam_init
    ql, kl, vl = diff_qkv(zl[..., RW_COLS:], p, rope)
    qc, kc, vc = diff_qkv(zc[..., RW_COLS:], p, None)
    K = jnp.concatenate([kc, kl], axis=1)
    V = jnp.concatenate([vc, vl], axis=1)
    ol = diff_attend_blocks(ql, K, V, lam)

    def merge(f, y_scan, o):
        ya = rwkv_output(f, y_scan, p).astype(hl.dtype)
        ob = (rms_norm(o, p["subln"]) * (1.0 - lam_init)).reshape(o.shape[0], o.shape[1], DF_WIDTH)
        return jnp.concatenate([ya, ob.astype(hl.dtype)], axis=-1) @ p["w_out"]

    yl = merge(fl, yl_scan, ol)
    yc = merge(fc, yc_scan, diff_attend(qc, kc, vc, lam)) if want_ctx else None
    return yl, yc


def sgu_mixer(hn, p):
    B, T, _ = hn.shape
    z = jax.nn.gelu(hn @ p["w_in"] + p["b_in"], approximate=False)
    u, v = jnp.split(z, 2, axis=-1)
    v = layer_norm(v, p["ln_g"], p["ln_b"])
    v = v.reshape(B, T // SGU_CHUNK, SGU_CHUNK, SGU_GROUPS, SGU_GROUP_DIM)
    sv = jnp.einsum('gpq,bnqgc->bnpgc', p["ws"], v) + p["bs"].T[:, :, None]
    return (u * sv.reshape(B, T, SGU_WIDTH)) @ p["w_out"]


def moe(xn, rt_w, rt_b, w1, b1, w2, b2):
    shp = xn.shape
    t = xn.reshape(-1, shp[-1])
    logits = (t @ rt_w + rt_b).astype(jnp.float32)
    top_v, top_i = lax.top_k(logits, TOP_K)
    wts = jax.nn.softmax(top_v, axis=-1)
    gates = jnp.einsum('tk,tke->te', wts, jax.nn.one_hot(top_i, N_EXPERTS, dtype=jnp.float32)).astype(t.dtype)
    out = jnp.zeros_like(t)
    for e in range(N_EXPERTS):
        glu, lin = jnp.split(t @ w1[e] + b1[e], 2, axis=-1)
        glu = jnp.minimum(glu, SWIGLU_LIMIT)
        lin = jnp.clip(lin, -SWIGLU_LIMIT, SWIGLU_LIMIT)
        act = glu * jax.nn.sigmoid(SWIGLU_ALPHA * glu) * (lin + 1.0)
        out = out + gates[:, e:e + 1] * (act @ w2[e] + b2[e])
    return out.reshape(shp)


def setup_inputs(seed: int = 0) -> dict:
    key = jax.random.key(seed)
    ks = iter(jax.random.split(key, 48))
    nrm = lambda shape, std: std * jax.random.normal(next(ks), shape, jnp.float32)
    D, E, F = D_MODEL, N_EXPERTS, D_EXPERT
    return {
        "x": nrm((BATCH, SEQ, D), 1.0),
        "c": nrm((BATCH, D), 1.0),
        "ctx": nrm((BATCH, CTX_LEN, D), 1.0),
        "c_ctx": nrm((D,), 1.0),
        "norm1_g": 1.0 + nrm((DEPTH, D), 0.02),
        "norm2_g": 1.0 + nrm((DEPTH, D), 0.02),
        "ada_w": nrm((DEPTH, D, 6 * D), 0.5 * D ** -0.5),
        "ada_b": nrm((DEPTH, 6 * D), 0.02),
        "ev_w_in": nrm((N_EVEN, D, EVEN_COLS), D ** -0.5),
        "ev_w_out": nrm((N_EVEN, MIX_WIDTH, D), MIX_WIDTH ** -0.5),
        "rw_mu": jax.random.uniform(next(ks), (N_EVEN, 2, RW_COLS), jnp.float32, 0.0, 0.5),
        "rw_w0": jnp.linspace(-6.5, -1.5, RW_WIDTH, dtype=jnp.float32) + nrm((N_EVEN, 2, RW_WIDTH), 0.1),
        "rw_w2": nrm((N_EVEN, 2, DECAY_LORA, RW_WIDTH), 0.1 * DECAY_LORA ** -0.5),
        "rw_a0": nrm((N_EVEN, 2, RW_WIDTH), 0.1),
        "rw_a2": nrm((N_EVEN, 2, ICLR_LORA, RW_WIDTH), 0.1 * ICLR_LORA ** -0.5),
        "rw_g2": nrm((N_EVEN, GATE_LORA, RW_WIDTH), GATE_LORA ** -0.5),
        "rw_kk": 0.85 + nrm((N_EVEN, RW_WIDTH), 0.02),
        "rw_ka": 1.0 + nrm((N_EVEN, RW_WIDTH), 0.02),
        "rw_rk": nrm((N_EVEN, RW_HEADS, RW_HEAD_DIM), 0.1),
        "rw_gn_w": 1.0 + nrm((N_EVEN, RW_WIDTH), 0.02),
        "rw_gn_b": nrm((N_EVEN, RW_WIDTH), 0.02),
        "df_qn": 1.0 + nrm((N_EVEN, DF_HEAD_DIM), 0.02),
        "df_kn": 1.0 + nrm((N_EVEN, DF_HEAD_DIM), 0.02),
        "df_lam": nrm((N_EVEN, 4, DF_HEAD_DIM), 0.1),
        "df_subln": 1.0 + nrm((N_EVEN, DF_V_DIM), 0.02),
        "sg_w_in": nrm((N_ODD, D, 2 * SGU_WIDTH), D ** -0.5),
        "sg_b_in": nrm((N_ODD, 2 * SGU_WIDTH), 0.02),
        "sg_ln_g": 1.0 + nrm((N_ODD, SGU_WIDTH), 0.02),
        "sg_ln_b": nrm((N_ODD, SGU_WIDTH), 0.02),
        "sg_ws": nrm((N_ODD, SGU_GROUPS, SGU_CHUNK, SGU_CHUNK), SGU_CHUNK ** -0.5),
        "sg_bs": 1.0 + nrm((N_ODD, SGU_GROUPS, SGU_CHUNK), 0.1),
        "sg_w_out": nrm((N_ODD, SGU_WIDTH, D), SGU_WIDTH ** -0.5),
        "rt_w": nrm((DEPTH, D, E), D ** -0.5),
        "rt_b": nrm((DEPTH, E), 0.01),
        "ex_w1": nrm((DEPTH, E, D, 2 * F), D ** -0.5),
        "ex_b1": nrm((DEPTH, E, 2 * F), 0.01),
        "ex_w2": nrm((DEPTH, E, F, D), F ** -0.5),
        "ex_b2": nrm((DEPTH, E, D), 0.01),
    }


def reference(x, c, ctx, c_ctx, norm1_g, norm2_g, ada_w, ada_b, ev_w_in, ev_w_out,
              rw_mu, rw_w0, rw_w2, rw_a0, rw_a2, rw_g2, rw_kk, rw_ka, rw_rk, rw_gn_w, rw_gn_b,
              df_qn, df_kn, df_lam, df_subln,
              sg_w_in, sg_b_in, sg_ln_g, sg_ln_b, sg_ws, sg_bs, sg_w_out,
              rt_w, rt_b, ex_w1, ex_b1, ex_w2, ex_b2):
    B, T, D = x.shape
    rope = axial_rope_tables(T)
    silu_c = jax.nn.silu(c)
    silu_cc = jax.nn.silu(c_ctx)
    h_lat, h_ctx = x, ctx
    for l in range(DEPTH):
        ctx_out = any(m % 2 == 0 for m in range(l + 1, DEPTH))
        ctx_in = (l % 2 == 0) or ctx_out
        j = l // 2
        mod_l = (silu_c @ ada_w[l] + ada_b[l]).reshape(B, 6, 1, D)
        a_l = modulate(rms_norm(h_lat, norm1_g[l]), mod_l[:, 0], mod_l[:, 1])
        a_c = None
        if ctx_in:
            mod_c = (silu_cc @ ada_w[l] + ada_b[l]).reshape(6, D)
            a_c = modulate(rms_norm(h_ctx, norm1_g[l]), mod_c[0], mod_c[1])
        if l % 2 == 0:
            p = {"w_in": ev_w_in[j], "w_out": ev_w_out[j], "mu": rw_mu[j], "w0": rw_w0[j], "w2": rw_w2[j],
                 "a0": rw_a0[j], "a2": rw_a2[j], "g2": rw_g2[j], "k_k": rw_kk[j], "k_a": rw_ka[j],
                 "r_k": rw_rk[j], "gn_w": rw_gn_w[j], "gn_b": rw_gn_b[j], "qn": df_qn[j], "kn": df_kn[j],
                 "lam": df_lam[j], "subln": df_subln[j]}
            y_l, y_c = even_mixer(a_l, a_c, p, l, rope, ctx_out)
        else:
            p = {"w_in": sg_w_in[j], "b_in": sg_b_in[j], "ln_g": sg_ln_g[j], "ln_b": sg_ln_b[j],
                 "ws": sg_ws[j], "bs": sg_bs[j], "w_out": sg_w_out[j]}
            y_l = sgu_mixer(a_l, p)
            y_c = sgu_mixer(a_c, p) if ctx_out else None
        h_lat = h_lat + mod_l[:, 2] * y_l.astype(h_lat.dtype)
        f_l = modulate(rms_norm(h_lat, norm2_g[l]), mod_l[:, 3], mod_l[:, 4])
        if ctx_out:
            h_ctx = h_ctx + mod_c[2] * y_c.astype(h_ctx.dtype)
            f_c = modulate(rms_norm(h_ctx, norm2_g[l]), mod_c[3], mod_c[4])
            m = moe(jnp.concatenate([f_c, f_l], axis=1), rt_w[l], rt_b[l], ex_w1[l], ex_b1[l], ex_w2[l], ex_b2[l])
            n_ctx = f_c.shape[1]
            h_ctx = h_ctx + mod_c[5] * m[:, :n_ctx]
            h_lat = h_lat + mod_l[:, 5] * m[:, n_ctx:]
        else:
            m = moe(f_l, rt_w[l], rt_b[l], ex_w1[l], ex_b1[l], ex_w2[l], ex_b2[l])
            h_lat = h_lat + mod_l[:, 5] * m
    return h_lat
```

```cpp
#include <hip/hip_runtime.h>
#include <cstdio>
#include <cstdint>

#define LAS __attribute__((address_space(3)))
typedef unsigned short bf16_t;
typedef short bf16x8 __attribute__((ext_vector_type(8)));
typedef float f32x4 __attribute__((ext_vector_type(4)));
typedef unsigned u32x4 __attribute__((ext_vector_type(4)));
typedef unsigned u32x2 __attribute__((ext_vector_type(2)));

constexpr int DM = 1024, NB = 16, TL = 2048, TC = 256;
constexpr int NCTX = NB * TC, NLAT = NB * TL, NTOK = NCTX + NLAT;
constexpr int RWC = 1920, EVC = 3456;
constexpr int NE = 32;
constexpr int XPROWS = NTOK * 4 + NE * 256;
constexpr int NTHREADS = 512, NWAVES = 8;

constexpr size_t MiB = 1u << 20;
constexpr size_t al256(size_t x) { return (x + 255) & ~(size_t)255; }
constexpr size_t WS_CTL = 0, CTL_ZERO_BYTES = 1 * MiB;
constexpr size_t WS_MOD = 1 * MiB;
constexpr size_t WS_RTWT = al256(WS_MOD + (size_t)4 * 17 * 6144 * 4);
constexpr size_t WS_WIN = al256(WS_RTWT + (size_t)4 * 32 * 1024 * 4);
constexpr size_t WS_WOUT = al256(WS_WIN + (size_t)2 * EVC * DM * 2);
constexpr size_t WS_SGIN = al256(WS_WOUT + (size_t)2 * DM * DM * 2);
constexpr size_t WS_SGOUT = al256(WS_SGIN + (size_t)2 * 2048 * DM * 2);
constexpr size_t WS_W1 = al256(WS_SGOUT + (size_t)2 * DM * DM * 2);
constexpr size_t WS_W2 = al256(WS_W1 + (size_t)4 * NE * 2048 * DM * 2);
constexpr size_t WS_H = al256(WS_W2 + (size_t)4 * NE * DM * DM * 2);
constexpr size_t WS_ABF = al256(WS_H + (size_t)NTOK * DM * 4);
constexpr size_t WS_TOKE = al256(WS_ABF + (size_t)NTOK * DM * 2);
constexpr size_t WS_TOKG = al256(WS_TOKE + (size_t)NTOK * 4 * 4);
constexpr size_t WS_ROWOF = al256(WS_TOKG + (size_t)NTOK * 4 * 4);
constexpr size_t WS_R = al256(WS_ROWOF + (size_t)NTOK * 4 * 4);
constexpr size_t FSZ = (size_t)NTOK * 512 * 4;
constexpr size_t WS_Z = WS_R;
constexpr size_t WS_F = al256(WS_Z + (size_t)NTOK * EVC * 2);
constexpr size_t WS_YS = WS_F + 11 * FSZ;
constexpr size_t WS_QF = WS_YS + 2 * FSZ;
constexpr size_t WS_KF = WS_QF + FSZ;
constexpr size_t WS_VF = WS_KF + FSZ;
constexpr size_t WS_OP = WS_VF + FSZ;
constexpr size_t WS_CAT = WS_OP + 2 * FSZ;
constexpr size_t WS_EVEN_END = WS_CAT + (size_t)NTOK * DM * 2;
constexpr size_t WS_Z2 = WS_R;
constexpr size_t WS_VN = al256(WS_Z2 + (size_t)NTOK * 2048 * 4);
constexpr size_t WS_G = al256(WS_VN + (size_t)NTOK * DM * 4);
constexpr size_t WS_ODD_END = WS_G + (size_t)NTOK * DM * 2;
constexpr size_t WS_XP = WS_R;
constexpr size_t WS_ACT = al256(WS_XP + (size_t)XPROWS * DM * 2);
constexpr size_t WS_YM = al256(WS_ACT + (size_t)XPROWS * DM * 2);
constexpr size_t WS_MOE_END = WS_YM + (size_t)XPROWS * DM * 4;
constexpr size_t WS_END = (WS_EVEN_END > WS_MOE_END ? (WS_EVEN_END > WS_ODD_END ? WS_EVEN_END : WS_ODD_END) : (WS_MOE_END > WS_ODD_END ? WS_MOE_END : WS_ODD_END));

constexpr int CW_BAR = 4096;
constexpr int CW_CNT = 16384;
constexpr int CW_CUR = 16384 + 256;

constexpr int LDS_BYTES = 147456;
constexpr int LDS_MISC = 144 * 1024 - 256;

__device__ __forceinline__ unsigned f2bf(float f) { unsigned u = __builtin_bit_cast(unsigned, f); return (u + 0x7fffu + ((u >> 16) & 1u)) >> 16; }
__device__ __forceinline__ unsigned pk2(float lo, float hi) { return f2bf(lo) | (f2bf(hi) << 16); }
__device__ __forceinline__ float bf2f(bf16_t b) { return __builtin_bit_cast(float, (unsigned)b << 16); }
__device__ __forceinline__ float wave_sum(float v) {
#pragma unroll
    for (int o = 1; o < 64; o <<= 1) v += __shfl_xor(v, o);
    return v;
}
__device__ __forceinline__ int tid_opaque() { int t = threadIdx.x; asm volatile("" : "+v"(t)); return t; }
__device__ __forceinline__ unsigned char* opq(unsigned char* p) { asm volatile("" : "+s"(p)); return p; }
__device__ __forceinline__ float rdl(float v, int k) { return __builtin_bit_cast(float, __builtin_amdgcn_readlane(__builtin_bit_cast(int, v), k)); }
__device__ __forceinline__ float sigmoidf_(float x) { return 1.0f / (1.0f + __expf(-x)); }

#define XB_TMO      128
#define XB_XCNT(j)  (256  + 64 * (j))
#define XB_XSUB(j)  (1280 + 64 * (j))
#define XB_XGEN(j)  (2304 + 64 * (j))
#define XB_TOP      3328
#define XB_TOPGEN   3392
#define XCD_BAR_WORDS 3456
#define XB_SPIN_CAP (1u << 22)
__device__ __forceinline__ unsigned xb_ld(unsigned* p)              { return __hip_atomic_load(p, __ATOMIC_RELAXED, __HIP_MEMORY_SCOPE_AGENT); }
__device__ __forceinline__ unsigned xb_add(unsigned* p, unsigned v) { return __hip_atomic_fetch_add(p, v, __ATOMIC_RELAXED, __HIP_MEMORY_SCOPE_AGENT); }
__device__ __forceinline__ unsigned xb_xcc_id() { return (unsigned)__builtin_amdgcn_s_getreg((3 << 11) | 20) & 0xFu; }
#define XB_SPIN(cond, bar) do { unsigned _sp = 0; while (cond) { __builtin_amdgcn_s_sleep(1); \
    if ((++_sp & 255u) == 0u) { if (xb_ld(&(bar)[XB_TMO])) break; if (_sp > XB_SPIN_CAP) { atomicAdd(&(bar)[XB_TMO], 1u); break; } } } } while (0)
struct XcdBarrier { unsigned* bar; unsigned x; volatile LAS unsigned* st; };
__device__ __forceinline__ XcdBarrier xcd_barrier_post(unsigned* bar, volatile LAS unsigned* st) {
    XcdBarrier b; b.bar = bar; b.x = xb_xcc_id(); b.st = st;
    if (threadIdx.x == 0) (void)xb_add(&bar[XB_XCNT(b.x)], 1u);
    return b;
}
__device__ __forceinline__ void xcd_barrier_complete(unsigned* bar, unsigned x, unsigned& nloc, unsigned& nx) {
    const unsigned G = gridDim.x * gridDim.y * gridDim.z;
    unsigned sum, cnt, mine, sp = 0u;
    for (;;) {
        sum = 0u; cnt = 0u; mine = 0u;
#pragma unroll
        for (unsigned j = 0; j < 16; ++j) { const unsigned c = xb_ld(&bar[XB_XCNT(j)]); sum += c; cnt += (c > 0u) ? 1u : 0u; mine = (j == x) ? c : mine; }
        if (sum == G) break;
        __builtin_amdgcn_s_sleep(1);
        if ((++sp & 255u) == 0u) { if (xb_ld(&bar[XB_TMO])) break; if (sp > XB_SPIN_CAP) { atomicAdd(&bar[XB_TMO], 1u); break; } }
    }
    nloc = mine > 0u ? mine : 1u; nx = cnt > 0u ? cnt : 1u;
}
__device__ __forceinline__ void xcd_barrier(const XcdBarrier& b) {
    asm volatile("s_waitcnt vmcnt(0)" ::: "memory");
    __syncthreads();
    if (threadIdx.x == 0) {
        unsigned* bar = b.bar;
        __builtin_amdgcn_s_waitcnt(0);
        unsigned nloc = b.st[0], nx = b.st[1];
        if (nloc == 0u) { xcd_barrier_complete(bar, b.x, nloc, nx); b.st[0] = nloc; b.st[1] = nx; }
        const unsigned old = xb_add(&bar[XB_XSUB(b.x)], 1u);
        const unsigned gen = old / nloc;
        if (old + 1u == (gen + 1u) * nloc) {
            __builtin_amdgcn_fence(__ATOMIC_RELEASE, "agent");
            asm volatile("s_waitcnt vmcnt(0)" ::: "memory");
            const unsigned og = xb_add(&bar[XB_TOP], 1u);
            const unsigned tg = og / nx;
            if (og + 1u == (tg + 1u) * nx) xb_add(&bar[XB_TOPGEN], 1u);
            else XB_SPIN(xb_ld(&bar[XB_TOPGEN]) == tg, bar);
            __builtin_amdgcn_fence(__ATOMIC_ACQUIRE, "agent");
            xb_add(&bar[XB_XGEN(b.x)], 1u);
            asm volatile("s_waitcnt vmcnt(0)" ::: "memory");
        } else {
            XB_SPIN(xb_ld(&bar[XB_XGEN(b.x)]) == gen, bar);
            __builtin_amdgcn_fence(__ATOMIC_ACQUIRE, "agent");
            asm volatile("s_waitcnt vmcnt(0)" ::: "memory");
        }
    }
    __syncthreads();
}

struct Args { const float* in[38]; float* out; unsigned char* ws; int ph_lo, ph_hi; };
enum { I_X = 0, I_C, I_CTX, I_CCTX, I_N1G, I_N2G, I_ADAW, I_ADAB, I_EVWIN, I_EVWOUT, I_RWMU, I_RWW0, I_RWW2, I_RWA0, I_RWA2, I_RWG2, I_RWKK, I_RWKA, I_RWRK,
       I_GNW, I_GNB, I_QN, I_KN, I_LAM, I_SUBLN, I_SGWIN, I_SGBIN, I_SGLNG, I_SGLNB, I_SGWS, I_SGBS, I_SGWOUT, I_RTW, I_RTB, I_W1, I_B1, I_W2, I_B2 };

struct Tok { int b, t, T, modrow; };
__device__ __forceinline__ Tok tokinfo(int g) {
    Tok k;
    if (g < NCTX) { k.b = g >> 8; k.t = g & 255; k.T = TC; k.modrow = 16; }
    else { const int q = g - NCTX; k.b = q >> 11; k.t = q & 2047; k.T = TL; k.modrow = k.b; }
    return k;
}

__device__ __forceinline__ void p0_transpose_item(const float* W, int K, int N, bf16_t* WT, LAS float* scr, int item, int lane) {
    const int nblk = N / 32, kb = item / nblk, nb = item % nblk, k0 = 64 * kb, n0 = 32 * nb;
#pragma unroll 8
    for (int i = 0; i < 32; ++i) { const int kk = 2 * i + (lane >> 5); scr[kk * 33 + (lane & 31)] = W[(size_t)(k0 + kk) * N + n0 + (lane & 31)]; }
    asm volatile("s_waitcnt lgkmcnt(0)" ::: "memory");
    const int c = lane & 7;
#pragma unroll
    for (int j = 0; j < 4; ++j) { const int n = (lane >> 3) + 8 * j; const LAS float* s = scr + (8 * c) * 33 + n;
        u32x4 o; o.x = pk2(s[0 * 33], s[1 * 33]); o.y = pk2(s[2 * 33], s[3 * 33]); o.z = pk2(s[4 * 33], s[5 * 33]); o.w = pk2(s[6 * 33], s[7 * 33]);
        *(u32x4*)(WT + (size_t)(n0 + n) * K + k0 + 8 * c) = o; }
    asm volatile("s_waitcnt lgkmcnt(0)" ::: "memory");
}

__device__ __forceinline__ void ph_prologue(const Args& A, LAS unsigned char* lds, int bid, int nb) {
    const int tid = tid_opaque(), lane = tid & 63, wid = tid >> 6;
    unsigned char* ws = opq(A.ws);
    {
        LAS float* s = (LAS float*)lds;
        LAS float* red = (LAS float*)(lds + 17 * 1024 * 4);
        for (int i = tid; i < 17 * 1024; i += NTHREADS) {
            const int r = i >> 10, k = i & 1023;
            const float x = (r < 16) ? A.in[I_C][r * 1024 + k] : A.in[I_CCTX][k];
            s[i] = x / (1.0f + __expf(-x));
        }
        __syncthreads();
        float* mod = (float*)(ws + WS_MOD);
        for (int u = bid; u < 4 * 96; u += nb) {
            const int l = u / 96, cg = u % 96, col = cg * 64 + lane;
            float acc[17];
#pragma unroll
            for (int r = 0; r < 17; ++r) acc[r] = 0.f;
            const float* wp = A.in[I_ADAW] + (size_t)l * 1024 * 6144 + col;
            for (int k = wid * 128; k < wid * 128 + 128; ++k) {
                const float wv = wp[(size_t)k * 6144];
#pragma unroll
                for (int r = 0; r < 17; ++r) acc[r] += s[r * 1024 + k] * wv;
            }
#pragma unroll
            for (int r = 0; r < 17; ++r) red[(wid * 17 + r) * 64 + lane] = acc[r];
            __syncthreads();
            for (int i = tid; i < 17 * 64; i += NTHREADS) {
                const int r = i >> 6, ln = i & 63; float v = 0.f;
#pragma unroll
                for (int w = 0; w < 8; ++w) v += red[(w * 17 + r) * 64 + ln];
                const int cc = cg * 64 + ln;
                mod[((size_t)l * 17 + r) * 6144 + cc] = v + A.in[I_ADAB][l * 6144 + cc];
            }
            __syncthreads();
        }
    }
    __syncthreads();
    {
        LAS float* scr = (LAS float*)(lds + wid * 16384);
        const int gw = bid * NWAVES + wid, NGW = nb * NWAVES;
        constexpr int IT_WIN = 16 * (EVC / 32), IT_SQ = 16 * 32, IT_SGIN = 16 * 64, IT_W1 = 16 * 64, IT_W2 = 16 * 32;
        constexpr int N0 = 2 * IT_WIN, N1 = N0 + 2 * IT_SQ, N2 = N1 + 2 * IT_SGIN, N3 = N2 + 2 * IT_SQ, N4 = N3 + 128 * IT_W1, N5 = N4 + 128 * IT_W2;
        for (int it = gw; it < N5; it += NGW) {
            if (it < N0) { const int m = it / IT_WIN, r = it % IT_WIN; p0_transpose_item(A.in[I_EVWIN] + (size_t)m * DM * EVC, DM, EVC, (bf16_t*)(ws + WS_WIN) + (size_t)m * EVC * DM, scr, r, lane); }
            else if (it < N1) { const int q = it - N0, m = q / IT_SQ, r = q % IT_SQ; p0_transpose_item(A.in[I_EVWOUT] + (size_t)m * DM * DM, DM, DM, (bf16_t*)(ws + WS_WOUT) + (size_t)m * DM * DM, scr, r, lane); }
            else if (it < N2) { const int q = it - N1, m = q / IT_SGIN, r = q % IT_SGIN; p0_transpose_item(A.in[I_SGWIN] + (size_t)m * DM * 2048, DM, 2048, (bf16_t*)(ws + WS_SGIN) + (size_t)m * 2048 * DM, scr, r, lane); }
            else if (it < N3) { const int q = it - N2, m = q / IT_SQ, r = q % IT_SQ; p0_transpose_item(A.in[I_SGWOUT] + (size_t)m * DM * DM, DM, DM, (bf16_t*)(ws + WS_SGOUT) + (size_t)m * DM * DM, scr, r, lane); }
            else if (it < N4) { const int q = it - N3, m = q / IT_W1, r = q % IT_W1; p0_transpose_item(A.in[I_W1] + (size_t)m * DM * 2048, DM, 2048, (bf16_t*)(ws + WS_W1) + (size_t)m * 2048 * DM, scr, r, lane); }
            else { const int q = it - N4, m = q / IT_W2, r = q % IT_W2; p0_transpose_item(A.in[I_W2] + (size_t)m * DM * DM, DM, DM, (bf16_t*)(ws + WS_W2) + (size_t)m * DM * DM, scr, r, lane); }
        }
    }
    {
        const size_t gt = (size_t)bid * NTHREADS + tid, GT = (size_t)nb * NTHREADS;
        f32x4* H4 = (f32x4*)(ws + WS_H);
        const f32x4* c4 = (const f32x4*)A.in[I_CTX]; const f32x4* x4 = (const f32x4*)A.in[I_X];
        constexpr size_t NC4 = (size_t)NCTX * DM / 4, NT4 = (size_t)NTOK * DM / 4;
        for (size_t i = gt; i < NT4; i += GT) H4[i] = (i < NC4) ? c4[i] : x4[i - NC4];
        float* rt = (float*)(ws + WS_RTWT);
        for (size_t i = gt; i < (size_t)4 * 32 * 1024; i += GT) { const int l = (int)(i >> 15), e = (int)(i >> 10) & 31, k = (int)i & 1023; rt[i] = A.in[I_RTW][((size_t)l * 1024 + k) * 32 + e]; }
    }
}

template <bool ROUTER>
__device__ __forceinline__ void ph_norm(const Args& A, int l, int row_lo, int bid, int nb) {
    const int tid = tid_opaque(), lane = tid & 63, wid = tid >> 6;
    unsigned char* ws = opq(A.ws);
    const float* H = (const float*)(ws + WS_H);
    const float* mod = (const float*)(ws + WS_MOD);
    bf16_t* abf = (bf16_t*)(ws + WS_ABF);
    const float* gp = A.in[ROUTER ? I_N2G : I_N1G] + l * 1024;
    const int c_shift = ROUTER ? 3 : 0, c_scale = ROUTER ? 4 : 1;
    for (int row = row_lo + bid * NWAVES + wid; row < NTOK; row += nb * NWAVES) {
        const Tok tk = tokinfo(row);
        const float* mrow = mod + ((size_t)l * 17 + tk.modrow) * 6144;
        f32x4 v[4]; float ss = 0.f;
#pragma unroll
        for (int j = 0; j < 4; ++j) { v[j] = *(const f32x4*)(H + (size_t)row * DM + j * 256 + lane * 4); ss += (v[j].x * v[j].x + v[j].y * v[j].y) + (v[j].z * v[j].z + v[j].w * v[j].w); }
        const float rstd = rsqrtf(wave_sum(ss) * (1.0f / DM) + 1e-6f);
#pragma unroll
        for (int j = 0; j < 4; ++j) {
            const int col = j * 256 + lane * 4;
            const f32x4 g = *(const f32x4*)(gp + col), sc = *(const f32x4*)(mrow + c_scale * 1024 + col), sh = *(const f32x4*)(mrow + c_shift * 1024 + col);
            v[j] = (v[j] * rstd * g) * (sc + 1.0f) + sh;
            u32x2 o; o.x = pk2(v[j].x, v[j].y); o.y = pk2(v[j].z, v[j].w);
            *(u32x2*)(abf + (size_t)row * DM + col) = o;
        }
        if constexpr (ROUTER) {
            const float* rt = (const float*)(ws + WS_RTWT) + (size_t)l * 32 * 1024;
            float tv[4] = {-3.0e38f, -3.0e38f, -3.0e38f, -3.0e38f}; int ti[4] = {0, 0, 0, 0};
#pragma unroll 2
            for (int e = 0; e < 32; ++e) {
                float p = 0.f;
#pragma unroll
                for (int j = 0; j < 4; ++j) { const f32x4 w = *(const f32x4*)(rt + e * 1024 + j * 256 + lane * 4); p += (v[j].x * w.x + v[j].y * w.y) + (v[j].z * w.z + v[j].w * w.w); }
                const float lgv = wave_sum(p) + A.in[I_RTB][l * 32 + e];
                if (lgv > tv[3]) {
                    tv[3] = lgv; ti[3] = e;
                    if (tv[3] > tv[2]) { const float a = tv[2]; tv[2] = tv[3]; tv[3] = a; const int b = ti[2]; ti[2] = ti[3]; ti[3] = b; }
                    if (tv[2] > tv[1]) { const float a = tv[1]; tv[1] = tv[2]; tv[2] = a; const int b = ti[1]; ti[1] = ti[2]; ti[2] = b; }
                    if (tv[1] > tv[0]) { const float a = tv[0]; tv[0] = tv[1]; tv[1] = a; const int b = ti[0]; ti[0] = ti[1]; ti[1] = b; }
                }
            }
            const float e1 = __expf(tv[1] - tv[0]), e2 = __expf(tv[2] - tv[0]), e3 = __expf(tv[3] - tv[0]);
            const float inv = 1.0f / (1.0f + e1 + e2 + e3);
            if (lane == 0) {
                int* te = (int*)(ws + WS_TOKE) + (size_t)row * 4; float* tg = (float*)(ws + WS_TOKG) + (size_t)row * 4;
                te[0] = ti[0]; te[1] = ti[1]; te[2] = ti[2]; te[3] = ti[3];
                tg[0] = inv; tg[1] = e1 * inv; tg[2] = e2 * inv; tg[3] = e3 * inv;
                unsigned* cnt = (unsigned*)(ws + WS_CTL) + CW_CNT + l * 32;
#pragma unroll
                for (int k = 0; k < 4; ++k) atomicAdd(cnt + ti[k], 1u);
            }
        }
    }
}

__device__ __forceinline__ void gemm_tile128(const bf16_t* At, int lda, const bf16_t* Bt, int ldb, int K, f32x4 (&acc)[4][2]) {
    const int tid = tid_opaque(), wid = tid >> 6, lane = tid & 63, wr = wid >> 2, wc = wid & 3, fr = lane & 15, fq = lane >> 4;
    const bf16_t* a0 = At + (size_t)(wr * 64 + fr) * lda + fq * 8;
    const bf16_t* b0 = Bt + (size_t)(wc * 32 + fr) * ldb + fq * 8;
#pragma unroll
    for (int i = 0; i < 4; ++i)
#pragma unroll
        for (int j = 0; j < 2; ++j) acc[i][j] = (f32x4){0.f, 0.f, 0.f, 0.f};
#pragma unroll 2
    for (int k = 0; k < K; k += 32) {
        bf16x8 af[4], bfr[2];
#pragma unroll
        for (int i = 0; i < 4; ++i) af[i] = *(const bf16x8*)(a0 + (size_t)i * 16 * lda + k);
#pragma unroll
        for (int j = 0; j < 2; ++j) bfr[j] = *(const bf16x8*)(b0 + (size_t)j * 16 * ldb + k);
#pragma unroll
        for (int i = 0; i < 4; ++i)
#pragma unroll
            for (int j = 0; j < 2; ++j) acc[i][j] = __builtin_amdgcn_mfma_f32_16x16x32_bf16(bfr[j], af[i], acc[i][j], 0, 0, 0);
    }
}
#define TILE_COORDS const int _tid = tid_opaque(), _wid = _tid >> 6, _lane = _tid & 63, _wr = _wid >> 2, _wc = _wid & 3, _fr = _lane & 15, _fq = _lane >> 4
#define TILE_ROW(i) (_wr * 64 + (i) * 16 + _fr)
#define TILE_COL(j) (_wc * 32 + (j) * 16 + _fq * 4)

__device__ __forceinline__ void ph_gemm_win(const Args& A, int j, int row_lo, int bid, int nb) {
    unsigned char* ws = opq(A.ws); TILE_COORDS;
    const bf16_t* abf = (const bf16_t*)(ws + WS_ABF); const bf16_t* wt = (const bf16_t*)(ws + WS_WIN) + (size_t)j * EVC * DM;
    bf16_t* Z = (bf16_t*)(ws + WS_Z);
    const int tm0 = row_lo / 128, tm = NTOK / 128 - tm0, tn = EVC / 128;
    for (int u = bid; u < tm * tn; u += nb) {
        const int pm = tm0 + u / tn, pn = u % tn;
        f32x4 acc[4][2];
        gemm_tile128(abf + (size_t)pm * 128 * DM, DM, wt + (size_t)pn * 128 * DM, DM, DM, acc);
#pragma unroll
        for (int i = 0; i < 4; ++i)
#pragma unroll
            for (int jj = 0; jj < 2; ++jj) {
                u32x2 o; o.x = pk2(acc[i][jj].x, acc[i][jj].y); o.y = pk2(acc[i][jj].z, acc[i][jj].w);
                *(u32x2*)(Z + (size_t)(pm * 128 + TILE_ROW(i)) * EVC + pn * 128 + TILE_COL(jj)) = o;
            }
    }
}

__device__ __forceinline__ void ph_rwkv_feat(const Args& A, int j, int row_lo, LAS unsigned char* lds, int bid, int nb) {
    unsigned char* ws = opq(A.ws);
    const int tid = tid_opaque(), c = tid;
    LAS float* zs = (LAS float*)lds;
    const bf16_t* Z = (const bf16_t*)(ws + WS_Z);
    const float* mu = A.in[I_RWMU] + (size_t)j * 2 * RWC;
    const float* w0 = A.in[I_RWW0] + (size_t)j * 2 * 512; const float* w2 = A.in[I_RWW2] + (size_t)j * 2 * 64 * 512;
    const float* a0 = A.in[I_RWA0] + (size_t)j * 2 * 512; const float* a2 = A.in[I_RWA2] + (size_t)j * 2 * 64 * 512;
    const float* g2 = A.in[I_RWG2] + (size_t)j * 128 * 512;
    const float kkw = A.in[I_RWKK][j * 512 + c], kaw = A.in[I_RWKA][j * 512 + c], rkw = A.in[I_RWRK][j * 512 + c];
    const float w00 = w0[c], w01 = w0[512 + c], a00 = a0[c], a01 = a0[512 + c];
    float* F = (float*)(ws + WS_F);
    for (int grp = row_lo / 4 + bid; grp < NTOK / 4; grp += nb) {
        const int g0 = grp * 4; const Tok tk = tokinfo(g0);
        for (int col = tid; col < RWC; col += NTHREADS) {
            const float m0 = mu[col], m1 = mu[RWC + col];
            float z[6];
#pragma unroll
            for (int i = 0; i < 6; ++i) { const int tt = tk.t - 1 + i; z[i] = (tt >= 0 && tt < tk.T) ? bf2f(Z[(size_t)(g0 - 1 + i) * EVC + col]) : 0.f; }
#pragma unroll
            for (int k = 0; k < 4; ++k) zs[k * RWC + col] = z[k + 1] + m0 * (z[k] - z[k + 1]) + m1 * (z[k + 2] - z[k + 1]);
        }
        __syncthreads();
        for (int i = tid; i < 1024; i += NTHREADS) {
            const int k = i >> 8, q = i & 255;
            if (q < 128) { const int idx = k * RWC + 1536 + q; zs[idx] = tanhf(zs[idx]); }
            else { const int idx = k * RWC + 1792 + (q - 128); zs[idx] = sigmoidf_(zs[idx]); }
        }
        __syncthreads();
        float aw0[4], aw1[4], aa0[4], aa1[4], ag[4];
#pragma unroll
        for (int k = 0; k < 4; ++k) { aw0[k] = 0.f; aw1[k] = 0.f; aa0[k] = 0.f; aa1[k] = 0.f; ag[k] = 0.f; }
        for (int r = 0; r < 64; ++r) {
            const float w20 = w2[r * 512 + c], w21 = w2[(64 + r) * 512 + c], a20 = a2[r * 512 + c], a21 = a2[(64 + r) * 512 + c];
#pragma unroll
            for (int k = 0; k < 4; ++k) {
                aw0[k] += zs[k * RWC + 1536 + r] * w20; aw1[k] += zs[k * RWC + 1600 + r] * w21;
                aa0[k] += zs[k * RWC + 1664 + r] * a20; aa1[k] += zs[k * RWC + 1728 + r] * a21;
            }
        }
        for (int r = 0; r < 128; ++r) {
            const float gv = g2[r * 512 + c];
#pragma unroll
            for (int k = 0; k < 4; ++k) ag[k] += zs[k * RWC + 1792 + r] * gv;
        }
#pragma unroll
        for (int k = 0; k < 4; ++k) {
            const float r_ = zs[k * RWC + c], k_ = zs[k * RWC + 512 + c], v_ = zs[k * RWC + 1024 + c];
            float dec[2], av[2];
#pragma unroll
            for (int d = 0; d < 2; ++d) {
                const float x = (d ? w01 : w00) + (d ? aw1[k] : aw0[k]);
                const float y = -x;
                const float sp = fmaxf(y, 0.f) + log1pf(__expf(-fabsf(y)));
                const float w = -sp - 0.5f;
                dec[d] = __expf(-__expf(w));
                av[d] = sigmoidf_((d ? a01 : a00) + (d ? aa1[k] : aa0[k]));
            }
            float kk = k_ * kkw;
            const float nrm = sqrtf(wave_sum(kk * kk));
            kk = kk / fmaxf(nrm, 1e-12f);
            const float kd0 = k_ * (1.0f + (av[0] - 1.0f) * kaw), kd1 = k_ * (1.0f + (av[1] - 1.0f) * kaw);
            const float s0 = wave_sum(r_ * kd0 * rkw), s1 = wave_sum(r_ * kd1 * rkw);
            const size_t o = (size_t)(g0 + k) * 512 + c; const size_t FS = (size_t)NTOK * 512;
            F[0 * FS + o] = r_; F[1 * FS + o] = v_; F[2 * FS + o] = kk; F[3 * FS + o] = ag[k]; F[4 * FS + o] = (s0 + s1) * v_;
            F[5 * FS + o] = dec[0]; F[6 * FS + o] = dec[1]; F[7 * FS + o] = kd0; F[8 * FS + o] = kd1; F[9 * FS + o] = kk * av[0]; F[10 * FS + o] = kk * av[1];
        }
        __syncthreads();
    }
}

__device__ __forceinline__ void ph_scan_naive(const Args& A, int bid, int nb) {
    unsigned char* ws = opq(A.ws);
    const int tid = tid_opaque(), lane = tid & 63, wid = tid >> 6;
    if (wid != 0) return;
    const float* F = (const float*)(ws + WS_F); const size_t FS = (size_t)NTOK * 512;
    float* YS = (float*)(ws + WS_YS);
    for (int inst = bid; inst < 256; inst += nb) {
        const int dir = inst & 1, h = (inst >> 1) & 7, b = inst >> 4;
        float S[64];
#pragma unroll
        for (int k = 0; k < 64; ++k) S[k] = 0.f;
        const float* Fw = F + (5 + dir) * FS; const float* Fk = F + (7 + dir) * FS; const float* Fb = F + (9 + dir) * FS;
        float* Y = YS + dir * FS;
        for (int s = 0; s < TC + TL; ++s) {
            int g;
            if (s < TC) g = b * TC + (dir ? (TC - 1 - s) : s);
            else { const int q = s - TC; g = NCTX + b * TL + (dir ? (TL - 1 - q) : q); }
            const size_t o = (size_t)g * 512 + h * 64 + lane;
            const float r_ = F[o], v_ = F[FS + o], kk_ = F[2 * FS + o], w_ = Fw[o], kd_ = Fk[o], b_ = Fb[o];
            float sa = 0.f;
#pragma unroll
            for (int k = 0; k < 64; ++k) sa -= S[k] * rdl(kk_, k);
            float y = 0.f;
#pragma unroll
            for (int k = 0; k < 64; ++k) {
                float sv = S[k] * rdl(w_, k);
                sv += sa * rdl(b_, k);
                sv += v_ * rdl(kd_, k);
                S[k] = sv;
                y += sv * rdl(r_, k);
            }
            Y[o] = y;
        }
    }
}

__device__ __forceinline__ void ph_qk(const Args& A, int j, int row_lo, int bid, int nb) {
    unsigned char* ws = opq(A.ws);
    const int tid = tid_opaque(), lane = tid & 63, wid = tid >> 6;
    const bf16_t* Z = (const bf16_t*)(ws + WS_Z);
    float* QF = (float*)(ws + WS_QF); float* KF = (float*)(ws + WS_KF); float* VF = (float*)(ws + WS_VF);
    const float qn = A.in[I_QN][j * 64 + lane], kn = A.in[I_KN][j * 64 + lane];
    const float invf = __powf(10000.0f, -(float)(lane & 15) / 16.0f);
    for (int g = row_lo + bid; g < NTOK; g += nb) {
        const Tok tk = tokinfo(g);
        const bf16_t* zr = Z + (size_t)g * EVC + RWC;
        VF[(size_t)g * 512 + tid] = bf2f(zr[1024 + tid]);
#pragma unroll
        for (int ss = 0; ss < 2; ++ss) {
            const int sh = wid * 2 + ss, isk = sh >> 3, s = sh & 7;
            const float x = bf2f(zr[isk * 512 + s * 64 + lane]);
            const float ms = wave_sum(x * x) * (1.0f / 64.0f);
            float y = x * rsqrtf(ms + 1e-6f) * (isk ? kn : qn);
            if (tk.T == TL) {
                const float pos = (float)((lane & 32) ? (tk.t & 63) : (tk.t >> 6));
                const float ang = pos * invf;
                float sn, cs; __sincosf(ang, &sn, &cs);
                const float other = __shfl_xor(y, 16);
                y = (lane & 16) ? (y * cs + other * sn) : (y * cs - other * sn);
            }
            (isk ? KF : QF)[(size_t)g * 512 + s * 64 + lane] = y;
        }
    }
}

__device__ __forceinline__ void ph_attn_naive(const Args& A, bool want_ctx, int bid, int nb) {
    unsigned char* ws = opq(A.ws);
    const int tid = tid_opaque();
    const float* QF = (const float*)(ws + WS_QF); const float* KF = (const float*)(ws + WS_KF); const float* VF = (const float*)(ws + WS_VF);
    float* OP = (float*)(ws + WS_OP);
    const int nlat = 512 * 4;
    const int nunits = nlat + (want_ctx ? 256 : 0);
    for (int u = bid; u < nunits; u += nb) {
        int combo, q, nkeys, isctx;
        if (u < nlat) { combo = u >> 2; q = (u & 3) * 512 + tid; nkeys = TC + TL; isctx = 0; }
        else { combo = (u - nlat) * 2 + (tid >> 8); q = tid & 255; nkeys = TC; isctx = 1; }
        const int qr = combo & 3, m = (combo >> 2) & 1, h = (combo >> 3) & 3, b = combo >> 5, s = h * 2 + m;
        const int qtok = isctx ? b * TC + q : NCTX + b * TL + q;
        float qv[64];
#pragma unroll
        for (int d = 0; d < 64; d += 4) { const f32x4 t = *(const f32x4*)(QF + (size_t)qtok * 512 + s * 64 + d); qv[d] = t.x * 0.125f; qv[d + 1] = t.y * 0.125f; qv[d + 2] = t.z * 0.125f; qv[d + 3] = t.w * 0.125f; }
        float acc[32];
#pragma unroll
        for (int e = 0; e < 32; ++e) acc[e] = 0.f;
        float mrun = -3.0e38f, lrun = 0.f;
#pragma unroll 1
        for (int n0 = 0; n0 < nkeys; n0 += 2) {
            const int kt0 = (n0 < TC) ? b * TC + n0 : NCTX + b * TL + (n0 - TC);
            float sc[2];
#pragma unroll
            for (int i = 0; i < 2; ++i) {
                const float* kp = KF + (size_t)(kt0 + i) * 512 + s * 64; float a = 0.f;
#pragma unroll
                for (int d = 0; d < 64; d += 4) { const f32x4 t = *(const f32x4*)(kp + d); a += (qv[d] * t.x + qv[d + 1] * t.y) + (qv[d + 2] * t.z + qv[d + 3] * t.w); }
                sc[i] = a;
            }
            const float mnew = fmaxf(mrun, fmaxf(sc[0], sc[1]));
            const float corr = __expf(mrun - mnew);
            const float p0 = __expf(sc[0] - mnew), p1 = __expf(sc[1] - mnew);
            lrun = lrun * corr + p0 + p1;
            mrun = mnew;
            const float* vp0 = VF + (size_t)kt0 * 512 + h * 128 + qr * 32; const float* vp1 = vp0 + 512;
#pragma unroll
            for (int e = 0; e < 32; e += 4) {
                const f32x4 t0 = *(const f32x4*)(vp0 + e), t1 = *(const f32x4*)(vp1 + e);
                acc[e] = acc[e] * corr + p0 * t0.x + p1 * t1.x; acc[e + 1] = acc[e + 1] * corr + p0 * t0.y + p1 * t1.y;
                acc[e + 2] = acc[e + 2] * corr + p0 * t0.z + p1 * t1.z; acc[e + 3] = acc[e + 3] * corr + p0 * t0.w + p1 * t1.w;
            }
        }
        const float inv = 1.0f / lrun;
        float* op = OP + (size_t)m * NTOK * 512 + (size_t)qtok * 512 + h * 128 + qr * 32;
#pragma unroll
        for (int e = 0; e < 32; e += 4) *(f32x4*)(op + e) = (f32x4){acc[e] * inv, acc[e + 1] * inv, acc[e + 2] * inv, acc[e + 3] * inv};
    }
}

__device__ __forceinline__ void ph_merge(const Args& A, int l, int row_lo, LAS unsigned char* lds, int bid, int nb) {
    unsigned char* ws = opq(A.ws);
    const int j = l >> 1;
    const int tid = tid_opaque(), lane = tid & 63, wid = tid >> 6, c = tid;
    LAS float* sh = (LAS float*)lds;
    const float lam_init = 0.8f - 0.6f * __expf(-0.3f * (float)l);
    if (wid == 0) {
        const float* lp = A.in[I_LAM] + j * 4 * 64;
        const float s01 = wave_sum(lp[lane] * lp[64 + lane]), s23 = wave_sum(lp[128 + lane] * lp[192 + lane]);
        if (lane == 0) sh[8] = __expf(s01) - __expf(s23) + lam_init;
    }
    __syncthreads();
    const float lam = sh[8];
    const float* F = (const float*)(ws + WS_F); const size_t FS = (size_t)NTOK * 512;
    const float* YS = (const float*)(ws + WS_YS); const float* OP = (const float*)(ws + WS_OP);
    bf16_t* CAT = (bf16_t*)(ws + WS_CAT);
    const float gnw = A.in[I_GNW][j * 512 + c], gnb = A.in[I_GNB][j * 512 + c], sub = A.in[I_SUBLN][j * 128 + (c & 127)];
    for (int g = row_lo + bid; g < NTOK; g += nb) {
        const size_t o = (size_t)g * 512 + c;
        const float y = YS[o] + YS[FS + o];
        const float mu = wave_sum(y) * (1.0f / 64.0f);
        const float dv = y - mu;
        const float var = wave_sum(dv * dv) * (1.0f / 64.0f);
        const float yn = dv * rsqrtf(var + 64e-5f) * gnw + gnb;
        const float ya = (yn + F[4 * FS + o]) * F[3 * FS + o];
        const float od = OP[o] - lam * OP[FS + o];
        const float ssw = wave_sum(od * od);
        if (lane == 0) sh[wid] = ssw;
        __syncthreads();
        const float ms = (sh[wid & ~1] + sh[wid | 1]) * (1.0f / 128.0f);
        const float ob = od * rsqrtf(ms + 1e-6f) * sub * (1.0f - lam_init);
        CAT[(size_t)g * DM + c] = (bf16_t)f2bf(ya);
        CAT[(size_t)g * DM + 512 + c] = (bf16_t)f2bf(ob);
        __syncthreads();
    }
}

__device__ __forceinline__ void ph_gemm_out(const Args& A, int l, const bf16_t* X, const bf16_t* wt, int row_lo, int bid, int nb) {
    unsigned char* ws = opq(A.ws); TILE_COORDS;
    float* H = (float*)(ws + WS_H); const float* mod = (const float*)(ws + WS_MOD);
    const int tm0 = row_lo / 128, tm = NTOK / 128 - tm0, tn = DM / 128;
    for (int u = bid; u < tm * tn; u += nb) {
        const int pm = tm0 + u / tn, pn = u % tn;
        f32x4 acc[4][2];
        gemm_tile128(X + (size_t)pm * 128 * DM, DM, wt + (size_t)pn * 128 * DM, DM, DM, acc);
        const Tok tk = tokinfo(pm * 128);
        const float* gate = mod + ((size_t)l * 17 + tk.modrow) * 6144 + 2 * 1024;
#pragma unroll
        for (int i = 0; i < 4; ++i)
#pragma unroll
            for (int jj = 0; jj < 2; ++jj) {
                const int col = pn * 128 + TILE_COL(jj);
                float* hp = H + (size_t)(pm * 128 + TILE_ROW(i)) * DM + col;
                const f32x4 gv = *(const f32x4*)(gate + col);
                *(f32x4*)hp = *(const f32x4*)hp + gv * acc[i][jj];
            }
    }
}

__device__ __forceinline__ void ph_gemm_sgin(const Args& A, int j, int row_lo, int bid, int nb) {
    unsigned char* ws = opq(A.ws); TILE_COORDS;
    const bf16_t* abf = (const bf16_t*)(ws + WS_ABF); const bf16_t* wt = (const bf16_t*)(ws + WS_SGIN) + (size_t)j * 2048 * DM;
    float* Z2 = (float*)(ws + WS_Z2); const float* bias = A.in[I_SGBIN] + j * 2048;
    const int tm0 = row_lo / 128, tm = NTOK / 128 - tm0, tn = 2048 / 128;
    for (int u = bid; u < tm * tn; u += nb) {
        const int pm = tm0 + u / tn, pn = u % tn;
        f32x4 acc[4][2];
        gemm_tile128(abf + (size_t)pm * 128 * DM, DM, wt + (size_t)pn * 128 * DM, DM, DM, acc);
#pragma unroll
        for (int i = 0; i < 4; ++i)
#pragma unroll
            for (int jj = 0; jj < 2; ++jj) {
                const int col = pn * 128 + TILE_COL(jj);
                const f32x4 bv = *(const f32x4*)(bias + col);
                f32x4 v = acc[i][jj] + bv;
#pragma unroll
                for (int r = 0; r < 4; ++r) v[r] = 0.5f * v[r] * (1.0f + erff(v[r] * 0.70710678118654752f));
                *(f32x4*)(Z2 + (size_t)(pm * 128 + TILE_ROW(i)) * 2048 + col) = v;
            }
    }
}
__device__ __forceinline__ void ph_sgu_ln(const Args& A, int j, int row_lo, int bid, int nb) {
    unsigned char* ws = opq(A.ws);
    const int tid = tid_opaque(), lane = tid & 63, wid = tid >> 6;
    const float* Z2 = (const float*)(ws + WS_Z2); float* VN = (float*)(ws + WS_VN);
    const float* lg = A.in[I_SGLNG] + j * 1024; const float* lb = A.in[I_SGLNB] + j * 1024;
    for (int row = row_lo + bid * NWAVES + wid; row < NTOK; row += nb * NWAVES) {
        f32x4 v[4]; float s = 0.f;
#pragma unroll
        for (int q = 0; q < 4; ++q) { v[q] = *(const f32x4*)(Z2 + (size_t)row * 2048 + 1024 + q * 256 + lane * 4); s += (v[q].x + v[q].y) + (v[q].z + v[q].w); }
        const float mean = wave_sum(s) * (1.0f / 1024.0f); float s2 = 0.f;
#pragma unroll
        for (int q = 0; q < 4; ++q) { v[q] = v[q] - mean; s2 += (v[q].x * v[q].x + v[q].y * v[q].y) + (v[q].z * v[q].z + v[q].w * v[q].w); }
        const float rstd = rsqrtf(wave_sum(s2) * (1.0f / 1024.0f) + 1e-5f);
#pragma unroll
        for (int q = 0; q < 4; ++q) { const int col = q * 256 + lane * 4; *(f32x4*)(VN + (size_t)row * DM + col) = v[q] * rstd * *(const f32x4*)(lg + col) + *(const f32x4*)(lb + col); }
    }
}
__device__ __forceinline__ void ph_sgu_spatial(const Args& A, int j, int row_lo, LAS unsigned char* lds, int bid, int nb) {
    unsigned char* ws = opq(A.ws);
    const int tid = tid_opaque();
    const float* Z2 = (const float*)(ws + WS_Z2); const float* VN = (const float*)(ws + WS_VN); bf16_t* G = (bf16_t*)(ws + WS_G);
    LAS float* vt = (LAS float*)lds;
    LAS float* wl = (LAS float*)(lds + 65536);
    const int ch0 = row_lo / 128, nch = NTOK / 128 - ch0;
    for (int u = bid; u < nch * 8; u += nb) {
        const int ci = ch0 + u / 8, g = u % 8;
        const float* wsg = A.in[I_SGWS] + ((size_t)j * 8 + g) * 128 * 128;
        for (int i = tid; i < 128 * 32; i += NTHREADS) {
            const int q = i >> 5, c4 = (i & 31) * 4;
            *(LAS f32x4*)(vt + q * 128 + c4) = *(const f32x4*)(VN + (size_t)(ci * 128 + q) * DM + g * 128 + c4);
            *(LAS f32x4*)(wl + q * 128 + c4) = *(const f32x4*)(wsg + q * 128 + c4);
        }
        __syncthreads();
        const int c = tid & 127, pg = tid >> 7;
        float acc[32];
#pragma unroll
        for (int i = 0; i < 32; ++i) acc[i] = 0.f;
        for (int q = 0; q < 128; q += 4) {
            const float v0 = vt[q * 128 + c], v1 = vt[(q + 1) * 128 + c], v2 = vt[(q + 2) * 128 + c], v3 = vt[(q + 3) * 128 + c];
#pragma unroll
            for (int i = 0; i < 32; ++i) { const f32x4 w = *(const LAS f32x4*)(wl + (pg * 32 + i) * 128 + q); acc[i] += (w.x * v0 + w.y * v1) + (w.z * v2 + w.w * v3); }
        }
#pragma unroll
        for (int i = 0; i < 32; ++i) {
            const int p = pg * 32 + i; const size_t row = (size_t)ci * 128 + p;
            const float uu = Z2[row * 2048 + g * 128 + c];
            const float sv = acc[i] + A.in[I_SGBS][((size_t)j * 8 + g) * 128 + p];
            G[row * DM + g * 128 + c] = (bf16_t)f2bf(uu * sv);
        }
        __syncthreads();
    }
}

__device__ __forceinline__ int moe_layout(const Args& A, int l, LAS int* off  , LAS int* cntl  , LAS int* tile_e  ) {
    const int tid = tid_opaque();
    const unsigned* cnt = (const unsigned*)(A.ws + WS_CTL) + CW_CNT + l * 32;
    if (tid == 0) {
        int o = 0;
        for (int e = 0; e < 32; ++e) {
            const int n = (int)__hip_atomic_load(cnt + e, __ATOMIC_RELAXED, __HIP_MEMORY_SCOPE_AGENT);
            cntl[e] = n; off[e] = o;
            const int nt = (n + 255) >> 8;
            for (int t = 0; t < nt; ++t) tile_e[(o >> 8) + t] = e;
            o += nt * 256;
        }
        off[32] = o;
    }
    __syncthreads();
    return off[32] >> 8;
}
__device__ __forceinline__ void ph_moe_scatter(const Args& A, int l, int row_lo, LAS unsigned char* lds, int bid, int nb) {
    unsigned char* ws = opq(A.ws);
    const int tid = tid_opaque(), lane = tid & 63, wid = tid >> 6;
    LAS int* off = (LAS int*)lds; LAS int* cntl = off + 64; LAS int* tile_e = off + 128;
    moe_layout(A, l, off, cntl, tile_e);
    const bf16_t* abf = (const bf16_t*)(ws + WS_ABF); bf16_t* XP = (bf16_t*)(ws + WS_XP);
    const int* te = (const int*)(ws + WS_TOKE); int* rowof = (int*)(ws + WS_ROWOF);
    unsigned* cur = (unsigned*)(ws + WS_CTL) + CW_CUR + l * 32;
    const int ntask = (NTOK - row_lo) * 4;
    for (int task = bid * NWAVES + wid; task < ntask; task += nb * NWAVES) {
        const int g = row_lo + (task >> 2), k = task & 3;
        const int e = te[(size_t)g * 4 + k];
        int pos = 0;
        if (lane == 0) { pos = off[e] + (int)atomicAdd(cur + e, 1u); rowof[(size_t)g * 4 + k] = pos; }
        pos = __shfl(pos, 0);
        const u32x4* src = (const u32x4*)(abf + (size_t)g * DM); u32x4* dst = (u32x4*)(XP + (size_t)pos * DM);
        dst[lane] = src[lane]; dst[64 + lane] = src[64 + lane];
    }
    for (int e = bid; e < 32; e += nb) {
        const int r0 = off[e] + cntl[e], r1 = off[e + 1];
        for (int i = tid; i < (r1 - r0) * 128; i += NTHREADS) ((u32x4*)(XP + (size_t)r0 * DM))[i] = (u32x4){0u, 0u, 0u, 0u};
    }
}
__device__ __forceinline__ void ph_moe_gemm1(const Args& A, int l, LAS unsigned char* lds, int bid, int nb) {
    unsigned char* ws = opq(A.ws); TILE_COORDS;
    LAS int* off = (LAS int*)lds; LAS int* cntl = off + 64; LAS int* tile_e = off + 128;
    const int T = moe_layout(A, l, off, cntl, tile_e);
    const bf16_t* XP = (const bf16_t*)(ws + WS_XP); bf16_t* ACT = (bf16_t*)(ws + WS_ACT);
    const bf16_t* W1 = (const bf16_t*)(ws + WS_W1) + (size_t)l * NE * 2048 * DM;
    const float* B1 = A.in[I_B1] + (size_t)l * NE * 2048;
    const int tn = 8, nu = T * 2 * tn;
    for (int u = bid; u < nu; u += nb) {
        const int pm = u / tn, pn = u % tn, e = tile_e[pm >> 1];
        const bf16_t* wt = W1 + (size_t)e * 2048 * DM; const float* be = B1 + e * 2048;
        f32x4 ag[4][2], al[4][2];
        gemm_tile128(XP + (size_t)pm * 128 * DM, DM, wt + (size_t)pn * 128 * DM, DM, DM, ag);
        gemm_tile128(XP + (size_t)pm * 128 * DM, DM, wt + (size_t)(1024 + pn * 128) * DM, DM, DM, al);
#pragma unroll
        for (int i = 0; i < 4; ++i)
#pragma unroll
            for (int jj = 0; jj < 2; ++jj) {
                const int col = pn * 128 + TILE_COL(jj);
                const f32x4 bg = *(const f32x4*)(be + col), bl = *(const f32x4*)(be + 1024 + col);
                float o[4];
#pragma unroll
                for (int r = 0; r < 4; ++r) {
                    const float gl = fminf(ag[i][jj][r] + bg[r], 7.0f);
                    const float li = fminf(fmaxf(al[i][jj][r] + bl[r], -7.0f), 7.0f);
                    o[r] = gl * sigmoidf_(1.702f * gl) * (li + 1.0f);
                }
                u32x2 w; w.x = pk2(o[0], o[1]); w.y = pk2(o[2], o[3]);
                *(u32x2*)(ACT + (size_t)(pm * 128 + TILE_ROW(i)) * DM + col) = w;
            }
    }
}
__device__ __forceinline__ void ph_moe_gemm2(const Args& A, int l, LAS unsigned char* lds, int bid, int nb) {
    unsigned char* ws = opq(A.ws); TILE_COORDS;
    LAS int* off = (LAS int*)lds; LAS int* cntl = off + 64; LAS int* tile_e = off + 128;
    const int T = moe_layout(A, l, off, cntl, tile_e);
    const bf16_t* ACT = (const bf16_t*)(ws + WS_ACT); float* YM = (float*)(ws + WS_YM);
    const bf16_t* W2 = (const bf16_t*)(ws + WS_W2) + (size_t)l * NE * DM * DM;
    const float* B2 = A.in[I_B2] + (size_t)l * NE * DM;
    const int tn = 8, nu = T * 2 * tn;
    for (int u = bid; u < nu; u += nb) {
        const int pm = u / tn, pn = u % tn, e = tile_e[pm >> 1];
        f32x4 acc[4][2];
        gemm_tile128(ACT + (size_t)pm * 128 * DM, DM, W2 + (size_t)e * DM * DM + (size_t)pn * 128 * DM, DM, DM, acc);
#pragma unroll
        for (int i = 0; i < 4; ++i)
#pragma unroll
            for (int jj = 0; jj < 2; ++jj) {
                const int col = pn * 128 + TILE_COL(jj);
                *(f32x4*)(YM + (size_t)(pm * 128 + TILE_ROW(i)) * DM + col) = acc[i][jj] + *(const f32x4*)(B2 + e * DM + col);
            }
    }
}
__device__ __forceinline__ void ph_moe_combine(const Args& A, int l, int row_lo, bool last, int bid, int nb) {
    unsigned char* ws = opq(A.ws);
    const int tid = tid_opaque(), lane = tid & 63, wid = tid >> 6;
    float* H = (float*)(ws + WS_H); const float* mod = (const float*)(ws + WS_MOD); const float* YM = (const float*)(ws + WS_YM);
    const int* rowof = (const int*)(ws + WS_ROWOF); const float* tg = (const float*)(ws + WS_TOKG);
    for (int row = row_lo + bid * NWAVES + wid; row < NTOK; row += nb * NWAVES) {
        const Tok tk = tokinfo(row);
        const float* gate = mod + ((size_t)l * 17 + tk.modrow) * 6144 + 5 * 1024;
        int r[4]; float gk[4];
#pragma unroll
        for (int k = 0; k < 4; ++k) { r[k] = rowof[(size_t)row * 4 + k]; gk[k] = tg[(size_t)row * 4 + k]; }
#pragma unroll
        for (int q = 0; q < 4; ++q) {
            const int col = q * 256 + lane * 4;
            f32x4 m = (f32x4){0.f, 0.f, 0.f, 0.f};
#pragma unroll
            for (int k = 0; k < 4; ++k) m = m + *(const f32x4*)(YM + (size_t)r[k] * DM + col) * gk[k];
            const f32x4 hv = *(const f32x4*)(H + (size_t)row * DM + col) + *(const f32x4*)(gate + col) * m;
            if (last) *(f32x4*)(A.out + (size_t)(row - NCTX) * DM + col) = hv;
            else *(f32x4*)(H + (size_t)row * DM + col) = hv;
        }
    }
}

__global__ void __launch_bounds__(NTHREADS, 2) fwd_kernel(Args A) {
    extern __shared__ __attribute__((aligned(16))) unsigned char lds_raw[];
    LAS unsigned char* lds = (LAS unsigned char*)lds_raw;
    volatile LAS unsigned* misc = (volatile LAS unsigned*)(lds + LDS_MISC);
    const int tid = threadIdx.x, bid = blockIdx.x, nb = gridDim.x;
    if (tid < 64) misc[tid] = 0u;
    __syncthreads();
    XcdBarrier bar = xcd_barrier_post((unsigned*)(A.ws + WS_CTL) + CW_BAR, misc + 8);
    const int lo = A.ph_lo, hi = A.ph_hi;
    int pc = 0;
#ifndef PHSEL
#define PHSEL -1
#endif
#define SEL(k) (PHSEL < 0 || PHSEL == (k))
#define PH_BEGIN if (pc >= lo && pc < hi) {
#define PH_END } if (pc >= lo && pc + 1 < hi) xcd_barrier(bar); ++pc;

    PH_BEGIN if (SEL(0)) ph_prologue(A, lds, bid, nb); PH_END

    for (int l = 0; l < 4; ++l) {
        const int j = l >> 1;
        const bool ctx_out = (l < 2), ctx_in = (l < 3);
        const int rin = ctx_in ? 0 : NCTX, rout = ctx_out ? 0 : NCTX;
        PH_BEGIN if (SEL(1)) ph_norm<false>(A, l, rin, bid, nb); PH_END
        if ((l & 1) == 0) {
            PH_BEGIN if (SEL(2)) ph_gemm_win(A, j, rin, bid, nb); PH_END
            PH_BEGIN if (SEL(3)) ph_rwkv_feat(A, j, rin, lds, bid, nb); if (SEL(4)) ph_qk(A, j, rin, bid, nb); PH_END
            PH_BEGIN if (SEL(5)) ph_scan_naive(A, bid, nb); if (SEL(6)) ph_attn_naive(A, ctx_out, bid, nb); PH_END
            PH_BEGIN if (SEL(7)) ph_merge(A, l, rout, lds, bid, nb); PH_END
            PH_BEGIN if (SEL(8)) ph_gemm_out(A, l, (const bf16_t*)(A.ws + WS_CAT), (const bf16_t*)(A.ws + WS_WOUT) + (size_t)j * DM * DM, rout, bid, nb); PH_END
        } else {
            PH_BEGIN if (SEL(9)) ph_gemm_sgin(A, j, rin, bid, nb); PH_END
            PH_BEGIN if (SEL(10)) ph_sgu_ln(A, j, rin, bid, nb); PH_END
            PH_BEGIN if (SEL(11)) ph_sgu_spatial(A, j, rout, lds, bid, nb); PH_END
            PH_BEGIN if (SEL(12)) ph_gemm_out(A, l, (const bf16_t*)(A.ws + WS_G), (const bf16_t*)(A.ws + WS_SGOUT) + (size_t)j * DM * DM, rout, bid, nb); PH_END
        }
        PH_BEGIN if (SEL(13)) ph_norm<true>(A, l, rout, bid, nb); PH_END
        PH_BEGIN if (SEL(14)) ph_moe_scatter(A, l, rout, lds, bid, nb); PH_END
        PH_BEGIN if (SEL(15)) ph_moe_gemm1(A, l, lds, bid, nb); PH_END
        PH_BEGIN if (SEL(16)) ph_moe_gemm2(A, l, lds, bid, nb); PH_END
        PH_BEGIN if (SEL(17)) ph_moe_combine(A, l, rout, l == 3, bid, nb); PH_END
    }
}

extern "C" void kernel_launch(void* const* d_in, const int* in_sizes, int n_in, void* d_out, int out_size, void* d_ws, size_t ws_size, hipStream_t stream) {
    static int grid = 0;
    if (grid == 0) {
        if (n_in != 38 || out_size != NLAT * DM || ws_size < WS_END) { fprintf(stderr, "kernel_launch: unexpected shapes: n_in %d out %d ws %zu (need %zu)\n", n_in, out_size, ws_size, (size_t)WS_END); grid = -1; return; }
        int dev = 0, cus = 0, per_cu = 0;
        if (hipGetDevice(&dev) != hipSuccess || hipDeviceGetAttribute(&cus, hipDeviceAttributeMultiprocessorCount, dev) != hipSuccess) { grid = -1; return; }
        if (hipFuncSetAttribute((const void*)fwd_kernel, hipFuncAttributeMaxDynamicSharedMemorySize, LDS_BYTES) != hipSuccess) { fprintf(stderr, "kernel_launch: hipFuncSetAttribute failed\n"); grid = -1; return; }
        if (hipOccupancyMaxActiveBlocksPerMultiprocessor(&per_cu, (const void*)fwd_kernel, NTHREADS, LDS_BYTES) != hipSuccess || per_cu < 1)
            fprintf(stderr, "kernel_launch: occupancy query reports %d workgroups per CU\n", per_cu);
        (void)hipGetLastError();
        grid = cus;
    }
    if (grid < 0) return;
    if (hipMemsetAsync((char*)d_ws + WS_CTL, 0, CTL_ZERO_BYTES, stream) != hipSuccess) { fprintf(stderr, "kernel_launch: memset failed\n"); return; }
    Args a{};
    for (int i = 0; i < 38; ++i) a.in[i] = (const float*)d_in[i];
    a.out = (float*)d_out; a.ws = (unsigned char*)d_ws; a.ph_lo = 0; a.ph_hi = 1 << 20;
    hipLaunchKernelGGL(fwd_kernel, dim3(grid), dim3(NTHREADS), LDS_BYTES, stream, a);
    const hipError_t le = hipPeekAtLastError();
    if (le != hipSuccess) fprintf(stderr, "kernel_launch: launch failed: %s\n", hipGetErrorName(le));
}
```

```cpp
#include <hip/hip_runtime.h>
#include <cstdio>
#include <cstdint>

#define LAS __attribute__((address_space(3)))
typedef unsigned short bf16_t;
typedef short bf16x8 __attribute__((ext_vector_type(8)));
typedef float f32x4 __attribute__((ext_vector_type(4)));
typedef unsigned u32x4 __attribute__((ext_vector_type(4)));
typedef unsigned u32x2 __attribute__((ext_vector_type(2)));

constexpr int DM = 1024, NB = 16, TL = 2048, TC = 256;
constexpr int NCTX = NB * TC, NLAT = NB * TL, NTOK = NCTX + NLAT;
constexpr int RWC = 1920, EVC = 3456, ZLD = 3584;
constexpr int NE = 32;
constexpr int XPROWS = NTOK * 4 + NE * 256;
constexpr int NTHREADS = 512, NWAVES = 8;

constexpr size_t MiB = 1u << 20;
constexpr size_t al256(size_t x) { return (x + 255) & ~(size_t)255; }
constexpr size_t WS_CTL = 0, CTL_ZERO_BYTES = 1 * MiB - 4096;
constexpr size_t WS_PTRS = 1 * MiB - 4096;
constexpr size_t WS_MOD = 1 * MiB;
constexpr size_t WS_RTWT = al256(WS_MOD + (size_t)4 * 17 * 6144 * 4);
constexpr size_t WS_WIN = al256(WS_RTWT + (size_t)4 * 32 * 1024 * 4);
constexpr size_t WS_WOUT = al256(WS_WIN + (size_t)2 * ZLD * DM * 2);
constexpr size_t WS_SGIN = al256(WS_WOUT + (size_t)2 * DM * DM * 2);
constexpr size_t WS_SGOUT = al256(WS_SGIN + (size_t)2 * 2048 * DM * 2);
constexpr size_t WS_W1 = al256(WS_SGOUT + (size_t)2 * DM * DM * 2);
constexpr size_t WS_W2 = al256(WS_W1 + (size_t)4 * NE * 2048 * DM * 2);
constexpr size_t WS_H = al256(WS_W2 + (size_t)4 * NE * DM * DM * 2);
constexpr size_t WS_ABF = al256(WS_H + (size_t)NTOK * DM * 4);
constexpr size_t WS_TOKE = al256(WS_ABF + (size_t)NTOK * DM * 2);
constexpr size_t WS_TOKG = al256(WS_TOKE + (size_t)NTOK * 4 * 4);
constexpr size_t WS_ROWOF = al256(WS_TOKG + (size_t)NTOK * 4 * 4);
constexpr size_t WS_R = al256(WS_ROWOF + (size_t)NTOK * 4 * 4);
constexpr size_t FSZ = (size_t)NTOK * 512 * 4;
constexpr size_t WS_Z = WS_R;
constexpr size_t WS_F = al256(WS_Z + (size_t)NTOK * ZLD * 2);
constexpr size_t WS_YS = WS_F + 11 * FSZ;
constexpr size_t WS_QF = WS_YS + 2 * FSZ;
constexpr size_t WS_KF = WS_QF + FSZ;
constexpr size_t WS_VF = WS_KF + FSZ;
constexpr size_t WS_OP = WS_VF + FSZ;
constexpr size_t WS_CAT = WS_OP + 2 * FSZ;
constexpr size_t WS_EVEN_END = WS_CAT + (size_t)NTOK * DM * 2;
constexpr size_t WS_Z2 = WS_R;
constexpr size_t WS_VN = al256(WS_Z2 + (size_t)NTOK * 2048 * 2);
constexpr size_t WS_G = al256(WS_VN + (size_t)NTOK * DM * 4);
constexpr size_t WS_ODD_END = WS_G + (size_t)NTOK * DM * 2;
constexpr size_t WS_XP = WS_R;
constexpr size_t WS_ACT = al256(WS_XP + (size_t)XPROWS * DM * 2);
constexpr size_t WS_YM = al256(WS_ACT + (size_t)XPROWS * DM * 2);
constexpr size_t WS_MOE_END = WS_YM + (size_t)XPROWS * DM * 2;
constexpr size_t WS_END = (WS_EVEN_END > WS_MOE_END ? (WS_EVEN_END > WS_ODD_END ? WS_EVEN_END : WS_ODD_END) : (WS_MOE_END > WS_ODD_END ? WS_MOE_END : WS_ODD_END));

constexpr int CW_BAR = 4096;
constexpr int CW_CNT = 16384;
constexpr int CW_CUR = 16384 + 256;

constexpr int LDS_BYTES = 147456;
constexpr int LDS_MISC = 144 * 1024 - 256;

__device__ __forceinline__ unsigned f2bf(float f) { unsigned u = __builtin_bit_cast(unsigned, f); return (u + 0x7fffu + ((u >> 16) & 1u)) >> 16; }
__device__ __forceinline__ unsigned pk2(float lo, float hi) { return f2bf(lo) | (f2bf(hi) << 16); }
__device__ __forceinline__ float bf2f(bf16_t b) { return __builtin_bit_cast(float, (unsigned)b << 16); }
__device__ __forceinline__ float wave_sum(float v) {
#pragma unroll
    for (int o = 1; o < 64; o <<= 1) v += __shfl_xor(v, o);
    return v;
}
__device__ __forceinline__ int tid_opaque() { int t = threadIdx.x; asm volatile("" : "+v"(t)); return t; }
__device__ __forceinline__ unsigned char* opq(unsigned char* p) { asm volatile("" : "+s"(p)); return p; }
__device__ __forceinline__ float rdl(float v, int k) { return __builtin_bit_cast(float, __builtin_amdgcn_readlane(__builtin_bit_cast(int, v), k)); }
__device__ __forceinline__ float sigmoidf_(float x) { return 1.0f / (1.0f + __expf(-x)); }

#define XB_TMO      128
#define XB_XCNT(j)  (256  + 64 * (j))
#define XB_XSUB(j)  (1280 + 64 * (j))
#define XB_XGEN(j)  (2304 + 64 * (j))
#define XB_TOP      3328
#define XB_TOPGEN   3392
#define XCD_BAR_WORDS 3456
#define XB_SPIN_CAP (1u << 22)
__device__ __forceinline__ unsigned xb_ld(unsigned* p)              { return __hip_atomic_load(p, __ATOMIC_RELAXED, __HIP_MEMORY_SCOPE_AGENT); }
__device__ __forceinline__ unsigned xb_add(unsigned* p, unsigned v) { return __hip_atomic_fetch_add(p, v, __ATOMIC_RELAXED, __HIP_MEMORY_SCOPE_AGENT); }
__device__ __forceinline__ unsigned xb_xcc_id() { return (unsigned)__builtin_amdgcn_s_getreg((3 << 11) | 20) & 0xFu; }
#define XB_SPIN(cond, bar) do { unsigned _sp = 0; while (cond) { __builtin_amdgcn_s_sleep(1); \
    if ((++_sp & 255u) == 0u) { if (xb_ld(&(bar)[XB_TMO])) break; if (_sp > XB_SPIN_CAP) { atomicAdd(&(bar)[XB_TMO], 1u); break; } } } } while (0)
struct XcdBarrier { unsigned* bar; unsigned x; volatile LAS unsigned* st; };
__device__ __forceinline__ XcdBarrier xcd_barrier_post(unsigned* bar, volatile LAS unsigned* st) {
    XcdBarrier b; b.bar = bar; b.x = xb_xcc_id(); b.st = st;
    if (threadIdx.x == 0) (void)xb_add(&bar[XB_XCNT(b.x)], 1u);
    return b;
}
__device__ __forceinline__ void xcd_barrier_complete(unsigned* bar, unsigned x, unsigned& nloc, unsigned& nx) {
    const unsigned G = gridDim.x * gridDim.y * gridDim.z;
    unsigned sum, cnt, mine, sp = 0u;
    for (;;) {
        sum = 0u; cnt = 0u; mine = 0u;
#pragma unroll
        for (unsigned j = 0; j < 16; ++j) { const unsigned c = xb_ld(&bar[XB_XCNT(j)]); sum += c; cnt += (c > 0u) ? 1u : 0u; mine = (j == x) ? c : mine; }
        if (sum == G) break;
        __builtin_amdgcn_s_sleep(1);
        if ((++sp & 255u) == 0u) { if (xb_ld(&bar[XB_TMO])) break; if (sp > XB_SPIN_CAP) { atomicAdd(&bar[XB_TMO], 1u); break; } }
    }
    nloc = mine > 0u ? mine : 1u; nx = cnt > 0u ? cnt : 1u;
}
__device__ __forceinline__ void xcd_barrier(const XcdBarrier& b) {
    asm volatile("s_waitcnt vmcnt(0)" ::: "memory");
    __syncthreads();
    if (threadIdx.x == 0) {
        unsigned* bar = b.bar;
        __builtin_amdgcn_s_waitcnt(0);
        unsigned nloc = b.st[0], nx = b.st[1];
        if (nloc == 0u) { xcd_barrier_complete(bar, b.x, nloc, nx); b.st[0] = nloc; b.st[1] = nx; }
        const unsigned old = xb_add(&bar[XB_XSUB(b.x)], 1u);
        const unsigned gen = old / nloc;
        if (old + 1u == (gen + 1u) * nloc) {
            __builtin_amdgcn_fence(__ATOMIC_RELEASE, "agent");
            asm volatile("s_waitcnt vmcnt(0)" ::: "memory");
            const unsigned og = xb_add(&bar[XB_TOP], 1u);
            const unsigned tg = og / nx;
            if (og + 1u == (tg + 1u) * nx) xb_add(&bar[XB_TOPGEN], 1u);
            else XB_SPIN(xb_ld(&bar[XB_TOPGEN]) == tg, bar);
            __builtin_amdgcn_fence(__ATOMIC_ACQUIRE, "agent");
            xb_add(&bar[XB_XGEN(b.x)], 1u);
            asm volatile("s_waitcnt vmcnt(0)" ::: "memory");
        } else {
            XB_SPIN(xb_ld(&bar[XB_XGEN(b.x)]) == gen, bar);
            __builtin_amdgcn_fence(__ATOMIC_ACQUIRE, "agent");
            asm volatile("s_waitcnt vmcnt(0)" ::: "memory");
        }
    }
    __syncthreads();
}

namespace pg8 {
#define PG8_LAS __attribute__((address_space(3)))
typedef unsigned short bf16_t;
typedef short bf16x8 __attribute__((ext_vector_type(8)));
typedef float f32x4 __attribute__((ext_vector_type(4)));
typedef unsigned u32x4 __attribute__((ext_vector_type(4)));
constexpr int BM = 256, BK = 64, HALF = 128, HTB = HALF * BK * 2  , STAGE_BYTES = 8 * HTB, NXCD = 8, WGM = 8;

__host__ __device__ __forceinline__ int lds_byte(int r, int c) { const int st = (r >> 4) * 2 + (c >> 5), rr = r & 15, cc = c & 31, ob = rr * 64 + cc * 2; return st * 1024 + (ob ^ (((ob >> 9) & 1) << 5)); }
__host__ __device__ __forceinline__ void stage_rc(int b, int& R, int& C) { const int st = b / 1024, sb = b % 1024, swz = sb ^ (((sb >> 9) & 1) << 5); R = (st >> 1) * 16 + swz / 64; C = (st & 1) * 32 + (swz % 64) / 2; }
__host__ __device__ __forceinline__ int perm32(int rho) { const int n = rho >> 4, i = rho & 15; return 8 * (i >> 2) + 4 * n + (i & 3); }

struct Unit { int pm, pn; };
struct Gemm { const bf16_t* A; const bf16_t* Bt; int M, N, K; };

struct StaticOrder {
    int nM, nN, nwg, G, c;
    __host__ __device__ void init(int M, int N, int G_, int c_) { nM = M / BM; nN = N / BM; nwg = nM * nN; G = G_; c = c_; }
    __host__ __device__ bool next(int i, Unit& u) const {
        const long L = (long)i * G + c; if (L >= nwg) return false;
        int wgid = (int)L; { const int q = nwg / NXCD, r = nwg % NXCD, xcd = wgid % NXCD, off = wgid / NXCD; wgid = (xcd < r ? xcd * (q + 1) : r * (q + 1) + (xcd - r) * q) + off; }
        const int nig = WGM * nN, gid = wgid / nig, fm = gid * WGM, gsz = (nM - fm) < WGM ? (nM - fm) : WGM;
        u.pm = fm + ((wgid % nig) % gsz); u.pn = (wgid % nig) / gsz; return true;
    }
    __device__ __forceinline__ void a_ready(const Unit&) const {}
    __device__ __forceinline__ void done(const Unit&) const {}
};

__device__ __forceinline__ unsigned cvt_pk_bf16(float lo, float hi) { unsigned r; asm volatile("v_cvt_pk_bf16_f32 %0, %1, %2" : "=v"(r) : "v"(lo), "v"(hi)); return r; }
typedef float f32x2 __attribute__((ext_vector_type(2)));
__device__ __forceinline__ f32x2 gelu_pk(f32x2 v) {
    const f32x2 av = __builtin_elementwise_abs(v), d = av * 0.2316418882f + 1.0f;
    f32x2 t; t.x = __builtin_amdgcn_rcpf(d.x); t.y = __builtin_amdgcn_rcpf(d.y);
    f32x2 q = t * 0.5307027145f + (-0.7265760135f); q = q * t + 0.7107068705f; q = q * t + (-0.142248368f); q = q * t + 0.127414796f; q = q * t;
    const f32x2 s = (v * v) * (-0.72134752044f);
    f32x2 e; e.x = __builtin_amdgcn_exp2f(s.x); e.y = __builtin_amdgcn_exp2f(s.y);
    const f32x2 m = v * (q * e), r = v - m;
    f32x2 o; o.x = v.x < 0.f ? m.x : r.x; o.y = v.y < 0.f ? m.y : r.y; return o;
}

template <class Epi, class Sched, bool ALIGN_EPI = false, bool SP2 = false>
__device__ __forceinline__ void gemm_phase(PG8_LAS unsigned char* lds, const Gemm g, const Sched& S, const Epi& E) {
    const int tid = tid_opaque(), wid = __builtin_amdgcn_readfirstlane(tid >> 6), lane = tid & 63, wr = wid >> 2, wc = wid & 3, fr = lane & 15, fq = lane >> 4;
    const int K = g.K, nt = K / BK;
    unsigned voffA[2], voffB[2];
#pragma unroll
    for (int i = 0; i < 2; ++i) { int R, C; stage_rc(tid * 16 + i * 8192, R, C); const int Rb = Epi::PERM ? ((R & ~31) + perm32(R & 31)) : R;
        voffA[i] = (unsigned)(R * K + C) * 2u; voffB[i] = (unsigned)(Rb * K + C) * 2u; }
    const size_t kstep = (size_t)(BK * 2);
    const size_t hstep = (size_t)HALF * K * 2;
    const size_t tstep = 2 * hstep;
    const unsigned ldsw = (unsigned)wid * 1024u;
    const int aoff = lds_byte(wr * 64 + fr, fq * 8), boff = lds_byte(wc * 32 + fr, fq * 8);
#define PG8_SA(b, h) (((b) * 2 + (h)) * HTB)
#define PG8_SB(b, h) ((4 + (b) * 2 + (h)) * HTB)
#define PG8_STAGE(bufoff, gbase, voff) do { _Pragma("unroll") for (int _i = 0; _i < 2; ++_i) \
        __builtin_amdgcn_global_load_lds((const unsigned*)((const char*)(gbase) + (voff)[_i]), (PG8_LAS unsigned*)(lds + (bufoff) + ldsw + _i * 8192), 16, 0, 0); } while (0)
#define PG8_LDA(dst, b, h) do { _Pragma("unroll") for (int m = 0; m < 4; ++m) _Pragma("unroll") for (int k = 0; k < 2; ++k) dst[m][k] = *(const PG8_LAS bf16x8*)(lds + PG8_SA(b, h) + aoff + m * 2048 + k * 1024); } while (0)
#define PG8_LDB(dst, b, h) do { _Pragma("unroll") for (int n = 0; n < 2; ++n) _Pragma("unroll") for (int k = 0; k < 2; ++k) dst[n][k] = *(const PG8_LAS bf16x8*)(lds + PG8_SB(b, h) + boff + n * 2048 + k * 1024); } while (0)
#define PG8_MMA(ai, bj, At, Bt) do { __builtin_amdgcn_s_setprio(1); _Pragma("unroll") for (int m = 0; m < 4; ++m) _Pragma("unroll") for (int n = 0; n < 2; ++n) _Pragma("unroll") for (int k = 0; k < 2; ++k) \
        acc[ai][bj][m][n] = __builtin_amdgcn_mfma_f32_16x16x32_bf16(Bt[n][k], At[m][k], acc[ai][bj][m][n], 0, 0, 0); __builtin_amdgcn_s_setprio(0); } while (0)
#define PG8_WAIT_V(n) asm volatile("s_waitcnt vmcnt(" #n ")" ::: "memory")
#define PG8_WAIT_L(n) asm volatile("s_waitcnt lgkmcnt(" #n ")" ::: "memory")
#define PG8_BAR __builtin_amdgcn_s_barrier()
#define PG8_SCHED __builtin_amdgcn_sched_barrier(0)
    Unit cur, nxt; int ui = 0;
    if (!S.next(0, cur)) return;
    f32x4 acc[2][2][4][2];
#pragma unroll
    for (int a = 0; a < 2; ++a)
#pragma unroll
        for (int b = 0; b < 2; ++b)
#pragma unroll
            for (int m = 0; m < 4; ++m)
#pragma unroll
                for (int n = 0; n < 2; ++n) acc[a][b][m][n] = (f32x4){0.f, 0.f, 0.f, 0.f};
    bf16x8 At[4][2], B0[2][2], B1[2][2];
    const char* cA = (const char*)g.A + (size_t)cur.pm * tstep; const char* cB = (const char*)g.Bt + (size_t)cur.pn * tstep;
    S.a_ready(cur);
    if constexpr (SP2) {
        PG8_STAGE(PG8_SB(0, 0), cB, voffB); PG8_STAGE(PG8_SB(0, 1), cB + hstep, voffB); PG8_STAGE(PG8_SA(0, 0), cA, voffA); PG8_STAGE(PG8_SA(0, 1), cA + hstep, voffA);
        if (wr == 1) PG8_BAR;
        PG8_WAIT_V(2); PG8_BAR;
        PG8_STAGE(PG8_SB(1, 0), cB + kstep, voffB); PG8_STAGE(PG8_SA(1, 0), cA + kstep, voffA); PG8_STAGE(PG8_SB(1, 1), cB + hstep + kstep, voffB);
        PG8_WAIT_V(6); PG8_BAR;
    } else {
        PG8_STAGE(PG8_SB(0, 0), cB, voffB); PG8_STAGE(PG8_SA(0, 0), cA, voffA); PG8_STAGE(PG8_SB(0, 1), cB + hstep, voffB); PG8_STAGE(PG8_SA(0, 1), cA + hstep, voffA);
        if (wr == 1) PG8_BAR;
        PG8_WAIT_V(4); PG8_BAR;
        PG8_STAGE(PG8_SB(1, 0), cB + kstep, voffB); PG8_STAGE(PG8_SA(1, 0), cA + kstep, voffA); PG8_STAGE(PG8_SB(1, 1), cB + hstep + kstep, voffB);
        PG8_WAIT_V(6); PG8_BAR;
    }
    for (;;) {
        const bool has_next = S.next(ui + 1, nxt);
        const char* nA = has_next ? (const char*)g.A + (size_t)nxt.pm * tstep : cA; const char* nB = has_next ? (const char*)g.Bt + (size_t)nxt.pn * tstep : cB;
        for (int t = 0; t < nt; t += 2) {
            const bool last = (t == nt - 2);
            const char* a1 = cA + (size_t)(t + 1) * kstep;
            const char* a2 = last ? nA : cA + (size_t)(t + 2) * kstep; const char* b2 = last ? nB : cB + (size_t)(t + 2) * kstep;
            const char* a3 = a2 + kstep; const char* b3 = b2 + kstep;
            if (last && has_next) S.a_ready(nxt);
            if constexpr (SP2) {
            PG8_LDB(B0, 0, 0); PG8_LDB(B1, 0, 1); PG8_SCHED; PG8_LDA(At, 0, 0); PG8_STAGE(PG8_SA(1, 1), a1 + hstep, voffA);
            PG8_WAIT_V(8); PG8_WAIT_L(0); PG8_BAR; PG8_MMA(0, 0, At, B0); PG8_MMA(0, 1, At, B1); PG8_BAR; PG8_SCHED;
            PG8_LDA(At, 0, 1); PG8_STAGE(PG8_SB(0, 0), b2, voffB); PG8_STAGE(PG8_SB(0, 1), b2 + hstep, voffB); PG8_STAGE(PG8_SA(0, 0), a2, voffA);
            PG8_WAIT_V(8); PG8_WAIT_L(0); PG8_BAR; PG8_MMA(1, 0, At, B0); PG8_MMA(1, 1, At, B1); PG8_BAR; PG8_SCHED;
            PG8_LDB(B0, 1, 0); PG8_LDB(B1, 1, 1); PG8_SCHED; PG8_LDA(At, 1, 0); PG8_STAGE(PG8_SA(0, 1), a2 + hstep, voffA);
            PG8_WAIT_V(8); PG8_WAIT_L(0); PG8_BAR; PG8_MMA(0, 0, At, B0); PG8_MMA(0, 1, At, B1); PG8_BAR; PG8_SCHED;
            PG8_LDA(At, 1, 1); PG8_STAGE(PG8_SB(1, 0), b3, voffB); PG8_STAGE(PG8_SB(1, 1), b3 + hstep, voffB); PG8_STAGE(PG8_SA(1, 0), a3, voffA);
            PG8_WAIT_V(8); PG8_WAIT_L(0); PG8_BAR; PG8_MMA(1, 0, At, B0); PG8_MMA(1, 1, At, B1); PG8_BAR; PG8_SCHED;
            } else {
            PG8_LDB(B0, 0, 0); PG8_SCHED; PG8_LDA(At, 0, 0); PG8_STAGE(PG8_SA(1, 1), a1 + hstep, voffA);
            PG8_WAIT_L(8); PG8_BAR; PG8_WAIT_L(0); PG8_MMA(0, 0, At, B0); PG8_BAR; PG8_SCHED;
            PG8_LDB(B1, 0, 1); PG8_STAGE(PG8_SB(0, 0), b2, voffB);
            PG8_BAR; PG8_WAIT_L(0); PG8_MMA(0, 1, At, B1); PG8_BAR;
            PG8_LDA(At, 0, 1); PG8_STAGE(PG8_SA(0, 0), a2, voffA);
            PG8_BAR; PG8_WAIT_L(0); PG8_MMA(1, 0, At, B0); PG8_BAR; PG8_SCHED;
            PG8_STAGE(PG8_SB(0, 1), b2 + hstep, voffB);
            PG8_WAIT_V(6); PG8_BAR; PG8_MMA(1, 1, At, B1); PG8_BAR;
            PG8_LDB(B0, 1, 0); PG8_SCHED; PG8_LDA(At, 1, 0); PG8_STAGE(PG8_SA(0, 1), a2 + hstep, voffA);
            PG8_WAIT_L(8); PG8_BAR; PG8_WAIT_L(0); PG8_MMA(0, 0, At, B0); PG8_BAR; PG8_SCHED;
            PG8_LDB(B1, 1, 1); PG8_STAGE(PG8_SB(1, 0), b3, voffB);
            PG8_BAR; PG8_WAIT_L(0); PG8_MMA(0, 1, At, B1); PG8_BAR;
            PG8_LDA(At, 1, 1); PG8_STAGE(PG8_SA(1, 0), a3, voffA);
            PG8_BAR; PG8_WAIT_L(0); PG8_MMA(1, 0, At, B0); PG8_BAR; PG8_SCHED;
            PG8_STAGE(PG8_SB(1, 1), b3 + hstep, voffB);
            PG8_WAIT_V(6); PG8_BAR; PG8_MMA(1, 1, At, B1); PG8_BAR;
            }
        }
        if constexpr (ALIGN_EPI) { if (wr == 0) PG8_BAR; }
        if constexpr (!Epi::AFTER_DRAIN) { E(acc, cur, wr, wc, fr, fq); S.done(cur); }
        if (!has_next) break;
#pragma unroll
        for (int a = 0; a < 2; ++a)
#pragma unroll
            for (int b = 0; b < 2; ++b)
#pragma unroll
                for (int m = 0; m < 4; ++m)
#pragma unroll
                    for (int n = 0; n < 2; ++n) acc[a][b][m][n] = (f32x4){0.f, 0.f, 0.f, 0.f};
        cur = nxt; cA = nA; cB = nB; ++ui;
        if constexpr (ALIGN_EPI) { if (wr == 1) PG8_BAR; }
    }
    PG8_WAIT_V(0);
    if constexpr (!ALIGN_EPI) { if (wr == 0) PG8_BAR; }
    PG8_BAR;
    if constexpr (Epi::AFTER_DRAIN) { E.fused(acc, cur, wr, wc, fr, fq, lds, wid, lane); S.done(cur); }
#undef PG8_SA
#undef PG8_SB
#undef PG8_STAGE
#undef PG8_LDA
#undef PG8_LDB
#undef PG8_MMA
#undef PG8_WAIT_V
#undef PG8_WAIT_L
#undef PG8_BAR
#undef PG8_SCHED
}
}

struct Args { const float* in[38]; float* out; unsigned char* ws; int ph_lo, ph_hi; };
enum { I_X = 0, I_C, I_CTX, I_CCTX, I_N1G, I_N2G, I_ADAW, I_ADAB, I_EVWIN, I_EVWOUT, I_RWMU, I_RWW0, I_RWW2, I_RWA0, I_RWA2, I_RWG2, I_RWKK, I_RWKA, I_RWRK,
       I_GNW, I_GNB, I_QN, I_KN, I_LAM, I_SUBLN, I_SGWIN, I_SGBIN, I_SGLNG, I_SGLNB, I_SGWS, I_SGBS, I_SGWOUT, I_RTW, I_RTB, I_W1, I_B1, I_W2, I_B2 };

struct Tok { int b, t, T, modrow; };
__device__ __forceinline__ Tok tokinfo(int g) {
    Tok k;
    if (g < NCTX) { k.b = g >> 8; k.t = g & 255; k.T = TC; k.modrow = 16; }
    else { const int q = g - NCTX; k.b = q >> 11; k.t = q & 2047; k.T = TL; k.modrow = k.b; }
    return k;
}

template <int MAP>
__device__ __forceinline__ void p0_transpose_item(const float* W, int K, int N, bf16_t* WT, LAS float* scr, int item, int lane) {
    const int nblk = N / 32, kb = item / nblk, nb = item % nblk, k0 = 64 * kb, n0 = 32 * nb;
    const int d0 = MAP ? (256 * ((n0 & 1023) >> 7) + 128 * (n0 >> 10) + (n0 & 127)) : n0;
#pragma unroll 8
    for (int i = 0; i < 32; ++i) { const int kk = 2 * i + (lane >> 5); scr[kk * 33 + (lane & 31)] = W[(size_t)(k0 + kk) * N + n0 + (lane & 31)]; }
    asm volatile("s_waitcnt lgkmcnt(0)" ::: "memory");
    const int c = lane & 7;
#pragma unroll
    for (int j = 0; j < 4; ++j) { const int n = (lane >> 3) + 8 * j; const LAS float* s = scr + (8 * c) * 33 + n;
        u32x4 o; o.x = pk2(s[0 * 33], s[1 * 33]); o.y = pk2(s[2 * 33], s[3 * 33]); o.z = pk2(s[4 * 33], s[5 * 33]); o.w = pk2(s[6 * 33], s[7 * 33]);
        *(u32x4*)(WT + (size_t)(d0 + n) * K + k0 + 8 * c) = o; }
    asm volatile("s_waitcnt lgkmcnt(0)" ::: "memory");
}

__device__ __forceinline__ void ph_prologue(const Args& A, LAS unsigned char* lds, int bid, int nb) {
    const int tid = tid_opaque(), lane = tid & 63, wid = tid >> 6;
    unsigned char* ws = opq(A.ws);
    if (bid == 0 && tid < 39) ((const float**)(ws + WS_PTRS))[tid] = (tid < 38) ? A.in[tid] : (const float*)A.out;
    {
        LAS float* s = (LAS float*)lds;
        LAS float* red = (LAS float*)(lds + 17 * 1024 * 4);
        for (int i = tid; i < 17 * 1024; i += NTHREADS) {
            const int r = i >> 10, k = i & 1023;
            const float x = (r < 16) ? A.in[I_C][r * 1024 + k] : A.in[I_CCTX][k];
            s[i] = x / (1.0f + __expf(-x));
        }
        __syncthreads();
        float* mod = (float*)(ws + WS_MOD);
        for (int u = bid; u < 4 * 96; u += nb) {
            const int l = u / 96, cg = u % 96, col = cg * 64 + lane;
            float acc[17];
#pragma unroll
            for (int r = 0; r < 17; ++r) acc[r] = 0.f;
            const float* wp = A.in[I_ADAW] + (size_t)l * 1024 * 6144 + col;
            for (int k = wid * 128; k < wid * 128 + 128; ++k) {
                const float wv = wp[(size_t)k * 6144];
#pragma unroll
                for (int r = 0; r < 17; ++r) acc[r] += s[r * 1024 + k] * wv;
            }
#pragma unroll
            for (int r = 0; r < 17; ++r) red[(wid * 17 + r) * 64 + lane] = acc[r];
            __syncthreads();
            for (int i = tid; i < 17 * 64; i += NTHREADS) {
                const int r = i >> 6, ln = i & 63; float v = 0.f;
#pragma unroll
                for (int w = 0; w < 8; ++w) v += red[(w * 17 + r) * 64 + ln];
                const int cc = cg * 64 + ln;
                mod[((size_t)l * 17 + r) * 6144 + cc] = v + A.in[I_ADAB][l * 6144 + cc];
            }
            __syncthreads();
        }
    }
    __syncthreads();
    {
        LAS float* scr = (LAS float*)(lds + wid * 16384);
        const int gw = bid * NWAVES + wid, NGW = nb * NWAVES;
        constexpr int IT_WIN = 16 * (EVC / 32), IT_SQ = 16 * 32, IT_SGIN = 16 * 64, IT_W1 = 16 * 64, IT_W2 = 16 * 32;
        constexpr int N0 = 2 * IT_WIN, N1 = N0 + 2 * IT_SQ, N2 = N1 + 2 * IT_SGIN, N3 = N2 + 2 * IT_SQ, N4 = N3 + 128 * IT_W1, N5 = N4 + 128 * IT_W2;
        for (int it = gw; it < N5; it += NGW) {
            if (it < N0) { const int m = it / IT_WIN, r = it % IT_WIN; p0_transpose_item<0>(A.in[I_EVWIN] + (size_t)m * DM * EVC, DM, EVC, (bf16_t*)(ws + WS_WIN) + (size_t)m * ZLD * DM, scr, r, lane); }
            else if (it < N1) { const int q = it - N0, m = q / IT_SQ, r = q % IT_SQ; p0_transpose_item<0>(A.in[I_EVWOUT] + (size_t)m * DM * DM, DM, DM, (bf16_t*)(ws + WS_WOUT) + (size_t)m * DM * DM, scr, r, lane); }
            else if (it < N2) { const int q = it - N1, m = q / IT_SGIN, r = q % IT_SGIN; p0_transpose_item<0>(A.in[I_SGWIN] + (size_t)m * DM * 2048, DM, 2048, (bf16_t*)(ws + WS_SGIN) + (size_t)m * 2048 * DM, scr, r, lane); }
            else if (it < N3) { const int q = it - N2, m = q / IT_SQ, r = q % IT_SQ; p0_transpose_item<0>(A.in[I_SGWOUT] + (size_t)m * DM * DM, DM, DM, (bf16_t*)(ws + WS_SGOUT) + (size_t)m * DM * DM, scr, r, lane); }
            else if (it < N4) { const int q = it - N3, m = q / IT_W1, r = q % IT_W1; p0_transpose_item<1>(A.in[I_W1] + (size_t)m * DM * 2048, DM, 2048, (bf16_t*)(ws + WS_W1) + (size_t)m * 2048 * DM, scr, r, lane); }
            else { const int q = it - N4, m = q / IT_W2, r = q % IT_W2; p0_transpose_item<0>(A.in[I_W2] + (size_t)m * DM * DM, DM, DM, (bf16_t*)(ws + WS_W2) + (size_t)m * DM * DM, scr, r, lane); }
        }
    }
    {
        const size_t gt = (size_t)bid * NTHREADS + tid, GT = (size_t)nb * NTHREADS;
        f32x4* H4 = (f32x4*)(ws + WS_H);
        const f32x4* c4 = (const f32x4*)A.in[I_CTX]; const f32x4* x4 = (const f32x4*)A.in[I_X];
        constexpr size_t NC4 = (size_t)NCTX * DM / 4, NT4 = (size_t)NTOK * DM / 4;
        for (size_t i = gt; i < NT4; i += GT) H4[i] = (i < NC4) ? c4[i] : x4[i - NC4];
        for (size_t i = gt; i < (size_t)2 * 128 * DM / 8; i += GT) { const size_t m = i / (128 * DM / 8), r = i % (128 * DM / 8); ((u32x4*)((bf16_t*)(ws + WS_WIN) + (m * ZLD + EVC) * DM))[r] = (u32x4){0u, 0u, 0u, 0u}; }
        float* rt = (float*)(ws + WS_RTWT);
        for (size_t i = gt; i < (size_t)4 * 32 * 1024; i += GT) { const int l = (int)(i >> 15), e = (int)(i >> 10) & 31, k = (int)i & 1023; rt[i] = A.in[I_RTW][((size_t)l * 1024 + k) * 32 + e]; }
    }
}

template <bool ROUTER>
__device__ __forceinline__ void ph_norm(const Args& A, int l, int row_lo, int bid, int nb) {
    const int tid = tid_opaque(), lane = tid & 63, wid = tid >> 6;
    unsigned char* ws = opq(A.ws); const float* const* IN = (const float* const*)(ws + WS_PTRS); (void)IN;
    const float* H = (const float*)(ws + WS_H);
    const float* mod = (const float*)(ws + WS_MOD);
    bf16_t* abf = (bf16_t*)(ws + WS_ABF);
    const float* gp = IN[ROUTER ? I_N2G : I_N1G] + l * 1024;
    const int c_shift = ROUTER ? 3 : 0, c_scale = ROUTER ? 4 : 1;
    for (int row = row_lo + bid * NWAVES + wid; row < NTOK; row += nb * NWAVES) {
        const Tok tk = tokinfo(row);
        const float* mrow = mod + ((size_t)l * 17 + tk.modrow) * 6144;
        f32x4 v[4]; float ss = 0.f;
#pragma unroll
        for (int j = 0; j < 4; ++j) { v[j] = *(const f32x4*)(H + (size_t)row * DM + j * 256 + lane * 4); ss += (v[j].x * v[j].x + v[j].y * v[j].y) + (v[j].z * v[j].z + v[j].w * v[j].w); }
        const float rstd = rsqrtf(wave_sum(ss) * (1.0f / DM) + 1e-6f);
#pragma unroll
        for (int j = 0; j < 4; ++j) {
            const int col = j * 256 + lane * 4;
            const f32x4 g = *(const f32x4*)(gp + col), sc = *(const f32x4*)(mrow + c_scale * 1024 + col), sh = *(const f32x4*)(mrow + c_shift * 1024 + col);
            v[j] = (v[j] * rstd * g) * (sc + 1.0f) + sh;
            u32x2 o; o.x = pk2(v[j].x, v[j].y); o.y = pk2(v[j].z, v[j].w);
            *(u32x2*)(abf + (size_t)row * DM + col) = o;
        }
        if constexpr (ROUTER) {
            const float* rt = (const float*)(ws + WS_RTWT) + (size_t)l * 32 * 1024;
            float tv[4] = {-3.0e38f, -3.0e38f, -3.0e38f, -3.0e38f}; int ti[4] = {0, 0, 0, 0};
#pragma unroll 2
            for (int e = 0; e < 32; ++e) {
                float p = 0.f;
#pragma unroll
                for (int j = 0; j < 4; ++j) { const f32x4 w = *(const f32x4*)(rt + e * 1024 + j * 256 + lane * 4); p += (v[j].x * w.x + v[j].y * w.y) + (v[j].z * w.z + v[j].w * w.w); }
                const float lgv = wave_sum(p) + IN[I_RTB][l * 32 + e];
                if (lgv > tv[3]) {
                    tv[3] = lgv; ti[3] = e;
                    if (tv[3] > tv[2]) { const float a = tv[2]; tv[2] = tv[3]; tv[3] = a; const int b = ti[2]; ti[2] = ti[3]; ti[3] = b; }
                    if (tv[2] > tv[1]) { const float a = tv[1]; tv[1] = tv[2]; tv[2] = a; const int b = ti[1]; ti[1] = ti[2]; ti[2] = b; }
                    if (tv[1] > tv[0]) { const float a = tv[0]; tv[0] = tv[1]; tv[1] = a; const int b = ti[0]; ti[0] = ti[1]; ti[1] = b; }
                }
            }
            const float e1 = __expf(tv[1] - tv[0]), e2 = __expf(tv[2] - tv[0]), e3 = __expf(tv[3] - tv[0]);
            const float inv = 1.0f / (1.0f + e1 + e2 + e3);
            if (lane == 0) {
                int* te = (int*)(ws + WS_TOKE) + (size_t)row * 4; float* tg = (float*)(ws + WS_TOKG) + (size_t)row * 4;
                te[0] = ti[0]; te[1] = ti[1]; te[2] = ti[2]; te[3] = ti[3];
                tg[0] = inv; tg[1] = e1 * inv; tg[2] = e2 * inv; tg[3] = e3 * inv;
                unsigned* cnt = (unsigned*)(ws + WS_CTL) + CW_CNT + l * 32;
#pragma unroll
                for (int k = 0; k < 4; ++k) atomicAdd(cnt + ti[k], 1u);
            }
        }
    }
}

__device__ __forceinline__ void gemm_tile128(const bf16_t* At, int lda, const bf16_t* Bt, int ldb, int K, f32x4 (&acc)[4][2]) {
    const int tid = tid_opaque(), wid = tid >> 6, lane = tid & 63, wr = wid >> 2, wc = wid & 3, fr = lane & 15, fq = lane >> 4;
    const bf16_t* a0 = At + (size_t)(wr * 64 + fr) * lda + fq * 8;
    const bf16_t* b0 = Bt + (size_t)(wc * 32 + fr) * ldb + fq * 8;
#pragma unroll
    for (int i = 0; i < 4; ++i)
#pragma unroll
        for (int j = 0; j < 2; ++j) acc[i][j] = (f32x4){0.f, 0.f, 0.f, 0.f};
#pragma unroll 2
    for (int k = 0; k < K; k += 32) {
        bf16x8 af[4], bfr[2];
#pragma unroll
        for (int i = 0; i < 4; ++i) af[i] = *(const bf16x8*)(a0 + (size_t)i * 16 * lda + k);
#pragma unroll
        for (int j = 0; j < 2; ++j) bfr[j] = *(const bf16x8*)(b0 + (size_t)j * 16 * ldb + k);
#pragma unroll
        for (int i = 0; i < 4; ++i)
#pragma unroll
            for (int j = 0; j < 2; ++j) acc[i][j] = __builtin_amdgcn_mfma_f32_16x16x32_bf16(bfr[j], af[i], acc[i][j], 0, 0, 0);
    }
}
#define TILE_COORDS const int _tid = tid_opaque(), _wid = _tid >> 6, _lane = _tid & 63, _wr = _wid >> 2, _wc = _wid & 3, _fr = _lane & 15, _fq = _lane >> 4
#define TILE_ROW(i) (_wr * 64 + (i) * 16 + _fr)
#define TILE_COL(j) (_wc * 32 + (j) * 16 + _fq * 4)

typedef pg8::f32x4 (&AccRef)[2][2][4][2];
struct EpiStoreBf16 {
    static constexpr bool PERM = true, AFTER_DRAIN = false;
    bf16_t* O; int ldc;
    __device__ __forceinline__ void operator()(const pg8::f32x4 (&acc)[2][2][4][2], const pg8::Unit& u, int wr, int wc, int fr, int fq) const {
        const int row0 = u.pm * 256 + wr * 64 + fr, col0 = u.pn * 256 + wc * 32 + 8 * fq;
#pragma unroll
        for (int ai = 0; ai < 2; ++ai)
#pragma unroll
            for (int m = 0; m < 4; ++m) { bf16_t* rowp = O + (size_t)(row0 + ai * 128 + m * 16) * ldc + col0;
#pragma unroll
                for (int bj = 0; bj < 2; ++bj) { const pg8::f32x4 v0 = acc[ai][bj][m][0], v1 = acc[ai][bj][m][1];
                    u32x4 w; w.x = pg8::cvt_pk_bf16(v0[0], v0[1]); w.y = pg8::cvt_pk_bf16(v0[2], v0[3]); w.z = pg8::cvt_pk_bf16(v1[0], v1[1]); w.w = pg8::cvt_pk_bf16(v1[2], v1[3]);
                    *(u32x4*)(rowp + bj * 128) = w; } }
    }
};
struct EpiGeluBf16 {
    static constexpr bool PERM = true, AFTER_DRAIN = false;
    bf16_t* O; int ldc; const float* bias;
    __device__ __forceinline__ void operator()(const pg8::f32x4 (&acc)[2][2][4][2], const pg8::Unit& u, int wr, int wc, int fr, int fq) const {
        const int row0 = u.pm * 256 + wr * 64 + fr, col0 = u.pn * 256 + wc * 32 + 8 * fq;
        pg8::f32x4 bv[2][2];
#pragma unroll
        for (int bj = 0; bj < 2; ++bj)
#pragma unroll
            for (int n = 0; n < 2; ++n) bv[bj][n] = *(const pg8::f32x4*)(bias + col0 + bj * 128 + 4 * n);
#pragma unroll
        for (int ai = 0; ai < 2; ++ai)
#pragma unroll
            for (int m = 0; m < 4; ++m) { bf16_t* rowp = O + (size_t)(row0 + ai * 128 + m * 16) * ldc + col0;
#pragma unroll
                for (int bj = 0; bj < 2; ++bj) { pg8::f32x4 v0 = acc[ai][bj][m][0] + bv[bj][0], v1 = acc[ai][bj][m][1] + bv[bj][1];
                    const pg8::f32x2 a = pg8::gelu_pk((pg8::f32x2){v0[0], v0[1]}), b = pg8::gelu_pk((pg8::f32x2){v0[2], v0[3]}), c = pg8::gelu_pk((pg8::f32x2){v1[0], v1[1]}), d = pg8::gelu_pk((pg8::f32x2){v1[2], v1[3]});
                    u32x4 w; w.x = pg8::cvt_pk_bf16(a.x, a.y); w.y = pg8::cvt_pk_bf16(b.x, b.y); w.z = pg8::cvt_pk_bf16(c.x, c.y); w.w = pg8::cvt_pk_bf16(d.x, d.y);
                    *(u32x4*)(rowp + bj * 128) = w; } }
    }
};
struct EpiResidual {
    static constexpr bool PERM = false, AFTER_DRAIN = false;
    float* H; const float* gate0; int row_base;
    __device__ __forceinline__ void operator()(const pg8::f32x4 (&acc)[2][2][4][2], const pg8::Unit& u, int wr, int wc, int fr, int fq) const {
        const int row0 = u.pm * 256 + wr * 64 + fr, col0 = u.pn * 256 + wc * 32 + 4 * fq;
        const Tok tk = tokinfo(row_base + u.pm * 256);
        const float* gate = gate0 + (size_t)tk.modrow * 6144 + col0;
        pg8::f32x4 gv[2][2];
#pragma unroll
        for (int bj = 0; bj < 2; ++bj)
#pragma unroll
            for (int n = 0; n < 2; ++n) gv[bj][n] = *(const pg8::f32x4*)(gate + bj * 128 + n * 16);
#pragma unroll
        for (int ai = 0; ai < 2; ++ai)
#pragma unroll
            for (int m = 0; m < 4; ++m) { float* rowp = H + (size_t)(row0 + ai * 128 + m * 16) * DM + col0;
#pragma unroll
                for (int bj = 0; bj < 2; ++bj)
#pragma unroll
                    for (int n = 0; n < 2; ++n) { pg8::f32x4* p = (pg8::f32x4*)(rowp + bj * 128 + n * 16); *p = *p + gv[bj][n] * acc[ai][bj][m][n]; } }
    }
};
struct ListOrder {
    const LAS int* list; int n;
    __device__ __forceinline__ bool next(int i, pg8::Unit& u) const {
        if (i >= n) return false;
        u.pm = __builtin_amdgcn_readfirstlane(list[2 * i]); u.pn = __builtin_amdgcn_readfirstlane(list[2 * i + 1]); return true;
    }
    __device__ __forceinline__ void a_ready(const pg8::Unit&) const {}
    __device__ __forceinline__ void done(const pg8::Unit&) const {}
};
constexpr int LDS_TAB = 131072;
constexpr int LDS_LIST = LDS_TAB + 4096;
__device__ __forceinline__ ListOrder build_units(LAS unsigned char* lds, int nM, int nN, int G, int c, const LAS int* tile_e, int ncol) {
    LAS int* list = (LAS int*)(lds + LDS_LIST);
    pg8::StaticOrder S; S.nM = nM; S.nN = nN; S.nwg = nM * nN; S.G = G; S.c = c;
    const int tid = tid_opaque();
    if (tid < 64) { pg8::Unit u; if (S.next(tid, u)) { if (tile_e) u.pn = tile_e[u.pm] * ncol + u.pn; list[2 * tid] = u.pm; list[2 * tid + 1] = u.pn; } }
    __syncthreads();
    ListOrder L; L.list = list; L.n = (c < S.nwg) ? (S.nwg - c + G - 1) / G : 0;
    return L;
}
struct EpiMoe1 {
    static constexpr bool PERM = true, AFTER_DRAIN = false;
    bf16_t* O; const float* b1;
    __device__ __forceinline__ void operator()(const pg8::f32x4 (&acc)[2][2][4][2], const pg8::Unit& u, int wr, int wc, int fr, int fq) const {
        const int e = u.pn >> 3, pn = u.pn & 7;
        const int row0 = u.pm * 256 + wr * 64 + fr, ci = pn * 128 + wc * 32 + 8 * fq;
        const float* be = b1 + (size_t)e * 2048 + ci;
        const pg8::f32x4 bg0 = *(const pg8::f32x4*)(be), bg1 = *(const pg8::f32x4*)(be + 4), bl0 = *(const pg8::f32x4*)(be + 1024), bl1 = *(const pg8::f32x4*)(be + 1028);
#pragma unroll
        for (int ai = 0; ai < 2; ++ai)
#pragma unroll
            for (int m = 0; m < 4; ++m) {
                const pg8::f32x4 g0 = acc[ai][0][m][0] + bg0, g1 = acc[ai][0][m][1] + bg1, l0 = acc[ai][1][m][0] + bl0, l1 = acc[ai][1][m][1] + bl1;
                float o[8];
#pragma unroll
                for (int r = 0; r < 4; ++r) {
                    const float ga = fminf(g0[r], 7.0f), gb = fminf(g1[r], 7.0f);
                    const float la = fminf(fmaxf(l0[r], -7.0f), 7.0f), lb = fminf(fmaxf(l1[r], -7.0f), 7.0f);
                    o[r] = ga * __builtin_amdgcn_rcpf(1.0f + __expf(-1.702f * ga)) * (la + 1.0f);
                    o[4 + r] = gb * __builtin_amdgcn_rcpf(1.0f + __expf(-1.702f * gb)) * (lb + 1.0f);
                }
                u32x4 w; w.x = pg8::cvt_pk_bf16(o[0], o[1]); w.y = pg8::cvt_pk_bf16(o[2], o[3]); w.z = pg8::cvt_pk_bf16(o[4], o[5]); w.w = pg8::cvt_pk_bf16(o[6], o[7]);
                *(u32x4*)(O + (size_t)(row0 + ai * 128 + m * 16) * DM + ci) = w;
            }
    }
};
struct EpiMoe2 {
    static constexpr bool PERM = true, AFTER_DRAIN = false;
    bf16_t* O; const float* b2;
    __device__ __forceinline__ void operator()(const pg8::f32x4 (&acc)[2][2][4][2], const pg8::Unit& u, int wr, int wc, int fr, int fq) const {
        const int e = u.pn >> 2, pn = u.pn & 3;
        const int row0 = u.pm * 256 + wr * 64 + fr, col0 = pn * 256 + wc * 32 + 8 * fq;
        const float* be = b2 + (size_t)e * DM + col0;
        pg8::f32x4 bv[2][2];
#pragma unroll
        for (int bj = 0; bj < 2; ++bj)
#pragma unroll
            for (int n = 0; n < 2; ++n) bv[bj][n] = *(const pg8::f32x4*)(be + bj * 128 + 4 * n);
#pragma unroll
        for (int ai = 0; ai < 2; ++ai)
#pragma unroll
            for (int m = 0; m < 4; ++m) { bf16_t* rowp = O + (size_t)(row0 + ai * 128 + m * 16) * DM + col0;
#pragma unroll
                for (int bj = 0; bj < 2; ++bj) { const pg8::f32x4 v0 = acc[ai][bj][m][0] + bv[bj][0], v1 = acc[ai][bj][m][1] + bv[bj][1];
                    u32x4 w; w.x = pg8::cvt_pk_bf16(v0[0], v0[1]); w.y = pg8::cvt_pk_bf16(v0[2], v0[3]); w.z = pg8::cvt_pk_bf16(v1[0], v1[1]); w.w = pg8::cvt_pk_bf16(v1[2], v1[3]);
                    *(u32x4*)(rowp + bj * 128) = w; } }
    }
};

__device__ __forceinline__ void ph_gemm_win(const Args& A, int j, int row_lo, LAS unsigned char* lds, int bid, int nb) {
    unsigned char* ws = opq(A.ws); const float* const* IN = (const float* const*)(ws + WS_PTRS); (void)IN;
    pg8::Gemm g{(const bf16_t*)(ws + WS_ABF) + (size_t)row_lo * DM, (const bf16_t*)(ws + WS_WIN) + (size_t)j * ZLD * DM, NTOK - row_lo, ZLD, DM};
    const ListOrder S = build_units(lds, (NTOK - row_lo) / 256, ZLD / 256, nb, bid, nullptr, 0);
    EpiStoreBf16 E{(bf16_t*)(ws + WS_Z) + (size_t)row_lo * ZLD, ZLD};
    pg8::gemm_phase<EpiStoreBf16, ListOrder, true, true>(lds, g, S, E);
}

__device__ __forceinline__ void ph_rwkv_feat(const Args& A, int j, int row_lo, LAS unsigned char* lds, int bid, int nb) {
    unsigned char* ws = opq(A.ws); const float* const* IN = (const float* const*)(ws + WS_PTRS); (void)IN;
    const int tid = tid_opaque(), c = tid;
    LAS float* zs = (LAS float*)lds;
    const bf16_t* Z = (const bf16_t*)(ws + WS_Z);
    const float* mu = IN[I_RWMU] + (size_t)j * 2 * RWC;
    const float* w0 = IN[I_RWW0] + (size_t)j * 2 * 512; const float* w2 = IN[I_RWW2] + (size_t)j * 2 * 64 * 512;
    const float* a0 = IN[I_RWA0] + (size_t)j * 2 * 512; const float* a2 = IN[I_RWA2] + (size_t)j * 2 * 64 * 512;
    const float* g2 = IN[I_RWG2] + (size_t)j * 128 * 512;
    const float kkw = IN[I_RWKK][j * 512 + c], kaw = IN[I_RWKA][j * 512 + c], rkw = IN[I_RWRK][j * 512 + c];
    const float w00 = w0[c], w01 = w0[512 + c], a00 = a0[c], a01 = a0[512 + c];
    float* F = (float*)(ws + WS_F);
    for (int grp = row_lo / 4 + bid; grp < NTOK / 4; grp += nb) {
        const int g0 = grp * 4; const Tok tk = tokinfo(g0);
        for (int col = tid; col < RWC; col += NTHREADS) {
            const float m0 = mu[col], m1 = mu[RWC + col];
            float z[6];
#pragma unroll
            for (int i = 0; i < 6; ++i) { const int tt = tk.t - 1 + i; z[i] = (tt >= 0 && tt < tk.T) ? bf2f(Z[(size_t)(g0 - 1 + i) * ZLD + col]) : 0.f; }
#pragma unroll
            for (int k = 0; k < 4; ++k) zs[k * RWC + col] = z[k + 1] + m0 * (z[k] - z[k + 1]) + m1 * (z[k + 2] - z[k + 1]);
        }
        __syncthreads();
        for (int i = tid; i < 1024; i += NTHREADS) {
            const int k = i >> 8, q = i & 255;
            if (q < 128) { const int idx = k * RWC + 1536 + q; zs[idx] = tanhf(zs[idx]); }
            else { const int idx = k * RWC + 1792 + (q - 128); zs[idx] = sigmoidf_(zs[idx]); }
        }
        __syncthreads();
        float aw0[4], aw1[4], aa0[4], aa1[4], ag[4];
#pragma unroll
        for (int k = 0; k < 4; ++k) { aw0[k] = 0.f; aw1[k] = 0.f; aa0[k] = 0.f; aa1[k] = 0.f; ag[k] = 0.f; }
        for (int r = 0; r < 64; ++r) {
            const float w20 = w2[r * 512 + c], w21 = w2[(64 + r) * 512 + c], a20 = a2[r * 512 + c], a21 = a2[(64 + r) * 512 + c];
#pragma unroll
            for (int k = 0; k < 4; ++k) {
                aw0[k] += zs[k * RWC + 1536 + r] * w20; aw1[k] += zs[k * RWC + 1600 + r] * w21;
                aa0[k] += zs[k * RWC + 1664 + r] * a20; aa1[k] += zs[k * RWC + 1728 + r] * a21;
            }
        }
        for (int r = 0; r < 128; ++r) {
            const float gv = g2[r * 512 + c];
#pragma unroll
            for (int k = 0; k < 4; ++k) ag[k] += zs[k * RWC + 1792 + r] * gv;
        }
#pragma unroll
        for (int k = 0; k < 4; ++k) {
            const float r_ = zs[k * RWC + c], k_ = zs[k * RWC + 512 + c], v_ = zs[k * RWC + 1024 + c];
            float dec[2], av[2];
#pragma unroll
            for (int d = 0; d < 2; ++d) {
                const float x = (d ? w01 : w00) + (d ? aw1[k] : aw0[k]);
                const float y = -x;
                const float sp = fmaxf(y, 0.f) + log1pf(__expf(-fabsf(y)));
                const float w = -sp - 0.5f;
                dec[d] = __expf(-__expf(w));
                av[d] = sigmoidf_((d ? a01 : a00) + (d ? aa1[k] : aa0[k]));
            }
            float kk = k_ * kkw;
            const float nrm = sqrtf(wave_sum(kk * kk));
            kk = kk / fmaxf(nrm, 1e-12f);
            const float kd0 = k_ * (1.0f + (av[0] - 1.0f) * kaw), kd1 = k_ * (1.0f + (av[1] - 1.0f) * kaw);
            const float s0 = wave_sum(r_ * kd0 * rkw), s1 = wave_sum(r_ * kd1 * rkw);
            const size_t o = (size_t)(g0 + k) * 512 + c; const size_t FS = (size_t)NTOK * 512;
            F[0 * FS + o] = r_; F[1 * FS + o] = v_; F[2 * FS + o] = kk; F[3 * FS + o] = ag[k]; F[4 * FS + o] = (s0 + s1) * v_;
            F[5 * FS + o] = dec[0]; F[6 * FS + o] = dec[1]; F[7 * FS + o] = kd0; F[8 * FS + o] = kd1; F[9 * FS + o] = kk * av[0]; F[10 * FS + o] = kk * av[1];
        }
        __syncthreads();
    }
}

__device__ __forceinline__ void ph_scan_naive(const Args& A, int bid, int nb) {
    unsigned char* ws = opq(A.ws); const float* const* IN = (const float* const*)(ws + WS_PTRS); (void)IN;
    const int tid = tid_opaque(), lane = tid & 63, wid = tid >> 6;
    if (wid != 0) return;
    const float* F = (const float*)(ws + WS_F); const size_t FS = (size_t)NTOK * 512;
    float* YS = (float*)(ws + WS_YS);
    for (int inst = bid; inst < 256; inst += nb) {
        const int dir = inst & 1, h = (inst >> 1) & 7, b = inst >> 4;
        float S[64];
#pragma unroll
        for (int k = 0; k < 64; ++k) S[k] = 0.f;
        const float* Fw = F + (5 + dir) * FS; const float* Fk = F + (7 + dir) * FS; const float* Fb = F + (9 + dir) * FS;
        float* Y = YS + dir * FS;
        for (int s = 0; s < TC + TL; ++s) {
            int g;
            if (s < TC) g = b * TC + (dir ? (TC - 1 - s) : s);
            else { const int q = s - TC; g = NCTX + b * TL + (dir ? (TL - 1 - q) : q); }
            const size_t o = (size_t)g * 512 + h * 64 + lane;
            const float r_ = F[o], v_ = F[FS + o], kk_ = F[2 * FS + o], w_ = Fw[o], kd_ = Fk[o], b_ = Fb[o];
            float sa = 0.f;
#pragma unroll
            for (int k = 0; k < 64; ++k) sa -= S[k] * rdl(kk_, k);
            float y = 0.f;
#pragma unroll
            for (int k = 0; k < 64; ++k) {
                float sv = S[k] * rdl(w_, k);
                sv += sa * rdl(b_, k);
                sv += v_ * rdl(kd_, k);
                S[k] = sv;
                y += sv * rdl(r_, k);
            }
            Y[o] = y;
        }
    }
}

__device__ __forceinline__ void ph_qk(const Args& A, int j, int row_lo, int bid, int nb) {
    unsigned char* ws = opq(A.ws); const float* const* IN = (const float* const*)(ws + WS_PTRS); (void)IN;
    const int tid = tid_opaque(), lane = tid & 63, wid = tid >> 6;
    const bf16_t* Z = (const bf16_t*)(ws + WS_Z);
    float* QF = (float*)(ws + WS_QF); float* KF = (float*)(ws + WS_KF); float* VF = (float*)(ws + WS_VF);
    const float qn = IN[I_QN][j * 64 + lane], kn = IN[I_KN][j * 64 + lane];
    const float invf = __powf(10000.0f, -(float)(lane & 15) / 16.0f);
    for (int g = row_lo + bid; g < NTOK; g += nb) {
        const Tok tk = tokinfo(g);
        const bf16_t* zr = Z + (size_t)g * ZLD + RWC;
        VF[(size_t)g * 512 + tid] = bf2f(zr[1024 + tid]);
#pragma unroll
        for (int ss = 0; ss < 2; ++ss) {
            const int sh = wid * 2 + ss, isk = sh >> 3, s = sh & 7;
            const float x = bf2f(zr[isk * 512 + s * 64 + lane]);
            const float ms = wave_sum(x * x) * (1.0f / 64.0f);
            float y = x * rsqrtf(ms + 1e-6f) * (isk ? kn : qn);
            if (tk.T == TL) {
                const float pos = (float)((lane & 32) ? (tk.t & 63) : (tk.t >> 6));
                const float ang = pos * invf;
                float sn, cs; __sincosf(ang, &sn, &cs);
                const float other = __shfl_xor(y, 16);
                y = (lane & 16) ? (y * cs + other * sn) : (y * cs - other * sn);
            }
            (isk ? KF : QF)[(size_t)g * 512 + s * 64 + lane] = y;
        }
    }
}

__device__ __forceinline__ void ph_attn_naive(const Args& A, bool want_ctx, int bid, int nb) {
    unsigned char* ws = opq(A.ws); const float* const* IN = (const float* const*)(ws + WS_PTRS); (void)IN;
    const int tid = tid_opaque();
    const float* QF = (const float*)(ws + WS_QF); const float* KF = (const float*)(ws + WS_KF); const float* VF = (const float*)(ws + WS_VF);
    float* OP = (float*)(ws + WS_OP);
    const int nlat = 512 * 4;
    const int nunits = nlat + (want_ctx ? 256 : 0);
    for (int u = bid; u < nunits; u += nb) {
        int combo, q, nkeys, isctx;
        if (u < nlat) { combo = u >> 2; q = (u & 3) * 512 + tid; nkeys = TC + TL; isctx = 0; }
        else { combo = (u - nlat) * 2 + (tid >> 8); q = tid & 255; nkeys = TC; isctx = 1; }
        const int qr = combo & 3, m = (combo >> 2) & 1, h = (combo >> 3) & 3, b = combo >> 5, s = h * 2 + m;
        const int qtok = isctx ? b * TC + q : NCTX + b * TL + q;
        float qv[64];
#pragma unroll
        for (int d = 0; d < 64; d += 4) { const f32x4 t = *(const f32x4*)(QF + (size_t)qtok * 512 + s * 64 + d); qv[d] = t.x * 0.125f; qv[d + 1] = t.y * 0.125f; qv[d + 2] = t.z * 0.125f; qv[d + 3] = t.w * 0.125f; }
        float acc[32];
#pragma unroll
        for (int e = 0; e < 32; ++e) acc[e] = 0.f;
        float mrun = -3.0e38f, lrun = 0.f;
#pragma unroll 1
        for (int n0 = 0; n0 < nkeys; n0 += 2) {
            const int kt0 = (n0 < TC) ? b * TC + n0 : NCTX + b * TL + (n0 - TC);
            float sc[2];
#pragma unroll
            for (int i = 0; i < 2; ++i) {
                const float* kp = KF + (size_t)(kt0 + i) * 512 + s * 64; float a = 0.f;
#pragma unroll
                for (int d = 0; d < 64; d += 4) { const f32x4 t = *(const f32x4*)(kp + d); a += (qv[d] * t.x + qv[d + 1] * t.y) + (qv[d + 2] * t.z + qv[d + 3] * t.w); }
                sc[i] = a;
            }
            const float mnew = fmaxf(mrun, fmaxf(sc[0], sc[1]));
            const float corr = __expf(mrun - mnew);
            const float p0 = __expf(sc[0] - mnew), p1 = __expf(sc[1] - mnew);
            lrun = lrun * corr + p0 + p1;
            mrun = mnew;
            const float* vp0 = VF + (size_t)kt0 * 512 + h * 128 + qr * 32; const float* vp1 = vp0 + 512;
#pragma unroll
            for (int e = 0; e < 32; e += 4) {
                const f32x4 t0 = *(const f32x4*)(vp0 + e), t1 = *(const f32x4*)(vp1 + e);
                acc[e] = acc[e] * corr + p0 * t0.x + p1 * t1.x; acc[e + 1] = acc[e + 1] * corr + p0 * t0.y + p1 * t1.y;
                acc[e + 2] = acc[e + 2] * corr + p0 * t0.z + p1 * t1.z; acc[e + 3] = acc[e + 3] * corr + p0 * t0.w + p1 * t1.w;
            }
        }
        const float inv = 1.0f / lrun;
        float* op = OP + (size_t)m * NTOK * 512 + (size_t)qtok * 512 + h * 128 + qr * 32;
#pragma unroll
        for (int e = 0; e < 32; e += 4) *(f32x4*)(op + e) = (f32x4){acc[e] * inv, acc[e + 1] * inv, acc[e + 2] * inv, acc[e + 3] * inv};
    }
}

__device__ __forceinline__ void ph_merge(const Args& A, int l, int row_lo, LAS unsigned char* lds, int bid, int nb) {
    unsigned char* ws = opq(A.ws); const float* const* IN = (const float* const*)(ws + WS_PTRS); (void)IN;
    const int j = l >> 1;
    const int tid = tid_opaque(), lane = tid & 63, wid = tid >> 6, c = tid;
    LAS float* sh = (LAS float*)lds;
    const float lam_init = 0.8f - 0.6f * __expf(-0.3f * (float)l);
    if (wid == 0) {
        const float* lp = IN[I_LAM] + j * 4 * 64;
        const float s01 = wave_sum(lp[lane] * lp[64 + lane]), s23 = wave_sum(lp[128 + lane] * lp[192 + lane]);
        if (lane == 0) sh[8] = __expf(s01) - __expf(s23) + lam_init;
    }
    __syncthreads();
    const float lam = sh[8];
    const float* F = (const float*)(ws + WS_F); const size_t FS = (size_t)NTOK * 512;
    const float* YS = (const float*)(ws + WS_YS); const float* OP = (const float*)(ws + WS_OP);
    bf16_t* CAT = (bf16_t*)(ws + WS_CAT);
    const float gnw = IN[I_GNW][j * 512 + c], gnb = IN[I_GNB][j * 512 + c], sub = IN[I_SUBLN][j * 128 + (c & 127)];
    for (int g = row_lo + bid; g < NTOK; g += nb) {
        const size_t o = (size_t)g * 512 + c;
        const float y = YS[o] + YS[FS + o];
        const float mu = wave_sum(y) * (1.0f / 64.0f);
        const float dv = y - mu;
        const float var = wave_sum(dv * dv) * (1.0f / 64.0f);
        const float yn = dv * rsqrtf(var + 64e-5f) * gnw + gnb;
        const float ya = (yn + F[4 * FS + o]) * F[3 * FS + o];
        const float od = OP[o] - lam * OP[FS + o];
        const float ssw = wave_sum(od * od);
        if (lane == 0) sh[wid] = ssw;
        __syncthreads();
        const float ms = (sh[wid & ~1] + sh[wid | 1]) * (1.0f / 128.0f);
        const float ob = od * rsqrtf(ms + 1e-6f) * sub * (1.0f - lam_init);
        CAT[(size_t)g * DM + c] = (bf16_t)f2bf(ya);
        CAT[(size_t)g * DM + 512 + c] = (bf16_t)f2bf(ob);
        __syncthreads();
    }
}

__device__ __forceinline__ void ph_gemm_out(const Args& A, int l, size_t x_off, size_t wt_off, int row_lo, LAS unsigned char* lds, int bid, int nb) {
    unsigned char* ws = opq(A.ws); const float* const* IN = (const float* const*)(ws + WS_PTRS); (void)IN;
    pg8::Gemm g{(const bf16_t*)(ws + x_off) + (size_t)row_lo * DM, (const bf16_t*)(ws + wt_off), NTOK - row_lo, DM, DM};
    const ListOrder S = build_units(lds, (NTOK - row_lo) / 256, DM / 256, nb, bid, nullptr, 0);
    EpiResidual E{(float*)(ws + WS_H) + (size_t)row_lo * DM, (const float*)(ws + WS_MOD) + (size_t)l * 17 * 6144 + 2 * 1024, row_lo};
    pg8::gemm_phase<EpiResidual, ListOrder, true, true>(lds, g, S, E);
}

__device__ __forceinline__ void ph_gemm_sgin(const Args& A, int j, int row_lo, LAS unsigned char* lds, int bid, int nb) {
    unsigned char* ws = opq(A.ws); const float* const* IN = (const float* const*)(ws + WS_PTRS); (void)IN;
    pg8::Gemm g{(const bf16_t*)(ws + WS_ABF) + (size_t)row_lo * DM, (const bf16_t*)(ws + WS_SGIN) + (size_t)j * 2048 * DM, NTOK - row_lo, 2048, DM};
    const ListOrder S = build_units(lds, (NTOK - row_lo) / 256, 2048 / 256, nb, bid, nullptr, 0);
    EpiGeluBf16 E{(bf16_t*)(ws + WS_Z2) + (size_t)row_lo * 2048, 2048, IN[I_SGBIN] + j * 2048};
    pg8::gemm_phase<EpiGeluBf16, ListOrder, true, true>(lds, g, S, E);
}
__device__ __forceinline__ void ph_sgu_ln(const Args& A, int j, int row_lo, int bid, int nb) {
    unsigned char* ws = opq(A.ws); const float* const* IN = (const float* const*)(ws + WS_PTRS); (void)IN;
    const int tid = tid_opaque(), lane = tid & 63, wid = tid >> 6;
    const bf16_t* Z2 = (const bf16_t*)(ws + WS_Z2); float* VN = (float*)(ws + WS_VN);
    const float* lg = IN[I_SGLNG] + j * 1024; const float* lb = IN[I_SGLNB] + j * 1024;
    for (int row = row_lo + bid * NWAVES + wid; row < NTOK; row += nb * NWAVES) {
        f32x4 v[4]; float s = 0.f;
#pragma unroll
        for (int q = 0; q < 4; ++q) { const u32x2 t = *(const u32x2*)(Z2 + (size_t)row * 2048 + 1024 + q * 256 + lane * 4);
            v[q] = (f32x4){__builtin_bit_cast(float, t.x << 16), __builtin_bit_cast(float, t.x & 0xffff0000u), __builtin_bit_cast(float, t.y << 16), __builtin_bit_cast(float, t.y & 0xffff0000u)}; s += (v[q].x + v[q].y) + (v[q].z + v[q].w); }
        const float mean = wave_sum(s) * (1.0f / 1024.0f); float s2 = 0.f;
#pragma unroll
        for (int q = 0; q < 4; ++q) { v[q] = v[q] - mean; s2 += (v[q].x * v[q].x + v[q].y * v[q].y) + (v[q].z * v[q].z + v[q].w * v[q].w); }
        const float rstd = rsqrtf(wave_sum(s2) * (1.0f / 1024.0f) + 1e-5f);
#pragma unroll
        for (int q = 0; q < 4; ++q) { const int col = q * 256 + lane * 4; *(f32x4*)(VN + (size_t)row * DM + col) = v[q] * rstd * *(const f32x4*)(lg + col) + *(const f32x4*)(lb + col); }
    }
}
__device__ __forceinline__ void ph_sgu_spatial(const Args& A, int j, int row_lo, LAS unsigned char* lds, int bid, int nb) {
    unsigned char* ws = opq(A.ws); const float* const* IN = (const float* const*)(ws + WS_PTRS); (void)IN;
    const int tid = tid_opaque();
    const bf16_t* Z2 = (const bf16_t*)(ws + WS_Z2); const float* VN = (const float*)(ws + WS_VN); bf16_t* G = (bf16_t*)(ws + WS_G);
    LAS float* vt = (LAS float*)lds;
    LAS float* wl = (LAS float*)(lds + 65536);
    const int ch0 = row_lo / 128, nch = NTOK / 128 - ch0;
    for (int u = bid; u < nch * 8; u += nb) {
        const int ci = ch0 + u / 8, g = u % 8;
        const float* wsg = IN[I_SGWS] + ((size_t)j * 8 + g) * 128 * 128;
        for (int i = tid; i < 128 * 32; i += NTHREADS) {
            const int q = i >> 5, c4 = (i & 31) * 4;
            *(LAS f32x4*)(vt + q * 128 + c4) = *(const f32x4*)(VN + (size_t)(ci * 128 + q) * DM + g * 128 + c4);
            *(LAS f32x4*)(wl + q * 128 + c4) = *(const f32x4*)(wsg + q * 128 + c4);
        }
        __syncthreads();
        const int c = tid & 127, pg = tid >> 7;
        float acc[32];
#pragma unroll
        for (int i = 0; i < 32; ++i) acc[i] = 0.f;
        for (int q = 0; q < 128; q += 4) {
            const float v0 = vt[q * 128 + c], v1 = vt[(q + 1) * 128 + c], v2 = vt[(q + 2) * 128 + c], v3 = vt[(q + 3) * 128 + c];
#pragma unroll
            for (int i = 0; i < 32; ++i) { const f32x4 w = *(const LAS f32x4*)(wl + (pg * 32 + i) * 128 + q); acc[i] += (w.x * v0 + w.y * v1) + (w.z * v2 + w.w * v3); }
        }
#pragma unroll
        for (int i = 0; i < 32; ++i) {
            const int p = pg * 32 + i; const size_t row = (size_t)ci * 128 + p;
            const float uu = bf2f(Z2[row * 2048 + g * 128 + c]);
            const float sv = acc[i] + IN[I_SGBS][((size_t)j * 8 + g) * 128 + p];
            G[row * DM + g * 128 + c] = (bf16_t)f2bf(uu * sv);
        }
        __syncthreads();
    }
}

__device__ __forceinline__ int moe_layout(const Args& A, int l, LAS int* off  , LAS int* cntl  , LAS int* tile_e  ) {
    const int tid = tid_opaque();
    const unsigned* cnt = (const unsigned*)(opq(A.ws) + WS_CTL) + CW_CNT + l * 32;
    if (tid < 64) {
        const int n = (tid < 32) ? (int)__hip_atomic_load(cnt + tid, __ATOMIC_RELAXED, __HIP_MEMORY_SCOPE_AGENT) : 0;
        const int nt = (n + 255) >> 8;
        int x = nt;
#pragma unroll
        for (int o = 1; o < 32; o <<= 1) { const int y = __shfl_up(x, o); if (tid >= o) x += y; }
        const int start = x - nt;
        if (tid < 32) {
            cntl[tid] = n; off[tid] = start * 256;
#pragma unroll 1
            for (int t = 0; t < nt; ++t) tile_e[start + t] = tid;
        }
        if (tid == 31) off[32] = x * 256;
    }
    __syncthreads();
    return off[32] >> 8;
}
__device__ __forceinline__ void ph_moe_scatter(const Args& A, int l, int row_lo, LAS unsigned char* lds, int bid, int nb) {
    unsigned char* ws = opq(A.ws); const float* const* IN = (const float* const*)(ws + WS_PTRS); (void)IN;
    const int tid = tid_opaque(), lane = tid & 63, wid = tid >> 6;
    LAS int* off = (LAS int*)lds; LAS int* cntl = off + 64; LAS int* tile_e = off + 128;
    moe_layout(A, l, off, cntl, tile_e);
    const bf16_t* abf = (const bf16_t*)(ws + WS_ABF); bf16_t* XP = (bf16_t*)(ws + WS_XP);
    const int* te = (const int*)(ws + WS_TOKE); int* rowof = (int*)(ws + WS_ROWOF);
    unsigned* cur = (unsigned*)(ws + WS_CTL) + CW_CUR + l * 32;
    const int ntask = (NTOK - row_lo) * 4;
    for (int task = bid * NWAVES + wid; task < ntask; task += nb * NWAVES) {
        const int g = row_lo + (task >> 2), k = task & 3;
        const int e = te[(size_t)g * 4 + k];
        int pos = 0;
        if (lane == 0) { pos = off[e] + (int)atomicAdd(cur + e, 1u); rowof[(size_t)g * 4 + k] = pos; }
        pos = __shfl(pos, 0);
        const u32x4* src = (const u32x4*)(abf + (size_t)g * DM); u32x4* dst = (u32x4*)(XP + (size_t)pos * DM);
        dst[lane] = src[lane]; dst[64 + lane] = src[64 + lane];
    }
    for (int e = bid; e < 32; e += nb) {
        const int r0 = off[e] + cntl[e], r1 = off[e + 1];
        for (int i = tid; i < (r1 - r0) * 128; i += NTHREADS) ((u32x4*)(XP + (size_t)r0 * DM))[i] = (u32x4){0u, 0u, 0u, 0u};
    }
}
__device__ __forceinline__ void ph_moe_gemm1(const Args& A, int l, LAS unsigned char* lds, int bid, int nb) {
    unsigned char* ws = opq(A.ws); const float* const* IN = (const float* const*)(ws + WS_PTRS); (void)IN;
    LAS int* off = (LAS int*)(lds + LDS_TAB); LAS int* cntl = off + 64; LAS int* tile_e = off + 128;
    const int T = moe_layout(A, l, off, cntl, tile_e);
    pg8::Gemm g{(const bf16_t*)(ws + WS_XP), (const bf16_t*)(ws + WS_W1) + (size_t)l * NE * 2048 * DM, T * 256, 2048, DM};
    const ListOrder S = build_units(lds, T, 8, nb, bid, tile_e, 8);
    EpiMoe1 E{(bf16_t*)(ws + WS_ACT), IN[I_B1] + (size_t)l * NE * 2048};
    pg8::gemm_phase<EpiMoe1, ListOrder, true, true>(lds, g, S, E);
}
__device__ __forceinline__ void ph_moe_gemm2(const Args& A, int l, LAS unsigned char* lds, int bid, int nb) {
    unsigned char* ws = opq(A.ws); const float* const* IN = (const float* const*)(ws + WS_PTRS); (void)IN;
    LAS int* off = (LAS int*)(lds + LDS_TAB); LAS int* cntl = off + 64; LAS int* tile_e = off + 128;
    const int T = moe_layout(A, l, off, cntl, tile_e);
    pg8::Gemm g{(const bf16_t*)(ws + WS_ACT), (const bf16_t*)(ws + WS_W2) + (size_t)l * NE * DM * DM, T * 256, DM, DM};
    const ListOrder S = build_units(lds, T, 4, nb, bid, tile_e, 4);
    EpiMoe2 E{(bf16_t*)(ws + WS_YM), IN[I_B2] + (size_t)l * NE * DM};
    pg8::gemm_phase<EpiMoe2, ListOrder, true, true>(lds, g, S, E);
}
__device__ __forceinline__ void ph_moe_combine(const Args& A, int l, int row_lo, bool last, int bid, int nb) {
    unsigned char* ws = opq(A.ws); const float* const* IN = (const float* const*)(ws + WS_PTRS); (void)IN;
    const int tid = tid_opaque(), lane = tid & 63, wid = tid >> 6;
    float* H = (float*)(ws + WS_H); const float* mod = (const float*)(ws + WS_MOD); const bf16_t* YM = (const bf16_t*)(ws + WS_YM);
    const int* rowof = (const int*)(ws + WS_ROWOF); const float* tg = (const float*)(ws + WS_TOKG);
    for (int row = row_lo + bid * NWAVES + wid; row < NTOK; row += nb * NWAVES) {
        const Tok tk = tokinfo(row);
        const float* gate = mod + ((size_t)l * 17 + tk.modrow) * 6144 + 5 * 1024;
        int r[4]; float gk[4];
#pragma unroll
        for (int k = 0; k < 4; ++k) { r[k] = rowof[(size_t)row * 4 + k]; gk[k] = tg[(size_t)row * 4 + k]; }
#pragma unroll
        for (int q = 0; q < 4; ++q) {
            const int col = q * 256 + lane * 4;
            f32x4 m = (f32x4){0.f, 0.f, 0.f, 0.f};
#pragma unroll
            for (int k = 0; k < 4; ++k) { const u32x2 t = *(const u32x2*)(YM + (size_t)r[k] * DM + col);
                m = m + (f32x4){__builtin_bit_cast(float, t.x << 16), __builtin_bit_cast(float, t.x & 0xffff0000u), __builtin_bit_cast(float, t.y << 16), __builtin_bit_cast(float, t.y & 0xffff0000u)} * gk[k]; }
            const f32x4 hv = *(const f32x4*)(H + (size_t)row * DM + col) + *(const f32x4*)(gate + col) * m;
            if (last) *(f32x4*)(((float* const*)IN)[38] + (size_t)(row - NCTX) * DM + col) = hv;
            else *(f32x4*)(H + (size_t)row * DM + col) = hv;
        }
    }
}

__global__ void __launch_bounds__(NTHREADS, 2) fwd_kernel(Args A) {
    extern __shared__ __attribute__((aligned(16))) unsigned char lds_raw[];
    LAS unsigned char* lds = (LAS unsigned char*)lds_raw;
    volatile LAS unsigned* misc = (volatile LAS unsigned*)(lds + LDS_MISC);
    const int tid = threadIdx.x, bid = blockIdx.x, nb = gridDim.x;
    if (tid < 64) misc[tid] = 0u;
    __syncthreads();
    XcdBarrier bar = xcd_barrier_post((unsigned*)(A.ws + WS_CTL) + CW_BAR, misc + 8);
    const int lo = A.ph_lo, hi = A.ph_hi;
    int pc = 0;
#ifndef PHSEL
#define PHSEL -1
#endif
#define SEL(k) (PHSEL < 0 || PHSEL == (k))
#define PH_BEGIN if (pc >= lo && pc < hi) {
#define PH_END } if (pc >= lo && pc + 1 < hi) xcd_barrier(bar); ++pc;

    PH_BEGIN if (SEL(0)) ph_prologue(A, lds, bid, nb); PH_END

    for (int l = 0; l < 4; ++l) {
        const int j = l >> 1;
        const bool ctx_out = (l < 2), ctx_in = (l < 3);
        const int rin = ctx_in ? 0 : NCTX, rout = ctx_out ? 0 : NCTX;
        PH_BEGIN if (SEL(1)) ph_norm<false>(A, l, rin, bid, nb); PH_END
        if ((l & 1) == 0) {
            PH_BEGIN if (SEL(2)) ph_gemm_win(A, j, rin, lds, bid, nb); PH_END
            PH_BEGIN if (SEL(3)) ph_rwkv_feat(A, j, rin, lds, bid, nb); if (SEL(4)) ph_qk(A, j, rin, bid, nb); PH_END
            PH_BEGIN if (SEL(5)) ph_scan_naive(A, bid, nb); if (SEL(6)) ph_attn_naive(A, ctx_out, bid, nb); PH_END
            PH_BEGIN if (SEL(7)) ph_merge(A, l, rout, lds, bid, nb); PH_END
            PH_BEGIN if (SEL(8)) ph_gemm_out(A, l, WS_CAT, WS_WOUT + (size_t)j * DM * DM * 2, rout, lds, bid, nb); PH_END
        } else {
            PH_BEGIN if (SEL(9)) ph_gemm_sgin(A, j, rin, lds, bid, nb); PH_END
            PH_BEGIN if (SEL(10)) ph_sgu_ln(A, j, rin, bid, nb); PH_END
            PH_BEGIN if (SEL(11)) ph_sgu_spatial(A, j, rout, lds, bid, nb); PH_END
            PH_BEGIN if (SEL(12)) ph_gemm_out(A, l, WS_G, WS_SGOUT + (size_t)j * DM * DM * 2, rout, lds, bid, nb); PH_END
        }
        PH_BEGIN if (SEL(13)) ph_norm<true>(A, l, rout, bid, nb); PH_END
        PH_BEGIN if (SEL(14)) ph_moe_scatter(A, l, rout, lds, bid, nb); PH_END
        PH_BEGIN if (SEL(15)) ph_moe_gemm1(A, l, lds, bid, nb); PH_END
        PH_BEGIN if (SEL(16)) ph_moe_gemm2(A, l, lds, bid, nb); PH_END
        PH_BEGIN if (SEL(17)) ph_moe_combine(A, l, rout, l == 3, bid, nb); PH_END
    }
}

extern "C" void kernel_launch(void* const* d_in, const int* in_sizes, int n_in, void* d_out, int out_size, void* d_ws, size_t ws_size, hipStream_t stream) {
    static int grid = 0;
    if (grid == 0) {
        if (n_in != 38 || out_size != NLAT * DM || ws_size < WS_END) { fprintf(stderr, "kernel_launch: unexpected shapes: n_in %d out %d ws %zu (need %zu)\n", n_in, out_size, ws_size, (size_t)WS_END); grid = -1; return; }
        int dev = 0, cus = 0, per_cu = 0;
        if (hipGetDevice(&dev) != hipSuccess || hipDeviceGetAttribute(&cus, hipDeviceAttributeMultiprocessorCount, dev) != hipSuccess) { grid = -1; return; }
        if (hipFuncSetAttribute((const void*)fwd_kernel, hipFuncAttributeMaxDynamicSharedMemorySize, LDS_BYTES) != hipSuccess) { fprintf(stderr, "kernel_launch: hipFuncSetAttribute failed\n"); grid = -1; return; }
        if (hipOccupancyMaxActiveBlocksPerMultiprocessor(&per_cu, (const void*)fwd_kernel, NTHREADS, LDS_BYTES) != hipSuccess || per_cu < 1)
            fprintf(stderr, "kernel_launch: occupancy query reports %d workgroups per CU\n", per_cu);
        (void)hipGetLastError();
        grid = cus;
    }
    if (grid < 0) return;
    if (hipMemsetAsync((char*)d_ws + WS_CTL, 0, CTL_ZERO_BYTES, stream) != hipSuccess) { fprintf(stderr, "kernel_launch: memset failed\n"); return; }
    Args a{};
    for (int i = 0; i < 38; ++i) a.in[i] = (const float*)d_in[i];
    a.out = (float*)d_out; a.ws = (unsigned char*)d_ws; a.ph_lo = 0; a.ph_hi = 1 << 20;
    hipLaunchKernelGGL(fwd_kernel, dim3(grid), dim3(NTHREADS), LDS_BYTES, stream, a);
    const hipError_t le = hipPeekAtLastError();
    if (le != hipSuccess) fprintf(stderr, "kernel_launch: launch failed: %s\n", hipGetErrorName(le));
}
```

```cpp
#include <hip/hip_runtime.h>
#include <cstdio>
#include <cstdint>

#define LAS __attribute__((address_space(3)))
typedef unsigned short bf16_t;
typedef short bf16x8 __attribute__((ext_vector_type(8)));
typedef float f32x4 __attribute__((ext_vector_type(4)));
typedef unsigned u32x4 __attribute__((ext_vector_type(4)));
typedef unsigned u32x2 __attribute__((ext_vector_type(2)));

constexpr int DM = 1024, NB = 16, TL = 2048, TC = 256;
constexpr int NCTX = NB * TC, NLAT = NB * TL, NTOK = NCTX + NLAT;
constexpr int RWC = 1920, EVC = 3456, ZLD = 3584;
constexpr int NE = 32;
constexpr int XPROWS = NTOK * 4 + NE * 256;
constexpr int NTHREADS = 512, NWAVES = 8;

constexpr size_t MiB = 1u << 20;
constexpr size_t al256(size_t x) { return (x + 255) & ~(size_t)255; }
constexpr size_t WS_CTL = 0, CTL_ZERO_BYTES = 1 * MiB - 4096;
constexpr size_t WS_PTRS = 1 * MiB - 4096;
constexpr size_t WS_MOD = 1 * MiB;
constexpr size_t WS_RTWT = al256(WS_MOD + (size_t)4 * 17 * 6144 * 4);
constexpr size_t WS_WIN = al256(WS_RTWT + (size_t)4 * 32 * 1024 * 4);
constexpr size_t WS_WOUT = al256(WS_WIN + (size_t)2 * ZLD * DM * 2);
constexpr size_t WS_SGIN = al256(WS_WOUT + (size_t)2 * DM * DM * 2);
constexpr size_t WS_SGOUT = al256(WS_SGIN + (size_t)2 * 2048 * DM * 2);
constexpr size_t WS_W1 = al256(WS_SGOUT + (size_t)2 * DM * DM * 2);
constexpr size_t WS_W2 = al256(WS_W1 + (size_t)4 * NE * 2048 * DM * 2);
constexpr size_t WS_H = al256(WS_W2 + (size_t)4 * NE * DM * DM * 2);
constexpr size_t WS_ABF = al256(WS_H + (size_t)NTOK * DM * 4);
constexpr size_t WS_TOKE = al256(WS_ABF + (size_t)NTOK * DM * 2);
constexpr size_t WS_TOKG = al256(WS_TOKE + (size_t)NTOK * 4 * 4);
constexpr size_t WS_ROWOF = al256(WS_TOKG + (size_t)NTOK * 4 * 4);
constexpr size_t WS_R = al256(WS_ROWOF + (size_t)NTOK * 4 * 4);
constexpr size_t FSZ = (size_t)NTOK * 512 * 4;
constexpr size_t WS_Z = WS_R;
constexpr size_t WS_F = al256(WS_Z + (size_t)NTOK * ZLD * 2);
constexpr size_t WS_YS = WS_F + 11 * FSZ;
constexpr size_t WS_QB = WS_YS + 2 * FSZ;
constexpr size_t WS_KB = WS_QB + FSZ / 2;
constexpr size_t WS_VB = WS_KB + FSZ / 2;
constexpr size_t WS_OP = WS_VB + FSZ / 2;
constexpr size_t WS_CAT = WS_OP + 2 * FSZ;
constexpr size_t WS_EVEN_END = WS_CAT + (size_t)NTOK * DM * 2;
constexpr size_t WS_Z2 = WS_R;
constexpr size_t WS_VN = al256(WS_Z2 + (size_t)NTOK * 2048 * 2);
constexpr size_t WS_G = al256(WS_VN + (size_t)NTOK * DM * 4);
constexpr size_t WS_ODD_END = WS_G + (size_t)NTOK * DM * 2;
constexpr size_t WS_XP = WS_R;
constexpr size_t WS_ACT = al256(WS_XP + (size_t)XPROWS * DM * 2);
constexpr size_t WS_YM = al256(WS_ACT + (size_t)XPROWS * DM * 2);
constexpr size_t WS_MOE_END = WS_YM + (size_t)XPROWS * DM * 2;
constexpr size_t WS_END = (WS_EVEN_END > WS_MOE_END ? (WS_EVEN_END > WS_ODD_END ? WS_EVEN_END : WS_ODD_END) : (WS_MOE_END > WS_ODD_END ? WS_MOE_END : WS_ODD_END));

constexpr int CW_BAR = 4096;
constexpr int CW_CNT = 16384;
constexpr int CW_CUR = 16384 + 256;

constexpr int LDS_BYTES = 147456;
constexpr int LDS_MISC = 144 * 1024 - 256;

__device__ __forceinline__ unsigned f2bf(float f) { unsigned u = __builtin_bit_cast(unsigned, f); return (u + 0x7fffu + ((u >> 16) & 1u)) >> 16; }
__device__ __forceinline__ unsigned pk2(float lo, float hi) { return f2bf(lo) | (f2bf(hi) << 16); }
__device__ __forceinline__ float bf2f(bf16_t b) { return __builtin_bit_cast(float, (unsigned)b << 16); }
__device__ __forceinline__ float wave_sum(float v) {
#pragma unroll
    for (int o = 1; o < 64; o <<= 1) v += __shfl_xor(v, o);
    return v;
}
__device__ __forceinline__ int tid_opaque() { int t = threadIdx.x; asm volatile("" : "+v"(t)); return t; }
#define GAS __attribute__((address_space(1)))
template <class T> __device__ __forceinline__ T* as_global(T* p) { return (T*)(GAS T*)p; }
__device__ __forceinline__ unsigned char* opq(unsigned char* p) { GAS unsigned char* g = (GAS unsigned char*)p; asm volatile("" : "+s"(g)); return (unsigned char*)g; }
__device__ __forceinline__ float rdl(float v, int k) { return __builtin_bit_cast(float, __builtin_amdgcn_readlane(__builtin_bit_cast(int, v), k)); }
__device__ __forceinline__ float sigmoidf_(float x) { return 1.0f / (1.0f + __expf(-x)); }

#define XB_TMO      128
#define XB_XCNT(j)  (256  + 64 * (j))
#define XB_XSUB(j)  (1280 + 64 * (j))
#define XB_XGEN(j)  (2304 + 64 * (j))
#define XB_TOP      3328
#define XB_TOPGEN   3392
#define XCD_BAR_WORDS 3456
#define XB_SPIN_CAP (1u << 22)
__device__ __forceinline__ unsigned xb_ld(unsigned* p)              { return __hip_atomic_load(p, __ATOMIC_RELAXED, __HIP_MEMORY_SCOPE_AGENT); }
__device__ __forceinline__ unsigned xb_add(unsigned* p, unsigned v) { return __hip_atomic_fetch_add(p, v, __ATOMIC_RELAXED, __HIP_MEMORY_SCOPE_AGENT); }
__device__ __forceinline__ unsigned xb_xcc_id() { return (unsigned)__builtin_amdgcn_s_getreg((3 << 11) | 20) & 0xFu; }
#define XB_SPIN(cond, bar) do { unsigned _sp = 0; while (cond) { __builtin_amdgcn_s_sleep(1); \
    if ((++_sp & 255u) == 0u) { if (xb_ld(&(bar)[XB_TMO])) break; if (_sp > XB_SPIN_CAP) { atomicAdd(&(bar)[XB_TMO], 1u); break; } } } } while (0)
struct XcdBarrier { unsigned* bar; unsigned x; volatile LAS unsigned* st; };
__device__ __forceinline__ XcdBarrier xcd_barrier_post(unsigned* bar, volatile LAS unsigned* st) {
    XcdBarrier b; b.bar = bar; b.x = xb_xcc_id(); b.st = st;
    if (threadIdx.x == 0) (void)xb_add(&bar[XB_XCNT(b.x)], 1u);
    return b;
}
__device__ __forceinline__ void xcd_barrier_complete(unsigned* bar, unsigned x, unsigned& nloc, unsigned& nx) {
    const unsigned G = gridDim.x * gridDim.y * gridDim.z;
    unsigned sum, cnt, mine, sp = 0u;
    for (;;) {
        sum = 0u; cnt = 0u; mine = 0u;
#pragma unroll
        for (unsigned j = 0; j < 16; ++j) { const unsigned c = xb_ld(&bar[XB_XCNT(j)]); sum += c; cnt += (c > 0u) ? 1u : 0u; mine = (j == x) ? c : mine; }
        if (sum == G) break;
        __builtin_amdgcn_s_sleep(1);
        if ((++sp & 255u) == 0u) { if (xb_ld(&bar[XB_TMO])) break; if (sp > XB_SPIN_CAP) { atomicAdd(&bar[XB_TMO], 1u); break; } }
    }
    nloc = mine > 0u ? mine : 1u; nx = cnt > 0u ? cnt : 1u;
}
__device__ __forceinline__ void xcd_barrier(const XcdBarrier& b) {
    asm volatile("s_waitcnt vmcnt(0)" ::: "memory");
    __syncthreads();
    if (threadIdx.x == 0) {
        unsigned* bar = b.bar;
        __builtin_amdgcn_s_waitcnt(0);
        unsigned nloc = b.st[0], nx = b.st[1];
        if (nloc == 0u) { xcd_barrier_complete(bar, b.x, nloc, nx); b.st[0] = nloc; b.st[1] = nx; }
        const unsigned old = xb_add(&bar[XB_XSUB(b.x)], 1u);
        const unsigned gen = old / nloc;
        if (old + 1u == (gen + 1u) * nloc) {
            __builtin_amdgcn_fence(__ATOMIC_RELEASE, "agent");
            asm volatile("s_waitcnt vmcnt(0)" ::: "memory");
            const unsigned og = xb_add(&bar[XB_TOP], 1u);
            const unsigned tg = og / nx;
            if (og + 1u == (tg + 1u) * nx) xb_add(&bar[XB_TOPGEN], 1u);
            else XB_SPIN(xb_ld(&bar[XB_TOPGEN]) == tg, bar);
            __builtin_amdgcn_fence(__ATOMIC_ACQUIRE, "agent");
            xb_add(&bar[XB_XGEN(b.x)], 1u);
            asm volatile("s_waitcnt vmcnt(0)" ::: "memory");
        } else {
            XB_SPIN(xb_ld(&bar[XB_XGEN(b.x)]) == gen, bar);
            __builtin_amdgcn_fence(__ATOMIC_ACQUIRE, "agent");
            asm volatile("s_waitcnt vmcnt(0)" ::: "memory");
        }
    }
    __syncthreads();
}

namespace pg8 {
#define PG8_LAS __attribute__((address_space(3)))
typedef unsigned short bf16_t;
typedef short bf16x8 __attribute__((ext_vector_type(8)));
typedef float f32x4 __attribute__((ext_vector_type(4)));
typedef unsigned u32x4 __attribute__((ext_vector_type(4)));
constexpr int BM = 256, BK = 64, HALF = 128, HTB = HALF * BK * 2  , STAGE_BYTES = 8 * HTB, NXCD = 8, WGM = 8;

__host__ __device__ __forceinline__ int lds_byte(int r, int c) { const int st = (r >> 4) * 2 + (c >> 5), rr = r & 15, cc = c & 31, ob = rr * 64 + cc * 2; return st * 1024 + (ob ^ (((ob >> 9) & 1) << 5)); }
__host__ __device__ __forceinline__ void stage_rc(int b, int& R, int& C) { const int st = b / 1024, sb = b % 1024, swz = sb ^ (((sb >> 9) & 1) << 5); R = (st >> 1) * 16 + swz / 64; C = (st & 1) * 32 + (swz % 64) / 2; }
__host__ __device__ __forceinline__ int perm32(int rho) { const int n = rho >> 4, i = rho & 15; return 8 * (i >> 2) + 4 * n + (i & 3); }

struct Unit { int pm, pn; };
struct Gemm { const bf16_t* A; const bf16_t* Bt; int M, N, K; };

struct StaticOrder {
    int nM, nN, nwg, G, c;
    __host__ __device__ void init(int M, int N, int G_, int c_) { nM = M / BM; nN = N / BM; nwg = nM * nN; G = G_; c = c_; }
    __host__ __device__ bool next(int i, Unit& u) const {
        const long L = (long)i * G + c; if (L >= nwg) return false;
        int wgid = (int)L; { const int q = nwg / NXCD, r = nwg % NXCD, xcd = wgid % NXCD, off = wgid / NXCD; wgid = (xcd < r ? xcd * (q + 1) : r * (q + 1) + (xcd - r) * q) + off; }
        const int nig = WGM * nN, gid = wgid / nig, fm = gid * WGM, gsz = (nM - fm) < WGM ? (nM - fm) : WGM;
        u.pm = fm + ((wgid % nig) % gsz); u.pn = (wgid % nig) / gsz; return true;
    }
    __device__ __forceinline__ void a_ready(const Unit&) const {}
    __device__ __forceinline__ void done(const Unit&) const {}
};

__device__ __forceinline__ unsigned cvt_pk_bf16(float lo, float hi) { unsigned r; asm volatile("v_cvt_pk_bf16_f32 %0, %1, %2" : "=v"(r) : "v"(lo), "v"(hi)); return r; }
typedef float f32x2 __attribute__((ext_vector_type(2)));
__device__ __forceinline__ f32x2 gelu_pk(f32x2 v) {
    const f32x2 av = __builtin_elementwise_abs(v), d = av * 0.2316418882f + 1.0f;
    f32x2 t; t.x = __builtin_amdgcn_rcpf(d.x); t.y = __builtin_amdgcn_rcpf(d.y);
    f32x2 q = t * 0.5307027145f + (-0.7265760135f); q = q * t + 0.7107068705f; q = q * t + (-0.142248368f); q = q * t + 0.127414796f; q = q * t;
    const f32x2 s = (v * v) * (-0.72134752044f);
    f32x2 e; e.x = __builtin_amdgcn_exp2f(s.x); e.y = __builtin_amdgcn_exp2f(s.y);
    const f32x2 m = v * (q * e), r = v - m;
    f32x2 o; o.x = v.x < 0.f ? m.x : r.x; o.y = v.y < 0.f ? m.y : r.y; return o;
}

template <class Epi, class Sched, bool ALIGN_EPI = false, bool SP2 = false>
__device__ __forceinline__ void gemm_phase(PG8_LAS unsigned char* lds, const Gemm g, const Sched& S, const Epi& E) {
    const int tid = tid_opaque(), wid = __builtin_amdgcn_readfirstlane(tid >> 6), lane = tid & 63, wr = wid >> 2, wc = wid & 3, fr = lane & 15, fq = lane >> 4;
    const int K = g.K, nt = K / BK;
    unsigned voffA[2], voffB[2];
#pragma unroll
    for (int i = 0; i < 2; ++i) { int R, C; stage_rc(tid * 16 + i * 8192, R, C); const int Rb = Epi::PERM ? ((R & ~31) + perm32(R & 31)) : R;
        voffA[i] = (unsigned)(R * K + C) * 2u; voffB[i] = (unsigned)(Rb * K + C) * 2u; }
    const size_t kstep = (size_t)(BK * 2);
    const size_t hstep = (size_t)HALF * K * 2;
    const size_t tstep = 2 * hstep;
    const unsigned ldsw = (unsigned)wid * 1024u;
    const int aoff = lds_byte(wr * 64 + fr, fq * 8), boff = lds_byte(wc * 32 + fr, fq * 8);
#define PG8_SA(b, h) (((b) * 2 + (h)) * HTB)
#define PG8_SB(b, h) ((4 + (b) * 2 + (h)) * HTB)
#define PG8_STAGE(bufoff, gbase, voff) do { _Pragma("unroll") for (int _i = 0; _i < 2; ++_i) \
        __builtin_amdgcn_global_load_lds((const unsigned*)((const char*)(gbase) + (voff)[_i]), (PG8_LAS unsigned*)(lds + (bufoff) + ldsw + _i * 8192), 16, 0, 0); } while (0)
#define PG8_LDA(dst, b, h) do { _Pragma("unroll") for (int m = 0; m < 4; ++m) _Pragma("unroll") for (int k = 0; k < 2; ++k) dst[m][k] = *(const PG8_LAS bf16x8*)(lds + PG8_SA(b, h) + aoff + m * 2048 + k * 1024); } while (0)
#define PG8_LDB(dst, b, h) do { _Pragma("unroll") for (int n = 0; n < 2; ++n) _Pragma("unroll") for (int k = 0; k < 2; ++k) dst[n][k] = *(const PG8_LAS bf16x8*)(lds + PG8_SB(b, h) + boff + n * 2048 + k * 1024); } while (0)
#define PG8_MMA(ai, bj, At, Bt) do { __builtin_amdgcn_s_setprio(1); _Pragma("unroll") for (int m = 0; m < 4; ++m) _Pragma("unroll") for (int n = 0; n < 2; ++n) _Pragma("unroll") for (int k = 0; k < 2; ++k) \
        acc[ai][bj][m][n] = __builtin_amdgcn_mfma_f32_16x16x32_bf16(Bt[n][k], At[m][k], acc[ai][bj][m][n], 0, 0, 0); __builtin_amdgcn_s_setprio(0); } while (0)
#define PG8_WAIT_V(n) asm volatile("s_waitcnt vmcnt(" #n ")" ::: "memory")
#define PG8_WAIT_L(n) asm volatile("s_waitcnt lgkmcnt(" #n ")" ::: "memory")
#define PG8_BAR __builtin_amdgcn_s_barrier()
#define PG8_SCHED __builtin_amdgcn_sched_barrier(0)
    Unit cur, nxt; int ui = 0;
    if (!S.next(0, cur)) return;
    f32x4 acc[2][2][4][2];
#pragma unroll
    for (int a = 0; a < 2; ++a)
#pragma unroll
        for (int b = 0; b < 2; ++b)
#pragma unroll
            for (int m = 0; m < 4; ++m)
#pragma unroll
                for (int n = 0; n < 2; ++n) acc[a][b][m][n] = (f32x4){0.f, 0.f, 0.f, 0.f};
    bf16x8 At[4][2], B0[2][2], B1[2][2];
    const char* cA = (const char*)g.A + (size_t)cur.pm * tstep; const char* cB = (const char*)g.Bt + (size_t)cur.pn * tstep;
    S.a_ready(cur);
    if constexpr (SP2) {
        PG8_STAGE(PG8_SB(0, 0), cB, voffB); PG8_STAGE(PG8_SB(0, 1), cB + hstep, voffB); PG8_STAGE(PG8_SA(0, 0), cA, voffA); PG8_STAGE(PG8_SA(0, 1), cA + hstep, voffA);
        if (wr == 1) PG8_BAR;
        PG8_WAIT_V(2); PG8_BAR;
        PG8_STAGE(PG8_SB(1, 0), cB + kstep, voffB); PG8_STAGE(PG8_SA(1, 0), cA + kstep, voffA); PG8_STAGE(PG8_SB(1, 1), cB + hstep + kstep, voffB);
        PG8_WAIT_V(6); PG8_BAR;
    } else {
        PG8_STAGE(PG8_SB(0, 0), cB, voffB); PG8_STAGE(PG8_SA(0, 0), cA, voffA); PG8_STAGE(PG8_SB(0, 1), cB + hstep, voffB); PG8_STAGE(PG8_SA(0, 1), cA + hstep, voffA);
        if (wr == 1) PG8_BAR;
        PG8_WAIT_V(4); PG8_BAR;
        PG8_STAGE(PG8_SB(1, 0), cB + kstep, voffB); PG8_STAGE(PG8_SA(1, 0), cA + kstep, voffA); PG8_STAGE(PG8_SB(1, 1), cB + hstep + kstep, voffB);
        PG8_WAIT_V(6); PG8_BAR;
    }
    for (;;) {
        const bool has_next = S.next(ui + 1, nxt);
        const char* nA = has_next ? (const char*)g.A + (size_t)nxt.pm * tstep : cA; const char* nB = has_next ? (const char*)g.Bt + (size_t)nxt.pn * tstep : cB;
        for (int t = 0; t < nt; t += 2) {
            const bool last = (t == nt - 2);
            const char* a1 = cA + (size_t)(t + 1) * kstep;
            const char* a2 = last ? nA : cA + (size_t)(t + 2) * kstep; const char* b2 = last ? nB : cB + (size_t)(t + 2) * kstep;
            const char* a3 = a2 + kstep; const char* b3 = b2 + kstep;
            if (last && has_next) S.a_ready(nxt);
            if constexpr (SP2) {
            PG8_LDB(B0, 0, 0); PG8_LDB(B1, 0, 1); PG8_SCHED; PG8_LDA(At, 0, 0); PG8_STAGE(PG8_SA(1, 1), a1 + hstep, voffA);
            PG8_WAIT_V(8); PG8_WAIT_L(0); PG8_BAR; PG8_MMA(0, 0, At, B0); PG8_MMA(0, 1, At, B1); PG8_BAR; PG8_SCHED;
            PG8_LDA(At, 0, 1); PG8_STAGE(PG8_SB(0, 0), b2, voffB); PG8_STAGE(PG8_SB(0, 1), b2 + hstep, voffB); PG8_STAGE(PG8_SA(0, 0), a2, voffA);
            PG8_WAIT_V(8); PG8_WAIT_L(0); PG8_BAR; PG8_MMA(1, 0, At, B0); PG8_MMA(1, 1, At, B1); PG8_BAR; PG8_SCHED;
            PG8_LDB(B0, 1, 0); PG8_LDB(B1, 1, 1); PG8_SCHED; PG8_LDA(At, 1, 0); PG8_STAGE(PG8_SA(0, 1), a2 + hstep, voffA);
            PG8_WAIT_V(8); PG8_WAIT_L(0); PG8_BAR; PG8_MMA(0, 0, At, B0); PG8_MMA(0, 1, At, B1); PG8_BAR; PG8_SCHED;
            PG8_LDA(At, 1, 1); PG8_STAGE(PG8_SB(1, 0), b3, voffB); PG8_STAGE(PG8_SB(1, 1), b3 + hstep, voffB); PG8_STAGE(PG8_SA(1, 0), a3, voffA);
            PG8_WAIT_V(8); PG8_WAIT_L(0); PG8_BAR; PG8_MMA(1, 0, At, B0); PG8_MMA(1, 1, At, B1); PG8_BAR; PG8_SCHED;
            } else {
            PG8_LDB(B0, 0, 0); PG8_SCHED; PG8_LDA(At, 0, 0); PG8_STAGE(PG8_SA(1, 1), a1 + hstep, voffA);
            PG8_WAIT_L(8); PG8_BAR; PG8_WAIT_L(0); PG8_MMA(0, 0, At, B0); PG8_BAR; PG8_SCHED;
            PG8_LDB(B1, 0, 1); PG8_STAGE(PG8_SB(0, 0), b2, voffB);
            PG8_BAR; PG8_WAIT_L(0); PG8_MMA(0, 1, At, B1); PG8_BAR;
            PG8_LDA(At, 0, 1); PG8_STAGE(PG8_SA(0, 0), a2, voffA);
            PG8_BAR; PG8_WAIT_L(0); PG8_MMA(1, 0, At, B0); PG8_BAR; PG8_SCHED;
            PG8_STAGE(PG8_SB(0, 1), b2 + hstep, voffB);
            PG8_WAIT_V(6); PG8_BAR; PG8_MMA(1, 1, At, B1); PG8_BAR;
            PG8_LDB(B0, 1, 0); PG8_SCHED; PG8_LDA(At, 1, 0); PG8_STAGE(PG8_SA(0, 1), a2 + hstep, voffA);
            PG8_WAIT_L(8); PG8_BAR; PG8_WAIT_L(0); PG8_MMA(0, 0, At, B0); PG8_BAR; PG8_SCHED;
            PG8_LDB(B1, 1, 1); PG8_STAGE(PG8_SB(1, 0), b3, voffB);
            PG8_BAR; PG8_WAIT_L(0); PG8_MMA(0, 1, At, B1); PG8_BAR;
            PG8_LDA(At, 1, 1); PG8_STAGE(PG8_SA(1, 0), a3, voffA);
            PG8_BAR; PG8_WAIT_L(0); PG8_MMA(1, 0, At, B0); PG8_BAR; PG8_SCHED;
            PG8_STAGE(PG8_SB(1, 1), b3 + hstep, voffB);
            PG8_WAIT_V(6); PG8_BAR; PG8_MMA(1, 1, At, B1); PG8_BAR;
            }
        }
        if constexpr (ALIGN_EPI) { if (wr == 0) PG8_BAR; }
        if constexpr (!Epi::AFTER_DRAIN) { E(acc, cur, wr, wc, fr, fq); S.done(cur); }
        if (!has_next) break;
#pragma unroll
        for (int a = 0; a < 2; ++a)
#pragma unroll
            for (int b = 0; b < 2; ++b)
#pragma unroll
                for (int m = 0; m < 4; ++m)
#pragma unroll
                    for (int n = 0; n < 2; ++n) acc[a][b][m][n] = (f32x4){0.f, 0.f, 0.f, 0.f};
        cur = nxt; cA = nA; cB = nB; ++ui;
        if constexpr (ALIGN_EPI) { if (wr == 1) PG8_BAR; }
    }
    PG8_WAIT_V(0);
    if constexpr (!ALIGN_EPI) { if (wr == 0) PG8_BAR; }
    PG8_BAR;
    if constexpr (Epi::AFTER_DRAIN) { E.fused(acc, cur, wr, wc, fr, fq, lds, wid, lane); S.done(cur); }
#undef PG8_SA
#undef PG8_SB
#undef PG8_STAGE
#undef PG8_LDA
#undef PG8_LDB
#undef PG8_MMA
#undef PG8_WAIT_V
#undef PG8_WAIT_L
#undef PG8_BAR
#undef PG8_SCHED
}
}

struct Args { const float* in[38]; float* out; unsigned char* ws; int ph_lo, ph_hi; };
#define INP(k) as_global(IN[k])
#define AIN(k) as_global(A.in[k])
enum { I_X = 0, I_C, I_CTX, I_CCTX, I_N1G, I_N2G, I_ADAW, I_ADAB, I_EVWIN, I_EVWOUT, I_RWMU, I_RWW0, I_RWW2, I_RWA0, I_RWA2, I_RWG2, I_RWKK, I_RWKA, I_RWRK,
       I_GNW, I_GNB, I_QN, I_KN, I_LAM, I_SUBLN, I_SGWIN, I_SGBIN, I_SGLNG, I_SGLNB, I_SGWS, I_SGBS, I_SGWOUT, I_RTW, I_RTB, I_W1, I_B1, I_W2, I_B2 };

struct Tok { int b, t, T, modrow; };
__device__ __forceinline__ Tok tokinfo(int g) {
    Tok k;
    if (g < NCTX) { k.b = g >> 8; k.t = g & 255; k.T = TC; k.modrow = 16; }
    else { const int q = g - NCTX; k.b = q >> 11; k.t = q & 2047; k.T = TL; k.modrow = k.b; }
    return k;
}

template <int MAP>
__device__ __forceinline__ void p0_transpose_item(const float* W, int K, int N, bf16_t* WT, LAS float* scr, int item, int lane) {
    const int nblk = N / 32, kb = item / nblk, nb = item % nblk, k0 = 64 * kb, n0 = 32 * nb;
    const int d0 = MAP ? (256 * ((n0 & 1023) >> 7) + 128 * (n0 >> 10) + (n0 & 127)) : n0;
#pragma unroll 8
    for (int i = 0; i < 32; ++i) { const int kk = 2 * i + (lane >> 5); scr[kk * 33 + (lane & 31)] = W[(size_t)(k0 + kk) * N + n0 + (lane & 31)]; }
    asm volatile("s_waitcnt lgkmcnt(0)" ::: "memory");
    const int c = lane & 7;
#pragma unroll
    for (int j = 0; j < 4; ++j) { const int n = (lane >> 3) + 8 * j; const LAS float* s = scr + (8 * c) * 33 + n;
        u32x4 o; o.x = pk2(s[0 * 33], s[1 * 33]); o.y = pk2(s[2 * 33], s[3 * 33]); o.z = pk2(s[4 * 33], s[5 * 33]); o.w = pk2(s[6 * 33], s[7 * 33]);
        *(u32x4*)(WT + (size_t)(d0 + n) * K + k0 + 8 * c) = o; }
    asm volatile("s_waitcnt lgkmcnt(0)" ::: "memory");
}

__device__ __forceinline__ void ph_prologue(const Args& A, LAS unsigned char* lds, int bid, int nb) {
    const int tid = tid_opaque(), lane = tid & 63, wid = tid >> 6;
    unsigned char* ws = opq(A.ws);
    if (bid == 0 && tid < 39) ((const float**)(ws + WS_PTRS))[tid] = (tid < 38) ? A.in[tid] : (const float*)A.out;
    {
        LAS float* s = (LAS float*)lds;
        LAS float* red = (LAS float*)(lds + 17 * 1024 * 4);
        for (int i = tid; i < 17 * 1024; i += NTHREADS) {
            const int r = i >> 10, k = i & 1023;
            const float x = (r < 16) ? AIN(I_C)[r * 1024 + k] : AIN(I_CCTX)[k];
            s[i] = x / (1.0f + __expf(-x));
        }
        __syncthreads();
        float* mod = (float*)(ws + WS_MOD);
        for (int u = bid; u < 4 * 96; u += nb) {
            const int l = u / 96, cg = u % 96, col = cg * 64 + lane;
            float acc[17];
#pragma unroll
            for (int r = 0; r < 17; ++r) acc[r] = 0.f;
            const float* wp = AIN(I_ADAW) + (size_t)l * 1024 * 6144 + col;
            for (int k = wid * 128; k < wid * 128 + 128; ++k) {
                const float wv = wp[(size_t)k * 6144];
#pragma unroll
                for (int r = 0; r < 17; ++r) acc[r] += s[r * 1024 + k] * wv;
            }
#pragma unroll
            for (int r = 0; r < 17; ++r) red[(wid * 17 + r) * 64 + lane] = acc[r];
            __syncthreads();
            for (int i = tid; i < 17 * 64; i += NTHREADS) {
                const int r = i >> 6, ln = i & 63; float v = 0.f;
#pragma unroll
                for (int w = 0; w < 8; ++w) v += red[(w * 17 + r) * 64 + ln];
                const int cc = cg * 64 + ln;
                mod[((size_t)l * 17 + r) * 6144 + cc] = v + AIN(I_ADAB)[l * 6144 + cc];
            }
            __syncthreads();
        }
    }
    __syncthreads();
    {
        LAS float* scr = (LAS float*)(lds + wid * 16384);
        const int gw = bid * NWAVES + wid, NGW = nb * NWAVES;
        constexpr int IT_WIN = 16 * (EVC / 32), IT_SQ = 16 * 32, IT_SGIN = 16 * 64, IT_W1 = 16 * 64, IT_W2 = 16 * 32;
        constexpr int N0 = 2 * IT_WIN, N1 = N0 + 2 * IT_SQ, N2 = N1 + 2 * IT_SGIN, N3 = N2 + 2 * IT_SQ, N4 = N3 + 128 * IT_W1, N5 = N4 + 128 * IT_W2;
        for (int it = gw; it < N5; it += NGW) {
            if (it < N0) { const int m = it / IT_WIN, r = it % IT_WIN; p0_transpose_item<0>(AIN(I_EVWIN) + (size_t)m * DM * EVC, DM, EVC, (bf16_t*)(ws + WS_WIN) + (size_t)m * ZLD * DM, scr, r, lane); }
            else if (it < N1) { const int q = it - N0, m = q / IT_SQ, r = q % IT_SQ; p0_transpose_item<0>(AIN(I_EVWOUT) + (size_t)m * DM * DM, DM, DM, (bf16_t*)(ws + WS_WOUT) + (size_t)m * DM * DM, scr, r, lane); }
            else if (it < N2) { const int q = it - N1, m = q / IT_SGIN, r = q % IT_SGIN; p0_transpose_item<0>(AIN(I_SGWIN) + (size_t)m * DM * 2048, DM, 2048, (bf16_t*)(ws + WS_SGIN) + (size_t)m * 2048 * DM, scr, r, lane); }
            else if (it < N3) { const int q = it - N2, m = q / IT_SQ, r = q % IT_SQ; p0_transpose_item<0>(AIN(I_SGWOUT) + (size_t)m * DM * DM, DM, DM, (bf16_t*)(ws + WS_SGOUT) + (size_t)m * DM * DM, scr, r, lane); }
            else if (it < N4) { const int q = it - N3, m = q / IT_W1, r = q % IT_W1; p0_transpose_item<1>(AIN(I_W1) + (size_t)m * DM * 2048, DM, 2048, (bf16_t*)(ws + WS_W1) + (size_t)m * 2048 * DM, scr, r, lane); }
            else { const int q = it - N4, m = q / IT_W2, r = q % IT_W2; p0_transpose_item<0>(AIN(I_W2) + (size_t)m * DM * DM, DM, DM, (bf16_t*)(ws + WS_W2) + (size_t)m * DM * DM, scr, r, lane); }
        }
    }
    {
        const size_t gt = (size_t)bid * NTHREADS + tid, GT = (size_t)nb * NTHREADS;
        f32x4* H4 = (f32x4*)(ws + WS_H);
        const f32x4* c4 = (const f32x4*)AIN(I_CTX); const f32x4* x4 = (const f32x4*)AIN(I_X);
        constexpr size_t NC4 = (size_t)NCTX * DM / 4, NT4 = (size_t)NTOK * DM / 4;
        for (size_t i = gt; i < NT4; i += GT) H4[i] = (i < NC4) ? c4[i] : x4[i - NC4];
        for (size_t i = gt; i < (size_t)2 * 128 * DM / 8; i += GT) { const size_t m = i / (128 * DM / 8), r = i % (128 * DM / 8); ((u32x4*)((bf16_t*)(ws + WS_WIN) + (m * ZLD + EVC) * DM))[r] = (u32x4){0u, 0u, 0u, 0u}; }
        float* rt = (float*)(ws + WS_RTWT);
        for (size_t i = gt; i < (size_t)4 * 32 * 1024; i += GT) { const int l = (int)(i >> 15), e = (int)(i >> 10) & 31, k = (int)i & 1023; rt[i] = AIN(I_RTW)[((size_t)l * 1024 + k) * 32 + e]; }
    }
}

template <bool ROUTER>
__device__ __forceinline__ void ph_norm(const Args& A, int l, int row_lo, int bid, int nb) {
    const int tid = tid_opaque(), lane = tid & 63, wid = tid >> 6;
    unsigned char* ws = opq(A.ws); const float* const* IN = (const float* const*)(ws + WS_PTRS); (void)IN;
    const float* H = (const float*)(ws + WS_H);
    const float* mod = (const float*)(ws + WS_MOD);
    bf16_t* abf = (bf16_t*)(ws + WS_ABF);
    const float* gp = IN[ROUTER ? I_N2G : I_N1G] + l * 1024;
    const int c_shift = ROUTER ? 3 : 0, c_scale = ROUTER ? 4 : 1;
    for (int row = row_lo + bid * NWAVES + wid; row < NTOK; row += nb * NWAVES) {
        const Tok tk = tokinfo(row);
        const float* mrow = mod + ((size_t)l * 17 + tk.modrow) * 6144;
        f32x4 v[4]; float ss = 0.f;
#pragma unroll
        for (int j = 0; j < 4; ++j) { v[j] = *(const f32x4*)(H + (size_t)row * DM + j * 256 + lane * 4); ss += (v[j].x * v[j].x + v[j].y * v[j].y) + (v[j].z * v[j].z + v[j].w * v[j].w); }
        const float rstd = rsqrtf(wave_sum(ss) * (1.0f / DM) + 1e-6f);
#pragma unroll
        for (int j = 0; j < 4; ++j) {
            const int col = j * 256 + lane * 4;
            const f32x4 g = *(const f32x4*)(gp + col), sc = *(const f32x4*)(mrow + c_scale * 1024 + col), sh = *(const f32x4*)(mrow + c_shift * 1024 + col);
            v[j] = (v[j] * rstd * g) * (sc + 1.0f) + sh;
            u32x2 o; o.x = pk2(v[j].x, v[j].y); o.y = pk2(v[j].z, v[j].w);
            *(u32x2*)(abf + (size_t)row * DM + col) = o;
        }
        if constexpr (ROUTER) {
            const float* rt = (const float*)(ws + WS_RTWT) + (size_t)l * 32 * 1024;
            float tv[4] = {-3.0e38f, -3.0e38f, -3.0e38f, -3.0e38f}; int ti[4] = {0, 0, 0, 0};
#pragma unroll 2
            for (int e = 0; e < 32; ++e) {
                float p = 0.f;
#pragma unroll
                for (int j = 0; j < 4; ++j) { const f32x4 w = *(const f32x4*)(rt + e * 1024 + j * 256 + lane * 4); p += (v[j].x * w.x + v[j].y * w.y) + (v[j].z * w.z + v[j].w * w.w); }
                const float lgv = wave_sum(p) + INP(I_RTB)[l * 32 + e];
                if (lgv > tv[3]) {
                    tv[3] = lgv; ti[3] = e;
                    if (tv[3] > tv[2]) { const float a = tv[2]; tv[2] = tv[3]; tv[3] = a; const int b = ti[2]; ti[2] = ti[3]; ti[3] = b; }
                    if (tv[2] > tv[1]) { const float a = tv[1]; tv[1] = tv[2]; tv[2] = a; const int b = ti[1]; ti[1] = ti[2]; ti[2] = b; }
                    if (tv[1] > tv[0]) { const float a = tv[0]; tv[0] = tv[1]; tv[1] = a; const int b = ti[0]; ti[0] = ti[1]; ti[1] = b; }
                }
            }
            const float e1 = __expf(tv[1] - tv[0]), e2 = __expf(tv[2] - tv[0]), e3 = __expf(tv[3] - tv[0]);
            const float inv = 1.0f / (1.0f + e1 + e2 + e3);
            if (lane == 0) {
                int* te = (int*)(ws + WS_TOKE) + (size_t)row * 4; float* tg = (float*)(ws + WS_TOKG) + (size_t)row * 4;
                te[0] = ti[0]; te[1] = ti[1]; te[2] = ti[2]; te[3] = ti[3];
                tg[0] = inv; tg[1] = e1 * inv; tg[2] = e2 * inv; tg[3] = e3 * inv;
                unsigned* cnt = (unsigned*)(ws + WS_CTL) + CW_CNT + l * 32;
#pragma unroll
                for (int k = 0; k < 4; ++k) atomicAdd(cnt + ti[k], 1u);
            }
        }
    }
}

__device__ __forceinline__ void gemm_tile128(const bf16_t* At, int lda, const bf16_t* Bt, int ldb, int K, f32x4 (&acc)[4][2]) {
    const int tid = tid_opaque(), wid = tid >> 6, lane = tid & 63, wr = wid >> 2, wc = wid & 3, fr = lane & 15, fq = lane >> 4;
    const bf16_t* a0 = At + (size_t)(wr * 64 + fr) * lda + fq * 8;
    const bf16_t* b0 = Bt + (size_t)(wc * 32 + fr) * ldb + fq * 8;
#pragma unroll
    for (int i = 0; i < 4; ++i)
#pragma unroll
        for (int j = 0; j < 2; ++j) acc[i][j] = (f32x4){0.f, 0.f, 0.f, 0.f};
#pragma unroll 2
    for (int k = 0; k < K; k += 32) {
        bf16x8 af[4], bfr[2];
#pragma unroll
        for (int i = 0; i < 4; ++i) af[i] = *(const bf16x8*)(a0 + (size_t)i * 16 * lda + k);
#pragma unroll
        for (int j = 0; j < 2; ++j) bfr[j] = *(const bf16x8*)(b0 + (size_t)j * 16 * ldb + k);
#pragma unroll
        for (int i = 0; i < 4; ++i)
#pragma unroll
            for (int j = 0; j < 2; ++j) acc[i][j] = __builtin_amdgcn_mfma_f32_16x16x32_bf16(bfr[j], af[i], acc[i][j], 0, 0, 0);
    }
}
#define TILE_COORDS const int _tid = tid_opaque(), _wid = _tid >> 6, _lane = _tid & 63, _wr = _wid >> 2, _wc = _wid & 3, _fr = _lane & 15, _fq = _lane >> 4
#define TILE_ROW(i) (_wr * 64 + (i) * 16 + _fr)
#define TILE_COL(j) (_wc * 32 + (j) * 16 + _fq * 4)

typedef pg8::f32x4 (&AccRef)[2][2][4][2];
struct EpiStoreBf16 {
    static constexpr bool PERM = true, AFTER_DRAIN = false;
    bf16_t* O; int ldc;
    __device__ __forceinline__ void operator()(const pg8::f32x4 (&acc)[2][2][4][2], const pg8::Unit& u, int wr, int wc, int fr, int fq) const {
        const int row0 = u.pm * 256 + wr * 64 + fr, col0 = u.pn * 256 + wc * 32 + 8 * fq;
#pragma unroll
        for (int ai = 0; ai < 2; ++ai)
#pragma unroll
            for (int m = 0; m < 4; ++m) { bf16_t* rowp = O + (size_t)(row0 + ai * 128 + m * 16) * ldc + col0;
#pragma unroll
                for (int bj = 0; bj < 2; ++bj) { const pg8::f32x4 v0 = acc[ai][bj][m][0], v1 = acc[ai][bj][m][1];
                    u32x4 w; w.x = pg8::cvt_pk_bf16(v0[0], v0[1]); w.y = pg8::cvt_pk_bf16(v0[2], v0[3]); w.z = pg8::cvt_pk_bf16(v1[0], v1[1]); w.w = pg8::cvt_pk_bf16(v1[2], v1[3]);
                    *(u32x4*)(rowp + bj * 128) = w; } }
    }
};
struct EpiGeluBf16 {
    static constexpr bool PERM = true, AFTER_DRAIN = false;
    bf16_t* O; int ldc; const float* bias;
    __device__ __forceinline__ void operator()(const pg8::f32x4 (&acc)[2][2][4][2], const pg8::Unit& u, int wr, int wc, int fr, int fq) const {
        const int row0 = u.pm * 256 + wr * 64 + fr, col0 = u.pn * 256 + wc * 32 + 8 * fq;
        pg8::f32x4 bv[2][2];
#pragma unroll
        for (int bj = 0; bj < 2; ++bj)
#pragma unroll
            for (int n = 0; n < 2; ++n) bv[bj][n] = *(const pg8::f32x4*)(bias + col0 + bj * 128 + 4 * n);
#pragma unroll
        for (int ai = 0; ai < 2; ++ai)
#pragma unroll
            for (int m = 0; m < 4; ++m) { bf16_t* rowp = O + (size_t)(row0 + ai * 128 + m * 16) * ldc + col0;
#pragma unroll
                for (int bj = 0; bj < 2; ++bj) { pg8::f32x4 v0 = acc[ai][bj][m][0] + bv[bj][0], v1 = acc[ai][bj][m][1] + bv[bj][1];
                    const pg8::f32x2 a = pg8::gelu_pk((pg8::f32x2){v0[0], v0[1]}), b = pg8::gelu_pk((pg8::f32x2){v0[2], v0[3]}), c = pg8::gelu_pk((pg8::f32x2){v1[0], v1[1]}), d = pg8::gelu_pk((pg8::f32x2){v1[2], v1[3]});
                    u32x4 w; w.x = pg8::cvt_pk_bf16(a.x, a.y); w.y = pg8::cvt_pk_bf16(b.x, b.y); w.z = pg8::cvt_pk_bf16(c.x, c.y); w.w = pg8::cvt_pk_bf16(d.x, d.y);
                    *(u32x4*)(rowp + bj * 128) = w; } }
    }
};
struct EpiResidual {
    static constexpr bool PERM = false, AFTER_DRAIN = false;
    float* H; const float* gate0; int row_base;
    __device__ __forceinline__ void operator()(const pg8::f32x4 (&acc)[2][2][4][2], const pg8::Unit& u, int wr, int wc, int fr, int fq) const {
        const int row0 = u.pm * 256 + wr * 64 + fr, col0 = u.pn * 256 + wc * 32 + 4 * fq;
        const Tok tk = tokinfo(row_base + u.pm * 256);
        const float* gate = gate0 + (size_t)tk.modrow * 6144 + col0;
        pg8::f32x4 gv[2][2];
#pragma unroll
        for (int bj = 0; bj < 2; ++bj)
#pragma unroll
            for (int n = 0; n < 2; ++n) gv[bj][n] = *(const pg8::f32x4*)(gate + bj * 128 + n * 16);
#pragma unroll
        for (int ai = 0; ai < 2; ++ai)
#pragma unroll
            for (int m = 0; m < 4; ++m) { float* rowp = H + (size_t)(row0 + ai * 128 + m * 16) * DM + col0;
#pragma unroll
                for (int bj = 0; bj < 2; ++bj)
#pragma unroll
                    for (int n = 0; n < 2; ++n) { pg8::f32x4* p = (pg8::f32x4*)(rowp + bj * 128 + n * 16); *p = *p + gv[bj][n] * acc[ai][bj][m][n]; } }
    }
};
struct ListOrder {
    const LAS int* list; int n;
    __device__ __forceinline__ bool next(int i, pg8::Unit& u) const {
        if (i >= n) return false;
        u.pm = __builtin_amdgcn_readfirstlane(list[2 * i]); u.pn = __builtin_amdgcn_readfirstlane(list[2 * i + 1]); return true;
    }
    __device__ __forceinline__ void a_ready(const pg8::Unit&) const {}
    __device__ __forceinline__ void done(const pg8::Unit&) const {}
};
constexpr int LDS_TAB = 131072;
constexpr int LDS_LIST = LDS_TAB + 4096;
__device__ __forceinline__ ListOrder build_units(LAS unsigned char* lds, int nM, int nN, int G, int c, const LAS int* tile_e, int ncol) {
    LAS int* list = (LAS int*)(lds + LDS_LIST);
    pg8::StaticOrder S; S.nM = nM; S.nN = nN; S.nwg = nM * nN; S.G = G; S.c = c;
    const int tid = tid_opaque();
    if (tid < 64) { pg8::Unit u; if (S.next(tid, u)) { if (tile_e) u.pn = tile_e[u.pm] * ncol + u.pn; list[2 * tid] = u.pm; list[2 * tid + 1] = u.pn; } }
    __syncthreads();
    ListOrder L; L.list = list; L.n = (c < S.nwg) ? (S.nwg - c + G - 1) / G : 0;
    return L;
}
struct EpiMoe1 {
    static constexpr bool PERM = true, AFTER_DRAIN = false;
    bf16_t* O; const float* b1;
    __device__ __forceinline__ void operator()(const pg8::f32x4 (&acc)[2][2][4][2], const pg8::Unit& u, int wr, int wc, int fr, int fq) const {
        const int e = u.pn >> 3, pn = u.pn & 7;
        const int row0 = u.pm * 256 + wr * 64 + fr, ci = pn * 128 + wc * 32 + 8 * fq;
        const float* be = b1 + (size_t)e * 2048 + ci;
        const pg8::f32x4 bg0 = *(const pg8::f32x4*)(be), bg1 = *(const pg8::f32x4*)(be + 4), bl0 = *(const pg8::f32x4*)(be + 1024), bl1 = *(const pg8::f32x4*)(be + 1028);
#pragma unroll
        for (int ai = 0; ai < 2; ++ai)
#pragma unroll
            for (int m = 0; m < 4; ++m) {
                const pg8::f32x4 g0 = acc[ai][0][m][0] + bg0, g1 = acc[ai][0][m][1] + bg1, l0 = acc[ai][1][m][0] + bl0, l1 = acc[ai][1][m][1] + bl1;
                float o[8];
#pragma unroll
                for (int r = 0; r < 4; ++r) {
                    const float ga = fminf(g0[r], 7.0f), gb = fminf(g1[r], 7.0f);
                    const float la = fminf(fmaxf(l0[r], -7.0f), 7.0f), lb = fminf(fmaxf(l1[r], -7.0f), 7.0f);
                    o[r] = ga * __builtin_amdgcn_rcpf(1.0f + __expf(-1.702f * ga)) * (la + 1.0f);
                    o[4 + r] = gb * __builtin_amdgcn_rcpf(1.0f + __expf(-1.702f * gb)) * (lb + 1.0f);
                }
                u32x4 w; w.x = pg8::cvt_pk_bf16(o[0], o[1]); w.y = pg8::cvt_pk_bf16(o[2], o[3]); w.z = pg8::cvt_pk_bf16(o[4], o[5]); w.w = pg8::cvt_pk_bf16(o[6], o[7]);
                *(u32x4*)(O + (size_t)(row0 + ai * 128 + m * 16) * DM + ci) = w;
            }
    }
};
struct EpiMoe2 {
    static constexpr bool PERM = true, AFTER_DRAIN = false;
    bf16_t* O; const float* b2;
    __device__ __forceinline__ void operator()(const pg8::f32x4 (&acc)[2][2][4][2], const pg8::Unit& u, int wr, int wc, int fr, int fq) const {
        const int e = u.pn >> 2, pn = u.pn & 3;
        const int row0 = u.pm * 256 + wr * 64 + fr, col0 = pn * 256 + wc * 32 + 8 * fq;
        const float* be = b2 + (size_t)e * DM + col0;
        pg8::f32x4 bv[2][2];
#pragma unroll
        for (int bj = 0; bj < 2; ++bj)
#pragma unroll
            for (int n = 0; n < 2; ++n) bv[bj][n] = *(const pg8::f32x4*)(be + bj * 128 + 4 * n);
#pragma unroll
        for (int ai = 0; ai < 2; ++ai)
#pragma unroll
            for (int m = 0; m < 4; ++m) { bf16_t* rowp = O + (size_t)(row0 + ai * 128 + m * 16) * DM + col0;
#pragma unroll
                for (int bj = 0; bj < 2; ++bj) { const pg8::f32x4 v0 = acc[ai][bj][m][0] + bv[bj][0], v1 = acc[ai][bj][m][1] + bv[bj][1];
                    u32x4 w; w.x = pg8::cvt_pk_bf16(v0[0], v0[1]); w.y = pg8::cvt_pk_bf16(v0[2], v0[3]); w.z = pg8::cvt_pk_bf16(v1[0], v1[1]); w.w = pg8::cvt_pk_bf16(v1[2], v1[3]);
                    *(u32x4*)(rowp + bj * 128) = w; } }
    }
};

namespace att {
typedef float f32x16 __attribute__((ext_vector_type(16)));
typedef short s16x4 __attribute__((ext_vector_type(4)));
constexpr int KVBLK = 64, LDR = 512;
constexpr float SCALE = 0.125f, THR = 8.f;
constexpr int SHM_V = KVBLK * 128 * 2, SHM_K = KVBLK * 64 * 2, SHM_ATTN = 2 * SHM_V + 2 * SHM_K + NWAVES * 64 * 4;
#define ATT_KSWZ(row, colB) ((row) * 128 + ((colB) ^ ((((row) >> 1) & 7) << 4)))
#define ATT_SBAR() __builtin_amdgcn_sched_barrier(0)
__device__ __forceinline__ int crow(int r, int hi) { return (r & 3) + 8 * (r >> 2) + 4 * hi; }
__device__ __forceinline__ unsigned cvtpk(float lo, float hi) { unsigned r; asm volatile("v_cvt_pk_bf16_f32 %0, %1, %2" : "=v"(r) : "v"(lo), "v"(hi)); return r; }
__device__ __forceinline__ void partialSM(f32x16& p0, f32x16& p1, float& m_reg, float& mn, float& alpha) {
    constexpr float C = SCALE * 1.4426950408889634f;
    float pmax = p0[0];
#pragma unroll
    for (int r = 1; r < 16; ++r) pmax = fmaxf(pmax, p0[r]);
#pragma unroll
    for (int r = 0; r < 16; ++r) pmax = fmaxf(pmax, p1[r]);
    { auto rr = __builtin_amdgcn_permlane32_swap(__float_as_uint(pmax), __float_as_uint(pmax), false, false);
      pmax = fmaxf(__uint_as_float(rr[0]), __uint_as_float(rr[1])); }
    if (__builtin_expect(__all(pmax - m_reg <= THR / SCALE), 1)) { mn = m_reg; alpha = 1.f; }
    else { mn = fmaxf(m_reg, pmax); alpha = __builtin_amdgcn_exp2f((m_reg - mn) * C); m_reg = mn; }
    const float mnC = -mn * C;
#pragma unroll
    for (int r = 0; r < 16; ++r) p0[r] = fmaf(p0[r], C, mnC);
#pragma unroll
    for (int r = 0; r < 16; ++r) p1[r] = fmaf(p1[r], C, mnC);
#pragma unroll
    for (int r = 0; r < 16; ++r) p0[r] = __builtin_amdgcn_exp2f(p0[r]);
}
__device__ __forceinline__ void finishSM(f32x16& p0, f32x16& p1, float alpha, float& l_reg, bf16x8& pa0, bf16x8& pa1, bf16x8& pa2, bf16x8& pa3) {
#pragma unroll
    for (int r = 0; r < 16; ++r) p1[r] = __builtin_amdgcn_exp2f(p1[r]);
    float ps = 0;
#pragma unroll
    for (int r = 0; r < 16; ++r) ps += p0[r];
#pragma unroll
    for (int r = 0; r < 16; ++r) ps += p1[r];
    { auto rr = __builtin_amdgcn_permlane32_swap(__float_as_uint(ps), __float_as_uint(ps), false, false);
      ps = __uint_as_float(rr[0]) + __uint_as_float(rr[1]); }
    l_reg = l_reg * alpha + ps;
#define ATT_PK4(P, BASE, OUT) do { unsigned a0 = cvtpk(P[BASE + 0], P[BASE + 1]), a1 = cvtpk(P[BASE + 2], P[BASE + 3]);   \
    unsigned b0 = cvtpk(P[BASE + 4], P[BASE + 5]), b1 = cvtpk(P[BASE + 6], P[BASE + 7]);                              \
    auto r0 = __builtin_amdgcn_permlane32_swap(a0, b0, false, false); auto r1 = __builtin_amdgcn_permlane32_swap(a1, b1, false, false); \
    u32x4 w = {r0[0], r1[0], r0[1], r1[1]}; OUT = __builtin_bit_cast(bf16x8, w); } while (0)
    ATT_PK4(p0, 0, pa0); ATT_PK4(p0, 8, pa1); ATT_PK4(p1, 0, pa2); ATT_PK4(p1, 8, pa3);
#undef ATT_PK4
}
__device__ __forceinline__ void qkt(f32x16& p0, f32x16& p1, const LAS unsigned char* Ks, const bf16x8 (&qr)[4], int r32, int hi) {
    p0 = f32x16{}; p1 = f32x16{};
#pragma unroll
    for (int d0 = 0; d0 < 4; ++d0) { const int cb = (d0 * 16 + hi * 8) * 2;
        const bf16x8 b0 = *(const LAS bf16x8*)(Ks + ATT_KSWZ(r32, cb));
        const bf16x8 b1 = *(const LAS bf16x8*)(Ks + ATT_KSWZ(32 + r32, cb));
        p0 = __builtin_amdgcn_mfma_f32_32x32x16_bf16(b0, qr[d0], p0, 0, 0, 0);
        p1 = __builtin_amdgcn_mfma_f32_32x32x16_bf16(b1, qr[d0], p1, 0, 0, 0); }
}
__device__ __forceinline__ int v_st(int k, int c) { const int kk = (k & ~0xC) | ((k & 4) << 1) | ((k & 8) >> 1); return ((kk >> 3) * 4 + (c >> 5)) * 512 + ((kk & 7) * 32 + (c & 31)) * 2; }
__device__ __forceinline__ int v_rd_base(int lane) { return ((lane & 3) << 3) | (((lane >> 2) & 3) << 6) | (((lane >> 4) & 1) << 5) | (((lane >> 5) & 1) << 8); }
constexpr int v_rd_off(int d0, int ks, int half) { return d0 * 512 + ks * 4096 + half * 2048; }
template <int OFF> __device__ __forceinline__ s16x4 tr_read(int vb) { s16x4 r; asm volatile("ds_read_b64_tr_b16 %0, %1 offset:%2" : "=&v"(r) : "v"(vb), "i"(OFF) : "memory"); return r; }
template <int D0> __device__ __forceinline__ void pv_one(f32x16& od, int vb, bf16x8 pa0, bf16x8 pa1, bf16x8 pa2, bf16x8 pa3) {
    const s16x4 l0 = tr_read<v_rd_off(D0, 0, 0)>(vb), h0 = tr_read<v_rd_off(D0, 0, 1)>(vb), l1 = tr_read<v_rd_off(D0, 1, 0)>(vb), h1 = tr_read<v_rd_off(D0, 1, 1)>(vb);
    const s16x4 l2 = tr_read<v_rd_off(D0, 2, 0)>(vb), h2 = tr_read<v_rd_off(D0, 2, 1)>(vb), l3 = tr_read<v_rd_off(D0, 3, 0)>(vb), h3 = tr_read<v_rd_off(D0, 3, 1)>(vb);
    asm volatile("s_waitcnt lgkmcnt(0)" ::: "memory"); ATT_SBAR();
#define ATT_PK(L, H) (bf16x8){L[0], L[1], L[2], L[3], H[0], H[1], H[2], H[3]}
    od = __builtin_amdgcn_mfma_f32_32x32x16_bf16(pa0, ATT_PK(l0, h0), od, 0, 0, 0);
    od = __builtin_amdgcn_mfma_f32_32x32x16_bf16(pa1, ATT_PK(l1, h1), od, 0, 0, 0);
    od = __builtin_amdgcn_mfma_f32_32x32x16_bf16(pa2, ATT_PK(l2, h2), od, 0, 0, 0);
    od = __builtin_amdgcn_mfma_f32_32x32x16_bf16(pa3, ATT_PK(l3, h3), od, 0, 0, 0);
#undef ATT_PK
}
__device__ __forceinline__ void pv_d0(f32x16 (&o)[4], int vb, bf16x8 pa0, bf16x8 pa1, bf16x8 pa2, bf16x8 pa3) {
    pv_one<0>(o[0], vb, pa0, pa1, pa2, pa3); pv_one<1>(o[1], vb, pa0, pa1, pa2, pa3); pv_one<2>(o[2], vb, pa0, pa1, pa2, pa3); pv_one<3>(o[3], vb, pa0, pa1, pa2, pa3);
}
__device__ __forceinline__ void attn_body(const bf16_t* Qb, const bf16_t* Kh, const bf16_t* Vh, float* Ob, int seq, LAS unsigned char* lds) {
    const int tid = tid_opaque(), wid = tid >> 6, lane = tid & 63, r32 = lane & 31, hi = lane >> 5;
    LAS unsigned char* V_lds = lds; LAS unsigned char* K_lds = lds + 2 * SHM_V;
    LAS float* wsl = (LAS float*)(lds + 2 * SHM_V + 2 * SHM_K) + wid * 64; LAS float* li_l = wsl; LAS float* al_l = wsl + 32;
    float m_reg = -1e30f, l_reg = 0; f32x16 o[4] = {}; bf16x8 qr[4];
    const bf16_t* Qw = Qb + (size_t)(wid * 32 + r32) * LDR + hi * 8;
#pragma unroll
    for (int d0 = 0; d0 < 4; ++d0) qr[d0] = *(const bf16x8*)(Qw + d0 * 16);
    const int sr = tid >> 4, sc = (tid & 15) * 8, vst0 = v_st(sr, sc), vst1 = v_st(32 + sr, sc);
    const int kr = tid >> 3, kc = (tid & 7) * 8, kst = ATT_KSWZ(kr, kc * 2);
    const int vb0 = (int)(uintptr_t)V_lds + v_rd_base(lane);
    bf16x8 vsA0, vsA1, ksA, vsB0, vsB1, ksB;
#define ATT_SLOAD(V0, V1, K0, k0) do { V0 = *(const bf16x8*)(Vh + (size_t)((k0) + sr) * LDR + sc); V1 = *(const bf16x8*)(Vh + (size_t)((k0) + 32 + sr) * LDR + sc); \
    K0 = *(const bf16x8*)(Kh + (size_t)((k0) + kr) * LDR + kc); } while (0)
#define ATT_SWRITE(b, V0, V1, K0) do { *(LAS bf16x8*)(V_lds + (b) * SHM_V + vst0) = V0; *(LAS bf16x8*)(V_lds + (b) * SHM_V + vst1) = V1; \
    *(LAS bf16x8*)(K_lds + (b) * SHM_K + kst) = K0; } while (0)
#define ATT_SWAIT() asm volatile("s_waitcnt vmcnt(3)" ::: "memory")
#define ATT_RESC(a) do { if (__any((a) < 1.f)) { if (hi == 0) al_l[r32] = (a); asm volatile("s_waitcnt lgkmcnt(0)" ::: "memory"); \
    _Pragma("unroll") for (int d = 0; d < 4; ++d) _Pragma("unroll") for (int r = 0; r < 16; ++r) o[d][r] *= al_l[crow(r, hi)]; } } while (0)
    f32x16 pA0, pA1, pB0, pB1; float mnA, mnB, alA, alB; bf16x8 pa0, pa1, pa2, pa3; const int NT = seq / KVBLK;
    ATT_SLOAD(vsA0, vsA1, ksA, 0); asm volatile("s_waitcnt vmcnt(0)" ::: "memory"); ATT_SWRITE(0, vsA0, vsA1, ksA); __syncthreads();
    qkt(pA0, pA1, K_lds, qr, r32, hi); partialSM(pA0, pA1, m_reg, mnA, alA);
    ATT_SLOAD(vsB0, vsB1, ksB, KVBLK); if (2 < NT) ATT_SLOAD(vsA0, vsA1, ksA, 2 * KVBLK);
    ATT_SWAIT(); ATT_SWRITE(1, vsB0, vsB1, ksB); __syncthreads();
    for (int j = 1; j + 1 < NT; j += 2) {
        ATT_SBAR(); qkt(pB0, pB1, K_lds + SHM_K, qr, r32, hi);
        finishSM(pA0, pA1, alA, l_reg, pa0, pa1, pa2, pa3); ATT_SBAR();
        ATT_SLOAD(vsB0, vsB1, ksB, (j + 2) * KVBLK); ATT_SBAR();
        pv_d0(o, vb0, pa0, pa1, pa2, pa3); partialSM(pB0, pB1, m_reg, mnB, alB);
        __syncthreads(); ATT_SWAIT(); ATT_SWRITE(0, vsA0, vsA1, ksA);
        ATT_RESC(alB); __syncthreads();
        ATT_SBAR(); qkt(pA0, pA1, K_lds, qr, r32, hi);
        finishSM(pB0, pB1, alB, l_reg, pa0, pa1, pa2, pa3); ATT_SBAR();
        if (j + 3 < NT) ATT_SLOAD(vsA0, vsA1, ksA, (j + 3) * KVBLK); ATT_SBAR();
        pv_d0(o, vb0 + SHM_V, pa0, pa1, pa2, pa3); partialSM(pA0, pA1, m_reg, mnA, alA);
        __syncthreads(); ATT_SWAIT(); ATT_SWRITE(1, vsB0, vsB1, ksB);
        ATT_RESC(alA); __syncthreads();
    }
    ATT_SBAR(); qkt(pB0, pB1, K_lds + SHM_K, qr, r32, hi);
    finishSM(pA0, pA1, alA, l_reg, pa0, pa1, pa2, pa3); ATT_SBAR();
    pv_d0(o, vb0, pa0, pa1, pa2, pa3); partialSM(pB0, pB1, m_reg, mnB, alB);
    __syncthreads(); ATT_RESC(alB);
    finishSM(pB0, pB1, alB, l_reg, pa0, pa1, pa2, pa3); ATT_SBAR();
    pv_d0(o, vb0 + SHM_V, pa0, pa1, pa2, pa3);
    if (hi == 0) li_l[r32] = l_reg; asm volatile("s_waitcnt lgkmcnt(0)" ::: "memory");
    float rli[16];
#pragma unroll
    for (int r = 0; r < 16; ++r) rli[r] = __builtin_amdgcn_rcpf(li_l[crow(r, hi)]);
    float* Ow = Ob + (size_t)(wid * 32) * LDR;
#pragma unroll
    for (int r = 0; r < 16; ++r) { const int orow = crow(r, hi);
#pragma unroll
        for (int d0 = 0; d0 < 4; ++d0) Ow[(size_t)orow * LDR + d0 * 32 + r32] = o[d0][r] * rli[r]; }
#undef ATT_SLOAD
#undef ATT_SWRITE
#undef ATT_SWAIT
#undef ATT_RESC
}
}

__device__ __forceinline__ void ph_gemm_win(const Args& A, int j, int row_lo, LAS unsigned char* lds, int bid, int nb) {
    unsigned char* ws = opq(A.ws); const float* const* IN = (const float* const*)(ws + WS_PTRS); (void)IN;
    pg8::Gemm g{(const bf16_t*)(ws + WS_ABF) + (size_t)row_lo * DM, (const bf16_t*)(ws + WS_WIN) + (size_t)j * ZLD * DM, NTOK - row_lo, ZLD, DM};
    const ListOrder S = build_units(lds, (NTOK - row_lo) / 256, ZLD / 256, nb, bid, nullptr, 0);
    EpiStoreBf16 E{(bf16_t*)(ws + WS_Z) + (size_t)row_lo * ZLD, ZLD};
    pg8::gemm_phase<EpiStoreBf16, ListOrder, true, true>(lds, g, S, E);
}

__device__ __forceinline__ void ph_rwkv_feat(const Args& A, int j, int row_lo, LAS unsigned char* lds, int bid, int nb) {
    unsigned char* ws = opq(A.ws); const float* const* IN = (const float* const*)(ws + WS_PTRS); (void)IN;
    const int tid = tid_opaque(), c = tid;
    LAS float* zs = (LAS float*)lds;
    const bf16_t* Z = (const bf16_t*)(ws + WS_Z);
    const float* mu = INP(I_RWMU) + (size_t)j * 2 * RWC;
    const float* w0 = INP(I_RWW0) + (size_t)j * 2 * 512; const float* w2 = INP(I_RWW2) + (size_t)j * 2 * 64 * 512;
    const float* a0 = INP(I_RWA0) + (size_t)j * 2 * 512; const float* a2 = INP(I_RWA2) + (size_t)j * 2 * 64 * 512;
    const float* g2 = INP(I_RWG2) + (size_t)j * 128 * 512;
    const float kkw = INP(I_RWKK)[j * 512 + c], kaw = INP(I_RWKA)[j * 512 + c], rkw = INP(I_RWRK)[j * 512 + c];
    const float w00 = w0[c], w01 = w0[512 + c], a00 = a0[c], a01 = a0[512 + c];
    float* F = (float*)(ws + WS_F);
    for (int grp = row_lo / 4 + bid; grp < NTOK / 4; grp += nb) {
        const int g0 = grp * 4; const Tok tk = tokinfo(g0);
        for (int col = tid; col < RWC; col += NTHREADS) {
            const float m0 = mu[col], m1 = mu[RWC + col];
            float z[6];
#pragma unroll
            for (int i = 0; i < 6; ++i) { const int tt = tk.t - 1 + i; z[i] = (tt >= 0 && tt < tk.T) ? bf2f(Z[(size_t)(g0 - 1 + i) * ZLD + col]) : 0.f; }
#pragma unroll
            for (int k = 0; k < 4; ++k) zs[k * RWC + col] = z[k + 1] + m0 * (z[k] - z[k + 1]) + m1 * (z[k + 2] - z[k + 1]);
        }
        __syncthreads();
        for (int i = tid; i < 1024; i += NTHREADS) {
            const int k = i >> 8, q = i & 255;
            if (q < 128) { const int idx = k * RWC + 1536 + q; zs[idx] = tanhf(zs[idx]); }
            else { const int idx = k * RWC + 1792 + (q - 128); zs[idx] = sigmoidf_(zs[idx]); }
        }
        __syncthreads();
        float aw0[4], aw1[4], aa0[4], aa1[4], ag[4];
#pragma unroll
        for (int k = 0; k < 4; ++k) { aw0[k] = 0.f; aw1[k] = 0.f; aa0[k] = 0.f; aa1[k] = 0.f; ag[k] = 0.f; }
        for (int r = 0; r < 64; ++r) {
            const float w20 = w2[r * 512 + c], w21 = w2[(64 + r) * 512 + c], a20 = a2[r * 512 + c], a21 = a2[(64 + r) * 512 + c];
#pragma unroll
            for (int k = 0; k < 4; ++k) {
                aw0[k] += zs[k * RWC + 1536 + r] * w20; aw1[k] += zs[k * RWC + 1600 + r] * w21;
                aa0[k] += zs[k * RWC + 1664 + r] * a20; aa1[k] += zs[k * RWC + 1728 + r] * a21;
            }
        }
        for (int r = 0; r < 128; ++r) {
            const float gv = g2[r * 512 + c];
#pragma unroll
            for (int k = 0; k < 4; ++k) ag[k] += zs[k * RWC + 1792 + r] * gv;
        }
#pragma unroll
        for (int k = 0; k < 4; ++k) {
            const float r_ = zs[k * RWC + c], k_ = zs[k * RWC + 512 + c], v_ = zs[k * RWC + 1024 + c];
            float dec[2], av[2];
#pragma unroll
            for (int d = 0; d < 2; ++d) {
                const float x = (d ? w01 : w00) + (d ? aw1[k] : aw0[k]);
                const float y = -x;
                const float sp = fmaxf(y, 0.f) + log1pf(__expf(-fabsf(y)));
                const float w = -sp - 0.5f;
                dec[d] = __expf(-__expf(w));
                av[d] = sigmoidf_((d ? a01 : a00) + (d ? aa1[k] : aa0[k]));
            }
            float kk = k_ * kkw;
            const float nrm = sqrtf(wave_sum(kk * kk));
            kk = kk / fmaxf(nrm, 1e-12f);
            const float kd0 = k_ * (1.0f + (av[0] - 1.0f) * kaw), kd1 = k_ * (1.0f + (av[1] - 1.0f) * kaw);
            const float s0 = wave_sum(r_ * kd0 * rkw), s1 = wave_sum(r_ * kd1 * rkw);
            const size_t o = (size_t)(g0 + k) * 512 + c; const size_t FS = (size_t)NTOK * 512;
            F[0 * FS + o] = r_; F[1 * FS + o] = v_; F[2 * FS + o] = kk; F[3 * FS + o] = ag[k]; F[4 * FS + o] = (s0 + s1) * v_;
            F[5 * FS + o] = dec[0]; F[6 * FS + o] = dec[1]; F[7 * FS + o] = kd0; F[8 * FS + o] = kd1; F[9 * FS + o] = kk * av[0]; F[10 * FS + o] = kk * av[1];
        }
        __syncthreads();
    }
}

__device__ __forceinline__ void ph_scan_naive(const Args& A, int bid, int nb) {
    unsigned char* ws = opq(A.ws); const float* const* IN = (const float* const*)(ws + WS_PTRS); (void)IN;
    const int tid = tid_opaque(), lane = tid & 63, wid = tid >> 6;
    if (wid != 0) return;
    const float* F = (const float*)(ws + WS_F); const size_t FS = (size_t)NTOK * 512;
    float* YS = (float*)(ws + WS_YS);
    for (int inst = bid; inst < 256; inst += nb) {
        const int dir = inst & 1, h = (inst >> 1) & 7, b = inst >> 4;
        float S[64];
#pragma unroll
        for (int k = 0; k < 64; ++k) S[k] = 0.f;
        const float* Fw = F + (5 + dir) * FS; const float* Fk = F + (7 + dir) * FS; const float* Fb = F + (9 + dir) * FS;
        float* Y = YS + dir * FS;
        for (int s = 0; s < TC + TL; ++s) {
            int g;
            if (s < TC) g = b * TC + (dir ? (TC - 1 - s) : s);
            else { const int q = s - TC; g = NCTX + b * TL + (dir ? (TL - 1 - q) : q); }
            const size_t o = (size_t)g * 512 + h * 64 + lane;
            const float r_ = F[o], v_ = F[FS + o], kk_ = F[2 * FS + o], w_ = Fw[o], kd_ = Fk[o], b_ = Fb[o];
            float sa = 0.f;
#pragma unroll
            for (int k = 0; k < 64; ++k) sa -= S[k] * rdl(kk_, k);
            float y = 0.f;
#pragma unroll
            for (int k = 0; k < 64; ++k) {
                float sv = S[k] * rdl(w_, k);
                sv += sa * rdl(b_, k);
                sv += v_ * rdl(kd_, k);
                S[k] = sv;
                y += sv * rdl(r_, k);
            }
            Y[o] = y;
        }
    }
}

__device__ __forceinline__ void ph_qk(const Args& A, int j, int row_lo, int bid, int nb) {
    unsigned char* ws = opq(A.ws); const float* const* IN = (const float* const*)(ws + WS_PTRS);
    const int tid = tid_opaque(), lane = tid & 63, wid = tid >> 6;
    const bf16_t* Z = (const bf16_t*)(ws + WS_Z);
    bf16_t* QB = (bf16_t*)(ws + WS_QB); bf16_t* KB = (bf16_t*)(ws + WS_KB); bf16_t* VB = (bf16_t*)(ws + WS_VB);
    const float qn = INP(I_QN)[j * 64 + lane], kn = INP(I_KN)[j * 64 + lane];
    const float invf = __powf(10000.0f, -(float)(lane & 15) / 16.0f);
    for (int g = row_lo + bid; g < NTOK; g += nb) {
        const Tok tk = tokinfo(g);
        const size_t krow = (size_t)tk.b * (TC + TL) + (tk.T == TL ? TC + tk.t : tk.t);
        const bf16_t* zr = Z + (size_t)g * ZLD + RWC;
        VB[krow * 512 + tid] = zr[1024 + tid];
#pragma unroll
        for (int ss = 0; ss < 2; ++ss) {
            const int sh = wid * 2 + ss, isk = sh >> 3, s = sh & 7;
            const float x = bf2f(zr[isk * 512 + s * 64 + lane]);
            const float ms = wave_sum(x * x) * (1.0f / 64.0f);
            float y = x * rsqrtf(ms + 1e-6f) * (isk ? kn : qn);
            if (tk.T == TL) {
                const float pos = (float)((lane & 32) ? (tk.t & 63) : (tk.t >> 6));
                const float ang = pos * invf;
                float sn, cs; __sincosf(ang, &sn, &cs);
                const float other = __shfl_xor(y, 16);
                y = (lane & 16) ? (y * cs + other * sn) : (y * cs - other * sn);
            }
            if (isk) KB[krow * 512 + s * 64 + lane] = (bf16_t)f2bf(y); else QB[(size_t)g * 512 + s * 64 + lane] = (bf16_t)f2bf(y);
        }
    }
}

__device__ __forceinline__ void ph_attn(const Args& A, bool want_ctx, LAS unsigned char* lds, int bid, int nb) {
    unsigned char* ws = opq(A.ws);
    const bf16_t* QB = (const bf16_t*)(ws + WS_QB); const bf16_t* KB = (const bf16_t*)(ws + WS_KB); const bf16_t* VB = (const bf16_t*)(ws + WS_VB);
    float* OP = (float*)(ws + WS_OP);
    const int vcu = (nb % 8 == 0) ? (bid % 8) * (nb / 8) + bid / 8 : bid;
    const int nunits = 1024 + (want_ctx ? 128 : 0);
    for (int u = vcu; u < nunits; u += nb) {
        int b, h, m, q0, seq;
        if (u < 1024) { const int qb = u & 7; m = (u >> 3) & 1; h = (u >> 4) & 3; b = u >> 6; q0 = NCTX + b * TL + qb * 256; seq = TC + TL; }
        else { const int v = u - 1024; m = v & 1; h = (v >> 1) & 3; b = v >> 3; q0 = b * TC; seq = TC; }
        const int s = h * 2 + m;
        att::attn_body(QB + (size_t)q0 * 512 + s * 64, KB + (size_t)b * (TC + TL) * 512 + s * 64, VB + (size_t)b * (TC + TL) * 512 + h * 128,
                       OP + (size_t)m * NTOK * 512 + (size_t)q0 * 512 + h * 128, seq, lds);
    }
}

__device__ __forceinline__ void ph_merge(const Args& A, int l, int row_lo, LAS unsigned char* lds, int bid, int nb) {
    unsigned char* ws = opq(A.ws); const float* const* IN = (const float* const*)(ws + WS_PTRS); (void)IN;
    const int j = l >> 1;
    const int tid = tid_opaque(), lane = tid & 63, wid = tid >> 6, c = tid;
    LAS float* sh = (LAS float*)lds;
    const float lam_init = 0.8f - 0.6f * __expf(-0.3f * (float)l);
    if (wid == 0) {
        const float* lp = INP(I_LAM) + j * 4 * 64;
        const float s01 = wave_sum(lp[lane] * lp[64 + lane]), s23 = wave_sum(lp[128 + lane] * lp[192 + lane]);
        if (lane == 0) sh[8] = __expf(s01) - __expf(s23) + lam_init;
    }
    __syncthreads();
    const float lam = sh[8];
    const float* F = (const float*)(ws + WS_F); const size_t FS = (size_t)NTOK * 512;
    const float* YS = (const float*)(ws + WS_YS); const float* OP = (const float*)(ws + WS_OP);
    bf16_t* CAT = (bf16_t*)(ws + WS_CAT);
    const float gnw = INP(I_GNW)[j * 512 + c], gnb = INP(I_GNB)[j * 512 + c], sub = INP(I_SUBLN)[j * 128 + (c & 127)];
    for (int g = row_lo + bid; g < NTOK; g += nb) {
        const size_t o = (size_t)g * 512 + c;
        const float y = YS[o] + YS[FS + o];
        const float mu = wave_sum(y) * (1.0f / 64.0f);
        const float dv = y - mu;
        const float var = wave_sum(dv * dv) * (1.0f / 64.0f);
        const float yn = dv * rsqrtf(var + 64e-5f) * gnw + gnb;
        const float ya = (yn + F[4 * FS + o]) * F[3 * FS + o];
        const float od = OP[o] - lam * OP[FS + o];
        const float ssw = wave_sum(od * od);
        if (lane == 0) sh[wid] = ssw;
        __syncthreads();
        const float ms = (sh[wid & ~1] + sh[wid | 1]) * (1.0f / 128.0f);
        const float ob = od * rsqrtf(ms + 1e-6f) * sub * (1.0f - lam_init);
        CAT[(size_t)g * DM + c] = (bf16_t)f2bf(ya);
        CAT[(size_t)g * DM + 512 + c] = (bf16_t)f2bf(ob);
        __syncthreads();
    }
}

__device__ __forceinline__ void ph_gemm_out(const Args& A, int l, size_t x_off, size_t wt_off, int row_lo, LAS unsigned char* lds, int bid, int nb) {
    unsigned char* ws = opq(A.ws); const float* const* IN = (const float* const*)(ws + WS_PTRS); (void)IN;
    pg8::Gemm g{(const bf16_t*)(ws + x_off) + (size_t)row_lo * DM, (const bf16_t*)(ws + wt_off), NTOK - row_lo, DM, DM};
    const ListOrder S = build_units(lds, (NTOK - row_lo) / 256, DM / 256, nb, bid, nullptr, 0);
    EpiResidual E{(float*)(ws + WS_H) + (size_t)row_lo * DM, (const float*)(ws + WS_MOD) + (size_t)l * 17 * 6144 + 2 * 1024, row_lo};
    pg8::gemm_phase<EpiResidual, ListOrder, true, true>(lds, g, S, E);
}

__device__ __forceinline__ void ph_gemm_sgin(const Args& A, int j, int row_lo, LAS unsigned char* lds, int bid, int nb) {
    unsigned char* ws = opq(A.ws); const float* const* IN = (const float* const*)(ws + WS_PTRS); (void)IN;
    pg8::Gemm g{(const bf16_t*)(ws + WS_ABF) + (size_t)row_lo * DM, (const bf16_t*)(ws + WS_SGIN) + (size_t)j * 2048 * DM, NTOK - row_lo, 2048, DM};
    const ListOrder S = build_units(lds, (NTOK - row_lo) / 256, 2048 / 256, nb, bid, nullptr, 0);
    EpiGeluBf16 E{(bf16_t*)(ws + WS_Z2) + (size_t)row_lo * 2048, 2048, INP(I_SGBIN) + j * 2048};
    pg8::gemm_phase<EpiGeluBf16, ListOrder, true, true>(lds, g, S, E);
}
__device__ __forceinline__ void ph_sgu_ln(const Args& A, int j, int row_lo, int bid, int nb) {
    unsigned char* ws = opq(A.ws); const float* const* IN = (const float* const*)(ws + WS_PTRS); (void)IN;
    const int tid = tid_opaque(), lane = tid & 63, wid = tid >> 6;
    const bf16_t* Z2 = (const bf16_t*)(ws + WS_Z2); float* VN = (float*)(ws + WS_VN);
    const float* lg = INP(I_SGLNG) + j * 1024; const float* lb = INP(I_SGLNB) + j * 1024;
    for (int row = row_lo + bid * NWAVES + wid; row < NTOK; row += nb * NWAVES) {
        f32x4 v[4]; float s = 0.f;
#pragma unroll
        for (int q = 0; q < 4; ++q) { const u32x2 t = *(const u32x2*)(Z2 + (size_t)row * 2048 + 1024 + q * 256 + lane * 4);
            v[q] = (f32x4){__builtin_bit_cast(float, t.x << 16), __builtin_bit_cast(float, t.x & 0xffff0000u), __builtin_bit_cast(float, t.y << 16), __builtin_bit_cast(float, t.y & 0xffff0000u)}; s += (v[q].x + v[q].y) + (v[q].z + v[q].w); }
        const float mean = wave_sum(s) * (1.0f / 1024.0f); float s2 = 0.f;
#pragma unroll
        for (int q = 0; q < 4; ++q) { v[q] = v[q] - mean; s2 += (v[q].x * v[q].x + v[q].y * v[q].y) + (v[q].z * v[q].z + v[q].w * v[q].w); }
        const float rstd = rsqrtf(wave_sum(s2) * (1.0f / 1024.0f) + 1e-5f);
#pragma unroll
        for (int q = 0; q < 4; ++q) { const int col = q * 256 + lane * 4; *(f32x4*)(VN + (size_t)row * DM + col) = v[q] * rstd * *(const f32x4*)(lg + col) + *(const f32x4*)(lb + col); }
    }
}
__device__ __forceinline__ void ph_sgu_spatial(const Args& A, int j, int row_lo, LAS unsigned char* lds, int bid, int nb) {
    unsigned char* ws = opq(A.ws); const float* const* IN = (const float* const*)(ws + WS_PTRS); (void)IN;
    const int tid = tid_opaque();
    const bf16_t* Z2 = (const bf16_t*)(ws + WS_Z2); const float* VN = (const float*)(ws + WS_VN); bf16_t* G = (bf16_t*)(ws + WS_G);
    LAS float* vt = (LAS float*)lds;
    LAS float* wl = (LAS float*)(lds + 65536);
    const int ch0 = row_lo / 128, nch = NTOK / 128 - ch0;
    for (int u = bid; u < nch * 8; u += nb) {
        const int ci = ch0 + u / 8, g = u % 8;
        const float* wsg = INP(I_SGWS) + ((size_t)j * 8 + g) * 128 * 128;
        for (int i = tid; i < 128 * 32; i += NTHREADS) {
            const int q = i >> 5, c4 = (i & 31) * 4;
            *(LAS f32x4*)(vt + q * 128 + c4) = *(const f32x4*)(VN + (size_t)(ci * 128 + q) * DM + g * 128 + c4);
            *(LAS f32x4*)(wl + q * 128 + c4) = *(const f32x4*)(wsg + q * 128 + c4);
        }
        __syncthreads();
        const int c = tid & 127, pg = tid >> 7;
        float acc[32];
#pragma unroll
        for (int i = 0; i < 32; ++i) acc[i] = 0.f;
        for (int q = 0; q < 128; q += 4) {
            const float v0 = vt[q * 128 + c], v1 = vt[(q + 1) * 128 + c], v2 = vt[(q + 2) * 128 + c], v3 = vt[(q + 3) * 128 + c];
#pragma unroll
            for (int i = 0; i < 32; ++i) { const f32x4 w = *(const LAS f32x4*)(wl + (pg * 32 + i) * 128 + q); acc[i] += (w.x * v0 + w.y * v1) + (w.z * v2 + w.w * v3); }
        }
#pragma unroll
        for (int i = 0; i < 32; ++i) {
            const int p = pg * 32 + i; const size_t row = (size_t)ci * 128 + p;
            const float uu = bf2f(Z2[row * 2048 + g * 128 + c]);
            const float sv = acc[i] + INP(I_SGBS)[((size_t)j * 8 + g) * 128 + p];
            G[row * DM + g * 128 + c] = (bf16_t)f2bf(uu * sv);
        }
        __syncthreads();
    }
}

__device__ __forceinline__ int moe_layout(const Args& A, int l, LAS int* off  , LAS int* cntl  , LAS int* tile_e  ) {
    const int tid = tid_opaque();
    const unsigned* cnt = (const unsigned*)(opq(A.ws) + WS_CTL) + CW_CNT + l * 32;
    if (tid < 64) {
        const int n = (tid < 32) ? (int)__hip_atomic_load(cnt + tid, __ATOMIC_RELAXED, __HIP_MEMORY_SCOPE_AGENT) : 0;
        const int nt = (n + 255) >> 8;
        int x = nt;
#pragma unroll
        for (int o = 1; o < 32; o <<= 1) { const int y = __shfl_up(x, o); if (tid >= o) x += y; }
        const int start = x - nt;
        if (tid < 32) {
            cntl[tid] = n; off[tid] = start * 256;
#pragma unroll 1
            for (int t = 0; t < nt; ++t) tile_e[start + t] = tid;
        }
        if (tid == 31) off[32] = x * 256;
    }
    __syncthreads();
    return off[32] >> 8;
}
__device__ __forceinline__ void ph_moe_scatter(const Args& A, int l, int row_lo, LAS unsigned char* lds, int bid, int nb) {
    unsigned char* ws = opq(A.ws); const float* const* IN = (const float* const*)(ws + WS_PTRS); (void)IN;
    const int tid = tid_opaque(), lane = tid & 63, wid = tid >> 6;
    LAS int* off = (LAS int*)lds; LAS int* cntl = off + 64; LAS int* tile_e = off + 128;
    moe_layout(A, l, off, cntl, tile_e);
    const bf16_t* abf = (const bf16_t*)(ws + WS_ABF); bf16_t* XP = (bf16_t*)(ws + WS_XP);
    const int* te = (const int*)(ws + WS_TOKE); int* rowof = (int*)(ws + WS_ROWOF);
    unsigned* cur = (unsigned*)(ws + WS_CTL) + CW_CUR + l * 32;
    const int ntask = (NTOK - row_lo) * 4;
    for (int task = bid * NWAVES + wid; task < ntask; task += nb * NWAVES) {
        const int g = row_lo + (task >> 2), k = task & 3;
        const int e = te[(size_t)g * 4 + k];
        int pos = 0;
        if (lane == 0) { pos = off[e] + (int)atomicAdd(cur + e, 1u); rowof[(size_t)g * 4 + k] = pos; }
        pos = __shfl(pos, 0);
        const u32x4* src = (const u32x4*)(abf + (size_t)g * DM); u32x4* dst = (u32x4*)(XP + (size_t)pos * DM);
        dst[lane] = src[lane]; dst[64 + lane] = src[64 + lane];
    }
    for (int e = bid; e < 32; e += nb) {
        const int r0 = off[e] + cntl[e], r1 = off[e + 1];
        for (int i = tid; i < (r1 - r0) * 128; i += NTHREADS) ((u32x4*)(XP + (size_t)r0 * DM))[i] = (u32x4){0u, 0u, 0u, 0u};
    }
}
__device__ __forceinline__ void ph_moe_gemm1(const Args& A, int l, LAS unsigned char* lds, int bid, int nb) {
    unsigned char* ws = opq(A.ws); const float* const* IN = (const float* const*)(ws + WS_PTRS); (void)IN;
    LAS int* off = (LAS int*)(lds + LDS_TAB); LAS int* cntl = off + 64; LAS int* tile_e = off + 128;
    const int T = moe_layout(A, l, off, cntl, tile_e);
    pg8::Gemm g{(const bf16_t*)(ws + WS_XP), (const bf16_t*)(ws + WS_W1) + (size_t)l * NE * 2048 * DM, T * 256, 2048, DM};
    const ListOrder S = build_units(lds, T, 8, nb, bid, tile_e, 8);
    EpiMoe1 E{(bf16_t*)(ws + WS_ACT), INP(I_B1) + (size_t)l * NE * 2048};
    pg8::gemm_phase<EpiMoe1, ListOrder, true, true>(lds, g, S, E);
}
__device__ __forceinline__ void ph_moe_gemm2(const Args& A, int l, LAS unsigned char* lds, int bid, int nb) {
    unsigned char* ws = opq(A.ws); const float* const* IN = (const float* const*)(ws + WS_PTRS); (void)IN;
    LAS int* off = (LAS int*)(lds + LDS_TAB); LAS int* cntl = off + 64; LAS int* tile_e = off + 128;
    const int T = moe_layout(A, l, off, cntl, tile_e);
    pg8::Gemm g{(const bf16_t*)(ws + WS_ACT), (const bf16_t*)(ws + WS_W2) + (size_t)l * NE * DM * DM, T * 256, DM, DM};
    const ListOrder S = build_units(lds, T, 4, nb, bid, tile_e, 4);
    EpiMoe2 E{(bf16_t*)(ws + WS_YM), INP(I_B2) + (size_t)l * NE * DM};
    pg8::gemm_phase<EpiMoe2, ListOrder, true, true>(lds, g, S, E);
}
__device__ __forceinline__ void ph_moe_combine(const Args& A, int l, int row_lo, bool last, int bid, int nb) {
    unsigned char* ws = opq(A.ws); const float* const* IN = (const float* const*)(ws + WS_PTRS); (void)IN;
    const int tid = tid_opaque(), lane = tid & 63, wid = tid >> 6;
    float* H = (float*)(ws + WS_H); const float* mod = (const float*)(ws + WS_MOD); const bf16_t* YM = (const bf16_t*)(ws + WS_YM);
    const int* rowof = (const int*)(ws + WS_ROWOF); const float* tg = (const float*)(ws + WS_TOKG);
    for (int row = row_lo + bid * NWAVES + wid; row < NTOK; row += nb * NWAVES) {
        const Tok tk = tokinfo(row);
        const float* gate = mod + ((size_t)l * 17 + tk.modrow) * 6144 + 5 * 1024;
        int r[4]; float gk[4];
#pragma unroll
        for (int k = 0; k < 4; ++k) { r[k] = rowof[(size_t)row * 4 + k]; gk[k] = tg[(size_t)row * 4 + k]; }
#pragma unroll
        for (int q = 0; q < 4; ++q) {
            const int col = q * 256 + lane * 4;
            f32x4 m = (f32x4){0.f, 0.f, 0.f, 0.f};
#pragma unroll
            for (int k = 0; k < 4; ++k) { const u32x2 t = *(const u32x2*)(YM + (size_t)r[k] * DM + col);
                m = m + (f32x4){__builtin_bit_cast(float, t.x << 16), __builtin_bit_cast(float, t.x & 0xffff0000u), __builtin_bit_cast(float, t.y << 16), __builtin_bit_cast(float, t.y & 0xffff0000u)} * gk[k]; }
            const f32x4 hv = *(const f32x4*)(H + (size_t)row * DM + col) + *(const f32x4*)(gate + col) * m;
            if (last) *(f32x4*)(as_global(((float* const*)IN)[38]) + (size_t)(row - NCTX) * DM + col) = hv;
            else *(f32x4*)(H + (size_t)row * DM + col) = hv;
        }
    }
}

__global__ void __launch_bounds__(NTHREADS, 2) fwd_kernel(Args A) {
    extern __shared__ __attribute__((aligned(16))) unsigned char lds_raw[];
    LAS unsigned char* lds = (LAS unsigned char*)lds_raw;
    volatile LAS unsigned* misc = (volatile LAS unsigned*)(lds + LDS_MISC);
    const int tid = threadIdx.x, bid = blockIdx.x, nb = gridDim.x;
    if (tid < 64) misc[tid] = 0u;
    __syncthreads();
    XcdBarrier bar = xcd_barrier_post((unsigned*)(A.ws + WS_CTL) + CW_BAR, misc + 8);
    const int lo = A.ph_lo, hi = A.ph_hi;
    int pc = 0;
#ifndef PHSEL
#define PHSEL -1
#endif
#define SEL(k) (PHSEL < 0 || PHSEL == (k))
#define PH_BEGIN if (pc >= lo && pc < hi) {
#define PH_END } if (pc >= lo && pc + 1 < hi) xcd_barrier(bar); ++pc;

    PH_BEGIN if (SEL(0)) ph_prologue(A, lds, bid, nb); PH_END

    for (int l = 0; l < 4; ++l) {
        const int j = l >> 1;
        const bool ctx_out = (l < 2), ctx_in = (l < 3);
        const int rin = ctx_in ? 0 : NCTX, rout = ctx_out ? 0 : NCTX;
        PH_BEGIN if (SEL(1)) ph_norm<false>(A, l, rin, bid, nb); PH_END
        if ((l & 1) == 0) {
            PH_BEGIN if (SEL(2)) ph_gemm_win(A, j, rin, lds, bid, nb); PH_END
            PH_BEGIN if (SEL(3)) ph_rwkv_feat(A, j, rin, lds, bid, nb); if (SEL(4)) ph_qk(A, j, rin, bid, nb); PH_END
            PH_BEGIN if (SEL(5)) ph_scan_naive(A, bid, nb); PH_END
            PH_BEGIN if (SEL(6)) ph_attn(A, ctx_out, lds, bid, nb); PH_END
            PH_BEGIN if (SEL(7)) ph_merge(A, l, rout, lds, bid, nb); PH_END
            PH_BEGIN if (SEL(8)) ph_gemm_out(A, l, WS_CAT, WS_WOUT + (size_t)j * DM * DM * 2, rout, lds, bid, nb); PH_END
        } else {
            PH_BEGIN if (SEL(9)) ph_gemm_sgin(A, j, rin, lds, bid, nb); PH_END
            PH_BEGIN if (SEL(10)) ph_sgu_ln(A, j, rin, bid, nb); PH_END
            PH_BEGIN if (SEL(11)) ph_sgu_spatial(A, j, rout, lds, bid, nb); PH_END
            PH_BEGIN if (SEL(12)) ph_gemm_out(A, l, WS_G, WS_SGOUT + (size_t)j * DM * DM * 2, rout, lds, bid, nb); PH_END
        }
        PH_BEGIN if (SEL(13)) ph_norm<true>(A, l, rout, bid, nb); PH_END
        PH_BEGIN if (SEL(14)) ph_moe_scatter(A, l, rout, lds, bid, nb); PH_END
        PH_BEGIN if (SEL(15)) ph_moe_gemm1(A, l, lds, bid, nb); PH_END
        PH_BEGIN if (SEL(16)) ph_moe_gemm2(A, l, lds, bid, nb); PH_END
        PH_BEGIN if (SEL(17)) ph_moe_combine(A, l, rout, l == 3, bid, nb); PH_END
    }
}

extern "C" void kernel_launch(void* const* d_in, const int* in_sizes, int n_in, void* d_out, int out_size, void* d_ws, size_t ws_size, hipStream_t stream) {
    static int grid = 0;
    if (grid == 0) {
        if (n_in != 38 || out_size != NLAT * DM || ws_size < WS_END) { fprintf(stderr, "kernel_launch: unexpected shapes: n_in %d out %d ws %zu (need %zu)\n", n_in, out_size, ws_size, (size_t)WS_END); grid = -1; return; }
        int dev = 0, cus = 0, per_cu = 0;
        if (hipGetDevice(&dev) != hipSuccess || hipDeviceGetAttribute(&cus, hipDeviceAttributeMultiprocessorCount, dev) != hipSuccess) { grid = -1; return; }
        if (hipFuncSetAttribute((const void*)fwd_kernel, hipFuncAttributeMaxDynamicSharedMemorySize, LDS_BYTES) != hipSuccess) { fprintf(stderr, "kernel_launch: hipFuncSetAttribute failed\n"); grid = -1; return; }
        if (hipOccupancyMaxActiveBlocksPerMultiprocessor(&per_cu, (const void*)fwd_kernel, NTHREADS, LDS_BYTES) != hipSuccess || per_cu < 1)
            fprintf(stderr, "kernel_launch: occupancy query reports %d workgroups per CU\n", per_cu);
        (void)hipGetLastError();
        grid = cus;
    }
    if (grid < 0) return;
    if (hipMemsetAsync((char*)d_ws + WS_CTL, 0, CTL_ZERO_BYTES, stream) != hipSuccess) { fprintf(stderr, "kernel_launch: memset failed\n"); return; }
    Args a{};
    for (int i = 0; i < 38; ++i) a.in[i] = (const float*)d_in[i];
    a.out = (float*)d_out; a.ws = (unsigned char*)d_ws; a.ph_lo = 0; a.ph_hi = 1 << 20;
    hipLaunchKernelGGL(fwd_kernel, dim3(grid), dim3(NTHREADS), LDS_BYTES, stream, a);
    const hipError_t le = hipPeekAtLastError();
    if (le != hipSuccess) fprintf(stderr, "kernel_launch: launch failed: %s\n", hipGetErrorName(le));
}
```

```cpp
#include <hip/hip_runtime.h>
#include <cstdio>
#include <cstdint>

#define LAS __attribute__((address_space(3)))
typedef unsigned short bf16_t;
typedef short bf16x8 __attribute__((ext_vector_type(8)));
typedef float f32x4 __attribute__((ext_vector_type(4)));
typedef unsigned u32x4 __attribute__((ext_vector_type(4)));
typedef unsigned u32x2 __attribute__((ext_vector_type(2)));

constexpr int DM = 1024, NB = 16, TL = 2048, TC = 256;
constexpr int NCTX = NB * TC, NLAT = NB * TL, NTOK = NCTX + NLAT;
constexpr int RWC = 1920, EVC = 3456, ZLD = 3584;
constexpr int NE = 32;
constexpr int XPROWS = NTOK * 4 + NE * 256;
constexpr int NTHREADS = 512, NWAVES = 8;

constexpr size_t MiB = 1u << 20;
constexpr size_t al256(size_t x) { return (x + 255) & ~(size_t)255; }
constexpr size_t WS_CTL = 0, CTL_ZERO_BYTES = 1 * MiB - 4096;
constexpr size_t WS_PTRS = 1 * MiB - 4096;
constexpr size_t WS_MOD = 1 * MiB;
constexpr size_t WS_RTWT = al256(WS_MOD + (size_t)4 * 17 * 6144 * 4);
constexpr size_t WS_WIN = al256(WS_RTWT + (size_t)4 * 32 * 1024 * 4);
constexpr size_t WS_WOUT = al256(WS_WIN + (size_t)2 * ZLD * DM * 2);
constexpr size_t WS_SGIN = al256(WS_WOUT + (size_t)2 * DM * DM * 2);
constexpr size_t WS_SGOUT = al256(WS_SGIN + (size_t)2 * 2048 * DM * 2);
constexpr size_t WS_W1 = al256(WS_SGOUT + (size_t)2 * DM * DM * 2);
constexpr size_t WS_W2 = al256(WS_W1 + (size_t)4 * NE * 2048 * DM * 2);
constexpr size_t WS_H = al256(WS_W2 + (size_t)4 * NE * DM * DM * 2);
constexpr size_t WS_ABF = al256(WS_H + (size_t)NTOK * DM * 4);
constexpr size_t WS_TOKE = al256(WS_ABF + (size_t)NTOK * DM * 2);
constexpr size_t WS_TOKG = al256(WS_TOKE + (size_t)NTOK * 4 * 4);
constexpr size_t WS_ROWOF = al256(WS_TOKG + (size_t)NTOK * 4 * 4);
constexpr size_t WS_TOKR = al256(WS_ROWOF + (size_t)NTOK * 4 * 4);
constexpr size_t WS_BCNT = al256(WS_TOKR + (size_t)NTOK * 4 * 4);
constexpr size_t WS_R = al256(WS_BCNT + (size_t)4 * 256 * 32 * 4);
constexpr size_t FSZ = (size_t)NTOK * 512 * 4;
constexpr size_t WS_Z = WS_R;
constexpr size_t WS_F = al256(WS_Z + (size_t)NTOK * ZLD * 2);
constexpr size_t WS_YS = WS_F + 11 * FSZ;
constexpr size_t WS_QB = WS_YS + 2 * FSZ;
constexpr size_t WS_KB = WS_QB + FSZ / 2;
constexpr size_t WS_VB = WS_KB + FSZ / 2;
constexpr size_t WS_OP = WS_VB + FSZ / 2;
constexpr size_t WS_CAT = WS_OP + 2 * FSZ;
constexpr int WKV_REC = 12288, WKV_NCH = (TC + TL) / 16;
constexpr size_t WS_WKV = al256(WS_CAT + (size_t)NTOK * DM * 2);
constexpr size_t WS_EVEN_END = WS_WKV + (size_t)256 * WKV_NCH * WKV_REC;
constexpr size_t WS_Z2 = WS_R;
constexpr size_t WS_VN = al256(WS_Z2 + (size_t)NTOK * 2048 * 2);
constexpr size_t WS_G = al256(WS_VN + (size_t)NTOK * DM * 4);
constexpr size_t WS_ODD_END = WS_G + (size_t)NTOK * DM * 2;
constexpr size_t WS_XP = WS_R;
constexpr size_t WS_ACT = al256(WS_XP + (size_t)XPROWS * DM * 2);
constexpr size_t WS_YM = al256(WS_ACT + (size_t)XPROWS * DM * 2);
constexpr size_t WS_MOE_END = WS_YM + (size_t)XPROWS * DM * 2;
constexpr size_t WS_END = (WS_EVEN_END > WS_MOE_END ? (WS_EVEN_END > WS_ODD_END ? WS_EVEN_END : WS_ODD_END) : (WS_MOE_END > WS_ODD_END ? WS_MOE_END : WS_ODD_END));

constexpr int CW_BAR = 4096;
constexpr int CW_CNT = 16384;
constexpr int CW_CUR = 16384 + 256;

constexpr int LDS_BYTES = 147456;
constexpr int LDS_MISC = 144 * 1024 - 256;

__device__ __forceinline__ unsigned f2bf(float f) { unsigned u = __builtin_bit_cast(unsigned, f); return (u + 0x7fffu + ((u >> 16) & 1u)) >> 16; }
__device__ __forceinline__ unsigned pk2(float lo, float hi) { return f2bf(lo) | (f2bf(hi) << 16); }
typedef float f32x2_t __attribute__((ext_vector_type(2))); typedef __bf16 bf16x2_t __attribute__((ext_vector_type(2)));
__device__ __forceinline__ unsigned cvtpk_s(float lo, float hi) { f32x2_t v = {lo, hi}; bf16x2_t b = __builtin_convertvector(v, bf16x2_t); return __builtin_bit_cast(unsigned, b); }
__device__ __forceinline__ float bf2f(bf16_t b) { return __builtin_bit_cast(float, (unsigned)b << 16); }
__device__ __forceinline__ float wave_sum(float v) {
#pragma unroll
    for (int o = 1; o < 64; o <<= 1) v += __shfl_xor(v, o);
    return v;
}
__device__ __forceinline__ int tid_opaque() { int t = threadIdx.x; asm volatile("" : "+v"(t)); return t; }
#define GAS __attribute__((address_space(1)))
template <class T> __device__ __forceinline__ T* as_global(T* p) { return (T*)(GAS T*)p; }
__device__ __forceinline__ unsigned char* opq(unsigned char* p) { GAS unsigned char* g = (GAS unsigned char*)p; asm volatile("" : "+s"(g)); return (unsigned char*)g; }
__device__ __forceinline__ float rdl(float v, int k) { return __builtin_bit_cast(float, __builtin_amdgcn_readlane(__builtin_bit_cast(int, v), k)); }
__device__ __forceinline__ float sigmoidf_(float x) { return 1.0f / (1.0f + __expf(-x)); }

#define XB_TMO      128
#define XB_XCNT(j)  (256  + 64 * (j))
#define XB_XSUB(j)  (1280 + 64 * (j))
#define XB_XGEN(j)  (2304 + 64 * (j))
#define XB_TOP      3328
#define XB_TOPGEN   3392
#define XCD_BAR_WORDS 3456
#define XB_SPIN_CAP (1u << 22)
__device__ __forceinline__ unsigned xb_ld(unsigned* p)              { return __hip_atomic_load(p, __ATOMIC_RELAXED, __HIP_MEMORY_SCOPE_AGENT); }
__device__ __forceinline__ unsigned xb_add(unsigned* p, unsigned v) { return __hip_atomic_fetch_add(p, v, __ATOMIC_RELAXED, __HIP_MEMORY_SCOPE_AGENT); }
__device__ __forceinline__ unsigned xb_xcc_id() { return (unsigned)__builtin_amdgcn_s_getreg((3 << 11) | 20) & 0xFu; }
#define XB_SPIN(cond, bar) do { unsigned _sp = 0; while (cond) { __builtin_amdgcn_s_sleep(1); \
    if ((++_sp & 255u) == 0u) { if (xb_ld(&(bar)[XB_TMO])) break; if (_sp > XB_SPIN_CAP) { atomicAdd(&(bar)[XB_TMO], 1u); break; } } } } while (0)
struct XcdBarrier { unsigned* bar; unsigned x; volatile LAS unsigned* st; };
__device__ __forceinline__ XcdBarrier xcd_barrier_post(unsigned* bar, volatile LAS unsigned* st) {
    XcdBarrier b; b.bar = bar; b.x = xb_xcc_id(); b.st = st;
    if (threadIdx.x == 0) (void)xb_add(&bar[XB_XCNT(b.x)], 1u);
    return b;
}
__device__ __forceinline__ void xcd_barrier_complete(unsigned* bar, unsigned x, unsigned& nloc, unsigned& nx) {
    const unsigned G = gridDim.x * gridDim.y * gridDim.z;
    unsigned sum, cnt, mine, sp = 0u;
    for (;;) {
        sum = 0u; cnt = 0u; mine = 0u;
#pragma unroll
        for (unsigned j = 0; j < 16; ++j) { const unsigned c = xb_ld(&bar[XB_XCNT(j)]); sum += c; cnt += (c > 0u) ? 1u : 0u; mine = (j == x) ? c : mine; }
        if (sum == G) break;
        __builtin_amdgcn_s_sleep(1);
        if ((++sp & 255u) == 0u) { if (xb_ld(&bar[XB_TMO])) break; if (sp > XB_SPIN_CAP) { atomicAdd(&bar[XB_TMO], 1u); break; } }
    }
    nloc = mine > 0u ? mine : 1u; nx = cnt > 0u ? cnt : 1u;
}
__device__ __forceinline__ void xcd_barrier(const XcdBarrier& b) {
    asm volatile("s_waitcnt vmcnt(0)" ::: "memory");
    __syncthreads();
    if (threadIdx.x == 0) {
        unsigned* bar = b.bar;
        __builtin_amdgcn_s_waitcnt(0);
        unsigned nloc = b.st[0], nx = b.st[1];
        if (nloc == 0u) { xcd_barrier_complete(bar, b.x, nloc, nx); b.st[0] = nloc; b.st[1] = nx; }
        const unsigned old = xb_add(&bar[XB_XSUB(b.x)], 1u);
        const unsigned gen = old / nloc;
        if (old + 1u == (gen + 1u) * nloc) {
            __builtin_amdgcn_fence(__ATOMIC_RELEASE, "agent");
            asm volatile("s_waitcnt vmcnt(0)" ::: "memory");
            const unsigned og = xb_add(&bar[XB_TOP], 1u);
            const unsigned tg = og / nx;
            if (og + 1u == (tg + 1u) * nx) xb_add(&bar[XB_TOPGEN], 1u);
            else XB_SPIN(xb_ld(&bar[XB_TOPGEN]) == tg, bar);
            __builtin_amdgcn_fence(__ATOMIC_ACQUIRE, "agent");
            xb_add(&bar[XB_XGEN(b.x)], 1u);
            asm volatile("s_waitcnt vmcnt(0)" ::: "memory");
        } else {
            XB_SPIN(xb_ld(&bar[XB_XGEN(b.x)]) == gen, bar);
            __builtin_amdgcn_fence(__ATOMIC_ACQUIRE, "agent");
            asm volatile("s_waitcnt vmcnt(0)" ::: "memory");
        }
    }
    __syncthreads();
}

namespace pg8 {
#define PG8_LAS __attribute__((address_space(3)))
typedef unsigned short bf16_t;
typedef short bf16x8 __attribute__((ext_vector_type(8)));
typedef float f32x4 __attribute__((ext_vector_type(4)));
typedef unsigned u32x4 __attribute__((ext_vector_type(4)));
constexpr int BM = 256, BK = 64, HALF = 128, HTB = HALF * BK * 2  , STAGE_BYTES = 8 * HTB, NXCD = 8, WGM = 8;

__host__ __device__ __forceinline__ int lds_byte(int r, int c) { const int st = (r >> 4) * 2 + (c >> 5), rr = r & 15, cc = c & 31, ob = rr * 64 + cc * 2; return st * 1024 + (ob ^ (((ob >> 9) & 1) << 5)); }
__host__ __device__ __forceinline__ void stage_rc(int b, int& R, int& C) { const int st = b / 1024, sb = b % 1024, swz = sb ^ (((sb >> 9) & 1) << 5); R = (st >> 1) * 16 + swz / 64; C = (st & 1) * 32 + (swz % 64) / 2; }
__host__ __device__ __forceinline__ int perm32(int rho) { const int n = rho >> 4, i = rho & 15; return 8 * (i >> 2) + 4 * n + (i & 3); }

struct Unit { int pm, pn; };
struct Gemm { const bf16_t* A; const bf16_t* Bt; int M, N, K; };

struct StaticOrder {
    int nM, nN, nwg, G, c;
    __host__ __device__ void init(int M, int N, int G_, int c_) { nM = M / BM; nN = N / BM; nwg = nM * nN; G = G_; c = c_; }
    __host__ __device__ bool next(int i, Unit& u) const {
        const long L = (long)i * G + c; if (L >= nwg) return false;
        int wgid = (int)L; { const int q = nwg / NXCD, r = nwg % NXCD, xcd = wgid % NXCD, off = wgid / NXCD; wgid = (xcd < r ? xcd * (q + 1) : r * (q + 1) + (xcd - r) * q) + off; }
        const int nig = WGM * nN, gid = wgid / nig, fm = gid * WGM, gsz = (nM - fm) < WGM ? (nM - fm) : WGM;
        u.pm = fm + ((wgid % nig) % gsz); u.pn = (wgid % nig) / gsz; return true;
    }
    __device__ __forceinline__ void a_ready(const Unit&) const {}
    __device__ __forceinline__ void done(const Unit&) const {}
};

__device__ __forceinline__ unsigned cvt_pk_bf16(float lo, float hi) { unsigned r; asm volatile("v_cvt_pk_bf16_f32 %0, %1, %2" : "=v"(r) : "v"(lo), "v"(hi)); return r; }
typedef float f32x2 __attribute__((ext_vector_type(2)));
__device__ __forceinline__ f32x2 gelu_pk(f32x2 v) {
    const f32x2 av = __builtin_elementwise_abs(v), d = av * 0.2316418882f + 1.0f;
    f32x2 t; t.x = __builtin_amdgcn_rcpf(d.x); t.y = __builtin_amdgcn_rcpf(d.y);
    f32x2 q = t * 0.5307027145f + (-0.7265760135f); q = q * t + 0.7107068705f; q = q * t + (-0.142248368f); q = q * t + 0.127414796f; q = q * t;
    const f32x2 s = (v * v) * (-0.72134752044f);
    f32x2 e; e.x = __builtin_amdgcn_exp2f(s.x); e.y = __builtin_amdgcn_exp2f(s.y);
    const f32x2 m = v * (q * e), r = v - m;
    f32x2 o; o.x = v.x < 0.f ? m.x : r.x; o.y = v.y < 0.f ? m.y : r.y; return o;
}

template <class Epi, class Sched, bool ALIGN_EPI = false, bool SP2 = false>
__device__ __forceinline__ void gemm_phase(PG8_LAS unsigned char* lds, const Gemm g, const Sched& S, const Epi& E) {
    const int tid = tid_opaque(), wid = __builtin_amdgcn_readfirstlane(tid >> 6), lane = tid & 63, wr = wid >> 2, wc = wid & 3, fr = lane & 15, fq = lane >> 4;
    const int K = g.K, nt = K / BK;
    unsigned voffA[2], voffB[2];
#pragma unroll
    for (int i = 0; i < 2; ++i) { int R, C; stage_rc(tid * 16 + i * 8192, R, C); const int Rb = Epi::PERM ? ((R & ~31) + perm32(R & 31)) : R;
        voffA[i] = (unsigned)(R * K + C) * 2u; voffB[i] = (unsigned)(Rb * K + C) * 2u; }
    const size_t kstep = (size_t)(BK * 2);
    const size_t hstep = (size_t)HALF * K * 2;
    const size_t tstep = 2 * hstep;
    const unsigned ldsw = (unsigned)wid * 1024u;
    const int aoff = lds_byte(wr * 64 + fr, fq * 8), boff = lds_byte(wc * 32 + fr, fq * 8);
#define PG8_SA(b, h) (((b) * 2 + (h)) * HTB)
#define PG8_SB(b, h) ((4 + (b) * 2 + (h)) * HTB)
#define PG8_STAGE(bufoff, gbase, voff) do { _Pragma("unroll") for (int _i = 0; _i < 2; ++_i) \
        __builtin_amdgcn_global_load_lds((const unsigned*)((const char*)(gbase) + (voff)[_i]), (PG8_LAS unsigned*)(lds + (bufoff) + ldsw + _i * 8192), 16, 0, 0); } while (0)
#define PG8_LDA(dst, b, h) do { _Pragma("unroll") for (int m = 0; m < 4; ++m) _Pragma("unroll") for (int k = 0; k < 2; ++k) dst[m][k] = *(const PG8_LAS bf16x8*)(lds + PG8_SA(b, h) + aoff + m * 2048 + k * 1024); } while (0)
#define PG8_LDB(dst, b, h) do { _Pragma("unroll") for (int n = 0; n < 2; ++n) _Pragma("unroll") for (int k = 0; k < 2; ++k) dst[n][k] = *(const PG8_LAS bf16x8*)(lds + PG8_SB(b, h) + boff + n * 2048 + k * 1024); } while (0)
#define PG8_MMA(ai, bj, At, Bt) do { __builtin_amdgcn_s_setprio(1); _Pragma("unroll") for (int m = 0; m < 4; ++m) _Pragma("unroll") for (int n = 0; n < 2; ++n) _Pragma("unroll") for (int k = 0; k < 2; ++k) \
        acc[ai][bj][m][n] = __builtin_amdgcn_mfma_f32_16x16x32_bf16(Bt[n][k], At[m][k], acc[ai][bj][m][n], 0, 0, 0); __builtin_amdgcn_s_setprio(0); } while (0)
#define PG8_WAIT_V(n) asm volatile("s_waitcnt vmcnt(" #n ")" ::: "memory")
#define PG8_WAIT_L(n) asm volatile("s_waitcnt lgkmcnt(" #n ")" ::: "memory")
#define PG8_BAR __builtin_amdgcn_s_barrier()
#define PG8_SCHED __builtin_amdgcn_sched_barrier(0)
    Unit cur, nxt; int ui = 0;
    if (!S.next(0, cur)) return;
    f32x4 acc[2][2][4][2];
#pragma unroll
    for (int a = 0; a < 2; ++a)
#pragma unroll
        for (int b = 0; b < 2; ++b)
#pragma unroll
            for (int m = 0; m < 4; ++m)
#pragma unroll
                for (int n = 0; n < 2; ++n) acc[a][b][m][n] = (f32x4){0.f, 0.f, 0.f, 0.f};
    bf16x8 At[4][2], B0[2][2], B1[2][2];
    const char* cA = (const char*)g.A + (size_t)cur.pm * tstep; const char* cB = (const char*)g.Bt + (size_t)cur.pn * tstep;
    S.a_ready(cur);
    if constexpr (SP2) {
        PG8_STAGE(PG8_SB(0, 0), cB, voffB); PG8_STAGE(PG8_SB(0, 1), cB + hstep, voffB); PG8_STAGE(PG8_SA(0, 0), cA, voffA); PG8_STAGE(PG8_SA(0, 1), cA + hstep, voffA);
        if (wr == 1) PG8_BAR;
        PG8_WAIT_V(2); PG8_BAR;
        PG8_STAGE(PG8_SB(1, 0), cB + kstep, voffB); PG8_STAGE(PG8_SA(1, 0), cA + kstep, voffA); PG8_STAGE(PG8_SB(1, 1), cB + hstep + kstep, voffB);
        PG8_WAIT_V(6); PG8_BAR;
    } else {
        PG8_STAGE(PG8_SB(0, 0), cB, voffB); PG8_STAGE(PG8_SA(0, 0), cA, voffA); PG8_STAGE(PG8_SB(0, 1), cB + hstep, voffB); PG8_STAGE(PG8_SA(0, 1), cA + hstep, voffA);
        if (wr == 1) PG8_BAR;
        PG8_WAIT_V(4); PG8_BAR;
        PG8_STAGE(PG8_SB(1, 0), cB + kstep, voffB); PG8_STAGE(PG8_SA(1, 0), cA + kstep, voffA); PG8_STAGE(PG8_SB(1, 1), cB + hstep + kstep, voffB);
        PG8_WAIT_V(6); PG8_BAR;
    }
    for (;;) {
        const bool has_next = S.next(ui + 1, nxt);
        const char* nA = has_next ? (const char*)g.A + (size_t)nxt.pm * tstep : cA; const char* nB = has_next ? (const char*)g.Bt + (size_t)nxt.pn * tstep : cB;
        for (int t = 0; t < nt; t += 2) {
            const bool last = (t == nt - 2);
            const char* a1 = cA + (size_t)(t + 1) * kstep;
            const char* a2 = last ? nA : cA + (size_t)(t + 2) * kstep; const char* b2 = last ? nB : cB + (size_t)(t + 2) * kstep;
            const char* a3 = a2 + kstep; const char* b3 = b2 + kstep;
            if (last && has_next) S.a_ready(nxt);
            if constexpr (SP2) {
            PG8_LDB(B0, 0, 0); PG8_LDB(B1, 0, 1); PG8_SCHED; PG8_LDA(At, 0, 0); PG8_STAGE(PG8_SA(1, 1), a1 + hstep, voffA);
            PG8_WAIT_V(8); PG8_WAIT_L(0); PG8_BAR; PG8_MMA(0, 0, At, B0); PG8_MMA(0, 1, At, B1); PG8_BAR; PG8_SCHED;
            PG8_LDA(At, 0, 1); PG8_STAGE(PG8_SB(0, 0), b2, voffB); PG8_STAGE(PG8_SB(0, 1), b2 + hstep, voffB); PG8_STAGE(PG8_SA(0, 0), a2, voffA);
            PG8_WAIT_V(8); PG8_WAIT_L(0); PG8_BAR; PG8_MMA(1, 0, At, B0); PG8_MMA(1, 1, At, B1); PG8_BAR; PG8_SCHED;
            PG8_LDB(B0, 1, 0); PG8_LDB(B1, 1, 1); PG8_SCHED; PG8_LDA(At, 1, 0); PG8_STAGE(PG8_SA(0, 1), a2 + hstep, voffA);
            PG8_WAIT_V(8); PG8_WAIT_L(0); PG8_BAR; PG8_MMA(0, 0, At, B0); PG8_MMA(0, 1, At, B1); PG8_BAR; PG8_SCHED;
            PG8_LDA(At, 1, 1); PG8_STAGE(PG8_SB(1, 0), b3, voffB); PG8_STAGE(PG8_SB(1, 1), b3 + hstep, voffB); PG8_STAGE(PG8_SA(1, 0), a3, voffA);
            PG8_WAIT_V(8); PG8_WAIT_L(0); PG8_BAR; PG8_MMA(1, 0, At, B0); PG8_MMA(1, 1, At, B1); PG8_BAR; PG8_SCHED;
            } else {
            PG8_LDB(B0, 0, 0); PG8_SCHED; PG8_LDA(At, 0, 0); PG8_STAGE(PG8_SA(1, 1), a1 + hstep, voffA);
            PG8_WAIT_L(8); PG8_BAR; PG8_WAIT_L(0); PG8_MMA(0, 0, At, B0); PG8_BAR; PG8_SCHED;
            PG8_LDB(B1, 0, 1); PG8_STAGE(PG8_SB(0, 0), b2, voffB);
            PG8_BAR; PG8_WAIT_L(0); PG8_MMA(0, 1, At, B1); PG8_BAR;
            PG8_LDA(At, 0, 1); PG8_STAGE(PG8_SA(0, 0), a2, voffA);
            PG8_BAR; PG8_WAIT_L(0); PG8_MMA(1, 0, At, B0); PG8_BAR; PG8_SCHED;
            PG8_STAGE(PG8_SB(0, 1), b2 + hstep, voffB);
            PG8_WAIT_V(6); PG8_BAR; PG8_MMA(1, 1, At, B1); PG8_BAR;
            PG8_LDB(B0, 1, 0); PG8_SCHED; PG8_LDA(At, 1, 0); PG8_STAGE(PG8_SA(0, 1), a2 + hstep, voffA);
            PG8_WAIT_L(8); PG8_BAR; PG8_WAIT_L(0); PG8_MMA(0, 0, At, B0); PG8_BAR; PG8_SCHED;
            PG8_LDB(B1, 1, 1); PG8_STAGE(PG8_SB(1, 0), b3, voffB);
            PG8_BAR; PG8_WAIT_L(0); PG8_MMA(0, 1, At, B1); PG8_BAR;
            PG8_LDA(At, 1, 1); PG8_STAGE(PG8_SA(1, 0), a3, voffA);
            PG8_BAR; PG8_WAIT_L(0); PG8_MMA(1, 0, At, B0); PG8_BAR; PG8_SCHED;
            PG8_STAGE(PG8_SB(1, 1), b3 + hstep, voffB);
            PG8_WAIT_V(6); PG8_BAR; PG8_MMA(1, 1, At, B1); PG8_BAR;
            }
        }
        if constexpr (ALIGN_EPI) { if (wr == 0) PG8_BAR; }
        if constexpr (!Epi::AFTER_DRAIN) { E(acc, cur, wr, wc, fr, fq); S.done(cur); }
        if (!has_next) break;
#pragma unroll
        for (int a = 0; a < 2; ++a)
#pragma unroll
            for (int b = 0; b < 2; ++b)
#pragma unroll
                for (int m = 0; m < 4; ++m)
#pragma unroll
                    for (int n = 0; n < 2; ++n) acc[a][b][m][n] = (f32x4){0.f, 0.f, 0.f, 0.f};
        cur = nxt; cA = nA; cB = nB; ++ui;
        if constexpr (ALIGN_EPI) { if (wr == 1) PG8_BAR; }
    }
    PG8_WAIT_V(0);
    if constexpr (!ALIGN_EPI) { if (wr == 0) PG8_BAR; }
    PG8_BAR;
    if constexpr (Epi::AFTER_DRAIN) { E.fused(acc, cur, wr, wc, fr, fq, lds, wid, lane); S.done(cur); }
#undef PG8_SA
#undef PG8_SB
#undef PG8_STAGE
#undef PG8_LDA
#undef PG8_LDB
#undef PG8_MMA
#undef PG8_WAIT_V
#undef PG8_WAIT_L
#undef PG8_BAR
#undef PG8_SCHED
}
}

struct Args { const float* in[38]; float* out; unsigned char* ws; int ph_lo, ph_hi; };
#define INP(k) as_global(IN[k])
#define AIN(k) as_global(A.in[k])
enum { I_X = 0, I_C, I_CTX, I_CCTX, I_N1G, I_N2G, I_ADAW, I_ADAB, I_EVWIN, I_EVWOUT, I_RWMU, I_RWW0, I_RWW2, I_RWA0, I_RWA2, I_RWG2, I_RWKK, I_RWKA, I_RWRK,
       I_GNW, I_GNB, I_QN, I_KN, I_LAM, I_SUBLN, I_SGWIN, I_SGBIN, I_SGLNG, I_SGLNB, I_SGWS, I_SGBS, I_SGWOUT, I_RTW, I_RTB, I_W1, I_B1, I_W2, I_B2 };

struct Tok { int b, t, T, modrow; };
__device__ __forceinline__ Tok tokinfo(int g) {
    Tok k;
    if (g < NCTX) { k.b = g >> 8; k.t = g & 255; k.T = TC; k.modrow = 16; }
    else { const int q = g - NCTX; k.b = q >> 11; k.t = q & 2047; k.T = TL; k.modrow = k.b; }
    return k;
}

template <int MAP>
__device__ __forceinline__ void p0_transpose_item(const float* W, int K, int N, bf16_t* WT, LAS float* scr, int item, int lane) {
    const int nblk = N / 32, kb = item / nblk, nb = item % nblk, k0 = 64 * kb, n0 = 32 * nb;
    const int d0 = MAP ? (256 * ((n0 & 1023) >> 7) + 128 * (n0 >> 10) + (n0 & 127)) : n0;
#pragma unroll 8
    for (int i = 0; i < 32; ++i) { const int kk = 2 * i + (lane >> 5); scr[kk * 33 + (lane & 31)] = W[(size_t)(k0 + kk) * N + n0 + (lane & 31)]; }
    asm volatile("s_waitcnt lgkmcnt(0)" ::: "memory");
    const int c = lane & 7;
#pragma unroll
    for (int j = 0; j < 4; ++j) { const int n = (lane >> 3) + 8 * j; const LAS float* s = scr + (8 * c) * 33 + n;
        u32x4 o; o.x = pk2(s[0 * 33], s[1 * 33]); o.y = pk2(s[2 * 33], s[3 * 33]); o.z = pk2(s[4 * 33], s[5 * 33]); o.w = pk2(s[6 * 33], s[7 * 33]);
        *(u32x4*)(WT + (size_t)(d0 + n) * K + k0 + 8 * c) = o; }
    asm volatile("s_waitcnt lgkmcnt(0)" ::: "memory");
}

__device__ __forceinline__ void ph_prologue(const Args& A, LAS unsigned char* lds, int bid, int nb) {
    const int tid = tid_opaque(), lane = tid & 63, wid = tid >> 6;
    unsigned char* ws = opq(A.ws);
    if (bid == 0 && tid < 39) ((const float**)(ws + WS_PTRS))[tid] = (tid < 38) ? A.in[tid] : (const float*)A.out;
    {
        LAS float* s = (LAS float*)lds;
        LAS float* red = (LAS float*)(lds + 17 * 1024 * 4);
        for (int i = tid; i < 17 * 1024; i += NTHREADS) {
            const int r = i >> 10, k = i & 1023;
            const float x = (r < 16) ? AIN(I_C)[r * 1024 + k] : AIN(I_CCTX)[k];
            s[i] = x / (1.0f + __expf(-x));
        }
        __syncthreads();
        float* mod = (float*)(ws + WS_MOD);
        for (int u = bid; u < 4 * 96; u += nb) {
            const int l = u / 96, cg = u % 96, col = cg * 64 + lane;
            float acc[17];
#pragma unroll
            for (int r = 0; r < 17; ++r) acc[r] = 0.f;
            const float* wp = AIN(I_ADAW) + (size_t)l * 1024 * 6144 + col;
            for (int k = wid * 128; k < wid * 128 + 128; ++k) {
                const float wv = wp[(size_t)k * 6144];
#pragma unroll
                for (int r = 0; r < 17; ++r) acc[r] += s[r * 1024 + k] * wv;
            }
#pragma unroll
            for (int r = 0; r < 17; ++r) red[(wid * 17 + r) * 64 + lane] = acc[r];
            __syncthreads();
            for (int i = tid; i < 17 * 64; i += NTHREADS) {
                const int r = i >> 6, ln = i & 63; float v = 0.f;
#pragma unroll
                for (int w = 0; w < 8; ++w) v += red[(w * 17 + r) * 64 + ln];
                const int cc = cg * 64 + ln;
                mod[((size_t)l * 17 + r) * 6144 + cc] = v + AIN(I_ADAB)[l * 6144 + cc];
            }
            __syncthreads();
        }
    }
    __syncthreads();
    {
        LAS float* scr = (LAS float*)(lds + wid * 16384);
        const int gw = bid * NWAVES + wid, NGW = nb * NWAVES;
        constexpr int IT_WIN = 16 * (EVC / 32), IT_SQ = 16 * 32, IT_SGIN = 16 * 64, IT_W1 = 16 * 64, IT_W2 = 16 * 32;
        constexpr int N0 = 2 * IT_WIN, N1 = N0 + 2 * IT_SQ, N2 = N1 + 2 * IT_SGIN, N3 = N2 + 2 * IT_SQ, N4 = N3 + 128 * IT_W1, N5 = N4 + 128 * IT_W2;
        for (int it = gw; it < N5; it += NGW) {
            if (it < N0) { const int m = it / IT_WIN, r = it % IT_WIN; p0_transpose_item<0>(AIN(I_EVWIN) + (size_t)m * DM * EVC, DM, EVC, (bf16_t*)(ws + WS_WIN) + (size_t)m * ZLD * DM, scr, r, lane); }
            else if (it < N1) { const int q = it - N0, m = q / IT_SQ, r = q % IT_SQ; p0_transpose_item<0>(AIN(I_EVWOUT) + (size_t)m * DM * DM, DM, DM, (bf16_t*)(ws + WS_WOUT) + (size_t)m * DM * DM, scr, r, lane); }
            else if (it < N2) { const int q = it - N1, m = q / IT_SGIN, r = q % IT_SGIN; p0_transpose_item<0>(AIN(I_SGWIN) + (size_t)m * DM * 2048, DM, 2048, (bf16_t*)(ws + WS_SGIN) + (size_t)m * 2048 * DM, scr, r, lane); }
            else if (it < N3) { const int q = it - N2, m = q / IT_SQ, r = q % IT_SQ; p0_transpose_item<0>(AIN(I_SGWOUT) + (size_t)m * DM * DM, DM, DM, (bf16_t*)(ws + WS_SGOUT) + (size_t)m * DM * DM, scr, r, lane); }
            else if (it < N4) { const int q = it - N3, m = q / IT_W1, r = q % IT_W1; p0_transpose_item<1>(AIN(I_W1) + (size_t)m * DM * 2048, DM, 2048, (bf16_t*)(ws + WS_W1) + (size_t)m * 2048 * DM, scr, r, lane); }
            else { const int q = it - N4, m = q / IT_W2, r = q % IT_W2; p0_transpose_item<0>(AIN(I_W2) + (size_t)m * DM * DM, DM, DM, (bf16_t*)(ws + WS_W2) + (size_t)m * DM * DM, scr, r, lane); }
        }
    }
    {
        const size_t gt = (size_t)bid * NTHREADS + tid, GT = (size_t)nb * NTHREADS;
        f32x4* H4 = (f32x4*)(ws + WS_H);
        const f32x4* c4 = (const f32x4*)AIN(I_CTX); const f32x4* x4 = (const f32x4*)AIN(I_X);
        constexpr size_t NC4 = (size_t)NCTX * DM / 4, NT4 = (size_t)NTOK * DM / 4;
        for (size_t i = gt; i < NT4; i += GT) H4[i] = (i < NC4) ? c4[i] : x4[i - NC4];
        for (size_t i = gt; i < (size_t)2 * 128 * DM / 8; i += GT) { const size_t m = i / (128 * DM / 8), r = i % (128 * DM / 8); ((u32x4*)((bf16_t*)(ws + WS_WIN) + (m * ZLD + EVC) * DM))[r] = (u32x4){0u, 0u, 0u, 0u}; }
        float* rt = (float*)(ws + WS_RTWT);
        for (size_t i = gt; i < (size_t)4 * 32 * 1024; i += GT) { const int l = (int)(i >> 15), e = (int)(i >> 10) & 31, k = (int)i & 1023; rt[i] = AIN(I_RTW)[((size_t)l * 1024 + k) * 32 + e]; }
    }
}

template <bool ROUTER>
__device__ __forceinline__ void ph_norm(const Args& A, int l, int row_lo, LAS unsigned char* lds, int bid, int nb) {
    unsigned char* ws = opq(A.ws); const float* const* IN = (const float* const*)(ws + WS_PTRS); (void)IN;
    const int tid = tid_opaque(), lane = tid & 63, wid = tid >> 6;
    const float* H = (const float*)(ws + WS_H);
    const float* mod = (const float*)(ws + WS_MOD);
    bf16_t* abf = (bf16_t*)(ws + WS_ABF);
    const float* gp = INP(ROUTER ? I_N2G : I_N1G) + l * 1024;
    const int c_shift = ROUTER ? 3 : 0, c_scale = ROUTER ? 4 : 1;
    LAS float* rtl = (LAS float*)lds;
    LAS int* hist = (LAS int*)(lds + 131072);
    float rtb = 0.f;
    if constexpr (ROUTER) {
        const f32x4* rt4 = (const f32x4*)((const float*)(ws + WS_RTWT) + (size_t)l * 32 * 1024);
        for (int i = tid; i < 32 * 1024 / 4; i += NTHREADS) ((LAS f32x4*)rtl)[i] = rt4[i];
        if (tid < 32) hist[tid] = 0;
        rtb = INP(I_RTB)[l * 32 + (lane >> 1)];
        __syncthreads();
    }
    for (int row = row_lo + bid * NWAVES + wid; row < NTOK; row += nb * NWAVES) {
        const Tok tk = tokinfo(row);
        const float* mrow = mod + ((size_t)l * 17 + tk.modrow) * 6144;
        f32x4 v[4]; float ss = 0.f;
#pragma unroll
        for (int j = 0; j < 4; ++j) { v[j] = *(const f32x4*)(H + (size_t)row * DM + j * 256 + lane * 4); ss += (v[j].x * v[j].x + v[j].y * v[j].y) + (v[j].z * v[j].z + v[j].w * v[j].w); }
        const float rstd = rsqrtf(wave_sum(ss) * (1.0f / DM) + 1e-6f);
#pragma unroll
        for (int j = 0; j < 4; ++j) {
            const int col = j * 256 + lane * 4;
            const f32x4 g = *(const f32x4*)(gp + col), sc = *(const f32x4*)(mrow + c_scale * 1024 + col), sh = *(const f32x4*)(mrow + c_shift * 1024 + col);
            v[j] = (v[j] * rstd * g) * (sc + 1.0f) + sh;
            u32x2 o; o.x = pk2(v[j].x, v[j].y); o.y = pk2(v[j].z, v[j].w);
            *(u32x2*)(abf + (size_t)row * DM + col) = o;
        }
        if constexpr (ROUTER) {
            float p[32];
#pragma unroll
            for (int e = 0; e < 32; ++e) {
                float acc = 0.f;
#pragma unroll
                for (int j = 0; j < 4; ++j) { const f32x4 w = *(const LAS f32x4*)(rtl + e * 1024 + j * 256 + lane * 4); acc += (v[j].x * w.x + v[j].y * w.y) + (v[j].z * w.z + v[j].w * w.w); }
                p[e] = acc;
            }
#define RS_STEP(N, OFF) _Pragma("unroll") for (int i = 0; i < (N); ++i) { const bool up = (lane & (OFF)) != 0; const float send = up ? p[i] : p[i + (N)], keep = up ? p[i + (N)] : p[i]; p[i] = keep + __shfl_xor(send, (OFF)); }
            RS_STEP(16, 32) RS_STEP(8, 16) RS_STEP(4, 8) RS_STEP(2, 4) RS_STEP(1, 2)
#undef RS_STEP
            const float mylg = p[0] + __shfl_xor(p[0], 1) + rtb;
            float tv[4] = {-3.0e38f, -3.0e38f, -3.0e38f, -3.0e38f}; int ti[4] = {0, 0, 0, 0};
#pragma unroll
            for (int e = 0; e < 32; ++e) {
                const float lgv = rdl(mylg, 2 * e);
                if (lgv > tv[3]) {
                    tv[3] = lgv; ti[3] = e;
                    if (tv[3] > tv[2]) { const float a = tv[2]; tv[2] = tv[3]; tv[3] = a; const int b = ti[2]; ti[2] = ti[3]; ti[3] = b; }
                    if (tv[2] > tv[1]) { const float a = tv[1]; tv[1] = tv[2]; tv[2] = a; const int b = ti[1]; ti[1] = ti[2]; ti[2] = b; }
                    if (tv[1] > tv[0]) { const float a = tv[0]; tv[0] = tv[1]; tv[1] = a; const int b = ti[0]; ti[0] = ti[1]; ti[1] = b; }
                }
            }
            const float e1 = __expf(tv[1] - tv[0]), e2 = __expf(tv[2] - tv[0]), e3 = __expf(tv[3] - tv[0]);
            const float inv = 1.0f / (1.0f + e1 + e2 + e3);
            if (lane == 0) {
                int* te = (int*)(ws + WS_TOKE) + (size_t)row * 4; float* tg = (float*)(ws + WS_TOKG) + (size_t)row * 4; int* tr = (int*)(ws + WS_TOKR) + (size_t)row * 4;
                te[0] = ti[0]; te[1] = ti[1]; te[2] = ti[2]; te[3] = ti[3];
                tg[0] = inv; tg[1] = e1 * inv; tg[2] = e2 * inv; tg[3] = e3 * inv;
#pragma unroll
                for (int k = 0; k < 4; ++k) tr[k] = __hip_atomic_fetch_add(hist + ti[k], 1, __ATOMIC_RELAXED, __HIP_MEMORY_SCOPE_WORKGROUP);
            }
        }
    }
    if constexpr (ROUTER) {
        __syncthreads();
        if (tid < 32) ((int*)(ws + WS_BCNT))[((size_t)l * 256 + bid) * 32 + tid] = hist[tid];
    }
}

__device__ __forceinline__ void gemm_tile128(const bf16_t* At, int lda, const bf16_t* Bt, int ldb, int K, f32x4 (&acc)[4][2]) {
    const int tid = tid_opaque(), wid = tid >> 6, lane = tid & 63, wr = wid >> 2, wc = wid & 3, fr = lane & 15, fq = lane >> 4;
    const bf16_t* a0 = At + (size_t)(wr * 64 + fr) * lda + fq * 8;
    const bf16_t* b0 = Bt + (size_t)(wc * 32 + fr) * ldb + fq * 8;
#pragma unroll
    for (int i = 0; i < 4; ++i)
#pragma unroll
        for (int j = 0; j < 2; ++j) acc[i][j] = (f32x4){0.f, 0.f, 0.f, 0.f};
#pragma unroll 2
    for (int k = 0; k < K; k += 32) {
        bf16x8 af[4], bfr[2];
#pragma unroll
        for (int i = 0; i < 4; ++i) af[i] = *(const bf16x8*)(a0 + (size_t)i * 16 * lda + k);
#pragma unroll
        for (int j = 0; j < 2; ++j) bfr[j] = *(const bf16x8*)(b0 + (size_t)j * 16 * ldb + k);
#pragma unroll
        for (int i = 0; i < 4; ++i)
#pragma unroll
            for (int j = 0; j < 2; ++j) acc[i][j] = __builtin_amdgcn_mfma_f32_16x16x32_bf16(bfr[j], af[i], acc[i][j], 0, 0, 0);
    }
}
#define TILE_COORDS const int _tid = tid_opaque(), _wid = _tid >> 6, _lane = _tid & 63, _wr = _wid >> 2, _wc = _wid & 3, _fr = _lane & 15, _fq = _lane >> 4
#define TILE_ROW(i) (_wr * 64 + (i) * 16 + _fr)
#define TILE_COL(j) (_wc * 32 + (j) * 16 + _fq * 4)

typedef pg8::f32x4 (&AccRef)[2][2][4][2];
struct EpiStoreBf16 {
    static constexpr bool PERM = true, AFTER_DRAIN = false;
    bf16_t* O; int ldc;
    __device__ __forceinline__ void operator()(const pg8::f32x4 (&acc)[2][2][4][2], const pg8::Unit& u, int wr, int wc, int fr, int fq) const {
        const int row0 = u.pm * 256 + wr * 64 + fr, col0 = u.pn * 256 + wc * 32 + 8 * fq;
#pragma unroll
        for (int ai = 0; ai < 2; ++ai)
#pragma unroll
            for (int m = 0; m < 4; ++m) { bf16_t* rowp = O + (size_t)(row0 + ai * 128 + m * 16) * ldc + col0;
#pragma unroll
                for (int bj = 0; bj < 2; ++bj) { const pg8::f32x4 v0 = acc[ai][bj][m][0], v1 = acc[ai][bj][m][1];
                    u32x4 w; w.x = cvtpk_s(v0[0], v0[1]); w.y = cvtpk_s(v0[2], v0[3]); w.z = cvtpk_s(v1[0], v1[1]); w.w = cvtpk_s(v1[2], v1[3]);
                    *(u32x4*)(rowp + bj * 128) = w; } }
    }
};
struct EpiGeluBf16 {
    static constexpr bool PERM = true, AFTER_DRAIN = false;
    bf16_t* O; int ldc; const float* bias;
    __device__ __forceinline__ void operator()(const pg8::f32x4 (&acc)[2][2][4][2], const pg8::Unit& u, int wr, int wc, int fr, int fq) const {
        const int row0 = u.pm * 256 + wr * 64 + fr, col0 = u.pn * 256 + wc * 32 + 8 * fq;
        pg8::f32x4 bv[2][2];
#pragma unroll
        for (int bj = 0; bj < 2; ++bj)
#pragma unroll
            for (int n = 0; n < 2; ++n) bv[bj][n] = *(const pg8::f32x4*)(bias + col0 + bj * 128 + 4 * n);
#pragma unroll
        for (int ai = 0; ai < 2; ++ai)
#pragma unroll
            for (int m = 0; m < 4; ++m) { bf16_t* rowp = O + (size_t)(row0 + ai * 128 + m * 16) * ldc + col0;
#pragma unroll
                for (int bj = 0; bj < 2; ++bj) { pg8::f32x4 v0 = acc[ai][bj][m][0] + bv[bj][0], v1 = acc[ai][bj][m][1] + bv[bj][1];
                    const pg8::f32x2 a = pg8::gelu_pk((pg8::f32x2){v0[0], v0[1]}), b = pg8::gelu_pk((pg8::f32x2){v0[2], v0[3]}), c = pg8::gelu_pk((pg8::f32x2){v1[0], v1[1]}), d = pg8::gelu_pk((pg8::f32x2){v1[2], v1[3]});
                    u32x4 w; w.x = cvtpk_s(a.x, a.y); w.y = cvtpk_s(b.x, b.y); w.z = cvtpk_s(c.x, c.y); w.w = cvtpk_s(d.x, d.y);
                    *(u32x4*)(rowp + bj * 128) = w; } }
    }
};
struct EpiResidual {
    static constexpr bool PERM = false, AFTER_DRAIN = false;
    float* H; const float* gate0; int row_base;
    __device__ __forceinline__ void operator()(const pg8::f32x4 (&acc)[2][2][4][2], const pg8::Unit& u, int wr, int wc, int fr, int fq) const {
        const int row0 = u.pm * 256 + wr * 64 + fr, col0 = u.pn * 256 + wc * 32 + 4 * fq;
        const Tok tk = tokinfo(row_base + u.pm * 256);
        const float* gate = gate0 + (size_t)tk.modrow * 6144 + col0;
        pg8::f32x4 gv[2][2];
#pragma unroll
        for (int bj = 0; bj < 2; ++bj)
#pragma unroll
            for (int n = 0; n < 2; ++n) gv[bj][n] = *(const pg8::f32x4*)(gate + bj * 128 + n * 16);
#pragma unroll
        for (int ai = 0; ai < 2; ++ai)
#pragma unroll
            for (int m = 0; m < 4; ++m) { float* rowp = H + (size_t)(row0 + ai * 128 + m * 16) * DM + col0;
#pragma unroll
                for (int bj = 0; bj < 2; ++bj)
#pragma unroll
                    for (int n = 0; n < 2; ++n) { pg8::f32x4* p = (pg8::f32x4*)(rowp + bj * 128 + n * 16); *p = *p + gv[bj][n] * acc[ai][bj][m][n]; } }
    }
};
struct ListOrder {
    const LAS int* list; int n;
    __device__ __forceinline__ bool next(int i, pg8::Unit& u) const {
        if (i >= n) return false;
        u.pm = __builtin_amdgcn_readfirstlane(list[2 * i]); u.pn = __builtin_amdgcn_readfirstlane(list[2 * i + 1]); return true;
    }
    __device__ __forceinline__ void a_ready(const pg8::Unit&) const {}
    __device__ __forceinline__ void done(const pg8::Unit&) const {}
};
constexpr int LDS_TAB = 131072;
constexpr int LDS_LIST = LDS_TAB + 4096;
__device__ __forceinline__ ListOrder build_units(LAS unsigned char* lds, int nM, int nN, int G, int c, const LAS int* tile_e, int ncol) {
    LAS int* list = (LAS int*)(lds + LDS_LIST);
    pg8::StaticOrder S; S.nM = nM; S.nN = nN; S.nwg = nM * nN; S.G = G; S.c = c;
    const int tid = tid_opaque();
    if (tid < 64) { pg8::Unit u; if (S.next(tid, u)) { if (tile_e) u.pn = tile_e[u.pm] * ncol + u.pn; list[2 * tid] = u.pm; list[2 * tid + 1] = u.pn; } }
    __syncthreads();
    ListOrder L; L.list = list; L.n = (c < S.nwg) ? (S.nwg - c + G - 1) / G : 0;
    return L;
}
struct EpiMoe1 {
    static constexpr bool PERM = true, AFTER_DRAIN = false;
    bf16_t* O; const float* b1;
    __device__ __forceinline__ void operator()(const pg8::f32x4 (&acc)[2][2][4][2], const pg8::Unit& u, int wr, int wc, int fr, int fq) const {
        const int e = u.pn >> 3, pn = u.pn & 7;
        const int row0 = u.pm * 256 + wr * 64 + fr, ci = pn * 128 + wc * 32 + 8 * fq;
        const float* be = b1 + (size_t)e * 2048 + ci;
        const pg8::f32x4 bg0 = *(const pg8::f32x4*)(be), bg1 = *(const pg8::f32x4*)(be + 4), bl0 = *(const pg8::f32x4*)(be + 1024), bl1 = *(const pg8::f32x4*)(be + 1028);
#pragma unroll
        for (int ai = 0; ai < 2; ++ai)
#pragma unroll
            for (int m = 0; m < 4; ++m) {
                const pg8::f32x4 g0 = acc[ai][0][m][0] + bg0, g1 = acc[ai][0][m][1] + bg1, l0 = acc[ai][1][m][0] + bl0, l1 = acc[ai][1][m][1] + bl1;
                float o[8];
#pragma unroll
                for (int r = 0; r < 4; ++r) {
                    const float ga = fminf(g0[r], 7.0f), gb = fminf(g1[r], 7.0f);
                    const float la = fminf(fmaxf(l0[r], -7.0f), 7.0f), lb = fminf(fmaxf(l1[r], -7.0f), 7.0f);
                    o[r] = ga * __builtin_amdgcn_rcpf(1.0f + __expf(-1.702f * ga)) * (la + 1.0f);
                    o[4 + r] = gb * __builtin_amdgcn_rcpf(1.0f + __expf(-1.702f * gb)) * (lb + 1.0f);
                }
                u32x4 w; w.x = cvtpk_s(o[0], o[1]); w.y = cvtpk_s(o[2], o[3]); w.z = cvtpk_s(o[4], o[5]); w.w = cvtpk_s(o[6], o[7]);
                *(u32x4*)(O + (size_t)(row0 + ai * 128 + m * 16) * DM + ci) = w;
            }
    }
};
struct EpiMoe2 {
    static constexpr bool PERM = true, AFTER_DRAIN = false;
    bf16_t* O; const float* b2;
    __device__ __forceinline__ void operator()(const pg8::f32x4 (&acc)[2][2][4][2], const pg8::Unit& u, int wr, int wc, int fr, int fq) const {
        const int e = u.pn >> 2, pn = u.pn & 3;
        const int row0 = u.pm * 256 + wr * 64 + fr, col0 = pn * 256 + wc * 32 + 8 * fq;
        const float* be = b2 + (size_t)e * DM + col0;
        pg8::f32x4 bv[2][2];
#pragma unroll
        for (int bj = 0; bj < 2; ++bj)
#pragma unroll
            for (int n = 0; n < 2; ++n) bv[bj][n] = *(const pg8::f32x4*)(be + bj * 128 + 4 * n);
#pragma unroll
        for (int ai = 0; ai < 2; ++ai)
#pragma unroll
            for (int m = 0; m < 4; ++m) { bf16_t* rowp = O + (size_t)(row0 + ai * 128 + m * 16) * DM + col0;
#pragma unroll
                for (int bj = 0; bj < 2; ++bj) { const pg8::f32x4 v0 = acc[ai][bj][m][0] + bv[bj][0], v1 = acc[ai][bj][m][1] + bv[bj][1];
                    u32x4 w; w.x = cvtpk_s(v0[0], v0[1]); w.y = cvtpk_s(v0[2], v0[3]); w.z = cvtpk_s(v1[0], v1[1]); w.w = cvtpk_s(v1[2], v1[3]);
                    *(u32x4*)(rowp + bj * 128) = w; } }
    }
};

namespace att {
typedef float f32x16 __attribute__((ext_vector_type(16)));
typedef short s16x4 __attribute__((ext_vector_type(4)));
constexpr int KVBLK = 64, LDR = 512;
constexpr float SCALE = 0.125f, THR = 8.f;
constexpr int SHM_V = KVBLK * 128 * 2, SHM_K = KVBLK * 64 * 2, SHM_ATTN = 2 * SHM_V + 2 * SHM_K + NWAVES * 64 * 4;
#define ATT_KSWZ(row, colB) ((row) * 128 + ((colB) ^ ((((row) >> 1) & 7) << 4)))
#define ATT_SBAR() __builtin_amdgcn_sched_barrier(0)
__device__ __forceinline__ int crow(int r, int hi) { return (r & 3) + 8 * (r >> 2) + 4 * hi; }
__device__ __forceinline__ unsigned cvtpk(float lo, float hi) { unsigned r; asm volatile("v_cvt_pk_bf16_f32 %0, %1, %2" : "=v"(r) : "v"(lo), "v"(hi)); return r; }
__device__ __forceinline__ void partialSM(f32x16& p0, f32x16& p1, float& m_reg, float& mn, float& alpha) {
    constexpr float C = SCALE * 1.4426950408889634f;
    float pmax = p0[0];
#pragma unroll
    for (int r = 1; r < 16; ++r) pmax = fmaxf(pmax, p0[r]);
#pragma unroll
    for (int r = 0; r < 16; ++r) pmax = fmaxf(pmax, p1[r]);
    { auto rr = __builtin_amdgcn_permlane32_swap(__float_as_uint(pmax), __float_as_uint(pmax), false, false);
      pmax = fmaxf(__uint_as_float(rr[0]), __uint_as_float(rr[1])); }
    if (__builtin_expect(__all(pmax - m_reg <= THR / SCALE), 1)) { mn = m_reg; alpha = 1.f; }
    else { mn = fmaxf(m_reg, pmax); alpha = __builtin_amdgcn_exp2f((m_reg - mn) * C); m_reg = mn; }
    const float mnC = -mn * C;
#pragma unroll
    for (int r = 0; r < 16; ++r) p0[r] = fmaf(p0[r], C, mnC);
#pragma unroll
    for (int r = 0; r < 16; ++r) p1[r] = fmaf(p1[r], C, mnC);
#pragma unroll
    for (int r = 0; r < 16; ++r) p0[r] = __builtin_amdgcn_exp2f(p0[r]);
}
__device__ __forceinline__ void finishSM(f32x16& p0, f32x16& p1, float alpha, float& l_reg, bf16x8& pa0, bf16x8& pa1, bf16x8& pa2, bf16x8& pa3) {
#pragma unroll
    for (int r = 0; r < 16; ++r) p1[r] = __builtin_amdgcn_exp2f(p1[r]);
    float ps = 0;
#pragma unroll
    for (int r = 0; r < 16; ++r) ps += p0[r];
#pragma unroll
    for (int r = 0; r < 16; ++r) ps += p1[r];
    { auto rr = __builtin_amdgcn_permlane32_swap(__float_as_uint(ps), __float_as_uint(ps), false, false);
      ps = __uint_as_float(rr[0]) + __uint_as_float(rr[1]); }
    l_reg = l_reg * alpha + ps;
#define ATT_PK4(P, BASE, OUT) do { unsigned a0 = cvtpk(P[BASE + 0], P[BASE + 1]), a1 = cvtpk(P[BASE + 2], P[BASE + 3]);   \
    unsigned b0 = cvtpk(P[BASE + 4], P[BASE + 5]), b1 = cvtpk(P[BASE + 6], P[BASE + 7]);                              \
    auto r0 = __builtin_amdgcn_permlane32_swap(a0, b0, false, false); auto r1 = __builtin_amdgcn_permlane32_swap(a1, b1, false, false); \
    u32x4 w = {r0[0], r1[0], r0[1], r1[1]}; OUT = __builtin_bit_cast(bf16x8, w); } while (0)
    ATT_PK4(p0, 0, pa0); ATT_PK4(p0, 8, pa1); ATT_PK4(p1, 0, pa2); ATT_PK4(p1, 8, pa3);
#undef ATT_PK4
}
__device__ __forceinline__ void qkt(f32x16& p0, f32x16& p1, const LAS unsigned char* Ks, const bf16x8 (&qr)[4], int r32, int hi) {
    p0 = f32x16{}; p1 = f32x16{};
#pragma unroll
    for (int d0 = 0; d0 < 4; ++d0) { const int cb = (d0 * 16 + hi * 8) * 2;
        const bf16x8 b0 = *(const LAS bf16x8*)(Ks + ATT_KSWZ(r32, cb));
        const bf16x8 b1 = *(const LAS bf16x8*)(Ks + ATT_KSWZ(32 + r32, cb));
        p0 = __builtin_amdgcn_mfma_f32_32x32x16_bf16(b0, qr[d0], p0, 0, 0, 0);
        p1 = __builtin_amdgcn_mfma_f32_32x32x16_bf16(b1, qr[d0], p1, 0, 0, 0); }
}
__device__ __forceinline__ int v_st(int k, int c) { const int kk = (k & ~0xC) | ((k & 4) << 1) | ((k & 8) >> 1); return ((kk >> 3) * 4 + (c >> 5)) * 512 + ((kk & 7) * 32 + (c & 31)) * 2; }
__device__ __forceinline__ int v_rd_base(int lane) { return ((lane & 3) << 3) | (((lane >> 2) & 3) << 6) | (((lane >> 4) & 1) << 5) | (((lane >> 5) & 1) << 8); }
constexpr int v_rd_off(int d0, int ks, int half) { return d0 * 512 + ks * 4096 + half * 2048; }
template <int OFF> __device__ __forceinline__ s16x4 tr_read(int vb) { s16x4 r; asm volatile("ds_read_b64_tr_b16 %0, %1 offset:%2" : "=&v"(r) : "v"(vb), "i"(OFF) : "memory"); return r; }
template <int D0> __device__ __forceinline__ void pv_one(f32x16& od, int vb, bf16x8 pa0, bf16x8 pa1, bf16x8 pa2, bf16x8 pa3) {
    const s16x4 l0 = tr_read<v_rd_off(D0, 0, 0)>(vb), h0 = tr_read<v_rd_off(D0, 0, 1)>(vb), l1 = tr_read<v_rd_off(D0, 1, 0)>(vb), h1 = tr_read<v_rd_off(D0, 1, 1)>(vb);
    const s16x4 l2 = tr_read<v_rd_off(D0, 2, 0)>(vb), h2 = tr_read<v_rd_off(D0, 2, 1)>(vb), l3 = tr_read<v_rd_off(D0, 3, 0)>(vb), h3 = tr_read<v_rd_off(D0, 3, 1)>(vb);
    asm volatile("s_waitcnt lgkmcnt(0)" ::: "memory"); ATT_SBAR();
#define ATT_PK(L, H) (bf16x8){L[0], L[1], L[2], L[3], H[0], H[1], H[2], H[3]}
    od = __builtin_amdgcn_mfma_f32_32x32x16_bf16(pa0, ATT_PK(l0, h0), od, 0, 0, 0);
    od = __builtin_amdgcn_mfma_f32_32x32x16_bf16(pa1, ATT_PK(l1, h1), od, 0, 0, 0);
    od = __builtin_amdgcn_mfma_f32_32x32x16_bf16(pa2, ATT_PK(l2, h2), od, 0, 0, 0);
    od = __builtin_amdgcn_mfma_f32_32x32x16_bf16(pa3, ATT_PK(l3, h3), od, 0, 0, 0);
#undef ATT_PK
}
__device__ __forceinline__ void pv_d0(f32x16 (&o)[4], int vb, bf16x8 pa0, bf16x8 pa1, bf16x8 pa2, bf16x8 pa3) {
    pv_one<0>(o[0], vb, pa0, pa1, pa2, pa3); pv_one<1>(o[1], vb, pa0, pa1, pa2, pa3); pv_one<2>(o[2], vb, pa0, pa1, pa2, pa3); pv_one<3>(o[3], vb, pa0, pa1, pa2, pa3);
}
__device__ __forceinline__ void attn_body(const bf16_t* Qb, const bf16_t* Kh, const bf16_t* Vh, float* Ob, int seq, LAS unsigned char* lds) {
    const int tid = tid_opaque(), wid = tid >> 6, lane = tid & 63, r32 = lane & 31, hi = lane >> 5;
    LAS unsigned char* V_lds = lds; LAS unsigned char* K_lds = lds + 2 * SHM_V;
    LAS float* wsl = (LAS float*)(lds + 2 * SHM_V + 2 * SHM_K) + wid * 64; LAS float* li_l = wsl; LAS float* al_l = wsl + 32;
    float m_reg = -1e30f, l_reg = 0; f32x16 o[4] = {}; bf16x8 qr[4];
    const bf16_t* Qw = Qb + (size_t)(wid * 32 + r32) * LDR + hi * 8;
#pragma unroll
    for (int d0 = 0; d0 < 4; ++d0) qr[d0] = *(const bf16x8*)(Qw + d0 * 16);
    const int sr = tid >> 4, sc = (tid & 15) * 8, vst0 = v_st(sr, sc), vst1 = v_st(32 + sr, sc);
    const int kr = tid >> 3, kc = (tid & 7) * 8, kst = ATT_KSWZ(kr, kc * 2);
    const int vb0 = (int)(uintptr_t)V_lds + v_rd_base(lane);
    bf16x8 vsA0, vsA1, ksA, vsB0, vsB1, ksB;
#define ATT_SLOAD(V0, V1, K0, k0) do { V0 = *(const bf16x8*)(Vh + (size_t)((k0) + sr) * LDR + sc); V1 = *(const bf16x8*)(Vh + (size_t)((k0) + 32 + sr) * LDR + sc); \
    K0 = *(const bf16x8*)(Kh + (size_t)((k0) + kr) * LDR + kc); } while (0)
#define ATT_SWRITE(b, V0, V1, K0) do { *(LAS bf16x8*)(V_lds + (b) * SHM_V + vst0) = V0; *(LAS bf16x8*)(V_lds + (b) * SHM_V + vst1) = V1; \
    *(LAS bf16x8*)(K_lds + (b) * SHM_K + kst) = K0; } while (0)
#define ATT_SWAIT() asm volatile("s_waitcnt vmcnt(3)" ::: "memory")
#define ATT_RESC(a) do { if (__any((a) < 1.f)) { if (hi == 0) al_l[r32] = (a); asm volatile("s_waitcnt lgkmcnt(0)" ::: "memory"); \
    _Pragma("unroll") for (int d = 0; d < 4; ++d) _Pragma("unroll") for (int r = 0; r < 16; ++r) o[d][r] *= al_l[crow(r, hi)]; } } while (0)
    f32x16 pA0, pA1, pB0, pB1; float mnA, mnB, alA, alB; bf16x8 pa0, pa1, pa2, pa3; const int NT = seq / KVBLK;
    ATT_SLOAD(vsA0, vsA1, ksA, 0); asm volatile("s_waitcnt vmcnt(0)" ::: "memory"); ATT_SWRITE(0, vsA0, vsA1, ksA); __syncthreads();
    qkt(pA0, pA1, K_lds, qr, r32, hi); partialSM(pA0, pA1, m_reg, mnA, alA);
    ATT_SLOAD(vsB0, vsB1, ksB, KVBLK); if (2 < NT) ATT_SLOAD(vsA0, vsA1, ksA, 2 * KVBLK);
    ATT_SWAIT(); ATT_SWRITE(1, vsB0, vsB1, ksB); __syncthreads();
    for (int j = 1; j + 1 < NT; j += 2) {
        ATT_SBAR(); qkt(pB0, pB1, K_lds + SHM_K, qr, r32, hi);
        finishSM(pA0, pA1, alA, l_reg, pa0, pa1, pa2, pa3); ATT_SBAR();
        ATT_SLOAD(vsB0, vsB1, ksB, (j + 2) * KVBLK); ATT_SBAR();
        pv_d0(o, vb0, pa0, pa1, pa2, pa3); partialSM(pB0, pB1, m_reg, mnB, alB);
        __syncthreads(); ATT_SWAIT(); ATT_SWRITE(0, vsA0, vsA1, ksA);
        ATT_RESC(alB); __syncthreads();
        ATT_SBAR(); qkt(pA0, pA1, K_lds, qr, r32, hi);
        finishSM(pB0, pB1, alB, l_reg, pa0, pa1, pa2, pa3); ATT_SBAR();
        if (j + 3 < NT) ATT_SLOAD(vsA0, vsA1, ksA, (j + 3) * KVBLK); ATT_SBAR();
        pv_d0(o, vb0 + SHM_V, pa0, pa1, pa2, pa3); partialSM(pA0, pA1, m_reg, mnA, alA);
        __syncthreads(); ATT_SWAIT(); ATT_SWRITE(1, vsB0, vsB1, ksB);
        ATT_RESC(alA); __syncthreads();
    }
    ATT_SBAR(); qkt(pB0, pB1, K_lds + SHM_K, qr, r32, hi);
    finishSM(pA0, pA1, alA, l_reg, pa0, pa1, pa2, pa3); ATT_SBAR();
    pv_d0(o, vb0, pa0, pa1, pa2, pa3); partialSM(pB0, pB1, m_reg, mnB, alB);
    __syncthreads(); ATT_RESC(alB);
    finishSM(pB0, pB1, alB, l_reg, pa0, pa1, pa2, pa3); ATT_SBAR();
    pv_d0(o, vb0 + SHM_V, pa0, pa1, pa2, pa3);
    if (hi == 0) li_l[r32] = l_reg; asm volatile("s_waitcnt lgkmcnt(0)" ::: "memory");
    float rli[16];
#pragma unroll
    for (int r = 0; r < 16; ++r) rli[r] = __builtin_amdgcn_rcpf(li_l[crow(r, hi)]);
    float* Ow = Ob + (size_t)(wid * 32) * LDR;
#pragma unroll
    for (int r = 0; r < 16; ++r) { const int orow = crow(r, hi);
#pragma unroll
        for (int d0 = 0; d0 < 4; ++d0) Ow[(size_t)orow * LDR + d0 * 32 + r32] = o[d0][r] * rli[r]; }
#undef ATT_SLOAD
#undef ATT_SWRITE
#undef ATT_SWAIT
#undef ATT_RESC
}
}

__device__ __forceinline__ void ph_gemm_win(const Args& A, int j, int row_lo, LAS unsigned char* lds, int bid, int nb) {
    unsigned char* ws = opq(A.ws); const float* const* IN = (const float* const*)(ws + WS_PTRS); (void)IN;
    pg8::Gemm g{(const bf16_t*)(ws + WS_ABF) + (size_t)row_lo * DM, (const bf16_t*)(ws + WS_WIN) + (size_t)j * ZLD * DM, NTOK - row_lo, ZLD, DM};
    const ListOrder S = build_units(lds, (NTOK - row_lo) / 256, ZLD / 256, nb, bid, nullptr, 0);
    EpiStoreBf16 E{(bf16_t*)(ws + WS_Z) + (size_t)row_lo * ZLD, ZLD};
    pg8::gemm_phase<EpiStoreBf16, ListOrder, true, true>(lds, g, S, E);
}

__device__ __forceinline__ void ph_rwkv_feat(const Args& A, int j, int row_lo, LAS unsigned char* lds, int bid, int nb) {
    unsigned char* ws = opq(A.ws); const float* const* IN = (const float* const*)(ws + WS_PTRS); (void)IN;
    const int tid = tid_opaque(), c = tid;
    LAS float* zs = (LAS float*)lds;
    const bf16_t* Z = (const bf16_t*)(ws + WS_Z);
    const float* mu = INP(I_RWMU) + (size_t)j * 2 * RWC;
    const float* w0 = INP(I_RWW0) + (size_t)j * 2 * 512; const float* w2 = INP(I_RWW2) + (size_t)j * 2 * 64 * 512;
    const float* a0 = INP(I_RWA0) + (size_t)j * 2 * 512; const float* a2 = INP(I_RWA2) + (size_t)j * 2 * 64 * 512;
    const float* g2 = INP(I_RWG2) + (size_t)j * 128 * 512;
    const float kkw = INP(I_RWKK)[j * 512 + c], kaw = INP(I_RWKA)[j * 512 + c], rkw = INP(I_RWRK)[j * 512 + c];
    const float w00 = w0[c], w01 = w0[512 + c], a00 = a0[c], a01 = a0[512 + c];
    float* F = (float*)(ws + WS_F);
    for (int grp = row_lo / 4 + bid; grp < NTOK / 4; grp += nb) {
        const int g0 = grp * 4; const Tok tk = tokinfo(g0);
        for (int col = tid; col < RWC; col += NTHREADS) {
            const float m0 = mu[col], m1 = mu[RWC + col];
            float z[6];
#pragma unroll
            for (int i = 0; i < 6; ++i) { const int tt = tk.t - 1 + i; z[i] = (tt >= 0 && tt < tk.T) ? bf2f(Z[(size_t)(g0 - 1 + i) * ZLD + col]) : 0.f; }
#pragma unroll
            for (int k = 0; k < 4; ++k) zs[k * RWC + col] = z[k + 1] + m0 * (z[k] - z[k + 1]) + m1 * (z[k + 2] - z[k + 1]);
        }
        __syncthreads();
        for (int i = tid; i < 1024; i += NTHREADS) {
            const int k = i >> 8, q = i & 255;
            if (q < 128) { const int idx = k * RWC + 1536 + q; zs[idx] = tanhf(zs[idx]); }
            else { const int idx = k * RWC + 1792 + (q - 128); zs[idx] = sigmoidf_(zs[idx]); }
        }
        __syncthreads();
        float aw0[4], aw1[4], aa0[4], aa1[4], ag[4];
#pragma unroll
        for (int k = 0; k < 4; ++k) { aw0[k] = 0.f; aw1[k] = 0.f; aa0[k] = 0.f; aa1[k] = 0.f; ag[k] = 0.f; }
        for (int r = 0; r < 64; ++r) {
            const float w20 = w2[r * 512 + c], w21 = w2[(64 + r) * 512 + c], a20 = a2[r * 512 + c], a21 = a2[(64 + r) * 512 + c];
#pragma unroll
            for (int k = 0; k < 4; ++k) {
                aw0[k] += zs[k * RWC + 1536 + r] * w20; aw1[k] += zs[k * RWC + 1600 + r] * w21;
                aa0[k] += zs[k * RWC + 1664 + r] * a20; aa1[k] += zs[k * RWC + 1728 + r] * a21;
            }
        }
        for (int r = 0; r < 128; ++r) {
            const float gv = g2[r * 512 + c];
#pragma unroll
            for (int k = 0; k < 4; ++k) ag[k] += zs[k * RWC + 1792 + r] * gv;
        }
#pragma unroll
        for (int k = 0; k < 4; ++k) {
            const float r_ = zs[k * RWC + c], k_ = zs[k * RWC + 512 + c], v_ = zs[k * RWC + 1024 + c];
            float dec[2], av[2];
#pragma unroll
            for (int d = 0; d < 2; ++d) {
                const float x = (d ? w01 : w00) + (d ? aw1[k] : aw0[k]);
                const float y = -x;
                const float sp = fmaxf(y, 0.f) + log1pf(__expf(-fabsf(y)));
                const float w = -sp - 0.5f;
                dec[d] = -__expf(w);
                av[d] = sigmoidf_((d ? a01 : a00) + (d ? aa1[k] : aa0[k]));
            }
            float kk = k_ * kkw;
            const float nrm = sqrtf(wave_sum(kk * kk));
            kk = kk / fmaxf(nrm, 1e-12f);
            const float kd0 = k_ * (1.0f + (av[0] - 1.0f) * kaw), kd1 = k_ * (1.0f + (av[1] - 1.0f) * kaw);
            const float s0 = wave_sum(r_ * kd0 * rkw), s1 = wave_sum(r_ * kd1 * rkw);
            const size_t o = (size_t)(g0 + k) * 512 + c; const size_t FS = (size_t)NTOK * 512;
            F[0 * FS + o] = r_; F[1 * FS + o] = v_; F[2 * FS + o] = kk; F[3 * FS + o] = ag[k]; F[4 * FS + o] = (s0 + s1) * v_;
            F[5 * FS + o] = dec[0]; F[6 * FS + o] = dec[1]; F[7 * FS + o] = kd0; F[8 * FS + o] = kd1; F[9 * FS + o] = kk * av[0]; F[10 * FS + o] = kk * av[1];
        }
        __syncthreads();
    }
}

__device__ __forceinline__ void ph_scan_naive(const Args& A, int bid, int nb) {
    unsigned char* ws = opq(A.ws); const float* const* IN = (const float* const*)(ws + WS_PTRS); (void)IN;
    const int tid = tid_opaque(), lane = tid & 63, wid = tid >> 6;
    if (wid != 0) return;
    const float* F = (const float*)(ws + WS_F); const size_t FS = (size_t)NTOK * 512;
    float* YS = (float*)(ws + WS_YS);
    for (int inst = bid; inst < 256; inst += nb) {
        const int dir = inst & 1, h = (inst >> 1) & 7, b = inst >> 4;
        float S[64];
#pragma unroll
        for (int k = 0; k < 64; ++k) S[k] = 0.f;
        const float* Fw = F + (5 + dir) * FS; const float* Fk = F + (7 + dir) * FS; const float* Fb = F + (9 + dir) * FS;
        float* Y = YS + dir * FS;
        for (int s = 0; s < TC + TL; ++s) {
            int g;
            if (s < TC) g = b * TC + (dir ? (TC - 1 - s) : s);
            else { const int q = s - TC; g = NCTX + b * TL + (dir ? (TL - 1 - q) : q); }
            const size_t o = (size_t)g * 512 + h * 64 + lane;
            const float r_ = F[o], v_ = F[FS + o], kk_ = F[2 * FS + o], w_ = __expf(Fw[o]), kd_ = Fk[o], b_ = Fb[o];
            float sa = 0.f;
#pragma unroll
            for (int k = 0; k < 64; ++k) sa -= S[k] * rdl(kk_, k);
            float y = 0.f;
#pragma unroll
            for (int k = 0; k < 64; ++k) {
                float sv = S[k] * rdl(w_, k);
                sv += sa * rdl(b_, k);
                sv += v_ * rdl(kd_, k);
                S[k] = sv;
                y += sv * rdl(r_, k);
            }
            Y[o] = y;
        }
    }
}

constexpr int R_A2 = 0, R_RT = 2048, R_BT = 4096, R_KT = 6144, R_VT = 8192, R_MBR = 10240, R_MKR = 10752, R_G = 11264, R_P = 11776;
__device__ __forceinline__ bf16x8 frag4(u32x2 lo) { const u32x4 w = {lo.x, lo.y, 0u, 0u}; return __builtin_bit_cast(bf16x8, w); }
__device__ __forceinline__ bf16x8 frag8(u32x2 lo, u32x2 hi) { const u32x4 w = {lo.x, lo.y, hi.x, hi.y}; return __builtin_bit_cast(bf16x8, w); }
__device__ __forceinline__ u32x2 pack4(f32x4 v) { u32x2 o; o.x = cvtpk_s(v[0], v[1]); o.y = cvtpk_s(v[2], v[3]); return o; }
__device__ __forceinline__ int wkv_token(int b, int dir, int s) {
    if (s < TC) return b * TC + (dir ? (TC - 1 - s) : s);
    const int q = s - TC; return NCTX + b * TL + (dir ? (TL - 1 - q) : q);
}
__device__ __forceinline__ void ph_wkv_prep(const Args& A, LAS unsigned char* lds, int bid, int nb) {
    unsigned char* ws = opq(A.ws);
    const int tid = tid_opaque(), lane = tid & 63, wid = tid >> 6, c16 = lane & 15, g4 = lane >> 4;
    constexpr int RS = 144;
    LAS unsigned char* wl = lds + wid * 16384;
    LAS unsigned char* Lat = wl; LAS unsigned char* Lbt = wl + 2304; LAS unsigned char* Lkt = wl + 4608; LAS unsigned char* Lrt = wl + 6912;
    LAS unsigned char* LaT = wl + 9216;
    LAS float* Lnf = (LAS float*)(wl + 11264);
    LAS unsigned char* Lx = wl + 12352;
    const float* F = (const float*)(ws + WS_F); const size_t FS = (size_t)NTOK * 512;
    for (int unit = bid * NWAVES + wid; unit < 256 * WKV_NCH; unit += nb * NWAVES) {
        const int inst = unit / WKV_NCH, c = unit - inst * WKV_NCH, dir = inst & 1, h = (inst >> 1) & 7, b = inst >> 4;
        const int g0 = wkv_token(b, dir, c * 16), gstep = dir ? -1 : 1;
        unsigned char* rec = ws + WS_WKV + (size_t)unit * WKV_REC;
        const float* Fw = F + (5 + dir) * FS; const float* Fk = F + (7 + dir) * FS; const float* Fb = F + (9 + dir) * FS;
        float cs = 0.f, ec = 1.f; unsigned aTp[8], bTp[8], kTp[8], vTp[8]; float pa = 0.f, pb = 0.f, pk = 0.f, pv = 0.f;
#pragma unroll
        for (int t = 0; t < 16; ++t) {
            const size_t o = (size_t)(g0 + gstep * t) * 512 + h * 64 + lane;
            const float lw = Fw[o], kkv = F[2 * FS + o], bb = Fb[o], kdv = Fk[o], rv = F[o], vv = F[FS + o];
            const float ep = ec; cs += lw; ec = __expf(cs); const float em = __expf(-cs);
            const float at = -kkv * ep, bt = bb * em, kt = kdv * em, rt = rv * ec;
            *(LAS bf16_t*)(Lat + t * RS + lane * 2) = (bf16_t)f2bf(at); *(LAS bf16_t*)(Lbt + t * RS + lane * 2) = (bf16_t)f2bf(bt);
            *(LAS bf16_t*)(Lkt + t * RS + lane * 2) = (bf16_t)f2bf(kt); *(LAS bf16_t*)(Lrt + t * RS + lane * 2) = (bf16_t)f2bf(rt);
            if (t & 1) { aTp[t >> 1] = pk2(pa, at); bTp[t >> 1] = pk2(pb, bt); kTp[t >> 1] = pk2(pk, kt); vTp[t >> 1] = pk2(pv, vv); }
            else { pa = at; pb = bt; pk = kt; pv = vv; }
        }
        *(float*)(rec + R_P + lane * 4) = ec;
        *(u32x4*)(rec + R_BT + lane * 32) = (u32x4){bTp[0], bTp[1], bTp[2], bTp[3]}; *(u32x4*)(rec + R_BT + lane * 32 + 16) = (u32x4){bTp[4], bTp[5], bTp[6], bTp[7]};
        *(u32x4*)(rec + R_KT + lane * 32) = (u32x4){kTp[0], kTp[1], kTp[2], kTp[3]}; *(u32x4*)(rec + R_KT + lane * 32 + 16) = (u32x4){kTp[4], kTp[5], kTp[6], kTp[7]};
        *(u32x4*)(rec + R_VT + lane * 32) = (u32x4){vTp[0], vTp[1], vTp[2], vTp[3]}; *(u32x4*)(rec + R_VT + lane * 32 + 16) = (u32x4){vTp[4], vTp[5], vTp[6], vTp[7]};
        *(LAS u32x4*)(LaT + lane * 32) = (u32x4){aTp[0], aTp[1], aTp[2], aTp[3]}; *(LAS u32x4*)(LaT + lane * 32 + 16) = (u32x4){aTp[4], aTp[5], aTp[6], aTp[7]};
        asm volatile("s_waitcnt lgkmcnt(0)" ::: "memory");
        f32x4 nD = {0.f, 0.f, 0.f, 0.f}, makD = nD, mbrD = nD, mkrD = nD;
#pragma unroll
        for (int ks = 0; ks < 2; ++ks) {
            const int off = c16 * RS + (32 * ks + 8 * g4) * 2;
            const bf16x8 fa = *(const LAS bf16x8*)(Lat + off), fb = *(const LAS bf16x8*)(Lbt + off), fk = *(const LAS bf16x8*)(Lkt + off), fr = *(const LAS bf16x8*)(Lrt + off);
            nD = __builtin_amdgcn_mfma_f32_16x16x32_bf16(fa, fb, nD, 0, 0, 0);
            makD = __builtin_amdgcn_mfma_f32_16x16x32_bf16(fa, fk, makD, 0, 0, 0);
            mbrD = __builtin_amdgcn_mfma_f32_16x16x32_bf16(fb, fr, mbrD, 0, 0, 0);
            mkrD = __builtin_amdgcn_mfma_f32_16x16x32_bf16(fk, fr, mkrD, 0, 0, 0);
        }
#pragma unroll
        for (int r = 0; r < 4; ++r) {
            const int row = 4 * g4 + r;
            nD[r] = (c16 < row) ? nD[r] : 0.f; makD[r] = (c16 < row) ? makD[r] : 0.f;
            mbrD[r] = (row <= c16) ? mbrD[r] : 0.f; mkrD[r] = (row <= c16) ? mkrD[r] : 0.f;
            Lnf[row * 17 + c16] = nD[r];
        }
        asm volatile("s_waitcnt lgkmcnt(0)" ::: "memory");
        float x[16];
#pragma unroll
        for (int t = 0; t < 16; ++t) {
            float acc = (t == c16) ? 1.f : 0.f;
#pragma unroll
            for (int i = 0; i < t; ++i) acc += Lnf[t * 17 + i] * x[i];
            x[t] = acc;
        }
        if (g4 == 0) {
#pragma unroll
            for (int t = 0; t < 16; ++t) *(LAS bf16_t*)(Lx + t * 32 + c16 * 2) = (bf16_t)f2bf(x[t]);
        }
        asm volatile("s_waitcnt lgkmcnt(0)" ::: "memory");
        const bf16x8 xB = frag4(*(const LAS u32x2*)(Lx + c16 * 32 + g4 * 8));
        const f32x4 z4 = {0.f, 0.f, 0.f, 0.f};
        const f32x4 gD = __builtin_amdgcn_mfma_f32_16x16x32_bf16(frag4(pack4(makD)), xB, z4, 0, 0, 0);
        *(u32x2*)(rec + R_G + (c16 * 16 + 4 * g4) * 2) = pack4(gD);
        *(u32x2*)(rec + R_MBR + (c16 * 16 + 4 * g4) * 2) = pack4(mbrD);
        *(u32x2*)(rec + R_MKR + (c16 * 16 + 4 * g4) * 2) = pack4(mkrD);
#pragma unroll
        for (int mt = 0; mt < 4; ++mt) {
            const bf16x8 aA = frag4(*(const LAS u32x2*)(LaT + (16 * mt + c16) * 32 + g4 * 8));
            const f32x4 d = __builtin_amdgcn_mfma_f32_16x16x32_bf16(aA, xB, z4, 0, 0, 0);
            *(u32x2*)(rec + R_A2 + (c16 * 64 + 16 * mt + 4 * g4) * 2) = pack4(d);
        }
        { const int row = lane >> 2, cb = (lane & 3) * 16;
          const u32x4 r0 = *(const LAS u32x4*)(Lrt + row * RS + cb * 2), r1 = *(const LAS u32x4*)(Lrt + row * RS + cb * 2 + 16);
          *(u32x4*)(rec + R_RT + (row * 64 + cb) * 2) = r0; *(u32x4*)(rec + R_RT + (row * 64 + cb) * 2 + 16) = r1; }
        asm volatile("s_waitcnt lgkmcnt(0)" ::: "memory");
    }
}
struct WkvOps { u32x2 a2[4], rt[4], g, mkr, mbr, bt[4], kt[4], vt; f32x4 p[4]; };
__device__ __forceinline__ void wkv_load(WkvOps& o, const unsigned char* rec, int c16, int g4, int v0) {
#pragma unroll
    for (int q = 0; q < 4; ++q) {
        o.a2[q] = *(const u32x2*)(rec + R_A2 + (c16 * 64 + 16 * q + 4 * g4) * 2);
        o.rt[q] = *(const u32x2*)(rec + R_RT + (c16 * 64 + 16 * q + 4 * g4) * 2);
        o.bt[q] = *(const u32x2*)(rec + R_BT + ((16 * q + c16) * 16 + 4 * g4) * 2);
        o.kt[q] = *(const u32x2*)(rec + R_KT + ((16 * q + c16) * 16 + 4 * g4) * 2);
        o.p[q] = *(const f32x4*)(rec + R_P + (16 * q + 4 * g4) * 4);
    }
    o.g = *(const u32x2*)(rec + R_G + (c16 * 16 + 4 * g4) * 2); o.mkr = *(const u32x2*)(rec + R_MKR + (c16 * 16 + 4 * g4) * 2); o.mbr = *(const u32x2*)(rec + R_MBR + (c16 * 16 + 4 * g4) * 2);
    o.vt = *(const u32x2*)(rec + R_VT + ((v0 + c16) * 16 + 4 * g4) * 2);
}
__device__ __forceinline__ void ph_wkv_scan(const Args& A, int bid, int nb) {
    unsigned char* ws = opq(A.ws);
    const int tid = tid_opaque(), lane = tid & 63, wid = tid >> 6, c16 = lane & 15, g4 = lane >> 4;
    if (wid >= 4) return;
    float* YS = (float*)(ws + WS_YS); const size_t FS = (size_t)NTOK * 512;
    const int v0 = wid * 16;
    for (int inst = bid; inst < 256; inst += nb) {
        const int dir = inst & 1, h = (inst >> 1) & 7, b = inst >> 4;
        const unsigned char* rec0 = ws + WS_WKV + (size_t)inst * WKV_NCH * WKV_REC;
        float* Y = YS + dir * FS + h * 64 + v0 + c16;
        f32x4 S[4];
#pragma unroll
        for (int mt = 0; mt < 4; ++mt) S[mt] = (f32x4){0.f, 0.f, 0.f, 0.f};
        WkvOps cur, nxt;
        wkv_load(cur, rec0, c16, g4, v0);
        for (int c = 0; c < WKV_NCH; ++c) {
            wkv_load(nxt, rec0 + (size_t)((c + 1 < WKV_NCH) ? c + 1 : c) * WKV_REC, c16, g4, v0);
            const f32x4 z4 = {0.f, 0.f, 0.f, 0.f};
            const bf16x8 sb0 = frag8(pack4(S[0]), pack4(S[1])), sb1 = frag8(pack4(S[2]), pack4(S[3]));
            const bf16x8 vb = frag4(cur.vt);
            f32x4 U = __builtin_amdgcn_mfma_f32_16x16x32_bf16(frag4(cur.g), vb, z4, 0, 0, 0);
            U = __builtin_amdgcn_mfma_f32_16x16x32_bf16(frag8(cur.a2[0], cur.a2[1]), sb0, U, 0, 0, 0);
            U = __builtin_amdgcn_mfma_f32_16x16x32_bf16(frag8(cur.a2[2], cur.a2[3]), sb1, U, 0, 0, 0);
            f32x4 Yt = __builtin_amdgcn_mfma_f32_16x16x32_bf16(frag4(cur.mkr), vb, z4, 0, 0, 0);
            Yt = __builtin_amdgcn_mfma_f32_16x16x32_bf16(frag8(cur.rt[0], cur.rt[1]), sb0, Yt, 0, 0, 0);
            Yt = __builtin_amdgcn_mfma_f32_16x16x32_bf16(frag8(cur.rt[2], cur.rt[3]), sb1, Yt, 0, 0, 0);
            const bf16x8 ub = frag4(pack4(U));
            Yt = __builtin_amdgcn_mfma_f32_16x16x32_bf16(frag4(cur.mbr), ub, Yt, 0, 0, 0);
#pragma unroll
            for (int mt = 0; mt < 4; ++mt) {
                f32x4 sn = __builtin_amdgcn_mfma_f32_16x16x32_bf16(frag4(cur.kt[mt]), vb, S[mt], 0, 0, 0);
                sn = __builtin_amdgcn_mfma_f32_16x16x32_bf16(frag4(cur.bt[mt]), ub, sn, 0, 0, 0);
                S[mt] = sn * cur.p[mt];
            }
#pragma unroll
            for (int r = 0; r < 4; ++r) Y[(size_t)wkv_token(b, dir, c * 16 + 4 * g4 + r) * 512] = Yt[r];
            cur = nxt;
        }
    }
}

__device__ __forceinline__ void ph_qk(const Args& A, int j, int row_lo, int bid, int nb) {
    unsigned char* ws = opq(A.ws); const float* const* IN = (const float* const*)(ws + WS_PTRS);
    const int tid = tid_opaque(), lane = tid & 63, wid = tid >> 6;
    const bf16_t* Z = (const bf16_t*)(ws + WS_Z);
    bf16_t* QB = (bf16_t*)(ws + WS_QB); bf16_t* KB = (bf16_t*)(ws + WS_KB); bf16_t* VB = (bf16_t*)(ws + WS_VB);
    const float qn = INP(I_QN)[j * 64 + lane], kn = INP(I_KN)[j * 64 + lane];
    const float invf = __powf(10000.0f, -(float)(lane & 15) / 16.0f);
    for (int g = row_lo + bid; g < NTOK; g += nb) {
        const Tok tk = tokinfo(g);
        const size_t krow = (size_t)tk.b * (TC + TL) + (tk.T == TL ? TC + tk.t : tk.t);
        const bf16_t* zr = Z + (size_t)g * ZLD + RWC;
        VB[krow * 512 + tid] = zr[1024 + tid];
#pragma unroll
        for (int ss = 0; ss < 2; ++ss) {
            const int sh = wid * 2 + ss, isk = sh >> 3, s = sh & 7;
            const float x = bf2f(zr[isk * 512 + s * 64 + lane]);
            const float ms = wave_sum(x * x) * (1.0f / 64.0f);
            float y = x * rsqrtf(ms + 1e-6f) * (isk ? kn : qn);
            if (tk.T == TL) {
                const float pos = (float)((lane & 32) ? (tk.t & 63) : (tk.t >> 6));
                const float ang = pos * invf;
                float sn, cs; __sincosf(ang, &sn, &cs);
                const float other = __shfl_xor(y, 16);
                y = (lane & 16) ? (y * cs + other * sn) : (y * cs - other * sn);
            }
            if (isk) KB[krow * 512 + s * 64 + lane] = (bf16_t)f2bf(y); else QB[(size_t)g * 512 + s * 64 + lane] = (bf16_t)f2bf(y);
        }
    }
}

__device__ __forceinline__ void ph_attn(const Args& A, bool want_ctx, LAS unsigned char* lds, int bid, int nb) {
    unsigned char* ws = opq(A.ws);
    const bf16_t* QB = (const bf16_t*)(ws + WS_QB); const bf16_t* KB = (const bf16_t*)(ws + WS_KB); const bf16_t* VB = (const bf16_t*)(ws + WS_VB);
    float* OP = (float*)(ws + WS_OP);
    const int vcu = (nb % 8 == 0) ? (bid % 8) * (nb / 8) + bid / 8 : bid;
    const int nunits = 1024 + (want_ctx ? 128 : 0);
    for (int u = vcu; u < nunits; u += nb) {
        int b, h, m, q0, seq;
        if (u < 1024) { const int qb = u & 7; m = (u >> 3) & 1; h = (u >> 4) & 3; b = u >> 6; q0 = NCTX + b * TL + qb * 256; seq = TC + TL; }
        else { const int v = u - 1024; m = v & 1; h = (v >> 1) & 3; b = v >> 3; q0 = b * TC; seq = TC; }
        const int s = h * 2 + m;
        att::attn_body(QB + (size_t)q0 * 512 + s * 64, KB + (size_t)b * (TC + TL) * 512 + s * 64, VB + (size_t)b * (TC + TL) * 512 + h * 128,
                       OP + (size_t)m * NTOK * 512 + (size_t)q0 * 512 + h * 128, seq, lds);
    }
}

__device__ __forceinline__ void ph_merge(const Args& A, int l, int row_lo, LAS unsigned char* lds, int bid, int nb) {
    unsigned char* ws = opq(A.ws); const float* const* IN = (const float* const*)(ws + WS_PTRS); (void)IN;
    const int j = l >> 1;
    const int tid = tid_opaque(), lane = tid & 63, wid = tid >> 6, c = tid;
    LAS float* sh = (LAS float*)lds;
    const float lam_init = 0.8f - 0.6f * __expf(-0.3f * (float)l);
    if (wid == 0) {
        const float* lp = INP(I_LAM) + j * 4 * 64;
        const float s01 = wave_sum(lp[lane] * lp[64 + lane]), s23 = wave_sum(lp[128 + lane] * lp[192 + lane]);
        if (lane == 0) sh[8] = __expf(s01) - __expf(s23) + lam_init;
    }
    __syncthreads();
    const float lam = sh[8];
    const float* F = (const float*)(ws + WS_F); const size_t FS = (size_t)NTOK * 512;
    const float* YS = (const float*)(ws + WS_YS); const float* OP = (const float*)(ws + WS_OP);
    bf16_t* CAT = (bf16_t*)(ws + WS_CAT);
    const float gnw = INP(I_GNW)[j * 512 + c], gnb = INP(I_GNB)[j * 512 + c], sub = INP(I_SUBLN)[j * 128 + (c & 127)];
    for (int g = row_lo + bid; g < NTOK; g += nb) {
        const size_t o = (size_t)g * 512 + c;
        const float y = YS[o] + YS[FS + o];
        const float mu = wave_sum(y) * (1.0f / 64.0f);
        const float dv = y - mu;
        const float var = wave_sum(dv * dv) * (1.0f / 64.0f);
        const float yn = dv * rsqrtf(var + 64e-5f) * gnw + gnb;
        const float ya = (yn + F[4 * FS + o]) * F[3 * FS + o];
        const float od = OP[o] - lam * OP[FS + o];
        const float ssw = wave_sum(od * od);
        if (lane == 0) sh[wid] = ssw;
        __syncthreads();
        const float ms = (sh[wid & ~1] + sh[wid | 1]) * (1.0f / 128.0f);
        const float ob = od * rsqrtf(ms + 1e-6f) * sub * (1.0f - lam_init);
        CAT[(size_t)g * DM + c] = (bf16_t)f2bf(ya);
        CAT[(size_t)g * DM + 512 + c] = (bf16_t)f2bf(ob);
        __syncthreads();
    }
}

__device__ __forceinline__ void ph_gemm_out(const Args& A, int l, size_t x_off, size_t wt_off, int row_lo, LAS unsigned char* lds, int bid, int nb) {
    unsigned char* ws = opq(A.ws); const float* const* IN = (const float* const*)(ws + WS_PTRS); (void)IN;
    pg8::Gemm g{(const bf16_t*)(ws + x_off) + (size_t)row_lo * DM, (const bf16_t*)(ws + wt_off), NTOK - row_lo, DM, DM};
    const ListOrder S = build_units(lds, (NTOK - row_lo) / 256, DM / 256, nb, bid, nullptr, 0);
    EpiResidual E{(float*)(ws + WS_H) + (size_t)row_lo * DM, (const float*)(ws + WS_MOD) + (size_t)l * 17 * 6144 + 2 * 1024, row_lo};
    pg8::gemm_phase<EpiResidual, ListOrder, true, true>(lds, g, S, E);
}

__device__ __forceinline__ void ph_gemm_sgin(const Args& A, int j, int row_lo, LAS unsigned char* lds, int bid, int nb) {
    unsigned char* ws = opq(A.ws); const float* const* IN = (const float* const*)(ws + WS_PTRS); (void)IN;
    pg8::Gemm g{(const bf16_t*)(ws + WS_ABF) + (size_t)row_lo * DM, (const bf16_t*)(ws + WS_SGIN) + (size_t)j * 2048 * DM, NTOK - row_lo, 2048, DM};
    const ListOrder S = build_units(lds, (NTOK - row_lo) / 256, 2048 / 256, nb, bid, nullptr, 0);
    EpiGeluBf16 E{(bf16_t*)(ws + WS_Z2) + (size_t)row_lo * 2048, 2048, INP(I_SGBIN) + j * 2048};
    pg8::gemm_phase<EpiGeluBf16, ListOrder, true, true>(lds, g, S, E);
}
__device__ __forceinline__ void ph_sgu_ln(const Args& A, int j, int row_lo, int bid, int nb) {
    unsigned char* ws = opq(A.ws); const float* const* IN = (const float* const*)(ws + WS_PTRS); (void)IN;
    const int tid = tid_opaque(), lane = tid & 63, wid = tid >> 6;
    const bf16_t* Z2 = (const bf16_t*)(ws + WS_Z2); float* VN = (float*)(ws + WS_VN);
    const float* lg = INP(I_SGLNG) + j * 1024; const float* lb = INP(I_SGLNB) + j * 1024;
    for (int row = row_lo + bid * NWAVES + wid; row < NTOK; row += nb * NWAVES) {
        f32x4 v[4]; float s = 0.f;
#pragma unroll
        for (int q = 0; q < 4; ++q) { const u32x2 t = *(const u32x2*)(Z2 + (size_t)row * 2048 + 1024 + q * 256 + lane * 4);
            v[q] = (f32x4){__builtin_bit_cast(float, t.x << 16), __builtin_bit_cast(float, t.x & 0xffff0000u), __builtin_bit_cast(float, t.y << 16), __builtin_bit_cast(float, t.y & 0xffff0000u)}; s += (v[q].x + v[q].y) + (v[q].z + v[q].w); }
        const float mean = wave_sum(s) * (1.0f / 1024.0f); float s2 = 0.f;
#pragma unroll
        for (int q = 0; q < 4; ++q) { v[q] = v[q] - mean; s2 += (v[q].x * v[q].x + v[q].y * v[q].y) + (v[q].z * v[q].z + v[q].w * v[q].w); }
        const float rstd = rsqrtf(wave_sum(s2) * (1.0f / 1024.0f) + 1e-5f);
#pragma unroll
        for (int q = 0; q < 4; ++q) { const int col = q * 256 + lane * 4; *(f32x4*)(VN + (size_t)row * DM + col) = v[q] * rstd * *(const f32x4*)(lg + col) + *(const f32x4*)(lb + col); }
    }
}
__device__ __forceinline__ void ph_sgu_spatial(const Args& A, int j, int row_lo, LAS unsigned char* lds, int bid, int nb) {
    unsigned char* ws = opq(A.ws); const float* const* IN = (const float* const*)(ws + WS_PTRS); (void)IN;
    const int tid = tid_opaque();
    const bf16_t* Z2 = (const bf16_t*)(ws + WS_Z2); const float* VN = (const float*)(ws + WS_VN); bf16_t* G = (bf16_t*)(ws + WS_G);
    LAS float* vt = (LAS float*)lds;
    LAS float* wl = (LAS float*)(lds + 65536);
    const int ch0 = row_lo / 128, nch = NTOK / 128 - ch0;
    for (int u = bid; u < nch * 8; u += nb) {
        const int ci = ch0 + u / 8, g = u % 8;
        const float* wsg = INP(I_SGWS) + ((size_t)j * 8 + g) * 128 * 128;
        for (int i = tid; i < 128 * 32; i += NTHREADS) {
            const int q = i >> 5, c4 = (i & 31) * 4;
            *(LAS f32x4*)(vt + q * 128 + c4) = *(const f32x4*)(VN + (size_t)(ci * 128 + q) * DM + g * 128 + c4);
            *(LAS f32x4*)(wl + q * 128 + c4) = *(const f32x4*)(wsg + q * 128 + c4);
        }
        __syncthreads();
        const int c = tid & 127, pg = tid >> 7;
        float acc[32];
#pragma unroll
        for (int i = 0; i < 32; ++i) acc[i] = 0.f;
        for (int q = 0; q < 128; q += 4) {
            const float v0 = vt[q * 128 + c], v1 = vt[(q + 1) * 128 + c], v2 = vt[(q + 2) * 128 + c], v3 = vt[(q + 3) * 128 + c];
#pragma unroll
            for (int i = 0; i < 32; ++i) { const f32x4 w = *(const LAS f32x4*)(wl + (pg * 32 + i) * 128 + q); acc[i] += (w.x * v0 + w.y * v1) + (w.z * v2 + w.w * v3); }
        }
#pragma unroll
        for (int i = 0; i < 32; ++i) {
            const int p = pg * 32 + i; const size_t row = (size_t)ci * 128 + p;
            const float uu = bf2f(Z2[row * 2048 + g * 128 + c]);
            const float sv = acc[i] + INP(I_SGBS)[((size_t)j * 8 + g) * 128 + p];
            G[row * DM + g * 128 + c] = (bf16_t)f2bf(uu * sv);
        }
        __syncthreads();
    }
}

__device__ __forceinline__ int moe_layout(const Args& A, int l, int bid, int nb, LAS int* off  , LAS int* cntl  , LAS int* tile_e  , LAS int* base  ) {
    const int tid = tid_opaque();
    const int* bc = (const int*)(opq(A.ws) + WS_BCNT) + (size_t)l * 256 * 32;
    if (tid < 64) {
        int n = 0, pre = 0;
        if (tid < 32) {
#pragma unroll 8
            for (int b = 0; b < nb; ++b) { const int c = bc[b * 32 + tid]; n += c; pre += (b < bid) ? c : 0; }
        }
        const int nt = (n + 255) >> 8;
        int x = nt;
#pragma unroll
        for (int o = 1; o < 32; o <<= 1) { const int y = __shfl_up(x, o); if (tid >= o) x += y; }
        const int start = x - nt;
        if (tid < 32) {
            cntl[tid] = n; off[tid] = start * 256; base[tid] = start * 256 + pre;
#pragma unroll 1
            for (int t = 0; t < nt; ++t) tile_e[start + t] = tid;
        }
        if (tid == 31) off[32] = x * 256;
    }
    __syncthreads();
    return off[32] >> 8;
}
__device__ __forceinline__ void ph_moe_scatter(const Args& A, int l, int row_lo, LAS unsigned char* lds, int bid, int nb) {
    unsigned char* ws = opq(A.ws);
    const int tid = tid_opaque(), lane = tid & 63, wid = tid >> 6;
    LAS int* off = (LAS int*)(lds + LDS_TAB); LAS int* cntl = off + 64; LAS int* tile_e = off + 128; LAS int* base = off + 800;
    moe_layout(A, l, bid, nb, off, cntl, tile_e, base);
    const bf16_t* abf = (const bf16_t*)(ws + WS_ABF); bf16_t* XP = (bf16_t*)(ws + WS_XP);
    const int* te = (const int*)(ws + WS_TOKE); const int* tr = (const int*)(ws + WS_TOKR); int* rowof = (int*)(ws + WS_ROWOF);
    for (int row = row_lo + bid * NWAVES + wid; row < NTOK; row += nb * NWAVES) {
        const u32x4* src = (const u32x4*)(abf + (size_t)row * DM);
        const u32x4 s0 = src[lane], s1 = src[64 + lane];
#pragma unroll
        for (int k = 0; k < 4; ++k) {
            const int e = te[(size_t)row * 4 + k];
            const int pos = base[e] + tr[(size_t)row * 4 + k];
            if (lane == 0) rowof[(size_t)row * 4 + k] = pos;
            u32x4* dst = (u32x4*)(XP + (size_t)pos * DM);
            dst[lane] = s0; dst[64 + lane] = s1;
        }
    }
    for (int e = bid; e < 32; e += nb) {
        const int r0 = off[e] + cntl[e], r1 = off[e + 1];
        for (int i = tid; i < (r1 - r0) * 128; i += NTHREADS) ((u32x4*)(XP + (size_t)r0 * DM))[i] = (u32x4){0u, 0u, 0u, 0u};
    }
}
__device__ __forceinline__ void ph_moe_gemm1(const Args& A, int l, LAS unsigned char* lds, int bid, int nb) {
    unsigned char* ws = opq(A.ws); const float* const* IN = (const float* const*)(ws + WS_PTRS); (void)IN;
    LAS int* off = (LAS int*)(lds + LDS_TAB); LAS int* cntl = off + 64; LAS int* tile_e = off + 128; LAS int* base = off + 800;
    const int T = moe_layout(A, l, bid, nb, off, cntl, tile_e, base);
    pg8::Gemm g{(const bf16_t*)(ws + WS_XP), (const bf16_t*)(ws + WS_W1) + (size_t)l * NE * 2048 * DM, T * 256, 2048, DM};
    const ListOrder S = build_units(lds, T, 8, nb, bid, tile_e, 8);
    EpiMoe1 E{(bf16_t*)(ws + WS_ACT), INP(I_B1) + (size_t)l * NE * 2048};
    pg8::gemm_phase<EpiMoe1, ListOrder, true, true>(lds, g, S, E);
}
__device__ __forceinline__ void ph_moe_gemm2(const Args& A, int l, LAS unsigned char* lds, int bid, int nb) {
    unsigned char* ws = opq(A.ws); const float* const* IN = (const float* const*)(ws + WS_PTRS); (void)IN;
    LAS int* off = (LAS int*)(lds + LDS_TAB); LAS int* cntl = off + 64; LAS int* tile_e = off + 128; LAS int* base = off + 800;
    const int T = moe_layout(A, l, bid, nb, off, cntl, tile_e, base);
    pg8::Gemm g{(const bf16_t*)(ws + WS_ACT), (const bf16_t*)(ws + WS_W2) + (size_t)l * NE * DM * DM, T * 256, DM, DM};
    const ListOrder S = build_units(lds, T, 4, nb, bid, tile_e, 4);
    EpiMoe2 E{(bf16_t*)(ws + WS_YM), INP(I_B2) + (size_t)l * NE * DM};
    pg8::gemm_phase<EpiMoe2, ListOrder, true, true>(lds, g, S, E);
}
__device__ __forceinline__ void ph_moe_combine(const Args& A, int l, int row_lo, bool last, int bid, int nb) {
    unsigned char* ws = opq(A.ws); const float* const* IN = (const float* const*)(ws + WS_PTRS); (void)IN;
    const int tid = tid_opaque(), lane = tid & 63, wid = tid >> 6;
    float* H = (float*)(ws + WS_H); const float* mod = (const float*)(ws + WS_MOD); const bf16_t* YM = (const bf16_t*)(ws + WS_YM);
    const int* rowof = (const int*)(ws + WS_ROWOF); const float* tg = (const float*)(ws + WS_TOKG);
    for (int row = row_lo + bid * NWAVES + wid; row < NTOK; row += nb * NWAVES) {
        const Tok tk = tokinfo(row);
        const float* gate = mod + ((size_t)l * 17 + tk.modrow) * 6144 + 5 * 1024;
        int r[4]; float gk[4];
#pragma unroll
        for (int k = 0; k < 4; ++k) { r[k] = rowof[(size_t)row * 4 + k]; gk[k] = tg[(size_t)row * 4 + k]; }
#pragma unroll
        for (int q = 0; q < 4; ++q) {
            const int col = q * 256 + lane * 4;
            f32x4 m = (f32x4){0.f, 0.f, 0.f, 0.f};
#pragma unroll
            for (int k = 0; k < 4; ++k) { const u32x2 t = *(const u32x2*)(YM + (size_t)r[k] * DM + col);
                m = m + (f32x4){__builtin_bit_cast(float, t.x << 16), __builtin_bit_cast(float, t.x & 0xffff0000u), __builtin_bit_cast(float, t.y << 16), __builtin_bit_cast(float, t.y & 0xffff0000u)} * gk[k]; }
            const f32x4 hv = *(const f32x4*)(H + (size_t)row * DM + col) + *(const f32x4*)(gate + col) * m;
            if (last) *(f32x4*)(as_global(((float* const*)IN)[38]) + (size_t)(row - NCTX) * DM + col) = hv;
            else *(f32x4*)(H + (size_t)row * DM + col) = hv;
        }
    }
}

__global__ void __launch_bounds__(NTHREADS, 2) fwd_kernel(Args A) {
    extern __shared__ __attribute__((aligned(16))) unsigned char lds_raw[];
    LAS unsigned char* lds = (LAS unsigned char*)lds_raw;
    volatile LAS unsigned* misc = (volatile LAS unsigned*)(lds + LDS_MISC);
    const int tid = threadIdx.x, bid = blockIdx.x, nb = gridDim.x;
    if (tid < 64) misc[tid] = 0u;
    __syncthreads();
    XcdBarrier bar = xcd_barrier_post((unsigned*)(A.ws + WS_CTL) + CW_BAR, misc + 8);
    const int lo = A.ph_lo, hi = A.ph_hi;
    int pc = 0;
#ifndef PHSEL
#define PHSEL -1
#endif
#define SEL(k) (PHSEL < 0 || PHSEL == (k))
#ifndef REPEAT_MASK
#define REPEAT_MASK 0
#endif
#define RUN(k, call) do { if (SEL(k)) { call; if ((REPEAT_MASK >> (k)) & 1) { xcd_barrier(bar); call; } } } while (0)
#define PH_BEGIN if (pc >= lo && pc < hi) {
#define PH_END } if (pc >= lo && pc + 1 < hi) xcd_barrier(bar); ++pc;

    PH_BEGIN RUN(0, ph_prologue(A, lds, bid, nb)); PH_END

    for (int l = 0; l < 4; ++l) {
        const int j = l >> 1;
        const bool ctx_out = (l < 2), ctx_in = (l < 3);
        const int rin = ctx_in ? 0 : NCTX, rout = ctx_out ? 0 : NCTX;
        PH_BEGIN RUN(1, ph_norm<false>(A, l, rin, lds, bid, nb)); PH_END
        if ((l & 1) == 0) {
            PH_BEGIN RUN(2, ph_gemm_win(A, j, rin, lds, bid, nb)); PH_END
            PH_BEGIN RUN(3, ph_rwkv_feat(A, j, rin, lds, bid, nb)); RUN(4, ph_qk(A, j, rin, bid, nb)); PH_END
            #ifdef WKV_NAIVE
            PH_BEGIN RUN(5, ph_scan_naive(A, bid, nb)); PH_END
#else
            PH_BEGIN RUN(18, ph_wkv_prep(A, lds, bid, nb)); PH_END
            PH_BEGIN RUN(5, ph_wkv_scan(A, bid, nb)); PH_END
#endif
            PH_BEGIN RUN(6, ph_attn(A, ctx_out, lds, bid, nb)); PH_END
            PH_BEGIN RUN(7, ph_merge(A, l, rout, lds, bid, nb)); PH_END
            PH_BEGIN RUN(8, ph_gemm_out(A, l, WS_CAT, WS_WOUT + (size_t)j * DM * DM * 2, rout, lds, bid, nb)); PH_END
        } else {
            PH_BEGIN RUN(9, ph_gemm_sgin(A, j, rin, lds, bid, nb)); PH_END
            PH_BEGIN RUN(10, ph_sgu_ln(A, j, rin, bid, nb)); PH_END
            PH_BEGIN RUN(11, ph_sgu_spatial(A, j, rout, lds, bid, nb)); PH_END
            PH_BEGIN RUN(12, ph_gemm_out(A, l, WS_G, WS_SGOUT + (size_t)j * DM * DM * 2, rout, lds, bid, nb)); PH_END
        }
        PH_BEGIN RUN(13, ph_norm<true>(A, l, rout, lds, bid, nb)); PH_END
        PH_BEGIN RUN(14, ph_moe_scatter(A, l, rout, lds, bid, nb)); PH_END
        PH_BEGIN RUN(15, ph_moe_gemm1(A, l, lds, bid, nb)); PH_END
        PH_BEGIN RUN(16, ph_moe_gemm2(A, l, lds, bid, nb)); PH_END
        PH_BEGIN RUN(17, ph_moe_combine(A, l, rout, l == 3, bid, nb)); PH_END
    }
}

extern "C" void kernel_launch(void* const* d_in, const int* in_sizes, int n_in, void* d_out, int out_size, void* d_ws, size_t ws_size, hipStream_t stream) {
    static int grid = 0;
    if (grid == 0) {
        if (n_in != 38 || out_size != NLAT * DM || ws_size < WS_END) { fprintf(stderr, "kernel_launch: unexpected shapes: n_in %d out %d ws %zu (need %zu)\n", n_in, out_size, ws_size, (size_t)WS_END); grid = -1; return; }
        int dev = 0, cus = 0, per_cu = 0;
        if (hipGetDevice(&dev) != hipSuccess || hipDeviceGetAttribute(&cus, hipDeviceAttributeMultiprocessorCount, dev) != hipSuccess) { grid = -1; return; }
        if (hipFuncSetAttribute((const void*)fwd_kernel, hipFuncAttributeMaxDynamicSharedMemorySize, LDS_BYTES) != hipSuccess) { fprintf(stderr, "kernel_launch: hipFuncSetAttribute failed\n"); grid = -1; return; }
        if (hipOccupancyMaxActiveBlocksPerMultiprocessor(&per_cu, (const void*)fwd_kernel, NTHREADS, LDS_BYTES) != hipSuccess || per_cu < 1)
            fprintf(stderr, "kernel_launch: occupancy query reports %d workgroups per CU\n", per_cu);
        (void)hipGetLastError();
        grid = cus;
    }
    if (grid < 0) return;
    if (hipMemsetAsync((char*)d_ws + WS_CTL, 0, CTL_ZERO_BYTES, stream) != hipSuccess) { fprintf(stderr, "kernel_launch: memset failed\n"); return; }
    Args a{};
    for (int i = 0; i < 38; ++i) a.in[i] = (const float*)d_in[i];
    a.out = (float*)d_out; a.ws = (unsigned char*)d_ws; a.ph_lo = 0; a.ph_hi = 1 << 20;
    hipLaunchKernelGGL(fwd_kernel, dim3(grid), dim3(NTHREADS), LDS_BYTES, stream, a);
    const hipError_t le = hipPeekAtLastError();
    if (le != hipSuccess) fprintf(stderr, "kernel_launch: launch failed: %s\n", hipGetErrorName(le));
}
```

```cpp
#include <hip/hip_runtime.h>
#include <cstdio>
#include <cstdint>

#define LAS __attribute__((address_space(3)))
typedef unsigned short bf16_t;
typedef short bf16x8 __attribute__((ext_vector_type(8)));
typedef float f32x4 __attribute__((ext_vector_type(4)));
typedef unsigned u32x4 __attribute__((ext_vector_type(4)));
typedef unsigned u32x2 __attribute__((ext_vector_type(2)));

constexpr int DM = 1024, NB = 16, TL = 2048, TC = 256;
constexpr int NCTX = NB * TC, NLAT = NB * TL, NTOK = NCTX + NLAT;
constexpr int RWC = 1920, EVC = 3456, ZLD = 3584;
constexpr int NE = 32;
constexpr int XPROWS = NTOK * 4 + NE * 256;
constexpr int NTHREADS = 512, NWAVES = 8;

constexpr size_t MiB = 1u << 20;
constexpr size_t al256(size_t x) { return (x + 255) & ~(size_t)255; }
constexpr size_t WS_CTL = 0, CTL_ZERO_BYTES = 1 * MiB - 4096;
constexpr size_t WS_PTRS = 1 * MiB - 4096;
constexpr size_t WS_MOD = 1 * MiB;
constexpr size_t WS_RTWT = al256(WS_MOD + (size_t)4 * 17 * 6144 * 4);
constexpr size_t WS_WIN = al256(WS_RTWT + (size_t)4 * 32 * 1024 * 4);
constexpr size_t WS_WOUT = al256(WS_WIN + (size_t)2 * ZLD * DM * 2);
constexpr size_t WS_SGIN = al256(WS_WOUT + (size_t)2 * DM * DM * 2);
constexpr size_t WS_SGOUT = al256(WS_SGIN + (size_t)2 * 2048 * DM * 2);
constexpr int LORA_N = 2560, LORA_K = 384;
constexpr size_t WS_WLORA = al256(WS_SGOUT + (size_t)2 * DM * DM * 2);
constexpr size_t WS_LBIAS = al256(WS_WLORA + (size_t)2 * LORA_N * LORA_K * 2);
constexpr size_t WS_W1 = al256(WS_LBIAS + (size_t)2 * LORA_N * 4);
constexpr size_t WS_W2 = al256(WS_W1 + (size_t)4 * NE * 2048 * DM * 2);
constexpr size_t WS_H = al256(WS_W2 + (size_t)4 * NE * DM * DM * 2);
constexpr size_t WS_ABF = al256(WS_H + (size_t)NTOK * DM * 4);
constexpr size_t WS_TOKE = al256(WS_ABF + (size_t)NTOK * DM * 2);
constexpr size_t WS_TOKG = al256(WS_TOKE + (size_t)NTOK * 4 * 4);
constexpr size_t WS_ROWOF = al256(WS_TOKG + (size_t)NTOK * 4 * 4);
constexpr size_t WS_TOKR = al256(WS_ROWOF + (size_t)NTOK * 4 * 4);
constexpr size_t WS_BCNT = al256(WS_TOKR + (size_t)NTOK * 4 * 4);
constexpr size_t WS_R = al256(WS_BCNT + (size_t)4 * 256 * 32 * 4);
constexpr size_t FSZ = (size_t)NTOK * 512 * 4;
constexpr size_t WS_Z = WS_R;
constexpr size_t HSZ = (size_t)NTOK * 512 * 2;
constexpr size_t WS_RB = al256(WS_Z + (size_t)NTOK * ZLD * 2);
constexpr size_t WS_KS = WS_RB + HSZ, WS_VS = WS_KS + HSZ, WS_KKN = WS_VS + HSZ;
constexpr size_t WS_LIN = WS_KKN + HSZ;
constexpr size_t WS_LO = al256(WS_LIN + (size_t)NTOK * 384 * 2);
constexpr size_t WS_AB = WS_LO + 2 * HSZ;
constexpr size_t WS_GB = WS_LO + 4 * HSZ;
constexpr size_t WS_YS = WS_LO + 5 * HSZ;
constexpr size_t WS_QB = WS_YS + 2 * FSZ;
constexpr size_t WS_KB = WS_QB + FSZ / 2;
constexpr size_t WS_VB = WS_KB + FSZ / 2;
constexpr size_t WS_OP = WS_VB + FSZ / 2;
constexpr size_t WS_CAT = WS_OP + 2 * FSZ;
constexpr int WKV_REC = 12288, WKV_NCH = (TC + TL) / 16;
constexpr size_t WS_WKV = al256(WS_CAT + (size_t)NTOK * DM * 2);
constexpr size_t WS_EVEN_END = WS_WKV + (size_t)256 * WKV_NCH * WKV_REC;
constexpr size_t WS_Z2 = WS_R;
constexpr size_t WS_VN = al256(WS_Z2 + (size_t)NTOK * 2048 * 2);
constexpr size_t WS_G = al256(WS_VN + (size_t)NTOK * DM * 4);
constexpr size_t WS_ODD_END = WS_G + (size_t)NTOK * DM * 2;
constexpr size_t WS_XP = WS_R;
constexpr size_t WS_ACT = al256(WS_XP + (size_t)XPROWS * DM * 2);
constexpr size_t WS_YM = al256(WS_ACT + (size_t)XPROWS * DM * 2);
constexpr size_t WS_MOE_END = WS_YM + (size_t)XPROWS * DM * 2;
constexpr size_t WS_END = (WS_EVEN_END > WS_MOE_END ? (WS_EVEN_END > WS_ODD_END ? WS_EVEN_END : WS_ODD_END) : (WS_MOE_END > WS_ODD_END ? WS_MOE_END : WS_ODD_END));

constexpr int CW_BAR = 4096;
constexpr int CW_CNT = 16384;
constexpr int CW_CUR = 16384 + 256;

constexpr int LDS_BYTES = 147456;
constexpr int LDS_MISC = 144 * 1024 - 256;

__device__ __forceinline__ unsigned f2bf(float f) { unsigned u = __builtin_bit_cast(unsigned, f); return (u + 0x7fffu + ((u >> 16) & 1u)) >> 16; }
__device__ __forceinline__ unsigned pk2(float lo, float hi) { return f2bf(lo) | (f2bf(hi) << 16); }
typedef float f32x2_t __attribute__((ext_vector_type(2))); typedef __bf16 bf16x2_t __attribute__((ext_vector_type(2)));
__device__ __forceinline__ unsigned cvtpk_s(float lo, float hi) { f32x2_t v = {lo, hi}; bf16x2_t b = __builtin_convertvector(v, bf16x2_t); return __builtin_bit_cast(unsigned, b); }
__device__ __forceinline__ float bf2f(bf16_t b) { return __builtin_bit_cast(float, (unsigned)b << 16); }
__device__ __forceinline__ float wave_sum(float v) {
#pragma unroll
    for (int o = 1; o < 64; o <<= 1) v += __shfl_xor(v, o);
    return v;
}
__device__ __forceinline__ int tid_opaque() { int t = threadIdx.x; asm volatile("" : "+v"(t)); return t; }
#define GAS __attribute__((address_space(1)))
template <class T> __device__ __forceinline__ T* as_global(T* p) { return (T*)(GAS T*)p; }
__device__ __forceinline__ unsigned char* opq(unsigned char* p) { GAS unsigned char* g = (GAS unsigned char*)p; asm volatile("" : "+s"(g)); return (unsigned char*)g; }
__device__ __forceinline__ float rdl(float v, int k) { return __builtin_bit_cast(float, __builtin_amdgcn_readlane(__builtin_bit_cast(int, v), k)); }
__device__ __forceinline__ float sigmoidf_(float x) { return 1.0f / (1.0f + __expf(-x)); }

#define XB_TMO      128
#define XB_XCNT(j)  (256  + 64 * (j))
#define XB_XSUB(j)  (1280 + 64 * (j))
#define XB_XGEN(j)  (2304 + 64 * (j))
#define XB_TOP      3328
#define XB_TOPGEN   3392
#define XCD_BAR_WORDS 3456
#define XB_SPIN_CAP (1u << 22)
__device__ __forceinline__ unsigned xb_ld(unsigned* p)              { return __hip_atomic_load(p, __ATOMIC_RELAXED, __HIP_MEMORY_SCOPE_AGENT); }
__device__ __forceinline__ unsigned xb_add(unsigned* p, unsigned v) { return __hip_atomic_fetch_add(p, v, __ATOMIC_RELAXED, __HIP_MEMORY_SCOPE_AGENT); }
__device__ __forceinline__ unsigned xb_xcc_id() { return (unsigned)__builtin_amdgcn_s_getreg((3 << 11) | 20) & 0xFu; }
#define XB_SPIN(cond, bar) do { unsigned _sp = 0; while (cond) { __builtin_amdgcn_s_sleep(1); \
    if ((++_sp & 255u) == 0u) { if (xb_ld(&(bar)[XB_TMO])) break; if (_sp > XB_SPIN_CAP) { atomicAdd(&(bar)[XB_TMO], 1u); break; } } } } while (0)
struct XcdBarrier { unsigned* bar; unsigned x; volatile LAS unsigned* st; };
__device__ __forceinline__ XcdBarrier xcd_barrier_post(unsigned* bar, volatile LAS unsigned* st) {
    XcdBarrier b; b.bar = bar; b.x = xb_xcc_id(); b.st = st;
    if (threadIdx.x == 0) (void)xb_add(&bar[XB_XCNT(b.x)], 1u);
    return b;
}
__device__ __forceinline__ void xcd_barrier_complete(unsigned* bar, unsigned x, unsigned& nloc, unsigned& nx) {
    const unsigned G = gridDim.x * gridDim.y * gridDim.z;
    unsigned sum, cnt, mine, sp = 0u;
    for (;;) {
        sum = 0u; cnt = 0u; mine = 0u;
#pragma unroll
        for (unsigned j = 0; j < 16; ++j) { const unsigned c = xb_ld(&bar[XB_XCNT(j)]); sum += c; cnt += (c > 0u) ? 1u : 0u; mine = (j == x) ? c : mine; }
        if (sum == G) break;
        __builtin_amdgcn_s_sleep(1);
        if ((++sp & 255u) == 0u) { if (xb_ld(&bar[XB_TMO])) break; if (sp > XB_SPIN_CAP) { atomicAdd(&bar[XB_TMO], 1u); break; } }
    }
    nloc = mine > 0u ? mine : 1u; nx = cnt > 0u ? cnt : 1u;
}
__device__ __forceinline__ void xcd_barrier(const XcdBarrier& b) {
    asm volatile("s_waitcnt vmcnt(0)" ::: "memory");
    __syncthreads();
    if (threadIdx.x == 0) {
        unsigned* bar = b.bar;
        __builtin_amdgcn_s_waitcnt(0);
        unsigned nloc = b.st[0], nx = b.st[1];
        if (nloc == 0u) { xcd_barrier_complete(bar, b.x, nloc, nx); b.st[0] = nloc; b.st[1] = nx; }
        const unsigned old = xb_add(&bar[XB_XSUB(b.x)], 1u);
        const unsigned gen = old / nloc;
        if (old + 1u == (gen + 1u) * nloc) {
            __builtin_amdgcn_fence(__ATOMIC_RELEASE, "agent");
            asm volatile("s_waitcnt vmcnt(0)" ::: "memory");
            const unsigned og = xb_add(&bar[XB_TOP], 1u);
            const unsigned tg = og / nx;
            if (og + 1u == (tg + 1u) * nx) xb_add(&bar[XB_TOPGEN], 1u);
            else XB_SPIN(xb_ld(&bar[XB_TOPGEN]) == tg, bar);
            __builtin_amdgcn_fence(__ATOMIC_ACQUIRE, "agent");
            xb_add(&bar[XB_XGEN(b.x)], 1u);
            asm volatile("s_waitcnt vmcnt(0)" ::: "memory");
        } else {
            XB_SPIN(xb_ld(&bar[XB_XGEN(b.x)]) == gen, bar);
            __builtin_amdgcn_fence(__ATOMIC_ACQUIRE, "agent");
            asm volatile("s_waitcnt vmcnt(0)" ::: "memory");
        }
    }
    __syncthreads();
}

namespace pg8 {
#define PG8_LAS __attribute__((address_space(3)))
typedef unsigned short bf16_t;
typedef short bf16x8 __attribute__((ext_vector_type(8)));
typedef float f32x4 __attribute__((ext_vector_type(4)));
typedef unsigned u32x4 __attribute__((ext_vector_type(4)));
constexpr int BM = 256, BK = 64, HALF = 128, HTB = HALF * BK * 2  , STAGE_BYTES = 8 * HTB, NXCD = 8, WGM = 8;

__host__ __device__ __forceinline__ int lds_byte(int r, int c) { const int st = (r >> 4) * 2 + (c >> 5), rr = r & 15, cc = c & 31, ob = rr * 64 + cc * 2; return st * 1024 + (ob ^ (((ob >> 9) & 1) << 5)); }
__host__ __device__ __forceinline__ void stage_rc(int b, int& R, int& C) { const int st = b / 1024, sb = b % 1024, swz = sb ^ (((sb >> 9) & 1) << 5); R = (st >> 1) * 16 + swz / 64; C = (st & 1) * 32 + (swz % 64) / 2; }
__host__ __device__ __forceinline__ int perm32(int rho) { const int n = rho >> 4, i = rho & 15; return 8 * (i >> 2) + 4 * n + (i & 3); }

struct Unit { int pm, pn; };
struct Gemm { const bf16_t* A; const bf16_t* Bt; int M, N, K; };

struct StaticOrder {
    int nM, nN, nwg, G, c;
    __host__ __device__ void init(int M, int N, int G_, int c_) { nM = M / BM; nN = N / BM; nwg = nM * nN; G = G_; c = c_; }
    __host__ __device__ bool next(int i, Unit& u) const {
        const long L = (long)i * G + c; if (L >= nwg) return false;
        int wgid = (int)L; { const int q = nwg / NXCD, r = nwg % NXCD, xcd = wgid % NXCD, off = wgid / NXCD; wgid = (xcd < r ? xcd * (q + 1) : r * (q + 1) + (xcd - r) * q) + off; }
        const int nig = WGM * nN, gid = wgid / nig, fm = gid * WGM, gsz = (nM - fm) < WGM ? (nM - fm) : WGM;
        u.pm = fm + ((wgid % nig) % gsz); u.pn = (wgid % nig) / gsz; return true;
    }
    __device__ __forceinline__ void a_ready(const Unit&) const {}
    __device__ __forceinline__ void done(const Unit&) const {}
};

__device__ __forceinline__ unsigned cvt_pk_bf16(float lo, float hi) { unsigned r; asm volatile("v_cvt_pk_bf16_f32 %0, %1, %2" : "=v"(r) : "v"(lo), "v"(hi)); return r; }
typedef float f32x2 __attribute__((ext_vector_type(2)));
__device__ __forceinline__ f32x2 gelu_pk(f32x2 v) {
    const f32x2 av = __builtin_elementwise_abs(v), d = av * 0.2316418882f + 1.0f;
    f32x2 t; t.x = __builtin_amdgcn_rcpf(d.x); t.y = __builtin_amdgcn_rcpf(d.y);
    f32x2 q = t * 0.5307027145f + (-0.7265760135f); q = q * t + 0.7107068705f; q = q * t + (-0.142248368f); q = q * t + 0.127414796f; q = q * t;
    const f32x2 s = (v * v) * (-0.72134752044f);
    f32x2 e; e.x = __builtin_amdgcn_exp2f(s.x); e.y = __builtin_amdgcn_exp2f(s.y);
    const f32x2 m = v * (q * e), r = v - m;
    f32x2 o; o.x = v.x < 0.f ? m.x : r.x; o.y = v.y < 0.f ? m.y : r.y; return o;
}

template <class Epi, class Sched, bool ALIGN_EPI = false, bool SP2 = false>
__device__ __forceinline__ void gemm_phase(PG8_LAS unsigned char* lds, const Gemm g, const Sched& S, const Epi& E) {
    const int tid = tid_opaque(), wid = __builtin_amdgcn_readfirstlane(tid >> 6), lane = tid & 63, wr = wid >> 2, wc = wid & 3, fr = lane & 15, fq = lane >> 4;
    const int K = g.K, nt = K / BK;
    unsigned voffA[2], voffB[2];
#pragma unroll
    for (int i = 0; i < 2; ++i) { int R, C; stage_rc(tid * 16 + i * 8192, R, C); const int Rb = Epi::PERM ? ((R & ~31) + perm32(R & 31)) : R;
        voffA[i] = (unsigned)(R * K + C) * 2u; voffB[i] = (unsigned)(Rb * K + C) * 2u; }
    const size_t kstep = (size_t)(BK * 2);
    const size_t hstep = (size_t)HALF * K * 2;
    const size_t tstep = 2 * hstep;
    const unsigned ldsw = (unsigned)wid * 1024u;
    const int aoff = lds_byte(wr * 64 + fr, fq * 8), boff = lds_byte(wc * 32 + fr, fq * 8);
#define PG8_SA(b, h) (((b) * 2 + (h)) * HTB)
#define PG8_SB(b, h) ((4 + (b) * 2 + (h)) * HTB)
#define PG8_STAGE(bufoff, gbase, voff) do { _Pragma("unroll") for (int _i = 0; _i < 2; ++_i) \
        __builtin_amdgcn_global_load_lds((const unsigned*)((const char*)(gbase) + (voff)[_i]), (PG8_LAS unsigned*)(lds + (bufoff) + ldsw + _i * 8192), 16, 0, 0); } while (0)
#define PG8_LDA(dst, b, h) do { _Pragma("unroll") for (int m = 0; m < 4; ++m) _Pragma("unroll") for (int k = 0; k < 2; ++k) dst[m][k] = *(const PG8_LAS bf16x8*)(lds + PG8_SA(b, h) + aoff + m * 2048 + k * 1024); } while (0)
#define PG8_LDB(dst, b, h) do { _Pragma("unroll") for (int n = 0; n < 2; ++n) _Pragma("unroll") for (int k = 0; k < 2; ++k) dst[n][k] = *(const PG8_LAS bf16x8*)(lds + PG8_SB(b, h) + boff + n * 2048 + k * 1024); } while (0)
#define PG8_MMA(ai, bj, At, Bt) do { __builtin_amdgcn_s_setprio(1); _Pragma("unroll") for (int m = 0; m < 4; ++m) _Pragma("unroll") for (int n = 0; n < 2; ++n) _Pragma("unroll") for (int k = 0; k < 2; ++k) \
        acc[ai][bj][m][n] = __builtin_amdgcn_mfma_f32_16x16x32_bf16(Bt[n][k], At[m][k], acc[ai][bj][m][n], 0, 0, 0); __builtin_amdgcn_s_setprio(0); } while (0)
#define PG8_WAIT_V(n) asm volatile("s_waitcnt vmcnt(" #n ")" ::: "memory")
#define PG8_WAIT_L(n) asm volatile("s_waitcnt lgkmcnt(" #n ")" ::: "memory")
#define PG8_BAR __builtin_amdgcn_s_barrier()
#define PG8_SCHED __builtin_amdgcn_sched_barrier(0)
    Unit cur, nxt; int ui = 0;
    if (!S.next(0, cur)) return;
    f32x4 acc[2][2][4][2];
#pragma unroll
    for (int a = 0; a < 2; ++a)
#pragma unroll
        for (int b = 0; b < 2; ++b)
#pragma unroll
            for (int m = 0; m < 4; ++m)
#pragma unroll
                for (int n = 0; n < 2; ++n) acc[a][b][m][n] = (f32x4){0.f, 0.f, 0.f, 0.f};
    bf16x8 At[4][2], B0[2][2], B1[2][2];
    const char* cA = (const char*)g.A + (size_t)cur.pm * tstep; const char* cB = (const char*)g.Bt + (size_t)cur.pn * tstep;
    S.a_ready(cur);
    if constexpr (SP2) {
        PG8_STAGE(PG8_SB(0, 0), cB, voffB); PG8_STAGE(PG8_SB(0, 1), cB + hstep, voffB); PG8_STAGE(PG8_SA(0, 0), cA, voffA); PG8_STAGE(PG8_SA(0, 1), cA + hstep, voffA);
        if (wr == 1) PG8_BAR;
        PG8_WAIT_V(2); PG8_BAR;
        PG8_STAGE(PG8_SB(1, 0), cB + kstep, voffB); PG8_STAGE(PG8_SA(1, 0), cA + kstep, voffA); PG8_STAGE(PG8_SB(1, 1), cB + hstep + kstep, voffB);
        PG8_WAIT_V(6); PG8_BAR;
    } else {
        PG8_STAGE(PG8_SB(0, 0), cB, voffB); PG8_STAGE(PG8_SA(0, 0), cA, voffA); PG8_STAGE(PG8_SB(0, 1), cB + hstep, voffB); PG8_STAGE(PG8_SA(0, 1), cA + hstep, voffA);
        if (wr == 1) PG8_BAR;
        PG8_WAIT_V(4); PG8_BAR;
        PG8_STAGE(PG8_SB(1, 0), cB + kstep, voffB); PG8_STAGE(PG8_SA(1, 0), cA + kstep, voffA); PG8_STAGE(PG8_SB(1, 1), cB + hstep + kstep, voffB);
        PG8_WAIT_V(6); PG8_BAR;
    }
    for (;;) {
        const bool has_next = S.next(ui + 1, nxt);
        const char* nA = has_next ? (const char*)g.A + (size_t)nxt.pm * tstep : cA; const char* nB = has_next ? (const char*)g.Bt + (size_t)nxt.pn * tstep : cB;
        for (int t = 0; t < nt; t += 2) {
            const bool last = (t == nt - 2);
            const char* a1 = cA + (size_t)(t + 1) * kstep;
            const char* a2 = last ? nA : cA + (size_t)(t + 2) * kstep; const char* b2 = last ? nB : cB + (size_t)(t + 2) * kstep;
            const char* a3 = a2 + kstep; const char* b3 = b2 + kstep;
            if (last && has_next) S.a_ready(nxt);
            if constexpr (SP2) {
            PG8_LDB(B0, 0, 0); PG8_LDB(B1, 0, 1); PG8_SCHED; PG8_LDA(At, 0, 0); PG8_STAGE(PG8_SA(1, 1), a1 + hstep, voffA);
            PG8_WAIT_V(8); PG8_WAIT_L(0); PG8_BAR; PG8_MMA(0, 0, At, B0); PG8_MMA(0, 1, At, B1); PG8_BAR; PG8_SCHED;
            PG8_LDA(At, 0, 1); PG8_STAGE(PG8_SB(0, 0), b2, voffB); PG8_STAGE(PG8_SB(0, 1), b2 + hstep, voffB); PG8_STAGE(PG8_SA(0, 0), a2, voffA);
            PG8_WAIT_V(8); PG8_WAIT_L(0); PG8_BAR; PG8_MMA(1, 0, At, B0); PG8_MMA(1, 1, At, B1); PG8_BAR; PG8_SCHED;
            PG8_LDB(B0, 1, 0); PG8_LDB(B1, 1, 1); PG8_SCHED; PG8_LDA(At, 1, 0); PG8_STAGE(PG8_SA(0, 1), a2 + hstep, voffA);
            PG8_WAIT_V(8); PG8_WAIT_L(0); PG8_BAR; PG8_MMA(0, 0, At, B0); PG8_MMA(0, 1, At, B1); PG8_BAR; PG8_SCHED;
            PG8_LDA(At, 1, 1); PG8_STAGE(PG8_SB(1, 0), b3, voffB); PG8_STAGE(PG8_SB(1, 1), b3 + hstep, voffB); PG8_STAGE(PG8_SA(1, 0), a3, voffA);
            PG8_WAIT_V(8); PG8_WAIT_L(0); PG8_BAR; PG8_MMA(1, 0, At, B0); PG8_MMA(1, 1, At, B1); PG8_BAR; PG8_SCHED;
            } else {
            PG8_LDB(B0, 0, 0); PG8_SCHED; PG8_LDA(At, 0, 0); PG8_STAGE(PG8_SA(1, 1), a1 + hstep, voffA);
            PG8_WAIT_L(8); PG8_BAR; PG8_WAIT_L(0); PG8_MMA(0, 0, At, B0); PG8_BAR; PG8_SCHED;
            PG8_LDB(B1, 0, 1); PG8_STAGE(PG8_SB(0, 0), b2, voffB);
            PG8_BAR; PG8_WAIT_L(0); PG8_MMA(0, 1, At, B1); PG8_BAR;
            PG8_LDA(At, 0, 1); PG8_STAGE(PG8_SA(0, 0), a2, voffA);
            PG8_BAR; PG8_WAIT_L(0); PG8_MMA(1, 0, At, B0); PG8_BAR; PG8_SCHED;
            PG8_STAGE(PG8_SB(0, 1), b2 + hstep, voffB);
            PG8_WAIT_V(6); PG8_BAR; PG8_MMA(1, 1, At, B1); PG8_BAR;
            PG8_LDB(B0, 1, 0); PG8_SCHED; PG8_LDA(At, 1, 0); PG8_STAGE(PG8_SA(0, 1), a2 + hstep, voffA);
            PG8_WAIT_L(8); PG8_BAR; PG8_WAIT_L(0); PG8_MMA(0, 0, At, B0); PG8_BAR; PG8_SCHED;
            PG8_LDB(B1, 1, 1); PG8_STAGE(PG8_SB(1, 0), b3, voffB);
            PG8_BAR; PG8_WAIT_L(0); PG8_MMA(0, 1, At, B1); PG8_BAR;
            PG8_LDA(At, 1, 1); PG8_STAGE(PG8_SA(1, 0), a3, voffA);
            PG8_BAR; PG8_WAIT_L(0); PG8_MMA(1, 0, At, B0); PG8_BAR; PG8_SCHED;
            PG8_STAGE(PG8_SB(1, 1), b3 + hstep, voffB);
            PG8_WAIT_V(6); PG8_BAR; PG8_MMA(1, 1, At, B1); PG8_BAR;
            }
        }
        if constexpr (ALIGN_EPI) { if (wr == 0) PG8_BAR; }
        if constexpr (!Epi::AFTER_DRAIN) { E(acc, cur, wr, wc, fr, fq); S.done(cur); }
        if (!has_next) break;
#pragma unroll
        for (int a = 0; a < 2; ++a)
#pragma unroll
            for (int b = 0; b < 2; ++b)
#pragma unroll
                for (int m = 0; m < 4; ++m)
#pragma unroll
                    for (int n = 0; n < 2; ++n) acc[a][b][m][n] = (f32x4){0.f, 0.f, 0.f, 0.f};
        cur = nxt; cA = nA; cB = nB; ++ui;
        if constexpr (ALIGN_EPI) { if (wr == 1) PG8_BAR; }
    }
    PG8_WAIT_V(0);
    if constexpr (!ALIGN_EPI) { if (wr == 0) PG8_BAR; }
    PG8_BAR;
    if constexpr (Epi::AFTER_DRAIN) { E.fused(acc, cur, wr, wc, fr, fq, lds, wid, lane); S.done(cur); }
#undef PG8_SA
#undef PG8_SB
#undef PG8_STAGE
#undef PG8_LDA
#undef PG8_LDB
#undef PG8_MMA
#undef PG8_WAIT_V
#undef PG8_WAIT_L
#undef PG8_BAR
#undef PG8_SCHED
}
}

struct Args { const float* in[38]; float* out; unsigned char* ws; int ph_lo, ph_hi; };
#define INP(k) as_global(IN[k])
#define AIN(k) as_global(A.in[k])
enum { I_X = 0, I_C, I_CTX, I_CCTX, I_N1G, I_N2G, I_ADAW, I_ADAB, I_EVWIN, I_EVWOUT, I_RWMU, I_RWW0, I_RWW2, I_RWA0, I_RWA2, I_RWG2, I_RWKK, I_RWKA, I_RWRK,
       I_GNW, I_GNB, I_QN, I_KN, I_LAM, I_SUBLN, I_SGWIN, I_SGBIN, I_SGLNG, I_SGLNB, I_SGWS, I_SGBS, I_SGWOUT, I_RTW, I_RTB, I_W1, I_B1, I_W2, I_B2 };

struct Tok { int b, t, T, modrow; };
__device__ __forceinline__ Tok tokinfo(int g) {
    Tok k;
    if (g < NCTX) { k.b = g >> 8; k.t = g & 255; k.T = TC; k.modrow = 16; }
    else { const int q = g - NCTX; k.b = q >> 11; k.t = q & 2047; k.T = TL; k.modrow = k.b; }
    return k;
}

template <int MAP>
__device__ __forceinline__ void p0_transpose_item(const float* W, int K, int N, bf16_t* WT, LAS float* scr, int item, int lane) {
    const int nblk = N / 32, kb = item / nblk, nb = item % nblk, k0 = 64 * kb, n0 = 32 * nb;
    const int d0 = MAP ? (256 * ((n0 & 1023) >> 7) + 128 * (n0 >> 10) + (n0 & 127)) : n0;
#pragma unroll 8
    for (int i = 0; i < 32; ++i) { const int kk = 2 * i + (lane >> 5); scr[kk * 33 + (lane & 31)] = W[(size_t)(k0 + kk) * N + n0 + (lane & 31)]; }
    asm volatile("s_waitcnt lgkmcnt(0)" ::: "memory");
    const int c = lane & 7;
#pragma unroll
    for (int j = 0; j < 4; ++j) { const int n = (lane >> 3) + 8 * j; const LAS float* s = scr + (8 * c) * 33 + n;
        u32x4 o; o.x = pk2(s[0 * 33], s[1 * 33]); o.y = pk2(s[2 * 33], s[3 * 33]); o.z = pk2(s[4 * 33], s[5 * 33]); o.w = pk2(s[6 * 33], s[7 * 33]);
        *(u32x4*)(WT + (size_t)(d0 + n) * K + k0 + 8 * c) = o; }
    asm volatile("s_waitcnt lgkmcnt(0)" ::: "memory");
}

__device__ __forceinline__ void ph_prologue(const Args& A, LAS unsigned char* lds, int bid, int nb) {
    const int tid = tid_opaque(), lane = tid & 63, wid = tid >> 6;
    unsigned char* ws = opq(A.ws);
    if (bid == 0 && tid < 39) ((const float**)(ws + WS_PTRS))[tid] = (tid < 38) ? A.in[tid] : (const float*)A.out;
    {
        LAS float* s = (LAS float*)lds;
        LAS float* red = (LAS float*)(lds + 17 * 1024 * 4);
        for (int i = tid; i < 17 * 1024; i += NTHREADS) {
            const int r = i >> 10, k = i & 1023;
            const float x = (r < 16) ? AIN(I_C)[r * 1024 + k] : AIN(I_CCTX)[k];
            s[i] = x / (1.0f + __expf(-x));
        }
        __syncthreads();
        float* mod = (float*)(ws + WS_MOD);
        for (int u = bid; u < 4 * 96; u += nb) {
            const int l = u / 96, cg = u % 96, col = cg * 64 + lane;
            float acc[17];
#pragma unroll
            for (int r = 0; r < 17; ++r) acc[r] = 0.f;
            const float* wp = AIN(I_ADAW) + (size_t)l * 1024 * 6144 + col;
            for (int k = wid * 128; k < wid * 128 + 128; ++k) {
                const float wv = wp[(size_t)k * 6144];
#pragma unroll
                for (int r = 0; r < 17; ++r) acc[r] += s[r * 1024 + k] * wv;
            }
#pragma unroll
            for (int r = 0; r < 17; ++r) red[(wid * 17 + r) * 64 + lane] = acc[r];
            __syncthreads();
            for (int i = tid; i < 17 * 64; i += NTHREADS) {
                const int r = i >> 6, ln = i & 63; float v = 0.f;
#pragma unroll
                for (int w = 0; w < 8; ++w) v += red[(w * 17 + r) * 64 + ln];
                const int cc = cg * 64 + ln;
                mod[((size_t)l * 17 + r) * 6144 + cc] = v + AIN(I_ADAB)[l * 6144 + cc];
            }
            __syncthreads();
        }
    }
    __syncthreads();
    {
        LAS float* scr = (LAS float*)(lds + wid * 16384);
        const int gw = bid * NWAVES + wid, NGW = nb * NWAVES;
        constexpr int IT_WIN = 16 * (EVC / 32), IT_SQ = 16 * 32, IT_SGIN = 16 * 64, IT_W1 = 16 * 64, IT_W2 = 16 * 32;
        constexpr int N0 = 2 * IT_WIN, N1 = N0 + 2 * IT_SQ, N2 = N1 + 2 * IT_SGIN, N3 = N2 + 2 * IT_SQ, N4 = N3 + 128 * IT_W1, N5 = N4 + 128 * IT_W2;
        for (int it = gw; it < N5; it += NGW) {
            if (it < N0) { const int m = it / IT_WIN, r = it % IT_WIN; p0_transpose_item<0>(AIN(I_EVWIN) + (size_t)m * DM * EVC, DM, EVC, (bf16_t*)(ws + WS_WIN) + (size_t)m * ZLD * DM, scr, r, lane); }
            else if (it < N1) { const int q = it - N0, m = q / IT_SQ, r = q % IT_SQ; p0_transpose_item<0>(AIN(I_EVWOUT) + (size_t)m * DM * DM, DM, DM, (bf16_t*)(ws + WS_WOUT) + (size_t)m * DM * DM, scr, r, lane); }
            else if (it < N2) { const int q = it - N1, m = q / IT_SGIN, r = q % IT_SGIN; p0_transpose_item<0>(AIN(I_SGWIN) + (size_t)m * DM * 2048, DM, 2048, (bf16_t*)(ws + WS_SGIN) + (size_t)m * 2048 * DM, scr, r, lane); }
            else if (it < N3) { const int q = it - N2, m = q / IT_SQ, r = q % IT_SQ; p0_transpose_item<0>(AIN(I_SGWOUT) + (size_t)m * DM * DM, DM, DM, (bf16_t*)(ws + WS_SGOUT) + (size_t)m * DM * DM, scr, r, lane); }
            else if (it < N4) { const int q = it - N3, m = q / IT_W1, r = q % IT_W1; p0_transpose_item<1>(AIN(I_W1) + (size_t)m * DM * 2048, DM, 2048, (bf16_t*)(ws + WS_W1) + (size_t)m * 2048 * DM, scr, r, lane); }
            else { const int q = it - N4, m = q / IT_W2, r = q % IT_W2; p0_transpose_item<0>(AIN(I_W2) + (size_t)m * DM * DM, DM, DM, (bf16_t*)(ws + WS_W2) + (size_t)m * DM * DM, scr, r, lane); }
        }
    }
    {
        const size_t gt = (size_t)bid * NTHREADS + tid, GT = (size_t)nb * NTHREADS;
        f32x4* H4 = (f32x4*)(ws + WS_H);
        const f32x4* c4 = (const f32x4*)AIN(I_CTX); const f32x4* x4 = (const f32x4*)AIN(I_X);
        constexpr size_t NC4 = (size_t)NCTX * DM / 4, NT4 = (size_t)NTOK * DM / 4;
        for (size_t i = gt; i < NT4; i += GT) H4[i] = (i < NC4) ? c4[i] : x4[i - NC4];
        for (size_t i = gt; i < (size_t)2 * 128 * DM / 8; i += GT) { const size_t m = i / (128 * DM / 8), r = i % (128 * DM / 8); ((u32x4*)((bf16_t*)(ws + WS_WIN) + (m * ZLD + EVC) * DM))[r] = (u32x4){0u, 0u, 0u, 0u}; }
        bf16_t* wl = (bf16_t*)(ws + WS_WLORA);
        for (size_t i = gt; i < (size_t)2 * LORA_N * LORA_K; i += GT) {
            const int jj = (int)(i / ((size_t)LORA_N * LORA_K)), rem = (int)(i % ((size_t)LORA_N * LORA_K)), n = rem / LORA_K, k = rem % LORA_K, seg = n >> 9, c = n & 511;
            float v = 0.f;
            if (seg < 2) { if ((k >> 6) == seg) v = AIN(I_RWW2)[(((size_t)jj * 2 + seg) * 64 + (k & 63)) * 512 + c]; }
            else if (seg < 4) { if ((k >> 6) == seg) v = AIN(I_RWA2)[(((size_t)jj * 2 + (seg - 2)) * 64 + (k & 63)) * 512 + c]; }
            else { if (k >= 256) v = AIN(I_RWG2)[((size_t)jj * 128 + (k - 256)) * 512 + c]; }
            wl[i] = (bf16_t)f2bf(v);
        }
        for (size_t i = gt; i < (size_t)2 * LORA_N; i += GT) { const int jj = (int)(i / LORA_N), n = (int)(i % LORA_N), seg = n >> 9, c = n & 511;
            ((float*)(ws + WS_LBIAS))[i] = seg < 2 ? AIN(I_RWW0)[((size_t)jj * 2 + seg) * 512 + c] : (seg < 4 ? AIN(I_RWA0)[((size_t)jj * 2 + (seg - 2)) * 512 + c] : 0.f); }
        float* rt = (float*)(ws + WS_RTWT);
        for (size_t i = gt; i < (size_t)4 * 32 * 1024; i += GT) { const int l = (int)(i >> 15), e = (int)(i >> 10) & 31, k = (int)i & 1023; rt[i] = AIN(I_RTW)[((size_t)l * 1024 + k) * 32 + e]; }
    }
}

template <bool ROUTER>
__device__ __forceinline__ void ph_norm(const Args& A, int l, int row_lo, LAS unsigned char* lds, int bid, int nb) {
    unsigned char* ws = opq(A.ws); const float* const* IN = (const float* const*)(ws + WS_PTRS); (void)IN;
    const int tid = tid_opaque(), lane = tid & 63, wid = tid >> 6;
    const float* H = (const float*)(ws + WS_H);
    const float* mod = (const float*)(ws + WS_MOD);
    bf16_t* abf = (bf16_t*)(ws + WS_ABF);
    const float* gp = INP(ROUTER ? I_N2G : I_N1G) + l * 1024;
    const int c_shift = ROUTER ? 3 : 0, c_scale = ROUTER ? 4 : 1;
    LAS float* rtl = (LAS float*)lds;
    LAS int* hist = (LAS int*)(lds + 131072);
    float rtb = 0.f;
    if constexpr (ROUTER) {
        const f32x4* rt4 = (const f32x4*)((const float*)(ws + WS_RTWT) + (size_t)l * 32 * 1024);
        for (int i = tid; i < 32 * 1024 / 4; i += NTHREADS) ((LAS f32x4*)rtl)[i] = rt4[i];
        if (tid < 32) hist[tid] = 0;
        rtb = INP(I_RTB)[l * 32 + (lane >> 1)];
        __syncthreads();
    }
    for (int row = row_lo + bid * NWAVES + wid; row < NTOK; row += nb * NWAVES) {
        const Tok tk = tokinfo(row);
        const float* mrow = mod + ((size_t)l * 17 + tk.modrow) * 6144;
        f32x4 v[4]; float ss = 0.f;
#pragma unroll
        for (int j = 0; j < 4; ++j) { v[j] = *(const f32x4*)(H + (size_t)row * DM + j * 256 + lane * 4); ss += (v[j].x * v[j].x + v[j].y * v[j].y) + (v[j].z * v[j].z + v[j].w * v[j].w); }
        const float rstd = rsqrtf(wave_sum(ss) * (1.0f / DM) + 1e-6f);
#pragma unroll
        for (int j = 0; j < 4; ++j) {
            const int col = j * 256 + lane * 4;
            const f32x4 g = *(const f32x4*)(gp + col), sc = *(const f32x4*)(mrow + c_scale * 1024 + col), sh = *(const f32x4*)(mrow + c_shift * 1024 + col);
            v[j] = (v[j] * rstd * g) * (sc + 1.0f) + sh;
            u32x2 o; o.x = pk2(v[j].x, v[j].y); o.y = pk2(v[j].z, v[j].w);
            *(u32x2*)(abf + (size_t)row * DM + col) = o;
        }
        if constexpr (ROUTER) {
            float p[32];
#pragma unroll
            for (int e = 0; e < 32; ++e) {
                float acc = 0.f;
#pragma unroll
                for (int j = 0; j < 4; ++j) { const f32x4 w = *(const LAS f32x4*)(rtl + e * 1024 + j * 256 + lane * 4); acc += (v[j].x * w.x + v[j].y * w.y) + (v[j].z * w.z + v[j].w * w.w); }
                p[e] = acc;
            }
#define RS_STEP(N, OFF) _Pragma("unroll") for (int i = 0; i < (N); ++i) { const bool up = (lane & (OFF)) != 0; const float send = up ? p[i] : p[i + (N)], keep = up ? p[i + (N)] : p[i]; p[i] = keep + __shfl_xor(send, (OFF)); }
            RS_STEP(16, 32) RS_STEP(8, 16) RS_STEP(4, 8) RS_STEP(2, 4) RS_STEP(1, 2)
#undef RS_STEP
            const float mylg = p[0] + __shfl_xor(p[0], 1) + rtb;
            float tv[4] = {-3.0e38f, -3.0e38f, -3.0e38f, -3.0e38f}; int ti[4] = {0, 0, 0, 0};
#pragma unroll
            for (int e = 0; e < 32; ++e) {
                const float lgv = rdl(mylg, 2 * e);
                if (lgv > tv[3]) {
                    tv[3] = lgv; ti[3] = e;
                    if (tv[3] > tv[2]) { const float a = tv[2]; tv[2] = tv[3]; tv[3] = a; const int b = ti[2]; ti[2] = ti[3]; ti[3] = b; }
                    if (tv[2] > tv[1]) { const float a = tv[1]; tv[1] = tv[2]; tv[2] = a; const int b = ti[1]; ti[1] = ti[2]; ti[2] = b; }
                    if (tv[1] > tv[0]) { const float a = tv[0]; tv[0] = tv[1]; tv[1] = a; const int b = ti[0]; ti[0] = ti[1]; ti[1] = b; }
                }
            }
            const float e1 = __expf(tv[1] - tv[0]), e2 = __expf(tv[2] - tv[0]), e3 = __expf(tv[3] - tv[0]);
            const float inv = 1.0f / (1.0f + e1 + e2 + e3);
            if (lane == 0) {
                int* te = (int*)(ws + WS_TOKE) + (size_t)row * 4; float* tg = (float*)(ws + WS_TOKG) + (size_t)row * 4; int* tr = (int*)(ws + WS_TOKR) + (size_t)row * 4;
                te[0] = ti[0]; te[1] = ti[1]; te[2] = ti[2]; te[3] = ti[3];
                tg[0] = inv; tg[1] = e1 * inv; tg[2] = e2 * inv; tg[3] = e3 * inv;
#pragma unroll
                for (int k = 0; k < 4; ++k) tr[k] = __hip_atomic_fetch_add(hist + ti[k], 1, __ATOMIC_RELAXED, __HIP_MEMORY_SCOPE_WORKGROUP);
            }
        }
    }
    if constexpr (ROUTER) {
        __syncthreads();
        if (tid < 32) ((int*)(ws + WS_BCNT))[((size_t)l * 256 + bid) * 32 + tid] = hist[tid];
    }
}

typedef pg8::f32x4 (&AccRef)[2][2][4][2];
struct EpiStoreBf16 {
    static constexpr bool PERM = true, AFTER_DRAIN = false;
    bf16_t* O; int ldc;
    __device__ __forceinline__ void operator()(const pg8::f32x4 (&acc)[2][2][4][2], const pg8::Unit& u, int wr, int wc, int fr, int fq) const {
        const int row0 = u.pm * 256 + wr * 64 + fr, col0 = u.pn * 256 + wc * 32 + 8 * fq;
#pragma unroll
        for (int ai = 0; ai < 2; ++ai)
#pragma unroll
            for (int m = 0; m < 4; ++m) { bf16_t* rowp = O + (size_t)(row0 + ai * 128 + m * 16) * ldc + col0;
#pragma unroll
                for (int bj = 0; bj < 2; ++bj) { const pg8::f32x4 v0 = acc[ai][bj][m][0], v1 = acc[ai][bj][m][1];
                    u32x4 w; w.x = cvtpk_s(v0[0], v0[1]); w.y = cvtpk_s(v0[2], v0[3]); w.z = cvtpk_s(v1[0], v1[1]); w.w = cvtpk_s(v1[2], v1[3]);
                    *(u32x4*)(rowp + bj * 128) = w; } }
    }
};
struct EpiGeluBf16 {
    static constexpr bool PERM = true, AFTER_DRAIN = false;
    bf16_t* O; int ldc; const float* bias;
    __device__ __forceinline__ void operator()(const pg8::f32x4 (&acc)[2][2][4][2], const pg8::Unit& u, int wr, int wc, int fr, int fq) const {
        const int row0 = u.pm * 256 + wr * 64 + fr, col0 = u.pn * 256 + wc * 32 + 8 * fq;
        pg8::f32x4 bv[2][2];
#pragma unroll
        for (int bj = 0; bj < 2; ++bj)
#pragma unroll
            for (int n = 0; n < 2; ++n) bv[bj][n] = *(const pg8::f32x4*)(bias + col0 + bj * 128 + 4 * n);
#pragma unroll
        for (int ai = 0; ai < 2; ++ai)
#pragma unroll
            for (int m = 0; m < 4; ++m) { bf16_t* rowp = O + (size_t)(row0 + ai * 128 + m * 16) * ldc + col0;
#pragma unroll
                for (int bj = 0; bj < 2; ++bj) { pg8::f32x4 v0 = acc[ai][bj][m][0] + bv[bj][0], v1 = acc[ai][bj][m][1] + bv[bj][1];
                    const pg8::f32x2 a = pg8::gelu_pk((pg8::f32x2){v0[0], v0[1]}), b = pg8::gelu_pk((pg8::f32x2){v0[2], v0[3]}), c = pg8::gelu_pk((pg8::f32x2){v1[0], v1[1]}), d = pg8::gelu_pk((pg8::f32x2){v1[2], v1[3]});
                    u32x4 w; w.x = cvtpk_s(a.x, a.y); w.y = cvtpk_s(b.x, b.y); w.z = cvtpk_s(c.x, c.y); w.w = cvtpk_s(d.x, d.y);
                    *(u32x4*)(rowp + bj * 128) = w; } }
    }
};
struct EpiResidual {
    static constexpr bool PERM = false, AFTER_DRAIN = false;
    float* H; const float* gate0; int row_base;
    __device__ __forceinline__ void operator()(const pg8::f32x4 (&acc)[2][2][4][2], const pg8::Unit& u, int wr, int wc, int fr, int fq) const {
        const int row0 = u.pm * 256 + wr * 64 + fr, col0 = u.pn * 256 + wc * 32 + 4 * fq;
        const Tok tk = tokinfo(row_base + u.pm * 256);
        const float* gate = gate0 + (size_t)tk.modrow * 6144 + col0;
        pg8::f32x4 gv[2][2];
#pragma unroll
        for (int bj = 0; bj < 2; ++bj)
#pragma unroll
            for (int n = 0; n < 2; ++n) gv[bj][n] = *(const pg8::f32x4*)(gate + bj * 128 + n * 16);
#pragma unroll
        for (int ai = 0; ai < 2; ++ai)
#pragma unroll
            for (int m = 0; m < 4; ++m) { float* rowp = H + (size_t)(row0 + ai * 128 + m * 16) * DM + col0;
#pragma unroll
                for (int bj = 0; bj < 2; ++bj)
#pragma unroll
                    for (int n = 0; n < 2; ++n) { pg8::f32x4* p = (pg8::f32x4*)(rowp + bj * 128 + n * 16); *p = *p + gv[bj][n] * acc[ai][bj][m][n]; } }
    }
};
struct ListOrder {
    const LAS int* list; int n;
    __device__ __forceinline__ bool next(int i, pg8::Unit& u) const {
        if (i >= n) return false;
        u.pm = __builtin_amdgcn_readfirstlane(list[2 * i]); u.pn = __builtin_amdgcn_readfirstlane(list[2 * i + 1]); return true;
    }
    __device__ __forceinline__ void a_ready(const pg8::Unit&) const {}
    __device__ __forceinline__ void done(const pg8::Unit&) const {}
};
struct EpiLora {
    static constexpr bool PERM = true, AFTER_DRAIN = false;
    bf16_t* O; const float* bias; int row_base;
    __device__ __forceinline__ void operator()(const pg8::f32x4 (&acc)[2][2][4][2], const pg8::Unit& u, int wr, int wc, int fr, int fq) const {
        const int seg = u.pn >> 1, row0 = row_base + u.pm * 256 + wr * 64 + fr, cs0 = (u.pn & 1) * 256 + wc * 32 + 8 * fq;
        const float ksig = seg < 2 ? -0.60653065971f : 1.0f; const bool lin = seg == 4;
        bf16_t* Os = O + (size_t)seg * NTOK * 512;
#pragma unroll
        for (int bj = 0; bj < 2; ++bj) {
            const int cs = cs0 + bj * 128;
            const pg8::f32x4 b0 = *(const pg8::f32x4*)(bias + seg * 512 + cs), b1 = *(const pg8::f32x4*)(bias + seg * 512 + cs + 4);
#pragma unroll
            for (int ai = 0; ai < 2; ++ai)
#pragma unroll
                for (int m = 0; m < 4; ++m) {
                    pg8::f32x4 v0 = acc[ai][bj][m][0] + b0, v1 = acc[ai][bj][m][1] + b1;
#pragma unroll
                    for (int r = 0; r < 4; ++r) {
                        const float t0 = ksig * __builtin_amdgcn_rcpf(1.0f + __expf(-v0[r])), t1 = ksig * __builtin_amdgcn_rcpf(1.0f + __expf(-v1[r]));
                        v0[r] = lin ? v0[r] : t0; v1[r] = lin ? v1[r] : t1;
                    }
                    u32x4 w; w.x = cvtpk_s(v0[0], v0[1]); w.y = cvtpk_s(v0[2], v0[3]); w.z = cvtpk_s(v1[0], v1[1]); w.w = cvtpk_s(v1[2], v1[3]);
                    *(u32x4*)(Os + (size_t)(row0 + ai * 128 + m * 16) * 512 + cs) = w;
                }
        }
    }
};
constexpr int LDS_TAB = 131072;
constexpr int LDS_LIST = LDS_TAB + 4096;
__device__ __forceinline__ ListOrder build_units(LAS unsigned char* lds, int nM, int nN, int G, int c, const LAS int* tile_e, int ncol) {
    LAS int* list = (LAS int*)(lds + LDS_LIST);
    pg8::StaticOrder S; S.nM = nM; S.nN = nN; S.nwg = nM * nN; S.G = G; S.c = c;
    const int tid = tid_opaque();
    if (tid < 64) { pg8::Unit u; if (S.next(tid, u)) { if (tile_e) u.pn = tile_e[u.pm] * ncol + u.pn; list[2 * tid] = u.pm; list[2 * tid + 1] = u.pn; } }
    __syncthreads();
    ListOrder L; L.list = list; L.n = (c < S.nwg) ? (S.nwg - c + G - 1) / G : 0;
    return L;
}
struct EpiMoe1 {
    static constexpr bool PERM = true, AFTER_DRAIN = false;
    bf16_t* O; const float* b1;
    __device__ __forceinline__ void operator()(const pg8::f32x4 (&acc)[2][2][4][2], const pg8::Unit& u, int wr, int wc, int fr, int fq) const {
        const int e = u.pn >> 3, pn = u.pn & 7;
        const int row0 = u.pm * 256 + wr * 64 + fr, ci = pn * 128 + wc * 32 + 8 * fq;
        const float* be = b1 + (size_t)e * 2048 + ci;
        const pg8::f32x4 bg0 = *(const pg8::f32x4*)(be), bg1 = *(const pg8::f32x4*)(be + 4), bl0 = *(const pg8::f32x4*)(be + 1024), bl1 = *(const pg8::f32x4*)(be + 1028);
#pragma unroll
        for (int ai = 0; ai < 2; ++ai)
#pragma unroll
            for (int m = 0; m < 4; ++m) {
                const pg8::f32x4 g0 = acc[ai][0][m][0] + bg0, g1 = acc[ai][0][m][1] + bg1, l0 = acc[ai][1][m][0] + bl0, l1 = acc[ai][1][m][1] + bl1;
                float o[8];
#pragma unroll
                for (int r = 0; r < 4; ++r) {
                    const float ga = fminf(g0[r], 7.0f), gb = fminf(g1[r], 7.0f);
                    const float la = fminf(fmaxf(l0[r], -7.0f), 7.0f), lb = fminf(fmaxf(l1[r], -7.0f), 7.0f);
                    o[r] = ga * __builtin_amdgcn_rcpf(1.0f + __expf(-1.702f * ga)) * (la + 1.0f);
                    o[4 + r] = gb * __builtin_amdgcn_rcpf(1.0f + __expf(-1.702f * gb)) * (lb + 1.0f);
                }
                u32x4 w; w.x = cvtpk_s(o[0], o[1]); w.y = cvtpk_s(o[2], o[3]); w.z = cvtpk_s(o[4], o[5]); w.w = cvtpk_s(o[6], o[7]);
                *(u32x4*)(O + (size_t)(row0 + ai * 128 + m * 16) * DM + ci) = w;
            }
    }
};
struct EpiMoe2 {
    static constexpr bool PERM = true, AFTER_DRAIN = false;
    bf16_t* O; const float* b2;
    __device__ __forceinline__ void operator()(const pg8::f32x4 (&acc)[2][2][4][2], const pg8::Unit& u, int wr, int wc, int fr, int fq) const {
        const int e = u.pn >> 2, pn = u.pn & 3;
        const int row0 = u.pm * 256 + wr * 64 + fr, col0 = pn * 256 + wc * 32 + 8 * fq;
        const float* be = b2 + (size_t)e * DM + col0;
        pg8::f32x4 bv[2][2];
#pragma unroll
        for (int bj = 0; bj < 2; ++bj)
#pragma unroll
            for (int n = 0; n < 2; ++n) bv[bj][n] = *(const pg8::f32x4*)(be + bj * 128 + 4 * n);
#pragma unroll
        for (int ai = 0; ai < 2; ++ai)
#pragma unroll
            for (int m = 0; m < 4; ++m) { bf16_t* rowp = O + (size_t)(row0 + ai * 128 + m * 16) * DM + col0;
#pragma unroll
                for (int bj = 0; bj < 2; ++bj) { const pg8::f32x4 v0 = acc[ai][bj][m][0] + bv[bj][0], v1 = acc[ai][bj][m][1] + bv[bj][1];
                    u32x4 w; w.x = cvtpk_s(v0[0], v0[1]); w.y = cvtpk_s(v0[2], v0[3]); w.z = cvtpk_s(v1[0], v1[1]); w.w = cvtpk_s(v1[2], v1[3]);
                    *(u32x4*)(rowp + bj * 128) = w; } }
    }
};

namespace att {
typedef float f32x16 __attribute__((ext_vector_type(16)));
typedef short s16x4 __attribute__((ext_vector_type(4)));
constexpr int KVBLK = 64, LDR = 512;
constexpr float SCALE = 0.125f, THR = 8.f;
constexpr int SHM_V = KVBLK * 128 * 2, SHM_K = KVBLK * 64 * 2, SHM_ATTN = 2 * SHM_V + 2 * SHM_K + NWAVES * 64 * 4;
#define ATT_KSWZ(row, colB) ((row) * 128 + ((colB) ^ ((((row) >> 1) & 7) << 4)))
#define ATT_SBAR() __builtin_amdgcn_sched_barrier(0)
__device__ __forceinline__ int crow(int r, int hi) { return (r & 3) + 8 * (r >> 2) + 4 * hi; }
__device__ __forceinline__ unsigned cvtpk(float lo, float hi) { unsigned r; asm volatile("v_cvt_pk_bf16_f32 %0, %1, %2" : "=v"(r) : "v"(lo), "v"(hi)); return r; }
__device__ __forceinline__ void partialSM(f32x16& p0, f32x16& p1, float& m_reg, float& mn, float& alpha) {
    constexpr float C = SCALE * 1.4426950408889634f;
    float pmax = p0[0];
#pragma unroll
    for (int r = 1; r < 16; ++r) pmax = fmaxf(pmax, p0[r]);
#pragma unroll
    for (int r = 0; r < 16; ++r) pmax = fmaxf(pmax, p1[r]);
    { auto rr = __builtin_amdgcn_permlane32_swap(__float_as_uint(pmax), __float_as_uint(pmax), false, false);
      pmax = fmaxf(__uint_as_float(rr[0]), __uint_as_float(rr[1])); }
    if (__builtin_expect(__all(pmax - m_reg <= THR / SCALE), 1)) { mn = m_reg; alpha = 1.f; }
    else { mn = fmaxf(m_reg, pmax); alpha = __builtin_amdgcn_exp2f((m_reg - mn) * C); m_reg = mn; }
    const float mnC = -mn * C;
#pragma unroll
    for (int r = 0; r < 16; ++r) p0[r] = fmaf(p0[r], C, mnC);
#pragma unroll
    for (int r = 0; r < 16; ++r) p1[r] = fmaf(p1[r], C, mnC);
#pragma unroll
    for (int r = 0; r < 16; ++r) p0[r] = __builtin_amdgcn_exp2f(p0[r]);
}
__device__ __forceinline__ void finishSM(f32x16& p0, f32x16& p1, float alpha, float& l_reg, bf16x8& pa0, bf16x8& pa1, bf16x8& pa2, bf16x8& pa3) {
#pragma unroll
    for (int r = 0; r < 16; ++r) p1[r] = __builtin_amdgcn_exp2f(p1[r]);
    float ps = 0;
#pragma unroll
    for (int r = 0; r < 16; ++r) ps += p0[r];
#pragma unroll
    for (int r = 0; r < 16; ++r) ps += p1[r];
    { auto rr = __builtin_amdgcn_permlane32_swap(__float_as_uint(ps), __float_as_uint(ps), false, false);
      ps = __uint_as_float(rr[0]) + __uint_as_float(rr[1]); }
    l_reg = l_reg * alpha + ps;
#define ATT_PK4(P, BASE, OUT) do { unsigned a0 = cvtpk(P[BASE + 0], P[BASE + 1]), a1 = cvtpk(P[BASE + 2], P[BASE + 3]);   \
    unsigned b0 = cvtpk(P[BASE + 4], P[BASE + 5]), b1 = cvtpk(P[BASE + 6], P[BASE + 7]);                              \
    auto r0 = __builtin_amdgcn_permlane32_swap(a0, b0, false, false); auto r1 = __builtin_amdgcn_permlane32_swap(a1, b1, false, false); \
    u32x4 w = {r0[0], r1[0], r0[1], r1[1]}; OUT = __builtin_bit_cast(bf16x8, w); } while (0)
    ATT_PK4(p0, 0, pa0); ATT_PK4(p0, 8, pa1); ATT_PK4(p1, 0, pa2); ATT_PK4(p1, 8, pa3);
#undef ATT_PK4
}
__device__ __forceinline__ void qkt(f32x16& p0, f32x16& p1, const LAS unsigned char* Ks, const bf16x8 (&qr)[4], int r32, int hi) {
    p0 = f32x16{}; p1 = f32x16{};
#pragma unroll
    for (int d0 = 0; d0 < 4; ++d0) { const int cb = (d0 * 16 + hi * 8) * 2;
        const bf16x8 b0 = *(const LAS bf16x8*)(Ks + ATT_KSWZ(r32, cb));
        const bf16x8 b1 = *(const LAS bf16x8*)(Ks + ATT_KSWZ(32 + r32, cb));
        p0 = __builtin_amdgcn_mfma_f32_32x32x16_bf16(b0, qr[d0], p0, 0, 0, 0);
        p1 = __builtin_amdgcn_mfma_f32_32x32x16_bf16(b1, qr[d0], p1, 0, 0, 0); }
}
__device__ __forceinline__ int v_st(int k, int c) { const int kk = (k & ~0xC) | ((k & 4) << 1) | ((k & 8) >> 1); return ((kk >> 3) * 4 + (c >> 5)) * 512 + ((kk & 7) * 32 + (c & 31)) * 2; }
__device__ __forceinline__ int v_rd_base(int lane) { return ((lane & 3) << 3) | (((lane >> 2) & 3) << 6) | (((lane >> 4) & 1) << 5) | (((lane >> 5) & 1) << 8); }
constexpr int v_rd_off(int d0, int ks, int half) { return d0 * 512 + ks * 4096 + half * 2048; }
template <int OFF> __device__ __forceinline__ s16x4 tr_read(int vb) { s16x4 r; asm volatile("ds_read_b64_tr_b16 %0, %1 offset:%2" : "=&v"(r) : "v"(vb), "i"(OFF) : "memory"); return r; }
template <int D0> __device__ __forceinline__ void pv_one(f32x16& od, int vb, bf16x8 pa0, bf16x8 pa1, bf16x8 pa2, bf16x8 pa3) {
    const s16x4 l0 = tr_read<v_rd_off(D0, 0, 0)>(vb), h0 = tr_read<v_rd_off(D0, 0, 1)>(vb), l1 = tr_read<v_rd_off(D0, 1, 0)>(vb), h1 = tr_read<v_rd_off(D0, 1, 1)>(vb);
    const s16x4 l2 = tr_read<v_rd_off(D0, 2, 0)>(vb), h2 = tr_read<v_rd_off(D0, 2, 1)>(vb), l3 = tr_read<v_rd_off(D0, 3, 0)>(vb), h3 = tr_read<v_rd_off(D0, 3, 1)>(vb);
    asm volatile("s_waitcnt lgkmcnt(0)" ::: "memory"); ATT_SBAR();
#define ATT_PK(L, H) (bf16x8){L[0], L[1], L[2], L[3], H[0], H[1], H[2], H[3]}
    od = __builtin_amdgcn_mfma_f32_32x32x16_bf16(pa0, ATT_PK(l0, h0), od, 0, 0, 0);
    od = __builtin_amdgcn_mfma_f32_32x32x16_bf16(pa1, ATT_PK(l1, h1), od, 0, 0, 0);
    od = __builtin_amdgcn_mfma_f32_32x32x16_bf16(pa2, ATT_PK(l2, h2), od, 0, 0, 0);
    od = __builtin_amdgcn_mfma_f32_32x32x16_bf16(pa3, ATT_PK(l3, h3), od, 0, 0, 0);
#undef ATT_PK
}
__device__ __forceinline__ void pv_d0(f32x16 (&o)[4], int vb, bf16x8 pa0, bf16x8 pa1, bf16x8 pa2, bf16x8 pa3) {
    pv_one<0>(o[0], vb, pa0, pa1, pa2, pa3); pv_one<1>(o[1], vb, pa0, pa1, pa2, pa3); pv_one<2>(o[2], vb, pa0, pa1, pa2, pa3); pv_one<3>(o[3], vb, pa0, pa1, pa2, pa3);
}
__device__ __forceinline__ void attn_body(const bf16_t* Qb, const bf16_t* Kh, const bf16_t* Vh, float* Ob, int seq, LAS unsigned char* lds) {
    const int tid = tid_opaque(), wid = tid >> 6, lane = tid & 63, r32 = lane & 31, hi = lane >> 5;
    LAS unsigned char* V_lds = lds; LAS unsigned char* K_lds = lds + 2 * SHM_V;
    LAS float* wsl = (LAS float*)(lds + 2 * SHM_V + 2 * SHM_K) + wid * 64; LAS float* li_l = wsl; LAS float* al_l = wsl + 32;
    float m_reg = -1e30f, l_reg = 0; f32x16 o[4] = {}; bf16x8 qr[4];
    const bf16_t* Qw = Qb + (size_t)(wid * 32 + r32) * LDR + hi * 8;
#pragma unroll
    for (int d0 = 0; d0 < 4; ++d0) qr[d0] = *(const bf16x8*)(Qw + d0 * 16);
    const int sr = tid >> 4, sc = (tid & 15) * 8, vst0 = v_st(sr, sc), vst1 = v_st(32 + sr, sc);
    const int kr = tid >> 3, kc = (tid & 7) * 8, kst = ATT_KSWZ(kr, kc * 2);
    const int vb0 = (int)(uintptr_t)V_lds + v_rd_base(lane);
    bf16x8 vsA0, vsA1, ksA, vsB0, vsB1, ksB;
#define ATT_SLOAD(V0, V1, K0, k0) do { V0 = *(const bf16x8*)(Vh + (size_t)((k0) + sr) * LDR + sc); V1 = *(const bf16x8*)(Vh + (size_t)((k0) + 32 + sr) * LDR + sc); \
    K0 = *(const bf16x8*)(Kh + (size_t)((k0) + kr) * LDR + kc); } while (0)
#define ATT_SWRITE(b, V0, V1, K0) do { *(LAS bf16x8*)(V_lds + (b) * SHM_V + vst0) = V0; *(LAS bf16x8*)(V_lds + (b) * SHM_V + vst1) = V1; \
    *(LAS bf16x8*)(K_lds + (b) * SHM_K + kst) = K0; } while (0)
#define ATT_SWAIT() asm volatile("s_waitcnt vmcnt(3)" ::: "memory")
#define ATT_RESC(a) do { if (__any((a) < 1.f)) { if (hi == 0) al_l[r32] = (a); asm volatile("s_waitcnt lgkmcnt(0)" ::: "memory"); \
    _Pragma("unroll") for (int d = 0; d < 4; ++d) _Pragma("unroll") for (int r = 0; r < 16; ++r) o[d][r] *= al_l[crow(r, hi)]; } } while (0)
    f32x16 pA0, pA1, pB0, pB1; float mnA, mnB, alA, alB; bf16x8 pa0, pa1, pa2, pa3; const int NT = seq / KVBLK;
    ATT_SLOAD(vsA0, vsA1, ksA, 0); asm volatile("s_waitcnt vmcnt(0)" ::: "memory"); ATT_SWRITE(0, vsA0, vsA1, ksA); __syncthreads();
    qkt(pA0, pA1, K_lds, qr, r32, hi); partialSM(pA0, pA1, m_reg, mnA, alA);
    ATT_SLOAD(vsB0, vsB1, ksB, KVBLK); if (2 < NT) ATT_SLOAD(vsA0, vsA1, ksA, 2 * KVBLK);
    ATT_SWAIT(); ATT_SWRITE(1, vsB0, vsB1, ksB); __syncthreads();
    for (int j = 1; j + 1 < NT; j += 2) {
        ATT_SBAR(); qkt(pB0, pB1, K_lds + SHM_K, qr, r32, hi);
        finishSM(pA0, pA1, alA, l_reg, pa0, pa1, pa2, pa3); ATT_SBAR();
        ATT_SLOAD(vsB0, vsB1, ksB, (j + 2) * KVBLK); ATT_SBAR();
        pv_d0(o, vb0, pa0, pa1, pa2, pa3); partialSM(pB0, pB1, m_reg, mnB, alB);
        __syncthreads(); ATT_SWAIT(); ATT_SWRITE(0, vsA0, vsA1, ksA);
        ATT_RESC(alB); __syncthreads();
        ATT_SBAR(); qkt(pA0, pA1, K_lds, qr, r32, hi);
        finishSM(pB0, pB1, alB, l_reg, pa0, pa1, pa2, pa3); ATT_SBAR();
        if (j + 3 < NT) ATT_SLOAD(vsA0, vsA1, ksA, (j + 3) * KVBLK); ATT_SBAR();
        pv_d0(o, vb0 + SHM_V, pa0, pa1, pa2, pa3); partialSM(pA0, pA1, m_reg, mnA, alA);
        __syncthreads(); ATT_SWAIT(); ATT_SWRITE(1, vsB0, vsB1, ksB);
        ATT_RESC(alA); __syncthreads();
    }
    ATT_SBAR(); qkt(pB0, pB1, K_lds + SHM_K, qr, r32, hi);
    finishSM(pA0, pA1, alA, l_reg, pa0, pa1, pa2, pa3); ATT_SBAR();
    pv_d0(o, vb0, pa0, pa1, pa2, pa3); partialSM(pB0, pB1, m_reg, mnB, alB);
    __syncthreads(); ATT_RESC(alB);
    finishSM(pB0, pB1, alB, l_reg, pa0, pa1, pa2, pa3); ATT_SBAR();
    pv_d0(o, vb0 + SHM_V, pa0, pa1, pa2, pa3);
    if (hi == 0) li_l[r32] = l_reg; asm volatile("s_waitcnt lgkmcnt(0)" ::: "memory");
    float rli[16];
#pragma unroll
    for (int r = 0; r < 16; ++r) rli[r] = __builtin_amdgcn_rcpf(li_l[crow(r, hi)]);
    float* Ow = Ob + (size_t)(wid * 32) * LDR;
#pragma unroll
    for (int r = 0; r < 16; ++r) { const int orow = crow(r, hi);
#pragma unroll
        for (int d0 = 0; d0 < 4; ++d0) Ow[(size_t)orow * LDR + d0 * 32 + r32] = o[d0][r] * rli[r]; }
#undef ATT_SLOAD
#undef ATT_SWRITE
#undef ATT_SWAIT
#undef ATT_RESC
}
}

__device__ __forceinline__ void ph_gemm_win(const Args& A, int j, int row_lo, LAS unsigned char* lds, int bid, int nb) {
    unsigned char* ws = opq(A.ws); const float* const* IN = (const float* const*)(ws + WS_PTRS); (void)IN;
    pg8::Gemm g{(const bf16_t*)(ws + WS_ABF) + (size_t)row_lo * DM, (const bf16_t*)(ws + WS_WIN) + (size_t)j * ZLD * DM, NTOK - row_lo, ZLD, DM};
    const ListOrder S = build_units(lds, (NTOK - row_lo) / 256, ZLD / 256, nb, bid, nullptr, 0);
    EpiStoreBf16 E{(bf16_t*)(ws + WS_Z) + (size_t)row_lo * ZLD, ZLD};
    pg8::gemm_phase<EpiStoreBf16, ListOrder, true, true>(lds, g, S, E);
}

__device__ __forceinline__ void ph_rwkv_pre(const Args& A, int j, int row_lo, int bid, int nb) {
    unsigned char* ws = opq(A.ws); const float* const* IN = (const float* const*)(ws + WS_PTRS);
    const int tid = tid_opaque(), lane = tid & 63, wid = tid >> 6;
    const bf16_t* Z = (const bf16_t*)(ws + WS_Z);
    const float* mu = INP(I_RWMU) + (size_t)j * 2 * RWC; const float* kkw = INP(I_RWKK) + j * 512;
    bf16_t* RB = (bf16_t*)(ws + WS_RB); bf16_t* KS = (bf16_t*)(ws + WS_KS); bf16_t* VS = (bf16_t*)(ws + WS_VS); bf16_t* KKN = (bf16_t*)(ws + WS_KKN); bf16_t* LIN = (bf16_t*)(ws + WS_LIN);
    for (int g = row_lo + bid * NWAVES + wid; g < NTOK; g += nb * NWAVES) {
        const Tok tk = tokinfo(g);
        const bool hp = tk.t > 0, hn = tk.t < tk.T - 1;
        const bf16_t* zc = Z + (size_t)g * ZLD;
#pragma unroll
        for (int i = 0; i < 15; ++i) {
            const int col = i * 128 + lane * 2;
            const unsigned c = *(const unsigned*)(zc + col), p = hp ? *(const unsigned*)(zc - ZLD + col) : 0u, n = hn ? *(const unsigned*)(zc + ZLD + col) : 0u;
            const f32x2_t m0 = *(const f32x2_t*)(mu + col), m1 = *(const f32x2_t*)(mu + RWC + col);
            const float z0 = __builtin_bit_cast(float, c << 16), z1 = __builtin_bit_cast(float, c & 0xffff0000u);
            const float p0 = __builtin_bit_cast(float, p << 16), p1 = __builtin_bit_cast(float, p & 0xffff0000u);
            const float n0 = __builtin_bit_cast(float, n << 16), n1 = __builtin_bit_cast(float, n & 0xffff0000u);
            const float s0 = z0 + m0.x * (p0 - z0) + m1.x * (n0 - z0), s1 = z1 + m0.y * (p1 - z1) + m1.y * (n1 - z1);
            if (i < 4) *(unsigned*)(RB + (size_t)g * 512 + col) = pk2(s0, s1);
            else if (i < 8) {
                const int ck = col - 512;
                *(unsigned*)(KS + (size_t)g * 512 + ck) = pk2(s0, s1);
                const f32x2_t kw = *(const f32x2_t*)(kkw + ck);
                const float k0 = s0 * kw.x, k1 = s1 * kw.y;
                float ss = k0 * k0 + k1 * k1;
#pragma unroll
                for (int o = 1; o < 32; o <<= 1) ss += __shfl_xor(ss, o);
                const float inv = 1.0f / fmaxf(sqrtf(ss), 1e-12f);
                *(unsigned*)(KKN + (size_t)g * 512 + ck) = pk2(k0 * inv, k1 * inv);
            }
            else if (i < 12) *(unsigned*)(VS + (size_t)g * 512 + (col - 1024)) = pk2(s0, s1);
            else if (i == 12) *(unsigned*)(LIN + (size_t)g * 384 + (col - 1536)) = pk2(tanhf(s0), tanhf(s1));
            else if (i == 13) *(unsigned*)(LIN + (size_t)g * 384 + 128 + (col - 1664)) = pk2(s0, s1);
            else *(unsigned*)(LIN + (size_t)g * 384 + 256 + (col - 1792)) = pk2(sigmoidf_(s0), sigmoidf_(s1));
        }
    }
}
__device__ __forceinline__ void ph_gemm_lora(const Args& A, int j, int row_lo, LAS unsigned char* lds, int bid, int nb) {
    unsigned char* ws = opq(A.ws);
    int Kq = LORA_K; asm volatile("" : "+s"(Kq));
    pg8::Gemm g{(const bf16_t*)(ws + WS_LIN) + (size_t)row_lo * LORA_K, (const bf16_t*)(ws + WS_WLORA) + (size_t)j * LORA_N * LORA_K, NTOK - row_lo, LORA_N, Kq};
    const ListOrder S = build_units(lds, (NTOK - row_lo) / 256, LORA_N / 256, nb, bid, nullptr, 0);
    EpiLora E{(bf16_t*)(ws + WS_LO), (const float*)(ws + WS_LBIAS) + (size_t)j * LORA_N, row_lo};
    pg8::gemm_phase<EpiLora, ListOrder, true, true>(lds, g, S, E);
}

constexpr int R_A2 = 0, R_RT = 2048, R_BT = 4096, R_KT = 6144, R_VT = 8192, R_MBR = 10240, R_MKR = 10752, R_G = 11264, R_P = 11776;
__device__ __forceinline__ bf16x8 frag4(u32x2 lo) { const u32x4 w = {lo.x, lo.y, 0u, 0u}; return __builtin_bit_cast(bf16x8, w); }
__device__ __forceinline__ bf16x8 frag8(u32x2 lo, u32x2 hi) { const u32x4 w = {lo.x, lo.y, hi.x, hi.y}; return __builtin_bit_cast(bf16x8, w); }
__device__ __forceinline__ u32x2 pack4(f32x4 v) { u32x2 o; o.x = cvtpk_s(v[0], v[1]); o.y = cvtpk_s(v[2], v[3]); return o; }
__device__ __forceinline__ int wkv_token(int b, int dir, int s) {
    if (s < TC) return b * TC + (dir ? (TC - 1 - s) : s);
    const int q = s - TC; return NCTX + b * TL + (dir ? (TL - 1 - q) : q);
}
__device__ __forceinline__ void ph_wkv_prep(const Args& A, int j, LAS unsigned char* lds, int bid, int nb) {
    unsigned char* ws = opq(A.ws); const float* const* IN = (const float* const*)(ws + WS_PTRS);
    const int tid = tid_opaque(), lane = tid & 63, wid = tid >> 6, c16 = lane & 15, g4 = lane >> 4;
    constexpr int RS = 144;
    LAS unsigned char* wl = lds + wid * 16384;
    LAS unsigned char* Lat = wl; LAS unsigned char* Lbt = wl + 2304; LAS unsigned char* Lkt = wl + 4608; LAS unsigned char* Lrt = wl + 6912;
    LAS unsigned char* LaT = wl + 9216;
    LAS float* Lnf = (LAS float*)(wl + 11264);
    LAS unsigned char* Lx = wl + 12352;
    const size_t FS = (size_t)NTOK * 512;
    const bf16_t* RB = (const bf16_t*)(ws + WS_RB); const bf16_t* KS = (const bf16_t*)(ws + WS_KS); const bf16_t* VS = (const bf16_t*)(ws + WS_VS); const bf16_t* KKN = (const bf16_t*)(ws + WS_KKN);
    for (int unit = bid * NWAVES + wid; unit < 256 * WKV_NCH; unit += nb * NWAVES) {
        const int inst = unit / WKV_NCH, c = unit - inst * WKV_NCH, dir = inst & 1, h = (inst >> 1) & 7, b = inst >> 4;
        const int g0 = wkv_token(b, dir, c * 16), gstep = dir ? -1 : 1;
        unsigned char* rec = ws + WS_WKV + (size_t)unit * WKV_REC;
        const bf16_t* LWd = (const bf16_t*)(ws + WS_LO) + dir * FS; const bf16_t* ABd = (const bf16_t*)(ws + WS_AB) + dir * FS;
        const float kaw = INP(I_RWKA)[j * 512 + h * 64 + lane];
        float cs = 0.f, ec = 1.f; unsigned aTp[8], bTp[8], kTp[8], vTp[8]; float pa = 0.f, pb = 0.f, pk = 0.f, pv = 0.f;
#pragma unroll
        for (int t = 0; t < 16; ++t) {
            const size_t o = (size_t)(g0 + gstep * t) * 512 + h * 64 + lane;
            const float lw = bf2f(LWd[o]), av = bf2f(ABd[o]), kkv = bf2f(KKN[o]), ksv = bf2f(KS[o]), rv = bf2f(RB[o]), vv = bf2f(VS[o]);
            const float bb = kkv * av, kdv = ksv * (1.0f + (av - 1.0f) * kaw);
            const float ep = ec; cs += lw; ec = __expf(cs); const float em = __expf(-cs);
            const float at = -kkv * ep, bt = bb * em, kt = kdv * em, rt = rv * ec;
            *(LAS bf16_t*)(Lat + t * RS + lane * 2) = (bf16_t)f2bf(at); *(LAS bf16_t*)(Lbt + t * RS + lane * 2) = (bf16_t)f2bf(bt);
            *(LAS bf16_t*)(Lkt + t * RS + lane * 2) = (bf16_t)f2bf(kt); *(LAS bf16_t*)(Lrt + t * RS + lane * 2) = (bf16_t)f2bf(rt);
            if (t & 1) { aTp[t >> 1] = pk2(pa, at); bTp[t >> 1] = pk2(pb, bt); kTp[t >> 1] = pk2(pk, kt); vTp[t >> 1] = pk2(pv, vv); }
            else { pa = at; pb = bt; pk = kt; pv = vv; }
        }
        *(float*)(rec + R_P + lane * 4) = ec;
        *(u32x4*)(rec + R_BT + lane * 32) = (u32x4){bTp[0], bTp[1], bTp[2], bTp[3]}; *(u32x4*)(rec + R_BT + lane * 32 + 16) = (u32x4){bTp[4], bTp[5], bTp[6], bTp[7]};
        *(u32x4*)(rec + R_KT + lane * 32) = (u32x4){kTp[0], kTp[1], kTp[2], kTp[3]}; *(u32x4*)(rec + R_KT + lane * 32 + 16) = (u32x4){kTp[4], kTp[5], kTp[6], kTp[7]};
        *(u32x4*)(rec + R_VT + lane * 32) = (u32x4){vTp[0], vTp[1], vTp[2], vTp[3]}; *(u32x4*)(rec + R_VT + lane * 32 + 16) = (u32x4){vTp[4], vTp[5], vTp[6], vTp[7]};
        *(LAS u32x4*)(LaT + lane * 32) = (u32x4){aTp[0], aTp[1], aTp[2], aTp[3]}; *(LAS u32x4*)(LaT + lane * 32 + 16) = (u32x4){aTp[4], aTp[5], aTp[6], aTp[7]};
        asm volatile("s_waitcnt lgkmcnt(0)" ::: "memory");
        f32x4 nD = {0.f, 0.f, 0.f, 0.f}, makD = nD, mbrD = nD, mkrD = nD;
#pragma unroll
        for (int ks = 0; ks < 2; ++ks) {
            const int off = c16 * RS + (32 * ks + 8 * g4) * 2;
            const bf16x8 fa = *(const LAS bf16x8*)(Lat + off), fb = *(const LAS bf16x8*)(Lbt + off), fk = *(const LAS bf16x8*)(Lkt + off), fr = *(const LAS bf16x8*)(Lrt + off);
            nD = __builtin_amdgcn_mfma_f32_16x16x32_bf16(fa, fb, nD, 0, 0, 0);
            makD = __builtin_amdgcn_mfma_f32_16x16x32_bf16(fa, fk, makD, 0, 0, 0);
            mbrD = __builtin_amdgcn_mfma_f32_16x16x32_bf16(fb, fr, mbrD, 0, 0, 0);
            mkrD = __builtin_amdgcn_mfma_f32_16x16x32_bf16(fk, fr, mkrD, 0, 0, 0);
        }
#pragma unroll
        for (int r = 0; r < 4; ++r) {
            const int row = 4 * g4 + r;
            nD[r] = (c16 < row) ? nD[r] : 0.f; makD[r] = (c16 < row) ? makD[r] : 0.f;
            mbrD[r] = (row <= c16) ? mbrD[r] : 0.f; mkrD[r] = (row <= c16) ? mkrD[r] : 0.f;
            Lnf[row * 17 + c16] = nD[r];
        }
        asm volatile("s_waitcnt lgkmcnt(0)" ::: "memory");
        float x[16];
#pragma unroll
        for (int t = 0; t < 16; ++t) {
            float acc = (t == c16) ? 1.f : 0.f;
#pragma unroll
            for (int i = 0; i < t; ++i) acc += Lnf[t * 17 + i] * x[i];
            x[t] = acc;
        }
        if (g4 == 0) {
#pragma unroll
            for (int t = 0; t < 16; ++t) *(LAS bf16_t*)(Lx + t * 32 + c16 * 2) = (bf16_t)f2bf(x[t]);
        }
        asm volatile("s_waitcnt lgkmcnt(0)" ::: "memory");
        const bf16x8 xB = frag4(*(const LAS u32x2*)(Lx + c16 * 32 + g4 * 8));
        const f32x4 z4 = {0.f, 0.f, 0.f, 0.f};
        const f32x4 gD = __builtin_amdgcn_mfma_f32_16x16x32_bf16(frag4(pack4(makD)), xB, z4, 0, 0, 0);
        *(u32x2*)(rec + R_G + (c16 * 16 + 4 * g4) * 2) = pack4(gD);
        *(u32x2*)(rec + R_MBR + (c16 * 16 + 4 * g4) * 2) = pack4(mbrD);
        *(u32x2*)(rec + R_MKR + (c16 * 16 + 4 * g4) * 2) = pack4(mkrD);
#pragma unroll
        for (int mt = 0; mt < 4; ++mt) {
            const bf16x8 aA = frag4(*(const LAS u32x2*)(LaT + (16 * mt + c16) * 32 + g4 * 8));
            const f32x4 d = __builtin_amdgcn_mfma_f32_16x16x32_bf16(aA, xB, z4, 0, 0, 0);
            *(u32x2*)(rec + R_A2 + (c16 * 64 + 16 * mt + 4 * g4) * 2) = pack4(d);
        }
        { const int row = lane >> 2, cb = (lane & 3) * 16;
          const u32x4 r0 = *(const LAS u32x4*)(Lrt + row * RS + cb * 2), r1 = *(const LAS u32x4*)(Lrt + row * RS + cb * 2 + 16);
          *(u32x4*)(rec + R_RT + (row * 64 + cb) * 2) = r0; *(u32x4*)(rec + R_RT + (row * 64 + cb) * 2 + 16) = r1; }
        asm volatile("s_waitcnt lgkmcnt(0)" ::: "memory");
    }
}
struct WkvOps { u32x2 a2[4], rt[4], g, mkr, mbr, bt[4], kt[4], vt; f32x4 p[4]; };
__device__ __forceinline__ void wkv_load(WkvOps& o, const unsigned char* rec, int c16, int g4, int v0) {
#pragma unroll
    for (int q = 0; q < 4; ++q) {
        o.a2[q] = *(const u32x2*)(rec + R_A2 + (c16 * 64 + 16 * q + 4 * g4) * 2);
        o.rt[q] = *(const u32x2*)(rec + R_RT + (c16 * 64 + 16 * q + 4 * g4) * 2);
        o.bt[q] = *(const u32x2*)(rec + R_BT + ((16 * q + c16) * 16 + 4 * g4) * 2);
        o.kt[q] = *(const u32x2*)(rec + R_KT + ((16 * q + c16) * 16 + 4 * g4) * 2);
        o.p[q] = *(const f32x4*)(rec + R_P + (16 * q + 4 * g4) * 4);
    }
    o.g = *(const u32x2*)(rec + R_G + (c16 * 16 + 4 * g4) * 2); o.mkr = *(const u32x2*)(rec + R_MKR + (c16 * 16 + 4 * g4) * 2); o.mbr = *(const u32x2*)(rec + R_MBR + (c16 * 16 + 4 * g4) * 2);
    o.vt = *(const u32x2*)(rec + R_VT + ((v0 + c16) * 16 + 4 * g4) * 2);
}
__device__ __forceinline__ void ph_wkv_scan(const Args& A, int bid, int nb) {
    unsigned char* ws = opq(A.ws);
    const int tid = tid_opaque(), lane = tid & 63, wid = tid >> 6, c16 = lane & 15, g4 = lane >> 4;
    if (wid >= 4) return;
    float* YS = (float*)(ws + WS_YS); const size_t FS = (size_t)NTOK * 512;
    const int v0 = wid * 16;
    for (int inst = bid; inst < 256; inst += nb) {
        const int dir = inst & 1, h = (inst >> 1) & 7, b = inst >> 4;
        const unsigned char* rec0 = ws + WS_WKV + (size_t)inst * WKV_NCH * WKV_REC;
        float* Y = YS + dir * FS + h * 64 + v0 + c16;
        f32x4 S[4];
#pragma unroll
        for (int mt = 0; mt < 4; ++mt) S[mt] = (f32x4){0.f, 0.f, 0.f, 0.f};
        WkvOps cur, nxt;
        wkv_load(cur, rec0, c16, g4, v0);
        for (int c = 0; c < WKV_NCH; ++c) {
            wkv_load(nxt, rec0 + (size_t)((c + 1 < WKV_NCH) ? c + 1 : c) * WKV_REC, c16, g4, v0);
            const f32x4 z4 = {0.f, 0.f, 0.f, 0.f};
            const bf16x8 sb0 = frag8(pack4(S[0]), pack4(S[1])), sb1 = frag8(pack4(S[2]), pack4(S[3]));
            const bf16x8 vb = frag4(cur.vt);
            f32x4 U = __builtin_amdgcn_mfma_f32_16x16x32_bf16(frag4(cur.g), vb, z4, 0, 0, 0);
            U = __builtin_amdgcn_mfma_f32_16x16x32_bf16(frag8(cur.a2[0], cur.a2[1]), sb0, U, 0, 0, 0);
            U = __builtin_amdgcn_mfma_f32_16x16x32_bf16(frag8(cur.a2[2], cur.a2[3]), sb1, U, 0, 0, 0);
            f32x4 Yt = __builtin_amdgcn_mfma_f32_16x16x32_bf16(frag4(cur.mkr), vb, z4, 0, 0, 0);
            Yt = __builtin_amdgcn_mfma_f32_16x16x32_bf16(frag8(cur.rt[0], cur.rt[1]), sb0, Yt, 0, 0, 0);
            Yt = __builtin_amdgcn_mfma_f32_16x16x32_bf16(frag8(cur.rt[2], cur.rt[3]), sb1, Yt, 0, 0, 0);
            const bf16x8 ub = frag4(pack4(U));
            Yt = __builtin_amdgcn_mfma_f32_16x16x32_bf16(frag4(cur.mbr), ub, Yt, 0, 0, 0);
#pragma unroll
            for (int mt = 0; mt < 4; ++mt) {
                f32x4 sn = __builtin_amdgcn_mfma_f32_16x16x32_bf16(frag4(cur.kt[mt]), vb, S[mt], 0, 0, 0);
                sn = __builtin_amdgcn_mfma_f32_16x16x32_bf16(frag4(cur.bt[mt]), ub, sn, 0, 0, 0);
                S[mt] = sn * cur.p[mt];
            }
#pragma unroll
            for (int r = 0; r < 4; ++r) Y[(size_t)wkv_token(b, dir, c * 16 + 4 * g4 + r) * 512] = Yt[r];
            cur = nxt;
        }
    }
}

__device__ __forceinline__ void ph_qk(const Args& A, int j, int row_lo, int bid, int nb) {
    unsigned char* ws = opq(A.ws); const float* const* IN = (const float* const*)(ws + WS_PTRS);
    const int tid = tid_opaque(), lane = tid & 63, wid = tid >> 6;
    const bf16_t* Z = (const bf16_t*)(ws + WS_Z);
    bf16_t* QB = (bf16_t*)(ws + WS_QB); bf16_t* KB = (bf16_t*)(ws + WS_KB); bf16_t* VB = (bf16_t*)(ws + WS_VB);
    const int d0 = (lane & 7) * 8;
    float qn[8], kn[8], invf[8];
#pragma unroll
    for (int i = 0; i < 8; ++i) { qn[i] = INP(I_QN)[j * 64 + d0 + i]; kn[i] = INP(I_KN)[j * 64 + d0 + i]; invf[i] = __powf(10000.0f, -(float)((d0 + i) & 15) / 16.0f); }
    const bool upper = (d0 & 16) != 0, colaxis = (d0 & 32) != 0;
    for (int g = row_lo + bid * NWAVES + wid; g < NTOK; g += nb * NWAVES) {
        const Tok tk = tokinfo(g);
        const size_t krow = (size_t)tk.b * (TC + TL) + (tk.T == TL ? TC + tk.t : tk.t);
        const bf16_t* zr = Z + (size_t)g * ZLD + RWC;
        *(u32x4*)(VB + krow * 512 + lane * 8) = *(const u32x4*)(zr + 1024 + lane * 8);
        float cs[8], sn[8];
        if (tk.T == TL) {
            const float pos = (float)(colaxis ? (tk.t & 63) : (tk.t >> 6));
#pragma unroll
            for (int i = 0; i < 8; ++i) __sincosf(pos * invf[i], &sn[i], &cs[i]);
        }
#pragma unroll
        for (int isk = 0; isk < 2; ++isk) {
            const u32x4 raw = *(const u32x4*)(zr + isk * 512 + lane * 8);
            float x[8];
#pragma unroll
            for (int i = 0; i < 4; ++i) { x[2 * i] = __builtin_bit_cast(float, raw[i] << 16); x[2 * i + 1] = __builtin_bit_cast(float, raw[i] & 0xffff0000u); }
            float ss = 0.f;
#pragma unroll
            for (int i = 0; i < 8; ++i) ss += x[i] * x[i];
            ss += __shfl_xor(ss, 1); ss += __shfl_xor(ss, 2); ss += __shfl_xor(ss, 4);
            const float rs = rsqrtf(ss * (1.0f / 64.0f) + 1e-6f);
#pragma unroll
            for (int i = 0; i < 8; ++i) x[i] = x[i] * rs * (isk ? kn[i] : qn[i]);
            if (tk.T == TL) {
#pragma unroll
                for (int i = 0; i < 8; ++i) { const float other = __shfl_xor(x[i], 2); x[i] = upper ? (x[i] * cs[i] + other * sn[i]) : (x[i] * cs[i] - other * sn[i]); }
            }
            u32x4 o; o.x = pk2(x[0], x[1]); o.y = pk2(x[2], x[3]); o.z = pk2(x[4], x[5]); o.w = pk2(x[6], x[7]);
            if (isk) *(u32x4*)(KB + krow * 512 + lane * 8) = o; else *(u32x4*)(QB + (size_t)g * 512 + lane * 8) = o;
        }
    }
}

__device__ __forceinline__ void ph_attn(const Args& A, bool want_ctx, LAS unsigned char* lds, int bid, int nb) {
    unsigned char* ws = opq(A.ws);
    const bf16_t* QB = (const bf16_t*)(ws + WS_QB); const bf16_t* KB = (const bf16_t*)(ws + WS_KB); const bf16_t* VB = (const bf16_t*)(ws + WS_VB);
    float* OP = (float*)(ws + WS_OP);
    const int vcu = (nb % 8 == 0) ? (bid % 8) * (nb / 8) + bid / 8 : bid;
    const int nunits = 1024 + (want_ctx ? 128 : 0);
    for (int u = vcu; u < nunits; u += nb) {
        int b, h, m, q0, seq;
        if (u < 1024) { const int qb = u & 7; m = (u >> 3) & 1; h = (u >> 4) & 3; b = u >> 6; q0 = NCTX + b * TL + qb * 256; seq = TC + TL; }
        else { const int v = u - 1024; m = v & 1; h = (v >> 1) & 3; b = v >> 3; q0 = b * TC; seq = TC; }
        const int s = h * 2 + m;
        att::attn_body(QB + (size_t)q0 * 512 + s * 64, KB + (size_t)b * (TC + TL) * 512 + s * 64, VB + (size_t)b * (TC + TL) * 512 + h * 128,
                       OP + (size_t)m * NTOK * 512 + (size_t)q0 * 512 + h * 128, seq, lds);
    }
}

__device__ __forceinline__ void ph_merge(const Args& A, int l, int row_lo, int bid, int nb) {
    unsigned char* ws = opq(A.ws); const float* const* IN = (const float* const*)(ws + WS_PTRS);
    const int j = l >> 1;
    const int tid = tid_opaque(), lane = tid & 63, wid = tid >> 6, c0 = lane * 8;
    const float lam_init = 0.8f - 0.6f * __expf(-0.3f * (float)l);
    const float* lp = INP(I_LAM) + j * 4 * 64;
    const float lam = __expf(wave_sum(lp[lane] * lp[64 + lane])) - __expf(wave_sum(lp[128 + lane] * lp[192 + lane])) + lam_init;
    const size_t FS = (size_t)NTOK * 512;
    const bf16_t* RB = (const bf16_t*)(ws + WS_RB); const bf16_t* KS = (const bf16_t*)(ws + WS_KS); const bf16_t* VS = (const bf16_t*)(ws + WS_VS);
    const bf16_t* AB = (const bf16_t*)(ws + WS_AB); const bf16_t* GB = (const bf16_t*)(ws + WS_GB);
    const float* YS = (const float*)(ws + WS_YS); const float* OP = (const float*)(ws + WS_OP);
    bf16_t* CAT = (bf16_t*)(ws + WS_CAT);
    float gnw[8], gnb[8], kaw[8], rkw[8], sub[8];
#pragma unroll
    for (int i = 0; i < 8; ++i) { gnw[i] = INP(I_GNW)[j * 512 + c0 + i]; gnb[i] = INP(I_GNB)[j * 512 + c0 + i]; kaw[i] = INP(I_RWKA)[j * 512 + c0 + i]; rkw[i] = INP(I_RWRK)[j * 512 + c0 + i];
        sub[i] = INP(I_SUBLN)[j * 128 + ((c0 + i) & 127)] * (1.0f - lam_init); }
#define LD8BF(dst, ptr) do { const u32x4 _t = *(const u32x4*)(ptr); _Pragma("unroll") for (int _i = 0; _i < 4; ++_i) { dst[2 * _i] = __builtin_bit_cast(float, _t[_i] << 16); dst[2 * _i + 1] = __builtin_bit_cast(float, _t[_i] & 0xffff0000u); } } while (0)
    for (int g = row_lo + bid * NWAVES + wid; g < NTOK; g += nb * NWAVES) {
        const size_t o = (size_t)g * 512 + c0;
        float y[8], r_[8], k_[8], v_[8], a0[8], a1[8], gg[8];
        { const f32x4 y0 = *(const f32x4*)(YS + o), y1 = *(const f32x4*)(YS + o + 4), z0 = *(const f32x4*)(YS + FS + o), z1 = *(const f32x4*)(YS + FS + o + 4);
#pragma unroll
          for (int i = 0; i < 4; ++i) { y[i] = y0[i] + z0[i]; y[4 + i] = y1[i] + z1[i]; } }
        LD8BF(r_, RB + o); LD8BF(k_, KS + o); LD8BF(v_, VS + o); LD8BF(a0, AB + o); LD8BF(a1, AB + FS + o); LD8BF(gg, GB + o);
        float sy = 0.f, sb = 0.f;
#pragma unroll
        for (int i = 0; i < 8; ++i) { sy += y[i]; sb += r_[i] * k_[i] * (2.0f + (a0[i] + a1[i] - 2.0f) * kaw[i]) * rkw[i]; }
        sy += __shfl_xor(sy, 1); sy += __shfl_xor(sy, 2); sy += __shfl_xor(sy, 4);
        sb += __shfl_xor(sb, 1); sb += __shfl_xor(sb, 2); sb += __shfl_xor(sb, 4);
        const float mu = sy * (1.0f / 64.0f);
        float sv = 0.f;
#pragma unroll
        for (int i = 0; i < 8; ++i) { y[i] -= mu; sv += y[i] * y[i]; }
        sv += __shfl_xor(sv, 1); sv += __shfl_xor(sv, 2); sv += __shfl_xor(sv, 4);
        const float rstd = rsqrtf(sv * (1.0f / 64.0f) + 64e-5f);
        float ya[8];
#pragma unroll
        for (int i = 0; i < 8; ++i) ya[i] = (y[i] * rstd * gnw[i] + gnb[i] + sb * v_[i]) * gg[i];
        { u32x4 w; w.x = pk2(ya[0], ya[1]); w.y = pk2(ya[2], ya[3]); w.z = pk2(ya[4], ya[5]); w.w = pk2(ya[6], ya[7]); *(u32x4*)(CAT + (size_t)g * DM + c0) = w; }
        float od[8];
        { const f32x4 p0 = *(const f32x4*)(OP + o), p1 = *(const f32x4*)(OP + o + 4), q0 = *(const f32x4*)(OP + FS + o), q1 = *(const f32x4*)(OP + FS + o + 4);
#pragma unroll
          for (int i = 0; i < 4; ++i) { od[i] = p0[i] - lam * q0[i]; od[4 + i] = p1[i] - lam * q1[i]; } }
        float so = 0.f;
#pragma unroll
        for (int i = 0; i < 8; ++i) so += od[i] * od[i];
        so += __shfl_xor(so, 1); so += __shfl_xor(so, 2); so += __shfl_xor(so, 4); so += __shfl_xor(so, 8);
        const float ro = rsqrtf(so * (1.0f / 128.0f) + 1e-6f);
        { u32x4 w; w.x = pk2(od[0] * ro * sub[0], od[1] * ro * sub[1]); w.y = pk2(od[2] * ro * sub[2], od[3] * ro * sub[3]);
          w.z = pk2(od[4] * ro * sub[4], od[5] * ro * sub[5]); w.w = pk2(od[6] * ro * sub[6], od[7] * ro * sub[7]); *(u32x4*)(CAT + (size_t)g * DM + 512 + c0) = w; }
    }
#undef LD8BF
}

__device__ __forceinline__ void ph_gemm_out(const Args& A, int l, size_t x_off, size_t wt_off, int row_lo, LAS unsigned char* lds, int bid, int nb) {
    unsigned char* ws = opq(A.ws); const float* const* IN = (const float* const*)(ws + WS_PTRS); (void)IN;
    pg8::Gemm g{(const bf16_t*)(ws + x_off) + (size_t)row_lo * DM, (const bf16_t*)(ws + wt_off), NTOK - row_lo, DM, DM};
    const ListOrder S = build_units(lds, (NTOK - row_lo) / 256, DM / 256, nb, bid, nullptr, 0);
    EpiResidual E{(float*)(ws + WS_H) + (size_t)row_lo * DM, (const float*)(ws + WS_MOD) + (size_t)l * 17 * 6144 + 2 * 1024, row_lo};
    pg8::gemm_phase<EpiResidual, ListOrder, true, true>(lds, g, S, E);
}

__device__ __forceinline__ void ph_gemm_sgin(const Args& A, int j, int row_lo, LAS unsigned char* lds, int bid, int nb) {
    unsigned char* ws = opq(A.ws); const float* const* IN = (const float* const*)(ws + WS_PTRS); (void)IN;
    pg8::Gemm g{(const bf16_t*)(ws + WS_ABF) + (size_t)row_lo * DM, (const bf16_t*)(ws + WS_SGIN) + (size_t)j * 2048 * DM, NTOK - row_lo, 2048, DM};
    const ListOrder S = build_units(lds, (NTOK - row_lo) / 256, 2048 / 256, nb, bid, nullptr, 0);
    EpiGeluBf16 E{(bf16_t*)(ws + WS_Z2) + (size_t)row_lo * 2048, 2048, INP(I_SGBIN) + j * 2048};
    pg8::gemm_phase<EpiGeluBf16, ListOrder, true, true>(lds, g, S, E);
}
__device__ __forceinline__ void ph_sgu_ln(const Args& A, int j, int row_lo, int bid, int nb) {
    unsigned char* ws = opq(A.ws); const float* const* IN = (const float* const*)(ws + WS_PTRS); (void)IN;
    const int tid = tid_opaque(), lane = tid & 63, wid = tid >> 6;
    const bf16_t* Z2 = (const bf16_t*)(ws + WS_Z2); float* VN = (float*)(ws + WS_VN);
    const float* lg = INP(I_SGLNG) + j * 1024; const float* lb = INP(I_SGLNB) + j * 1024;
    for (int row = row_lo + bid * NWAVES + wid; row < NTOK; row += nb * NWAVES) {
        f32x4 v[4]; float s = 0.f;
#pragma unroll
        for (int q = 0; q < 4; ++q) { const u32x2 t = *(const u32x2*)(Z2 + (size_t)row * 2048 + 1024 + q * 256 + lane * 4);
            v[q] = (f32x4){__builtin_bit_cast(float, t.x << 16), __builtin_bit_cast(float, t.x & 0xffff0000u), __builtin_bit_cast(float, t.y << 16), __builtin_bit_cast(float, t.y & 0xffff0000u)}; s += (v[q].x + v[q].y) + (v[q].z + v[q].w); }
        const float mean = wave_sum(s) * (1.0f / 1024.0f); float s2 = 0.f;
#pragma unroll
        for (int q = 0; q < 4; ++q) { v[q] = v[q] - mean; s2 += (v[q].x * v[q].x + v[q].y * v[q].y) + (v[q].z * v[q].z + v[q].w * v[q].w); }
        const float rstd = rsqrtf(wave_sum(s2) * (1.0f / 1024.0f) + 1e-5f);
#pragma unroll
        for (int q = 0; q < 4; ++q) { const int col = q * 256 + lane * 4; *(f32x4*)(VN + (size_t)row * DM + col) = v[q] * rstd * *(const f32x4*)(lg + col) + *(const f32x4*)(lb + col); }
    }
}
__device__ __forceinline__ void ph_sgu_spatial(const Args& A, int j, int row_lo, LAS unsigned char* lds, int bid, int nb) {
    unsigned char* ws = opq(A.ws); const float* const* IN = (const float* const*)(ws + WS_PTRS); (void)IN;
    const int tid = tid_opaque();
    const bf16_t* Z2 = (const bf16_t*)(ws + WS_Z2); const float* VN = (const float*)(ws + WS_VN); bf16_t* G = (bf16_t*)(ws + WS_G);
    LAS float* vt = (LAS float*)lds;
    LAS float* wl = (LAS float*)(lds + 65536);
    const int ch0 = row_lo / 128, nch = NTOK / 128 - ch0;
    for (int u = bid; u < nch * 8; u += nb) {
        const int ci = ch0 + u / 8, g = u % 8;
        const float* wsg = INP(I_SGWS) + ((size_t)j * 8 + g) * 128 * 128;
        for (int i = tid; i < 128 * 32; i += NTHREADS) {
            const int q = i >> 5, c4 = (i & 31) * 4;
            *(LAS f32x4*)(vt + q * 128 + c4) = *(const f32x4*)(VN + (size_t)(ci * 128 + q) * DM + g * 128 + c4);
            *(LAS f32x4*)(wl + q * 128 + c4) = *(const f32x4*)(wsg + q * 128 + c4);
        }
        __syncthreads();
        const int c = tid & 127, pg = tid >> 7;
        float acc[32];
#pragma unroll
        for (int i = 0; i < 32; ++i) acc[i] = 0.f;
        for (int q = 0; q < 128; q += 4) {
            const float v0 = vt[q * 128 + c], v1 = vt[(q + 1) * 128 + c], v2 = vt[(q + 2) * 128 + c], v3 = vt[(q + 3) * 128 + c];
#pragma unroll
            for (int i = 0; i < 32; ++i) { const f32x4 w = *(const LAS f32x4*)(wl + (pg * 32 + i) * 128 + q); acc[i] += (w.x * v0 + w.y * v1) + (w.z * v2 + w.w * v3); }
        }
#pragma unroll
        for (int i = 0; i < 32; ++i) {
            const int p = pg * 32 + i; const size_t row = (size_t)ci * 128 + p;
            const float uu = bf2f(Z2[row * 2048 + g * 128 + c]);
            const float sv = acc[i] + INP(I_SGBS)[((size_t)j * 8 + g) * 128 + p];
            G[row * DM + g * 128 + c] = (bf16_t)f2bf(uu * sv);
        }
        __syncthreads();
    }
}

__device__ __forceinline__ int moe_layout(const Args& A, int l, int bid, int nb, LAS int* off  , LAS int* cntl  , LAS int* tile_e  , LAS int* base  ) {
    const int tid = tid_opaque();
    const int* bc = (const int*)(opq(A.ws) + WS_BCNT) + (size_t)l * 256 * 32;
    if (tid < 64) {
        int n = 0, pre = 0;
        if (tid < 32) {
#pragma unroll 8
            for (int b = 0; b < nb; ++b) { const int c = bc[b * 32 + tid]; n += c; pre += (b < bid) ? c : 0; }
        }
        const int nt = (n + 255) >> 8;
        int x = nt;
#pragma unroll
        for (int o = 1; o < 32; o <<= 1) { const int y = __shfl_up(x, o); if (tid >= o) x += y; }
        const int start = x - nt;
        if (tid < 32) {
            cntl[tid] = n; off[tid] = start * 256; base[tid] = start * 256 + pre;
#pragma unroll 1
            for (int t = 0; t < nt; ++t) tile_e[start + t] = tid;
        }
        if (tid == 31) off[32] = x * 256;
    }
    __syncthreads();
    return off[32] >> 8;
}
__device__ __forceinline__ void ph_moe_scatter(const Args& A, int l, int row_lo, LAS unsigned char* lds, int bid, int nb) {
    unsigned char* ws = opq(A.ws);
    const int tid = tid_opaque(), lane = tid & 63, wid = tid >> 6;
    LAS int* off = (LAS int*)(lds + LDS_TAB); LAS int* cntl = off + 64; LAS int* tile_e = off + 128; LAS int* base = off + 800;
    moe_layout(A, l, bid, nb, off, cntl, tile_e, base);
    const bf16_t* abf = (const bf16_t*)(ws + WS_ABF); bf16_t* XP = (bf16_t*)(ws + WS_XP);
    const int* te = (const int*)(ws + WS_TOKE); const int* tr = (const int*)(ws + WS_TOKR); int* rowof = (int*)(ws + WS_ROWOF);
    for (int row = row_lo + bid * NWAVES + wid; row < NTOK; row += nb * NWAVES) {
        const u32x4* src = (const u32x4*)(abf + (size_t)row * DM);
        const u32x4 s0 = src[lane], s1 = src[64 + lane];
#pragma unroll
        for (int k = 0; k < 4; ++k) {
            const int e = te[(size_t)row * 4 + k];
            const int pos = base[e] + tr[(size_t)row * 4 + k];
            if (lane == 0) rowof[(size_t)row * 4 + k] = pos;
            u32x4* dst = (u32x4*)(XP + (size_t)pos * DM);
            dst[lane] = s0; dst[64 + lane] = s1;
        }
    }
    for (int e = bid; e < 32; e += nb) {
        const int r0 = off[e] + cntl[e], r1 = off[e + 1];
        for (int i = tid; i < (r1 - r0) * 128; i += NTHREADS) ((u32x4*)(XP + (size_t)r0 * DM))[i] = (u32x4){0u, 0u, 0u, 0u};
    }
}
__device__ __forceinline__ void ph_moe_gemm1(const Args& A, int l, LAS unsigned char* lds, int bid, int nb) {
    unsigned char* ws = opq(A.ws); const float* const* IN = (const float* const*)(ws + WS_PTRS); (void)IN;
    LAS int* off = (LAS int*)(lds + LDS_TAB); LAS int* cntl = off + 64; LAS int* tile_e = off + 128; LAS int* base = off + 800;
    const int T = moe_layout(A, l, bid, nb, off, cntl, tile_e, base);
    pg8::Gemm g{(const bf16_t*)(ws + WS_XP), (const bf16_t*)(ws + WS_W1) + (size_t)l * NE * 2048 * DM, T * 256, 2048, DM};
    const ListOrder S = build_units(lds, T, 8, nb, bid, tile_e, 8);
    EpiMoe1 E{(bf16_t*)(ws + WS_ACT), INP(I_B1) + (size_t)l * NE * 2048};
    pg8::gemm_phase<EpiMoe1, ListOrder, true, true>(lds, g, S, E);
}
__device__ __forceinline__ void ph_moe_gemm2(const Args& A, int l, LAS unsigned char* lds, int bid, int nb) {
    unsigned char* ws = opq(A.ws); const float* const* IN = (const float* const*)(ws + WS_PTRS); (void)IN;
    LAS int* off = (LAS int*)(lds + LDS_TAB); LAS int* cntl = off + 64; LAS int* tile_e = off + 128; LAS int* base = off + 800;
    const int T = moe_layout(A, l, bid, nb, off, cntl, tile_e, base);
    pg8::Gemm g{(const bf16_t*)(ws + WS_ACT), (const bf16_t*)(ws + WS_W2) + (size_t)l * NE * DM * DM, T * 256, DM, DM};
    const ListOrder S = build_units(lds, T, 4, nb, bid, tile_e, 4);
    EpiMoe2 E{(bf16_t*)(ws + WS_YM), INP(I_B2) + (size_t)l * NE * DM};
    pg8::gemm_phase<EpiMoe2, ListOrder, true, true>(lds, g, S, E);
}
__device__ __forceinline__ void ph_moe_combine(const Args& A, int l, int row_lo, bool last, int bid, int nb) {
    unsigned char* ws = opq(A.ws); const float* const* IN = (const float* const*)(ws + WS_PTRS);
    const int tid = tid_opaque(), lane = tid & 63, wid = tid >> 6;
    float* H = (float*)(ws + WS_H); const float* mod = (const float*)(ws + WS_MOD); const bf16_t* YM = (const bf16_t*)(ws + WS_YM);
    const int* rowof = (const int*)(ws + WS_ROWOF); const float* tg = (const float*)(ws + WS_TOKG);
    bf16_t* abf = (bf16_t*)(ws + WS_ABF);
    const int ln = last ? l : l + 1;
    const float* gp = INP(I_N1G) + ln * 1024;
    for (int row = row_lo + bid * NWAVES + wid; row < NTOK; row += nb * NWAVES) {
        const Tok tk = tokinfo(row);
        const float* gate = mod + ((size_t)l * 17 + tk.modrow) * 6144 + 5 * 1024;
        int r[4]; float gk[4];
#pragma unroll
        for (int k = 0; k < 4; ++k) { r[k] = rowof[(size_t)row * 4 + k]; gk[k] = tg[(size_t)row * 4 + k]; }
        f32x4 hv[4]; float ss = 0.f;
#pragma unroll
        for (int q = 0; q < 4; ++q) {
            const int col = q * 256 + lane * 4;
            f32x4 m = (f32x4){0.f, 0.f, 0.f, 0.f};
#pragma unroll
            for (int k = 0; k < 4; ++k) { const u32x2 t = *(const u32x2*)(YM + (size_t)r[k] * DM + col);
                m = m + (f32x4){__builtin_bit_cast(float, t.x << 16), __builtin_bit_cast(float, t.x & 0xffff0000u), __builtin_bit_cast(float, t.y << 16), __builtin_bit_cast(float, t.y & 0xffff0000u)} * gk[k]; }
            hv[q] = *(const f32x4*)(H + (size_t)row * DM + col) + *(const f32x4*)(gate + col) * m;
            if (last) *(f32x4*)(as_global(((float* const*)IN)[38]) + (size_t)(row - NCTX) * DM + col) = hv[q];
            else *(f32x4*)(H + (size_t)row * DM + col) = hv[q];
            ss += (hv[q].x * hv[q].x + hv[q].y * hv[q].y) + (hv[q].z * hv[q].z + hv[q].w * hv[q].w);
        }
        if (!last) {
            const float rstd = rsqrtf(wave_sum(ss) * (1.0f / DM) + 1e-6f);
            const float* mrow = mod + ((size_t)ln * 17 + tk.modrow) * 6144;
#pragma unroll
            for (int q = 0; q < 4; ++q) {
                const int col = q * 256 + lane * 4;
                const f32x4 g = *(const f32x4*)(gp + col), sc = *(const f32x4*)(mrow + 1024 + col), sh = *(const f32x4*)(mrow + col);
                const f32x4 v = (hv[q] * rstd * g) * (sc + 1.0f) + sh;
                u32x2 o; o.x = pk2(v.x, v.y); o.y = pk2(v.z, v.w);
                *(u32x2*)(abf + (size_t)row * DM + col) = o;
            }
        }
    }
}

__global__ void __launch_bounds__(NTHREADS, 2) fwd_kernel(Args A) {
    extern __shared__ __attribute__((aligned(16))) unsigned char lds_raw[];
    LAS unsigned char* lds = (LAS unsigned char*)lds_raw;
    volatile LAS unsigned* misc = (volatile LAS unsigned*)(lds + LDS_MISC);
    const int tid = threadIdx.x, bid = blockIdx.x, nb = gridDim.x;
    if (tid < 64) misc[tid] = 0u;
    __syncthreads();
    XcdBarrier bar = xcd_barrier_post((unsigned*)(A.ws + WS_CTL) + CW_BAR, misc + 8);
    const int lo = A.ph_lo, hi = A.ph_hi;
    int pc = 0;
#ifndef PHSEL
#define PHSEL -1
#endif
#define SEL(k) (PHSEL < 0 || PHSEL == (k))
#ifndef REPEAT_MASK
#define REPEAT_MASK 0
#endif
#define RUN(k, call) do { if (SEL(k)) { call; if ((REPEAT_MASK >> (k)) & 1) { xcd_barrier(bar); call; } } } while (0)
#define PH_BEGIN if (pc >= lo && pc < hi) {
#define PH_END } if (pc >= lo && pc + 1 < hi) xcd_barrier(bar); ++pc;

    PH_BEGIN RUN(0, ph_prologue(A, lds, bid, nb)); PH_END

    for (int l = 0; l < 4; ++l) {
        const int j = l >> 1;
        const bool ctx_out = (l < 2), ctx_in = (l < 3);
        const int rin = ctx_in ? 0 : NCTX, rout = ctx_out ? 0 : NCTX;
        if (l == 0) { PH_BEGIN RUN(1, ph_norm<false>(A, l, rin, lds, bid, nb)); PH_END }
        if ((l & 1) == 0) {
            PH_BEGIN RUN(2, ph_gemm_win(A, j, rin, lds, bid, nb)); PH_END
            PH_BEGIN RUN(3, ph_rwkv_pre(A, j, rin, bid, nb)); RUN(4, ph_qk(A, j, rin, bid, nb)); PH_END
            PH_BEGIN RUN(19, ph_gemm_lora(A, j, rin, lds, bid, nb)); PH_END
            PH_BEGIN RUN(18, ph_wkv_prep(A, j, lds, bid, nb)); PH_END
            PH_BEGIN RUN(5, ph_wkv_scan(A, bid, nb)); PH_END
            PH_BEGIN RUN(6, ph_attn(A, ctx_out, lds, bid, nb)); PH_END
            PH_BEGIN RUN(7, ph_merge(A, l, rout, bid, nb)); PH_END
            PH_BEGIN RUN(8, ph_gemm_out(A, l, WS_CAT, WS_WOUT + (size_t)j * DM * DM * 2, rout, lds, bid, nb)); PH_END
        } else {
            PH_BEGIN RUN(9, ph_gemm_sgin(A, j, rin, lds, bid, nb)); PH_END
            PH_BEGIN RUN(10, ph_sgu_ln(A, j, rin, bid, nb)); PH_END
            PH_BEGIN RUN(11, ph_sgu_spatial(A, j, rout, lds, bid, nb)); PH_END
            PH_BEGIN RUN(12, ph_gemm_out(A, l, WS_G, WS_SGOUT + (size_t)j * DM * DM * 2, rout, lds, bid, nb)); PH_END
        }
        PH_BEGIN RUN(13, ph_norm<true>(A, l, rout, lds, bid, nb)); PH_END
        PH_BEGIN RUN(14, ph_moe_scatter(A, l, rout, lds, bid, nb)); PH_END
        PH_BEGIN RUN(15, ph_moe_gemm1(A, l, lds, bid, nb)); PH_END
        PH_BEGIN RUN(16, ph_moe_gemm2(A, l, lds, bid, nb)); PH_END
        PH_BEGIN RUN(17, ph_moe_combine(A, l, rout, l == 3, bid, nb)); PH_END
    }
}

extern "C" void kernel_launch(void* const* d_in, const int* in_sizes, int n_in, void* d_out, int out_size, void* d_ws, size_t ws_size, hipStream_t stream) {
    static int grid = 0;
    if (grid == 0) {
        if (n_in != 38 || out_size != NLAT * DM || ws_size < WS_END) { fprintf(stderr, "kernel_launch: unexpected shapes: n_in %d out %d ws %zu (need %zu)\n", n_in, out_size, ws_size, (size_t)WS_END); grid = -1; return; }
        int dev = 0, cus = 0, per_cu = 0;
        if (hipGetDevice(&dev) != hipSuccess || hipDeviceGetAttribute(&cus, hipDeviceAttributeMultiprocessorCount, dev) != hipSuccess) { grid = -1; return; }
        if (hipFuncSetAttribute((const void*)fwd_kernel, hipFuncAttributeMaxDynamicSharedMemorySize, LDS_BYTES) != hipSuccess) { fprintf(stderr, "kernel_launch: hipFuncSetAttribute failed\n"); grid = -1; return; }
        if (hipOccupancyMaxActiveBlocksPerMultiprocessor(&per_cu, (const void*)fwd_kernel, NTHREADS, LDS_BYTES) != hipSuccess || per_cu < 1)
            fprintf(stderr, "kernel_launch: occupancy query reports %d workgroups per CU\n", per_cu);
        (void)hipGetLastError();
        grid = cus;
    }
    if (grid < 0) return;
    if (hipMemsetAsync((char*)d_ws + WS_CTL, 0, CTL_ZERO_BYTES, stream) != hipSuccess) { fprintf(stderr, "kernel_launch: memset failed\n"); return; }
    Args a{};
    for (int i = 0; i < 38; ++i) a.in[i] = (const float*)d_in[i];
    a.out = (float*)d_out; a.ws = (unsigned char*)d_ws; a.ph_lo = 0; a.ph_hi = 1 << 20;
    hipLaunchKernelGGL(fwd_kernel, dim3(grid), dim3(NTHREADS), LDS_BYTES, stream, a);
    const hipError_t le = hipPeekAtLastError();
    if (le != hipSuccess) fprintf(stderr, "kernel_launch: launch failed: %s\n", hipGetErrorName(le));
}
```

```cpp
#include <hip/hip_runtime.h>
#include <cstdio>
#include <cstdint>

#define LAS __attribute__((address_space(3)))
typedef unsigned short bf16_t;
typedef short bf16x8 __attribute__((ext_vector_type(8)));
typedef float f32x4 __attribute__((ext_vector_type(4)));
typedef unsigned u32x4 __attribute__((ext_vector_type(4)));
typedef unsigned u32x2 __attribute__((ext_vector_type(2)));

constexpr int DM = 1024, NB = 16, TL = 2048, TC = 256;
constexpr int NCTX = NB * TC, NLAT = NB * TL, NTOK = NCTX + NLAT;
constexpr int RWC = 1920, EVC = 3456, ZLD = 3584;
constexpr int NE = 32;
constexpr int XPROWS = NTOK * 4 + NE * 256;
constexpr int NTHREADS = 512, NWAVES = 8;

constexpr size_t MiB = 1u << 20;
constexpr size_t al256(size_t x) { return (x + 255) & ~(size_t)255; }
constexpr size_t WS_CTL = 0, CTL_ZERO_BYTES = 1 * MiB - 4096;
constexpr size_t WS_PTRS = 1 * MiB - 4096;
constexpr size_t WS_MOD = 1 * MiB;
constexpr size_t WS_RTWT = al256(WS_MOD + (size_t)4 * 17 * 6144 * 4);
constexpr size_t WS_WIN = al256(WS_RTWT + (size_t)4 * 32 * 1024 * 4);
constexpr size_t WS_WOUT = al256(WS_WIN + (size_t)2 * ZLD * DM * 2);
constexpr size_t WS_SGIN = al256(WS_WOUT + (size_t)2 * DM * DM * 2);
constexpr size_t WS_SGOUT = al256(WS_SGIN + (size_t)2 * 2048 * DM * 2);
constexpr int LORA_N = 2560, LORA_K = 384;
constexpr size_t WS_WLORA = al256(WS_SGOUT + (size_t)2 * DM * DM * 2);
constexpr size_t WS_LBIAS = al256(WS_WLORA + (size_t)2 * LORA_N * LORA_K * 2);
constexpr size_t WS_W1 = al256(WS_LBIAS + (size_t)2 * LORA_N * 4);
constexpr size_t WS_W2 = al256(WS_W1 + (size_t)4 * NE * 2048 * DM * 2);
constexpr size_t WS_H = al256(WS_W2 + (size_t)4 * NE * DM * DM * 2);
constexpr size_t WS_ABF = al256(WS_H + (size_t)NTOK * DM * 4);
constexpr size_t WS_TOKE = al256(WS_ABF + (size_t)NTOK * DM * 2);
constexpr size_t WS_TOKG = al256(WS_TOKE + (size_t)NTOK * 4 * 4);
constexpr size_t WS_ROWOF = al256(WS_TOKG + (size_t)NTOK * 4 * 4);
constexpr size_t WS_TOKR = al256(WS_ROWOF + (size_t)NTOK * 4 * 4);
constexpr size_t WS_BCNT = al256(WS_TOKR + (size_t)NTOK * 4 * 4);
constexpr size_t WS_SRCROW = al256(WS_BCNT + (size_t)4 * 256 * 32 * 4);
constexpr size_t WS_R = al256(WS_SRCROW + (size_t)XPROWS * 4);
constexpr size_t FSZ = (size_t)NTOK * 512 * 4;
constexpr size_t WS_Z = WS_R;
constexpr size_t HSZ = (size_t)NTOK * 512 * 2;
constexpr size_t WS_RB = al256(WS_Z + (size_t)NTOK * ZLD * 2);
constexpr size_t WS_KS = WS_RB + HSZ, WS_VS = WS_KS + HSZ, WS_KKN = WS_VS + HSZ;
constexpr size_t WS_LIN = WS_KKN + HSZ;
constexpr size_t WS_LO = al256(WS_LIN + (size_t)NTOK * 384 * 2);
constexpr size_t WS_AB = WS_LO + 2 * HSZ;
constexpr size_t WS_GB = WS_LO + 4 * HSZ;
constexpr size_t WS_YS = WS_LO + 5 * HSZ;
constexpr size_t WS_QB = WS_YS + 2 * FSZ;
constexpr size_t WS_KB = WS_QB + FSZ / 2;
constexpr size_t WS_VB = WS_KB + FSZ / 2;
constexpr size_t WS_OP = WS_VB + FSZ / 2;
constexpr size_t WS_CAT = WS_OP + 2 * FSZ;
constexpr int WKV_REC = 12288, WKV_NCH = (TC + TL) / 16;
constexpr size_t WS_WKV = al256(WS_CAT + (size_t)NTOK * DM * 2);
constexpr size_t WS_EVEN_END = WS_WKV + (size_t)256 * WKV_NCH * WKV_REC;
constexpr size_t WS_Z2 = WS_R;
constexpr size_t WS_VST = al256(WS_Z2 + (size_t)NTOK * 2048 * 2);
constexpr size_t WS_G = al256(WS_VST + (size_t)NTOK * 2 * 4);
constexpr size_t WS_ODD_END = WS_G + (size_t)NTOK * DM * 2;
constexpr size_t WS_XP = WS_R;
constexpr size_t WS_ACT = al256(WS_XP + (size_t)XPROWS * DM * 2);
constexpr size_t WS_YM = al256(WS_ACT + (size_t)XPROWS * DM * 2);
constexpr size_t WS_MOE_END = WS_YM + (size_t)XPROWS * DM * 2;
constexpr size_t WS_END = (WS_EVEN_END > WS_MOE_END ? (WS_EVEN_END > WS_ODD_END ? WS_EVEN_END : WS_ODD_END) : (WS_MOE_END > WS_ODD_END ? WS_MOE_END : WS_ODD_END));

constexpr int CW_BAR = 4096;
constexpr int CW_CNT = 16384;
constexpr int CW_CUR = 16384 + 256;

constexpr int LDS_BYTES = 163840;
constexpr int LDS_MISC = 160 * 1024 - 256;

__device__ __forceinline__ unsigned f2bf(float f) { unsigned u = __builtin_bit_cast(unsigned, f); return (u + 0x7fffu + ((u >> 16) & 1u)) >> 16; }
__device__ __forceinline__ unsigned pk2(float lo, float hi) { return f2bf(lo) | (f2bf(hi) << 16); }
typedef float f32x2_t __attribute__((ext_vector_type(2))); typedef __bf16 bf16x2_t __attribute__((ext_vector_type(2)));
__device__ __forceinline__ unsigned cvtpk_s(float lo, float hi) { f32x2_t v = {lo, hi}; bf16x2_t b = __builtin_convertvector(v, bf16x2_t); return __builtin_bit_cast(unsigned, b); }
__device__ __forceinline__ float bf2f(bf16_t b) { return __builtin_bit_cast(float, (unsigned)b << 16); }
__device__ __forceinline__ float wave_sum(float v) {
#pragma unroll
    for (int o = 1; o < 64; o <<= 1) v += __shfl_xor(v, o);
    return v;
}
__device__ __forceinline__ int tid_opaque() { int t = threadIdx.x; asm volatile("" : "+v"(t)); return t; }
#define GAS __attribute__((address_space(1)))
template <class T> __device__ __forceinline__ T* as_global(T* p) { return (T*)(GAS T*)p; }
__device__ __forceinline__ unsigned char* opq(unsigned char* p) { GAS unsigned char* g = (GAS unsigned char*)p; asm volatile("" : "+s"(g)); return (unsigned char*)g; }
__device__ __forceinline__ float rdl(float v, int k) { return __builtin_bit_cast(float, __builtin_amdgcn_readlane(__builtin_bit_cast(int, v), k)); }
__device__ __forceinline__ float sigmoidf_(float x) { return 1.0f / (1.0f + __expf(-x)); }

#define XB_TMO      128
#define XB_XCNT(j)  (256  + 64 * (j))
#define XB_XSUB(j)  (1280 + 64 * (j))
#define XB_XGEN(j)  (2304 + 64 * (j))
#define XB_TOP      3328
#define XB_TOPGEN   3392
#define XCD_BAR_WORDS 3456
#define XB_SPIN_CAP (1u << 22)
__device__ __forceinline__ unsigned xb_ld(unsigned* p)              { return __hip_atomic_load(p, __ATOMIC_RELAXED, __HIP_MEMORY_SCOPE_AGENT); }
__device__ __forceinline__ unsigned xb_add(unsigned* p, unsigned v) { return __hip_atomic_fetch_add(p, v, __ATOMIC_RELAXED, __HIP_MEMORY_SCOPE_AGENT); }
__device__ __forceinline__ unsigned xb_xcc_id() { return (unsigned)__builtin_amdgcn_s_getreg((3 << 11) | 20) & 0xFu; }
#define XB_SPIN(cond, bar) do { unsigned _sp = 0; while (cond) { __builtin_amdgcn_s_sleep(1); \
    if ((++_sp & 255u) == 0u) { if (xb_ld(&(bar)[XB_TMO])) break; if (_sp > XB_SPIN_CAP) { atomicAdd(&(bar)[XB_TMO], 1u); break; } } } } while (0)
struct XcdBarrier { unsigned* bar; unsigned x; volatile LAS unsigned* st; };
__device__ __forceinline__ XcdBarrier xcd_barrier_post(unsigned* bar, volatile LAS unsigned* st) {
    XcdBarrier b; b.bar = bar; b.x = xb_xcc_id(); b.st = st;
    if (threadIdx.x == 0) (void)xb_add(&bar[XB_XCNT(b.x)], 1u);
    return b;
}
__device__ __forceinline__ void xcd_barrier_complete(unsigned* bar, unsigned x, unsigned& nloc, unsigned& nx) {
    const unsigned G = gridDim.x * gridDim.y * gridDim.z;
    unsigned sum, cnt, mine, sp = 0u;
    for (;;) {
        sum = 0u; cnt = 0u; mine = 0u;
#pragma unroll
        for (unsigned j = 0; j < 16; ++j) { const unsigned c = xb_ld(&bar[XB_XCNT(j)]); sum += c; cnt += (c > 0u) ? 1u : 0u; mine = (j == x) ? c : mine; }
        if (sum == G) break;
        __builtin_amdgcn_s_sleep(1);
        if ((++sp & 255u) == 0u) { if (xb_ld(&bar[XB_TMO])) break; if (sp > XB_SPIN_CAP) { atomicAdd(&bar[XB_TMO], 1u); break; } }
    }
    nloc = mine > 0u ? mine : 1u; nx = cnt > 0u ? cnt : 1u;
}
__device__ __forceinline__ void xcd_barrier(const XcdBarrier& b) {
    asm volatile("s_waitcnt vmcnt(0)" ::: "memory");
    __syncthreads();
    if (threadIdx.x == 0) {
        unsigned* bar = b.bar;
        __builtin_amdgcn_s_waitcnt(0);
        unsigned nloc = b.st[0], nx = b.st[1];
        if (nloc == 0u) { xcd_barrier_complete(bar, b.x, nloc, nx); b.st[0] = nloc; b.st[1] = nx; }
        const unsigned old = xb_add(&bar[XB_XSUB(b.x)], 1u);
        const unsigned gen = old / nloc;
        if (old + 1u == (gen + 1u) * nloc) {
            __builtin_amdgcn_fence(__ATOMIC_RELEASE, "agent");
            asm volatile("s_waitcnt vmcnt(0)" ::: "memory");
            const unsigned og = xb_add(&bar[XB_TOP], 1u);
            const unsigned tg = og / nx;
            if (og + 1u == (tg + 1u) * nx) xb_add(&bar[XB_TOPGEN], 1u);
            else XB_SPIN(xb_ld(&bar[XB_TOPGEN]) == tg, bar);
            __builtin_amdgcn_fence(__ATOMIC_ACQUIRE, "agent");
            xb_add(&bar[XB_XGEN(b.x)], 1u);
            asm volatile("s_waitcnt vmcnt(0)" ::: "memory");
        } else {
            XB_SPIN(xb_ld(&bar[XB_XGEN(b.x)]) == gen, bar);
            __builtin_amdgcn_fence(__ATOMIC_ACQUIRE, "agent");
            asm volatile("s_waitcnt vmcnt(0)" ::: "memory");
        }
    }
    __syncthreads();
}

namespace pg8 {
#define PG8_LAS __attribute__((address_space(3)))
typedef unsigned short bf16_t;
typedef short bf16x8 __attribute__((ext_vector_type(8)));
typedef float f32x4 __attribute__((ext_vector_type(4)));
typedef unsigned u32x4 __attribute__((ext_vector_type(4)));
constexpr int BM = 256, BK = 64, HALF = 128, HTB = HALF * BK * 2  , STAGE_BYTES = 8 * HTB, NXCD = 8, WGM = 8;

__host__ __device__ __forceinline__ int lds_byte(int r, int c) { const int st = (r >> 4) * 2 + (c >> 5), rr = r & 15, cc = c & 31, ob = rr * 64 + cc * 2; return st * 1024 + (ob ^ (((ob >> 9) & 1) << 5)); }
__host__ __device__ __forceinline__ void stage_rc(int b, int& R, int& C) { const int st = b / 1024, sb = b % 1024, swz = sb ^ (((sb >> 9) & 1) << 5); R = (st >> 1) * 16 + swz / 64; C = (st & 1) * 32 + (swz % 64) / 2; }
__host__ __device__ __forceinline__ int perm32(int rho) { const int n = rho >> 4, i = rho & 15; return 8 * (i >> 2) + 4 * n + (i & 3); }

struct Unit { int pm, pn; };
struct Gemm { const bf16_t* A; const bf16_t* Bt; int M, N, K; };

struct StaticOrder {
    int nM, nN, nwg, G, c;
    __host__ __device__ void init(int M, int N, int G_, int c_) { nM = M / BM; nN = N / BM; nwg = nM * nN; G = G_; c = c_; }
    __host__ __device__ bool next(int i, Unit& u) const {
        const long L = (long)i * G + c; if (L >= nwg) return false;
        int wgid = (int)L; { const int q = nwg / NXCD, r = nwg % NXCD, xcd = wgid % NXCD, off = wgid / NXCD; wgid = (xcd < r ? xcd * (q + 1) : r * (q + 1) + (xcd - r) * q) + off; }
        const int nig = WGM * nN, gid = wgid / nig, fm = gid * WGM, gsz = (nM - fm) < WGM ? (nM - fm) : WGM;
        u.pm = fm + ((wgid % nig) % gsz); u.pn = (wgid % nig) / gsz; return true;
    }
    __device__ __forceinline__ void a_ready(const Unit&) const {}
    __device__ __forceinline__ void done(const Unit&) const {}
};

__device__ __forceinline__ unsigned cvt_pk_bf16(float lo, float hi) { unsigned r; asm volatile("v_cvt_pk_bf16_f32 %0, %1, %2" : "=v"(r) : "v"(lo), "v"(hi)); return r; }
typedef float f32x2 __attribute__((ext_vector_type(2)));
__device__ __forceinline__ f32x2 gelu_pk(f32x2 v) {
    const f32x2 av = __builtin_elementwise_abs(v), d = av * 0.2316418882f + 1.0f;
    f32x2 t; t.x = __builtin_amdgcn_rcpf(d.x); t.y = __builtin_amdgcn_rcpf(d.y);
    f32x2 q = t * 0.5307027145f + (-0.7265760135f); q = q * t + 0.7107068705f; q = q * t + (-0.142248368f); q = q * t + 0.127414796f; q = q * t;
    const f32x2 s = (v * v) * (-0.72134752044f);
    f32x2 e; e.x = __builtin_amdgcn_exp2f(s.x); e.y = __builtin_amdgcn_exp2f(s.y);
    const f32x2 m = v * (q * e), r = v - m;
    f32x2 o; o.x = v.x < 0.f ? m.x : r.x; o.y = v.y < 0.f ? m.y : r.y; return o;
}

template <class Epi, class Sched, bool ALIGN_EPI = false, bool SP2 = false, bool GATHER = false>
__device__ __forceinline__ void gemm_phase(PG8_LAS unsigned char* lds, const Gemm g, const Sched& S, const Epi& E) {
    const int tid = tid_opaque(), wid = __builtin_amdgcn_readfirstlane(tid >> 6), lane = tid & 63, wr = wid >> 2, wc = wid & 3, fr = lane & 15, fq = lane >> 4;
    static_assert(!GATHER || SP2, "GATHER is wired into the SP2 loop only");
    const int K = g.K, nt = K / BK;
    unsigned voffA[2], voffB[2];
#pragma unroll
    for (int i = 0; i < 2; ++i) { int R, C; stage_rc(tid * 16 + i * 8192, R, C); const int Rb = Epi::PERM ? ((R & ~31) + perm32(R & 31)) : R;
        voffA[i] = (unsigned)(R * K + C) * 2u; voffB[i] = (unsigned)(Rb * K + C) * 2u; }
    unsigned gAc[2][2] = {{0u, 0u}, {0u, 0u}}, gAn[2][2] = {{0u, 0u}, {0u, 0u}};
    int gR[2] = {0, 0}; unsigned gC[2] = {0u, 0u};
    if constexpr (GATHER) {
#pragma unroll
        for (int i = 0; i < 2; ++i) { int R, C; stage_rc(tid * 16 + i * 8192, R, C); gR[i] = R; gC[i] = (unsigned)C * 2u; }
    }
#define PG8_GROWS(dst, ui_) do { _Pragma("unroll") for (int _h = 0; _h < 2; ++_h) _Pragma("unroll") for (int _i = 0; _i < 2; ++_i) dst[_h][_i] = S.rowtab[(ui_) * 256 + _h * 128 + gR[_i]] + gC[_i]; } while (0)
    const size_t kstep = (size_t)(BK * 2);
    const size_t hstep = (size_t)HALF * K * 2;
    const size_t tstep = 2 * hstep;
    const unsigned ldsw = (unsigned)wid * 1024u;
    const int aoff = lds_byte(wr * 64 + fr, fq * 8), boff = lds_byte(wc * 32 + fr, fq * 8);
#define PG8_SA(b, h) (((b) * 2 + (h)) * HTB)
#define PG8_SB(b, h) ((4 + (b) * 2 + (h)) * HTB)
#define PG8_STAGE(bufoff, gbase, voff) do { _Pragma("unroll") for (int _i = 0; _i < 2; ++_i) \
        __builtin_amdgcn_global_load_lds((const unsigned*)((const char*)(gbase) + (voff)[_i]), (PG8_LAS unsigned*)(lds + (bufoff) + ldsw + _i * 8192), 16, 0, 0); } while (0)
#define PG8_STAGE_A(bufoff, kptr, h, vsel) do { if constexpr (GATHER) { PG8_STAGE(bufoff, kptr, vsel[h]); } else { PG8_STAGE(bufoff, (kptr) + (h) * hstep, voffA); } } while (0)
#define PG8_LDA(dst, b, h) do { _Pragma("unroll") for (int m = 0; m < 4; ++m) _Pragma("unroll") for (int k = 0; k < 2; ++k) dst[m][k] = *(const PG8_LAS bf16x8*)(lds + PG8_SA(b, h) + aoff + m * 2048 + k * 1024); } while (0)
#define PG8_LDB(dst, b, h) do { _Pragma("unroll") for (int n = 0; n < 2; ++n) _Pragma("unroll") for (int k = 0; k < 2; ++k) dst[n][k] = *(const PG8_LAS bf16x8*)(lds + PG8_SB(b, h) + boff + n * 2048 + k * 1024); } while (0)
#define PG8_MMA(ai, bj, At, Bt) do { __builtin_amdgcn_s_setprio(1); _Pragma("unroll") for (int m = 0; m < 4; ++m) _Pragma("unroll") for (int n = 0; n < 2; ++n) _Pragma("unroll") for (int k = 0; k < 2; ++k) \
        acc[ai][bj][m][n] = __builtin_amdgcn_mfma_f32_16x16x32_bf16(Bt[n][k], At[m][k], acc[ai][bj][m][n], 0, 0, 0); __builtin_amdgcn_s_setprio(0); } while (0)
#define PG8_WAIT_V(n) asm volatile("s_waitcnt vmcnt(" #n ")" ::: "memory")
#define PG8_WAIT_L(n) asm volatile("s_waitcnt lgkmcnt(" #n ")" ::: "memory")
#define PG8_BAR __builtin_amdgcn_s_barrier()
#define PG8_SCHED __builtin_amdgcn_sched_barrier(0)
    Unit cur, nxt; int ui = 0;
    if (!S.next(0, cur)) return;
    f32x4 acc[2][2][4][2];
#pragma unroll
    for (int a = 0; a < 2; ++a)
#pragma unroll
        for (int b = 0; b < 2; ++b)
#pragma unroll
            for (int m = 0; m < 4; ++m)
#pragma unroll
                for (int n = 0; n < 2; ++n) acc[a][b][m][n] = (f32x4){0.f, 0.f, 0.f, 0.f};
    bf16x8 At[4][2], B0[2][2], B1[2][2];
    const char* cA = GATHER ? (const char*)g.A : (const char*)g.A + (size_t)cur.pm * tstep; const char* cB = (const char*)g.Bt + (size_t)cur.pn * tstep;
    if constexpr (GATHER) { PG8_GROWS(gAc, 0); }
    S.a_ready(cur);
    if constexpr (SP2) {
        PG8_STAGE(PG8_SB(0, 0), cB, voffB); PG8_STAGE(PG8_SB(0, 1), cB + hstep, voffB); PG8_STAGE_A(PG8_SA(0, 0), cA, 0, gAc); PG8_STAGE_A(PG8_SA(0, 1), cA, 1, gAc);
        if (wr == 1) PG8_BAR;
        PG8_WAIT_V(2); PG8_BAR;
        PG8_STAGE(PG8_SB(1, 0), cB + kstep, voffB); PG8_STAGE_A(PG8_SA(1, 0), cA + kstep, 0, gAc); PG8_STAGE(PG8_SB(1, 1), cB + hstep + kstep, voffB);
        PG8_WAIT_V(6); PG8_BAR;
    } else {
        PG8_STAGE(PG8_SB(0, 0), cB, voffB); PG8_STAGE(PG8_SA(0, 0), cA, voffA); PG8_STAGE(PG8_SB(0, 1), cB + hstep, voffB); PG8_STAGE(PG8_SA(0, 1), cA + hstep, voffA);
        if (wr == 1) PG8_BAR;
        PG8_WAIT_V(4); PG8_BAR;
        PG8_STAGE(PG8_SB(1, 0), cB + kstep, voffB); PG8_STAGE(PG8_SA(1, 0), cA + kstep, voffA); PG8_STAGE(PG8_SB(1, 1), cB + hstep + kstep, voffB);
        PG8_WAIT_V(6); PG8_BAR;
    }
    for (;;) {
        const bool has_next = S.next(ui + 1, nxt);
        if constexpr (GATHER) { if (has_next) { PG8_GROWS(gAn, ui + 1); } else { _Pragma("unroll") for (int _h = 0; _h < 2; ++_h) _Pragma("unroll") for (int _i = 0; _i < 2; ++_i) gAn[_h][_i] = gAc[_h][_i]; } }
        const char* nA = GATHER ? (const char*)g.A : (has_next ? (const char*)g.A + (size_t)nxt.pm * tstep : cA); const char* nB = has_next ? (const char*)g.Bt + (size_t)nxt.pn * tstep : cB;
        for (int t = 0; t < nt; t += 2) {
            const bool last = (t == nt - 2);
            const char* a1 = cA + (size_t)(t + 1) * kstep;
            const char* a2 = last ? nA : cA + (size_t)(t + 2) * kstep; const char* b2 = last ? nB : cB + (size_t)(t + 2) * kstep;
            const char* a3 = a2 + kstep; const char* b3 = b2 + kstep;
            if (last && has_next) S.a_ready(nxt);
            unsigned gA2[2][2];
            if constexpr (GATHER) { _Pragma("unroll") for (int _h = 0; _h < 2; ++_h) _Pragma("unroll") for (int _i = 0; _i < 2; ++_i) gA2[_h][_i] = last ? gAn[_h][_i] : gAc[_h][_i]; }
            if constexpr (SP2) {
            PG8_LDB(B0, 0, 0); PG8_LDB(B1, 0, 1); PG8_SCHED; PG8_LDA(At, 0, 0); PG8_STAGE_A(PG8_SA(1, 1), a1, 1, gAc);
            PG8_WAIT_V(8); PG8_WAIT_L(0); PG8_BAR; PG8_MMA(0, 0, At, B0); PG8_MMA(0, 1, At, B1); PG8_BAR; PG8_SCHED;
            PG8_LDA(At, 0, 1); PG8_STAGE(PG8_SB(0, 0), b2, voffB); PG8_STAGE(PG8_SB(0, 1), b2 + hstep, voffB); PG8_STAGE_A(PG8_SA(0, 0), a2, 0, gA2);
            PG8_WAIT_V(8); PG8_WAIT_L(0); PG8_BAR; PG8_MMA(1, 0, At, B0); PG8_MMA(1, 1, At, B1); PG8_BAR; PG8_SCHED;
            PG8_LDB(B0, 1, 0); PG8_LDB(B1, 1, 1); PG8_SCHED; PG8_LDA(At, 1, 0); PG8_STAGE_A(PG8_SA(0, 1), a2, 1, gA2);
            PG8_WAIT_V(8); PG8_WAIT_L(0); PG8_BAR; PG8_MMA(0, 0, At, B0); PG8_MMA(0, 1, At, B1); PG8_BAR; PG8_SCHED;
            PG8_LDA(At, 1, 1); PG8_STAGE(PG8_SB(1, 0), b3, voffB); PG8_STAGE(PG8_SB(1, 1), b3 + hstep, voffB); PG8_STAGE_A(PG8_SA(1, 0), a3, 0, gA2);
            PG8_WAIT_V(8); PG8_WAIT_L(0); PG8_BAR; PG8_MMA(1, 0, At, B0); PG8_MMA(1, 1, At, B1); PG8_BAR; PG8_SCHED;
            } else {
            PG8_LDB(B0, 0, 0); PG8_SCHED; PG8_LDA(At, 0, 0); PG8_STAGE(PG8_SA(1, 1), a1 + hstep, voffA);
            PG8_WAIT_L(8); PG8_BAR; PG8_WAIT_L(0); PG8_MMA(0, 0, At, B0); PG8_BAR; PG8_SCHED;
            PG8_LDB(B1, 0, 1); PG8_STAGE(PG8_SB(0, 0), b2, voffB);
            PG8_BAR; PG8_WAIT_L(0); PG8_MMA(0, 1, At, B1); PG8_BAR;
            PG8_LDA(At, 0, 1); PG8_STAGE(PG8_SA(0, 0), a2, voffA);
            PG8_BAR; PG8_WAIT_L(0); PG8_MMA(1, 0, At, B0); PG8_BAR; PG8_SCHED;
            PG8_STAGE(PG8_SB(0, 1), b2 + hstep, voffB);
            PG8_WAIT_V(6); PG8_BAR; PG8_MMA(1, 1, At, B1); PG8_BAR;
            PG8_LDB(B0, 1, 0); PG8_SCHED; PG8_LDA(At, 1, 0); PG8_STAGE(PG8_SA(0, 1), a2 + hstep, voffA);
            PG8_WAIT_L(8); PG8_BAR; PG8_WAIT_L(0); PG8_MMA(0, 0, At, B0); PG8_BAR; PG8_SCHED;
            PG8_LDB(B1, 1, 1); PG8_STAGE(PG8_SB(1, 0), b3, voffB);
            PG8_BAR; PG8_WAIT_L(0); PG8_MMA(0, 1, At, B1); PG8_BAR;
            PG8_LDA(At, 1, 1); PG8_STAGE(PG8_SA(1, 0), a3, voffA);
            PG8_BAR; PG8_WAIT_L(0); PG8_MMA(1, 0, At, B0); PG8_BAR; PG8_SCHED;
            PG8_STAGE(PG8_SB(1, 1), b3 + hstep, voffB);
            PG8_WAIT_V(6); PG8_BAR; PG8_MMA(1, 1, At, B1); PG8_BAR;
            }
        }
        if constexpr (ALIGN_EPI) { if (wr == 0) PG8_BAR; }
        if constexpr (!Epi::AFTER_DRAIN) { E(acc, cur, wr, wc, fr, fq); S.done(cur); }
        if (!has_next) break;
#pragma unroll
        for (int a = 0; a < 2; ++a)
#pragma unroll
            for (int b = 0; b < 2; ++b)
#pragma unroll
                for (int m = 0; m < 4; ++m)
#pragma unroll
                    for (int n = 0; n < 2; ++n) acc[a][b][m][n] = (f32x4){0.f, 0.f, 0.f, 0.f};
        cur = nxt; cA = nA; cB = nB; ++ui;
        if constexpr (GATHER) { _Pragma("unroll") for (int _h = 0; _h < 2; ++_h) _Pragma("unroll") for (int _i = 0; _i < 2; ++_i) gAc[_h][_i] = gAn[_h][_i]; }
        if constexpr (ALIGN_EPI) { if (wr == 1) PG8_BAR; }
    }
    PG8_WAIT_V(0);
    if constexpr (!ALIGN_EPI) { if (wr == 0) PG8_BAR; }
    PG8_BAR;
    if constexpr (Epi::AFTER_DRAIN) { E.fused(acc, cur, wr, wc, fr, fq, lds, wid, lane); S.done(cur); }
#undef PG8_SA
#undef PG8_SB
#undef PG8_STAGE
#undef PG8_STAGE_A
#undef PG8_GROWS
#undef PG8_LDA
#undef PG8_LDB
#undef PG8_MMA
#undef PG8_WAIT_V
#undef PG8_WAIT_L
#undef PG8_BAR
#undef PG8_SCHED
}
}

struct Args { const float* in[38]; float* out; unsigned char* ws; int ph_lo, ph_hi; };
#define INP(k) as_global(IN[k])
#define AIN(k) as_global(A.in[k])
enum { I_X = 0, I_C, I_CTX, I_CCTX, I_N1G, I_N2G, I_ADAW, I_ADAB, I_EVWIN, I_EVWOUT, I_RWMU, I_RWW0, I_RWW2, I_RWA0, I_RWA2, I_RWG2, I_RWKK, I_RWKA, I_RWRK,
       I_GNW, I_GNB, I_QN, I_KN, I_LAM, I_SUBLN, I_SGWIN, I_SGBIN, I_SGLNG, I_SGLNB, I_SGWS, I_SGBS, I_SGWOUT, I_RTW, I_RTB, I_W1, I_B1, I_W2, I_B2 };

struct Tok { int b, t, T, modrow; };
__device__ __forceinline__ Tok tokinfo(int g) {
    Tok k;
    if (g < NCTX) { k.b = g >> 8; k.t = g & 255; k.T = TC; k.modrow = 16; }
    else { const int q = g - NCTX; k.b = q >> 11; k.t = q & 2047; k.T = TL; k.modrow = k.b; }
    return k;
}

template <int MAP>
__device__ __forceinline__ void p0_transpose_item(const float* W, int K, int N, bf16_t* WT, LAS float* scr, int item, int lane) {
    const int nblk = N / 32, kb = item / nblk, nb = item % nblk, k0 = 64 * kb, n0 = 32 * nb;
    const int d0 = MAP ? (256 * ((n0 & 1023) >> 7) + 128 * (n0 >> 10) + (n0 & 127)) : n0;
#pragma unroll 8
    for (int i = 0; i < 32; ++i) { const int kk = 2 * i + (lane >> 5); scr[kk * 33 + (lane & 31)] = W[(size_t)(k0 + kk) * N + n0 + (lane & 31)]; }
    asm volatile("s_waitcnt lgkmcnt(0)" ::: "memory");
    const int c = lane & 7;
#pragma unroll
    for (int j = 0; j < 4; ++j) { const int n = (lane >> 3) + 8 * j; const LAS float* s = scr + (8 * c) * 33 + n;
        u32x4 o; o.x = pk2(s[0 * 33], s[1 * 33]); o.y = pk2(s[2 * 33], s[3 * 33]); o.z = pk2(s[4 * 33], s[5 * 33]); o.w = pk2(s[6 * 33], s[7 * 33]);
        *(u32x4*)(WT + (size_t)(d0 + n) * K + k0 + 8 * c) = o; }
    asm volatile("s_waitcnt lgkmcnt(0)" ::: "memory");
}

__device__ __forceinline__ void ph_prologue(const Args& A, LAS unsigned char* lds, int bid, int nb) {
    const int tid = tid_opaque(), lane = tid & 63, wid = tid >> 6;
    unsigned char* ws = opq(A.ws);
    if (bid == 0 && tid < 39) ((const float**)(ws + WS_PTRS))[tid] = (tid < 38) ? A.in[tid] : (const float*)A.out;
    {
        LAS float* s = (LAS float*)lds;
        LAS float* red = (LAS float*)(lds + 17 * 1024 * 4);
        for (int i = tid; i < 17 * 1024; i += NTHREADS) {
            const int r = i >> 10, k = i & 1023;
            const float x = (r < 16) ? AIN(I_C)[r * 1024 + k] : AIN(I_CCTX)[k];
            s[i] = x / (1.0f + __expf(-x));
        }
        __syncthreads();
        float* mod = (float*)(ws + WS_MOD);
        for (int u = bid; u < 4 * 96; u += nb) {
            const int l = u / 96, cg = u % 96, col = cg * 64 + lane;
            float acc[17];
#pragma unroll
            for (int r = 0; r < 17; ++r) acc[r] = 0.f;
            const float* wp = AIN(I_ADAW) + (size_t)l * 1024 * 6144 + col;
            for (int k = wid * 128; k < wid * 128 + 128; ++k) {
                const float wv = wp[(size_t)k * 6144];
#pragma unroll
                for (int r = 0; r < 17; ++r) acc[r] += s[r * 1024 + k] * wv;
            }
#pragma unroll
            for (int r = 0; r < 17; ++r) red[(wid * 17 + r) * 64 + lane] = acc[r];
            __syncthreads();
            for (int i = tid; i < 17 * 64; i += NTHREADS) {
                const int r = i >> 6, ln = i & 63; float v = 0.f;
#pragma unroll
                for (int w = 0; w < 8; ++w) v += red[(w * 17 + r) * 64 + ln];
                const int cc = cg * 64 + ln;
                mod[((size_t)l * 17 + r) * 6144 + cc] = v + AIN(I_ADAB)[l * 6144 + cc];
            }
            __syncthreads();
        }
    }
    __syncthreads();
    {
        LAS float* scr = (LAS float*)(lds + wid * 16384);
        const int gw = bid * NWAVES + wid, NGW = nb * NWAVES;
        constexpr int IT_WIN = 16 * (EVC / 32), IT_SQ = 16 * 32, IT_SGIN = 16 * 64, IT_W1 = 16 * 64, IT_W2 = 16 * 32;
        constexpr int N0 = 2 * IT_WIN, N1 = N0 + 2 * IT_SQ, N2 = N1 + 2 * IT_SGIN, N3 = N2 + 2 * IT_SQ, N4 = N3 + 128 * IT_W1, N5 = N4 + 128 * IT_W2;
        for (int it = gw; it < N5; it += NGW) {
            if (it < N0) { const int m = it / IT_WIN, r = it % IT_WIN; p0_transpose_item<0>(AIN(I_EVWIN) + (size_t)m * DM * EVC, DM, EVC, (bf16_t*)(ws + WS_WIN) + (size_t)m * ZLD * DM, scr, r, lane); }
            else if (it < N1) { const int q = it - N0, m = q / IT_SQ, r = q % IT_SQ; p0_transpose_item<0>(AIN(I_EVWOUT) + (size_t)m * DM * DM, DM, DM, (bf16_t*)(ws + WS_WOUT) + (size_t)m * DM * DM, scr, r, lane); }
            else if (it < N2) { const int q = it - N1, m = q / IT_SGIN, r = q % IT_SGIN; p0_transpose_item<0>(AIN(I_SGWIN) + (size_t)m * DM * 2048, DM, 2048, (bf16_t*)(ws + WS_SGIN) + (size_t)m * 2048 * DM, scr, r, lane); }
            else if (it < N3) { const int q = it - N2, m = q / IT_SQ, r = q % IT_SQ; p0_transpose_item<0>(AIN(I_SGWOUT) + (size_t)m * DM * DM, DM, DM, (bf16_t*)(ws + WS_SGOUT) + (size_t)m * DM * DM, scr, r, lane); }
            else if (it < N4) { const int q = it - N3, m = q / IT_W1, r = q % IT_W1; p0_transpose_item<1>(AIN(I_W1) + (size_t)m * DM * 2048, DM, 2048, (bf16_t*)(ws + WS_W1) + (size_t)m * 2048 * DM, scr, r, lane); }
            else { const int q = it - N4, m = q / IT_W2, r = q % IT_W2; p0_transpose_item<0>(AIN(I_W2) + (size_t)m * DM * DM, DM, DM, (bf16_t*)(ws + WS_W2) + (size_t)m * DM * DM, scr, r, lane); }
        }
    }
    {
        const size_t gt = (size_t)bid * NTHREADS + tid, GT = (size_t)nb * NTHREADS;
        f32x4* H4 = (f32x4*)(ws + WS_H);
        const f32x4* c4 = (const f32x4*)AIN(I_CTX); const f32x4* x4 = (const f32x4*)AIN(I_X);
        constexpr size_t NC4 = (size_t)NCTX * DM / 4, NT4 = (size_t)NTOK * DM / 4;
        for (size_t i = gt; i < NT4; i += GT) H4[i] = (i < NC4) ? c4[i] : x4[i - NC4];
        for (size_t i = gt; i < (size_t)2 * 128 * DM / 8; i += GT) { const size_t m = i / (128 * DM / 8), r = i % (128 * DM / 8); ((u32x4*)((bf16_t*)(ws + WS_WIN) + (m * ZLD + EVC) * DM))[r] = (u32x4){0u, 0u, 0u, 0u}; }
        bf16_t* wl = (bf16_t*)(ws + WS_WLORA);
        for (size_t i = gt; i < (size_t)2 * LORA_N * LORA_K; i += GT) {
            const int jj = (int)(i / ((size_t)LORA_N * LORA_K)), rem = (int)(i % ((size_t)LORA_N * LORA_K)), n = rem / LORA_K, k = rem % LORA_K, seg = n >> 9, c = n & 511;
            float v = 0.f;
            if (seg < 2) { if ((k >> 6) == seg) v = AIN(I_RWW2)[(((size_t)jj * 2 + seg) * 64 + (k & 63)) * 512 + c]; }
            else if (seg < 4) { if ((k >> 6) == seg) v = AIN(I_RWA2)[(((size_t)jj * 2 + (seg - 2)) * 64 + (k & 63)) * 512 + c]; }
            else { if (k >= 256) v = AIN(I_RWG2)[((size_t)jj * 128 + (k - 256)) * 512 + c]; }
            wl[i] = (bf16_t)f2bf(v);
        }
        for (size_t i = gt; i < (size_t)2 * LORA_N; i += GT) { const int jj = (int)(i / LORA_N), n = (int)(i % LORA_N), seg = n >> 9, c = n & 511;
            ((float*)(ws + WS_LBIAS))[i] = seg < 2 ? AIN(I_RWW0)[((size_t)jj * 2 + seg) * 512 + c] : (seg < 4 ? AIN(I_RWA0)[((size_t)jj * 2 + (seg - 2)) * 512 + c] : 0.f); }
        float* rt = (float*)(ws + WS_RTWT);
        for (size_t i = gt; i < (size_t)4 * 32 * 1024; i += GT) { const int l = (int)(i >> 15), e = (int)(i >> 10) & 31, k = (int)i & 1023; rt[i] = AIN(I_RTW)[((size_t)l * 1024 + k) * 32 + e]; }
    }
}

template <bool ROUTER>
__device__ __forceinline__ void ph_norm(const Args& A, int l, int row_lo, LAS unsigned char* lds, int bid, int nb) {
    unsigned char* ws = opq(A.ws); const float* const* IN = (const float* const*)(ws + WS_PTRS); (void)IN;
    const int tid = tid_opaque(), lane = tid & 63, wid = tid >> 6;
    const float* H = (const float*)(ws + WS_H);
    const float* mod = (const float*)(ws + WS_MOD);
    bf16_t* abf = (bf16_t*)(ws + WS_ABF);
    const float* gp = INP(ROUTER ? I_N2G : I_N1G) + l * 1024;
    const int c_shift = ROUTER ? 3 : 0, c_scale = ROUTER ? 4 : 1;
    LAS float* rtl = (LAS float*)lds;
    LAS int* hist = (LAS int*)(lds + 131072);
    float rtb = 0.f;
    if constexpr (ROUTER) {
        const f32x4* rt4 = (const f32x4*)((const float*)(ws + WS_RTWT) + (size_t)l * 32 * 1024);
        for (int i = tid; i < 32 * 1024 / 4; i += NTHREADS) ((LAS f32x4*)rtl)[i] = rt4[i];
        if (tid < 32) hist[tid] = 0;
        rtb = INP(I_RTB)[l * 32 + (lane >> 1)];
        __syncthreads();
    }
    for (int row = row_lo + bid * NWAVES + wid; row < NTOK; row += nb * NWAVES) {
        const Tok tk = tokinfo(row);
        const float* mrow = mod + ((size_t)l * 17 + tk.modrow) * 6144;
        f32x4 v[4]; float ss = 0.f;
#pragma unroll
        for (int j = 0; j < 4; ++j) { v[j] = *(const f32x4*)(H + (size_t)row * DM + j * 256 + lane * 4); ss += (v[j].x * v[j].x + v[j].y * v[j].y) + (v[j].z * v[j].z + v[j].w * v[j].w); }
        const float rstd = rsqrtf(wave_sum(ss) * (1.0f / DM) + 1e-6f);
#pragma unroll
        for (int j = 0; j < 4; ++j) {
            const int col = j * 256 + lane * 4;
            const f32x4 g = *(const f32x4*)(gp + col), sc = *(const f32x4*)(mrow + c_scale * 1024 + col), sh = *(const f32x4*)(mrow + c_shift * 1024 + col);
            v[j] = (v[j] * rstd * g) * (sc + 1.0f) + sh;
            u32x2 o; o.x = pk2(v[j].x, v[j].y); o.y = pk2(v[j].z, v[j].w);
            *(u32x2*)(abf + (size_t)row * DM + col) = o;
        }
        if constexpr (ROUTER) {
            float p[32];
#pragma unroll
            for (int e = 0; e < 32; ++e) {
                float acc = 0.f;
#pragma unroll
                for (int j = 0; j < 4; ++j) { const f32x4 w = *(const LAS f32x4*)(rtl + e * 1024 + j * 256 + lane * 4); acc += (v[j].x * w.x + v[j].y * w.y) + (v[j].z * w.z + v[j].w * w.w); }
                p[e] = acc;
            }
#define RS_STEP(N, OFF) _Pragma("unroll") for (int i = 0; i < (N); ++i) { const bool up = (lane & (OFF)) != 0; const float send = up ? p[i] : p[i + (N)], keep = up ? p[i + (N)] : p[i]; p[i] = keep + __shfl_xor(send, (OFF)); }
            RS_STEP(16, 32) RS_STEP(8, 16) RS_STEP(4, 8) RS_STEP(2, 4) RS_STEP(1, 2)
#undef RS_STEP
            const float mylg = p[0] + __shfl_xor(p[0], 1) + rtb;
            float tv[4] = {-3.0e38f, -3.0e38f, -3.0e38f, -3.0e38f}; int ti[4] = {0, 0, 0, 0};
#pragma unroll
            for (int e = 0; e < 32; ++e) {
                const float lgv = rdl(mylg, 2 * e);
                if (lgv > tv[3]) {
                    tv[3] = lgv; ti[3] = e;
                    if (tv[3] > tv[2]) { const float a = tv[2]; tv[2] = tv[3]; tv[3] = a; const int b = ti[2]; ti[2] = ti[3]; ti[3] = b; }
                    if (tv[2] > tv[1]) { const float a = tv[1]; tv[1] = tv[2]; tv[2] = a; const int b = ti[1]; ti[1] = ti[2]; ti[2] = b; }
                    if (tv[1] > tv[0]) { const float a = tv[0]; tv[0] = tv[1]; tv[1] = a; const int b = ti[0]; ti[0] = ti[1]; ti[1] = b; }
                }
            }
            const float e1 = __expf(tv[1] - tv[0]), e2 = __expf(tv[2] - tv[0]), e3 = __expf(tv[3] - tv[0]);
            const float inv = 1.0f / (1.0f + e1 + e2 + e3);
            if (lane == 0) {
                int* te = (int*)(ws + WS_TOKE) + (size_t)row * 4; float* tg = (float*)(ws + WS_TOKG) + (size_t)row * 4; int* tr = (int*)(ws + WS_TOKR) + (size_t)row * 4;
                te[0] = ti[0]; te[1] = ti[1]; te[2] = ti[2]; te[3] = ti[3];
                tg[0] = inv; tg[1] = e1 * inv; tg[2] = e2 * inv; tg[3] = e3 * inv;
#pragma unroll
                for (int k = 0; k < 4; ++k) tr[k] = __hip_atomic_fetch_add(hist + ti[k], 1, __ATOMIC_RELAXED, __HIP_MEMORY_SCOPE_WORKGROUP);
            }
        }
    }
    if constexpr (ROUTER) {
        __syncthreads();
        if (tid < 32) ((int*)(ws + WS_BCNT))[((size_t)l * 256 + bid) * 32 + tid] = hist[tid];
    }
}

typedef pg8::f32x4 (&AccRef)[2][2][4][2];
struct EpiStoreBf16 {
    static constexpr bool PERM = true, AFTER_DRAIN = false;
    bf16_t* O; int ldc;
    __device__ __forceinline__ void operator()(const pg8::f32x4 (&acc)[2][2][4][2], const pg8::Unit& u, int wr, int wc, int fr, int fq) const {
        const int row0 = u.pm * 256 + wr * 64 + fr, col0 = u.pn * 256 + wc * 32 + 8 * fq;
#pragma unroll
        for (int ai = 0; ai < 2; ++ai)
#pragma unroll
            for (int m = 0; m < 4; ++m) { bf16_t* rowp = O + (size_t)(row0 + ai * 128 + m * 16) * ldc + col0;
#pragma unroll
                for (int bj = 0; bj < 2; ++bj) { const pg8::f32x4 v0 = acc[ai][bj][m][0], v1 = acc[ai][bj][m][1];
                    u32x4 w; w.x = cvtpk_s(v0[0], v0[1]); w.y = cvtpk_s(v0[2], v0[3]); w.z = cvtpk_s(v1[0], v1[1]); w.w = cvtpk_s(v1[2], v1[3]);
                    *(u32x4*)(rowp + bj * 128) = w; } }
    }
};
struct EpiGeluBf16 {
    static constexpr bool PERM = true, AFTER_DRAIN = false;
    bf16_t* O; int ldc; const float* bias;
    __device__ __forceinline__ void operator()(const pg8::f32x4 (&acc)[2][2][4][2], const pg8::Unit& u, int wr, int wc, int fr, int fq) const {
        const int row0 = u.pm * 256 + wr * 64 + fr, col0 = u.pn * 256 + wc * 32 + 8 * fq;
        pg8::f32x4 bv[2][2];
#pragma unroll
        for (int bj = 0; bj < 2; ++bj)
#pragma unroll
            for (int n = 0; n < 2; ++n) bv[bj][n] = *(const pg8::f32x4*)(bias + col0 + bj * 128 + 4 * n);
#pragma unroll
        for (int ai = 0; ai < 2; ++ai)
#pragma unroll
            for (int m = 0; m < 4; ++m) { bf16_t* rowp = O + (size_t)(row0 + ai * 128 + m * 16) * ldc + col0;
#pragma unroll
                for (int bj = 0; bj < 2; ++bj) { pg8::f32x4 v0 = acc[ai][bj][m][0] + bv[bj][0], v1 = acc[ai][bj][m][1] + bv[bj][1];
                    const pg8::f32x2 a = pg8::gelu_pk((pg8::f32x2){v0[0], v0[1]}), b = pg8::gelu_pk((pg8::f32x2){v0[2], v0[3]}), c = pg8::gelu_pk((pg8::f32x2){v1[0], v1[1]}), d = pg8::gelu_pk((pg8::f32x2){v1[2], v1[3]});
                    u32x4 w; w.x = cvtpk_s(a.x, a.y); w.y = cvtpk_s(b.x, b.y); w.z = cvtpk_s(c.x, c.y); w.w = cvtpk_s(d.x, d.y);
                    *(u32x4*)(rowp + bj * 128) = w; } }
    }
};
struct EpiResidual {
    static constexpr bool PERM = false, AFTER_DRAIN = false;
    float* H; const float* gate0; int row_base;
    __device__ __forceinline__ void operator()(const pg8::f32x4 (&acc)[2][2][4][2], const pg8::Unit& u, int wr, int wc, int fr, int fq) const {
        const int row0 = u.pm * 256 + wr * 64 + fr, col0 = u.pn * 256 + wc * 32 + 4 * fq;
        const Tok tk = tokinfo(row_base + u.pm * 256);
        const float* gate = gate0 + (size_t)tk.modrow * 6144 + col0;
        pg8::f32x4 gv[2][2];
#pragma unroll
        for (int bj = 0; bj < 2; ++bj)
#pragma unroll
            for (int n = 0; n < 2; ++n) gv[bj][n] = *(const pg8::f32x4*)(gate + bj * 128 + n * 16);
#pragma unroll
        for (int ai = 0; ai < 2; ++ai)
#pragma unroll
            for (int m = 0; m < 4; ++m) { float* rowp = H + (size_t)(row0 + ai * 128 + m * 16) * DM + col0;
#pragma unroll
                for (int bj = 0; bj < 2; ++bj)
#pragma unroll
                    for (int n = 0; n < 2; ++n) { pg8::f32x4* p = (pg8::f32x4*)(rowp + bj * 128 + n * 16); *p = *p + gv[bj][n] * acc[ai][bj][m][n]; } }
    }
};
struct ListOrder {
    const LAS int* list; int n; const LAS unsigned* rowtab;
    __device__ __forceinline__ bool next(int i, pg8::Unit& u) const {
        if (i >= n) return false;
        u.pm = __builtin_amdgcn_readfirstlane(list[2 * i]); u.pn = __builtin_amdgcn_readfirstlane(list[2 * i + 1]); return true;
    }
    __device__ __forceinline__ void a_ready(const pg8::Unit&) const {}
    __device__ __forceinline__ void done(const pg8::Unit&) const {}
};
struct EpiLora {
    static constexpr bool PERM = true, AFTER_DRAIN = false;
    bf16_t* O; const float* bias; int row_base;
    __device__ __forceinline__ void operator()(const pg8::f32x4 (&acc)[2][2][4][2], const pg8::Unit& u, int wr, int wc, int fr, int fq) const {
        const int seg = u.pn >> 1, row0 = row_base + u.pm * 256 + wr * 64 + fr, cs0 = (u.pn & 1) * 256 + wc * 32 + 8 * fq;
        const float ksig = seg < 2 ? -0.60653065971f : 1.0f; const bool lin = seg == 4;
        bf16_t* Os = O + (size_t)seg * NTOK * 512;
#pragma unroll
        for (int bj = 0; bj < 2; ++bj) {
            const int cs = cs0 + bj * 128;
            const pg8::f32x4 b0 = *(const pg8::f32x4*)(bias + seg * 512 + cs), b1 = *(const pg8::f32x4*)(bias + seg * 512 + cs + 4);
#pragma unroll
            for (int ai = 0; ai < 2; ++ai)
#pragma unroll
                for (int m = 0; m < 4; ++m) {
                    pg8::f32x4 v0 = acc[ai][bj][m][0] + b0, v1 = acc[ai][bj][m][1] + b1;
#pragma unroll
                    for (int r = 0; r < 4; ++r) {
                        const float t0 = ksig * __builtin_amdgcn_rcpf(1.0f + __expf(-v0[r])), t1 = ksig * __builtin_amdgcn_rcpf(1.0f + __expf(-v1[r]));
                        v0[r] = lin ? v0[r] : t0; v1[r] = lin ? v1[r] : t1;
                    }
                    u32x4 w; w.x = cvtpk_s(v0[0], v0[1]); w.y = cvtpk_s(v0[2], v0[3]); w.z = cvtpk_s(v1[0], v1[1]); w.w = cvtpk_s(v1[2], v1[3]);
                    *(u32x4*)(Os + (size_t)(row0 + ai * 128 + m * 16) * 512 + cs) = w;
                }
        }
    }
};
constexpr int LDS_TAB = 131072;
constexpr int LDS_LIST = LDS_TAB + 4096;
constexpr int LDS_ROWTAB = LDS_LIST + 1024;
__device__ __forceinline__ ListOrder build_units(LAS unsigned char* lds, int nM, int nN, int G, int c, const LAS int* tile_e, int ncol) {
    LAS int* list = (LAS int*)(lds + LDS_LIST);
    pg8::StaticOrder S; S.nM = nM; S.nN = nN; S.nwg = nM * nN; S.G = G; S.c = c;
    const int tid = tid_opaque();
    if (tid < 64) { pg8::Unit u; if (S.next(tid, u)) { if (tile_e) u.pn = tile_e[u.pm] * ncol + u.pn; list[2 * tid] = u.pm; list[2 * tid + 1] = u.pn; } }
    __syncthreads();
    ListOrder L; L.list = list; L.n = (c < S.nwg) ? (S.nwg - c + G - 1) / G : 0; L.rowtab = (const LAS unsigned*)(lds + LDS_ROWTAB);
    return L;
}
struct EpiMoe1 {
    static constexpr bool PERM = true, AFTER_DRAIN = false;
    bf16_t* O; const float* b1;
    __device__ __forceinline__ void operator()(const pg8::f32x4 (&acc)[2][2][4][2], const pg8::Unit& u, int wr, int wc, int fr, int fq) const {
        const int e = u.pn >> 3, pn = u.pn & 7;
        const int row0 = u.pm * 256 + wr * 64 + fr, ci = pn * 128 + wc * 32 + 8 * fq;
        const float* be = b1 + (size_t)e * 2048 + ci;
        const pg8::f32x4 bg0 = *(const pg8::f32x4*)(be), bg1 = *(const pg8::f32x4*)(be + 4), bl0 = *(const pg8::f32x4*)(be + 1024), bl1 = *(const pg8::f32x4*)(be + 1028);
#pragma unroll
        for (int ai = 0; ai < 2; ++ai)
#pragma unroll
            for (int m = 0; m < 4; ++m) {
                const pg8::f32x4 g0 = acc[ai][0][m][0] + bg0, g1 = acc[ai][0][m][1] + bg1, l0 = acc[ai][1][m][0] + bl0, l1 = acc[ai][1][m][1] + bl1;
                float o[8];
#pragma unroll
                for (int r = 0; r < 4; ++r) {
                    const float ga = fminf(g0[r], 7.0f), gb = fminf(g1[r], 7.0f);
                    const float la = fminf(fmaxf(l0[r], -7.0f), 7.0f), lb = fminf(fmaxf(l1[r], -7.0f), 7.0f);
                    o[r] = ga * __builtin_amdgcn_rcpf(1.0f + __expf(-1.702f * ga)) * (la + 1.0f);
                    o[4 + r] = gb * __builtin_amdgcn_rcpf(1.0f + __expf(-1.702f * gb)) * (lb + 1.0f);
                }
                u32x4 w; w.x = cvtpk_s(o[0], o[1]); w.y = cvtpk_s(o[2], o[3]); w.z = cvtpk_s(o[4], o[5]); w.w = cvtpk_s(o[6], o[7]);
                *(u32x4*)(O + (size_t)(row0 + ai * 128 + m * 16) * DM + ci) = w;
            }
    }
};
struct EpiMoe2 {
    static constexpr bool PERM = true, AFTER_DRAIN = false;
    bf16_t* O; const float* b2;
    __device__ __forceinline__ void operator()(const pg8::f32x4 (&acc)[2][2][4][2], const pg8::Unit& u, int wr, int wc, int fr, int fq) const {
        const int e = u.pn >> 2, pn = u.pn & 3;
        const int row0 = u.pm * 256 + wr * 64 + fr, col0 = pn * 256 + wc * 32 + 8 * fq;
        const float* be = b2 + (size_t)e * DM + col0;
        pg8::f32x4 bv[2][2];
#pragma unroll
        for (int bj = 0; bj < 2; ++bj)
#pragma unroll
            for (int n = 0; n < 2; ++n) bv[bj][n] = *(const pg8::f32x4*)(be + bj * 128 + 4 * n);
#pragma unroll
        for (int ai = 0; ai < 2; ++ai)
#pragma unroll
            for (int m = 0; m < 4; ++m) { bf16_t* rowp = O + (size_t)(row0 + ai * 128 + m * 16) * DM + col0;
#pragma unroll
                for (int bj = 0; bj < 2; ++bj) { const pg8::f32x4 v0 = acc[ai][bj][m][0] + bv[bj][0], v1 = acc[ai][bj][m][1] + bv[bj][1];
                    u32x4 w; w.x = cvtpk_s(v0[0], v0[1]); w.y = cvtpk_s(v0[2], v0[3]); w.z = cvtpk_s(v1[0], v1[1]); w.w = cvtpk_s(v1[2], v1[3]);
                    *(u32x4*)(rowp + bj * 128) = w; } }
    }
};

namespace att {
typedef float f32x16 __attribute__((ext_vector_type(16)));
typedef short s16x4 __attribute__((ext_vector_type(4)));
constexpr int KVBLK = 64, LDR = 512;
constexpr float SCALE = 0.125f, THR = 8.f;
constexpr int SHM_V = KVBLK * 128 * 2, SHM_K = KVBLK * 64 * 2, SHM_ATTN = 2 * SHM_V + 2 * SHM_K + NWAVES * 64 * 4;
#define ATT_KSWZ(row, colB) ((row) * 128 + ((colB) ^ ((((row) >> 1) & 7) << 4)))
#define ATT_SBAR() __builtin_amdgcn_sched_barrier(0)
__device__ __forceinline__ int crow(int r, int hi) { return (r & 3) + 8 * (r >> 2) + 4 * hi; }
__device__ __forceinline__ unsigned cvtpk(float lo, float hi) { unsigned r; asm volatile("v_cvt_pk_bf16_f32 %0, %1, %2" : "=v"(r) : "v"(lo), "v"(hi)); return r; }
__device__ __forceinline__ void partialSM(f32x16& p0, f32x16& p1, float& m_reg, float& mn, float& alpha) {
    constexpr float C = SCALE * 1.4426950408889634f;
    float pmax = p0[0];
#pragma unroll
    for (int r = 1; r < 16; ++r) pmax = fmaxf(pmax, p0[r]);
#pragma unroll
    for (int r = 0; r < 16; ++r) pmax = fmaxf(pmax, p1[r]);
    { auto rr = __builtin_amdgcn_permlane32_swap(__float_as_uint(pmax), __float_as_uint(pmax), false, false);
      pmax = fmaxf(__uint_as_float(rr[0]), __uint_as_float(rr[1])); }
    if (__builtin_expect(__all(pmax - m_reg <= THR / SCALE), 1)) { mn = m_reg; alpha = 1.f; }
    else { mn = fmaxf(m_reg, pmax); alpha = __builtin_amdgcn_exp2f((m_reg - mn) * C); m_reg = mn; }
    const float mnC = -mn * C;
#pragma unroll
    for (int r = 0; r < 16; ++r) p0[r] = fmaf(p0[r], C, mnC);
#pragma unroll
    for (int r = 0; r < 16; ++r) p1[r] = fmaf(p1[r], C, mnC);
#pragma unroll
    for (int r = 0; r < 16; ++r) p0[r] = __builtin_amdgcn_exp2f(p0[r]);
}
__device__ __forceinline__ void finishSM(f32x16& p0, f32x16& p1, float alpha, float& l_reg, bf16x8& pa0, bf16x8& pa1, bf16x8& pa2, bf16x8& pa3) {
#pragma unroll
    for (int r = 0; r < 16; ++r) p1[r] = __builtin_amdgcn_exp2f(p1[r]);
    float ps = 0;
#pragma unroll
    for (int r = 0; r < 16; ++r) ps += p0[r];
#pragma unroll
    for (int r = 0; r < 16; ++r) ps += p1[r];
    { auto rr = __builtin_amdgcn_permlane32_swap(__float_as_uint(ps), __float_as_uint(ps), false, false);
      ps = __uint_as_float(rr[0]) + __uint_as_float(rr[1]); }
    l_reg = l_reg * alpha + ps;
#define ATT_PK4(P, BASE, OUT) do { unsigned a0 = cvtpk(P[BASE + 0], P[BASE + 1]), a1 = cvtpk(P[BASE + 2], P[BASE + 3]);   \
    unsigned b0 = cvtpk(P[BASE + 4], P[BASE + 5]), b1 = cvtpk(P[BASE + 6], P[BASE + 7]);                              \
    auto r0 = __builtin_amdgcn_permlane32_swap(a0, b0, false, false); auto r1 = __builtin_amdgcn_permlane32_swap(a1, b1, false, false); \
    u32x4 w = {r0[0], r1[0], r0[1], r1[1]}; OUT = __builtin_bit_cast(bf16x8, w); } while (0)
    ATT_PK4(p0, 0, pa0); ATT_PK4(p0, 8, pa1); ATT_PK4(p1, 0, pa2); ATT_PK4(p1, 8, pa3);
#undef ATT_PK4
}
__device__ __forceinline__ void qkt(f32x16& p0, f32x16& p1, const LAS unsigned char* Ks, const bf16x8 (&qr)[4], int r32, int hi) {
    p0 = f32x16{}; p1 = f32x16{};
#pragma unroll
    for (int d0 = 0; d0 < 4; ++d0) { const int cb = (d0 * 16 + hi * 8) * 2;
        const bf16x8 b0 = *(const LAS bf16x8*)(Ks + ATT_KSWZ(r32, cb));
        const bf16x8 b1 = *(const LAS bf16x8*)(Ks + ATT_KSWZ(32 + r32, cb));
        p0 = __builtin_amdgcn_mfma_f32_32x32x16_bf16(b0, qr[d0], p0, 0, 0, 0);
        p1 = __builtin_amdgcn_mfma_f32_32x32x16_bf16(b1, qr[d0], p1, 0, 0, 0); }
}
__device__ __forceinline__ int v_st(int k, int c) { const int kk = (k & ~0xC) | ((k & 4) << 1) | ((k & 8) >> 1); return ((kk >> 3) * 4 + (c >> 5)) * 512 + ((kk & 7) * 32 + (c & 31)) * 2; }
__device__ __forceinline__ int v_rd_base(int lane) { return ((lane & 3) << 3) | (((lane >> 2) & 3) << 6) | (((lane >> 4) & 1) << 5) | (((lane >> 5) & 1) << 8); }
constexpr int v_rd_off(int d0, int ks, int half) { return d0 * 512 + ks * 4096 + half * 2048; }
template <int OFF> __device__ __forceinline__ s16x4 tr_read(int vb) { s16x4 r; asm volatile("ds_read_b64_tr_b16 %0, %1 offset:%2" : "=&v"(r) : "v"(vb), "i"(OFF) : "memory"); return r; }
template <int D0> __device__ __forceinline__ void pv_one(f32x16& od, int vb, bf16x8 pa0, bf16x8 pa1, bf16x8 pa2, bf16x8 pa3) {
    const s16x4 l0 = tr_read<v_rd_off(D0, 0, 0)>(vb), h0 = tr_read<v_rd_off(D0, 0, 1)>(vb), l1 = tr_read<v_rd_off(D0, 1, 0)>(vb), h1 = tr_read<v_rd_off(D0, 1, 1)>(vb);
    const s16x4 l2 = tr_read<v_rd_off(D0, 2, 0)>(vb), h2 = tr_read<v_rd_off(D0, 2, 1)>(vb), l3 = tr_read<v_rd_off(D0, 3, 0)>(vb), h3 = tr_read<v_rd_off(D0, 3, 1)>(vb);
    asm volatile("s_waitcnt lgkmcnt(0)" ::: "memory"); ATT_SBAR();
#define ATT_PK(L, H) (bf16x8){L[0], L[1], L[2], L[3], H[0], H[1], H[2], H[3]}
    od = __builtin_amdgcn_mfma_f32_32x32x16_bf16(pa0, ATT_PK(l0, h0), od, 0, 0, 0);
    od = __builtin_amdgcn_mfma_f32_32x32x16_bf16(pa1, ATT_PK(l1, h1), od, 0, 0, 0);
    od = __builtin_amdgcn_mfma_f32_32x32x16_bf16(pa2, ATT_PK(l2, h2), od, 0, 0, 0);
    od = __builtin_amdgcn_mfma_f32_32x32x16_bf16(pa3, ATT_PK(l3, h3), od, 0, 0, 0);
#undef ATT_PK
}
__device__ __forceinline__ void pv_d0(f32x16 (&o)[4], int vb, bf16x8 pa0, bf16x8 pa1, bf16x8 pa2, bf16x8 pa3) {
    pv_one<0>(o[0], vb, pa0, pa1, pa2, pa3); pv_one<1>(o[1], vb, pa0, pa1, pa2, pa3); pv_one<2>(o[2], vb, pa0, pa1, pa2, pa3); pv_one<3>(o[3], vb, pa0, pa1, pa2, pa3);
}
__device__ __forceinline__ void attn_body(const bf16_t* Qb, const bf16_t* Kh, const bf16_t* Vh, float* Ob, int seq, LAS unsigned char* lds) {
    const int tid = tid_opaque(), wid = tid >> 6, lane = tid & 63, r32 = lane & 31, hi = lane >> 5;
    LAS unsigned char* V_lds = lds; LAS unsigned char* K_lds = lds + 2 * SHM_V;
    LAS float* wsl = (LAS float*)(lds + 2 * SHM_V + 2 * SHM_K) + wid * 64; LAS float* li_l = wsl; LAS float* al_l = wsl + 32;
    float m_reg = -1e30f, l_reg = 0; f32x16 o[4] = {}; bf16x8 qr[4];
    const bf16_t* Qw = Qb + (size_t)(wid * 32 + r32) * LDR + hi * 8;
#pragma unroll
    for (int d0 = 0; d0 < 4; ++d0) qr[d0] = *(const bf16x8*)(Qw + d0 * 16);
    const int sr = tid >> 4, sc = (tid & 15) * 8, vst0 = v_st(sr, sc), vst1 = v_st(32 + sr, sc);
    const int kr = tid >> 3, kc = (tid & 7) * 8, kst = ATT_KSWZ(kr, kc * 2);
    const int vb0 = (int)(uintptr_t)V_lds + v_rd_base(lane);
    bf16x8 vsA0, vsA1, ksA, vsB0, vsB1, ksB;
#define ATT_SLOAD(V0, V1, K0, k0) do { V0 = *(const bf16x8*)(Vh + (size_t)((k0) + sr) * LDR + sc); V1 = *(const bf16x8*)(Vh + (size_t)((k0) + 32 + sr) * LDR + sc); \
    K0 = *(const bf16x8*)(Kh + (size_t)((k0) + kr) * LDR + kc); } while (0)
#define ATT_SWRITE(b, V0, V1, K0) do { *(LAS bf16x8*)(V_lds + (b) * SHM_V + vst0) = V0; *(LAS bf16x8*)(V_lds + (b) * SHM_V + vst1) = V1; \
    *(LAS bf16x8*)(K_lds + (b) * SHM_K + kst) = K0; } while (0)
#define ATT_SWAIT() asm volatile("s_waitcnt vmcnt(3)" ::: "memory")
#define ATT_RESC(a) do { if (__any((a) < 1.f)) { if (hi == 0) al_l[r32] = (a); asm volatile("s_waitcnt lgkmcnt(0)" ::: "memory"); \
    _Pragma("unroll") for (int d = 0; d < 4; ++d) _Pragma("unroll") for (int r = 0; r < 16; ++r) o[d][r] *= al_l[crow(r, hi)]; } } while (0)
    f32x16 pA0, pA1, pB0, pB1; float mnA, mnB, alA, alB; bf16x8 pa0, pa1, pa2, pa3; const int NT = seq / KVBLK;
    ATT_SLOAD(vsA0, vsA1, ksA, 0); asm volatile("s_waitcnt vmcnt(0)" ::: "memory"); ATT_SWRITE(0, vsA0, vsA1, ksA); __syncthreads();
    qkt(pA0, pA1, K_lds, qr, r32, hi); partialSM(pA0, pA1, m_reg, mnA, alA);
    ATT_SLOAD(vsB0, vsB1, ksB, KVBLK); if (2 < NT) ATT_SLOAD(vsA0, vsA1, ksA, 2 * KVBLK);
    ATT_SWAIT(); ATT_SWRITE(1, vsB0, vsB1, ksB); __syncthreads();
    for (int j = 1; j + 1 < NT; j += 2) {
        ATT_SBAR(); qkt(pB0, pB1, K_lds + SHM_K, qr, r32, hi);
        finishSM(pA0, pA1, alA, l_reg, pa0, pa1, pa2, pa3); ATT_SBAR();
        ATT_SLOAD(vsB0, vsB1, ksB, (j + 2) * KVBLK); ATT_SBAR();
        pv_d0(o, vb0, pa0, pa1, pa2, pa3); partialSM(pB0, pB1, m_reg, mnB, alB);
        __syncthreads(); ATT_SWAIT(); ATT_SWRITE(0, vsA0, vsA1, ksA);
        ATT_RESC(alB); __syncthreads();
        ATT_SBAR(); qkt(pA0, pA1, K_lds, qr, r32, hi);
        finishSM(pB0, pB1, alB, l_reg, pa0, pa1, pa2, pa3); ATT_SBAR();
        if (j + 3 < NT) ATT_SLOAD(vsA0, vsA1, ksA, (j + 3) * KVBLK); ATT_SBAR();
        pv_d0(o, vb0 + SHM_V, pa0, pa1, pa2, pa3); partialSM(pA0, pA1, m_reg, mnA, alA);
        __syncthreads(); ATT_SWAIT(); ATT_SWRITE(1, vsB0, vsB1, ksB);
        ATT_RESC(alA); __syncthreads();
    }
    ATT_SBAR(); qkt(pB0, pB1, K_lds + SHM_K, qr, r32, hi);
    finishSM(pA0, pA1, alA, l_reg, pa0, pa1, pa2, pa3); ATT_SBAR();
    pv_d0(o, vb0, pa0, pa1, pa2, pa3); partialSM(pB0, pB1, m_reg, mnB, alB);
    __syncthreads(); ATT_RESC(alB);
    finishSM(pB0, pB1, alB, l_reg, pa0, pa1, pa2, pa3); ATT_SBAR();
    pv_d0(o, vb0 + SHM_V, pa0, pa1, pa2, pa3);
    if (hi == 0) li_l[r32] = l_reg; asm volatile("s_waitcnt lgkmcnt(0)" ::: "memory");
    float rli[16];
#pragma unroll
    for (int r = 0; r < 16; ++r) rli[r] = __builtin_amdgcn_rcpf(li_l[crow(r, hi)]);
    float* Ow = Ob + (size_t)(wid * 32) * LDR;
#pragma unroll
    for (int r = 0; r < 16; ++r) { const int orow = crow(r, hi);
#pragma unroll
        for (int d0 = 0; d0 < 4; ++d0) Ow[(size_t)orow * LDR + d0 * 32 + r32] = o[d0][r] * rli[r]; }
#undef ATT_SLOAD
#undef ATT_SWRITE
#undef ATT_SWAIT
#undef ATT_RESC
}
}

__device__ __forceinline__ void ph_gemm_win(const Args& A, int j, int row_lo, LAS unsigned char* lds, int bid, int nb) {
    unsigned char* ws = opq(A.ws); const float* const* IN = (const float* const*)(ws + WS_PTRS); (void)IN;
    pg8::Gemm g{(const bf16_t*)(ws + WS_ABF) + (size_t)row_lo * DM, (const bf16_t*)(ws + WS_WIN) + (size_t)j * ZLD * DM, NTOK - row_lo, ZLD, DM};
    const ListOrder S = build_units(lds, (NTOK - row_lo) / 256, ZLD / 256, nb, bid, nullptr, 0);
    EpiStoreBf16 E{(bf16_t*)(ws + WS_Z) + (size_t)row_lo * ZLD, ZLD};
    pg8::gemm_phase<EpiStoreBf16, ListOrder, true, true>(lds, g, S, E);
}

__device__ __forceinline__ void ph_rwkv_pre(const Args& A, int j, int row_lo, int bid, int nb) {
    unsigned char* ws = opq(A.ws); const float* const* IN = (const float* const*)(ws + WS_PTRS);
    const int tid = tid_opaque(), lane = tid & 63, wid = tid >> 6;
    const bf16_t* Z = (const bf16_t*)(ws + WS_Z);
    const float* mu = INP(I_RWMU) + (size_t)j * 2 * RWC; const float* kkw = INP(I_RWKK) + j * 512;
    bf16_t* RB = (bf16_t*)(ws + WS_RB); bf16_t* KS = (bf16_t*)(ws + WS_KS); bf16_t* VS = (bf16_t*)(ws + WS_VS); bf16_t* KKN = (bf16_t*)(ws + WS_KKN); bf16_t* LIN = (bf16_t*)(ws + WS_LIN);
    for (int g = row_lo + bid * NWAVES + wid; g < NTOK; g += nb * NWAVES) {
        const Tok tk = tokinfo(g);
        const bool hp = tk.t > 0, hn = tk.t < tk.T - 1;
        const bf16_t* zc = Z + (size_t)g * ZLD;
#pragma unroll
        for (int i = 0; i < 15; ++i) {
            const int col = i * 128 + lane * 2;
            const unsigned c = *(const unsigned*)(zc + col), p = hp ? *(const unsigned*)(zc - ZLD + col) : 0u, n = hn ? *(const unsigned*)(zc + ZLD + col) : 0u;
            const f32x2_t m0 = *(const f32x2_t*)(mu + col), m1 = *(const f32x2_t*)(mu + RWC + col);
            const float z0 = __builtin_bit_cast(float, c << 16), z1 = __builtin_bit_cast(float, c & 0xffff0000u);
            const float p0 = __builtin_bit_cast(float, p << 16), p1 = __builtin_bit_cast(float, p & 0xffff0000u);
            const float n0 = __builtin_bit_cast(float, n << 16), n1 = __builtin_bit_cast(float, n & 0xffff0000u);
            const float s0 = z0 + m0.x * (p0 - z0) + m1.x * (n0 - z0), s1 = z1 + m0.y * (p1 - z1) + m1.y * (n1 - z1);
            if (i < 4) *(unsigned*)(RB + (size_t)g * 512 + col) = pk2(s0, s1);
            else if (i < 8) {
                const int ck = col - 512;
                *(unsigned*)(KS + (size_t)g * 512 + ck) = pk2(s0, s1);
                const f32x2_t kw = *(const f32x2_t*)(kkw + ck);
                const float k0 = s0 * kw.x, k1 = s1 * kw.y;
                float ss = k0 * k0 + k1 * k1;
#pragma unroll
                for (int o = 1; o < 32; o <<= 1) ss += __shfl_xor(ss, o);
                const float inv = 1.0f / fmaxf(sqrtf(ss), 1e-12f);
                *(unsigned*)(KKN + (size_t)g * 512 + ck) = pk2(k0 * inv, k1 * inv);
            }
            else if (i < 12) *(unsigned*)(VS + (size_t)g * 512 + (col - 1024)) = pk2(s0, s1);
            else if (i == 12) *(unsigned*)(LIN + (size_t)g * 384 + (col - 1536)) = pk2(tanhf(s0), tanhf(s1));
            else if (i == 13) *(unsigned*)(LIN + (size_t)g * 384 + 128 + (col - 1664)) = pk2(s0, s1);
            else *(unsigned*)(LIN + (size_t)g * 384 + 256 + (col - 1792)) = pk2(sigmoidf_(s0), sigmoidf_(s1));
        }
    }
}
__device__ __forceinline__ void ph_gemm_lora(const Args& A, int j, int row_lo, LAS unsigned char* lds, int bid, int nb) {
    unsigned char* ws = opq(A.ws);
    int Kq = LORA_K; asm volatile("" : "+s"(Kq));
    pg8::Gemm g{(const bf16_t*)(ws + WS_LIN) + (size_t)row_lo * LORA_K, (const bf16_t*)(ws + WS_WLORA) + (size_t)j * LORA_N * LORA_K, NTOK - row_lo, LORA_N, Kq};
    const ListOrder S = build_units(lds, (NTOK - row_lo) / 256, LORA_N / 256, nb, bid, nullptr, 0);
    EpiLora E{(bf16_t*)(ws + WS_LO), (const float*)(ws + WS_LBIAS) + (size_t)j * LORA_N, row_lo};
    pg8::gemm_phase<EpiLora, ListOrder, true, true>(lds, g, S, E);
}

constexpr int R_A2 = 0, R_RT = 2048, R_BT = 4096, R_KT = 6144, R_VT = 8192, R_MBR = 10240, R_MKR = 10752, R_G = 11264, R_P = 11776;
__device__ __forceinline__ bf16x8 frag4(u32x2 lo) { const u32x4 w = {lo.x, lo.y, 0u, 0u}; return __builtin_bit_cast(bf16x8, w); }
__device__ __forceinline__ bf16x8 frag8(u32x2 lo, u32x2 hi) { const u32x4 w = {lo.x, lo.y, hi.x, hi.y}; return __builtin_bit_cast(bf16x8, w); }
__device__ __forceinline__ u32x2 pack4(f32x4 v) { u32x2 o; o.x = cvtpk_s(v[0], v[1]); o.y = cvtpk_s(v[2], v[3]); return o; }
__device__ __forceinline__ int wkv_token(int b, int dir, int s) {
    if (s < TC) return b * TC + (dir ? (TC - 1 - s) : s);
    const int q = s - TC; return NCTX + b * TL + (dir ? (TL - 1 - q) : q);
}
__device__ __forceinline__ void ph_wkv_prep(const Args& A, int j, LAS unsigned char* lds, int bid, int nb) {
    unsigned char* ws = opq(A.ws); const float* const* IN = (const float* const*)(ws + WS_PTRS);
    const int tid = tid_opaque(), lane = tid & 63, wid = tid >> 6, c16 = lane & 15, g4 = lane >> 4;
    constexpr int RS = 144;
    LAS unsigned char* wl = lds + wid * 16384;
    LAS unsigned char* Lat = wl; LAS unsigned char* Lbt = wl + 2304; LAS unsigned char* Lkt = wl + 4608; LAS unsigned char* Lrt = wl + 6912;
    LAS unsigned char* LaT = wl + 9216;
    LAS float* Lnf = (LAS float*)(wl + 11264);
    LAS unsigned char* Lx = wl + 12352;
    const size_t FS = (size_t)NTOK * 512;
    const bf16_t* RB = (const bf16_t*)(ws + WS_RB); const bf16_t* KS = (const bf16_t*)(ws + WS_KS); const bf16_t* VS = (const bf16_t*)(ws + WS_VS); const bf16_t* KKN = (const bf16_t*)(ws + WS_KKN);
    for (int unit = bid * NWAVES + wid; unit < 256 * WKV_NCH; unit += nb * NWAVES) {
        const int inst = unit / WKV_NCH, c = unit - inst * WKV_NCH, dir = inst & 1, h = (inst >> 1) & 7, b = inst >> 4;
        const int g0 = wkv_token(b, dir, c * 16), gstep = dir ? -1 : 1;
        unsigned char* rec = ws + WS_WKV + (size_t)unit * WKV_REC;
        const bf16_t* LWd = (const bf16_t*)(ws + WS_LO) + dir * FS; const bf16_t* ABd = (const bf16_t*)(ws + WS_AB) + dir * FS;
        const float kaw = INP(I_RWKA)[j * 512 + h * 64 + lane];
        float cs = 0.f, ec = 1.f; unsigned aTp[8], bTp[8], kTp[8], vTp[8]; float pa = 0.f, pb = 0.f, pk = 0.f, pv = 0.f;
#pragma unroll
        for (int t = 0; t < 16; ++t) {
            const size_t o = (size_t)(g0 + gstep * t) * 512 + h * 64 + lane;
            const float lw = bf2f(LWd[o]), av = bf2f(ABd[o]), kkv = bf2f(KKN[o]), ksv = bf2f(KS[o]), rv = bf2f(RB[o]), vv = bf2f(VS[o]);
            const float bb = kkv * av, kdv = ksv * (1.0f + (av - 1.0f) * kaw);
            const float ep = ec; cs += lw; ec = __expf(cs); const float em = __expf(-cs);
            const float at = -kkv * ep, bt = bb * em, kt = kdv * em, rt = rv * ec;
            *(LAS bf16_t*)(Lat + t * RS + lane * 2) = (bf16_t)f2bf(at); *(LAS bf16_t*)(Lbt + t * RS + lane * 2) = (bf16_t)f2bf(bt);
            *(LAS bf16_t*)(Lkt + t * RS + lane * 2) = (bf16_t)f2bf(kt); *(LAS bf16_t*)(Lrt + t * RS + lane * 2) = (bf16_t)f2bf(rt);
            if (t & 1) { aTp[t >> 1] = pk2(pa, at); bTp[t >> 1] = pk2(pb, bt); kTp[t >> 1] = pk2(pk, kt); vTp[t >> 1] = pk2(pv, vv); }
            else { pa = at; pb = bt; pk = kt; pv = vv; }
        }
        *(float*)(rec + R_P + lane * 4) = ec;
        *(u32x4*)(rec + R_BT + lane * 32) = (u32x4){bTp[0], bTp[1], bTp[2], bTp[3]}; *(u32x4*)(rec + R_BT + lane * 32 + 16) = (u32x4){bTp[4], bTp[5], bTp[6], bTp[7]};
        *(u32x4*)(rec + R_KT + lane * 32) = (u32x4){kTp[0], kTp[1], kTp[2], kTp[3]}; *(u32x4*)(rec + R_KT + lane * 32 + 16) = (u32x4){kTp[4], kTp[5], kTp[6], kTp[7]};
        *(u32x4*)(rec + R_VT + lane * 32) = (u32x4){vTp[0], vTp[1], vTp[2], vTp[3]}; *(u32x4*)(rec + R_VT + lane * 32 + 16) = (u32x4){vTp[4], vTp[5], vTp[6], vTp[7]};
        *(LAS u32x4*)(LaT + lane * 32) = (u32x4){aTp[0], aTp[1], aTp[2], aTp[3]}; *(LAS u32x4*)(LaT + lane * 32 + 16) = (u32x4){aTp[4], aTp[5], aTp[6], aTp[7]};
        asm volatile("s_waitcnt lgkmcnt(0)" ::: "memory");
        f32x4 nD = {0.f, 0.f, 0.f, 0.f}, makD = nD, mbrD = nD, mkrD = nD;
#pragma unroll
        for (int ks = 0; ks < 2; ++ks) {
            const int off = c16 * RS + (32 * ks + 8 * g4) * 2;
            const bf16x8 fa = *(const LAS bf16x8*)(Lat + off), fb = *(const LAS bf16x8*)(Lbt + off), fk = *(const LAS bf16x8*)(Lkt + off), fr = *(const LAS bf16x8*)(Lrt + off);
            nD = __builtin_amdgcn_mfma_f32_16x16x32_bf16(fa, fb, nD, 0, 0, 0);
            makD = __builtin_amdgcn_mfma_f32_16x16x32_bf16(fa, fk, makD, 0, 0, 0);
            mbrD = __builtin_amdgcn_mfma_f32_16x16x32_bf16(fb, fr, mbrD, 0, 0, 0);
            mkrD = __builtin_amdgcn_mfma_f32_16x16x32_bf16(fk, fr, mkrD, 0, 0, 0);
        }
#pragma unroll
        for (int r = 0; r < 4; ++r) {
            const int row = 4 * g4 + r;
            nD[r] = (c16 < row) ? nD[r] : 0.f; makD[r] = (c16 < row) ? makD[r] : 0.f;
            mbrD[r] = (row <= c16) ? mbrD[r] : 0.f; mkrD[r] = (row <= c16) ? mkrD[r] : 0.f;
            Lnf[row * 17 + c16] = nD[r];
        }
        asm volatile("s_waitcnt lgkmcnt(0)" ::: "memory");
        float x[16];
#pragma unroll
        for (int t = 0; t < 16; ++t) {
            float acc = (t == c16) ? 1.f : 0.f;
#pragma unroll
            for (int i = 0; i < t; ++i) acc += Lnf[t * 17 + i] * x[i];
            x[t] = acc;
        }
        if (g4 == 0) {
#pragma unroll
            for (int t = 0; t < 16; ++t) *(LAS bf16_t*)(Lx + t * 32 + c16 * 2) = (bf16_t)f2bf(x[t]);
        }
        asm volatile("s_waitcnt lgkmcnt(0)" ::: "memory");
        const bf16x8 xB = frag4(*(const LAS u32x2*)(Lx + c16 * 32 + g4 * 8));
        const f32x4 z4 = {0.f, 0.f, 0.f, 0.f};
        const f32x4 gD = __builtin_amdgcn_mfma_f32_16x16x32_bf16(frag4(pack4(makD)), xB, z4, 0, 0, 0);
        *(u32x2*)(rec + R_G + (c16 * 16 + 4 * g4) * 2) = pack4(gD);
        *(u32x2*)(rec + R_MBR + (c16 * 16 + 4 * g4) * 2) = pack4(mbrD);
        *(u32x2*)(rec + R_MKR + (c16 * 16 + 4 * g4) * 2) = pack4(mkrD);
#pragma unroll
        for (int mt = 0; mt < 4; ++mt) {
            const bf16x8 aA = frag4(*(const LAS u32x2*)(LaT + (16 * mt + c16) * 32 + g4 * 8));
            const f32x4 d = __builtin_amdgcn_mfma_f32_16x16x32_bf16(aA, xB, z4, 0, 0, 0);
            *(u32x2*)(rec + R_A2 + (c16 * 64 + 16 * mt + 4 * g4) * 2) = pack4(d);
        }
        { const int row = lane >> 2, cb = (lane & 3) * 16;
          const u32x4 r0 = *(const LAS u32x4*)(Lrt + row * RS + cb * 2), r1 = *(const LAS u32x4*)(Lrt + row * RS + cb * 2 + 16);
          *(u32x4*)(rec + R_RT + (row * 64 + cb) * 2) = r0; *(u32x4*)(rec + R_RT + (row * 64 + cb) * 2 + 16) = r1; }
        asm volatile("s_waitcnt lgkmcnt(0)" ::: "memory");
    }
}
struct WkvOps { u32x2 a2[4], rt[4], g, mkr, mbr, bt[4], kt[4], vt; f32x4 p[4]; };
__device__ __forceinline__ void wkv_load(WkvOps& o, const unsigned char* rec, int c16, int g4, int v0) {
#pragma unroll
    for (int q = 0; q < 4; ++q) {
        o.a2[q] = *(const u32x2*)(rec + R_A2 + (c16 * 64 + 16 * q + 4 * g4) * 2);
        o.rt[q] = *(const u32x2*)(rec + R_RT + (c16 * 64 + 16 * q + 4 * g4) * 2);
        o.bt[q] = *(const u32x2*)(rec + R_BT + ((16 * q + c16) * 16 + 4 * g4) * 2);
        o.kt[q] = *(const u32x2*)(rec + R_KT + ((16 * q + c16) * 16 + 4 * g4) * 2);
        o.p[q] = *(const f32x4*)(rec + R_P + (16 * q + 4 * g4) * 4);
    }
    o.g = *(const u32x2*)(rec + R_G + (c16 * 16 + 4 * g4) * 2); o.mkr = *(const u32x2*)(rec + R_MKR + (c16 * 16 + 4 * g4) * 2); o.mbr = *(const u32x2*)(rec + R_MBR + (c16 * 16 + 4 * g4) * 2);
    o.vt = *(const u32x2*)(rec + R_VT + ((v0 + c16) * 16 + 4 * g4) * 2);
}
__device__ __forceinline__ void ph_wkv_scan(const Args& A, int bid, int nb) {
    unsigned char* ws = opq(A.ws);
    const int tid = tid_opaque(), lane = tid & 63, wid = tid >> 6, c16 = lane & 15, g4 = lane >> 4;
    if (wid >= 4) return;
    float* YS = (float*)(ws + WS_YS); const size_t FS = (size_t)NTOK * 512;
    const int v0 = wid * 16;
    for (int inst = bid; inst < 256; inst += nb) {
        const int dir = inst & 1, h = (inst >> 1) & 7, b = inst >> 4;
        const unsigned char* rec0 = ws + WS_WKV + (size_t)inst * WKV_NCH * WKV_REC;
        float* Y = YS + dir * FS + h * 64 + v0 + c16;
        f32x4 S[4];
#pragma unroll
        for (int mt = 0; mt < 4; ++mt) S[mt] = (f32x4){0.f, 0.f, 0.f, 0.f};
        WkvOps cur, nxt;
        wkv_load(cur, rec0, c16, g4, v0);
        for (int c = 0; c < WKV_NCH; ++c) {
            wkv_load(nxt, rec0 + (size_t)((c + 1 < WKV_NCH) ? c + 1 : c) * WKV_REC, c16, g4, v0);
            const f32x4 z4 = {0.f, 0.f, 0.f, 0.f};
            const bf16x8 sb0 = frag8(pack4(S[0]), pack4(S[1])), sb1 = frag8(pack4(S[2]), pack4(S[3]));
            const bf16x8 vb = frag4(cur.vt);
            f32x4 U = __builtin_amdgcn_mfma_f32_16x16x32_bf16(frag4(cur.g), vb, z4, 0, 0, 0);
            U = __builtin_amdgcn_mfma_f32_16x16x32_bf16(frag8(cur.a2[0], cur.a2[1]), sb0, U, 0, 0, 0);
            U = __builtin_amdgcn_mfma_f32_16x16x32_bf16(frag8(cur.a2[2], cur.a2[3]), sb1, U, 0, 0, 0);
            f32x4 Yt = __builtin_amdgcn_mfma_f32_16x16x32_bf16(frag4(cur.mkr), vb, z4, 0, 0, 0);
            Yt = __builtin_amdgcn_mfma_f32_16x16x32_bf16(frag8(cur.rt[0], cur.rt[1]), sb0, Yt, 0, 0, 0);
            Yt = __builtin_amdgcn_mfma_f32_16x16x32_bf16(frag8(cur.rt[2], cur.rt[3]), sb1, Yt, 0, 0, 0);
            const bf16x8 ub = frag4(pack4(U));
            Yt = __builtin_amdgcn_mfma_f32_16x16x32_bf16(frag4(cur.mbr), ub, Yt, 0, 0, 0);
#pragma unroll
            for (int mt = 0; mt < 4; ++mt) {
                f32x4 sn = __builtin_amdgcn_mfma_f32_16x16x32_bf16(frag4(cur.kt[mt]), vb, S[mt], 0, 0, 0);
                sn = __builtin_amdgcn_mfma_f32_16x16x32_bf16(frag4(cur.bt[mt]), ub, sn, 0, 0, 0);
                S[mt] = sn * cur.p[mt];
            }
#pragma unroll
            for (int r = 0; r < 4; ++r) Y[(size_t)wkv_token(b, dir, c * 16 + 4 * g4 + r) * 512] = Yt[r];
            cur = nxt;
        }
    }
}

__device__ __forceinline__ void ph_qk(const Args& A, int j, int row_lo, int bid, int nb) {
    unsigned char* ws = opq(A.ws); const float* const* IN = (const float* const*)(ws + WS_PTRS);
    const int tid = tid_opaque(), lane = tid & 63, wid = tid >> 6;
    const bf16_t* Z = (const bf16_t*)(ws + WS_Z);
    bf16_t* QB = (bf16_t*)(ws + WS_QB); bf16_t* KB = (bf16_t*)(ws + WS_KB); bf16_t* VB = (bf16_t*)(ws + WS_VB);
    const int d0 = (lane & 7) * 8;
    float qn[8], kn[8], invf[8];
#pragma unroll
    for (int i = 0; i < 8; ++i) { qn[i] = INP(I_QN)[j * 64 + d0 + i]; kn[i] = INP(I_KN)[j * 64 + d0 + i]; invf[i] = __powf(10000.0f, -(float)((d0 + i) & 15) / 16.0f); }
    const bool upper = (d0 & 16) != 0, colaxis = (d0 & 32) != 0;
    for (int g = row_lo + bid * NWAVES + wid; g < NTOK; g += nb * NWAVES) {
        const Tok tk = tokinfo(g);
        const size_t krow = (size_t)tk.b * (TC + TL) + (tk.T == TL ? TC + tk.t : tk.t);
        const bf16_t* zr = Z + (size_t)g * ZLD + RWC;
        *(u32x4*)(VB + krow * 512 + lane * 8) = *(const u32x4*)(zr + 1024 + lane * 8);
        float cs[8], sn[8];
        if (tk.T == TL) {
            const float pos = (float)(colaxis ? (tk.t & 63) : (tk.t >> 6));
#pragma unroll
            for (int i = 0; i < 8; ++i) __sincosf(pos * invf[i], &sn[i], &cs[i]);
        }
#pragma unroll
        for (int isk = 0; isk < 2; ++isk) {
            const u32x4 raw = *(const u32x4*)(zr + isk * 512 + lane * 8);
            float x[8];
#pragma unroll
            for (int i = 0; i < 4; ++i) { x[2 * i] = __builtin_bit_cast(float, raw[i] << 16); x[2 * i + 1] = __builtin_bit_cast(float, raw[i] & 0xffff0000u); }
            float ss = 0.f;
#pragma unroll
            for (int i = 0; i < 8; ++i) ss += x[i] * x[i];
            ss += __shfl_xor(ss, 1); ss += __shfl_xor(ss, 2); ss += __shfl_xor(ss, 4);
            const float rs = rsqrtf(ss * (1.0f / 64.0f) + 1e-6f);
#pragma unroll
            for (int i = 0; i < 8; ++i) x[i] = x[i] * rs * (isk ? kn[i] : qn[i]);
            if (tk.T == TL) {
#pragma unroll
                for (int i = 0; i < 8; ++i) { const float other = __shfl_xor(x[i], 2); x[i] = upper ? (x[i] * cs[i] + other * sn[i]) : (x[i] * cs[i] - other * sn[i]); }
            }
            u32x4 o; o.x = pk2(x[0], x[1]); o.y = pk2(x[2], x[3]); o.z = pk2(x[4], x[5]); o.w = pk2(x[6], x[7]);
            if (isk) *(u32x4*)(KB + krow * 512 + lane * 8) = o; else *(u32x4*)(QB + (size_t)g * 512 + lane * 8) = o;
        }
    }
}

__device__ __forceinline__ void ph_attn(const Args& A, bool want_ctx, LAS unsigned char* lds, int bid, int nb) {
    unsigned char* ws = opq(A.ws);
    const bf16_t* QB = (const bf16_t*)(ws + WS_QB); const bf16_t* KB = (const bf16_t*)(ws + WS_KB); const bf16_t* VB = (const bf16_t*)(ws + WS_VB);
    float* OP = (float*)(ws + WS_OP);
    const int vcu = (nb % 8 == 0) ? (bid % 8) * (nb / 8) + bid / 8 : bid;
    const int nunits = 1024 + (want_ctx ? 128 : 0);
    for (int u = vcu; u < nunits; u += nb) {
        int b, h, m, q0, seq;
        if (u < 1024) { const int qb = u & 7; m = (u >> 3) & 1; h = (u >> 4) & 3; b = u >> 6; q0 = NCTX + b * TL + qb * 256; seq = TC + TL; }
        else { const int v = u - 1024; m = v & 1; h = (v >> 1) & 3; b = v >> 3; q0 = b * TC; seq = TC; }
        const int s = h * 2 + m;
        att::attn_body(QB + (size_t)q0 * 512 + s * 64, KB + (size_t)b * (TC + TL) * 512 + s * 64, VB + (size_t)b * (TC + TL) * 512 + h * 128,
                       OP + (size_t)m * NTOK * 512 + (size_t)q0 * 512 + h * 128, seq, lds);
    }
}

__device__ __forceinline__ void ph_merge(const Args& A, int l, int row_lo, int bid, int nb) {
    unsigned char* ws = opq(A.ws); const float* const* IN = (const float* const*)(ws + WS_PTRS);
    const int j = l >> 1;
    const int tid = tid_opaque(), lane = tid & 63, wid = tid >> 6, c0 = lane * 8;
    const float lam_init = 0.8f - 0.6f * __expf(-0.3f * (float)l);
    const float* lp = INP(I_LAM) + j * 4 * 64;
    const float lam = __expf(wave_sum(lp[lane] * lp[64 + lane])) - __expf(wave_sum(lp[128 + lane] * lp[192 + lane])) + lam_init;
    const size_t FS = (size_t)NTOK * 512;
    const bf16_t* RB = (const bf16_t*)(ws + WS_RB); const bf16_t* KS = (const bf16_t*)(ws + WS_KS); const bf16_t* VS = (const bf16_t*)(ws + WS_VS);
    const bf16_t* AB = (const bf16_t*)(ws + WS_AB); const bf16_t* GB = (const bf16_t*)(ws + WS_GB);
    const float* YS = (const float*)(ws + WS_YS); const float* OP = (const float*)(ws + WS_OP);
    bf16_t* CAT = (bf16_t*)(ws + WS_CAT);
    float gnw[8], gnb[8], kaw[8], rkw[8], sub[8];
#pragma unroll
    for (int i = 0; i < 8; ++i) { gnw[i] = INP(I_GNW)[j * 512 + c0 + i]; gnb[i] = INP(I_GNB)[j * 512 + c0 + i]; kaw[i] = INP(I_RWKA)[j * 512 + c0 + i]; rkw[i] = INP(I_RWRK)[j * 512 + c0 + i];
        sub[i] = INP(I_SUBLN)[j * 128 + ((c0 + i) & 127)] * (1.0f - lam_init); }
#define LD8BF(dst, ptr) do { const u32x4 _t = *(const u32x4*)(ptr); _Pragma("unroll") for (int _i = 0; _i < 4; ++_i) { dst[2 * _i] = __builtin_bit_cast(float, _t[_i] << 16); dst[2 * _i + 1] = __builtin_bit_cast(float, _t[_i] & 0xffff0000u); } } while (0)
    for (int g = row_lo + bid * NWAVES + wid; g < NTOK; g += nb * NWAVES) {
        const size_t o = (size_t)g * 512 + c0;
        float y[8], r_[8], k_[8], v_[8], a0[8], a1[8], gg[8];
        { const f32x4 y0 = *(const f32x4*)(YS + o), y1 = *(const f32x4*)(YS + o + 4), z0 = *(const f32x4*)(YS + FS + o), z1 = *(const f32x4*)(YS + FS + o + 4);
#pragma unroll
          for (int i = 0; i < 4; ++i) { y[i] = y0[i] + z0[i]; y[4 + i] = y1[i] + z1[i]; } }
        LD8BF(r_, RB + o); LD8BF(k_, KS + o); LD8BF(v_, VS + o); LD8BF(a0, AB + o); LD8BF(a1, AB + FS + o); LD8BF(gg, GB + o);
        float sy = 0.f, sb = 0.f;
#pragma unroll
        for (int i = 0; i < 8; ++i) { sy += y[i]; sb += r_[i] * k_[i] * (2.0f + (a0[i] + a1[i] - 2.0f) * kaw[i]) * rkw[i]; }
        sy += __shfl_xor(sy, 1); sy += __shfl_xor(sy, 2); sy += __shfl_xor(sy, 4);
        sb += __shfl_xor(sb, 1); sb += __shfl_xor(sb, 2); sb += __shfl_xor(sb, 4);
        const float mu = sy * (1.0f / 64.0f);
        float sv = 0.f;
#pragma unroll
        for (int i = 0; i < 8; ++i) { y[i] -= mu; sv += y[i] * y[i]; }
        sv += __shfl_xor(sv, 1); sv += __shfl_xor(sv, 2); sv += __shfl_xor(sv, 4);
        const float rstd = rsqrtf(sv * (1.0f / 64.0f) + 64e-5f);
        float ya[8];
#pragma unroll
        for (int i = 0; i < 8; ++i) ya[i] = (y[i] * rstd * gnw[i] + gnb[i] + sb * v_[i]) * gg[i];
        { u32x4 w; w.x = pk2(ya[0], ya[1]); w.y = pk2(ya[2], ya[3]); w.z = pk2(ya[4], ya[5]); w.w = pk2(ya[6], ya[7]); *(u32x4*)(CAT + (size_t)g * DM + c0) = w; }
        float od[8];
        { const f32x4 p0 = *(const f32x4*)(OP + o), p1 = *(const f32x4*)(OP + o + 4), q0 = *(const f32x4*)(OP + FS + o), q1 = *(const f32x4*)(OP + FS + o + 4);
#pragma unroll
          for (int i = 0; i < 4; ++i) { od[i] = p0[i] - lam * q0[i]; od[4 + i] = p1[i] - lam * q1[i]; } }
        float so = 0.f;
#pragma unroll
        for (int i = 0; i < 8; ++i) so += od[i] * od[i];
        so += __shfl_xor(so, 1); so += __shfl_xor(so, 2); so += __shfl_xor(so, 4); so += __shfl_xor(so, 8);
        const float ro = rsqrtf(so * (1.0f / 128.0f) + 1e-6f);
        { u32x4 w; w.x = pk2(od[0] * ro * sub[0], od[1] * ro * sub[1]); w.y = pk2(od[2] * ro * sub[2], od[3] * ro * sub[3]);
          w.z = pk2(od[4] * ro * sub[4], od[5] * ro * sub[5]); w.w = pk2(od[6] * ro * sub[6], od[7] * ro * sub[7]); *(u32x4*)(CAT + (size_t)g * DM + 512 + c0) = w; }
    }
#undef LD8BF
}

__device__ __forceinline__ void ph_gemm_out(const Args& A, int l, size_t x_off, size_t wt_off, int row_lo, LAS unsigned char* lds, int bid, int nb) {
    unsigned char* ws = opq(A.ws); const float* const* IN = (const float* const*)(ws + WS_PTRS); (void)IN;
    pg8::Gemm g{(const bf16_t*)(ws + x_off) + (size_t)row_lo * DM, (const bf16_t*)(ws + wt_off), NTOK - row_lo, DM, DM};
    const ListOrder S = build_units(lds, (NTOK - row_lo) / 256, DM / 256, nb, bid, nullptr, 0);
    EpiResidual E{(float*)(ws + WS_H) + (size_t)row_lo * DM, (const float*)(ws + WS_MOD) + (size_t)l * 17 * 6144 + 2 * 1024, row_lo};
    pg8::gemm_phase<EpiResidual, ListOrder, true, true>(lds, g, S, E);
}

__device__ __forceinline__ void ph_gemm_sgin(const Args& A, int j, int row_lo, LAS unsigned char* lds, int bid, int nb) {
    unsigned char* ws = opq(A.ws); const float* const* IN = (const float* const*)(ws + WS_PTRS); (void)IN;
    pg8::Gemm g{(const bf16_t*)(ws + WS_ABF) + (size_t)row_lo * DM, (const bf16_t*)(ws + WS_SGIN) + (size_t)j * 2048 * DM, NTOK - row_lo, 2048, DM};
    const ListOrder S = build_units(lds, (NTOK - row_lo) / 256, 2048 / 256, nb, bid, nullptr, 0);
    EpiGeluBf16 E{(bf16_t*)(ws + WS_Z2) + (size_t)row_lo * 2048, 2048, INP(I_SGBIN) + j * 2048};
    pg8::gemm_phase<EpiGeluBf16, ListOrder, true, true>(lds, g, S, E);
}
__device__ __forceinline__ void ph_sgu_stats(const Args& A, int row_lo, int bid, int nb) {
    unsigned char* ws = opq(A.ws);
    const int tid = tid_opaque(), lane = tid & 63, wid = tid >> 6;
    const bf16_t* Z2 = (const bf16_t*)(ws + WS_Z2); float* ST = (float*)(ws + WS_VST);
    for (int row = row_lo + bid * NWAVES + wid; row < NTOK; row += nb * NWAVES) {
        const u32x4 t0 = *(const u32x4*)(Z2 + (size_t)row * 2048 + 1024 + lane * 8), t1 = *(const u32x4*)(Z2 + (size_t)row * 2048 + 1536 + lane * 8);
        float v[16]; float s = 0.f;
#pragma unroll
        for (int i = 0; i < 4; ++i) { v[2 * i] = __builtin_bit_cast(float, t0[i] << 16); v[2 * i + 1] = __builtin_bit_cast(float, t0[i] & 0xffff0000u);
            v[8 + 2 * i] = __builtin_bit_cast(float, t1[i] << 16); v[9 + 2 * i] = __builtin_bit_cast(float, t1[i] & 0xffff0000u); }
#pragma unroll
        for (int i = 0; i < 16; ++i) s += v[i];
        const float mean = wave_sum(s) * (1.0f / 1024.0f); float s2 = 0.f;
#pragma unroll
        for (int i = 0; i < 16; ++i) { const float d = v[i] - mean; s2 += d * d; }
        const float rstd = rsqrtf(wave_sum(s2) * (1.0f / 1024.0f) + 1e-5f);
        if (lane == 0) { ST[(size_t)row * 2] = mean; ST[(size_t)row * 2 + 1] = rstd; }
    }
}
__device__ __forceinline__ void ph_sgu_spatial(const Args& A, int j, int row_lo, LAS unsigned char* lds, int bid, int nb) {
    unsigned char* ws = opq(A.ws); const float* const* IN = (const float* const*)(ws + WS_PTRS);
    const int tid = tid_opaque(), lane = tid & 63, wid = tid >> 6, c16 = lane & 15, g4 = lane >> 4;
    const bf16_t* Z2 = (const bf16_t*)(ws + WS_Z2); const float* ST = (const float*)(ws + WS_VST); bf16_t* G = (bf16_t*)(ws + WS_G);
    constexpr int VS = 272;
    LAS unsigned char* vt = lds;
    LAS float* stl = (LAS float*)(lds + 36864);
    const int ch0 = row_lo / 128, nch = NTOK / 128 - ch0;
    for (int u = bid; u < nch * 8; u += nb) {
        const int ci = ch0 + u / 8, g = u % 8;
        const size_t r0 = (size_t)ci * 128;
        __syncthreads();
#pragma unroll
        for (int i = 0; i < 4; ++i) {
            const int idx = tid + NTHREADS * i, q = idx >> 4, jc = idx & 15;
            const u32x4 t = *(const u32x4*)(Z2 + (r0 + q) * 2048 + 1024 + g * 128 + jc * 8);
#pragma unroll
            for (int e = 0; e < 4; ++e) { *(LAS bf16_t*)(vt + (jc * 8 + 2 * e) * VS + q * 2) = (bf16_t)(t[e] & 0xffffu); *(LAS bf16_t*)(vt + (jc * 8 + 2 * e + 1) * VS + q * 2) = (bf16_t)(t[e] >> 16); }
        }
        if (tid < 256) stl[tid] = ST[r0 * 2 + tid];
        __syncthreads();
        const float* wrow = INP(I_SGWS) + (((size_t)j * 8 + g) * 128 + 16 * wid + c16) * 128;
        bf16x8 af[4]; float wm = 0.f, rs = 0.f;
#pragma unroll
        for (int ks = 0; ks < 4; ++ks) {
            const int q0 = 32 * ks + 8 * g4;
            const f32x4 w0 = *(const f32x4*)(wrow + q0), w1 = *(const f32x4*)(wrow + q0 + 4);
            float wv[8] = {w0[0], w0[1], w0[2], w0[3], w1[0], w1[1], w1[2], w1[3]};
#pragma unroll
            for (int e = 0; e < 8; ++e) { rs += wv[e]; wv[e] *= stl[(q0 + e) * 2 + 1]; wm += wv[e] * stl[(q0 + e) * 2]; }
            const u32x4 pk = {pk2(wv[0], wv[1]), pk2(wv[2], wv[3]), pk2(wv[4], wv[5]), pk2(wv[6], wv[7])};
            af[ks] = __builtin_bit_cast(bf16x8, pk);
        }
        wm += __shfl_xor(wm, 16); wm += __shfl_xor(wm, 32); rs += __shfl_xor(rs, 16); rs += __shfl_xor(rs, 32);
        f32x4 acc[8];
#pragma unroll
        for (int nt = 0; nt < 8; ++nt) acc[nt] = (f32x4){0.f, 0.f, 0.f, 0.f};
#pragma unroll
        for (int ks = 0; ks < 4; ++ks)
#pragma unroll
            for (int nt = 0; nt < 8; ++nt) {
                const bf16x8 bfr = *(const LAS bf16x8*)(vt + (16 * nt + c16) * VS + (32 * ks + 8 * g4) * 2);
                acc[nt] = __builtin_amdgcn_mfma_f32_16x16x32_bf16(af[ks], bfr, acc[nt], 0, 0, 0);
            }
        float wmr[4], rsr[4], bsr[4];
#pragma unroll
        for (int r = 0; r < 4; ++r) { wmr[r] = __shfl(wm, 4 * g4 + r); rsr[r] = __shfl(rs, 4 * g4 + r); bsr[r] = INP(I_SGBS)[((size_t)j * 8 + g) * 128 + 16 * wid + 4 * g4 + r]; }
#pragma unroll
        for (int nt = 0; nt < 8; ++nt) {
            const int c = g * 128 + 16 * nt + c16;
            const float lg = INP(I_SGLNG)[j * 1024 + c], lb = INP(I_SGLNB)[j * 1024 + c];
#pragma unroll
            for (int r = 0; r < 4; ++r) {
                const size_t row = r0 + 16 * wid + 4 * g4 + r;
                const float sv = lg * (acc[nt][r] - wmr[r]) + rsr[r] * lb + bsr[r];
                G[row * DM + c] = (bf16_t)f2bf(bf2f(Z2[row * 2048 + c]) * sv);
            }
        }
    }
}

__device__ __forceinline__ int moe_layout(const Args& A, int l, int bid, int nb, LAS int* off  , LAS int* cntl  , LAS int* tile_e  , LAS int* base  ) {
    const int tid = tid_opaque();
    const int* bc = (const int*)(opq(A.ws) + WS_BCNT) + (size_t)l * 256 * 32;
    if (tid < 64) {
        int n = 0, pre = 0;
        if (tid < 32) {
#pragma unroll 8
            for (int b = 0; b < nb; ++b) { const int c = bc[b * 32 + tid]; n += c; pre += (b < bid) ? c : 0; }
        }
        const int nt = (n + 255) >> 8;
        int x = nt;
#pragma unroll
        for (int o = 1; o < 32; o <<= 1) { const int y = __shfl_up(x, o); if (tid >= o) x += y; }
        const int start = x - nt;
        if (tid < 32) {
            cntl[tid] = n; off[tid] = start * 256; base[tid] = start * 256 + pre;
#pragma unroll 1
            for (int t = 0; t < nt; ++t) tile_e[start + t] = tid;
        }
        if (tid == 31) off[32] = x * 256;
    }
    __syncthreads();
    return off[32] >> 8;
}
__device__ __forceinline__ void ph_moe_scatter(const Args& A, int l, int row_lo, LAS unsigned char* lds, int bid, int nb) {
    unsigned char* ws = opq(A.ws);
    const int tid = tid_opaque();
    LAS int* off = (LAS int*)(lds + LDS_TAB); LAS int* cntl = off + 64; LAS int* tile_e = off + 128; LAS int* base = off + 800;
    moe_layout(A, l, bid, nb, off, cntl, tile_e, base);
    const int* te = (const int*)(ws + WS_TOKE); const int* tr = (const int*)(ws + WS_TOKR); int* rowof = (int*)(ws + WS_ROWOF); int* srcrow = (int*)(ws + WS_SRCROW);
    const int nslots = (NTOK - row_lo - bid * NWAVES + nb * NWAVES - 1) / (nb * NWAVES) * NWAVES;
    for (int q = tid; q < nslots * 4; q += NTHREADS) {
        const int slot = q >> 2, k = q & 3, i = slot >> 3, w = slot & 7;
        const int row = row_lo + bid * NWAVES + w + i * nb * NWAVES;
        if (row < NTOK) {
            const int e = te[(size_t)row * 4 + k];
            const int pos = base[e] + tr[(size_t)row * 4 + k];
            rowof[(size_t)row * 4 + k] = pos; srcrow[pos] = row;
        }
    }
    for (int e = bid; e < 32; e += nb) {
        const int r0 = off[e] + cntl[e], r1 = off[e + 1];
        for (int i = r0 + tid; i < r1; i += NTHREADS) srcrow[i] = NCTX;
    }
}
__device__ __forceinline__ void ph_moe_gemm1(const Args& A, int l, LAS unsigned char* lds, int bid, int nb) {
    unsigned char* ws = opq(A.ws); const float* const* IN = (const float* const*)(ws + WS_PTRS); (void)IN;
    LAS int* off = (LAS int*)(lds + LDS_TAB); LAS int* cntl = off + 64; LAS int* tile_e = off + 128; LAS int* base = off + 800;
    const int T = moe_layout(A, l, bid, nb, off, cntl, tile_e, base);
    pg8::Gemm g{(const bf16_t*)(ws + WS_ABF), (const bf16_t*)(ws + WS_W1) + (size_t)l * NE * 2048 * DM, T * 256, 2048, DM};
    const ListOrder S = build_units(lds, T, 8, nb, bid, tile_e, 8);
    { LAS unsigned* rowtab = (LAS unsigned*)(lds + LDS_ROWTAB); const int* srcrow = (const int*)(ws + WS_SRCROW); const int tid = tid_opaque();
      for (int q = tid; q < S.n * 256; q += NTHREADS) rowtab[q] = (unsigned)srcrow[S.list[2 * (q >> 8)] * 256 + (q & 255)] * (unsigned)(DM * 2);
      __syncthreads(); }
    EpiMoe1 E{(bf16_t*)(ws + WS_ACT), INP(I_B1) + (size_t)l * NE * 2048};
    pg8::gemm_phase<EpiMoe1, ListOrder, true, true, true>(lds, g, S, E);
}
__device__ __forceinline__ void ph_moe_gemm2(const Args& A, int l, LAS unsigned char* lds, int bid, int nb) {
    unsigned char* ws = opq(A.ws); const float* const* IN = (const float* const*)(ws + WS_PTRS); (void)IN;
    LAS int* off = (LAS int*)(lds + LDS_TAB); LAS int* cntl = off + 64; LAS int* tile_e = off + 128; LAS int* base = off + 800;
    const int T = moe_layout(A, l, bid, nb, off, cntl, tile_e, base);
    pg8::Gemm g{(const bf16_t*)(ws + WS_ACT), (const bf16_t*)(ws + WS_W2) + (size_t)l * NE * DM * DM, T * 256, DM, DM};
    const ListOrder S = build_units(lds, T, 4, nb, bid, tile_e, 4);
    EpiMoe2 E{(bf16_t*)(ws + WS_YM), INP(I_B2) + (size_t)l * NE * DM};
    pg8::gemm_phase<EpiMoe2, ListOrder, true, true>(lds, g, S, E);
}
__device__ __forceinline__ void ph_moe_combine(const Args& A, int l, int row_lo, bool last, int bid, int nb) {
    unsigned char* ws = opq(A.ws); const float* const* IN = (const float* const*)(ws + WS_PTRS);
    const int tid = tid_opaque(), lane = tid & 63, wid = tid >> 6;
    float* H = (float*)(ws + WS_H); const float* mod = (const float*)(ws + WS_MOD); const bf16_t* YM = (const bf16_t*)(ws + WS_YM);
    const int* rowof = (const int*)(ws + WS_ROWOF); const float* tg = (const float*)(ws + WS_TOKG);
    bf16_t* abf = (bf16_t*)(ws + WS_ABF);
    const int ln = last ? l : l + 1;
    const float* gp = INP(I_N1G) + ln * 1024;
    for (int row = row_lo + bid * NWAVES + wid; row < NTOK; row += nb * NWAVES) {
        const Tok tk = tokinfo(row);
        const float* gate = mod + ((size_t)l * 17 + tk.modrow) * 6144 + 5 * 1024;
        int r[4]; float gk[4];
#pragma unroll
        for (int k = 0; k < 4; ++k) { r[k] = rowof[(size_t)row * 4 + k]; gk[k] = tg[(size_t)row * 4 + k]; }
        f32x4 hv[4]; float ss = 0.f;
#pragma unroll
        for (int q = 0; q < 4; ++q) {
            const int col = q * 256 + lane * 4;
            f32x4 m = (f32x4){0.f, 0.f, 0.f, 0.f};
#pragma unroll
            for (int k = 0; k < 4; ++k) { const u32x2 t = *(const u32x2*)(YM + (size_t)r[k] * DM + col);
                m = m + (f32x4){__builtin_bit_cast(float, t.x << 16), __builtin_bit_cast(float, t.x & 0xffff0000u), __builtin_bit_cast(float, t.y << 16), __builtin_bit_cast(float, t.y & 0xffff0000u)} * gk[k]; }
            hv[q] = *(const f32x4*)(H + (size_t)row * DM + col) + *(const f32x4*)(gate + col) * m;
            if (last) *(f32x4*)(as_global(((float* const*)IN)[38]) + (size_t)(row - NCTX) * DM + col) = hv[q];
            else *(f32x4*)(H + (size_t)row * DM + col) = hv[q];
            ss += (hv[q].x * hv[q].x + hv[q].y * hv[q].y) + (hv[q].z * hv[q].z + hv[q].w * hv[q].w);
        }
        if (!last) {
            const float rstd = rsqrtf(wave_sum(ss) * (1.0f / DM) + 1e-6f);
            const float* mrow = mod + ((size_t)ln * 17 + tk.modrow) * 6144;
#pragma unroll
            for (int q = 0; q < 4; ++q) {
                const int col = q * 256 + lane * 4;
                const f32x4 g = *(const f32x4*)(gp + col), sc = *(const f32x4*)(mrow + 1024 + col), sh = *(const f32x4*)(mrow + col);
                const f32x4 v = (hv[q] * rstd * g) * (sc + 1.0f) + sh;
                u32x2 o; o.x = pk2(v.x, v.y); o.y = pk2(v.z, v.w);
                *(u32x2*)(abf + (size_t)row * DM + col) = o;
            }
        }
    }
}

__global__ void __launch_bounds__(NTHREADS, 2) fwd_kernel(Args A) {
    extern __shared__ __attribute__((aligned(16))) unsigned char lds_raw[];
    LAS unsigned char* lds = (LAS unsigned char*)lds_raw;
    volatile LAS unsigned* misc = (volatile LAS unsigned*)(lds + LDS_MISC);
    const int tid = threadIdx.x, bid = blockIdx.x, nb = gridDim.x;
    if (tid < 64) misc[tid] = 0u;
    __syncthreads();
    XcdBarrier bar = xcd_barrier_post((unsigned*)(A.ws + WS_CTL) + CW_BAR, misc + 8);
    const int lo = A.ph_lo, hi = A.ph_hi;
    int pc = 0;
#ifndef PHSEL
#define PHSEL -1
#endif
#define SEL(k) (PHSEL < 0 || PHSEL == (k))
#ifndef REPEAT_MASK
#define REPEAT_MASK 0
#endif
#define RUN(k, call) do { if (SEL(k)) { call; if ((REPEAT_MASK >> (k)) & 1) { xcd_barrier(bar); call; } } } while (0)
#define PH_BEGIN if (pc >= lo && pc < hi) {
#define PH_END } if (pc >= lo && pc + 1 < hi) xcd_barrier(bar); ++pc;

    PH_BEGIN RUN(0, ph_prologue(A, lds, bid, nb)); PH_END

    for (int l = 0; l < 4; ++l) {
        const int j = l >> 1;
        const bool ctx_out = (l < 2), ctx_in = (l < 3);
        const int rin = ctx_in ? 0 : NCTX, rout = ctx_out ? 0 : NCTX;
        if (l == 0) { PH_BEGIN RUN(1, ph_norm<false>(A, l, rin, lds, bid, nb)); PH_END }
        if ((l & 1) == 0) {
            PH_BEGIN RUN(2, ph_gemm_win(A, j, rin, lds, bid, nb)); PH_END
            PH_BEGIN RUN(3, ph_rwkv_pre(A, j, rin, bid, nb)); RUN(4, ph_qk(A, j, rin, bid, nb)); PH_END
            PH_BEGIN RUN(19, ph_gemm_lora(A, j, rin, lds, bid, nb)); PH_END
            PH_BEGIN RUN(18, ph_wkv_prep(A, j, lds, bid, nb)); PH_END
            PH_BEGIN RUN(5, ph_wkv_scan(A, bid, nb)); PH_END
            PH_BEGIN RUN(6, ph_attn(A, ctx_out, lds, bid, nb)); PH_END
            PH_BEGIN RUN(7, ph_merge(A, l, rout, bid, nb)); PH_END
            PH_BEGIN RUN(8, ph_gemm_out(A, l, WS_CAT, WS_WOUT + (size_t)j * DM * DM * 2, rout, lds, bid, nb)); PH_END
        } else {
            PH_BEGIN RUN(9, ph_gemm_sgin(A, j, rin, lds, bid, nb)); PH_END
            PH_BEGIN RUN(10, ph_sgu_stats(A, rin, bid, nb)); PH_END
            PH_BEGIN RUN(11, ph_sgu_spatial(A, j, rout, lds, bid, nb)); PH_END
            PH_BEGIN RUN(12, ph_gemm_out(A, l, WS_G, WS_SGOUT + (size_t)j * DM * DM * 2, rout, lds, bid, nb)); PH_END
        }
        PH_BEGIN RUN(13, ph_norm<true>(A, l, rout, lds, bid, nb)); PH_END
        PH_BEGIN RUN(14, ph_moe_scatter(A, l, rout, lds, bid, nb)); PH_END
        PH_BEGIN RUN(15, ph_moe_gemm1(A, l, lds, bid, nb)); PH_END
        PH_BEGIN RUN(16, ph_moe_gemm2(A, l, lds, bid, nb)); PH_END
        PH_BEGIN RUN(17, ph_moe_combine(A, l, rout, l == 3, bid, nb)); PH_END
    }
}

extern "C" void kernel_launch(void* const* d_in, const int* in_sizes, int n_in, void* d_out, int out_size, void* d_ws, size_t ws_size, hipStream_t stream) {
    static int grid = 0;
    if (grid == 0) {
        if (n_in != 38 || out_size != NLAT * DM || ws_size < WS_END) { fprintf(stderr, "kernel_launch: unexpected shapes: n_in %d out %d ws %zu (need %zu)\n", n_in, out_size, ws_size, (size_t)WS_END); grid = -1; return; }
        int dev = 0, cus = 0, per_cu = 0;
        if (hipGetDevice(&dev) != hipSuccess || hipDeviceGetAttribute(&cus, hipDeviceAttributeMultiprocessorCount, dev) != hipSuccess) { grid = -1; return; }
        if (hipFuncSetAttribute((const void*)fwd_kernel, hipFuncAttributeMaxDynamicSharedMemorySize, LDS_BYTES) != hipSuccess) { fprintf(stderr, "kernel_launch: hipFuncSetAttribute failed\n"); grid = -1; return; }
        if (hipOccupancyMaxActiveBlocksPerMultiprocessor(&per_cu, (const void*)fwd_kernel, NTHREADS, LDS_BYTES) != hipSuccess || per_cu < 1)
            fprintf(stderr, "kernel_launch: occupancy query reports %d workgroups per CU\n", per_cu);
        (void)hipGetLastError();
        grid = cus;
    }
    if (grid < 0) return;
    if (hipMemsetAsync((char*)d_ws + WS_CTL, 0, CTL_ZERO_BYTES, stream) != hipSuccess) { fprintf(stderr, "kernel_launch: memset failed\n"); return; }
    Args a{};
    for (int i = 0; i < 38; ++i) a.in[i] = (const float*)d_in[i];
    a.out = (float*)d_out; a.ws = (unsigned char*)d_ws; a.ph_lo = 0; a.ph_hi = 1 << 20;
    hipLaunchKernelGGL(fwd_kernel, dim3(grid), dim3(NTHREADS), LDS_BYTES, stream, a);
    const hipError_t le = hipPeekAtLastError();
    if (le != hipSuccess) fprintf(stderr, "kernel_launch: launch failed: %s\n", hipGetErrorName(le));
}
```

```cpp
#include <hip/hip_runtime.h>
#include <cstdio>
#include <cstdint>

#define LAS __attribute__((address_space(3)))
typedef unsigned short bf16_t;
typedef short bf16x8 __attribute__((ext_vector_type(8)));
typedef float f32x4 __attribute__((ext_vector_type(4)));
typedef unsigned u32x4 __attribute__((ext_vector_type(4)));
typedef unsigned u32x2 __attribute__((ext_vector_type(2)));

constexpr int DM = 1024, NB = 16, TL = 2048, TC = 256;
constexpr int NCTX = NB * TC, NLAT = NB * TL, NTOK = NCTX + NLAT;
constexpr int RWC = 1920, EVC = 3456, ZLD = 3584;
constexpr int NE = 32;
constexpr int XPROWS = NTOK * 4 + NE * 256;
constexpr int NTHREADS = 512, NWAVES = 8;

constexpr size_t MiB = 1u << 20;
constexpr size_t al256(size_t x) { return (x + 255) & ~(size_t)255; }
constexpr size_t WS_CTL = 0, CTL_ZERO_BYTES = 1 * MiB - 4096;
constexpr size_t WS_PTRS = 1 * MiB - 4096;
constexpr size_t WS_MOD = 1 * MiB;
constexpr size_t WS_RTWT = al256(WS_MOD + (size_t)4 * 17 * 6144 * 4);
constexpr size_t WS_WIN = al256(WS_RTWT + (size_t)4 * 32 * 1024 * 4);
constexpr size_t WS_WOUT = al256(WS_WIN + (size_t)2 * ZLD * DM * 2);
constexpr size_t WS_SGIN = al256(WS_WOUT + (size_t)2 * DM * DM * 2);
constexpr size_t WS_SGOUT = al256(WS_SGIN + (size_t)2 * 2048 * DM * 2);
constexpr int LORA_N = 2560, LORA_K = 384;
constexpr size_t WS_WLORA = al256(WS_SGOUT + (size_t)2 * DM * DM * 2);
constexpr size_t WS_LBIAS = al256(WS_WLORA + (size_t)2 * LORA_N * LORA_K * 2);
constexpr size_t WS_W1 = al256(WS_LBIAS + (size_t)2 * LORA_N * 4);
constexpr size_t WS_W2 = al256(WS_W1 + (size_t)4 * NE * 2048 * DM * 2);
constexpr size_t WS_H = al256(WS_W2 + (size_t)4 * NE * DM * DM * 2);
constexpr size_t WS_ABF = al256(WS_H + (size_t)NTOK * DM * 4);
constexpr size_t WS_TOKE = al256(WS_ABF + (size_t)NTOK * DM * 2);
constexpr size_t WS_TOKG = al256(WS_TOKE + (size_t)NTOK * 4 * 4);
constexpr size_t WS_ROWOF = al256(WS_TOKG + (size_t)NTOK * 4 * 4);
constexpr size_t WS_TOKR = al256(WS_ROWOF + (size_t)NTOK * 4 * 4);
constexpr size_t WS_BCNT = al256(WS_TOKR + (size_t)NTOK * 4 * 4);
constexpr size_t WS_SRCROW = al256(WS_BCNT + (size_t)4 * 256 * 32 * 4);
constexpr size_t WS_R = al256(WS_SRCROW + (size_t)XPROWS * 4);
constexpr size_t FSZ = (size_t)NTOK * 512 * 4;
constexpr size_t WS_Z = WS_R;
constexpr size_t HSZ = (size_t)NTOK * 512 * 2;
constexpr size_t WS_RB = al256(WS_Z + (size_t)NTOK * ZLD * 2);
constexpr size_t WS_KS = WS_RB + HSZ, WS_VS = WS_KS + HSZ, WS_KKN = WS_VS + HSZ;
constexpr size_t WS_LIN = WS_KKN + HSZ;
constexpr size_t WS_LO = al256(WS_LIN + (size_t)NTOK * 384 * 2);
constexpr size_t WS_AB = WS_LO + 2 * HSZ;
constexpr size_t WS_GB = WS_LO + 4 * HSZ;
constexpr size_t WS_YS = WS_LO + 5 * HSZ;
constexpr size_t WS_QB = WS_YS + 2 * FSZ;
constexpr size_t WS_KB = WS_QB + FSZ / 2;
constexpr size_t WS_VB = WS_KB + FSZ / 2;
constexpr size_t WS_OP = WS_VB + FSZ / 2;
constexpr size_t WS_CAT = WS_OP + 2 * FSZ;
constexpr int WKV_REC = 12288, WKV_NCH = (TC + TL) / 16;
constexpr size_t WS_WKV = al256(WS_CAT + (size_t)NTOK * DM * 2);
constexpr size_t WS_EVEN_END = WS_WKV + (size_t)256 * WKV_NCH * WKV_REC;
constexpr size_t WS_Z2 = WS_R;
constexpr size_t WS_VST = al256(WS_Z2 + (size_t)NTOK * 2048 * 2);
constexpr size_t WS_G = al256(WS_VST + (size_t)NTOK * 2 * 4);
constexpr size_t WS_ODD_END = WS_G + (size_t)NTOK * DM * 2;
constexpr size_t WS_XP = WS_R;
constexpr size_t WS_ACT = al256(WS_XP + (size_t)XPROWS * DM * 2);
constexpr size_t WS_YM = al256(WS_ACT + (size_t)XPROWS * DM * 2);
constexpr size_t WS_MOE_END = WS_YM + (size_t)XPROWS * DM * 2;
constexpr size_t WS_END = (WS_EVEN_END > WS_MOE_END ? (WS_EVEN_END > WS_ODD_END ? WS_EVEN_END : WS_ODD_END) : (WS_MOE_END > WS_ODD_END ? WS_MOE_END : WS_ODD_END));

constexpr int CW_BAR = 4096;
constexpr int CW_CNT = 16384;
constexpr int CW_CUR = 16384 + 256;

constexpr int LDS_BYTES = 163840;
constexpr int LDS_MISC = 160 * 1024 - 256;

__device__ __forceinline__ unsigned f2bf(float f) { unsigned u = __builtin_bit_cast(unsigned, f); return (u + 0x7fffu + ((u >> 16) & 1u)) >> 16; }
__device__ __forceinline__ unsigned pk2(float lo, float hi) { return f2bf(lo) | (f2bf(hi) << 16); }
typedef float f32x2_t __attribute__((ext_vector_type(2))); typedef __bf16 bf16x2_t __attribute__((ext_vector_type(2)));
__device__ __forceinline__ unsigned cvtpk_s(float lo, float hi) { f32x2_t v = {lo, hi}; bf16x2_t b = __builtin_convertvector(v, bf16x2_t); return __builtin_bit_cast(unsigned, b); }
__device__ __forceinline__ float bf2f(bf16_t b) { return __builtin_bit_cast(float, (unsigned)b << 16); }
__device__ __forceinline__ float wave_sum(float v) {
#pragma unroll
    for (int o = 1; o < 64; o <<= 1) v += __shfl_xor(v, o);
    return v;
}
__device__ __forceinline__ int tid_opaque() { int t = threadIdx.x; asm volatile("" : "+v"(t)); return t; }
#define GAS __attribute__((address_space(1)))
template <class T> __device__ __forceinline__ T* as_global(T* p) { return (T*)(GAS T*)p; }
__device__ __forceinline__ unsigned char* opq(unsigned char* p) { GAS unsigned char* g = (GAS unsigned char*)p; asm volatile("" : "+s"(g)); return (unsigned char*)g; }
__device__ __forceinline__ float rdl(float v, int k) { return __builtin_bit_cast(float, __builtin_amdgcn_readlane(__builtin_bit_cast(int, v), k)); }
__device__ __forceinline__ float sigmoidf_(float x) { return 1.0f / (1.0f + __expf(-x)); }

#define XB_TMO      128
#define XB_XCNT(j)  (256  + 64 * (j))
#define XB_XSUB(j)  (1280 + 64 * (j))
#define XB_XGEN(j)  (2304 + 64 * (j))
#define XB_TOP      3328
#define XB_TOPGEN   3392
#define XCD_BAR_WORDS 3456
#define XB_SPIN_CAP (1u << 22)
__device__ __forceinline__ unsigned xb_ld(unsigned* p)              { return __hip_atomic_load(p, __ATOMIC_RELAXED, __HIP_MEMORY_SCOPE_AGENT); }
__device__ __forceinline__ unsigned xb_add(unsigned* p, unsigned v) { return __hip_atomic_fetch_add(p, v, __ATOMIC_RELAXED, __HIP_MEMORY_SCOPE_AGENT); }
__device__ __forceinline__ unsigned xb_xcc_id() { return (unsigned)__builtin_amdgcn_s_getreg((3 << 11) | 20) & 0xFu; }
#define XB_SPIN(cond, bar) do { unsigned _sp = 0; while (cond) { __builtin_amdgcn_s_sleep(1); \
    if ((++_sp & 255u) == 0u) { if (xb_ld(&(bar)[XB_TMO])) break; if (_sp > XB_SPIN_CAP) { atomicAdd(&(bar)[XB_TMO], 1u); break; } } } } while (0)
struct XcdBarrier { unsigned* bar; unsigned x; volatile LAS unsigned* st; };
__device__ __forceinline__ XcdBarrier xcd_barrier_post(unsigned* bar, volatile LAS unsigned* st) {
    XcdBarrier b; b.bar = bar; b.x = xb_xcc_id(); b.st = st;
    if (threadIdx.x == 0) (void)xb_add(&bar[XB_XCNT(b.x)], 1u);
    return b;
}
__device__ __forceinline__ void xcd_barrier_complete(unsigned* bar, unsigned x, unsigned& nloc, unsigned& nx) {
    const unsigned G = gridDim.x * gridDim.y * gridDim.z;
    unsigned sum, cnt, mine, sp = 0u;
    for (;;) {
        sum = 0u; cnt = 0u; mine = 0u;
#pragma unroll
        for (unsigned j = 0; j < 16; ++j) { const unsigned c = xb_ld(&bar[XB_XCNT(j)]); sum += c; cnt += (c > 0u) ? 1u : 0u; mine = (j == x) ? c : mine; }
        if (sum == G) break;
        __builtin_amdgcn_s_sleep(1);
        if ((++sp & 255u) == 0u) { if (xb_ld(&bar[XB_TMO])) break; if (sp > XB_SPIN_CAP) { atomicAdd(&bar[XB_TMO], 1u); break; } }
    }
    nloc = mine > 0u ? mine : 1u; nx = cnt > 0u ? cnt : 1u;
}
__device__ __forceinline__ void xcd_barrier(const XcdBarrier& b) {
    asm volatile("s_waitcnt vmcnt(0)" ::: "memory");
    __syncthreads();
    if (threadIdx.x == 0) {
        unsigned* bar = b.bar;
        __builtin_amdgcn_s_waitcnt(0);
        unsigned nloc = b.st[0], nx = b.st[1];
        if (nloc == 0u) { xcd_barrier_complete(bar, b.x, nloc, nx); b.st[0] = nloc; b.st[1] = nx; }
        const unsigned old = xb_add(&bar[XB_XSUB(b.x)], 1u);
        const unsigned gen = old / nloc;
        if (old + 1u == (gen + 1u) * nloc) {
            __builtin_amdgcn_fence(__ATOMIC_RELEASE, "agent");
            asm volatile("s_waitcnt vmcnt(0)" ::: "memory");
            const unsigned og = xb_add(&bar[XB_TOP], 1u);
            const unsigned tg = og / nx;
            if (og + 1u == (tg + 1u) * nx) xb_add(&bar[XB_TOPGEN], 1u);
            else XB_SPIN(xb_ld(&bar[XB_TOPGEN]) == tg, bar);
            __builtin_amdgcn_fence(__ATOMIC_ACQUIRE, "agent");
            xb_add(&bar[XB_XGEN(b.x)], 1u);
            asm volatile("s_waitcnt vmcnt(0)" ::: "memory");
        } else {
            XB_SPIN(xb_ld(&bar[XB_XGEN(b.x)]) == gen, bar);
            __builtin_amdgcn_fence(__ATOMIC_ACQUIRE, "agent");
            asm volatile("s_waitcnt vmcnt(0)" ::: "memory");
        }
    }
    __syncthreads();
}

namespace pg8 {
#define PG8_LAS __attribute__((address_space(3)))
typedef unsigned short bf16_t;
typedef short bf16x8 __attribute__((ext_vector_type(8)));
typedef float f32x4 __attribute__((ext_vector_type(4)));
typedef unsigned u32x4 __attribute__((ext_vector_type(4)));
constexpr int BM = 256, BK = 64, HALF = 128, HTB = HALF * BK * 2  , STAGE_BYTES = 8 * HTB, NXCD = 8, WGM = 8;

__host__ __device__ __forceinline__ int lds_byte(int r, int c) { const int st = (r >> 4) * 2 + (c >> 5), rr = r & 15, cc = c & 31, ob = rr * 64 + cc * 2; return st * 1024 + (ob ^ (((ob >> 9) & 1) << 5)); }
__host__ __device__ __forceinline__ void stage_rc(int b, int& R, int& C) { const int st = b / 1024, sb = b % 1024, swz = sb ^ (((sb >> 9) & 1) << 5); R = (st >> 1) * 16 + swz / 64; C = (st & 1) * 32 + (swz % 64) / 2; }
__host__ __device__ __forceinline__ int perm32(int rho) { const int n = rho >> 4, i = rho & 15; return 8 * (i >> 2) + 4 * n + (i & 3); }

struct Unit { int pm, pn; };
struct Gemm { const bf16_t* A; const bf16_t* Bt; int M, N, K; };

struct StaticOrder {
    int nM, nN, nwg, G, c;
    __host__ __device__ void init(int M, int N, int G_, int c_) { nM = M / BM; nN = N / BM; nwg = nM * nN; G = G_; c = c_; }
    __host__ __device__ bool next(int i, Unit& u) const {
        const long L = (long)i * G + c; if (L >= nwg) return false;
        int wgid = (int)L; { const int q = nwg / NXCD, r = nwg % NXCD, xcd = wgid % NXCD, off = wgid / NXCD; wgid = (xcd < r ? xcd * (q + 1) : r * (q + 1) + (xcd - r) * q) + off; }
        const int nig = WGM * nN, gid = wgid / nig, fm = gid * WGM, gsz = (nM - fm) < WGM ? (nM - fm) : WGM;
        u.pm = fm + ((wgid % nig) % gsz); u.pn = (wgid % nig) / gsz; return true;
    }
    __device__ __forceinline__ void a_ready(const Unit&) const {}
    __device__ __forceinline__ void done(const Unit&) const {}
};

__device__ __forceinline__ unsigned cvt_pk_bf16(float lo, float hi) { unsigned r; asm volatile("v_cvt_pk_bf16_f32 %0, %1, %2" : "=v"(r) : "v"(lo), "v"(hi)); return r; }
typedef float f32x2 __attribute__((ext_vector_type(2)));
__device__ __forceinline__ f32x2 gelu_pk(f32x2 v) {
    const f32x2 av = __builtin_elementwise_abs(v), d = av * 0.2316418882f + 1.0f;
    f32x2 t; t.x = __builtin_amdgcn_rcpf(d.x); t.y = __builtin_amdgcn_rcpf(d.y);
    f32x2 q = t * 0.5307027145f + (-0.7265760135f); q = q * t + 0.7107068705f; q = q * t + (-0.142248368f); q = q * t + 0.127414796f; q = q * t;
    const f32x2 s = (v * v) * (-0.72134752044f);
    f32x2 e; e.x = __builtin_amdgcn_exp2f(s.x); e.y = __builtin_amdgcn_exp2f(s.y);
    const f32x2 m = v * (q * e), r = v - m;
    f32x2 o; o.x = v.x < 0.f ? m.x : r.x; o.y = v.y < 0.f ? m.y : r.y; return o;
}

template <class Epi, class Sched, bool ALIGN_EPI = false, bool SP2 = false, bool GATHER = false>
__device__ __forceinline__ void gemm_phase(PG8_LAS unsigned char* lds, const Gemm g, const Sched& S, const Epi& E) {
    const int tid = tid_opaque(), wid = __builtin_amdgcn_readfirstlane(tid >> 6), lane = tid & 63, wr = wid >> 2, wc = wid & 3, fr = lane & 15, fq = lane >> 4;
    static_assert(!GATHER || SP2, "GATHER is wired into the SP2 loop only");
    const int K = g.K, nt = K / BK;
    unsigned voffA[2], voffB[2];
#pragma unroll
    for (int i = 0; i < 2; ++i) { int R, C; stage_rc(tid * 16 + i * 8192, R, C); const int Rb = Epi::PERM ? ((R & ~31) + perm32(R & 31)) : R;
        voffA[i] = (unsigned)(R * K + C) * 2u; voffB[i] = (unsigned)(Rb * K + C) * 2u; }
    unsigned gAc[2][2] = {{0u, 0u}, {0u, 0u}}, gAn[2][2] = {{0u, 0u}, {0u, 0u}};
    int gR[2] = {0, 0}; unsigned gC[2] = {0u, 0u};
    if constexpr (GATHER) {
#pragma unroll
        for (int i = 0; i < 2; ++i) { int R, C; stage_rc(tid * 16 + i * 8192, R, C); gR[i] = R; gC[i] = (unsigned)C * 2u; }
    }
#define PG8_GROWS(dst, ui_) do { _Pragma("unroll") for (int _h = 0; _h < 2; ++_h) _Pragma("unroll") for (int _i = 0; _i < 2; ++_i) dst[_h][_i] = S.rowtab[(ui_) * 256 + _h * 128 + gR[_i]] + gC[_i]; } while (0)
    const size_t kstep = (size_t)(BK * 2);
    const size_t hstep = (size_t)HALF * K * 2;
    const size_t tstep = 2 * hstep;
    const unsigned ldsw = (unsigned)wid * 1024u;
    const int aoff = lds_byte(wr * 64 + fr, fq * 8), boff = lds_byte(wc * 32 + fr, fq * 8);
#define PG8_SA(b, h) (((b) * 2 + (h)) * HTB)
#define PG8_SB(b, h) ((4 + (b) * 2 + (h)) * HTB)
#define PG8_STAGE(bufoff, gbase, voff) do { _Pragma("unroll") for (int _i = 0; _i < 2; ++_i) \
        __builtin_amdgcn_global_load_lds((const unsigned*)((const char*)(gbase) + (voff)[_i]), (PG8_LAS unsigned*)(lds + (bufoff) + ldsw + _i * 8192), 16, 0, 0); } while (0)
#define PG8_STAGE_A(bufoff, kptr, h, vsel) do { if constexpr (GATHER) { PG8_STAGE(bufoff, kptr, vsel[h]); } else { PG8_STAGE(bufoff, (kptr) + (h) * hstep, voffA); } } while (0)
#define PG8_LDA(dst, b, h) do { _Pragma("unroll") for (int m = 0; m < 4; ++m) _Pragma("unroll") for (int k = 0; k < 2; ++k) dst[m][k] = *(const PG8_LAS bf16x8*)(lds + PG8_SA(b, h) + aoff + m * 2048 + k * 1024); } while (0)
#define PG8_LDB(dst, b, h) do { _Pragma("unroll") for (int n = 0; n < 2; ++n) _Pragma("unroll") for (int k = 0; k < 2; ++k) dst[n][k] = *(const PG8_LAS bf16x8*)(lds + PG8_SB(b, h) + boff + n * 2048 + k * 1024); } while (0)
#define PG8_MMA(ai, bj, At, Bt) do { __builtin_amdgcn_s_setprio(1); _Pragma("unroll") for (int m = 0; m < 4; ++m) _Pragma("unroll") for (int n = 0; n < 2; ++n) _Pragma("unroll") for (int k = 0; k < 2; ++k) \
        acc[ai][bj][m][n] = __builtin_amdgcn_mfma_f32_16x16x32_bf16(Bt[n][k], At[m][k], acc[ai][bj][m][n], 0, 0, 0); __builtin_amdgcn_s_setprio(0); } while (0)
#define PG8_WAIT_V(n) asm volatile("s_waitcnt vmcnt(" #n ")" ::: "memory")
#define PG8_WAIT_L(n) asm volatile("s_waitcnt lgkmcnt(" #n ")" ::: "memory")
#define PG8_BAR __builtin_amdgcn_s_barrier()
#define PG8_SCHED __builtin_amdgcn_sched_barrier(0)
    Unit cur, nxt; int ui = 0;
    if (!S.next(0, cur)) return;
    f32x4 acc[2][2][4][2];
#pragma unroll
    for (int a = 0; a < 2; ++a)
#pragma unroll
        for (int b = 0; b < 2; ++b)
#pragma unroll
            for (int m = 0; m < 4; ++m)
#pragma unroll
                for (int n = 0; n < 2; ++n) acc[a][b][m][n] = (f32x4){0.f, 0.f, 0.f, 0.f};
    bf16x8 At[4][2], B0[2][2], B1[2][2];
    const char* cA = GATHER ? (const char*)g.A : (const char*)g.A + (size_t)cur.pm * tstep; const char* cB = (const char*)g.Bt + (size_t)cur.pn * tstep;
    if constexpr (GATHER) { PG8_GROWS(gAc, 0); }
    S.a_ready(cur);
    if constexpr (SP2) {
        PG8_STAGE(PG8_SB(0, 0), cB, voffB); PG8_STAGE(PG8_SB(0, 1), cB + hstep, voffB); PG8_STAGE_A(PG8_SA(0, 0), cA, 0, gAc); PG8_STAGE_A(PG8_SA(0, 1), cA, 1, gAc);
        if (wr == 1) PG8_BAR;
        PG8_WAIT_V(2); PG8_BAR;
        PG8_STAGE(PG8_SB(1, 0), cB + kstep, voffB); PG8_STAGE_A(PG8_SA(1, 0), cA + kstep, 0, gAc); PG8_STAGE(PG8_SB(1, 1), cB + hstep + kstep, voffB);
        PG8_WAIT_V(6); PG8_BAR;
    } else {
        PG8_STAGE(PG8_SB(0, 0), cB, voffB); PG8_STAGE(PG8_SA(0, 0), cA, voffA); PG8_STAGE(PG8_SB(0, 1), cB + hstep, voffB); PG8_STAGE(PG8_SA(0, 1), cA + hstep, voffA);
        if (wr == 1) PG8_BAR;
        PG8_WAIT_V(4); PG8_BAR;
        PG8_STAGE(PG8_SB(1, 0), cB + kstep, voffB); PG8_STAGE(PG8_SA(1, 0), cA + kstep, voffA); PG8_STAGE(PG8_SB(1, 1), cB + hstep + kstep, voffB);
        PG8_WAIT_V(6); PG8_BAR;
    }
    for (;;) {
        const bool has_next = S.next(ui + 1, nxt);
        if constexpr (GATHER) { if (has_next) { PG8_GROWS(gAn, ui + 1); } else { _Pragma("unroll") for (int _h = 0; _h < 2; ++_h) _Pragma("unroll") for (int _i = 0; _i < 2; ++_i) gAn[_h][_i] = gAc[_h][_i]; } }
        const char* nA = GATHER ? (const char*)g.A : (has_next ? (const char*)g.A + (size_t)nxt.pm * tstep : cA); const char* nB = has_next ? (const char*)g.Bt + (size_t)nxt.pn * tstep : cB;
        for (int t = 0; t < nt; t += 2) {
            const bool last = (t == nt - 2);
            const char* a1 = cA + (size_t)(t + 1) * kstep;
            const char* a2 = last ? nA : cA + (size_t)(t + 2) * kstep; const char* b2 = last ? nB : cB + (size_t)(t + 2) * kstep;
            const char* a3 = a2 + kstep; const char* b3 = b2 + kstep;
            if (last && has_next) S.a_ready(nxt);
            unsigned gA2[2][2];
            if constexpr (GATHER) { _Pragma("unroll") for (int _h = 0; _h < 2; ++_h) _Pragma("unroll") for (int _i = 0; _i < 2; ++_i) gA2[_h][_i] = last ? gAn[_h][_i] : gAc[_h][_i]; }
            if constexpr (SP2) {
            PG8_LDB(B0, 0, 0); PG8_LDB(B1, 0, 1); PG8_SCHED; PG8_LDA(At, 0, 0); PG8_STAGE_A(PG8_SA(1, 1), a1, 1, gAc);
            PG8_WAIT_V(8); PG8_WAIT_L(0); PG8_BAR; PG8_MMA(0, 0, At, B0); PG8_MMA(0, 1, At, B1); PG8_BAR; PG8_SCHED;
            PG8_LDA(At, 0, 1); PG8_STAGE(PG8_SB(0, 0), b2, voffB); PG8_STAGE(PG8_SB(0, 1), b2 + hstep, voffB); PG8_STAGE_A(PG8_SA(0, 0), a2, 0, gA2);
            PG8_WAIT_V(8); PG8_WAIT_L(0); PG8_BAR; PG8_MMA(1, 0, At, B0); PG8_MMA(1, 1, At, B1); PG8_BAR; PG8_SCHED;
            PG8_LDB(B0, 1, 0); PG8_LDB(B1, 1, 1); PG8_SCHED; PG8_LDA(At, 1, 0); PG8_STAGE_A(PG8_SA(0, 1), a2, 1, gA2);
            PG8_WAIT_V(8); PG8_WAIT_L(0); PG8_BAR; PG8_MMA(0, 0, At, B0); PG8_MMA(0, 1, At, B1); PG8_BAR; PG8_SCHED;
            PG8_LDA(At, 1, 1); PG8_STAGE(PG8_SB(1, 0), b3, voffB); PG8_STAGE(PG8_SB(1, 1), b3 + hstep, voffB); PG8_STAGE_A(PG8_SA(1, 0), a3, 0, gA2);
            PG8_WAIT_V(8); PG8_WAIT_L(0); PG8_BAR; PG8_MMA(1, 0, At, B0); PG8_MMA(1, 1, At, B1); PG8_BAR; PG8_SCHED;
            } else {
            PG8_LDB(B0, 0, 0); PG8_SCHED; PG8_LDA(At, 0, 0); PG8_STAGE(PG8_SA(1, 1), a1 + hstep, voffA);
            PG8_WAIT_L(8); PG8_BAR; PG8_WAIT_L(0); PG8_MMA(0, 0, At, B0); PG8_BAR; PG8_SCHED;
            PG8_LDB(B1, 0, 1); PG8_STAGE(PG8_SB(0, 0), b2, voffB);
            PG8_BAR; PG8_WAIT_L(0); PG8_MMA(0, 1, At, B1); PG8_BAR;
            PG8_LDA(At, 0, 1); PG8_STAGE(PG8_SA(0, 0), a2, voffA);
            PG8_BAR; PG8_WAIT_L(0); PG8_MMA(1, 0, At, B0); PG8_BAR; PG8_SCHED;
            PG8_STAGE(PG8_SB(0, 1), b2 + hstep, voffB);
            PG8_WAIT_V(6); PG8_BAR; PG8_MMA(1, 1, At, B1); PG8_BAR;
            PG8_LDB(B0, 1, 0); PG8_SCHED; PG8_LDA(At, 1, 0); PG8_STAGE(PG8_SA(0, 1), a2 + hstep, voffA);
            PG8_WAIT_L(8); PG8_BAR; PG8_WAIT_L(0); PG8_MMA(0, 0, At, B0); PG8_BAR; PG8_SCHED;
            PG8_LDB(B1, 1, 1); PG8_STAGE(PG8_SB(1, 0), b3, voffB);
            PG8_BAR; PG8_WAIT_L(0); PG8_MMA(0, 1, At, B1); PG8_BAR;
            PG8_LDA(At, 1, 1); PG8_STAGE(PG8_SA(1, 0), a3, voffA);
            PG8_BAR; PG8_WAIT_L(0); PG8_MMA(1, 0, At, B0); PG8_BAR; PG8_SCHED;
            PG8_STAGE(PG8_SB(1, 1), b3 + hstep, voffB);
            PG8_WAIT_V(6); PG8_BAR; PG8_MMA(1, 1, At, B1); PG8_BAR;
            }
        }
        if constexpr (ALIGN_EPI) { if (wr == 0) PG8_BAR; }
        if constexpr (!Epi::AFTER_DRAIN) { E(acc, cur, wr, wc, fr, fq); S.done(cur); }
        if (!has_next) break;
#pragma unroll
        for (int a = 0; a < 2; ++a)
#pragma unroll
            for (int b = 0; b < 2; ++b)
#pragma unroll
                for (int m = 0; m < 4; ++m)
#pragma unroll
                    for (int n = 0; n < 2; ++n) acc[a][b][m][n] = (f32x4){0.f, 0.f, 0.f, 0.f};
        cur = nxt; cA = nA; cB = nB; ++ui;
        if constexpr (GATHER) { _Pragma("unroll") for (int _h = 0; _h < 2; ++_h) _Pragma("unroll") for (int _i = 0; _i < 2; ++_i) gAc[_h][_i] = gAn[_h][_i]; }
        if constexpr (ALIGN_EPI) { if (wr == 1) PG8_BAR; }
    }
    PG8_WAIT_V(0);
    if constexpr (!ALIGN_EPI) { if (wr == 0) PG8_BAR; }
    PG8_BAR;
    if constexpr (Epi::AFTER_DRAIN) { E.fused(acc, cur, wr, wc, fr, fq, lds, wid, lane); S.done(cur); }
#undef PG8_SA
#undef PG8_SB
#undef PG8_STAGE
#undef PG8_STAGE_A
#undef PG8_GROWS
#undef PG8_LDA
#undef PG8_LDB
#undef PG8_MMA
#undef PG8_WAIT_V
#undef PG8_WAIT_L
#undef PG8_BAR
#undef PG8_SCHED
}
}

struct Args { const float* in[38]; float* out; unsigned char* ws; int ph_lo, ph_hi; };
#define INP(k) as_global(IN[k])
#define AIN(k) as_global(A.in[k])
enum { I_X = 0, I_C, I_CTX, I_CCTX, I_N1G, I_N2G, I_ADAW, I_ADAB, I_EVWIN, I_EVWOUT, I_RWMU, I_RWW0, I_RWW2, I_RWA0, I_RWA2, I_RWG2, I_RWKK, I_RWKA, I_RWRK,
       I_GNW, I_GNB, I_QN, I_KN, I_LAM, I_SUBLN, I_SGWIN, I_SGBIN, I_SGLNG, I_SGLNB, I_SGWS, I_SGBS, I_SGWOUT, I_RTW, I_RTB, I_W1, I_B1, I_W2, I_B2 };

struct Tok { int b, t, T, modrow; };
__device__ __forceinline__ Tok tokinfo(int g) {
    Tok k;
    if (g < NCTX) { k.b = g >> 8; k.t = g & 255; k.T = TC; k.modrow = 16; }
    else { const int q = g - NCTX; k.b = q >> 11; k.t = q & 2047; k.T = TL; k.modrow = k.b; }
    return k;
}

template <int MAP>
__device__ __forceinline__ void p0_transpose_item(const float* W, int K, int N, bf16_t* WT, LAS float* scr, int item, int lane) {
    const int nblk = N / 32, kb = item / nblk, nb = item % nblk, k0 = 64 * kb, n0 = 32 * nb;
    const int d0 = MAP ? (256 * ((n0 & 1023) >> 7) + 128 * (n0 >> 10) + (n0 & 127)) : n0;
#pragma unroll 8
    for (int i = 0; i < 32; ++i) { const int kk = 2 * i + (lane >> 5); scr[kk * 33 + (lane & 31)] = W[(size_t)(k0 + kk) * N + n0 + (lane & 31)]; }
    asm volatile("s_waitcnt lgkmcnt(0)" ::: "memory");
    const int c = lane & 7;
#pragma unroll
    for (int j = 0; j < 4; ++j) { const int n = (lane >> 3) + 8 * j; const LAS float* s = scr + (8 * c) * 33 + n;
        u32x4 o; o.x = pk2(s[0 * 33], s[1 * 33]); o.y = pk2(s[2 * 33], s[3 * 33]); o.z = pk2(s[4 * 33], s[5 * 33]); o.w = pk2(s[6 * 33], s[7 * 33]);
        *(u32x4*)(WT + (size_t)(d0 + n) * K + k0 + 8 * c) = o; }
    asm volatile("s_waitcnt lgkmcnt(0)" ::: "memory");
}

__device__ __forceinline__ void ph_prologue(const Args& A, LAS unsigned char* lds, int bid, int nb) {
    const int tid = tid_opaque(), lane = tid & 63, wid = tid >> 6;
    unsigned char* ws = opq(A.ws);
    if (bid == 0 && tid < 39) ((const float**)(ws + WS_PTRS))[tid] = (tid < 38) ? A.in[tid] : (const float*)A.out;
    {
        LAS float* s = (LAS float*)lds;
        LAS float* red = (LAS float*)(lds + 17 * 1024 * 4);
        for (int i = tid; i < 17 * 1024; i += NTHREADS) {
            const int r = i >> 10, k = i & 1023;
            const float x = (r < 16) ? AIN(I_C)[r * 1024 + k] : AIN(I_CCTX)[k];
            s[i] = x / (1.0f + __expf(-x));
        }
        __syncthreads();
        float* mod = (float*)(ws + WS_MOD);
        for (int u = bid; u < 4 * 96; u += nb) {
            const int l = u / 96, cg = u % 96, col = cg * 64 + lane;
            float acc[17];
#pragma unroll
            for (int r = 0; r < 17; ++r) acc[r] = 0.f;
            const float* wp = AIN(I_ADAW) + (size_t)l * 1024 * 6144 + col;
            for (int k = wid * 128; k < wid * 128 + 128; ++k) {
                const float wv = wp[(size_t)k * 6144];
#pragma unroll
                for (int r = 0; r < 17; ++r) acc[r] += s[r * 1024 + k] * wv;
            }
#pragma unroll
            for (int r = 0; r < 17; ++r) red[(wid * 17 + r) * 64 + lane] = acc[r];
            __syncthreads();
            for (int i = tid; i < 17 * 64; i += NTHREADS) {
                const int r = i >> 6, ln = i & 63; float v = 0.f;
#pragma unroll
                for (int w = 0; w < 8; ++w) v += red[(w * 17 + r) * 64 + ln];
                const int cc = cg * 64 + ln;
                mod[((size_t)l * 17 + r) * 6144 + cc] = v + AIN(I_ADAB)[l * 6144 + cc];
            }
            __syncthreads();
        }
    }
    __syncthreads();
    {
        LAS float* scr = (LAS float*)(lds + wid * 16384);
        const int gw = bid * NWAVES + wid, NGW = nb * NWAVES;
        constexpr int IT_WIN = 16 * (EVC / 32), IT_SQ = 16 * 32, IT_SGIN = 16 * 64, IT_W1 = 16 * 64, IT_W2 = 16 * 32;
        constexpr int N0 = 2 * IT_WIN, N1 = N0 + 2 * IT_SQ, N2 = N1 + 2 * IT_SGIN, N3 = N2 + 2 * IT_SQ, N4 = N3 + 128 * IT_W1, N5 = N4 + 128 * IT_W2;
        for (int it = gw; it < N5; it += NGW) {
            if (it < N0) { const int m = it / IT_WIN, r = it % IT_WIN; p0_transpose_item<0>(AIN(I_EVWIN) + (size_t)m * DM * EVC, DM, EVC, (bf16_t*)(ws + WS_WIN) + (size_t)m * ZLD * DM, scr, r, lane); }
            else if (it < N1) { const int q = it - N0, m = q / IT_SQ, r = q % IT_SQ; p0_transpose_item<0>(AIN(I_EVWOUT) + (size_t)m * DM * DM, DM, DM, (bf16_t*)(ws + WS_WOUT) + (size_t)m * DM * DM, scr, r, lane); }
            else if (it < N2) { const int q = it - N1, m = q / IT_SGIN, r = q % IT_SGIN; p0_transpose_item<0>(AIN(I_SGWIN) + (size_t)m * DM * 2048, DM, 2048, (bf16_t*)(ws + WS_SGIN) + (size_t)m * 2048 * DM, scr, r, lane); }
            else if (it < N3) { const int q = it - N2, m = q / IT_SQ, r = q % IT_SQ; p0_transpose_item<0>(AIN(I_SGWOUT) + (size_t)m * DM * DM, DM, DM, (bf16_t*)(ws + WS_SGOUT) + (size_t)m * DM * DM, scr, r, lane); }
            else if (it < N4) { const int q = it - N3, m = q / IT_W1, r = q % IT_W1; p0_transpose_item<1>(AIN(I_W1) + (size_t)m * DM * 2048, DM, 2048, (bf16_t*)(ws + WS_W1) + (size_t)m * 2048 * DM, scr, r, lane); }
            else { const int q = it - N4, m = q / IT_W2, r = q % IT_W2; p0_transpose_item<0>(AIN(I_W2) + (size_t)m * DM * DM, DM, DM, (bf16_t*)(ws + WS_W2) + (size_t)m * DM * DM, scr, r, lane); }
        }
    }
    {
        const size_t gt = (size_t)bid * NTHREADS + tid, GT = (size_t)nb * NTHREADS;
        f32x4* H4 = (f32x4*)(ws + WS_H);
        const f32x4* c4 = (const f32x4*)AIN(I_CTX); const f32x4* x4 = (const f32x4*)AIN(I_X);
        constexpr size_t NC4 = (size_t)NCTX * DM / 4, NT4 = (size_t)NTOK * DM / 4;
        for (size_t i = gt; i < NT4; i += GT) H4[i] = (i < NC4) ? c4[i] : x4[i - NC4];
        for (size_t i = gt; i < (size_t)2 * 128 * DM / 8; i += GT) { const size_t m = i / (128 * DM / 8), r = i % (128 * DM / 8); ((u32x4*)((bf16_t*)(ws + WS_WIN) + (m * ZLD + EVC) * DM))[r] = (u32x4){0u, 0u, 0u, 0u}; }
        bf16_t* wl = (bf16_t*)(ws + WS_WLORA);
        for (size_t i = gt; i < (size_t)2 * LORA_N * LORA_K; i += GT) {
            const int jj = (int)(i / ((size_t)LORA_N * LORA_K)), rem = (int)(i % ((size_t)LORA_N * LORA_K)), n = rem / LORA_K, k = rem % LORA_K, seg = n >> 9, c = n & 511;
            float v = 0.f;
            if (seg < 2) { if ((k >> 6) == seg) v = AIN(I_RWW2)[(((size_t)jj * 2 + seg) * 64 + (k & 63)) * 512 + c]; }
            else if (seg < 4) { if ((k >> 6) == seg) v = AIN(I_RWA2)[(((size_t)jj * 2 + (seg - 2)) * 64 + (k & 63)) * 512 + c]; }
            else { if (k >= 256) v = AIN(I_RWG2)[((size_t)jj * 128 + (k - 256)) * 512 + c]; }
            wl[i] = (bf16_t)f2bf(v);
        }
        for (size_t i = gt; i < (size_t)2 * LORA_N; i += GT) { const int jj = (int)(i / LORA_N), n = (int)(i % LORA_N), seg = n >> 9, c = n & 511;
            ((float*)(ws + WS_LBIAS))[i] = seg < 2 ? AIN(I_RWW0)[((size_t)jj * 2 + seg) * 512 + c] : (seg < 4 ? AIN(I_RWA0)[((size_t)jj * 2 + (seg - 2)) * 512 + c] : 0.f); }
        float* rt = (float*)(ws + WS_RTWT);
        for (size_t i = gt; i < (size_t)4 * 32 * 1024; i += GT) { const int l = (int)(i >> 15), e = (int)(i >> 10) & 31, k = (int)i & 1023; const float w = AIN(I_RTW)[((size_t)l * 1024 + k) * 32 + e];
            const unsigned hi = f2bf(w); const float lo = w - __builtin_bit_cast(float, hi << 16);
            ((bf16_t*)rt)[((size_t)l * 2 * 32 + e) * 1024 + k] = (bf16_t)hi; ((bf16_t*)rt)[((size_t)(l * 2 + 1) * 32 + e) * 1024 + k] = (bf16_t)f2bf(lo); }
    }
}

template <bool ROUTER>
__device__ __forceinline__ void ph_norm(const Args& A, int l, int row_lo, LAS unsigned char* lds, int bid, int nb) {
    unsigned char* ws = opq(A.ws); const float* const* IN = (const float* const*)(ws + WS_PTRS); (void)IN;
    const int tid = tid_opaque(), lane = tid & 63, wid = tid >> 6;
    const float* H = (const float*)(ws + WS_H);
    const float* mod = (const float*)(ws + WS_MOD);
    bf16_t* abf = (bf16_t*)(ws + WS_ABF);
    const float* gp = INP(ROUTER ? I_N2G : I_N1G) + l * 1024;
    const int c_shift = ROUTER ? 3 : 0, c_scale = ROUTER ? 4 : 1;
    LAS float* rtl = (LAS float*)lds;
    LAS int* hist = (LAS int*)(lds + 131072);
    float rtb = 0.f;
    if constexpr (ROUTER) {
        const f32x4* rt4 = (const f32x4*)((const float*)(ws + WS_RTWT) + (size_t)l * 32 * 1024);
        for (int i = tid; i < 32 * 1024 / 4; i += NTHREADS) ((LAS f32x4*)rtl)[i] = rt4[i];
        if (tid < 32) hist[tid] = 0;
        rtb = INP(I_RTB)[l * 32 + (lane >> 1)];
        __syncthreads();
    }
    for (int row = row_lo + bid * NWAVES + wid; row < NTOK; row += nb * NWAVES) {
        const Tok tk = tokinfo(row);
        const float* mrow = mod + ((size_t)l * 17 + tk.modrow) * 6144;
        f32x4 v[4]; float ss = 0.f;
#pragma unroll
        for (int j = 0; j < 4; ++j) { v[j] = *(const f32x4*)(H + (size_t)row * DM + j * 256 + lane * 4); ss += (v[j].x * v[j].x + v[j].y * v[j].y) + (v[j].z * v[j].z + v[j].w * v[j].w); }
        const float rstd = rsqrtf(wave_sum(ss) * (1.0f / DM) + 1e-6f);
#pragma unroll
        for (int j = 0; j < 4; ++j) {
            const int col = j * 256 + lane * 4;
            const f32x4 g = *(const f32x4*)(gp + col), sc = *(const f32x4*)(mrow + c_scale * 1024 + col), sh = *(const f32x4*)(mrow + c_shift * 1024 + col);
            v[j] = (v[j] * rstd * g) * (sc + 1.0f) + sh;
            u32x2 o; o.x = pk2(v[j].x, v[j].y); o.y = pk2(v[j].z, v[j].w);
            *(u32x2*)(abf + (size_t)row * DM + col) = o;
        }
        if constexpr (ROUTER) {
            float p[32];
#pragma unroll
            for (int e = 0; e < 32; ++e) {
                float acc = 0.f;
#pragma unroll
                for (int j = 0; j < 4; ++j) { const f32x4 w = *(const LAS f32x4*)(rtl + e * 1024 + j * 256 + lane * 4); acc += (v[j].x * w.x + v[j].y * w.y) + (v[j].z * w.z + v[j].w * w.w); }
                p[e] = acc;
            }
#define RS_STEP(N, OFF) _Pragma("unroll") for (int i = 0; i < (N); ++i) { const bool up = (lane & (OFF)) != 0; const float send = up ? p[i] : p[i + (N)], keep = up ? p[i + (N)] : p[i]; p[i] = keep + __shfl_xor(send, (OFF)); }
            RS_STEP(16, 32) RS_STEP(8, 16) RS_STEP(4, 8) RS_STEP(2, 4) RS_STEP(1, 2)
#undef RS_STEP
            const float mylg = p[0] + __shfl_xor(p[0], 1) + rtb;
            float tv[4] = {-3.0e38f, -3.0e38f, -3.0e38f, -3.0e38f}; int ti[4] = {0, 0, 0, 0};
#pragma unroll
            for (int e = 0; e < 32; ++e) {
                const float lgv = rdl(mylg, 2 * e);
                if (lgv > tv[3]) {
                    tv[3] = lgv; ti[3] = e;
                    if (tv[3] > tv[2]) { const float a = tv[2]; tv[2] = tv[3]; tv[3] = a; const int b = ti[2]; ti[2] = ti[3]; ti[3] = b; }
                    if (tv[2] > tv[1]) { const float a = tv[1]; tv[1] = tv[2]; tv[2] = a; const int b = ti[1]; ti[1] = ti[2]; ti[2] = b; }
                    if (tv[1] > tv[0]) { const float a = tv[0]; tv[0] = tv[1]; tv[1] = a; const int b = ti[0]; ti[0] = ti[1]; ti[1] = b; }
                }
            }
            const float e1 = __expf(tv[1] - tv[0]), e2 = __expf(tv[2] - tv[0]), e3 = __expf(tv[3] - tv[0]);
            const float inv = 1.0f / (1.0f + e1 + e2 + e3);
            if (lane == 0) {
                int* te = (int*)(ws + WS_TOKE) + (size_t)row * 4; float* tg = (float*)(ws + WS_TOKG) + (size_t)row * 4; int* tr = (int*)(ws + WS_TOKR) + (size_t)row * 4;
                te[0] = ti[0]; te[1] = ti[1]; te[2] = ti[2]; te[3] = ti[3];
                tg[0] = inv; tg[1] = e1 * inv; tg[2] = e2 * inv; tg[3] = e3 * inv;
#pragma unroll
                for (int k = 0; k < 4; ++k) tr[k] = __hip_atomic_fetch_add(hist + ti[k], 1, __ATOMIC_RELAXED, __HIP_MEMORY_SCOPE_WORKGROUP);
            }
        }
    }
    if constexpr (ROUTER) {
        __syncthreads();
        if (tid < 32) ((int*)(ws + WS_BCNT))[((size_t)l * 256 + bid) * 32 + tid] = hist[tid];
    }
}


constexpr int RT_LS = 2064;
__device__ __forceinline__ void ph_norm2_router(const Args& A, int l, int row_lo, LAS unsigned char* lds, int bid, int nb) {
    unsigned char* ws = opq(A.ws); const float* const* IN = (const float* const*)(ws + WS_PTRS);
    const int tid = tid_opaque(), lane = tid & 63, wid = tid >> 6, c16 = lane & 15, g4 = lane >> 4;
    const float* H = (const float*)(ws + WS_H); const float* mod = (const float*)(ws + WS_MOD); bf16_t* abf = (bf16_t*)(ws + WS_ABF);
    const float* gp = INP(I_N2G) + l * 1024;
    LAS unsigned char* rth = lds; LAS unsigned char* rtl = lds + 32 * RT_LS;
    LAS int* hist = (LAS int*)(lds + 64 * RT_LS);
    LAS float* lgs = (LAS float*)(lds + 64 * RT_LS + 256) + wid * 544;
    {
        const u32x4* src = (const u32x4*)((const bf16_t*)(ws + WS_RTWT) + (size_t)l * 2 * 32 * 1024);
        for (int i = tid; i < 64 * 128; i += NTHREADS) { const int row = i >> 7, ch = i & 127; *(LAS u32x4*)(lds + row * RT_LS + ch * 16) = src[i]; }
        if (tid < 32) hist[tid] = 0;
        __syncthreads();
    }
    const float rtb0 = INP(I_RTB)[l * 32 + c16], rtb1 = INP(I_RTB)[l * 32 + 16 + c16];
    const int ngroups = (NTOK - row_lo) / 16;
    for (int u = bid * NWAVES + wid; u < ngroups; u += nb * NWAVES) {
        const int row = row_lo + 16 * u + c16;
        const Tok tk = tokinfo(row_lo + 16 * u);
        const float* mrow = mod + ((size_t)l * 17 + tk.modrow) * 6144;
        const float* hrow = H + (size_t)row * DM + 8 * g4;
        float ss = 0.f;
#pragma unroll 8
        for (int ks = 0; ks < 32; ++ks) { const f32x4 a = *(const f32x4*)(hrow + 32 * ks), b = *(const f32x4*)(hrow + 32 * ks + 4);
            ss += (a.x * a.x + a.y * a.y) + (a.z * a.z + a.w * a.w) + (b.x * b.x + b.y * b.y) + (b.z * b.z + b.w * b.w); }
        ss += __shfl_xor(ss, 16); ss += __shfl_xor(ss, 32);
        const float rstd = rsqrtf(ss * (1.0f / DM) + 1e-6f);
        f32x4 acc0 = {0.f, 0.f, 0.f, 0.f}, acc1 = acc0;
#pragma unroll 2
        for (int ks = 0; ks < 32; ++ks) {
            const int col = 32 * ks + 8 * g4;
            float f[8];
            { const f32x4 xa = *(const f32x4*)(hrow + 32 * ks), xb = *(const f32x4*)(hrow + 32 * ks + 4);
              const f32x4 ga = *(const f32x4*)(gp + col), gb = *(const f32x4*)(gp + col + 4), sa = *(const f32x4*)(mrow + 4 * 1024 + col), sb = *(const f32x4*)(mrow + 4 * 1024 + col + 4);
              const f32x4 ha = *(const f32x4*)(mrow + 3 * 1024 + col), hb = *(const f32x4*)(mrow + 3 * 1024 + col + 4);
              const f32x4 fa = (xa * rstd * ga) * (sa + 1.0f) + ha, fb = (xb * rstd * gb) * (sb + 1.0f) + hb;
              f[0] = fa.x; f[1] = fa.y; f[2] = fa.z; f[3] = fa.w; f[4] = fb.x; f[5] = fb.y; f[6] = fb.z; f[7] = fb.w; }
            unsigned hi[4], lo[4];
#pragma unroll
            for (int e = 0; e < 4; ++e) { hi[e] = pk2(f[2 * e], f[2 * e + 1]);
                lo[e] = pk2(f[2 * e] - __builtin_bit_cast(float, hi[e] << 16), f[2 * e + 1] - __builtin_bit_cast(float, hi[e] & 0xffff0000u)); }
            const u32x4 hv = {hi[0], hi[1], hi[2], hi[3]}, lv = {lo[0], lo[1], lo[2], lo[3]};
            *(u32x4*)(abf + (size_t)row * DM + col) = hv;
            const bf16x8 fh = __builtin_bit_cast(bf16x8, hv), fl = __builtin_bit_cast(bf16x8, lv);
            const int wo = c16 * RT_LS + col * 2;
            const bf16x8 wh0 = *(const LAS bf16x8*)(rth + wo), wh1 = *(const LAS bf16x8*)(rth + 16 * RT_LS + wo), wl0 = *(const LAS bf16x8*)(rtl + wo), wl1 = *(const LAS bf16x8*)(rtl + 16 * RT_LS + wo);
            acc0 = __builtin_amdgcn_mfma_f32_16x16x32_bf16(fh, wh0, acc0, 0, 0, 0); acc1 = __builtin_amdgcn_mfma_f32_16x16x32_bf16(fh, wh1, acc1, 0, 0, 0);
            acc0 = __builtin_amdgcn_mfma_f32_16x16x32_bf16(fl, wh0, acc0, 0, 0, 0); acc1 = __builtin_amdgcn_mfma_f32_16x16x32_bf16(fl, wh1, acc1, 0, 0, 0);
            acc0 = __builtin_amdgcn_mfma_f32_16x16x32_bf16(fh, wl0, acc0, 0, 0, 0); acc1 = __builtin_amdgcn_mfma_f32_16x16x32_bf16(fh, wl1, acc1, 0, 0, 0);
        }
#pragma unroll
        for (int r = 0; r < 4; ++r) { lgs[(4 * g4 + r) * 34 + c16] = acc0[r] + rtb0; lgs[(4 * g4 + r) * 34 + 16 + c16] = acc1[r] + rtb1; }
        asm volatile("s_waitcnt lgkmcnt(0)" ::: "memory");
        if (lane < 16) {
            float tv[4] = {-3.0e38f, -3.0e38f, -3.0e38f, -3.0e38f}; int ti[4] = {0, 0, 0, 0};
#pragma unroll
            for (int e = 0; e < 32; ++e) {
                const float lgv = lgs[lane * 34 + e];
                if (lgv > tv[3]) {
                    tv[3] = lgv; ti[3] = e;
                    if (tv[3] > tv[2]) { const float a = tv[2]; tv[2] = tv[3]; tv[3] = a; const int b = ti[2]; ti[2] = ti[3]; ti[3] = b; }
                    if (tv[2] > tv[1]) { const float a = tv[1]; tv[1] = tv[2]; tv[2] = a; const int b = ti[1]; ti[1] = ti[2]; ti[2] = b; }
                    if (tv[1] > tv[0]) { const float a = tv[0]; tv[0] = tv[1]; tv[1] = a; const int b = ti[0]; ti[0] = ti[1]; ti[1] = b; }
                }
            }
            const float e1 = __expf(tv[1] - tv[0]), e2 = __expf(tv[2] - tv[0]), e3 = __expf(tv[3] - tv[0]);
            const float inv = 1.0f / (1.0f + e1 + e2 + e3);
            const size_t r4 = (size_t)(row_lo + 16 * u + lane) * 4;
            *(int4*)((int*)(ws + WS_TOKE) + r4) = make_int4(ti[0], ti[1], ti[2], ti[3]);
            *(f32x4*)((float*)(ws + WS_TOKG) + r4) = (f32x4){inv, e1 * inv, e2 * inv, e3 * inv};
            int rk[4];
#pragma unroll
            for (int k = 0; k < 4; ++k) rk[k] = __hip_atomic_fetch_add(hist + ti[k], 1, __ATOMIC_RELAXED, __HIP_MEMORY_SCOPE_WORKGROUP);
            *(int4*)((int*)(ws + WS_TOKR) + r4) = make_int4(rk[0], rk[1], rk[2], rk[3]);
        }
        asm volatile("s_waitcnt lgkmcnt(0)" ::: "memory");
    }
    __syncthreads();
    if (tid < 32) ((int*)(ws + WS_BCNT))[((size_t)l * 256 + bid) * 32 + tid] = hist[tid];
}

typedef pg8::f32x4 (&AccRef)[2][2][4][2];
struct EpiStoreBf16 {
    static constexpr bool PERM = true, AFTER_DRAIN = false;
    bf16_t* O; int ldc;
    __device__ __forceinline__ void operator()(const pg8::f32x4 (&acc)[2][2][4][2], const pg8::Unit& u, int wr, int wc, int fr, int fq) const {
        const int row0 = u.pm * 256 + wr * 64 + fr, col0 = u.pn * 256 + wc * 32 + 8 * fq;
#pragma unroll
        for (int ai = 0; ai < 2; ++ai)
#pragma unroll
            for (int m = 0; m < 4; ++m) { bf16_t* rowp = O + (size_t)(row0 + ai * 128 + m * 16) * ldc + col0;
#pragma unroll
                for (int bj = 0; bj < 2; ++bj) { const pg8::f32x4 v0 = acc[ai][bj][m][0], v1 = acc[ai][bj][m][1];
                    u32x4 w; w.x = cvtpk_s(v0[0], v0[1]); w.y = cvtpk_s(v0[2], v0[3]); w.z = cvtpk_s(v1[0], v1[1]); w.w = cvtpk_s(v1[2], v1[3]);
                    *(u32x4*)(rowp + bj * 128) = w; } }
    }
};
struct EpiGeluBf16 {
    static constexpr bool PERM = true, AFTER_DRAIN = false;
    bf16_t* O; int ldc; const float* bias;
    __device__ __forceinline__ void operator()(const pg8::f32x4 (&acc)[2][2][4][2], const pg8::Unit& u, int wr, int wc, int fr, int fq) const {
        const int row0 = u.pm * 256 + wr * 64 + fr, col0 = u.pn * 256 + wc * 32 + 8 * fq;
        pg8::f32x4 bv[2][2];
#pragma unroll
        for (int bj = 0; bj < 2; ++bj)
#pragma unroll
            for (int n = 0; n < 2; ++n) bv[bj][n] = *(const pg8::f32x4*)(bias + col0 + bj * 128 + 4 * n);
#pragma unroll
        for (int ai = 0; ai < 2; ++ai)
#pragma unroll
            for (int m = 0; m < 4; ++m) { bf16_t* rowp = O + (size_t)(row0 + ai * 128 + m * 16) * ldc + col0;
#pragma unroll
                for (int bj = 0; bj < 2; ++bj) { pg8::f32x4 v0 = acc[ai][bj][m][0] + bv[bj][0], v1 = acc[ai][bj][m][1] + bv[bj][1];
                    const pg8::f32x2 a = pg8::gelu_pk((pg8::f32x2){v0[0], v0[1]}), b = pg8::gelu_pk((pg8::f32x2){v0[2], v0[3]}), c = pg8::gelu_pk((pg8::f32x2){v1[0], v1[1]}), d = pg8::gelu_pk((pg8::f32x2){v1[2], v1[3]});
                    u32x4 w; w.x = cvtpk_s(a.x, a.y); w.y = cvtpk_s(b.x, b.y); w.z = cvtpk_s(c.x, c.y); w.w = cvtpk_s(d.x, d.y);
                    *(u32x4*)(rowp + bj * 128) = w; } }
    }
};
struct EpiResidual {
    static constexpr bool PERM = false, AFTER_DRAIN = false;
    float* H; const float* gate0; int row_base;
    __device__ __forceinline__ void operator()(const pg8::f32x4 (&acc)[2][2][4][2], const pg8::Unit& u, int wr, int wc, int fr, int fq) const {
        const int row0 = u.pm * 256 + wr * 64 + fr, col0 = u.pn * 256 + wc * 32 + 4 * fq;
        const Tok tk = tokinfo(row_base + u.pm * 256);
        const float* gate = gate0 + (size_t)tk.modrow * 6144 + col0;
        pg8::f32x4 gv[2][2];
#pragma unroll
        for (int bj = 0; bj < 2; ++bj)
#pragma unroll
            for (int n = 0; n < 2; ++n) gv[bj][n] = *(const pg8::f32x4*)(gate + bj * 128 + n * 16);
#pragma unroll
        for (int ai = 0; ai < 2; ++ai)
#pragma unroll
            for (int m = 0; m < 4; ++m) { float* rowp = H + (size_t)(row0 + ai * 128 + m * 16) * DM + col0;
#pragma unroll
                for (int bj = 0; bj < 2; ++bj)
#pragma unroll
                    for (int n = 0; n < 2; ++n) { pg8::f32x4* p = (pg8::f32x4*)(rowp + bj * 128 + n * 16); *p = *p + gv[bj][n] * acc[ai][bj][m][n]; } }
    }
};
struct ListOrder {
    const LAS int* list; int n; const LAS unsigned* rowtab;
    __device__ __forceinline__ bool next(int i, pg8::Unit& u) const {
        if (i >= n) return false;
        u.pm = __builtin_amdgcn_readfirstlane(list[2 * i]); u.pn = __builtin_amdgcn_readfirstlane(list[2 * i + 1]); return true;
    }
    __device__ __forceinline__ void a_ready(const pg8::Unit&) const {}
    __device__ __forceinline__ void done(const pg8::Unit&) const {}
};
struct EpiLora {
    static constexpr bool PERM = true, AFTER_DRAIN = false;
    bf16_t* O; const float* bias; int row_base;
    __device__ __forceinline__ void operator()(const pg8::f32x4 (&acc)[2][2][4][2], const pg8::Unit& u, int wr, int wc, int fr, int fq) const {
        const int seg = u.pn >> 1, row0 = row_base + u.pm * 256 + wr * 64 + fr, cs0 = (u.pn & 1) * 256 + wc * 32 + 8 * fq;
        const float ksig = seg < 2 ? -0.60653065971f : 1.0f; const bool lin = seg == 4;
        bf16_t* Os = O + (size_t)seg * NTOK * 512;
#pragma unroll
        for (int bj = 0; bj < 2; ++bj) {
            const int cs = cs0 + bj * 128;
            const pg8::f32x4 b0 = *(const pg8::f32x4*)(bias + seg * 512 + cs), b1 = *(const pg8::f32x4*)(bias + seg * 512 + cs + 4);
#pragma unroll
            for (int ai = 0; ai < 2; ++ai)
#pragma unroll
                for (int m = 0; m < 4; ++m) {
                    pg8::f32x4 v0 = acc[ai][bj][m][0] + b0, v1 = acc[ai][bj][m][1] + b1;
#pragma unroll
                    for (int r = 0; r < 4; ++r) {
                        const float t0 = ksig * __builtin_amdgcn_rcpf(1.0f + __expf(-v0[r])), t1 = ksig * __builtin_amdgcn_rcpf(1.0f + __expf(-v1[r]));
                        v0[r] = lin ? v0[r] : t0; v1[r] = lin ? v1[r] : t1;
                    }
                    u32x4 w; w.x = cvtpk_s(v0[0], v0[1]); w.y = cvtpk_s(v0[2], v0[3]); w.z = cvtpk_s(v1[0], v1[1]); w.w = cvtpk_s(v1[2], v1[3]);
                    *(u32x4*)(Os + (size_t)(row0 + ai * 128 + m * 16) * 512 + cs) = w;
                }
        }
    }
};
constexpr int LDS_TAB = 131072;
constexpr int LDS_LIST = LDS_TAB + 4096;
constexpr int LDS_ROWTAB = LDS_LIST + 1024;
__device__ __forceinline__ ListOrder build_units(LAS unsigned char* lds, int nM, int nN, int G, int c, const LAS int* tile_e, int ncol) {
    LAS int* list = (LAS int*)(lds + LDS_LIST);
    pg8::StaticOrder S; S.nM = nM; S.nN = nN; S.nwg = nM * nN; S.G = G; S.c = c;
    const int tid = tid_opaque();
    if (tid < 64) { pg8::Unit u; if (S.next(tid, u)) { if (tile_e) u.pn = tile_e[u.pm] * ncol + u.pn; list[2 * tid] = u.pm; list[2 * tid + 1] = u.pn; } }
    __syncthreads();
    ListOrder L; L.list = list; L.n = (c < S.nwg) ? (S.nwg - c + G - 1) / G : 0; L.rowtab = (const LAS unsigned*)(lds + LDS_ROWTAB);
    return L;
}
struct EpiMoe1 {
    static constexpr bool PERM = true, AFTER_DRAIN = false;
    bf16_t* O; const float* b1;
    __device__ __forceinline__ void operator()(const pg8::f32x4 (&acc)[2][2][4][2], const pg8::Unit& u, int wr, int wc, int fr, int fq) const {
        const int e = u.pn >> 3, pn = u.pn & 7;
        const int row0 = u.pm * 256 + wr * 64 + fr, ci = pn * 128 + wc * 32 + 8 * fq;
        const float* be = b1 + (size_t)e * 2048 + ci;
        const pg8::f32x4 bg0 = *(const pg8::f32x4*)(be), bg1 = *(const pg8::f32x4*)(be + 4), bl0 = *(const pg8::f32x4*)(be + 1024), bl1 = *(const pg8::f32x4*)(be + 1028);
#pragma unroll
        for (int ai = 0; ai < 2; ++ai)
#pragma unroll
            for (int m = 0; m < 4; ++m) {
                const pg8::f32x4 g0 = acc[ai][0][m][0] + bg0, g1 = acc[ai][0][m][1] + bg1, l0 = acc[ai][1][m][0] + bl0, l1 = acc[ai][1][m][1] + bl1;
                float o[8];
#pragma unroll
                for (int r = 0; r < 4; ++r) {
                    const float ga = fminf(g0[r], 7.0f), gb = fminf(g1[r], 7.0f);
                    const float la = fminf(fmaxf(l0[r], -7.0f), 7.0f), lb = fminf(fmaxf(l1[r], -7.0f), 7.0f);
                    o[r] = ga * __builtin_amdgcn_rcpf(1.0f + __expf(-1.702f * ga)) * (la + 1.0f);
                    o[4 + r] = gb * __builtin_amdgcn_rcpf(1.0f + __expf(-1.702f * gb)) * (lb + 1.0f);
                }
                u32x4 w; w.x = cvtpk_s(o[0], o[1]); w.y = cvtpk_s(o[2], o[3]); w.z = cvtpk_s(o[4], o[5]); w.w = cvtpk_s(o[6], o[7]);
                *(u32x4*)(O + (size_t)(row0 + ai * 128 + m * 16) * DM + ci) = w;
            }
    }
};
struct EpiMoe2 {
    static constexpr bool PERM = true, AFTER_DRAIN = false;
    bf16_t* O; const float* b2;
    __device__ __forceinline__ void operator()(const pg8::f32x4 (&acc)[2][2][4][2], const pg8::Unit& u, int wr, int wc, int fr, int fq) const {
        const int e = u.pn >> 2, pn = u.pn & 3;
        const int row0 = u.pm * 256 + wr * 64 + fr, col0 = pn * 256 + wc * 32 + 8 * fq;
        const float* be = b2 + (size_t)e * DM + col0;
        pg8::f32x4 bv[2][2];
#pragma unroll
        for (int bj = 0; bj < 2; ++bj)
#pragma unroll
            for (int n = 0; n < 2; ++n) bv[bj][n] = *(const pg8::f32x4*)(be + bj * 128 + 4 * n);
#pragma unroll
        for (int ai = 0; ai < 2; ++ai)
#pragma unroll
            for (int m = 0; m < 4; ++m) { bf16_t* rowp = O + (size_t)(row0 + ai * 128 + m * 16) * DM + col0;
#pragma unroll
                for (int bj = 0; bj < 2; ++bj) { const pg8::f32x4 v0 = acc[ai][bj][m][0] + bv[bj][0], v1 = acc[ai][bj][m][1] + bv[bj][1];
                    u32x4 w; w.x = cvtpk_s(v0[0], v0[1]); w.y = cvtpk_s(v0[2], v0[3]); w.z = cvtpk_s(v1[0], v1[1]); w.w = cvtpk_s(v1[2], v1[3]);
                    *(u32x4*)(rowp + bj * 128) = w; } }
    }
};

namespace att {
typedef float f32x16 __attribute__((ext_vector_type(16)));
typedef short s16x4 __attribute__((ext_vector_type(4)));
constexpr int KVBLK = 64, LDR = 512;
constexpr float SCALE = 0.125f, THR = 8.f;
constexpr int SHM_V = KVBLK * 128 * 2, SHM_K = KVBLK * 64 * 2, SHM_ATTN = 2 * SHM_V + 2 * SHM_K + NWAVES * 64 * 4;
#define ATT_KSWZ(row, colB) ((row) * 128 + ((colB) ^ ((((row) >> 1) & 7) << 4)))
#define ATT_SBAR() __builtin_amdgcn_sched_barrier(0)
__device__ __forceinline__ int crow(int r, int hi) { return (r & 3) + 8 * (r >> 2) + 4 * hi; }
__device__ __forceinline__ unsigned cvtpk(float lo, float hi) { unsigned r; asm volatile("v_cvt_pk_bf16_f32 %0, %1, %2" : "=v"(r) : "v"(lo), "v"(hi)); return r; }
__device__ __forceinline__ void partialSM(f32x16& p0, f32x16& p1, float& m_reg, float& mn, float& alpha) {
    constexpr float C = SCALE * 1.4426950408889634f;
    float pmax = p0[0];
#pragma unroll
    for (int r = 1; r < 16; ++r) pmax = fmaxf(pmax, p0[r]);
#pragma unroll
    for (int r = 0; r < 16; ++r) pmax = fmaxf(pmax, p1[r]);
    { auto rr = __builtin_amdgcn_permlane32_swap(__float_as_uint(pmax), __float_as_uint(pmax), false, false);
      pmax = fmaxf(__uint_as_float(rr[0]), __uint_as_float(rr[1])); }
    if (__builtin_expect(__all(pmax - m_reg <= THR / SCALE), 1)) { mn = m_reg; alpha = 1.f; }
    else { mn = fmaxf(m_reg, pmax); alpha = __builtin_amdgcn_exp2f((m_reg - mn) * C); m_reg = mn; }
    const float mnC = -mn * C;
#pragma unroll
    for (int r = 0; r < 16; ++r) p0[r] = fmaf(p0[r], C, mnC);
#pragma unroll
    for (int r = 0; r < 16; ++r) p1[r] = fmaf(p1[r], C, mnC);
#pragma unroll
    for (int r = 0; r < 16; ++r) p0[r] = __builtin_amdgcn_exp2f(p0[r]);
}
__device__ __forceinline__ void finishSM(f32x16& p0, f32x16& p1, float alpha, float& l_reg, bf16x8& pa0, bf16x8& pa1, bf16x8& pa2, bf16x8& pa3) {
#pragma unroll
    for (int r = 0; r < 16; ++r) p1[r] = __builtin_amdgcn_exp2f(p1[r]);
    float ps = 0;
#pragma unroll
    for (int r = 0; r < 16; ++r) ps += p0[r];
#pragma unroll
    for (int r = 0; r < 16; ++r) ps += p1[r];
    { auto rr = __builtin_amdgcn_permlane32_swap(__float_as_uint(ps), __float_as_uint(ps), false, false);
      ps = __uint_as_float(rr[0]) + __uint_as_float(rr[1]); }
    l_reg = l_reg * alpha + ps;
#define ATT_PK4(P, BASE, OUT) do { unsigned a0 = cvtpk(P[BASE + 0], P[BASE + 1]), a1 = cvtpk(P[BASE + 2], P[BASE + 3]);   \
    unsigned b0 = cvtpk(P[BASE + 4], P[BASE + 5]), b1 = cvtpk(P[BASE + 6], P[BASE + 7]);                              \
    auto r0 = __builtin_amdgcn_permlane32_swap(a0, b0, false, false); auto r1 = __builtin_amdgcn_permlane32_swap(a1, b1, false, false); \
    u32x4 w = {r0[0], r1[0], r0[1], r1[1]}; OUT = __builtin_bit_cast(bf16x8, w); } while (0)
    ATT_PK4(p0, 0, pa0); ATT_PK4(p0, 8, pa1); ATT_PK4(p1, 0, pa2); ATT_PK4(p1, 8, pa3);
#undef ATT_PK4
}
__device__ __forceinline__ void qkt(f32x16& p0, f32x16& p1, const LAS unsigned char* Ks, const bf16x8 (&qr)[4], int r32, int hi) {
    p0 = f32x16{}; p1 = f32x16{};
#pragma unroll
    for (int d0 = 0; d0 < 4; ++d0) { const int cb = (d0 * 16 + hi * 8) * 2;
        const bf16x8 b0 = *(const LAS bf16x8*)(Ks + ATT_KSWZ(r32, cb));
        const bf16x8 b1 = *(const LAS bf16x8*)(Ks + ATT_KSWZ(32 + r32, cb));
        p0 = __builtin_amdgcn_mfma_f32_32x32x16_bf16(b0, qr[d0], p0, 0, 0, 0);
        p1 = __builtin_amdgcn_mfma_f32_32x32x16_bf16(b1, qr[d0], p1, 0, 0, 0); }
}
__device__ __forceinline__ int v_st(int k, int c) { const int kk = (k & ~0xC) | ((k & 4) << 1) | ((k & 8) >> 1); return ((kk >> 3) * 4 + (c >> 5)) * 512 + ((kk & 7) * 32 + (c & 31)) * 2; }
__device__ __forceinline__ int v_rd_base(int lane) { return ((lane & 3) << 3) | (((lane >> 2) & 3) << 6) | (((lane >> 4) & 1) << 5) | (((lane >> 5) & 1) << 8); }
constexpr int v_rd_off(int d0, int ks, int half) { return d0 * 512 + ks * 4096 + half * 2048; }
template <int OFF> __device__ __forceinline__ s16x4 tr_read(int vb) { s16x4 r; asm volatile("ds_read_b64_tr_b16 %0, %1 offset:%2" : "=&v"(r) : "v"(vb), "i"(OFF) : "memory"); return r; }
template <int D0> __device__ __forceinline__ void pv_one(f32x16& od, int vb, bf16x8 pa0, bf16x8 pa1, bf16x8 pa2, bf16x8 pa3) {
    const s16x4 l0 = tr_read<v_rd_off(D0, 0, 0)>(vb), h0 = tr_read<v_rd_off(D0, 0, 1)>(vb), l1 = tr_read<v_rd_off(D0, 1, 0)>(vb), h1 = tr_read<v_rd_off(D0, 1, 1)>(vb);
    const s16x4 l2 = tr_read<v_rd_off(D0, 2, 0)>(vb), h2 = tr_read<v_rd_off(D0, 2, 1)>(vb), l3 = tr_read<v_rd_off(D0, 3, 0)>(vb), h3 = tr_read<v_rd_off(D0, 3, 1)>(vb);
    asm volatile("s_waitcnt lgkmcnt(0)" ::: "memory"); ATT_SBAR();
#define ATT_PK(L, H) (bf16x8){L[0], L[1], L[2], L[3], H[0], H[1], H[2], H[3]}
    od = __builtin_amdgcn_mfma_f32_32x32x16_bf16(pa0, ATT_PK(l0, h0), od, 0, 0, 0);
    od = __builtin_amdgcn_mfma_f32_32x32x16_bf16(pa1, ATT_PK(l1, h1), od, 0, 0, 0);
    od = __builtin_amdgcn_mfma_f32_32x32x16_bf16(pa2, ATT_PK(l2, h2), od, 0, 0, 0);
    od = __builtin_amdgcn_mfma_f32_32x32x16_bf16(pa3, ATT_PK(l3, h3), od, 0, 0, 0);
#undef ATT_PK
}
__device__ __forceinline__ void pv_d0(f32x16 (&o)[4], int vb, bf16x8 pa0, bf16x8 pa1, bf16x8 pa2, bf16x8 pa3) {
    pv_one<0>(o[0], vb, pa0, pa1, pa2, pa3); pv_one<1>(o[1], vb, pa0, pa1, pa2, pa3); pv_one<2>(o[2], vb, pa0, pa1, pa2, pa3); pv_one<3>(o[3], vb, pa0, pa1, pa2, pa3);
}
__device__ __forceinline__ void attn_body(const bf16_t* Qb, const bf16_t* Kh, const bf16_t* Vh, float* Ob, int seq, LAS unsigned char* lds) {
    const int tid = tid_opaque(), wid = tid >> 6, lane = tid & 63, r32 = lane & 31, hi = lane >> 5;
    LAS unsigned char* V_lds = lds; LAS unsigned char* K_lds = lds + 2 * SHM_V;
    LAS float* wsl = (LAS float*)(lds + 2 * SHM_V + 2 * SHM_K) + wid * 64; LAS float* li_l = wsl; LAS float* al_l = wsl + 32;
    float m_reg = -1e30f, l_reg = 0; f32x16 o[4] = {}; bf16x8 qr[4];
    const bf16_t* Qw = Qb + (size_t)(wid * 32 + r32) * LDR + hi * 8;
#pragma unroll
    for (int d0 = 0; d0 < 4; ++d0) qr[d0] = *(const bf16x8*)(Qw + d0 * 16);
    const int sr = tid >> 4, sc = (tid & 15) * 8, vst0 = v_st(sr, sc), vst1 = v_st(32 + sr, sc);
    const int kr = tid >> 3, kc = (tid & 7) * 8, kst = ATT_KSWZ(kr, kc * 2);
    const int vb0 = (int)(uintptr_t)V_lds + v_rd_base(lane);
    bf16x8 vsA0, vsA1, ksA, vsB0, vsB1, ksB;
#define ATT_SLOAD(V0, V1, K0, k0) do { V0 = *(const bf16x8*)(Vh + (size_t)((k0) + sr) * LDR + sc); V1 = *(const bf16x8*)(Vh + (size_t)((k0) + 32 + sr) * LDR + sc); \
    K0 = *(const bf16x8*)(Kh + (size_t)((k0) + kr) * LDR + kc); } while (0)
#define ATT_SWRITE(b, V0, V1, K0) do { *(LAS bf16x8*)(V_lds + (b) * SHM_V + vst0) = V0; *(LAS bf16x8*)(V_lds + (b) * SHM_V + vst1) = V1; \
    *(LAS bf16x8*)(K_lds + (b) * SHM_K + kst) = K0; } while (0)
#define ATT_SWAIT() asm volatile("s_waitcnt vmcnt(3)" ::: "memory")
#define ATT_RESC(a) do { if (__any((a) < 1.f)) { if (hi == 0) al_l[r32] = (a); asm volatile("s_waitcnt lgkmcnt(0)" ::: "memory"); \
    _Pragma("unroll") for (int d = 0; d < 4; ++d) _Pragma("unroll") for (int r = 0; r < 16; ++r) o[d][r] *= al_l[crow(r, hi)]; } } while (0)
    f32x16 pA0, pA1, pB0, pB1; float mnA, mnB, alA, alB; bf16x8 pa0, pa1, pa2, pa3; const int NT = seq / KVBLK;
    ATT_SLOAD(vsA0, vsA1, ksA, 0); asm volatile("s_waitcnt vmcnt(0)" ::: "memory"); ATT_SWRITE(0, vsA0, vsA1, ksA); __syncthreads();
    qkt(pA0, pA1, K_lds, qr, r32, hi); partialSM(pA0, pA1, m_reg, mnA, alA);
    ATT_SLOAD(vsB0, vsB1, ksB, KVBLK); if (2 < NT) ATT_SLOAD(vsA0, vsA1, ksA, 2 * KVBLK);
    ATT_SWAIT(); ATT_SWRITE(1, vsB0, vsB1, ksB); __syncthreads();
    for (int j = 1; j + 1 < NT; j += 2) {
        ATT_SBAR(); qkt(pB0, pB1, K_lds + SHM_K, qr, r32, hi);
        finishSM(pA0, pA1, alA, l_reg, pa0, pa1, pa2, pa3); ATT_SBAR();
        ATT_SLOAD(vsB0, vsB1, ksB, (j + 2) * KVBLK); ATT_SBAR();
        pv_d0(o, vb0, pa0, pa1, pa2, pa3); partialSM(pB0, pB1, m_reg, mnB, alB);
        __syncthreads(); ATT_SWAIT(); ATT_SWRITE(0, vsA0, vsA1, ksA);
        ATT_RESC(alB); __syncthreads();
        ATT_SBAR(); qkt(pA0, pA1, K_lds, qr, r32, hi);
        finishSM(pB0, pB1, alB, l_reg, pa0, pa1, pa2, pa3); ATT_SBAR();
        if (j + 3 < NT) ATT_SLOAD(vsA0, vsA1, ksA, (j + 3) * KVBLK); ATT_SBAR();
        pv_d0(o, vb0 + SHM_V, pa0, pa1, pa2, pa3); partialSM(pA0, pA1, m_reg, mnA, alA);
        __syncthreads(); ATT_SWAIT(); ATT_SWRITE(1, vsB0, vsB1, ksB);
        ATT_RESC(alA); __syncthreads();
    }
    ATT_SBAR(); qkt(pB0, pB1, K_lds + SHM_K, qr, r32, hi);
    finishSM(pA0, pA1, alA, l_reg, pa0, pa1, pa2, pa3); ATT_SBAR();
    pv_d0(o, vb0, pa0, pa1, pa2, pa3); partialSM(pB0, pB1, m_reg, mnB, alB);
    __syncthreads(); ATT_RESC(alB);
    finishSM(pB0, pB1, alB, l_reg, pa0, pa1, pa2, pa3); ATT_SBAR();
    pv_d0(o, vb0 + SHM_V, pa0, pa1, pa2, pa3);
    if (hi == 0) li_l[r32] = l_reg; asm volatile("s_waitcnt lgkmcnt(0)" ::: "memory");
    float rli[16];
#pragma unroll
    for (int r = 0; r < 16; ++r) rli[r] = __builtin_amdgcn_rcpf(li_l[crow(r, hi)]);
    float* Ow = Ob + (size_t)(wid * 32) * LDR;
#pragma unroll
    for (int r = 0; r < 16; ++r) { const int orow = crow(r, hi);
#pragma unroll
        for (int d0 = 0; d0 < 4; ++d0) Ow[(size_t)orow * LDR + d0 * 32 + r32] = o[d0][r] * rli[r]; }
#undef ATT_SLOAD
#undef ATT_SWRITE
#undef ATT_SWAIT
#undef ATT_RESC
}
}

__device__ __forceinline__ void ph_gemm_win(const Args& A, int j, int row_lo, LAS unsigned char* lds, int bid, int nb) {
    unsigned char* ws = opq(A.ws); const float* const* IN = (const float* const*)(ws + WS_PTRS); (void)IN;
    pg8::Gemm g{(const bf16_t*)(ws + WS_ABF) + (size_t)row_lo * DM, (const bf16_t*)(ws + WS_WIN) + (size_t)j * ZLD * DM, NTOK - row_lo, ZLD, DM};
    const ListOrder S = build_units(lds, (NTOK - row_lo) / 256, ZLD / 256, nb, bid, nullptr, 0);
    EpiStoreBf16 E{(bf16_t*)(ws + WS_Z) + (size_t)row_lo * ZLD, ZLD};
    pg8::gemm_phase<EpiStoreBf16, ListOrder, true, true>(lds, g, S, E);
}

__device__ __forceinline__ void ph_rwkv_pre(const Args& A, int j, int row_lo, int bid, int nb) {
    unsigned char* ws = opq(A.ws); const float* const* IN = (const float* const*)(ws + WS_PTRS);
    const int tid = tid_opaque(), lane = tid & 63, wid = tid >> 6;
    const bf16_t* Z = (const bf16_t*)(ws + WS_Z);
    const float* mu = INP(I_RWMU) + (size_t)j * 2 * RWC; const float* kkw = INP(I_RWKK) + j * 512;
    bf16_t* RB = (bf16_t*)(ws + WS_RB); bf16_t* KS = (bf16_t*)(ws + WS_KS); bf16_t* VS = (bf16_t*)(ws + WS_VS); bf16_t* KKN = (bf16_t*)(ws + WS_KKN); bf16_t* LIN = (bf16_t*)(ws + WS_LIN);
#define UNPK8(dst, raw) do { _Pragma("unroll") for (int _i = 0; _i < 4; ++_i) { dst[2 * _i] = __builtin_bit_cast(float, raw[_i] << 16); dst[2 * _i + 1] = __builtin_bit_cast(float, raw[_i] & 0xffff0000u); } } while (0)
#define PK8(v) (u32x4){pk2(v[0], v[1]), pk2(v[2], v[3]), pk2(v[4], v[5]), pk2(v[6], v[7])}
    for (int g = row_lo + bid * NWAVES + wid; g < NTOK; g += nb * NWAVES) {
        const Tok tk = tokinfo(g);
        const bool hp = tk.t > 0, hn = tk.t < tk.T - 1;
        const bf16_t* zc = Z + (size_t)g * ZLD;
#pragma unroll
        for (int i = 0; i < 4; ++i) {
            const int ch = i * 64 + lane, col = ch * 8;
            if (ch < 240) {
                const u32x4 zero = {0u, 0u, 0u, 0u};
                const u32x4 cr = *(const u32x4*)(zc + col), pr = hp ? *(const u32x4*)(zc - ZLD + col) : zero, nr = hn ? *(const u32x4*)(zc + ZLD + col) : zero;
                float z[8], p[8], n[8], s8[8];
                UNPK8(z, cr); UNPK8(p, pr); UNPK8(n, nr);
                const f32x4 m0a = *(const f32x4*)(mu + col), m0b = *(const f32x4*)(mu + col + 4), m1a = *(const f32x4*)(mu + RWC + col), m1b = *(const f32x4*)(mu + RWC + col + 4);
#pragma unroll
                for (int e = 0; e < 4; ++e) { s8[e] = z[e] + m0a[e] * (p[e] - z[e]) + m1a[e] * (n[e] - z[e]); s8[4 + e] = z[4 + e] + m0b[e] * (p[4 + e] - z[4 + e]) + m1b[e] * (n[4 + e] - z[4 + e]); }
                if (col < 512) *(u32x4*)(RB + (size_t)g * 512 + col) = PK8(s8);
                else if (col < 1024) {
                    const int ck = col - 512;
                    *(u32x4*)(KS + (size_t)g * 512 + ck) = PK8(s8);
                    const f32x4 kwa = *(const f32x4*)(kkw + ck), kwb = *(const f32x4*)(kkw + ck + 4);
                    float kk[8]; float ss = 0.f;
#pragma unroll
                    for (int e = 0; e < 4; ++e) { kk[e] = s8[e] * kwa[e]; kk[4 + e] = s8[4 + e] * kwb[e]; ss += kk[e] * kk[e] + kk[4 + e] * kk[4 + e]; }
                    ss += __shfl_xor(ss, 1); ss += __shfl_xor(ss, 2); ss += __shfl_xor(ss, 4);
                    const float inv = 1.0f / fmaxf(sqrtf(ss), 1e-12f);
#pragma unroll
                    for (int e = 0; e < 8; ++e) kk[e] *= inv;
                    *(u32x4*)(KKN + (size_t)g * 512 + ck) = PK8(kk);
                }
                else if (col < 1536) *(u32x4*)(VS + (size_t)g * 512 + (col - 1024)) = PK8(s8);
                else {
                    float t8[8];
#pragma unroll
                    for (int e = 0; e < 8; ++e) t8[e] = col < 1664 ? tanhf(s8[e]) : (col < 1792 ? s8[e] : sigmoidf_(s8[e]));
                    *(u32x4*)(LIN + (size_t)g * 384 + (col - 1536)) = PK8(t8);
                }
            }
        }
    }
#undef UNPK8
#undef PK8
}
__device__ __forceinline__ void ph_gemm_lora(const Args& A, int j, int row_lo, LAS unsigned char* lds, int bid, int nb) {
    unsigned char* ws = opq(A.ws);
    int Kq = LORA_K; asm volatile("" : "+s"(Kq));
    pg8::Gemm g{(const bf16_t*)(ws + WS_LIN) + (size_t)row_lo * LORA_K, (const bf16_t*)(ws + WS_WLORA) + (size_t)j * LORA_N * LORA_K, NTOK - row_lo, LORA_N, Kq};
    const ListOrder S = build_units(lds, (NTOK - row_lo) / 256, LORA_N / 256, nb, bid, nullptr, 0);
    EpiLora E{(bf16_t*)(ws + WS_LO), (const float*)(ws + WS_LBIAS) + (size_t)j * LORA_N, row_lo};
    pg8::gemm_phase<EpiLora, ListOrder, true, true>(lds, g, S, E);
}

constexpr int R_A2 = 0, R_RT = 2048, R_BT = 4096, R_KT = 6144, R_VT = 8192, R_MBR = 10240, R_MKR = 10752, R_G = 11264, R_P = 11776;
__device__ __forceinline__ bf16x8 frag4(u32x2 lo) { const u32x4 w = {lo.x, lo.y, 0u, 0u}; return __builtin_bit_cast(bf16x8, w); }
__device__ __forceinline__ bf16x8 frag8(u32x2 lo, u32x2 hi) { const u32x4 w = {lo.x, lo.y, hi.x, hi.y}; return __builtin_bit_cast(bf16x8, w); }
__device__ __forceinline__ u32x2 pack4(f32x4 v) { u32x2 o; o.x = cvtpk_s(v[0], v[1]); o.y = cvtpk_s(v[2], v[3]); return o; }
__device__ __forceinline__ int wkv_token(int b, int dir, int s) {
    if (s < TC) return b * TC + (dir ? (TC - 1 - s) : s);
    const int q = s - TC; return NCTX + b * TL + (dir ? (TL - 1 - q) : q);
}
__device__ __forceinline__ float dpp_row_shr(float x, const int n) {
    switch (n) {
        case 1: return __builtin_bit_cast(float, __builtin_amdgcn_update_dpp(0, __builtin_bit_cast(int, x), 0x111, 0xF, 0xF, false));
        case 2: return __builtin_bit_cast(float, __builtin_amdgcn_update_dpp(0, __builtin_bit_cast(int, x), 0x112, 0xF, 0xF, false));
        case 4: return __builtin_bit_cast(float, __builtin_amdgcn_update_dpp(0, __builtin_bit_cast(int, x), 0x114, 0xF, 0xF, false));
        default: return __builtin_bit_cast(float, __builtin_amdgcn_update_dpp(0, __builtin_bit_cast(int, x), 0x118, 0xF, 0xF, false));
    }
}
#define WKV_TR(dst, addr) asm volatile("ds_read_b64_tr_b16 %0, %1" : "=&v"(dst) : "v"(addr) : "memory")
__device__ __forceinline__ void ph_wkv_prep(const Args& A, int j, LAS unsigned char* lds, int bid, int nb) {
    unsigned char* ws = opq(A.ws); const float* const* IN = (const float* const*)(ws + WS_PTRS);
    const int tid = tid_opaque(), lane = tid & 63, wid = tid >> 6, c16 = lane & 15, g4 = lane >> 4;
    constexpr int RS = 144;
    LAS unsigned char* wl = lds + wid * 16384;
    LAS unsigned char* Lat = wl; LAS unsigned char* Lbt = wl + 2304; LAS unsigned char* Lkt = wl + 4608; LAS unsigned char* Lrt = wl + 6912; LAS unsigned char* Lvt = wl + 9216;
    LAS float* Lnf = (LAS float*)(wl + 11520);
    LAS unsigned char* Lx = wl + 12608;
    const size_t FS = (size_t)NTOK * 512;
    const bf16_t* RB = (const bf16_t*)(ws + WS_RB); const bf16_t* KS = (const bf16_t*)(ws + WS_KS); const bf16_t* VS = (const bf16_t*)(ws + WS_VS); const bf16_t* KKN = (const bf16_t*)(ws + WS_KKN);
#define UNPK16(dst, p) do { const u32x4 _a = *(const u32x4*)(p), _b = *(const u32x4*)((p) + 8); _Pragma("unroll") for (int _i = 0; _i < 4; ++_i) { \
        dst[2 * _i] = __builtin_bit_cast(float, _a[_i] << 16); dst[2 * _i + 1] = __builtin_bit_cast(float, _a[_i] & 0xffff0000u); \
        dst[8 + 2 * _i] = __builtin_bit_cast(float, _b[_i] << 16); dst[9 + 2 * _i] = __builtin_bit_cast(float, _b[_i] & 0xffff0000u); } } while (0)
#define PK16ST(base, v) do { *(LAS u32x4*)(base) = (u32x4){pk2(v[0], v[1]), pk2(v[2], v[3]), pk2(v[4], v[5]), pk2(v[6], v[7])}; \
        *(LAS u32x4*)((base) + 16) = (u32x4){pk2(v[8], v[9]), pk2(v[10], v[11]), pk2(v[12], v[13]), pk2(v[14], v[15])}; } while (0)
    for (int unit = bid * NWAVES + wid; unit < 256 * WKV_NCH; unit += nb * NWAVES) {
        const int inst = unit / WKV_NCH, c = unit - inst * WKV_NCH, dir = inst & 1, h = (inst >> 1) & 7, b = inst >> 4;
        const int g0 = wkv_token(b, dir, c * 16), gstep = dir ? -1 : 1;
        unsigned char* rec = ws + WS_WKV + (size_t)unit * WKV_REC;
        {
            const size_t o = (size_t)(g0 + gstep * c16) * 512 + h * 64 + 16 * g4;
            float lw[16], av[16], kv[16], kn[16], rv[16];
            UNPK16(lw, (const bf16_t*)(ws + WS_LO) + dir * FS + o); UNPK16(av, (const bf16_t*)(ws + WS_AB) + dir * FS + o);
            UNPK16(kv, KS + o); UNPK16(kn, KKN + o); UNPK16(rv, RB + o);
            { const u32x4 v0 = *(const u32x4*)(VS + o), v1 = *(const u32x4*)(VS + o + 8); *(LAS u32x4*)(Lvt + c16 * RS + 32 * g4) = v0; *(LAS u32x4*)(Lvt + c16 * RS + 32 * g4 + 16) = v1; }
            const float* kap = INP(I_RWKA) + j * 512 + h * 64 + 16 * g4;
            float at[16], bt[16], kt[16], rt[16], ecl[16];
#pragma unroll
            for (int i = 0; i < 16; ++i) {
                float cs = lw[i];
                cs += dpp_row_shr(cs, 1); cs += dpp_row_shr(cs, 2); cs += dpp_row_shr(cs, 4); cs += dpp_row_shr(cs, 8);
                const float ep = __expf(cs - lw[i]), ec = __expf(cs), em = __builtin_amdgcn_rcpf(ec);
                at[i] = -kn[i] * ep; bt[i] = kn[i] * av[i] * em; kt[i] = kv[i] * (1.0f + (av[i] - 1.0f) * kap[i]) * em; rt[i] = rv[i] * ec; ecl[i] = ec;
            }
            PK16ST(Lat + c16 * RS + 32 * g4, at); PK16ST(Lbt + c16 * RS + 32 * g4, bt); PK16ST(Lkt + c16 * RS + 32 * g4, kt); PK16ST(Lrt + c16 * RS + 32 * g4, rt);
            if (c16 == 15) {
#pragma unroll
                for (int q = 0; q < 4; ++q) *(f32x4*)(rec + R_P + (16 * g4 + 4 * q) * 4) = (f32x4){ecl[4 * q], ecl[4 * q + 1], ecl[4 * q + 2], ecl[4 * q + 3]};
            }
        }
        asm volatile("s_waitcnt lgkmcnt(0)" ::: "memory");
        f32x4 nD = {0.f, 0.f, 0.f, 0.f}, makD = nD, mbrD = nD, mkrD = nD;
#pragma unroll
        for (int ks = 0; ks < 2; ++ks) {
            const int off = c16 * RS + (32 * ks + 8 * g4) * 2;
            const bf16x8 fa = *(const LAS bf16x8*)(Lat + off), fb = *(const LAS bf16x8*)(Lbt + off), fk = *(const LAS bf16x8*)(Lkt + off), fr = *(const LAS bf16x8*)(Lrt + off);
            nD = __builtin_amdgcn_mfma_f32_16x16x32_bf16(fa, fb, nD, 0, 0, 0);
            makD = __builtin_amdgcn_mfma_f32_16x16x32_bf16(fa, fk, makD, 0, 0, 0);
            mbrD = __builtin_amdgcn_mfma_f32_16x16x32_bf16(fb, fr, mbrD, 0, 0, 0);
            mkrD = __builtin_amdgcn_mfma_f32_16x16x32_bf16(fk, fr, mkrD, 0, 0, 0);
        }
#pragma unroll
        for (int r = 0; r < 4; ++r) {
            const int row = 4 * g4 + r;
            nD[r] = (c16 < row) ? nD[r] : 0.f; makD[r] = (c16 < row) ? makD[r] : 0.f;
            mbrD[r] = (row <= c16) ? mbrD[r] : 0.f; mkrD[r] = (row <= c16) ? mkrD[r] : 0.f;
            Lnf[row * 17 + c16] = nD[r];
        }
        asm volatile("s_waitcnt lgkmcnt(0)" ::: "memory");
        float x[16];
#pragma unroll
        for (int t = 0; t < 16; ++t) {
            float acc = (t == c16) ? 1.f : 0.f;
#pragma unroll
            for (int i = 0; i < t; ++i) acc += Lnf[t * 17 + i] * x[i];
            x[t] = acc;
        }
        if (g4 == 0) {
#pragma unroll
            for (int t = 0; t < 16; ++t) *(LAS bf16_t*)(Lx + t * 32 + c16 * 2) = (bf16_t)f2bf(x[t]);
        }
        asm volatile("s_waitcnt lgkmcnt(0)" ::: "memory");
        const bf16x8 xB = frag4(*(const LAS u32x2*)(Lx + c16 * 32 + g4 * 8));
        const f32x4 z4 = {0.f, 0.f, 0.f, 0.f};
        const f32x4 gD = __builtin_amdgcn_mfma_f32_16x16x32_bf16(frag4(pack4(makD)), xB, z4, 0, 0, 0);
        *(u32x2*)(rec + R_G + (c16 * 16 + 4 * g4) * 2) = pack4(gD);
        *(u32x2*)(rec + R_MBR + (c16 * 16 + 4 * g4) * 2) = pack4(mbrD);
        *(u32x2*)(rec + R_MKR + (c16 * 16 + 4 * g4) * 2) = pack4(mkrD);
        {
            const int trow = c16 >> 2, tcol = 4 * (c16 & 3);
            u32x2 ta[4], tb[4], tk[4], tv[4];
#pragma unroll
            for (int m = 0; m < 4; ++m) {
                const int aA = (int)(uintptr_t)(Lat + (4 * g4 + trow) * RS + (16 * m + tcol) * 2);
                const int offr = (4 * m + trow) * RS + (16 * g4 + tcol) * 2;
                const int aB = (int)(uintptr_t)(Lbt + offr), aK = (int)(uintptr_t)(Lkt + offr), aV = (int)(uintptr_t)(Lvt + offr);
                WKV_TR(ta[m], aA); WKV_TR(tb[m], aB); WKV_TR(tk[m], aK); WKV_TR(tv[m], aV);
            }
            asm volatile("s_waitcnt lgkmcnt(0)" ::: "memory"); __builtin_amdgcn_sched_barrier(0);
#pragma unroll
            for (int m = 0; m < 4; ++m) {
                const f32x4 d = __builtin_amdgcn_mfma_f32_16x16x32_bf16(frag4(ta[m]), xB, z4, 0, 0, 0);
                *(u32x2*)(rec + R_A2 + (c16 * 64 + 16 * m + 4 * g4) * 2) = pack4(d);
            }
            const int kch = 16 * g4 + c16;
            *(u32x4*)(rec + R_BT + kch * 32) = (u32x4){tb[0].x, tb[0].y, tb[1].x, tb[1].y}; *(u32x4*)(rec + R_BT + kch * 32 + 16) = (u32x4){tb[2].x, tb[2].y, tb[3].x, tb[3].y};
            *(u32x4*)(rec + R_KT + kch * 32) = (u32x4){tk[0].x, tk[0].y, tk[1].x, tk[1].y}; *(u32x4*)(rec + R_KT + kch * 32 + 16) = (u32x4){tk[2].x, tk[2].y, tk[3].x, tk[3].y};
            *(u32x4*)(rec + R_VT + kch * 32) = (u32x4){tv[0].x, tv[0].y, tv[1].x, tv[1].y}; *(u32x4*)(rec + R_VT + kch * 32 + 16) = (u32x4){tv[2].x, tv[2].y, tv[3].x, tv[3].y};
        }
        { const int row = lane >> 2, cb = (lane & 3) * 16;
          const u32x4 r0 = *(const LAS u32x4*)(Lrt + row * RS + cb * 2), r1 = *(const LAS u32x4*)(Lrt + row * RS + cb * 2 + 16);
          *(u32x4*)(rec + R_RT + (row * 64 + cb) * 2) = r0; *(u32x4*)(rec + R_RT + (row * 64 + cb) * 2 + 16) = r1; }
        asm volatile("s_waitcnt lgkmcnt(0)" ::: "memory");
    }
#undef UNPK16
#undef PK16ST
}
constexpr int WKV_D = 6, WKV_R = WKV_D + 2;
__device__ __forceinline__ void ph_wkv_scan(const Args& A, LAS unsigned char* lds, int bid, int nb) {
    unsigned char* ws = opq(A.ws);
    const int tid = tid_opaque(), lane = tid & 63, wid = __builtin_amdgcn_readfirstlane(tid >> 6), c16 = lane & 15, g4 = lane >> 4;
    float* YS = (float*)(ws + WS_YS); const size_t FS = (size_t)NTOK * 512;
    for (int inst = bid; inst < 256; inst += nb) {
        const int dir = inst & 1, h = (inst >> 1) & 7, b = inst >> 4;
        const unsigned char* rec0 = ws + WS_WKV + (size_t)inst * WKV_NCH * WKV_REC;
        asm volatile("s_waitcnt vmcnt(0) lgkmcnt(0)" ::: "memory"); __builtin_amdgcn_s_barrier();
        if (wid >= 4) {
            const int p0 = 3 * (wid - 4);
#define WKV_ISSUE(c_) do { const unsigned char* src_ = rec0 + (size_t)(c_) * WKV_REC + p0 * 1024 + lane * 16; LAS unsigned char* dst_ = lds + ((c_) % WKV_R) * WKV_REC + p0 * 1024; \
        _Pragma("unroll") for (int i_ = 0; i_ < 3; ++i_) __builtin_amdgcn_global_load_lds((const unsigned*)(src_ + i_ * 1024), (LAS unsigned*)(dst_ + i_ * 1024), 16, 0, 0); } while (0)
            for (int c = 0; c < WKV_D; ++c) WKV_ISSUE(c);
            for (int c = 0; c < WKV_NCH; ++c) {
                if (c + WKV_D < WKV_NCH) { WKV_ISSUE(c + WKV_D); asm volatile("s_waitcnt vmcnt(18)" ::: "memory"); }
                else asm volatile("s_waitcnt vmcnt(0)" ::: "memory");
                __builtin_amdgcn_s_barrier();
            }
#undef WKV_ISSUE
        } else {
            const int v0 = wid * 16;
            float* Y = YS + dir * FS + h * 64 + v0 + c16;
            f32x4 S[4];
#pragma unroll
            for (int mt = 0; mt < 4; ++mt) S[mt] = (f32x4){0.f, 0.f, 0.f, 0.f};
            for (int c = 0; c < WKV_NCH; ++c) {
                __builtin_amdgcn_s_barrier();
                const LAS unsigned char* rec = lds + (c % WKV_R) * WKV_REC;
                u32x2 a2[4], rt[4], bt[4], kt[4]; f32x4 p[4];
#pragma unroll
                for (int q = 0; q < 4; ++q) {
                    a2[q] = *(const LAS u32x2*)(rec + R_A2 + (c16 * 64 + 16 * q + 4 * g4) * 2);
                    rt[q] = *(const LAS u32x2*)(rec + R_RT + (c16 * 64 + 16 * q + 4 * g4) * 2);
                    bt[q] = *(const LAS u32x2*)(rec + R_BT + ((16 * q + c16) * 16 + 4 * g4) * 2);
                    kt[q] = *(const LAS u32x2*)(rec + R_KT + ((16 * q + c16) * 16 + 4 * g4) * 2);
                    p[q] = *(const LAS f32x4*)(rec + R_P + (16 * q + 4 * g4) * 4);
                }
                const u32x2 gq = *(const LAS u32x2*)(rec + R_G + (c16 * 16 + 4 * g4) * 2), mkr = *(const LAS u32x2*)(rec + R_MKR + (c16 * 16 + 4 * g4) * 2), mbr = *(const LAS u32x2*)(rec + R_MBR + (c16 * 16 + 4 * g4) * 2);
                const u32x2 vt = *(const LAS u32x2*)(rec + R_VT + ((v0 + c16) * 16 + 4 * g4) * 2);
                const f32x4 z4 = {0.f, 0.f, 0.f, 0.f};
                const bf16x8 sb0 = frag8(pack4(S[0]), pack4(S[1])), sb1 = frag8(pack4(S[2]), pack4(S[3]));
                const bf16x8 vb = frag4(vt);
                f32x4 U = __builtin_amdgcn_mfma_f32_16x16x32_bf16(frag4(gq), vb, z4, 0, 0, 0);
                U = __builtin_amdgcn_mfma_f32_16x16x32_bf16(frag8(a2[0], a2[1]), sb0, U, 0, 0, 0);
                U = __builtin_amdgcn_mfma_f32_16x16x32_bf16(frag8(a2[2], a2[3]), sb1, U, 0, 0, 0);
                f32x4 Yt = __builtin_amdgcn_mfma_f32_16x16x32_bf16(frag4(mkr), vb, z4, 0, 0, 0);
                Yt = __builtin_amdgcn_mfma_f32_16x16x32_bf16(frag8(rt[0], rt[1]), sb0, Yt, 0, 0, 0);
                Yt = __builtin_amdgcn_mfma_f32_16x16x32_bf16(frag8(rt[2], rt[3]), sb1, Yt, 0, 0, 0);
                const bf16x8 ub = frag4(pack4(U));
                Yt = __builtin_amdgcn_mfma_f32_16x16x32_bf16(frag4(mbr), ub, Yt, 0, 0, 0);
#pragma unroll
                for (int mt = 0; mt < 4; ++mt) {
                    f32x4 sn = __builtin_amdgcn_mfma_f32_16x16x32_bf16(frag4(kt[mt]), vb, S[mt], 0, 0, 0);
                    sn = __builtin_amdgcn_mfma_f32_16x16x32_bf16(frag4(bt[mt]), ub, sn, 0, 0, 0);
                    S[mt] = sn * p[mt];
                }
#pragma unroll
                for (int r = 0; r < 4; ++r) Y[(size_t)wkv_token(b, dir, c * 16 + 4 * g4 + r) * 512] = Yt[r];
            }
        }
    }
}

__device__ __forceinline__ void ph_qk(const Args& A, int j, int row_lo, int bid, int nb) {
    unsigned char* ws = opq(A.ws); const float* const* IN = (const float* const*)(ws + WS_PTRS);
    const int tid = tid_opaque(), lane = tid & 63, wid = tid >> 6;
    const bf16_t* Z = (const bf16_t*)(ws + WS_Z);
    bf16_t* QB = (bf16_t*)(ws + WS_QB); bf16_t* KB = (bf16_t*)(ws + WS_KB); bf16_t* VB = (bf16_t*)(ws + WS_VB);
    const int d0 = (lane & 7) * 8;
    float qn[8], kn[8], invf[8];
#pragma unroll
    for (int i = 0; i < 8; ++i) { qn[i] = INP(I_QN)[j * 64 + d0 + i]; kn[i] = INP(I_KN)[j * 64 + d0 + i]; invf[i] = __powf(10000.0f, -(float)((d0 + i) & 15) / 16.0f); }
    const bool upper = (d0 & 16) != 0, colaxis = (d0 & 32) != 0;
    for (int g = row_lo + bid * NWAVES + wid; g < NTOK; g += nb * NWAVES) {
        const Tok tk = tokinfo(g);
        const size_t krow = (size_t)tk.b * (TC + TL) + (tk.T == TL ? TC + tk.t : tk.t);
        const bf16_t* zr = Z + (size_t)g * ZLD + RWC;
        *(u32x4*)(VB + krow * 512 + lane * 8) = *(const u32x4*)(zr + 1024 + lane * 8);
        float cs[8], sn[8];
        if (tk.T == TL) {
            const float pos = (float)(colaxis ? (tk.t & 63) : (tk.t >> 6));
#pragma unroll
            for (int i = 0; i < 8; ++i) __sincosf(pos * invf[i], &sn[i], &cs[i]);
        }
#pragma unroll
        for (int isk = 0; isk < 2; ++isk) {
            const u32x4 raw = *(const u32x4*)(zr + isk * 512 + lane * 8);
            float x[8];
#pragma unroll
            for (int i = 0; i < 4; ++i) { x[2 * i] = __builtin_bit_cast(float, raw[i] << 16); x[2 * i + 1] = __builtin_bit_cast(float, raw[i] & 0xffff0000u); }
            float ss = 0.f;
#pragma unroll
            for (int i = 0; i < 8; ++i) ss += x[i] * x[i];
            ss += __shfl_xor(ss, 1); ss += __shfl_xor(ss, 2); ss += __shfl_xor(ss, 4);
            const float rs = rsqrtf(ss * (1.0f / 64.0f) + 1e-6f);
#pragma unroll
            for (int i = 0; i < 8; ++i) x[i] = x[i] * rs * (isk ? kn[i] : qn[i]);
            if (tk.T == TL) {
#pragma unroll
                for (int i = 0; i < 8; ++i) { const float other = __shfl_xor(x[i], 2); x[i] = upper ? (x[i] * cs[i] + other * sn[i]) : (x[i] * cs[i] - other * sn[i]); }
            }
            u32x4 o; o.x = pk2(x[0], x[1]); o.y = pk2(x[2], x[3]); o.z = pk2(x[4], x[5]); o.w = pk2(x[6], x[7]);
            if (isk) *(u32x4*)(KB + krow * 512 + lane * 8) = o; else *(u32x4*)(QB + (size_t)g * 512 + lane * 8) = o;
        }
    }
}

__device__ __forceinline__ void ph_attn(const Args& A, bool want_ctx, LAS unsigned char* lds, int bid, int nb) {
    unsigned char* ws = opq(A.ws);
    const bf16_t* QB = (const bf16_t*)(ws + WS_QB); const bf16_t* KB = (const bf16_t*)(ws + WS_KB); const bf16_t* VB = (const bf16_t*)(ws + WS_VB);
    float* OP = (float*)(ws + WS_OP);
    const int vcu = (nb % 8 == 0) ? (bid % 8) * (nb / 8) + bid / 8 : bid;
    const int nunits = 1024 + (want_ctx ? 128 : 0);
    for (int u = vcu; u < nunits; u += nb) {
        int b, h, m, q0, seq;
        if (u < 1024) { const int qb = u & 7; m = (u >> 3) & 1; h = (u >> 4) & 3; b = u >> 6; q0 = NCTX + b * TL + qb * 256; seq = TC + TL; }
        else { const int v = u - 1024; m = v & 1; h = (v >> 1) & 3; b = v >> 3; q0 = b * TC; seq = TC; }
        const int s = h * 2 + m;
        att::attn_body(QB + (size_t)q0 * 512 + s * 64, KB + (size_t)b * (TC + TL) * 512 + s * 64, VB + (size_t)b * (TC + TL) * 512 + h * 128,
                       OP + (size_t)m * NTOK * 512 + (size_t)q0 * 512 + h * 128, seq, lds);
    }
}

__device__ __forceinline__ void ph_merge(const Args& A, int l, int row_lo, int bid, int nb) {
    unsigned char* ws = opq(A.ws); const float* const* IN = (const float* const*)(ws + WS_PTRS);
    const int j = l >> 1;
    const int tid = tid_opaque(), lane = tid & 63, wid = tid >> 6, c0 = lane * 8;
    const float lam_init = 0.8f - 0.6f * __expf(-0.3f * (float)l);
    const float* lp = INP(I_LAM) + j * 4 * 64;
    const float lam = __expf(wave_sum(lp[lane] * lp[64 + lane])) - __expf(wave_sum(lp[128 + lane] * lp[192 + lane])) + lam_init;
    const size_t FS = (size_t)NTOK * 512;
    const bf16_t* RB = (const bf16_t*)(ws + WS_RB); const bf16_t* KS = (const bf16_t*)(ws + WS_KS); const bf16_t* VS = (const bf16_t*)(ws + WS_VS);
    const bf16_t* AB = (const bf16_t*)(ws + WS_AB); const bf16_t* GB = (const bf16_t*)(ws + WS_GB);
    const float* YS = (const float*)(ws + WS_YS); const float* OP = (const float*)(ws + WS_OP);
    bf16_t* CAT = (bf16_t*)(ws + WS_CAT);
    float gnw[8], gnb[8], kaw[8], rkw[8], sub[8];
#pragma unroll
    for (int i = 0; i < 8; ++i) { gnw[i] = INP(I_GNW)[j * 512 + c0 + i]; gnb[i] = INP(I_GNB)[j * 512 + c0 + i]; kaw[i] = INP(I_RWKA)[j * 512 + c0 + i]; rkw[i] = INP(I_RWRK)[j * 512 + c0 + i];
        sub[i] = INP(I_SUBLN)[j * 128 + ((c0 + i) & 127)] * (1.0f - lam_init); }
#define LD8BF(dst, ptr) do { const u32x4 _t = *(const u32x4*)(ptr); _Pragma("unroll") for (int _i = 0; _i < 4; ++_i) { dst[2 * _i] = __builtin_bit_cast(float, _t[_i] << 16); dst[2 * _i + 1] = __builtin_bit_cast(float, _t[_i] & 0xffff0000u); } } while (0)
    for (int g = row_lo + bid * NWAVES + wid; g < NTOK; g += nb * NWAVES) {
        const size_t o = (size_t)g * 512 + c0;
        float y[8], r_[8], k_[8], v_[8], a0[8], a1[8], gg[8];
        { const f32x4 y0 = *(const f32x4*)(YS + o), y1 = *(const f32x4*)(YS + o + 4), z0 = *(const f32x4*)(YS + FS + o), z1 = *(const f32x4*)(YS + FS + o + 4);
#pragma unroll
          for (int i = 0; i < 4; ++i) { y[i] = y0[i] + z0[i]; y[4 + i] = y1[i] + z1[i]; } }
        LD8BF(r_, RB + o); LD8BF(k_, KS + o); LD8BF(v_, VS + o); LD8BF(a0, AB + o); LD8BF(a1, AB + FS + o); LD8BF(gg, GB + o);
        float sy = 0.f, sb = 0.f;
#pragma unroll
        for (int i = 0; i < 8; ++i) { sy += y[i]; sb += r_[i] * k_[i] * (2.0f + (a0[i] + a1[i] - 2.0f) * kaw[i]) * rkw[i]; }
        sy += __shfl_xor(sy, 1); sy += __shfl_xor(sy, 2); sy += __shfl_xor(sy, 4);
        sb += __shfl_xor(sb, 1); sb += __shfl_xor(sb, 2); sb += __shfl_xor(sb, 4);
        const float mu = sy * (1.0f / 64.0f);
        float sv = 0.f;
#pragma unroll
        for (int i = 0; i < 8; ++i) { y[i] -= mu; sv += y[i] * y[i]; }
        sv += __shfl_xor(sv, 1); sv += __shfl_xor(sv, 2); sv += __shfl_xor(sv, 4);
        const float rstd = rsqrtf(sv * (1.0f / 64.0f) + 64e-5f);
        float ya[8];
#pragma unroll
        for (int i = 0; i < 8; ++i) ya[i] = (y[i] * rstd * gnw[i] + gnb[i] + sb * v_[i]) * gg[i];
        { u32x4 w; w.x = pk2(ya[0], ya[1]); w.y = pk2(ya[2], ya[3]); w.z = pk2(ya[4], ya[5]); w.w = pk2(ya[6], ya[7]); *(u32x4*)(CAT + (size_t)g * DM + c0) = w; }
        float od[8];
        { const f32x4 p0 = *(const f32x4*)(OP + o), p1 = *(const f32x4*)(OP + o + 4), q0 = *(const f32x4*)(OP + FS + o), q1 = *(const f32x4*)(OP + FS + o + 4);
#pragma unroll
          for (int i = 0; i < 4; ++i) { od[i] = p0[i] - lam * q0[i]; od[4 + i] = p1[i] - lam * q1[i]; } }
        float so = 0.f;
#pragma unroll
        for (int i = 0; i < 8; ++i) so += od[i] * od[i];
        so += __shfl_xor(so, 1); so += __shfl_xor(so, 2); so += __shfl_xor(so, 4); so += __shfl_xor(so, 8);
        const float ro = rsqrtf(so * (1.0f / 128.0f) + 1e-6f);
        { u32x4 w; w.x = pk2(od[0] * ro * sub[0], od[1] * ro * sub[1]); w.y = pk2(od[2] * ro * sub[2], od[3] * ro * sub[3]);
          w.z = pk2(od[4] * ro * sub[4], od[5] * ro * sub[5]); w.w = pk2(od[6] * ro * sub[6], od[7] * ro * sub[7]); *(u32x4*)(CAT + (size_t)g * DM + 512 + c0) = w; }
    }
#undef LD8BF
}

__device__ __forceinline__ void ph_gemm_out(const Args& A, int l, size_t x_off, size_t wt_off, int row_lo, LAS unsigned char* lds, int bid, int nb) {
    unsigned char* ws = opq(A.ws); const float* const* IN = (const float* const*)(ws + WS_PTRS); (void)IN;
    pg8::Gemm g{(const bf16_t*)(ws + x_off) + (size_t)row_lo * DM, (const bf16_t*)(ws + wt_off), NTOK - row_lo, DM, DM};
    const ListOrder S = build_units(lds, (NTOK - row_lo) / 256, DM / 256, nb, bid, nullptr, 0);
    EpiResidual E{(float*)(ws + WS_H) + (size_t)row_lo * DM, (const float*)(ws + WS_MOD) + (size_t)l * 17 * 6144 + 2 * 1024, row_lo};
    pg8::gemm_phase<EpiResidual, ListOrder, true, true>(lds, g, S, E);
}

__device__ __forceinline__ void ph_gemm_sgin(const Args& A, int j, int row_lo, LAS unsigned char* lds, int bid, int nb) {
    unsigned char* ws = opq(A.ws); const float* const* IN = (const float* const*)(ws + WS_PTRS); (void)IN;
    pg8::Gemm g{(const bf16_t*)(ws + WS_ABF) + (size_t)row_lo * DM, (const bf16_t*)(ws + WS_SGIN) + (size_t)j * 2048 * DM, NTOK - row_lo, 2048, DM};
    const ListOrder S = build_units(lds, (NTOK - row_lo) / 256, 2048 / 256, nb, bid, nullptr, 0);
    EpiGeluBf16 E{(bf16_t*)(ws + WS_Z2) + (size_t)row_lo * 2048, 2048, INP(I_SGBIN) + j * 2048};
    pg8::gemm_phase<EpiGeluBf16, ListOrder, true, true>(lds, g, S, E);
}
__device__ __forceinline__ void ph_sgu_stats(const Args& A, int row_lo, int bid, int nb) {
    unsigned char* ws = opq(A.ws);
    const int tid = tid_opaque(), lane = tid & 63, wid = tid >> 6;
    const bf16_t* Z2 = (const bf16_t*)(ws + WS_Z2); float* ST = (float*)(ws + WS_VST);
    for (int row = row_lo + bid * NWAVES + wid; row < NTOK; row += nb * NWAVES) {
        const u32x4 t0 = *(const u32x4*)(Z2 + (size_t)row * 2048 + 1024 + lane * 8), t1 = *(const u32x4*)(Z2 + (size_t)row * 2048 + 1536 + lane * 8);
        float v[16]; float s = 0.f;
#pragma unroll
        for (int i = 0; i < 4; ++i) { v[2 * i] = __builtin_bit_cast(float, t0[i] << 16); v[2 * i + 1] = __builtin_bit_cast(float, t0[i] & 0xffff0000u);
            v[8 + 2 * i] = __builtin_bit_cast(float, t1[i] << 16); v[9 + 2 * i] = __builtin_bit_cast(float, t1[i] & 0xffff0000u); }
#pragma unroll
        for (int i = 0; i < 16; ++i) s += v[i];
        const float mean = wave_sum(s) * (1.0f / 1024.0f); float s2 = 0.f;
#pragma unroll
        for (int i = 0; i < 16; ++i) { const float d = v[i] - mean; s2 += d * d; }
        const float rstd = rsqrtf(wave_sum(s2) * (1.0f / 1024.0f) + 1e-5f);
        if (lane == 0) { ST[(size_t)row * 2] = mean; ST[(size_t)row * 2 + 1] = rstd; }
    }
}
__device__ __forceinline__ void ph_sgu_spatial(const Args& A, int j, int row_lo, LAS unsigned char* lds, int bid, int nb) {
    unsigned char* ws = opq(A.ws); const float* const* IN = (const float* const*)(ws + WS_PTRS);
    const int tid = tid_opaque(), lane = tid & 63, wid = tid >> 6, c16 = lane & 15, g4 = lane >> 4;
    const bf16_t* Z2 = (const bf16_t*)(ws + WS_Z2); const float* ST = (const float*)(ws + WS_VST); bf16_t* G = (bf16_t*)(ws + WS_G);
    constexpr int VS = 272;
    LAS unsigned char* vt = lds;
    LAS float* stl = (LAS float*)(lds + 36864);
    const int ch0 = row_lo / 128, nch = NTOK / 128 - ch0;
    for (int u = bid; u < nch * 8; u += nb) {
        const int ci = ch0 + u / 8, g = u % 8;
        const size_t r0 = (size_t)ci * 128;
        __syncthreads();
#pragma unroll
        for (int i = 0; i < 4; ++i) {
            const int idx = tid + NTHREADS * i, q = idx >> 4, jc = idx & 15;
            const u32x4 t = *(const u32x4*)(Z2 + (r0 + q) * 2048 + 1024 + g * 128 + jc * 8);
#pragma unroll
            for (int e = 0; e < 4; ++e) { *(LAS bf16_t*)(vt + (jc * 8 + 2 * e) * VS + q * 2) = (bf16_t)(t[e] & 0xffffu); *(LAS bf16_t*)(vt + (jc * 8 + 2 * e + 1) * VS + q * 2) = (bf16_t)(t[e] >> 16); }
        }
        if (tid < 256) stl[tid] = ST[r0 * 2 + tid];
        __syncthreads();
        const float* wrow = INP(I_SGWS) + (((size_t)j * 8 + g) * 128 + 16 * wid + c16) * 128;
        bf16x8 af[4]; float wm = 0.f, rs = 0.f;
#pragma unroll
        for (int ks = 0; ks < 4; ++ks) {
            const int q0 = 32 * ks + 8 * g4;
            const f32x4 w0 = *(const f32x4*)(wrow + q0), w1 = *(const f32x4*)(wrow + q0 + 4);
            float wv[8] = {w0[0], w0[1], w0[2], w0[3], w1[0], w1[1], w1[2], w1[3]};
#pragma unroll
            for (int e = 0; e < 8; ++e) { rs += wv[e]; wv[e] *= stl[(q0 + e) * 2 + 1]; wm += wv[e] * stl[(q0 + e) * 2]; }
            const u32x4 pk = {pk2(wv[0], wv[1]), pk2(wv[2], wv[3]), pk2(wv[4], wv[5]), pk2(wv[6], wv[7])};
            af[ks] = __builtin_bit_cast(bf16x8, pk);
        }
        wm += __shfl_xor(wm, 16); wm += __shfl_xor(wm, 32); rs += __shfl_xor(rs, 16); rs += __shfl_xor(rs, 32);
        f32x4 acc[8];
#pragma unroll
        for (int nt = 0; nt < 8; ++nt) acc[nt] = (f32x4){0.f, 0.f, 0.f, 0.f};
#pragma unroll
        for (int ks = 0; ks < 4; ++ks)
#pragma unroll
            for (int nt = 0; nt < 8; ++nt) {
                const bf16x8 bfr = *(const LAS bf16x8*)(vt + (16 * nt + c16) * VS + (32 * ks + 8 * g4) * 2);
                acc[nt] = __builtin_amdgcn_mfma_f32_16x16x32_bf16(af[ks], bfr, acc[nt], 0, 0, 0);
            }
        float wmr[4], rsr[4], bsr[4];
#pragma unroll
        for (int r = 0; r < 4; ++r) { wmr[r] = __shfl(wm, 4 * g4 + r); rsr[r] = __shfl(rs, 4 * g4 + r); bsr[r] = INP(I_SGBS)[((size_t)j * 8 + g) * 128 + 16 * wid + 4 * g4 + r]; }
#pragma unroll
        for (int nt = 0; nt < 8; ++nt) {
            const int c = g * 128 + 16 * nt + c16;
            const float lg = INP(I_SGLNG)[j * 1024 + c], lb = INP(I_SGLNB)[j * 1024 + c];
#pragma unroll
            for (int r = 0; r < 4; ++r) {
                const size_t row = r0 + 16 * wid + 4 * g4 + r;
                const float sv = lg * (acc[nt][r] - wmr[r]) + rsr[r] * lb + bsr[r];
                G[row * DM + c] = (bf16_t)f2bf(bf2f(Z2[row * 2048 + c]) * sv);
            }
        }
    }
}

__device__ __forceinline__ int moe_layout(const Args& A, int l, int bid, int nb, LAS int* off  , LAS int* cntl  , LAS int* tile_e  , LAS int* base  ) {
    const int tid = tid_opaque();
    const int* bc = (const int*)(opq(A.ws) + WS_BCNT) + (size_t)l * 256 * 32;
    if (tid < 64) {
        int n = 0, pre = 0;
        if (tid < 32) {
#pragma unroll 8
            for (int b = 0; b < nb; ++b) { const int c = bc[b * 32 + tid]; n += c; pre += (b < bid) ? c : 0; }
        }
        const int nt = (n + 255) >> 8;
        int x = nt;
#pragma unroll
        for (int o = 1; o < 32; o <<= 1) { const int y = __shfl_up(x, o); if (tid >= o) x += y; }
        const int start = x - nt;
        if (tid < 32) {
            cntl[tid] = n; off[tid] = start * 256; base[tid] = start * 256 + pre;
#pragma unroll 1
            for (int t = 0; t < nt; ++t) tile_e[start + t] = tid;
        }
        if (tid == 31) off[32] = x * 256;
    }
    __syncthreads();
    return off[32] >> 8;
}
__device__ __forceinline__ void ph_moe_scatter(const Args& A, int l, int row_lo, LAS unsigned char* lds, int bid, int nb) {
    unsigned char* ws = opq(A.ws);
    const int tid = tid_opaque();
    LAS int* off = (LAS int*)(lds + LDS_TAB); LAS int* cntl = off + 64; LAS int* tile_e = off + 128; LAS int* base = off + 800;
    moe_layout(A, l, bid, nb, off, cntl, tile_e, base);
    const int* te = (const int*)(ws + WS_TOKE); const int* tr = (const int*)(ws + WS_TOKR); int* rowof = (int*)(ws + WS_ROWOF); int* srcrow = (int*)(ws + WS_SRCROW);
    const int ngroups = (NTOK - row_lo) / 16, per = nb * NWAVES;
    const int nmine = (ngroups - bid * NWAVES + per - 1) / per * NWAVES;
    for (int q = tid; q < nmine * 64; q += NTHREADS) {
        const int slot = q >> 6, r = (q >> 2) & 15, k = q & 3, i = slot >> 3, w = slot & 7;
        const int u = i * per + bid * NWAVES + w;
        if (u < ngroups) {
            const int row = row_lo + 16 * u + r;
            const int e = te[(size_t)row * 4 + k];
            const int pos = base[e] + tr[(size_t)row * 4 + k];
            rowof[(size_t)row * 4 + k] = pos; srcrow[pos] = row;
        }
    }
    for (int e = bid; e < 32; e += nb) {
        const int r0 = off[e] + cntl[e], r1 = off[e + 1];
        for (int i = r0 + tid; i < r1; i += NTHREADS) srcrow[i] = NCTX;
    }
}
__device__ __forceinline__ void ph_moe_gemm1(const Args& A, int l, LAS unsigned char* lds, int bid, int nb) {
    unsigned char* ws = opq(A.ws); const float* const* IN = (const float* const*)(ws + WS_PTRS); (void)IN;
    LAS int* off = (LAS int*)(lds + LDS_TAB); LAS int* cntl = off + 64; LAS int* tile_e = off + 128; LAS int* base = off + 800;
    const int T = moe_layout(A, l, bid, nb, off, cntl, tile_e, base);
    pg8::Gemm g{(const bf16_t*)(ws + WS_ABF), (const bf16_t*)(ws + WS_W1) + (size_t)l * NE * 2048 * DM, T * 256, 2048, DM};
    const ListOrder S = build_units(lds, T, 8, nb, bid, tile_e, 8);
    { LAS unsigned* rowtab = (LAS unsigned*)(lds + LDS_ROWTAB); const int* srcrow = (const int*)(ws + WS_SRCROW); const int tid = tid_opaque();
      for (int q = tid; q < S.n * 256; q += NTHREADS) rowtab[q] = (unsigned)srcrow[S.list[2 * (q >> 8)] * 256 + (q & 255)] * (unsigned)(DM * 2);
      __syncthreads(); }
    EpiMoe1 E{(bf16_t*)(ws + WS_ACT), INP(I_B1) + (size_t)l * NE * 2048};
    pg8::gemm_phase<EpiMoe1, ListOrder, true, true, true>(lds, g, S, E);
}
__device__ __forceinline__ void ph_moe_gemm2(const Args& A, int l, LAS unsigned char* lds, int bid, int nb) {
    unsigned char* ws = opq(A.ws); const float* const* IN = (const float* const*)(ws + WS_PTRS); (void)IN;
    LAS int* off = (LAS int*)(lds + LDS_TAB); LAS int* cntl = off + 64; LAS int* tile_e = off + 128; LAS int* base = off + 800;
    const int T = moe_layout(A, l, bid, nb, off, cntl, tile_e, base);
    pg8::Gemm g{(const bf16_t*)(ws + WS_ACT), (const bf16_t*)(ws + WS_W2) + (size_t)l * NE * DM * DM, T * 256, DM, DM};
    const ListOrder S = build_units(lds, T, 4, nb, bid, tile_e, 4);
    EpiMoe2 E{(bf16_t*)(ws + WS_YM), INP(I_B2) + (size_t)l * NE * DM};
    pg8::gemm_phase<EpiMoe2, ListOrder, true, true>(lds, g, S, E);
}
__device__ __forceinline__ void ph_moe_combine(const Args& A, int l, int row_lo, bool last, int bid, int nb, bool dry = false) {
    unsigned char* ws = opq(A.ws); const float* const* IN = (const float* const*)(ws + WS_PTRS);
    const int tid = tid_opaque(), lane = tid & 63, wid = tid >> 6;
    float* H = (float*)(ws + WS_H); const float* mod = (const float*)(ws + WS_MOD); const bf16_t* YM = (const bf16_t*)(ws + WS_YM);
    float* Hw = dry ? (float*)(ws + WS_XP) : H;
    const int* rowof = (const int*)(ws + WS_ROWOF); const float* tg = (const float*)(ws + WS_TOKG);
    bf16_t* abf = dry ? (bf16_t*)(ws + WS_XP + (size_t)NTOK * DM * 4) : (bf16_t*)(ws + WS_ABF);
    const int ln = last ? l : l + 1;
    const float* gp = INP(I_N1G) + ln * 1024;
    for (int row = row_lo + bid * NWAVES + wid; row < NTOK; row += nb * NWAVES) {
        const Tok tk = tokinfo(row);
        const float* gate = mod + ((size_t)l * 17 + tk.modrow) * 6144 + 5 * 1024;
        int r[4]; float gk[4];
#pragma unroll
        for (int k = 0; k < 4; ++k) { r[k] = rowof[(size_t)row * 4 + k]; gk[k] = tg[(size_t)row * 4 + k]; }
        f32x4 hv[4]; float ss = 0.f;
#pragma unroll
        for (int q = 0; q < 4; ++q) {
            const int col = q * 256 + lane * 4;
            f32x4 m = (f32x4){0.f, 0.f, 0.f, 0.f};
#pragma unroll
            for (int k = 0; k < 4; ++k) { const u32x2 t = *(const u32x2*)(YM + (size_t)r[k] * DM + col);
                m = m + (f32x4){__builtin_bit_cast(float, t.x << 16), __builtin_bit_cast(float, t.x & 0xffff0000u), __builtin_bit_cast(float, t.y << 16), __builtin_bit_cast(float, t.y & 0xffff0000u)} * gk[k]; }
            hv[q] = *(const f32x4*)(H + (size_t)row * DM + col) + *(const f32x4*)(gate + col) * m;
            if (last && !dry) *(f32x4*)(as_global(((float* const*)IN)[38]) + (size_t)(row - NCTX) * DM + col) = hv[q];
            else *(f32x4*)(Hw + (size_t)row * DM + col) = hv[q];
            ss += (hv[q].x * hv[q].x + hv[q].y * hv[q].y) + (hv[q].z * hv[q].z + hv[q].w * hv[q].w);
        }
        if (!last) {
            const float rstd = rsqrtf(wave_sum(ss) * (1.0f / DM) + 1e-6f);
            const float* mrow = mod + ((size_t)ln * 17 + tk.modrow) * 6144;
#pragma unroll
            for (int q = 0; q < 4; ++q) {
                const int col = q * 256 + lane * 4;
                const f32x4 g = *(const f32x4*)(gp + col), sc = *(const f32x4*)(mrow + 1024 + col), sh = *(const f32x4*)(mrow + col);
                const f32x4 v = (hv[q] * rstd * g) * (sc + 1.0f) + sh;
                u32x2 o; o.x = pk2(v.x, v.y); o.y = pk2(v.z, v.w);
                *(u32x2*)(abf + (size_t)row * DM + col) = o;
            }
        }
    }
}

__global__ void __launch_bounds__(NTHREADS, 2) fwd_kernel(Args A) {
    extern __shared__ __attribute__((aligned(16))) unsigned char lds_raw[];
    LAS unsigned char* lds = (LAS unsigned char*)lds_raw;
    volatile LAS unsigned* misc = (volatile LAS unsigned*)(lds + LDS_MISC);
    const int tid = threadIdx.x, bid = blockIdx.x, nb = gridDim.x;
    if (tid < 64) misc[tid] = 0u;
    __syncthreads();
    XcdBarrier bar = xcd_barrier_post((unsigned*)(A.ws + WS_CTL) + CW_BAR, misc + 8);
    const int lo = A.ph_lo, hi = A.ph_hi;
    int pc = 0;
#ifndef PHSEL
#define PHSEL -1
#endif
#define SEL(k) (PHSEL < 0 || PHSEL == (k))
#ifndef REPEAT_MASK
#define REPEAT_MASK 0
#endif
#define RUN(k, call) do { if (SEL(k)) { call; if ((REPEAT_MASK >> (k)) & 1) { xcd_barrier(bar); call; } } } while (0)
#define PH_BEGIN if (pc >= lo && pc < hi) {
#define PH_END } if (pc >= lo && pc + 1 < hi) xcd_barrier(bar); ++pc;

    PH_BEGIN RUN(0, ph_prologue(A, lds, bid, nb)); PH_END

    for (int l = 0; l < 4; ++l) {
        const int j = l >> 1;
        const bool ctx_out = (l < 2), ctx_in = (l < 3);
        const int rin = ctx_in ? 0 : NCTX, rout = ctx_out ? 0 : NCTX;
        if (l == 0) { PH_BEGIN RUN(1, ph_norm<false>(A, l, rin, lds, bid, nb)); PH_END }
        if ((l & 1) == 0) {
            PH_BEGIN RUN(2, ph_gemm_win(A, j, rin, lds, bid, nb)); PH_END
            PH_BEGIN RUN(3, ph_rwkv_pre(A, j, rin, bid, nb)); RUN(4, ph_qk(A, j, rin, bid, nb)); PH_END
            PH_BEGIN RUN(19, ph_gemm_lora(A, j, rin, lds, bid, nb)); PH_END
            PH_BEGIN RUN(18, ph_wkv_prep(A, j, lds, bid, nb)); PH_END
            PH_BEGIN RUN(5, ph_wkv_scan(A, lds, bid, nb)); PH_END
            PH_BEGIN RUN(6, ph_attn(A, ctx_out, lds, bid, nb)); PH_END
            PH_BEGIN RUN(7, ph_merge(A, l, rout, bid, nb)); PH_END
            PH_BEGIN RUN(8, ph_gemm_out(A, l, WS_CAT, WS_WOUT + (size_t)j * DM * DM * 2, rout, lds, bid, nb)); PH_END
        } else {
            PH_BEGIN RUN(9, ph_gemm_sgin(A, j, rin, lds, bid, nb)); PH_END
            PH_BEGIN RUN(10, ph_sgu_stats(A, rin, bid, nb)); PH_END
            PH_BEGIN RUN(11, ph_sgu_spatial(A, j, rout, lds, bid, nb)); PH_END
            PH_BEGIN RUN(12, ph_gemm_out(A, l, WS_G, WS_SGOUT + (size_t)j * DM * DM * 2, rout, lds, bid, nb)); PH_END
        }
        PH_BEGIN RUN(13, ph_norm2_router(A, l, rout, lds, bid, nb)); PH_END
        PH_BEGIN RUN(14, ph_moe_scatter(A, l, rout, lds, bid, nb)); PH_END
        PH_BEGIN RUN(15, ph_moe_gemm1(A, l, lds, bid, nb)); PH_END
        PH_BEGIN RUN(16, ph_moe_gemm2(A, l, lds, bid, nb)); PH_END
        PH_BEGIN if (SEL(17)) { if ((REPEAT_MASK >> 17) & 1) { ph_moe_combine(A, l, rout, l == 3, bid, nb, true); xcd_barrier(bar); } ph_moe_combine(A, l, rout, l == 3, bid, nb); } PH_END
    }
}

extern "C" void kernel_launch(void* const* d_in, const int* in_sizes, int n_in, void* d_out, int out_size, void* d_ws, size_t ws_size, hipStream_t stream) {
    static int grid = 0;
    if (grid == 0) {
        if (n_in != 38 || out_size != NLAT * DM || ws_size < WS_END) { fprintf(stderr, "kernel_launch: unexpected shapes: n_in %d out %d ws %zu (need %zu)\n", n_in, out_size, ws_size, (size_t)WS_END); grid = -1; return; }
        int dev = 0, cus = 0, per_cu = 0;
        if (hipGetDevice(&dev) != hipSuccess || hipDeviceGetAttribute(&cus, hipDeviceAttributeMultiprocessorCount, dev) != hipSuccess) { grid = -1; return; }
        if (hipFuncSetAttribute((const void*)fwd_kernel, hipFuncAttributeMaxDynamicSharedMemorySize, LDS_BYTES) != hipSuccess) { fprintf(stderr, "kernel_launch: hipFuncSetAttribute failed\n"); grid = -1; return; }
        if (hipOccupancyMaxActiveBlocksPerMultiprocessor(&per_cu, (const void*)fwd_kernel, NTHREADS, LDS_BYTES) != hipSuccess || per_cu < 1)
            fprintf(stderr, "kernel_launch: occupancy query reports %d workgroups per CU\n", per_cu);
        (void)hipGetLastError();
        grid = cus;
    }
    if (grid < 0) return;
    if (hipMemsetAsync((char*)d_ws + WS_CTL, 0, CTL_ZERO_BYTES, stream) != hipSuccess) { fprintf(stderr, "kernel_launch: memset failed\n"); return; }
    Args a{};
    for (int i = 0; i < 38; ++i) a.in[i] = (const float*)d_in[i];
    a.out = (float*)d_out; a.ws = (unsigned char*)d_ws; a.ph_lo = 0; a.ph_hi = 1 << 20;
    hipLaunchKernelGGL(fwd_kernel, dim3(grid), dim3(NTHREADS), LDS_BYTES, stream, a);
    const hipError_t le = hipPeekAtLastError();
    if (le != hipSuccess) fprintf(stderr, "kernel_launch: launch failed: %s\n", hipGetErrorName(le));
}
```

```cpp
#include <hip/hip_runtime.h>
#include <cstdio>
#include <cstdint>

#define LAS __attribute__((address_space(3)))
typedef unsigned short bf16_t;
typedef short bf16x8 __attribute__((ext_vector_type(8)));
typedef float f32x4 __attribute__((ext_vector_type(4)));
typedef unsigned u32x4 __attribute__((ext_vector_type(4)));
typedef unsigned u32x2 __attribute__((ext_vector_type(2)));

constexpr int DM = 1024, NB = 16, TL = 2048, TC = 256;
constexpr int NCTX = NB * TC, NLAT = NB * TL, NTOK = NCTX + NLAT;
constexpr int RWC = 1920, EVC = 3456, ZLD = 3584;
constexpr int NE = 32;
constexpr int XPROWS = NTOK * 4 + NE * 256;
constexpr int NTHREADS = 512, NWAVES = 8;

constexpr size_t MiB = 1u << 20;
constexpr size_t al256(size_t x) { return (x + 255) & ~(size_t)255; }
constexpr size_t WS_CTL = 0, CTL_ZERO_BYTES = 1 * MiB - 4096;
constexpr size_t WS_PTRS = 1 * MiB - 4096;
constexpr size_t WS_MOD = 1 * MiB;
constexpr size_t WS_RTWT = al256(WS_MOD + (size_t)4 * 17 * 6144 * 4);
constexpr size_t WS_WIN = al256(WS_RTWT + (size_t)4 * 32 * 1024 * 4);
constexpr size_t WS_WOUT = al256(WS_WIN + (size_t)2 * ZLD * DM * 2);
constexpr size_t WS_SGIN = al256(WS_WOUT + (size_t)2 * DM * DM * 2);
constexpr size_t WS_SGOUT = al256(WS_SGIN + (size_t)2 * 2048 * DM * 2);
constexpr int LORA_N = 2560, LORA_K = 384;
constexpr size_t WS_WLORA = al256(WS_SGOUT + (size_t)2 * DM * DM * 2);
constexpr size_t WS_LBIAS = al256(WS_WLORA + (size_t)2 * LORA_N * LORA_K * 2);
constexpr size_t WS_W1 = al256(WS_LBIAS + (size_t)2 * LORA_N * 4);
constexpr size_t WS_W2 = al256(WS_W1 + (size_t)4 * NE * 2048 * DM * 2);
constexpr size_t WS_H = al256(WS_W2 + (size_t)4 * NE * DM * DM * 2);
constexpr size_t WS_ABF = al256(WS_H + (size_t)NTOK * DM * 4);
constexpr size_t WS_TOKE = al256(WS_ABF + (size_t)NTOK * DM * 2);
constexpr size_t WS_TOKG = al256(WS_TOKE + (size_t)NTOK * 4 * 4);
constexpr size_t WS_ROWOF = al256(WS_TOKG + (size_t)NTOK * 4 * 4);
constexpr size_t WS_TOKR = al256(WS_ROWOF + (size_t)NTOK * 4 * 4);
constexpr size_t WS_BCNT = al256(WS_TOKR + (size_t)NTOK * 4 * 4);
constexpr size_t WS_SRCROW = al256(WS_BCNT + (size_t)4 * 256 * 32 * 4);
constexpr size_t WS_R = al256(WS_SRCROW + (size_t)XPROWS * 4);
constexpr size_t FSZ = (size_t)NTOK * 512 * 4;
constexpr size_t WS_Z = WS_R;
constexpr size_t HSZ = (size_t)NTOK * 512 * 2;
constexpr size_t WS_RB = al256(WS_Z + (size_t)NTOK * ZLD * 2);
constexpr size_t WS_KS = WS_RB + HSZ, WS_VS = WS_KS + HSZ, WS_KKN = WS_VS + HSZ;
constexpr size_t WS_LIN = WS_KKN + HSZ;
constexpr size_t WS_LO = al256(WS_LIN + (size_t)NTOK * 384 * 2);
constexpr size_t WS_AB = WS_LO + 2 * HSZ;
constexpr size_t WS_GB = WS_LO + 4 * HSZ;
constexpr size_t WS_YS = WS_LO + 5 * HSZ;
constexpr size_t WS_QB = WS_YS + 2 * FSZ;
constexpr size_t WS_KB = WS_QB + FSZ / 2;
constexpr size_t WS_VB = WS_KB + FSZ / 2;
constexpr size_t WS_OP = WS_VB + FSZ / 2;
constexpr size_t WS_CAT = WS_OP + 2 * FSZ;
constexpr int WKV_REC = 12288, WKV_NCH = (TC + TL) / 16;
constexpr size_t WS_WKV = al256(WS_CAT + (size_t)NTOK * DM * 2);
constexpr size_t WS_EVEN_END = WS_WKV + (size_t)256 * WKV_NCH * WKV_REC;
constexpr size_t WS_Z2 = WS_R;
constexpr size_t WS_VST = al256(WS_Z2 + (size_t)NTOK * 2048 * 2);
constexpr size_t WS_G = al256(WS_VST + (size_t)NTOK * 2 * 4);
constexpr size_t WS_ODD_END = WS_G + (size_t)NTOK * DM * 2;
constexpr size_t WS_XP = WS_R;
constexpr size_t WS_ACT = al256(WS_XP + (size_t)XPROWS * DM * 2);
constexpr size_t WS_YM = al256(WS_ACT + (size_t)XPROWS * DM * 2);
constexpr size_t WS_MOE_END = WS_YM + (size_t)XPROWS * DM * 2;
constexpr size_t WS_END = (WS_EVEN_END > WS_MOE_END ? (WS_EVEN_END > WS_ODD_END ? WS_EVEN_END : WS_ODD_END) : (WS_MOE_END > WS_ODD_END ? WS_MOE_END : WS_ODD_END));

constexpr int CW_BAR = 4096;
constexpr int CW_CNT = 16384;
constexpr int CW_CUR = 16384 + 256;

constexpr int LDS_BYTES = 163840;
constexpr int LDS_MISC = 160 * 1024 - 256;

__device__ __forceinline__ unsigned f2bf(float f) { unsigned u = __builtin_bit_cast(unsigned, f); return (u + 0x7fffu + ((u >> 16) & 1u)) >> 16; }
__device__ __forceinline__ unsigned pk2(float lo, float hi) { return f2bf(lo) | (f2bf(hi) << 16); }
typedef float f32x2_t __attribute__((ext_vector_type(2))); typedef __bf16 bf16x2_t __attribute__((ext_vector_type(2)));
__device__ __forceinline__ unsigned cvtpk_s(float lo, float hi) { f32x2_t v = {lo, hi}; bf16x2_t b = __builtin_convertvector(v, bf16x2_t); return __builtin_bit_cast(unsigned, b); }
__device__ __forceinline__ float bf2f(bf16_t b) { return __builtin_bit_cast(float, (unsigned)b << 16); }
__device__ __forceinline__ float wave_sum(float v) {
#pragma unroll
    for (int o = 1; o < 64; o <<= 1) v += __shfl_xor(v, o);
    return v;
}
__device__ __forceinline__ int tid_opaque() { int t = threadIdx.x; asm volatile("" : "+v"(t)); return t; }
#define GAS __attribute__((address_space(1)))
template <class T> __device__ __forceinline__ T* as_global(T* p) { return (T*)(GAS T*)p; }
__device__ __forceinline__ unsigned char* opq(unsigned char* p) { GAS unsigned char* g = (GAS unsigned char*)p; asm volatile("" : "+s"(g)); return (unsigned char*)g; }
__device__ __forceinline__ float rdl(float v, int k) { return __builtin_bit_cast(float, __builtin_amdgcn_readlane(__builtin_bit_cast(int, v), k)); }
__device__ __forceinline__ float sigmoidf_(float x) { return 1.0f / (1.0f + __expf(-x)); }

#define XB_TMO      128
#define XB_XCNT(j)  (256  + 64 * (j))
#define XB_XSUB(j)  (1280 + 64 * (j))
#define XB_XGEN(j)  (2304 + 64 * (j))
#define XB_TOP      3328
#define XB_TOPGEN   3392
#define XCD_BAR_WORDS 3456
#define XB_SPIN_CAP (1u << 22)
__device__ __forceinline__ unsigned xb_ld(unsigned* p)              { return __hip_atomic_load(p, __ATOMIC_RELAXED, __HIP_MEMORY_SCOPE_AGENT); }
__device__ __forceinline__ unsigned xb_add(unsigned* p, unsigned v) { return __hip_atomic_fetch_add(p, v, __ATOMIC_RELAXED, __HIP_MEMORY_SCOPE_AGENT); }
__device__ __forceinline__ unsigned xb_xcc_id() { return (unsigned)__builtin_amdgcn_s_getreg((3 << 11) | 20) & 0xFu; }
#define XB_SPIN(cond, bar) do { unsigned _sp = 0; while (cond) { __builtin_amdgcn_s_sleep(1); \
    if ((++_sp & 255u) == 0u) { if (xb_ld(&(bar)[XB_TMO])) break; if (_sp > XB_SPIN_CAP) { atomicAdd(&(bar)[XB_TMO], 1u); break; } } } } while (0)
struct XcdBarrier { unsigned* bar; unsigned x; volatile LAS unsigned* st; };
__device__ __forceinline__ XcdBarrier xcd_barrier_post(unsigned* bar, volatile LAS unsigned* st) {
    XcdBarrier b; b.bar = bar; b.x = xb_xcc_id(); b.st = st;
    if (threadIdx.x == 0) (void)xb_add(&bar[XB_XCNT(b.x)], 1u);
    return b;
}
__device__ __forceinline__ void xcd_barrier_complete(unsigned* bar, unsigned x, unsigned& nloc, unsigned& nx) {
    const unsigned G = gridDim.x * gridDim.y * gridDim.z;
    unsigned sum, cnt, mine, sp = 0u;
    for (;;) {
        sum = 0u; cnt = 0u; mine = 0u;
#pragma unroll
        for (unsigned j = 0; j < 16; ++j) { const unsigned c = xb_ld(&bar[XB_XCNT(j)]); sum += c; cnt += (c > 0u) ? 1u : 0u; mine = (j == x) ? c : mine; }
        if (sum == G) break;
        __builtin_amdgcn_s_sleep(1);
        if ((++sp & 255u) == 0u) { if (xb_ld(&bar[XB_TMO])) break; if (sp > XB_SPIN_CAP) { atomicAdd(&bar[XB_TMO], 1u); break; } }
    }
    nloc = mine > 0u ? mine : 1u; nx = cnt > 0u ? cnt : 1u;
}
__device__ __forceinline__ void xcd_barrier(const XcdBarrier& b) {
    asm volatile("s_waitcnt vmcnt(0)" ::: "memory");
    __syncthreads();
    if (threadIdx.x == 0) {
        unsigned* bar = b.bar; asm volatile("" : "+s"(bar));
        __builtin_amdgcn_s_waitcnt(0);
        unsigned nloc = b.st[0], nx = b.st[1];
        if (nloc == 0u) { xcd_barrier_complete(bar, b.x, nloc, nx); b.st[0] = nloc; b.st[1] = nx; }
        const unsigned old = xb_add(&bar[XB_XSUB(b.x)], 1u);
        const unsigned gen = old / nloc;
        if (old + 1u == (gen + 1u) * nloc) {
            __builtin_amdgcn_fence(__ATOMIC_RELEASE, "agent");
            asm volatile("s_waitcnt vmcnt(0)" ::: "memory");
            const unsigned og = xb_add(&bar[XB_TOP], 1u);
            const unsigned tg = og / nx;
            if (og + 1u == (tg + 1u) * nx) xb_add(&bar[XB_TOPGEN], 1u);
            else XB_SPIN(xb_ld(&bar[XB_TOPGEN]) == tg, bar);
            __builtin_amdgcn_fence(__ATOMIC_ACQUIRE, "agent");
            xb_add(&bar[XB_XGEN(b.x)], 1u);
            asm volatile("s_waitcnt vmcnt(0)" ::: "memory");
        } else {
            XB_SPIN(xb_ld(&bar[XB_XGEN(b.x)]) == gen, bar);
            __builtin_amdgcn_fence(__ATOMIC_ACQUIRE, "agent");
            asm volatile("s_waitcnt vmcnt(0)" ::: "memory");
        }
    }
    __syncthreads();
}

namespace pg8 {
#define PG8_LAS __attribute__((address_space(3)))
typedef unsigned short bf16_t;
typedef short bf16x8 __attribute__((ext_vector_type(8)));
typedef float f32x4 __attribute__((ext_vector_type(4)));
typedef unsigned u32x4 __attribute__((ext_vector_type(4)));
constexpr int BM = 256, BK = 64, HALF = 128, HTB = HALF * BK * 2  , STAGE_BYTES = 8 * HTB, NXCD = 8, WGM = 8;

__host__ __device__ __forceinline__ int lds_byte(int r, int c) { const int st = (r >> 4) * 2 + (c >> 5), rr = r & 15, cc = c & 31, ob = rr * 64 + cc * 2; return st * 1024 + (ob ^ (((ob >> 9) & 1) << 5)); }
__host__ __device__ __forceinline__ void stage_rc(int b, int& R, int& C) { const int st = b / 1024, sb = b % 1024, swz = sb ^ (((sb >> 9) & 1) << 5); R = (st >> 1) * 16 + swz / 64; C = (st & 1) * 32 + (swz % 64) / 2; }
__host__ __device__ __forceinline__ int perm32(int rho) { const int n = rho >> 4, i = rho & 15; return 8 * (i >> 2) + 4 * n + (i & 3); }

struct Unit { int pm, pn; };
struct Gemm { const bf16_t* A; const bf16_t* Bt; int M, N, K; };

struct StaticOrder {
    int nM, nN, nwg, G, c;
    __host__ __device__ void init(int M, int N, int G_, int c_) { nM = M / BM; nN = N / BM; nwg = nM * nN; G = G_; c = c_; }
    __host__ __device__ bool next(int i, Unit& u) const {
        const long L = (long)i * G + c; if (L >= nwg) return false;
        int wgid = (int)L; { const int q = nwg / NXCD, r = nwg % NXCD, xcd = wgid % NXCD, off = wgid / NXCD; wgid = (xcd < r ? xcd * (q + 1) : r * (q + 1) + (xcd - r) * q) + off; }
        const int nig = WGM * nN, gid = wgid / nig, fm = gid * WGM, gsz = (nM - fm) < WGM ? (nM - fm) : WGM;
        u.pm = fm + ((wgid % nig) % gsz); u.pn = (wgid % nig) / gsz; return true;
    }
    __device__ __forceinline__ void a_ready(const Unit&) const {}
    __device__ __forceinline__ void done(const Unit&) const {}
};

__device__ __forceinline__ unsigned cvt_pk_bf16(float lo, float hi) { unsigned r; asm volatile("v_cvt_pk_bf16_f32 %0, %1, %2" : "=v"(r) : "v"(lo), "v"(hi)); return r; }
typedef float f32x2 __attribute__((ext_vector_type(2)));
__device__ __forceinline__ f32x2 gelu_pk(f32x2 v) {
    const f32x2 av = __builtin_elementwise_abs(v), d = av * 0.2316418882f + 1.0f;
    f32x2 t; t.x = __builtin_amdgcn_rcpf(d.x); t.y = __builtin_amdgcn_rcpf(d.y);
    f32x2 q = t * 0.5307027145f + (-0.7265760135f); q = q * t + 0.7107068705f; q = q * t + (-0.142248368f); q = q * t + 0.127414796f; q = q * t;
    const f32x2 s = (v * v) * (-0.72134752044f);
    f32x2 e; e.x = __builtin_amdgcn_exp2f(s.x); e.y = __builtin_amdgcn_exp2f(s.y);
    const f32x2 m = v * (q * e), r = v - m;
    f32x2 o; o.x = v.x < 0.f ? m.x : r.x; o.y = v.y < 0.f ? m.y : r.y; return o;
}

template <class Epi, class Sched, bool ALIGN_EPI = false, bool SP2 = false, bool GATHER = false>
__device__ __forceinline__ void gemm_phase(PG8_LAS unsigned char* lds, const Gemm g, const Sched& S, const Epi& E) {
    const int tid = tid_opaque(), wid = __builtin_amdgcn_readfirstlane(tid >> 6), lane = tid & 63, wr = wid >> 2, wc = wid & 3, fr = lane & 15, fq = lane >> 4;
    static_assert(!GATHER || SP2, "GATHER is wired into the SP2 loop only");
    const int K = g.K, nt = K / BK;
    unsigned voffA[2], voffB[2];
#pragma unroll
    for (int i = 0; i < 2; ++i) { int R, C; stage_rc(tid * 16 + i * 8192, R, C); const int Rb = Epi::PERM ? ((R & ~31) + perm32(R & 31)) : R;
        voffA[i] = (unsigned)(R * K + C) * 2u; voffB[i] = (unsigned)(Rb * K + C) * 2u; }
    unsigned gAc[2][2] = {{0u, 0u}, {0u, 0u}}, gAn[2][2] = {{0u, 0u}, {0u, 0u}};
    int gR[2] = {0, 0}; unsigned gC[2] = {0u, 0u};
    if constexpr (GATHER) {
#pragma unroll
        for (int i = 0; i < 2; ++i) { int R, C; stage_rc(tid * 16 + i * 8192, R, C); gR[i] = R; gC[i] = (unsigned)C * 2u; }
    }
#define PG8_GROWS(dst, ui_) do { _Pragma("unroll") for (int _h = 0; _h < 2; ++_h) _Pragma("unroll") for (int _i = 0; _i < 2; ++_i) dst[_h][_i] = S.rowtab[(ui_) * 256 + _h * 128 + gR[_i]] + gC[_i]; } while (0)
    const size_t kstep = (size_t)(BK * 2);
    const size_t hstep = (size_t)HALF * K * 2;
    const size_t tstep = 2 * hstep;
    const unsigned ldsw = (unsigned)wid * 1024u;
    const int aoff = lds_byte(wr * 64 + fr, fq * 8), boff = lds_byte(wc * 32 + fr, fq * 8);
#define PG8_SA(b, h) (((b) * 2 + (h)) * HTB)
#define PG8_SB(b, h) ((4 + (b) * 2 + (h)) * HTB)
#define PG8_STAGE(bufoff, gbase, voff) do { _Pragma("unroll") for (int _i = 0; _i < 2; ++_i) \
        __builtin_amdgcn_global_load_lds((const unsigned*)((const char*)(gbase) + (voff)[_i]), (PG8_LAS unsigned*)(lds + (bufoff) + ldsw + _i * 8192), 16, 0, 0); } while (0)
#define PG8_STAGE_A(bufoff, kptr, h, vsel) do { if constexpr (GATHER) { PG8_STAGE(bufoff, kptr, vsel[h]); } else { PG8_STAGE(bufoff, (kptr) + (h) * hstep, voffA); } } while (0)
#define PG8_LDA(dst, b, h) do { _Pragma("unroll") for (int m = 0; m < 4; ++m) _Pragma("unroll") for (int k = 0; k < 2; ++k) dst[m][k] = *(const PG8_LAS bf16x8*)(lds + PG8_SA(b, h) + aoff + m * 2048 + k * 1024); } while (0)
#define PG8_LDB(dst, b, h) do { _Pragma("unroll") for (int n = 0; n < 2; ++n) _Pragma("unroll") for (int k = 0; k < 2; ++k) dst[n][k] = *(const PG8_LAS bf16x8*)(lds + PG8_SB(b, h) + boff + n * 2048 + k * 1024); } while (0)
#define PG8_MMA(ai, bj, At, Bt) do { __builtin_amdgcn_s_setprio(1); _Pragma("unroll") for (int m = 0; m < 4; ++m) _Pragma("unroll") for (int n = 0; n < 2; ++n) _Pragma("unroll") for (int k = 0; k < 2; ++k) \
        acc[ai][bj][m][n] = __builtin_amdgcn_mfma_f32_16x16x32_bf16(Bt[n][k], At[m][k], acc[ai][bj][m][n], 0, 0, 0); __builtin_amdgcn_s_setprio(0); } while (0)
#define PG8_WAIT_V(n) asm volatile("s_waitcnt vmcnt(" #n ")" ::: "memory")
#define PG8_WAIT_L(n) asm volatile("s_waitcnt lgkmcnt(" #n ")" ::: "memory")
#define PG8_BAR __builtin_amdgcn_s_barrier()
#define PG8_SCHED __builtin_amdgcn_sched_barrier(0)
    Unit cur, nxt; int ui = 0;
    if (!S.next(0, cur)) return;
    f32x4 acc[2][2][4][2];
#pragma unroll
    for (int a = 0; a < 2; ++a)
#pragma unroll
        for (int b = 0; b < 2; ++b)
#pragma unroll
            for (int m = 0; m < 4; ++m)
#pragma unroll
                for (int n = 0; n < 2; ++n) acc[a][b][m][n] = (f32x4){0.f, 0.f, 0.f, 0.f};
    bf16x8 At[4][2], B0[2][2], B1[2][2];
    const char* cA = GATHER ? (const char*)g.A : (const char*)g.A + (size_t)cur.pm * tstep; const char* cB = (const char*)g.Bt + (size_t)cur.pn * tstep;
    if constexpr (GATHER) { PG8_GROWS(gAc, 0); }
    S.a_ready(cur);
    if constexpr (SP2) {
        PG8_STAGE(PG8_SB(0, 0), cB, voffB); PG8_STAGE(PG8_SB(0, 1), cB + hstep, voffB); PG8_STAGE_A(PG8_SA(0, 0), cA, 0, gAc); PG8_STAGE_A(PG8_SA(0, 1), cA, 1, gAc);
        if (wr == 1) PG8_BAR;
        PG8_WAIT_V(2); PG8_BAR;
        PG8_STAGE(PG8_SB(1, 0), cB + kstep, voffB); PG8_STAGE_A(PG8_SA(1, 0), cA + kstep, 0, gAc); PG8_STAGE(PG8_SB(1, 1), cB + hstep + kstep, voffB);
        PG8_WAIT_V(6); PG8_BAR;
    } else {
        PG8_STAGE(PG8_SB(0, 0), cB, voffB); PG8_STAGE(PG8_SA(0, 0), cA, voffA); PG8_STAGE(PG8_SB(0, 1), cB + hstep, voffB); PG8_STAGE(PG8_SA(0, 1), cA + hstep, voffA);
        if (wr == 1) PG8_BAR;
        PG8_WAIT_V(4); PG8_BAR;
        PG8_STAGE(PG8_SB(1, 0), cB + kstep, voffB); PG8_STAGE(PG8_SA(1, 0), cA + kstep, voffA); PG8_STAGE(PG8_SB(1, 1), cB + hstep + kstep, voffB);
        PG8_WAIT_V(6); PG8_BAR;
    }
    for (;;) {
        const bool has_next = S.next(ui + 1, nxt);
        if constexpr (GATHER) { if (has_next) { PG8_GROWS(gAn, ui + 1); } else { _Pragma("unroll") for (int _h = 0; _h < 2; ++_h) _Pragma("unroll") for (int _i = 0; _i < 2; ++_i) gAn[_h][_i] = gAc[_h][_i]; } }
        const char* nA = GATHER ? (const char*)g.A : (has_next ? (const char*)g.A + (size_t)nxt.pm * tstep : cA); const char* nB = has_next ? (const char*)g.Bt + (size_t)nxt.pn * tstep : cB;
        for (int t = 0; t < nt; t += 2) {
            const bool last = (t == nt - 2);
            const char* a1 = cA + (size_t)(t + 1) * kstep;
            const char* a2 = last ? nA : cA + (size_t)(t + 2) * kstep; const char* b2 = last ? nB : cB + (size_t)(t + 2) * kstep;
            const char* a3 = a2 + kstep; const char* b3 = b2 + kstep;
            if (last && has_next) S.a_ready(nxt);
            unsigned gA2[2][2];
            if constexpr (GATHER) { _Pragma("unroll") for (int _h = 0; _h < 2; ++_h) _Pragma("unroll") for (int _i = 0; _i < 2; ++_i) gA2[_h][_i] = last ? gAn[_h][_i] : gAc[_h][_i]; }
            if constexpr (SP2) {
            PG8_LDB(B0, 0, 0); PG8_LDB(B1, 0, 1); PG8_SCHED; PG8_LDA(At, 0, 0); PG8_STAGE_A(PG8_SA(1, 1), a1, 1, gAc);
            PG8_WAIT_V(8); PG8_WAIT_L(0); PG8_BAR; PG8_MMA(0, 0, At, B0); PG8_MMA(0, 1, At, B1); PG8_BAR; PG8_SCHED;
            PG8_LDA(At, 0, 1); PG8_STAGE(PG8_SB(0, 0), b2, voffB); PG8_STAGE(PG8_SB(0, 1), b2 + hstep, voffB); PG8_STAGE_A(PG8_SA(0, 0), a2, 0, gA2);
            PG8_WAIT_V(8); PG8_WAIT_L(0); PG8_BAR; PG8_MMA(1, 0, At, B0); PG8_MMA(1, 1, At, B1); PG8_BAR; PG8_SCHED;
            PG8_LDB(B0, 1, 0); PG8_LDB(B1, 1, 1); PG8_SCHED; PG8_LDA(At, 1, 0); PG8_STAGE_A(PG8_SA(0, 1), a2, 1, gA2);
            PG8_WAIT_V(8); PG8_WAIT_L(0); PG8_BAR; PG8_MMA(0, 0, At, B0); PG8_MMA(0, 1, At, B1); PG8_BAR; PG8_SCHED;
            PG8_LDA(At, 1, 1); PG8_STAGE(PG8_SB(1, 0), b3, voffB); PG8_STAGE(PG8_SB(1, 1), b3 + hstep, voffB); PG8_STAGE_A(PG8_SA(1, 0), a3, 0, gA2);
            PG8_WAIT_V(8); PG8_WAIT_L(0); PG8_BAR; PG8_MMA(1, 0, At, B0); PG8_MMA(1, 1, At, B1); PG8_BAR; PG8_SCHED;
            } else {
            PG8_LDB(B0, 0, 0); PG8_SCHED; PG8_LDA(At, 0, 0); PG8_STAGE(PG8_SA(1, 1), a1 + hstep, voffA);
            PG8_WAIT_L(8); PG8_BAR; PG8_WAIT_L(0); PG8_MMA(0, 0, At, B0); PG8_BAR; PG8_SCHED;
            PG8_LDB(B1, 0, 1); PG8_STAGE(PG8_SB(0, 0), b2, voffB);
            PG8_BAR; PG8_WAIT_L(0); PG8_MMA(0, 1, At, B1); PG8_BAR;
            PG8_LDA(At, 0, 1); PG8_STAGE(PG8_SA(0, 0), a2, voffA);
            PG8_BAR; PG8_WAIT_L(0); PG8_MMA(1, 0, At, B0); PG8_BAR; PG8_SCHED;
            PG8_STAGE(PG8_SB(0, 1), b2 + hstep, voffB);
            PG8_WAIT_V(6); PG8_BAR; PG8_MMA(1, 1, At, B1); PG8_BAR;
            PG8_LDB(B0, 1, 0); PG8_SCHED; PG8_LDA(At, 1, 0); PG8_STAGE(PG8_SA(0, 1), a2 + hstep, voffA);
            PG8_WAIT_L(8); PG8_BAR; PG8_WAIT_L(0); PG8_MMA(0, 0, At, B0); PG8_BAR; PG8_SCHED;
            PG8_LDB(B1, 1, 1); PG8_STAGE(PG8_SB(1, 0), b3, voffB);
            PG8_BAR; PG8_WAIT_L(0); PG8_MMA(0, 1, At, B1); PG8_BAR;
            PG8_LDA(At, 1, 1); PG8_STAGE(PG8_SA(1, 0), a3, voffA);
            PG8_BAR; PG8_WAIT_L(0); PG8_MMA(1, 0, At, B0); PG8_BAR; PG8_SCHED;
            PG8_STAGE(PG8_SB(1, 1), b3 + hstep, voffB);
            PG8_WAIT_V(6); PG8_BAR; PG8_MMA(1, 1, At, B1); PG8_BAR;
            }
        }
        if constexpr (ALIGN_EPI) { if (wr == 0) PG8_BAR; }
        if constexpr (!Epi::AFTER_DRAIN) { E(acc, cur, wr, wc, fr, fq); S.done(cur); }
        if (!has_next) break;
#pragma unroll
        for (int a = 0; a < 2; ++a)
#pragma unroll
            for (int b = 0; b < 2; ++b)
#pragma unroll
                for (int m = 0; m < 4; ++m)
#pragma unroll
                    for (int n = 0; n < 2; ++n) acc[a][b][m][n] = (f32x4){0.f, 0.f, 0.f, 0.f};
        cur = nxt; cA = nA; cB = nB; ++ui;
        if constexpr (GATHER) { _Pragma("unroll") for (int _h = 0; _h < 2; ++_h) _Pragma("unroll") for (int _i = 0; _i < 2; ++_i) gAc[_h][_i] = gAn[_h][_i]; }
        if constexpr (ALIGN_EPI) { if (wr == 1) PG8_BAR; }
    }
    PG8_WAIT_V(0);
    if constexpr (!ALIGN_EPI) { if (wr == 0) PG8_BAR; }
    PG8_BAR;
    if constexpr (Epi::AFTER_DRAIN) { E.fused(acc, cur, wr, wc, fr, fq, lds, wid, lane); S.done(cur); }
#undef PG8_SA
#undef PG8_SB
#undef PG8_STAGE
#undef PG8_STAGE_A
#undef PG8_GROWS
#undef PG8_LDA
#undef PG8_LDB
#undef PG8_MMA
#undef PG8_WAIT_V
#undef PG8_WAIT_L
#undef PG8_BAR
#undef PG8_SCHED
}
}

struct Args { const float* in[38]; float* out; unsigned char* ws; int ph_lo, ph_hi; };
#define INP(k) as_global(IN[k])
#define AIN(k) as_global(A.in[k])
enum { I_X = 0, I_C, I_CTX, I_CCTX, I_N1G, I_N2G, I_ADAW, I_ADAB, I_EVWIN, I_EVWOUT, I_RWMU, I_RWW0, I_RWW2, I_RWA0, I_RWA2, I_RWG2, I_RWKK, I_RWKA, I_RWRK,
       I_GNW, I_GNB, I_QN, I_KN, I_LAM, I_SUBLN, I_SGWIN, I_SGBIN, I_SGLNG, I_SGLNB, I_SGWS, I_SGBS, I_SGWOUT, I_RTW, I_RTB, I_W1, I_B1, I_W2, I_B2 };

struct Tok { int b, t, T, modrow; };
__device__ __forceinline__ Tok tokinfo(int g) {
    Tok k;
    if (g < NCTX) { k.b = g >> 8; k.t = g & 255; k.T = TC; k.modrow = 16; }
    else { const int q = g - NCTX; k.b = q >> 11; k.t = q & 2047; k.T = TL; k.modrow = k.b; }
    return k;
}

template <int MAP>
__device__ __forceinline__ void p0_transpose_item(const float* W, int K, int N, bf16_t* WT, LAS float* scr, int item, int lane) {
    const int nblk = N / 32, kb = item / nblk, nb = item % nblk, k0 = 64 * kb, n0 = 32 * nb;
    const int d0 = MAP ? (256 * ((n0 & 1023) >> 7) + 128 * (n0 >> 10) + (n0 & 127)) : n0;
#pragma unroll 8
    for (int i = 0; i < 32; ++i) { const int kk = 2 * i + (lane >> 5); scr[kk * 33 + (lane & 31)] = W[(size_t)(k0 + kk) * N + n0 + (lane & 31)]; }
    asm volatile("s_waitcnt lgkmcnt(0)" ::: "memory");
    const int c = lane & 7;
#pragma unroll
    for (int j = 0; j < 4; ++j) { const int n = (lane >> 3) + 8 * j; const LAS float* s = scr + (8 * c) * 33 + n;
        u32x4 o; o.x = pk2(s[0 * 33], s[1 * 33]); o.y = pk2(s[2 * 33], s[3 * 33]); o.z = pk2(s[4 * 33], s[5 * 33]); o.w = pk2(s[6 * 33], s[7 * 33]);
        *(u32x4*)(WT + (size_t)(d0 + n) * K + k0 + 8 * c) = o; }
    asm volatile("s_waitcnt lgkmcnt(0)" ::: "memory");
}

__device__ __forceinline__ void ph_prologue(const Args& A, LAS unsigned char* lds, int bid, int nb) {
    const int tid = tid_opaque(), lane = tid & 63, wid = tid >> 6;
    unsigned char* ws = opq(A.ws);
    if (bid == 0 && tid < 39) ((const float**)(ws + WS_PTRS))[tid] = (tid < 38) ? A.in[tid] : (const float*)A.out;
    {
        LAS float* s = (LAS float*)lds;
        LAS float* red = (LAS float*)(lds + 17 * 1024 * 4);
        for (int i = tid; i < 17 * 1024; i += NTHREADS) {
            const int r = i >> 10, k = i & 1023;
            const float x = (r < 16) ? AIN(I_C)[r * 1024 + k] : AIN(I_CCTX)[k];
            s[i] = x / (1.0f + __expf(-x));
        }
        __syncthreads();
        float* mod = (float*)(ws + WS_MOD);
        for (int u = bid; u < 4 * 96; u += nb) {
            const int l = u / 96, cg = u % 96, col = cg * 64 + lane;
            float acc[17];
#pragma unroll
            for (int r = 0; r < 17; ++r) acc[r] = 0.f;
            const float* wp = AIN(I_ADAW) + (size_t)l * 1024 * 6144 + col;
            for (int k = wid * 128; k < wid * 128 + 128; ++k) {
                const float wv = wp[(size_t)k * 6144];
#pragma unroll
                for (int r = 0; r < 17; ++r) acc[r] += s[r * 1024 + k] * wv;
            }
#pragma unroll
            for (int r = 0; r < 17; ++r) red[(wid * 17 + r) * 64 + lane] = acc[r];
            __syncthreads();
            for (int i = tid; i < 17 * 64; i += NTHREADS) {
                const int r = i >> 6, ln = i & 63; float v = 0.f;
#pragma unroll
                for (int w = 0; w < 8; ++w) v += red[(w * 17 + r) * 64 + ln];
                const int cc = cg * 64 + ln;
                mod[((size_t)l * 17 + r) * 6144 + cc] = v + AIN(I_ADAB)[l * 6144 + cc];
            }
            __syncthreads();
        }
    }
    __syncthreads();
    {
        LAS float* scr = (LAS float*)(lds + wid * 16384);
        const int gw = bid * NWAVES + wid, NGW = nb * NWAVES;
        constexpr int IT_WIN = 16 * (EVC / 32), IT_SQ = 16 * 32, IT_SGIN = 16 * 64, IT_W1 = 16 * 64, IT_W2 = 16 * 32;
        constexpr int N0 = 2 * IT_WIN, N1 = N0 + 2 * IT_SQ, N2 = N1 + 2 * IT_SGIN, N3 = N2 + 2 * IT_SQ, N4 = N3 + 128 * IT_W1, N5 = N4 + 128 * IT_W2;
        for (int it = gw; it < N5; it += NGW) {
            if (it < N0) { const int m = it / IT_WIN, r = it % IT_WIN; p0_transpose_item<0>(AIN(I_EVWIN) + (size_t)m * DM * EVC, DM, EVC, (bf16_t*)(ws + WS_WIN) + (size_t)m * ZLD * DM, scr, r, lane); }
            else if (it < N1) { const int q = it - N0, m = q / IT_SQ, r = q % IT_SQ; p0_transpose_item<0>(AIN(I_EVWOUT) + (size_t)m * DM * DM, DM, DM, (bf16_t*)(ws + WS_WOUT) + (size_t)m * DM * DM, scr, r, lane); }
            else if (it < N2) { const int q = it - N1, m = q / IT_SGIN, r = q % IT_SGIN; p0_transpose_item<0>(AIN(I_SGWIN) + (size_t)m * DM * 2048, DM, 2048, (bf16_t*)(ws + WS_SGIN) + (size_t)m * 2048 * DM, scr, r, lane); }
            else if (it < N3) { const int q = it - N2, m = q / IT_SQ, r = q % IT_SQ; p0_transpose_item<0>(AIN(I_SGWOUT) + (size_t)m * DM * DM, DM, DM, (bf16_t*)(ws + WS_SGOUT) + (size_t)m * DM * DM, scr, r, lane); }
            else if (it < N4) { const int q = it - N3, m = q / IT_W1, r = q % IT_W1; p0_transpose_item<1>(AIN(I_W1) + (size_t)m * DM * 2048, DM, 2048, (bf16_t*)(ws + WS_W1) + (size_t)m * 2048 * DM, scr, r, lane); }
            else { const int q = it - N4, m = q / IT_W2, r = q % IT_W2; p0_transpose_item<0>(AIN(I_W2) + (size_t)m * DM * DM, DM, DM, (bf16_t*)(ws + WS_W2) + (size_t)m * DM * DM, scr, r, lane); }
        }
    }
    {
        const size_t gt = (size_t)bid * NTHREADS + tid, GT = (size_t)nb * NTHREADS;
        f32x4* H4 = (f32x4*)(ws + WS_H);
        const f32x4* c4 = (const f32x4*)AIN(I_CTX); const f32x4* x4 = (const f32x4*)AIN(I_X);
        constexpr size_t NC4 = (size_t)NCTX * DM / 4, NT4 = (size_t)NTOK * DM / 4;
        for (size_t i = gt; i < NT4; i += GT) H4[i] = (i < NC4) ? c4[i] : x4[i - NC4];
        for (size_t i = gt; i < (size_t)2 * 128 * DM / 8; i += GT) { const size_t m = i / (128 * DM / 8), r = i % (128 * DM / 8); ((u32x4*)((bf16_t*)(ws + WS_WIN) + (m * ZLD + EVC) * DM))[r] = (u32x4){0u, 0u, 0u, 0u}; }
        bf16_t* wl = (bf16_t*)(ws + WS_WLORA);
        for (size_t i = gt; i < (size_t)2 * LORA_N * LORA_K; i += GT) {
            const int jj = (int)(i / ((size_t)LORA_N * LORA_K)), rem = (int)(i % ((size_t)LORA_N * LORA_K)), n = rem / LORA_K, k = rem % LORA_K, seg = n >> 9, c = n & 511;
            float v = 0.f;
            if (seg < 2) { if ((k >> 6) == seg) v = AIN(I_RWW2)[(((size_t)jj * 2 + seg) * 64 + (k & 63)) * 512 + c]; }
            else if (seg < 4) { if ((k >> 6) == seg) v = AIN(I_RWA2)[(((size_t)jj * 2 + (seg - 2)) * 64 + (k & 63)) * 512 + c]; }
            else { if (k >= 256) v = AIN(I_RWG2)[((size_t)jj * 128 + (k - 256)) * 512 + c]; }
            wl[i] = (bf16_t)f2bf(v);
        }
        for (size_t i = gt; i < (size_t)2 * LORA_N; i += GT) { const int jj = (int)(i / LORA_N), n = (int)(i % LORA_N), seg = n >> 9, c = n & 511;
            ((float*)(ws + WS_LBIAS))[i] = seg < 2 ? AIN(I_RWW0)[((size_t)jj * 2 + seg) * 512 + c] : (seg < 4 ? AIN(I_RWA0)[((size_t)jj * 2 + (seg - 2)) * 512 + c] : 0.f); }
        float* rt = (float*)(ws + WS_RTWT);
        for (size_t i = gt; i < (size_t)4 * 32 * 1024; i += GT) { const int l = (int)(i >> 15), e = (int)(i >> 10) & 31, k = (int)i & 1023; const float w = AIN(I_RTW)[((size_t)l * 1024 + k) * 32 + e];
            const unsigned hi = f2bf(w); const float lo = w - __builtin_bit_cast(float, hi << 16);
            ((bf16_t*)rt)[((size_t)l * 2 * 32 + e) * 1024 + k] = (bf16_t)hi; ((bf16_t*)rt)[((size_t)(l * 2 + 1) * 32 + e) * 1024 + k] = (bf16_t)f2bf(lo); }
    }
}

template <bool ROUTER>
__device__ __forceinline__ void ph_norm(const Args& A, int l, int row_lo, LAS unsigned char* lds, int bid, int nb) {
    unsigned char* ws = opq(A.ws); const float* const* IN = (const float* const*)(ws + WS_PTRS); (void)IN;
    const int tid = tid_opaque(), lane = tid & 63, wid = tid >> 6;
    const float* H = (const float*)(ws + WS_H);
    const float* mod = (const float*)(ws + WS_MOD);
    bf16_t* abf = (bf16_t*)(ws + WS_ABF);
    const float* gp = INP(ROUTER ? I_N2G : I_N1G) + l * 1024;
    const int c_shift = ROUTER ? 3 : 0, c_scale = ROUTER ? 4 : 1;
    LAS float* rtl = (LAS float*)lds;
    LAS int* hist = (LAS int*)(lds + 131072);
    float rtb = 0.f;
    if constexpr (ROUTER) {
        const f32x4* rt4 = (const f32x4*)((const float*)(ws + WS_RTWT) + (size_t)l * 32 * 1024);
        for (int i = tid; i < 32 * 1024 / 4; i += NTHREADS) ((LAS f32x4*)rtl)[i] = rt4[i];
        if (tid < 32) hist[tid] = 0;
        rtb = INP(I_RTB)[l * 32 + (lane >> 1)];
        __syncthreads();
    }
    for (int row = row_lo + bid * NWAVES + wid; row < NTOK; row += nb * NWAVES) {
        const Tok tk = tokinfo(row);
        const float* mrow = mod + ((size_t)l * 17 + tk.modrow) * 6144;
        f32x4 v[4]; float ss = 0.f;
#pragma unroll
        for (int j = 0; j < 4; ++j) { v[j] = *(const f32x4*)(H + (size_t)row * DM + j * 256 + lane * 4); ss += (v[j].x * v[j].x + v[j].y * v[j].y) + (v[j].z * v[j].z + v[j].w * v[j].w); }
        const float rstd = rsqrtf(wave_sum(ss) * (1.0f / DM) + 1e-6f);
#pragma unroll
        for (int j = 0; j < 4; ++j) {
            const int col = j * 256 + lane * 4;
            const f32x4 g = *(const f32x4*)(gp + col), sc = *(const f32x4*)(mrow + c_scale * 1024 + col), sh = *(const f32x4*)(mrow + c_shift * 1024 + col);
            v[j] = (v[j] * rstd * g) * (sc + 1.0f) + sh;
            u32x2 o; o.x = pk2(v[j].x, v[j].y); o.y = pk2(v[j].z, v[j].w);
            *(u32x2*)(abf + (size_t)row * DM + col) = o;
        }
        if constexpr (ROUTER) {
            float p[32];
#pragma unroll
            for (int e = 0; e < 32; ++e) {
                float acc = 0.f;
#pragma unroll
                for (int j = 0; j < 4; ++j) { const f32x4 w = *(const LAS f32x4*)(rtl + e * 1024 + j * 256 + lane * 4); acc += (v[j].x * w.x + v[j].y * w.y) + (v[j].z * w.z + v[j].w * w.w); }
                p[e] = acc;
            }
#define RS_STEP(N, OFF) _Pragma("unroll") for (int i = 0; i < (N); ++i) { const bool up = (lane & (OFF)) != 0; const float send = up ? p[i] : p[i + (N)], keep = up ? p[i + (N)] : p[i]; p[i] = keep + __shfl_xor(send, (OFF)); }
            RS_STEP(16, 32) RS_STEP(8, 16) RS_STEP(4, 8) RS_STEP(2, 4) RS_STEP(1, 2)
#undef RS_STEP
            const float mylg = p[0] + __shfl_xor(p[0], 1) + rtb;
            float tv[4] = {-3.0e38f, -3.0e38f, -3.0e38f, -3.0e38f}; int ti[4] = {0, 0, 0, 0};
#pragma unroll
            for (int e = 0; e < 32; ++e) {
                const float lgv = rdl(mylg, 2 * e);
                if (lgv > tv[3]) {
                    tv[3] = lgv; ti[3] = e;
                    if (tv[3] > tv[2]) { const float a = tv[2]; tv[2] = tv[3]; tv[3] = a; const int b = ti[2]; ti[2] = ti[3]; ti[3] = b; }
                    if (tv[2] > tv[1]) { const float a = tv[1]; tv[1] = tv[2]; tv[2] = a; const int b = ti[1]; ti[1] = ti[2]; ti[2] = b; }
                    if (tv[1] > tv[0]) { const float a = tv[0]; tv[0] = tv[1]; tv[1] = a; const int b = ti[0]; ti[0] = ti[1]; ti[1] = b; }
                }
            }
            const float e1 = __expf(tv[1] - tv[0]), e2 = __expf(tv[2] - tv[0]), e3 = __expf(tv[3] - tv[0]);
            const float inv = 1.0f / (1.0f + e1 + e2 + e3);
            if (lane == 0) {
                int* te = (int*)(ws + WS_TOKE) + (size_t)row * 4; float* tg = (float*)(ws + WS_TOKG) + (size_t)row * 4; int* tr = (int*)(ws + WS_TOKR) + (size_t)row * 4;
                te[0] = ti[0]; te[1] = ti[1]; te[2] = ti[2]; te[3] = ti[3];
                tg[0] = inv; tg[1] = e1 * inv; tg[2] = e2 * inv; tg[3] = e3 * inv;
#pragma unroll
                for (int k = 0; k < 4; ++k) tr[k] = __hip_atomic_fetch_add(hist + ti[k], 1, __ATOMIC_RELAXED, __HIP_MEMORY_SCOPE_WORKGROUP);
            }
        }
    }
    if constexpr (ROUTER) {
        __syncthreads();
        if (tid < 32) ((int*)(ws + WS_BCNT))[((size_t)l * 256 + bid) * 32 + tid] = hist[tid];
    }
}


constexpr int RT_LS = 2064;
__device__ __forceinline__ void ph_norm2_router(const Args& A, int l, int row_lo, LAS unsigned char* lds, int bid, int nb) {
    unsigned char* ws = opq(A.ws); const float* const* IN = (const float* const*)(ws + WS_PTRS);
    const int tid = tid_opaque(), lane = tid & 63, wid = tid >> 6, c16 = lane & 15, g4 = lane >> 4;
    const float* H = (const float*)(ws + WS_H); const float* mod = (const float*)(ws + WS_MOD); bf16_t* abf = (bf16_t*)(ws + WS_ABF);
    const float* gp = INP(I_N2G) + l * 1024;
    LAS unsigned char* rth = lds; LAS unsigned char* rtl = lds + 32 * RT_LS;
    LAS int* hist = (LAS int*)(lds + 64 * RT_LS);
    LAS float* lgs = (LAS float*)(lds + 64 * RT_LS + 256) + wid * 544;
    {
        const u32x4* src = (const u32x4*)((const bf16_t*)(ws + WS_RTWT) + (size_t)l * 2 * 32 * 1024);
        for (int i = tid; i < 64 * 128; i += NTHREADS) { const int row = i >> 7, ch = i & 127; *(LAS u32x4*)(lds + row * RT_LS + ch * 16) = src[i]; }
        if (tid < 32) hist[tid] = 0;
        __syncthreads();
    }
    const float rtb0 = INP(I_RTB)[l * 32 + c16], rtb1 = INP(I_RTB)[l * 32 + 16 + c16];
    const int ngroups = (NTOK - row_lo) / 16;
    for (int u = bid * NWAVES + wid; u < ngroups; u += nb * NWAVES) {
        const int row = row_lo + 16 * u + c16;
        const Tok tk = tokinfo(row_lo + 16 * u);
        const float* mrow = mod + ((size_t)l * 17 + tk.modrow) * 6144;
        const float* hrow = H + (size_t)row * DM + 8 * g4;
        float ss = 0.f;
#pragma unroll 8
        for (int ks = 0; ks < 32; ++ks) { const f32x4 a = *(const f32x4*)(hrow + 32 * ks), b = *(const f32x4*)(hrow + 32 * ks + 4);
            ss += (a.x * a.x + a.y * a.y) + (a.z * a.z + a.w * a.w) + (b.x * b.x + b.y * b.y) + (b.z * b.z + b.w * b.w); }
        ss += __shfl_xor(ss, 16); ss += __shfl_xor(ss, 32);
        const float rstd = rsqrtf(ss * (1.0f / DM) + 1e-6f);
        f32x4 acc0 = {0.f, 0.f, 0.f, 0.f}, acc1 = acc0;
#pragma unroll 2
        for (int ks = 0; ks < 32; ++ks) {
            const int col = 32 * ks + 8 * g4;
            float f[8];
            { const f32x4 xa = *(const f32x4*)(hrow + 32 * ks), xb = *(const f32x4*)(hrow + 32 * ks + 4);
              const f32x4 ga = *(const f32x4*)(gp + col), gb = *(const f32x4*)(gp + col + 4), sa = *(const f32x4*)(mrow + 4 * 1024 + col), sb = *(const f32x4*)(mrow + 4 * 1024 + col + 4);
              const f32x4 ha = *(const f32x4*)(mrow + 3 * 1024 + col), hb = *(const f32x4*)(mrow + 3 * 1024 + col + 4);
              const f32x4 fa = (xa * rstd * ga) * (sa + 1.0f) + ha, fb = (xb * rstd * gb) * (sb + 1.0f) + hb;
              f[0] = fa.x; f[1] = fa.y; f[2] = fa.z; f[3] = fa.w; f[4] = fb.x; f[5] = fb.y; f[6] = fb.z; f[7] = fb.w; }
            unsigned hi[4], lo[4];
#pragma unroll
            for (int e = 0; e < 4; ++e) { hi[e] = pk2(f[2 * e], f[2 * e + 1]);
                lo[e] = pk2(f[2 * e] - __builtin_bit_cast(float, hi[e] << 16), f[2 * e + 1] - __builtin_bit_cast(float, hi[e] & 0xffff0000u)); }
            const u32x4 hv = {hi[0], hi[1], hi[2], hi[3]}, lv = {lo[0], lo[1], lo[2], lo[3]};
            *(u32x4*)(abf + (size_t)row * DM + col) = hv;
            const bf16x8 fh = __builtin_bit_cast(bf16x8, hv), fl = __builtin_bit_cast(bf16x8, lv);
            const int wo = c16 * RT_LS + col * 2;
            const bf16x8 wh0 = *(const LAS bf16x8*)(rth + wo), wh1 = *(const LAS bf16x8*)(rth + 16 * RT_LS + wo), wl0 = *(const LAS bf16x8*)(rtl + wo), wl1 = *(const LAS bf16x8*)(rtl + 16 * RT_LS + wo);
            acc0 = __builtin_amdgcn_mfma_f32_16x16x32_bf16(fh, wh0, acc0, 0, 0, 0); acc1 = __builtin_amdgcn_mfma_f32_16x16x32_bf16(fh, wh1, acc1, 0, 0, 0);
            acc0 = __builtin_amdgcn_mfma_f32_16x16x32_bf16(fl, wh0, acc0, 0, 0, 0); acc1 = __builtin_amdgcn_mfma_f32_16x16x32_bf16(fl, wh1, acc1, 0, 0, 0);
            acc0 = __builtin_amdgcn_mfma_f32_16x16x32_bf16(fh, wl0, acc0, 0, 0, 0); acc1 = __builtin_amdgcn_mfma_f32_16x16x32_bf16(fh, wl1, acc1, 0, 0, 0);
        }
#pragma unroll
        for (int r = 0; r < 4; ++r) { lgs[(4 * g4 + r) * 34 + c16] = acc0[r] + rtb0; lgs[(4 * g4 + r) * 34 + 16 + c16] = acc1[r] + rtb1; }
        asm volatile("s_waitcnt lgkmcnt(0)" ::: "memory");
        if (lane < 16) {
            float tv[4] = {-3.0e38f, -3.0e38f, -3.0e38f, -3.0e38f}; int ti[4] = {0, 0, 0, 0};
#pragma unroll
            for (int e = 0; e < 32; ++e) {
                const float lgv = lgs[lane * 34 + e];
                if (lgv > tv[3]) {
                    tv[3] = lgv; ti[3] = e;
                    if (tv[3] > tv[2]) { const float a = tv[2]; tv[2] = tv[3]; tv[3] = a; const int b = ti[2]; ti[2] = ti[3]; ti[3] = b; }
                    if (tv[2] > tv[1]) { const float a = tv[1]; tv[1] = tv[2]; tv[2] = a; const int b = ti[1]; ti[1] = ti[2]; ti[2] = b; }
                    if (tv[1] > tv[0]) { const float a = tv[0]; tv[0] = tv[1]; tv[1] = a; const int b = ti[0]; ti[0] = ti[1]; ti[1] = b; }
                }
            }
            const float e1 = __expf(tv[1] - tv[0]), e2 = __expf(tv[2] - tv[0]), e3 = __expf(tv[3] - tv[0]);
            const float inv = 1.0f / (1.0f + e1 + e2 + e3);
            const size_t r4 = (size_t)(row_lo + 16 * u + lane) * 4;
            *(int4*)((int*)(ws + WS_TOKE) + r4) = make_int4(ti[0], ti[1], ti[2], ti[3]);
            *(f32x4*)((float*)(ws + WS_TOKG) + r4) = (f32x4){inv, e1 * inv, e2 * inv, e3 * inv};
            int rk[4];
#pragma unroll
            for (int k = 0; k < 4; ++k) rk[k] = __hip_atomic_fetch_add(hist + ti[k], 1, __ATOMIC_RELAXED, __HIP_MEMORY_SCOPE_WORKGROUP);
            *(int4*)((int*)(ws + WS_TOKR) + r4) = make_int4(rk[0], rk[1], rk[2], rk[3]);
        }
        asm volatile("s_waitcnt lgkmcnt(0)" ::: "memory");
    }
    __syncthreads();
    if (tid < 32) ((int*)(ws + WS_BCNT))[((size_t)l * 256 + bid) * 32 + tid] = hist[tid];
}

typedef pg8::f32x4 (&AccRef)[2][2][4][2];
struct EpiStoreBf16 {
    static constexpr bool PERM = true, AFTER_DRAIN = false;
    bf16_t* O; int ldc;
    __device__ __forceinline__ void operator()(const pg8::f32x4 (&acc)[2][2][4][2], const pg8::Unit& u, int wr, int wc, int fr, int fq) const {
        const int row0 = u.pm * 256 + wr * 64 + fr, col0 = u.pn * 256 + wc * 32 + 8 * fq;
#pragma unroll
        for (int ai = 0; ai < 2; ++ai)
#pragma unroll
            for (int m = 0; m < 4; ++m) { bf16_t* rowp = O + (size_t)(row0 + ai * 128 + m * 16) * ldc + col0;
#pragma unroll
                for (int bj = 0; bj < 2; ++bj) { const pg8::f32x4 v0 = acc[ai][bj][m][0], v1 = acc[ai][bj][m][1];
                    u32x4 w; w.x = cvtpk_s(v0[0], v0[1]); w.y = cvtpk_s(v0[2], v0[3]); w.z = cvtpk_s(v1[0], v1[1]); w.w = cvtpk_s(v1[2], v1[3]);
                    *(u32x4*)(rowp + bj * 128) = w; } }
    }
};
struct EpiGeluBf16 {
    static constexpr bool PERM = true, AFTER_DRAIN = false;
    bf16_t* O; int ldc; const float* bias;
    __device__ __forceinline__ void operator()(const pg8::f32x4 (&acc)[2][2][4][2], const pg8::Unit& u, int wr, int wc, int fr, int fq) const {
        const int row0 = u.pm * 256 + wr * 64 + fr, col0 = u.pn * 256 + wc * 32 + 8 * fq;
        pg8::f32x4 bv[2][2];
#pragma unroll
        for (int bj = 0; bj < 2; ++bj)
#pragma unroll
            for (int n = 0; n < 2; ++n) bv[bj][n] = *(const pg8::f32x4*)(bias + col0 + bj * 128 + 4 * n);
#pragma unroll
        for (int ai = 0; ai < 2; ++ai)
#pragma unroll
            for (int m = 0; m < 4; ++m) { bf16_t* rowp = O + (size_t)(row0 + ai * 128 + m * 16) * ldc + col0;
#pragma unroll
                for (int bj = 0; bj < 2; ++bj) { pg8::f32x4 v0 = acc[ai][bj][m][0] + bv[bj][0], v1 = acc[ai][bj][m][1] + bv[bj][1];
                    const pg8::f32x2 a = pg8::gelu_pk((pg8::f32x2){v0[0], v0[1]}), b = pg8::gelu_pk((pg8::f32x2){v0[2], v0[3]}), c = pg8::gelu_pk((pg8::f32x2){v1[0], v1[1]}), d = pg8::gelu_pk((pg8::f32x2){v1[2], v1[3]});
                    u32x4 w; w.x = cvtpk_s(a.x, a.y); w.y = cvtpk_s(b.x, b.y); w.z = cvtpk_s(c.x, c.y); w.w = cvtpk_s(d.x, d.y);
                    *(u32x4*)(rowp + bj * 128) = w; } }
    }
};
struct EpiResidual {
    static constexpr bool PERM = false, AFTER_DRAIN = false;
    float* H; const float* gate0; int row_base;
    __device__ __forceinline__ void operator()(const pg8::f32x4 (&acc)[2][2][4][2], const pg8::Unit& u, int wr, int wc, int fr, int fq) const {
        const int row0 = u.pm * 256 + wr * 64 + fr, col0 = u.pn * 256 + wc * 32 + 4 * fq;
        const Tok tk = tokinfo(row_base + u.pm * 256);
        const float* gate = gate0 + (size_t)tk.modrow * 6144 + col0;
        pg8::f32x4 gv[2][2];
#pragma unroll
        for (int bj = 0; bj < 2; ++bj)
#pragma unroll
            for (int n = 0; n < 2; ++n) gv[bj][n] = *(const pg8::f32x4*)(gate + bj * 128 + n * 16);
#pragma unroll
        for (int ai = 0; ai < 2; ++ai)
#pragma unroll
            for (int m = 0; m < 4; ++m) { float* rowp = H + (size_t)(row0 + ai * 128 + m * 16) * DM + col0;
#pragma unroll
                for (int bj = 0; bj < 2; ++bj)
#pragma unroll
                    for (int n = 0; n < 2; ++n) { pg8::f32x4* p = (pg8::f32x4*)(rowp + bj * 128 + n * 16); *p = *p + gv[bj][n] * acc[ai][bj][m][n]; } }
    }
};
struct ListOrder {
    const LAS int* list; int n; const LAS unsigned* rowtab;
    __device__ __forceinline__ bool next(int i, pg8::Unit& u) const {
        if (i >= n) return false;
        u.pm = __builtin_amdgcn_readfirstlane(list[2 * i]); u.pn = __builtin_amdgcn_readfirstlane(list[2 * i + 1]); return true;
    }
    __device__ __forceinline__ void a_ready(const pg8::Unit&) const {}
    __device__ __forceinline__ void done(const pg8::Unit&) const {}
};
struct EpiLora {
    static constexpr bool PERM = true, AFTER_DRAIN = false;
    bf16_t* O; const float* bias; int row_base;
    __device__ __forceinline__ void operator()(const pg8::f32x4 (&acc)[2][2][4][2], const pg8::Unit& u, int wr, int wc, int fr, int fq) const {
        const int seg = u.pn >> 1, row0 = row_base + u.pm * 256 + wr * 64 + fr, cs0 = (u.pn & 1) * 256 + wc * 32 + 8 * fq;
        const float ksig = seg < 2 ? -0.60653065971f : 1.0f; const bool lin = seg == 4;
        bf16_t* Os = O + (size_t)seg * NTOK * 512;
#pragma unroll
        for (int bj = 0; bj < 2; ++bj) {
            const int cs = cs0 + bj * 128;
            const pg8::f32x4 b0 = *(const pg8::f32x4*)(bias + seg * 512 + cs), b1 = *(const pg8::f32x4*)(bias + seg * 512 + cs + 4);
#pragma unroll
            for (int ai = 0; ai < 2; ++ai)
#pragma unroll
                for (int m = 0; m < 4; ++m) {
                    pg8::f32x4 v0 = acc[ai][bj][m][0] + b0, v1 = acc[ai][bj][m][1] + b1;
#pragma unroll
                    for (int r = 0; r < 4; ++r) {
                        const float t0 = ksig * __builtin_amdgcn_rcpf(1.0f + __expf(-v0[r])), t1 = ksig * __builtin_amdgcn_rcpf(1.0f + __expf(-v1[r]));
                        v0[r] = lin ? v0[r] : t0; v1[r] = lin ? v1[r] : t1;
                    }
                    u32x4 w; w.x = cvtpk_s(v0[0], v0[1]); w.y = cvtpk_s(v0[2], v0[3]); w.z = cvtpk_s(v1[0], v1[1]); w.w = cvtpk_s(v1[2], v1[3]);
                    *(u32x4*)(Os + (size_t)(row0 + ai * 128 + m * 16) * 512 + cs) = w;
                }
        }
    }
};
constexpr int LDS_TAB = 131072;
constexpr int LDS_LIST = LDS_TAB + 4096;
constexpr int LDS_ROWTAB = LDS_LIST + 1024;
__device__ __forceinline__ ListOrder build_units(LAS unsigned char* lds, int nM, int nN, int G, int c, const LAS int* tile_e, int ncol) {
    LAS int* list = (LAS int*)(lds + LDS_LIST);
    pg8::StaticOrder S; S.nM = nM; S.nN = nN; S.nwg = nM * nN; S.G = G; S.c = c;
    const int tid = tid_opaque();
    if (tid < 64) { pg8::Unit u; if (S.next(tid, u)) { if (tile_e) u.pn = tile_e[u.pm] * ncol + u.pn; list[2 * tid] = u.pm; list[2 * tid + 1] = u.pn; } }
    __syncthreads();
    ListOrder L; L.list = list; L.n = (c < S.nwg) ? (S.nwg - c + G - 1) / G : 0; L.rowtab = (const LAS unsigned*)(lds + LDS_ROWTAB);
    return L;
}
struct EpiMoe1 {
    static constexpr bool PERM = true, AFTER_DRAIN = false;
    bf16_t* O; const float* b1;
    __device__ __forceinline__ void operator()(const pg8::f32x4 (&acc)[2][2][4][2], const pg8::Unit& u, int wr, int wc, int fr, int fq) const {
        const int e = u.pn >> 3, pn = u.pn & 7;
        const int row0 = u.pm * 256 + wr * 64 + fr, ci = pn * 128 + wc * 32 + 8 * fq;
        const float* be = b1 + (size_t)e * 2048 + ci;
        const pg8::f32x4 bg0 = *(const pg8::f32x4*)(be), bg1 = *(const pg8::f32x4*)(be + 4), bl0 = *(const pg8::f32x4*)(be + 1024), bl1 = *(const pg8::f32x4*)(be + 1028);
#pragma unroll
        for (int ai = 0; ai < 2; ++ai)
#pragma unroll
            for (int m = 0; m < 4; ++m) {
                const pg8::f32x4 g0 = acc[ai][0][m][0] + bg0, g1 = acc[ai][0][m][1] + bg1, l0 = acc[ai][1][m][0] + bl0, l1 = acc[ai][1][m][1] + bl1;
                float o[8];
#pragma unroll
                for (int r = 0; r < 4; ++r) {
                    const float ga = fminf(g0[r], 7.0f), gb = fminf(g1[r], 7.0f);
                    const float la = fminf(fmaxf(l0[r], -7.0f), 7.0f), lb = fminf(fmaxf(l1[r], -7.0f), 7.0f);
                    o[r] = ga * __builtin_amdgcn_rcpf(1.0f + __expf(-1.702f * ga)) * (la + 1.0f);
                    o[4 + r] = gb * __builtin_amdgcn_rcpf(1.0f + __expf(-1.702f * gb)) * (lb + 1.0f);
                }
                u32x4 w; w.x = cvtpk_s(o[0], o[1]); w.y = cvtpk_s(o[2], o[3]); w.z = cvtpk_s(o[4], o[5]); w.w = cvtpk_s(o[6], o[7]);
                *(u32x4*)(O + (size_t)(row0 + ai * 128 + m * 16) * DM + ci) = w;
            }
    }
};
struct EpiMoe2 {
    static constexpr bool PERM = true, AFTER_DRAIN = false;
    bf16_t* O; const float* b2;
    __device__ __forceinline__ void operator()(const pg8::f32x4 (&acc)[2][2][4][2], const pg8::Unit& u, int wr, int wc, int fr, int fq) const {
        const int e = u.pn >> 2, pn = u.pn & 3;
        const int row0 = u.pm * 256 + wr * 64 + fr, col0 = pn * 256 + wc * 32 + 8 * fq;
        const float* be = b2 + (size_t)e * DM + col0;
        pg8::f32x4 bv[2][2];
#pragma unroll
        for (int bj = 0; bj < 2; ++bj)
#pragma unroll
            for (int n = 0; n < 2; ++n) bv[bj][n] = *(const pg8::f32x4*)(be + bj * 128 + 4 * n);
#pragma unroll
        for (int ai = 0; ai < 2; ++ai)
#pragma unroll
            for (int m = 0; m < 4; ++m) { bf16_t* rowp = O + (size_t)(row0 + ai * 128 + m * 16) * DM + col0;
#pragma unroll
                for (int bj = 0; bj < 2; ++bj) { const pg8::f32x4 v0 = acc[ai][bj][m][0] + bv[bj][0], v1 = acc[ai][bj][m][1] + bv[bj][1];
                    u32x4 w; w.x = cvtpk_s(v0[0], v0[1]); w.y = cvtpk_s(v0[2], v0[3]); w.z = cvtpk_s(v1[0], v1[1]); w.w = cvtpk_s(v1[2], v1[3]);
                    *(u32x4*)(rowp + bj * 128) = w; } }
    }
};

namespace att {
typedef float f32x16 __attribute__((ext_vector_type(16)));
typedef short s16x4 __attribute__((ext_vector_type(4)));
constexpr int KVBLK = 64, LDR = 512;
constexpr float QSCALE = 0.125f * 1.4426950408889634f;
constexpr int SHM_V = KVBLK * 128 * 2, SHM_K = KVBLK * 64 * 2, SHM_ATTN = 2 * SHM_V + 2 * SHM_K + NWAVES * 64 * 4;
#define ATT_KSWZ(row, colB) ((row) * 128 + ((colB) ^ ((((row) >> 1) & 7) << 4)))
#define ATT_SBAR() __builtin_amdgcn_sched_barrier(0)
__device__ __forceinline__ int crow(int r, int hi) { return (r & 3) + 8 * (r >> 2) + 4 * hi; }
__device__ __forceinline__ unsigned cvtpk(float lo, float hi) { unsigned r; asm volatile("v_cvt_pk_bf16_f32 %0, %1, %2" : "=v"(r) : "v"(lo), "v"(hi)); return r; }
constexpr float SHIFT = -12.0f;
__device__ __forceinline__ void partialSM(f32x16& p0) {
#pragma unroll
    for (int r = 0; r < 16; ++r) p0[r] = __builtin_amdgcn_exp2f(p0[r]);
}
__device__ __forceinline__ void finishSM(f32x16& p0, f32x16& p1, float& l_reg, bf16x8& pa0, bf16x8& pa1, bf16x8& pa2, bf16x8& pa3) {
#pragma unroll
    for (int r = 0; r < 16; ++r) p1[r] = __builtin_amdgcn_exp2f(p1[r]);
    float ps = 0;
#pragma unroll
    for (int r = 0; r < 16; ++r) ps += p0[r];
#pragma unroll
    for (int r = 0; r < 16; ++r) ps += p1[r];
    l_reg += ps;
#define ATT_PK4(P, BASE, OUT) do { unsigned a0 = cvtpk(P[BASE + 0], P[BASE + 1]), a1 = cvtpk(P[BASE + 2], P[BASE + 3]);   \
    unsigned b0 = cvtpk(P[BASE + 4], P[BASE + 5]), b1 = cvtpk(P[BASE + 6], P[BASE + 7]);                              \
    auto r0 = __builtin_amdgcn_permlane32_swap(a0, b0, false, false); auto r1 = __builtin_amdgcn_permlane32_swap(a1, b1, false, false); \
    u32x4 w = {r0[0], r1[0], r0[1], r1[1]}; OUT = __builtin_bit_cast(bf16x8, w); } while (0)
    ATT_PK4(p0, 0, pa0); ATT_PK4(p0, 8, pa1); ATT_PK4(p1, 0, pa2); ATT_PK4(p1, 8, pa3);
#undef ATT_PK4
}
__device__ __forceinline__ void qkt(f32x16& p0, f32x16& p1, const LAS unsigned char* Ks, int qaddr, int r32, int hi) {
    asm volatile("" : "+v"(qaddr)); const LAS unsigned char* qp = (const LAS unsigned char*)(uintptr_t)qaddr;
    bf16x8 qr[4];
#pragma unroll
    for (int d0 = 0; d0 < 4; ++d0) qr[d0] = *(const LAS bf16x8*)(qp + d0 * 1024);
#pragma unroll
    for (int r = 0; r < 16; ++r) { p0[r] = SHIFT; p1[r] = SHIFT; }
#pragma unroll
    for (int d0 = 0; d0 < 4; ++d0) { const int cb = (d0 * 16 + hi * 8) * 2;
        const bf16x8 b0 = *(const LAS bf16x8*)(Ks + ATT_KSWZ(r32, cb));
        const bf16x8 b1 = *(const LAS bf16x8*)(Ks + ATT_KSWZ(32 + r32, cb));
        p0 = __builtin_amdgcn_mfma_f32_32x32x16_bf16(b0, qr[d0], p0, 0, 0, 0);
        p1 = __builtin_amdgcn_mfma_f32_32x32x16_bf16(b1, qr[d0], p1, 0, 0, 0); }
}
__device__ __forceinline__ int v_st(int k, int c) { const int kk = (k & ~0xC) | ((k & 4) << 1) | ((k & 8) >> 1); return ((kk >> 3) * 4 + (c >> 5)) * 512 + ((kk & 7) * 32 + (c & 31)) * 2; }
__device__ __forceinline__ int v_rd_base(int lane) { return ((lane & 3) << 3) | (((lane >> 2) & 3) << 6) | (((lane >> 4) & 1) << 5) | (((lane >> 5) & 1) << 8); }
constexpr int v_rd_off(int d0, int ks, int half) { return d0 * 512 + ks * 4096 + half * 2048; }
template <int OFF> __device__ __forceinline__ s16x4 tr_read(int vb) { s16x4 r; asm volatile("ds_read_b64_tr_b16 %0, %1 offset:%2" : "=&v"(r) : "v"(vb), "i"(OFF) : "memory"); return r; }
template <int D0> __device__ __forceinline__ void pv_one(f32x16& od, int vb, bf16x8 pa0, bf16x8 pa1, bf16x8 pa2, bf16x8 pa3) {
    const s16x4 l0 = tr_read<v_rd_off(D0, 0, 0)>(vb), h0 = tr_read<v_rd_off(D0, 0, 1)>(vb), l1 = tr_read<v_rd_off(D0, 1, 0)>(vb), h1 = tr_read<v_rd_off(D0, 1, 1)>(vb);
    const s16x4 l2 = tr_read<v_rd_off(D0, 2, 0)>(vb), h2 = tr_read<v_rd_off(D0, 2, 1)>(vb), l3 = tr_read<v_rd_off(D0, 3, 0)>(vb), h3 = tr_read<v_rd_off(D0, 3, 1)>(vb);
    asm volatile("s_waitcnt lgkmcnt(0)" ::: "memory"); ATT_SBAR();
#define ATT_PK(L, H) (bf16x8){L[0], L[1], L[2], L[3], H[0], H[1], H[2], H[3]}
    od = __builtin_amdgcn_mfma_f32_32x32x16_bf16(pa0, ATT_PK(l0, h0), od, 0, 0, 0);
    od = __builtin_amdgcn_mfma_f32_32x32x16_bf16(pa1, ATT_PK(l1, h1), od, 0, 0, 0);
    od = __builtin_amdgcn_mfma_f32_32x32x16_bf16(pa2, ATT_PK(l2, h2), od, 0, 0, 0);
    od = __builtin_amdgcn_mfma_f32_32x32x16_bf16(pa3, ATT_PK(l3, h3), od, 0, 0, 0);
#undef ATT_PK
}
__device__ __forceinline__ void pv_d0(f32x16 (&o)[4], int vb, bf16x8 pa0, bf16x8 pa1, bf16x8 pa2, bf16x8 pa3) {
    pv_one<0>(o[0], vb, pa0, pa1, pa2, pa3); pv_one<1>(o[1], vb, pa0, pa1, pa2, pa3); pv_one<2>(o[2], vb, pa0, pa1, pa2, pa3); pv_one<3>(o[3], vb, pa0, pa1, pa2, pa3);
}
__device__ __forceinline__ void attn_body(const bf16_t* Qb, const bf16_t* Kh, const bf16_t* Vh, float* Ob, int seq, LAS unsigned char* lds) {
    const int tid = tid_opaque(), wid = tid >> 6, lane = tid & 63, r32 = lane & 31, hi = lane >> 5;
    LAS unsigned char* V_lds = lds; LAS unsigned char* K_lds = lds + 2 * SHM_V;
    LAS float* wsl = (LAS float*)(lds + 2 * SHM_V + 2 * SHM_K) + wid * 64; LAS float* li_l = wsl; LAS float* al_l = wsl + 32;
    float l_reg = 0; f32x16 o[4] = {};
    const bf16_t* Qw = Qb + (size_t)(wid * 32 + r32) * LDR + hi * 8;
    LAS unsigned char* qlds = lds + SHM_ATTN + wid * 4096 + lane * 16;
#pragma unroll
    for (int d0 = 0; d0 < 4; ++d0) *(LAS bf16x8*)(qlds + d0 * 1024) = *(const bf16x8*)(Qw + d0 * 16);
    const int qr = (int)(uintptr_t)qlds;
    const int sr = tid >> 4, sc = (tid & 15) * 8, vst0 = v_st(sr, sc), vst1 = v_st(32 + sr, sc);
    const int kr = tid >> 3, kc = (tid & 7) * 8, kst = ATT_KSWZ(kr, kc * 2);
    const int vb0 = (int)(uintptr_t)V_lds + v_rd_base(lane);
    bf16x8 vsA0, vsA1, ksA, vsB0, vsB1, ksB;
#define ATT_SLOAD(V0, V1, K0, k0) do { V0 = *(const bf16x8*)(Vh + (size_t)((k0) + sr) * LDR + sc); V1 = *(const bf16x8*)(Vh + (size_t)((k0) + 32 + sr) * LDR + sc); \
    K0 = *(const bf16x8*)(Kh + (size_t)((k0) + kr) * LDR + kc); } while (0)
#define ATT_SWRITE(b, V0, V1, K0) do { *(LAS bf16x8*)(V_lds + (b) * SHM_V + vst0) = V0; *(LAS bf16x8*)(V_lds + (b) * SHM_V + vst1) = V1; \
    *(LAS bf16x8*)(K_lds + (b) * SHM_K + kst) = K0; } while (0)
#define ATT_SWAIT() asm volatile("s_waitcnt vmcnt(3)" ::: "memory")
    f32x16 p0, p1; bf16x8 pa0, pa1, pa2, pa3; const int NT = seq / KVBLK;
    ATT_SLOAD(vsA0, vsA1, ksA, 0); asm volatile("s_waitcnt vmcnt(0)" ::: "memory"); ATT_SWRITE(0, vsA0, vsA1, ksA);
    ATT_SLOAD(vsB0, vsB1, ksB, KVBLK); if (2 < NT) ATT_SLOAD(vsA0, vsA1, ksA, 2 * KVBLK);
    ATT_SWAIT(); ATT_SWRITE(1, vsB0, vsB1, ksB); __syncthreads();
    for (int j = 0; j < NT; j += 2) {
        ATT_SBAR(); qkt(p0, p1, K_lds, qr, r32, hi); partialSM(p0);
        finishSM(p0, p1, l_reg, pa0, pa1, pa2, pa3); ATT_SBAR();
        if (j + 3 < NT) ATT_SLOAD(vsB0, vsB1, ksB, (j + 3) * KVBLK); ATT_SBAR();
        pv_d0(o, vb0, pa0, pa1, pa2, pa3); ATT_SBAR();
        __syncthreads();
        if (j + 2 < NT) { ATT_SWAIT(); ATT_SWRITE(0, vsA0, vsA1, ksA); }
        asm volatile("" : "+v"(o[0]), "+v"(o[1]), "+v"(o[2]), "+v"(o[3]));
        __syncthreads();
        ATT_SBAR(); qkt(p0, p1, K_lds + SHM_K, qr, r32, hi); partialSM(p0);
        finishSM(p0, p1, l_reg, pa0, pa1, pa2, pa3); ATT_SBAR();
        if (j + 4 < NT) ATT_SLOAD(vsA0, vsA1, ksA, (j + 4) * KVBLK); ATT_SBAR();
        pv_d0(o, vb0 + SHM_V, pa0, pa1, pa2, pa3); ATT_SBAR();
        __syncthreads();
        if (j + 3 < NT) { ATT_SWAIT(); ATT_SWRITE(1, vsB0, vsB1, ksB); }
        asm volatile("" : "+v"(o[0]), "+v"(o[1]), "+v"(o[2]), "+v"(o[3]));
        __syncthreads();
    }
    { auto rr = __builtin_amdgcn_permlane32_swap(__float_as_uint(l_reg), __float_as_uint(l_reg), false, false); l_reg = __uint_as_float(rr[0]) + __uint_as_float(rr[1]); }
    if (hi == 0) li_l[r32] = l_reg; asm volatile("s_waitcnt lgkmcnt(0)" ::: "memory");
    float rli[16];
#pragma unroll
    for (int r = 0; r < 16; ++r) rli[r] = __builtin_amdgcn_rcpf(li_l[crow(r, hi)]);
    float* Ow = Ob + (size_t)(wid * 32) * LDR;
#pragma unroll
    for (int r = 0; r < 16; ++r) { const int orow = crow(r, hi);
#pragma unroll
        for (int d0 = 0; d0 < 4; ++d0) Ow[(size_t)orow * LDR + d0 * 32 + r32] = o[d0][r] * rli[r]; }
#undef ATT_SLOAD
#undef ATT_SWRITE
#undef ATT_SWAIT
}
}

__device__ __forceinline__ void ph_gemm_win(const Args& A, int j, int row_lo, LAS unsigned char* lds, int bid, int nb) {
    unsigned char* ws = opq(A.ws); const float* const* IN = (const float* const*)(ws + WS_PTRS); (void)IN;
    pg8::Gemm g{(const bf16_t*)(ws + WS_ABF) + (size_t)row_lo * DM, (const bf16_t*)(ws + WS_WIN) + (size_t)j * ZLD * DM, NTOK - row_lo, ZLD, DM};
    const ListOrder S = build_units(lds, (NTOK - row_lo) / 256, ZLD / 256, nb, bid, nullptr, 0);
    EpiStoreBf16 E{(bf16_t*)(ws + WS_Z) + (size_t)row_lo * ZLD, ZLD};
    pg8::gemm_phase<EpiStoreBf16, ListOrder, true, true>(lds, g, S, E);
}

__device__ __forceinline__ void ph_rwkv_pre(const Args& A, int j, int row_lo, int bid, int nb) {
    unsigned char* ws = opq(A.ws); const float* const* IN = (const float* const*)(ws + WS_PTRS);
    const int tid = tid_opaque(), lane = tid & 63, wid = tid >> 6;
    const bf16_t* Z = (const bf16_t*)(ws + WS_Z);
    const float* mu = INP(I_RWMU) + (size_t)j * 2 * RWC; const float* kkw = INP(I_RWKK) + j * 512;
    bf16_t* RB = (bf16_t*)(ws + WS_RB); bf16_t* KS = (bf16_t*)(ws + WS_KS); bf16_t* VS = (bf16_t*)(ws + WS_VS); bf16_t* KKN = (bf16_t*)(ws + WS_KKN); bf16_t* LIN = (bf16_t*)(ws + WS_LIN);
#define UNPK8(dst, raw) do { _Pragma("unroll") for (int _i = 0; _i < 4; ++_i) { dst[2 * _i] = __builtin_bit_cast(float, raw[_i] << 16); dst[2 * _i + 1] = __builtin_bit_cast(float, raw[_i] & 0xffff0000u); } } while (0)
#define PK8(v) (u32x4){pk2(v[0], v[1]), pk2(v[2], v[3]), pk2(v[4], v[5]), pk2(v[6], v[7])}
    for (int g = row_lo + bid * NWAVES + wid; g < NTOK; g += nb * NWAVES) {
        const Tok tk = tokinfo(g);
        const bool hp = tk.t > 0, hn = tk.t < tk.T - 1;
        const bf16_t* zc = Z + (size_t)g * ZLD;
#pragma unroll
        for (int i = 0; i < 4; ++i) {
            const int ch = i * 64 + lane, col = ch * 8;
            if (ch < 240) {
                const u32x4 zero = {0u, 0u, 0u, 0u};
                const u32x4 cr = *(const u32x4*)(zc + col), pr = hp ? *(const u32x4*)(zc - ZLD + col) : zero, nr = hn ? *(const u32x4*)(zc + ZLD + col) : zero;
                float z[8], p[8], n[8], s8[8];
                UNPK8(z, cr); UNPK8(p, pr); UNPK8(n, nr);
                const f32x4 m0a = *(const f32x4*)(mu + col), m0b = *(const f32x4*)(mu + col + 4), m1a = *(const f32x4*)(mu + RWC + col), m1b = *(const f32x4*)(mu + RWC + col + 4);
#pragma unroll
                for (int e = 0; e < 4; ++e) { s8[e] = z[e] + m0a[e] * (p[e] - z[e]) + m1a[e] * (n[e] - z[e]); s8[4 + e] = z[4 + e] + m0b[e] * (p[4 + e] - z[4 + e]) + m1b[e] * (n[4 + e] - z[4 + e]); }
                if (col < 512) *(u32x4*)(RB + (size_t)g * 512 + col) = PK8(s8);
                else if (col < 1024) {
                    const int ck = col - 512;
                    *(u32x4*)(KS + (size_t)g * 512 + ck) = PK8(s8);
                    const f32x4 kwa = *(const f32x4*)(kkw + ck), kwb = *(const f32x4*)(kkw + ck + 4);
                    float kk[8]; float ss = 0.f;
#pragma unroll
                    for (int e = 0; e < 4; ++e) { kk[e] = s8[e] * kwa[e]; kk[4 + e] = s8[4 + e] * kwb[e]; ss += kk[e] * kk[e] + kk[4 + e] * kk[4 + e]; }
                    ss += __shfl_xor(ss, 1); ss += __shfl_xor(ss, 2); ss += __shfl_xor(ss, 4);
                    const float inv = 1.0f / fmaxf(sqrtf(ss), 1e-12f);
#pragma unroll
                    for (int e = 0; e < 8; ++e) kk[e] *= inv;
                    *(u32x4*)(KKN + (size_t)g * 512 + ck) = PK8(kk);
                }
                else if (col < 1536) *(u32x4*)(VS + (size_t)g * 512 + (col - 1024)) = PK8(s8);
                else {
                    float t8[8];
#pragma unroll
                    for (int e = 0; e < 8; ++e) t8[e] = col < 1664 ? tanhf(s8[e]) : (col < 1792 ? s8[e] : sigmoidf_(s8[e]));
                    *(u32x4*)(LIN + (size_t)g * 384 + (col - 1536)) = PK8(t8);
                }
            }
        }
    }
#undef UNPK8
#undef PK8
}
__device__ __forceinline__ void ph_gemm_lora(const Args& A, int j, int row_lo, LAS unsigned char* lds, int bid, int nb) {
    unsigned char* ws = opq(A.ws);
    int Kq = LORA_K; asm volatile("" : "+s"(Kq));
    pg8::Gemm g{(const bf16_t*)(ws + WS_LIN) + (size_t)row_lo * LORA_K, (const bf16_t*)(ws + WS_WLORA) + (size_t)j * LORA_N * LORA_K, NTOK - row_lo, LORA_N, Kq};
    const ListOrder S = build_units(lds, (NTOK - row_lo) / 256, LORA_N / 256, nb, bid, nullptr, 0);
    EpiLora E{(bf16_t*)(ws + WS_LO), (const float*)(ws + WS_LBIAS) + (size_t)j * LORA_N, row_lo};
    pg8::gemm_phase<EpiLora, ListOrder, true, true>(lds, g, S, E);
}

constexpr int R_A2 = 0, R_RT = 2048, R_BT = 4096, R_KT = 6144, R_VT = 8192, R_MBR = 10240, R_MKR = 10752, R_G = 11264, R_P = 11776;
__device__ __forceinline__ bf16x8 frag4(u32x2 lo) { const u32x4 w = {lo.x, lo.y, 0u, 0u}; return __builtin_bit_cast(bf16x8, w); }
__device__ __forceinline__ bf16x8 frag8(u32x2 lo, u32x2 hi) { const u32x4 w = {lo.x, lo.y, hi.x, hi.y}; return __builtin_bit_cast(bf16x8, w); }
__device__ __forceinline__ u32x2 pack4(f32x4 v) { u32x2 o; o.x = cvtpk_s(v[0], v[1]); o.y = cvtpk_s(v[2], v[3]); return o; }
__device__ __forceinline__ int wkv_token(int b, int dir, int s) {
    if (s < TC) return b * TC + (dir ? (TC - 1 - s) : s);
    const int q = s - TC; return NCTX + b * TL + (dir ? (TL - 1 - q) : q);
}
__device__ __forceinline__ float dpp_row_shr(float x, const int n) {
    switch (n) {
        case 1: return __builtin_bit_cast(float, __builtin_amdgcn_update_dpp(0, __builtin_bit_cast(int, x), 0x111, 0xF, 0xF, false));
        case 2: return __builtin_bit_cast(float, __builtin_amdgcn_update_dpp(0, __builtin_bit_cast(int, x), 0x112, 0xF, 0xF, false));
        case 4: return __builtin_bit_cast(float, __builtin_amdgcn_update_dpp(0, __builtin_bit_cast(int, x), 0x114, 0xF, 0xF, false));
        default: return __builtin_bit_cast(float, __builtin_amdgcn_update_dpp(0, __builtin_bit_cast(int, x), 0x118, 0xF, 0xF, false));
    }
}
#define WKV_TR(dst, addr) asm volatile("ds_read_b64_tr_b16 %0, %1" : "=&v"(dst) : "v"(addr) : "memory")
__device__ __forceinline__ void ph_wkv_prep(const Args& A, int j, LAS unsigned char* lds, int bid, int nb) {
    unsigned char* ws = opq(A.ws); const float* const* IN = (const float* const*)(ws + WS_PTRS);
    const int tid = tid_opaque(), lane = tid & 63, wid = tid >> 6, c16 = lane & 15, g4 = lane >> 4;
    constexpr int RS = 144;
    LAS unsigned char* wl = lds + wid * 16384;
    LAS unsigned char* Lat = wl; LAS unsigned char* Lbt = wl + 2304; LAS unsigned char* Lkt = wl + 4608; LAS unsigned char* Lrt = wl + 6912; LAS unsigned char* Lvt = wl + 9216;
    LAS float* Lnf = (LAS float*)(wl + 11520);
    LAS unsigned char* Lx = wl + 12608;
    const size_t FS = (size_t)NTOK * 512;
    const bf16_t* RB = (const bf16_t*)(ws + WS_RB); const bf16_t* KS = (const bf16_t*)(ws + WS_KS); const bf16_t* VS = (const bf16_t*)(ws + WS_VS); const bf16_t* KKN = (const bf16_t*)(ws + WS_KKN);
#define UNPK16(dst, p) do { const u32x4 _a = *(const u32x4*)(p), _b = *(const u32x4*)((p) + 8); _Pragma("unroll") for (int _i = 0; _i < 4; ++_i) { \
        dst[2 * _i] = __builtin_bit_cast(float, _a[_i] << 16); dst[2 * _i + 1] = __builtin_bit_cast(float, _a[_i] & 0xffff0000u); \
        dst[8 + 2 * _i] = __builtin_bit_cast(float, _b[_i] << 16); dst[9 + 2 * _i] = __builtin_bit_cast(float, _b[_i] & 0xffff0000u); } } while (0)
#define PK16ST(base, v) do { *(LAS u32x4*)(base) = (u32x4){pk2(v[0], v[1]), pk2(v[2], v[3]), pk2(v[4], v[5]), pk2(v[6], v[7])}; \
        *(LAS u32x4*)((base) + 16) = (u32x4){pk2(v[8], v[9]), pk2(v[10], v[11]), pk2(v[12], v[13]), pk2(v[14], v[15])}; } while (0)
    for (int unit = bid * NWAVES + wid; unit < 256 * WKV_NCH; unit += nb * NWAVES) {
        const int inst = unit / WKV_NCH, c = unit - inst * WKV_NCH, dir = inst & 1, h = (inst >> 1) & 7, b = inst >> 4;
        const int g0 = wkv_token(b, dir, c * 16), gstep = dir ? -1 : 1;
        unsigned char* rec = ws + WS_WKV + (size_t)unit * WKV_REC;
        {
            const size_t o = (size_t)(g0 + gstep * c16) * 512 + h * 64 + 16 * g4;
            float lw[16], av[16], kv[16], kn[16], rv[16];
            UNPK16(lw, (const bf16_t*)(ws + WS_LO) + dir * FS + o); UNPK16(av, (const bf16_t*)(ws + WS_AB) + dir * FS + o);
            UNPK16(kv, KS + o); UNPK16(kn, KKN + o); UNPK16(rv, RB + o);
            { const u32x4 v0 = *(const u32x4*)(VS + o), v1 = *(const u32x4*)(VS + o + 8); *(LAS u32x4*)(Lvt + c16 * RS + 32 * g4) = v0; *(LAS u32x4*)(Lvt + c16 * RS + 32 * g4 + 16) = v1; }
            const float* kap = INP(I_RWKA) + j * 512 + h * 64 + 16 * g4;
            float at[16], bt[16], kt[16], rt[16], ecl[16];
#pragma unroll
            for (int i = 0; i < 16; ++i) {
                float cs = lw[i];
                cs += dpp_row_shr(cs, 1); cs += dpp_row_shr(cs, 2); cs += dpp_row_shr(cs, 4); cs += dpp_row_shr(cs, 8);
                const float ep = __expf(cs - lw[i]), ec = __expf(cs), em = __builtin_amdgcn_rcpf(ec);
                at[i] = -kn[i] * ep; bt[i] = kn[i] * av[i] * em; kt[i] = kv[i] * (1.0f + (av[i] - 1.0f) * kap[i]) * em; rt[i] = rv[i] * ec; ecl[i] = ec;
            }
            PK16ST(Lat + c16 * RS + 32 * g4, at); PK16ST(Lbt + c16 * RS + 32 * g4, bt); PK16ST(Lkt + c16 * RS + 32 * g4, kt); PK16ST(Lrt + c16 * RS + 32 * g4, rt);
            if (c16 == 15) {
#pragma unroll
                for (int q = 0; q < 4; ++q) *(f32x4*)(rec + R_P + (16 * g4 + 4 * q) * 4) = (f32x4){ecl[4 * q], ecl[4 * q + 1], ecl[4 * q + 2], ecl[4 * q + 3]};
            }
        }
        asm volatile("s_waitcnt lgkmcnt(0)" ::: "memory");
        f32x4 nD = {0.f, 0.f, 0.f, 0.f}, makD = nD, mbrD = nD, mkrD = nD;
#pragma unroll
        for (int ks = 0; ks < 2; ++ks) {
            const int off = c16 * RS + (32 * ks + 8 * g4) * 2;
            const bf16x8 fa = *(const LAS bf16x8*)(Lat + off), fb = *(const LAS bf16x8*)(Lbt + off), fk = *(const LAS bf16x8*)(Lkt + off), fr = *(const LAS bf16x8*)(Lrt + off);
            nD = __builtin_amdgcn_mfma_f32_16x16x32_bf16(fa, fb, nD, 0, 0, 0);
            makD = __builtin_amdgcn_mfma_f32_16x16x32_bf16(fa, fk, makD, 0, 0, 0);
            mbrD = __builtin_amdgcn_mfma_f32_16x16x32_bf16(fb, fr, mbrD, 0, 0, 0);
            mkrD = __builtin_amdgcn_mfma_f32_16x16x32_bf16(fk, fr, mkrD, 0, 0, 0);
        }
#pragma unroll
        for (int r = 0; r < 4; ++r) {
            const int row = 4 * g4 + r;
            nD[r] = (c16 < row) ? nD[r] : 0.f; makD[r] = (c16 < row) ? makD[r] : 0.f;
            mbrD[r] = (row <= c16) ? mbrD[r] : 0.f; mkrD[r] = (row <= c16) ? mkrD[r] : 0.f;
            Lnf[row * 17 + c16] = nD[r];
        }
        asm volatile("s_waitcnt lgkmcnt(0)" ::: "memory");
        float x[16];
#pragma unroll
        for (int t = 0; t < 16; ++t) {
            float acc = (t == c16) ? 1.f : 0.f;
#pragma unroll
            for (int i = 0; i < t; ++i) acc += Lnf[t * 17 + i] * x[i];
            x[t] = acc;
        }
        if (g4 == 0) {
#pragma unroll
            for (int t = 0; t < 16; ++t) *(LAS bf16_t*)(Lx + t * 32 + c16 * 2) = (bf16_t)f2bf(x[t]);
        }
        asm volatile("s_waitcnt lgkmcnt(0)" ::: "memory");
        const bf16x8 xB = frag4(*(const LAS u32x2*)(Lx + c16 * 32 + g4 * 8));
        const f32x4 z4 = {0.f, 0.f, 0.f, 0.f};
        const f32x4 gD = __builtin_amdgcn_mfma_f32_16x16x32_bf16(frag4(pack4(makD)), xB, z4, 0, 0, 0);
        *(u32x2*)(rec + R_G + (c16 * 16 + 4 * g4) * 2) = pack4(gD);
        *(u32x2*)(rec + R_MBR + (c16 * 16 + 4 * g4) * 2) = pack4(mbrD);
        *(u32x2*)(rec + R_MKR + (c16 * 16 + 4 * g4) * 2) = pack4(mkrD);
        {
            const int trow = c16 >> 2, tcol = 4 * (c16 & 3);
            u32x2 ta[4], tb[4], tk[4], tv[4];
#pragma unroll
            for (int m = 0; m < 4; ++m) {
                const int aA = (int)(uintptr_t)(Lat + (4 * g4 + trow) * RS + (16 * m + tcol) * 2);
                const int offr = (4 * m + trow) * RS + (16 * g4 + tcol) * 2;
                const int aB = (int)(uintptr_t)(Lbt + offr), aK = (int)(uintptr_t)(Lkt + offr), aV = (int)(uintptr_t)(Lvt + offr);
                WKV_TR(ta[m], aA); WKV_TR(tb[m], aB); WKV_TR(tk[m], aK); WKV_TR(tv[m], aV);
            }
            asm volatile("s_waitcnt lgkmcnt(0)" ::: "memory"); __builtin_amdgcn_sched_barrier(0);
#pragma unroll
            for (int m = 0; m < 4; ++m) {
                const f32x4 d = __builtin_amdgcn_mfma_f32_16x16x32_bf16(frag4(ta[m]), xB, z4, 0, 0, 0);
                *(u32x2*)(rec + R_A2 + (c16 * 64 + 16 * m + 4 * g4) * 2) = pack4(d);
            }
            const int kch = 16 * g4 + c16;
            *(u32x4*)(rec + R_BT + kch * 32) = (u32x4){tb[0].x, tb[0].y, tb[1].x, tb[1].y}; *(u32x4*)(rec + R_BT + kch * 32 + 16) = (u32x4){tb[2].x, tb[2].y, tb[3].x, tb[3].y};
            *(u32x4*)(rec + R_KT + kch * 32) = (u32x4){tk[0].x, tk[0].y, tk[1].x, tk[1].y}; *(u32x4*)(rec + R_KT + kch * 32 + 16) = (u32x4){tk[2].x, tk[2].y, tk[3].x, tk[3].y};
            *(u32x4*)(rec + R_VT + kch * 32) = (u32x4){tv[0].x, tv[0].y, tv[1].x, tv[1].y}; *(u32x4*)(rec + R_VT + kch * 32 + 16) = (u32x4){tv[2].x, tv[2].y, tv[3].x, tv[3].y};
        }
        { const int row = lane >> 2, cb = (lane & 3) * 16;
          const u32x4 r0 = *(const LAS u32x4*)(Lrt + row * RS + cb * 2), r1 = *(const LAS u32x4*)(Lrt + row * RS + cb * 2 + 16);
          *(u32x4*)(rec + R_RT + (row * 64 + cb) * 2) = r0; *(u32x4*)(rec + R_RT + (row * 64 + cb) * 2 + 16) = r1; }
        asm volatile("s_waitcnt lgkmcnt(0)" ::: "memory");
    }
#undef UNPK16
#undef PK16ST
}
constexpr int WKV_D = 6, WKV_R = WKV_D + 2;
__device__ __forceinline__ void ph_wkv_scan(const Args& A, LAS unsigned char* lds, int bid, int nb) {
    unsigned char* ws = opq(A.ws);
    const int tid = tid_opaque(), lane = tid & 63, wid = __builtin_amdgcn_readfirstlane(tid >> 6), c16 = lane & 15, g4 = lane >> 4;
    float* YS = (float*)(ws + WS_YS); const size_t FS = (size_t)NTOK * 512;
    for (int inst = bid; inst < 256; inst += nb) {
        const int dir = inst & 1, h = (inst >> 1) & 7, b = inst >> 4;
        const unsigned char* rec0 = ws + WS_WKV + (size_t)inst * WKV_NCH * WKV_REC;
        asm volatile("s_waitcnt vmcnt(0) lgkmcnt(0)" ::: "memory"); __builtin_amdgcn_s_barrier();
        if (wid >= 4) {
            const int p0 = 3 * (wid - 4);
#define WKV_ISSUE(c_) do { const unsigned char* src_ = rec0 + (size_t)(c_) * WKV_REC + p0 * 1024 + lane * 16; LAS unsigned char* dst_ = lds + ((c_) % WKV_R) * WKV_REC + p0 * 1024; \
        _Pragma("unroll") for (int i_ = 0; i_ < 3; ++i_) __builtin_amdgcn_global_load_lds((const unsigned*)(src_ + i_ * 1024), (LAS unsigned*)(dst_ + i_ * 1024), 16, 0, 0); } while (0)
            for (int c = 0; c < WKV_D; ++c) WKV_ISSUE(c);
            for (int c = 0; c < WKV_NCH; ++c) {
                if (c + WKV_D < WKV_NCH) { WKV_ISSUE(c + WKV_D); asm volatile("s_waitcnt vmcnt(18)" ::: "memory"); }
                else asm volatile("s_waitcnt vmcnt(0)" ::: "memory");
                __builtin_amdgcn_s_barrier();
            }
#undef WKV_ISSUE
        } else {
            const int v0 = wid * 16;
            float* Y = YS + dir * FS + h * 64 + v0 + c16;
            f32x4 S[4];
#pragma unroll
            for (int mt = 0; mt < 4; ++mt) S[mt] = (f32x4){0.f, 0.f, 0.f, 0.f};
            for (int c = 0; c < WKV_NCH; ++c) {
                __builtin_amdgcn_s_barrier();
                const LAS unsigned char* rec = lds + (c % WKV_R) * WKV_REC;
                u32x2 a2[4], rt[4], bt[4], kt[4]; f32x4 p[4];
#pragma unroll
                for (int q = 0; q < 4; ++q) {
                    a2[q] = *(const LAS u32x2*)(rec + R_A2 + (c16 * 64 + 16 * q + 4 * g4) * 2);
                    rt[q] = *(const LAS u32x2*)(rec + R_RT + (c16 * 64 + 16 * q + 4 * g4) * 2);
                    bt[q] = *(const LAS u32x2*)(rec + R_BT + ((16 * q + c16) * 16 + 4 * g4) * 2);
                    kt[q] = *(const LAS u32x2*)(rec + R_KT + ((16 * q + c16) * 16 + 4 * g4) * 2);
                    p[q] = *(const LAS f32x4*)(rec + R_P + (16 * q + 4 * g4) * 4);
                }
                const u32x2 gq = *(const LAS u32x2*)(rec + R_G + (c16 * 16 + 4 * g4) * 2), mkr = *(const LAS u32x2*)(rec + R_MKR + (c16 * 16 + 4 * g4) * 2), mbr = *(const LAS u32x2*)(rec + R_MBR + (c16 * 16 + 4 * g4) * 2);
                const u32x2 vt = *(const LAS u32x2*)(rec + R_VT + ((v0 + c16) * 16 + 4 * g4) * 2);
                const f32x4 z4 = {0.f, 0.f, 0.f, 0.f};
                const bf16x8 sb0 = frag8(pack4(S[0]), pack4(S[1])), sb1 = frag8(pack4(S[2]), pack4(S[3]));
                const bf16x8 vb = frag4(vt);
                f32x4 U = __builtin_amdgcn_mfma_f32_16x16x32_bf16(frag4(gq), vb, z4, 0, 0, 0);
                U = __builtin_amdgcn_mfma_f32_16x16x32_bf16(frag8(a2[0], a2[1]), sb0, U, 0, 0, 0);
                U = __builtin_amdgcn_mfma_f32_16x16x32_bf16(frag8(a2[2], a2[3]), sb1, U, 0, 0, 0);
                f32x4 Yt = __builtin_amdgcn_mfma_f32_16x16x32_bf16(frag4(mkr), vb, z4, 0, 0, 0);
                Yt = __builtin_amdgcn_mfma_f32_16x16x32_bf16(frag8(rt[0], rt[1]), sb0, Yt, 0, 0, 0);
                Yt = __builtin_amdgcn_mfma_f32_16x16x32_bf16(frag8(rt[2], rt[3]), sb1, Yt, 0, 0, 0);
                const bf16x8 ub = frag4(pack4(U));
                Yt = __builtin_amdgcn_mfma_f32_16x16x32_bf16(frag4(mbr), ub, Yt, 0, 0, 0);
#pragma unroll
                for (int mt = 0; mt < 4; ++mt) {
                    f32x4 sn = __builtin_amdgcn_mfma_f32_16x16x32_bf16(frag4(kt[mt]), vb, S[mt], 0, 0, 0);
                    sn = __builtin_amdgcn_mfma_f32_16x16x32_bf16(frag4(bt[mt]), ub, sn, 0, 0, 0);
                    S[mt] = sn * p[mt];
                }
#pragma unroll
                for (int r = 0; r < 4; ++r) Y[(size_t)wkv_token(b, dir, c * 16 + 4 * g4 + r) * 512] = Yt[r];
            }
        }
    }
}

__device__ __forceinline__ void ph_qk(const Args& A, int j, int row_lo, int bid, int nb) {
    unsigned char* ws = opq(A.ws); const float* const* IN = (const float* const*)(ws + WS_PTRS);
    const int tid = tid_opaque(), lane = tid & 63, wid = tid >> 6;
    const bf16_t* Z = (const bf16_t*)(ws + WS_Z);
    bf16_t* QB = (bf16_t*)(ws + WS_QB); bf16_t* KB = (bf16_t*)(ws + WS_KB); bf16_t* VB = (bf16_t*)(ws + WS_VB);
    const int d0 = (lane & 7) * 8;
    float qn[8], kn[8], invf[8];
#pragma unroll
    for (int i = 0; i < 8; ++i) { qn[i] = INP(I_QN)[j * 64 + d0 + i]; kn[i] = INP(I_KN)[j * 64 + d0 + i]; invf[i] = __powf(10000.0f, -(float)((d0 + i) & 15) / 16.0f); }
    const bool upper = (d0 & 16) != 0, colaxis = (d0 & 32) != 0;
    for (int g = row_lo + bid * NWAVES + wid; g < NTOK; g += nb * NWAVES) {
        const Tok tk = tokinfo(g);
        const size_t krow = (size_t)tk.b * (TC + TL) + (tk.T == TL ? TC + tk.t : tk.t);
        const bf16_t* zr = Z + (size_t)g * ZLD + RWC;
        *(u32x4*)(VB + krow * 512 + lane * 8) = *(const u32x4*)(zr + 1024 + lane * 8);
        float cs[8], sn[8];
        if (tk.T == TL) {
            const float pos = (float)(colaxis ? (tk.t & 63) : (tk.t >> 6));
#pragma unroll
            for (int i = 0; i < 8; ++i) __sincosf(pos * invf[i], &sn[i], &cs[i]);
        }
#pragma unroll
        for (int isk = 0; isk < 2; ++isk) {
            const u32x4 raw = *(const u32x4*)(zr + isk * 512 + lane * 8);
            float x[8];
#pragma unroll
            for (int i = 0; i < 4; ++i) { x[2 * i] = __builtin_bit_cast(float, raw[i] << 16); x[2 * i + 1] = __builtin_bit_cast(float, raw[i] & 0xffff0000u); }
            float ss = 0.f;
#pragma unroll
            for (int i = 0; i < 8; ++i) ss += x[i] * x[i];
            ss += __shfl_xor(ss, 1); ss += __shfl_xor(ss, 2); ss += __shfl_xor(ss, 4);
            const float rs = rsqrtf(ss * (1.0f / 64.0f) + 1e-6f);
#pragma unroll
            for (int i = 0; i < 8; ++i) x[i] = x[i] * rs * (isk ? kn[i] : qn[i] * att::QSCALE);
            if (tk.T == TL) {
#pragma unroll
                for (int i = 0; i < 8; ++i) { const float other = __shfl_xor(x[i], 2); x[i] = upper ? (x[i] * cs[i] + other * sn[i]) : (x[i] * cs[i] - other * sn[i]); }
            }
            u32x4 o; o.x = pk2(x[0], x[1]); o.y = pk2(x[2], x[3]); o.z = pk2(x[4], x[5]); o.w = pk2(x[6], x[7]);
            if (isk) *(u32x4*)(KB + krow * 512 + lane * 8) = o; else *(u32x4*)(QB + (size_t)g * 512 + lane * 8) = o;
        }
    }
}

__device__ __forceinline__ void ph_attn(const Args& A, bool want_ctx, LAS unsigned char* lds, int bid, int nb) {
    unsigned char* ws = opq(A.ws);
    const bf16_t* QB = (const bf16_t*)(ws + WS_QB); const bf16_t* KB = (const bf16_t*)(ws + WS_KB); const bf16_t* VB = (const bf16_t*)(ws + WS_VB);
    float* OP = (float*)(ws + WS_OP);
    const int vcu = (nb % 8 == 0) ? (bid % 8) * (nb / 8) + bid / 8 : bid;
    const int nunits = 1024 + (want_ctx ? 128 : 0);
    for (int u = vcu; u < nunits; u += nb) {
        int b, h, m, q0, seq;
        if (u < 1024) { const int qb = u & 7; m = (u >> 3) & 1; h = (u >> 4) & 3; b = u >> 6; q0 = NCTX + b * TL + qb * 256; seq = TC + TL; }
        else { const int v = u - 1024; m = v & 1; h = (v >> 1) & 3; b = v >> 3; q0 = b * TC; seq = TC; }
        const int s = h * 2 + m;
        att::attn_body(QB + (size_t)q0 * 512 + s * 64, KB + (size_t)b * (TC + TL) * 512 + s * 64, VB + (size_t)b * (TC + TL) * 512 + h * 128,
                       OP + (size_t)m * NTOK * 512 + (size_t)q0 * 512 + h * 128, seq, lds);
    }
}

__device__ __forceinline__ void ph_merge(const Args& A, int l, int row_lo, int bid, int nb) {
    unsigned char* ws = opq(A.ws); const float* const* IN = (const float* const*)(ws + WS_PTRS);
    const int j = l >> 1;
    const int tid = tid_opaque(), lane = tid & 63, wid = tid >> 6, c0 = lane * 8;
    const float lam_init = 0.8f - 0.6f * __expf(-0.3f * (float)l);
    const float* lp = INP(I_LAM) + j * 4 * 64;
    const float lam = __expf(wave_sum(lp[lane] * lp[64 + lane])) - __expf(wave_sum(lp[128 + lane] * lp[192 + lane])) + lam_init;
    const size_t FS = (size_t)NTOK * 512;
    const bf16_t* RB = (const bf16_t*)(ws + WS_RB); const bf16_t* KS = (const bf16_t*)(ws + WS_KS); const bf16_t* VS = (const bf16_t*)(ws + WS_VS);
    const bf16_t* AB = (const bf16_t*)(ws + WS_AB); const bf16_t* GB = (const bf16_t*)(ws + WS_GB);
    const float* YS = (const float*)(ws + WS_YS); const float* OP = (const float*)(ws + WS_OP);
    bf16_t* CAT = (bf16_t*)(ws + WS_CAT);
    float gnw[8], gnb[8], kaw[8], rkw[8], sub[8];
#pragma unroll
    for (int i = 0; i < 8; ++i) { gnw[i] = INP(I_GNW)[j * 512 + c0 + i]; gnb[i] = INP(I_GNB)[j * 512 + c0 + i]; kaw[i] = INP(I_RWKA)[j * 512 + c0 + i]; rkw[i] = INP(I_RWRK)[j * 512 + c0 + i];
        sub[i] = INP(I_SUBLN)[j * 128 + ((c0 + i) & 127)] * (1.0f - lam_init); }
#define LD8BF(dst, ptr) do { const u32x4 _t = *(const u32x4*)(ptr); _Pragma("unroll") for (int _i = 0; _i < 4; ++_i) { dst[2 * _i] = __builtin_bit_cast(float, _t[_i] << 16); dst[2 * _i + 1] = __builtin_bit_cast(float, _t[_i] & 0xffff0000u); } } while (0)
    for (int g = row_lo + bid * NWAVES + wid; g < NTOK; g += nb * NWAVES) {
        const size_t o = (size_t)g * 512 + c0;
        float y[8], r_[8], k_[8], v_[8], a0[8], a1[8], gg[8];
        { const f32x4 y0 = *(const f32x4*)(YS + o), y1 = *(const f32x4*)(YS + o + 4), z0 = *(const f32x4*)(YS + FS + o), z1 = *(const f32x4*)(YS + FS + o + 4);
#pragma unroll
          for (int i = 0; i < 4; ++i) { y[i] = y0[i] + z0[i]; y[4 + i] = y1[i] + z1[i]; } }
        LD8BF(r_, RB + o); LD8BF(k_, KS + o); LD8BF(v_, VS + o); LD8BF(a0, AB + o); LD8BF(a1, AB + FS + o); LD8BF(gg, GB + o);
        float sy = 0.f, sb = 0.f;
#pragma unroll
        for (int i = 0; i < 8; ++i) { sy += y[i]; sb += r_[i] * k_[i] * (2.0f + (a0[i] + a1[i] - 2.0f) * kaw[i]) * rkw[i]; }
        sy += __shfl_xor(sy, 1); sy += __shfl_xor(sy, 2); sy += __shfl_xor(sy, 4);
        sb += __shfl_xor(sb, 1); sb += __shfl_xor(sb, 2); sb += __shfl_xor(sb, 4);
        const float mu = sy * (1.0f / 64.0f);
        float sv = 0.f;
#pragma unroll
        for (int i = 0; i < 8; ++i) { y[i] -= mu; sv += y[i] * y[i]; }
        sv += __shfl_xor(sv, 1); sv += __shfl_xor(sv, 2); sv += __shfl_xor(sv, 4);
        const float rstd = rsqrtf(sv * (1.0f / 64.0f) + 64e-5f);
        float ya[8];
#pragma unroll
        for (int i = 0; i < 8; ++i) ya[i] = (y[i] * rstd * gnw[i] + gnb[i] + sb * v_[i]) * gg[i];
        { u32x4 w; w.x = pk2(ya[0], ya[1]); w.y = pk2(ya[2], ya[3]); w.z = pk2(ya[4], ya[5]); w.w = pk2(ya[6], ya[7]); *(u32x4*)(CAT + (size_t)g * DM + c0) = w; }
        float od[8];
        { const f32x4 p0 = *(const f32x4*)(OP + o), p1 = *(const f32x4*)(OP + o + 4), q0 = *(const f32x4*)(OP + FS + o), q1 = *(const f32x4*)(OP + FS + o + 4);
#pragma unroll
          for (int i = 0; i < 4; ++i) { od[i] = p0[i] - lam * q0[i]; od[4 + i] = p1[i] - lam * q1[i]; } }
        float so = 0.f;
#pragma unroll
        for (int i = 0; i < 8; ++i) so += od[i] * od[i];
        so += __shfl_xor(so, 1); so += __shfl_xor(so, 2); so += __shfl_xor(so, 4); so += __shfl_xor(so, 8);
        const float ro = rsqrtf(so * (1.0f / 128.0f) + 1e-6f);
        { u32x4 w; w.x = pk2(od[0] * ro * sub[0], od[1] * ro * sub[1]); w.y = pk2(od[2] * ro * sub[2], od[3] * ro * sub[3]);
          w.z = pk2(od[4] * ro * sub[4], od[5] * ro * sub[5]); w.w = pk2(od[6] * ro * sub[6], od[7] * ro * sub[7]); *(u32x4*)(CAT + (size_t)g * DM + 512 + c0) = w; }
    }
#undef LD8BF
}

__device__ __forceinline__ void ph_gemm_out(const Args& A, int l, size_t x_off, size_t wt_off, int row_lo, LAS unsigned char* lds, int bid, int nb) {
    unsigned char* ws = opq(A.ws); const float* const* IN = (const float* const*)(ws + WS_PTRS); (void)IN;
    pg8::Gemm g{(const bf16_t*)(ws + x_off) + (size_t)row_lo * DM, (const bf16_t*)(ws + wt_off), NTOK - row_lo, DM, DM};
    const ListOrder S = build_units(lds, (NTOK - row_lo) / 256, DM / 256, nb, bid, nullptr, 0);
    EpiResidual E{(float*)(ws + WS_H) + (size_t)row_lo * DM, (const float*)(ws + WS_MOD) + (size_t)l * 17 * 6144 + 2 * 1024, row_lo};
    pg8::gemm_phase<EpiResidual, ListOrder, true, true>(lds, g, S, E);
}

__device__ __forceinline__ void ph_gemm_sgin(const Args& A, int j, int row_lo, LAS unsigned char* lds, int bid, int nb) {
    unsigned char* ws = opq(A.ws); const float* const* IN = (const float* const*)(ws + WS_PTRS); (void)IN;
    pg8::Gemm g{(const bf16_t*)(ws + WS_ABF) + (size_t)row_lo * DM, (const bf16_t*)(ws + WS_SGIN) + (size_t)j * 2048 * DM, NTOK - row_lo, 2048, DM};
    const ListOrder S = build_units(lds, (NTOK - row_lo) / 256, 2048 / 256, nb, bid, nullptr, 0);
    EpiGeluBf16 E{(bf16_t*)(ws + WS_Z2) + (size_t)row_lo * 2048, 2048, INP(I_SGBIN) + j * 2048};
    pg8::gemm_phase<EpiGeluBf16, ListOrder, true, true>(lds, g, S, E);
}
__device__ __forceinline__ void ph_sgu_stats(const Args& A, int row_lo, int bid, int nb) {
    unsigned char* ws = opq(A.ws);
    const int tid = tid_opaque(), lane = tid & 63, wid = tid >> 6;
    const bf16_t* Z2 = (const bf16_t*)(ws + WS_Z2); float* ST = (float*)(ws + WS_VST);
    for (int row = row_lo + bid * NWAVES + wid; row < NTOK; row += nb * NWAVES) {
        const u32x4 t0 = *(const u32x4*)(Z2 + (size_t)row * 2048 + 1024 + lane * 8), t1 = *(const u32x4*)(Z2 + (size_t)row * 2048 + 1536 + lane * 8);
        float v[16]; float s = 0.f;
#pragma unroll
        for (int i = 0; i < 4; ++i) { v[2 * i] = __builtin_bit_cast(float, t0[i] << 16); v[2 * i + 1] = __builtin_bit_cast(float, t0[i] & 0xffff0000u);
            v[8 + 2 * i] = __builtin_bit_cast(float, t1[i] << 16); v[9 + 2 * i] = __builtin_bit_cast(float, t1[i] & 0xffff0000u); }
#pragma unroll
        for (int i = 0; i < 16; ++i) s += v[i];
        const float mean = wave_sum(s) * (1.0f / 1024.0f); float s2 = 0.f;
#pragma unroll
        for (int i = 0; i < 16; ++i) { const float d = v[i] - mean; s2 += d * d; }
        const float rstd = rsqrtf(wave_sum(s2) * (1.0f / 1024.0f) + 1e-5f);
        if (lane == 0) { ST[(size_t)row * 2] = mean; ST[(size_t)row * 2 + 1] = rstd; }
    }
}
__device__ __forceinline__ void ph_sgu_spatial(const Args& A, int j, int row_lo, LAS unsigned char* lds, int bid, int nb) {
    unsigned char* ws = opq(A.ws); const float* const* IN = (const float* const*)(ws + WS_PTRS);
    const int tid = tid_opaque(), lane = tid & 63, wid = tid >> 6, c16 = lane & 15, g4 = lane >> 4;
    const bf16_t* Z2 = (const bf16_t*)(ws + WS_Z2); const float* ST = (const float*)(ws + WS_VST); bf16_t* G = (bf16_t*)(ws + WS_G);
    constexpr int VS = 272;
    LAS unsigned char* vt = lds;
    LAS float* stl = (LAS float*)(lds + 36864);
    const int ch0 = row_lo / 128, nch = NTOK / 128 - ch0;
    for (int u = bid; u < nch * 8; u += nb) {
        const int ci = ch0 + u / 8, g = u % 8;
        const size_t r0 = (size_t)ci * 128;
        __syncthreads();
#pragma unroll
        for (int i = 0; i < 4; ++i) {
            const int idx = tid + NTHREADS * i, q = idx >> 4, jc = idx & 15;
            const u32x4 t = *(const u32x4*)(Z2 + (r0 + q) * 2048 + 1024 + g * 128 + jc * 8);
#pragma unroll
            for (int e = 0; e < 4; ++e) { *(LAS bf16_t*)(vt + (jc * 8 + 2 * e) * VS + q * 2) = (bf16_t)(t[e] & 0xffffu); *(LAS bf16_t*)(vt + (jc * 8 + 2 * e + 1) * VS + q * 2) = (bf16_t)(t[e] >> 16); }
        }
        if (tid < 256) stl[tid] = ST[r0 * 2 + tid];
        __syncthreads();
        const float* wrow = INP(I_SGWS) + (((size_t)j * 8 + g) * 128 + 16 * wid + c16) * 128;
        bf16x8 af[4]; float wm = 0.f, rs = 0.f;
#pragma unroll
        for (int ks = 0; ks < 4; ++ks) {
            const int q0 = 32 * ks + 8 * g4;
            const f32x4 w0 = *(const f32x4*)(wrow + q0), w1 = *(const f32x4*)(wrow + q0 + 4);
            float wv[8] = {w0[0], w0[1], w0[2], w0[3], w1[0], w1[1], w1[2], w1[3]};
#pragma unroll
            for (int e = 0; e < 8; ++e) { rs += wv[e]; wv[e] *= stl[(q0 + e) * 2 + 1]; wm += wv[e] * stl[(q0 + e) * 2]; }
            const u32x4 pk = {pk2(wv[0], wv[1]), pk2(wv[2], wv[3]), pk2(wv[4], wv[5]), pk2(wv[6], wv[7])};
            af[ks] = __builtin_bit_cast(bf16x8, pk);
        }
        wm += __shfl_xor(wm, 16); wm += __shfl_xor(wm, 32); rs += __shfl_xor(rs, 16); rs += __shfl_xor(rs, 32);
        f32x4 acc[8];
#pragma unroll
        for (int nt = 0; nt < 8; ++nt) acc[nt] = (f32x4){0.f, 0.f, 0.f, 0.f};
#pragma unroll
        for (int ks = 0; ks < 4; ++ks)
#pragma unroll
            for (int nt = 0; nt < 8; ++nt) {
                const bf16x8 bfr = *(const LAS bf16x8*)(vt + (16 * nt + c16) * VS + (32 * ks + 8 * g4) * 2);
                acc[nt] = __builtin_amdgcn_mfma_f32_16x16x32_bf16(af[ks], bfr, acc[nt], 0, 0, 0);
            }
        float wmr[4], rsr[4], bsr[4];
#pragma unroll
        for (int r = 0; r < 4; ++r) { wmr[r] = __shfl(wm, 4 * g4 + r); rsr[r] = __shfl(rs, 4 * g4 + r); bsr[r] = INP(I_SGBS)[((size_t)j * 8 + g) * 128 + 16 * wid + 4 * g4 + r]; }
#pragma unroll
        for (int nt = 0; nt < 8; ++nt) {
            const int c = g * 128 + 16 * nt + c16;
            const float lg = INP(I_SGLNG)[j * 1024 + c], lb = INP(I_SGLNB)[j * 1024 + c];
#pragma unroll
            for (int r = 0; r < 4; ++r) {
                const size_t row = r0 + 16 * wid + 4 * g4 + r;
                const float sv = lg * (acc[nt][r] - wmr[r]) + rsr[r] * lb + bsr[r];
                G[row * DM + c] = (bf16_t)f2bf(bf2f(Z2[row * 2048 + c]) * sv);
            }
        }
    }
}

__device__ __forceinline__ int moe_layout(const Args& A, int l, int bid, int nb, LAS int* off  , LAS int* cntl  , LAS int* tile_e  , LAS int* base  ) {
    const int tid = tid_opaque();
    const int* bc = (const int*)(opq(A.ws) + WS_BCNT) + (size_t)l * 256 * 32;
    if (tid < 64) {
        int n = 0, pre = 0;
        if (tid < 32) {
#pragma unroll 8
            for (int b = 0; b < nb; ++b) { const int c = bc[b * 32 + tid]; n += c; pre += (b < bid) ? c : 0; }
        }
        const int nt = (n + 255) >> 8;
        int x = nt;
#pragma unroll
        for (int o = 1; o < 32; o <<= 1) { const int y = __shfl_up(x, o); if (tid >= o) x += y; }
        const int start = x - nt;
        if (tid < 32) {
            cntl[tid] = n; off[tid] = start * 256; base[tid] = start * 256 + pre;
#pragma unroll 1
            for (int t = 0; t < nt; ++t) tile_e[start + t] = tid;
        }
        if (tid == 31) off[32] = x * 256;
    }
    __syncthreads();
    return off[32] >> 8;
}
__device__ __forceinline__ void ph_moe_scatter(const Args& A, int l, int row_lo, LAS unsigned char* lds, int bid, int nb) {
    unsigned char* ws = opq(A.ws);
    const int tid = tid_opaque();
    LAS int* off = (LAS int*)(lds + LDS_TAB); LAS int* cntl = off + 64; LAS int* tile_e = off + 128; LAS int* base = off + 800;
    moe_layout(A, l, bid, nb, off, cntl, tile_e, base);
    const int* te = (const int*)(ws + WS_TOKE); const int* tr = (const int*)(ws + WS_TOKR); int* rowof = (int*)(ws + WS_ROWOF); int* srcrow = (int*)(ws + WS_SRCROW);
    const int ngroups = (NTOK - row_lo) / 16, per = nb * NWAVES;
    const int nmine = (ngroups - bid * NWAVES + per - 1) / per * NWAVES;
    for (int q = tid; q < nmine * 64; q += NTHREADS) {
        const int slot = q >> 6, r = (q >> 2) & 15, k = q & 3, i = slot >> 3, w = slot & 7;
        const int u = i * per + bid * NWAVES + w;
        if (u < ngroups) {
            const int row = row_lo + 16 * u + r;
            const int e = te[(size_t)row * 4 + k];
            const int pos = base[e] + tr[(size_t)row * 4 + k];
            rowof[(size_t)row * 4 + k] = pos; srcrow[pos] = row;
        }
    }
    for (int e = bid; e < 32; e += nb) {
        const int r0 = off[e] + cntl[e], r1 = off[e + 1];
        for (int i = r0 + tid; i < r1; i += NTHREADS) srcrow[i] = NCTX;
    }
}
__device__ __forceinline__ void ph_moe_gemm1(const Args& A, int l, LAS unsigned char* lds, int bid, int nb) {
    unsigned char* ws = opq(A.ws); const float* const* IN = (const float* const*)(ws + WS_PTRS); (void)IN;
    LAS int* off = (LAS int*)(lds + LDS_TAB); LAS int* cntl = off + 64; LAS int* tile_e = off + 128; LAS int* base = off + 800;
    const int T = moe_layout(A, l, bid, nb, off, cntl, tile_e, base);
    pg8::Gemm g{(const bf16_t*)(ws + WS_ABF), (const bf16_t*)(ws + WS_W1) + (size_t)l * NE * 2048 * DM, T * 256, 2048, DM};
    const ListOrder S = build_units(lds, T, 8, nb, bid, tile_e, 8);
    { LAS unsigned* rowtab = (LAS unsigned*)(lds + LDS_ROWTAB); const int* srcrow = (const int*)(ws + WS_SRCROW); const int tid = tid_opaque();
      for (int q = tid; q < S.n * 256; q += NTHREADS) rowtab[q] = (unsigned)srcrow[S.list[2 * (q >> 8)] * 256 + (q & 255)] * (unsigned)(DM * 2);
      __syncthreads(); }
    EpiMoe1 E{(bf16_t*)(ws + WS_ACT), INP(I_B1) + (size_t)l * NE * 2048};
    pg8::gemm_phase<EpiMoe1, ListOrder, true, true, true>(lds, g, S, E);
}
__device__ __forceinline__ void ph_moe_gemm2(const Args& A, int l, LAS unsigned char* lds, int bid, int nb) {
    unsigned char* ws = opq(A.ws); const float* const* IN = (const float* const*)(ws + WS_PTRS); (void)IN;
    LAS int* off = (LAS int*)(lds + LDS_TAB); LAS int* cntl = off + 64; LAS int* tile_e = off + 128; LAS int* base = off + 800;
    const int T = moe_layout(A, l, bid, nb, off, cntl, tile_e, base);
    pg8::Gemm g{(const bf16_t*)(ws + WS_ACT), (const bf16_t*)(ws + WS_W2) + (size_t)l * NE * DM * DM, T * 256, DM, DM};
    const ListOrder S = build_units(lds, T, 4, nb, bid, tile_e, 4);
    EpiMoe2 E{(bf16_t*)(ws + WS_YM), INP(I_B2) + (size_t)l * NE * DM};
    pg8::gemm_phase<EpiMoe2, ListOrder, true, true>(lds, g, S, E);
}
__device__ __forceinline__ void ph_moe_combine(const Args& A, int l, int row_lo, bool last, int bid, int nb, bool dry = false) {
    unsigned char* ws = opq(A.ws); const float* const* IN = (const float* const*)(ws + WS_PTRS);
    const int tid = tid_opaque(), lane = tid & 63, wid = tid >> 6;
    float* H = (float*)(ws + WS_H); const float* mod = (const float*)(ws + WS_MOD); const bf16_t* YM = (const bf16_t*)(ws + WS_YM);
    float* Hw = dry ? (float*)(ws + WS_XP) : H;
    const int* rowof = (const int*)(ws + WS_ROWOF); const float* tg = (const float*)(ws + WS_TOKG);
    bf16_t* abf = dry ? (bf16_t*)(ws + WS_XP + (size_t)NTOK * DM * 4) : (bf16_t*)(ws + WS_ABF);
    const int ln = last ? l : l + 1;
    const float* gp = INP(I_N1G) + ln * 1024;
    for (int row = row_lo + bid * NWAVES + wid; row < NTOK; row += nb * NWAVES) {
        const Tok tk = tokinfo(row);
        const float* gate = mod + ((size_t)l * 17 + tk.modrow) * 6144 + 5 * 1024;
        int r[4]; float gk[4];
#pragma unroll
        for (int k = 0; k < 4; ++k) { r[k] = rowof[(size_t)row * 4 + k]; gk[k] = tg[(size_t)row * 4 + k]; }
        f32x4 hv[4]; float ss = 0.f;
#pragma unroll
        for (int q = 0; q < 4; ++q) {
            const int col = q * 256 + lane * 4;
            f32x4 m = (f32x4){0.f, 0.f, 0.f, 0.f};
#pragma unroll
            for (int k = 0; k < 4; ++k) { const u32x2 t = *(const u32x2*)(YM + (size_t)r[k] * DM + col);
                m = m + (f32x4){__builtin_bit_cast(float, t.x << 16), __builtin_bit_cast(float, t.x & 0xffff0000u), __builtin_bit_cast(float, t.y << 16), __builtin_bit_cast(float, t.y & 0xffff0000u)} * gk[k]; }
            hv[q] = *(const f32x4*)(H + (size_t)row * DM + col) + *(const f32x4*)(gate + col) * m;
            if (last && !dry) *(f32x4*)(as_global(((float* const*)IN)[38]) + (size_t)(row - NCTX) * DM + col) = hv[q];
            else *(f32x4*)(Hw + (size_t)row * DM + col) = hv[q];
            ss += (hv[q].x * hv[q].x + hv[q].y * hv[q].y) + (hv[q].z * hv[q].z + hv[q].w * hv[q].w);
        }
        if (!last) {
            const float rstd = rsqrtf(wave_sum(ss) * (1.0f / DM) + 1e-6f);
            const float* mrow = mod + ((size_t)ln * 17 + tk.modrow) * 6144;
#pragma unroll
            for (int q = 0; q < 4; ++q) {
                const int col = q * 256 + lane * 4;
                const f32x4 g = *(const f32x4*)(gp + col), sc = *(const f32x4*)(mrow + 1024 + col), sh = *(const f32x4*)(mrow + col);
                const f32x4 v = (hv[q] * rstd * g) * (sc + 1.0f) + sh;
                u32x2 o; o.x = pk2(v.x, v.y); o.y = pk2(v.z, v.w);
                *(u32x2*)(abf + (size_t)row * DM + col) = o;
            }
        }
    }
}

__global__ void __launch_bounds__(NTHREADS, 2) fwd_kernel(Args A) {
    extern __shared__ __attribute__((aligned(16))) unsigned char lds_raw[];
    LAS unsigned char* lds = (LAS unsigned char*)lds_raw;
    volatile LAS unsigned* misc = (volatile LAS unsigned*)(lds + LDS_MISC);
    const int tid = threadIdx.x, bid = blockIdx.x, nb = gridDim.x;
    if (tid < 64) misc[tid] = 0u;
    __syncthreads();
    XcdBarrier bar = xcd_barrier_post((unsigned*)(A.ws + WS_CTL) + CW_BAR, misc + 8);
    const int lo = A.ph_lo, hi = A.ph_hi;
    int pc = 0;
#ifndef PHSEL
#define PHSEL -1
#endif
#define SEL(k) (PHSEL < 0 || PHSEL == (k))
#ifndef REPEAT_MASK
#define REPEAT_MASK 0
#endif
#define RUN(k, call) do { if (SEL(k)) { call; if ((REPEAT_MASK >> (k)) & 1) { xcd_barrier(bar); call; } } } while (0)
#define PH_BEGIN if (pc >= lo && pc < hi) {
#define PH_END } if (pc >= lo && pc + 1 < hi) xcd_barrier(bar); ++pc;

    PH_BEGIN RUN(0, ph_prologue(A, lds, bid, nb)); PH_END

    for (int l = 0; l < 4; ++l) {
        const int j = l >> 1;
        const bool ctx_out = (l < 2), ctx_in = (l < 3);
        const int rin = ctx_in ? 0 : NCTX, rout = ctx_out ? 0 : NCTX;
        if (l == 0) { PH_BEGIN RUN(1, ph_norm<false>(A, l, rin, lds, bid, nb)); PH_END }
        if ((l & 1) == 0) {
            PH_BEGIN RUN(2, ph_gemm_win(A, j, rin, lds, bid, nb)); PH_END
            PH_BEGIN RUN(3, ph_rwkv_pre(A, j, rin, bid, nb)); RUN(4, ph_qk(A, j, rin, bid, nb)); PH_END
            PH_BEGIN RUN(19, ph_gemm_lora(A, j, rin, lds, bid, nb)); PH_END
            PH_BEGIN RUN(18, ph_wkv_prep(A, j, lds, bid, nb)); PH_END
            PH_BEGIN RUN(5, ph_wkv_scan(A, lds, bid, nb)); PH_END
            PH_BEGIN RUN(6, ph_attn(A, ctx_out, lds, bid, nb)); PH_END
            PH_BEGIN RUN(7, ph_merge(A, l, rout, bid, nb)); PH_END
            PH_BEGIN RUN(8, ph_gemm_out(A, l, WS_CAT, WS_WOUT + (size_t)j * DM * DM * 2, rout, lds, bid, nb)); PH_END
        } else {
            PH_BEGIN RUN(9, ph_gemm_sgin(A, j, rin, lds, bid, nb)); PH_END
            PH_BEGIN RUN(10, ph_sgu_stats(A, rin, bid, nb)); PH_END
            PH_BEGIN RUN(11, ph_sgu_spatial(A, j, rout, lds, bid, nb)); PH_END
            PH_BEGIN RUN(12, ph_gemm_out(A, l, WS_G, WS_SGOUT + (size_t)j * DM * DM * 2, rout, lds, bid, nb)); PH_END
        }
        PH_BEGIN RUN(13, ph_norm2_router(A, l, rout, lds, bid, nb)); PH_END
        PH_BEGIN RUN(14, ph_moe_scatter(A, l, rout, lds, bid, nb)); PH_END
        PH_BEGIN RUN(15, ph_moe_gemm1(A, l, lds, bid, nb)); PH_END
        PH_BEGIN RUN(16, ph_moe_gemm2(A, l, lds, bid, nb)); PH_END
        PH_BEGIN if (SEL(17)) { if ((REPEAT_MASK >> 17) & 1) { ph_moe_combine(A, l, rout, l == 3, bid, nb, true); xcd_barrier(bar); } ph_moe_combine(A, l, rout, l == 3, bid, nb); } PH_END
    }
}

extern "C" void kernel_launch(void* const* d_in, const int* in_sizes, int n_in, void* d_out, int out_size, void* d_ws, size_t ws_size, hipStream_t stream) {
    static int grid = 0;
    if (grid == 0) {
        if (n_in != 38 || out_size != NLAT * DM || ws_size < WS_END) { fprintf(stderr, "kernel_launch: unexpected shapes: n_in %d out %d ws %zu (need %zu)\n", n_in, out_size, ws_size, (size_t)WS_END); grid = -1; return; }
        int dev = 0, cus = 0, per_cu = 0;
        if (hipGetDevice(&dev) != hipSuccess || hipDeviceGetAttribute(&cus, hipDeviceAttributeMultiprocessorCount, dev) != hipSuccess) { grid = -1; return; }
        if (hipFuncSetAttribute((const void*)fwd_kernel, hipFuncAttributeMaxDynamicSharedMemorySize, LDS_BYTES) != hipSuccess) { fprintf(stderr, "kernel_launch: hipFuncSetAttribute failed\n"); grid = -1; return; }
        if (hipOccupancyMaxActiveBlocksPerMultiprocessor(&per_cu, (const void*)fwd_kernel, NTHREADS, LDS_BYTES) != hipSuccess || per_cu < 1)
            fprintf(stderr, "kernel_launch: occupancy query reports %d workgroups per CU\n", per_cu);
        (void)hipGetLastError();
        grid = cus;
    }
    if (grid < 0) return;
    if (hipMemsetAsync((char*)d_ws + WS_CTL, 0, CTL_ZERO_BYTES, stream) != hipSuccess) { fprintf(stderr, "kernel_launch: memset failed\n"); return; }
    Args a{};
    for (int i = 0; i < 38; ++i) a.in[i] = (const float*)d_in[i];
    a.out = (float*)d_out; a.ws = (unsigned char*)d_ws; a.ph_lo = 0; a.ph_hi = 1 << 20;
    hipLaunchKernelGGL(fwd_kernel, dim3(grid), dim3(NTHREADS), LDS_BYTES, stream, a);
    const hipError_t le = hipPeekAtLastError();
    if (le != hipSuccess) fprintf(stderr, "kernel_launch: launch failed: %s\n", hipGetErrorName(le));
}
```

```cpp
#include <hip/hip_runtime.h>
#include <cstdio>
#include <cstdint>

#define LAS __attribute__((address_space(3)))
typedef unsigned short bf16_t;
typedef short bf16x8 __attribute__((ext_vector_type(8)));
typedef float f32x4 __attribute__((ext_vector_type(4)));
typedef unsigned u32x4 __attribute__((ext_vector_type(4)));
typedef unsigned u32x2 __attribute__((ext_vector_type(2)));

constexpr int DM = 1024, NB = 16, TL = 2048, TC = 256;
constexpr int NCTX = NB * TC, NLAT = NB * TL, NTOK = NCTX + NLAT;
constexpr int RWC = 1920, EVC = 3456, ZLD = 3584;
constexpr int NE = 32;
constexpr int XPROWS = NTOK * 4 + NE * 256;
constexpr int NTHREADS = 512, NWAVES = 8;

constexpr size_t MiB = 1u << 20;
constexpr size_t al256(size_t x) { return (x + 255) & ~(size_t)255; }
constexpr size_t WS_CTL = 0, CTL_ZERO_BYTES = 1 * MiB - 4096;
constexpr size_t WS_PTRS = 1 * MiB - 4096;
constexpr size_t WS_MOD = 1 * MiB;
constexpr size_t WS_RTWT = al256(WS_MOD + (size_t)4 * 17 * 6144 * 4);
constexpr size_t WS_WIN = al256(WS_RTWT + (size_t)4 * 32 * 1024 * 4);
constexpr size_t WS_WOUT = al256(WS_WIN + (size_t)2 * ZLD * DM * 2);
constexpr size_t WS_SGIN = al256(WS_WOUT + (size_t)2 * DM * DM * 2);
constexpr size_t WS_SGOUT = al256(WS_SGIN + (size_t)2 * 2048 * DM * 2);
constexpr int LORA_N = 2560, LORA_K = 384;
constexpr size_t WS_WLORA = al256(WS_SGOUT + (size_t)2 * DM * DM * 2);
constexpr size_t WS_LBIAS = al256(WS_WLORA + (size_t)2 * LORA_N * LORA_K * 2);
constexpr size_t WS_W1 = al256(WS_LBIAS + (size_t)2 * LORA_N * 4);
constexpr size_t WS_W2 = al256(WS_W1 + (size_t)4 * NE * 2048 * DM * 2);
constexpr size_t WS_H = al256(WS_W2 + (size_t)4 * NE * DM * DM * 2);
constexpr size_t WS_ABF = al256(WS_H + (size_t)NTOK * DM * 4);
constexpr size_t WS_TOKE = al256(WS_ABF + (size_t)NTOK * DM * 2);
constexpr size_t WS_TOKG = al256(WS_TOKE + (size_t)NTOK * 4 * 4);
constexpr size_t WS_ROWOF = al256(WS_TOKG + (size_t)NTOK * 4 * 4);
constexpr size_t WS_TOKR = al256(WS_ROWOF + (size_t)NTOK * 4 * 4);
constexpr size_t WS_BCNT = al256(WS_TOKR + (size_t)NTOK * 4 * 4);
constexpr size_t WS_SRCROW = al256(WS_BCNT + (size_t)4 * 256 * 32 * 4);
constexpr size_t WS_R = al256(WS_SRCROW + (size_t)XPROWS * 4);
constexpr size_t FSZ = (size_t)NTOK * 512 * 4;
constexpr size_t WS_Z = WS_R;
constexpr size_t HSZ = (size_t)NTOK * 512 * 2;
constexpr size_t WS_RB = al256(WS_Z + (size_t)NTOK * ZLD * 2);
constexpr size_t WS_KS = WS_RB + HSZ, WS_VS = WS_KS + HSZ, WS_KKN = WS_VS + HSZ;
constexpr size_t WS_LIN = WS_KKN + HSZ;
constexpr size_t WS_LO = al256(WS_LIN + (size_t)NTOK * 384 * 2);
constexpr size_t WS_AB = WS_LO + 2 * HSZ;
constexpr size_t WS_GB = WS_LO + 4 * HSZ;
constexpr size_t WS_YS = WS_LO + 5 * HSZ;
constexpr size_t WS_QB = WS_YS + 2 * FSZ;
constexpr size_t WS_KB = WS_QB + FSZ / 2;
constexpr size_t WS_VB = WS_KB + FSZ / 2;
constexpr size_t WS_OP = WS_VB + FSZ / 2;
constexpr size_t WS_CAT = WS_OP + 2 * FSZ;
constexpr int WKV_REC = 12288, WKV_NCH = (TC + TL) / 16;
constexpr size_t WS_WKV = al256(WS_CAT + (size_t)NTOK * DM * 2);
constexpr size_t WS_EVEN_END = WS_WKV + (size_t)256 * WKV_NCH * WKV_REC;
constexpr size_t WS_Z2 = WS_R;
constexpr size_t WS_VST = al256(WS_Z2 + (size_t)NTOK * 2048 * 2);
constexpr size_t WS_G = al256(WS_VST + (size_t)NTOK * 2 * 4);
constexpr size_t WS_ODD_END = WS_G + (size_t)NTOK * DM * 2;
constexpr size_t WS_XP = WS_R;
constexpr size_t WS_ACT = al256(WS_XP + (size_t)XPROWS * DM * 2);
constexpr size_t WS_YM = al256(WS_ACT + (size_t)XPROWS * DM * 2);
constexpr size_t WS_MOE_END = WS_YM + (size_t)XPROWS * DM * 2;
constexpr size_t WS_END = (WS_EVEN_END > WS_MOE_END ? (WS_EVEN_END > WS_ODD_END ? WS_EVEN_END : WS_ODD_END) : (WS_MOE_END > WS_ODD_END ? WS_MOE_END : WS_ODD_END));

constexpr int CW_BAR = 4096;
constexpr int CW_CNT = 16384;
constexpr int CW_CUR = 16384 + 256;

constexpr int LDS_BYTES = 163840;
constexpr int LDS_MISC = 160 * 1024 - 256;

__device__ __forceinline__ unsigned f2bf(float f) { unsigned u = __builtin_bit_cast(unsigned, f); return (u + 0x7fffu + ((u >> 16) & 1u)) >> 16; }
__device__ __forceinline__ unsigned pk2(float lo, float hi) { return f2bf(lo) | (f2bf(hi) << 16); }
typedef float f32x2_t __attribute__((ext_vector_type(2))); typedef __bf16 bf16x2_t __attribute__((ext_vector_type(2)));
__device__ __forceinline__ unsigned cvtpk_s(float lo, float hi) { f32x2_t v = {lo, hi}; bf16x2_t b = __builtin_convertvector(v, bf16x2_t); return __builtin_bit_cast(unsigned, b); }
__device__ __forceinline__ float bf2f(bf16_t b) { return __builtin_bit_cast(float, (unsigned)b << 16); }
__device__ __forceinline__ float wave_sum(float v) {
#pragma unroll
    for (int o = 1; o < 64; o <<= 1) v += __shfl_xor(v, o);
    return v;
}
__device__ __forceinline__ int tid_opaque() { int t = threadIdx.x; asm volatile("" : "+v"(t)); return t; }
#define GAS __attribute__((address_space(1)))
template <class T> __device__ __forceinline__ T* as_global(T* p) { return (T*)(GAS T*)p; }
__device__ __forceinline__ unsigned char* opq(unsigned char* p) { GAS unsigned char* g = (GAS unsigned char*)p; asm volatile("" : "+s"(g)); return (unsigned char*)g; }
__device__ __forceinline__ float rdl(float v, int k) { return __builtin_bit_cast(float, __builtin_amdgcn_readlane(__builtin_bit_cast(int, v), k)); }
__device__ __forceinline__ float sigmoidf_(float x) { return 1.0f / (1.0f + __expf(-x)); }

#define XB_TMO      128
#define XB_XCNT(j)  (256  + 64 * (j))
#define XB_XSUB(j)  (1280 + 64 * (j))
#define XB_XGEN(j)  (2304 + 64 * (j))
#define XB_TOP      3328
#define XB_TOPGEN   3392
#define XCD_BAR_WORDS 3456
#define XB_SPIN_CAP (1u << 22)
__device__ __forceinline__ unsigned xb_ld(unsigned* p)              { return __hip_atomic_load(p, __ATOMIC_RELAXED, __HIP_MEMORY_SCOPE_AGENT); }
__device__ __forceinline__ unsigned xb_add(unsigned* p, unsigned v) { return __hip_atomic_fetch_add(p, v, __ATOMIC_RELAXED, __HIP_MEMORY_SCOPE_AGENT); }
__device__ __forceinline__ unsigned xb_xcc_id() { return (unsigned)__builtin_amdgcn_s_getreg((3 << 11) | 20) & 0xFu; }
#define XB_SPIN(cond, bar) do { unsigned _sp = 0; while (cond) { __builtin_amdgcn_s_sleep(1); \
    if ((++_sp & 255u) == 0u) { if (xb_ld(&(bar)[XB_TMO])) break; if (_sp > XB_SPIN_CAP) { atomicAdd(&(bar)[XB_TMO], 1u); break; } } } } while (0)
struct XcdBarrier { unsigned* bar; unsigned x; volatile LAS unsigned* st; };
__device__ __forceinline__ XcdBarrier xcd_barrier_post(unsigned* bar, volatile LAS unsigned* st) {
    XcdBarrier b; b.bar = bar; b.x = xb_xcc_id(); b.st = st;
    if (threadIdx.x == 0) (void)xb_add(&bar[XB_XCNT(b.x)], 1u);
    return b;
}
__device__ __forceinline__ void xcd_barrier_complete(unsigned* bar, unsigned x, unsigned& nloc, unsigned& nx) {
    const unsigned G = gridDim.x * gridDim.y * gridDim.z;
    unsigned sum, cnt, mine, sp = 0u;
    for (;;) {
        sum = 0u; cnt = 0u; mine = 0u;
#pragma unroll
        for (unsigned j = 0; j < 16; ++j) { const unsigned c = xb_ld(&bar[XB_XCNT(j)]); sum += c; cnt += (c > 0u) ? 1u : 0u; mine = (j == x) ? c : mine; }
        if (sum == G) break;
        __builtin_amdgcn_s_sleep(1);
        if ((++sp & 255u) == 0u) { if (xb_ld(&bar[XB_TMO])) break; if (sp > XB_SPIN_CAP) { atomicAdd(&bar[XB_TMO], 1u); break; } }
    }
    nloc = mine > 0u ? mine : 1u; nx = cnt > 0u ? cnt : 1u;
}
__device__ __forceinline__ void xcd_barrier(const XcdBarrier& b) {
    asm volatile("s_waitcnt vmcnt(0)" ::: "memory");
    __syncthreads();
    if (threadIdx.x == 0) {
        unsigned* bar = b.bar; asm volatile("" : "+s"(bar));
        __builtin_amdgcn_s_waitcnt(0);
        unsigned nloc = b.st[0], nx = b.st[1];
        if (nloc == 0u) { xcd_barrier_complete(bar, b.x, nloc, nx); b.st[0] = nloc; b.st[1] = nx; }
        const unsigned old = xb_add(&bar[XB_XSUB(b.x)], 1u);
        const unsigned gen = old / nloc;
        if (old + 1u == (gen + 1u) * nloc) {
            __builtin_amdgcn_fence(__ATOMIC_RELEASE, "agent");
            asm volatile("s_waitcnt vmcnt(0)" ::: "memory");
            const unsigned og = xb_add(&bar[XB_TOP], 1u);
            const unsigned tg = og / nx;
            if (og + 1u == (tg + 1u) * nx) xb_add(&bar[XB_TOPGEN], 1u);
            else XB_SPIN(xb_ld(&bar[XB_TOPGEN]) == tg, bar);
            __builtin_amdgcn_fence(__ATOMIC_ACQUIRE, "agent");
            xb_add(&bar[XB_XGEN(b.x)], 1u);
            asm volatile("s_waitcnt vmcnt(0)" ::: "memory");
        } else {
            XB_SPIN(xb_ld(&bar[XB_XGEN(b.x)]) == gen, bar);
            __builtin_amdgcn_fence(__ATOMIC_ACQUIRE, "agent");
            asm volatile("s_waitcnt vmcnt(0)" ::: "memory");
        }
    }
    __syncthreads();
}

namespace pg8 {
#define PG8_LAS __attribute__((address_space(3)))
typedef unsigned short bf16_t;
typedef short bf16x8 __attribute__((ext_vector_type(8)));
typedef float f32x4 __attribute__((ext_vector_type(4)));
typedef unsigned u32x4 __attribute__((ext_vector_type(4)));
constexpr int BM = 256, BK = 64, HALF = 128, HTB = HALF * BK * 2  , STAGE_BYTES = 8 * HTB, NXCD = 8, WGM = 8;

__host__ __device__ __forceinline__ int lds_byte(int r, int c) { const int st = (r >> 4) * 2 + (c >> 5), rr = r & 15, cc = c & 31, ob = rr * 64 + cc * 2; return st * 1024 + (ob ^ (((ob >> 9) & 1) << 5)); }
__host__ __device__ __forceinline__ void stage_rc(int b, int& R, int& C) { const int st = b / 1024, sb = b % 1024, swz = sb ^ (((sb >> 9) & 1) << 5); R = (st >> 1) * 16 + swz / 64; C = (st & 1) * 32 + (swz % 64) / 2; }
__host__ __device__ __forceinline__ int perm32(int rho) { const int n = rho >> 4, i = rho & 15; return 8 * (i >> 2) + 4 * n + (i & 3); }

struct Unit { int pm, pn; };
struct Gemm { const bf16_t* A; const bf16_t* Bt; int M, N, K; };

struct StaticOrder {
    int nM, nN, nwg, G, c;
    __host__ __device__ void init(int M, int N, int G_, int c_) { nM = M / BM; nN = N / BM; nwg = nM * nN; G = G_; c = c_; }
    __host__ __device__ bool next(int i, Unit& u) const {
        const long L = (long)i * G + c; if (L >= nwg) return false;
        int wgid = (int)L; { const int q = nwg / NXCD, r = nwg % NXCD, xcd = wgid % NXCD, off = wgid / NXCD; wgid = (xcd < r ? xcd * (q + 1) : r * (q + 1) + (xcd - r) * q) + off; }
        const int nig = WGM * nN, gid = wgid / nig, fm = gid * WGM, gsz = (nM - fm) < WGM ? (nM - fm) : WGM;
        u.pm = fm + ((wgid % nig) % gsz); u.pn = (wgid % nig) / gsz; return true;
    }
    __device__ __forceinline__ void a_ready(const Unit&) const {}
    __device__ __forceinline__ void done(const Unit&) const {}
};

__device__ __forceinline__ unsigned cvt_pk_bf16(float lo, float hi) { unsigned r; asm volatile("v_cvt_pk_bf16_f32 %0, %1, %2" : "=v"(r) : "v"(lo), "v"(hi)); return r; }
typedef float f32x2 __attribute__((ext_vector_type(2)));
__device__ __forceinline__ f32x2 gelu_pk(f32x2 v) {
    const f32x2 av = __builtin_elementwise_abs(v), d = av * 0.2316418882f + 1.0f;
    f32x2 t; t.x = __builtin_amdgcn_rcpf(d.x); t.y = __builtin_amdgcn_rcpf(d.y);
    f32x2 q = t * 0.5307027145f + (-0.7265760135f); q = q * t + 0.7107068705f; q = q * t + (-0.142248368f); q = q * t + 0.127414796f; q = q * t;
    const f32x2 s = (v * v) * (-0.72134752044f);
    f32x2 e; e.x = __builtin_amdgcn_exp2f(s.x); e.y = __builtin_amdgcn_exp2f(s.y);
    const f32x2 m = v * (q * e), r = v - m;
    f32x2 o; o.x = v.x < 0.f ? m.x : r.x; o.y = v.y < 0.f ? m.y : r.y; return o;
}

typedef int v8i32 __attribute__((ext_vector_type(8)));
typedef int v4i32 __attribute__((ext_vector_type(4)));
__device__ __forceinline__ v8i32 cat8(v4i32 a, v4i32 b) { return __builtin_shufflevector(a, b, 0, 1, 2, 3, 4, 5, 6, 7); }
template <class Epi, class Sched, bool ALIGN_EPI = false, bool SP2 = false, bool GATHER = false, bool FP8 = false>
__device__ __forceinline__ void gemm_phase(PG8_LAS unsigned char* lds, const Gemm g, const Sched& S, const Epi& E) {
    const int tid = tid_opaque(), wid = __builtin_amdgcn_readfirstlane(tid >> 6), lane = tid & 63, wr = wid >> 2, wc = wid & 3, fr = lane & 15, fq = lane >> 4;
    static_assert(!GATHER || SP2, "GATHER is wired into the SP2 loop only");
    const int K = g.K, nt = K / BK;
    unsigned voffA[2], voffB[2];
#pragma unroll
    for (int i = 0; i < 2; ++i) { int R, C; stage_rc(tid * 16 + i * 8192, R, C); const int Rb = Epi::PERM ? ((R & ~31) + perm32(R & 31)) : R;
        voffA[i] = (unsigned)(R * K + C) * 2u; voffB[i] = (unsigned)(Rb * K + C) * 2u; }
    unsigned gAc[2][2] = {{0u, 0u}, {0u, 0u}}, gAn[2][2] = {{0u, 0u}, {0u, 0u}};
    int gR[2] = {0, 0}; unsigned gC[2] = {0u, 0u};
    if constexpr (GATHER) {
#pragma unroll
        for (int i = 0; i < 2; ++i) { int R, C; stage_rc(tid * 16 + i * 8192, R, C); gR[i] = R; gC[i] = (unsigned)C * 2u; }
    }
#define PG8_GROWS(dst, ui_) do { _Pragma("unroll") for (int _h = 0; _h < 2; ++_h) _Pragma("unroll") for (int _i = 0; _i < 2; ++_i) dst[_h][_i] = S.rowtab[(ui_) * 256 + _h * 128 + gR[_i]] + gC[_i]; } while (0)
    const size_t kstep = (size_t)(BK * 2);
    const size_t hstep = (size_t)HALF * K * 2;
    const size_t tstep = 2 * hstep;
    const unsigned ldsw = (unsigned)wid * 1024u;
    const int aoff = lds_byte(wr * 64 + fr, fq * 8), boff = lds_byte(wc * 32 + fr, fq * 8);
#define PG8_SA(b, h) (((b) * 2 + (h)) * HTB)
#define PG8_SB(b, h) ((4 + (b) * 2 + (h)) * HTB)
#define PG8_STAGE(bufoff, gbase, voff) do { _Pragma("unroll") for (int _i = 0; _i < 2; ++_i) \
        __builtin_amdgcn_global_load_lds((const unsigned*)((const char*)(gbase) + (voff)[_i]), (PG8_LAS unsigned*)(lds + (bufoff) + ldsw + _i * 8192), 16, 0, 0); } while (0)
#define PG8_STAGE_A(bufoff, kptr, h, vsel) do { if constexpr (GATHER) { PG8_STAGE(bufoff, kptr, vsel[h]); } else { PG8_STAGE(bufoff, (kptr) + (h) * hstep, voffA); } } while (0)
#define PG8_LDA(dst, b, h) do { if constexpr (FP8) { _Pragma("unroll") for (int m = 0; m < 4; ++m) dst##8[m] = cat8(*(const PG8_LAS v4i32*)(lds + PG8_SA(b, h) + aoff + m * 2048), *(const PG8_LAS v4i32*)(lds + PG8_SA(b, h) + aoff + m * 2048 + 1024)); } \
        else { _Pragma("unroll") for (int m = 0; m < 4; ++m) _Pragma("unroll") for (int k = 0; k < 2; ++k) dst[m][k] = *(const PG8_LAS bf16x8*)(lds + PG8_SA(b, h) + aoff + m * 2048 + k * 1024); } } while (0)
#define PG8_LDB(dst, b, h) do { if constexpr (FP8) { _Pragma("unroll") for (int n = 0; n < 2; ++n) dst##8[n] = cat8(*(const PG8_LAS v4i32*)(lds + PG8_SB(b, h) + boff + n * 2048), *(const PG8_LAS v4i32*)(lds + PG8_SB(b, h) + boff + n * 2048 + 1024)); } \
        else { _Pragma("unroll") for (int n = 0; n < 2; ++n) _Pragma("unroll") for (int k = 0; k < 2; ++k) dst[n][k] = *(const PG8_LAS bf16x8*)(lds + PG8_SB(b, h) + boff + n * 2048 + k * 1024); } } while (0)
#define PG8_MMA(ai, bj, At, Bt) do { __builtin_amdgcn_s_setprio(1); if constexpr (FP8) { _Pragma("unroll") for (int m = 0; m < 4; ++m) _Pragma("unroll") for (int n = 0; n < 2; ++n) \
        asm volatile("s_nop 1\n\tv_mfma_scale_f32_16x16x128_f8f6f4 %0, %1, %2, %0, %3, %4 op_sel_hi:[0,0,0]" : "+v"(acc[ai][bj][m][n]) : "v"(Bt##8[n]), "v"(At##8[m]), "v"(fp8_sa), "v"(fp8_sb)); } else { \
        _Pragma("unroll") for (int m = 0; m < 4; ++m) _Pragma("unroll") for (int n = 0; n < 2; ++n) _Pragma("unroll") for (int k = 0; k < 2; ++k) \
        acc[ai][bj][m][n] = __builtin_amdgcn_mfma_f32_16x16x32_bf16(Bt[n][k], At[m][k], acc[ai][bj][m][n], 0, 0, 0); } __builtin_amdgcn_s_setprio(0); } while (0)
#define PG8_WAIT_V(n) asm volatile("s_waitcnt vmcnt(" #n ")" ::: "memory")
#define PG8_WAIT_L(n) asm volatile("s_waitcnt lgkmcnt(" #n ")" ::: "memory")
#define PG8_BAR __builtin_amdgcn_s_barrier()
#define PG8_SCHED __builtin_amdgcn_sched_barrier(0)
    Unit cur, nxt; int ui = 0;
    if (!S.next(0, cur)) return;
    f32x4 acc[2][2][4][2];
#pragma unroll
    for (int a = 0; a < 2; ++a)
#pragma unroll
        for (int b = 0; b < 2; ++b)
#pragma unroll
            for (int m = 0; m < 4; ++m)
#pragma unroll
                for (int n = 0; n < 2; ++n) acc[a][b][m][n] = (f32x4){0.f, 0.f, 0.f, 0.f};
    const int fp8_sa = 0x77777777, fp8_sb = 0x7f7f7f7f;
    bf16x8 At[4][2], B0[2][2], B1[2][2]; v8i32 At8[4], B08[2], B18[2];
    const char* cA = GATHER ? (const char*)g.A : (const char*)g.A + (size_t)cur.pm * tstep; const char* cB = (const char*)g.Bt + (size_t)cur.pn * tstep;
    if constexpr (GATHER) { PG8_GROWS(gAc, 0); }
    S.a_ready(cur);
    if constexpr (SP2) {
        PG8_STAGE(PG8_SB(0, 0), cB, voffB); PG8_STAGE(PG8_SB(0, 1), cB + hstep, voffB); PG8_STAGE_A(PG8_SA(0, 0), cA, 0, gAc); PG8_STAGE_A(PG8_SA(0, 1), cA, 1, gAc);
        if (wr == 1) PG8_BAR;
        PG8_WAIT_V(2); PG8_BAR;
        PG8_STAGE(PG8_SB(1, 0), cB + kstep, voffB); PG8_STAGE_A(PG8_SA(1, 0), cA + kstep, 0, gAc); PG8_STAGE(PG8_SB(1, 1), cB + hstep + kstep, voffB);
        PG8_WAIT_V(6); PG8_BAR;
    } else {
        PG8_STAGE(PG8_SB(0, 0), cB, voffB); PG8_STAGE(PG8_SA(0, 0), cA, voffA); PG8_STAGE(PG8_SB(0, 1), cB + hstep, voffB); PG8_STAGE(PG8_SA(0, 1), cA + hstep, voffA);
        if (wr == 1) PG8_BAR;
        PG8_WAIT_V(4); PG8_BAR;
        PG8_STAGE(PG8_SB(1, 0), cB + kstep, voffB); PG8_STAGE(PG8_SA(1, 0), cA + kstep, voffA); PG8_STAGE(PG8_SB(1, 1), cB + hstep + kstep, voffB);
        PG8_WAIT_V(6); PG8_BAR;
    }
    for (;;) {
        const bool has_next = S.next(ui + 1, nxt);
        if constexpr (GATHER) { if (has_next) { PG8_GROWS(gAn, ui + 1); } else { _Pragma("unroll") for (int _h = 0; _h < 2; ++_h) _Pragma("unroll") for (int _i = 0; _i < 2; ++_i) gAn[_h][_i] = gAc[_h][_i]; } }
        const char* nA = GATHER ? (const char*)g.A : (has_next ? (const char*)g.A + (size_t)nxt.pm * tstep : cA); const char* nB = has_next ? (const char*)g.Bt + (size_t)nxt.pn * tstep : cB;
        for (int t = 0; t < nt; t += 2) {
            const bool last = (t == nt - 2);
            const char* a1 = cA + (size_t)(t + 1) * kstep;
            const char* a2 = last ? nA : cA + (size_t)(t + 2) * kstep; const char* b2 = last ? nB : cB + (size_t)(t + 2) * kstep;
            const char* a3 = a2 + kstep; const char* b3 = b2 + kstep;
            if (last && has_next) S.a_ready(nxt);
            unsigned gA2[2][2];
            if constexpr (GATHER) { _Pragma("unroll") for (int _h = 0; _h < 2; ++_h) _Pragma("unroll") for (int _i = 0; _i < 2; ++_i) gA2[_h][_i] = last ? gAn[_h][_i] : gAc[_h][_i]; }
            if constexpr (SP2) {
            PG8_LDB(B0, 0, 0); PG8_LDB(B1, 0, 1); PG8_SCHED; PG8_LDA(At, 0, 0); PG8_STAGE_A(PG8_SA(1, 1), a1, 1, gAc);
            PG8_WAIT_V(8); PG8_WAIT_L(0); PG8_BAR; PG8_MMA(0, 0, At, B0); PG8_MMA(0, 1, At, B1); PG8_BAR; PG8_SCHED;
            PG8_LDA(At, 0, 1); PG8_STAGE(PG8_SB(0, 0), b2, voffB); PG8_STAGE(PG8_SB(0, 1), b2 + hstep, voffB); PG8_STAGE_A(PG8_SA(0, 0), a2, 0, gA2);
            PG8_WAIT_V(8); PG8_WAIT_L(0); PG8_BAR; PG8_MMA(1, 0, At, B0); PG8_MMA(1, 1, At, B1); PG8_BAR; PG8_SCHED;
            PG8_LDB(B0, 1, 0); PG8_LDB(B1, 1, 1); PG8_SCHED; PG8_LDA(At, 1, 0); PG8_STAGE_A(PG8_SA(0, 1), a2, 1, gA2);
            PG8_WAIT_V(8); PG8_WAIT_L(0); PG8_BAR; PG8_MMA(0, 0, At, B0); PG8_MMA(0, 1, At, B1); PG8_BAR; PG8_SCHED;
            PG8_LDA(At, 1, 1); PG8_STAGE(PG8_SB(1, 0), b3, voffB); PG8_STAGE(PG8_SB(1, 1), b3 + hstep, voffB); PG8_STAGE_A(PG8_SA(1, 0), a3, 0, gA2);
            PG8_WAIT_V(8); PG8_WAIT_L(0); PG8_BAR; PG8_MMA(1, 0, At, B0); PG8_MMA(1, 1, At, B1); PG8_BAR; PG8_SCHED;
            } else {
            PG8_LDB(B0, 0, 0); PG8_SCHED; PG8_LDA(At, 0, 0); PG8_STAGE(PG8_SA(1, 1), a1 + hstep, voffA);
            PG8_WAIT_L(8); PG8_BAR; PG8_WAIT_L(0); PG8_MMA(0, 0, At, B0); PG8_BAR; PG8_SCHED;
            PG8_LDB(B1, 0, 1); PG8_STAGE(PG8_SB(0, 0), b2, voffB);
            PG8_BAR; PG8_WAIT_L(0); PG8_MMA(0, 1, At, B1); PG8_BAR;
            PG8_LDA(At, 0, 1); PG8_STAGE(PG8_SA(0, 0), a2, voffA);
            PG8_BAR; PG8_WAIT_L(0); PG8_MMA(1, 0, At, B0); PG8_BAR; PG8_SCHED;
            PG8_STAGE(PG8_SB(0, 1), b2 + hstep, voffB);
            PG8_WAIT_V(6); PG8_BAR; PG8_MMA(1, 1, At, B1); PG8_BAR;
            PG8_LDB(B0, 1, 0); PG8_SCHED; PG8_LDA(At, 1, 0); PG8_STAGE(PG8_SA(0, 1), a2 + hstep, voffA);
            PG8_WAIT_L(8); PG8_BAR; PG8_WAIT_L(0); PG8_MMA(0, 0, At, B0); PG8_BAR; PG8_SCHED;
            PG8_LDB(B1, 1, 1); PG8_STAGE(PG8_SB(1, 0), b3, voffB);
            PG8_BAR; PG8_WAIT_L(0); PG8_MMA(0, 1, At, B1); PG8_BAR;
            PG8_LDA(At, 1, 1); PG8_STAGE(PG8_SA(1, 0), a3, voffA);
            PG8_BAR; PG8_WAIT_L(0); PG8_MMA(1, 0, At, B0); PG8_BAR; PG8_SCHED;
            PG8_STAGE(PG8_SB(1, 1), b3 + hstep, voffB);
            PG8_WAIT_V(6); PG8_BAR; PG8_MMA(1, 1, At, B1); PG8_BAR;
            }
        }
        if constexpr (ALIGN_EPI) { if (wr == 0) PG8_BAR; }
        if constexpr (FP8) { asm volatile("s_nop 15\n\ts_nop 15" ::: "memory"); __builtin_amdgcn_sched_barrier(0); }
        if constexpr (!Epi::AFTER_DRAIN) { E(acc, cur, wr, wc, fr, fq); S.done(cur); }
        if (!has_next) break;
#pragma unroll
        for (int a = 0; a < 2; ++a)
#pragma unroll
            for (int b = 0; b < 2; ++b)
#pragma unroll
                for (int m = 0; m < 4; ++m)
#pragma unroll
                    for (int n = 0; n < 2; ++n) acc[a][b][m][n] = (f32x4){0.f, 0.f, 0.f, 0.f};
        cur = nxt; cA = nA; cB = nB; ++ui;
        if constexpr (GATHER) { _Pragma("unroll") for (int _h = 0; _h < 2; ++_h) _Pragma("unroll") for (int _i = 0; _i < 2; ++_i) gAc[_h][_i] = gAn[_h][_i]; }
        if constexpr (ALIGN_EPI) { if (wr == 1) PG8_BAR; }
    }
    PG8_WAIT_V(0);
    if constexpr (!ALIGN_EPI) { if (wr == 0) PG8_BAR; }
    PG8_BAR;
    if constexpr (Epi::AFTER_DRAIN) { E.fused(acc, cur, wr, wc, fr, fq, lds, wid, lane); S.done(cur); }
#undef PG8_SA
#undef PG8_SB
#undef PG8_STAGE
#undef PG8_STAGE_A
#undef PG8_GROWS
#undef PG8_LDA
#undef PG8_LDB
#undef PG8_MMA
#undef PG8_WAIT_V
#undef PG8_WAIT_L
#undef PG8_BAR
#undef PG8_SCHED
}
}

struct Args { const float* in[38]; float* out; unsigned char* ws; int ph_lo, ph_hi; };
#define INP(k) as_global(IN[k])
#define AIN(k) as_global(A.in[k])
enum { I_X = 0, I_C, I_CTX, I_CCTX, I_N1G, I_N2G, I_ADAW, I_ADAB, I_EVWIN, I_EVWOUT, I_RWMU, I_RWW0, I_RWW2, I_RWA0, I_RWA2, I_RWG2, I_RWKK, I_RWKA, I_RWRK,
       I_GNW, I_GNB, I_QN, I_KN, I_LAM, I_SUBLN, I_SGWIN, I_SGBIN, I_SGLNG, I_SGLNB, I_SGWS, I_SGBS, I_SGWOUT, I_RTW, I_RTB, I_W1, I_B1, I_W2, I_B2 };

struct Tok { int b, t, T, modrow; };
__device__ __forceinline__ Tok tokinfo(int g) {
    Tok k;
    if (g < NCTX) { k.b = g >> 8; k.t = g & 255; k.T = TC; k.modrow = 16; }
    else { const int q = g - NCTX; k.b = q >> 11; k.t = q & 2047; k.T = TL; k.modrow = k.b; }
    return k;
}

template <int MAP>
__device__ __forceinline__ void p0_transpose_item(const float* W, int K, int N, bf16_t* WT, LAS float* scr, int item, int lane) {
    const int nblk = N / 32, kb = item / nblk, nb = item % nblk, k0 = 64 * kb, n0 = 32 * nb;
    const int d0 = MAP ? (256 * ((n0 & 1023) >> 7) + 128 * (n0 >> 10) + (n0 & 127)) : n0;
#pragma unroll 8
    for (int i = 0; i < 32; ++i) { const int kk = 2 * i + (lane >> 5); scr[kk * 33 + (lane & 31)] = W[(size_t)(k0 + kk) * N + n0 + (lane & 31)]; }
    asm volatile("s_waitcnt lgkmcnt(0)" ::: "memory");
    const int c = lane & 7;
#pragma unroll
    for (int j = 0; j < 4; ++j) { const int n = (lane >> 3) + 8 * j; const LAS float* s = scr + (8 * c) * 33 + n;
        u32x4 o; o.x = pk2(s[0 * 33], s[1 * 33]); o.y = pk2(s[2 * 33], s[3 * 33]); o.z = pk2(s[4 * 33], s[5 * 33]); o.w = pk2(s[6 * 33], s[7 * 33]);
        *(u32x4*)(WT + (size_t)(d0 + n) * K + k0 + 8 * c) = o; }
    asm volatile("s_waitcnt lgkmcnt(0)" ::: "memory");
}

template <int MAP>
__device__ __forceinline__ void p0_transpose_item_fp8(const float* W, int K, int N, unsigned char* WT, LAS float* scr, int item, int lane) {
    const int nblk = N / 32, kb = item / nblk, nb = item % nblk, k0 = 64 * kb, n0 = 32 * nb;
    const int d0 = MAP ? (256 * ((n0 & 1023) >> 7) + 128 * (n0 >> 10) + (n0 & 127)) : n0;
#pragma unroll 8
    for (int i = 0; i < 32; ++i) { const int kk = 2 * i + (lane >> 5); scr[kk * 33 + (lane & 31)] = W[(size_t)(k0 + kk) * N + n0 + (lane & 31)]; }
    asm volatile("s_waitcnt lgkmcnt(0)" ::: "memory");
    const int c = lane & 3;
#pragma unroll
    for (int j = 0; j < 2; ++j) { const int n = (lane >> 2) + 16 * j; const LAS float* sp = scr + (16 * c) * 33 + n;
        u32x4 o;
#pragma unroll
        for (int d = 0; d < 4; ++d) { int w = __builtin_amdgcn_cvt_pk_fp8_f32(sp[(4 * d) * 33] * 256.0f, sp[(4 * d + 1) * 33] * 256.0f, 0, false);
            w = __builtin_amdgcn_cvt_pk_fp8_f32(sp[(4 * d + 2) * 33] * 256.0f, sp[(4 * d + 3) * 33] * 256.0f, w, true); o[d] = (unsigned)w; }
        *(u32x4*)(WT + (size_t)(d0 + n) * K + k0 + 16 * c) = o; }
    asm volatile("s_waitcnt lgkmcnt(0)" ::: "memory");
}

__device__ __forceinline__ void ph_prologue(const Args& A, LAS unsigned char* lds, int bid, int nb) {
    const int tid = tid_opaque(), lane = tid & 63, wid = tid >> 6;
    unsigned char* ws = opq(A.ws);
    if (bid == 0 && tid < 39) ((const float**)(ws + WS_PTRS))[tid] = (tid < 38) ? A.in[tid] : (const float*)A.out;
    {
        LAS float* s = (LAS float*)lds;
        LAS float* red = (LAS float*)(lds + 17 * 1024 * 4);
        for (int i = tid; i < 17 * 1024; i += NTHREADS) {
            const int r = i >> 10, k = i & 1023;
            const float x = (r < 16) ? AIN(I_C)[r * 1024 + k] : AIN(I_CCTX)[k];
            s[i] = x / (1.0f + __expf(-x));
        }
        __syncthreads();
        float* mod = (float*)(ws + WS_MOD);
        for (int u = bid; u < 4 * 96; u += nb) {
            const int l = u / 96, cg = u % 96, col = cg * 64 + lane;
            float acc[17];
#pragma unroll
            for (int r = 0; r < 17; ++r) acc[r] = 0.f;
            const float* wp = AIN(I_ADAW) + (size_t)l * 1024 * 6144 + col;
            for (int k = wid * 128; k < wid * 128 + 128; ++k) {
                const float wv = wp[(size_t)k * 6144];
#pragma unroll
                for (int r = 0; r < 17; ++r) acc[r] += s[r * 1024 + k] * wv;
            }
#pragma unroll
            for (int r = 0; r < 17; ++r) red[(wid * 17 + r) * 64 + lane] = acc[r];
            __syncthreads();
            for (int i = tid; i < 17 * 64; i += NTHREADS) {
                const int r = i >> 6, ln = i & 63; float v = 0.f;
#pragma unroll
                for (int w = 0; w < 8; ++w) v += red[(w * 17 + r) * 64 + ln];
                const int cc = cg * 64 + ln;
                mod[((size_t)l * 17 + r) * 6144 + cc] = v + AIN(I_ADAB)[l * 6144 + cc];
            }
            __syncthreads();
        }
    }
    __syncthreads();
    {
        LAS float* scr = (LAS float*)(lds + wid * 16384);
        const int gw = bid * NWAVES + wid, NGW = nb * NWAVES;
        constexpr int IT_WIN = 16 * (EVC / 32), IT_SQ = 16 * 32, IT_SGIN = 16 * 64, IT_W1 = 16 * 64, IT_W2 = 16 * 32;
        constexpr int N0 = 2 * IT_WIN, N1 = N0 + 2 * IT_SQ, N2 = N1 + 2 * IT_SGIN, N3 = N2 + 2 * IT_SQ, N4 = N3 + 128 * IT_W1, N5 = N4 + 128 * IT_W2;
        for (int it = gw; it < N5; it += NGW) {
            if (it < N0) { const int m = it / IT_WIN, r = it % IT_WIN; p0_transpose_item<0>(AIN(I_EVWIN) + (size_t)m * DM * EVC, DM, EVC, (bf16_t*)(ws + WS_WIN) + (size_t)m * ZLD * DM, scr, r, lane); }
            else if (it < N1) { const int q = it - N0, m = q / IT_SQ, r = q % IT_SQ; p0_transpose_item<0>(AIN(I_EVWOUT) + (size_t)m * DM * DM, DM, DM, (bf16_t*)(ws + WS_WOUT) + (size_t)m * DM * DM, scr, r, lane); }
            else if (it < N2) { const int q = it - N1, m = q / IT_SGIN, r = q % IT_SGIN; p0_transpose_item<0>(AIN(I_SGWIN) + (size_t)m * DM * 2048, DM, 2048, (bf16_t*)(ws + WS_SGIN) + (size_t)m * 2048 * DM, scr, r, lane); }
            else if (it < N3) { const int q = it - N2, m = q / IT_SQ, r = q % IT_SQ; p0_transpose_item<0>(AIN(I_SGWOUT) + (size_t)m * DM * DM, DM, DM, (bf16_t*)(ws + WS_SGOUT) + (size_t)m * DM * DM, scr, r, lane); }
            else if (it < N4) { const int q = it - N3, m = q / IT_W1, r = q % IT_W1; p0_transpose_item_fp8<1>(AIN(I_W1) + (size_t)m * DM * 2048, DM, 2048, ws + WS_W1 + (size_t)m * 2048 * DM, scr, r, lane); }
            else { const int q = it - N4, m = q / IT_W2, r = q % IT_W2; p0_transpose_item<0>(AIN(I_W2) + (size_t)m * DM * DM, DM, DM, (bf16_t*)(ws + WS_W2) + (size_t)m * DM * DM, scr, r, lane); }
        }
    }
    {
        const size_t gt = (size_t)bid * NTHREADS + tid, GT = (size_t)nb * NTHREADS;
        f32x4* H4 = (f32x4*)(ws + WS_H);
        const f32x4* c4 = (const f32x4*)AIN(I_CTX); const f32x4* x4 = (const f32x4*)AIN(I_X);
        constexpr size_t NC4 = (size_t)NCTX * DM / 4, NT4 = (size_t)NTOK * DM / 4;
        for (size_t i = gt; i < NT4; i += GT) H4[i] = (i < NC4) ? c4[i] : x4[i - NC4];
        for (size_t i = gt; i < (size_t)2 * 128 * DM / 8; i += GT) { const size_t m = i / (128 * DM / 8), r = i % (128 * DM / 8); ((u32x4*)((bf16_t*)(ws + WS_WIN) + (m * ZLD + EVC) * DM))[r] = (u32x4){0u, 0u, 0u, 0u}; }
        bf16_t* wl = (bf16_t*)(ws + WS_WLORA);
        for (size_t i = gt; i < (size_t)2 * LORA_N * (LORA_K / 8); i += GT) {
            const int n = (int)(i % LORA_N), kc = (int)((i / LORA_N) % (LORA_K / 8)), jj = (int)(i / ((size_t)LORA_N * (LORA_K / 8))), seg = n >> 9, c = n & 511, k0 = kc * 8;
            float v[8];
#pragma unroll
            for (int e = 0; e < 8; ++e) v[e] = 0.f;
            if (seg < 2) { if ((k0 >> 6) == seg) {
#pragma unroll
                for (int e = 0; e < 8; ++e) v[e] = AIN(I_RWW2)[(((size_t)jj * 2 + seg) * 64 + (k0 & 63) + e) * 512 + c]; } }
            else if (seg < 4) { if ((k0 >> 6) == seg) {
#pragma unroll
                for (int e = 0; e < 8; ++e) v[e] = AIN(I_RWA2)[(((size_t)jj * 2 + (seg - 2)) * 64 + (k0 & 63) + e) * 512 + c]; } }
            else if (k0 >= 256) {
#pragma unroll
                for (int e = 0; e < 8; ++e) v[e] = AIN(I_RWG2)[((size_t)jj * 128 + (k0 - 256) + e) * 512 + c]; }
            *(u32x4*)(wl + ((size_t)jj * LORA_N + n) * LORA_K + k0) = (u32x4){pk2(v[0], v[1]), pk2(v[2], v[3]), pk2(v[4], v[5]), pk2(v[6], v[7])};
        }
        for (size_t i = gt; i < (size_t)2 * LORA_N; i += GT) { const int jj = (int)(i / LORA_N), n = (int)(i % LORA_N), seg = n >> 9, c = n & 511;
            ((float*)(ws + WS_LBIAS))[i] = seg < 2 ? AIN(I_RWW0)[((size_t)jj * 2 + seg) * 512 + c] : (seg < 4 ? AIN(I_RWA0)[((size_t)jj * 2 + (seg - 2)) * 512 + c] : 0.f); }
        float* rt = (float*)(ws + WS_RTWT);
        for (size_t i = gt; i < (size_t)4 * 128 * 32; i += GT) {
            const int e = (int)i & 31, k0 = ((int)(i >> 5) & 127) * 8, l = (int)(i >> 12);
            unsigned hi[4], lo[4]; float w[8];
#pragma unroll
            for (int q = 0; q < 8; ++q) w[q] = AIN(I_RTW)[((size_t)l * 1024 + k0 + q) * 32 + e];
#pragma unroll
            for (int q = 0; q < 4; ++q) { hi[q] = pk2(w[2 * q], w[2 * q + 1]); lo[q] = pk2(w[2 * q] - __builtin_bit_cast(float, hi[q] << 16), w[2 * q + 1] - __builtin_bit_cast(float, hi[q] & 0xffff0000u)); }
            *(u32x4*)((bf16_t*)rt + ((size_t)l * 2 * 32 + e) * 1024 + k0) = (u32x4){hi[0], hi[1], hi[2], hi[3]};
            *(u32x4*)((bf16_t*)rt + ((size_t)(l * 2 + 1) * 32 + e) * 1024 + k0) = (u32x4){lo[0], lo[1], lo[2], lo[3]};
        }
    }
}

template <bool ROUTER>
__device__ __forceinline__ void ph_norm(const Args& A, int l, int row_lo, LAS unsigned char* lds, int bid, int nb) {
    unsigned char* ws = opq(A.ws); const float* const* IN = (const float* const*)(ws + WS_PTRS); (void)IN;
    const int tid = tid_opaque(), lane = tid & 63, wid = tid >> 6;
    const float* H = (const float*)(ws + WS_H);
    const float* mod = (const float*)(ws + WS_MOD);
    bf16_t* abf = (bf16_t*)(ws + WS_ABF);
    const float* gp = INP(ROUTER ? I_N2G : I_N1G) + l * 1024;
    const int c_shift = ROUTER ? 3 : 0, c_scale = ROUTER ? 4 : 1;
    LAS float* rtl = (LAS float*)lds;
    LAS int* hist = (LAS int*)(lds + 131072);
    float rtb = 0.f;
    if constexpr (ROUTER) {
        const f32x4* rt4 = (const f32x4*)((const float*)(ws + WS_RTWT) + (size_t)l * 32 * 1024);
        for (int i = tid; i < 32 * 1024 / 4; i += NTHREADS) ((LAS f32x4*)rtl)[i] = rt4[i];
        if (tid < 32) hist[tid] = 0;
        rtb = INP(I_RTB)[l * 32 + (lane >> 1)];
        __syncthreads();
    }
    for (int row = row_lo + bid * NWAVES + wid; row < NTOK; row += nb * NWAVES) {
        const Tok tk = tokinfo(row);
        const float* mrow = mod + ((size_t)l * 17 + tk.modrow) * 6144;
        f32x4 v[4]; float ss = 0.f;
#pragma unroll
        for (int j = 0; j < 4; ++j) { v[j] = *(const f32x4*)(H + (size_t)row * DM + j * 256 + lane * 4); ss += (v[j].x * v[j].x + v[j].y * v[j].y) + (v[j].z * v[j].z + v[j].w * v[j].w); }
        const float rstd = rsqrtf(wave_sum(ss) * (1.0f / DM) + 1e-6f);
#pragma unroll
        for (int j = 0; j < 4; ++j) {
            const int col = j * 256 + lane * 4;
            const f32x4 g = *(const f32x4*)(gp + col), sc = *(const f32x4*)(mrow + c_scale * 1024 + col), sh = *(const f32x4*)(mrow + c_shift * 1024 + col);
            v[j] = (v[j] * rstd * g) * (sc + 1.0f) + sh;
            u32x2 o; o.x = pk2(v[j].x, v[j].y); o.y = pk2(v[j].z, v[j].w);
            *(u32x2*)(abf + (size_t)row * DM + col) = o;
        }
        if constexpr (ROUTER) {
            float p[32];
#pragma unroll
            for (int e = 0; e < 32; ++e) {
                float acc = 0.f;
#pragma unroll
                for (int j = 0; j < 4; ++j) { const f32x4 w = *(const LAS f32x4*)(rtl + e * 1024 + j * 256 + lane * 4); acc += (v[j].x * w.x + v[j].y * w.y) + (v[j].z * w.z + v[j].w * w.w); }
                p[e] = acc;
            }
#define RS_STEP(N, OFF) _Pragma("unroll") for (int i = 0; i < (N); ++i) { const bool up = (lane & (OFF)) != 0; const float send = up ? p[i] : p[i + (N)], keep = up ? p[i + (N)] : p[i]; p[i] = keep + __shfl_xor(send, (OFF)); }
            RS_STEP(16, 32) RS_STEP(8, 16) RS_STEP(4, 8) RS_STEP(2, 4) RS_STEP(1, 2)
#undef RS_STEP
            const float mylg = p[0] + __shfl_xor(p[0], 1) + rtb;
            float tv[4] = {-3.0e38f, -3.0e38f, -3.0e38f, -3.0e38f}; int ti[4] = {0, 0, 0, 0};
#pragma unroll
            for (int e = 0; e < 32; ++e) {
                const float lgv = rdl(mylg, 2 * e);
                if (lgv > tv[3]) {
                    tv[3] = lgv; ti[3] = e;
                    if (tv[3] > tv[2]) { const float a = tv[2]; tv[2] = tv[3]; tv[3] = a; const int b = ti[2]; ti[2] = ti[3]; ti[3] = b; }
                    if (tv[2] > tv[1]) { const float a = tv[1]; tv[1] = tv[2]; tv[2] = a; const int b = ti[1]; ti[1] = ti[2]; ti[2] = b; }
                    if (tv[1] > tv[0]) { const float a = tv[0]; tv[0] = tv[1]; tv[1] = a; const int b = ti[0]; ti[0] = ti[1]; ti[1] = b; }
                }
            }
            const float e1 = __expf(tv[1] - tv[0]), e2 = __expf(tv[2] - tv[0]), e3 = __expf(tv[3] - tv[0]);
            const float inv = 1.0f / (1.0f + e1 + e2 + e3);
            if (lane == 0) {
                int* te = (int*)(ws + WS_TOKE) + (size_t)row * 4; float* tg = (float*)(ws + WS_TOKG) + (size_t)row * 4; int* tr = (int*)(ws + WS_TOKR) + (size_t)row * 4;
                te[0] = ti[0]; te[1] = ti[1]; te[2] = ti[2]; te[3] = ti[3];
                tg[0] = inv; tg[1] = e1 * inv; tg[2] = e2 * inv; tg[3] = e3 * inv;
#pragma unroll
                for (int k = 0; k < 4; ++k) tr[k] = __hip_atomic_fetch_add(hist + ti[k], 1, __ATOMIC_RELAXED, __HIP_MEMORY_SCOPE_WORKGROUP);
            }
        }
    }
    if constexpr (ROUTER) {
        __syncthreads();
        if (tid < 32) ((int*)(ws + WS_BCNT))[((size_t)l * 256 + bid) * 32 + tid] = hist[tid];
    }
}


constexpr int RT_LS = 2064;
__device__ __forceinline__ void ph_norm2_router(const Args& A, int l, int row_lo, LAS unsigned char* lds, int bid, int nb) {
    unsigned char* ws = opq(A.ws); const float* const* IN = (const float* const*)(ws + WS_PTRS);
    const int tid = tid_opaque(), lane = tid & 63, wid = tid >> 6, c16 = lane & 15, g4 = lane >> 4;
    const float* H = (const float*)(ws + WS_H); const float* mod = (const float*)(ws + WS_MOD); bf16_t* abf = (bf16_t*)(ws + WS_ABF);
    const float* gp = INP(I_N2G) + l * 1024;
    LAS unsigned char* rth = lds; LAS unsigned char* rtl = lds + 32 * RT_LS;
    LAS int* hist = (LAS int*)(lds + 64 * RT_LS);
    LAS float* lgs = (LAS float*)(lds + 64 * RT_LS + 256) + wid * 544;
    {
        const u32x4* src = (const u32x4*)((const bf16_t*)(ws + WS_RTWT) + (size_t)l * 2 * 32 * 1024);
        for (int i = tid; i < 64 * 128; i += NTHREADS) { const int row = i >> 7, ch = i & 127; *(LAS u32x4*)(lds + row * RT_LS + ch * 16) = src[i]; }
        if (tid < 32) hist[tid] = 0;
        __syncthreads();
    }
    const float rtb0 = INP(I_RTB)[l * 32 + c16], rtb1 = INP(I_RTB)[l * 32 + 16 + c16];
    const int ngroups = (NTOK - row_lo) / 16;
    for (int u = bid * NWAVES + wid; u < ngroups; u += nb * NWAVES) {
        const int row = row_lo + 16 * u + c16;
        const Tok tk = tokinfo(row_lo + 16 * u);
        const float* mrow = mod + ((size_t)l * 17 + tk.modrow) * 6144;
        const float* hrow = H + (size_t)row * DM + 8 * g4;
        float ss = 0.f;
#pragma unroll 8
        for (int ks = 0; ks < 32; ++ks) { const f32x4 a = *(const f32x4*)(hrow + 32 * ks), b = *(const f32x4*)(hrow + 32 * ks + 4);
            ss += (a.x * a.x + a.y * a.y) + (a.z * a.z + a.w * a.w) + (b.x * b.x + b.y * b.y) + (b.z * b.z + b.w * b.w); }
        ss += __shfl_xor(ss, 16); ss += __shfl_xor(ss, 32);
        const float rstd = rsqrtf(ss * (1.0f / DM) + 1e-6f);
        f32x4 acc0 = {0.f, 0.f, 0.f, 0.f}, acc1 = acc0;
#pragma unroll 2
        for (int ks = 0; ks < 32; ++ks) {
            const int col = 32 * ks + 8 * g4;
            float f[8];
            { const f32x4 xa = *(const f32x4*)(hrow + 32 * ks), xb = *(const f32x4*)(hrow + 32 * ks + 4);
              const f32x4 ga = *(const f32x4*)(gp + col), gb = *(const f32x4*)(gp + col + 4), sa = *(const f32x4*)(mrow + 4 * 1024 + col), sb = *(const f32x4*)(mrow + 4 * 1024 + col + 4);
              const f32x4 ha = *(const f32x4*)(mrow + 3 * 1024 + col), hb = *(const f32x4*)(mrow + 3 * 1024 + col + 4);
              const f32x4 fa = (xa * rstd * ga) * (sa + 1.0f) + ha, fb = (xb * rstd * gb) * (sb + 1.0f) + hb;
              f[0] = fa.x; f[1] = fa.y; f[2] = fa.z; f[3] = fa.w; f[4] = fb.x; f[5] = fb.y; f[6] = fb.z; f[7] = fb.w; }
            unsigned hi[4], lo[4];
#pragma unroll
            for (int e = 0; e < 4; ++e) { hi[e] = pk2(f[2 * e], f[2 * e + 1]);
                lo[e] = pk2(f[2 * e] - __builtin_bit_cast(float, hi[e] << 16), f[2 * e + 1] - __builtin_bit_cast(float, hi[e] & 0xffff0000u)); }
            const u32x4 hv = {hi[0], hi[1], hi[2], hi[3]}, lv = {lo[0], lo[1], lo[2], lo[3]};
            { int w0 = __builtin_amdgcn_cvt_pk_fp8_f32(f[0], f[1], 0, false); w0 = __builtin_amdgcn_cvt_pk_fp8_f32(f[2], f[3], w0, true);
              int w1 = __builtin_amdgcn_cvt_pk_fp8_f32(f[4], f[5], 0, false); w1 = __builtin_amdgcn_cvt_pk_fp8_f32(f[6], f[7], w1, true);
              *(u32x2*)((unsigned char*)abf + (size_t)row * DM + col) = (u32x2){(unsigned)w0, (unsigned)w1}; }
            const bf16x8 fh = __builtin_bit_cast(bf16x8, hv), fl = __builtin_bit_cast(bf16x8, lv);
            const int wo = c16 * RT_LS + col * 2;
            const bf16x8 wh0 = *(const LAS bf16x8*)(rth + wo), wh1 = *(const LAS bf16x8*)(rth + 16 * RT_LS + wo), wl0 = *(const LAS bf16x8*)(rtl + wo), wl1 = *(const LAS bf16x8*)(rtl + 16 * RT_LS + wo);
            acc0 = __builtin_amdgcn_mfma_f32_16x16x32_bf16(fh, wh0, acc0, 0, 0, 0); acc1 = __builtin_amdgcn_mfma_f32_16x16x32_bf16(fh, wh1, acc1, 0, 0, 0);
            acc0 = __builtin_amdgcn_mfma_f32_16x16x32_bf16(fl, wh0, acc0, 0, 0, 0); acc1 = __builtin_amdgcn_mfma_f32_16x16x32_bf16(fl, wh1, acc1, 0, 0, 0);
            acc0 = __builtin_amdgcn_mfma_f32_16x16x32_bf16(fh, wl0, acc0, 0, 0, 0); acc1 = __builtin_amdgcn_mfma_f32_16x16x32_bf16(fh, wl1, acc1, 0, 0, 0);
        }
#pragma unroll
        for (int r = 0; r < 4; ++r) { lgs[(4 * g4 + r) * 34 + c16] = acc0[r] + rtb0; lgs[(4 * g4 + r) * 34 + 16 + c16] = acc1[r] + rtb1; }
        asm volatile("s_waitcnt lgkmcnt(0)" ::: "memory");
        if (lane < 16) {
            float tv[4] = {-3.0e38f, -3.0e38f, -3.0e38f, -3.0e38f}; int ti[4] = {0, 0, 0, 0};
#pragma unroll
            for (int e = 0; e < 32; ++e) {
                const float lgv = lgs[lane * 34 + e];
                if (lgv > tv[3]) {
                    tv[3] = lgv; ti[3] = e;
                    if (tv[3] > tv[2]) { const float a = tv[2]; tv[2] = tv[3]; tv[3] = a; const int b = ti[2]; ti[2] = ti[3]; ti[3] = b; }
                    if (tv[2] > tv[1]) { const float a = tv[1]; tv[1] = tv[2]; tv[2] = a; const int b = ti[1]; ti[1] = ti[2]; ti[2] = b; }
                    if (tv[1] > tv[0]) { const float a = tv[0]; tv[0] = tv[1]; tv[1] = a; const int b = ti[0]; ti[0] = ti[1]; ti[1] = b; }
                }
            }
            const float e1 = __expf(tv[1] - tv[0]), e2 = __expf(tv[2] - tv[0]), e3 = __expf(tv[3] - tv[0]);
            const float inv = 1.0f / (1.0f + e1 + e2 + e3);
            const size_t r4 = (size_t)(row_lo + 16 * u + lane) * 4;
            *(int4*)((int*)(ws + WS_TOKE) + r4) = make_int4(ti[0], ti[1], ti[2], ti[3]);
            *(f32x4*)((float*)(ws + WS_TOKG) + r4) = (f32x4){inv, e1 * inv, e2 * inv, e3 * inv};
            int rk[4];
#pragma unroll
            for (int k = 0; k < 4; ++k) rk[k] = __hip_atomic_fetch_add(hist + ti[k], 1, __ATOMIC_RELAXED, __HIP_MEMORY_SCOPE_WORKGROUP);
            *(int4*)((int*)(ws + WS_TOKR) + r4) = make_int4(rk[0], rk[1], rk[2], rk[3]);
        }
        asm volatile("s_waitcnt lgkmcnt(0)" ::: "memory");
    }
    __syncthreads();
    if (tid < 32) ((int*)(ws + WS_BCNT))[((size_t)l * 256 + bid) * 32 + tid] = hist[tid];
}

typedef pg8::f32x4 (&AccRef)[2][2][4][2];
struct EpiStoreBf16 {
    static constexpr bool PERM = true, AFTER_DRAIN = false;
    bf16_t* O; int ldc;
    __device__ __forceinline__ void operator()(const pg8::f32x4 (&acc)[2][2][4][2], const pg8::Unit& u, int wr, int wc, int fr, int fq) const {
        const int row0 = u.pm * 256 + wr * 64 + fr, col0 = u.pn * 256 + wc * 32 + 8 * fq;
#pragma unroll
        for (int ai = 0; ai < 2; ++ai)
#pragma unroll
            for (int m = 0; m < 4; ++m) { bf16_t* rowp = O + (size_t)(row0 + ai * 128 + m * 16) * ldc + col0;
#pragma unroll
                for (int bj = 0; bj < 2; ++bj) { const pg8::f32x4 v0 = acc[ai][bj][m][0], v1 = acc[ai][bj][m][1];
                    u32x4 w; w.x = cvtpk_s(v0[0], v0[1]); w.y = cvtpk_s(v0[2], v0[3]); w.z = cvtpk_s(v1[0], v1[1]); w.w = cvtpk_s(v1[2], v1[3]);
                    *(u32x4*)(rowp + bj * 128) = w; } }
    }
};
struct EpiGeluBf16 {
    static constexpr bool PERM = true, AFTER_DRAIN = false;
    bf16_t* O; int ldc; const float* bias;
    __device__ __forceinline__ void operator()(const pg8::f32x4 (&acc)[2][2][4][2], const pg8::Unit& u, int wr, int wc, int fr, int fq) const {
        const int row0 = u.pm * 256 + wr * 64 + fr, col0 = u.pn * 256 + wc * 32 + 8 * fq;
        pg8::f32x4 bv[2][2];
#pragma unroll
        for (int bj = 0; bj < 2; ++bj)
#pragma unroll
            for (int n = 0; n < 2; ++n) bv[bj][n] = *(const pg8::f32x4*)(bias + col0 + bj * 128 + 4 * n);
#pragma unroll
        for (int ai = 0; ai < 2; ++ai)
#pragma unroll
            for (int m = 0; m < 4; ++m) { bf16_t* rowp = O + (size_t)(row0 + ai * 128 + m * 16) * ldc + col0;
#pragma unroll
                for (int bj = 0; bj < 2; ++bj) { pg8::f32x4 v0 = acc[ai][bj][m][0] + bv[bj][0], v1 = acc[ai][bj][m][1] + bv[bj][1];
                    const pg8::f32x2 a = pg8::gelu_pk((pg8::f32x2){v0[0], v0[1]}), b = pg8::gelu_pk((pg8::f32x2){v0[2], v0[3]}), c = pg8::gelu_pk((pg8::f32x2){v1[0], v1[1]}), d = pg8::gelu_pk((pg8::f32x2){v1[2], v1[3]});
                    u32x4 w; w.x = cvtpk_s(a.x, a.y); w.y = cvtpk_s(b.x, b.y); w.z = cvtpk_s(c.x, c.y); w.w = cvtpk_s(d.x, d.y);
                    *(u32x4*)(rowp + bj * 128) = w; } }
    }
};
struct EpiResidual {
    static constexpr bool PERM = false, AFTER_DRAIN = false;
    float* H; const float* gate0; int row_base;
    __device__ __forceinline__ void operator()(const pg8::f32x4 (&acc)[2][2][4][2], const pg8::Unit& u, int wr, int wc, int fr, int fq) const {
        const int row0 = u.pm * 256 + wr * 64 + fr, col0 = u.pn * 256 + wc * 32 + 4 * fq;
        const Tok tk = tokinfo(row_base + u.pm * 256);
        const float* gate = gate0 + (size_t)tk.modrow * 6144 + col0;
        pg8::f32x4 gv[2][2];
#pragma unroll
        for (int bj = 0; bj < 2; ++bj)
#pragma unroll
            for (int n = 0; n < 2; ++n) gv[bj][n] = *(const pg8::f32x4*)(gate + bj * 128 + n * 16);
#pragma unroll
        for (int ai = 0; ai < 2; ++ai)
#pragma unroll
            for (int m = 0; m < 4; ++m) { float* rowp = H + (size_t)(row0 + ai * 128 + m * 16) * DM + col0;
#pragma unroll
                for (int bj = 0; bj < 2; ++bj)
#pragma unroll
                    for (int n = 0; n < 2; ++n) { pg8::f32x4* p = (pg8::f32x4*)(rowp + bj * 128 + n * 16); *p = *p + gv[bj][n] * acc[ai][bj][m][n]; } }
    }
};
struct ListOrder {
    const LAS int* list; int n; const LAS unsigned* rowtab;
    __device__ __forceinline__ bool next(int i, pg8::Unit& u) const {
        if (i >= n) return false;
        u.pm = __builtin_amdgcn_readfirstlane(list[2 * i]); u.pn = __builtin_amdgcn_readfirstlane(list[2 * i + 1]); return true;
    }
    __device__ __forceinline__ void a_ready(const pg8::Unit&) const {}
    __device__ __forceinline__ void done(const pg8::Unit&) const {}
};
struct EpiLora {
    static constexpr bool PERM = true, AFTER_DRAIN = false;
    bf16_t* O; const float* bias; int row_base;
    __device__ __forceinline__ void operator()(const pg8::f32x4 (&acc)[2][2][4][2], const pg8::Unit& u, int wr, int wc, int fr, int fq) const {
        const int seg = u.pn >> 1, row0 = row_base + u.pm * 256 + wr * 64 + fr, cs0 = (u.pn & 1) * 256 + wc * 32 + 8 * fq;
        const float ksig = seg < 2 ? -0.60653065971f : 1.0f; const bool lin = seg == 4;
        bf16_t* Os = O + (size_t)seg * NTOK * 512;
#pragma unroll
        for (int bj = 0; bj < 2; ++bj) {
            const int cs = cs0 + bj * 128;
            const pg8::f32x4 b0 = *(const pg8::f32x4*)(bias + seg * 512 + cs), b1 = *(const pg8::f32x4*)(bias + seg * 512 + cs + 4);
#pragma unroll
            for (int ai = 0; ai < 2; ++ai)
#pragma unroll
                for (int m = 0; m < 4; ++m) {
                    pg8::f32x4 v0 = acc[ai][bj][m][0] + b0, v1 = acc[ai][bj][m][1] + b1;
#pragma unroll
                    for (int r = 0; r < 4; ++r) {
                        const float t0 = ksig * __builtin_amdgcn_rcpf(1.0f + __expf(-v0[r])), t1 = ksig * __builtin_amdgcn_rcpf(1.0f + __expf(-v1[r]));
                        v0[r] = lin ? v0[r] : t0; v1[r] = lin ? v1[r] : t1;
                    }
                    u32x4 w; w.x = cvtpk_s(v0[0], v0[1]); w.y = cvtpk_s(v0[2], v0[3]); w.z = cvtpk_s(v1[0], v1[1]); w.w = cvtpk_s(v1[2], v1[3]);
                    *(u32x4*)(Os + (size_t)(row0 + ai * 128 + m * 16) * 512 + cs) = w;
                }
        }
    }
};
constexpr int LDS_TAB = 131072;
constexpr int LDS_LIST = LDS_TAB + 4096;
constexpr int LDS_ROWTAB = LDS_LIST + 1024;
__device__ __forceinline__ ListOrder build_units(LAS unsigned char* lds, int nM, int nN, int G, int c, const LAS int* tile_e, int ncol) {
    LAS int* list = (LAS int*)(lds + LDS_LIST);
    pg8::StaticOrder S; S.nM = nM; S.nN = nN; S.nwg = nM * nN; S.G = G; S.c = c;
    const int tid = tid_opaque();
    if (tid < 64) { pg8::Unit u; if (S.next(tid, u)) { if (tile_e) u.pn = tile_e[u.pm] * ncol + u.pn; list[2 * tid] = u.pm; list[2 * tid + 1] = u.pn; } }
    __syncthreads();
    ListOrder L; L.list = list; L.n = (c < S.nwg) ? (S.nwg - c + G - 1) / G : 0; L.rowtab = (const LAS unsigned*)(lds + LDS_ROWTAB);
    return L;
}
struct EpiMoe1 {
    static constexpr bool PERM = true, AFTER_DRAIN = false;
    bf16_t* O; const float* b1;
    __device__ __forceinline__ void operator()(const pg8::f32x4 (&acc)[2][2][4][2], const pg8::Unit& u, int wr, int wc, int fr, int fq) const {
        const int e = u.pn >> 3, pn = u.pn & 7;
        const int row0 = u.pm * 256 + wr * 64 + fr, ci = pn * 128 + wc * 32 + 8 * fq;
        const float* be = b1 + (size_t)e * 2048 + ci;
        const pg8::f32x4 bg0 = *(const pg8::f32x4*)(be), bg1 = *(const pg8::f32x4*)(be + 4), bl0 = *(const pg8::f32x4*)(be + 1024), bl1 = *(const pg8::f32x4*)(be + 1028);
#pragma unroll
        for (int ai = 0; ai < 2; ++ai)
#pragma unroll
            for (int m = 0; m < 4; ++m) {
                const pg8::f32x4 g0 = acc[ai][0][m][0] + bg0, g1 = acc[ai][0][m][1] + bg1, l0 = acc[ai][1][m][0] + bl0, l1 = acc[ai][1][m][1] + bl1;
                float o[8];
#pragma unroll
                for (int r = 0; r < 4; ++r) {
                    const float ga = fminf(g0[r], 7.0f), gb = fminf(g1[r], 7.0f);
                    const float la = fminf(fmaxf(l0[r], -7.0f), 7.0f), lb = fminf(fmaxf(l1[r], -7.0f), 7.0f);
                    o[r] = ga * __builtin_amdgcn_rcpf(1.0f + __expf(-1.702f * ga)) * (la + 1.0f);
                    o[4 + r] = gb * __builtin_amdgcn_rcpf(1.0f + __expf(-1.702f * gb)) * (lb + 1.0f);
                }
                u32x4 w; w.x = cvtpk_s(o[0], o[1]); w.y = cvtpk_s(o[2], o[3]); w.z = cvtpk_s(o[4], o[5]); w.w = cvtpk_s(o[6], o[7]);
                *(u32x4*)(O + (size_t)(row0 + ai * 128 + m * 16) * DM + ci) = w;
            }
    }
};
struct EpiMoe2 {
    static constexpr bool PERM = true, AFTER_DRAIN = false;
    bf16_t* O; const float* b2;
    __device__ __forceinline__ void operator()(const pg8::f32x4 (&acc)[2][2][4][2], const pg8::Unit& u, int wr, int wc, int fr, int fq) const {
        const int e = u.pn >> 2, pn = u.pn & 3;
        const int row0 = u.pm * 256 + wr * 64 + fr, col0 = pn * 256 + wc * 32 + 8 * fq;
        const float* be = b2 + (size_t)e * DM + col0;
        pg8::f32x4 bv[2][2];
#pragma unroll
        for (int bj = 0; bj < 2; ++bj)
#pragma unroll
            for (int n = 0; n < 2; ++n) bv[bj][n] = *(const pg8::f32x4*)(be + bj * 128 + 4 * n);
#pragma unroll
        for (int ai = 0; ai < 2; ++ai)
#pragma unroll
            for (int m = 0; m < 4; ++m) { bf16_t* rowp = O + (size_t)(row0 + ai * 128 + m * 16) * DM + col0;
#pragma unroll
                for (int bj = 0; bj < 2; ++bj) { const pg8::f32x4 v0 = acc[ai][bj][m][0] + bv[bj][0], v1 = acc[ai][bj][m][1] + bv[bj][1];
                    u32x4 w; w.x = cvtpk_s(v0[0], v0[1]); w.y = cvtpk_s(v0[2], v0[3]); w.z = cvtpk_s(v1[0], v1[1]); w.w = cvtpk_s(v1[2], v1[3]);
                    *(u32x4*)(rowp + bj * 128) = w; } }
    }
};

namespace att {
typedef float f32x16 __attribute__((ext_vector_type(16)));
typedef short s16x4 __attribute__((ext_vector_type(4)));
constexpr int KVBLK = 64, LDR = 512;
constexpr float QSCALE = 0.125f * 1.4426950408889634f;
constexpr int SHM_V = KVBLK * 128 * 2, SHM_K = KVBLK * 64 * 2, SHM_ATTN = 2 * SHM_V + 2 * SHM_K + NWAVES * 64 * 4;
#define ATT_KSWZ(row, colB) ((row) * 128 + ((colB) ^ ((((row) >> 1) & 7) << 4)))
#define ATT_SBAR() __builtin_amdgcn_sched_barrier(0)
__device__ __forceinline__ int crow(int r, int hi) { return (r & 3) + 8 * (r >> 2) + 4 * hi; }
__device__ __forceinline__ unsigned cvtpk(float lo, float hi) { unsigned r; asm volatile("v_cvt_pk_bf16_f32 %0, %1, %2" : "=v"(r) : "v"(lo), "v"(hi)); return r; }
constexpr float SHIFT = -12.0f;
__device__ __forceinline__ void partialSM(f32x16& p0) {
#pragma unroll
    for (int r = 0; r < 16; ++r) p0[r] = __builtin_amdgcn_exp2f(p0[r]);
}
__device__ __forceinline__ void finishSM(f32x16& p0, f32x16& p1, float& l_reg, bf16x8& pa0, bf16x8& pa1, bf16x8& pa2, bf16x8& pa3) {
#pragma unroll
    for (int r = 0; r < 16; ++r) p1[r] = __builtin_amdgcn_exp2f(p1[r]);
    float ps = 0;
#pragma unroll
    for (int r = 0; r < 16; ++r) ps += p0[r];
#pragma unroll
    for (int r = 0; r < 16; ++r) ps += p1[r];
    l_reg += ps;
#define ATT_PK4(P, BASE, OUT) do { unsigned a0 = cvtpk(P[BASE + 0], P[BASE + 1]), a1 = cvtpk(P[BASE + 2], P[BASE + 3]);   \
    unsigned b0 = cvtpk(P[BASE + 4], P[BASE + 5]), b1 = cvtpk(P[BASE + 6], P[BASE + 7]);                              \
    auto r0 = __builtin_amdgcn_permlane32_swap(a0, b0, false, false); auto r1 = __builtin_amdgcn_permlane32_swap(a1, b1, false, false); \
    u32x4 w = {r0[0], r1[0], r0[1], r1[1]}; OUT = __builtin_bit_cast(bf16x8, w); } while (0)
    ATT_PK4(p0, 0, pa0); ATT_PK4(p0, 8, pa1); ATT_PK4(p1, 0, pa2); ATT_PK4(p1, 8, pa3);
#undef ATT_PK4
}
__device__ __forceinline__ void qkt(f32x16& p0, f32x16& p1, const LAS unsigned char* Ks, int qaddr, int r32, int hi) {
    asm volatile("" : "+v"(qaddr)); const LAS unsigned char* qp = (const LAS unsigned char*)(uintptr_t)qaddr;
    bf16x8 qr[4];
#pragma unroll
    for (int d0 = 0; d0 < 4; ++d0) qr[d0] = *(const LAS bf16x8*)(qp + d0 * 1024);
#pragma unroll
    for (int r = 0; r < 16; ++r) { p0[r] = SHIFT; p1[r] = SHIFT; }
#pragma unroll
    for (int d0 = 0; d0 < 4; ++d0) { const int cb = (d0 * 16 + hi * 8) * 2;
        const bf16x8 b0 = *(const LAS bf16x8*)(Ks + ATT_KSWZ(r32, cb));
        const bf16x8 b1 = *(const LAS bf16x8*)(Ks + ATT_KSWZ(32 + r32, cb));
        p0 = __builtin_amdgcn_mfma_f32_32x32x16_bf16(b0, qr[d0], p0, 0, 0, 0);
        p1 = __builtin_amdgcn_mfma_f32_32x32x16_bf16(b1, qr[d0], p1, 0, 0, 0); }
}
__device__ __forceinline__ int v_st(int k, int c) { const int kk = (k & ~0xC) | ((k & 4) << 1) | ((k & 8) >> 1); return ((kk >> 3) * 4 + (c >> 5)) * 512 + ((kk & 7) * 32 + (c & 31)) * 2; }
__device__ __forceinline__ int v_rd_base(int lane) { return ((lane & 3) << 3) | (((lane >> 2) & 3) << 6) | (((lane >> 4) & 1) << 5) | (((lane >> 5) & 1) << 8); }
constexpr int v_rd_off(int d0, int ks, int half) { return d0 * 512 + ks * 4096 + half * 2048; }
template <int OFF> __device__ __forceinline__ s16x4 tr_read(int vb) { s16x4 r; asm volatile("ds_read_b64_tr_b16 %0, %1 offset:%2" : "=&v"(r) : "v"(vb), "i"(OFF) : "memory"); return r; }
template <int D0> __device__ __forceinline__ void pv_one(f32x16& od, int vb, bf16x8 pa0, bf16x8 pa1, bf16x8 pa2, bf16x8 pa3) {
    const s16x4 l0 = tr_read<v_rd_off(D0, 0, 0)>(vb), h0 = tr_read<v_rd_off(D0, 0, 1)>(vb), l1 = tr_read<v_rd_off(D0, 1, 0)>(vb), h1 = tr_read<v_rd_off(D0, 1, 1)>(vb);
    const s16x4 l2 = tr_read<v_rd_off(D0, 2, 0)>(vb), h2 = tr_read<v_rd_off(D0, 2, 1)>(vb), l3 = tr_read<v_rd_off(D0, 3, 0)>(vb), h3 = tr_read<v_rd_off(D0, 3, 1)>(vb);
    asm volatile("s_waitcnt lgkmcnt(0)" ::: "memory"); ATT_SBAR();
#define ATT_PK(L, H) (bf16x8){L[0], L[1], L[2], L[3], H[0], H[1], H[2], H[3]}
    od = __builtin_amdgcn_mfma_f32_32x32x16_bf16(pa0, ATT_PK(l0, h0), od, 0, 0, 0);
    od = __builtin_amdgcn_mfma_f32_32x32x16_bf16(pa1, ATT_PK(l1, h1), od, 0, 0, 0);
    od = __builtin_amdgcn_mfma_f32_32x32x16_bf16(pa2, ATT_PK(l2, h2), od, 0, 0, 0);
    od = __builtin_amdgcn_mfma_f32_32x32x16_bf16(pa3, ATT_PK(l3, h3), od, 0, 0, 0);
#undef ATT_PK
}
__device__ __forceinline__ void pv_d0(f32x16 (&o)[4], int vb, bf16x8 pa0, bf16x8 pa1, bf16x8 pa2, bf16x8 pa3) {
    pv_one<0>(o[0], vb, pa0, pa1, pa2, pa3); pv_one<1>(o[1], vb, pa0, pa1, pa2, pa3); pv_one<2>(o[2], vb, pa0, pa1, pa2, pa3); pv_one<3>(o[3], vb, pa0, pa1, pa2, pa3);
}
__device__ __forceinline__ void attn_body(const bf16_t* Qb, const bf16_t* Kh, const bf16_t* Vh, float* Ob, int seq, LAS unsigned char* lds) {
    const int tid = tid_opaque(), wid = tid >> 6, lane = tid & 63, r32 = lane & 31, hi = lane >> 5;
    LAS unsigned char* V_lds = lds; LAS unsigned char* K_lds = lds + 2 * SHM_V;
    LAS float* wsl = (LAS float*)(lds + 2 * SHM_V + 2 * SHM_K) + wid * 64; LAS float* li_l = wsl; LAS float* al_l = wsl + 32;
    float l_reg = 0; f32x16 o[4] = {};
    const bf16_t* Qw = Qb + (size_t)(wid * 32 + r32) * LDR + hi * 8;
    LAS unsigned char* qlds = lds + SHM_ATTN + wid * 4096 + lane * 16;
#pragma unroll
    for (int d0 = 0; d0 < 4; ++d0) *(LAS bf16x8*)(qlds + d0 * 1024) = *(const bf16x8*)(Qw + d0 * 16);
    const int qr = (int)(uintptr_t)qlds;
    const int sr = tid >> 4, sc = (tid & 15) * 8, vst0 = v_st(sr, sc), vst1 = v_st(32 + sr, sc);
    const int kr = tid >> 3, kc = (tid & 7) * 8, kst = ATT_KSWZ(kr, kc * 2);
    const int vb0 = (int)(uintptr_t)V_lds + v_rd_base(lane);
    bf16x8 vsA0, vsA1, ksA, vsB0, vsB1, ksB;
#define ATT_SLOAD(V0, V1, K0, k0) do { V0 = *(const bf16x8*)(Vh + (size_t)((k0) + sr) * LDR + sc); V1 = *(const bf16x8*)(Vh + (size_t)((k0) + 32 + sr) * LDR + sc); \
    K0 = *(const bf16x8*)(Kh + (size_t)((k0) + kr) * LDR + kc); } while (0)
#define ATT_SWRITE(b, V0, V1, K0) do { *(LAS bf16x8*)(V_lds + (b) * SHM_V + vst0) = V0; *(LAS bf16x8*)(V_lds + (b) * SHM_V + vst1) = V1; \
    *(LAS bf16x8*)(K_lds + (b) * SHM_K + kst) = K0; } while (0)
#define ATT_SWAIT() asm volatile("s_waitcnt vmcnt(3)" ::: "memory")
    f32x16 p0, p1; bf16x8 pa0, pa1, pa2, pa3; const int NT = seq / KVBLK;
    ATT_SLOAD(vsA0, vsA1, ksA, 0); asm volatile("s_waitcnt vmcnt(0)" ::: "memory"); ATT_SWRITE(0, vsA0, vsA1, ksA);
    ATT_SLOAD(vsB0, vsB1, ksB, KVBLK); if (2 < NT) ATT_SLOAD(vsA0, vsA1, ksA, 2 * KVBLK);
    ATT_SWAIT(); ATT_SWRITE(1, vsB0, vsB1, ksB); __syncthreads();
    for (int j = 0; j < NT; j += 2) {
        ATT_SBAR(); qkt(p0, p1, K_lds, qr, r32, hi); partialSM(p0);
        finishSM(p0, p1, l_reg, pa0, pa1, pa2, pa3); ATT_SBAR();
        if (j + 3 < NT) ATT_SLOAD(vsB0, vsB1, ksB, (j + 3) * KVBLK); ATT_SBAR();
        pv_d0(o, vb0, pa0, pa1, pa2, pa3); ATT_SBAR();
        __syncthreads();
        if (j + 2 < NT) { ATT_SWAIT(); ATT_SWRITE(0, vsA0, vsA1, ksA); }
        asm volatile("" : "+v"(o[0]), "+v"(o[1]), "+v"(o[2]), "+v"(o[3]));
        __syncthreads();
        ATT_SBAR(); qkt(p0, p1, K_lds + SHM_K, qr, r32, hi); partialSM(p0);
        finishSM(p0, p1, l_reg, pa0, pa1, pa2, pa3); ATT_SBAR();
        if (j + 4 < NT) ATT_SLOAD(vsA0, vsA1, ksA, (j + 4) * KVBLK); ATT_SBAR();
        pv_d0(o, vb0 + SHM_V, pa0, pa1, pa2, pa3); ATT_SBAR();
        __syncthreads();
        if (j + 3 < NT) { ATT_SWAIT(); ATT_SWRITE(1, vsB0, vsB1, ksB); }
        asm volatile("" : "+v"(o[0]), "+v"(o[1]), "+v"(o[2]), "+v"(o[3]));
        __syncthreads();
    }
    { auto rr = __builtin_amdgcn_permlane32_swap(__float_as_uint(l_reg), __float_as_uint(l_reg), false, false); l_reg = __uint_as_float(rr[0]) + __uint_as_float(rr[1]); }
    if (hi == 0) li_l[r32] = l_reg; asm volatile("s_waitcnt lgkmcnt(0)" ::: "memory");
    float rli[16];
#pragma unroll
    for (int r = 0; r < 16; ++r) rli[r] = __builtin_amdgcn_rcpf(li_l[crow(r, hi)]);
    float* Ow = Ob + (size_t)(wid * 32) * LDR;
#pragma unroll
    for (int r = 0; r < 16; ++r) { const int orow = crow(r, hi);
#pragma unroll
        for (int d0 = 0; d0 < 4; ++d0) Ow[(size_t)orow * LDR + d0 * 32 + r32] = o[d0][r] * rli[r]; }
#undef ATT_SLOAD
#undef ATT_SWRITE
#undef ATT_SWAIT
}
}

__device__ __forceinline__ void ph_gemm_win(const Args& A, int j, int row_lo, LAS unsigned char* lds, int bid, int nb) {
    unsigned char* ws = opq(A.ws); const float* const* IN = (const float* const*)(ws + WS_PTRS); (void)IN;
    pg8::Gemm g{(const bf16_t*)(ws + WS_ABF) + (size_t)row_lo * DM, (const bf16_t*)(ws + WS_WIN) + (size_t)j * ZLD * DM, NTOK - row_lo, ZLD, DM};
    const ListOrder S = build_units(lds, (NTOK - row_lo) / 256, ZLD / 256, nb, bid, nullptr, 0);
    EpiStoreBf16 E{(bf16_t*)(ws + WS_Z) + (size_t)row_lo * ZLD, ZLD};
    pg8::gemm_phase<EpiStoreBf16, ListOrder, true, true>(lds, g, S, E);
}

__device__ __forceinline__ void ph_rwkv_pre(const Args& A, int j, int row_lo, int bid, int nb) {
    unsigned char* ws = opq(A.ws); const float* const* IN = (const float* const*)(ws + WS_PTRS);
    const int tid = tid_opaque(), lane = tid & 63, wid = tid >> 6;
    const bf16_t* Z = (const bf16_t*)(ws + WS_Z);
    const float* mu = INP(I_RWMU) + (size_t)j * 2 * RWC; const float* kkw = INP(I_RWKK) + j * 512;
    bf16_t* RB = (bf16_t*)(ws + WS_RB); bf16_t* KS = (bf16_t*)(ws + WS_KS); bf16_t* VS = (bf16_t*)(ws + WS_VS); bf16_t* KKN = (bf16_t*)(ws + WS_KKN); bf16_t* LIN = (bf16_t*)(ws + WS_LIN);
#define UNPK8(dst, raw) do { _Pragma("unroll") for (int _i = 0; _i < 4; ++_i) { dst[2 * _i] = __builtin_bit_cast(float, raw[_i] << 16); dst[2 * _i + 1] = __builtin_bit_cast(float, raw[_i] & 0xffff0000u); } } while (0)
#define PK8(v) (u32x4){pk2(v[0], v[1]), pk2(v[2], v[3]), pk2(v[4], v[5]), pk2(v[6], v[7])}
    for (int g = row_lo + bid * NWAVES + wid; g < NTOK; g += nb * NWAVES) {
        const Tok tk = tokinfo(g);
        const bool hp = tk.t > 0, hn = tk.t < tk.T - 1;
        const bf16_t* zc = Z + (size_t)g * ZLD;
#pragma unroll
        for (int i = 0; i < 4; ++i) {
            const int ch = i * 64 + lane, col = ch * 8;
            if (ch < 240) {
                const u32x4 zero = {0u, 0u, 0u, 0u};
                const u32x4 cr = *(const u32x4*)(zc + col), pr = hp ? *(const u32x4*)(zc - ZLD + col) : zero, nr = hn ? *(const u32x4*)(zc + ZLD + col) : zero;
                float z[8], p[8], n[8], s8[8];
                UNPK8(z, cr); UNPK8(p, pr); UNPK8(n, nr);
                const f32x4 m0a = *(const f32x4*)(mu + col), m0b = *(const f32x4*)(mu + col + 4), m1a = *(const f32x4*)(mu + RWC + col), m1b = *(const f32x4*)(mu + RWC + col + 4);
#pragma unroll
                for (int e = 0; e < 4; ++e) { s8[e] = z[e] + m0a[e] * (p[e] - z[e]) + m1a[e] * (n[e] - z[e]); s8[4 + e] = z[4 + e] + m0b[e] * (p[4 + e] - z[4 + e]) + m1b[e] * (n[4 + e] - z[4 + e]); }
                if (col < 512) *(u32x4*)(RB + (size_t)g * 512 + col) = PK8(s8);
                else if (col < 1024) {
                    const int ck = col - 512;
                    *(u32x4*)(KS + (size_t)g * 512 + ck) = PK8(s8);
                    const f32x4 kwa = *(const f32x4*)(kkw + ck), kwb = *(const f32x4*)(kkw + ck + 4);
                    float kk[8]; float ss = 0.f;
#pragma unroll
                    for (int e = 0; e < 4; ++e) { kk[e] = s8[e] * kwa[e]; kk[4 + e] = s8[4 + e] * kwb[e]; ss += kk[e] * kk[e] + kk[4 + e] * kk[4 + e]; }
                    ss += __shfl_xor(ss, 1); ss += __shfl_xor(ss, 2); ss += __shfl_xor(ss, 4);
                    const float inv = 1.0f / fmaxf(sqrtf(ss), 1e-12f);
#pragma unroll
                    for (int e = 0; e < 8; ++e) kk[e] *= inv;
                    *(u32x4*)(KKN + (size_t)g * 512 + ck) = PK8(kk);
                }
                else if (col < 1536) *(u32x4*)(VS + (size_t)g * 512 + (col - 1024)) = PK8(s8);
                else {
                    float t8[8];
#pragma unroll
                    for (int e = 0; e < 8; ++e) t8[e] = col < 1664 ? tanhf(s8[e]) : (col < 1792 ? s8[e] : sigmoidf_(s8[e]));
                    *(u32x4*)(LIN + (size_t)g * 384 + (col - 1536)) = PK8(t8);
                }
            }
        }
    }
#undef UNPK8
#undef PK8
}
__device__ __forceinline__ void ph_gemm_lora(const Args& A, int j, int row_lo, LAS unsigned char* lds, int bid, int nb) {
    unsigned char* ws = opq(A.ws);
    int Kq = LORA_K; asm volatile("" : "+s"(Kq));
    pg8::Gemm g{(const bf16_t*)(ws + WS_LIN) + (size_t)row_lo * LORA_K, (const bf16_t*)(ws + WS_WLORA) + (size_t)j * LORA_N * LORA_K, NTOK - row_lo, LORA_N, Kq};
    const ListOrder S = build_units(lds, (NTOK - row_lo) / 256, LORA_N / 256, nb, bid, nullptr, 0);
    EpiLora E{(bf16_t*)(ws + WS_LO), (const float*)(ws + WS_LBIAS) + (size_t)j * LORA_N, row_lo};
    pg8::gemm_phase<EpiLora, ListOrder, true, true>(lds, g, S, E);
}

constexpr int R_A2 = 0, R_RT = 2048, R_BT = 4096, R_KT = 6144, R_VT = 8192, R_MBR = 10240, R_MKR = 10752, R_G = 11264, R_P = 11776;
__device__ __forceinline__ bf16x8 frag4(u32x2 lo) { const u32x4 w = {lo.x, lo.y, 0u, 0u}; return __builtin_bit_cast(bf16x8, w); }
__device__ __forceinline__ bf16x8 frag8(u32x2 lo, u32x2 hi) { const u32x4 w = {lo.x, lo.y, hi.x, hi.y}; return __builtin_bit_cast(bf16x8, w); }
__device__ __forceinline__ u32x2 pack4(f32x4 v) { u32x2 o; o.x = cvtpk_s(v[0], v[1]); o.y = cvtpk_s(v[2], v[3]); return o; }
__device__ __forceinline__ int wkv_token(int b, int dir, int s) {
    if (s < TC) return b * TC + (dir ? (TC - 1 - s) : s);
    const int q = s - TC; return NCTX + b * TL + (dir ? (TL - 1 - q) : q);
}
__device__ __forceinline__ float dpp_row_shr(float x, const int n) {
    switch (n) {
        case 1: return __builtin_bit_cast(float, __builtin_amdgcn_update_dpp(0, __builtin_bit_cast(int, x), 0x111, 0xF, 0xF, false));
        case 2: return __builtin_bit_cast(float, __builtin_amdgcn_update_dpp(0, __builtin_bit_cast(int, x), 0x112, 0xF, 0xF, false));
        case 4: return __builtin_bit_cast(float, __builtin_amdgcn_update_dpp(0, __builtin_bit_cast(int, x), 0x114, 0xF, 0xF, false));
        default: return __builtin_bit_cast(float, __builtin_amdgcn_update_dpp(0, __builtin_bit_cast(int, x), 0x118, 0xF, 0xF, false));
    }
}
#define WKV_TR(dst, addr) asm volatile("ds_read_b64_tr_b16 %0, %1" : "=&v"(dst) : "v"(addr) : "memory")
__device__ __forceinline__ void ph_wkv_prep(const Args& A, int j, LAS unsigned char* lds, int bid, int nb) {
    unsigned char* ws = opq(A.ws); const float* const* IN = (const float* const*)(ws + WS_PTRS);
    const int tid = tid_opaque(), lane = tid & 63, wid = tid >> 6, c16 = lane & 15, g4 = lane >> 4;
    constexpr int RS = 144;
    LAS unsigned char* wl = lds + wid * 16384;
    LAS unsigned char* Lat = wl; LAS unsigned char* Lbt = wl + 2304; LAS unsigned char* Lkt = wl + 4608; LAS unsigned char* Lrt = wl + 6912; LAS unsigned char* Lvt = wl + 9216;
    LAS float* Lnf = (LAS float*)(wl + 11520);
    LAS unsigned char* Lx = wl + 12608;
    const size_t FS = (size_t)NTOK * 512;
    const bf16_t* RB = (const bf16_t*)(ws + WS_RB); const bf16_t* KS = (const bf16_t*)(ws + WS_KS); const bf16_t* VS = (const bf16_t*)(ws + WS_VS); const bf16_t* KKN = (const bf16_t*)(ws + WS_KKN);
#define UNPK16(dst, p) do { const u32x4 _a = *(const u32x4*)(p), _b = *(const u32x4*)((p) + 8); _Pragma("unroll") for (int _i = 0; _i < 4; ++_i) { \
        dst[2 * _i] = __builtin_bit_cast(float, _a[_i] << 16); dst[2 * _i + 1] = __builtin_bit_cast(float, _a[_i] & 0xffff0000u); \
        dst[8 + 2 * _i] = __builtin_bit_cast(float, _b[_i] << 16); dst[9 + 2 * _i] = __builtin_bit_cast(float, _b[_i] & 0xffff0000u); } } while (0)
#define PK16ST(base, v) do { *(LAS u32x4*)(base) = (u32x4){pk2(v[0], v[1]), pk2(v[2], v[3]), pk2(v[4], v[5]), pk2(v[6], v[7])}; \
        *(LAS u32x4*)((base) + 16) = (u32x4){pk2(v[8], v[9]), pk2(v[10], v[11]), pk2(v[12], v[13]), pk2(v[14], v[15])}; } while (0)
    for (int unit = bid * NWAVES + wid; unit < 256 * WKV_NCH; unit += nb * NWAVES) {
        const int inst = unit / WKV_NCH, c = unit - inst * WKV_NCH, dir = inst & 1, h = (inst >> 1) & 7, b = inst >> 4;
        const int g0 = wkv_token(b, dir, c * 16), gstep = dir ? -1 : 1;
        unsigned char* rec = ws + WS_WKV + (size_t)unit * WKV_REC;
        {
            const size_t o = (size_t)(g0 + gstep * c16) * 512 + h * 64 + 16 * g4;
            float lw[16], av[16], kv[16], kn[16], rv[16];
            UNPK16(lw, (const bf16_t*)(ws + WS_LO) + dir * FS + o); UNPK16(av, (const bf16_t*)(ws + WS_AB) + dir * FS + o);
            UNPK16(kv, KS + o); UNPK16(kn, KKN + o); UNPK16(rv, RB + o);
            { const u32x4 v0 = *(const u32x4*)(VS + o), v1 = *(const u32x4*)(VS + o + 8); *(LAS u32x4*)(Lvt + c16 * RS + 32 * g4) = v0; *(LAS u32x4*)(Lvt + c16 * RS + 32 * g4 + 16) = v1; }
            const float* kap = INP(I_RWKA) + j * 512 + h * 64 + 16 * g4;
            float at[16], bt[16], kt[16], rt[16], ecl[16];
#pragma unroll
            for (int i = 0; i < 16; ++i) {
                float cs = lw[i];
                cs += dpp_row_shr(cs, 1); cs += dpp_row_shr(cs, 2); cs += dpp_row_shr(cs, 4); cs += dpp_row_shr(cs, 8);
                const float ep = __expf(cs - lw[i]), ec = __expf(cs), em = __builtin_amdgcn_rcpf(ec);
                at[i] = -kn[i] * ep; bt[i] = kn[i] * av[i] * em; kt[i] = kv[i] * (1.0f + (av[i] - 1.0f) * kap[i]) * em; rt[i] = rv[i] * ec; ecl[i] = ec;
            }
            PK16ST(Lat + c16 * RS + 32 * g4, at); PK16ST(Lbt + c16 * RS + 32 * g4, bt); PK16ST(Lkt + c16 * RS + 32 * g4, kt); PK16ST(Lrt + c16 * RS + 32 * g4, rt);
            if (c16 == 15) {
#pragma unroll
                for (int q = 0; q < 4; ++q) *(f32x4*)(rec + R_P + (16 * g4 + 4 * q) * 4) = (f32x4){ecl[4 * q], ecl[4 * q + 1], ecl[4 * q + 2], ecl[4 * q + 3]};
            }
        }
        asm volatile("s_waitcnt lgkmcnt(0)" ::: "memory");
        f32x4 nD = {0.f, 0.f, 0.f, 0.f}, makD = nD, mbrD = nD, mkrD = nD;
#pragma unroll
        for (int ks = 0; ks < 2; ++ks) {
            const int off = c16 * RS + (32 * ks + 8 * g4) * 2;
            const bf16x8 fa = *(const LAS bf16x8*)(Lat + off), fb = *(const LAS bf16x8*)(Lbt + off), fk = *(const LAS bf16x8*)(Lkt + off), fr = *(const LAS bf16x8*)(Lrt + off);
            nD = __builtin_amdgcn_mfma_f32_16x16x32_bf16(fa, fb, nD, 0, 0, 0);
            makD = __builtin_amdgcn_mfma_f32_16x16x32_bf16(fa, fk, makD, 0, 0, 0);
            mbrD = __builtin_amdgcn_mfma_f32_16x16x32_bf16(fb, fr, mbrD, 0, 0, 0);
            mkrD = __builtin_amdgcn_mfma_f32_16x16x32_bf16(fk, fr, mkrD, 0, 0, 0);
        }
#pragma unroll
        for (int r = 0; r < 4; ++r) {
            const int row = 4 * g4 + r;
            nD[r] = (c16 < row) ? nD[r] : 0.f; makD[r] = (c16 < row) ? makD[r] : 0.f;
            mbrD[r] = (row <= c16) ? mbrD[r] : 0.f; mkrD[r] = (row <= c16) ? mkrD[r] : 0.f;
            Lnf[row * 17 + c16] = nD[r];
        }
        asm volatile("s_waitcnt lgkmcnt(0)" ::: "memory");
        float x[16];
#pragma unroll
        for (int t = 0; t < 16; ++t) {
            float acc = (t == c16) ? 1.f : 0.f;
#pragma unroll
            for (int i = 0; i < t; ++i) acc += Lnf[t * 17 + i] * x[i];
            x[t] = acc;
        }
        if (g4 == 0) {
#pragma unroll
            for (int t = 0; t < 16; ++t) *(LAS bf16_t*)(Lx + t * 32 + c16 * 2) = (bf16_t)f2bf(x[t]);
        }
        asm volatile("s_waitcnt lgkmcnt(0)" ::: "memory");
        const bf16x8 xB = frag4(*(const LAS u32x2*)(Lx + c16 * 32 + g4 * 8));
        const f32x4 z4 = {0.f, 0.f, 0.f, 0.f};
        const f32x4 gD = __builtin_amdgcn_mfma_f32_16x16x32_bf16(frag4(pack4(makD)), xB, z4, 0, 0, 0);
        *(u32x2*)(rec + R_G + (c16 * 16 + 4 * g4) * 2) = pack4(gD);
        *(u32x2*)(rec + R_MBR + (c16 * 16 + 4 * g4) * 2) = pack4(mbrD);
        *(u32x2*)(rec + R_MKR + (c16 * 16 + 4 * g4) * 2) = pack4(mkrD);
        {
            const int trow = c16 >> 2, tcol = 4 * (c16 & 3);
            u32x2 ta[4], tb[4], tk[4], tv[4];
#pragma unroll
            for (int m = 0; m < 4; ++m) {
                const int aA = (int)(uintptr_t)(Lat + (4 * g4 + trow) * RS + (16 * m + tcol) * 2);
                const int offr = (4 * m + trow) * RS + (16 * g4 + tcol) * 2;
                const int aB = (int)(uintptr_t)(Lbt + offr), aK = (int)(uintptr_t)(Lkt + offr), aV = (int)(uintptr_t)(Lvt + offr);
                WKV_TR(ta[m], aA); WKV_TR(tb[m], aB); WKV_TR(tk[m], aK); WKV_TR(tv[m], aV);
            }
            asm volatile("s_waitcnt lgkmcnt(0)" ::: "memory"); __builtin_amdgcn_sched_barrier(0);
#pragma unroll
            for (int m = 0; m < 4; ++m) {
                const f32x4 d = __builtin_amdgcn_mfma_f32_16x16x32_bf16(frag4(ta[m]), xB, z4, 0, 0, 0);
                *(u32x2*)(rec + R_A2 + (c16 * 64 + 16 * m + 4 * g4) * 2) = pack4(d);
            }
            const int kch = 16 * g4 + c16;
            *(u32x4*)(rec + R_BT + kch * 32) = (u32x4){tb[0].x, tb[0].y, tb[1].x, tb[1].y}; *(u32x4*)(rec + R_BT + kch * 32 + 16) = (u32x4){tb[2].x, tb[2].y, tb[3].x, tb[3].y};
            *(u32x4*)(rec + R_KT + kch * 32) = (u32x4){tk[0].x, tk[0].y, tk[1].x, tk[1].y}; *(u32x4*)(rec + R_KT + kch * 32 + 16) = (u32x4){tk[2].x, tk[2].y, tk[3].x, tk[3].y};
            *(u32x4*)(rec + R_VT + kch * 32) = (u32x4){tv[0].x, tv[0].y, tv[1].x, tv[1].y}; *(u32x4*)(rec + R_VT + kch * 32 + 16) = (u32x4){tv[2].x, tv[2].y, tv[3].x, tv[3].y};
        }
        { const int row = lane >> 2, cb = (lane & 3) * 16;
          const u32x4 r0 = *(const LAS u32x4*)(Lrt + row * RS + cb * 2), r1 = *(const LAS u32x4*)(Lrt + row * RS + cb * 2 + 16);
          *(u32x4*)(rec + R_RT + (row * 64 + cb) * 2) = r0; *(u32x4*)(rec + R_RT + (row * 64 + cb) * 2 + 16) = r1; }
        asm volatile("s_waitcnt lgkmcnt(0)" ::: "memory");
    }
#undef UNPK16
#undef PK16ST
}
constexpr int WKV_D = 6, WKV_R = WKV_D + 2;
__device__ __forceinline__ void ph_wkv_scan(const Args& A, LAS unsigned char* lds, int bid, int nb) {
    unsigned char* ws = opq(A.ws);
    const int tid = tid_opaque(), lane = tid & 63, wid = __builtin_amdgcn_readfirstlane(tid >> 6), c16 = lane & 15, g4 = lane >> 4;
    float* YS = (float*)(ws + WS_YS); const size_t FS = (size_t)NTOK * 512;
    for (int inst = bid; inst < 256; inst += nb) {
        const int dir = inst & 1, h = (inst >> 1) & 7, b = inst >> 4;
        const unsigned char* rec0 = ws + WS_WKV + (size_t)inst * WKV_NCH * WKV_REC;
        asm volatile("s_waitcnt vmcnt(0) lgkmcnt(0)" ::: "memory"); __builtin_amdgcn_s_barrier();
        if (wid >= 4) {
            const int p0 = 3 * (wid - 4);
#define WKV_ISSUE(c_) do { const unsigned char* src_ = rec0 + (size_t)(c_) * WKV_REC + p0 * 1024 + lane * 16; LAS unsigned char* dst_ = lds + ((c_) % WKV_R) * WKV_REC + p0 * 1024; \
        _Pragma("unroll") for (int i_ = 0; i_ < 3; ++i_) __builtin_amdgcn_global_load_lds((const unsigned*)(src_ + i_ * 1024), (LAS unsigned*)(dst_ + i_ * 1024), 16, 0, 0); } while (0)
            for (int c = 0; c < WKV_D; ++c) WKV_ISSUE(c);
            for (int c = 0; c < WKV_NCH; ++c) {
                if (c + WKV_D < WKV_NCH) { WKV_ISSUE(c + WKV_D); asm volatile("s_waitcnt vmcnt(18)" ::: "memory"); }
                else asm volatile("s_waitcnt vmcnt(0)" ::: "memory");
                __builtin_amdgcn_s_barrier();
            }
#undef WKV_ISSUE
        } else {
            const int v0 = wid * 16;
            float* Y = YS + dir * FS + h * 64 + v0 + c16;
            f32x4 S[4];
#pragma unroll
            for (int mt = 0; mt < 4; ++mt) S[mt] = (f32x4){0.f, 0.f, 0.f, 0.f};
            for (int c = 0; c < WKV_NCH; ++c) {
                __builtin_amdgcn_s_barrier();
                const LAS unsigned char* rec = lds + (c % WKV_R) * WKV_REC;
                u32x2 a2[4], rt[4], bt[4], kt[4]; f32x4 p[4];
#pragma unroll
                for (int q = 0; q < 4; ++q) {
                    a2[q] = *(const LAS u32x2*)(rec + R_A2 + (c16 * 64 + 16 * q + 4 * g4) * 2);
                    rt[q] = *(const LAS u32x2*)(rec + R_RT + (c16 * 64 + 16 * q + 4 * g4) * 2);
                    bt[q] = *(const LAS u32x2*)(rec + R_BT + ((16 * q + c16) * 16 + 4 * g4) * 2);
                    kt[q] = *(const LAS u32x2*)(rec + R_KT + ((16 * q + c16) * 16 + 4 * g4) * 2);
                    p[q] = *(const LAS f32x4*)(rec + R_P + (16 * q + 4 * g4) * 4);
                }
                const u32x2 gq = *(const LAS u32x2*)(rec + R_G + (c16 * 16 + 4 * g4) * 2), mkr = *(const LAS u32x2*)(rec + R_MKR + (c16 * 16 + 4 * g4) * 2), mbr = *(const LAS u32x2*)(rec + R_MBR + (c16 * 16 + 4 * g4) * 2);
                const u32x2 vt = *(const LAS u32x2*)(rec + R_VT + ((v0 + c16) * 16 + 4 * g4) * 2);
                const f32x4 z4 = {0.f, 0.f, 0.f, 0.f};
                const bf16x8 sb0 = frag8(pack4(S[0]), pack4(S[1])), sb1 = frag8(pack4(S[2]), pack4(S[3]));
                const bf16x8 vb = frag4(vt);
                f32x4 U = __builtin_amdgcn_mfma_f32_16x16x32_bf16(frag4(gq), vb, z4, 0, 0, 0);
                U = __builtin_amdgcn_mfma_f32_16x16x32_bf16(frag8(a2[0], a2[1]), sb0, U, 0, 0, 0);
                U = __builtin_amdgcn_mfma_f32_16x16x32_bf16(frag8(a2[2], a2[3]), sb1, U, 0, 0, 0);
                f32x4 Yt = __builtin_amdgcn_mfma_f32_16x16x32_bf16(frag4(mkr), vb, z4, 0, 0, 0);
                Yt = __builtin_amdgcn_mfma_f32_16x16x32_bf16(frag8(rt[0], rt[1]), sb0, Yt, 0, 0, 0);
                Yt = __builtin_amdgcn_mfma_f32_16x16x32_bf16(frag8(rt[2], rt[3]), sb1, Yt, 0, 0, 0);
                const bf16x8 ub = frag4(pack4(U));
                Yt = __builtin_amdgcn_mfma_f32_16x16x32_bf16(frag4(mbr), ub, Yt, 0, 0, 0);
#pragma unroll
                for (int mt = 0; mt < 4; ++mt) {
                    f32x4 sn = __builtin_amdgcn_mfma_f32_16x16x32_bf16(frag4(kt[mt]), vb, S[mt], 0, 0, 0);
                    sn = __builtin_amdgcn_mfma_f32_16x16x32_bf16(frag4(bt[mt]), ub, sn, 0, 0, 0);
                    S[mt] = sn * p[mt];
                }
#pragma unroll
                for (int r = 0; r < 4; ++r) Y[(size_t)wkv_token(b, dir, c * 16 + 4 * g4 + r) * 512] = Yt[r];
            }
        }
    }
}

__device__ __forceinline__ void ph_qk(const Args& A, int j, int row_lo, int bid, int nb) {
    unsigned char* ws = opq(A.ws); const float* const* IN = (const float* const*)(ws + WS_PTRS);
    const int tid = tid_opaque(), lane = tid & 63, wid = tid >> 6;
    const bf16_t* Z = (const bf16_t*)(ws + WS_Z);
    bf16_t* QB = (bf16_t*)(ws + WS_QB); bf16_t* KB = (bf16_t*)(ws + WS_KB); bf16_t* VB = (bf16_t*)(ws + WS_VB);
    const int d0 = (lane & 7) * 8;
    float qn[8], kn[8], invf[8];
#pragma unroll
    for (int i = 0; i < 8; ++i) { qn[i] = INP(I_QN)[j * 64 + d0 + i]; kn[i] = INP(I_KN)[j * 64 + d0 + i]; invf[i] = __powf(10000.0f, -(float)((d0 + i) & 15) / 16.0f); }
    const bool upper = (d0 & 16) != 0, colaxis = (d0 & 32) != 0;
    for (int g = row_lo + bid * NWAVES + wid; g < NTOK; g += nb * NWAVES) {
        const Tok tk = tokinfo(g);
        const size_t krow = (size_t)tk.b * (TC + TL) + (tk.T == TL ? TC + tk.t : tk.t);
        const bf16_t* zr = Z + (size_t)g * ZLD + RWC;
        *(u32x4*)(VB + krow * 512 + lane * 8) = *(const u32x4*)(zr + 1024 + lane * 8);
        float cs[8], sn[8];
        if (tk.T == TL) {
            const float pos = (float)(colaxis ? (tk.t & 63) : (tk.t >> 6));
#pragma unroll
            for (int i = 0; i < 8; ++i) __sincosf(pos * invf[i], &sn[i], &cs[i]);
        }
#pragma unroll
        for (int isk = 0; isk < 2; ++isk) {
            const u32x4 raw = *(const u32x4*)(zr + isk * 512 + lane * 8);
            float x[8];
#pragma unroll
            for (int i = 0; i < 4; ++i) { x[2 * i] = __builtin_bit_cast(float, raw[i] << 16); x[2 * i + 1] = __builtin_bit_cast(float, raw[i] & 0xffff0000u); }
            float ss = 0.f;
#pragma unroll
            for (int i = 0; i < 8; ++i) ss += x[i] * x[i];
            ss += __shfl_xor(ss, 1); ss += __shfl_xor(ss, 2); ss += __shfl_xor(ss, 4);
            const float rs = rsqrtf(ss * (1.0f / 64.0f) + 1e-6f);
#pragma unroll
            for (int i = 0; i < 8; ++i) x[i] = x[i] * rs * (isk ? kn[i] : qn[i] * att::QSCALE);
            if (tk.T == TL) {
#pragma unroll
                for (int i = 0; i < 8; ++i) { const float other = __shfl_xor(x[i], 2); x[i] = upper ? (x[i] * cs[i] + other * sn[i]) : (x[i] * cs[i] - other * sn[i]); }
            }
            u32x4 o; o.x = pk2(x[0], x[1]); o.y = pk2(x[2], x[3]); o.z = pk2(x[4], x[5]); o.w = pk2(x[6], x[7]);
            if (isk) *(u32x4*)(KB + krow * 512 + lane * 8) = o; else *(u32x4*)(QB + (size_t)g * 512 + lane * 8) = o;
        }
    }
}

__device__ __forceinline__ void ph_attn(const Args& A, bool want_ctx, LAS unsigned char* lds, int bid, int nb) {
    unsigned char* ws = opq(A.ws);
    const bf16_t* QB = (const bf16_t*)(ws + WS_QB); const bf16_t* KB = (const bf16_t*)(ws + WS_KB); const bf16_t* VB = (const bf16_t*)(ws + WS_VB);
    float* OP = (float*)(ws + WS_OP);
    const int vcu = (nb % 8 == 0) ? (bid % 8) * (nb / 8) + bid / 8 : bid;
    const int nunits = 1024 + (want_ctx ? 128 : 0);
    for (int u = vcu; u < nunits; u += nb) {
        int b, h, m, q0, seq;
        if (u < 1024) { const int qb = u & 7; m = (u >> 3) & 1; h = (u >> 4) & 3; b = u >> 6; q0 = NCTX + b * TL + qb * 256; seq = TC + TL; }
        else { const int v = u - 1024; m = v & 1; h = (v >> 1) & 3; b = v >> 3; q0 = b * TC; seq = TC; }
        const int s = h * 2 + m;
        att::attn_body(QB + (size_t)q0 * 512 + s * 64, KB + (size_t)b * (TC + TL) * 512 + s * 64, VB + (size_t)b * (TC + TL) * 512 + h * 128,
                       OP + (size_t)m * NTOK * 512 + (size_t)q0 * 512 + h * 128, seq, lds);
    }
}

__device__ __forceinline__ void ph_merge(const Args& A, int l, int row_lo, int bid, int nb) {
    unsigned char* ws = opq(A.ws); const float* const* IN = (const float* const*)(ws + WS_PTRS);
    const int j = l >> 1;
    const int tid = tid_opaque(), lane = tid & 63, wid = tid >> 6, c0 = lane * 8;
    const float lam_init = 0.8f - 0.6f * __expf(-0.3f * (float)l);
    const float* lp = INP(I_LAM) + j * 4 * 64;
    const float lam = __expf(wave_sum(lp[lane] * lp[64 + lane])) - __expf(wave_sum(lp[128 + lane] * lp[192 + lane])) + lam_init;
    const size_t FS = (size_t)NTOK * 512;
    const bf16_t* RB = (const bf16_t*)(ws + WS_RB); const bf16_t* KS = (const bf16_t*)(ws + WS_KS); const bf16_t* VS = (const bf16_t*)(ws + WS_VS);
    const bf16_t* AB = (const bf16_t*)(ws + WS_AB); const bf16_t* GB = (const bf16_t*)(ws + WS_GB);
    const float* YS = (const float*)(ws + WS_YS); const float* OP = (const float*)(ws + WS_OP);
    bf16_t* CAT = (bf16_t*)(ws + WS_CAT);
    float gnw[8], gnb[8], kaw[8], rkw[8], sub[8];
#pragma unroll
    for (int i = 0; i < 8; ++i) { gnw[i] = INP(I_GNW)[j * 512 + c0 + i]; gnb[i] = INP(I_GNB)[j * 512 + c0 + i]; kaw[i] = INP(I_RWKA)[j * 512 + c0 + i]; rkw[i] = INP(I_RWRK)[j * 512 + c0 + i];
        sub[i] = INP(I_SUBLN)[j * 128 + ((c0 + i) & 127)] * (1.0f - lam_init); }
#define LD8BF(dst, ptr) do { const u32x4 _t = *(const u32x4*)(ptr); _Pragma("unroll") for (int _i = 0; _i < 4; ++_i) { dst[2 * _i] = __builtin_bit_cast(float, _t[_i] << 16); dst[2 * _i + 1] = __builtin_bit_cast(float, _t[_i] & 0xffff0000u); } } while (0)
    for (int g = row_lo + bid * NWAVES + wid; g < NTOK; g += nb * NWAVES) {
        const size_t o = (size_t)g * 512 + c0;
        float y[8], r_[8], k_[8], v_[8], a0[8], a1[8], gg[8];
        { const f32x4 y0 = *(const f32x4*)(YS + o), y1 = *(const f32x4*)(YS + o + 4), z0 = *(const f32x4*)(YS + FS + o), z1 = *(const f32x4*)(YS + FS + o + 4);
#pragma unroll
          for (int i = 0; i < 4; ++i) { y[i] = y0[i] + z0[i]; y[4 + i] = y1[i] + z1[i]; } }
        LD8BF(r_, RB + o); LD8BF(k_, KS + o); LD8BF(v_, VS + o); LD8BF(a0, AB + o); LD8BF(a1, AB + FS + o); LD8BF(gg, GB + o);
        float sy = 0.f, sb = 0.f;
#pragma unroll
        for (int i = 0; i < 8; ++i) { sy += y[i]; sb += r_[i] * k_[i] * (2.0f + (a0[i] + a1[i] - 2.0f) * kaw[i]) * rkw[i]; }
        sy += __shfl_xor(sy, 1); sy += __shfl_xor(sy, 2); sy += __shfl_xor(sy, 4);
        sb += __shfl_xor(sb, 1); sb += __shfl_xor(sb, 2); sb += __shfl_xor(sb, 4);
        const float mu = sy * (1.0f / 64.0f);
        float sv = 0.f;
#pragma unroll
        for (int i = 0; i < 8; ++i) { y[i] -= mu; sv += y[i] * y[i]; }
        sv += __shfl_xor(sv, 1); sv += __shfl_xor(sv, 2); sv += __shfl_xor(sv, 4);
        const float rstd = rsqrtf(sv * (1.0f / 64.0f) + 64e-5f);
        float ya[8];
#pragma unroll
        for (int i = 0; i < 8; ++i) ya[i] = (y[i] * rstd * gnw[i] + gnb[i] + sb * v_[i]) * gg[i];
        { u32x4 w; w.x = pk2(ya[0], ya[1]); w.y = pk2(ya[2], ya[3]); w.z = pk2(ya[4], ya[5]); w.w = pk2(ya[6], ya[7]); *(u32x4*)(CAT + (size_t)g * DM + c0) = w; }
        float od[8];
        { const f32x4 p0 = *(const f32x4*)(OP + o), p1 = *(const f32x4*)(OP + o + 4), q0 = *(const f32x4*)(OP + FS + o), q1 = *(const f32x4*)(OP + FS + o + 4);
#pragma unroll
          for (int i = 0; i < 4; ++i) { od[i] = p0[i] - lam * q0[i]; od[4 + i] = p1[i] - lam * q1[i]; } }
        float so = 0.f;
#pragma unroll
        for (int i = 0; i < 8; ++i) so += od[i] * od[i];
        so += __shfl_xor(so, 1); so += __shfl_xor(so, 2); so += __shfl_xor(so, 4); so += __shfl_xor(so, 8);
        const float ro = rsqrtf(so * (1.0f / 128.0f) + 1e-6f);
        { u32x4 w; w.x = pk2(od[0] * ro * sub[0], od[1] * ro * sub[1]); w.y = pk2(od[2] * ro * sub[2], od[3] * ro * sub[3]);
          w.z = pk2(od[4] * ro * sub[4], od[5] * ro * sub[5]); w.w = pk2(od[6] * ro * sub[6], od[7] * ro * sub[7]); *(u32x4*)(CAT + (size_t)g * DM + 512 + c0) = w; }
    }
#undef LD8BF
}

__device__ __forceinline__ void ph_gemm_out(const Args& A, int l, size_t x_off, size_t wt_off, int row_lo, LAS unsigned char* lds, int bid, int nb) {
    unsigned char* ws = opq(A.ws); const float* const* IN = (const float* const*)(ws + WS_PTRS); (void)IN;
    pg8::Gemm g{(const bf16_t*)(ws + x_off) + (size_t)row_lo * DM, (const bf16_t*)(ws + wt_off), NTOK - row_lo, DM, DM};
    const ListOrder S = build_units(lds, (NTOK - row_lo) / 256, DM / 256, nb, bid, nullptr, 0);
    EpiResidual E{(float*)(ws + WS_H) + (size_t)row_lo * DM, (const float*)(ws + WS_MOD) + (size_t)l * 17 * 6144 + 2 * 1024, row_lo};
    pg8::gemm_phase<EpiResidual, ListOrder, true, true>(lds, g, S, E);
}

__device__ __forceinline__ void ph_gemm_sgin(const Args& A, int j, int row_lo, LAS unsigned char* lds, int bid, int nb) {
    unsigned char* ws = opq(A.ws); const float* const* IN = (const float* const*)(ws + WS_PTRS); (void)IN;
    pg8::Gemm g{(const bf16_t*)(ws + WS_ABF) + (size_t)row_lo * DM, (const bf16_t*)(ws + WS_SGIN) + (size_t)j * 2048 * DM, NTOK - row_lo, 2048, DM};
    const ListOrder S = build_units(lds, (NTOK - row_lo) / 256, 2048 / 256, nb, bid, nullptr, 0);
    EpiGeluBf16 E{(bf16_t*)(ws + WS_Z2) + (size_t)row_lo * 2048, 2048, INP(I_SGBIN) + j * 2048};
    pg8::gemm_phase<EpiGeluBf16, ListOrder, true, true>(lds, g, S, E);
}
__device__ __forceinline__ void ph_sgu_stats(const Args& A, int row_lo, int bid, int nb) {
    unsigned char* ws = opq(A.ws);
    const int tid = tid_opaque(), lane = tid & 63, wid = tid >> 6;
    const bf16_t* Z2 = (const bf16_t*)(ws + WS_Z2); float* ST = (float*)(ws + WS_VST);
    for (int row = row_lo + bid * NWAVES + wid; row < NTOK; row += nb * NWAVES) {
        const u32x4 t0 = *(const u32x4*)(Z2 + (size_t)row * 2048 + 1024 + lane * 8), t1 = *(const u32x4*)(Z2 + (size_t)row * 2048 + 1536 + lane * 8);
        float v[16]; float s = 0.f;
#pragma unroll
        for (int i = 0; i < 4; ++i) { v[2 * i] = __builtin_bit_cast(float, t0[i] << 16); v[2 * i + 1] = __builtin_bit_cast(float, t0[i] & 0xffff0000u);
            v[8 + 2 * i] = __builtin_bit_cast(float, t1[i] << 16); v[9 + 2 * i] = __builtin_bit_cast(float, t1[i] & 0xffff0000u); }
#pragma unroll
        for (int i = 0; i < 16; ++i) s += v[i];
        const float mean = wave_sum(s) * (1.0f / 1024.0f); float s2 = 0.f;
#pragma unroll
        for (int i = 0; i < 16; ++i) { const float d = v[i] - mean; s2 += d * d; }
        const float rstd = rsqrtf(wave_sum(s2) * (1.0f / 1024.0f) + 1e-5f);
        if (lane == 0) { ST[(size_t)row * 2] = mean; ST[(size_t)row * 2 + 1] = rstd; }
    }
}
__device__ __forceinline__ void ph_sgu_spatial(const Args& A, int j, int row_lo, LAS unsigned char* lds, int bid, int nb) {
    unsigned char* ws = opq(A.ws); const float* const* IN = (const float* const*)(ws + WS_PTRS);
    const int tid = tid_opaque(), lane = tid & 63, wid = tid >> 6, c16 = lane & 15, g4 = lane >> 4;
    const bf16_t* Z2 = (const bf16_t*)(ws + WS_Z2); const float* ST = (const float*)(ws + WS_VST); bf16_t* G = (bf16_t*)(ws + WS_G);
    constexpr int VS = 272;
    LAS unsigned char* vt = lds;
    LAS float* stl = (LAS float*)(lds + 36864);
    const int ch0 = row_lo / 128, nch = NTOK / 128 - ch0;
    for (int u = bid; u < nch * 8; u += nb) {
        const int ci = ch0 + u / 8, g = u % 8;
        const size_t r0 = (size_t)ci * 128;
        __syncthreads();
#pragma unroll
        for (int i = 0; i < 4; ++i) {
            const int idx = tid + NTHREADS * i, q = idx >> 4, jc = idx & 15;
            const u32x4 t = *(const u32x4*)(Z2 + (r0 + q) * 2048 + 1024 + g * 128 + jc * 8);
#pragma unroll
            for (int e = 0; e < 4; ++e) { *(LAS bf16_t*)(vt + (jc * 8 + 2 * e) * VS + q * 2) = (bf16_t)(t[e] & 0xffffu); *(LAS bf16_t*)(vt + (jc * 8 + 2 * e + 1) * VS + q * 2) = (bf16_t)(t[e] >> 16); }
        }
        if (tid < 256) stl[tid] = ST[r0 * 2 + tid];
        __syncthreads();
        const float* wrow = INP(I_SGWS) + (((size_t)j * 8 + g) * 128 + 16 * wid + c16) * 128;
        bf16x8 af[4]; float wm = 0.f, rs = 0.f;
#pragma unroll
        for (int ks = 0; ks < 4; ++ks) {
            const int q0 = 32 * ks + 8 * g4;
            const f32x4 w0 = *(const f32x4*)(wrow + q0), w1 = *(const f32x4*)(wrow + q0 + 4);
            float wv[8] = {w0[0], w0[1], w0[2], w0[3], w1[0], w1[1], w1[2], w1[3]};
#pragma unroll
            for (int e = 0; e < 8; ++e) { rs += wv[e]; wv[e] *= stl[(q0 + e) * 2 + 1]; wm += wv[e] * stl[(q0 + e) * 2]; }
            const u32x4 pk = {pk2(wv[0], wv[1]), pk2(wv[2], wv[3]), pk2(wv[4], wv[5]), pk2(wv[6], wv[7])};
            af[ks] = __builtin_bit_cast(bf16x8, pk);
        }
        wm += __shfl_xor(wm, 16); wm += __shfl_xor(wm, 32); rs += __shfl_xor(rs, 16); rs += __shfl_xor(rs, 32);
        f32x4 acc[8];
#pragma unroll
        for (int nt = 0; nt < 8; ++nt) acc[nt] = (f32x4){0.f, 0.f, 0.f, 0.f};
#pragma unroll
        for (int ks = 0; ks < 4; ++ks)
#pragma unroll
            for (int nt = 0; nt < 8; ++nt) {
                const bf16x8 bfr = *(const LAS bf16x8*)(vt + (16 * nt + c16) * VS + (32 * ks + 8 * g4) * 2);
                acc[nt] = __builtin_amdgcn_mfma_f32_16x16x32_bf16(af[ks], bfr, acc[nt], 0, 0, 0);
            }
        float wmr[4], rsr[4], bsr[4];
#pragma unroll
        for (int r = 0; r < 4; ++r) { wmr[r] = __shfl(wm, 4 * g4 + r); rsr[r] = __shfl(rs, 4 * g4 + r); bsr[r] = INP(I_SGBS)[((size_t)j * 8 + g) * 128 + 16 * wid + 4 * g4 + r]; }
#pragma unroll
        for (int nt = 0; nt < 8; ++nt) {
            const int c = g * 128 + 16 * nt + c16;
            const float lg = INP(I_SGLNG)[j * 1024 + c], lb = INP(I_SGLNB)[j * 1024 + c];
#pragma unroll
            for (int r = 0; r < 4; ++r) {
                const size_t row = r0 + 16 * wid + 4 * g4 + r;
                const float sv = lg * (acc[nt][r] - wmr[r]) + rsr[r] * lb + bsr[r];
                G[row * DM + c] = (bf16_t)f2bf(bf2f(Z2[row * 2048 + c]) * sv);
            }
        }
    }
}

__device__ __forceinline__ int moe_layout(const Args& A, int l, int bid, int nb, LAS int* off  , LAS int* cntl  , LAS int* tile_e  , LAS int* base  ) {
    const int tid = tid_opaque();
    const int* bc = (const int*)(opq(A.ws) + WS_BCNT) + (size_t)l * 256 * 32;
    if (tid < 64) {
        int n = 0, pre = 0;
        if (tid < 32) {
#pragma unroll 8
            for (int b = 0; b < nb; ++b) { const int c = bc[b * 32 + tid]; n += c; pre += (b < bid) ? c : 0; }
        }
        const int nt = (n + 255) >> 8;
        int x = nt;
#pragma unroll
        for (int o = 1; o < 32; o <<= 1) { const int y = __shfl_up(x, o); if (tid >= o) x += y; }
        const int start = x - nt;
        if (tid < 32) {
            cntl[tid] = n; off[tid] = start * 256; base[tid] = start * 256 + pre;
#pragma unroll 1
            for (int t = 0; t < nt; ++t) tile_e[start + t] = tid;
        }
        if (tid == 31) off[32] = x * 256;
    }
    __syncthreads();
    return off[32] >> 8;
}
__device__ __forceinline__ void ph_moe_scatter(const Args& A, int l, int row_lo, LAS unsigned char* lds, int bid, int nb) {
    unsigned char* ws = opq(A.ws);
    const int tid = tid_opaque();
    LAS int* off = (LAS int*)(lds + LDS_TAB); LAS int* cntl = off + 64; LAS int* tile_e = off + 128; LAS int* base = off + 800;
    moe_layout(A, l, bid, nb, off, cntl, tile_e, base);
    const int* te = (const int*)(ws + WS_TOKE); const int* tr = (const int*)(ws + WS_TOKR); int* rowof = (int*)(ws + WS_ROWOF); int* srcrow = (int*)(ws + WS_SRCROW);
    const int ngroups = (NTOK - row_lo) / 16, per = nb * NWAVES;
    const int nmine = (ngroups - bid * NWAVES + per - 1) / per * NWAVES;
    for (int q = tid; q < nmine * 64; q += NTHREADS) {
        const int slot = q >> 6, r = (q >> 2) & 15, k = q & 3, i = slot >> 3, w = slot & 7;
        const int u = i * per + bid * NWAVES + w;
        if (u < ngroups) {
            const int row = row_lo + 16 * u + r;
            const int e = te[(size_t)row * 4 + k];
            const int pos = base[e] + tr[(size_t)row * 4 + k];
            rowof[(size_t)row * 4 + k] = pos; srcrow[pos] = row;
        }
    }
    for (int e = bid; e < 32; e += nb) {
        const int r0 = off[e] + cntl[e], r1 = off[e + 1];
        for (int i = r0 + tid; i < r1; i += NTHREADS) srcrow[i] = NCTX;
    }
}
__device__ __forceinline__ void ph_moe_gemm1(const Args& A, int l, LAS unsigned char* lds, int bid, int nb) {
    unsigned char* ws = opq(A.ws); const float* const* IN = (const float* const*)(ws + WS_PTRS); (void)IN;
    LAS int* off = (LAS int*)(lds + LDS_TAB); LAS int* cntl = off + 64; LAS int* tile_e = off + 128; LAS int* base = off + 800;
    const int T = moe_layout(A, l, bid, nb, off, cntl, tile_e, base);
    int Kq = DM / 2; asm volatile("" : "+s"(Kq));
    pg8::Gemm g{(const bf16_t*)(ws + WS_ABF), (const bf16_t*)(ws + WS_W1 + (size_t)l * NE * 2048 * DM), T * 256, 2048, Kq};
    const ListOrder S = build_units(lds, T, 8, nb, bid, tile_e, 8);
    { LAS unsigned* rowtab = (LAS unsigned*)(lds + LDS_ROWTAB); const int* srcrow = (const int*)(ws + WS_SRCROW); const int tid = tid_opaque();
      for (int q = tid; q < S.n * 256; q += NTHREADS) rowtab[q] = (unsigned)srcrow[S.list[2 * (q >> 8)] * 256 + (q & 255)] * (unsigned)DM;
      __syncthreads(); }
    EpiMoe1 E{(bf16_t*)(ws + WS_ACT), INP(I_B1) + (size_t)l * NE * 2048};
    pg8::gemm_phase<EpiMoe1, ListOrder, true, true, true, true>(lds, g, S, E);
}
__device__ __forceinline__ void ph_moe_gemm2(const Args& A, int l, LAS unsigned char* lds, int bid, int nb) {
    unsigned char* ws = opq(A.ws); const float* const* IN = (const float* const*)(ws + WS_PTRS); (void)IN;
    LAS int* off = (LAS int*)(lds + LDS_TAB); LAS int* cntl = off + 64; LAS int* tile_e = off + 128; LAS int* base = off + 800;
    const int T = moe_layout(A, l, bid, nb, off, cntl, tile_e, base);
    pg8::Gemm g{(const bf16_t*)(ws + WS_ACT), (const bf16_t*)(ws + WS_W2) + (size_t)l * NE * DM * DM, T * 256, DM, DM};
    const ListOrder S = build_units(lds, T, 4, nb, bid, tile_e, 4);
    EpiMoe2 E{(bf16_t*)(ws + WS_YM), INP(I_B2) + (size_t)l * NE * DM};
    pg8::gemm_phase<EpiMoe2, ListOrder, true, true>(lds, g, S, E);
}
__device__ __forceinline__ void ph_moe_combine(const Args& A, int l, int row_lo, bool last, int bid, int nb, bool dry = false) {
    unsigned char* ws = opq(A.ws); const float* const* IN = (const float* const*)(ws + WS_PTRS);
    const int tid = tid_opaque(), lane = tid & 63, wid = tid >> 6;
    float* H = (float*)(ws + WS_H); const float* mod = (const float*)(ws + WS_MOD); const bf16_t* YM = (const bf16_t*)(ws + WS_YM);
    float* Hw = dry ? (float*)(ws + WS_XP) : H;
    const int* rowof = (const int*)(ws + WS_ROWOF); const float* tg = (const float*)(ws + WS_TOKG);
    bf16_t* abf = dry ? (bf16_t*)(ws + WS_XP + (size_t)NTOK * DM * 4) : (bf16_t*)(ws + WS_ABF);
    const int ln = last ? l : l + 1;
    const float* gp = INP(I_N1G) + ln * 1024;
    for (int row = row_lo + bid * NWAVES + wid; row < NTOK; row += nb * NWAVES) {
        const Tok tk = tokinfo(row);
        const float* gate = mod + ((size_t)l * 17 + tk.modrow) * 6144 + 5 * 1024;
        int r[4]; float gk[4];
#pragma unroll
        for (int k = 0; k < 4; ++k) { r[k] = rowof[(size_t)row * 4 + k]; gk[k] = tg[(size_t)row * 4 + k]; }
        f32x4 hv[4]; float ss = 0.f;
#pragma unroll
        for (int q = 0; q < 4; ++q) {
            const int col = q * 256 + lane * 4;
            f32x4 m = (f32x4){0.f, 0.f, 0.f, 0.f};
#pragma unroll
            for (int k = 0; k < 4; ++k) { const u32x2 t = *(const u32x2*)(YM + (size_t)r[k] * DM + col);
                m = m + (f32x4){__builtin_bit_cast(float, t.x << 16), __builtin_bit_cast(float, t.x & 0xffff0000u), __builtin_bit_cast(float, t.y << 16), __builtin_bit_cast(float, t.y & 0xffff0000u)} * gk[k]; }
            hv[q] = *(const f32x4*)(H + (size_t)row * DM + col) + *(const f32x4*)(gate + col) * m;
            if (last && !dry) *(f32x4*)(as_global(((float* const*)IN)[38]) + (size_t)(row - NCTX) * DM + col) = hv[q];
            else *(f32x4*)(Hw + (size_t)row * DM + col) = hv[q];
            ss += (hv[q].x * hv[q].x + hv[q].y * hv[q].y) + (hv[q].z * hv[q].z + hv[q].w * hv[q].w);
        }
        if (!last) {
            const float rstd = rsqrtf(wave_sum(ss) * (1.0f / DM) + 1e-6f);
            const float* mrow = mod + ((size_t)ln * 17 + tk.modrow) * 6144;
#pragma unroll
            for (int q = 0; q < 4; ++q) {
                const int col = q * 256 + lane * 4;
                const f32x4 g = *(const f32x4*)(gp + col), sc = *(const f32x4*)(mrow + 1024 + col), sh = *(const f32x4*)(mrow + col);
                const f32x4 v = (hv[q] * rstd * g) * (sc + 1.0f) + sh;
                u32x2 o; o.x = pk2(v.x, v.y); o.y = pk2(v.z, v.w);
                *(u32x2*)(abf + (size_t)row * DM + col) = o;
            }
        }
    }
}

__global__ void __launch_bounds__(NTHREADS, 2) fwd_kernel(Args A) {
    extern __shared__ __attribute__((aligned(16))) unsigned char lds_raw[];
    LAS unsigned char* lds = (LAS unsigned char*)lds_raw;
    volatile LAS unsigned* misc = (volatile LAS unsigned*)(lds + LDS_MISC);
    const int tid = threadIdx.x, bid = blockIdx.x, nb = gridDim.x;
    if (tid < 64) misc[tid] = 0u;
    __syncthreads();
    XcdBarrier bar = xcd_barrier_post((unsigned*)(A.ws + WS_CTL) + CW_BAR, misc + 8);
    const int lo = A.ph_lo, hi = A.ph_hi;
    int pc = 0;
#ifndef PHSEL
#define PHSEL -1
#endif
#define SEL(k) (PHSEL < 0 || PHSEL == (k))
#ifndef REPEAT_MASK
#define REPEAT_MASK 0
#endif
#define RUN(k, call) do { if (SEL(k)) { call; if ((REPEAT_MASK >> (k)) & 1) { xcd_barrier(bar); call; } } } while (0)
#define PH_BEGIN if (pc >= lo && pc < hi) {
#define PH_END } if (pc >= lo && pc + 1 < hi) xcd_barrier(bar); ++pc;

    PH_BEGIN RUN(0, ph_prologue(A, lds, bid, nb)); PH_END

    for (int l = 0; l < 4; ++l) {
        const int j = l >> 1;
        const bool ctx_out = (l < 2), ctx_in = (l < 3);
        const int rin = ctx_in ? 0 : NCTX, rout = ctx_out ? 0 : NCTX;
        if (l == 0) { PH_BEGIN RUN(1, ph_norm<false>(A, l, rin, lds, bid, nb)); PH_END }
        if ((l & 1) == 0) {
            PH_BEGIN RUN(2, ph_gemm_win(A, j, rin, lds, bid, nb)); PH_END
            PH_BEGIN RUN(3, ph_rwkv_pre(A, j, rin, bid, nb)); RUN(4, ph_qk(A, j, rin, bid, nb)); PH_END
            PH_BEGIN RUN(19, ph_gemm_lora(A, j, rin, lds, bid, nb)); PH_END
            PH_BEGIN RUN(18, ph_wkv_prep(A, j, lds, bid, nb)); PH_END
            PH_BEGIN RUN(5, ph_wkv_scan(A, lds, bid, nb)); PH_END
            PH_BEGIN RUN(6, ph_attn(A, ctx_out, lds, bid, nb)); PH_END
            PH_BEGIN RUN(7, ph_merge(A, l, rout, bid, nb)); PH_END
            PH_BEGIN RUN(8, ph_gemm_out(A, l, WS_CAT, WS_WOUT + (size_t)j * DM * DM * 2, rout, lds, bid, nb)); PH_END
        } else {
            PH_BEGIN RUN(9, ph_gemm_sgin(A, j, rin, lds, bid, nb)); PH_END
            PH_BEGIN RUN(10, ph_sgu_stats(A, rin, bid, nb)); PH_END
            PH_BEGIN RUN(11, ph_sgu_spatial(A, j, rout, lds, bid, nb)); PH_END
            PH_BEGIN RUN(12, ph_gemm_out(A, l, WS_G, WS_SGOUT + (size_t)j * DM * DM * 2, rout, lds, bid, nb)); PH_END
        }
        PH_BEGIN RUN(13, ph_norm2_router(A, l, rout, lds, bid, nb)); PH_END
        PH_BEGIN RUN(14, ph_moe_scatter(A, l, rout, lds, bid, nb)); PH_END
        PH_BEGIN RUN(15, ph_moe_gemm1(A, l, lds, bid, nb)); PH_END
        PH_BEGIN RUN(16, ph_moe_gemm2(A, l, lds, bid, nb)); PH_END
        PH_BEGIN if (SEL(17)) { if ((REPEAT_MASK >> 17) & 1) { ph_moe_combine(A, l, rout, l == 3, bid, nb, true); xcd_barrier(bar); } ph_moe_combine(A, l, rout, l == 3, bid, nb); } PH_END
    }
}

extern "C" void kernel_launch(void* const* d_in, const int* in_sizes, int n_in, void* d_out, int out_size, void* d_ws, size_t ws_size, hipStream_t stream) {
    static int grid = 0;
    if (grid == 0) {
        if (n_in != 38 || out_size != NLAT * DM || ws_size < WS_END) { fprintf(stderr, "kernel_launch: unexpected shapes: n_in %d out %d ws %zu (need %zu)\n", n_in, out_size, ws_size, (size_t)WS_END); grid = -1; return; }
        int dev = 0, cus = 0, per_cu = 0;
        if (hipGetDevice(&dev) != hipSuccess || hipDeviceGetAttribute(&cus, hipDeviceAttributeMultiprocessorCount, dev) != hipSuccess) { grid = -1; return; }
        if (hipFuncSetAttribute((const void*)fwd_kernel, hipFuncAttributeMaxDynamicSharedMemorySize, LDS_BYTES) != hipSuccess) { fprintf(stderr, "kernel_launch: hipFuncSetAttribute failed\n"); grid = -1; return; }
        if (hipOccupancyMaxActiveBlocksPerMultiprocessor(&per_cu, (const void*)fwd_kernel, NTHREADS, LDS_BYTES) != hipSuccess || per_cu < 1)
            fprintf(stderr, "kernel_launch: occupancy query reports %d workgroups per CU\n", per_cu);
        (void)hipGetLastError();
        grid = cus;
    }
    if (grid < 0) return;
    if (hipMemsetAsync((char*)d_ws + WS_CTL, 0, CTL_ZERO_BYTES, stream) != hipSuccess) { fprintf(stderr, "kernel_launch: memset failed\n"); return; }
    Args a{};
    for (int i = 0; i < 38; ++i) a.in[i] = (const float*)d_in[i];
    a.out = (float*)d_out; a.ws = (unsigned char*)d_ws; a.ph_lo = 0; a.ph_hi = 1 << 20;
    hipLaunchKernelGGL(fwd_kernel, dim3(grid), dim3(NTHREADS), LDS_BYTES, stream, a);
    const hipError_t le = hipPeekAtLastError();
    if (le != hipSuccess) fprintf(stderr, "kernel_launch: launch failed: %s\n", hipGetErrorName(le));
}
```

```cpp
#include <hip/hip_runtime.h>
#include <cstdio>
#include <cstdint>

#define LAS __attribute__((address_space(3)))
typedef unsigned short bf16_t;
typedef short bf16x8 __attribute__((ext_vector_type(8)));
typedef float f32x4 __attribute__((ext_vector_type(4)));
typedef unsigned u32x4 __attribute__((ext_vector_type(4)));
typedef unsigned u32x2 __attribute__((ext_vector_type(2)));

constexpr int DM = 1024, NB = 16, TL = 2048, TC = 256;
constexpr int NCTX = NB * TC, NLAT = NB * TL, NTOK = NCTX + NLAT;
constexpr int RWC = 1920, EVC = 3456, ZLD = 3584;
constexpr int NE = 32;
constexpr int XPROWS = NTOK * 4 + NE * 256;
constexpr int NTHREADS = 512, NWAVES = 8;

constexpr size_t MiB = 1u << 20;
constexpr size_t al256(size_t x) { return (x + 255) & ~(size_t)255; }
constexpr size_t WS_CTL = 0, CTL_ZERO_BYTES = 1 * MiB - 4096;
constexpr size_t WS_PTRS = 1 * MiB - 4096;
constexpr size_t WS_MOD = 1 * MiB;
constexpr size_t WS_RTWT = al256(WS_MOD + (size_t)4 * 17 * 6144 * 4);
constexpr size_t WS_WIN = al256(WS_RTWT + (size_t)4 * 32 * 1024 * 4);
constexpr size_t WS_WOUT = al256(WS_WIN + (size_t)2 * ZLD * DM * 2);
constexpr size_t WS_SGIN = al256(WS_WOUT + (size_t)2 * DM * DM * 2);
constexpr size_t WS_SGOUT = al256(WS_SGIN + (size_t)2 * 2048 * DM * 2);
constexpr int LORA_N = 2560, LORA_K = 384;
constexpr size_t WS_WLORA = al256(WS_SGOUT + (size_t)2 * DM * DM * 2);
constexpr size_t WS_LBIAS = al256(WS_WLORA + (size_t)2 * LORA_N * LORA_K * 2);
constexpr size_t WS_W1 = al256(WS_LBIAS + (size_t)2 * LORA_N * 4);
constexpr size_t WS_W2 = al256(WS_W1 + (size_t)4 * NE * 2048 * DM * 2);
constexpr size_t WS_H = al256(WS_W2 + (size_t)4 * NE * DM * DM * 2);
constexpr size_t WS_ABF = al256(WS_H + (size_t)NTOK * DM * 4);
constexpr size_t WS_TOKE = al256(WS_ABF + (size_t)NTOK * DM * 2);
constexpr size_t WS_TOKG = al256(WS_TOKE + (size_t)NTOK * 4 * 4);
constexpr size_t WS_ROWOF = al256(WS_TOKG + (size_t)NTOK * 4 * 4);
constexpr size_t WS_TOKR = al256(WS_ROWOF + (size_t)NTOK * 4 * 4);
constexpr size_t WS_BCNT = al256(WS_TOKR + (size_t)NTOK * 4 * 4);
constexpr size_t WS_SRCROW = al256(WS_BCNT + (size_t)4 * 256 * 32 * 4);
constexpr size_t WS_R = al256(WS_SRCROW + (size_t)XPROWS * 4);
constexpr size_t FSZ = (size_t)NTOK * 512 * 4;
constexpr size_t WS_Z = WS_R;
constexpr size_t HSZ = (size_t)NTOK * 512 * 2;
constexpr size_t WS_RB = al256(WS_Z + (size_t)NTOK * ZLD * 2);
constexpr size_t WS_KS = WS_RB + HSZ, WS_VS = WS_KS + HSZ, WS_KKN = WS_VS + HSZ;
constexpr size_t WS_LIN = WS_KKN + HSZ;
constexpr size_t WS_LO = al256(WS_LIN + (size_t)NTOK * 384 * 2);
constexpr size_t WS_AB = WS_LO + 2 * HSZ;
constexpr size_t WS_GB = WS_LO + 4 * HSZ;
constexpr size_t WS_YS = WS_LO + 5 * HSZ;
constexpr size_t WS_QB = WS_YS + 2 * FSZ;
constexpr size_t WS_KB = WS_QB + FSZ / 2;
constexpr size_t WS_VB = WS_KB + FSZ / 2;
constexpr size_t WS_OP = WS_VB + FSZ / 2;
constexpr size_t WS_CAT = WS_OP + 2 * FSZ;
constexpr int WKV_REC = 12288, WKV_NCH = (TC + TL) / 16;
constexpr size_t WS_WKV = al256(WS_CAT + (size_t)NTOK * DM * 2);
constexpr size_t WS_EVEN_END = WS_WKV + (size_t)256 * WKV_NCH * WKV_REC;
constexpr size_t WS_Z2 = WS_R;
constexpr size_t WS_VST = al256(WS_Z2 + (size_t)NTOK * 2048 * 2);
constexpr size_t WS_G = al256(WS_VST + (size_t)NTOK * 2 * 4);
constexpr size_t WS_ODD_END = WS_G + (size_t)NTOK * DM * 2;
constexpr size_t WS_XP = WS_R;
constexpr size_t WS_ACT = al256(WS_XP + (size_t)XPROWS * DM * 2);
constexpr size_t WS_YM = al256(WS_ACT + (size_t)XPROWS * DM * 2);
constexpr size_t WS_MOE_END = WS_YM + (size_t)XPROWS * DM * 2;
constexpr size_t WS_END = (WS_EVEN_END > WS_MOE_END ? (WS_EVEN_END > WS_ODD_END ? WS_EVEN_END : WS_ODD_END) : (WS_MOE_END > WS_ODD_END ? WS_MOE_END : WS_ODD_END));

constexpr int CW_BAR = 4096;
constexpr int CW_CNT = 16384;
constexpr int CW_CUR = 16384 + 256;

constexpr int LDS_BYTES = 163840;
constexpr int LDS_MISC = 160 * 1024 - 256;

__device__ __forceinline__ unsigned f2bf(float f) { unsigned u = __builtin_bit_cast(unsigned, f); return (u + 0x7fffu + ((u >> 16) & 1u)) >> 16; }
__device__ __forceinline__ unsigned pk2(float lo, float hi) { return f2bf(lo) | (f2bf(hi) << 16); }
typedef float f32x2_t __attribute__((ext_vector_type(2))); typedef __bf16 bf16x2_t __attribute__((ext_vector_type(2)));
__device__ __forceinline__ unsigned cvtpk_s(float lo, float hi) { f32x2_t v = {lo, hi}; bf16x2_t b = __builtin_convertvector(v, bf16x2_t); return __builtin_bit_cast(unsigned, b); }
__device__ __forceinline__ float bf2f(bf16_t b) { return __builtin_bit_cast(float, (unsigned)b << 16); }
__device__ __forceinline__ float wave_sum(float v) {
#pragma unroll
    for (int o = 1; o < 64; o <<= 1) v += __shfl_xor(v, o);
    return v;
}
__device__ __forceinline__ int tid_opaque() { int t = threadIdx.x; asm volatile("" : "+v"(t)); return t; }
#define GAS __attribute__((address_space(1)))
template <class T> __device__ __forceinline__ T* as_global(T* p) { return (T*)(GAS T*)p; }
__device__ __forceinline__ unsigned char* opq(unsigned char* p) { GAS unsigned char* g = (GAS unsigned char*)p; asm volatile("" : "+s"(g)); return (unsigned char*)g; }
__device__ __forceinline__ float rdl(float v, int k) { return __builtin_bit_cast(float, __builtin_amdgcn_readlane(__builtin_bit_cast(int, v), k)); }
__device__ __forceinline__ float sigmoidf_(float x) { return 1.0f / (1.0f + __expf(-x)); }

#define XB_TMO      128
#define XB_XCNT(j)  (256  + 64 * (j))
#define XB_XSUB(j)  (1280 + 64 * (j))
#define XB_XGEN(j)  (2304 + 64 * (j))
#define XB_TOP      3328
#define XB_TOPGEN   3392
#define XCD_BAR_WORDS 3456
#define XB_SPIN_CAP (1u << 22)
__device__ __forceinline__ unsigned xb_ld(unsigned* p)              { return __hip_atomic_load(p, __ATOMIC_RELAXED, __HIP_MEMORY_SCOPE_AGENT); }
__device__ __forceinline__ unsigned xb_add(unsigned* p, unsigned v) { return __hip_atomic_fetch_add(p, v, __ATOMIC_RELAXED, __HIP_MEMORY_SCOPE_AGENT); }
__device__ __forceinline__ unsigned xb_xcc_id() { return (unsigned)__builtin_amdgcn_s_getreg((3 << 11) | 20) & 0xFu; }
#define XB_SPIN(cond, bar) do { unsigned _sp = 0; while (cond) { __builtin_amdgcn_s_sleep(1); \
    if ((++_sp & 255u) == 0u) { if (xb_ld(&(bar)[XB_TMO])) break; if (_sp > XB_SPIN_CAP) { atomicAdd(&(bar)[XB_TMO], 1u); break; } } } } while (0)
struct XcdBarrier { unsigned* bar; unsigned x; volatile LAS unsigned* st; };
__device__ __forceinline__ XcdBarrier xcd_barrier_post(unsigned* bar, volatile LAS unsigned* st) {
    XcdBarrier b; b.bar = bar; b.x = xb_xcc_id(); b.st = st;
    if (threadIdx.x == 0) (void)xb_add(&bar[XB_XCNT(b.x)], 1u);
    return b;
}
__device__ __forceinline__ void xcd_barrier_complete(unsigned* bar, unsigned x, unsigned& nloc, unsigned& nx) {
    const unsigned G = gridDim.x * gridDim.y * gridDim.z;
    unsigned sum, cnt, mine, sp = 0u;
    for (;;) {
        sum = 0u; cnt = 0u; mine = 0u;
#pragma unroll
        for (unsigned j = 0; j < 16; ++j) { const unsigned c = xb_ld(&bar[XB_XCNT(j)]); sum += c; cnt += (c > 0u) ? 1u : 0u; mine = (j == x) ? c : mine; }
        if (sum == G) break;
        __builtin_amdgcn_s_sleep(1);
        if ((++sp & 255u) == 0u) { if (xb_ld(&bar[XB_TMO])) break; if (sp > XB_SPIN_CAP) { atomicAdd(&bar[XB_TMO], 1u); break; } }
    }
    nloc = mine > 0u ? mine : 1u; nx = cnt > 0u ? cnt : 1u;
}
__device__ __forceinline__ void xcd_barrier(const XcdBarrier& b) {
    asm volatile("s_waitcnt vmcnt(0)" ::: "memory");
    __syncthreads();
    if (threadIdx.x == 0) {
        unsigned* bar = b.bar; asm volatile("" : "+s"(bar));
        __builtin_amdgcn_s_waitcnt(0);
        unsigned nloc = b.st[0], nx = b.st[1];
        if (nloc == 0u) { xcd_barrier_complete(bar, b.x, nloc, nx); b.st[0] = nloc; b.st[1] = nx; }
        const unsigned old = xb_add(&bar[XB_XSUB(b.x)], 1u);
        const unsigned gen = old / nloc;
        if (old + 1u == (gen + 1u) * nloc) {
            __builtin_amdgcn_fence(__ATOMIC_RELEASE, "agent");
            asm volatile("s_waitcnt vmcnt(0)" ::: "memory");
            const unsigned og = xb_add(&bar[XB_TOP], 1u);
            const unsigned tg = og / nx;
            if (og + 1u == (tg + 1u) * nx) xb_add(&bar[XB_TOPGEN], 1u);
            else XB_SPIN(xb_ld(&bar[XB_TOPGEN]) == tg, bar);
            __builtin_amdgcn_fence(__ATOMIC_ACQUIRE, "agent");
            xb_add(&bar[XB_XGEN(b.x)], 1u);
            asm volatile("s_waitcnt vmcnt(0)" ::: "memory");
        } else {
            XB_SPIN(xb_ld(&bar[XB_XGEN(b.x)]) == gen, bar);
            __builtin_amdgcn_fence(__ATOMIC_ACQUIRE, "agent");
            asm volatile("s_waitcnt vmcnt(0)" ::: "memory");
        }
    }
    __syncthreads();
}

namespace pg8 {
#define PG8_LAS __attribute__((address_space(3)))
typedef unsigned short bf16_t;
typedef short bf16x8 __attribute__((ext_vector_type(8)));
typedef float f32x4 __attribute__((ext_vector_type(4)));
typedef unsigned u32x4 __attribute__((ext_vector_type(4)));
constexpr int BM = 256, BK = 64, HALF = 128, HTB = HALF * BK * 2  , STAGE_BYTES = 8 * HTB, NXCD = 8, WGM = 8;

__host__ __device__ __forceinline__ int lds_byte(int r, int c) { const int st = (r >> 4) * 2 + (c >> 5), rr = r & 15, cc = c & 31, ob = rr * 64 + cc * 2; return st * 1024 + (ob ^ (((ob >> 9) & 1) << 5)); }
__host__ __device__ __forceinline__ void stage_rc(int b, int& R, int& C) { const int st = b / 1024, sb = b % 1024, swz = sb ^ (((sb >> 9) & 1) << 5); R = (st >> 1) * 16 + swz / 64; C = (st & 1) * 32 + (swz % 64) / 2; }
__host__ __device__ __forceinline__ int perm32(int rho) { const int n = rho >> 4, i = rho & 15; return 8 * (i >> 2) + 4 * n + (i & 3); }

struct Unit { int pm, pn; };
struct Gemm { const bf16_t* A; const bf16_t* Bt; int M, N, K; int sb_w = 0x77777777, sb_a = 0x7f7f7f7f; };

struct StaticOrder {
    int nM, nN, nwg, G, c;
    __host__ __device__ void init(int M, int N, int G_, int c_) { nM = M / BM; nN = N / BM; nwg = nM * nN; G = G_; c = c_; }
    __host__ __device__ bool next(int i, Unit& u) const {
        const long L = (long)i * G + c; if (L >= nwg) return false;
        int wgid = (int)L; { const int q = nwg / NXCD, r = nwg % NXCD, xcd = wgid % NXCD, off = wgid / NXCD; wgid = (xcd < r ? xcd * (q + 1) : r * (q + 1) + (xcd - r) * q) + off; }
        const int nig = WGM * nN, gid = wgid / nig, fm = gid * WGM, gsz = (nM - fm) < WGM ? (nM - fm) : WGM;
        u.pm = fm + ((wgid % nig) % gsz); u.pn = (wgid % nig) / gsz; return true;
    }
    __device__ __forceinline__ void a_ready(const Unit&) const {}
    __device__ __forceinline__ void done(const Unit&) const {}
};

__device__ __forceinline__ unsigned cvt_pk_bf16(float lo, float hi) { unsigned r; asm volatile("v_cvt_pk_bf16_f32 %0, %1, %2" : "=v"(r) : "v"(lo), "v"(hi)); return r; }
typedef float f32x2 __attribute__((ext_vector_type(2)));
__device__ __forceinline__ f32x2 gelu_pk(f32x2 v) {
    const f32x2 av = __builtin_elementwise_abs(v), d = av * 0.2316418882f + 1.0f;
    f32x2 t; t.x = __builtin_amdgcn_rcpf(d.x); t.y = __builtin_amdgcn_rcpf(d.y);
    f32x2 q = t * 0.5307027145f + (-0.7265760135f); q = q * t + 0.7107068705f; q = q * t + (-0.142248368f); q = q * t + 0.127414796f; q = q * t;
    const f32x2 s = (v * v) * (-0.72134752044f);
    f32x2 e; e.x = __builtin_amdgcn_exp2f(s.x); e.y = __builtin_amdgcn_exp2f(s.y);
    const f32x2 m = v * (q * e), r = v - m;
    f32x2 o; o.x = v.x < 0.f ? m.x : r.x; o.y = v.y < 0.f ? m.y : r.y; return o;
}

typedef int v8i32 __attribute__((ext_vector_type(8)));
typedef int v4i32 __attribute__((ext_vector_type(4)));
__device__ __forceinline__ v8i32 cat8(v4i32 a, v4i32 b) { return __builtin_shufflevector(a, b, 0, 1, 2, 3, 4, 5, 6, 7); }
template <class Epi, class Sched, bool ALIGN_EPI = false, bool SP2 = false, bool GATHER = false, bool FP8 = false>
__device__ __forceinline__ void gemm_phase(PG8_LAS unsigned char* lds, const Gemm g, const Sched& S, const Epi& E) {
    const int tid = tid_opaque(), wid = __builtin_amdgcn_readfirstlane(tid >> 6), lane = tid & 63, wr = wid >> 2, wc = wid & 3, fr = lane & 15, fq = lane >> 4;
    static_assert(!GATHER || SP2, "GATHER is wired into the SP2 loop only");
    const int K = g.K, nt = K / BK;
    unsigned voffA[2], voffB[2];
#pragma unroll
    for (int i = 0; i < 2; ++i) { int R, C; stage_rc(tid * 16 + i * 8192, R, C); const int Rb = Epi::PERM ? ((R & ~31) + perm32(R & 31)) : R;
        voffA[i] = (unsigned)(R * K + C) * 2u; voffB[i] = (unsigned)(Rb * K + C) * 2u; }
    unsigned gAc[2][2] = {{0u, 0u}, {0u, 0u}}, gAn[2][2] = {{0u, 0u}, {0u, 0u}};
    int gR[2] = {0, 0}; unsigned gC[2] = {0u, 0u};
    if constexpr (GATHER) {
#pragma unroll
        for (int i = 0; i < 2; ++i) { int R, C; stage_rc(tid * 16 + i * 8192, R, C); gR[i] = R; gC[i] = (unsigned)C * 2u; }
    }
#define PG8_GROWS(dst, ui_) do { _Pragma("unroll") for (int _h = 0; _h < 2; ++_h) _Pragma("unroll") for (int _i = 0; _i < 2; ++_i) dst[_h][_i] = S.rowtab[(ui_) * 256 + _h * 128 + gR[_i]] + gC[_i]; } while (0)
    const size_t kstep = (size_t)(BK * 2);
    const size_t hstep = (size_t)HALF * K * 2;
    const size_t tstep = 2 * hstep;
    const unsigned ldsw = (unsigned)wid * 1024u;
    const int aoff = lds_byte(wr * 64 + fr, fq * 8), boff = lds_byte(wc * 32 + fr, fq * 8);
#define PG8_SA(b, h) (((b) * 2 + (h)) * HTB)
#define PG8_SB(b, h) ((4 + (b) * 2 + (h)) * HTB)
#define PG8_STAGE(bufoff, gbase, voff) do { _Pragma("unroll") for (int _i = 0; _i < 2; ++_i) \
        __builtin_amdgcn_global_load_lds((const unsigned*)((const char*)(gbase) + (voff)[_i]), (PG8_LAS unsigned*)(lds + (bufoff) + ldsw + _i * 8192), 16, 0, 0); } while (0)
#define PG8_STAGE_A(bufoff, kptr, h, vsel) do { if constexpr (GATHER) { PG8_STAGE(bufoff, kptr, vsel[h]); } else { PG8_STAGE(bufoff, (kptr) + (h) * hstep, voffA); } } while (0)
#define PG8_LDA(dst, b, h) do { if constexpr (FP8) { _Pragma("unroll") for (int m = 0; m < 4; ++m) dst##8[m] = cat8(*(const PG8_LAS v4i32*)(lds + PG8_SA(b, h) + aoff + m * 2048), *(const PG8_LAS v4i32*)(lds + PG8_SA(b, h) + aoff + m * 2048 + 1024)); } \
        else { _Pragma("unroll") for (int m = 0; m < 4; ++m) _Pragma("unroll") for (int k = 0; k < 2; ++k) dst[m][k] = *(const PG8_LAS bf16x8*)(lds + PG8_SA(b, h) + aoff + m * 2048 + k * 1024); } } while (0)
#define PG8_LDB(dst, b, h) do { if constexpr (FP8) { _Pragma("unroll") for (int n = 0; n < 2; ++n) dst##8[n] = cat8(*(const PG8_LAS v4i32*)(lds + PG8_SB(b, h) + boff + n * 2048), *(const PG8_LAS v4i32*)(lds + PG8_SB(b, h) + boff + n * 2048 + 1024)); } \
        else { _Pragma("unroll") for (int n = 0; n < 2; ++n) _Pragma("unroll") for (int k = 0; k < 2; ++k) dst[n][k] = *(const PG8_LAS bf16x8*)(lds + PG8_SB(b, h) + boff + n * 2048 + k * 1024); } } while (0)
#define PG8_MMA(ai, bj, At, Bt) do { __builtin_amdgcn_s_setprio(1); if constexpr (FP8) { _Pragma("unroll") for (int m = 0; m < 4; ++m) _Pragma("unroll") for (int n = 0; n < 2; ++n) \
        asm volatile("s_nop 1\n\tv_mfma_scale_f32_16x16x128_f8f6f4 %0, %1, %2, %0, %3, %4 op_sel_hi:[0,0,0]" : "+v"(acc[ai][bj][m][n]) : "v"(Bt##8[n]), "v"(At##8[m]), "v"(fp8_sa), "v"(fp8_sb)); } else { \
        _Pragma("unroll") for (int m = 0; m < 4; ++m) _Pragma("unroll") for (int n = 0; n < 2; ++n) _Pragma("unroll") for (int k = 0; k < 2; ++k) \
        acc[ai][bj][m][n] = __builtin_amdgcn_mfma_f32_16x16x32_bf16(Bt[n][k], At[m][k], acc[ai][bj][m][n], 0, 0, 0); } __builtin_amdgcn_s_setprio(0); } while (0)
#define PG8_WAIT_V(n) asm volatile("s_waitcnt vmcnt(" #n ")" ::: "memory")
#define PG8_WAIT_L(n) asm volatile("s_waitcnt lgkmcnt(" #n ")" ::: "memory")
#define PG8_BAR __builtin_amdgcn_s_barrier()
#define PG8_SCHED __builtin_amdgcn_sched_barrier(0)
    Unit cur, nxt; int ui = 0;
    if (!S.next(0, cur)) return;
    f32x4 acc[2][2][4][2];
#pragma unroll
    for (int a = 0; a < 2; ++a)
#pragma unroll
        for (int b = 0; b < 2; ++b)
#pragma unroll
            for (int m = 0; m < 4; ++m)
#pragma unroll
                for (int n = 0; n < 2; ++n) acc[a][b][m][n] = (f32x4){0.f, 0.f, 0.f, 0.f};
    const int fp8_sa = g.sb_w, fp8_sb = g.sb_a;
    bf16x8 At[4][2], B0[2][2], B1[2][2]; v8i32 At8[4], B08[2], B18[2];
    const char* cA = GATHER ? (const char*)g.A : (const char*)g.A + (size_t)cur.pm * tstep; const char* cB = (const char*)g.Bt + (size_t)cur.pn * tstep;
    if constexpr (GATHER) { PG8_GROWS(gAc, 0); }
    S.a_ready(cur);
    if constexpr (SP2) {
        PG8_STAGE(PG8_SB(0, 0), cB, voffB); PG8_STAGE(PG8_SB(0, 1), cB + hstep, voffB); PG8_STAGE_A(PG8_SA(0, 0), cA, 0, gAc); PG8_STAGE_A(PG8_SA(0, 1), cA, 1, gAc);
        if (wr == 1) PG8_BAR;
        PG8_WAIT_V(2); PG8_BAR;
        PG8_STAGE(PG8_SB(1, 0), cB + kstep, voffB); PG8_STAGE_A(PG8_SA(1, 0), cA + kstep, 0, gAc); PG8_STAGE(PG8_SB(1, 1), cB + hstep + kstep, voffB);
        PG8_WAIT_V(6); PG8_BAR;
    } else {
        PG8_STAGE(PG8_SB(0, 0), cB, voffB); PG8_STAGE(PG8_SA(0, 0), cA, voffA); PG8_STAGE(PG8_SB(0, 1), cB + hstep, voffB); PG8_STAGE(PG8_SA(0, 1), cA + hstep, voffA);
        if (wr == 1) PG8_BAR;
        PG8_WAIT_V(4); PG8_BAR;
        PG8_STAGE(PG8_SB(1, 0), cB + kstep, voffB); PG8_STAGE(PG8_SA(1, 0), cA + kstep, voffA); PG8_STAGE(PG8_SB(1, 1), cB + hstep + kstep, voffB);
        PG8_WAIT_V(6); PG8_BAR;
    }
    for (;;) {
        const bool has_next = S.next(ui + 1, nxt);
        if constexpr (GATHER) { if (has_next) { PG8_GROWS(gAn, ui + 1); } else { _Pragma("unroll") for (int _h = 0; _h < 2; ++_h) _Pragma("unroll") for (int _i = 0; _i < 2; ++_i) gAn[_h][_i] = gAc[_h][_i]; } }
        const char* nA = GATHER ? (const char*)g.A : (has_next ? (const char*)g.A + (size_t)nxt.pm * tstep : cA); const char* nB = has_next ? (const char*)g.Bt + (size_t)nxt.pn * tstep : cB;
        for (int t = 0; t < nt; t += 2) {
            const bool last = (t == nt - 2);
            const char* a1 = cA + (size_t)(t + 1) * kstep;
            const char* a2 = last ? nA : cA + (size_t)(t + 2) * kstep; const char* b2 = last ? nB : cB + (size_t)(t + 2) * kstep;
            const char* a3 = a2 + kstep; const char* b3 = b2 + kstep;
            if (last && has_next) S.a_ready(nxt);
            unsigned gA2[2][2];
            if constexpr (GATHER) { _Pragma("unroll") for (int _h = 0; _h < 2; ++_h) _Pragma("unroll") for (int _i = 0; _i < 2; ++_i) gA2[_h][_i] = last ? gAn[_h][_i] : gAc[_h][_i]; }
            if constexpr (SP2) {
            PG8_LDB(B0, 0, 0); PG8_LDB(B1, 0, 1); PG8_SCHED; PG8_LDA(At, 0, 0); PG8_STAGE_A(PG8_SA(1, 1), a1, 1, gAc);
            PG8_WAIT_V(8); PG8_WAIT_L(0); PG8_BAR; PG8_MMA(0, 0, At, B0); PG8_MMA(0, 1, At, B1); PG8_BAR; PG8_SCHED;
            PG8_LDA(At, 0, 1); PG8_STAGE(PG8_SB(0, 0), b2, voffB); PG8_STAGE(PG8_SB(0, 1), b2 + hstep, voffB); PG8_STAGE_A(PG8_SA(0, 0), a2, 0, gA2);
            PG8_WAIT_V(8); PG8_WAIT_L(0); PG8_BAR; PG8_MMA(1, 0, At, B0); PG8_MMA(1, 1, At, B1); PG8_BAR; PG8_SCHED;
            PG8_LDB(B0, 1, 0); PG8_LDB(B1, 1, 1); PG8_SCHED; PG8_LDA(At, 1, 0); PG8_STAGE_A(PG8_SA(0, 1), a2, 1, gA2);
            PG8_WAIT_V(8); PG8_WAIT_L(0); PG8_BAR; PG8_MMA(0, 0, At, B0); PG8_MMA(0, 1, At, B1); PG8_BAR; PG8_SCHED;
            PG8_LDA(At, 1, 1); PG8_STAGE(PG8_SB(1, 0), b3, voffB); PG8_STAGE(PG8_SB(1, 1), b3 + hstep, voffB); PG8_STAGE_A(PG8_SA(1, 0), a3, 0, gA2);
            PG8_WAIT_V(8); PG8_WAIT_L(0); PG8_BAR; PG8_MMA(1, 0, At, B0); PG8_MMA(1, 1, At, B1); PG8_BAR; PG8_SCHED;
            } else {
            PG8_LDB(B0, 0, 0); PG8_SCHED; PG8_LDA(At, 0, 0); PG8_STAGE(PG8_SA(1, 1), a1 + hstep, voffA);
            PG8_WAIT_L(8); PG8_BAR; PG8_WAIT_L(0); PG8_MMA(0, 0, At, B0); PG8_BAR; PG8_SCHED;
            PG8_LDB(B1, 0, 1); PG8_STAGE(PG8_SB(0, 0), b2, voffB);
            PG8_BAR; PG8_WAIT_L(0); PG8_MMA(0, 1, At, B1); PG8_BAR;
            PG8_LDA(At, 0, 1); PG8_STAGE(PG8_SA(0, 0), a2, voffA);
            PG8_BAR; PG8_WAIT_L(0); PG8_MMA(1, 0, At, B0); PG8_BAR; PG8_SCHED;
            PG8_STAGE(PG8_SB(0, 1), b2 + hstep, voffB);
            PG8_WAIT_V(6); PG8_BAR; PG8_MMA(1, 1, At, B1); PG8_BAR;
            PG8_LDB(B0, 1, 0); PG8_SCHED; PG8_LDA(At, 1, 0); PG8_STAGE(PG8_SA(0, 1), a2 + hstep, voffA);
            PG8_WAIT_L(8); PG8_BAR; PG8_WAIT_L(0); PG8_MMA(0, 0, At, B0); PG8_BAR; PG8_SCHED;
            PG8_LDB(B1, 1, 1); PG8_STAGE(PG8_SB(1, 0), b3, voffB);
            PG8_BAR; PG8_WAIT_L(0); PG8_MMA(0, 1, At, B1); PG8_BAR;
            PG8_LDA(At, 1, 1); PG8_STAGE(PG8_SA(1, 0), a3, voffA);
            PG8_BAR; PG8_WAIT_L(0); PG8_MMA(1, 0, At, B0); PG8_BAR; PG8_SCHED;
            PG8_STAGE(PG8_SB(1, 1), b3 + hstep, voffB);
            PG8_WAIT_V(6); PG8_BAR; PG8_MMA(1, 1, At, B1); PG8_BAR;
            }
        }
        if constexpr (ALIGN_EPI) { if (wr == 0) PG8_BAR; }
        if constexpr (FP8) { asm volatile("s_nop 15\n\ts_nop 15" ::: "memory"); __builtin_amdgcn_sched_barrier(0); }
        if constexpr (!Epi::AFTER_DRAIN) { E(acc, cur, wr, wc, fr, fq); S.done(cur); }
        if (!has_next) break;
#pragma unroll
        for (int a = 0; a < 2; ++a)
#pragma unroll
            for (int b = 0; b < 2; ++b)
#pragma unroll
                for (int m = 0; m < 4; ++m)
#pragma unroll
                    for (int n = 0; n < 2; ++n) acc[a][b][m][n] = (f32x4){0.f, 0.f, 0.f, 0.f};
        cur = nxt; cA = nA; cB = nB; ++ui;
        if constexpr (GATHER) { _Pragma("unroll") for (int _h = 0; _h < 2; ++_h) _Pragma("unroll") for (int _i = 0; _i < 2; ++_i) gAc[_h][_i] = gAn[_h][_i]; }
        if constexpr (ALIGN_EPI) { if (wr == 1) PG8_BAR; }
    }
    PG8_WAIT_V(0);
    if constexpr (!ALIGN_EPI) { if (wr == 0) PG8_BAR; }
    PG8_BAR;
    if constexpr (Epi::AFTER_DRAIN) { E.fused(acc, cur, wr, wc, fr, fq, lds, wid, lane); S.done(cur); }
#undef PG8_SA
#undef PG8_SB
#undef PG8_STAGE
#undef PG8_STAGE_A
#undef PG8_GROWS
#undef PG8_LDA
#undef PG8_LDB
#undef PG8_MMA
#undef PG8_WAIT_V
#undef PG8_WAIT_L
#undef PG8_BAR
#undef PG8_SCHED
}
}

struct Args { const float* in[38]; float* out; unsigned char* ws; int ph_lo, ph_hi; };
#define INP(k) as_global(IN[k])
#define AIN(k) as_global(A.in[k])
enum { I_X = 0, I_C, I_CTX, I_CCTX, I_N1G, I_N2G, I_ADAW, I_ADAB, I_EVWIN, I_EVWOUT, I_RWMU, I_RWW0, I_RWW2, I_RWA0, I_RWA2, I_RWG2, I_RWKK, I_RWKA, I_RWRK,
       I_GNW, I_GNB, I_QN, I_KN, I_LAM, I_SUBLN, I_SGWIN, I_SGBIN, I_SGLNG, I_SGLNB, I_SGWS, I_SGBS, I_SGWOUT, I_RTW, I_RTB, I_W1, I_B1, I_W2, I_B2 };

struct Tok { int b, t, T, modrow; };
__device__ __forceinline__ Tok tokinfo(int g) {
    Tok k;
    if (g < NCTX) { k.b = g >> 8; k.t = g & 255; k.T = TC; k.modrow = 16; }
    else { const int q = g - NCTX; k.b = q >> 11; k.t = q & 2047; k.T = TL; k.modrow = k.b; }
    return k;
}

template <int MAP>
__device__ __forceinline__ void p0_transpose_item(const float* W, int K, int N, bf16_t* WT, LAS float* scr, int item, int lane) {
    const int nblk = N / 32, kb = item / nblk, nb = item % nblk, k0 = 64 * kb, n0 = 32 * nb;
    const int d0 = MAP ? (256 * ((n0 & 1023) >> 7) + 128 * (n0 >> 10) + (n0 & 127)) : n0;
#pragma unroll 8
    for (int i = 0; i < 32; ++i) { const int kk = 2 * i + (lane >> 5); scr[kk * 33 + (lane & 31)] = W[(size_t)(k0 + kk) * N + n0 + (lane & 31)]; }
    asm volatile("s_waitcnt lgkmcnt(0)" ::: "memory");
    const int c = lane & 7;
#pragma unroll
    for (int j = 0; j < 4; ++j) { const int n = (lane >> 3) + 8 * j; const LAS float* s = scr + (8 * c) * 33 + n;
        u32x4 o; o.x = pk2(s[0 * 33], s[1 * 33]); o.y = pk2(s[2 * 33], s[3 * 33]); o.z = pk2(s[4 * 33], s[5 * 33]); o.w = pk2(s[6 * 33], s[7 * 33]);
        *(u32x4*)(WT + (size_t)(d0 + n) * K + k0 + 8 * c) = o; }
    asm volatile("s_waitcnt lgkmcnt(0)" ::: "memory");
}

template <int MAP>
__device__ __forceinline__ void p0_transpose_item_fp8(const float* W, int K, int N, unsigned char* WT, LAS float* scr, int item, int lane) {
    const int nblk = N / 32, kb = item / nblk, nb = item % nblk, k0 = 64 * kb, n0 = 32 * nb;
    const int d0 = MAP ? (256 * ((n0 & 1023) >> 7) + 128 * (n0 >> 10) + (n0 & 127)) : n0;
#pragma unroll 8
    for (int i = 0; i < 32; ++i) { const int kk = 2 * i + (lane >> 5); scr[kk * 33 + (lane & 31)] = W[(size_t)(k0 + kk) * N + n0 + (lane & 31)]; }
    asm volatile("s_waitcnt lgkmcnt(0)" ::: "memory");
    const int c = lane & 3;
#pragma unroll
    for (int j = 0; j < 2; ++j) { const int n = (lane >> 2) + 16 * j; const LAS float* sp = scr + (16 * c) * 33 + n;
        u32x4 o;
#pragma unroll
        for (int d = 0; d < 4; ++d) { int w = __builtin_amdgcn_cvt_pk_fp8_f32(sp[(4 * d) * 33] * 256.0f, sp[(4 * d + 1) * 33] * 256.0f, 0, false);
            w = __builtin_amdgcn_cvt_pk_fp8_f32(sp[(4 * d + 2) * 33] * 256.0f, sp[(4 * d + 3) * 33] * 256.0f, w, true); o[d] = (unsigned)w; }
        *(u32x4*)(WT + (size_t)(d0 + n) * K + k0 + 16 * c) = o; }
    asm volatile("s_waitcnt lgkmcnt(0)" ::: "memory");
}

__device__ __forceinline__ void ph_prologue(const Args& A, LAS unsigned char* lds, int bid, int nb) {
    const int tid = tid_opaque(), lane = tid & 63, wid = tid >> 6;
    unsigned char* ws = opq(A.ws);
    if (bid == 0 && tid < 39) ((const float**)(ws + WS_PTRS))[tid] = (tid < 38) ? A.in[tid] : (const float*)A.out;
    {
        LAS float* s = (LAS float*)lds;
        LAS float* red = (LAS float*)(lds + 17 * 1024 * 4);
        for (int i = tid; i < 17 * 1024; i += NTHREADS) {
            const int r = i >> 10, k = i & 1023;
            const float x = (r < 16) ? AIN(I_C)[r * 1024 + k] : AIN(I_CCTX)[k];
            s[i] = x / (1.0f + __expf(-x));
        }
        __syncthreads();
        float* mod = (float*)(ws + WS_MOD);
        for (int u = bid; u < 4 * 96; u += nb) {
            const int l = u / 96, cg = u % 96, col = cg * 64 + lane;
            float acc[17];
#pragma unroll
            for (int r = 0; r < 17; ++r) acc[r] = 0.f;
            const float* wp = AIN(I_ADAW) + (size_t)l * 1024 * 6144 + col;
            for (int k = wid * 128; k < wid * 128 + 128; ++k) {
                const float wv = wp[(size_t)k * 6144];
#pragma unroll
                for (int r = 0; r < 17; ++r) acc[r] += s[r * 1024 + k] * wv;
            }
#pragma unroll
            for (int r = 0; r < 17; ++r) red[(wid * 17 + r) * 64 + lane] = acc[r];
            __syncthreads();
            for (int i = tid; i < 17 * 64; i += NTHREADS) {
                const int r = i >> 6, ln = i & 63; float v = 0.f;
#pragma unroll
                for (int w = 0; w < 8; ++w) v += red[(w * 17 + r) * 64 + ln];
                const int cc = cg * 64 + ln;
                mod[((size_t)l * 17 + r) * 6144 + cc] = v + AIN(I_ADAB)[l * 6144 + cc];
            }
            __syncthreads();
        }
    }
    __syncthreads();
    {
        LAS float* scr = (LAS float*)(lds + wid * 16384);
        const int gw = bid * NWAVES + wid, NGW = nb * NWAVES;
        constexpr int IT_WIN = 16 * (EVC / 32), IT_SQ = 16 * 32, IT_SGIN = 16 * 64, IT_W1 = 16 * 64, IT_W2 = 16 * 32;
        constexpr int N0 = 2 * IT_WIN, N1 = N0 + 2 * IT_SQ, N2 = N1 + 2 * IT_SGIN, N3 = N2 + 2 * IT_SQ, N4 = N3 + 128 * IT_W1, N5 = N4 + 128 * IT_W2;
        for (int it = gw; it < N5; it += NGW) {
            if (it < N0) { const int m = it / IT_WIN, r = it % IT_WIN; p0_transpose_item<0>(AIN(I_EVWIN) + (size_t)m * DM * EVC, DM, EVC, (bf16_t*)(ws + WS_WIN) + (size_t)m * ZLD * DM, scr, r, lane); }
            else if (it < N1) { const int q = it - N0, m = q / IT_SQ, r = q % IT_SQ; p0_transpose_item<0>(AIN(I_EVWOUT) + (size_t)m * DM * DM, DM, DM, (bf16_t*)(ws + WS_WOUT) + (size_t)m * DM * DM, scr, r, lane); }
            else if (it < N2) { const int q = it - N1, m = q / IT_SGIN, r = q % IT_SGIN; p0_transpose_item<0>(AIN(I_SGWIN) + (size_t)m * DM * 2048, DM, 2048, (bf16_t*)(ws + WS_SGIN) + (size_t)m * 2048 * DM, scr, r, lane); }
            else if (it < N3) { const int q = it - N2, m = q / IT_SQ, r = q % IT_SQ; p0_transpose_item<0>(AIN(I_SGWOUT) + (size_t)m * DM * DM, DM, DM, (bf16_t*)(ws + WS_SGOUT) + (size_t)m * DM * DM, scr, r, lane); }
            else if (it < N4) { const int q = it - N3, m = q / IT_W1, r = q % IT_W1; p0_transpose_item_fp8<1>(AIN(I_W1) + (size_t)m * DM * 2048, DM, 2048, ws + WS_W1 + (size_t)m * 2048 * DM, scr, r, lane); }
            else { const int q = it - N4, m = q / IT_W2, r = q % IT_W2; p0_transpose_item_fp8<0>(AIN(I_W2) + (size_t)m * DM * DM, DM, DM, ws + WS_W2 + (size_t)m * DM * DM, scr, r, lane); }
        }
    }
    {
        const size_t gt = (size_t)bid * NTHREADS + tid, GT = (size_t)nb * NTHREADS;
        f32x4* H4 = (f32x4*)(ws + WS_H);
        const f32x4* c4 = (const f32x4*)AIN(I_CTX); const f32x4* x4 = (const f32x4*)AIN(I_X);
        constexpr size_t NC4 = (size_t)NCTX * DM / 4, NT4 = (size_t)NTOK * DM / 4;
        for (size_t i = gt; i < NT4; i += GT) H4[i] = (i < NC4) ? c4[i] : x4[i - NC4];
        for (size_t i = gt; i < (size_t)2 * 128 * DM / 8; i += GT) { const size_t m = i / (128 * DM / 8), r = i % (128 * DM / 8); ((u32x4*)((bf16_t*)(ws + WS_WIN) + (m * ZLD + EVC) * DM))[r] = (u32x4){0u, 0u, 0u, 0u}; }
        bf16_t* wl = (bf16_t*)(ws + WS_WLORA);
        for (size_t i = gt; i < (size_t)2 * LORA_N * (LORA_K / 8); i += GT) {
            const int n = (int)(i % LORA_N), kc = (int)((i / LORA_N) % (LORA_K / 8)), jj = (int)(i / ((size_t)LORA_N * (LORA_K / 8))), seg = n >> 9, c = n & 511, k0 = kc * 8;
            float v[8];
#pragma unroll
            for (int e = 0; e < 8; ++e) v[e] = 0.f;
            if (seg < 2) { if ((k0 >> 6) == seg) {
#pragma unroll
                for (int e = 0; e < 8; ++e) v[e] = AIN(I_RWW2)[(((size_t)jj * 2 + seg) * 64 + (k0 & 63) + e) * 512 + c]; } }
            else if (seg < 4) { if ((k0 >> 6) == seg) {
#pragma unroll
                for (int e = 0; e < 8; ++e) v[e] = AIN(I_RWA2)[(((size_t)jj * 2 + (seg - 2)) * 64 + (k0 & 63) + e) * 512 + c]; } }
            else if (k0 >= 256) {
#pragma unroll
                for (int e = 0; e < 8; ++e) v[e] = AIN(I_RWG2)[((size_t)jj * 128 + (k0 - 256) + e) * 512 + c]; }
            *(u32x4*)(wl + ((size_t)jj * LORA_N + n) * LORA_K + k0) = (u32x4){pk2(v[0], v[1]), pk2(v[2], v[3]), pk2(v[4], v[5]), pk2(v[6], v[7])};
        }
        for (size_t i = gt; i < (size_t)2 * LORA_N; i += GT) { const int jj = (int)(i / LORA_N), n = (int)(i % LORA_N), seg = n >> 9, c = n & 511;
            ((float*)(ws + WS_LBIAS))[i] = seg < 2 ? AIN(I_RWW0)[((size_t)jj * 2 + seg) * 512 + c] : (seg < 4 ? AIN(I_RWA0)[((size_t)jj * 2 + (seg - 2)) * 512 + c] : 0.f); }
        float* rt = (float*)(ws + WS_RTWT);
        for (size_t i = gt; i < (size_t)4 * 128 * 32; i += GT) {
            const int e = (int)i & 31, k0 = ((int)(i >> 5) & 127) * 8, l = (int)(i >> 12);
            unsigned hi[4], lo[4]; float w[8];
#pragma unroll
            for (int q = 0; q < 8; ++q) w[q] = AIN(I_RTW)[((size_t)l * 1024 + k0 + q) * 32 + e];
#pragma unroll
            for (int q = 0; q < 4; ++q) { hi[q] = pk2(w[2 * q], w[2 * q + 1]); lo[q] = pk2(w[2 * q] - __builtin_bit_cast(float, hi[q] << 16), w[2 * q + 1] - __builtin_bit_cast(float, hi[q] & 0xffff0000u)); }
            *(u32x4*)((bf16_t*)rt + ((size_t)l * 2 * 32 + e) * 1024 + k0) = (u32x4){hi[0], hi[1], hi[2], hi[3]};
            *(u32x4*)((bf16_t*)rt + ((size_t)(l * 2 + 1) * 32 + e) * 1024 + k0) = (u32x4){lo[0], lo[1], lo[2], lo[3]};
        }
    }
}

template <bool ROUTER>
__device__ __forceinline__ void ph_norm(const Args& A, int l, int row_lo, LAS unsigned char* lds, int bid, int nb) {
    unsigned char* ws = opq(A.ws); const float* const* IN = (const float* const*)(ws + WS_PTRS); (void)IN;
    const int tid = tid_opaque(), lane = tid & 63, wid = tid >> 6;
    const float* H = (const float*)(ws + WS_H);
    const float* mod = (const float*)(ws + WS_MOD);
    bf16_t* abf = (bf16_t*)(ws + WS_ABF);
    const float* gp = INP(ROUTER ? I_N2G : I_N1G) + l * 1024;
    const int c_shift = ROUTER ? 3 : 0, c_scale = ROUTER ? 4 : 1;
    LAS float* rtl = (LAS float*)lds;
    LAS int* hist = (LAS int*)(lds + 131072);
    float rtb = 0.f;
    if constexpr (ROUTER) {
        const f32x4* rt4 = (const f32x4*)((const float*)(ws + WS_RTWT) + (size_t)l * 32 * 1024);
        for (int i = tid; i < 32 * 1024 / 4; i += NTHREADS) ((LAS f32x4*)rtl)[i] = rt4[i];
        if (tid < 32) hist[tid] = 0;
        rtb = INP(I_RTB)[l * 32 + (lane >> 1)];
        __syncthreads();
    }
    for (int row = row_lo + bid * NWAVES + wid; row < NTOK; row += nb * NWAVES) {
        const Tok tk = tokinfo(row);
        const float* mrow = mod + ((size_t)l * 17 + tk.modrow) * 6144;
        f32x4 v[4]; float ss = 0.f;
#pragma unroll
        for (int j = 0; j < 4; ++j) { v[j] = *(const f32x4*)(H + (size_t)row * DM + j * 256 + lane * 4); ss += (v[j].x * v[j].x + v[j].y * v[j].y) + (v[j].z * v[j].z + v[j].w * v[j].w); }
        const float rstd = rsqrtf(wave_sum(ss) * (1.0f / DM) + 1e-6f);
#pragma unroll
        for (int j = 0; j < 4; ++j) {
            const int col = j * 256 + lane * 4;
            const f32x4 g = *(const f32x4*)(gp + col), sc = *(const f32x4*)(mrow + c_scale * 1024 + col), sh = *(const f32x4*)(mrow + c_shift * 1024 + col);
            v[j] = (v[j] * rstd * g) * (sc + 1.0f) + sh;
            u32x2 o; o.x = pk2(v[j].x, v[j].y); o.y = pk2(v[j].z, v[j].w);
            *(u32x2*)(abf + (size_t)row * DM + col) = o;
        }
        if constexpr (ROUTER) {
            float p[32];
#pragma unroll
            for (int e = 0; e < 32; ++e) {
                float acc = 0.f;
#pragma unroll
                for (int j = 0; j < 4; ++j) { const f32x4 w = *(const LAS f32x4*)(rtl + e * 1024 + j * 256 + lane * 4); acc += (v[j].x * w.x + v[j].y * w.y) + (v[j].z * w.z + v[j].w * w.w); }
                p[e] = acc;
            }
#define RS_STEP(N, OFF) _Pragma("unroll") for (int i = 0; i < (N); ++i) { const bool up = (lane & (OFF)) != 0; const float send = up ? p[i] : p[i + (N)], keep = up ? p[i + (N)] : p[i]; p[i] = keep + __shfl_xor(send, (OFF)); }
            RS_STEP(16, 32) RS_STEP(8, 16) RS_STEP(4, 8) RS_STEP(2, 4) RS_STEP(1, 2)
#undef RS_STEP
            const float mylg = p[0] + __shfl_xor(p[0], 1) + rtb;
            float tv[4] = {-3.0e38f, -3.0e38f, -3.0e38f, -3.0e38f}; int ti[4] = {0, 0, 0, 0};
#pragma unroll
            for (int e = 0; e < 32; ++e) {
                const float lgv = rdl(mylg, 2 * e);
                if (lgv > tv[3]) {
                    tv[3] = lgv; ti[3] = e;
                    if (tv[3] > tv[2]) { const float a = tv[2]; tv[2] = tv[3]; tv[3] = a; const int b = ti[2]; ti[2] = ti[3]; ti[3] = b; }
                    if (tv[2] > tv[1]) { const float a = tv[1]; tv[1] = tv[2]; tv[2] = a; const int b = ti[1]; ti[1] = ti[2]; ti[2] = b; }
                    if (tv[1] > tv[0]) { const float a = tv[0]; tv[0] = tv[1]; tv[1] = a; const int b = ti[0]; ti[0] = ti[1]; ti[1] = b; }
                }
            }
            const float e1 = __expf(tv[1] - tv[0]), e2 = __expf(tv[2] - tv[0]), e3 = __expf(tv[3] - tv[0]);
            const float inv = 1.0f / (1.0f + e1 + e2 + e3);
            if (lane == 0) {
                int* te = (int*)(ws + WS_TOKE) + (size_t)row * 4; float* tg = (float*)(ws + WS_TOKG) + (size_t)row * 4; int* tr = (int*)(ws + WS_TOKR) + (size_t)row * 4;
                te[0] = ti[0]; te[1] = ti[1]; te[2] = ti[2]; te[3] = ti[3];
                tg[0] = inv; tg[1] = e1 * inv; tg[2] = e2 * inv; tg[3] = e3 * inv;
#pragma unroll
                for (int k = 0; k < 4; ++k) tr[k] = __hip_atomic_fetch_add(hist + ti[k], 1, __ATOMIC_RELAXED, __HIP_MEMORY_SCOPE_WORKGROUP);
            }
        }
    }
    if constexpr (ROUTER) {
        __syncthreads();
        if (tid < 32) ((int*)(ws + WS_BCNT))[((size_t)l * 256 + bid) * 32 + tid] = hist[tid];
    }
}


constexpr int RT_LS = 2064;
__device__ __forceinline__ void ph_norm2_router(const Args& A, int l, int row_lo, LAS unsigned char* lds, int bid, int nb) {
    unsigned char* ws = opq(A.ws); const float* const* IN = (const float* const*)(ws + WS_PTRS);
    const int tid = tid_opaque(), lane = tid & 63, wid = tid >> 6, c16 = lane & 15, g4 = lane >> 4;
    const float* H = (const float*)(ws + WS_H); const float* mod = (const float*)(ws + WS_MOD); bf16_t* abf = (bf16_t*)(ws + WS_ABF);
    const float* gp = INP(I_N2G) + l * 1024;
    LAS unsigned char* rth = lds; LAS unsigned char* rtl = lds + 32 * RT_LS;
    LAS int* hist = (LAS int*)(lds + 64 * RT_LS);
    LAS float* lgs = (LAS float*)(lds + 64 * RT_LS + 256) + wid * 544;
    {
        const u32x4* src = (const u32x4*)((const bf16_t*)(ws + WS_RTWT) + (size_t)l * 2 * 32 * 1024);
        for (int i = tid; i < 64 * 128; i += NTHREADS) { const int row = i >> 7, ch = i & 127; *(LAS u32x4*)(lds + row * RT_LS + ch * 16) = src[i]; }
        if (tid < 32) hist[tid] = 0;
        __syncthreads();
    }
    const float rtb0 = INP(I_RTB)[l * 32 + c16], rtb1 = INP(I_RTB)[l * 32 + 16 + c16];
    const int ngroups = (NTOK - row_lo) / 16;
    for (int u = bid * NWAVES + wid; u < ngroups; u += nb * NWAVES) {
        const int row = row_lo + 16 * u + c16;
        const Tok tk = tokinfo(row_lo + 16 * u);
        const float* mrow = mod + ((size_t)l * 17 + tk.modrow) * 6144;
        const float* hrow = H + (size_t)row * DM + 8 * g4;
        float ss = 0.f;
#pragma unroll 8
        for (int ks = 0; ks < 32; ++ks) { const f32x4 a = *(const f32x4*)(hrow + 32 * ks), b = *(const f32x4*)(hrow + 32 * ks + 4);
            ss += (a.x * a.x + a.y * a.y) + (a.z * a.z + a.w * a.w) + (b.x * b.x + b.y * b.y) + (b.z * b.z + b.w * b.w); }
        ss += __shfl_xor(ss, 16); ss += __shfl_xor(ss, 32);
        const float rstd = rsqrtf(ss * (1.0f / DM) + 1e-6f);
        f32x4 acc0 = {0.f, 0.f, 0.f, 0.f}, acc1 = acc0;
#pragma unroll 2
        for (int ks = 0; ks < 32; ++ks) {
            const int col = 32 * ks + 8 * g4;
            float f[8];
            { const f32x4 xa = *(const f32x4*)(hrow + 32 * ks), xb = *(const f32x4*)(hrow + 32 * ks + 4);
              const f32x4 ga = *(const f32x4*)(gp + col), gb = *(const f32x4*)(gp + col + 4), sa = *(const f32x4*)(mrow + 4 * 1024 + col), sb = *(const f32x4*)(mrow + 4 * 1024 + col + 4);
              const f32x4 ha = *(const f32x4*)(mrow + 3 * 1024 + col), hb = *(const f32x4*)(mrow + 3 * 1024 + col + 4);
              const f32x4 fa = (xa * rstd * ga) * (sa + 1.0f) + ha, fb = (xb * rstd * gb) * (sb + 1.0f) + hb;
              f[0] = fa.x; f[1] = fa.y; f[2] = fa.z; f[3] = fa.w; f[4] = fb.x; f[5] = fb.y; f[6] = fb.z; f[7] = fb.w; }
            unsigned hi[4], lo[4];
#pragma unroll
            for (int e = 0; e < 4; ++e) { hi[e] = pk2(f[2 * e], f[2 * e + 1]);
                lo[e] = pk2(f[2 * e] - __builtin_bit_cast(float, hi[e] << 16), f[2 * e + 1] - __builtin_bit_cast(float, hi[e] & 0xffff0000u)); }
            const u32x4 hv = {hi[0], hi[1], hi[2], hi[3]}, lv = {lo[0], lo[1], lo[2], lo[3]};
            { int w0 = __builtin_amdgcn_cvt_pk_fp8_f32(f[0], f[1], 0, false); w0 = __builtin_amdgcn_cvt_pk_fp8_f32(f[2], f[3], w0, true);
              int w1 = __builtin_amdgcn_cvt_pk_fp8_f32(f[4], f[5], 0, false); w1 = __builtin_amdgcn_cvt_pk_fp8_f32(f[6], f[7], w1, true);
              *(u32x2*)((unsigned char*)abf + (size_t)row * DM + col) = (u32x2){(unsigned)w0, (unsigned)w1}; }
            const bf16x8 fh = __builtin_bit_cast(bf16x8, hv), fl = __builtin_bit_cast(bf16x8, lv);
            const int wo = c16 * RT_LS + col * 2;
            const bf16x8 wh0 = *(const LAS bf16x8*)(rth + wo), wh1 = *(const LAS bf16x8*)(rth + 16 * RT_LS + wo), wl0 = *(const LAS bf16x8*)(rtl + wo), wl1 = *(const LAS bf16x8*)(rtl + 16 * RT_LS + wo);
            acc0 = __builtin_amdgcn_mfma_f32_16x16x32_bf16(fh, wh0, acc0, 0, 0, 0); acc1 = __builtin_amdgcn_mfma_f32_16x16x32_bf16(fh, wh1, acc1, 0, 0, 0);
            acc0 = __builtin_amdgcn_mfma_f32_16x16x32_bf16(fl, wh0, acc0, 0, 0, 0); acc1 = __builtin_amdgcn_mfma_f32_16x16x32_bf16(fl, wh1, acc1, 0, 0, 0);
            acc0 = __builtin_amdgcn_mfma_f32_16x16x32_bf16(fh, wl0, acc0, 0, 0, 0); acc1 = __builtin_amdgcn_mfma_f32_16x16x32_bf16(fh, wl1, acc1, 0, 0, 0);
        }
#pragma unroll
        for (int r = 0; r < 4; ++r) { lgs[(4 * g4 + r) * 34 + c16] = acc0[r] + rtb0; lgs[(4 * g4 + r) * 34 + 16 + c16] = acc1[r] + rtb1; }
        asm volatile("s_waitcnt lgkmcnt(0)" ::: "memory");
        if (lane < 16) {
            float tv[4] = {-3.0e38f, -3.0e38f, -3.0e38f, -3.0e38f}; int ti[4] = {0, 0, 0, 0};
#pragma unroll
            for (int e = 0; e < 32; ++e) {
                const float lgv = lgs[lane * 34 + e];
                if (lgv > tv[3]) {
                    tv[3] = lgv; ti[3] = e;
                    if (tv[3] > tv[2]) { const float a = tv[2]; tv[2] = tv[3]; tv[3] = a; const int b = ti[2]; ti[2] = ti[3]; ti[3] = b; }
                    if (tv[2] > tv[1]) { const float a = tv[1]; tv[1] = tv[2]; tv[2] = a; const int b = ti[1]; ti[1] = ti[2]; ti[2] = b; }
                    if (tv[1] > tv[0]) { const float a = tv[0]; tv[0] = tv[1]; tv[1] = a; const int b = ti[0]; ti[0] = ti[1]; ti[1] = b; }
                }
            }
            const float e1 = __expf(tv[1] - tv[0]), e2 = __expf(tv[2] - tv[0]), e3 = __expf(tv[3] - tv[0]);
            const float inv = 1.0f / (1.0f + e1 + e2 + e3);
            const size_t r4 = (size_t)(row_lo + 16 * u + lane) * 4;
            *(int4*)((int*)(ws + WS_TOKE) + r4) = make_int4(ti[0], ti[1], ti[2], ti[3]);
            *(f32x4*)((float*)(ws + WS_TOKG) + r4) = (f32x4){inv, e1 * inv, e2 * inv, e3 * inv};
            int rk[4];
#pragma unroll
            for (int k = 0; k < 4; ++k) rk[k] = __hip_atomic_fetch_add(hist + ti[k], 1, __ATOMIC_RELAXED, __HIP_MEMORY_SCOPE_WORKGROUP);
            *(int4*)((int*)(ws + WS_TOKR) + r4) = make_int4(rk[0], rk[1], rk[2], rk[3]);
        }
        asm volatile("s_waitcnt lgkmcnt(0)" ::: "memory");
    }
    __syncthreads();
    if (tid < 32) ((int*)(ws + WS_BCNT))[((size_t)l * 256 + bid) * 32 + tid] = hist[tid];
}

typedef pg8::f32x4 (&AccRef)[2][2][4][2];
struct EpiStoreBf16 {
    static constexpr bool PERM = true, AFTER_DRAIN = false;
    bf16_t* O; int ldc;
    __device__ __forceinline__ void operator()(const pg8::f32x4 (&acc)[2][2][4][2], const pg8::Unit& u, int wr, int wc, int fr, int fq) const {
        const int row0 = u.pm * 256 + wr * 64 + fr, col0 = u.pn * 256 + wc * 32 + 8 * fq;
#pragma unroll
        for (int ai = 0; ai < 2; ++ai)
#pragma unroll
            for (int m = 0; m < 4; ++m) { bf16_t* rowp = O + (size_t)(row0 + ai * 128 + m * 16) * ldc + col0;
#pragma unroll
                for (int bj = 0; bj < 2; ++bj) { const pg8::f32x4 v0 = acc[ai][bj][m][0], v1 = acc[ai][bj][m][1];
                    u32x4 w; w.x = cvtpk_s(v0[0], v0[1]); w.y = cvtpk_s(v0[2], v0[3]); w.z = cvtpk_s(v1[0], v1[1]); w.w = cvtpk_s(v1[2], v1[3]);
                    *(u32x4*)(rowp + bj * 128) = w; } }
    }
};
struct EpiGeluBf16 {
    static constexpr bool PERM = true, AFTER_DRAIN = false;
    bf16_t* O; int ldc; const float* bias;
    __device__ __forceinline__ void operator()(const pg8::f32x4 (&acc)[2][2][4][2], const pg8::Unit& u, int wr, int wc, int fr, int fq) const {
        const int row0 = u.pm * 256 + wr * 64 + fr, col0 = u.pn * 256 + wc * 32 + 8 * fq;
        pg8::f32x4 bv[2][2];
#pragma unroll
        for (int bj = 0; bj < 2; ++bj)
#pragma unroll
            for (int n = 0; n < 2; ++n) bv[bj][n] = *(const pg8::f32x4*)(bias + col0 + bj * 128 + 4 * n);
#pragma unroll
        for (int ai = 0; ai < 2; ++ai)
#pragma unroll
            for (int m = 0; m < 4; ++m) { bf16_t* rowp = O + (size_t)(row0 + ai * 128 + m * 16) * ldc + col0;
#pragma unroll
                for (int bj = 0; bj < 2; ++bj) { pg8::f32x4 v0 = acc[ai][bj][m][0] + bv[bj][0], v1 = acc[ai][bj][m][1] + bv[bj][1];
                    const pg8::f32x2 a = pg8::gelu_pk((pg8::f32x2){v0[0], v0[1]}), b = pg8::gelu_pk((pg8::f32x2){v0[2], v0[3]}), c = pg8::gelu_pk((pg8::f32x2){v1[0], v1[1]}), d = pg8::gelu_pk((pg8::f32x2){v1[2], v1[3]});
                    u32x4 w; w.x = cvtpk_s(a.x, a.y); w.y = cvtpk_s(b.x, b.y); w.z = cvtpk_s(c.x, c.y); w.w = cvtpk_s(d.x, d.y);
                    *(u32x4*)(rowp + bj * 128) = w; } }
    }
};
struct EpiResidual {
    static constexpr bool PERM = false, AFTER_DRAIN = false;
    float* H; const float* gate0; int row_base;
    __device__ __forceinline__ void operator()(const pg8::f32x4 (&acc)[2][2][4][2], const pg8::Unit& u, int wr, int wc, int fr, int fq) const {
        const int row0 = u.pm * 256 + wr * 64 + fr, col0 = u.pn * 256 + wc * 32 + 4 * fq;
        const Tok tk = tokinfo(row_base + u.pm * 256);
        const float* gate = gate0 + (size_t)tk.modrow * 6144 + col0;
        pg8::f32x4 gv[2][2];
#pragma unroll
        for (int bj = 0; bj < 2; ++bj)
#pragma unroll
            for (int n = 0; n < 2; ++n) gv[bj][n] = *(const pg8::f32x4*)(gate + bj * 128 + n * 16);
#pragma unroll
        for (int ai = 0; ai < 2; ++ai)
#pragma unroll
            for (int m = 0; m < 4; ++m) { float* rowp = H + (size_t)(row0 + ai * 128 + m * 16) * DM + col0;
#pragma unroll
                for (int bj = 0; bj < 2; ++bj)
#pragma unroll
                    for (int n = 0; n < 2; ++n) { pg8::f32x4* p = (pg8::f32x4*)(rowp + bj * 128 + n * 16); *p = *p + gv[bj][n] * acc[ai][bj][m][n]; } }
    }
};
struct ListOrder {
    const LAS int* list; int n; const LAS unsigned* rowtab;
    __device__ __forceinline__ bool next(int i, pg8::Unit& u) const {
        if (i >= n) return false;
        u.pm = __builtin_amdgcn_readfirstlane(list[2 * i]); u.pn = __builtin_amdgcn_readfirstlane(list[2 * i + 1]); return true;
    }
    __device__ __forceinline__ void a_ready(const pg8::Unit&) const {}
    __device__ __forceinline__ void done(const pg8::Unit&) const {}
};
struct EpiLora {
    static constexpr bool PERM = true, AFTER_DRAIN = false;
    bf16_t* O; const float* bias; int row_base;
    __device__ __forceinline__ void operator()(const pg8::f32x4 (&acc)[2][2][4][2], const pg8::Unit& u, int wr, int wc, int fr, int fq) const {
        const int seg = u.pn >> 1, row0 = row_base + u.pm * 256 + wr * 64 + fr, cs0 = (u.pn & 1) * 256 + wc * 32 + 8 * fq;
        const float ksig = seg < 2 ? -0.60653065971f : 1.0f; const bool lin = seg == 4;
        bf16_t* Os = O + (size_t)seg * NTOK * 512;
#pragma unroll
        for (int bj = 0; bj < 2; ++bj) {
            const int cs = cs0 + bj * 128;
            const pg8::f32x4 b0 = *(const pg8::f32x4*)(bias + seg * 512 + cs), b1 = *(const pg8::f32x4*)(bias + seg * 512 + cs + 4);
#pragma unroll
            for (int ai = 0; ai < 2; ++ai)
#pragma unroll
                for (int m = 0; m < 4; ++m) {
                    pg8::f32x4 v0 = acc[ai][bj][m][0] + b0, v1 = acc[ai][bj][m][1] + b1;
#pragma unroll
                    for (int r = 0; r < 4; ++r) {
                        const float t0 = ksig * __builtin_amdgcn_rcpf(1.0f + __expf(-v0[r])), t1 = ksig * __builtin_amdgcn_rcpf(1.0f + __expf(-v1[r]));
                        v0[r] = lin ? v0[r] : t0; v1[r] = lin ? v1[r] : t1;
                    }
                    u32x4 w; w.x = cvtpk_s(v0[0], v0[1]); w.y = cvtpk_s(v0[2], v0[3]); w.z = cvtpk_s(v1[0], v1[1]); w.w = cvtpk_s(v1[2], v1[3]);
                    *(u32x4*)(Os + (size_t)(row0 + ai * 128 + m * 16) * 512 + cs) = w;
                }
        }
    }
};
constexpr int LDS_TAB = 131072;
constexpr int LDS_LIST = LDS_TAB + 4096;
constexpr int LDS_ROWTAB = LDS_LIST + 1024;
__device__ __forceinline__ ListOrder build_units(LAS unsigned char* lds, int nM, int nN, int G, int c, const LAS int* tile_e, int ncol) {
    LAS int* list = (LAS int*)(lds + LDS_LIST);
    pg8::StaticOrder S; S.nM = nM; S.nN = nN; S.nwg = nM * nN; S.G = G; S.c = c;
    const int tid = tid_opaque();
    if (tid < 64) { pg8::Unit u; if (S.next(tid, u)) { if (tile_e) u.pn = tile_e[u.pm] * ncol + u.pn; list[2 * tid] = u.pm; list[2 * tid + 1] = u.pn; } }
    __syncthreads();
    ListOrder L; L.list = list; L.n = (c < S.nwg) ? (S.nwg - c + G - 1) / G : 0; L.rowtab = (const LAS unsigned*)(lds + LDS_ROWTAB);
    return L;
}
struct EpiMoe1 {
    static constexpr bool PERM = true, AFTER_DRAIN = false;
    bf16_t* O; const float* b1;
    __device__ __forceinline__ void operator()(const pg8::f32x4 (&acc)[2][2][4][2], const pg8::Unit& u, int wr, int wc, int fr, int fq) const {
        const int e = u.pn >> 3, pn = u.pn & 7;
        const int row0 = u.pm * 256 + wr * 64 + fr, ci = pn * 128 + wc * 32 + 8 * fq;
        const float* be = b1 + (size_t)e * 2048 + ci;
        const pg8::f32x4 bg0 = *(const pg8::f32x4*)(be), bg1 = *(const pg8::f32x4*)(be + 4), bl0 = *(const pg8::f32x4*)(be + 1024), bl1 = *(const pg8::f32x4*)(be + 1028);
#pragma unroll
        for (int ai = 0; ai < 2; ++ai)
#pragma unroll
            for (int m = 0; m < 4; ++m) {
                const pg8::f32x4 g0 = acc[ai][0][m][0] + bg0, g1 = acc[ai][0][m][1] + bg1, l0 = acc[ai][1][m][0] + bl0, l1 = acc[ai][1][m][1] + bl1;
                float o[8];
#pragma unroll
                for (int r = 0; r < 4; ++r) {
                    const float ga = fminf(g0[r], 7.0f), gb = fminf(g1[r], 7.0f);
                    const float la = fminf(fmaxf(l0[r], -7.0f), 7.0f), lb = fminf(fmaxf(l1[r], -7.0f), 7.0f);
                    o[r] = ga * __builtin_amdgcn_rcpf(1.0f + __expf(-1.702f * ga)) * (la + 1.0f);
                    o[4 + r] = gb * __builtin_amdgcn_rcpf(1.0f + __expf(-1.702f * gb)) * (lb + 1.0f);
                }
                int w0 = __builtin_amdgcn_cvt_pk_fp8_f32(o[0] * 4.0f, o[1] * 4.0f, 0, false); w0 = __builtin_amdgcn_cvt_pk_fp8_f32(o[2] * 4.0f, o[3] * 4.0f, w0, true);
                int w1 = __builtin_amdgcn_cvt_pk_fp8_f32(o[4] * 4.0f, o[5] * 4.0f, 0, false); w1 = __builtin_amdgcn_cvt_pk_fp8_f32(o[6] * 4.0f, o[7] * 4.0f, w1, true);
                *(u32x2*)((unsigned char*)O + (size_t)(row0 + ai * 128 + m * 16) * DM + ci) = (u32x2){(unsigned)w0, (unsigned)w1};
            }
    }
};
struct EpiMoe2 {
    static constexpr bool PERM = true, AFTER_DRAIN = false;
    bf16_t* O; const float* b2;
    __device__ __forceinline__ void operator()(const pg8::f32x4 (&acc)[2][2][4][2], const pg8::Unit& u, int wr, int wc, int fr, int fq) const {
        const int e = u.pn >> 2, pn = u.pn & 3;
        const int row0 = u.pm * 256 + wr * 64 + fr, col0 = pn * 256 + wc * 32 + 8 * fq;
        const float* be = b2 + (size_t)e * DM + col0;
        pg8::f32x4 bv[2][2];
#pragma unroll
        for (int bj = 0; bj < 2; ++bj)
#pragma unroll
            for (int n = 0; n < 2; ++n) bv[bj][n] = *(const pg8::f32x4*)(be + bj * 128 + 4 * n);
#pragma unroll
        for (int ai = 0; ai < 2; ++ai)
#pragma unroll
            for (int m = 0; m < 4; ++m) { bf16_t* rowp = O + (size_t)(row0 + ai * 128 + m * 16) * DM + col0;
#pragma unroll
                for (int bj = 0; bj < 2; ++bj) { const pg8::f32x4 v0 = acc[ai][bj][m][0] + bv[bj][0], v1 = acc[ai][bj][m][1] + bv[bj][1];
                    u32x4 w; w.x = cvtpk_s(v0[0], v0[1]); w.y = cvtpk_s(v0[2], v0[3]); w.z = cvtpk_s(v1[0], v1[1]); w.w = cvtpk_s(v1[2], v1[3]);
                    *(u32x4*)(rowp + bj * 128) = w; } }
    }
};

namespace att {
typedef float f32x16 __attribute__((ext_vector_type(16)));
typedef short s16x4 __attribute__((ext_vector_type(4)));
constexpr int KVBLK = 64, LDR = 512;
constexpr float QSCALE = 0.125f * 1.4426950408889634f;
constexpr int SHM_V = KVBLK * 128 * 2, SHM_K = KVBLK * 64 * 2, SHM_ATTN = 2 * SHM_V + 2 * SHM_K + NWAVES * 64 * 4;
#define ATT_KSWZ(row, colB) ((row) * 128 + ((colB) ^ ((((row) >> 1) & 7) << 4)))
#define ATT_SBAR() __builtin_amdgcn_sched_barrier(0)
__device__ __forceinline__ int crow(int r, int hi) { return (r & 3) + 8 * (r >> 2) + 4 * hi; }
__device__ __forceinline__ unsigned cvtpk(float lo, float hi) { unsigned r; asm volatile("v_cvt_pk_bf16_f32 %0, %1, %2" : "=v"(r) : "v"(lo), "v"(hi)); return r; }
constexpr float SHIFT = -12.0f;
__device__ __forceinline__ void partialSM(f32x16& p0) {
#pragma unroll
    for (int r = 0; r < 16; ++r) p0[r] = __builtin_amdgcn_exp2f(p0[r]);
}
__device__ __forceinline__ void finishSM(f32x16& p0, f32x16& p1, float& l_reg, bf16x8& pa0, bf16x8& pa1, bf16x8& pa2, bf16x8& pa3) {
#pragma unroll
    for (int r = 0; r < 16; ++r) p1[r] = __builtin_amdgcn_exp2f(p1[r]);
    float ps = 0;
#pragma unroll
    for (int r = 0; r < 16; ++r) ps += p0[r];
#pragma unroll
    for (int r = 0; r < 16; ++r) ps += p1[r];
    l_reg += ps;
#define ATT_PK4(P, BASE, OUT) do { unsigned a0 = cvtpk(P[BASE + 0], P[BASE + 1]), a1 = cvtpk(P[BASE + 2], P[BASE + 3]);   \
    unsigned b0 = cvtpk(P[BASE + 4], P[BASE + 5]), b1 = cvtpk(P[BASE + 6], P[BASE + 7]);                              \
    auto r0 = __builtin_amdgcn_permlane32_swap(a0, b0, false, false); auto r1 = __builtin_amdgcn_permlane32_swap(a1, b1, false, false); \
    u32x4 w = {r0[0], r1[0], r0[1], r1[1]}; OUT = __builtin_bit_cast(bf16x8, w); } while (0)
    ATT_PK4(p0, 0, pa0); ATT_PK4(p0, 8, pa1); ATT_PK4(p1, 0, pa2); ATT_PK4(p1, 8, pa3);
#undef ATT_PK4
}
__device__ __forceinline__ void qkt(f32x16& p0, f32x16& p1, const LAS unsigned char* Ks, int qaddr, int r32, int hi) {
    asm volatile("" : "+v"(qaddr)); const LAS unsigned char* qp = (const LAS unsigned char*)(uintptr_t)qaddr;
    bf16x8 qr[4];
#pragma unroll
    for (int d0 = 0; d0 < 4; ++d0) qr[d0] = *(const LAS bf16x8*)(qp + d0 * 1024);
#pragma unroll
    for (int r = 0; r < 16; ++r) { p0[r] = SHIFT; p1[r] = SHIFT; }
#pragma unroll
    for (int d0 = 0; d0 < 4; ++d0) { const int cb = (d0 * 16 + hi * 8) * 2;
        const bf16x8 b0 = *(const LAS bf16x8*)(Ks + ATT_KSWZ(r32, cb));
        const bf16x8 b1 = *(const LAS bf16x8*)(Ks + ATT_KSWZ(32 + r32, cb));
        p0 = __builtin_amdgcn_mfma_f32_32x32x16_bf16(b0, qr[d0], p0, 0, 0, 0);
        p1 = __builtin_amdgcn_mfma_f32_32x32x16_bf16(b1, qr[d0], p1, 0, 0, 0); }
}
__device__ __forceinline__ int v_st(int k, int c) { const int kk = (k & ~0xC) | ((k & 4) << 1) | ((k & 8) >> 1); return ((kk >> 3) * 4 + (c >> 5)) * 512 + ((kk & 7) * 32 + (c & 31)) * 2; }
__device__ __forceinline__ int v_rd_base(int lane) { return ((lane & 3) << 3) | (((lane >> 2) & 3) << 6) | (((lane >> 4) & 1) << 5) | (((lane >> 5) & 1) << 8); }
constexpr int v_rd_off(int d0, int ks, int half) { return d0 * 512 + ks * 4096 + half * 2048; }
template <int OFF> __device__ __forceinline__ s16x4 tr_read(int vb) { s16x4 r; asm volatile("ds_read_b64_tr_b16 %0, %1 offset:%2" : "=&v"(r) : "v"(vb), "i"(OFF) : "memory"); return r; }
template <int D0> __device__ __forceinline__ void pv_one(f32x16& od, int vb, bf16x8 pa0, bf16x8 pa1, bf16x8 pa2, bf16x8 pa3) {
    const s16x4 l0 = tr_read<v_rd_off(D0, 0, 0)>(vb), h0 = tr_read<v_rd_off(D0, 0, 1)>(vb), l1 = tr_read<v_rd_off(D0, 1, 0)>(vb), h1 = tr_read<v_rd_off(D0, 1, 1)>(vb);
    const s16x4 l2 = tr_read<v_rd_off(D0, 2, 0)>(vb), h2 = tr_read<v_rd_off(D0, 2, 1)>(vb), l3 = tr_read<v_rd_off(D0, 3, 0)>(vb), h3 = tr_read<v_rd_off(D0, 3, 1)>(vb);
    asm volatile("s_waitcnt lgkmcnt(0)" ::: "memory"); ATT_SBAR();
#define ATT_PK(L, H) (bf16x8){L[0], L[1], L[2], L[3], H[0], H[1], H[2], H[3]}
    od = __builtin_amdgcn_mfma_f32_32x32x16_bf16(pa0, ATT_PK(l0, h0), od, 0, 0, 0);
    od = __builtin_amdgcn_mfma_f32_32x32x16_bf16(pa1, ATT_PK(l1, h1), od, 0, 0, 0);
    od = __builtin_amdgcn_mfma_f32_32x32x16_bf16(pa2, ATT_PK(l2, h2), od, 0, 0, 0);
    od = __builtin_amdgcn_mfma_f32_32x32x16_bf16(pa3, ATT_PK(l3, h3), od, 0, 0, 0);
#undef ATT_PK
}
__device__ __forceinline__ void pv_d0(f32x16 (&o)[4], int vb, bf16x8 pa0, bf16x8 pa1, bf16x8 pa2, bf16x8 pa3) {
    pv_one<0>(o[0], vb, pa0, pa1, pa2, pa3); pv_one<1>(o[1], vb, pa0, pa1, pa2, pa3); pv_one<2>(o[2], vb, pa0, pa1, pa2, pa3); pv_one<3>(o[3], vb, pa0, pa1, pa2, pa3);
}
__device__ __forceinline__ void attn_body(const bf16_t* Qb, const bf16_t* Kh, const bf16_t* Vh, float* Ob, int seq, LAS unsigned char* lds) {
    const int tid = tid_opaque(), wid = tid >> 6, lane = tid & 63, r32 = lane & 31, hi = lane >> 5;
    LAS unsigned char* V_lds = lds; LAS unsigned char* K_lds = lds + 2 * SHM_V;
    LAS float* wsl = (LAS float*)(lds + 2 * SHM_V + 2 * SHM_K) + wid * 64; LAS float* li_l = wsl; LAS float* al_l = wsl + 32;
    float l_reg = 0; f32x16 o[4] = {};
    const bf16_t* Qw = Qb + (size_t)(wid * 32 + r32) * LDR + hi * 8;
    LAS unsigned char* qlds = lds + SHM_ATTN + wid * 4096 + lane * 16;
#pragma unroll
    for (int d0 = 0; d0 < 4; ++d0) *(LAS bf16x8*)(qlds + d0 * 1024) = *(const bf16x8*)(Qw + d0 * 16);
    const int qr = (int)(uintptr_t)qlds;
    const int sr = tid >> 4, sc = (tid & 15) * 8, vst0 = v_st(sr, sc), vst1 = v_st(32 + sr, sc);
    const int kr = tid >> 3, kc = (tid & 7) * 8, kst = ATT_KSWZ(kr, kc * 2);
    const int vb0 = (int)(uintptr_t)V_lds + v_rd_base(lane);
    bf16x8 vsA0, vsA1, ksA, vsB0, vsB1, ksB;
#define ATT_SLOAD(V0, V1, K0, k0) do { V0 = *(const bf16x8*)(Vh + (size_t)((k0) + sr) * LDR + sc); V1 = *(const bf16x8*)(Vh + (size_t)((k0) + 32 + sr) * LDR + sc); \
    K0 = *(const bf16x8*)(Kh + (size_t)((k0) + kr) * LDR + kc); } while (0)
#define ATT_SWRITE(b, V0, V1, K0) do { *(LAS bf16x8*)(V_lds + (b) * SHM_V + vst0) = V0; *(LAS bf16x8*)(V_lds + (b) * SHM_V + vst1) = V1; \
    *(LAS bf16x8*)(K_lds + (b) * SHM_K + kst) = K0; } while (0)
#define ATT_SWAIT() asm volatile("s_waitcnt vmcnt(3)" ::: "memory")
    f32x16 p0, p1; bf16x8 pa0, pa1, pa2, pa3; const int NT = seq / KVBLK;
    ATT_SLOAD(vsA0, vsA1, ksA, 0); asm volatile("s_waitcnt vmcnt(0)" ::: "memory"); ATT_SWRITE(0, vsA0, vsA1, ksA);
    ATT_SLOAD(vsB0, vsB1, ksB, KVBLK); if (2 < NT) ATT_SLOAD(vsA0, vsA1, ksA, 2 * KVBLK);
    ATT_SWAIT(); ATT_SWRITE(1, vsB0, vsB1, ksB); __syncthreads();
    for (int j = 0; j < NT; j += 2) {
        ATT_SBAR(); qkt(p0, p1, K_lds, qr, r32, hi); partialSM(p0);
        finishSM(p0, p1, l_reg, pa0, pa1, pa2, pa3); ATT_SBAR();
        if (j + 3 < NT) ATT_SLOAD(vsB0, vsB1, ksB, (j + 3) * KVBLK); ATT_SBAR();
        pv_d0(o, vb0, pa0, pa1, pa2, pa3); ATT_SBAR();
        __syncthreads();
        if (j + 2 < NT) { ATT_SWAIT(); ATT_SWRITE(0, vsA0, vsA1, ksA); }
        asm volatile("" : "+v"(o[0]), "+v"(o[1]), "+v"(o[2]), "+v"(o[3]));
        __syncthreads();
        ATT_SBAR(); qkt(p0, p1, K_lds + SHM_K, qr, r32, hi); partialSM(p0);
        finishSM(p0, p1, l_reg, pa0, pa1, pa2, pa3); ATT_SBAR();
        if (j + 4 < NT) ATT_SLOAD(vsA0, vsA1, ksA, (j + 4) * KVBLK); ATT_SBAR();
        pv_d0(o, vb0 + SHM_V, pa0, pa1, pa2, pa3); ATT_SBAR();
        __syncthreads();
        if (j + 3 < NT) { ATT_SWAIT(); ATT_SWRITE(1, vsB0, vsB1, ksB); }
        asm volatile("" : "+v"(o[0]), "+v"(o[1]), "+v"(o[2]), "+v"(o[3]));
        __syncthreads();
    }
    { auto rr = __builtin_amdgcn_permlane32_swap(__float_as_uint(l_reg), __float_as_uint(l_reg), false, false); l_reg = __uint_as_float(rr[0]) + __uint_as_float(rr[1]); }
    if (hi == 0) li_l[r32] = l_reg; asm volatile("s_waitcnt lgkmcnt(0)" ::: "memory");
    float rli[16];
#pragma unroll
    for (int r = 0; r < 16; ++r) rli[r] = __builtin_amdgcn_rcpf(li_l[crow(r, hi)]);
    float* Ow = Ob + (size_t)(wid * 32) * LDR;
#pragma unroll
    for (int r = 0; r < 16; ++r) { const int orow = crow(r, hi);
#pragma unroll
        for (int d0 = 0; d0 < 4; ++d0) Ow[(size_t)orow * LDR + d0 * 32 + r32] = o[d0][r] * rli[r]; }
#undef ATT_SLOAD
#undef ATT_SWRITE
#undef ATT_SWAIT
}
}

__device__ __forceinline__ void ph_gemm_win(const Args& A, int j, int row_lo, LAS unsigned char* lds, int bid, int nb) {
    unsigned char* ws = opq(A.ws); const float* const* IN = (const float* const*)(ws + WS_PTRS); (void)IN;
    pg8::Gemm g{(const bf16_t*)(ws + WS_ABF) + (size_t)row_lo * DM, (const bf16_t*)(ws + WS_WIN) + (size_t)j * ZLD * DM, NTOK - row_lo, ZLD, DM};
    const ListOrder S = build_units(lds, (NTOK - row_lo) / 256, ZLD / 256, nb, bid, nullptr, 0);
    EpiStoreBf16 E{(bf16_t*)(ws + WS_Z) + (size_t)row_lo * ZLD, ZLD};
    pg8::gemm_phase<EpiStoreBf16, ListOrder, true, true>(lds, g, S, E);
}

__device__ __forceinline__ void ph_rwkv_pre(const Args& A, int j, int row_lo, int bid, int nb) {
    unsigned char* ws = opq(A.ws); const float* const* IN = (const float* const*)(ws + WS_PTRS);
    const int tid = tid_opaque(), lane = tid & 63, wid = tid >> 6;
    const bf16_t* Z = (const bf16_t*)(ws + WS_Z);
    const float* mu = INP(I_RWMU) + (size_t)j * 2 * RWC; const float* kkw = INP(I_RWKK) + j * 512;
    bf16_t* RB = (bf16_t*)(ws + WS_RB); bf16_t* KS = (bf16_t*)(ws + WS_KS); bf16_t* VS = (bf16_t*)(ws + WS_VS); bf16_t* KKN = (bf16_t*)(ws + WS_KKN); bf16_t* LIN = (bf16_t*)(ws + WS_LIN);
#define UNPK8(dst, raw) do { _Pragma("unroll") for (int _i = 0; _i < 4; ++_i) { dst[2 * _i] = __builtin_bit_cast(float, raw[_i] << 16); dst[2 * _i + 1] = __builtin_bit_cast(float, raw[_i] & 0xffff0000u); } } while (0)
#define PK8(v) (u32x4){pk2(v[0], v[1]), pk2(v[2], v[3]), pk2(v[4], v[5]), pk2(v[6], v[7])}
    for (int g = row_lo + bid * NWAVES + wid; g < NTOK; g += nb * NWAVES) {
        const Tok tk = tokinfo(g);
        const bool hp = tk.t > 0, hn = tk.t < tk.T - 1;
        const bf16_t* zc = Z + (size_t)g * ZLD;
#pragma unroll
        for (int i = 0; i < 4; ++i) {
            const int ch = i * 64 + lane, col = ch * 8;
            if (ch < 240) {
                const u32x4 zero = {0u, 0u, 0u, 0u};
                const u32x4 cr = *(const u32x4*)(zc + col), pr = hp ? *(const u32x4*)(zc - ZLD + col) : zero, nr = hn ? *(const u32x4*)(zc + ZLD + col) : zero;
                float z[8], p[8], n[8], s8[8];
                UNPK8(z, cr); UNPK8(p, pr); UNPK8(n, nr);
                const f32x4 m0a = *(const f32x4*)(mu + col), m0b = *(const f32x4*)(mu + col + 4), m1a = *(const f32x4*)(mu + RWC + col), m1b = *(const f32x4*)(mu + RWC + col + 4);
#pragma unroll
                for (int e = 0; e < 4; ++e) { s8[e] = z[e] + m0a[e] * (p[e] - z[e]) + m1a[e] * (n[e] - z[e]); s8[4 + e] = z[4 + e] + m0b[e] * (p[4 + e] - z[4 + e]) + m1b[e] * (n[4 + e] - z[4 + e]); }
                if (col < 512) *(u32x4*)(RB + (size_t)g * 512 + col) = PK8(s8);
                else if (col < 1024) {
                    const int ck = col - 512;
                    *(u32x4*)(KS + (size_t)g * 512 + ck) = PK8(s8);
                    const f32x4 kwa = *(const f32x4*)(kkw + ck), kwb = *(const f32x4*)(kkw + ck + 4);
                    float kk[8]; float ss = 0.f;
#pragma unroll
                    for (int e = 0; e < 4; ++e) { kk[e] = s8[e] * kwa[e]; kk[4 + e] = s8[4 + e] * kwb[e]; ss += kk[e] * kk[e] + kk[4 + e] * kk[4 + e]; }
                    ss += __shfl_xor(ss, 1); ss += __shfl_xor(ss, 2); ss += __shfl_xor(ss, 4);
                    const float inv = 1.0f / fmaxf(sqrtf(ss), 1e-12f);
#pragma unroll
                    for (int e = 0; e < 8; ++e) kk[e] *= inv;
                    *(u32x4*)(KKN + (size_t)g * 512 + ck) = PK8(kk);
                }
                else if (col < 1536) *(u32x4*)(VS + (size_t)g * 512 + (col - 1024)) = PK8(s8);
                else {
                    float t8[8];
#pragma unroll
                    for (int e = 0; e < 8; ++e) t8[e] = col < 1664 ? tanhf(s8[e]) : (col < 1792 ? s8[e] : sigmoidf_(s8[e]));
                    *(u32x4*)(LIN + (size_t)g * 384 + (col - 1536)) = PK8(t8);
                }
            }
        }
    }
#undef UNPK8
#undef PK8
}
__device__ __forceinline__ void ph_gemm_lora(const Args& A, int j, int row_lo, LAS unsigned char* lds, int bid, int nb) {
    unsigned char* ws = opq(A.ws);
    int Kq = LORA_K; asm volatile("" : "+s"(Kq));
    pg8::Gemm g{(const bf16_t*)(ws + WS_LIN) + (size_t)row_lo * LORA_K, (const bf16_t*)(ws + WS_WLORA) + (size_t)j * LORA_N * LORA_K, NTOK - row_lo, LORA_N, Kq};
    const ListOrder S = build_units(lds, (NTOK - row_lo) / 256, LORA_N / 256, nb, bid, nullptr, 0);
    EpiLora E{(bf16_t*)(ws + WS_LO), (const float*)(ws + WS_LBIAS) + (size_t)j * LORA_N, row_lo};
    pg8::gemm_phase<EpiLora, ListOrder, true, true>(lds, g, S, E);
}

constexpr int R_A2 = 0, R_RT = 2048, R_BT = 4096, R_KT = 6144, R_VT = 8192, R_MBR = 10240, R_MKR = 10752, R_G = 11264, R_P = 11776;
__device__ __forceinline__ bf16x8 frag4(u32x2 lo) { const u32x4 w = {lo.x, lo.y, 0u, 0u}; return __builtin_bit_cast(bf16x8, w); }
__device__ __forceinline__ bf16x8 frag8(u32x2 lo, u32x2 hi) { const u32x4 w = {lo.x, lo.y, hi.x, hi.y}; return __builtin_bit_cast(bf16x8, w); }
__device__ __forceinline__ u32x2 pack4(f32x4 v) { u32x2 o; o.x = cvtpk_s(v[0], v[1]); o.y = cvtpk_s(v[2], v[3]); return o; }
__device__ __forceinline__ int wkv_token(int b, int dir, int s) {
    if (s < TC) return b * TC + (dir ? (TC - 1 - s) : s);
    const int q = s - TC; return NCTX + b * TL + (dir ? (TL - 1 - q) : q);
}
__device__ __forceinline__ float dpp_row_shr(float x, const int n) {
    switch (n) {
        case 1: return __builtin_bit_cast(float, __builtin_amdgcn_update_dpp(0, __builtin_bit_cast(int, x), 0x111, 0xF, 0xF, false));
        case 2: return __builtin_bit_cast(float, __builtin_amdgcn_update_dpp(0, __builtin_bit_cast(int, x), 0x112, 0xF, 0xF, false));
        case 4: return __builtin_bit_cast(float, __builtin_amdgcn_update_dpp(0, __builtin_bit_cast(int, x), 0x114, 0xF, 0xF, false));
        default: return __builtin_bit_cast(float, __builtin_amdgcn_update_dpp(0, __builtin_bit_cast(int, x), 0x118, 0xF, 0xF, false));
    }
}
#define WKV_TR(dst, addr) asm volatile("ds_read_b64_tr_b16 %0, %1" : "=&v"(dst) : "v"(addr) : "memory")
__device__ __forceinline__ void ph_wkv_prep(const Args& A, int j, LAS unsigned char* lds, int bid, int nb) {
    unsigned char* ws = opq(A.ws); const float* const* IN = (const float* const*)(ws + WS_PTRS);
    const int tid = tid_opaque(), lane = tid & 63, wid = tid >> 6, c16 = lane & 15, g4 = lane >> 4;
    constexpr int RS = 144;
    LAS unsigned char* wl = lds + wid * 16384;
    LAS unsigned char* Lat = wl; LAS unsigned char* Lbt = wl + 2304; LAS unsigned char* Lkt = wl + 4608; LAS unsigned char* Lrt = wl + 6912; LAS unsigned char* Lvt = wl + 9216;
    LAS float* Lnf = (LAS float*)(wl + 11520);
    LAS unsigned char* Lx = wl + 12608;
    const size_t FS = (size_t)NTOK * 512;
    const bf16_t* RB = (const bf16_t*)(ws + WS_RB); const bf16_t* KS = (const bf16_t*)(ws + WS_KS); const bf16_t* VS = (const bf16_t*)(ws + WS_VS); const bf16_t* KKN = (const bf16_t*)(ws + WS_KKN);
#define UNPK16(dst, p) do { const u32x4 _a = *(const u32x4*)(p), _b = *(const u32x4*)((p) + 8); _Pragma("unroll") for (int _i = 0; _i < 4; ++_i) { \
        dst[2 * _i] = __builtin_bit_cast(float, _a[_i] << 16); dst[2 * _i + 1] = __builtin_bit_cast(float, _a[_i] & 0xffff0000u); \
        dst[8 + 2 * _i] = __builtin_bit_cast(float, _b[_i] << 16); dst[9 + 2 * _i] = __builtin_bit_cast(float, _b[_i] & 0xffff0000u); } } while (0)
#define PK16ST(base, v) do { *(LAS u32x4*)(base) = (u32x4){pk2(v[0], v[1]), pk2(v[2], v[3]), pk2(v[4], v[5]), pk2(v[6], v[7])}; \
        *(LAS u32x4*)((base) + 16) = (u32x4){pk2(v[8], v[9]), pk2(v[10], v[11]), pk2(v[12], v[13]), pk2(v[14], v[15])}; } while (0)
    for (int unit = bid * NWAVES + wid; unit < 256 * WKV_NCH; unit += nb * NWAVES) {
        const int inst = unit / WKV_NCH, c = unit - inst * WKV_NCH, dir = inst & 1, h = (inst >> 1) & 7, b = inst >> 4;
        const int g0 = wkv_token(b, dir, c * 16), gstep = dir ? -1 : 1;
        unsigned char* rec = ws + WS_WKV + (size_t)unit * WKV_REC;
        {
            const size_t o = (size_t)(g0 + gstep * c16) * 512 + h * 64 + 16 * g4;
            float lw[16], av[16], kv[16], kn[16], rv[16];
            UNPK16(lw, (const bf16_t*)(ws + WS_LO) + dir * FS + o); UNPK16(av, (const bf16_t*)(ws + WS_AB) + dir * FS + o);
            UNPK16(kv, KS + o); UNPK16(kn, KKN + o); UNPK16(rv, RB + o);
            { const u32x4 v0 = *(const u32x4*)(VS + o), v1 = *(const u32x4*)(VS + o + 8); *(LAS u32x4*)(Lvt + c16 * RS + 32 * g4) = v0; *(LAS u32x4*)(Lvt + c16 * RS + 32 * g4 + 16) = v1; }
            const float* kap = INP(I_RWKA) + j * 512 + h * 64 + 16 * g4;
            float at[16], bt[16], kt[16], rt[16], ecl[16];
#pragma unroll
            for (int i = 0; i < 16; ++i) {
                float cs = lw[i];
                cs += dpp_row_shr(cs, 1); cs += dpp_row_shr(cs, 2); cs += dpp_row_shr(cs, 4); cs += dpp_row_shr(cs, 8);
                const float ep = __expf(cs - lw[i]), ec = __expf(cs), em = __builtin_amdgcn_rcpf(ec);
                at[i] = -kn[i] * ep; bt[i] = kn[i] * av[i] * em; kt[i] = kv[i] * (1.0f + (av[i] - 1.0f) * kap[i]) * em; rt[i] = rv[i] * ec; ecl[i] = ec;
            }
            PK16ST(Lat + c16 * RS + 32 * g4, at); PK16ST(Lbt + c16 * RS + 32 * g4, bt); PK16ST(Lkt + c16 * RS + 32 * g4, kt); PK16ST(Lrt + c16 * RS + 32 * g4, rt);
            if (c16 == 15) {
#pragma unroll
                for (int q = 0; q < 4; ++q) *(f32x4*)(rec + R_P + (16 * g4 + 4 * q) * 4) = (f32x4){ecl[4 * q], ecl[4 * q + 1], ecl[4 * q + 2], ecl[4 * q + 3]};
            }
        }
        asm volatile("s_waitcnt lgkmcnt(0)" ::: "memory");
        f32x4 nD = {0.f, 0.f, 0.f, 0.f}, makD = nD, mbrD = nD, mkrD = nD;
#pragma unroll
        for (int ks = 0; ks < 2; ++ks) {
            const int off = c16 * RS + (32 * ks + 8 * g4) * 2;
            const bf16x8 fa = *(const LAS bf16x8*)(Lat + off), fb = *(const LAS bf16x8*)(Lbt + off), fk = *(const LAS bf16x8*)(Lkt + off), fr = *(const LAS bf16x8*)(Lrt + off);
            nD = __builtin_amdgcn_mfma_f32_16x16x32_bf16(fa, fb, nD, 0, 0, 0);
            makD = __builtin_amdgcn_mfma_f32_16x16x32_bf16(fa, fk, makD, 0, 0, 0);
            mbrD = __builtin_amdgcn_mfma_f32_16x16x32_bf16(fb, fr, mbrD, 0, 0, 0);
            mkrD = __builtin_amdgcn_mfma_f32_16x16x32_bf16(fk, fr, mkrD, 0, 0, 0);
        }
#pragma unroll
        for (int r = 0; r < 4; ++r) {
            const int row = 4 * g4 + r;
            nD[r] = (c16 < row) ? nD[r] : 0.f; makD[r] = (c16 < row) ? makD[r] : 0.f;
            mbrD[r] = (row <= c16) ? mbrD[r] : 0.f; mkrD[r] = (row <= c16) ? mkrD[r] : 0.f;
            Lnf[row * 17 + c16] = nD[r];
        }
        asm volatile("s_waitcnt lgkmcnt(0)" ::: "memory");
        float x[16];
#pragma unroll
        for (int t = 0; t < 16; ++t) {
            float acc = (t == c16) ? 1.f : 0.f;
#pragma unroll
            for (int i = 0; i < t; ++i) acc += Lnf[t * 17 + i] * x[i];
            x[t] = acc;
        }
        if (g4 == 0) {
#pragma unroll
            for (int t = 0; t < 16; ++t) *(LAS bf16_t*)(Lx + t * 32 + c16 * 2) = (bf16_t)f2bf(x[t]);
        }
        asm volatile("s_waitcnt lgkmcnt(0)" ::: "memory");
        const bf16x8 xB = frag4(*(const LAS u32x2*)(Lx + c16 * 32 + g4 * 8));
        const f32x4 z4 = {0.f, 0.f, 0.f, 0.f};
        const f32x4 gD = __builtin_amdgcn_mfma_f32_16x16x32_bf16(frag4(pack4(makD)), xB, z4, 0, 0, 0);
        *(u32x2*)(rec + R_G + (c16 * 16 + 4 * g4) * 2) = pack4(gD);
        *(u32x2*)(rec + R_MBR + (c16 * 16 + 4 * g4) * 2) = pack4(mbrD);
        *(u32x2*)(rec + R_MKR + (c16 * 16 + 4 * g4) * 2) = pack4(mkrD);
        {
            const int trow = c16 >> 2, tcol = 4 * (c16 & 3);
            u32x2 ta[4], tb[4], tk[4], tv[4];
#pragma unroll
            for (int m = 0; m < 4; ++m) {
                const int aA = (int)(uintptr_t)(Lat + (4 * g4 + trow) * RS + (16 * m + tcol) * 2);
                const int offr = (4 * m + trow) * RS + (16 * g4 + tcol) * 2;
                const int aB = (int)(uintptr_t)(Lbt + offr), aK = (int)(uintptr_t)(Lkt + offr), aV = (int)(uintptr_t)(Lvt + offr);
                WKV_TR(ta[m], aA); WKV_TR(tb[m], aB); WKV_TR(tk[m], aK); WKV_TR(tv[m], aV);
            }
            asm volatile("s_waitcnt lgkmcnt(0)" ::: "memory"); __builtin_amdgcn_sched_barrier(0);
#pragma unroll
            for (int m = 0; m < 4; ++m) {
                const f32x4 d = __builtin_amdgcn_mfma_f32_16x16x32_bf16(frag4(ta[m]), xB, z4, 0, 0, 0);
                *(u32x2*)(rec + R_A2 + (c16 * 64 + 16 * m + 4 * g4) * 2) = pack4(d);
            }
            const int kch = 16 * g4 + c16;
            *(u32x4*)(rec + R_BT + kch * 32) = (u32x4){tb[0].x, tb[0].y, tb[1].x, tb[1].y}; *(u32x4*)(rec + R_BT + kch * 32 + 16) = (u32x4){tb[2].x, tb[2].y, tb[3].x, tb[3].y};
            *(u32x4*)(rec + R_KT + kch * 32) = (u32x4){tk[0].x, tk[0].y, tk[1].x, tk[1].y}; *(u32x4*)(rec + R_KT + kch * 32 + 16) = (u32x4){tk[2].x, tk[2].y, tk[3].x, tk[3].y};
            *(u32x4*)(rec + R_VT + kch * 32) = (u32x4){tv[0].x, tv[0].y, tv[1].x, tv[1].y}; *(u32x4*)(rec + R_VT + kch * 32 + 16) = (u32x4){tv[2].x, tv[2].y, tv[3].x, tv[3].y};
        }
        { const int row = lane >> 2, cb = (lane & 3) * 16;
          const u32x4 r0 = *(const LAS u32x4*)(Lrt + row * RS + cb * 2), r1 = *(const LAS u32x4*)(Lrt + row * RS + cb * 2 + 16);
          *(u32x4*)(rec + R_RT + (row * 64 + cb) * 2) = r0; *(u32x4*)(rec + R_RT + (row * 64 + cb) * 2 + 16) = r1; }
        asm volatile("s_waitcnt lgkmcnt(0)" ::: "memory");
    }
#undef UNPK16
#undef PK16ST
}
constexpr int WKV_D = 6, WKV_R = WKV_D + 2;
__device__ __forceinline__ void ph_wkv_scan(const Args& A, LAS unsigned char* lds, int bid, int nb) {
    unsigned char* ws = opq(A.ws);
    const int tid = tid_opaque(), lane = tid & 63, wid = __builtin_amdgcn_readfirstlane(tid >> 6), c16 = lane & 15, g4 = lane >> 4;
    float* YS = (float*)(ws + WS_YS); const size_t FS = (size_t)NTOK * 512;
    for (int inst = bid; inst < 256; inst += nb) {
        const int dir = inst & 1, h = (inst >> 1) & 7, b = inst >> 4;
        const unsigned char* rec0 = ws + WS_WKV + (size_t)inst * WKV_NCH * WKV_REC;
        asm volatile("s_waitcnt vmcnt(0) lgkmcnt(0)" ::: "memory"); __builtin_amdgcn_s_barrier();
        if (wid >= 4) {
            const int p0 = 3 * (wid - 4);
#define WKV_ISSUE(c_) do { const unsigned char* src_ = rec0 + (size_t)(c_) * WKV_REC + p0 * 1024 + lane * 16; LAS unsigned char* dst_ = lds + ((c_) % WKV_R) * WKV_REC + p0 * 1024; \
        _Pragma("unroll") for (int i_ = 0; i_ < 3; ++i_) __builtin_amdgcn_global_load_lds((const unsigned*)(src_ + i_ * 1024), (LAS unsigned*)(dst_ + i_ * 1024), 16, 0, 0); } while (0)
            for (int c = 0; c < WKV_D; ++c) WKV_ISSUE(c);
            for (int c = 0; c < WKV_NCH; ++c) {
                if (c + WKV_D < WKV_NCH) { WKV_ISSUE(c + WKV_D); asm volatile("s_waitcnt vmcnt(18)" ::: "memory"); }
                else asm volatile("s_waitcnt vmcnt(0)" ::: "memory");
                __builtin_amdgcn_s_barrier();
            }
#undef WKV_ISSUE
        } else {
            const int v0 = wid * 16;
            float* Y = YS + dir * FS + h * 64 + v0 + c16;
            f32x4 S[4];
#pragma unroll
            for (int mt = 0; mt < 4; ++mt) S[mt] = (f32x4){0.f, 0.f, 0.f, 0.f};
            for (int c = 0; c < WKV_NCH; ++c) {
                __builtin_amdgcn_s_barrier();
                const LAS unsigned char* rec = lds + (c % WKV_R) * WKV_REC;
                u32x2 a2[4], rt[4], bt[4], kt[4]; f32x4 p[4];
#pragma unroll
                for (int q = 0; q < 4; ++q) {
                    a2[q] = *(const LAS u32x2*)(rec + R_A2 + (c16 * 64 + 16 * q + 4 * g4) * 2);
                    rt[q] = *(const LAS u32x2*)(rec + R_RT + (c16 * 64 + 16 * q + 4 * g4) * 2);
                    bt[q] = *(const LAS u32x2*)(rec + R_BT + ((16 * q + c16) * 16 + 4 * g4) * 2);
                    kt[q] = *(const LAS u32x2*)(rec + R_KT + ((16 * q + c16) * 16 + 4 * g4) * 2);
                    p[q] = *(const LAS f32x4*)(rec + R_P + (16 * q + 4 * g4) * 4);
                }
                const u32x2 gq = *(const LAS u32x2*)(rec + R_G + (c16 * 16 + 4 * g4) * 2), mkr = *(const LAS u32x2*)(rec + R_MKR + (c16 * 16 + 4 * g4) * 2), mbr = *(const LAS u32x2*)(rec + R_MBR + (c16 * 16 + 4 * g4) * 2);
                const u32x2 vt = *(const LAS u32x2*)(rec + R_VT + ((v0 + c16) * 16 + 4 * g4) * 2);
                const f32x4 z4 = {0.f, 0.f, 0.f, 0.f};
                const bf16x8 sb0 = frag8(pack4(S[0]), pack4(S[1])), sb1 = frag8(pack4(S[2]), pack4(S[3]));
                const bf16x8 vb = frag4(vt);
                f32x4 U = __builtin_amdgcn_mfma_f32_16x16x32_bf16(frag4(gq), vb, z4, 0, 0, 0);
                U = __builtin_amdgcn_mfma_f32_16x16x32_bf16(frag8(a2[0], a2[1]), sb0, U, 0, 0, 0);
                U = __builtin_amdgcn_mfma_f32_16x16x32_bf16(frag8(a2[2], a2[3]), sb1, U, 0, 0, 0);
                f32x4 Yt = __builtin_amdgcn_mfma_f32_16x16x32_bf16(frag4(mkr), vb, z4, 0, 0, 0);
                Yt = __builtin_amdgcn_mfma_f32_16x16x32_bf16(frag8(rt[0], rt[1]), sb0, Yt, 0, 0, 0);
                Yt = __builtin_amdgcn_mfma_f32_16x16x32_bf16(frag8(rt[2], rt[3]), sb1, Yt, 0, 0, 0);
                const bf16x8 ub = frag4(pack4(U));
                Yt = __builtin_amdgcn_mfma_f32_16x16x32_bf16(frag4(mbr), ub, Yt, 0, 0, 0);
#pragma unroll
                for (int mt = 0; mt < 4; ++mt) {
                    f32x4 sn = __builtin_amdgcn_mfma_f32_16x16x32_bf16(frag4(kt[mt]), vb, S[mt], 0, 0, 0);
                    sn = __builtin_amdgcn_mfma_f32_16x16x32_bf16(frag4(bt[mt]), ub, sn, 0, 0, 0);
                    S[mt] = sn * p[mt];
                }
#pragma unroll
                for (int r = 0; r < 4; ++r) Y[(size_t)wkv_token(b, dir, c * 16 + 4 * g4 + r) * 512] = Yt[r];
            }
        }
    }
}

__device__ __forceinline__ void ph_qk(const Args& A, int j, int row_lo, int bid, int nb) {
    unsigned char* ws = opq(A.ws); const float* const* IN = (const float* const*)(ws + WS_PTRS);
    const int tid = tid_opaque(), lane = tid & 63, wid = tid >> 6;
    const bf16_t* Z = (const bf16_t*)(ws + WS_Z);
    bf16_t* QB = (bf16_t*)(ws + WS_QB); bf16_t* KB = (bf16_t*)(ws + WS_KB); bf16_t* VB = (bf16_t*)(ws + WS_VB);
    const int d0 = (lane & 7) * 8;
    float qn[8], kn[8], invf[8];
#pragma unroll
    for (int i = 0; i < 8; ++i) { qn[i] = INP(I_QN)[j * 64 + d0 + i]; kn[i] = INP(I_KN)[j * 64 + d0 + i]; invf[i] = __powf(10000.0f, -(float)((d0 + i) & 15) / 16.0f); }
    const bool upper = (d0 & 16) != 0, colaxis = (d0 & 32) != 0;
    for (int g = row_lo + bid * NWAVES + wid; g < NTOK; g += nb * NWAVES) {
        const Tok tk = tokinfo(g);
        const size_t krow = (size_t)tk.b * (TC + TL) + (tk.T == TL ? TC + tk.t : tk.t);
        const bf16_t* zr = Z + (size_t)g * ZLD + RWC;
        *(u32x4*)(VB + krow * 512 + lane * 8) = *(const u32x4*)(zr + 1024 + lane * 8);
        float cs[8], sn[8];
        if (tk.T == TL) {
            const float pos = (float)(colaxis ? (tk.t & 63) : (tk.t >> 6));
#pragma unroll
            for (int i = 0; i < 8; ++i) __sincosf(pos * invf[i], &sn[i], &cs[i]);
        }
#pragma unroll
        for (int isk = 0; isk < 2; ++isk) {
            const u32x4 raw = *(const u32x4*)(zr + isk * 512 + lane * 8);
            float x[8];
#pragma unroll
            for (int i = 0; i < 4; ++i) { x[2 * i] = __builtin_bit_cast(float, raw[i] << 16); x[2 * i + 1] = __builtin_bit_cast(float, raw[i] & 0xffff0000u); }
            float ss = 0.f;
#pragma unroll
            for (int i = 0; i < 8; ++i) ss += x[i] * x[i];
            ss += __shfl_xor(ss, 1); ss += __shfl_xor(ss, 2); ss += __shfl_xor(ss, 4);
            const float rs = rsqrtf(ss * (1.0f / 64.0f) + 1e-6f);
#pragma unroll
            for (int i = 0; i < 8; ++i) x[i] = x[i] * rs * (isk ? kn[i] : qn[i] * att::QSCALE);
            if (tk.T == TL) {
#pragma unroll
                for (int i = 0; i < 8; ++i) { const float other = __shfl_xor(x[i], 2); x[i] = upper ? (x[i] * cs[i] + other * sn[i]) : (x[i] * cs[i] - other * sn[i]); }
            }
            u32x4 o; o.x = pk2(x[0], x[1]); o.y = pk2(x[2], x[3]); o.z = pk2(x[4], x[5]); o.w = pk2(x[6], x[7]);
            if (isk) *(u32x4*)(KB + krow * 512 + lane * 8) = o; else *(u32x4*)(QB + (size_t)g * 512 + lane * 8) = o;
        }
    }
}

__device__ __forceinline__ void ph_attn(const Args& A, bool want_ctx, LAS unsigned char* lds, int bid, int nb) {
    unsigned char* ws = opq(A.ws);
    const bf16_t* QB = (const bf16_t*)(ws + WS_QB); const bf16_t* KB = (const bf16_t*)(ws + WS_KB); const bf16_t* VB = (const bf16_t*)(ws + WS_VB);
    float* OP = (float*)(ws + WS_OP);
    const int vcu = (nb % 8 == 0) ? (bid % 8) * (nb / 8) + bid / 8 : bid;
    const int nunits = 1024 + (want_ctx ? 128 : 0);
    for (int u = vcu; u < nunits; u += nb) {
        int b, h, m, q0, seq;
        if (u < 1024) { const int qb = u & 7; m = (u >> 3) & 1; h = (u >> 4) & 3; b = u >> 6; q0 = NCTX + b * TL + qb * 256; seq = TC + TL; }
        else { const int v = u - 1024; m = v & 1; h = (v >> 1) & 3; b = v >> 3; q0 = b * TC; seq = TC; }
        const int s = h * 2 + m;
        att::attn_body(QB + (size_t)q0 * 512 + s * 64, KB + (size_t)b * (TC + TL) * 512 + s * 64, VB + (size_t)b * (TC + TL) * 512 + h * 128,
                       OP + (size_t)m * NTOK * 512 + (size_t)q0 * 512 + h * 128, seq, lds);
    }
}

__device__ __forceinline__ void ph_merge(const Args& A, int l, int row_lo, int bid, int nb) {
    unsigned char* ws = opq(A.ws); const float* const* IN = (const float* const*)(ws + WS_PTRS);
    const int j = l >> 1;
    const int tid = tid_opaque(), lane = tid & 63, wid = tid >> 6, c0 = lane * 8;
    const float lam_init = 0.8f - 0.6f * __expf(-0.3f * (float)l);
    const float* lp = INP(I_LAM) + j * 4 * 64;
    const float lam = __expf(wave_sum(lp[lane] * lp[64 + lane])) - __expf(wave_sum(lp[128 + lane] * lp[192 + lane])) + lam_init;
    const size_t FS = (size_t)NTOK * 512;
    const bf16_t* RB = (const bf16_t*)(ws + WS_RB); const bf16_t* KS = (const bf16_t*)(ws + WS_KS); const bf16_t* VS = (const bf16_t*)(ws + WS_VS);
    const bf16_t* AB = (const bf16_t*)(ws + WS_AB); const bf16_t* GB = (const bf16_t*)(ws + WS_GB);
    const float* YS = (const float*)(ws + WS_YS); const float* OP = (const float*)(ws + WS_OP);
    bf16_t* CAT = (bf16_t*)(ws + WS_CAT);
    float gnw[8], gnb[8], kaw[8], rkw[8], sub[8];
#pragma unroll
    for (int i = 0; i < 8; ++i) { gnw[i] = INP(I_GNW)[j * 512 + c0 + i]; gnb[i] = INP(I_GNB)[j * 512 + c0 + i]; kaw[i] = INP(I_RWKA)[j * 512 + c0 + i]; rkw[i] = INP(I_RWRK)[j * 512 + c0 + i];
        sub[i] = INP(I_SUBLN)[j * 128 + ((c0 + i) & 127)] * (1.0f - lam_init); }
#define LD8BF(dst, ptr) do { const u32x4 _t = *(const u32x4*)(ptr); _Pragma("unroll") for (int _i = 0; _i < 4; ++_i) { dst[2 * _i] = __builtin_bit_cast(float, _t[_i] << 16); dst[2 * _i + 1] = __builtin_bit_cast(float, _t[_i] & 0xffff0000u); } } while (0)
    for (int g = row_lo + bid * NWAVES + wid; g < NTOK; g += nb * NWAVES) {
        const size_t o = (size_t)g * 512 + c0;
        float y[8], r_[8], k_[8], v_[8], a0[8], a1[8], gg[8];
        { const f32x4 y0 = *(const f32x4*)(YS + o), y1 = *(const f32x4*)(YS + o + 4), z0 = *(const f32x4*)(YS + FS + o), z1 = *(const f32x4*)(YS + FS + o + 4);
#pragma unroll
          for (int i = 0; i < 4; ++i) { y[i] = y0[i] + z0[i]; y[4 + i] = y1[i] + z1[i]; } }
        LD8BF(r_, RB + o); LD8BF(k_, KS + o); LD8BF(v_, VS + o); LD8BF(a0, AB + o); LD8BF(a1, AB + FS + o); LD8BF(gg, GB + o);
        float sy = 0.f, sb = 0.f;
#pragma unroll
        for (int i = 0; i < 8; ++i) { sy += y[i]; sb += r_[i] * k_[i] * (2.0f + (a0[i] + a1[i] - 2.0f) * kaw[i]) * rkw[i]; }
        sy += __shfl_xor(sy, 1); sy += __shfl_xor(sy, 2); sy += __shfl_xor(sy, 4);
        sb += __shfl_xor(sb, 1); sb += __shfl_xor(sb, 2); sb += __shfl_xor(sb, 4);
        const float mu = sy * (1.0f / 64.0f);
        float sv = 0.f;
#pragma unroll
        for (int i = 0; i < 8; ++i) { y[i] -= mu; sv += y[i] * y[i]; }
        sv += __shfl_xor(sv, 1); sv += __shfl_xor(sv, 2); sv += __shfl_xor(sv, 4);
        const float rstd = rsqrtf(sv * (1.0f / 64.0f) + 64e-5f);
        float ya[8];
#pragma unroll
        for (int i = 0; i < 8; ++i) ya[i] = (y[i] * rstd * gnw[i] + gnb[i] + sb * v_[i]) * gg[i];
        { u32x4 w; w.x = pk2(ya[0], ya[1]); w.y = pk2(ya[2], ya[3]); w.z = pk2(ya[4], ya[5]); w.w = pk2(ya[6], ya[7]); *(u32x4*)(CAT + (size_t)g * DM + c0) = w; }
        float od[8];
        { const f32x4 p0 = *(const f32x4*)(OP + o), p1 = *(const f32x4*)(OP + o + 4), q0 = *(const f32x4*)(OP + FS + o), q1 = *(const f32x4*)(OP + FS + o + 4);
#pragma unroll
          for (int i = 0; i < 4; ++i) { od[i] = p0[i] - lam * q0[i]; od[4 + i] = p1[i] - lam * q1[i]; } }
        float so = 0.f;
#pragma unroll
        for (int i = 0; i < 8; ++i) so += od[i] * od[i];
        so += __shfl_xor(so, 1); so += __shfl_xor(so, 2); so += __shfl_xor(so, 4); so += __shfl_xor(so, 8);
        const float ro = rsqrtf(so * (1.0f / 128.0f) + 1e-6f);
        { u32x4 w; w.x = pk2(od[0] * ro * sub[0], od[1] * ro * sub[1]); w.y = pk2(od[2] * ro * sub[2], od[3] * ro * sub[3]);
          w.z = pk2(od[4] * ro * sub[4], od[5] * ro * sub[5]); w.w = pk2(od[6] * ro * sub[6], od[7] * ro * sub[7]); *(u32x4*)(CAT + (size_t)g * DM + 512 + c0) = w; }
    }
#undef LD8BF
}

__device__ __forceinline__ void ph_gemm_out(const Args& A, int l, size_t x_off, size_t wt_off, int row_lo, LAS unsigned char* lds, int bid, int nb) {
    unsigned char* ws = opq(A.ws); const float* const* IN = (const float* const*)(ws + WS_PTRS); (void)IN;
    pg8::Gemm g{(const bf16_t*)(ws + x_off) + (size_t)row_lo * DM, (const bf16_t*)(ws + wt_off), NTOK - row_lo, DM, DM};
    const ListOrder S = build_units(lds, (NTOK - row_lo) / 256, DM / 256, nb, bid, nullptr, 0);
    EpiResidual E{(float*)(ws + WS_H) + (size_t)row_lo * DM, (const float*)(ws + WS_MOD) + (size_t)l * 17 * 6144 + 2 * 1024, row_lo};
    pg8::gemm_phase<EpiResidual, ListOrder, true, true>(lds, g, S, E);
}

__device__ __forceinline__ void ph_gemm_sgin(const Args& A, int j, int row_lo, LAS unsigned char* lds, int bid, int nb) {
    unsigned char* ws = opq(A.ws); const float* const* IN = (const float* const*)(ws + WS_PTRS); (void)IN;
    pg8::Gemm g{(const bf16_t*)(ws + WS_ABF) + (size_t)row_lo * DM, (const bf16_t*)(ws + WS_SGIN) + (size_t)j * 2048 * DM, NTOK - row_lo, 2048, DM};
    const ListOrder S = build_units(lds, (NTOK - row_lo) / 256, 2048 / 256, nb, bid, nullptr, 0);
    EpiGeluBf16 E{(bf16_t*)(ws + WS_Z2) + (size_t)row_lo * 2048, 2048, INP(I_SGBIN) + j * 2048};
    pg8::gemm_phase<EpiGeluBf16, ListOrder, true, true>(lds, g, S, E);
}
__device__ __forceinline__ void ph_sgu_stats(const Args& A, int row_lo, int bid, int nb) {
    unsigned char* ws = opq(A.ws);
    const int tid = tid_opaque(), lane = tid & 63, wid = tid >> 6;
    const bf16_t* Z2 = (const bf16_t*)(ws + WS_Z2); float* ST = (float*)(ws + WS_VST);
    for (int row = row_lo + bid * NWAVES + wid; row < NTOK; row += nb * NWAVES) {
        const u32x4 t0 = *(const u32x4*)(Z2 + (size_t)row * 2048 + 1024 + lane * 8), t1 = *(const u32x4*)(Z2 + (size_t)row * 2048 + 1536 + lane * 8);
        float v[16]; float s = 0.f;
#pragma unroll
        for (int i = 0; i < 4; ++i) { v[2 * i] = __builtin_bit_cast(float, t0[i] << 16); v[2 * i + 1] = __builtin_bit_cast(float, t0[i] & 0xffff0000u);
            v[8 + 2 * i] = __builtin_bit_cast(float, t1[i] << 16); v[9 + 2 * i] = __builtin_bit_cast(float, t1[i] & 0xffff0000u); }
#pragma unroll
        for (int i = 0; i < 16; ++i) s += v[i];
        const float mean = wave_sum(s) * (1.0f / 1024.0f); float s2 = 0.f;
#pragma unroll
        for (int i = 0; i < 16; ++i) { const float d = v[i] - mean; s2 += d * d; }
        const float rstd = rsqrtf(wave_sum(s2) * (1.0f / 1024.0f) + 1e-5f);
        if (lane == 0) { ST[(size_t)row * 2] = mean; ST[(size_t)row * 2 + 1] = rstd; }
    }
}
__device__ __forceinline__ void ph_sgu_spatial(const Args& A, int j, int row_lo, LAS unsigned char* lds, int bid, int nb) {
    unsigned char* ws = opq(A.ws); const float* const* IN = (const float* const*)(ws + WS_PTRS);
    const int tid = tid_opaque(), lane = tid & 63, wid = tid >> 6, c16 = lane & 15, g4 = lane >> 4;
    const bf16_t* Z2 = (const bf16_t*)(ws + WS_Z2); const float* ST = (const float*)(ws + WS_VST); bf16_t* G = (bf16_t*)(ws + WS_G);
    constexpr int VS = 272;
    LAS unsigned char* vt = lds;
    LAS float* stl = (LAS float*)(lds + 36864);
    const int ch0 = row_lo / 128, nch = NTOK / 128 - ch0;
    for (int u = bid; u < nch * 8; u += nb) {
        const int ci = ch0 + u / 8, g = u % 8;
        const size_t r0 = (size_t)ci * 128;
        __syncthreads();
#pragma unroll
        for (int i = 0; i < 4; ++i) {
            const int idx = tid + NTHREADS * i, q = idx >> 4, jc = idx & 15;
            const u32x4 t = *(const u32x4*)(Z2 + (r0 + q) * 2048 + 1024 + g * 128 + jc * 8);
#pragma unroll
            for (int e = 0; e < 4; ++e) { *(LAS bf16_t*)(vt + (jc * 8 + 2 * e) * VS + q * 2) = (bf16_t)(t[e] & 0xffffu); *(LAS bf16_t*)(vt + (jc * 8 + 2 * e + 1) * VS + q * 2) = (bf16_t)(t[e] >> 16); }
        }
        if (tid < 256) stl[tid] = ST[r0 * 2 + tid];
        __syncthreads();
        const float* wrow = INP(I_SGWS) + (((size_t)j * 8 + g) * 128 + 16 * wid + c16) * 128;
        bf16x8 af[4]; float wm = 0.f, rs = 0.f;
#pragma unroll
        for (int ks = 0; ks < 4; ++ks) {
            const int q0 = 32 * ks + 8 * g4;
            const f32x4 w0 = *(const f32x4*)(wrow + q0), w1 = *(const f32x4*)(wrow + q0 + 4);
            float wv[8] = {w0[0], w0[1], w0[2], w0[3], w1[0], w1[1], w1[2], w1[3]};
#pragma unroll
            for (int e = 0; e < 8; ++e) { rs += wv[e]; wv[e] *= stl[(q0 + e) * 2 + 1]; wm += wv[e] * stl[(q0 + e) * 2]; }
            const u32x4 pk = {pk2(wv[0], wv[1]), pk2(wv[2], wv[3]), pk2(wv[4], wv[5]), pk2(wv[6], wv[7])};
            af[ks] = __builtin_bit_cast(bf16x8, pk);
        }
        wm += __shfl_xor(wm, 16); wm += __shfl_xor(wm, 32); rs += __shfl_xor(rs, 16); rs += __shfl_xor(rs, 32);
        f32x4 acc[8];
#pragma unroll
        for (int nt = 0; nt < 8; ++nt) acc[nt] = (f32x4){0.f, 0.f, 0.f, 0.f};
#pragma unroll
        for (int ks = 0; ks < 4; ++ks)
#pragma unroll
            for (int nt = 0; nt < 8; ++nt) {
                const bf16x8 bfr = *(const LAS bf16x8*)(vt + (16 * nt + c16) * VS + (32 * ks + 8 * g4) * 2);
                acc[nt] = __builtin_amdgcn_mfma_f32_16x16x32_bf16(af[ks], bfr, acc[nt], 0, 0, 0);
            }
        float wmr[4], rsr[4], bsr[4];
#pragma unroll
        for (int r = 0; r < 4; ++r) { wmr[r] = __shfl(wm, 4 * g4 + r); rsr[r] = __shfl(rs, 4 * g4 + r); bsr[r] = INP(I_SGBS)[((size_t)j * 8 + g) * 128 + 16 * wid + 4 * g4 + r]; }
#pragma unroll
        for (int nt = 0; nt < 8; ++nt) {
            const int c = g * 128 + 16 * nt + c16;
            const float lg = INP(I_SGLNG)[j * 1024 + c], lb = INP(I_SGLNB)[j * 1024 + c];
#pragma unroll
            for (int r = 0; r < 4; ++r) {
                const size_t row = r0 + 16 * wid + 4 * g4 + r;
                const float sv = lg * (acc[nt][r] - wmr[r]) + rsr[r] * lb + bsr[r];
                G[row * DM + c] = (bf16_t)f2bf(bf2f(Z2[row * 2048 + c]) * sv);
            }
        }
    }
}

__device__ __forceinline__ int moe_layout(const Args& A, int l, int bid, int nb, LAS int* off  , LAS int* cntl  , LAS int* tile_e  , LAS int* base  ) {
    const int tid = tid_opaque();
    const int* bc = (const int*)(opq(A.ws) + WS_BCNT) + (size_t)l * 256 * 32;
    if (tid < 64) {
        int n = 0, pre = 0;
        if (tid < 32) {
#pragma unroll 8
            for (int b = 0; b < nb; ++b) { const int c = bc[b * 32 + tid]; n += c; pre += (b < bid) ? c : 0; }
        }
        const int nt = (n + 255) >> 8;
        int x = nt;
#pragma unroll
        for (int o = 1; o < 32; o <<= 1) { const int y = __shfl_up(x, o); if (tid >= o) x += y; }
        const int start = x - nt;
        if (tid < 32) {
            cntl[tid] = n; off[tid] = start * 256; base[tid] = start * 256 + pre;
#pragma unroll 1
            for (int t = 0; t < nt; ++t) tile_e[start + t] = tid;
        }
        if (tid == 31) off[32] = x * 256;
    }
    __syncthreads();
    return off[32] >> 8;
}
__device__ __forceinline__ void ph_moe_scatter(const Args& A, int l, int row_lo, LAS unsigned char* lds, int bid, int nb) {
    unsigned char* ws = opq(A.ws);
    const int tid = tid_opaque();
    LAS int* off = (LAS int*)(lds + LDS_TAB); LAS int* cntl = off + 64; LAS int* tile_e = off + 128; LAS int* base = off + 800;
    moe_layout(A, l, bid, nb, off, cntl, tile_e, base);
    const int* te = (const int*)(ws + WS_TOKE); const int* tr = (const int*)(ws + WS_TOKR); int* rowof = (int*)(ws + WS_ROWOF); int* srcrow = (int*)(ws + WS_SRCROW);
    const int ngroups = (NTOK - row_lo) / 16, per = nb * NWAVES;
    const int nmine = (ngroups - bid * NWAVES + per - 1) / per * NWAVES;
    for (int q = tid; q < nmine * 64; q += NTHREADS) {
        const int slot = q >> 6, r = (q >> 2) & 15, k = q & 3, i = slot >> 3, w = slot & 7;
        const int u = i * per + bid * NWAVES + w;
        if (u < ngroups) {
            const int row = row_lo + 16 * u + r;
            const int e = te[(size_t)row * 4 + k];
            const int pos = base[e] + tr[(size_t)row * 4 + k];
            rowof[(size_t)row * 4 + k] = pos; srcrow[pos] = row;
        }
    }
    for (int e = bid; e < 32; e += nb) {
        const int r0 = off[e] + cntl[e], r1 = off[e + 1];
        for (int i = r0 + tid; i < r1; i += NTHREADS) srcrow[i] = NCTX;
    }
}
__device__ __forceinline__ void ph_moe_gemm1(const Args& A, int l, LAS unsigned char* lds, int bid, int nb) {
    unsigned char* ws = opq(A.ws); const float* const* IN = (const float* const*)(ws + WS_PTRS); (void)IN;
    LAS int* off = (LAS int*)(lds + LDS_TAB); LAS int* cntl = off + 64; LAS int* tile_e = off + 128; LAS int* base = off + 800;
    const int T = moe_layout(A, l, bid, nb, off, cntl, tile_e, base);
    int Kq = DM / 2; asm volatile("" : "+s"(Kq));
    pg8::Gemm g{(const bf16_t*)(ws + WS_ABF), (const bf16_t*)(ws + WS_W1 + (size_t)l * NE * 2048 * DM), T * 256, 2048, Kq};
    const ListOrder S = build_units(lds, T, 8, nb, bid, tile_e, 8);
    { LAS unsigned* rowtab = (LAS unsigned*)(lds + LDS_ROWTAB); const int* srcrow = (const int*)(ws + WS_SRCROW); const int tid = tid_opaque();
      for (int q = tid; q < S.n * 256; q += NTHREADS) rowtab[q] = (unsigned)srcrow[S.list[2 * (q >> 8)] * 256 + (q & 255)] * (unsigned)DM;
      __syncthreads(); }
    EpiMoe1 E{(bf16_t*)(ws + WS_ACT), INP(I_B1) + (size_t)l * NE * 2048};
    pg8::gemm_phase<EpiMoe1, ListOrder, true, true, true, true>(lds, g, S, E);
}
__device__ __forceinline__ void ph_moe_gemm2(const Args& A, int l, LAS unsigned char* lds, int bid, int nb) {
    unsigned char* ws = opq(A.ws); const float* const* IN = (const float* const*)(ws + WS_PTRS); (void)IN;
    LAS int* off = (LAS int*)(lds + LDS_TAB); LAS int* cntl = off + 64; LAS int* tile_e = off + 128; LAS int* base = off + 800;
    const int T = moe_layout(A, l, bid, nb, off, cntl, tile_e, base);
    int Kq = DM / 2; asm volatile("" : "+s"(Kq));
    pg8::Gemm g{(const bf16_t*)(ws + WS_ACT), (const bf16_t*)(ws + WS_W2 + (size_t)l * NE * DM * DM), T * 256, DM, Kq, 0x77777777, 0x7d7d7d7d};
    const ListOrder S = build_units(lds, T, 4, nb, bid, tile_e, 4);
    EpiMoe2 E{(bf16_t*)(ws + WS_YM), INP(I_B2) + (size_t)l * NE * DM};
    pg8::gemm_phase<EpiMoe2, ListOrder, true, true, false, true>(lds, g, S, E);
}
__device__ __forceinline__ void ph_moe_combine(const Args& A, int l, int row_lo, bool last, int bid, int nb, bool dry = false) {
    unsigned char* ws = opq(A.ws); const float* const* IN = (const float* const*)(ws + WS_PTRS);
    const int tid = tid_opaque(), lane = tid & 63, wid = tid >> 6;
    float* H = (float*)(ws + WS_H); const float* mod = (const float*)(ws + WS_MOD); const bf16_t* YM = (const bf16_t*)(ws + WS_YM);
    float* Hw = dry ? (float*)(ws + WS_XP) : H;
    const int* rowof = (const int*)(ws + WS_ROWOF); const float* tg = (const float*)(ws + WS_TOKG);
    bf16_t* abf = dry ? (bf16_t*)(ws + WS_XP + (size_t)NTOK * DM * 4) : (bf16_t*)(ws + WS_ABF);
    const int ln = last ? l : l + 1;
    const float* gp = INP(I_N1G) + ln * 1024;
    for (int row = row_lo + bid * NWAVES + wid; row < NTOK; row += nb * NWAVES) {
        const Tok tk = tokinfo(row);
        const float* gate = mod + ((size_t)l * 17 + tk.modrow) * 6144 + 5 * 1024;
        int r[4]; float gk[4];
#pragma unroll
        for (int k = 0; k < 4; ++k) { r[k] = rowof[(size_t)row * 4 + k]; gk[k] = tg[(size_t)row * 4 + k]; }
        f32x4 hv[4]; float ss = 0.f;
#pragma unroll
        for (int q = 0; q < 4; ++q) {
            const int col = q * 256 + lane * 4;
            f32x4 m = (f32x4){0.f, 0.f, 0.f, 0.f};
#pragma unroll
            for (int k = 0; k < 4; ++k) { const u32x2 t = *(const u32x2*)(YM + (size_t)r[k] * DM + col);
                m = m + (f32x4){__builtin_bit_cast(float, t.x << 16), __builtin_bit_cast(float, t.x & 0xffff0000u), __builtin_bit_cast(float, t.y << 16), __builtin_bit_cast(float, t.y & 0xffff0000u)} * gk[k]; }
            hv[q] = *(const f32x4*)(H + (size_t)row * DM + col) + *(const f32x4*)(gate + col) * m;
            if (last && !dry) *(f32x4*)(as_global(((float* const*)IN)[38]) + (size_t)(row - NCTX) * DM + col) = hv[q];
            else *(f32x4*)(Hw + (size_t)row * DM + col) = hv[q];
            ss += (hv[q].x * hv[q].x + hv[q].y * hv[q].y) + (hv[q].z * hv[q].z + hv[q].w * hv[q].w);
        }
        if (!last) {
            const float rstd = rsqrtf(wave_sum(ss) * (1.0f / DM) + 1e-6f);
            const float* mrow = mod + ((size_t)ln * 17 + tk.modrow) * 6144;
#pragma unroll
            for (int q = 0; q < 4; ++q) {
                const int col = q * 256 + lane * 4;
                const f32x4 g = *(const f32x4*)(gp + col), sc = *(const f32x4*)(mrow + 1024 + col), sh = *(const f32x4*)(mrow + col);
                const f32x4 v = (hv[q] * rstd * g) * (sc + 1.0f) + sh;
                u32x2 o; o.x = pk2(v.x, v.y); o.y = pk2(v.z, v.w);
                *(u32x2*)(abf + (size_t)row * DM + col) = o;
            }
        }
    }
}

__global__ void __launch_bounds__(NTHREADS, 2) fwd_kernel(Args A) {
    extern __shared__ __attribute__((aligned(16))) unsigned char lds_raw[];
    LAS unsigned char* lds = (LAS unsigned char*)lds_raw;
    volatile LAS unsigned* misc = (volatile LAS unsigned*)(lds + LDS_MISC);
    const int tid = threadIdx.x, bid = blockIdx.x, nb = gridDim.x;
    if (tid < 64) misc[tid] = 0u;
    __syncthreads();
    XcdBarrier bar = xcd_barrier_post((unsigned*)(A.ws + WS_CTL) + CW_BAR, misc + 8);
    const int lo = A.ph_lo, hi = A.ph_hi;
    int pc = 0;
#ifndef PHSEL
#define PHSEL -1
#endif
#define SEL(k) (PHSEL < 0 || PHSEL == (k))
#ifndef REPEAT_MASK
#define REPEAT_MASK 0
#endif
#define RUN(k, call) do { if (SEL(k)) { call; if ((REPEAT_MASK >> (k)) & 1) { xcd_barrier(bar); call; } } } while (0)
#define PH_BEGIN if (pc >= lo && pc < hi) {
#define PH_END } if (pc >= lo && pc + 1 < hi) xcd_barrier(bar); ++pc;

    PH_BEGIN RUN(0, ph_prologue(A, lds, bid, nb)); PH_END

    for (int l = 0; l < 4; ++l) {
        const int j = l >> 1;
        const bool ctx_out = (l < 2), ctx_in = (l < 3);
        const int rin = ctx_in ? 0 : NCTX, rout = ctx_out ? 0 : NCTX;
        if (l == 0) { PH_BEGIN RUN(1, ph_norm<false>(A, l, rin, lds, bid, nb)); PH_END }
        if ((l & 1) == 0) {
            PH_BEGIN RUN(2, ph_gemm_win(A, j, rin, lds, bid, nb)); PH_END
            PH_BEGIN RUN(3, ph_rwkv_pre(A, j, rin, bid, nb)); RUN(4, ph_qk(A, j, rin, bid, nb)); PH_END
            PH_BEGIN RUN(19, ph_gemm_lora(A, j, rin, lds, bid, nb)); PH_END
            PH_BEGIN RUN(18, ph_wkv_prep(A, j, lds, bid, nb)); PH_END
            PH_BEGIN RUN(5, ph_wkv_scan(A, lds, bid, nb)); PH_END
            PH_BEGIN RUN(6, ph_attn(A, ctx_out, lds, bid, nb)); PH_END
            PH_BEGIN RUN(7, ph_merge(A, l, rout, bid, nb)); PH_END
            PH_BEGIN RUN(8, ph_gemm_out(A, l, WS_CAT, WS_WOUT + (size_t)j * DM * DM * 2, rout, lds, bid, nb)); PH_END
        } else {
            PH_BEGIN RUN(9, ph_gemm_sgin(A, j, rin, lds, bid, nb)); PH_END
            PH_BEGIN RUN(10, ph_sgu_stats(A, rin, bid, nb)); PH_END
            PH_BEGIN RUN(11, ph_sgu_spatial(A, j, rout, lds, bid, nb)); PH_END
            PH_BEGIN RUN(12, ph_gemm_out(A, l, WS_G, WS_SGOUT + (size_t)j * DM * DM * 2, rout, lds, bid, nb)); PH_END
        }
        PH_BEGIN RUN(13, ph_norm2_router(A, l, rout, lds, bid, nb)); PH_END
        PH_BEGIN RUN(14, ph_moe_scatter(A, l, rout, lds, bid, nb)); PH_END
        PH_BEGIN RUN(15, ph_moe_gemm1(A, l, lds, bid, nb)); PH_END
        PH_BEGIN RUN(16, ph_moe_gemm2(A, l, lds, bid, nb)); PH_END
        PH_BEGIN if (SEL(17)) { if ((REPEAT_MASK >> 17) & 1) { ph_moe_combine(A, l, rout, l == 3, bid, nb, true); xcd_barrier(bar); } ph_moe_combine(A, l, rout, l == 3, bid, nb); } PH_END
    }
}

extern "C" void kernel_launch(void* const* d_in, const int* in_sizes, int n_in, void* d_out, int out_size, void* d_ws, size_t ws_size, hipStream_t stream) {
    static int grid = 0;
    if (grid == 0) {
        if (n_in != 38 || out_size != NLAT * DM || ws_size < WS_END) { fprintf(stderr, "kernel_launch: unexpected shapes: n_in %d out %d ws %zu (need %zu)\n", n_in, out_size, ws_size, (size_t)WS_END); grid = -1; return; }
        int dev = 0, cus = 0, per_cu = 0;
        if (hipGetDevice(&dev) != hipSuccess || hipDeviceGetAttribute(&cus, hipDeviceAttributeMultiprocessorCount, dev) != hipSuccess) { grid = -1; return; }
        if (hipFuncSetAttribute((const void*)fwd_kernel, hipFuncAttributeMaxDynamicSharedMemorySize, LDS_BYTES) != hipSuccess) { fprintf(stderr, "kernel_launch: hipFuncSetAttribute failed\n"); grid = -1; return; }
        if (hipOccupancyMaxActiveBlocksPerMultiprocessor(&per_cu, (const void*)fwd_kernel, NTHREADS, LDS_BYTES) != hipSuccess || per_cu < 1)
            fprintf(stderr, "kernel_launch: occupancy query reports %d workgroups per CU\n", per_cu);
        (void)hipGetLastError();
        grid = cus;
    }
    if (grid < 0) return;
    if (hipMemsetAsync((char*)d_ws + WS_CTL, 0, CTL_ZERO_BYTES, stream) != hipSuccess) { fprintf(stderr, "kernel_launch: memset failed\n"); return; }
    Args a{};
    for (int i = 0; i < 38; ++i) a.in[i] = (const float*)d_in[i];
    a.out = (float*)d_out; a.ws = (unsigned char*)d_ws; a.ph_lo = 0; a.ph_hi = 1 << 20;
    hipLaunchKernelGGL(fwd_kernel, dim3(grid), dim3(NTHREADS), LDS_BYTES, stream, a);
    const hipError_t le = hipPeekAtLastError();
    if (le != hipSuccess) fprintf(stderr, "kernel_launch: launch failed: %s\n", hipGetErrorName(le));
}
```

```cpp
#include <hip/hip_runtime.h>
#include <cstdio>
#include <cstdint>

#define LAS __attribute__((address_space(3)))
typedef unsigned short bf16_t;
typedef short bf16x8 __attribute__((ext_vector_type(8)));
typedef float f32x4 __attribute__((ext_vector_type(4)));
typedef unsigned u32x4 __attribute__((ext_vector_type(4)));
typedef unsigned u32x2 __attribute__((ext_vector_type(2)));

constexpr int DM = 1024, NB = 16, TL = 2048, TC = 256;
constexpr int NCTX = NB * TC, NLAT = NB * TL, NTOK = NCTX + NLAT;
constexpr int RWC = 1920, EVC = 3456, ZLD = 3584;
constexpr int NE = 32;
constexpr int XPROWS = NTOK * 4 + NE * 256;
constexpr int NTHREADS = 512, NWAVES = 8;

constexpr size_t MiB = 1u << 20;
constexpr size_t al256(size_t x) { return (x + 255) & ~(size_t)255; }
constexpr size_t WS_CTL = 0, CTL_ZERO_BYTES = 1 * MiB - 4096;
constexpr size_t WS_PTRS = 1 * MiB - 4096;
constexpr size_t WS_MOD = 1 * MiB;
constexpr size_t WS_RTWT = al256(WS_MOD + (size_t)4 * 17 * 6144 * 4);
constexpr size_t WS_WIN = al256(WS_RTWT + (size_t)4 * 32 * 1024 * 4);
constexpr size_t WS_WOUT = al256(WS_WIN + (size_t)2 * ZLD * DM * 2);
constexpr size_t WS_SGIN = al256(WS_WOUT + (size_t)2 * DM * DM * 2);
constexpr size_t WS_SGOUT = al256(WS_SGIN + (size_t)2 * 2048 * DM * 2);
constexpr int LORA_N = 2560, LORA_K = 384;
constexpr size_t WS_WLORA = al256(WS_SGOUT + (size_t)2 * DM * DM * 2);
constexpr size_t WS_LBIAS = al256(WS_WLORA + (size_t)2 * LORA_N * LORA_K * 2);
constexpr size_t WS_W1 = al256(WS_LBIAS + (size_t)2 * LORA_N * 4);
constexpr size_t WS_W2 = al256(WS_W1 + (size_t)4 * NE * 2048 * DM * 2);
constexpr size_t WS_H = al256(WS_W2 + (size_t)4 * NE * DM * DM * 2);
constexpr size_t WS_ABF = al256(WS_H + (size_t)NTOK * DM * 4);
constexpr size_t WS_TOKE = al256(WS_ABF + (size_t)NTOK * DM * 2);
constexpr size_t WS_TOKG = al256(WS_TOKE + (size_t)NTOK * 4 * 4);
constexpr size_t WS_ROWOF = al256(WS_TOKG + (size_t)NTOK * 4 * 4);
constexpr size_t WS_TOKR = al256(WS_ROWOF + (size_t)NTOK * 4 * 4);
constexpr size_t WS_BCNT = al256(WS_TOKR + (size_t)NTOK * 4 * 4);
constexpr size_t WS_SRCROW = al256(WS_BCNT + (size_t)4 * 256 * 32 * 4);
constexpr size_t WS_R = al256(WS_SRCROW + (size_t)XPROWS * 4);
constexpr size_t FSZ = (size_t)NTOK * 512 * 4;
constexpr size_t WS_Z = WS_R;
constexpr size_t HSZ = (size_t)NTOK * 512 * 2;
constexpr size_t WS_RB = al256(WS_Z + (size_t)NTOK * ZLD * 2);
constexpr size_t WS_KS = WS_RB + HSZ, WS_VS = WS_KS + HSZ, WS_KKN = WS_VS + HSZ;
constexpr size_t WS_LIN = WS_KKN + HSZ;
constexpr size_t WS_LO = al256(WS_LIN + (size_t)NTOK * 384 * 2);
constexpr size_t WS_AB = WS_LO + 2 * HSZ;
constexpr size_t WS_GB = WS_LO + 4 * HSZ;
constexpr size_t WS_YS = WS_LO + 5 * HSZ;
constexpr size_t WS_QB = WS_YS + 2 * FSZ;
constexpr size_t WS_KB = WS_QB + FSZ / 2;
constexpr size_t WS_VB = WS_KB + FSZ / 2;
constexpr size_t WS_OP = WS_VB + FSZ / 2;
constexpr size_t WS_CAT = WS_OP + 2 * FSZ;
constexpr int WKV_REC = 12288, WKV_NCH = (TC + TL) / 16;
constexpr size_t WS_WKV = al256(WS_CAT + (size_t)NTOK * DM * 2);
constexpr size_t WS_EVEN_END = WS_WKV + (size_t)256 * WKV_NCH * WKV_REC;
constexpr size_t WS_Z2 = WS_R;
constexpr size_t WS_VST = al256(WS_Z2 + (size_t)NTOK * 2048 * 2);
constexpr size_t WS_G = al256(WS_VST + (size_t)NTOK * 2 * 4);
constexpr size_t WS_ODD_END = WS_G + (size_t)NTOK * DM * 2;
constexpr size_t WS_XP = WS_R;
constexpr size_t WS_ACT = al256(WS_XP + (size_t)XPROWS * DM * 2);
constexpr size_t WS_YM = al256(WS_ACT + (size_t)XPROWS * DM * 2);
constexpr size_t WS_MOE_END = WS_YM + (size_t)XPROWS * DM * 2;
constexpr size_t WS_END = (WS_EVEN_END > WS_MOE_END ? (WS_EVEN_END > WS_ODD_END ? WS_EVEN_END : WS_ODD_END) : (WS_MOE_END > WS_ODD_END ? WS_MOE_END : WS_ODD_END));

constexpr int CW_BAR = 4096;
constexpr int CW_CNT = 16384;
constexpr int CW_CUR = 16384 + 256;

constexpr int LDS_BYTES = 163840;
constexpr int LDS_MISC = 160 * 1024 - 256;

__device__ __forceinline__ unsigned f2bf(float f) { unsigned u = __builtin_bit_cast(unsigned, f); return (u + 0x7fffu + ((u >> 16) & 1u)) >> 16; }
__device__ __forceinline__ unsigned pk2(float lo, float hi) { return f2bf(lo) | (f2bf(hi) << 16); }
typedef float f32x2_t __attribute__((ext_vector_type(2))); typedef __bf16 bf16x2_t __attribute__((ext_vector_type(2)));
__device__ __forceinline__ unsigned cvtpk_s(float lo, float hi) { f32x2_t v = {lo, hi}; bf16x2_t b = __builtin_convertvector(v, bf16x2_t); return __builtin_bit_cast(unsigned, b); }
__device__ __forceinline__ float bf2f(bf16_t b) { return __builtin_bit_cast(float, (unsigned)b << 16); }
__device__ __forceinline__ float wave_sum(float v) {
#pragma unroll
    for (int o = 1; o < 64; o <<= 1) v += __shfl_xor(v, o);
    return v;
}
__device__ __forceinline__ int tid_opaque() { int t = threadIdx.x; asm volatile("" : "+v"(t)); return t; }
#define GAS __attribute__((address_space(1)))
template <class T> __device__ __forceinline__ T* as_global(T* p) { return (T*)(GAS T*)p; }
__device__ __forceinline__ unsigned char* opq(unsigned char* p) { GAS unsigned char* g = (GAS unsigned char*)p; asm volatile("" : "+s"(g)); return (unsigned char*)g; }
__device__ __forceinline__ float rdl(float v, int k) { return __builtin_bit_cast(float, __builtin_amdgcn_readlane(__builtin_bit_cast(int, v), k)); }
__device__ __forceinline__ float sigmoidf_(float x) { return 1.0f / (1.0f + __expf(-x)); }

#define XB_TMO      128
#define XB_XCNT(j)  (256  + 64 * (j))
#define XB_XSUB(j)  (1280 + 64 * (j))
#define XB_XGEN(j)  (2304 + 64 * (j))
#define XB_TOP      3328
#define XB_TOPGEN   3392
#define XCD_BAR_WORDS 3456
#define XB_SPIN_CAP (1u << 22)
__device__ __forceinline__ unsigned xb_ld(unsigned* p)              { return __hip_atomic_load(p, __ATOMIC_RELAXED, __HIP_MEMORY_SCOPE_AGENT); }
__device__ __forceinline__ unsigned xb_add(unsigned* p, unsigned v) { return __hip_atomic_fetch_add(p, v, __ATOMIC_RELAXED, __HIP_MEMORY_SCOPE_AGENT); }
__device__ __forceinline__ unsigned xb_xcc_id() { return (unsigned)__builtin_amdgcn_s_getreg((3 << 11) | 20) & 0xFu; }
#define XB_SPIN(cond, bar) do { unsigned _sp = 0; while (cond) { __builtin_amdgcn_s_sleep(1); \
    if ((++_sp & 255u) == 0u) { if (xb_ld(&(bar)[XB_TMO])) break; if (_sp > XB_SPIN_CAP) { atomicAdd(&(bar)[XB_TMO], 1u); break; } } } } while (0)
struct XcdBarrier { unsigned* bar; unsigned x; volatile LAS unsigned* st; };
__device__ __forceinline__ XcdBarrier xcd_barrier_post(unsigned* bar, volatile LAS unsigned* st) {
    XcdBarrier b; b.bar = bar; b.x = xb_xcc_id(); b.st = st;
    if (threadIdx.x == 0) (void)xb_add(&bar[XB_XCNT(b.x)], 1u);
    return b;
}
__device__ __forceinline__ void xcd_barrier_complete(unsigned* bar, unsigned x, unsigned& nloc, unsigned& nx) {
    const unsigned G = gridDim.x * gridDim.y * gridDim.z;
    unsigned sum, cnt, mine, sp = 0u;
    for (;;) {
        sum = 0u; cnt = 0u; mine = 0u;
#pragma unroll
        for (unsigned j = 0; j < 16; ++j) { const unsigned c = xb_ld(&bar[XB_XCNT(j)]); sum += c; cnt += (c > 0u) ? 1u : 0u; mine = (j == x) ? c : mine; }
        if (sum == G) break;
        __builtin_amdgcn_s_sleep(1);
        if ((++sp & 255u) == 0u) { if (xb_ld(&bar[XB_TMO])) break; if (sp > XB_SPIN_CAP) { atomicAdd(&bar[XB_TMO], 1u); break; } }
    }
    nloc = mine > 0u ? mine : 1u; nx = cnt > 0u ? cnt : 1u;
}
__device__ __forceinline__ void xcd_barrier(const XcdBarrier& b) {
    asm volatile("s_waitcnt vmcnt(0)" ::: "memory");
    __syncthreads();
    if (threadIdx.x == 0) {
        unsigned* bar = b.bar; asm volatile("" : "+s"(bar));
        __builtin_amdgcn_s_waitcnt(0);
        unsigned nloc = b.st[0], nx = b.st[1];
        if (nloc == 0u) { xcd_barrier_complete(bar, b.x, nloc, nx); b.st[0] = nloc; b.st[1] = nx; }
        const unsigned old = xb_add(&bar[XB_XSUB(b.x)], 1u);
        const unsigned gen = old / nloc;
        if (old + 1u == (gen + 1u) * nloc) {
            __builtin_amdgcn_fence(__ATOMIC_RELEASE, "agent");
            asm volatile("s_waitcnt vmcnt(0)" ::: "memory");
            const unsigned og = xb_add(&bar[XB_TOP], 1u);
            const unsigned tg = og / nx;
            if (og + 1u == (tg + 1u) * nx) xb_add(&bar[XB_TOPGEN], 1u);
            else XB_SPIN(xb_ld(&bar[XB_TOPGEN]) == tg, bar);
            __builtin_amdgcn_fence(__ATOMIC_ACQUIRE, "agent");
            xb_add(&bar[XB_XGEN(b.x)], 1u);
            asm volatile("s_waitcnt vmcnt(0)" ::: "memory");
        } else {
            XB_SPIN(xb_ld(&bar[XB_XGEN(b.x)]) == gen, bar);
            __builtin_amdgcn_fence(__ATOMIC_ACQUIRE, "agent");
            asm volatile("s_waitcnt vmcnt(0)" ::: "memory");
        }
    }
    __syncthreads();
}

namespace pg8 {
#define PG8_LAS __attribute__((address_space(3)))
typedef unsigned short bf16_t;
typedef short bf16x8 __attribute__((ext_vector_type(8)));
typedef float f32x4 __attribute__((ext_vector_type(4)));
typedef unsigned u32x4 __attribute__((ext_vector_type(4)));
constexpr int BM = 256, BK = 64, HALF = 128, HTB = HALF * BK * 2  , STAGE_BYTES = 8 * HTB, NXCD = 8, WGM = 8;

__host__ __device__ __forceinline__ int lds_byte(int r, int c) { const int st = (r >> 4) * 2 + (c >> 5), rr = r & 15, cc = c & 31, ob = rr * 64 + cc * 2; return st * 1024 + (ob ^ (((ob >> 9) & 1) << 5)); }
__host__ __device__ __forceinline__ void stage_rc(int b, int& R, int& C) { const int st = b / 1024, sb = b % 1024, swz = sb ^ (((sb >> 9) & 1) << 5); R = (st >> 1) * 16 + swz / 64; C = (st & 1) * 32 + (swz % 64) / 2; }
__host__ __device__ __forceinline__ int perm32(int rho) { const int n = rho >> 4, i = rho & 15; return 8 * (i >> 2) + 4 * n + (i & 3); }

struct Unit { int pm, pn; };
struct Gemm { const bf16_t* A; const bf16_t* Bt; int M, N, K; int sb_w = 0x77777777, sb_a = 0x7f7f7f7f; };

struct StaticOrder {
    int nM, nN, nwg, G, c;
    __host__ __device__ void init(int M, int N, int G_, int c_) { nM = M / BM; nN = N / BM; nwg = nM * nN; G = G_; c = c_; }
    __host__ __device__ bool next(int i, Unit& u) const {
        const long L = (long)i * G + c; if (L >= nwg) return false;
        int wgid = (int)L; { const int q = nwg / NXCD, r = nwg % NXCD, xcd = wgid % NXCD, off = wgid / NXCD; wgid = (xcd < r ? xcd * (q + 1) : r * (q + 1) + (xcd - r) * q) + off; }
        const int nig = WGM * nN, gid = wgid / nig, fm = gid * WGM, gsz = (nM - fm) < WGM ? (nM - fm) : WGM;
        u.pm = fm + ((wgid % nig) % gsz); u.pn = (wgid % nig) / gsz; return true;
    }
    __device__ __forceinline__ void a_ready(const Unit&) const {}
    __device__ __forceinline__ void done(const Unit&) const {}
};

__device__ __forceinline__ unsigned cvt_pk_bf16(float lo, float hi) { unsigned r; asm volatile("v_cvt_pk_bf16_f32 %0, %1, %2" : "=v"(r) : "v"(lo), "v"(hi)); return r; }
typedef float f32x2 __attribute__((ext_vector_type(2)));
__device__ __forceinline__ f32x2 gelu_pk(f32x2 v) {
    const f32x2 av = __builtin_elementwise_abs(v), d = av * 0.2316418882f + 1.0f;
    f32x2 t; t.x = __builtin_amdgcn_rcpf(d.x); t.y = __builtin_amdgcn_rcpf(d.y);
    f32x2 q = t * 0.5307027145f + (-0.7265760135f); q = q * t + 0.7107068705f; q = q * t + (-0.142248368f); q = q * t + 0.127414796f; q = q * t;
    const f32x2 s = (v * v) * (-0.72134752044f);
    f32x2 e; e.x = __builtin_amdgcn_exp2f(s.x); e.y = __builtin_amdgcn_exp2f(s.y);
    const f32x2 m = v * (q * e), r = v - m;
    f32x2 o; o.x = v.x < 0.f ? m.x : r.x; o.y = v.y < 0.f ? m.y : r.y; return o;
}

typedef int v8i32 __attribute__((ext_vector_type(8)));
typedef int v4i32 __attribute__((ext_vector_type(4)));
__device__ __forceinline__ v8i32 cat8(v4i32 a, v4i32 b) { return __builtin_shufflevector(a, b, 0, 1, 2, 3, 4, 5, 6, 7); }
template <class Epi, class Sched, bool ALIGN_EPI = false, bool SP2 = false, bool GATHER = false, bool FP8 = false>
__device__ __forceinline__ void gemm_phase(PG8_LAS unsigned char* lds, const Gemm g, const Sched& S, const Epi& E) {
    const int tid = tid_opaque(), wid = __builtin_amdgcn_readfirstlane(tid >> 6), lane = tid & 63, wr = wid >> 2, wc = wid & 3, fr = lane & 15, fq = lane >> 4;
    static_assert(!GATHER || SP2, "GATHER is wired into the SP2 loop only");
    const int K = g.K, nt = K / BK;
    unsigned voffA[2], voffB[2];
#pragma unroll
    for (int i = 0; i < 2; ++i) { int R, C; stage_rc(tid * 16 + i * 8192, R, C); const int Rb = Epi::PERM ? ((R & ~31) + perm32(R & 31)) : R;
        voffA[i] = (unsigned)(R * K + C) * 2u; voffB[i] = (unsigned)(Rb * K + C) * 2u; }
    unsigned gAc[2][2] = {{0u, 0u}, {0u, 0u}}, gAn[2][2] = {{0u, 0u}, {0u, 0u}};
    int gR[2] = {0, 0}; unsigned gC[2] = {0u, 0u};
    if constexpr (GATHER) {
#pragma unroll
        for (int i = 0; i < 2; ++i) { int R, C; stage_rc(tid * 16 + i * 8192, R, C); gR[i] = R; gC[i] = (unsigned)C * 2u; }
    }
#define PG8_GROWS(dst, ui_) do { _Pragma("unroll") for (int _h = 0; _h < 2; ++_h) _Pragma("unroll") for (int _i = 0; _i < 2; ++_i) dst[_h][_i] = S.rowtab[(ui_) * 256 + _h * 128 + gR[_i]] + gC[_i]; } while (0)
    const size_t kstep = (size_t)(BK * 2);
    const size_t hstep = (size_t)HALF * K * 2;
    const size_t tstep = 2 * hstep;
    const unsigned ldsw = (unsigned)wid * 1024u;
    const int aoff = lds_byte(wr * 64 + fr, fq * 8), boff = lds_byte(wc * 32 + fr, fq * 8);
#define PG8_SA(b, h) (((b) * 2 + (h)) * HTB)
#define PG8_SB(b, h) ((4 + (b) * 2 + (h)) * HTB)
#define PG8_STAGE(bufoff, gbase, voff) do { _Pragma("unroll") for (int _i = 0; _i < 2; ++_i) \
        __builtin_amdgcn_global_load_lds((const unsigned*)((const char*)(gbase) + (voff)[_i]), (PG8_LAS unsigned*)(lds + (bufoff) + ldsw + _i * 8192), 16, 0, 0); } while (0)
#define PG8_STAGE_A(bufoff, kptr, h, vsel) do { if constexpr (GATHER) { PG8_STAGE(bufoff, kptr, vsel[h]); } else { PG8_STAGE(bufoff, (kptr) + (h) * hstep, voffA); } } while (0)
#define PG8_LDA(dst, b, h) do { if constexpr (FP8) { _Pragma("unroll") for (int m = 0; m < 4; ++m) dst##8[m] = cat8(*(const PG8_LAS v4i32*)(lds + PG8_SA(b, h) + aoff + m * 2048), *(const PG8_LAS v4i32*)(lds + PG8_SA(b, h) + aoff + m * 2048 + 1024)); } \
        else { _Pragma("unroll") for (int m = 0; m < 4; ++m) _Pragma("unroll") for (int k = 0; k < 2; ++k) dst[m][k] = *(const PG8_LAS bf16x8*)(lds + PG8_SA(b, h) + aoff + m * 2048 + k * 1024); } } while (0)
#define PG8_LDB(dst, b, h) do { if constexpr (FP8) { _Pragma("unroll") for (int n = 0; n < 2; ++n) dst##8[n] = cat8(*(const PG8_LAS v4i32*)(lds + PG8_SB(b, h) + boff + n * 2048), *(const PG8_LAS v4i32*)(lds + PG8_SB(b, h) + boff + n * 2048 + 1024)); } \
        else { _Pragma("unroll") for (int n = 0; n < 2; ++n) _Pragma("unroll") for (int k = 0; k < 2; ++k) dst[n][k] = *(const PG8_LAS bf16x8*)(lds + PG8_SB(b, h) + boff + n * 2048 + k * 1024); } } while (0)
#define PG8_MMA(ai, bj, At, Bt) do { __builtin_amdgcn_s_setprio(1); if constexpr (FP8) { _Pragma("unroll") for (int m = 0; m < 4; ++m) _Pragma("unroll") for (int n = 0; n < 2; ++n) \
        asm volatile("s_nop 1\n\tv_mfma_scale_f32_16x16x128_f8f6f4 %0, %1, %2, %0, %3, %4 op_sel_hi:[0,0,0]" : "+v"(acc[ai][bj][m][n]) : "v"(Bt##8[n]), "v"(At##8[m]), "v"(fp8_sa), "v"(fp8_sb)); } else { \
        _Pragma("unroll") for (int m = 0; m < 4; ++m) _Pragma("unroll") for (int n = 0; n < 2; ++n) _Pragma("unroll") for (int k = 0; k < 2; ++k) \
        acc[ai][bj][m][n] = __builtin_amdgcn_mfma_f32_16x16x32_bf16(Bt[n][k], At[m][k], acc[ai][bj][m][n], 0, 0, 0); } __builtin_amdgcn_s_setprio(0); } while (0)
#define PG8_WAIT_V(n) asm volatile("s_waitcnt vmcnt(" #n ")" ::: "memory")
#define PG8_WAIT_L(n) asm volatile("s_waitcnt lgkmcnt(" #n ")" ::: "memory")
#define PG8_BAR __builtin_amdgcn_s_barrier()
#define PG8_SCHED __builtin_amdgcn_sched_barrier(0)
    Unit cur, nxt; int ui = 0;
    if (!S.next(0, cur)) return;
    f32x4 acc[2][2][4][2];
#pragma unroll
    for (int a = 0; a < 2; ++a)
#pragma unroll
        for (int b = 0; b < 2; ++b)
#pragma unroll
            for (int m = 0; m < 4; ++m)
#pragma unroll
                for (int n = 0; n < 2; ++n) acc[a][b][m][n] = (f32x4){0.f, 0.f, 0.f, 0.f};
    const int fp8_sa = g.sb_w, fp8_sb = g.sb_a;
    bf16x8 At[4][2], B0[2][2], B1[2][2]; v8i32 At8[4], B08[2], B18[2];
    const char* cA = GATHER ? (const char*)g.A : (const char*)g.A + (size_t)cur.pm * tstep; const char* cB = (const char*)g.Bt + (size_t)cur.pn * tstep;
    if constexpr (GATHER) { PG8_GROWS(gAc, 0); }
    S.a_ready(cur);
    if constexpr (SP2) {
        PG8_STAGE(PG8_SB(0, 0), cB, voffB); PG8_STAGE(PG8_SB(0, 1), cB + hstep, voffB); PG8_STAGE_A(PG8_SA(0, 0), cA, 0, gAc); PG8_STAGE_A(PG8_SA(0, 1), cA, 1, gAc);
        if (wr == 1) PG8_BAR;
        PG8_WAIT_V(2); PG8_BAR;
        PG8_STAGE(PG8_SB(1, 0), cB + kstep, voffB); PG8_STAGE_A(PG8_SA(1, 0), cA + kstep, 0, gAc); PG8_STAGE(PG8_SB(1, 1), cB + hstep + kstep, voffB);
        PG8_WAIT_V(6); PG8_BAR;
    } else {
        PG8_STAGE(PG8_SB(0, 0), cB, voffB); PG8_STAGE(PG8_SA(0, 0), cA, voffA); PG8_STAGE(PG8_SB(0, 1), cB + hstep, voffB); PG8_STAGE(PG8_SA(0, 1), cA + hstep, voffA);
        if (wr == 1) PG8_BAR;
        PG8_WAIT_V(4); PG8_BAR;
        PG8_STAGE(PG8_SB(1, 0), cB + kstep, voffB); PG8_STAGE(PG8_SA(1, 0), cA + kstep, voffA); PG8_STAGE(PG8_SB(1, 1), cB + hstep + kstep, voffB);
        PG8_WAIT_V(6); PG8_BAR;
    }
    for (;;) {
        const bool has_next = S.next(ui + 1, nxt);
        if constexpr (GATHER) { if (has_next) { PG8_GROWS(gAn, ui + 1); } else { _Pragma("unroll") for (int _h = 0; _h < 2; ++_h) _Pragma("unroll") for (int _i = 0; _i < 2; ++_i) gAn[_h][_i] = gAc[_h][_i]; } }
        const char* nA = GATHER ? (const char*)g.A : (has_next ? (const char*)g.A + (size_t)nxt.pm * tstep : cA); const char* nB = has_next ? (const char*)g.Bt + (size_t)nxt.pn * tstep : cB;
        for (int t = 0; t < nt; t += 2) {
            const bool last = (t == nt - 2);
            const char* a1 = cA + (size_t)(t + 1) * kstep;
            const char* a2 = last ? nA : cA + (size_t)(t + 2) * kstep; const char* b2 = last ? nB : cB + (size_t)(t + 2) * kstep;
            const char* a3 = a2 + kstep; const char* b3 = b2 + kstep;
            if (last && has_next) S.a_ready(nxt);
            unsigned gA2[2][2];
            if constexpr (GATHER) { _Pragma("unroll") for (int _h = 0; _h < 2; ++_h) _Pragma("unroll") for (int _i = 0; _i < 2; ++_i) gA2[_h][_i] = last ? gAn[_h][_i] : gAc[_h][_i]; }
            if constexpr (SP2) {
            PG8_LDB(B0, 0, 0); PG8_LDB(B1, 0, 1); PG8_SCHED; PG8_LDA(At, 0, 0); PG8_STAGE_A(PG8_SA(1, 1), a1, 1, gAc);
            PG8_WAIT_V(8); PG8_WAIT_L(0); PG8_BAR; PG8_MMA(0, 0, At, B0); PG8_MMA(0, 1, At, B1); PG8_BAR; PG8_SCHED;
            PG8_LDA(At, 0, 1); PG8_STAGE(PG8_SB(0, 0), b2, voffB); PG8_STAGE(PG8_SB(0, 1), b2 + hstep, voffB); PG8_STAGE_A(PG8_SA(0, 0), a2, 0, gA2);
            PG8_WAIT_V(8); PG8_WAIT_L(0); PG8_BAR; PG8_MMA(1, 0, At, B0); PG8_MMA(1, 1, At, B1); PG8_BAR; PG8_SCHED;
            PG8_LDB(B0, 1, 0); PG8_LDB(B1, 1, 1); PG8_SCHED; PG8_LDA(At, 1, 0); PG8_STAGE_A(PG8_SA(0, 1), a2, 1, gA2);
            PG8_WAIT_V(8); PG8_WAIT_L(0); PG8_BAR; PG8_MMA(0, 0, At, B0); PG8_MMA(0, 1, At, B1); PG8_BAR; PG8_SCHED;
            PG8_LDA(At, 1, 1); PG8_STAGE(PG8_SB(1, 0), b3, voffB); PG8_STAGE(PG8_SB(1, 1), b3 + hstep, voffB); PG8_STAGE_A(PG8_SA(1, 0), a3, 0, gA2);
            PG8_WAIT_V(8); PG8_WAIT_L(0); PG8_BAR; PG8_MMA(1, 0, At, B0); PG8_MMA(1, 1, At, B1); PG8_BAR; PG8_SCHED;
            } else {
            PG8_LDB(B0, 0, 0); PG8_SCHED; PG8_LDA(At, 0, 0); PG8_STAGE(PG8_SA(1, 1), a1 + hstep, voffA);
            PG8_WAIT_L(8); PG8_BAR; PG8_WAIT_L(0); PG8_MMA(0, 0, At, B0); PG8_BAR; PG8_SCHED;
            PG8_LDB(B1, 0, 1); PG8_STAGE(PG8_SB(0, 0), b2, voffB);
            PG8_BAR; PG8_WAIT_L(0); PG8_MMA(0, 1, At, B1); PG8_BAR;
            PG8_LDA(At, 0, 1); PG8_STAGE(PG8_SA(0, 0), a2, voffA);
            PG8_BAR; PG8_WAIT_L(0); PG8_MMA(1, 0, At, B0); PG8_BAR; PG8_SCHED;
            PG8_STAGE(PG8_SB(0, 1), b2 + hstep, voffB);
            PG8_WAIT_V(6); PG8_BAR; PG8_MMA(1, 1, At, B1); PG8_BAR;
            PG8_LDB(B0, 1, 0); PG8_SCHED; PG8_LDA(At, 1, 0); PG8_STAGE(PG8_SA(0, 1), a2 + hstep, voffA);
            PG8_WAIT_L(8); PG8_BAR; PG8_WAIT_L(0); PG8_MMA(0, 0, At, B0); PG8_BAR; PG8_SCHED;
            PG8_LDB(B1, 1, 1); PG8_STAGE(PG8_SB(1, 0), b3, voffB);
            PG8_BAR; PG8_WAIT_L(0); PG8_MMA(0, 1, At, B1); PG8_BAR;
            PG8_LDA(At, 1, 1); PG8_STAGE(PG8_SA(1, 0), a3, voffA);
            PG8_BAR; PG8_WAIT_L(0); PG8_MMA(1, 0, At, B0); PG8_BAR; PG8_SCHED;
            PG8_STAGE(PG8_SB(1, 1), b3 + hstep, voffB);
            PG8_WAIT_V(6); PG8_BAR; PG8_MMA(1, 1, At, B1); PG8_BAR;
            }
        }
        if constexpr (ALIGN_EPI) { if (wr == 0) PG8_BAR; }
        if constexpr (FP8) { asm volatile("s_nop 15\n\ts_nop 15" ::: "memory"); __builtin_amdgcn_sched_barrier(0); }
        if constexpr (!Epi::AFTER_DRAIN) { E(acc, cur, wr, wc, fr, fq); S.done(cur); }
        if (!has_next) break;
#pragma unroll
        for (int a = 0; a < 2; ++a)
#pragma unroll
            for (int b = 0; b < 2; ++b)
#pragma unroll
                for (int m = 0; m < 4; ++m)
#pragma unroll
                    for (int n = 0; n < 2; ++n) acc[a][b][m][n] = (f32x4){0.f, 0.f, 0.f, 0.f};
        cur = nxt; cA = nA; cB = nB; ++ui;
        if constexpr (GATHER) { _Pragma("unroll") for (int _h = 0; _h < 2; ++_h) _Pragma("unroll") for (int _i = 0; _i < 2; ++_i) gAc[_h][_i] = gAn[_h][_i]; }
        if constexpr (ALIGN_EPI) { if (wr == 1) PG8_BAR; }
    }
    PG8_WAIT_V(0);
    if constexpr (!ALIGN_EPI) { if (wr == 0) PG8_BAR; }
    PG8_BAR;
    if constexpr (Epi::AFTER_DRAIN) { E.fused(acc, cur, wr, wc, fr, fq, lds, wid, lane); S.done(cur); }
#undef PG8_SA
#undef PG8_SB
#undef PG8_STAGE
#undef PG8_STAGE_A
#undef PG8_GROWS
#undef PG8_LDA
#undef PG8_LDB
#undef PG8_MMA
#undef PG8_WAIT_V
#undef PG8_WAIT_L
#undef PG8_BAR
#undef PG8_SCHED
}
}

struct Args { const float* in[38]; float* out; unsigned char* ws; int ph_lo, ph_hi; };
#define INP(k) as_global(IN[k])
#define AIN(k) as_global(A.in[k])
enum { I_X = 0, I_C, I_CTX, I_CCTX, I_N1G, I_N2G, I_ADAW, I_ADAB, I_EVWIN, I_EVWOUT, I_RWMU, I_RWW0, I_RWW2, I_RWA0, I_RWA2, I_RWG2, I_RWKK, I_RWKA, I_RWRK,
       I_GNW, I_GNB, I_QN, I_KN, I_LAM, I_SUBLN, I_SGWIN, I_SGBIN, I_SGLNG, I_SGLNB, I_SGWS, I_SGBS, I_SGWOUT, I_RTW, I_RTB, I_W1, I_B1, I_W2, I_B2 };

struct Tok { int b, t, T, modrow; };
__device__ __forceinline__ Tok tokinfo(int g) {
    Tok k;
    if (g < NCTX) { k.b = g >> 8; k.t = g & 255; k.T = TC; k.modrow = 16; }
    else { const int q = g - NCTX; k.b = q >> 11; k.t = q & 2047; k.T = TL; k.modrow = k.b; }
    return k;
}

template <int MAP>
__device__ __forceinline__ void p0_transpose_item(const float* W, int K, int N, bf16_t* WT, LAS float* scr, int item, int lane) {
    const int nblk = N / 32, kb = item / nblk, nb = item % nblk, k0 = 64 * kb, n0 = 32 * nb;
    const int d0 = MAP ? (256 * ((n0 & 1023) >> 7) + 128 * (n0 >> 10) + (n0 & 127)) : n0;
#pragma unroll 8
    for (int i = 0; i < 32; ++i) { const int kk = 2 * i + (lane >> 5); scr[kk * 33 + (lane & 31)] = W[(size_t)(k0 + kk) * N + n0 + (lane & 31)]; }
    asm volatile("s_waitcnt lgkmcnt(0)" ::: "memory");
    const int c = lane & 7;
#pragma unroll
    for (int j = 0; j < 4; ++j) { const int n = (lane >> 3) + 8 * j; const LAS float* s = scr + (8 * c) * 33 + n;
        u32x4 o; o.x = pk2(s[0 * 33], s[1 * 33]); o.y = pk2(s[2 * 33], s[3 * 33]); o.z = pk2(s[4 * 33], s[5 * 33]); o.w = pk2(s[6 * 33], s[7 * 33]);
        *(u32x4*)(WT + (size_t)(d0 + n) * K + k0 + 8 * c) = o; }
    asm volatile("s_waitcnt lgkmcnt(0)" ::: "memory");
}

template <int MAP>
__device__ __forceinline__ void p0_transpose_item_fp8(const float* W, int K, int N, unsigned char* WT, LAS float* scr, int item, int lane) {
    const int nblk = N / 32, kb = item / nblk, nb = item % nblk, k0 = 64 * kb, n0 = 32 * nb;
    const int d0 = MAP ? (256 * ((n0 & 1023) >> 7) + 128 * (n0 >> 10) + (n0 & 127)) : n0;
#pragma unroll 8
    for (int i = 0; i < 32; ++i) { const int kk = 2 * i + (lane >> 5); scr[kk * 33 + (lane & 31)] = W[(size_t)(k0 + kk) * N + n0 + (lane & 31)]; }
    asm volatile("s_waitcnt lgkmcnt(0)" ::: "memory");
    const int c = lane & 3;
#pragma unroll
    for (int j = 0; j < 2; ++j) { const int n = (lane >> 2) + 16 * j; const LAS float* sp = scr + (16 * c) * 33 + n;
        u32x4 o;
#pragma unroll
        for (int d = 0; d < 4; ++d) { int w = __builtin_amdgcn_cvt_pk_fp8_f32(sp[(4 * d) * 33] * 256.0f, sp[(4 * d + 1) * 33] * 256.0f, 0, false);
            w = __builtin_amdgcn_cvt_pk_fp8_f32(sp[(4 * d + 2) * 33] * 256.0f, sp[(4 * d + 3) * 33] * 256.0f, w, true); o[d] = (unsigned)w; }
        *(u32x4*)(WT + (size_t)(d0 + n) * K + k0 + 16 * c) = o; }
    asm volatile("s_waitcnt lgkmcnt(0)" ::: "memory");
}

__device__ __forceinline__ void ph_prologue(const Args& A, LAS unsigned char* lds, int bid, int nb) {
    const int tid = tid_opaque(), lane = tid & 63, wid = tid >> 6;
    unsigned char* ws = opq(A.ws);
    if (bid == 0 && tid < 39) ((const float**)(ws + WS_PTRS))[tid] = (tid < 38) ? A.in[tid] : (const float*)A.out;
    {
        LAS float* s = (LAS float*)lds;
        LAS float* red = (LAS float*)(lds + 17 * 1024 * 4);
        for (int i = tid; i < 17 * 1024; i += NTHREADS) {
            const int r = i >> 10, k = i & 1023;
            const float x = (r < 16) ? AIN(I_C)[r * 1024 + k] : AIN(I_CCTX)[k];
            s[i] = x / (1.0f + __expf(-x));
        }
        __syncthreads();
        float* mod = (float*)(ws + WS_MOD);
        for (int u = bid; u < 4 * 96; u += nb) {
            const int l = u / 96, cg = u % 96, col = cg * 64 + lane;
            float acc[17];
#pragma unroll
            for (int r = 0; r < 17; ++r) acc[r] = 0.f;
            const float* wp = AIN(I_ADAW) + (size_t)l * 1024 * 6144 + col;
            for (int k = wid * 128; k < wid * 128 + 128; ++k) {
                const float wv = wp[(size_t)k * 6144];
#pragma unroll
                for (int r = 0; r < 17; ++r) acc[r] += s[r * 1024 + k] * wv;
            }
#pragma unroll
            for (int r = 0; r < 17; ++r) red[(wid * 17 + r) * 64 + lane] = acc[r];
            __syncthreads();
            for (int i = tid; i < 17 * 64; i += NTHREADS) {
                const int r = i >> 6, ln = i & 63; float v = 0.f;
#pragma unroll
                for (int w = 0; w < 8; ++w) v += red[(w * 17 + r) * 64 + ln];
                const int cc = cg * 64 + ln;
                mod[((size_t)l * 17 + r) * 6144 + cc] = v + AIN(I_ADAB)[l * 6144 + cc];
            }
            __syncthreads();
        }
    }
    __syncthreads();
    {
        LAS float* scr = (LAS float*)(lds + wid * 16384);
        const int gw = bid * NWAVES + wid, NGW = nb * NWAVES;
        constexpr int IT_WIN = 16 * (EVC / 32), IT_SQ = 16 * 32, IT_SGIN = 16 * 64, IT_W1 = 16 * 64, IT_W2 = 16 * 32;
        constexpr int N0 = 2 * IT_WIN, N1 = N0 + 2 * IT_SQ, N2 = N1 + 2 * IT_SGIN, N3 = N2 + 2 * IT_SQ, N4 = N3 + 128 * IT_W1, N5 = N4 + 128 * IT_W2;
        for (int it = gw; it < N5; it += NGW) {
            if (it < N0) { const int m = it / IT_WIN, r = it % IT_WIN; p0_transpose_item<0>(AIN(I_EVWIN) + (size_t)m * DM * EVC, DM, EVC, (bf16_t*)(ws + WS_WIN) + (size_t)m * ZLD * DM, scr, r, lane); }
            else if (it < N1) { const int q = it - N0, m = q / IT_SQ, r = q % IT_SQ; p0_transpose_item<0>(AIN(I_EVWOUT) + (size_t)m * DM * DM, DM, DM, (bf16_t*)(ws + WS_WOUT) + (size_t)m * DM * DM, scr, r, lane); }
            else if (it < N2) { const int q = it - N1, m = q / IT_SGIN, r = q % IT_SGIN; p0_transpose_item<0>(AIN(I_SGWIN) + (size_t)m * DM * 2048, DM, 2048, (bf16_t*)(ws + WS_SGIN) + (size_t)m * 2048 * DM, scr, r, lane); }
            else if (it < N3) { const int q = it - N2, m = q / IT_SQ, r = q % IT_SQ; p0_transpose_item<0>(AIN(I_SGWOUT) + (size_t)m * DM * DM, DM, DM, (bf16_t*)(ws + WS_SGOUT) + (size_t)m * DM * DM, scr, r, lane); }
            else if (it < N4) { const int q = it - N3, m = q / IT_W1, r = q % IT_W1; p0_transpose_item_fp8<1>(AIN(I_W1) + (size_t)m * DM * 2048, DM, 2048, ws + WS_W1 + (size_t)m * 2048 * DM, scr, r, lane); }
            else { const int q = it - N4, m = q / IT_W2, r = q % IT_W2; p0_transpose_item_fp8<0>(AIN(I_W2) + (size_t)m * DM * DM, DM, DM, ws + WS_W2 + (size_t)m * DM * DM, scr, r, lane); }
        }
    }
    {
        const size_t gt = (size_t)bid * NTHREADS + tid, GT = (size_t)nb * NTHREADS;
        f32x4* H4 = (f32x4*)(ws + WS_H);
        const f32x4* c4 = (const f32x4*)AIN(I_CTX); const f32x4* x4 = (const f32x4*)AIN(I_X);
        constexpr size_t NC4 = (size_t)NCTX * DM / 4, NT4 = (size_t)NTOK * DM / 4;
        for (size_t i = gt; i < NT4; i += GT) H4[i] = (i < NC4) ? c4[i] : x4[i - NC4];
        for (size_t i = gt; i < (size_t)2 * 128 * DM / 8; i += GT) { const size_t m = i / (128 * DM / 8), r = i % (128 * DM / 8); ((u32x4*)((bf16_t*)(ws + WS_WIN) + (m * ZLD + EVC) * DM))[r] = (u32x4){0u, 0u, 0u, 0u}; }
        bf16_t* wl = (bf16_t*)(ws + WS_WLORA);
        for (size_t i = gt; i < (size_t)2 * LORA_N * (LORA_K / 8); i += GT) {
            const int n = (int)(i % LORA_N), kc = (int)((i / LORA_N) % (LORA_K / 8)), jj = (int)(i / ((size_t)LORA_N * (LORA_K / 8))), seg = n >> 9, c = n & 511, k0 = kc * 8;
            float v[8];
#pragma unroll
            for (int e = 0; e < 8; ++e) v[e] = 0.f;
            if (seg < 2) { if ((k0 >> 6) == seg) {
#pragma unroll
                for (int e = 0; e < 8; ++e) v[e] = AIN(I_RWW2)[(((size_t)jj * 2 + seg) * 64 + (k0 & 63) + e) * 512 + c]; } }
            else if (seg < 4) { if ((k0 >> 6) == seg) {
#pragma unroll
                for (int e = 0; e < 8; ++e) v[e] = AIN(I_RWA2)[(((size_t)jj * 2 + (seg - 2)) * 64 + (k0 & 63) + e) * 512 + c]; } }
            else if (k0 >= 256) {
#pragma unroll
                for (int e = 0; e < 8; ++e) v[e] = AIN(I_RWG2)[((size_t)jj * 128 + (k0 - 256) + e) * 512 + c]; }
            *(u32x4*)(wl + ((size_t)jj * LORA_N + n) * LORA_K + k0) = (u32x4){pk2(v[0], v[1]), pk2(v[2], v[3]), pk2(v[4], v[5]), pk2(v[6], v[7])};
        }
        for (size_t i = gt; i < (size_t)2 * LORA_N; i += GT) { const int jj = (int)(i / LORA_N), n = (int)(i % LORA_N), seg = n >> 9, c = n & 511;
            ((float*)(ws + WS_LBIAS))[i] = seg < 2 ? AIN(I_RWW0)[((size_t)jj * 2 + seg) * 512 + c] : (seg < 4 ? AIN(I_RWA0)[((size_t)jj * 2 + (seg - 2)) * 512 + c] : 0.f); }
        float* rt = (float*)(ws + WS_RTWT);
        for (size_t i = gt; i < (size_t)4 * 128 * 32; i += GT) {
            const int e = (int)i & 31, k0 = ((int)(i >> 5) & 127) * 8, l = (int)(i >> 12);
            unsigned hi[4], lo[4]; float w[8];
#pragma unroll
            for (int q = 0; q < 8; ++q) w[q] = AIN(I_RTW)[((size_t)l * 1024 + k0 + q) * 32 + e];
#pragma unroll
            for (int q = 0; q < 4; ++q) { hi[q] = pk2(w[2 * q], w[2 * q + 1]); lo[q] = pk2(w[2 * q] - __builtin_bit_cast(float, hi[q] << 16), w[2 * q + 1] - __builtin_bit_cast(float, hi[q] & 0xffff0000u)); }
            *(u32x4*)((bf16_t*)rt + ((size_t)l * 2 * 32 + e) * 1024 + k0) = (u32x4){hi[0], hi[1], hi[2], hi[3]};
            *(u32x4*)((bf16_t*)rt + ((size_t)(l * 2 + 1) * 32 + e) * 1024 + k0) = (u32x4){lo[0], lo[1], lo[2], lo[3]};
        }
    }
}

template <bool ROUTER>
__device__ __forceinline__ void ph_norm(const Args& A, int l, int row_lo, LAS unsigned char* lds, int bid, int nb) {
    unsigned char* ws = opq(A.ws); const float* const* IN = (const float* const*)(ws + WS_PTRS); (void)IN;
    const int tid = tid_opaque(), lane = tid & 63, wid = tid >> 6;
    const float* H = (const float*)(ws + WS_H);
    const float* mod = (const float*)(ws + WS_MOD);
    bf16_t* abf = (bf16_t*)(ws + WS_ABF);
    const float* gp = INP(ROUTER ? I_N2G : I_N1G) + l * 1024;
    const int c_shift = ROUTER ? 3 : 0, c_scale = ROUTER ? 4 : 1;
    LAS float* rtl = (LAS float*)lds;
    LAS int* hist = (LAS int*)(lds + 131072);
    float rtb = 0.f;
    if constexpr (ROUTER) {
        const f32x4* rt4 = (const f32x4*)((const float*)(ws + WS_RTWT) + (size_t)l * 32 * 1024);
        for (int i = tid; i < 32 * 1024 / 4; i += NTHREADS) ((LAS f32x4*)rtl)[i] = rt4[i];
        if (tid < 32) hist[tid] = 0;
        rtb = INP(I_RTB)[l * 32 + (lane >> 1)];
        __syncthreads();
    }
    for (int row = row_lo + bid * NWAVES + wid; row < NTOK; row += nb * NWAVES) {
        const Tok tk = tokinfo(row);
        const float* mrow = mod + ((size_t)l * 17 + tk.modrow) * 6144;
        f32x4 v[4]; float ss = 0.f;
#pragma unroll
        for (int j = 0; j < 4; ++j) { v[j] = *(const f32x4*)(H + (size_t)row * DM + j * 256 + lane * 4); ss += (v[j].x * v[j].x + v[j].y * v[j].y) + (v[j].z * v[j].z + v[j].w * v[j].w); }
        const float rstd = rsqrtf(wave_sum(ss) * (1.0f / DM) + 1e-6f);
#pragma unroll
        for (int j = 0; j < 4; ++j) {
            const int col = j * 256 + lane * 4;
            const f32x4 g = *(const f32x4*)(gp + col), sc = *(const f32x4*)(mrow + c_scale * 1024 + col), sh = *(const f32x4*)(mrow + c_shift * 1024 + col);
            v[j] = (v[j] * rstd * g) * (sc + 1.0f) + sh;
            u32x2 o; o.x = pk2(v[j].x, v[j].y); o.y = pk2(v[j].z, v[j].w);
            *(u32x2*)(abf + (size_t)row * DM + col) = o;
        }
        if constexpr (ROUTER) {
            float p[32];
#pragma unroll
            for (int e = 0; e < 32; ++e) {
                float acc = 0.f;
#pragma unroll
                for (int j = 0; j < 4; ++j) { const f32x4 w = *(const LAS f32x4*)(rtl + e * 1024 + j * 256 + lane * 4); acc += (v[j].x * w.x + v[j].y * w.y) + (v[j].z * w.z + v[j].w * w.w); }
                p[e] = acc;
            }
#define RS_STEP(N, OFF) _Pragma("unroll") for (int i = 0; i < (N); ++i) { const bool up = (lane & (OFF)) != 0; const float send = up ? p[i] : p[i + (N)], keep = up ? p[i + (N)] : p[i]; p[i] = keep + __shfl_xor(send, (OFF)); }
            RS_STEP(16, 32) RS_STEP(8, 16) RS_STEP(4, 8) RS_STEP(2, 4) RS_STEP(1, 2)
#undef RS_STEP
            const float mylg = p[0] + __shfl_xor(p[0], 1) + rtb;
            float tv[4] = {-3.0e38f, -3.0e38f, -3.0e38f, -3.0e38f}; int ti[4] = {0, 0, 0, 0};
#pragma unroll
            for (int e = 0; e < 32; ++e) {
                const float lgv = rdl(mylg, 2 * e);
                if (lgv > tv[3]) {
                    tv[3] = lgv; ti[3] = e;
                    if (tv[3] > tv[2]) { const float a = tv[2]; tv[2] = tv[3]; tv[3] = a; const int b = ti[2]; ti[2] = ti[3]; ti[3] = b; }
                    if (tv[2] > tv[1]) { const float a = tv[1]; tv[1] = tv[2]; tv[2] = a; const int b = ti[1]; ti[1] = ti[2]; ti[2] = b; }
                    if (tv[1] > tv[0]) { const float a = tv[0]; tv[0] = tv[1]; tv[1] = a; const int b = ti[0]; ti[0] = ti[1]; ti[1] = b; }
                }
            }
            const float e1 = __expf(tv[1] - tv[0]), e2 = __expf(tv[2] - tv[0]), e3 = __expf(tv[3] - tv[0]);
            const float inv = 1.0f / (1.0f + e1 + e2 + e3);
            if (lane == 0) {
                int* te = (int*)(ws + WS_TOKE) + (size_t)row * 4; float* tg = (float*)(ws + WS_TOKG) + (size_t)row * 4; int* tr = (int*)(ws + WS_TOKR) + (size_t)row * 4;
                te[0] = ti[0]; te[1] = ti[1]; te[2] = ti[2]; te[3] = ti[3];
                tg[0] = inv; tg[1] = e1 * inv; tg[2] = e2 * inv; tg[3] = e3 * inv;
#pragma unroll
                for (int k = 0; k < 4; ++k) tr[k] = __hip_atomic_fetch_add(hist + ti[k], 1, __ATOMIC_RELAXED, __HIP_MEMORY_SCOPE_WORKGROUP);
            }
        }
    }
    if constexpr (ROUTER) {
        __syncthreads();
        if (tid < 32) ((int*)(ws + WS_BCNT))[((size_t)l * 256 + bid) * 32 + tid] = hist[tid];
    }
}


constexpr int RT_LS = 2064;
__device__ __forceinline__ void ph_norm2_router(const Args& A, int l, int row_lo, LAS unsigned char* lds, int bid, int nb) {
    unsigned char* ws = opq(A.ws); const float* const* IN = (const float* const*)(ws + WS_PTRS);
    const int tid = tid_opaque(), lane = tid & 63, wid = tid >> 6, c16 = lane & 15, g4 = lane >> 4;
    const float* H = (const float*)(ws + WS_H); const float* mod = (const float*)(ws + WS_MOD); bf16_t* abf = (bf16_t*)(ws + WS_ABF);
    const float* gp = INP(I_N2G) + l * 1024;
    LAS unsigned char* rth = lds; LAS unsigned char* rtl = lds + 32 * RT_LS;
    LAS int* hist = (LAS int*)(lds + 64 * RT_LS);
    LAS float* lgs = (LAS float*)(lds + 64 * RT_LS + 256) + wid * 544;
    {
        const u32x4* src = (const u32x4*)((const bf16_t*)(ws + WS_RTWT) + (size_t)l * 2 * 32 * 1024);
        for (int i = tid; i < 64 * 128; i += NTHREADS) { const int row = i >> 7, ch = i & 127; *(LAS u32x4*)(lds + row * RT_LS + ch * 16) = src[i]; }
        if (tid < 32) hist[tid] = 0;
        __syncthreads();
    }
    const float rtb0 = INP(I_RTB)[l * 32 + c16], rtb1 = INP(I_RTB)[l * 32 + 16 + c16];
    const int ngroups = (NTOK - row_lo) / 16;
    for (int u = bid * NWAVES + wid; u < ngroups; u += nb * NWAVES) {
        const int row = row_lo + 16 * u + c16;
        const Tok tk = tokinfo(row_lo + 16 * u);
        const float* mrow = mod + ((size_t)l * 17 + tk.modrow) * 6144;
        const float* hrow = H + (size_t)row * DM + 8 * g4;
        float ss = 0.f;
#pragma unroll 8
        for (int ks = 0; ks < 32; ++ks) { const f32x4 a = *(const f32x4*)(hrow + 32 * ks), b = *(const f32x4*)(hrow + 32 * ks + 4);
            ss += (a.x * a.x + a.y * a.y) + (a.z * a.z + a.w * a.w) + (b.x * b.x + b.y * b.y) + (b.z * b.z + b.w * b.w); }
        ss += __shfl_xor(ss, 16); ss += __shfl_xor(ss, 32);
        const float rstd = rsqrtf(ss * (1.0f / DM) + 1e-6f);
        f32x4 acc0 = {0.f, 0.f, 0.f, 0.f}, acc1 = acc0;
#pragma unroll 2
        for (int ks = 0; ks < 32; ++ks) {
            const int col = 32 * ks + 8 * g4;
            float f[8];
            { const f32x4 xa = *(const f32x4*)(hrow + 32 * ks), xb = *(const f32x4*)(hrow + 32 * ks + 4);
              const f32x4 ga = *(const f32x4*)(gp + col), gb = *(const f32x4*)(gp + col + 4), sa = *(const f32x4*)(mrow + 4 * 1024 + col), sb = *(const f32x4*)(mrow + 4 * 1024 + col + 4);
              const f32x4 ha = *(const f32x4*)(mrow + 3 * 1024 + col), hb = *(const f32x4*)(mrow + 3 * 1024 + col + 4);
              const f32x4 fa = (xa * rstd * ga) * (sa + 1.0f) + ha, fb = (xb * rstd * gb) * (sb + 1.0f) + hb;
              f[0] = fa.x; f[1] = fa.y; f[2] = fa.z; f[3] = fa.w; f[4] = fb.x; f[5] = fb.y; f[6] = fb.z; f[7] = fb.w; }
            unsigned hi[4], lo[4];
#pragma unroll
            for (int e = 0; e < 4; ++e) { hi[e] = pk2(f[2 * e], f[2 * e + 1]);
                lo[e] = pk2(f[2 * e] - __builtin_bit_cast(float, hi[e] << 16), f[2 * e + 1] - __builtin_bit_cast(float, hi[e] & 0xffff0000u)); }
            const u32x4 hv = {hi[0], hi[1], hi[2], hi[3]}, lv = {lo[0], lo[1], lo[2], lo[3]};
            { int w0 = __builtin_amdgcn_cvt_pk_fp8_f32(f[0], f[1], 0, false); w0 = __builtin_amdgcn_cvt_pk_fp8_f32(f[2], f[3], w0, true);
              int w1 = __builtin_amdgcn_cvt_pk_fp8_f32(f[4], f[5], 0, false); w1 = __builtin_amdgcn_cvt_pk_fp8_f32(f[6], f[7], w1, true);
              *(u32x2*)((unsigned char*)abf + (size_t)row * DM + col) = (u32x2){(unsigned)w0, (unsigned)w1}; }
            const bf16x8 fh = __builtin_bit_cast(bf16x8, hv), fl = __builtin_bit_cast(bf16x8, lv);
            const int wo = c16 * RT_LS + col * 2;
            const bf16x8 wh0 = *(const LAS bf16x8*)(rth + wo), wh1 = *(const LAS bf16x8*)(rth + 16 * RT_LS + wo), wl0 = *(const LAS bf16x8*)(rtl + wo), wl1 = *(const LAS bf16x8*)(rtl + 16 * RT_LS + wo);
            acc0 = __builtin_amdgcn_mfma_f32_16x16x32_bf16(fh, wh0, acc0, 0, 0, 0); acc1 = __builtin_amdgcn_mfma_f32_16x16x32_bf16(fh, wh1, acc1, 0, 0, 0);
            acc0 = __builtin_amdgcn_mfma_f32_16x16x32_bf16(fl, wh0, acc0, 0, 0, 0); acc1 = __builtin_amdgcn_mfma_f32_16x16x32_bf16(fl, wh1, acc1, 0, 0, 0);
            acc0 = __builtin_amdgcn_mfma_f32_16x16x32_bf16(fh, wl0, acc0, 0, 0, 0); acc1 = __builtin_amdgcn_mfma_f32_16x16x32_bf16(fh, wl1, acc1, 0, 0, 0);
        }
#pragma unroll
        for (int r = 0; r < 4; ++r) { lgs[(4 * g4 + r) * 34 + c16] = acc0[r] + rtb0; lgs[(4 * g4 + r) * 34 + 16 + c16] = acc1[r] + rtb1; }
        asm volatile("s_waitcnt lgkmcnt(0)" ::: "memory");
        if (lane < 16) {
            float tv[4] = {-3.0e38f, -3.0e38f, -3.0e38f, -3.0e38f}; int ti[4] = {0, 0, 0, 0};
#pragma unroll
            for (int e = 0; e < 32; ++e) {
                const float lgv = lgs[lane * 34 + e];
                if (lgv > tv[3]) {
                    tv[3] = lgv; ti[3] = e;
                    if (tv[3] > tv[2]) { const float a = tv[2]; tv[2] = tv[3]; tv[3] = a; const int b = ti[2]; ti[2] = ti[3]; ti[3] = b; }
                    if (tv[2] > tv[1]) { const float a = tv[1]; tv[1] = tv[2]; tv[2] = a; const int b = ti[1]; ti[1] = ti[2]; ti[2] = b; }
                    if (tv[1] > tv[0]) { const float a = tv[0]; tv[0] = tv[1]; tv[1] = a; const int b = ti[0]; ti[0] = ti[1]; ti[1] = b; }
                }
            }
            const float e1 = __expf(tv[1] - tv[0]), e2 = __expf(tv[2] - tv[0]), e3 = __expf(tv[3] - tv[0]);
            const float inv = 1.0f / (1.0f + e1 + e2 + e3);
            const size_t r4 = (size_t)(row_lo + 16 * u + lane) * 4;
            *(int4*)((int*)(ws + WS_TOKE) + r4) = make_int4(ti[0], ti[1], ti[2], ti[3]);
            *(f32x4*)((float*)(ws + WS_TOKG) + r4) = (f32x4){inv, e1 * inv, e2 * inv, e3 * inv};
            int rk[4];
#pragma unroll
            for (int k = 0; k < 4; ++k) rk[k] = __hip_atomic_fetch_add(hist + ti[k], 1, __ATOMIC_RELAXED, __HIP_MEMORY_SCOPE_WORKGROUP);
            *(int4*)((int*)(ws + WS_TOKR) + r4) = make_int4(rk[0], rk[1], rk[2], rk[3]);
        }
        asm volatile("s_waitcnt lgkmcnt(0)" ::: "memory");
    }
    __syncthreads();
    if (tid < 32) ((int*)(ws + WS_BCNT))[((size_t)l * 256 + bid) * 32 + tid] = hist[tid];
}

typedef pg8::f32x4 (&AccRef)[2][2][4][2];
struct EpiStoreBf16 {
    static constexpr bool PERM = true, AFTER_DRAIN = false;
    bf16_t* O; int ldc;
    __device__ __forceinline__ void operator()(const pg8::f32x4 (&acc)[2][2][4][2], const pg8::Unit& u, int wr, int wc, int fr, int fq) const {
        const int row0 = u.pm * 256 + wr * 64 + fr, col0 = u.pn * 256 + wc * 32 + 8 * fq;
#pragma unroll
        for (int ai = 0; ai < 2; ++ai)
#pragma unroll
            for (int m = 0; m < 4; ++m) { bf16_t* rowp = O + (size_t)(row0 + ai * 128 + m * 16) * ldc + col0;
#pragma unroll
                for (int bj = 0; bj < 2; ++bj) { const pg8::f32x4 v0 = acc[ai][bj][m][0], v1 = acc[ai][bj][m][1];
                    u32x4 w; w.x = cvtpk_s(v0[0], v0[1]); w.y = cvtpk_s(v0[2], v0[3]); w.z = cvtpk_s(v1[0], v1[1]); w.w = cvtpk_s(v1[2], v1[3]);
                    *(u32x4*)(rowp + bj * 128) = w; } }
    }
};
struct EpiGeluBf16 {
    static constexpr bool PERM = true, AFTER_DRAIN = false;
    bf16_t* O; int ldc; const float* bias;
    __device__ __forceinline__ void operator()(const pg8::f32x4 (&acc)[2][2][4][2], const pg8::Unit& u, int wr, int wc, int fr, int fq) const {
        const int row0 = u.pm * 256 + wr * 64 + fr, col0 = u.pn * 256 + wc * 32 + 8 * fq;
        pg8::f32x4 bv[2][2];
#pragma unroll
        for (int bj = 0; bj < 2; ++bj)
#pragma unroll
            for (int n = 0; n < 2; ++n) bv[bj][n] = *(const pg8::f32x4*)(bias + col0 + bj * 128 + 4 * n);
#pragma unroll
        for (int ai = 0; ai < 2; ++ai)
#pragma unroll
            for (int m = 0; m < 4; ++m) { bf16_t* rowp = O + (size_t)(row0 + ai * 128 + m * 16) * ldc + col0;
#pragma unroll
                for (int bj = 0; bj < 2; ++bj) { pg8::f32x4 v0 = acc[ai][bj][m][0] + bv[bj][0], v1 = acc[ai][bj][m][1] + bv[bj][1];
                    const pg8::f32x2 a = pg8::gelu_pk((pg8::f32x2){v0[0], v0[1]}), b = pg8::gelu_pk((pg8::f32x2){v0[2], v0[3]}), c = pg8::gelu_pk((pg8::f32x2){v1[0], v1[1]}), d = pg8::gelu_pk((pg8::f32x2){v1[2], v1[3]});
                    u32x4 w; w.x = cvtpk_s(a.x, a.y); w.y = cvtpk_s(b.x, b.y); w.z = cvtpk_s(c.x, c.y); w.w = cvtpk_s(d.x, d.y);
                    *(u32x4*)(rowp + bj * 128) = w; } }
    }
};
struct EpiResidual {
    static constexpr bool PERM = false, AFTER_DRAIN = false;
    float* H; const float* gate0; int row_base;
    __device__ __forceinline__ void operator()(const pg8::f32x4 (&acc)[2][2][4][2], const pg8::Unit& u, int wr, int wc, int fr, int fq) const {
        const int row0 = u.pm * 256 + wr * 64 + fr, col0 = u.pn * 256 + wc * 32 + 4 * fq;
        const Tok tk = tokinfo(row_base + u.pm * 256);
        const float* gate = gate0 + (size_t)tk.modrow * 6144 + col0;
        pg8::f32x4 gv[2][2];
#pragma unroll
        for (int bj = 0; bj < 2; ++bj)
#pragma unroll
            for (int n = 0; n < 2; ++n) gv[bj][n] = *(const pg8::f32x4*)(gate + bj * 128 + n * 16);
#pragma unroll
        for (int ai = 0; ai < 2; ++ai)
#pragma unroll
            for (int m = 0; m < 4; ++m) { float* rowp = H + (size_t)(row0 + ai * 128 + m * 16) * DM + col0;
#pragma unroll
                for (int bj = 0; bj < 2; ++bj)
#pragma unroll
                    for (int n = 0; n < 2; ++n) { pg8::f32x4* p = (pg8::f32x4*)(rowp + bj * 128 + n * 16); *p = *p + gv[bj][n] * acc[ai][bj][m][n]; } }
    }
};
struct ListOrder {
    const LAS int* list; int n; const LAS unsigned* rowtab;
    __device__ __forceinline__ bool next(int i, pg8::Unit& u) const {
        if (i >= n) return false;
        u.pm = __builtin_amdgcn_readfirstlane(list[2 * i]); u.pn = __builtin_amdgcn_readfirstlane(list[2 * i + 1]); return true;
    }
    __device__ __forceinline__ void a_ready(const pg8::Unit&) const {}
    __device__ __forceinline__ void done(const pg8::Unit&) const {}
};
struct EpiLora {
    static constexpr bool PERM = true, AFTER_DRAIN = false;
    bf16_t* O; const float* bias; int row_base;
    __device__ __forceinline__ void operator()(const pg8::f32x4 (&acc)[2][2][4][2], const pg8::Unit& u, int wr, int wc, int fr, int fq) const {
        const int seg = u.pn >> 1, row0 = row_base + u.pm * 256 + wr * 64 + fr, cs0 = (u.pn & 1) * 256 + wc * 32 + 8 * fq;
        const float ksig = seg < 2 ? -0.60653065971f : 1.0f; const bool lin = seg == 4;
        bf16_t* Os = O + (size_t)seg * NTOK * 512;
#pragma unroll
        for (int bj = 0; bj < 2; ++bj) {
            const int cs = cs0 + bj * 128;
            const pg8::f32x4 b0 = *(const pg8::f32x4*)(bias + seg * 512 + cs), b1 = *(const pg8::f32x4*)(bias + seg * 512 + cs + 4);
#pragma unroll
            for (int ai = 0; ai < 2; ++ai)
#pragma unroll
                for (int m = 0; m < 4; ++m) {
                    pg8::f32x4 v0 = acc[ai][bj][m][0] + b0, v1 = acc[ai][bj][m][1] + b1;
#pragma unroll
                    for (int r = 0; r < 4; ++r) {
                        const float t0 = ksig * __builtin_amdgcn_rcpf(1.0f + __expf(-v0[r])), t1 = ksig * __builtin_amdgcn_rcpf(1.0f + __expf(-v1[r]));
                        v0[r] = lin ? v0[r] : t0; v1[r] = lin ? v1[r] : t1;
                    }
                    u32x4 w; w.x = cvtpk_s(v0[0], v0[1]); w.y = cvtpk_s(v0[2], v0[3]); w.z = cvtpk_s(v1[0], v1[1]); w.w = cvtpk_s(v1[2], v1[3]);
                    *(u32x4*)(Os + (size_t)(row0 + ai * 128 + m * 16) * 512 + cs) = w;
                }
        }
    }
};
constexpr int LDS_TAB = 131072;
constexpr int LDS_LIST = LDS_TAB + 4096;
constexpr int LDS_ROWTAB = LDS_LIST + 1024;
__device__ __forceinline__ ListOrder build_units(LAS unsigned char* lds, int nM, int nN, int G, int c, const LAS int* tile_e, int ncol) {
    LAS int* list = (LAS int*)(lds + LDS_LIST);
    pg8::StaticOrder S; S.nM = nM; S.nN = nN; S.nwg = nM * nN; S.G = G; S.c = c;
    const int tid = tid_opaque();
    if (tid < 64) { pg8::Unit u; if (S.next(tid, u)) { if (tile_e) u.pn = tile_e[u.pm] * ncol + u.pn; list[2 * tid] = u.pm; list[2 * tid + 1] = u.pn; } }
    __syncthreads();
    ListOrder L; L.list = list; L.n = (c < S.nwg) ? (S.nwg - c + G - 1) / G : 0; L.rowtab = (const LAS unsigned*)(lds + LDS_ROWTAB);
    return L;
}
struct EpiMoe1 {
    static constexpr bool PERM = true, AFTER_DRAIN = false;
    bf16_t* O; const float* b1;
    __device__ __forceinline__ void operator()(const pg8::f32x4 (&acc)[2][2][4][2], const pg8::Unit& u, int wr, int wc, int fr, int fq) const {
        const int e = u.pn >> 3, pn = u.pn & 7;
        const int row0 = u.pm * 256 + wr * 64 + fr, ci = pn * 128 + wc * 32 + 8 * fq;
        const float* be = b1 + (size_t)e * 2048 + ci;
        const pg8::f32x4 bg0 = *(const pg8::f32x4*)(be), bg1 = *(const pg8::f32x4*)(be + 4), bl0 = *(const pg8::f32x4*)(be + 1024), bl1 = *(const pg8::f32x4*)(be + 1028);
#pragma unroll
        for (int ai = 0; ai < 2; ++ai)
#pragma unroll
            for (int m = 0; m < 4; ++m) {
                const pg8::f32x4 g0 = acc[ai][0][m][0] + bg0, g1 = acc[ai][0][m][1] + bg1, l0 = acc[ai][1][m][0] + bl0, l1 = acc[ai][1][m][1] + bl1;
                float o[8];
#pragma unroll
                for (int r = 0; r < 4; ++r) {
                    const float ga = fminf(g0[r], 7.0f), gb = fminf(g1[r], 7.0f);
                    const float la = fminf(fmaxf(l0[r], -7.0f), 7.0f), lb = fminf(fmaxf(l1[r], -7.0f), 7.0f);
                    o[r] = ga * __builtin_amdgcn_rcpf(1.0f + __expf(-1.702f * ga)) * (la + 1.0f);
                    o[4 + r] = gb * __builtin_amdgcn_rcpf(1.0f + __expf(-1.702f * gb)) * (lb + 1.0f);
                }
                int w0 = __builtin_amdgcn_cvt_pk_fp8_f32(o[0] * 4.0f, o[1] * 4.0f, 0, false); w0 = __builtin_amdgcn_cvt_pk_fp8_f32(o[2] * 4.0f, o[3] * 4.0f, w0, true);
                int w1 = __builtin_amdgcn_cvt_pk_fp8_f32(o[4] * 4.0f, o[5] * 4.0f, 0, false); w1 = __builtin_amdgcn_cvt_pk_fp8_f32(o[6] * 4.0f, o[7] * 4.0f, w1, true);
                *(u32x2*)((unsigned char*)O + (size_t)(row0 + ai * 128 + m * 16) * DM + ci) = (u32x2){(unsigned)w0, (unsigned)w1};
            }
    }
};
struct EpiMoe2 {
    static constexpr bool PERM = true, AFTER_DRAIN = false;
    bf16_t* O; const float* b2;
    __device__ __forceinline__ void operator()(const pg8::f32x4 (&acc)[2][2][4][2], const pg8::Unit& u, int wr, int wc, int fr, int fq) const {
        const int e = u.pn >> 2, pn = u.pn & 3;
        const int row0 = u.pm * 256 + wr * 64 + fr, col0 = pn * 256 + wc * 32 + 8 * fq;
        const float* be = b2 + (size_t)e * DM + col0;
        pg8::f32x4 bv[2][2];
#pragma unroll
        for (int bj = 0; bj < 2; ++bj)
#pragma unroll
            for (int n = 0; n < 2; ++n) bv[bj][n] = *(const pg8::f32x4*)(be + bj * 128 + 4 * n);
#pragma unroll
        for (int ai = 0; ai < 2; ++ai)
#pragma unroll
            for (int m = 0; m < 4; ++m) { bf16_t* rowp = O + (size_t)(row0 + ai * 128 + m * 16) * DM + col0;
#pragma unroll
                for (int bj = 0; bj < 2; ++bj) { const pg8::f32x4 v0 = acc[ai][bj][m][0] + bv[bj][0], v1 = acc[ai][bj][m][1] + bv[bj][1];
                    u32x4 w; w.x = cvtpk_s(v0[0], v0[1]); w.y = cvtpk_s(v0[2], v0[3]); w.z = cvtpk_s(v1[0], v1[1]); w.w = cvtpk_s(v1[2], v1[3]);
                    *(u32x4*)(rowp + bj * 128) = w; } }
    }
};

namespace att {
typedef float f32x16 __attribute__((ext_vector_type(16)));
typedef short s16x4 __attribute__((ext_vector_type(4)));
constexpr int KVBLK = 64, LDR = 512;
constexpr float QSCALE = 0.125f * 1.4426950408889634f;
constexpr int SHM_V = KVBLK * 128 * 2, SHM_K = KVBLK * 64 * 2, SHM_ATTN = 2 * SHM_V + 2 * SHM_K + NWAVES * 64 * 4;
#define ATT_KSWZ(row, colB) ((row) * 128 + ((colB) ^ ((((row) >> 1) & 7) << 4)))
#define ATT_SBAR() __builtin_amdgcn_sched_barrier(0)
__device__ __forceinline__ int crow(int r, int hi) { return (r & 3) + 8 * (r >> 2) + 4 * hi; }
__device__ __forceinline__ unsigned cvtpk(float lo, float hi) { unsigned r; asm volatile("v_cvt_pk_bf16_f32 %0, %1, %2" : "=v"(r) : "v"(lo), "v"(hi)); return r; }
constexpr float SHIFT = -12.0f;
__device__ __forceinline__ void partialSM(f32x16& p0) {
#pragma unroll
    for (int r = 0; r < 16; ++r) p0[r] = __builtin_amdgcn_exp2f(p0[r]);
}
__device__ __forceinline__ void finishSM(f32x16& p0, f32x16& p1, float& l_reg, bf16x8& pa0, bf16x8& pa1, bf16x8& pa2, bf16x8& pa3) {
#pragma unroll
    for (int r = 0; r < 16; ++r) p1[r] = __builtin_amdgcn_exp2f(p1[r]);
    float ps = 0;
#pragma unroll
    for (int r = 0; r < 16; ++r) ps += p0[r];
#pragma unroll
    for (int r = 0; r < 16; ++r) ps += p1[r];
    l_reg += ps;
#define ATT_PK4(P, BASE, OUT) do { unsigned a0 = cvtpk(P[BASE + 0], P[BASE + 1]), a1 = cvtpk(P[BASE + 2], P[BASE + 3]);   \
    unsigned b0 = cvtpk(P[BASE + 4], P[BASE + 5]), b1 = cvtpk(P[BASE + 6], P[BASE + 7]);                              \
    auto r0 = __builtin_amdgcn_permlane32_swap(a0, b0, false, false); auto r1 = __builtin_amdgcn_permlane32_swap(a1, b1, false, false); \
    u32x4 w = {r0[0], r1[0], r0[1], r1[1]}; OUT = __builtin_bit_cast(bf16x8, w); } while (0)
    ATT_PK4(p0, 0, pa0); ATT_PK4(p0, 8, pa1); ATT_PK4(p1, 0, pa2); ATT_PK4(p1, 8, pa3);
#undef ATT_PK4
}
__device__ __forceinline__ void qkt(f32x16& p0, f32x16& p1, const LAS unsigned char* Ks, int qaddr, int r32, int hi) {
    asm volatile("" : "+v"(qaddr)); const LAS unsigned char* qp = (const LAS unsigned char*)(uintptr_t)qaddr;
    bf16x8 qr[4];
#pragma unroll
    for (int d0 = 0; d0 < 4; ++d0) qr[d0] = *(const LAS bf16x8*)(qp + d0 * 1024);
#pragma unroll
    for (int r = 0; r < 16; ++r) { p0[r] = SHIFT; p1[r] = SHIFT; }
#pragma unroll
    for (int d0 = 0; d0 < 4; ++d0) { const int cb = (d0 * 16 + hi * 8) * 2;
        const bf16x8 b0 = *(const LAS bf16x8*)(Ks + ATT_KSWZ(r32, cb));
        const bf16x8 b1 = *(const LAS bf16x8*)(Ks + ATT_KSWZ(32 + r32, cb));
        p0 = __builtin_amdgcn_mfma_f32_32x32x16_bf16(b0, qr[d0], p0, 0, 0, 0);
        p1 = __builtin_amdgcn_mfma_f32_32x32x16_bf16(b1, qr[d0], p1, 0, 0, 0); }
}
__device__ __forceinline__ int v_st(int k, int c) { const int kk = (k & ~0xC) | ((k & 4) << 1) | ((k & 8) >> 1); return ((kk >> 3) * 4 + (c >> 5)) * 512 + ((kk & 7) * 32 + (c & 31)) * 2; }
__device__ __forceinline__ int v_rd_base(int lane) { return ((lane & 3) << 3) | (((lane >> 2) & 3) << 6) | (((lane >> 4) & 1) << 5) | (((lane >> 5) & 1) << 8); }
constexpr int v_rd_off(int d0, int ks, int half) { return d0 * 512 + ks * 4096 + half * 2048; }
template <int OFF> __device__ __forceinline__ s16x4 tr_read(int vb) { s16x4 r; asm volatile("ds_read_b64_tr_b16 %0, %1 offset:%2" : "=&v"(r) : "v"(vb), "i"(OFF) : "memory"); return r; }
template <int D0> __device__ __forceinline__ void pv_one(f32x16& od, int vb, bf16x8 pa0, bf16x8 pa1, bf16x8 pa2, bf16x8 pa3) {
    const s16x4 l0 = tr_read<v_rd_off(D0, 0, 0)>(vb), h0 = tr_read<v_rd_off(D0, 0, 1)>(vb), l1 = tr_read<v_rd_off(D0, 1, 0)>(vb), h1 = tr_read<v_rd_off(D0, 1, 1)>(vb);
    const s16x4 l2 = tr_read<v_rd_off(D0, 2, 0)>(vb), h2 = tr_read<v_rd_off(D0, 2, 1)>(vb), l3 = tr_read<v_rd_off(D0, 3, 0)>(vb), h3 = tr_read<v_rd_off(D0, 3, 1)>(vb);
    asm volatile("s_waitcnt lgkmcnt(0)" ::: "memory"); ATT_SBAR();
#define ATT_PK(L, H) (bf16x8){L[0], L[1], L[2], L[3], H[0], H[1], H[2], H[3]}
    od = __builtin_amdgcn_mfma_f32_32x32x16_bf16(pa0, ATT_PK(l0, h0), od, 0, 0, 0);
    od = __builtin_amdgcn_mfma_f32_32x32x16_bf16(pa1, ATT_PK(l1, h1), od, 0, 0, 0);
    od = __builtin_amdgcn_mfma_f32_32x32x16_bf16(pa2, ATT_PK(l2, h2), od, 0, 0, 0);
    od = __builtin_amdgcn_mfma_f32_32x32x16_bf16(pa3, ATT_PK(l3, h3), od, 0, 0, 0);
#undef ATT_PK
}
__device__ __forceinline__ void pv_d0(f32x16 (&o)[4], int vb, bf16x8 pa0, bf16x8 pa1, bf16x8 pa2, bf16x8 pa3) {
    pv_one<0>(o[0], vb, pa0, pa1, pa2, pa3); pv_one<1>(o[1], vb, pa0, pa1, pa2, pa3); pv_one<2>(o[2], vb, pa0, pa1, pa2, pa3); pv_one<3>(o[3], vb, pa0, pa1, pa2, pa3);
}
__device__ __forceinline__ void attn_body(const bf16_t* Qb, const bf16_t* Kh, const bf16_t* Vh, float* Ob, int seq, LAS unsigned char* lds) {
    const int tid = tid_opaque(), wid = tid >> 6, lane = tid & 63, r32 = lane & 31, hi = lane >> 5;
    LAS unsigned char* V_lds = lds; LAS unsigned char* K_lds = lds + 2 * SHM_V;
    LAS float* wsl = (LAS float*)(lds + 2 * SHM_V + 2 * SHM_K) + wid * 64; LAS float* li_l = wsl; LAS float* al_l = wsl + 32;
    float l_reg = 0; f32x16 o[4] = {};
    const bf16_t* Qw = Qb + (size_t)(wid * 32 + r32) * LDR + hi * 8;
    LAS unsigned char* qlds = lds + SHM_ATTN + wid * 4096 + lane * 16;
#pragma unroll
    for (int d0 = 0; d0 < 4; ++d0) *(LAS bf16x8*)(qlds + d0 * 1024) = *(const bf16x8*)(Qw + d0 * 16);
    const int qr = (int)(uintptr_t)qlds;
    const int sr = tid >> 4, sc = (tid & 15) * 8, vst0 = v_st(sr, sc), vst1 = v_st(32 + sr, sc);
    const int kr = tid >> 3, kc = (tid & 7) * 8, kst = ATT_KSWZ(kr, kc * 2);
    const int vb0 = (int)(uintptr_t)V_lds + v_rd_base(lane);
    bf16x8 vsA0, vsA1, ksA, vsB0, vsB1, ksB;
#define ATT_SLOAD(V0, V1, K0, k0) do { V0 = *(const bf16x8*)(Vh + (size_t)((k0) + sr) * LDR + sc); V1 = *(const bf16x8*)(Vh + (size_t)((k0) + 32 + sr) * LDR + sc); \
    K0 = *(const bf16x8*)(Kh + (size_t)((k0) + kr) * LDR + kc); } while (0)
#define ATT_SWRITE(b, V0, V1, K0) do { *(LAS bf16x8*)(V_lds + (b) * SHM_V + vst0) = V0; *(LAS bf16x8*)(V_lds + (b) * SHM_V + vst1) = V1; \
    *(LAS bf16x8*)(K_lds + (b) * SHM_K + kst) = K0; } while (0)
#define ATT_SWAIT() asm volatile("s_waitcnt vmcnt(3)" ::: "memory")
    f32x16 p0, p1; bf16x8 pa0, pa1, pa2, pa3; const int NT = seq / KVBLK;
    ATT_SLOAD(vsA0, vsA1, ksA, 0); asm volatile("s_waitcnt vmcnt(0)" ::: "memory"); ATT_SWRITE(0, vsA0, vsA1, ksA);
    ATT_SLOAD(vsB0, vsB1, ksB, KVBLK); if (2 < NT) ATT_SLOAD(vsA0, vsA1, ksA, 2 * KVBLK);
    ATT_SWAIT(); ATT_SWRITE(1, vsB0, vsB1, ksB); __syncthreads();
    for (int j = 0; j < NT; j += 2) {
        ATT_SBAR(); qkt(p0, p1, K_lds, qr, r32, hi); partialSM(p0);
        finishSM(p0, p1, l_reg, pa0, pa1, pa2, pa3); ATT_SBAR();
        if (j + 3 < NT) ATT_SLOAD(vsB0, vsB1, ksB, (j + 3) * KVBLK); ATT_SBAR();
        pv_d0(o, vb0, pa0, pa1, pa2, pa3); ATT_SBAR();
        __syncthreads();
        if (j + 2 < NT) { ATT_SWAIT(); ATT_SWRITE(0, vsA0, vsA1, ksA); }
        asm volatile("" : "+v"(o[0]), "+v"(o[1]), "+v"(o[2]), "+v"(o[3]));
        __syncthreads();
        ATT_SBAR(); qkt(p0, p1, K_lds + SHM_K, qr, r32, hi); partialSM(p0);
        finishSM(p0, p1, l_reg, pa0, pa1, pa2, pa3); ATT_SBAR();
        if (j + 4 < NT) ATT_SLOAD(vsA0, vsA1, ksA, (j + 4) * KVBLK); ATT_SBAR();
        pv_d0(o, vb0 + SHM_V, pa0, pa1, pa2, pa3); ATT_SBAR();
        __syncthreads();
        if (j + 3 < NT) { ATT_SWAIT(); ATT_SWRITE(1, vsB0, vsB1, ksB); }
        asm volatile("" : "+v"(o[0]), "+v"(o[1]), "+v"(o[2]), "+v"(o[3]));
        __syncthreads();
    }
    { auto rr = __builtin_amdgcn_permlane32_swap(__float_as_uint(l_reg), __float_as_uint(l_reg), false, false); l_reg = __uint_as_float(rr[0]) + __uint_as_float(rr[1]); }
    if (hi == 0) li_l[r32] = l_reg; asm volatile("s_waitcnt lgkmcnt(0)" ::: "memory");
    float rli[16];
#pragma unroll
    for (int r = 0; r < 16; ++r) rli[r] = __builtin_amdgcn_rcpf(li_l[crow(r, hi)]);
    float* Ow = Ob + (size_t)(wid * 32) * LDR;
#pragma unroll
    for (int r = 0; r < 16; ++r) { const int orow = crow(r, hi);
#pragma unroll
        for (int d0 = 0; d0 < 4; ++d0) Ow[(size_t)orow * LDR + d0 * 32 + r32] = o[d0][r] * rli[r]; }
#undef ATT_SLOAD
#undef ATT_SWRITE
#undef ATT_SWAIT
}
}

__device__ __forceinline__ void ph_gemm_win(const Args& A, int j, int row_lo, LAS unsigned char* lds, int bid, int nb) {
    unsigned char* ws = opq(A.ws); const float* const* IN = (const float* const*)(ws + WS_PTRS); (void)IN;
    pg8::Gemm g{(const bf16_t*)(ws + WS_ABF) + (size_t)row_lo * DM, (const bf16_t*)(ws + WS_WIN) + (size_t)j * ZLD * DM, NTOK - row_lo, ZLD, DM};
    const ListOrder S = build_units(lds, (NTOK - row_lo) / 256, ZLD / 256, nb, bid, nullptr, 0);
    EpiStoreBf16 E{(bf16_t*)(ws + WS_Z) + (size_t)row_lo * ZLD, ZLD};
    pg8::gemm_phase<EpiStoreBf16, ListOrder, true, true>(lds, g, S, E);
}

__device__ __forceinline__ void ph_rwkv_pre(const Args& A, int j, int row_lo, int bid, int nb) {
    unsigned char* ws = opq(A.ws); const float* const* IN = (const float* const*)(ws + WS_PTRS);
    const int tid = tid_opaque(), lane = tid & 63, wid = tid >> 6;
    const bf16_t* Z = (const bf16_t*)(ws + WS_Z);
    const float* mu = INP(I_RWMU) + (size_t)j * 2 * RWC; const float* kkw = INP(I_RWKK) + j * 512;
    bf16_t* RB = (bf16_t*)(ws + WS_RB); bf16_t* KS = (bf16_t*)(ws + WS_KS); bf16_t* VS = (bf16_t*)(ws + WS_VS); bf16_t* KKN = (bf16_t*)(ws + WS_KKN); bf16_t* LIN = (bf16_t*)(ws + WS_LIN);
#define UNPK8(dst, raw) do { _Pragma("unroll") for (int _i = 0; _i < 4; ++_i) { dst[2 * _i] = __builtin_bit_cast(float, raw[_i] << 16); dst[2 * _i + 1] = __builtin_bit_cast(float, raw[_i] & 0xffff0000u); } } while (0)
#define PK8(v) (u32x4){pk2(v[0], v[1]), pk2(v[2], v[3]), pk2(v[4], v[5]), pk2(v[6], v[7])}
    for (int g = row_lo + bid * NWAVES + wid; g < NTOK; g += nb * NWAVES) {
        const Tok tk = tokinfo(g);
        const bool hp = tk.t > 0, hn = tk.t < tk.T - 1;
        const bf16_t* zc = Z + (size_t)g * ZLD;
#pragma unroll
        for (int i = 0; i < 4; ++i) {
            const int ch = i * 64 + lane, col = ch * 8;
            if (ch < 240) {
                const u32x4 zero = {0u, 0u, 0u, 0u};
                const u32x4 cr = *(const u32x4*)(zc + col), pr = hp ? *(const u32x4*)(zc - ZLD + col) : zero, nr = hn ? *(const u32x4*)(zc + ZLD + col) : zero;
                float z[8], p[8], n[8], s8[8];
                UNPK8(z, cr); UNPK8(p, pr); UNPK8(n, nr);
                const f32x4 m0a = *(const f32x4*)(mu + col), m0b = *(const f32x4*)(mu + col + 4), m1a = *(const f32x4*)(mu + RWC + col), m1b = *(const f32x4*)(mu + RWC + col + 4);
#pragma unroll
                for (int e = 0; e < 4; ++e) { s8[e] = z[e] + m0a[e] * (p[e] - z[e]) + m1a[e] * (n[e] - z[e]); s8[4 + e] = z[4 + e] + m0b[e] * (p[4 + e] - z[4 + e]) + m1b[e] * (n[4 + e] - z[4 + e]); }
                if (col < 512) *(u32x4*)(RB + (size_t)g * 512 + col) = PK8(s8);
                else if (col < 1024) {
                    const int ck = col - 512;
                    *(u32x4*)(KS + (size_t)g * 512 + ck) = PK8(s8);
                    const f32x4 kwa = *(const f32x4*)(kkw + ck), kwb = *(const f32x4*)(kkw + ck + 4);
                    float kk[8]; float ss = 0.f;
#pragma unroll
                    for (int e = 0; e < 4; ++e) { kk[e] = s8[e] * kwa[e]; kk[4 + e] = s8[4 + e] * kwb[e]; ss += kk[e] * kk[e] + kk[4 + e] * kk[4 + e]; }
                    ss += __shfl_xor(ss, 1); ss += __shfl_xor(ss, 2); ss += __shfl_xor(ss, 4);
                    const float inv = 1.0f / fmaxf(sqrtf(ss), 1e-12f);
#pragma unroll
                    for (int e = 0; e < 8; ++e) kk[e] *= inv;
                    *(u32x4*)(KKN + (size_t)g * 512 + ck) = PK8(kk);
                }
                else if (col < 1536) *(u32x4*)(VS + (size_t)g * 512 + (col - 1024)) = PK8(s8);
                else {
                    float t8[8];
#pragma unroll
                    for (int e = 0; e < 8; ++e) t8[e] = col < 1664 ? tanhf(s8[e]) : (col < 1792 ? s8[e] : sigmoidf_(s8[e]));
                    *(u32x4*)(LIN + (size_t)g * 384 + (col - 1536)) = PK8(t8);
                }
            }
        }
    }
#undef UNPK8
#undef PK8
}
__device__ __forceinline__ void ph_gemm_lora(const Args& A, int j, int row_lo, LAS unsigned char* lds, int bid, int nb) {
    unsigned char* ws = opq(A.ws);
    int Kq = LORA_K; asm volatile("" : "+s"(Kq));
    pg8::Gemm g{(const bf16_t*)(ws + WS_LIN) + (size_t)row_lo * LORA_K, (const bf16_t*)(ws + WS_WLORA) + (size_t)j * LORA_N * LORA_K, NTOK - row_lo, LORA_N, Kq};
    const ListOrder S = build_units(lds, (NTOK - row_lo) / 256, LORA_N / 256, nb, bid, nullptr, 0);
    EpiLora E{(bf16_t*)(ws + WS_LO), (const float*)(ws + WS_LBIAS) + (size_t)j * LORA_N, row_lo};
    pg8::gemm_phase<EpiLora, ListOrder, true, true>(lds, g, S, E);
}

constexpr int R_A2 = 0, R_RT = 2048, R_BT = 4096, R_KT = 6144, R_VT = 8192, R_MBR = 10240, R_MKR = 10752, R_G = 11264, R_P = 11776;
__device__ __forceinline__ bf16x8 frag4(u32x2 lo) { const u32x4 w = {lo.x, lo.y, 0u, 0u}; return __builtin_bit_cast(bf16x8, w); }
__device__ __forceinline__ bf16x8 frag8(u32x2 lo, u32x2 hi) { const u32x4 w = {lo.x, lo.y, hi.x, hi.y}; return __builtin_bit_cast(bf16x8, w); }
__device__ __forceinline__ u32x2 pack4(f32x4 v) { u32x2 o; o.x = cvtpk_s(v[0], v[1]); o.y = cvtpk_s(v[2], v[3]); return o; }
__device__ __forceinline__ int wkv_token(int b, int dir, int s) {
    if (s < TC) return b * TC + (dir ? (TC - 1 - s) : s);
    const int q = s - TC; return NCTX + b * TL + (dir ? (TL - 1 - q) : q);
}
__device__ __forceinline__ float dpp_row_shr(float x, const int n) {
    switch (n) {
        case 1: return __builtin_bit_cast(float, __builtin_amdgcn_update_dpp(0, __builtin_bit_cast(int, x), 0x111, 0xF, 0xF, false));
        case 2: return __builtin_bit_cast(float, __builtin_amdgcn_update_dpp(0, __builtin_bit_cast(int, x), 0x112, 0xF, 0xF, false));
        case 4: return __builtin_bit_cast(float, __builtin_amdgcn_update_dpp(0, __builtin_bit_cast(int, x), 0x114, 0xF, 0xF, false));
        default: return __builtin_bit_cast(float, __builtin_amdgcn_update_dpp(0, __builtin_bit_cast(int, x), 0x118, 0xF, 0xF, false));
    }
}
#define WKV_TR(dst, addr) asm volatile("ds_read_b64_tr_b16 %0, %1" : "=&v"(dst) : "v"(addr) : "memory")
__device__ __forceinline__ void ph_wkv_prep(const Args& A, int j, LAS unsigned char* lds, int bid, int nb) {
    unsigned char* ws = opq(A.ws); const float* const* IN = (const float* const*)(ws + WS_PTRS);
    const int tid = tid_opaque(), lane = tid & 63, wid = tid >> 6, c16 = lane & 15, g4 = lane >> 4;
    constexpr int RS = 144;
    LAS unsigned char* wl = lds + wid * 16384;
    LAS unsigned char* Lat = wl; LAS unsigned char* Lbt = wl + 2304; LAS unsigned char* Lkt = wl + 4608; LAS unsigned char* Lrt = wl + 6912; LAS unsigned char* Lvt = wl + 9216;
    LAS float* Lnf = (LAS float*)(wl + 11520);
    LAS unsigned char* Lx = wl + 12608;
    const size_t FS = (size_t)NTOK * 512;
    const bf16_t* RB = (const bf16_t*)(ws + WS_RB); const bf16_t* KS = (const bf16_t*)(ws + WS_KS); const bf16_t* VS = (const bf16_t*)(ws + WS_VS); const bf16_t* KKN = (const bf16_t*)(ws + WS_KKN);
#define UNPK16(dst, p) do { const u32x4 _a = *(const u32x4*)(p), _b = *(const u32x4*)((p) + 8); _Pragma("unroll") for (int _i = 0; _i < 4; ++_i) { \
        dst[2 * _i] = __builtin_bit_cast(float, _a[_i] << 16); dst[2 * _i + 1] = __builtin_bit_cast(float, _a[_i] & 0xffff0000u); \
        dst[8 + 2 * _i] = __builtin_bit_cast(float, _b[_i] << 16); dst[9 + 2 * _i] = __builtin_bit_cast(float, _b[_i] & 0xffff0000u); } } while (0)
#define PK16ST(base, v) do { *(LAS u32x4*)(base) = (u32x4){pk2(v[0], v[1]), pk2(v[2], v[3]), pk2(v[4], v[5]), pk2(v[6], v[7])}; \
        *(LAS u32x4*)((base) + 16) = (u32x4){pk2(v[8], v[9]), pk2(v[10], v[11]), pk2(v[12], v[13]), pk2(v[14], v[15])}; } while (0)
    for (int unit = bid * NWAVES + wid; unit < 256 * WKV_NCH; unit += nb * NWAVES) {
        const int inst = unit / WKV_NCH, c = unit - inst * WKV_NCH, dir = inst & 1, h = (inst >> 1) & 7, b = inst >> 4;
        const int g0 = wkv_token(b, dir, c * 16), gstep = dir ? -1 : 1;
        unsigned char* rec = ws + WS_WKV + (size_t)unit * WKV_REC;
        {
            const size_t o = (size_t)(g0 + gstep * c16) * 512 + h * 64 + 16 * g4;
            float lw[16], av[16], kv[16], kn[16], rv[16];
            UNPK16(lw, (const bf16_t*)(ws + WS_LO) + dir * FS + o); UNPK16(av, (const bf16_t*)(ws + WS_AB) + dir * FS + o);
            UNPK16(kv, KS + o); UNPK16(kn, KKN + o); UNPK16(rv, RB + o);
            { const u32x4 v0 = *(const u32x4*)(VS + o), v1 = *(const u32x4*)(VS + o + 8); *(LAS u32x4*)(Lvt + c16 * RS + 32 * g4) = v0; *(LAS u32x4*)(Lvt + c16 * RS + 32 * g4 + 16) = v1; }
            const float* kap = INP(I_RWKA) + j * 512 + h * 64 + 16 * g4;
            float at[16], bt[16], kt[16], rt[16], ecl[16];
#pragma unroll
            for (int i = 0; i < 16; ++i) {
                float cs = lw[i];
                cs += dpp_row_shr(cs, 1); cs += dpp_row_shr(cs, 2); cs += dpp_row_shr(cs, 4); cs += dpp_row_shr(cs, 8);
                const float ep = __expf(cs - lw[i]), ec = __expf(cs), em = __builtin_amdgcn_rcpf(ec);
                at[i] = -kn[i] * ep; bt[i] = kn[i] * av[i] * em; kt[i] = kv[i] * (1.0f + (av[i] - 1.0f) * kap[i]) * em; rt[i] = rv[i] * ec; ecl[i] = ec;
            }
            PK16ST(Lat + c16 * RS + 32 * g4, at); PK16ST(Lbt + c16 * RS + 32 * g4, bt); PK16ST(Lkt + c16 * RS + 32 * g4, kt); PK16ST(Lrt + c16 * RS + 32 * g4, rt);
            if (c16 == 15) {
#pragma unroll
                for (int q = 0; q < 4; ++q) *(f32x4*)(rec + R_P + (16 * g4 + 4 * q) * 4) = (f32x4){ecl[4 * q], ecl[4 * q + 1], ecl[4 * q + 2], ecl[4 * q + 3]};
            }
        }
        asm volatile("s_waitcnt lgkmcnt(0)" ::: "memory");
        f32x4 nD = {0.f, 0.f, 0.f, 0.f}, makD = nD, mbrD = nD, mkrD = nD;
#pragma unroll
        for (int ks = 0; ks < 2; ++ks) {
            const int off = c16 * RS + (32 * ks + 8 * g4) * 2;
            const bf16x8 fa = *(const LAS bf16x8*)(Lat + off), fb = *(const LAS bf16x8*)(Lbt + off), fk = *(const LAS bf16x8*)(Lkt + off), fr = *(const LAS bf16x8*)(Lrt + off);
            nD = __builtin_amdgcn_mfma_f32_16x16x32_bf16(fa, fb, nD, 0, 0, 0);
            makD = __builtin_amdgcn_mfma_f32_16x16x32_bf16(fa, fk, makD, 0, 0, 0);
            mbrD = __builtin_amdgcn_mfma_f32_16x16x32_bf16(fb, fr, mbrD, 0, 0, 0);
            mkrD = __builtin_amdgcn_mfma_f32_16x16x32_bf16(fk, fr, mkrD, 0, 0, 0);
        }
#pragma unroll
        for (int r = 0; r < 4; ++r) {
            const int row = 4 * g4 + r;
            nD[r] = (c16 < row) ? nD[r] : 0.f; makD[r] = (c16 < row) ? makD[r] : 0.f;
            mbrD[r] = (row <= c16) ? mbrD[r] : 0.f; mkrD[r] = (row <= c16) ? mkrD[r] : 0.f;
            Lnf[row * 17 + c16] = nD[r];
        }
        asm volatile("s_waitcnt lgkmcnt(0)" ::: "memory");
        float x[16];
#pragma unroll
        for (int t = 0; t < 16; ++t) {
            float acc = (t == c16) ? 1.f : 0.f;
#pragma unroll
            for (int i = 0; i < t; ++i) acc += Lnf[t * 17 + i] * x[i];
            x[t] = acc;
        }
        if (g4 == 0) {
#pragma unroll
            for (int t = 0; t < 16; ++t) *(LAS bf16_t*)(Lx + t * 32 + c16 * 2) = (bf16_t)f2bf(x[t]);
        }
        asm volatile("s_waitcnt lgkmcnt(0)" ::: "memory");
        const bf16x8 xB = frag4(*(const LAS u32x2*)(Lx + c16 * 32 + g4 * 8));
        const f32x4 z4 = {0.f, 0.f, 0.f, 0.f};
        const f32x4 gD = __builtin_amdgcn_mfma_f32_16x16x32_bf16(frag4(pack4(makD)), xB, z4, 0, 0, 0);
        *(u32x2*)(rec + R_G + (c16 * 16 + 4 * g4) * 2) = pack4(gD);
        *(u32x2*)(rec + R_MBR + (c16 * 16 + 4 * g4) * 2) = pack4(mbrD);
        *(u32x2*)(rec + R_MKR + (c16 * 16 + 4 * g4) * 2) = pack4(mkrD);
        {
            const int trow = c16 >> 2, tcol = 4 * (c16 & 3);
            u32x2 ta[4], tb[4], tk[4], tv[4];
#pragma unroll
            for (int m = 0; m < 4; ++m) {
                const int aA = (int)(uintptr_t)(Lat + (4 * g4 + trow) * RS + (16 * m + tcol) * 2);
                const int offr = (4 * m + trow) * RS + (16 * g4 + tcol) * 2;
                const int aB = (int)(uintptr_t)(Lbt + offr), aK = (int)(uintptr_t)(Lkt + offr), aV = (int)(uintptr_t)(Lvt + offr);
                WKV_TR(ta[m], aA); WKV_TR(tb[m], aB); WKV_TR(tk[m], aK); WKV_TR(tv[m], aV);
            }
            asm volatile("s_waitcnt lgkmcnt(0)" ::: "memory"); __builtin_amdgcn_sched_barrier(0);
#pragma unroll
            for (int m = 0; m < 4; ++m) {
                const f32x4 d = __builtin_amdgcn_mfma_f32_16x16x32_bf16(frag4(ta[m]), xB, z4, 0, 0, 0);
                *(u32x2*)(rec + R_A2 + (c16 * 64 + 16 * m + 4 * g4) * 2) = pack4(d);
            }
            const int kch = 16 * g4 + c16;
            *(u32x4*)(rec + R_BT + kch * 32) = (u32x4){tb[0].x, tb[0].y, tb[1].x, tb[1].y}; *(u32x4*)(rec + R_BT + kch * 32 + 16) = (u32x4){tb[2].x, tb[2].y, tb[3].x, tb[3].y};
            *(u32x4*)(rec + R_KT + kch * 32) = (u32x4){tk[0].x, tk[0].y, tk[1].x, tk[1].y}; *(u32x4*)(rec + R_KT + kch * 32 + 16) = (u32x4){tk[2].x, tk[2].y, tk[3].x, tk[3].y};
            *(u32x4*)(rec + R_VT + kch * 32) = (u32x4){tv[0].x, tv[0].y, tv[1].x, tv[1].y}; *(u32x4*)(rec + R_VT + kch * 32 + 16) = (u32x4){tv[2].x, tv[2].y, tv[3].x, tv[3].y};
        }
        { const int row = lane >> 2, cb = (lane & 3) * 16;
          const u32x4 r0 = *(const LAS u32x4*)(Lrt + row * RS + cb * 2), r1 = *(const LAS u32x4*)(Lrt + row * RS + cb * 2 + 16);
          *(u32x4*)(rec + R_RT + (row * 64 + cb) * 2) = r0; *(u32x4*)(rec + R_RT + (row * 64 + cb) * 2 + 16) = r1; }
        asm volatile("s_waitcnt lgkmcnt(0)" ::: "memory");
    }
#undef UNPK16
#undef PK16ST
}
constexpr int WKV_D = 6, WKV_R = WKV_D + 2;
__device__ __forceinline__ void ph_wkv_scan(const Args& A, LAS unsigned char* lds, int bid, int nb) {
    unsigned char* ws = opq(A.ws);
    const int tid = tid_opaque(), lane = tid & 63, wid = __builtin_amdgcn_readfirstlane(tid >> 6), c16 = lane & 15, g4 = lane >> 4;
    float* YS = (float*)(ws + WS_YS); const size_t FS = (size_t)NTOK * 512;
    for (int inst = bid; inst < 256; inst += nb) {
        const int dir = inst & 1, h = (inst >> 1) & 7, b = inst >> 4;
        const unsigned char* rec0 = ws + WS_WKV + (size_t)inst * WKV_NCH * WKV_REC;
        asm volatile("s_waitcnt vmcnt(0) lgkmcnt(0)" ::: "memory"); __builtin_amdgcn_s_barrier();
        if (wid >= 4) {
            const int p0 = 3 * (wid - 4);
#define WKV_ISSUE(c_) do { const unsigned char* src_ = rec0 + (size_t)(c_) * WKV_REC + p0 * 1024 + lane * 16; LAS unsigned char* dst_ = lds + ((c_) % WKV_R) * WKV_REC + p0 * 1024; \
        _Pragma("unroll") for (int i_ = 0; i_ < 3; ++i_) __builtin_amdgcn_global_load_lds((const unsigned*)(src_ + i_ * 1024), (LAS unsigned*)(dst_ + i_ * 1024), 16, 0, 0); } while (0)
            for (int c = 0; c < WKV_D; ++c) WKV_ISSUE(c);
            for (int c = 0; c < WKV_NCH; ++c) {
                if (c + WKV_D < WKV_NCH) { WKV_ISSUE(c + WKV_D); asm volatile("s_waitcnt vmcnt(18)" ::: "memory"); }
                else asm volatile("s_waitcnt vmcnt(0)" ::: "memory");
                __builtin_amdgcn_s_barrier();
            }
#undef WKV_ISSUE
        } else {
            const int v0 = wid * 16;
            float* Y = YS + dir * FS + h * 64 + v0 + c16;
            f32x4 S[4];
#pragma unroll
            for (int mt = 0; mt < 4; ++mt) S[mt] = (f32x4){0.f, 0.f, 0.f, 0.f};
            for (int c = 0; c < WKV_NCH; ++c) {
                __builtin_amdgcn_s_barrier();
                const LAS unsigned char* rec = lds + (c % WKV_R) * WKV_REC;
                u32x2 a2[4], rt[4], bt[4], kt[4]; f32x4 p[4];
#pragma unroll
                for (int q = 0; q < 4; ++q) {
                    a2[q] = *(const LAS u32x2*)(rec + R_A2 + (c16 * 64 + 16 * q + 4 * g4) * 2);
                    rt[q] = *(const LAS u32x2*)(rec + R_RT + (c16 * 64 + 16 * q + 4 * g4) * 2);
                    bt[q] = *(const LAS u32x2*)(rec + R_BT + ((16 * q + c16) * 16 + 4 * g4) * 2);
                    kt[q] = *(const LAS u32x2*)(rec + R_KT + ((16 * q + c16) * 16 + 4 * g4) * 2);
                    p[q] = *(const LAS f32x4*)(rec + R_P + (16 * q + 4 * g4) * 4);
                }
                const u32x2 gq = *(const LAS u32x2*)(rec + R_G + (c16 * 16 + 4 * g4) * 2), mkr = *(const LAS u32x2*)(rec + R_MKR + (c16 * 16 + 4 * g4) * 2), mbr = *(const LAS u32x2*)(rec + R_MBR + (c16 * 16 + 4 * g4) * 2);
                const u32x2 vt = *(const LAS u32x2*)(rec + R_VT + ((v0 + c16) * 16 + 4 * g4) * 2);
                const f32x4 z4 = {0.f, 0.f, 0.f, 0.f};
                const bf16x8 sb0 = frag8(pack4(S[0]), pack4(S[1])), sb1 = frag8(pack4(S[2]), pack4(S[3]));
                const bf16x8 vb = frag4(vt);
                f32x4 U = __builtin_amdgcn_mfma_f32_16x16x32_bf16(frag4(gq), vb, z4, 0, 0, 0);
                U = __builtin_amdgcn_mfma_f32_16x16x32_bf16(frag8(a2[0], a2[1]), sb0, U, 0, 0, 0);
                U = __builtin_amdgcn_mfma_f32_16x16x32_bf16(frag8(a2[2], a2[3]), sb1, U, 0, 0, 0);
                f32x4 Yt = __builtin_amdgcn_mfma_f32_16x16x32_bf16(frag4(mkr), vb, z4, 0, 0, 0);
                Yt = __builtin_amdgcn_mfma_f32_16x16x32_bf16(frag8(rt[0], rt[1]), sb0, Yt, 0, 0, 0);
                Yt = __builtin_amdgcn_mfma_f32_16x16x32_bf16(frag8(rt[2], rt[3]), sb1, Yt, 0, 0, 0);
                const bf16x8 ub = frag4(pack4(U));
                Yt = __builtin_amdgcn_mfma_f32_16x16x32_bf16(frag4(mbr), ub, Yt, 0, 0, 0);
#pragma unroll
                for (int mt = 0; mt < 4; ++mt) {
                    f32x4 sn = __builtin_amdgcn_mfma_f32_16x16x32_bf16(frag4(kt[mt]), vb, S[mt], 0, 0, 0);
                    sn = __builtin_amdgcn_mfma_f32_16x16x32_bf16(frag4(bt[mt]), ub, sn, 0, 0, 0);
                    S[mt] = sn * p[mt];
                }
#pragma unroll
                for (int r = 0; r < 4; ++r) Y[(size_t)wkv_token(b, dir, c * 16 + 4 * g4 + r) * 512] = Yt[r];
            }
        }
    }
}

__device__ __forceinline__ void ph_qk(const Args& A, int j, int row_lo, int bid, int nb) {
    unsigned char* ws = opq(A.ws); const float* const* IN = (const float* const*)(ws + WS_PTRS);
    const int tid = tid_opaque(), lane = tid & 63, wid = tid >> 6;
    const bf16_t* Z = (const bf16_t*)(ws + WS_Z);
    bf16_t* QB = (bf16_t*)(ws + WS_QB); bf16_t* KB = (bf16_t*)(ws + WS_KB); bf16_t* VB = (bf16_t*)(ws + WS_VB);
    const int d0 = (lane & 7) * 8;
    float qn[8], kn[8], invf[8];
#pragma unroll
    for (int i = 0; i < 8; ++i) { qn[i] = INP(I_QN)[j * 64 + d0 + i]; kn[i] = INP(I_KN)[j * 64 + d0 + i]; invf[i] = __powf(10000.0f, -(float)((d0 + i) & 15) / 16.0f); }
    const bool upper = (d0 & 16) != 0, colaxis = (d0 & 32) != 0;
    for (int g = row_lo + bid * NWAVES + wid; g < NTOK; g += nb * NWAVES) {
        const Tok tk = tokinfo(g);
        const size_t krow = (size_t)tk.b * (TC + TL) + (tk.T == TL ? TC + tk.t : tk.t);
        const bf16_t* zr = Z + (size_t)g * ZLD + RWC;
        *(u32x4*)(VB + krow * 512 + lane * 8) = *(const u32x4*)(zr + 1024 + lane * 8);
        float cs[8], sn[8];
        if (tk.T == TL) {
            const float pos = (float)(colaxis ? (tk.t & 63) : (tk.t >> 6));
#pragma unroll
            for (int i = 0; i < 8; ++i) __sincosf(pos * invf[i], &sn[i], &cs[i]);
        }
#pragma unroll
        for (int isk = 0; isk < 2; ++isk) {
            const u32x4 raw = *(const u32x4*)(zr + isk * 512 + lane * 8);
            float x[8];
#pragma unroll
            for (int i = 0; i < 4; ++i) { x[2 * i] = __builtin_bit_cast(float, raw[i] << 16); x[2 * i + 1] = __builtin_bit_cast(float, raw[i] & 0xffff0000u); }
            float ss = 0.f;
#pragma unroll
            for (int i = 0; i < 8; ++i) ss += x[i] * x[i];
            ss += __shfl_xor(ss, 1); ss += __shfl_xor(ss, 2); ss += __shfl_xor(ss, 4);
            const float rs = rsqrtf(ss * (1.0f / 64.0f) + 1e-6f);
#pragma unroll
            for (int i = 0; i < 8; ++i) x[i] = x[i] * rs * (isk ? kn[i] : qn[i] * att::QSCALE);
            if (tk.T == TL) {
#pragma unroll
                for (int i = 0; i < 8; ++i) { const float other = __shfl_xor(x[i], 2); x[i] = upper ? (x[i] * cs[i] + other * sn[i]) : (x[i] * cs[i] - other * sn[i]); }
            }
            u32x4 o; o.x = pk2(x[0], x[1]); o.y = pk2(x[2], x[3]); o.z = pk2(x[4], x[5]); o.w = pk2(x[6], x[7]);
            if (isk) *(u32x4*)(KB + krow * 512 + lane * 8) = o; else *(u32x4*)(QB + (size_t)g * 512 + lane * 8) = o;
        }
    }
}

__device__ __forceinline__ void ph_attn(const Args& A, bool want_ctx, LAS unsigned char* lds, int bid, int nb) {
    unsigned char* ws = opq(A.ws);
    const bf16_t* QB = (const bf16_t*)(ws + WS_QB); const bf16_t* KB = (const bf16_t*)(ws + WS_KB); const bf16_t* VB = (const bf16_t*)(ws + WS_VB);
    float* OP = (float*)(ws + WS_OP);
    const int vcu = (nb % 8 == 0) ? (bid % 8) * (nb / 8) + bid / 8 : bid;
    const int nunits = 1024 + (want_ctx ? 128 : 0);
    for (int u = vcu; u < nunits; u += nb) {
        int b, h, m, q0, seq;
        if (u < 1024) { const int qb = u & 7; m = (u >> 3) & 1; h = (u >> 4) & 3; b = u >> 6; q0 = NCTX + b * TL + qb * 256; seq = TC + TL; }
        else { const int v = u - 1024; m = v & 1; h = (v >> 1) & 3; b = v >> 3; q0 = b * TC; seq = TC; }
        const int s = h * 2 + m;
        att::attn_body(QB + (size_t)q0 * 512 + s * 64, KB + (size_t)b * (TC + TL) * 512 + s * 64, VB + (size_t)b * (TC + TL) * 512 + h * 128,
                       OP + (size_t)m * NTOK * 512 + (size_t)q0 * 512 + h * 128, seq, lds);
    }
}

__device__ __forceinline__ void ph_merge(const Args& A, int l, int row_lo, int bid, int nb) {
    unsigned char* ws = opq(A.ws); const float* const* IN = (const float* const*)(ws + WS_PTRS);
    const int j = l >> 1;
    const int tid = tid_opaque(), lane = tid & 63, wid = tid >> 6, c0 = lane * 8;
    const float lam_init = 0.8f - 0.6f * __expf(-0.3f * (float)l);
    const float* lp = INP(I_LAM) + j * 4 * 64;
    const float lam = __expf(wave_sum(lp[lane] * lp[64 + lane])) - __expf(wave_sum(lp[128 + lane] * lp[192 + lane])) + lam_init;
    const size_t FS = (size_t)NTOK * 512;
    const bf16_t* RB = (const bf16_t*)(ws + WS_RB); const bf16_t* KS = (const bf16_t*)(ws + WS_KS); const bf16_t* VS = (const bf16_t*)(ws + WS_VS);
    const bf16_t* AB = (const bf16_t*)(ws + WS_AB); const bf16_t* GB = (const bf16_t*)(ws + WS_GB);
    const float* YS = (const float*)(ws + WS_YS); const float* OP = (const float*)(ws + WS_OP);
    bf16_t* CAT = (bf16_t*)(ws + WS_CAT);
    float gnw[8], gnb[8], kaw[8], rkw[8], sub[8];
#pragma unroll
    for (int i = 0; i < 8; ++i) { gnw[i] = INP(I_GNW)[j * 512 + c0 + i]; gnb[i] = INP(I_GNB)[j * 512 + c0 + i]; kaw[i] = INP(I_RWKA)[j * 512 + c0 + i]; rkw[i] = INP(I_RWRK)[j * 512 + c0 + i];
        sub[i] = INP(I_SUBLN)[j * 128 + ((c0 + i) & 127)] * (1.0f - lam_init); }
#define LD8BF(dst, ptr) do { const u32x4 _t = *(const u32x4*)(ptr); _Pragma("unroll") for (int _i = 0; _i < 4; ++_i) { dst[2 * _i] = __builtin_bit_cast(float, _t[_i] << 16); dst[2 * _i + 1] = __builtin_bit_cast(float, _t[_i] & 0xffff0000u); } } while (0)
    for (int g = row_lo + bid * NWAVES + wid; g < NTOK; g += nb * NWAVES) {
        const size_t o = (size_t)g * 512 + c0;
        float y[8], r_[8], k_[8], v_[8], a0[8], a1[8], gg[8];
        { const f32x4 y0 = *(const f32x4*)(YS + o), y1 = *(const f32x4*)(YS + o + 4), z0 = *(const f32x4*)(YS + FS + o), z1 = *(const f32x4*)(YS + FS + o + 4);
#pragma unroll
          for (int i = 0; i < 4; ++i) { y[i] = y0[i] + z0[i]; y[4 + i] = y1[i] + z1[i]; } }
        LD8BF(r_, RB + o); LD8BF(k_, KS + o); LD8BF(v_, VS + o); LD8BF(a0, AB + o); LD8BF(a1, AB + FS + o); LD8BF(gg, GB + o);
        float sy = 0.f, sb = 0.f;
#pragma unroll
        for (int i = 0; i < 8; ++i) { sy += y[i]; sb += r_[i] * k_[i] * (2.0f + (a0[i] + a1[i] - 2.0f) * kaw[i]) * rkw[i]; }
        sy += __shfl_xor(sy, 1); sy += __shfl_xor(sy, 2); sy += __shfl_xor(sy, 4);
        sb += __shfl_xor(sb, 1); sb += __shfl_xor(sb, 2); sb += __shfl_xor(sb, 4);
        const float mu = sy * (1.0f / 64.0f);
        float sv = 0.f;
#pragma unroll
        for (int i = 0; i < 8; ++i) { y[i] -= mu; sv += y[i] * y[i]; }
        sv += __shfl_xor(sv, 1); sv += __shfl_xor(sv, 2); sv += __shfl_xor(sv, 4);
        const float rstd = rsqrtf(sv * (1.0f / 64.0f) + 64e-5f);
        float ya[8];
#pragma unroll
        for (int i = 0; i < 8; ++i) ya[i] = (y[i] * rstd * gnw[i] + gnb[i] + sb * v_[i]) * gg[i];
        { u32x4 w; w.x = pk2(ya[0], ya[1]); w.y = pk2(ya[2], ya[3]); w.z = pk2(ya[4], ya[5]); w.w = pk2(ya[6], ya[7]); *(u32x4*)(CAT + (size_t)g * DM + c0) = w; }
        float od[8];
        { const f32x4 p0 = *(const f32x4*)(OP + o), p1 = *(const f32x4*)(OP + o + 4), q0 = *(const f32x4*)(OP + FS + o), q1 = *(const f32x4*)(OP + FS + o + 4);
#pragma unroll
          for (int i = 0; i < 4; ++i) { od[i] = p0[i] - lam * q0[i]; od[4 + i] = p1[i] - lam * q1[i]; } }
        float so = 0.f;
#pragma unroll
        for (int i = 0; i < 8; ++i) so += od[i] * od[i];
        so += __shfl_xor(so, 1); so += __shfl_xor(so, 2); so += __shfl_xor(so, 4); so += __shfl_xor(so, 8);
        const float ro = rsqrtf(so * (1.0f / 128.0f) + 1e-6f);
        { u32x4 w; w.x = pk2(od[0] * ro * sub[0], od[1] * ro * sub[1]); w.y = pk2(od[2] * ro * sub[2], od[3] * ro * sub[3]);
          w.z = pk2(od[4] * ro * sub[4], od[5] * ro * sub[5]); w.w = pk2(od[6] * ro * sub[6], od[7] * ro * sub[7]); *(u32x4*)(CAT + (size_t)g * DM + 512 + c0) = w; }
    }
#undef LD8BF
}

__device__ __forceinline__ void ph_gemm_out(const Args& A, int l, size_t x_off, size_t wt_off, int row_lo, LAS unsigned char* lds, int bid, int nb) {
    unsigned char* ws = opq(A.ws); const float* const* IN = (const float* const*)(ws + WS_PTRS); (void)IN;
    pg8::Gemm g{(const bf16_t*)(ws + x_off) + (size_t)row_lo * DM, (const bf16_t*)(ws + wt_off), NTOK - row_lo, DM, DM};
    const ListOrder S = build_units(lds, (NTOK - row_lo) / 256, DM / 256, nb, bid, nullptr, 0);
    EpiResidual E{(float*)(ws + WS_H) + (size_t)row_lo * DM, (const float*)(ws + WS_MOD) + (size_t)l * 17 * 6144 + 2 * 1024, row_lo};
    pg8::gemm_phase<EpiResidual, ListOrder, true, true>(lds, g, S, E);
}

__device__ __forceinline__ void ph_gemm_sgin(const Args& A, int j, int row_lo, LAS unsigned char* lds, int bid, int nb) {
    unsigned char* ws = opq(A.ws); const float* const* IN = (const float* const*)(ws + WS_PTRS); (void)IN;
    pg8::Gemm g{(const bf16_t*)(ws + WS_ABF) + (size_t)row_lo * DM, (const bf16_t*)(ws + WS_SGIN) + (size_t)j * 2048 * DM, NTOK - row_lo, 2048, DM};
    const ListOrder S = build_units(lds, (NTOK - row_lo) / 256, 2048 / 256, nb, bid, nullptr, 0);
    EpiGeluBf16 E{(bf16_t*)(ws + WS_Z2) + (size_t)row_lo * 2048, 2048, INP(I_SGBIN) + j * 2048};
    pg8::gemm_phase<EpiGeluBf16, ListOrder, true, true>(lds, g, S, E);
}
__device__ __forceinline__ void ph_sgu_stats(const Args& A, int row_lo, int bid, int nb) {
    unsigned char* ws = opq(A.ws);
    const int tid = tid_opaque(), lane = tid & 63, wid = tid >> 6;
    const bf16_t* Z2 = (const bf16_t*)(ws + WS_Z2); float* ST = (float*)(ws + WS_VST);
    for (int row = row_lo + bid * NWAVES + wid; row < NTOK; row += nb * NWAVES) {
        const u32x4 t0 = *(const u32x4*)(Z2 + (size_t)row * 2048 + 1024 + lane * 8), t1 = *(const u32x4*)(Z2 + (size_t)row * 2048 + 1536 + lane * 8);
        float v[16]; float s = 0.f;
#pragma unroll
        for (int i = 0; i < 4; ++i) { v[2 * i] = __builtin_bit_cast(float, t0[i] << 16); v[2 * i + 1] = __builtin_bit_cast(float, t0[i] & 0xffff0000u);
            v[8 + 2 * i] = __builtin_bit_cast(float, t1[i] << 16); v[9 + 2 * i] = __builtin_bit_cast(float, t1[i] & 0xffff0000u); }
#pragma unroll
        for (int i = 0; i < 16; ++i) s += v[i];
        const float mean = wave_sum(s) * (1.0f / 1024.0f); float s2 = 0.f;
#pragma unroll
        for (int i = 0; i < 16; ++i) { const float d = v[i] - mean; s2 += d * d; }
        const float rstd = rsqrtf(wave_sum(s2) * (1.0f / 1024.0f) + 1e-5f);
        if (lane == 0) { ST[(size_t)row * 2] = mean; ST[(size_t)row * 2 + 1] = rstd; }
    }
}
__device__ __forceinline__ void ph_sgu_spatial(const Args& A, int j, int row_lo, LAS unsigned char* lds, int bid, int nb) {
    unsigned char* ws = opq(A.ws); const float* const* IN = (const float* const*)(ws + WS_PTRS);
    const int tid = tid_opaque(), lane = tid & 63, wid = tid >> 6, c16 = lane & 15, g4 = lane >> 4;
    const bf16_t* Z2 = (const bf16_t*)(ws + WS_Z2); const float* ST = (const float*)(ws + WS_VST); bf16_t* G = (bf16_t*)(ws + WS_G);
    constexpr int VS = 272;
    LAS unsigned char* vt = lds;
    LAS float* stl = (LAS float*)(lds + 36864);
    const int ch0 = row_lo / 128, nch = NTOK / 128 - ch0;
    for (int u = bid; u < nch * 8; u += nb) {
        const int ci = ch0 + u / 8, g = u % 8;
        const size_t r0 = (size_t)ci * 128;
        __syncthreads();
#pragma unroll
        for (int i = 0; i < 4; ++i) {
            const int idx = tid + NTHREADS * i, q = idx >> 4, jc = idx & 15;
            const u32x4 t = *(const u32x4*)(Z2 + (r0 + q) * 2048 + 1024 + g * 128 + jc * 8);
#pragma unroll
            for (int e = 0; e < 4; ++e) { *(LAS bf16_t*)(vt + (jc * 8 + 2 * e) * VS + q * 2) = (bf16_t)(t[e] & 0xffffu); *(LAS bf16_t*)(vt + (jc * 8 + 2 * e + 1) * VS + q * 2) = (bf16_t)(t[e] >> 16); }
        }
        if (tid < 256) stl[tid] = ST[r0 * 2 + tid];
        __syncthreads();
        const float* wrow = INP(I_SGWS) + (((size_t)j * 8 + g) * 128 + 16 * wid + c16) * 128;
        bf16x8 af[4]; float wm = 0.f, rs = 0.f;
#pragma unroll
        for (int ks = 0; ks < 4; ++ks) {
            const int q0 = 32 * ks + 8 * g4;
            const f32x4 w0 = *(const f32x4*)(wrow + q0), w1 = *(const f32x4*)(wrow + q0 + 4);
            float wv[8] = {w0[0], w0[1], w0[2], w0[3], w1[0], w1[1], w1[2], w1[3]};
#pragma unroll
            for (int e = 0; e < 8; ++e) { rs += wv[e]; wv[e] *= stl[(q0 + e) * 2 + 1]; wm += wv[e] * stl[(q0 + e) * 2]; }
            const u32x4 pk = {pk2(wv[0], wv[1]), pk2(wv[2], wv[3]), pk2(wv[4], wv[5]), pk2(wv[6], wv[7])};
            af[ks] = __builtin_bit_cast(bf16x8, pk);
        }
        wm += __shfl_xor(wm, 16); wm += __shfl_xor(wm, 32); rs += __shfl_xor(rs, 16); rs += __shfl_xor(rs, 32);
        f32x4 acc[8];
#pragma unroll
        for (int nt = 0; nt < 8; ++nt) acc[nt] = (f32x4){0.f, 0.f, 0.f, 0.f};
#pragma unroll
        for (int ks = 0; ks < 4; ++ks)
#pragma unroll
            for (int nt = 0; nt < 8; ++nt) {
                const bf16x8 bfr = *(const LAS bf16x8*)(vt + (16 * nt + c16) * VS + (32 * ks + 8 * g4) * 2);
                acc[nt] = __builtin_amdgcn_mfma_f32_16x16x32_bf16(af[ks], bfr, acc[nt], 0, 0, 0);
            }
        float wmr[4], rsr[4], bsr[4];
#pragma unroll
        for (int r = 0; r < 4; ++r) { wmr[r] = __shfl(wm, 4 * g4 + r); rsr[r] = __shfl(rs, 4 * g4 + r); bsr[r] = INP(I_SGBS)[((size_t)j * 8 + g) * 128 + 16 * wid + 4 * g4 + r]; }
#pragma unroll
        for (int nt = 0; nt < 8; ++nt) {
            const int c = g * 128 + 16 * nt + c16;
            const float lg = INP(I_SGLNG)[j * 1024 + c], lb = INP(I_SGLNB)[j * 1024 + c];
#pragma unroll
            for (int r = 0; r < 4; ++r) {
                const size_t row = r0 + 16 * wid + 4 * g4 + r;
                const float sv = lg * (acc[nt][r] - wmr[r]) + rsr[r] * lb + bsr[r];
                G[row * DM + c] = (bf16_t)f2bf(bf2f(Z2[row * 2048 + c]) * sv);
            }
        }
    }
}

__device__ __forceinline__ int moe_layout(const Args& A, int l, int bid, int nb, LAS int* off  , LAS int* cntl  , LAS int* tile_e  , LAS int* base  ) {
    const int tid = tid_opaque();
    const int* bc = (const int*)(opq(A.ws) + WS_BCNT) + (size_t)l * 256 * 32;
    if (tid < 64) {
        int n = 0, pre = 0;
        if (tid < 32) {
#pragma unroll 8
            for (int b = 0; b < nb; ++b) { const int c = bc[b * 32 + tid]; n += c; pre += (b < bid) ? c : 0; }
        }
        const int nt = (n + 255) >> 8;
        int x = nt;
#pragma unroll
        for (int o = 1; o < 32; o <<= 1) { const int y = __shfl_up(x, o); if (tid >= o) x += y; }
        const int start = x - nt;
        if (tid < 32) {
            cntl[tid] = n; off[tid] = start * 256; base[tid] = start * 256 + pre;
#pragma unroll 1
            for (int t = 0; t < nt; ++t) tile_e[start + t] = tid;
        }
        if (tid == 31) off[32] = x * 256;
    }
    __syncthreads();
    return off[32] >> 8;
}
__device__ __forceinline__ void ph_moe_scatter(const Args& A, int l, int row_lo, LAS unsigned char* lds, int bid, int nb) {
    unsigned char* ws = opq(A.ws);
    const int tid = tid_opaque();
    LAS int* off = (LAS int*)(lds + LDS_TAB); LAS int* cntl = off + 64; LAS int* tile_e = off + 128; LAS int* base = off + 800;
    moe_layout(A, l, bid, nb, off, cntl, tile_e, base);
    const int* te = (const int*)(ws + WS_TOKE); const int* tr = (const int*)(ws + WS_TOKR); int* rowof = (int*)(ws + WS_ROWOF); int* srcrow = (int*)(ws + WS_SRCROW);
    const int ngroups = (NTOK - row_lo) / 16, per = nb * NWAVES;
    const int nmine = (ngroups - bid * NWAVES + per - 1) / per * NWAVES;
    for (int q = tid; q < nmine * 64; q += NTHREADS) {
        const int slot = q >> 6, r = (q >> 2) & 15, k = q & 3, i = slot >> 3, w = slot & 7;
        const int u = i * per + bid * NWAVES + w;
        if (u < ngroups) {
            const int row = row_lo + 16 * u + r;
            const int e = te[(size_t)row * 4 + k];
            const int pos = base[e] + tr[(size_t)row * 4 + k];
            rowof[(size_t)row * 4 + k] = pos; srcrow[pos] = row;
        }
    }
    for (int e = bid; e < 32; e += nb) {
        const int r0 = off[e] + cntl[e], r1 = off[e + 1];
        for (int i = r0 + tid; i < r1; i += NTHREADS) srcrow[i] = NCTX;
    }
}
__device__ __forceinline__ void ph_moe_gemm1(const Args& A, int l, LAS unsigned char* lds, int bid, int nb) {
    unsigned char* ws = opq(A.ws); const float* const* IN = (const float* const*)(ws + WS_PTRS); (void)IN;
    LAS int* off = (LAS int*)(lds + LDS_TAB); LAS int* cntl = off + 64; LAS int* tile_e = off + 128; LAS int* base = off + 800;
    const int T = moe_layout(A, l, bid, nb, off, cntl, tile_e, base);
    int Kq = DM / 2; asm volatile("" : "+s"(Kq));
    pg8::Gemm g{(const bf16_t*)(ws + WS_ABF), (const bf16_t*)(ws + WS_W1 + (size_t)l * NE * 2048 * DM), T * 256, 2048, Kq};
    const ListOrder S = build_units(lds, T, 8, nb, bid, tile_e, 8);
    { LAS unsigned* rowtab = (LAS unsigned*)(lds + LDS_ROWTAB); const int* srcrow = (const int*)(ws + WS_SRCROW); const int tid = tid_opaque();
      for (int q = tid; q < S.n * 256; q += NTHREADS) rowtab[q] = (unsigned)srcrow[S.list[2 * (q >> 8)] * 256 + (q & 255)] * (unsigned)DM;
      __syncthreads(); }
    EpiMoe1 E{(bf16_t*)(ws + WS_ACT), INP(I_B1) + (size_t)l * NE * 2048};
    pg8::gemm_phase<EpiMoe1, ListOrder, true, true, true, true>(lds, g, S, E);
}
__device__ __forceinline__ void ph_moe_gemm2(const Args& A, int l, LAS unsigned char* lds, int bid, int nb) {
    unsigned char* ws = opq(A.ws); const float* const* IN = (const float* const*)(ws + WS_PTRS); (void)IN;
    LAS int* off = (LAS int*)(lds + LDS_TAB); LAS int* cntl = off + 64; LAS int* tile_e = off + 128; LAS int* base = off + 800;
    const int T = moe_layout(A, l, bid, nb, off, cntl, tile_e, base);
    int Kq = DM / 2; asm volatile("" : "+s"(Kq));
    pg8::Gemm g{(const bf16_t*)(ws + WS_ACT), (const bf16_t*)(ws + WS_W2 + (size_t)l * NE * DM * DM), T * 256, DM, Kq, 0x77777777, 0x7d7d7d7d};
    const ListOrder S = build_units(lds, T, 4, nb, bid, tile_e, 4);
    EpiMoe2 E{(bf16_t*)(ws + WS_YM), INP(I_B2) + (size_t)l * NE * DM};
    pg8::gemm_phase<EpiMoe2, ListOrder, true, true, false, true>(lds, g, S, E);
}
__device__ __forceinline__ void ph_moe_combine(const Args& A, int l, int row_lo, bool last, int bid, int nb, bool dry = false) {
    unsigned char* ws = opq(A.ws); const float* const* IN = (const float* const*)(ws + WS_PTRS);
    const int tid = tid_opaque(), lane = tid & 63, wid = tid >> 6;
    float* H = (float*)(ws + WS_H); const float* mod = (const float*)(ws + WS_MOD); const bf16_t* YM = (const bf16_t*)(ws + WS_YM);
    float* Hw = dry ? (float*)(ws + WS_XP) : H;
    const int* rowof = (const int*)(ws + WS_ROWOF); const float* tg = (const float*)(ws + WS_TOKG);
    bf16_t* abf = dry ? (bf16_t*)(ws + WS_XP + (size_t)NTOK * DM * 4) : (bf16_t*)(ws + WS_ABF);
    const int ln = last ? l : l + 1;
    const float* gp = INP(I_N1G) + ln * 1024;
    for (int row = row_lo + bid * NWAVES + wid; row < NTOK; row += nb * NWAVES) {
        const Tok tk = tokinfo(row);
        const float* gate = mod + ((size_t)l * 17 + tk.modrow) * 6144 + 5 * 1024;
        int r[4]; float gk[4];
#pragma unroll
        for (int k = 0; k < 4; ++k) { r[k] = rowof[(size_t)row * 4 + k]; gk[k] = tg[(size_t)row * 4 + k]; }
        u32x4 y[2][4];
#pragma unroll
        for (int h = 0; h < 2; ++h)
#pragma unroll
            for (int k = 0; k < 4; ++k) y[h][k] = *(const u32x4*)(YM + (size_t)r[k] * DM + h * 512 + lane * 8);
        f32x4 hv[2][2]; float ss = 0.f;
#pragma unroll
        for (int h = 0; h < 2; ++h) {
            const int col = h * 512 + lane * 8;
            f32x4 m0 = (f32x4){0.f, 0.f, 0.f, 0.f}, m1 = m0;
#pragma unroll
            for (int k = 0; k < 4; ++k) { const u32x4 t = y[h][k];
                m0 = m0 + (f32x4){__builtin_bit_cast(float, t.x << 16), __builtin_bit_cast(float, t.x & 0xffff0000u), __builtin_bit_cast(float, t.y << 16), __builtin_bit_cast(float, t.y & 0xffff0000u)} * gk[k];
                m1 = m1 + (f32x4){__builtin_bit_cast(float, t.z << 16), __builtin_bit_cast(float, t.z & 0xffff0000u), __builtin_bit_cast(float, t.w << 16), __builtin_bit_cast(float, t.w & 0xffff0000u)} * gk[k]; }
            hv[h][0] = *(const f32x4*)(H + (size_t)row * DM + col) + *(const f32x4*)(gate + col) * m0;
            hv[h][1] = *(const f32x4*)(H + (size_t)row * DM + col + 4) + *(const f32x4*)(gate + col + 4) * m1;
            float* dst = (last && !dry) ? as_global(((float* const*)IN)[38]) + (size_t)(row - NCTX) * DM + col : Hw + (size_t)row * DM + col;
            *(f32x4*)dst = hv[h][0]; *(f32x4*)(dst + 4) = hv[h][1];
#pragma unroll
            for (int e = 0; e < 2; ++e) ss += (hv[h][e].x * hv[h][e].x + hv[h][e].y * hv[h][e].y) + (hv[h][e].z * hv[h][e].z + hv[h][e].w * hv[h][e].w);
        }
        if (!last) {
            const float rstd = rsqrtf(wave_sum(ss) * (1.0f / DM) + 1e-6f);
            const float* mrow = mod + ((size_t)ln * 17 + tk.modrow) * 6144;
#pragma unroll
            for (int h = 0; h < 2; ++h) {
                const int col = h * 512 + lane * 8;
                u32x4 o;
#pragma unroll
                for (int e = 0; e < 2; ++e) {
                    const f32x4 g = *(const f32x4*)(gp + col + 4 * e), sc = *(const f32x4*)(mrow + 1024 + col + 4 * e), sh = *(const f32x4*)(mrow + col + 4 * e);
                    const f32x4 v = (hv[h][e] * rstd * g) * (sc + 1.0f) + sh;
                    o[2 * e] = pk2(v.x, v.y); o[2 * e + 1] = pk2(v.z, v.w);
                }
                *(u32x4*)(abf + (size_t)row * DM + col) = o;
            }
        }
    }
}

__global__ void __launch_bounds__(NTHREADS, 2) fwd_kernel(Args A) {
    extern __shared__ __attribute__((aligned(16))) unsigned char lds_raw[];
    LAS unsigned char* lds = (LAS unsigned char*)lds_raw;
    volatile LAS unsigned* misc = (volatile LAS unsigned*)(lds + LDS_MISC);
    const int tid = threadIdx.x, bid = blockIdx.x, nb = gridDim.x;
    if (tid < 64) misc[tid] = 0u;
    __syncthreads();
    XcdBarrier bar = xcd_barrier_post((unsigned*)(A.ws + WS_CTL) + CW_BAR, misc + 8);
    const int lo = A.ph_lo, hi = A.ph_hi;
    int pc = 0;
#ifndef PHSEL
#define PHSEL -1
#endif
#define SEL(k) (PHSEL < 0 || PHSEL == (k))
#ifndef REPEAT_MASK
#define REPEAT_MASK 0
#endif
#define RUN(k, call) do { if (SEL(k)) { call; if ((REPEAT_MASK >> (k)) & 1) { xcd_barrier(bar); call; } } } while (0)
#define PH_BEGIN if (pc >= lo && pc < hi) {
#define PH_END } if (pc >= lo && pc + 1 < hi) xcd_barrier(bar); ++pc;

    PH_BEGIN RUN(0, ph_prologue(A, lds, bid, nb)); PH_END

    for (int l = 0; l < 4; ++l) {
        const int j = l >> 1;
        const bool ctx_out = (l < 2), ctx_in = (l < 3);
        const int rin = ctx_in ? 0 : NCTX, rout = ctx_out ? 0 : NCTX;
        if (l == 0) { PH_BEGIN RUN(1, ph_norm<false>(A, l, rin, lds, bid, nb)); PH_END }
        if ((l & 1) == 0) {
            PH_BEGIN RUN(2, ph_gemm_win(A, j, rin, lds, bid, nb)); PH_END
            PH_BEGIN RUN(3, ph_rwkv_pre(A, j, rin, bid, nb)); RUN(4, ph_qk(A, j, rin, bid, nb)); PH_END
            PH_BEGIN RUN(19, ph_gemm_lora(A, j, rin, lds, bid, nb)); PH_END
            PH_BEGIN RUN(18, ph_wkv_prep(A, j, lds, bid, nb)); PH_END
            PH_BEGIN RUN(5, ph_wkv_scan(A, lds, bid, nb)); PH_END
            PH_BEGIN RUN(6, ph_attn(A, ctx_out, lds, bid, nb)); PH_END
            PH_BEGIN RUN(7, ph_merge(A, l, rout, bid, nb)); PH_END
            PH_BEGIN RUN(8, ph_gemm_out(A, l, WS_CAT, WS_WOUT + (size_t)j * DM * DM * 2, rout, lds, bid, nb)); PH_END
        } else {
            PH_BEGIN RUN(9, ph_gemm_sgin(A, j, rin, lds, bid, nb)); PH_END
            PH_BEGIN RUN(10, ph_sgu_stats(A, rin, bid, nb)); PH_END
            PH_BEGIN RUN(11, ph_sgu_spatial(A, j, rout, lds, bid, nb)); PH_END
            PH_BEGIN RUN(12, ph_gemm_out(A, l, WS_G, WS_SGOUT + (size_t)j * DM * DM * 2, rout, lds, bid, nb)); PH_END
        }
        PH_BEGIN RUN(13, ph_norm2_router(A, l, rout, lds, bid, nb)); PH_END
        PH_BEGIN RUN(14, ph_moe_scatter(A, l, rout, lds, bid, nb)); PH_END
        PH_BEGIN RUN(15, ph_moe_gemm1(A, l, lds, bid, nb)); PH_END
        PH_BEGIN RUN(16, ph_moe_gemm2(A, l, lds, bid, nb)); PH_END
        PH_BEGIN if (SEL(17)) { if ((REPEAT_MASK >> 17) & 1) { ph_moe_combine(A, l, rout, l == 3, bid, nb, true); xcd_barrier(bar); } ph_moe_combine(A, l, rout, l == 3, bid, nb); } PH_END
    }
}

extern "C" void kernel_launch(void* const* d_in, const int* in_sizes, int n_in, void* d_out, int out_size, void* d_ws, size_t ws_size, hipStream_t stream) {
    static int grid = 0;
    if (grid == 0) {
        if (n_in != 38 || out_size != NLAT * DM || ws_size < WS_END) { fprintf(stderr, "kernel_launch: unexpected shapes: n_in %d out %d ws %zu (need %zu)\n", n_in, out_size, ws_size, (size_t)WS_END); grid = -1; return; }
        int dev = 0, cus = 0, per_cu = 0;
        if (hipGetDevice(&dev) != hipSuccess || hipDeviceGetAttribute(&cus, hipDeviceAttributeMultiprocessorCount, dev) != hipSuccess) { grid = -1; return; }
        if (hipFuncSetAttribute((const void*)fwd_kernel, hipFuncAttributeMaxDynamicSharedMemorySize, LDS_BYTES) != hipSuccess) { fprintf(stderr, "kernel_launch: hipFuncSetAttribute failed\n"); grid = -1; return; }
        if (hipOccupancyMaxActiveBlocksPerMultiprocessor(&per_cu, (const void*)fwd_kernel, NTHREADS, LDS_BYTES) != hipSuccess || per_cu < 1)
            fprintf(stderr, "kernel_launch: occupancy query reports %d workgroups per CU\n", per_cu);
        (void)hipGetLastError();
        grid = cus;
    }
    if (grid < 0) return;
    if (hipMemsetAsync((char*)d_ws + WS_CTL, 0, CTL_ZERO_BYTES, stream) != hipSuccess) { fprintf(stderr, "kernel_launch: memset failed\n"); return; }
    Args a{};
    for (int i = 0; i < 38; ++i) a.in[i] = (const float*)d_in[i];
    a.out = (float*)d_out; a.ws = (unsigned char*)d_ws; a.ph_lo = 0; a.ph_hi = 1 << 20;
    hipLaunchKernelGGL(fwd_kernel, dim3(grid), dim3(NTHREADS), LDS_BYTES, stream, a);
    const hipError_t le = hipPeekAtLastError();
    if (le != hipSuccess) fprintf(stderr, "kernel_launch: launch failed: %s\n", hipGetErrorName(le));
}
```

```cpp
#include <hip/hip_runtime.h>
#include <cstdio>
#include <cstdint>

#define LAS __attribute__((address_space(3)))
typedef unsigned short bf16_t;
typedef short bf16x8 __attribute__((ext_vector_type(8)));
typedef float f32x4 __attribute__((ext_vector_type(4)));
typedef unsigned u32x4 __attribute__((ext_vector_type(4)));
typedef unsigned u32x2 __attribute__((ext_vector_type(2)));

constexpr int DM = 1024, NB = 16, TL = 2048, TC = 256;
constexpr int NCTX = NB * TC, NLAT = NB * TL, NTOK = NCTX + NLAT;
constexpr int RWC = 1920, EVC = 3456, ZLD = 3584;
constexpr int NE = 32;
constexpr int XPROWS = NTOK * 4 + NE * 256;
constexpr int NTHREADS = 512, NWAVES = 8;

constexpr size_t MiB = 1u << 20;
constexpr size_t al256(size_t x) { return (x + 255) & ~(size_t)255; }
constexpr size_t WS_CTL = 0, CTL_ZERO_BYTES = 1 * MiB - 4096;
constexpr size_t WS_PTRS = 1 * MiB - 4096;
constexpr size_t WS_MOD = 1 * MiB;
constexpr size_t WS_RTWT = al256(WS_MOD + (size_t)4 * 17 * 6144 * 4);
constexpr size_t WS_WIN = al256(WS_RTWT + (size_t)4 * 32 * 1024 * 4);
constexpr size_t WS_WOUT = al256(WS_WIN + (size_t)2 * ZLD * DM * 2);
constexpr size_t WS_SGIN = al256(WS_WOUT + (size_t)2 * DM * DM * 2);
constexpr size_t WS_SGOUT = al256(WS_SGIN + (size_t)2 * 2048 * DM * 2);
constexpr int LORA_N = 2560, LORA_K = 384;
constexpr size_t WS_WLORA = al256(WS_SGOUT + (size_t)2 * DM * DM * 2);
constexpr size_t WS_LBIAS = al256(WS_WLORA + (size_t)2 * LORA_N * LORA_K * 2);
constexpr size_t WS_W1 = al256(WS_LBIAS + (size_t)2 * LORA_N * 4);
constexpr size_t WS_W2 = al256(WS_W1 + (size_t)4 * NE * 2048 * DM * 2);
constexpr size_t WS_H = al256(WS_W2 + (size_t)4 * NE * DM * DM * 2);
constexpr size_t WS_ABF = al256(WS_H + (size_t)NTOK * DM * 4);
constexpr size_t WS_TOKE = al256(WS_ABF + (size_t)NTOK * DM * 2);
constexpr size_t WS_TOKG = al256(WS_TOKE + (size_t)NTOK * 4 * 4);
constexpr size_t WS_ROWOF = al256(WS_TOKG + (size_t)NTOK * 4 * 4);
constexpr size_t WS_TOKR = al256(WS_ROWOF + (size_t)NTOK * 4 * 4);
constexpr size_t WS_BCNT = al256(WS_TOKR + (size_t)NTOK * 4 * 4);
constexpr size_t WS_SRCROW = al256(WS_BCNT + (size_t)4 * 256 * 32 * 4);
constexpr size_t WS_R = al256(WS_SRCROW + (size_t)XPROWS * 4);
constexpr size_t FSZ = (size_t)NTOK * 512 * 4;
constexpr size_t WS_Z = WS_R;
constexpr size_t HSZ = (size_t)NTOK * 512 * 2;
constexpr size_t WS_RB = al256(WS_Z + (size_t)NTOK * ZLD * 2);
constexpr size_t WS_KS = WS_RB + HSZ, WS_VS = WS_KS + HSZ, WS_KKN = WS_VS + HSZ;
constexpr size_t WS_LIN = WS_KKN + HSZ;
constexpr size_t WS_LO = al256(WS_LIN + (size_t)NTOK * 384 * 2);
constexpr size_t WS_AB = WS_LO + 2 * HSZ;
constexpr size_t WS_GB = WS_LO + 4 * HSZ;
constexpr size_t WS_YS = WS_LO + 5 * HSZ;
constexpr size_t WS_QB = WS_YS + 2 * FSZ;
constexpr size_t WS_KB = WS_QB + FSZ / 2;
constexpr size_t WS_VB = WS_KB + FSZ / 2;
constexpr size_t WS_OP = WS_VB + FSZ / 2;
constexpr size_t WS_CAT = WS_OP + 2 * FSZ;
constexpr int WKV_REC = 12288, WKV_NCH = (TC + TL) / 16;
constexpr size_t WS_WKV = al256(WS_CAT + (size_t)NTOK * DM * 2);
constexpr size_t WS_EVEN_END = WS_WKV + (size_t)256 * WKV_NCH * WKV_REC;
constexpr size_t WS_Z2 = WS_R;
constexpr size_t WS_VST = al256(WS_Z2 + (size_t)NTOK * 2048 * 2);
constexpr size_t WS_G = al256(WS_VST + (size_t)NTOK * 2 * 4);
constexpr size_t WS_ODD_END = WS_G + (size_t)NTOK * DM * 2;
constexpr size_t WS_XP = WS_R;
constexpr size_t WS_ACT = al256(WS_XP + (size_t)XPROWS * DM * 2);
constexpr size_t WS_YM = al256(WS_ACT + (size_t)XPROWS * DM * 2);
constexpr size_t WS_MOE_END = WS_YM + (size_t)XPROWS * DM * 2;
constexpr size_t WS_END = (WS_EVEN_END > WS_MOE_END ? (WS_EVEN_END > WS_ODD_END ? WS_EVEN_END : WS_ODD_END) : (WS_MOE_END > WS_ODD_END ? WS_MOE_END : WS_ODD_END));

constexpr int CW_BAR = 4096;
constexpr int CW_CNT = 16384;
constexpr int CW_CUR = 16384 + 256;

constexpr int LDS_BYTES = 163840;
constexpr int LDS_MISC = 160 * 1024 - 256;

__device__ __forceinline__ unsigned f2bf(float f) { unsigned u = __builtin_bit_cast(unsigned, f); return (u + 0x7fffu + ((u >> 16) & 1u)) >> 16; }
__device__ __forceinline__ unsigned pk2(float lo, float hi) { return f2bf(lo) | (f2bf(hi) << 16); }
typedef float f32x2_t __attribute__((ext_vector_type(2))); typedef __bf16 bf16x2_t __attribute__((ext_vector_type(2)));
__device__ __forceinline__ unsigned cvtpk_s(float lo, float hi) { f32x2_t v = {lo, hi}; bf16x2_t b = __builtin_convertvector(v, bf16x2_t); return __builtin_bit_cast(unsigned, b); }
__device__ __forceinline__ float bf2f(bf16_t b) { return __builtin_bit_cast(float, (unsigned)b << 16); }
__device__ __forceinline__ float wave_sum(float v) {
#pragma unroll
    for (int o = 1; o < 64; o <<= 1) v += __shfl_xor(v, o);
    return v;
}
__device__ __forceinline__ int tid_opaque() { int t = threadIdx.x; asm volatile("" : "+v"(t)); return t; }
#define GAS __attribute__((address_space(1)))
template <class T> __device__ __forceinline__ T* as_global(T* p) { return (T*)(GAS T*)p; }
__device__ __forceinline__ unsigned char* opq(unsigned char* p) { GAS unsigned char* g = (GAS unsigned char*)p; asm volatile("" : "+s"(g)); return (unsigned char*)g; }
__device__ __forceinline__ float rdl(float v, int k) { return __builtin_bit_cast(float, __builtin_amdgcn_readlane(__builtin_bit_cast(int, v), k)); }
__device__ __forceinline__ float sigmoidf_(float x) { return 1.0f / (1.0f + __expf(-x)); }

#define XB_TMO      128
#define XB_XCNT(j)  (256  + 64 * (j))
#define XB_XSUB(j)  (1280 + 64 * (j))
#define XB_XGEN(j)  (2304 + 64 * (j))
#define XB_TOP      3328
#define XB_TOPGEN   3392
#define XCD_BAR_WORDS 3456
#define XB_SPIN_CAP (1u << 22)
__device__ __forceinline__ unsigned xb_ld(unsigned* p)              { return __hip_atomic_load(p, __ATOMIC_RELAXED, __HIP_MEMORY_SCOPE_AGENT); }
__device__ __forceinline__ unsigned xb_add(unsigned* p, unsigned v) { return __hip_atomic_fetch_add(p, v, __ATOMIC_RELAXED, __HIP_MEMORY_SCOPE_AGENT); }
__device__ __forceinline__ unsigned xb_xcc_id() { return (unsigned)__builtin_amdgcn_s_getreg((3 << 11) | 20) & 0xFu; }
#define XB_SPIN(cond, bar) do { unsigned _sp = 0; while (cond) { __builtin_amdgcn_s_sleep(1); \
    if ((++_sp & 255u) == 0u) { if (xb_ld(&(bar)[XB_TMO])) break; if (_sp > XB_SPIN_CAP) { atomicAdd(&(bar)[XB_TMO], 1u); break; } } } } while (0)
struct XcdBarrier { unsigned* bar; unsigned x; volatile LAS unsigned* st; };
__device__ __forceinline__ XcdBarrier xcd_barrier_post(unsigned* bar, volatile LAS unsigned* st) {
    XcdBarrier b; b.bar = bar; b.x = xb_xcc_id(); b.st = st;
    if (threadIdx.x == 0) (void)xb_add(&bar[XB_XCNT(b.x)], 1u);
    return b;
}
__device__ __forceinline__ void xcd_barrier_complete(unsigned* bar, unsigned x, unsigned& nloc, unsigned& nx) {
    const unsigned G = gridDim.x * gridDim.y * gridDim.z;
    unsigned sum, cnt, mine, sp = 0u;
    for (;;) {
        sum = 0u; cnt = 0u; mine = 0u;
#pragma unroll
        for (unsigned j = 0; j < 16; ++j) { const unsigned c = xb_ld(&bar[XB_XCNT(j)]); sum += c; cnt += (c > 0u) ? 1u : 0u; mine = (j == x) ? c : mine; }
        if (sum == G) break;
        __builtin_amdgcn_s_sleep(1);
        if ((++sp & 255u) == 0u) { if (xb_ld(&bar[XB_TMO])) break; if (sp > XB_SPIN_CAP) { atomicAdd(&bar[XB_TMO], 1u); break; } }
    }
    nloc = mine > 0u ? mine : 1u; nx = cnt > 0u ? cnt : 1u;
}
__device__ __forceinline__ void xcd_barrier(const XcdBarrier& b) {
    asm volatile("s_waitcnt vmcnt(0)" ::: "memory");
    __syncthreads();
    if (threadIdx.x == 0) {
        unsigned* bar = b.bar; asm volatile("" : "+s"(bar));
        __builtin_amdgcn_s_waitcnt(0);
        unsigned nloc = b.st[0], nx = b.st[1];
        if (nloc == 0u) { xcd_barrier_complete(bar, b.x, nloc, nx); b.st[0] = nloc; b.st[1] = nx; }
        const unsigned old = xb_add(&bar[XB_XSUB(b.x)], 1u);
        const unsigned gen = old / nloc;
        if (old + 1u == (gen + 1u) * nloc) {
            __builtin_amdgcn_fence(__ATOMIC_RELEASE, "agent");
            asm volatile("s_waitcnt vmcnt(0)" ::: "memory");
            const unsigned og = xb_add(&bar[XB_TOP], 1u);
            const unsigned tg = og / nx;
            if (og + 1u == (tg + 1u) * nx) xb_add(&bar[XB_TOPGEN], 1u);
            else XB_SPIN(xb_ld(&bar[XB_TOPGEN]) == tg, bar);
            __builtin_amdgcn_fence(__ATOMIC_ACQUIRE, "agent");
            xb_add(&bar[XB_XGEN(b.x)], 1u);
            asm volatile("s_waitcnt vmcnt(0)" ::: "memory");
        } else {
            XB_SPIN(xb_ld(&bar[XB_XGEN(b.x)]) == gen, bar);
            __builtin_amdgcn_fence(__ATOMIC_ACQUIRE, "agent");
            asm volatile("s_waitcnt vmcnt(0)" ::: "memory");
        }
    }
    __syncthreads();
}

namespace pg8 {
#define PG8_LAS __attribute__((address_space(3)))
typedef unsigned short bf16_t;
typedef short bf16x8 __attribute__((ext_vector_type(8)));
typedef float f32x4 __attribute__((ext_vector_type(4)));
typedef unsigned u32x4 __attribute__((ext_vector_type(4)));
constexpr int BM = 256, BK = 64, HALF = 128, HTB = HALF * BK * 2  , STAGE_BYTES = 8 * HTB, NXCD = 8, WGM = 8;

__host__ __device__ __forceinline__ int lds_byte(int r, int c) { const int st = (r >> 4) * 2 + (c >> 5), rr = r & 15, cc = c & 31, ob = rr * 64 + cc * 2; return st * 1024 + (ob ^ (((ob >> 9) & 1) << 5)); }
__host__ __device__ __forceinline__ void stage_rc(int b, int& R, int& C) { const int st = b / 1024, sb = b % 1024, swz = sb ^ (((sb >> 9) & 1) << 5); R = (st >> 1) * 16 + swz / 64; C = (st & 1) * 32 + (swz % 64) / 2; }
__host__ __device__ __forceinline__ int perm32(int rho) { const int n = rho >> 4, i = rho & 15; return 8 * (i >> 2) + 4 * n + (i & 3); }

struct Unit { int pm, pn, ui; };
struct Gemm { const bf16_t* A; const bf16_t* Bt; int M, N, K; int sb_w = 0x77777777, sb_a = 0x7f7f7f7f; };

struct StaticOrder {
    int nM, nN, nwg, G, c;
    __host__ __device__ void init(int M, int N, int G_, int c_) { nM = M / BM; nN = N / BM; nwg = nM * nN; G = G_; c = c_; }
    __host__ __device__ bool next(int i, Unit& u) const {
        const long L = (long)i * G + c; if (L >= nwg) return false;
        int wgid = (int)L; { const int q = nwg / NXCD, r = nwg % NXCD, xcd = wgid % NXCD, off = wgid / NXCD; wgid = (xcd < r ? xcd * (q + 1) : r * (q + 1) + (xcd - r) * q) + off; }
        const int nig = WGM * nN, gid = wgid / nig, fm = gid * WGM, gsz = (nM - fm) < WGM ? (nM - fm) : WGM;
        u.pm = fm + ((wgid % nig) % gsz); u.pn = (wgid % nig) / gsz; return true;
    }
    __device__ __forceinline__ void a_ready(const Unit&) const {}
    __device__ __forceinline__ void done(const Unit&) const {}
};

__device__ __forceinline__ unsigned cvt_pk_bf16(float lo, float hi) { unsigned r; asm volatile("v_cvt_pk_bf16_f32 %0, %1, %2" : "=v"(r) : "v"(lo), "v"(hi)); return r; }
typedef float f32x2 __attribute__((ext_vector_type(2)));
__device__ __forceinline__ f32x2 gelu_pk(f32x2 v) {
    const f32x2 av = __builtin_elementwise_abs(v), d = av * 0.2316418882f + 1.0f;
    f32x2 t; t.x = __builtin_amdgcn_rcpf(d.x); t.y = __builtin_amdgcn_rcpf(d.y);
    f32x2 q = t * 0.5307027145f + (-0.7265760135f); q = q * t + 0.7107068705f; q = q * t + (-0.142248368f); q = q * t + 0.127414796f; q = q * t;
    const f32x2 s = (v * v) * (-0.72134752044f);
    f32x2 e; e.x = __builtin_amdgcn_exp2f(s.x); e.y = __builtin_amdgcn_exp2f(s.y);
    const f32x2 m = v * (q * e), r = v - m;
    f32x2 o; o.x = v.x < 0.f ? m.x : r.x; o.y = v.y < 0.f ? m.y : r.y; return o;
}

typedef int v8i32 __attribute__((ext_vector_type(8)));
typedef int v4i32 __attribute__((ext_vector_type(4)));
__device__ __forceinline__ v8i32 cat8(v4i32 a, v4i32 b) { return __builtin_shufflevector(a, b, 0, 1, 2, 3, 4, 5, 6, 7); }
template <class Epi, class Sched, bool ALIGN_EPI = false, bool SP2 = false, bool GATHER = false, bool FP8 = false>
__device__ __forceinline__ void gemm_phase(PG8_LAS unsigned char* lds, const Gemm g, const Sched& S, const Epi& E) {
    const int tid = tid_opaque(), wid = __builtin_amdgcn_readfirstlane(tid >> 6), lane = tid & 63, wr = wid >> 2, wc = wid & 3, fr = lane & 15, fq = lane >> 4;
    static_assert(!GATHER || SP2, "GATHER is wired into the SP2 loop only");
    const int K = g.K, nt = K / BK;
    unsigned voffA[2], voffB[2];
#pragma unroll
    for (int i = 0; i < 2; ++i) { int R, C; stage_rc(tid * 16 + i * 8192, R, C); const int Rb = Epi::PERM ? ((R & ~31) + perm32(R & 31)) : R;
        voffA[i] = (unsigned)(R * K + C) * 2u; voffB[i] = (unsigned)(Rb * K + C) * 2u; }
    unsigned gAc[2][2] = {{0u, 0u}, {0u, 0u}}, gAn[2][2] = {{0u, 0u}, {0u, 0u}};
    int gR[2] = {0, 0}; unsigned gC[2] = {0u, 0u};
    if constexpr (GATHER) {
#pragma unroll
        for (int i = 0; i < 2; ++i) { int R, C; stage_rc(tid * 16 + i * 8192, R, C); gR[i] = R; gC[i] = (unsigned)C * 2u; }
    }
#define PG8_GROWS(dst, ui_) do { _Pragma("unroll") for (int _h = 0; _h < 2; ++_h) _Pragma("unroll") for (int _i = 0; _i < 2; ++_i) dst[_h][_i] = S.rowtab[(ui_) * 256 + _h * 128 + gR[_i]] + gC[_i]; } while (0)
    const size_t kstep = (size_t)(BK * 2);
    const size_t hstep = (size_t)HALF * K * 2;
    const size_t tstep = 2 * hstep;
    const unsigned ldsw = (unsigned)wid * 1024u;
    const int aoff = lds_byte(wr * 64 + fr, fq * 8), boff = lds_byte(wc * 32 + fr, fq * 8);
#define PG8_SA(b, h) (((b) * 2 + (h)) * HTB)
#define PG8_SB(b, h) ((4 + (b) * 2 + (h)) * HTB)
#define PG8_STAGE(bufoff, gbase, voff) do { _Pragma("unroll") for (int _i = 0; _i < 2; ++_i) \
        __builtin_amdgcn_global_load_lds((const unsigned*)((const char*)(gbase) + (voff)[_i]), (PG8_LAS unsigned*)(lds + (bufoff) + ldsw + _i * 8192), 16, 0, 0); } while (0)
#define PG8_STAGE_A(bufoff, kptr, h, vsel) do { if constexpr (GATHER) { PG8_STAGE(bufoff, kptr, vsel[h]); } else { PG8_STAGE(bufoff, (kptr) + (h) * hstep, voffA); } } while (0)
#define PG8_LDA(dst, b, h) do { if constexpr (FP8) { _Pragma("unroll") for (int m = 0; m < 4; ++m) dst##8[m] = cat8(*(const PG8_LAS v4i32*)(lds + PG8_SA(b, h) + aoff + m * 2048), *(const PG8_LAS v4i32*)(lds + PG8_SA(b, h) + aoff + m * 2048 + 1024)); } \
        else { _Pragma("unroll") for (int m = 0; m < 4; ++m) _Pragma("unroll") for (int k = 0; k < 2; ++k) dst[m][k] = *(const PG8_LAS bf16x8*)(lds + PG8_SA(b, h) + aoff + m * 2048 + k * 1024); } } while (0)
#define PG8_LDB(dst, b, h) do { if constexpr (FP8) { _Pragma("unroll") for (int n = 0; n < 2; ++n) dst##8[n] = cat8(*(const PG8_LAS v4i32*)(lds + PG8_SB(b, h) + boff + n * 2048), *(const PG8_LAS v4i32*)(lds + PG8_SB(b, h) + boff + n * 2048 + 1024)); } \
        else { _Pragma("unroll") for (int n = 0; n < 2; ++n) _Pragma("unroll") for (int k = 0; k < 2; ++k) dst[n][k] = *(const PG8_LAS bf16x8*)(lds + PG8_SB(b, h) + boff + n * 2048 + k * 1024); } } while (0)
#define PG8_MMA(ai, bj, At, Bt) do { __builtin_amdgcn_s_setprio(1); if constexpr (FP8) { _Pragma("unroll") for (int m = 0; m < 4; ++m) _Pragma("unroll") for (int n = 0; n < 2; ++n) \
        asm volatile("s_nop 1\n\tv_mfma_scale_f32_16x16x128_f8f6f4 %0, %1, %2, %0, %3, %4 op_sel_hi:[0,0,0]" : "+v"(acc[ai][bj][m][n]) : "v"(Bt##8[n]), "v"(At##8[m]), "v"(fp8_sa), "v"(fp8_sb)); } else { \
        _Pragma("unroll") for (int m = 0; m < 4; ++m) _Pragma("unroll") for (int n = 0; n < 2; ++n) _Pragma("unroll") for (int k = 0; k < 2; ++k) \
        acc[ai][bj][m][n] = __builtin_amdgcn_mfma_f32_16x16x32_bf16(Bt[n][k], At[m][k], acc[ai][bj][m][n], 0, 0, 0); } __builtin_amdgcn_s_setprio(0); } while (0)
#define PG8_WAIT_V(n) asm volatile("s_waitcnt vmcnt(" #n ")" ::: "memory")
#define PG8_WAIT_L(n) asm volatile("s_waitcnt lgkmcnt(" #n ")" ::: "memory")
#define PG8_BAR __builtin_amdgcn_s_barrier()
#define PG8_SCHED __builtin_amdgcn_sched_barrier(0)
    Unit cur, nxt; int ui = 0;
    if (!S.next(0, cur)) return;
    f32x4 acc[2][2][4][2];
#pragma unroll
    for (int a = 0; a < 2; ++a)
#pragma unroll
        for (int b = 0; b < 2; ++b)
#pragma unroll
            for (int m = 0; m < 4; ++m)
#pragma unroll
                for (int n = 0; n < 2; ++n) acc[a][b][m][n] = (f32x4){0.f, 0.f, 0.f, 0.f};
    const int fp8_sa = g.sb_w, fp8_sb = g.sb_a;
    bf16x8 At[4][2], B0[2][2], B1[2][2]; v8i32 At8[4], B08[2], B18[2];
    const char* cA = GATHER ? (const char*)g.A : (const char*)g.A + (size_t)cur.pm * tstep; const char* cB = (const char*)g.Bt + (size_t)cur.pn * tstep;
    if constexpr (GATHER) { PG8_GROWS(gAc, 0); }
    S.a_ready(cur);
    if constexpr (SP2) {
        PG8_STAGE(PG8_SB(0, 0), cB, voffB); PG8_STAGE(PG8_SB(0, 1), cB + hstep, voffB); PG8_STAGE_A(PG8_SA(0, 0), cA, 0, gAc); PG8_STAGE_A(PG8_SA(0, 1), cA, 1, gAc);
        if (wr == 1) PG8_BAR;
        PG8_WAIT_V(2); PG8_BAR;
        PG8_STAGE(PG8_SB(1, 0), cB + kstep, voffB); PG8_STAGE_A(PG8_SA(1, 0), cA + kstep, 0, gAc); PG8_STAGE(PG8_SB(1, 1), cB + hstep + kstep, voffB);
        PG8_WAIT_V(6); PG8_BAR;
    } else {
        PG8_STAGE(PG8_SB(0, 0), cB, voffB); PG8_STAGE(PG8_SA(0, 0), cA, voffA); PG8_STAGE(PG8_SB(0, 1), cB + hstep, voffB); PG8_STAGE(PG8_SA(0, 1), cA + hstep, voffA);
        if (wr == 1) PG8_BAR;
        PG8_WAIT_V(4); PG8_BAR;
        PG8_STAGE(PG8_SB(1, 0), cB + kstep, voffB); PG8_STAGE(PG8_SA(1, 0), cA + kstep, voffA); PG8_STAGE(PG8_SB(1, 1), cB + hstep + kstep, voffB);
        PG8_WAIT_V(6); PG8_BAR;
    }
    for (;;) {
        const bool has_next = S.next(ui + 1, nxt);
        if constexpr (GATHER) { if (has_next) { PG8_GROWS(gAn, ui + 1); } else { _Pragma("unroll") for (int _h = 0; _h < 2; ++_h) _Pragma("unroll") for (int _i = 0; _i < 2; ++_i) gAn[_h][_i] = gAc[_h][_i]; } }
        const char* nA = GATHER ? (const char*)g.A : (has_next ? (const char*)g.A + (size_t)nxt.pm * tstep : cA); const char* nB = has_next ? (const char*)g.Bt + (size_t)nxt.pn * tstep : cB;
        for (int t = 0; t < nt; t += 2) {
            const bool last = (t == nt - 2);
            const char* a1 = cA + (size_t)(t + 1) * kstep;
            const char* a2 = last ? nA : cA + (size_t)(t + 2) * kstep; const char* b2 = last ? nB : cB + (size_t)(t + 2) * kstep;
            const char* a3 = a2 + kstep; const char* b3 = b2 + kstep;
            if (last && has_next) S.a_ready(nxt);
            unsigned gA2[2][2];
            if constexpr (GATHER) { _Pragma("unroll") for (int _h = 0; _h < 2; ++_h) _Pragma("unroll") for (int _i = 0; _i < 2; ++_i) gA2[_h][_i] = last ? gAn[_h][_i] : gAc[_h][_i]; }
            if constexpr (SP2) {
            PG8_LDB(B0, 0, 0); PG8_LDB(B1, 0, 1); PG8_SCHED; PG8_LDA(At, 0, 0); PG8_STAGE_A(PG8_SA(1, 1), a1, 1, gAc);
            PG8_WAIT_V(8); PG8_WAIT_L(0); PG8_BAR; PG8_MMA(0, 0, At, B0); PG8_MMA(0, 1, At, B1); PG8_BAR; PG8_SCHED;
            PG8_LDA(At, 0, 1); PG8_STAGE(PG8_SB(0, 0), b2, voffB); PG8_STAGE(PG8_SB(0, 1), b2 + hstep, voffB); PG8_STAGE_A(PG8_SA(0, 0), a2, 0, gA2);
            PG8_WAIT_V(8); PG8_WAIT_L(0); PG8_BAR; PG8_MMA(1, 0, At, B0); PG8_MMA(1, 1, At, B1); PG8_BAR; PG8_SCHED;
            PG8_LDB(B0, 1, 0); PG8_LDB(B1, 1, 1); PG8_SCHED; PG8_LDA(At, 1, 0); PG8_STAGE_A(PG8_SA(0, 1), a2, 1, gA2);
            PG8_WAIT_V(8); PG8_WAIT_L(0); PG8_BAR; PG8_MMA(0, 0, At, B0); PG8_MMA(0, 1, At, B1); PG8_BAR; PG8_SCHED;
            PG8_LDA(At, 1, 1); PG8_STAGE(PG8_SB(1, 0), b3, voffB); PG8_STAGE(PG8_SB(1, 1), b3 + hstep, voffB); PG8_STAGE_A(PG8_SA(1, 0), a3, 0, gA2);
            PG8_WAIT_V(8); PG8_WAIT_L(0); PG8_BAR; PG8_MMA(1, 0, At, B0); PG8_MMA(1, 1, At, B1); PG8_BAR; PG8_SCHED;
            } else {
            PG8_LDB(B0, 0, 0); PG8_SCHED; PG8_LDA(At, 0, 0); PG8_STAGE(PG8_SA(1, 1), a1 + hstep, voffA);
            PG8_WAIT_L(8); PG8_BAR; PG8_WAIT_L(0); PG8_MMA(0, 0, At, B0); PG8_BAR; PG8_SCHED;
            PG8_LDB(B1, 0, 1); PG8_STAGE(PG8_SB(0, 0), b2, voffB);
            PG8_BAR; PG8_WAIT_L(0); PG8_MMA(0, 1, At, B1); PG8_BAR;
            PG8_LDA(At, 0, 1); PG8_STAGE(PG8_SA(0, 0), a2, voffA);
            PG8_BAR; PG8_WAIT_L(0); PG8_MMA(1, 0, At, B0); PG8_BAR; PG8_SCHED;
            PG8_STAGE(PG8_SB(0, 1), b2 + hstep, voffB);
            PG8_WAIT_V(6); PG8_BAR; PG8_MMA(1, 1, At, B1); PG8_BAR;
            PG8_LDB(B0, 1, 0); PG8_SCHED; PG8_LDA(At, 1, 0); PG8_STAGE(PG8_SA(0, 1), a2 + hstep, voffA);
            PG8_WAIT_L(8); PG8_BAR; PG8_WAIT_L(0); PG8_MMA(0, 0, At, B0); PG8_BAR; PG8_SCHED;
            PG8_LDB(B1, 1, 1); PG8_STAGE(PG8_SB(1, 0), b3, voffB);
            PG8_BAR; PG8_WAIT_L(0); PG8_MMA(0, 1, At, B1); PG8_BAR;
            PG8_LDA(At, 1, 1); PG8_STAGE(PG8_SA(1, 0), a3, voffA);
            PG8_BAR; PG8_WAIT_L(0); PG8_MMA(1, 0, At, B0); PG8_BAR; PG8_SCHED;
            PG8_STAGE(PG8_SB(1, 1), b3 + hstep, voffB);
            PG8_WAIT_V(6); PG8_BAR; PG8_MMA(1, 1, At, B1); PG8_BAR;
            }
        }
        if constexpr (ALIGN_EPI) { if (wr == 0) PG8_BAR; }
        if constexpr (FP8) { asm volatile("s_nop 15\n\ts_nop 15" ::: "memory"); __builtin_amdgcn_sched_barrier(0); }
        if constexpr (!Epi::AFTER_DRAIN) { E(acc, cur, wr, wc, fr, fq); S.done(cur); }
        if (!has_next) break;
#pragma unroll
        for (int a = 0; a < 2; ++a)
#pragma unroll
            for (int b = 0; b < 2; ++b)
#pragma unroll
                for (int m = 0; m < 4; ++m)
#pragma unroll
                    for (int n = 0; n < 2; ++n) acc[a][b][m][n] = (f32x4){0.f, 0.f, 0.f, 0.f};
        cur = nxt; cA = nA; cB = nB; ++ui;
        if constexpr (GATHER) { _Pragma("unroll") for (int _h = 0; _h < 2; ++_h) _Pragma("unroll") for (int _i = 0; _i < 2; ++_i) gAc[_h][_i] = gAn[_h][_i]; }
        if constexpr (ALIGN_EPI) { if (wr == 1) PG8_BAR; }
    }
    PG8_WAIT_V(0);
    if constexpr (!ALIGN_EPI) { if (wr == 0) PG8_BAR; }
    PG8_BAR;
    if constexpr (Epi::AFTER_DRAIN) { E.fused(acc, cur, wr, wc, fr, fq, lds, wid, lane); S.done(cur); }
#undef PG8_SA
#undef PG8_SB
#undef PG8_STAGE
#undef PG8_STAGE_A
#undef PG8_GROWS
#undef PG8_LDA
#undef PG8_LDB
#undef PG8_MMA
#undef PG8_WAIT_V
#undef PG8_WAIT_L
#undef PG8_BAR
#undef PG8_SCHED
}
}

struct Args { const float* in[38]; float* out; unsigned char* ws; int ph_lo, ph_hi; };
#define INP(k) as_global(IN[k])
#define AIN(k) as_global(A.in[k])
enum { I_X = 0, I_C, I_CTX, I_CCTX, I_N1G, I_N2G, I_ADAW, I_ADAB, I_EVWIN, I_EVWOUT, I_RWMU, I_RWW0, I_RWW2, I_RWA0, I_RWA2, I_RWG2, I_RWKK, I_RWKA, I_RWRK,
       I_GNW, I_GNB, I_QN, I_KN, I_LAM, I_SUBLN, I_SGWIN, I_SGBIN, I_SGLNG, I_SGLNB, I_SGWS, I_SGBS, I_SGWOUT, I_RTW, I_RTB, I_W1, I_B1, I_W2, I_B2 };

struct Tok { int b, t, T, modrow; };
__device__ __forceinline__ Tok tokinfo(int g) {
    Tok k;
    if (g < NCTX) { k.b = g >> 8; k.t = g & 255; k.T = TC; k.modrow = 16; }
    else { const int q = g - NCTX; k.b = q >> 11; k.t = q & 2047; k.T = TL; k.modrow = k.b; }
    return k;
}

template <int MAP>
__device__ __forceinline__ void p0_transpose_item(const float* W, int K, int N, bf16_t* WT, LAS float* scr, int item, int lane) {
    const int nblk = N / 32, kb = item / nblk, nb = item % nblk, k0 = 64 * kb, n0 = 32 * nb;
    const int d0 = MAP ? (256 * ((n0 & 1023) >> 7) + 128 * (n0 >> 10) + (n0 & 127)) : n0;
#pragma unroll 8
    for (int i = 0; i < 32; ++i) { const int kk = 2 * i + (lane >> 5); scr[kk * 33 + (lane & 31)] = W[(size_t)(k0 + kk) * N + n0 + (lane & 31)]; }
    asm volatile("s_waitcnt lgkmcnt(0)" ::: "memory");
    const int c = lane & 7;
#pragma unroll
    for (int j = 0; j < 4; ++j) { const int n = (lane >> 3) + 8 * j; const LAS float* s = scr + (8 * c) * 33 + n;
        u32x4 o; o.x = pk2(s[0 * 33], s[1 * 33]); o.y = pk2(s[2 * 33], s[3 * 33]); o.z = pk2(s[4 * 33], s[5 * 33]); o.w = pk2(s[6 * 33], s[7 * 33]);
        *(u32x4*)(WT + (size_t)(d0 + n) * K + k0 + 8 * c) = o; }
    asm volatile("s_waitcnt lgkmcnt(0)" ::: "memory");
}

template <int MAP>
__device__ __forceinline__ void p0_transpose_item_fp8(const float* W, int K, int N, unsigned char* WT, LAS float* scr, int item, int lane) {
    const int nblk = N / 32, kb = item / nblk, nb = item % nblk, k0 = 64 * kb, n0 = 32 * nb;
    const int d0 = MAP ? (256 * ((n0 & 1023) >> 7) + 128 * (n0 >> 10) + (n0 & 127)) : n0;
#pragma unroll 8
    for (int i = 0; i < 32; ++i) { const int kk = 2 * i + (lane >> 5); scr[kk * 33 + (lane & 31)] = W[(size_t)(k0 + kk) * N + n0 + (lane & 31)]; }
    asm volatile("s_waitcnt lgkmcnt(0)" ::: "memory");
    const int c = lane & 3;
#pragma unroll
    for (int j = 0; j < 2; ++j) { const int n = (lane >> 2) + 16 * j; const LAS float* sp = scr + (16 * c) * 33 + n;
        u32x4 o;
#pragma unroll
        for (int d = 0; d < 4; ++d) { int w = __builtin_amdgcn_cvt_pk_fp8_f32(sp[(4 * d) * 33] * 256.0f, sp[(4 * d + 1) * 33] * 256.0f, 0, false);
            w = __builtin_amdgcn_cvt_pk_fp8_f32(sp[(4 * d + 2) * 33] * 256.0f, sp[(4 * d + 3) * 33] * 256.0f, w, true); o[d] = (unsigned)w; }
        *(u32x4*)(WT + (size_t)(d0 + n) * K + k0 + 16 * c) = o; }
    asm volatile("s_waitcnt lgkmcnt(0)" ::: "memory");
}

__device__ __forceinline__ void ph_prologue(const Args& A, LAS unsigned char* lds, int bid, int nb) {
    const int tid = tid_opaque(), lane = tid & 63, wid = tid >> 6;
    unsigned char* ws = opq(A.ws);
    if (bid == 0 && tid < 39) ((const float**)(ws + WS_PTRS))[tid] = (tid < 38) ? A.in[tid] : (const float*)A.out;
    {
        LAS float* s = (LAS float*)lds;
        LAS float* red = (LAS float*)(lds + 17 * 1024 * 4);
        for (int i = tid; i < 17 * 1024; i += NTHREADS) {
            const int r = i >> 10, k = i & 1023;
            const float x = (r < 16) ? AIN(I_C)[r * 1024 + k] : AIN(I_CCTX)[k];
            s[i] = x / (1.0f + __expf(-x));
        }
        __syncthreads();
        float* mod = (float*)(ws + WS_MOD);
        for (int u = bid; u < 4 * 96; u += nb) {
            const int l = u / 96, cg = u % 96, col = cg * 64 + lane;
            float acc[17];
#pragma unroll
            for (int r = 0; r < 17; ++r) acc[r] = 0.f;
            const float* wp = AIN(I_ADAW) + (size_t)l * 1024 * 6144 + col;
            for (int k = wid * 128; k < wid * 128 + 128; ++k) {
                const float wv = wp[(size_t)k * 6144];
#pragma unroll
                for (int r = 0; r < 17; ++r) acc[r] += s[r * 1024 + k] * wv;
            }
#pragma unroll
            for (int r = 0; r < 17; ++r) red[(wid * 17 + r) * 64 + lane] = acc[r];
            __syncthreads();
            for (int i = tid; i < 17 * 64; i += NTHREADS) {
                const int r = i >> 6, ln = i & 63; float v = 0.f;
#pragma unroll
                for (int w = 0; w < 8; ++w) v += red[(w * 17 + r) * 64 + ln];
                const int cc = cg * 64 + ln;
                mod[((size_t)l * 17 + r) * 6144 + cc] = v + AIN(I_ADAB)[l * 6144 + cc];
            }
            __syncthreads();
        }
    }
    __syncthreads();
    {
        LAS float* scr = (LAS float*)(lds + wid * 16384);
        const int gw = bid * NWAVES + wid, NGW = nb * NWAVES;
        constexpr int IT_WIN = 16 * (EVC / 32), IT_SQ = 16 * 32, IT_SGIN = 16 * 64, IT_W1 = 16 * 64, IT_W2 = 16 * 32;
        constexpr int N0 = 2 * IT_WIN, N1 = N0 + 2 * IT_SQ, N2 = N1 + 2 * IT_SGIN, N3 = N2 + 2 * IT_SQ, N4 = N3 + 128 * IT_W1, N5 = N4 + 128 * IT_W2;
        for (int it = gw; it < N5; it += NGW) {
            if (it < N0) { const int m = it / IT_WIN, r = it % IT_WIN; p0_transpose_item<0>(AIN(I_EVWIN) + (size_t)m * DM * EVC, DM, EVC, (bf16_t*)(ws + WS_WIN) + (size_t)m * ZLD * DM, scr, r, lane); }
            else if (it < N1) { const int q = it - N0, m = q / IT_SQ, r = q % IT_SQ; p0_transpose_item<0>(AIN(I_EVWOUT) + (size_t)m * DM * DM, DM, DM, (bf16_t*)(ws + WS_WOUT) + (size_t)m * DM * DM, scr, r, lane); }
            else if (it < N2) { const int q = it - N1, m = q / IT_SGIN, r = q % IT_SGIN; p0_transpose_item<0>(AIN(I_SGWIN) + (size_t)m * DM * 2048, DM, 2048, (bf16_t*)(ws + WS_SGIN) + (size_t)m * 2048 * DM, scr, r, lane); }
            else if (it < N3) { const int q = it - N2, m = q / IT_SQ, r = q % IT_SQ; p0_transpose_item<0>(AIN(I_SGWOUT) + (size_t)m * DM * DM, DM, DM, (bf16_t*)(ws + WS_SGOUT) + (size_t)m * DM * DM, scr, r, lane); }
            else if (it < N4) { const int q = it - N3, m = q / IT_W1, r = q % IT_W1; p0_transpose_item_fp8<1>(AIN(I_W1) + (size_t)m * DM * 2048, DM, 2048, ws + WS_W1 + (size_t)m * 2048 * DM, scr, r, lane); }
            else { const int q = it - N4, m = q / IT_W2, r = q % IT_W2; p0_transpose_item_fp8<0>(AIN(I_W2) + (size_t)m * DM * DM, DM, DM, ws + WS_W2 + (size_t)m * DM * DM, scr, r, lane); }
        }
    }
    {
        const size_t gt = (size_t)bid * NTHREADS + tid, GT = (size_t)nb * NTHREADS;
        f32x4* H4 = (f32x4*)(ws + WS_H);
        const f32x4* c4 = (const f32x4*)AIN(I_CTX); const f32x4* x4 = (const f32x4*)AIN(I_X);
        constexpr size_t NC4 = (size_t)NCTX * DM / 4, NT4 = (size_t)NTOK * DM / 4;
        for (size_t i = gt; i < NT4; i += GT) H4[i] = (i < NC4) ? c4[i] : x4[i - NC4];
        for (size_t i = gt; i < (size_t)2 * 128 * DM / 8; i += GT) { const size_t m = i / (128 * DM / 8), r = i % (128 * DM / 8); ((u32x4*)((bf16_t*)(ws + WS_WIN) + (m * ZLD + EVC) * DM))[r] = (u32x4){0u, 0u, 0u, 0u}; }
        bf16_t* wl = (bf16_t*)(ws + WS_WLORA);
        for (size_t i = gt; i < (size_t)2 * LORA_N * (LORA_K / 8); i += GT) {
            const int n = (int)(i % LORA_N), kc = (int)((i / LORA_N) % (LORA_K / 8)), jj = (int)(i / ((size_t)LORA_N * (LORA_K / 8))), seg = n >> 9, c = n & 511, k0 = kc * 8;
            float v[8];
#pragma unroll
            for (int e = 0; e < 8; ++e) v[e] = 0.f;
            if (seg < 2) { if ((k0 >> 6) == seg) {
#pragma unroll
                for (int e = 0; e < 8; ++e) v[e] = AIN(I_RWW2)[(((size_t)jj * 2 + seg) * 64 + (k0 & 63) + e) * 512 + c]; } }
            else if (seg < 4) { if ((k0 >> 6) == seg) {
#pragma unroll
                for (int e = 0; e < 8; ++e) v[e] = AIN(I_RWA2)[(((size_t)jj * 2 + (seg - 2)) * 64 + (k0 & 63) + e) * 512 + c]; } }
            else if (k0 >= 256) {
#pragma unroll
                for (int e = 0; e < 8; ++e) v[e] = AIN(I_RWG2)[((size_t)jj * 128 + (k0 - 256) + e) * 512 + c]; }
            *(u32x4*)(wl + ((size_t)jj * LORA_N + n) * LORA_K + k0) = (u32x4){pk2(v[0], v[1]), pk2(v[2], v[3]), pk2(v[4], v[5]), pk2(v[6], v[7])};
        }
        for (size_t i = gt; i < (size_t)2 * LORA_N; i += GT) { const int jj = (int)(i / LORA_N), n = (int)(i % LORA_N), seg = n >> 9, c = n & 511;
            ((float*)(ws + WS_LBIAS))[i] = seg < 2 ? AIN(I_RWW0)[((size_t)jj * 2 + seg) * 512 + c] : (seg < 4 ? AIN(I_RWA0)[((size_t)jj * 2 + (seg - 2)) * 512 + c] : 0.f); }
        float* rt = (float*)(ws + WS_RTWT);
        for (size_t i = gt; i < (size_t)4 * 128 * 32; i += GT) {
            const int e = (int)i & 31, k0 = ((int)(i >> 5) & 127) * 8, l = (int)(i >> 12);
            unsigned hi[4], lo[4]; float w[8];
#pragma unroll
            for (int q = 0; q < 8; ++q) w[q] = AIN(I_RTW)[((size_t)l * 1024 + k0 + q) * 32 + e];
#pragma unroll
            for (int q = 0; q < 4; ++q) { hi[q] = pk2(w[2 * q], w[2 * q + 1]); lo[q] = pk2(w[2 * q] - __builtin_bit_cast(float, hi[q] << 16), w[2 * q + 1] - __builtin_bit_cast(float, hi[q] & 0xffff0000u)); }
            *(u32x4*)((bf16_t*)rt + ((size_t)l * 2 * 32 + e) * 1024 + k0) = (u32x4){hi[0], hi[1], hi[2], hi[3]};
            *(u32x4*)((bf16_t*)rt + ((size_t)(l * 2 + 1) * 32 + e) * 1024 + k0) = (u32x4){lo[0], lo[1], lo[2], lo[3]};
        }
    }
}

template <bool ROUTER>
__device__ __forceinline__ void ph_norm(const Args& A, int l, int row_lo, LAS unsigned char* lds, int bid, int nb) {
    unsigned char* ws = opq(A.ws); const float* const* IN = (const float* const*)(ws + WS_PTRS); (void)IN;
    const int tid = tid_opaque(), lane = tid & 63, wid = tid >> 6;
    const float* H = (const float*)(ws + WS_H);
    const float* mod = (const float*)(ws + WS_MOD);
    bf16_t* abf = (bf16_t*)(ws + WS_ABF);
    const float* gp = INP(ROUTER ? I_N2G : I_N1G) + l * 1024;
    const int c_shift = ROUTER ? 3 : 0, c_scale = ROUTER ? 4 : 1;
    LAS float* rtl = (LAS float*)lds;
    LAS int* hist = (LAS int*)(lds + 131072);
    float rtb = 0.f;
    if constexpr (ROUTER) {
        const f32x4* rt4 = (const f32x4*)((const float*)(ws + WS_RTWT) + (size_t)l * 32 * 1024);
        for (int i = tid; i < 32 * 1024 / 4; i += NTHREADS) ((LAS f32x4*)rtl)[i] = rt4[i];
        if (tid < 32) hist[tid] = 0;
        rtb = INP(I_RTB)[l * 32 + (lane >> 1)];
        __syncthreads();
    }
    for (int row = row_lo + bid * NWAVES + wid; row < NTOK; row += nb * NWAVES) {
        const Tok tk = tokinfo(row);
        const float* mrow = mod + ((size_t)l * 17 + tk.modrow) * 6144;
        f32x4 v[4]; float ss = 0.f;
#pragma unroll
        for (int j = 0; j < 4; ++j) { v[j] = *(const f32x4*)(H + (size_t)row * DM + j * 256 + lane * 4); ss += (v[j].x * v[j].x + v[j].y * v[j].y) + (v[j].z * v[j].z + v[j].w * v[j].w); }
        const float rstd = rsqrtf(wave_sum(ss) * (1.0f / DM) + 1e-6f);
#pragma unroll
        for (int j = 0; j < 4; ++j) {
            const int col = j * 256 + lane * 4;
            const f32x4 g = *(const f32x4*)(gp + col), sc = *(const f32x4*)(mrow + c_scale * 1024 + col), sh = *(const f32x4*)(mrow + c_shift * 1024 + col);
            v[j] = (v[j] * rstd * g) * (sc + 1.0f) + sh;
            u32x2 o; o.x = pk2(v[j].x, v[j].y); o.y = pk2(v[j].z, v[j].w);
            *(u32x2*)(abf + (size_t)row * DM + col) = o;
        }
        if constexpr (ROUTER) {
            float p[32];
#pragma unroll
            for (int e = 0; e < 32; ++e) {
                float acc = 0.f;
#pragma unroll
                for (int j = 0; j < 4; ++j) { const f32x4 w = *(const LAS f32x4*)(rtl + e * 1024 + j * 256 + lane * 4); acc += (v[j].x * w.x + v[j].y * w.y) + (v[j].z * w.z + v[j].w * w.w); }
                p[e] = acc;
            }
#define RS_STEP(N, OFF) _Pragma("unroll") for (int i = 0; i < (N); ++i) { const bool up = (lane & (OFF)) != 0; const float send = up ? p[i] : p[i + (N)], keep = up ? p[i + (N)] : p[i]; p[i] = keep + __shfl_xor(send, (OFF)); }
            RS_STEP(16, 32) RS_STEP(8, 16) RS_STEP(4, 8) RS_STEP(2, 4) RS_STEP(1, 2)
#undef RS_STEP
            const float mylg = p[0] + __shfl_xor(p[0], 1) + rtb;
            float tv[4] = {-3.0e38f, -3.0e38f, -3.0e38f, -3.0e38f}; int ti[4] = {0, 0, 0, 0};
#pragma unroll
            for (int e = 0; e < 32; ++e) {
                const float lgv = rdl(mylg, 2 * e);
                if (lgv > tv[3]) {
                    tv[3] = lgv; ti[3] = e;
                    if (tv[3] > tv[2]) { const float a = tv[2]; tv[2] = tv[3]; tv[3] = a; const int b = ti[2]; ti[2] = ti[3]; ti[3] = b; }
                    if (tv[2] > tv[1]) { const float a = tv[1]; tv[1] = tv[2]; tv[2] = a; const int b = ti[1]; ti[1] = ti[2]; ti[2] = b; }
                    if (tv[1] > tv[0]) { const float a = tv[0]; tv[0] = tv[1]; tv[1] = a; const int b = ti[0]; ti[0] = ti[1]; ti[1] = b; }
                }
            }
            const float e1 = __expf(tv[1] - tv[0]), e2 = __expf(tv[2] - tv[0]), e3 = __expf(tv[3] - tv[0]);
            const float inv = 1.0f / (1.0f + e1 + e2 + e3);
            if (lane == 0) {
                int* te = (int*)(ws + WS_TOKE) + (size_t)row * 4; float* tg = (float*)(ws + WS_TOKG) + (size_t)row * 4; int* tr = (int*)(ws + WS_TOKR) + (size_t)row * 4;
                te[0] = ti[0]; te[1] = ti[1]; te[2] = ti[2]; te[3] = ti[3];
                tg[0] = inv; tg[1] = e1 * inv; tg[2] = e2 * inv; tg[3] = e3 * inv;
#pragma unroll
                for (int k = 0; k < 4; ++k) tr[k] = __hip_atomic_fetch_add(hist + ti[k], 1, __ATOMIC_RELAXED, __HIP_MEMORY_SCOPE_WORKGROUP);
            }
        }
    }
    if constexpr (ROUTER) {
        __syncthreads();
        if (tid < 32) ((int*)(ws + WS_BCNT))[((size_t)l * 256 + bid) * 32 + tid] = hist[tid];
    }
}


constexpr int RT_LS = 2064;
__device__ __forceinline__ void ph_norm2_router(const Args& A, int l, int row_lo, LAS unsigned char* lds, int bid, int nb) {
    unsigned char* ws = opq(A.ws); const float* const* IN = (const float* const*)(ws + WS_PTRS);
    const int tid = tid_opaque(), lane = tid & 63, wid = tid >> 6, c16 = lane & 15, g4 = lane >> 4;
    const float* H = (const float*)(ws + WS_H); const float* mod = (const float*)(ws + WS_MOD); bf16_t* abf = (bf16_t*)(ws + WS_ABF);
    const float* gp = INP(I_N2G) + l * 1024;
    LAS unsigned char* rth = lds; LAS unsigned char* rtl = lds + 32 * RT_LS;
    LAS int* hist = (LAS int*)(lds + 64 * RT_LS);
    LAS float* lgs = (LAS float*)(lds + 64 * RT_LS + 256) + wid * 544;
    {
        const u32x4* src = (const u32x4*)((const bf16_t*)(ws + WS_RTWT) + (size_t)l * 2 * 32 * 1024);
        for (int i = tid; i < 64 * 128; i += NTHREADS) { const int row = i >> 7, ch = i & 127; *(LAS u32x4*)(lds + row * RT_LS + ch * 16) = src[i]; }
        if (tid < 32) hist[tid] = 0;
        __syncthreads();
    }
    const float rtb0 = INP(I_RTB)[l * 32 + c16], rtb1 = INP(I_RTB)[l * 32 + 16 + c16];
    const int ngroups = (NTOK - row_lo) / 16;
    for (int u = bid * NWAVES + wid; u < ngroups; u += nb * NWAVES) {
        const int row = row_lo + 16 * u + c16;
        const Tok tk = tokinfo(row_lo + 16 * u);
        const float* mrow = mod + ((size_t)l * 17 + tk.modrow) * 6144;
        const float* hrow = H + (size_t)row * DM + 8 * g4;
        float ss = 0.f;
#pragma unroll 8
        for (int ks = 0; ks < 32; ++ks) { const f32x4 a = *(const f32x4*)(hrow + 32 * ks), b = *(const f32x4*)(hrow + 32 * ks + 4);
            ss += (a.x * a.x + a.y * a.y) + (a.z * a.z + a.w * a.w) + (b.x * b.x + b.y * b.y) + (b.z * b.z + b.w * b.w); }
        ss += __shfl_xor(ss, 16); ss += __shfl_xor(ss, 32);
        const float rstd = rsqrtf(ss * (1.0f / DM) + 1e-6f);
        f32x4 acc0 = {0.f, 0.f, 0.f, 0.f}, acc1 = acc0;
#pragma unroll 2
        for (int ks = 0; ks < 32; ++ks) {
            const int col = 32 * ks + 8 * g4;
            float f[8];
            { const f32x4 xa = *(const f32x4*)(hrow + 32 * ks), xb = *(const f32x4*)(hrow + 32 * ks + 4);
              const f32x4 ga = *(const f32x4*)(gp + col), gb = *(const f32x4*)(gp + col + 4), sa = *(const f32x4*)(mrow + 4 * 1024 + col), sb = *(const f32x4*)(mrow + 4 * 1024 + col + 4);
              const f32x4 ha = *(const f32x4*)(mrow + 3 * 1024 + col), hb = *(const f32x4*)(mrow + 3 * 1024 + col + 4);
              const f32x4 fa = (xa * rstd * ga) * (sa + 1.0f) + ha, fb = (xb * rstd * gb) * (sb + 1.0f) + hb;
              f[0] = fa.x; f[1] = fa.y; f[2] = fa.z; f[3] = fa.w; f[4] = fb.x; f[5] = fb.y; f[6] = fb.z; f[7] = fb.w; }
            unsigned hi[4], lo[4];
#pragma unroll
            for (int e = 0; e < 4; ++e) { hi[e] = pk2(f[2 * e], f[2 * e + 1]);
                lo[e] = pk2(f[2 * e] - __builtin_bit_cast(float, hi[e] << 16), f[2 * e + 1] - __builtin_bit_cast(float, hi[e] & 0xffff0000u)); }
            const u32x4 hv = {hi[0], hi[1], hi[2], hi[3]}, lv = {lo[0], lo[1], lo[2], lo[3]};
            { int w0 = __builtin_amdgcn_cvt_pk_fp8_f32(f[0], f[1], 0, false); w0 = __builtin_amdgcn_cvt_pk_fp8_f32(f[2], f[3], w0, true);
              int w1 = __builtin_amdgcn_cvt_pk_fp8_f32(f[4], f[5], 0, false); w1 = __builtin_amdgcn_cvt_pk_fp8_f32(f[6], f[7], w1, true);
              *(u32x2*)((unsigned char*)abf + (size_t)row * DM + col) = (u32x2){(unsigned)w0, (unsigned)w1}; }
            const bf16x8 fh = __builtin_bit_cast(bf16x8, hv), fl = __builtin_bit_cast(bf16x8, lv);
            const int wo = c16 * RT_LS + col * 2;
            const bf16x8 wh0 = *(const LAS bf16x8*)(rth + wo), wh1 = *(const LAS bf16x8*)(rth + 16 * RT_LS + wo), wl0 = *(const LAS bf16x8*)(rtl + wo), wl1 = *(const LAS bf16x8*)(rtl + 16 * RT_LS + wo);
            acc0 = __builtin_amdgcn_mfma_f32_16x16x32_bf16(fh, wh0, acc0, 0, 0, 0); acc1 = __builtin_amdgcn_mfma_f32_16x16x32_bf16(fh, wh1, acc1, 0, 0, 0);
            acc0 = __builtin_amdgcn_mfma_f32_16x16x32_bf16(fl, wh0, acc0, 0, 0, 0); acc1 = __builtin_amdgcn_mfma_f32_16x16x32_bf16(fl, wh1, acc1, 0, 0, 0);
            acc0 = __builtin_amdgcn_mfma_f32_16x16x32_bf16(fh, wl0, acc0, 0, 0, 0); acc1 = __builtin_amdgcn_mfma_f32_16x16x32_bf16(fh, wl1, acc1, 0, 0, 0);
        }
#pragma unroll
        for (int r = 0; r < 4; ++r) { lgs[(4 * g4 + r) * 34 + c16] = acc0[r] + rtb0; lgs[(4 * g4 + r) * 34 + 16 + c16] = acc1[r] + rtb1; }
        asm volatile("s_waitcnt lgkmcnt(0)" ::: "memory");
        if (lane < 16) {
            float tv[4] = {-3.0e38f, -3.0e38f, -3.0e38f, -3.0e38f}; int ti[4] = {0, 0, 0, 0};
#pragma unroll
            for (int e = 0; e < 32; ++e) {
                const float lgv = lgs[lane * 34 + e];
                if (lgv > tv[3]) {
                    tv[3] = lgv; ti[3] = e;
                    if (tv[3] > tv[2]) { const float a = tv[2]; tv[2] = tv[3]; tv[3] = a; const int b = ti[2]; ti[2] = ti[3]; ti[3] = b; }
                    if (tv[2] > tv[1]) { const float a = tv[1]; tv[1] = tv[2]; tv[2] = a; const int b = ti[1]; ti[1] = ti[2]; ti[2] = b; }
                    if (tv[1] > tv[0]) { const float a = tv[0]; tv[0] = tv[1]; tv[1] = a; const int b = ti[0]; ti[0] = ti[1]; ti[1] = b; }
                }
            }
            const float e1 = __expf(tv[1] - tv[0]), e2 = __expf(tv[2] - tv[0]), e3 = __expf(tv[3] - tv[0]);
            const float inv = 1.0f / (1.0f + e1 + e2 + e3);
            const size_t r4 = (size_t)(row_lo + 16 * u + lane) * 4;
            *(int4*)((int*)(ws + WS_TOKE) + r4) = make_int4(ti[0], ti[1], ti[2], ti[3]);
            *(f32x4*)((float*)(ws + WS_TOKG) + r4) = (f32x4){inv, e1 * inv, e2 * inv, e3 * inv};
            int rk[4];
#pragma unroll
            for (int k = 0; k < 4; ++k) rk[k] = __hip_atomic_fetch_add(hist + ti[k], 1, __ATOMIC_RELAXED, __HIP_MEMORY_SCOPE_WORKGROUP);
            *(int4*)((int*)(ws + WS_TOKR) + r4) = make_int4(rk[0], rk[1], rk[2], rk[3]);
        }
        asm volatile("s_waitcnt lgkmcnt(0)" ::: "memory");
    }
    __syncthreads();
    if (tid < 32) ((int*)(ws + WS_BCNT))[((size_t)l * 256 + bid) * 32 + tid] = hist[tid];
}

typedef pg8::f32x4 (&AccRef)[2][2][4][2];
struct EpiStoreBf16 {
    static constexpr bool PERM = true, AFTER_DRAIN = false;
    bf16_t* O; int ldc;
    __device__ __forceinline__ void operator()(const pg8::f32x4 (&acc)[2][2][4][2], const pg8::Unit& u, int wr, int wc, int fr, int fq) const {
        const int row0 = u.pm * 256 + wr * 64 + fr, col0 = u.pn * 256 + wc * 32 + 8 * fq;
#pragma unroll
        for (int ai = 0; ai < 2; ++ai)
#pragma unroll
            for (int m = 0; m < 4; ++m) { bf16_t* rowp = O + (size_t)(row0 + ai * 128 + m * 16) * ldc + col0;
#pragma unroll
                for (int bj = 0; bj < 2; ++bj) { const pg8::f32x4 v0 = acc[ai][bj][m][0], v1 = acc[ai][bj][m][1];
                    u32x4 w; w.x = cvtpk_s(v0[0], v0[1]); w.y = cvtpk_s(v0[2], v0[3]); w.z = cvtpk_s(v1[0], v1[1]); w.w = cvtpk_s(v1[2], v1[3]);
                    *(u32x4*)(rowp + bj * 128) = w; } }
    }
};
struct EpiGeluBf16 {
    static constexpr bool PERM = true, AFTER_DRAIN = false;
    bf16_t* O; int ldc; const float* bias;
    __device__ __forceinline__ void operator()(const pg8::f32x4 (&acc)[2][2][4][2], const pg8::Unit& u, int wr, int wc, int fr, int fq) const {
        const int row0 = u.pm * 256 + wr * 64 + fr, col0 = u.pn * 256 + wc * 32 + 8 * fq;
        pg8::f32x4 bv[2][2];
#pragma unroll
        for (int bj = 0; bj < 2; ++bj)
#pragma unroll
            for (int n = 0; n < 2; ++n) bv[bj][n] = *(const pg8::f32x4*)(bias + col0 + bj * 128 + 4 * n);
#pragma unroll
        for (int ai = 0; ai < 2; ++ai)
#pragma unroll
            for (int m = 0; m < 4; ++m) { bf16_t* rowp = O + (size_t)(row0 + ai * 128 + m * 16) * ldc + col0;
#pragma unroll
                for (int bj = 0; bj < 2; ++bj) { pg8::f32x4 v0 = acc[ai][bj][m][0] + bv[bj][0], v1 = acc[ai][bj][m][1] + bv[bj][1];
                    const pg8::f32x2 a = pg8::gelu_pk((pg8::f32x2){v0[0], v0[1]}), b = pg8::gelu_pk((pg8::f32x2){v0[2], v0[3]}), c = pg8::gelu_pk((pg8::f32x2){v1[0], v1[1]}), d = pg8::gelu_pk((pg8::f32x2){v1[2], v1[3]});
                    u32x4 w; w.x = cvtpk_s(a.x, a.y); w.y = cvtpk_s(b.x, b.y); w.z = cvtpk_s(c.x, c.y); w.w = cvtpk_s(d.x, d.y);
                    *(u32x4*)(rowp + bj * 128) = w; } }
    }
};
struct EpiResidual {
    static constexpr bool PERM = false, AFTER_DRAIN = false;
    float* H; const float* gate0; int row_base;
    __device__ __forceinline__ void operator()(const pg8::f32x4 (&acc)[2][2][4][2], const pg8::Unit& u, int wr, int wc, int fr, int fq) const {
        const int row0 = u.pm * 256 + wr * 64 + fr, col0 = u.pn * 256 + wc * 32 + 4 * fq;
        const Tok tk = tokinfo(row_base + u.pm * 256);
        const float* gate = gate0 + (size_t)tk.modrow * 6144 + col0;
        pg8::f32x4 gv[2][2];
#pragma unroll
        for (int bj = 0; bj < 2; ++bj)
#pragma unroll
            for (int n = 0; n < 2; ++n) gv[bj][n] = *(const pg8::f32x4*)(gate + bj * 128 + n * 16);
#pragma unroll
        for (int ai = 0; ai < 2; ++ai)
#pragma unroll
            for (int m = 0; m < 4; ++m) { float* rowp = H + (size_t)(row0 + ai * 128 + m * 16) * DM + col0;
#pragma unroll
                for (int bj = 0; bj < 2; ++bj)
#pragma unroll
                    for (int n = 0; n < 2; ++n) { pg8::f32x4* p = (pg8::f32x4*)(rowp + bj * 128 + n * 16); *p = *p + gv[bj][n] * acc[ai][bj][m][n]; } }
    }
};
struct ListOrder {
    const LAS int* list; int n; const LAS unsigned* rowtab;
    __device__ __forceinline__ bool next(int i, pg8::Unit& u) const {
        if (i >= n) return false;
        u.pm = __builtin_amdgcn_readfirstlane(list[2 * i]); u.pn = __builtin_amdgcn_readfirstlane(list[2 * i + 1]); u.ui = i; return true;
    }
    __device__ __forceinline__ void a_ready(const pg8::Unit&) const {}
    __device__ __forceinline__ void done(const pg8::Unit&) const {}
};
struct EpiLora {
    static constexpr bool PERM = true, AFTER_DRAIN = false;
    bf16_t* O; const float* bias; int row_base;
    __device__ __forceinline__ void operator()(const pg8::f32x4 (&acc)[2][2][4][2], const pg8::Unit& u, int wr, int wc, int fr, int fq) const {
        const int seg = u.pn >> 1, row0 = row_base + u.pm * 256 + wr * 64 + fr, cs0 = (u.pn & 1) * 256 + wc * 32 + 8 * fq;
        const float ksig = seg < 2 ? -0.60653065971f : 1.0f; const bool lin = seg == 4;
        bf16_t* Os = O + (size_t)seg * NTOK * 512;
#pragma unroll
        for (int bj = 0; bj < 2; ++bj) {
            const int cs = cs0 + bj * 128;
            const pg8::f32x4 b0 = *(const pg8::f32x4*)(bias + seg * 512 + cs), b1 = *(const pg8::f32x4*)(bias + seg * 512 + cs + 4);
#pragma unroll
            for (int ai = 0; ai < 2; ++ai)
#pragma unroll
                for (int m = 0; m < 4; ++m) {
                    pg8::f32x4 v0 = acc[ai][bj][m][0] + b0, v1 = acc[ai][bj][m][1] + b1;
#pragma unroll
                    for (int r = 0; r < 4; ++r) {
                        const float t0 = ksig * __builtin_amdgcn_rcpf(1.0f + __expf(-v0[r])), t1 = ksig * __builtin_amdgcn_rcpf(1.0f + __expf(-v1[r]));
                        v0[r] = lin ? v0[r] : t0; v1[r] = lin ? v1[r] : t1;
                    }
                    u32x4 w; w.x = cvtpk_s(v0[0], v0[1]); w.y = cvtpk_s(v0[2], v0[3]); w.z = cvtpk_s(v1[0], v1[1]); w.w = cvtpk_s(v1[2], v1[3]);
                    *(u32x4*)(Os + (size_t)(row0 + ai * 128 + m * 16) * 512 + cs) = w;
                }
        }
    }
};
constexpr int LDS_TAB = 131072;
constexpr int LDS_LIST = LDS_TAB + 4096;
constexpr int LDS_ROWTAB = LDS_LIST + 1024;
__device__ __forceinline__ ListOrder build_units(LAS unsigned char* lds, int nM, int nN, int G, int c, const LAS int* tile_e, int ncol) {
    LAS int* list = (LAS int*)(lds + LDS_LIST);
    pg8::StaticOrder S; S.nM = nM; S.nN = nN; S.nwg = nM * nN; S.G = G; S.c = c;
    const int tid = tid_opaque();
    if (tid < 64) { pg8::Unit u; if (S.next(tid, u)) { if (tile_e) u.pn = tile_e[u.pm] * ncol + u.pn; list[2 * tid] = u.pm; list[2 * tid + 1] = u.pn; } }
    __syncthreads();
    ListOrder L; L.list = list; L.n = (c < S.nwg) ? (S.nwg - c + G - 1) / G : 0; L.rowtab = (const LAS unsigned*)(lds + LDS_ROWTAB);
    return L;
}
struct EpiMoe1 {
    static constexpr bool PERM = true, AFTER_DRAIN = false;
    bf16_t* O; const float* b1;
    __device__ __forceinline__ void operator()(const pg8::f32x4 (&acc)[2][2][4][2], const pg8::Unit& u, int wr, int wc, int fr, int fq) const {
        const int e = u.pn >> 3, pn = u.pn & 7;
        const int row0 = u.pm * 256 + wr * 64 + fr, ci = pn * 128 + wc * 32 + 8 * fq;
        const float* be = b1 + (size_t)e * 2048 + ci;
        const pg8::f32x4 bg0 = *(const pg8::f32x4*)(be), bg1 = *(const pg8::f32x4*)(be + 4), bl0 = *(const pg8::f32x4*)(be + 1024), bl1 = *(const pg8::f32x4*)(be + 1028);
#pragma unroll
        for (int ai = 0; ai < 2; ++ai)
#pragma unroll
            for (int m = 0; m < 4; ++m) {
                const pg8::f32x4 g0 = acc[ai][0][m][0] + bg0, g1 = acc[ai][0][m][1] + bg1, l0 = acc[ai][1][m][0] + bl0, l1 = acc[ai][1][m][1] + bl1;
                float o[8];
#pragma unroll
                for (int r = 0; r < 4; r += 2) {
#pragma unroll
                    for (int hlf = 0; hlf < 2; ++hlf) {
                        const pg8::f32x4 gv = hlf ? g1 : g0, lv = hlf ? l1 : l0;
                        pg8::f32x2 ga = {fminf(gv[r], 7.0f), fminf(gv[r + 1], 7.0f)};
                        const pg8::f32x2 la = {__builtin_amdgcn_fmed3f(lv[r], -7.0f, 7.0f), __builtin_amdgcn_fmed3f(lv[r + 1], -7.0f, 7.0f)};
                        const pg8::f32x2 t = ga * la + ga, x = ga * (-1.702f * 1.4426950408889634f);
                        pg8::f32x2 e; e.x = __builtin_amdgcn_exp2f(x.x); e.y = __builtin_amdgcn_exp2f(x.y);
                        const pg8::f32x2 d = e * 0.25f + 0.25f;
                        o[4 * hlf + r] = t.x * __builtin_amdgcn_rcpf(d.x); o[4 * hlf + r + 1] = t.y * __builtin_amdgcn_rcpf(d.y);
                    }
                }
                int w0 = __builtin_amdgcn_cvt_pk_fp8_f32(o[0], o[1], 0, false); w0 = __builtin_amdgcn_cvt_pk_fp8_f32(o[2], o[3], w0, true);
                int w1 = __builtin_amdgcn_cvt_pk_fp8_f32(o[4], o[5], 0, false); w1 = __builtin_amdgcn_cvt_pk_fp8_f32(o[6], o[7], w1, true);
                *(u32x2*)((unsigned char*)O + (size_t)(row0 + ai * 128 + m * 16) * DM + ci) = (u32x2){(unsigned)w0, (unsigned)w1};
            }
    }
};
struct EpiMoe2 {
    static constexpr bool PERM = true, AFTER_DRAIN = false;
    unsigned char* O; const LAS float* btab;
    __device__ __forceinline__ void operator()(const pg8::f32x4 (&acc)[2][2][4][2], const pg8::Unit& u, int wr, int wc, int fr, int fq) const {
        const int pn = u.pn & 3;
        const int row0 = u.pm * 256 + wr * 64 + fr, col0 = pn * 256 + wc * 32 + 8 * fq;
        const LAS float* be = btab + u.ui * 256 + wc * 32 + 8 * fq;
        pg8::f32x4 bv[2][2];
#pragma unroll
        for (int bj = 0; bj < 2; ++bj)
#pragma unroll
            for (int n = 0; n < 2; ++n) bv[bj][n] = *(const LAS pg8::f32x4*)(be + bj * 128 + 4 * n);
#pragma unroll
        for (int ai = 0; ai < 2; ++ai)
#pragma unroll
            for (int m = 0; m < 4; ++m) { unsigned char* rowp = O + (size_t)(row0 + ai * 128 + m * 16) * DM + col0;
#pragma unroll
                for (int bj = 0; bj < 2; ++bj) { const pg8::f32x4 v0 = (acc[ai][bj][m][0] + bv[bj][0]) * 16.0f, v1 = (acc[ai][bj][m][1] + bv[bj][1]) * 16.0f;
                    int w0 = __builtin_amdgcn_cvt_pk_fp8_f32(v0[0], v0[1], 0, false); w0 = __builtin_amdgcn_cvt_pk_fp8_f32(v0[2], v0[3], w0, true);
                    int w1 = __builtin_amdgcn_cvt_pk_fp8_f32(v1[0], v1[1], 0, false); w1 = __builtin_amdgcn_cvt_pk_fp8_f32(v1[2], v1[3], w1, true);
                    *(u32x2*)(rowp + bj * 128) = (u32x2){(unsigned)w0, (unsigned)w1}; } }
    }
};

namespace att {
typedef float f32x16 __attribute__((ext_vector_type(16)));
typedef short s16x4 __attribute__((ext_vector_type(4)));
constexpr int KVBLK = 64, LDR = 512;
constexpr float QSCALE = 0.125f * 1.4426950408889634f;
constexpr int SHM_V = KVBLK * 128 * 2, SHM_K = KVBLK * 64 * 2, SHM_ATTN = 2 * SHM_V + 2 * SHM_K + NWAVES * 64 * 4;
#define ATT_KSWZ(row, colB) ((row) * 128 + ((colB) ^ ((((row) >> 1) & 7) << 4)))
#define ATT_SBAR() __builtin_amdgcn_sched_barrier(0)
__device__ __forceinline__ int crow(int r, int hi) { return (r & 3) + 8 * (r >> 2) + 4 * hi; }
__device__ __forceinline__ unsigned cvtpk(float lo, float hi) { unsigned r; asm volatile("v_cvt_pk_bf16_f32 %0, %1, %2" : "=v"(r) : "v"(lo), "v"(hi)); return r; }
constexpr float SHIFT = -12.0f;
__device__ __forceinline__ void partialSM(f32x16& p0) {
#pragma unroll
    for (int r = 0; r < 16; ++r) p0[r] = __builtin_amdgcn_exp2f(p0[r]);
}
__device__ __forceinline__ void finishSM(f32x16& p0, f32x16& p1, float& l_reg, bf16x8& pa0, bf16x8& pa1, bf16x8& pa2, bf16x8& pa3) {
#pragma unroll
    for (int r = 0; r < 16; ++r) p1[r] = __builtin_amdgcn_exp2f(p1[r]);
    float ps = 0;
#pragma unroll
    for (int r = 0; r < 16; ++r) ps += p0[r];
#pragma unroll
    for (int r = 0; r < 16; ++r) ps += p1[r];
    l_reg += ps;
#define ATT_PK4(P, BASE, OUT) do { unsigned a0 = cvtpk(P[BASE + 0], P[BASE + 1]), a1 = cvtpk(P[BASE + 2], P[BASE + 3]);   \
    unsigned b0 = cvtpk(P[BASE + 4], P[BASE + 5]), b1 = cvtpk(P[BASE + 6], P[BASE + 7]);                              \
    auto r0 = __builtin_amdgcn_permlane32_swap(a0, b0, false, false); auto r1 = __builtin_amdgcn_permlane32_swap(a1, b1, false, false); \
    u32x4 w = {r0[0], r1[0], r0[1], r1[1]}; OUT = __builtin_bit_cast(bf16x8, w); } while (0)
    ATT_PK4(p0, 0, pa0); ATT_PK4(p0, 8, pa1); ATT_PK4(p1, 0, pa2); ATT_PK4(p1, 8, pa3);
#undef ATT_PK4
}
__device__ __forceinline__ void qkt(f32x16& p0, f32x16& p1, const LAS unsigned char* Ks, int qaddr, int r32, int hi) {
    asm volatile("" : "+v"(qaddr)); const LAS unsigned char* qp = (const LAS unsigned char*)(uintptr_t)qaddr;
    bf16x8 qr[4];
#pragma unroll
    for (int d0 = 0; d0 < 4; ++d0) qr[d0] = *(const LAS bf16x8*)(qp + d0 * 1024);
#pragma unroll
    for (int r = 0; r < 16; ++r) { p0[r] = SHIFT; p1[r] = SHIFT; }
#pragma unroll
    for (int d0 = 0; d0 < 4; ++d0) { const int cb = (d0 * 16 + hi * 8) * 2;
        const bf16x8 b0 = *(const LAS bf16x8*)(Ks + ATT_KSWZ(r32, cb));
        const bf16x8 b1 = *(const LAS bf16x8*)(Ks + ATT_KSWZ(32 + r32, cb));
        p0 = __builtin_amdgcn_mfma_f32_32x32x16_bf16(b0, qr[d0], p0, 0, 0, 0);
        p1 = __builtin_amdgcn_mfma_f32_32x32x16_bf16(b1, qr[d0], p1, 0, 0, 0); }
}
__device__ __forceinline__ int v_st(int k, int c) { const int kk = (k & ~0xC) | ((k & 4) << 1) | ((k & 8) >> 1); return ((kk >> 3) * 4 + (c >> 5)) * 512 + ((kk & 7) * 32 + (c & 31)) * 2; }
__device__ __forceinline__ int v_rd_base(int lane) { return ((lane & 3) << 3) | (((lane >> 2) & 3) << 6) | (((lane >> 4) & 1) << 5) | (((lane >> 5) & 1) << 8); }
constexpr int v_rd_off(int d0, int ks, int half) { return d0 * 512 + ks * 4096 + half * 2048; }
template <int OFF> __device__ __forceinline__ s16x4 tr_read(int vb) { s16x4 r; asm volatile("ds_read_b64_tr_b16 %0, %1 offset:%2" : "=&v"(r) : "v"(vb), "i"(OFF) : "memory"); return r; }
template <int D0> __device__ __forceinline__ void pv_one(f32x16& od, int vb, bf16x8 pa0, bf16x8 pa1, bf16x8 pa2, bf16x8 pa3) {
    const s16x4 l0 = tr_read<v_rd_off(D0, 0, 0)>(vb), h0 = tr_read<v_rd_off(D0, 0, 1)>(vb), l1 = tr_read<v_rd_off(D0, 1, 0)>(vb), h1 = tr_read<v_rd_off(D0, 1, 1)>(vb);
    const s16x4 l2 = tr_read<v_rd_off(D0, 2, 0)>(vb), h2 = tr_read<v_rd_off(D0, 2, 1)>(vb), l3 = tr_read<v_rd_off(D0, 3, 0)>(vb), h3 = tr_read<v_rd_off(D0, 3, 1)>(vb);
    asm volatile("s_waitcnt lgkmcnt(0)" ::: "memory"); ATT_SBAR();
#define ATT_PK(L, H) (bf16x8){L[0], L[1], L[2], L[3], H[0], H[1], H[2], H[3]}
    od = __builtin_amdgcn_mfma_f32_32x32x16_bf16(pa0, ATT_PK(l0, h0), od, 0, 0, 0);
    od = __builtin_amdgcn_mfma_f32_32x32x16_bf16(pa1, ATT_PK(l1, h1), od, 0, 0, 0);
    od = __builtin_amdgcn_mfma_f32_32x32x16_bf16(pa2, ATT_PK(l2, h2), od, 0, 0, 0);
    od = __builtin_amdgcn_mfma_f32_32x32x16_bf16(pa3, ATT_PK(l3, h3), od, 0, 0, 0);
#undef ATT_PK
}
__device__ __forceinline__ void pv_d0(f32x16 (&o)[4], int vb, bf16x8 pa0, bf16x8 pa1, bf16x8 pa2, bf16x8 pa3) {
    pv_one<0>(o[0], vb, pa0, pa1, pa2, pa3); pv_one<1>(o[1], vb, pa0, pa1, pa2, pa3); pv_one<2>(o[2], vb, pa0, pa1, pa2, pa3); pv_one<3>(o[3], vb, pa0, pa1, pa2, pa3);
}
__device__ __forceinline__ void attn_body(const bf16_t* Qb, const bf16_t* Kh, const bf16_t* Vh, float* Ob, int seq, LAS unsigned char* lds) {
    const int tid = tid_opaque(), wid = tid >> 6, lane = tid & 63, r32 = lane & 31, hi = lane >> 5;
    LAS unsigned char* V_lds = lds; LAS unsigned char* K_lds = lds + 2 * SHM_V;
    LAS float* wsl = (LAS float*)(lds + 2 * SHM_V + 2 * SHM_K) + wid * 64; LAS float* li_l = wsl; LAS float* al_l = wsl + 32;
    float l_reg = 0; f32x16 o[4] = {};
    const bf16_t* Qw = Qb + (size_t)(wid * 32 + r32) * LDR + hi * 8;
    LAS unsigned char* qlds = lds + SHM_ATTN + wid * 4096 + lane * 16;
#pragma unroll
    for (int d0 = 0; d0 < 4; ++d0) *(LAS bf16x8*)(qlds + d0 * 1024) = *(const bf16x8*)(Qw + d0 * 16);
    const int qr = (int)(uintptr_t)qlds;
    const int sr = tid >> 4, sc = (tid & 15) * 8, vst0 = v_st(sr, sc), vst1 = v_st(32 + sr, sc);
    const int kr = tid >> 3, kc = (tid & 7) * 8, kst = ATT_KSWZ(kr, kc * 2);
    const int vb0 = (int)(uintptr_t)V_lds + v_rd_base(lane);
    bf16x8 vsA0, vsA1, ksA, vsB0, vsB1, ksB;
#define ATT_SLOAD(V0, V1, K0, k0) do { V0 = *(const bf16x8*)(Vh + (size_t)((k0) + sr) * LDR + sc); V1 = *(const bf16x8*)(Vh + (size_t)((k0) + 32 + sr) * LDR + sc); \
    K0 = *(const bf16x8*)(Kh + (size_t)((k0) + kr) * LDR + kc); } while (0)
#define ATT_SWRITE(b, V0, V1, K0) do { *(LAS bf16x8*)(V_lds + (b) * SHM_V + vst0) = V0; *(LAS bf16x8*)(V_lds + (b) * SHM_V + vst1) = V1; \
    *(LAS bf16x8*)(K_lds + (b) * SHM_K + kst) = K0; } while (0)
#define ATT_SWAIT() asm volatile("s_waitcnt vmcnt(3)" ::: "memory")
    f32x16 p0, p1; bf16x8 pa0, pa1, pa2, pa3; const int NT = seq / KVBLK;
    ATT_SLOAD(vsA0, vsA1, ksA, 0); asm volatile("s_waitcnt vmcnt(0)" ::: "memory"); ATT_SWRITE(0, vsA0, vsA1, ksA);
    ATT_SLOAD(vsB0, vsB1, ksB, KVBLK); if (2 < NT) ATT_SLOAD(vsA0, vsA1, ksA, 2 * KVBLK);
    ATT_SWAIT(); ATT_SWRITE(1, vsB0, vsB1, ksB); __syncthreads();
    for (int j = 0; j < NT; j += 2) {
        ATT_SBAR(); qkt(p0, p1, K_lds, qr, r32, hi); partialSM(p0);
        finishSM(p0, p1, l_reg, pa0, pa1, pa2, pa3); ATT_SBAR();
        if (j + 3 < NT) ATT_SLOAD(vsB0, vsB1, ksB, (j + 3) * KVBLK); ATT_SBAR();
        pv_d0(o, vb0, pa0, pa1, pa2, pa3); ATT_SBAR();
        __syncthreads();
        if (j + 2 < NT) { ATT_SWAIT(); ATT_SWRITE(0, vsA0, vsA1, ksA); }
        asm volatile("" : "+v"(o[0]), "+v"(o[1]), "+v"(o[2]), "+v"(o[3]));
        __syncthreads();
        ATT_SBAR(); qkt(p0, p1, K_lds + SHM_K, qr, r32, hi); partialSM(p0);
        finishSM(p0, p1, l_reg, pa0, pa1, pa2, pa3); ATT_SBAR();
        if (j + 4 < NT) ATT_SLOAD(vsA0, vsA1, ksA, (j + 4) * KVBLK); ATT_SBAR();
        pv_d0(o, vb0 + SHM_V, pa0, pa1, pa2, pa3); ATT_SBAR();
        __syncthreads();
        if (j + 3 < NT) { ATT_SWAIT(); ATT_SWRITE(1, vsB0, vsB1, ksB); }
        asm volatile("" : "+v"(o[0]), "+v"(o[1]), "+v"(o[2]), "+v"(o[3]));
        __syncthreads();
    }
    { auto rr = __builtin_amdgcn_permlane32_swap(__float_as_uint(l_reg), __float_as_uint(l_reg), false, false); l_reg = __uint_as_float(rr[0]) + __uint_as_float(rr[1]); }
    if (hi == 0) li_l[r32] = l_reg; asm volatile("s_waitcnt lgkmcnt(0)" ::: "memory");
    float rli[16];
#pragma unroll
    for (int r = 0; r < 16; ++r) rli[r] = __builtin_amdgcn_rcpf(li_l[crow(r, hi)]);
    float* Ow = Ob + (size_t)(wid * 32) * LDR;
#pragma unroll
    for (int r = 0; r < 16; ++r) { const int orow = crow(r, hi);
#pragma unroll
        for (int d0 = 0; d0 < 4; ++d0) Ow[(size_t)orow * LDR + d0 * 32 + r32] = o[d0][r] * rli[r]; }
#undef ATT_SLOAD
#undef ATT_SWRITE
#undef ATT_SWAIT
}
}

__device__ __forceinline__ void ph_gemm_win(const Args& A, int j, int row_lo, LAS unsigned char* lds, int bid, int nb) {
    unsigned char* ws = opq(A.ws); const float* const* IN = (const float* const*)(ws + WS_PTRS); (void)IN;
    pg8::Gemm g{(const bf16_t*)(ws + WS_ABF) + (size_t)row_lo * DM, (const bf16_t*)(ws + WS_WIN) + (size_t)j * ZLD * DM, NTOK - row_lo, ZLD, DM};
    const ListOrder S = build_units(lds, (NTOK - row_lo) / 256, ZLD / 256, nb, bid, nullptr, 0);
    EpiStoreBf16 E{(bf16_t*)(ws + WS_Z) + (size_t)row_lo * ZLD, ZLD};
    pg8::gemm_phase<EpiStoreBf16, ListOrder, true, true>(lds, g, S, E);
}

__device__ __forceinline__ void ph_rwkv_pre(const Args& A, int j, int row_lo, int bid, int nb) {
    unsigned char* ws = opq(A.ws); const float* const* IN = (const float* const*)(ws + WS_PTRS);
    const int tid = tid_opaque(), lane = tid & 63, wid = tid >> 6;
    const bf16_t* Z = (const bf16_t*)(ws + WS_Z);
    const float* mu = INP(I_RWMU) + (size_t)j * 2 * RWC; const float* kkw = INP(I_RWKK) + j * 512;
    bf16_t* RB = (bf16_t*)(ws + WS_RB); bf16_t* KS = (bf16_t*)(ws + WS_KS); bf16_t* VS = (bf16_t*)(ws + WS_VS); bf16_t* KKN = (bf16_t*)(ws + WS_KKN); bf16_t* LIN = (bf16_t*)(ws + WS_LIN);
#define UNPK8(dst, raw) do { _Pragma("unroll") for (int _i = 0; _i < 4; ++_i) { dst[2 * _i] = __builtin_bit_cast(float, raw[_i] << 16); dst[2 * _i + 1] = __builtin_bit_cast(float, raw[_i] & 0xffff0000u); } } while (0)
#define PK8(v) (u32x4){pk2(v[0], v[1]), pk2(v[2], v[3]), pk2(v[4], v[5]), pk2(v[6], v[7])}
    for (int g = row_lo + bid * NWAVES + wid; g < NTOK; g += nb * NWAVES) {
        const Tok tk = tokinfo(g);
        const bool hp = tk.t > 0, hn = tk.t < tk.T - 1;
        const bf16_t* zc = Z + (size_t)g * ZLD;
#pragma unroll
        for (int i = 0; i < 4; ++i) {
            const int ch = i * 64 + lane, col = ch * 8;
            if (ch < 240) {
                const u32x4 zero = {0u, 0u, 0u, 0u};
                const u32x4 cr = *(const u32x4*)(zc + col), pr = hp ? *(const u32x4*)(zc - ZLD + col) : zero, nr = hn ? *(const u32x4*)(zc + ZLD + col) : zero;
                float z[8], p[8], n[8], s8[8];
                UNPK8(z, cr); UNPK8(p, pr); UNPK8(n, nr);
                const f32x4 m0a = *(const f32x4*)(mu + col), m0b = *(const f32x4*)(mu + col + 4), m1a = *(const f32x4*)(mu + RWC + col), m1b = *(const f32x4*)(mu + RWC + col + 4);
#pragma unroll
                for (int e = 0; e < 4; ++e) { s8[e] = z[e] + m0a[e] * (p[e] - z[e]) + m1a[e] * (n[e] - z[e]); s8[4 + e] = z[4 + e] + m0b[e] * (p[4 + e] - z[4 + e]) + m1b[e] * (n[4 + e] - z[4 + e]); }
                if (col < 512) *(u32x4*)(RB + (size_t)g * 512 + col) = PK8(s8);
                else if (col < 1024) {
                    const int ck = col - 512;
                    *(u32x4*)(KS + (size_t)g * 512 + ck) = PK8(s8);
                    const f32x4 kwa = *(const f32x4*)(kkw + ck), kwb = *(const f32x4*)(kkw + ck + 4);
                    float kk[8]; float ss = 0.f;
#pragma unroll
                    for (int e = 0; e < 4; ++e) { kk[e] = s8[e] * kwa[e]; kk[4 + e] = s8[4 + e] * kwb[e]; ss += kk[e] * kk[e] + kk[4 + e] * kk[4 + e]; }
                    ss += __shfl_xor(ss, 1); ss += __shfl_xor(ss, 2); ss += __shfl_xor(ss, 4);
                    const float inv = 1.0f / fmaxf(sqrtf(ss), 1e-12f);
#pragma unroll
                    for (int e = 0; e < 8; ++e) kk[e] *= inv;
                    *(u32x4*)(KKN + (size_t)g * 512 + ck) = PK8(kk);
                }
                else if (col < 1536) *(u32x4*)(VS + (size_t)g * 512 + (col - 1024)) = PK8(s8);
                else {
                    float t8[8];
#pragma unroll
                    for (int e = 0; e < 8; ++e) t8[e] = col < 1664 ? tanhf(s8[e]) : (col < 1792 ? s8[e] : sigmoidf_(s8[e]));
                    *(u32x4*)(LIN + (size_t)g * 384 + (col - 1536)) = PK8(t8);
                }
            }
        }
    }
#undef UNPK8
#undef PK8
}
__device__ __forceinline__ void ph_gemm_lora(const Args& A, int j, int row_lo, LAS unsigned char* lds, int bid, int nb) {
    unsigned char* ws = opq(A.ws);
    int Kq = LORA_K; asm volatile("" : "+s"(Kq));
    pg8::Gemm g{(const bf16_t*)(ws + WS_LIN) + (size_t)row_lo * LORA_K, (const bf16_t*)(ws + WS_WLORA) + (size_t)j * LORA_N * LORA_K, NTOK - row_lo, LORA_N, Kq};
    const ListOrder S = build_units(lds, (NTOK - row_lo) / 256, LORA_N / 256, nb, bid, nullptr, 0);
    EpiLora E{(bf16_t*)(ws + WS_LO), (const float*)(ws + WS_LBIAS) + (size_t)j * LORA_N, row_lo};
    pg8::gemm_phase<EpiLora, ListOrder, true, true>(lds, g, S, E);
}

constexpr int R_A2 = 0, R_RT = 2048, R_BT = 4096, R_KT = 6144, R_VT = 8192, R_MBR = 10240, R_MKR = 10752, R_G = 11264, R_P = 11776;
__device__ __forceinline__ bf16x8 frag4(u32x2 lo) { const u32x4 w = {lo.x, lo.y, 0u, 0u}; return __builtin_bit_cast(bf16x8, w); }
__device__ __forceinline__ bf16x8 frag8(u32x2 lo, u32x2 hi) { const u32x4 w = {lo.x, lo.y, hi.x, hi.y}; return __builtin_bit_cast(bf16x8, w); }
__device__ __forceinline__ u32x2 pack4(f32x4 v) { u32x2 o; o.x = cvtpk_s(v[0], v[1]); o.y = cvtpk_s(v[2], v[3]); return o; }
__device__ __forceinline__ int wkv_token(int b, int dir, int s) {
    if (s < TC) return b * TC + (dir ? (TC - 1 - s) : s);
    const int q = s - TC; return NCTX + b * TL + (dir ? (TL - 1 - q) : q);
}
__device__ __forceinline__ float dpp_row_shr(float x, const int n) {
    switch (n) {
        case 1: return __builtin_bit_cast(float, __builtin_amdgcn_update_dpp(0, __builtin_bit_cast(int, x), 0x111, 0xF, 0xF, false));
        case 2: return __builtin_bit_cast(float, __builtin_amdgcn_update_dpp(0, __builtin_bit_cast(int, x), 0x112, 0xF, 0xF, false));
        case 4: return __builtin_bit_cast(float, __builtin_amdgcn_update_dpp(0, __builtin_bit_cast(int, x), 0x114, 0xF, 0xF, false));
        default: return __builtin_bit_cast(float, __builtin_amdgcn_update_dpp(0, __builtin_bit_cast(int, x), 0x118, 0xF, 0xF, false));
    }
}
#define WKV_TR(dst, addr) asm volatile("ds_read_b64_tr_b16 %0, %1" : "=&v"(dst) : "v"(addr) : "memory")
__device__ __forceinline__ void ph_wkv_prep(const Args& A, int j, LAS unsigned char* lds, int bid, int nb) {
    unsigned char* ws = opq(A.ws); const float* const* IN = (const float* const*)(ws + WS_PTRS);
    const int tid = tid_opaque(), lane = tid & 63, wid = tid >> 6, c16 = lane & 15, g4 = lane >> 4;
    constexpr int RS = 144;
    LAS unsigned char* wl = lds + wid * 16384;
    LAS unsigned char* Lat = wl; LAS unsigned char* Lbt = wl + 2304; LAS unsigned char* Lkt = wl + 4608; LAS unsigned char* Lrt = wl + 6912; LAS unsigned char* Lvt = wl + 9216;
    LAS float* Lnf = (LAS float*)(wl + 11520);
    LAS unsigned char* Lx = wl + 12608;
    const size_t FS = (size_t)NTOK * 512;
    const bf16_t* RB = (const bf16_t*)(ws + WS_RB); const bf16_t* KS = (const bf16_t*)(ws + WS_KS); const bf16_t* VS = (const bf16_t*)(ws + WS_VS); const bf16_t* KKN = (const bf16_t*)(ws + WS_KKN);
#define UNPK16(dst, p) do { const u32x4 _a = *(const u32x4*)(p), _b = *(const u32x4*)((p) + 8); _Pragma("unroll") for (int _i = 0; _i < 4; ++_i) { \
        dst[2 * _i] = __builtin_bit_cast(float, _a[_i] << 16); dst[2 * _i + 1] = __builtin_bit_cast(float, _a[_i] & 0xffff0000u); \
        dst[8 + 2 * _i] = __builtin_bit_cast(float, _b[_i] << 16); dst[9 + 2 * _i] = __builtin_bit_cast(float, _b[_i] & 0xffff0000u); } } while (0)
#define PK16ST(base, v) do { *(LAS u32x4*)(base) = (u32x4){pk2(v[0], v[1]), pk2(v[2], v[3]), pk2(v[4], v[5]), pk2(v[6], v[7])}; \
        *(LAS u32x4*)((base) + 16) = (u32x4){pk2(v[8], v[9]), pk2(v[10], v[11]), pk2(v[12], v[13]), pk2(v[14], v[15])}; } while (0)
    for (int unit = bid * NWAVES + wid; unit < 256 * WKV_NCH; unit += nb * NWAVES) {
        const int inst = unit / WKV_NCH, c = unit - inst * WKV_NCH, dir = inst & 1, h = (inst >> 1) & 7, b = inst >> 4;
        const int g0 = wkv_token(b, dir, c * 16), gstep = dir ? -1 : 1;
        unsigned char* rec = ws + WS_WKV + (size_t)unit * WKV_REC;
        {
            const size_t o = (size_t)(g0 + gstep * c16) * 512 + h * 64 + 16 * g4;
            float lw[16], av[16], kv[16], kn[16], rv[16];
            UNPK16(lw, (const bf16_t*)(ws + WS_LO) + dir * FS + o); UNPK16(av, (const bf16_t*)(ws + WS_AB) + dir * FS + o);
            UNPK16(kv, KS + o); UNPK16(kn, KKN + o); UNPK16(rv, RB + o);
            { const u32x4 v0 = *(const u32x4*)(VS + o), v1 = *(const u32x4*)(VS + o + 8); *(LAS u32x4*)(Lvt + c16 * RS + 32 * g4) = v0; *(LAS u32x4*)(Lvt + c16 * RS + 32 * g4 + 16) = v1; }
            const float* kap = INP(I_RWKA) + j * 512 + h * 64 + 16 * g4;
            float at[16], bt[16], kt[16], rt[16], ecl[16];
#pragma unroll
            for (int i = 0; i < 16; ++i) {
                float cs = lw[i];
                cs += dpp_row_shr(cs, 1); cs += dpp_row_shr(cs, 2); cs += dpp_row_shr(cs, 4); cs += dpp_row_shr(cs, 8);
                const float ep = __expf(cs - lw[i]), ec = __expf(cs), em = __builtin_amdgcn_rcpf(ec);
                at[i] = -kn[i] * ep; bt[i] = kn[i] * av[i] * em; kt[i] = kv[i] * (1.0f + (av[i] - 1.0f) * kap[i]) * em; rt[i] = rv[i] * ec; ecl[i] = ec;
            }
            PK16ST(Lat + c16 * RS + 32 * g4, at); PK16ST(Lbt + c16 * RS + 32 * g4, bt); PK16ST(Lkt + c16 * RS + 32 * g4, kt); PK16ST(Lrt + c16 * RS + 32 * g4, rt);
            if (c16 == 15) {
#pragma unroll
                for (int q = 0; q < 4; ++q) *(f32x4*)(rec + R_P + (16 * g4 + 4 * q) * 4) = (f32x4){ecl[4 * q], ecl[4 * q + 1], ecl[4 * q + 2], ecl[4 * q + 3]};
            }
        }
        asm volatile("s_waitcnt lgkmcnt(0)" ::: "memory");
        f32x4 nD = {0.f, 0.f, 0.f, 0.f}, makD = nD, mbrD = nD, mkrD = nD;
#pragma unroll
        for (int ks = 0; ks < 2; ++ks) {
            const int off = c16 * RS + (32 * ks + 8 * g4) * 2;
            const bf16x8 fa = *(const LAS bf16x8*)(Lat + off), fb = *(const LAS bf16x8*)(Lbt + off), fk = *(const LAS bf16x8*)(Lkt + off), fr = *(const LAS bf16x8*)(Lrt + off);
            nD = __builtin_amdgcn_mfma_f32_16x16x32_bf16(fa, fb, nD, 0, 0, 0);
            makD = __builtin_amdgcn_mfma_f32_16x16x32_bf16(fa, fk, makD, 0, 0, 0);
            mbrD = __builtin_amdgcn_mfma_f32_16x16x32_bf16(fb, fr, mbrD, 0, 0, 0);
            mkrD = __builtin_amdgcn_mfma_f32_16x16x32_bf16(fk, fr, mkrD, 0, 0, 0);
        }
#pragma unroll
        for (int r = 0; r < 4; ++r) {
            const int row = 4 * g4 + r;
            nD[r] = (c16 < row) ? nD[r] : 0.f; makD[r] = (c16 < row) ? makD[r] : 0.f;
            mbrD[r] = (row <= c16) ? mbrD[r] : 0.f; mkrD[r] = (row <= c16) ? mkrD[r] : 0.f;
            Lnf[row * 17 + c16] = nD[r];
        }
        asm volatile("s_waitcnt lgkmcnt(0)" ::: "memory");
        float x[16];
#pragma unroll
        for (int t = 0; t < 16; ++t) {
            float acc = (t == c16) ? 1.f : 0.f;
#pragma unroll
            for (int i = 0; i < t; ++i) acc += Lnf[t * 17 + i] * x[i];
            x[t] = acc;
        }
        if (g4 == 0) {
#pragma unroll
            for (int t = 0; t < 16; ++t) *(LAS bf16_t*)(Lx + t * 32 + c16 * 2) = (bf16_t)f2bf(x[t]);
        }
        asm volatile("s_waitcnt lgkmcnt(0)" ::: "memory");
        const bf16x8 xB = frag4(*(const LAS u32x2*)(Lx + c16 * 32 + g4 * 8));
        const f32x4 z4 = {0.f, 0.f, 0.f, 0.f};
        const f32x4 gD = __builtin_amdgcn_mfma_f32_16x16x32_bf16(frag4(pack4(makD)), xB, z4, 0, 0, 0);
        *(u32x2*)(rec + R_G + (c16 * 16 + 4 * g4) * 2) = pack4(gD);
        *(u32x2*)(rec + R_MBR + (c16 * 16 + 4 * g4) * 2) = pack4(mbrD);
        *(u32x2*)(rec + R_MKR + (c16 * 16 + 4 * g4) * 2) = pack4(mkrD);
        {
            const int trow = c16 >> 2, tcol = 4 * (c16 & 3);
            u32x2 ta[4], tb[4], tk[4], tv[4];
#pragma unroll
            for (int m = 0; m < 4; ++m) {
                const int aA = (int)(uintptr_t)(Lat + (4 * g4 + trow) * RS + (16 * m + tcol) * 2);
                const int offr = (4 * m + trow) * RS + (16 * g4 + tcol) * 2;
                const int aB = (int)(uintptr_t)(Lbt + offr), aK = (int)(uintptr_t)(Lkt + offr), aV = (int)(uintptr_t)(Lvt + offr);
                WKV_TR(ta[m], aA); WKV_TR(tb[m], aB); WKV_TR(tk[m], aK); WKV_TR(tv[m], aV);
            }
            asm volatile("s_waitcnt lgkmcnt(0)" ::: "memory"); __builtin_amdgcn_sched_barrier(0);
#pragma unroll
            for (int m = 0; m < 4; ++m) {
                const f32x4 d = __builtin_amdgcn_mfma_f32_16x16x32_bf16(frag4(ta[m]), xB, z4, 0, 0, 0);
                *(u32x2*)(rec + R_A2 + (c16 * 64 + 16 * m + 4 * g4) * 2) = pack4(d);
            }
            const int kch = 16 * g4 + c16;
            *(u32x4*)(rec + R_BT + kch * 32) = (u32x4){tb[0].x, tb[0].y, tb[1].x, tb[1].y}; *(u32x4*)(rec + R_BT + kch * 32 + 16) = (u32x4){tb[2].x, tb[2].y, tb[3].x, tb[3].y};
            *(u32x4*)(rec + R_KT + kch * 32) = (u32x4){tk[0].x, tk[0].y, tk[1].x, tk[1].y}; *(u32x4*)(rec + R_KT + kch * 32 + 16) = (u32x4){tk[2].x, tk[2].y, tk[3].x, tk[3].y};
            *(u32x4*)(rec + R_VT + kch * 32) = (u32x4){tv[0].x, tv[0].y, tv[1].x, tv[1].y}; *(u32x4*)(rec + R_VT + kch * 32 + 16) = (u32x4){tv[2].x, tv[2].y, tv[3].x, tv[3].y};
        }
        { const int row = lane >> 2, cb = (lane & 3) * 16;
          const u32x4 r0 = *(const LAS u32x4*)(Lrt + row * RS + cb * 2), r1 = *(const LAS u32x4*)(Lrt + row * RS + cb * 2 + 16);
          *(u32x4*)(rec + R_RT + (row * 64 + cb) * 2) = r0; *(u32x4*)(rec + R_RT + (row * 64 + cb) * 2 + 16) = r1; }
        asm volatile("s_waitcnt lgkmcnt(0)" ::: "memory");
    }
#undef UNPK16
#undef PK16ST
}
constexpr int WKV_D = 6, WKV_R = WKV_D + 2;
__device__ __forceinline__ void ph_wkv_scan(const Args& A, LAS unsigned char* lds, int bid, int nb) {
    unsigned char* ws = opq(A.ws);
    const int tid = tid_opaque(), lane = tid & 63, wid = __builtin_amdgcn_readfirstlane(tid >> 6), c16 = lane & 15, g4 = lane >> 4;
    float* YS = (float*)(ws + WS_YS); const size_t FS = (size_t)NTOK * 512;
    for (int inst = bid; inst < 256; inst += nb) {
        const int dir = inst & 1, h = (inst >> 1) & 7, b = inst >> 4;
        const unsigned char* rec0 = ws + WS_WKV + (size_t)inst * WKV_NCH * WKV_REC;
        asm volatile("s_waitcnt vmcnt(0) lgkmcnt(0)" ::: "memory"); __builtin_amdgcn_s_barrier();
        if (wid >= 4) {
            const int p0 = 3 * (wid - 4);
#define WKV_ISSUE(c_) do { const unsigned char* src_ = rec0 + (size_t)(c_) * WKV_REC + p0 * 1024 + lane * 16; LAS unsigned char* dst_ = lds + ((c_) % WKV_R) * WKV_REC + p0 * 1024; \
        _Pragma("unroll") for (int i_ = 0; i_ < 3; ++i_) __builtin_amdgcn_global_load_lds((const unsigned*)(src_ + i_ * 1024), (LAS unsigned*)(dst_ + i_ * 1024), 16, 0, 0); } while (0)
            for (int c = 0; c < WKV_D; ++c) WKV_ISSUE(c);
            for (int c = 0; c < WKV_NCH; ++c) {
                if (c + WKV_D < WKV_NCH) { WKV_ISSUE(c + WKV_D); asm volatile("s_waitcnt vmcnt(18)" ::: "memory"); }
                else asm volatile("s_waitcnt vmcnt(0)" ::: "memory");
                __builtin_amdgcn_s_barrier();
            }
#undef WKV_ISSUE
        } else {
            const int v0 = wid * 16;
            float* Y = YS + dir * FS + h * 64 + v0 + c16;
            f32x4 S[4];
#pragma unroll
            for (int mt = 0; mt < 4; ++mt) S[mt] = (f32x4){0.f, 0.f, 0.f, 0.f};
            for (int c = 0; c < WKV_NCH; ++c) {
                __builtin_amdgcn_s_barrier();
                const LAS unsigned char* rec = lds + (c % WKV_R) * WKV_REC;
                u32x2 a2[4], rt[4], bt[4], kt[4]; f32x4 p[4];
#pragma unroll
                for (int q = 0; q < 4; ++q) {
                    a2[q] = *(const LAS u32x2*)(rec + R_A2 + (c16 * 64 + 16 * q + 4 * g4) * 2);
                    rt[q] = *(const LAS u32x2*)(rec + R_RT + (c16 * 64 + 16 * q + 4 * g4) * 2);
                    bt[q] = *(const LAS u32x2*)(rec + R_BT + ((16 * q + c16) * 16 + 4 * g4) * 2);
                    kt[q] = *(const LAS u32x2*)(rec + R_KT + ((16 * q + c16) * 16 + 4 * g4) * 2);
                    p[q] = *(const LAS f32x4*)(rec + R_P + (16 * q + 4 * g4) * 4);
                }
                const u32x2 gq = *(const LAS u32x2*)(rec + R_G + (c16 * 16 + 4 * g4) * 2), mkr = *(const LAS u32x2*)(rec + R_MKR + (c16 * 16 + 4 * g4) * 2), mbr = *(const LAS u32x2*)(rec + R_MBR + (c16 * 16 + 4 * g4) * 2);
                const u32x2 vt = *(const LAS u32x2*)(rec + R_VT + ((v0 + c16) * 16 + 4 * g4) * 2);
                const f32x4 z4 = {0.f, 0.f, 0.f, 0.f};
                const bf16x8 sb0 = frag8(pack4(S[0]), pack4(S[1])), sb1 = frag8(pack4(S[2]), pack4(S[3]));
                const bf16x8 vb = frag4(vt);
                f32x4 U = __builtin_amdgcn_mfma_f32_16x16x32_bf16(frag4(gq), vb, z4, 0, 0, 0);
                U = __builtin_amdgcn_mfma_f32_16x16x32_bf16(frag8(a2[0], a2[1]), sb0, U, 0, 0, 0);
                U = __builtin_amdgcn_mfma_f32_16x16x32_bf16(frag8(a2[2], a2[3]), sb1, U, 0, 0, 0);
                f32x4 Yt = __builtin_amdgcn_mfma_f32_16x16x32_bf16(frag4(mkr), vb, z4, 0, 0, 0);
                Yt = __builtin_amdgcn_mfma_f32_16x16x32_bf16(frag8(rt[0], rt[1]), sb0, Yt, 0, 0, 0);
                Yt = __builtin_amdgcn_mfma_f32_16x16x32_bf16(frag8(rt[2], rt[3]), sb1, Yt, 0, 0, 0);
                const bf16x8 ub = frag4(pack4(U));
                Yt = __builtin_amdgcn_mfma_f32_16x16x32_bf16(frag4(mbr), ub, Yt, 0, 0, 0);
#pragma unroll
                for (int mt = 0; mt < 4; ++mt) {
                    f32x4 sn = __builtin_amdgcn_mfma_f32_16x16x32_bf16(frag4(kt[mt]), vb, S[mt], 0, 0, 0);
                    sn = __builtin_amdgcn_mfma_f32_16x16x32_bf16(frag4(bt[mt]), ub, sn, 0, 0, 0);
                    S[mt] = sn * p[mt];
                }
#pragma unroll
                for (int r = 0; r < 4; ++r) Y[(size_t)wkv_token(b, dir, c * 16 + 4 * g4 + r) * 512] = Yt[r];
            }
        }
    }
}

__device__ __forceinline__ void ph_qk(const Args& A, int j, int row_lo, int bid, int nb) {
    unsigned char* ws = opq(A.ws); const float* const* IN = (const float* const*)(ws + WS_PTRS);
    const int tid = tid_opaque(), lane = tid & 63, wid = tid >> 6;
    const bf16_t* Z = (const bf16_t*)(ws + WS_Z);
    bf16_t* QB = (bf16_t*)(ws + WS_QB); bf16_t* KB = (bf16_t*)(ws + WS_KB); bf16_t* VB = (bf16_t*)(ws + WS_VB);
    const int d0 = (lane & 7) * 8;
    float qn[8], kn[8], invf[8];
#pragma unroll
    for (int i = 0; i < 8; ++i) { qn[i] = INP(I_QN)[j * 64 + d0 + i]; kn[i] = INP(I_KN)[j * 64 + d0 + i]; invf[i] = __powf(10000.0f, -(float)((d0 + i) & 15) / 16.0f); }
    const bool upper = (d0 & 16) != 0, colaxis = (d0 & 32) != 0;
    for (int g = row_lo + bid * NWAVES + wid; g < NTOK; g += nb * NWAVES) {
        const Tok tk = tokinfo(g);
        const size_t krow = (size_t)tk.b * (TC + TL) + (tk.T == TL ? TC + tk.t : tk.t);
        const bf16_t* zr = Z + (size_t)g * ZLD + RWC;
        *(u32x4*)(VB + krow * 512 + lane * 8) = *(const u32x4*)(zr + 1024 + lane * 8);
        float cs[8], sn[8];
        if (tk.T == TL) {
            const float pos = (float)(colaxis ? (tk.t & 63) : (tk.t >> 6));
#pragma unroll
            for (int i = 0; i < 8; ++i) __sincosf(pos * invf[i], &sn[i], &cs[i]);
        }
#pragma unroll
        for (int isk = 0; isk < 2; ++isk) {
            const u32x4 raw = *(const u32x4*)(zr + isk * 512 + lane * 8);
            float x[8];
#pragma unroll
            for (int i = 0; i < 4; ++i) { x[2 * i] = __builtin_bit_cast(float, raw[i] << 16); x[2 * i + 1] = __builtin_bit_cast(float, raw[i] & 0xffff0000u); }
            float ss = 0.f;
#pragma unroll
            for (int i = 0; i < 8; ++i) ss += x[i] * x[i];
            ss += __shfl_xor(ss, 1); ss += __shfl_xor(ss, 2); ss += __shfl_xor(ss, 4);
            const float rs = rsqrtf(ss * (1.0f / 64.0f) + 1e-6f);
#pragma unroll
            for (int i = 0; i < 8; ++i) x[i] = x[i] * rs * (isk ? kn[i] : qn[i] * att::QSCALE);
            if (tk.T == TL) {
#pragma unroll
                for (int i = 0; i < 8; ++i) { const float other = __shfl_xor(x[i], 2); x[i] = upper ? (x[i] * cs[i] + other * sn[i]) : (x[i] * cs[i] - other * sn[i]); }
            }
            u32x4 o; o.x = pk2(x[0], x[1]); o.y = pk2(x[2], x[3]); o.z = pk2(x[4], x[5]); o.w = pk2(x[6], x[7]);
            if (isk) *(u32x4*)(KB + krow * 512 + lane * 8) = o; else *(u32x4*)(QB + (size_t)g * 512 + lane * 8) = o;
        }
    }
}

__device__ __forceinline__ void ph_attn(const Args& A, bool want_ctx, LAS unsigned char* lds, int bid, int nb) {
    unsigned char* ws = opq(A.ws);
    const bf16_t* QB = (const bf16_t*)(ws + WS_QB); const bf16_t* KB = (const bf16_t*)(ws + WS_KB); const bf16_t* VB = (const bf16_t*)(ws + WS_VB);
    float* OP = (float*)(ws + WS_OP);
    const int vcu = (nb % 8 == 0) ? (bid % 8) * (nb / 8) + bid / 8 : bid;
    const int nunits = 1024 + (want_ctx ? 128 : 0);
    for (int u = vcu; u < nunits; u += nb) {
        int b, h, m, q0, seq;
        if (u < 1024) { const int qb = u & 7; m = (u >> 3) & 1; h = (u >> 4) & 3; b = u >> 6; q0 = NCTX + b * TL + qb * 256; seq = TC + TL; }
        else { const int v = u - 1024; m = v & 1; h = (v >> 1) & 3; b = v >> 3; q0 = b * TC; seq = TC; }
        const int s = h * 2 + m;
        att::attn_body(QB + (size_t)q0 * 512 + s * 64, KB + (size_t)b * (TC + TL) * 512 + s * 64, VB + (size_t)b * (TC + TL) * 512 + h * 128,
                       OP + (size_t)m * NTOK * 512 + (size_t)q0 * 512 + h * 128, seq, lds);
    }
}

__device__ __forceinline__ void ph_merge(const Args& A, int l, int row_lo, int bid, int nb) {
    unsigned char* ws = opq(A.ws); const float* const* IN = (const float* const*)(ws + WS_PTRS);
    const int j = l >> 1;
    const int tid = tid_opaque(), lane = tid & 63, wid = tid >> 6, c0 = lane * 8;
    const float lam_init = 0.8f - 0.6f * __expf(-0.3f * (float)l);
    const float* lp = INP(I_LAM) + j * 4 * 64;
    const float lam = __expf(wave_sum(lp[lane] * lp[64 + lane])) - __expf(wave_sum(lp[128 + lane] * lp[192 + lane])) + lam_init;
    const size_t FS = (size_t)NTOK * 512;
    const bf16_t* RB = (const bf16_t*)(ws + WS_RB); const bf16_t* KS = (const bf16_t*)(ws + WS_KS); const bf16_t* VS = (const bf16_t*)(ws + WS_VS);
    const bf16_t* AB = (const bf16_t*)(ws + WS_AB); const bf16_t* GB = (const bf16_t*)(ws + WS_GB);
    const float* YS = (const float*)(ws + WS_YS); const float* OP = (const float*)(ws + WS_OP);
    bf16_t* CAT = (bf16_t*)(ws + WS_CAT);
    float gnw[8], gnb[8], kaw[8], rkw[8], sub[8];
#pragma unroll
    for (int i = 0; i < 8; ++i) { gnw[i] = INP(I_GNW)[j * 512 + c0 + i]; gnb[i] = INP(I_GNB)[j * 512 + c0 + i]; kaw[i] = INP(I_RWKA)[j * 512 + c0 + i]; rkw[i] = INP(I_RWRK)[j * 512 + c0 + i];
        sub[i] = INP(I_SUBLN)[j * 128 + ((c0 + i) & 127)] * (1.0f - lam_init); }
#define LD8BF(dst, ptr) do { const u32x4 _t = *(const u32x4*)(ptr); _Pragma("unroll") for (int _i = 0; _i < 4; ++_i) { dst[2 * _i] = __builtin_bit_cast(float, _t[_i] << 16); dst[2 * _i + 1] = __builtin_bit_cast(float, _t[_i] & 0xffff0000u); } } while (0)
    for (int g = row_lo + bid * NWAVES + wid; g < NTOK; g += nb * NWAVES) {
        const size_t o = (size_t)g * 512 + c0;
        float y[8], r_[8], k_[8], v_[8], a0[8], a1[8], gg[8];
        { const f32x4 y0 = *(const f32x4*)(YS + o), y1 = *(const f32x4*)(YS + o + 4), z0 = *(const f32x4*)(YS + FS + o), z1 = *(const f32x4*)(YS + FS + o + 4);
#pragma unroll
          for (int i = 0; i < 4; ++i) { y[i] = y0[i] + z0[i]; y[4 + i] = y1[i] + z1[i]; } }
        LD8BF(r_, RB + o); LD8BF(k_, KS + o); LD8BF(v_, VS + o); LD8BF(a0, AB + o); LD8BF(a1, AB + FS + o); LD8BF(gg, GB + o);
        float sy = 0.f, sb = 0.f;
#pragma unroll
        for (int i = 0; i < 8; ++i) { sy += y[i]; sb += r_[i] * k_[i] * (2.0f + (a0[i] + a1[i] - 2.0f) * kaw[i]) * rkw[i]; }
        sy += __shfl_xor(sy, 1); sy += __shfl_xor(sy, 2); sy += __shfl_xor(sy, 4);
        sb += __shfl_xor(sb, 1); sb += __shfl_xor(sb, 2); sb += __shfl_xor(sb, 4);
        const float mu = sy * (1.0f / 64.0f);
        float sv = 0.f;
#pragma unroll
        for (int i = 0; i < 8; ++i) { y[i] -= mu; sv += y[i] * y[i]; }
        sv += __shfl_xor(sv, 1); sv += __shfl_xor(sv, 2); sv += __shfl_xor(sv, 4);
        const float rstd = rsqrtf(sv * (1.0f / 64.0f) + 64e-5f);
        float ya[8];
#pragma unroll
        for (int i = 0; i < 8; ++i) ya[i] = (y[i] * rstd * gnw[i] + gnb[i] + sb * v_[i]) * gg[i];
        { u32x4 w; w.x = pk2(ya[0], ya[1]); w.y = pk2(ya[2], ya[3]); w.z = pk2(ya[4], ya[5]); w.w = pk2(ya[6], ya[7]); *(u32x4*)(CAT + (size_t)g * DM + c0) = w; }
        float od[8];
        { const f32x4 p0 = *(const f32x4*)(OP + o), p1 = *(const f32x4*)(OP + o + 4), q0 = *(const f32x4*)(OP + FS + o), q1 = *(const f32x4*)(OP + FS + o + 4);
#pragma unroll
          for (int i = 0; i < 4; ++i) { od[i] = p0[i] - lam * q0[i]; od[4 + i] = p1[i] - lam * q1[i]; } }
        float so = 0.f;
#pragma unroll
        for (int i = 0; i < 8; ++i) so += od[i] * od[i];
        so += __shfl_xor(so, 1); so += __shfl_xor(so, 2); so += __shfl_xor(so, 4); so += __shfl_xor(so, 8);
        const float ro = rsqrtf(so * (1.0f / 128.0f) + 1e-6f);
        { u32x4 w; w.x = pk2(od[0] * ro * sub[0], od[1] * ro * sub[1]); w.y = pk2(od[2] * ro * sub[2], od[3] * ro * sub[3]);
          w.z = pk2(od[4] * ro * sub[4], od[5] * ro * sub[5]); w.w = pk2(od[6] * ro * sub[6], od[7] * ro * sub[7]); *(u32x4*)(CAT + (size_t)g * DM + 512 + c0) = w; }
    }
#undef LD8BF
}

__device__ __forceinline__ void ph_gemm_out(const Args& A, int l, size_t x_off, size_t wt_off, int row_lo, LAS unsigned char* lds, int bid, int nb) {
    unsigned char* ws = opq(A.ws); const float* const* IN = (const float* const*)(ws + WS_PTRS); (void)IN;
    pg8::Gemm g{(const bf16_t*)(ws + x_off) + (size_t)row_lo * DM, (const bf16_t*)(ws + wt_off), NTOK - row_lo, DM, DM};
    const ListOrder S = build_units(lds, (NTOK - row_lo) / 256, DM / 256, nb, bid, nullptr, 0);
    EpiResidual E{(float*)(ws + WS_H) + (size_t)row_lo * DM, (const float*)(ws + WS_MOD) + (size_t)l * 17 * 6144 + 2 * 1024, row_lo};
    pg8::gemm_phase<EpiResidual, ListOrder, true, true>(lds, g, S, E);
}

__device__ __forceinline__ void ph_gemm_sgin(const Args& A, int j, int row_lo, LAS unsigned char* lds, int bid, int nb) {
    unsigned char* ws = opq(A.ws); const float* const* IN = (const float* const*)(ws + WS_PTRS); (void)IN;
    pg8::Gemm g{(const bf16_t*)(ws + WS_ABF) + (size_t)row_lo * DM, (const bf16_t*)(ws + WS_SGIN) + (size_t)j * 2048 * DM, NTOK - row_lo, 2048, DM};
    const ListOrder S = build_units(lds, (NTOK - row_lo) / 256, 2048 / 256, nb, bid, nullptr, 0);
    EpiGeluBf16 E{(bf16_t*)(ws + WS_Z2) + (size_t)row_lo * 2048, 2048, INP(I_SGBIN) + j * 2048};
    pg8::gemm_phase<EpiGeluBf16, ListOrder, true, true>(lds, g, S, E);
}
__device__ __forceinline__ void ph_sgu_stats(const Args& A, int row_lo, int bid, int nb) {
    unsigned char* ws = opq(A.ws);
    const int tid = tid_opaque(), lane = tid & 63, wid = tid >> 6;
    const bf16_t* Z2 = (const bf16_t*)(ws + WS_Z2); float* ST = (float*)(ws + WS_VST);
    for (int row = row_lo + bid * NWAVES + wid; row < NTOK; row += nb * NWAVES) {
        const u32x4 t0 = *(const u32x4*)(Z2 + (size_t)row * 2048 + 1024 + lane * 8), t1 = *(const u32x4*)(Z2 + (size_t)row * 2048 + 1536 + lane * 8);
        float v[16]; float s = 0.f;
#pragma unroll
        for (int i = 0; i < 4; ++i) { v[2 * i] = __builtin_bit_cast(float, t0[i] << 16); v[2 * i + 1] = __builtin_bit_cast(float, t0[i] & 0xffff0000u);
            v[8 + 2 * i] = __builtin_bit_cast(float, t1[i] << 16); v[9 + 2 * i] = __builtin_bit_cast(float, t1[i] & 0xffff0000u); }
#pragma unroll
        for (int i = 0; i < 16; ++i) s += v[i];
        const float mean = wave_sum(s) * (1.0f / 1024.0f); float s2 = 0.f;
#pragma unroll
        for (int i = 0; i < 16; ++i) { const float d = v[i] - mean; s2 += d * d; }
        const float rstd = rsqrtf(wave_sum(s2) * (1.0f / 1024.0f) + 1e-5f);
        if (lane == 0) { ST[(size_t)row * 2] = mean; ST[(size_t)row * 2 + 1] = rstd; }
    }
}
__device__ __forceinline__ void ph_sgu_spatial(const Args& A, int j, int row_lo, LAS unsigned char* lds, int bid, int nb) {
    unsigned char* ws = opq(A.ws); const float* const* IN = (const float* const*)(ws + WS_PTRS);
    const int tid = tid_opaque(), lane = tid & 63, wid = tid >> 6, c16 = lane & 15, g4 = lane >> 4;
    const bf16_t* Z2 = (const bf16_t*)(ws + WS_Z2); const float* ST = (const float*)(ws + WS_VST); bf16_t* G = (bf16_t*)(ws + WS_G);
    constexpr int VS = 272;
    LAS unsigned char* vt = lds;
    LAS float* stl = (LAS float*)(lds + 36864);
    const int ch0 = row_lo / 128, nch = NTOK / 128 - ch0;
    for (int u = bid; u < nch * 8; u += nb) {
        const int ci = ch0 + u / 8, g = u % 8;
        const size_t r0 = (size_t)ci * 128;
        __syncthreads();
#pragma unroll
        for (int i = 0; i < 4; ++i) {
            const int idx = tid + NTHREADS * i, q = idx >> 4, jc = idx & 15;
            const u32x4 t = *(const u32x4*)(Z2 + (r0 + q) * 2048 + 1024 + g * 128 + jc * 8);
#pragma unroll
            for (int e = 0; e < 4; ++e) { *(LAS bf16_t*)(vt + (jc * 8 + 2 * e) * VS + q * 2) = (bf16_t)(t[e] & 0xffffu); *(LAS bf16_t*)(vt + (jc * 8 + 2 * e + 1) * VS + q * 2) = (bf16_t)(t[e] >> 16); }
        }
        if (tid < 256) stl[tid] = ST[r0 * 2 + tid];
        __syncthreads();
        const float* wrow = INP(I_SGWS) + (((size_t)j * 8 + g) * 128 + 16 * wid + c16) * 128;
        bf16x8 af[4]; float wm = 0.f, rs = 0.f;
#pragma unroll
        for (int ks = 0; ks < 4; ++ks) {
            const int q0 = 32 * ks + 8 * g4;
            const f32x4 w0 = *(const f32x4*)(wrow + q0), w1 = *(const f32x4*)(wrow + q0 + 4);
            float wv[8] = {w0[0], w0[1], w0[2], w0[3], w1[0], w1[1], w1[2], w1[3]};
#pragma unroll
            for (int e = 0; e < 8; ++e) { rs += wv[e]; wv[e] *= stl[(q0 + e) * 2 + 1]; wm += wv[e] * stl[(q0 + e) * 2]; }
            const u32x4 pk = {pk2(wv[0], wv[1]), pk2(wv[2], wv[3]), pk2(wv[4], wv[5]), pk2(wv[6], wv[7])};
            af[ks] = __builtin_bit_cast(bf16x8, pk);
        }
        wm += __shfl_xor(wm, 16); wm += __shfl_xor(wm, 32); rs += __shfl_xor(rs, 16); rs += __shfl_xor(rs, 32);
        f32x4 acc[8];
#pragma unroll
        for (int nt = 0; nt < 8; ++nt) acc[nt] = (f32x4){0.f, 0.f, 0.f, 0.f};
#pragma unroll
        for (int ks = 0; ks < 4; ++ks)
#pragma unroll
            for (int nt = 0; nt < 8; ++nt) {
                const bf16x8 bfr = *(const LAS bf16x8*)(vt + (16 * nt + c16) * VS + (32 * ks + 8 * g4) * 2);
                acc[nt] = __builtin_amdgcn_mfma_f32_16x16x32_bf16(af[ks], bfr, acc[nt], 0, 0, 0);
            }
        float wmr[4], rsr[4], bsr[4];
#pragma unroll
        for (int r = 0; r < 4; ++r) { wmr[r] = __shfl(wm, 4 * g4 + r); rsr[r] = __shfl(rs, 4 * g4 + r); bsr[r] = INP(I_SGBS)[((size_t)j * 8 + g) * 128 + 16 * wid + 4 * g4 + r]; }
#pragma unroll
        for (int nt = 0; nt < 8; ++nt) {
            const int c = g * 128 + 16 * nt + c16;
            const float lg = INP(I_SGLNG)[j * 1024 + c], lb = INP(I_SGLNB)[j * 1024 + c];
#pragma unroll
            for (int r = 0; r < 4; ++r) {
                const size_t row = r0 + 16 * wid + 4 * g4 + r;
                const float sv = lg * (acc[nt][r] - wmr[r]) + rsr[r] * lb + bsr[r];
                G[row * DM + c] = (bf16_t)f2bf(bf2f(Z2[row * 2048 + c]) * sv);
            }
        }
    }
}

__device__ __forceinline__ int moe_layout(const Args& A, int l, int bid, int nb, LAS int* off  , LAS int* cntl  , LAS int* tile_e  , LAS int* base  ) {
    const int tid = tid_opaque();
    const int* bc = (const int*)(opq(A.ws) + WS_BCNT) + (size_t)l * 256 * 32;
    if (tid < 64) {
        int n = 0, pre = 0;
        if (tid < 32) {
#pragma unroll 8
            for (int b = 0; b < nb; ++b) { const int c = bc[b * 32 + tid]; n += c; pre += (b < bid) ? c : 0; }
        }
        const int nt = (n + 255) >> 8;
        int x = nt;
#pragma unroll
        for (int o = 1; o < 32; o <<= 1) { const int y = __shfl_up(x, o); if (tid >= o) x += y; }
        const int start = x - nt;
        if (tid < 32) {
            cntl[tid] = n; off[tid] = start * 256; base[tid] = start * 256 + pre;
#pragma unroll 1
            for (int t = 0; t < nt; ++t) tile_e[start + t] = tid;
        }
        if (tid == 31) off[32] = x * 256;
    }
    __syncthreads();
    return off[32] >> 8;
}
__device__ __forceinline__ void ph_moe_scatter(const Args& A, int l, int row_lo, LAS unsigned char* lds, int bid, int nb) {
    unsigned char* ws = opq(A.ws);
    const int tid = tid_opaque();
    LAS int* off = (LAS int*)(lds + LDS_TAB); LAS int* cntl = off + 64; LAS int* tile_e = off + 128; LAS int* base = off + 800;
    moe_layout(A, l, bid, nb, off, cntl, tile_e, base);
    const int* te = (const int*)(ws + WS_TOKE); const int* tr = (const int*)(ws + WS_TOKR); int* rowof = (int*)(ws + WS_ROWOF); int* srcrow = (int*)(ws + WS_SRCROW);
    const int ngroups = (NTOK - row_lo) / 16, per = nb * NWAVES;
    const int nmine = (ngroups - bid * NWAVES + per - 1) / per * NWAVES;
    for (int q = tid; q < nmine * 64; q += NTHREADS) {
        const int slot = q >> 6, r = (q >> 2) & 15, k = q & 3, i = slot >> 3, w = slot & 7;
        const int u = i * per + bid * NWAVES + w;
        if (u < ngroups) {
            const int row = row_lo + 16 * u + r;
            const int e = te[(size_t)row * 4 + k];
            const int pos = base[e] + tr[(size_t)row * 4 + k];
            rowof[(size_t)row * 4 + k] = pos; srcrow[pos] = row;
        }
    }
    for (int e = bid; e < 32; e += nb) {
        const int r0 = off[e] + cntl[e], r1 = off[e + 1];
        for (int i = r0 + tid; i < r1; i += NTHREADS) srcrow[i] = NCTX;
    }
}
__device__ __forceinline__ void ph_moe_gemm1(const Args& A, int l, LAS unsigned char* lds, int bid, int nb) {
    unsigned char* ws = opq(A.ws); const float* const* IN = (const float* const*)(ws + WS_PTRS); (void)IN;
    LAS int* off = (LAS int*)(lds + LDS_TAB); LAS int* cntl = off + 64; LAS int* tile_e = off + 128; LAS int* base = off + 800;
    const int T = moe_layout(A, l, bid, nb, off, cntl, tile_e, base);
    int Kq = DM / 2; asm volatile("" : "+s"(Kq));
    pg8::Gemm g{(const bf16_t*)(ws + WS_ABF), (const bf16_t*)(ws + WS_W1 + (size_t)l * NE * 2048 * DM), T * 256, 2048, Kq};
    const ListOrder S = build_units(lds, T, 8, nb, bid, tile_e, 8);
    { LAS unsigned* rowtab = (LAS unsigned*)(lds + LDS_ROWTAB); const int* srcrow = (const int*)(ws + WS_SRCROW); const int tid = tid_opaque();
      for (int q = tid; q < S.n * 256; q += NTHREADS) rowtab[q] = (unsigned)srcrow[S.list[2 * (q >> 8)] * 256 + (q & 255)] * (unsigned)DM;
      __syncthreads(); }
    EpiMoe1 E{(bf16_t*)(ws + WS_ACT), INP(I_B1) + (size_t)l * NE * 2048};
    pg8::gemm_phase<EpiMoe1, ListOrder, true, true, true, true>(lds, g, S, E);
}
__device__ __forceinline__ void ph_moe_gemm2(const Args& A, int l, LAS unsigned char* lds, int bid, int nb) {
    unsigned char* ws = opq(A.ws); const float* const* IN = (const float* const*)(ws + WS_PTRS); (void)IN;
    LAS int* off = (LAS int*)(lds + LDS_TAB); LAS int* cntl = off + 64; LAS int* tile_e = off + 128; LAS int* base = off + 800;
    const int T = moe_layout(A, l, bid, nb, off, cntl, tile_e, base);
    int Kq = DM / 2; asm volatile("" : "+s"(Kq));
    pg8::Gemm g{(const bf16_t*)(ws + WS_ACT), (const bf16_t*)(ws + WS_W2 + (size_t)l * NE * DM * DM), T * 256, DM, Kq, 0x77777777, 0x7d7d7d7d};
    const ListOrder S = build_units(lds, T, 4, nb, bid, tile_e, 4);
    LAS float* btab = (LAS float*)(lds + LDS_ROWTAB);
    { const float* b2 = INP(I_B2) + (size_t)l * NE * DM; const int tid = tid_opaque();
      for (int q = tid; q < S.n * 256; q += NTHREADS) { const int png = S.list[2 * (q >> 8) + 1]; btab[q] = b2[(size_t)(png >> 2) * DM + (png & 3) * 256 + (q & 255)]; }
      __syncthreads(); }
    EpiMoe2 E{ws + WS_YM, btab};
    pg8::gemm_phase<EpiMoe2, ListOrder, true, true, false, true>(lds, g, S, E);
}
__device__ __forceinline__ void ph_moe_combine(const Args& A, int l, int row_lo, bool last, int bid, int nb, bool dry = false) {
    unsigned char* ws = opq(A.ws); const float* const* IN = (const float* const*)(ws + WS_PTRS);
    const int tid = tid_opaque(), lane = tid & 63, wid = tid >> 6;
    float* H = (float*)(ws + WS_H); const float* mod = (const float*)(ws + WS_MOD); const bf16_t* YM = (const bf16_t*)(ws + WS_YM);
    float* Hw = dry ? (float*)(ws + WS_XP) : H;
    const int* rowof = (const int*)(ws + WS_ROWOF); const float* tg = (const float*)(ws + WS_TOKG);
    bf16_t* abf = dry ? (bf16_t*)(ws + WS_XP + (size_t)NTOK * DM * 4) : (bf16_t*)(ws + WS_ABF);
    const int ln = last ? l : l + 1;
    const float* gp = INP(I_N1G) + ln * 1024;
    for (int row = row_lo + bid * NWAVES + wid; row < NTOK; row += nb * NWAVES) {
        const Tok tk = tokinfo(row);
        const float* gate = mod + ((size_t)l * 17 + tk.modrow) * 6144 + 5 * 1024;
        int r[4]; float gk[4];
#pragma unroll
        for (int k = 0; k < 4; ++k) { r[k] = rowof[(size_t)row * 4 + k]; gk[k] = tg[(size_t)row * 4 + k]; }
        const unsigned char* YM8 = (const unsigned char*)YM;
        u32x4 y[4];
#pragma unroll
        for (int k = 0; k < 4; ++k) { y[k] = *(const u32x4*)(YM8 + (size_t)r[k] * DM + lane * 16); gk[k] *= (1.0f / 16.0f); }
        const int col = lane * 16;
        f32x4 hv[4]; float ss = 0.f;
#pragma unroll
        for (int q = 0; q < 4; ++q) {
            f32x4 m = (f32x4){0.f, 0.f, 0.f, 0.f};
#pragma unroll
            for (int k = 0; k < 4; ++k) { const auto lo2 = __builtin_amdgcn_cvt_pk_f32_fp8((int)y[k][q], false), hi2 = __builtin_amdgcn_cvt_pk_f32_fp8((int)y[k][q], true);
                m = m + (f32x4){lo2[0], lo2[1], hi2[0], hi2[1]} * gk[k]; }
            hv[q] = *(const f32x4*)(H + (size_t)row * DM + col + 4 * q) + *(const f32x4*)(gate + col + 4 * q) * m;
            float* dst = (last && !dry) ? as_global(((float* const*)IN)[38]) + (size_t)(row - NCTX) * DM + col + 4 * q : Hw + (size_t)row * DM + col + 4 * q;
            *(f32x4*)dst = hv[q];
            ss += (hv[q].x * hv[q].x + hv[q].y * hv[q].y) + (hv[q].z * hv[q].z + hv[q].w * hv[q].w);
        }
        if (!last) {
            const float rstd = rsqrtf(wave_sum(ss) * (1.0f / DM) + 1e-6f);
            const float* mrow = mod + ((size_t)ln * 17 + tk.modrow) * 6144;
            u32x4 o[2];
#pragma unroll
            for (int q = 0; q < 4; ++q) {
                const f32x4 g = *(const f32x4*)(gp + col + 4 * q), sc = *(const f32x4*)(mrow + 1024 + col + 4 * q), sh = *(const f32x4*)(mrow + col + 4 * q);
                const f32x4 v = (hv[q] * rstd * g) * (sc + 1.0f) + sh;
                o[q >> 1][2 * (q & 1)] = pk2(v.x, v.y); o[q >> 1][2 * (q & 1) + 1] = pk2(v.z, v.w);
            }
            *(u32x4*)(abf + (size_t)row * DM + col) = o[0]; *(u32x4*)(abf + (size_t)row * DM + col + 8) = o[1];
        }
    }
}

__global__ void __launch_bounds__(NTHREADS, 2) fwd_kernel(Args A) {
    extern __shared__ __attribute__((aligned(16))) unsigned char lds_raw[];
    LAS unsigned char* lds = (LAS unsigned char*)lds_raw;
    volatile LAS unsigned* misc = (volatile LAS unsigned*)(lds + LDS_MISC);
    const int tid = threadIdx.x, bid = blockIdx.x, nb = gridDim.x;
    if (tid < 64) misc[tid] = 0u;
    __syncthreads();
    XcdBarrier bar = xcd_barrier_post((unsigned*)(A.ws + WS_CTL) + CW_BAR, misc + 8);
    const int lo = A.ph_lo, hi = A.ph_hi;
    int pc = 0;
#ifndef PHSEL
#define PHSEL -1
#endif
#define SEL(k) (PHSEL < 0 || PHSEL == (k))
#ifndef REPEAT_MASK
#define REPEAT_MASK 0
#endif
#define RUN(k, call) do { if (SEL(k)) { call; if ((REPEAT_MASK >> (k)) & 1) { xcd_barrier(bar); call; } } } while (0)
#define PH_BEGIN if (pc >= lo && pc < hi) {
#define PH_END } if (pc >= lo && pc + 1 < hi) xcd_barrier(bar); ++pc;

    PH_BEGIN RUN(0, ph_prologue(A, lds, bid, nb)); PH_END

    for (int l = 0; l < 4; ++l) {
        const int j = l >> 1;
        const bool ctx_out = (l < 2), ctx_in = (l < 3);
        const int rin = ctx_in ? 0 : NCTX, rout = ctx_out ? 0 : NCTX;
        if (l == 0) { PH_BEGIN RUN(1, ph_norm<false>(A, l, rin, lds, bid, nb)); PH_END }
        if ((l & 1) == 0) {
            PH_BEGIN RUN(2, ph_gemm_win(A, j, rin, lds, bid, nb)); PH_END
            PH_BEGIN RUN(3, ph_rwkv_pre(A, j, rin, bid, nb)); RUN(4, ph_qk(A, j, rin, bid, nb)); PH_END
            PH_BEGIN RUN(19, ph_gemm_lora(A, j, rin, lds, bid, nb)); PH_END
            PH_BEGIN RUN(18, ph_wkv_prep(A, j, lds, bid, nb)); PH_END
            PH_BEGIN RUN(5, ph_wkv_scan(A, lds, bid, nb)); PH_END
            PH_BEGIN RUN(6, ph_attn(A, ctx_out, lds, bid, nb)); PH_END
            PH_BEGIN RUN(7, ph_merge(A, l, rout, bid, nb)); PH_END
            PH_BEGIN RUN(8, ph_gemm_out(A, l, WS_CAT, WS_WOUT + (size_t)j * DM * DM * 2, rout, lds, bid, nb)); PH_END
        } else {
            PH_BEGIN RUN(9, ph_gemm_sgin(A, j, rin, lds, bid, nb)); PH_END
            PH_BEGIN RUN(10, ph_sgu_stats(A, rin, bid, nb)); PH_END
            PH_BEGIN RUN(11, ph_sgu_spatial(A, j, rout, lds, bid, nb)); PH_END
            PH_BEGIN RUN(12, ph_gemm_out(A, l, WS_G, WS_SGOUT + (size_t)j * DM * DM * 2, rout, lds, bid, nb)); PH_END
        }
        PH_BEGIN RUN(13, ph_norm2_router(A, l, rout, lds, bid, nb)); PH_END
        PH_BEGIN RUN(14, ph_moe_scatter(A, l, rout, lds, bid, nb)); PH_END
        PH_BEGIN RUN(15, ph_moe_gemm1(A, l, lds, bid, nb)); PH_END
        PH_BEGIN RUN(16, ph_moe_gemm2(A, l, lds, bid, nb)); PH_END
        PH_BEGIN if (SEL(17)) { if ((REPEAT_MASK >> 17) & 1) { ph_moe_combine(A, l, rout, l == 3, bid, nb, true); xcd_barrier(bar); } ph_moe_combine(A, l, rout, l == 3, bid, nb); } PH_END
    }
}

extern "C" void kernel_launch(void* const* d_in, const int* in_sizes, int n_in, void* d_out, int out_size, void* d_ws, size_t ws_size, hipStream_t stream) {
    static int grid = 0;
    if (grid == 0) {
        if (n_in != 38 || out_size != NLAT * DM || ws_size < WS_END) { fprintf(stderr, "kernel_launch: unexpected shapes: n_in %d out %d ws %zu (need %zu)\n", n_in, out_size, ws_size, (size_t)WS_END); grid = -1; return; }
        int dev = 0, cus = 0, per_cu = 0;
        if (hipGetDevice(&dev) != hipSuccess || hipDeviceGetAttribute(&cus, hipDeviceAttributeMultiprocessorCount, dev) != hipSuccess) { grid = -1; return; }
        if (hipFuncSetAttribute((const void*)fwd_kernel, hipFuncAttributeMaxDynamicSharedMemorySize, LDS_BYTES) != hipSuccess) { fprintf(stderr, "kernel_launch: hipFuncSetAttribute failed\n"); grid = -1; return; }
        if (hipOccupancyMaxActiveBlocksPerMultiprocessor(&per_cu, (const void*)fwd_kernel, NTHREADS, LDS_BYTES) != hipSuccess || per_cu < 1)
            fprintf(stderr, "kernel_launch: occupancy query reports %d workgroups per CU\n", per_cu);
        (void)hipGetLastError();
        grid = cus;
    }
    if (grid < 0) return;
    if (hipMemsetAsync((char*)d_ws + WS_CTL, 0, CTL_ZERO_BYTES, stream) != hipSuccess) { fprintf(stderr, "kernel_launch: memset failed\n"); return; }
    Args a{};
    for (int i = 0; i < 38; ++i) a.in[i] = (const float*)d_in[i];
    a.out = (float*)d_out; a.ws = (unsigned char*)d_ws; a.ph_lo = 0; a.ph_hi = 1 << 20;
    hipLaunchKernelGGL(fwd_kernel, dim3(grid), dim3(NTHREADS), LDS_BYTES, stream, a);
    const hipError_t le = hipPeekAtLastError();
    if (le != hipSuccess) fprintf(stderr, "kernel_launch: launch failed: %s\n", hipGetErrorName(le));
}
```

```cpp
#include <hip/hip_runtime.h>
#include <cstdio>
#include <cstdint>

#define LAS __attribute__((address_space(3)))
typedef unsigned short bf16_t;
typedef short bf16x8 __attribute__((ext_vector_type(8)));
typedef float f32x4 __attribute__((ext_vector_type(4)));
typedef unsigned u32x4 __attribute__((ext_vector_type(4)));
typedef unsigned u32x2 __attribute__((ext_vector_type(2)));

constexpr int DM = 1024, NB = 16, TL = 2048, TC = 256;
constexpr int NCTX = NB * TC, NLAT = NB * TL, NTOK = NCTX + NLAT;
constexpr int RWC = 1920, EVC = 3456, ZLD = 3584;
constexpr int NE = 32;
constexpr int XPROWS = NTOK * 4 + NE * 256;
constexpr int NTHREADS = 512, NWAVES = 8;

constexpr size_t MiB = 1u << 20;
constexpr size_t al256(size_t x) { return (x + 255) & ~(size_t)255; }
constexpr size_t WS_CTL = 0, CTL_ZERO_BYTES = 1 * MiB - 4096;
constexpr size_t WS_PTRS = 1 * MiB - 4096;
constexpr size_t WS_MOD = 1 * MiB;
constexpr size_t WS_RTWT = al256(WS_MOD + (size_t)4 * 17 * 6144 * 4);
constexpr size_t WS_WIN = al256(WS_RTWT + (size_t)4 * 32 * 1024 * 4);
constexpr size_t WS_WOUT = al256(WS_WIN + (size_t)2 * ZLD * DM * 2);
constexpr size_t WS_SGIN = al256(WS_WOUT + (size_t)2 * DM * DM * 2);
constexpr size_t WS_SGOUT = al256(WS_SGIN + (size_t)2 * 2048 * DM * 2);
constexpr int LORA_N = 2560, LORA_K = 384;
constexpr size_t WS_WLORA = al256(WS_SGOUT + (size_t)2 * DM * DM * 2);
constexpr size_t WS_LBIAS = al256(WS_WLORA + (size_t)2 * LORA_N * LORA_K * 2);
constexpr size_t WS_W1 = al256(WS_LBIAS + (size_t)2 * LORA_N * 4);
constexpr size_t WS_W2 = al256(WS_W1 + (size_t)4 * NE * 2048 * DM * 2);
constexpr size_t WS_H = al256(WS_W2 + (size_t)4 * NE * DM * DM * 2);
constexpr size_t WS_ABF = al256(WS_H + (size_t)NTOK * DM * 4);
constexpr size_t WS_TOKE = al256(WS_ABF + (size_t)NTOK * DM * 2);
constexpr size_t WS_TOKG = al256(WS_TOKE + (size_t)NTOK * 4 * 4);
constexpr size_t WS_ROWOF = al256(WS_TOKG + (size_t)NTOK * 4 * 4);
constexpr size_t WS_TOKR = al256(WS_ROWOF + (size_t)NTOK * 4 * 4);
constexpr size_t WS_BCNT = al256(WS_TOKR + (size_t)NTOK * 4 * 4);
constexpr size_t WS_SRCROW = al256(WS_BCNT + (size_t)4 * 256 * 32 * 4);
constexpr size_t WS_R = al256(WS_SRCROW + (size_t)XPROWS * 4);
constexpr size_t FSZ = (size_t)NTOK * 512 * 4;
constexpr size_t WS_Z = WS_R;
constexpr size_t HSZ = (size_t)NTOK * 512 * 2;
constexpr size_t WS_RB = al256(WS_Z + (size_t)NTOK * ZLD * 2);
constexpr size_t WS_KS = WS_RB + HSZ, WS_VS = WS_KS + HSZ, WS_KKN = WS_VS + HSZ;
constexpr size_t WS_LIN = WS_KKN + HSZ;
constexpr size_t WS_LO = al256(WS_LIN + (size_t)NTOK * 384 * 2);
constexpr size_t WS_AB = WS_LO + 2 * HSZ;
constexpr size_t WS_GB = WS_LO + 4 * HSZ;
constexpr size_t WS_YS = WS_LO + 5 * HSZ;
constexpr size_t WS_QB = WS_YS + 2 * FSZ;
constexpr size_t WS_KB = WS_QB + FSZ / 2;
constexpr size_t WS_VB = WS_KB + FSZ / 2;
constexpr size_t WS_OP = WS_VB + FSZ / 2;
constexpr size_t WS_CAT = WS_OP + 2 * FSZ;
constexpr int WKV_REC = 12288, WKV_NCH = (TC + TL) / 16;
constexpr size_t WS_WKV = al256(WS_CAT + (size_t)NTOK * DM * 2);
constexpr size_t WS_EVEN_END = WS_WKV + (size_t)256 * WKV_NCH * WKV_REC;
constexpr size_t WS_Z2 = WS_R;
constexpr size_t WS_VST = al256(WS_Z2 + (size_t)NTOK * 2048 * 2);
constexpr size_t WS_G = al256(WS_VST + (size_t)NTOK * 2 * 4);
constexpr size_t WS_ODD_END = WS_G + (size_t)NTOK * DM * 2;
constexpr size_t WS_XP = WS_R;
constexpr size_t WS_ACT = al256(WS_XP + (size_t)XPROWS * DM * 2);
constexpr size_t WS_YM = al256(WS_ACT + (size_t)XPROWS * DM * 2);
constexpr size_t WS_MOE_END = WS_YM + (size_t)XPROWS * DM * 2;
constexpr size_t WS_END = (WS_EVEN_END > WS_MOE_END ? (WS_EVEN_END > WS_ODD_END ? WS_EVEN_END : WS_ODD_END) : (WS_MOE_END > WS_ODD_END ? WS_MOE_END : WS_ODD_END));

constexpr int CW_BAR = 4096;
constexpr int CW_CNT = 16384;
constexpr int CW_CUR = 16384 + 256;

constexpr int LDS_BYTES = 163840;
constexpr int LDS_MISC = 160 * 1024 - 256;

__device__ __forceinline__ unsigned f2bf(float f) { unsigned u = __builtin_bit_cast(unsigned, f); return (u + 0x7fffu + ((u >> 16) & 1u)) >> 16; }
typedef float f32x2_t __attribute__((ext_vector_type(2))); typedef __bf16 bf16x2_t __attribute__((ext_vector_type(2)));
__device__ __forceinline__ unsigned pk2(float lo, float hi) { f32x2_t v = {lo, hi}; bf16x2_t b = __builtin_convertvector(v, bf16x2_t); return __builtin_bit_cast(unsigned, b); }
__device__ __forceinline__ unsigned cvtpk_s(float lo, float hi) { f32x2_t v = {lo, hi}; bf16x2_t b = __builtin_convertvector(v, bf16x2_t); return __builtin_bit_cast(unsigned, b); }
__device__ __forceinline__ float bf2f(bf16_t b) { return __builtin_bit_cast(float, (unsigned)b << 16); }
__device__ __forceinline__ float bflo(unsigned p) { return __builtin_bit_cast(float, p << 16); }
__device__ __forceinline__ float bfhi(unsigned p) { return __builtin_bit_cast(float, p & 0xffff0000u); }
__device__ __forceinline__ float wave_sum(float v) {
#pragma unroll
    for (int o = 1; o < 64; o <<= 1) v += __shfl_xor(v, o);
    return v;
}
__device__ __forceinline__ int tid_opaque() { int t = threadIdx.x; asm volatile("" : "+v"(t)); return t; }
#define GAS __attribute__((address_space(1)))
template <class T> __device__ __forceinline__ T* as_global(T* p) { return (T*)(GAS T*)p; }
__device__ __forceinline__ unsigned char* opq(unsigned char* p) { GAS unsigned char* g = (GAS unsigned char*)p; asm volatile("" : "+s"(g)); return (unsigned char*)g; }
__device__ __forceinline__ float rdl(float v, int k) { return __builtin_bit_cast(float, __builtin_amdgcn_readlane(__builtin_bit_cast(int, v), k)); }
__device__ __forceinline__ float sigmoidf_(float x) { return 1.0f / (1.0f + __expf(-x)); }

#define XB_TMO      128
#define XB_XCNT(j)  (256  + 64 * (j))
#define XB_XSUB(j)  (1280 + 64 * (j))
#define XB_XGEN(j)  (2304 + 64 * (j))
#define XB_TOP      3328
#define XB_TOPGEN   3392
#define XCD_BAR_WORDS 3456
#define XB_SPIN_CAP (1u << 22)
__device__ __forceinline__ unsigned xb_ld(unsigned* p)              { return __hip_atomic_load(p, __ATOMIC_RELAXED, __HIP_MEMORY_SCOPE_AGENT); }
__device__ __forceinline__ unsigned xb_add(unsigned* p, unsigned v) { return __hip_atomic_fetch_add(p, v, __ATOMIC_RELAXED, __HIP_MEMORY_SCOPE_AGENT); }
__device__ __forceinline__ unsigned xb_xcc_id() { return (unsigned)__builtin_amdgcn_s_getreg((3 << 11) | 20) & 0xFu; }
#define XB_SPIN(cond, bar) do { unsigned _sp = 0; while (cond) { __builtin_amdgcn_s_sleep(1); \
    if ((++_sp & 255u) == 0u) { if (xb_ld(&(bar)[XB_TMO])) break; if (_sp > XB_SPIN_CAP) { atomicAdd(&(bar)[XB_TMO], 1u); break; } } } } while (0)
struct XcdBarrier { unsigned* bar; unsigned x; volatile LAS unsigned* st; };
__device__ __forceinline__ XcdBarrier xcd_barrier_post(unsigned* bar, volatile LAS unsigned* st) {
    XcdBarrier b; b.bar = bar; b.x = xb_xcc_id(); b.st = st;
    if (threadIdx.x == 0) (void)xb_add(&bar[XB_XCNT(b.x)], 1u);
    return b;
}
__device__ __forceinline__ void xcd_barrier_complete(unsigned* bar, unsigned x, unsigned& nloc, unsigned& nx) {
    const unsigned G = gridDim.x * gridDim.y * gridDim.z;
    unsigned sum, cnt, mine, sp = 0u;
    for (;;) {
        sum = 0u; cnt = 0u; mine = 0u;
#pragma unroll
        for (unsigned j = 0; j < 16; ++j) { const unsigned c = xb_ld(&bar[XB_XCNT(j)]); sum += c; cnt += (c > 0u) ? 1u : 0u; mine = (j == x) ? c : mine; }
        if (sum == G) break;
        __builtin_amdgcn_s_sleep(1);
        if ((++sp & 255u) == 0u) { if (xb_ld(&bar[XB_TMO])) break; if (sp > XB_SPIN_CAP) { atomicAdd(&bar[XB_TMO], 1u); break; } }
    }
    nloc = mine > 0u ? mine : 1u; nx = cnt > 0u ? cnt : 1u;
}
__device__ __forceinline__ void xcd_barrier(const XcdBarrier& b) {
    asm volatile("s_waitcnt vmcnt(0)" ::: "memory");
    __syncthreads();
    if (threadIdx.x == 0) {
        unsigned* bar = b.bar; asm volatile("" : "+s"(bar));
        __builtin_amdgcn_s_waitcnt(0);
        unsigned nloc = b.st[0], nx = b.st[1];
        if (nloc == 0u) { xcd_barrier_complete(bar, b.x, nloc, nx); b.st[0] = nloc; b.st[1] = nx; }
        const unsigned old = xb_add(&bar[XB_XSUB(b.x)], 1u);
        const unsigned gen = old / nloc;
        if (old + 1u == (gen + 1u) * nloc) {
            __builtin_amdgcn_fence(__ATOMIC_RELEASE, "agent");
            asm volatile("s_waitcnt vmcnt(0)" ::: "memory");
            const unsigned og = xb_add(&bar[XB_TOP], 1u);
            const unsigned tg = og / nx;
            if (og + 1u == (tg + 1u) * nx) xb_add(&bar[XB_TOPGEN], 1u);
            else XB_SPIN(xb_ld(&bar[XB_TOPGEN]) == tg, bar);
            __builtin_amdgcn_fence(__ATOMIC_ACQUIRE, "agent");
            xb_add(&bar[XB_XGEN(b.x)], 1u);
            asm volatile("s_waitcnt vmcnt(0)" ::: "memory");
        } else {
            XB_SPIN(xb_ld(&bar[XB_XGEN(b.x)]) == gen, bar);
            __builtin_amdgcn_fence(__ATOMIC_ACQUIRE, "agent");
            asm volatile("s_waitcnt vmcnt(0)" ::: "memory");
        }
    }
    __syncthreads();
}

namespace pg8 {
#define PG8_LAS __attribute__((address_space(3)))
typedef unsigned short bf16_t;
typedef short bf16x8 __attribute__((ext_vector_type(8)));
typedef float f32x4 __attribute__((ext_vector_type(4)));
typedef unsigned u32x4 __attribute__((ext_vector_type(4)));
constexpr int BM = 256, BK = 64, HALF = 128, HTB = HALF * BK * 2  , STAGE_BYTES = 8 * HTB, NXCD = 8, WGM = 8;

__host__ __device__ __forceinline__ int lds_byte(int r, int c) { const int st = (r >> 4) * 2 + (c >> 5), rr = r & 15, cc = c & 31, ob = rr * 64 + cc * 2; return st * 1024 + (ob ^ (((ob >> 9) & 1) << 5)); }
__host__ __device__ __forceinline__ void stage_rc(int b, int& R, int& C) { const int st = b / 1024, sb = b % 1024, swz = sb ^ (((sb >> 9) & 1) << 5); R = (st >> 1) * 16 + swz / 64; C = (st & 1) * 32 + (swz % 64) / 2; }
__host__ __device__ __forceinline__ int perm32(int rho) { const int n = rho >> 4, i = rho & 15; return 8 * (i >> 2) + 4 * n + (i & 3); }

struct Unit { int pm, pn, ui; };
struct Gemm { const bf16_t* A; const bf16_t* Bt; int M, N, K; int sb_w = 0x77777777, sb_a = 0x7f7f7f7f; };

struct StaticOrder {
    int nM, nN, nwg, G, c;
    __host__ __device__ void init(int M, int N, int G_, int c_) { nM = M / BM; nN = N / BM; nwg = nM * nN; G = G_; c = c_; }
    __host__ __device__ bool next(int i, Unit& u) const {
        const long L = (long)i * G + c; if (L >= nwg) return false;
        int wgid = (int)L; { const int q = nwg / NXCD, r = nwg % NXCD, xcd = wgid % NXCD, off = wgid / NXCD; wgid = (xcd < r ? xcd * (q + 1) : r * (q + 1) + (xcd - r) * q) + off; }
        const int nig = WGM * nN, gid = wgid / nig, fm = gid * WGM, gsz = (nM - fm) < WGM ? (nM - fm) : WGM;
        u.pm = fm + ((wgid % nig) % gsz); u.pn = (wgid % nig) / gsz; return true;
    }
    __device__ __forceinline__ void a_ready(const Unit&) const {}
    __device__ __forceinline__ void done(const Unit&) const {}
};

__device__ __forceinline__ unsigned cvt_pk_bf16(float lo, float hi) { unsigned r; asm volatile("v_cvt_pk_bf16_f32 %0, %1, %2" : "=v"(r) : "v"(lo), "v"(hi)); return r; }
typedef float f32x2 __attribute__((ext_vector_type(2)));
__device__ __forceinline__ f32x2 gelu_pk(f32x2 v) {
    const f32x2 av = __builtin_elementwise_abs(v), d = av * 0.2316418882f + 1.0f;
    f32x2 t; t.x = __builtin_amdgcn_rcpf(d.x); t.y = __builtin_amdgcn_rcpf(d.y);
    f32x2 q = t * 0.5307027145f + (-0.7265760135f); q = q * t + 0.7107068705f; q = q * t + (-0.142248368f); q = q * t + 0.127414796f; q = q * t;
    const f32x2 s = (v * v) * (-0.72134752044f);
    f32x2 e; e.x = __builtin_amdgcn_exp2f(s.x); e.y = __builtin_amdgcn_exp2f(s.y);
    const f32x2 m = v * (q * e), r = v - m;
    f32x2 o; o.x = v.x < 0.f ? m.x : r.x; o.y = v.y < 0.f ? m.y : r.y; return o;
}

typedef int v8i32 __attribute__((ext_vector_type(8)));
typedef int v4i32 __attribute__((ext_vector_type(4)));
__device__ __forceinline__ v8i32 cat8(v4i32 a, v4i32 b) { return __builtin_shufflevector(a, b, 0, 1, 2, 3, 4, 5, 6, 7); }
template <class E> constexpr auto pg8_wide(int) -> decltype(E::WIDE) { return E::WIDE; }
template <class E> constexpr bool pg8_wide(long) { return false; }
template <class Epi, class Sched, bool ALIGN_EPI = false, bool SP2 = false, bool GATHER = false, bool FP8 = false, bool ABLK = false>
__device__ __forceinline__ void gemm_phase(PG8_LAS unsigned char* lds, const Gemm g, const Sched& S, const Epi& E) {
    const int tid = tid_opaque(), wid = __builtin_amdgcn_readfirstlane(tid >> 6), lane = tid & 63, wr = wid >> 2, wc = wid & 3, fr = lane & 15, fq = lane >> 4;
    static_assert(!GATHER || SP2, "GATHER is wired into the SP2 loop only");
    const int K = g.K, nt = K / BK;
    unsigned voffA[2], voffB[2];
#pragma unroll
    for (int i = 0; i < 2; ++i) { int R, C; stage_rc(tid * 16 + i * 8192, R, C); const int Pw = perm32(R & 31);
        const int Rb = pg8_wide<Epi>(0) ? ((R >> 5) * 64 + (Pw >> 3) * 16 + (Pw & 7)) : Epi::PERM ? ((R & ~31) + Pw) : R;
        voffA[i] = ABLK ? (unsigned)(((C * 2) >> 5) * 8192 + R * 32 + ((C * 2) & 31)) : (unsigned)(R * K + C) * 2u; voffB[i] = (unsigned)(Rb * K + C) * 2u; }
    unsigned gAc[2][2] = {{0u, 0u}, {0u, 0u}}, gAn[2][2] = {{0u, 0u}, {0u, 0u}};
    int gR[2] = {0, 0}; unsigned gC[2] = {0u, 0u};
    if constexpr (GATHER) {
#pragma unroll
        for (int i = 0; i < 2; ++i) { int R, C; stage_rc(tid * 16 + i * 8192, R, C); gR[i] = R; gC[i] = (unsigned)C * 2u; }
    }
#define PG8_GROWS(dst, ui_) do { _Pragma("unroll") for (int _h = 0; _h < 2; ++_h) _Pragma("unroll") for (int _i = 0; _i < 2; ++_i) dst[_h][_i] = S.rowtab[(ui_) * 256 + _h * 128 + gR[_i]] + gC[_i]; } while (0)
    const size_t kstep = (size_t)(BK * 2);
    const size_t hstep = (size_t)HALF * K * 2;
    const size_t hstepB = pg8_wide<Epi>(0) ? (size_t)8 * K * 2 : hstep;
    const size_t kstepA = ABLK ? (size_t)32768 : kstep, hstepA = ABLK ? (size_t)4096 : hstep;
    const size_t tstep = 2 * hstep;
    const unsigned ldsw = (unsigned)wid * 1024u;
    const int aoff = lds_byte(wr * 64 + fr, fq * 8), boff = lds_byte(wc * 32 + fr, fq * 8);
#define PG8_SA(b, h) (((b) * 2 + (h)) * HTB)
#define PG8_SB(b, h) ((4 + (b) * 2 + (h)) * HTB)
#define PG8_STAGE(bufoff, gbase, voff) do { _Pragma("unroll") for (int _i = 0; _i < 2; ++_i) \
        __builtin_amdgcn_global_load_lds((const unsigned*)((const char*)(gbase) + (voff)[_i]), (PG8_LAS unsigned*)(lds + (bufoff) + ldsw + _i * 8192), 16, 0, 0); } while (0)
#define PG8_STAGE_A(bufoff, kptr, h, vsel) do { if constexpr (GATHER) { PG8_STAGE(bufoff, kptr, vsel[h]); } else { PG8_STAGE(bufoff, (kptr) + (h) * hstepA, voffA); } } while (0)
#define PG8_LDA(dst, b, h) do { if constexpr (FP8) { _Pragma("unroll") for (int m = 0; m < 4; ++m) dst##8[m] = cat8(*(const PG8_LAS v4i32*)(lds + PG8_SA(b, h) + aoff + m * 2048), *(const PG8_LAS v4i32*)(lds + PG8_SA(b, h) + aoff + m * 2048 + 1024)); } \
        else { _Pragma("unroll") for (int m = 0; m < 4; ++m) _Pragma("unroll") for (int k = 0; k < 2; ++k) dst[m][k] = *(const PG8_LAS bf16x8*)(lds + PG8_SA(b, h) + aoff + m * 2048 + k * 1024); } } while (0)
#define PG8_LDB(dst, b, h) do { if constexpr (FP8) { _Pragma("unroll") for (int n = 0; n < 2; ++n) dst##8[n] = cat8(*(const PG8_LAS v4i32*)(lds + PG8_SB(b, h) + boff + n * 2048), *(const PG8_LAS v4i32*)(lds + PG8_SB(b, h) + boff + n * 2048 + 1024)); } \
        else { _Pragma("unroll") for (int n = 0; n < 2; ++n) _Pragma("unroll") for (int k = 0; k < 2; ++k) dst[n][k] = *(const PG8_LAS bf16x8*)(lds + PG8_SB(b, h) + boff + n * 2048 + k * 1024); } } while (0)
#define PG8_MMA(ai, bj, At, Bt) do { __builtin_amdgcn_s_setprio(1); if constexpr (FP8) { _Pragma("unroll") for (int m = 0; m < 4; ++m) _Pragma("unroll") for (int n = 0; n < 2; ++n) \
        asm volatile("s_nop 1\n\tv_mfma_scale_f32_16x16x128_f8f6f4 %0, %1, %2, %0, %3, %4 op_sel_hi:[0,0,0]" : "+v"(acc[ai][bj][m][n]) : "v"(Bt##8[n]), "v"(At##8[m]), "v"(fp8_sa), "v"(fp8_sb)); } else { \
        _Pragma("unroll") for (int m = 0; m < 4; ++m) _Pragma("unroll") for (int n = 0; n < 2; ++n) _Pragma("unroll") for (int k = 0; k < 2; ++k) \
        acc[ai][bj][m][n] = __builtin_amdgcn_mfma_f32_16x16x32_bf16(Bt[n][k], At[m][k], acc[ai][bj][m][n], 0, 0, 0); } __builtin_amdgcn_s_setprio(0); } while (0)
#define PG8_WAIT_V(n) asm volatile("s_waitcnt vmcnt(" #n ")" ::: "memory")
#define PG8_WAIT_L(n) asm volatile("s_waitcnt lgkmcnt(" #n ")" ::: "memory")
#define PG8_BAR __builtin_amdgcn_s_barrier()
#define PG8_SCHED __builtin_amdgcn_sched_barrier(0)
    Unit cur, nxt; int ui = 0;
    if (!S.next(0, cur)) return;
    f32x4 acc[2][2][4][2];
#pragma unroll
    for (int a = 0; a < 2; ++a)
#pragma unroll
        for (int b = 0; b < 2; ++b)
#pragma unroll
            for (int m = 0; m < 4; ++m)
#pragma unroll
                for (int n = 0; n < 2; ++n) acc[a][b][m][n] = (f32x4){0.f, 0.f, 0.f, 0.f};
    const int fp8_sa = g.sb_w, fp8_sb = g.sb_a;
    bf16x8 At[4][2], B0[2][2], B1[2][2]; v8i32 At8[4], B08[2], B18[2];
    const char* cA = GATHER ? (const char*)g.A : (const char*)g.A + (size_t)cur.pm * tstep; const char* cB = (const char*)g.Bt + (size_t)cur.pn * tstep;
    if constexpr (GATHER) { PG8_GROWS(gAc, 0); }
    S.a_ready(cur);
    if constexpr (SP2) {
        PG8_STAGE(PG8_SB(0, 0), cB, voffB); PG8_STAGE(PG8_SB(0, 1), cB + hstepB, voffB); PG8_STAGE_A(PG8_SA(0, 0), cA, 0, gAc); PG8_STAGE_A(PG8_SA(0, 1), cA, 1, gAc);
        if (wr == 1) PG8_BAR;
        PG8_WAIT_V(2); PG8_BAR;
        PG8_STAGE(PG8_SB(1, 0), cB + kstep, voffB); PG8_STAGE_A(PG8_SA(1, 0), cA + kstepA, 0, gAc); PG8_STAGE(PG8_SB(1, 1), cB + hstepB + kstep, voffB);
        PG8_WAIT_V(6); PG8_BAR;
    } else {
        PG8_STAGE(PG8_SB(0, 0), cB, voffB); PG8_STAGE(PG8_SA(0, 0), cA, voffA); PG8_STAGE(PG8_SB(0, 1), cB + hstepB, voffB); PG8_STAGE(PG8_SA(0, 1), cA + hstep, voffA);
        if (wr == 1) PG8_BAR;
        PG8_WAIT_V(4); PG8_BAR;
        PG8_STAGE(PG8_SB(1, 0), cB + kstep, voffB); PG8_STAGE(PG8_SA(1, 0), cA + kstep, voffA); PG8_STAGE(PG8_SB(1, 1), cB + hstepB + kstep, voffB);
        PG8_WAIT_V(6); PG8_BAR;
    }
    for (;;) {
        const bool has_next = S.next(ui + 1, nxt);
        if constexpr (GATHER) { if (has_next) { PG8_GROWS(gAn, ui + 1); } else { _Pragma("unroll") for (int _h = 0; _h < 2; ++_h) _Pragma("unroll") for (int _i = 0; _i < 2; ++_i) gAn[_h][_i] = gAc[_h][_i]; } }
        const char* nA = GATHER ? (const char*)g.A : (has_next ? (const char*)g.A + (size_t)nxt.pm * tstep : cA); const char* nB = has_next ? (const char*)g.Bt + (size_t)nxt.pn * tstep : cB;
        for (int t = 0; t < nt; t += 2) {
            const bool last = (t == nt - 2);
            const char* a1 = cA + (size_t)(t + 1) * kstepA;
            const char* a2 = last ? nA : cA + (size_t)(t + 2) * kstepA; const char* b2 = last ? nB : cB + (size_t)(t + 2) * kstep;
            const char* a3 = a2 + kstepA; const char* b3 = b2 + kstep;
            if (last && has_next) S.a_ready(nxt);
            unsigned gA2[2][2];
            if constexpr (GATHER) { _Pragma("unroll") for (int _h = 0; _h < 2; ++_h) _Pragma("unroll") for (int _i = 0; _i < 2; ++_i) gA2[_h][_i] = last ? gAn[_h][_i] : gAc[_h][_i]; }
            if constexpr (SP2) {
            PG8_LDB(B0, 0, 0); PG8_LDB(B1, 0, 1); PG8_SCHED; PG8_LDA(At, 0, 0); PG8_STAGE_A(PG8_SA(1, 1), a1, 1, gAc);
            PG8_WAIT_V(8); PG8_WAIT_L(0); PG8_BAR; PG8_MMA(0, 0, At, B0); PG8_MMA(0, 1, At, B1); PG8_BAR; PG8_SCHED;
            PG8_LDA(At, 0, 1); PG8_STAGE(PG8_SB(0, 0), b2, voffB); PG8_STAGE(PG8_SB(0, 1), b2 + hstepB, voffB); PG8_STAGE_A(PG8_SA(0, 0), a2, 0, gA2);
            PG8_WAIT_V(8); PG8_WAIT_L(0); PG8_BAR; PG8_MMA(1, 0, At, B0); PG8_MMA(1, 1, At, B1); PG8_BAR; PG8_SCHED;
            PG8_LDB(B0, 1, 0); PG8_LDB(B1, 1, 1); PG8_SCHED; PG8_LDA(At, 1, 0); PG8_STAGE_A(PG8_SA(0, 1), a2, 1, gA2);
            PG8_WAIT_V(8); PG8_WAIT_L(0); PG8_BAR; PG8_MMA(0, 0, At, B0); PG8_MMA(0, 1, At, B1); PG8_BAR; PG8_SCHED;
            PG8_LDA(At, 1, 1); PG8_STAGE(PG8_SB(1, 0), b3, voffB); PG8_STAGE(PG8_SB(1, 1), b3 + hstepB, voffB); PG8_STAGE_A(PG8_SA(1, 0), a3, 0, gA2);
            PG8_WAIT_V(8); PG8_WAIT_L(0); PG8_BAR; PG8_MMA(1, 0, At, B0); PG8_MMA(1, 1, At, B1); PG8_BAR; PG8_SCHED;
            } else {
            PG8_LDB(B0, 0, 0); PG8_SCHED; PG8_LDA(At, 0, 0); PG8_STAGE(PG8_SA(1, 1), a1 + hstep, voffA);
            PG8_WAIT_L(8); PG8_BAR; PG8_WAIT_L(0); PG8_MMA(0, 0, At, B0); PG8_BAR; PG8_SCHED;
            PG8_LDB(B1, 0, 1); PG8_STAGE(PG8_SB(0, 0), b2, voffB);
            PG8_BAR; PG8_WAIT_L(0); PG8_MMA(0, 1, At, B1); PG8_BAR;
            PG8_LDA(At, 0, 1); PG8_STAGE(PG8_SA(0, 0), a2, voffA);
            PG8_BAR; PG8_WAIT_L(0); PG8_MMA(1, 0, At, B0); PG8_BAR; PG8_SCHED;
            PG8_STAGE(PG8_SB(0, 1), b2 + hstepB, voffB);
            PG8_WAIT_V(6); PG8_BAR; PG8_MMA(1, 1, At, B1); PG8_BAR;
            PG8_LDB(B0, 1, 0); PG8_SCHED; PG8_LDA(At, 1, 0); PG8_STAGE(PG8_SA(0, 1), a2 + hstep, voffA);
            PG8_WAIT_L(8); PG8_BAR; PG8_WAIT_L(0); PG8_MMA(0, 0, At, B0); PG8_BAR; PG8_SCHED;
            PG8_LDB(B1, 1, 1); PG8_STAGE(PG8_SB(1, 0), b3, voffB);
            PG8_BAR; PG8_WAIT_L(0); PG8_MMA(0, 1, At, B1); PG8_BAR;
            PG8_LDA(At, 1, 1); PG8_STAGE(PG8_SA(1, 0), a3, voffA);
            PG8_BAR; PG8_WAIT_L(0); PG8_MMA(1, 0, At, B0); PG8_BAR; PG8_SCHED;
            PG8_STAGE(PG8_SB(1, 1), b3 + hstepB, voffB);
            PG8_WAIT_V(6); PG8_BAR; PG8_MMA(1, 1, At, B1); PG8_BAR;
            }
        }
        if constexpr (ALIGN_EPI) { if (wr == 0) PG8_BAR; }
        if constexpr (FP8) { asm volatile("s_nop 15\n\ts_nop 15" ::: "memory"); __builtin_amdgcn_sched_barrier(0); }
        if constexpr (!Epi::AFTER_DRAIN) { E(acc, cur, wr, wc, fr, fq); S.done(cur); }
        if (!has_next) break;
#pragma unroll
        for (int a = 0; a < 2; ++a)
#pragma unroll
            for (int b = 0; b < 2; ++b)
#pragma unroll
                for (int m = 0; m < 4; ++m)
#pragma unroll
                    for (int n = 0; n < 2; ++n) acc[a][b][m][n] = (f32x4){0.f, 0.f, 0.f, 0.f};
        cur = nxt; cA = nA; cB = nB; ++ui;
        if constexpr (GATHER) { _Pragma("unroll") for (int _h = 0; _h < 2; ++_h) _Pragma("unroll") for (int _i = 0; _i < 2; ++_i) gAc[_h][_i] = gAn[_h][_i]; }
        if constexpr (ALIGN_EPI) { if (wr == 1) PG8_BAR; }
    }
    PG8_WAIT_V(0);
    if constexpr (!ALIGN_EPI) { if (wr == 0) PG8_BAR; }
    PG8_BAR;
    if constexpr (Epi::AFTER_DRAIN) { E.fused(acc, cur, wr, wc, fr, fq, lds, wid, lane); S.done(cur); }
#undef PG8_SA
#undef PG8_SB
#undef PG8_STAGE
#undef PG8_STAGE_A
#undef PG8_GROWS
#undef PG8_LDA
#undef PG8_LDB
#undef PG8_MMA
#undef PG8_WAIT_V
#undef PG8_WAIT_L
#undef PG8_BAR
#undef PG8_SCHED
}
}

struct Args { const float* in[38]; float* out; unsigned char* ws; int ph_lo, ph_hi; };
#define INP(k) as_global(IN[k])
#define AIN(k) as_global(A.in[k])
enum { I_X = 0, I_C, I_CTX, I_CCTX, I_N1G, I_N2G, I_ADAW, I_ADAB, I_EVWIN, I_EVWOUT, I_RWMU, I_RWW0, I_RWW2, I_RWA0, I_RWA2, I_RWG2, I_RWKK, I_RWKA, I_RWRK,
       I_GNW, I_GNB, I_QN, I_KN, I_LAM, I_SUBLN, I_SGWIN, I_SGBIN, I_SGLNG, I_SGLNB, I_SGWS, I_SGBS, I_SGWOUT, I_RTW, I_RTB, I_W1, I_B1, I_W2, I_B2 };

struct Tok { int b, t, T, modrow; };
__device__ __forceinline__ Tok tokinfo(int g) {
    Tok k;
    if (g < NCTX) { k.b = g >> 8; k.t = g & 255; k.T = TC; k.modrow = 16; }
    else { const int q = g - NCTX; k.b = q >> 11; k.t = q & 2047; k.T = TL; k.modrow = k.b; }
    return k;
}

template <int MAP>
__device__ __forceinline__ void p0_transpose_item(const float* W, int K, int N, bf16_t* WT, LAS float* scr, int item, int lane) {
    const int nblk = N / 32, kb = item / nblk, nb = item % nblk, k0 = 64 * kb, n0 = 32 * nb;
    const int d0 = MAP ? (256 * ((n0 & 1023) >> 7) + 128 * (n0 >> 10) + (n0 & 127)) : n0;
#pragma unroll 8
    for (int i = 0; i < 32; ++i) { const int kk = 2 * i + (lane >> 5); scr[kk * 33 + (lane & 31)] = W[(size_t)(k0 + kk) * N + n0 + (lane & 31)]; }
    asm volatile("s_waitcnt lgkmcnt(0)" ::: "memory");
    const int c = lane & 7;
#pragma unroll
    for (int j = 0; j < 4; ++j) { const int n = (lane >> 3) + 8 * j; const LAS float* s = scr + (8 * c) * 33 + n;
        u32x4 o; o.x = pk2(s[0 * 33], s[1 * 33]); o.y = pk2(s[2 * 33], s[3 * 33]); o.z = pk2(s[4 * 33], s[5 * 33]); o.w = pk2(s[6 * 33], s[7 * 33]);
        *(u32x4*)(WT + (size_t)(d0 + n) * K + k0 + 8 * c) = o; }
    asm volatile("s_waitcnt lgkmcnt(0)" ::: "memory");
}

template <int MAP>
__device__ __forceinline__ void p0_transpose_item_fp8w(const float* W, int K, int N, unsigned char* WT, LAS float* scr, int item, int lane) {
    const int nblk = N / 32, kb = item / nblk, nb = item % nblk, k0 = 128 * kb, n0 = 32 * nb;
    const int d0 = MAP ? (256 * ((n0 & 1023) >> 7) + 128 * (n0 >> 10) + (n0 & 127)) : n0;
    {
        f32x4 ld[16];
#pragma unroll
        for (int i = 0; i < 16; ++i) ld[i] = *(const f32x4*)(W + (size_t)(k0 + 8 * i + (lane >> 3)) * N + n0 + 4 * (lane & 7));
#pragma unroll
        for (int i = 0; i < 16; ++i) { LAS float* d = scr + (8 * i + (lane >> 3)) * 33 + 4 * (lane & 7); d[0] = ld[i].x; d[1] = ld[i].y; d[2] = ld[i].z; d[3] = ld[i].w; }
    }
    asm volatile("s_waitcnt lgkmcnt(0)" ::: "memory");
    const int c = lane & 7;
#pragma unroll
    for (int j = 0; j < 4; ++j) { const int n = (lane >> 3) + 8 * j; const LAS float* sp = scr + (16 * c) * 33 + n;
        u32x4 o;
#pragma unroll
        for (int d = 0; d < 4; ++d) { int w = __builtin_amdgcn_cvt_pk_fp8_f32(sp[(4 * d) * 33] * 256.0f, sp[(4 * d + 1) * 33] * 256.0f, 0, false);
            w = __builtin_amdgcn_cvt_pk_fp8_f32(sp[(4 * d + 2) * 33] * 256.0f, sp[(4 * d + 3) * 33] * 256.0f, w, true); o[d] = (unsigned)w; }
        *(u32x4*)(WT + (size_t)(d0 + n) * K + k0 + 16 * c) = o; }
    asm volatile("s_waitcnt lgkmcnt(0)" ::: "memory");
}

__device__ __forceinline__ void ph_prologue(const Args& A, LAS unsigned char* lds, int bid, int nb) {
    const int tid = tid_opaque(), lane = tid & 63, wid = tid >> 6;
    unsigned char* ws = opq(A.ws);
    if (bid == 0 && tid < 39) ((const float**)(ws + WS_PTRS))[tid] = (tid < 38) ? A.in[tid] : (const float*)A.out;
    {
        LAS float* s = (LAS float*)lds;
        LAS float* red = (LAS float*)(lds + 17 * 1024 * 4);
        for (int i = tid; i < 17 * 1024; i += NTHREADS) {
            const int r = i >> 10, k = i & 1023;
            const float x = (r < 16) ? AIN(I_C)[r * 1024 + k] : AIN(I_CCTX)[k];
            s[i] = x / (1.0f + __expf(-x));
        }
        __syncthreads();
        float* mod = (float*)(ws + WS_MOD);
        for (int u = bid; u < 4 * 96; u += nb) {
            const int l = u / 96, cg = u % 96, col = cg * 64 + lane;
            float acc[17];
#pragma unroll
            for (int r = 0; r < 17; ++r) acc[r] = 0.f;
            const float* wp = AIN(I_ADAW) + (size_t)l * 1024 * 6144 + col;
            for (int k = wid * 128; k < wid * 128 + 128; ++k) {
                const float wv = wp[(size_t)k * 6144];
#pragma unroll
                for (int r = 0; r < 17; ++r) acc[r] += s[r * 1024 + k] * wv;
            }
#pragma unroll
            for (int r = 0; r < 17; ++r) red[(wid * 17 + r) * 64 + lane] = acc[r];
            __syncthreads();
            for (int i = tid; i < 17 * 64; i += NTHREADS) {
                const int r = i >> 6, ln = i & 63; float v = 0.f;
#pragma unroll
                for (int w = 0; w < 8; ++w) v += red[(w * 17 + r) * 64 + ln];
                const int cc = cg * 64 + ln;
                mod[((size_t)l * 17 + r) * 6144 + cc] = v + AIN(I_ADAB)[l * 6144 + cc];
            }
            __syncthreads();
        }
    }
    __syncthreads();
    {
        LAS float* scr = (LAS float*)(lds + wid * 17408);
        const int gw = bid * NWAVES + wid, NGW = nb * NWAVES;
        constexpr int IT_WIN = 16 * (EVC / 32), IT_SQ = 16 * 32, IT_SGIN = 16 * 64, IT_W1 = 8 * 64, IT_W2 = 8 * 32;
        constexpr int N0 = 2 * IT_WIN, N1 = N0 + 2 * IT_SQ, N2 = N1 + 2 * IT_SGIN, N3 = N2 + 2 * IT_SQ, N4 = N3 + 128 * IT_W1, N5 = N4 + 128 * IT_W2;
        for (int it = gw; it < N5; it += NGW) {
            if (it < N0) { const int m = it / IT_WIN, r = it % IT_WIN; p0_transpose_item<0>(AIN(I_EVWIN) + (size_t)m * DM * EVC, DM, EVC, (bf16_t*)(ws + WS_WIN) + (size_t)m * ZLD * DM, scr, r, lane); }
            else if (it < N1) { const int q = it - N0, m = q / IT_SQ, r = q % IT_SQ; p0_transpose_item<0>(AIN(I_EVWOUT) + (size_t)m * DM * DM, DM, DM, (bf16_t*)(ws + WS_WOUT) + (size_t)m * DM * DM, scr, r, lane); }
            else if (it < N2) { const int q = it - N1, m = q / IT_SGIN, r = q % IT_SGIN; p0_transpose_item<0>(AIN(I_SGWIN) + (size_t)m * DM * 2048, DM, 2048, (bf16_t*)(ws + WS_SGIN) + (size_t)m * 2048 * DM, scr, r, lane); }
            else if (it < N3) { const int q = it - N2, m = q / IT_SQ, r = q % IT_SQ; p0_transpose_item<0>(AIN(I_SGWOUT) + (size_t)m * DM * DM, DM, DM, (bf16_t*)(ws + WS_SGOUT) + (size_t)m * DM * DM, scr, r, lane); }
            else if (it < N4) { const int q = it - N3, m = q / IT_W1, r = q % IT_W1; p0_transpose_item_fp8w<1>(AIN(I_W1) + (size_t)m * DM * 2048, DM, 2048, ws + WS_W1 + (size_t)m * 2048 * DM, scr, r, lane); }
            else { const int q = it - N4, m = q / IT_W2, r = q % IT_W2; p0_transpose_item_fp8w<0>(AIN(I_W2) + (size_t)m * DM * DM, DM, DM, ws + WS_W2 + (size_t)m * DM * DM, scr, r, lane); }
        }
    }
    {
        const size_t gt = (size_t)bid * NTHREADS + tid, GT = (size_t)nb * NTHREADS;
        u32x4* H8 = (u32x4*)(ws + WS_H);
        const f32x4* c4 = (const f32x4*)AIN(I_CTX); const f32x4* x4 = (const f32x4*)AIN(I_X);
        constexpr size_t NC8 = (size_t)NCTX * DM / 8, NT8 = (size_t)NTOK * DM / 8;
        for (size_t i = gt; i < NT8; i += GT) { const f32x4* s = (i < NC8) ? c4 + 2 * i : x4 + 2 * (i - NC8); const f32x4 a = s[0], b = s[1];
            H8[i] = (u32x4){pk2(a.x, a.y), pk2(a.z, a.w), pk2(b.x, b.y), pk2(b.z, b.w)}; }
        for (size_t i = gt; i < (size_t)2 * 128 * DM / 8; i += GT) { const size_t m = i / (128 * DM / 8), r = i % (128 * DM / 8); ((u32x4*)((bf16_t*)(ws + WS_WIN) + (m * ZLD + EVC) * DM))[r] = (u32x4){0u, 0u, 0u, 0u}; }
        bf16_t* wl = (bf16_t*)(ws + WS_WLORA);
        for (size_t i = gt; i < (size_t)2 * LORA_N * (LORA_K / 8); i += GT) {
            const int n = (int)(i % LORA_N), kc = (int)((i / LORA_N) % (LORA_K / 8)), jj = (int)(i / ((size_t)LORA_N * (LORA_K / 8))), seg = n >> 9, c = n & 511, k0 = kc * 8;
            float v[8];
#pragma unroll
            for (int e = 0; e < 8; ++e) v[e] = 0.f;
            if (seg < 2) { if ((k0 >> 6) == seg) {
#pragma unroll
                for (int e = 0; e < 8; ++e) v[e] = AIN(I_RWW2)[(((size_t)jj * 2 + seg) * 64 + (k0 & 63) + e) * 512 + c]; } }
            else if (seg < 4) { if ((k0 >> 6) == seg) {
#pragma unroll
                for (int e = 0; e < 8; ++e) v[e] = AIN(I_RWA2)[(((size_t)jj * 2 + (seg - 2)) * 64 + (k0 & 63) + e) * 512 + c]; } }
            else if (k0 >= 256) {
#pragma unroll
                for (int e = 0; e < 8; ++e) v[e] = AIN(I_RWG2)[((size_t)jj * 128 + (k0 - 256) + e) * 512 + c]; }
            *(u32x4*)(wl + ((size_t)jj * LORA_N + n) * LORA_K + k0) = (u32x4){pk2(v[0], v[1]), pk2(v[2], v[3]), pk2(v[4], v[5]), pk2(v[6], v[7])};
        }
        for (size_t i = gt; i < (size_t)2 * LORA_N; i += GT) { const int jj = (int)(i / LORA_N), n = (int)(i % LORA_N), seg = n >> 9, c = n & 511;
            ((float*)(ws + WS_LBIAS))[i] = seg < 2 ? AIN(I_RWW0)[((size_t)jj * 2 + seg) * 512 + c] : (seg < 4 ? AIN(I_RWA0)[((size_t)jj * 2 + (seg - 2)) * 512 + c] : 0.f); }
        float* rt = (float*)(ws + WS_RTWT);
        for (size_t i = gt; i < (size_t)4 * 128 * 32; i += GT) {
            const int e = (int)i & 31, k0 = ((int)(i >> 5) & 127) * 8, l = (int)(i >> 12);
            unsigned hi[4], lo[4]; float w[8];
#pragma unroll
            for (int q = 0; q < 8; ++q) w[q] = AIN(I_RTW)[((size_t)l * 1024 + k0 + q) * 32 + e];
#pragma unroll
            for (int q = 0; q < 4; ++q) { hi[q] = pk2(w[2 * q], w[2 * q + 1]); lo[q] = pk2(w[2 * q] - __builtin_bit_cast(float, hi[q] << 16), w[2 * q + 1] - __builtin_bit_cast(float, hi[q] & 0xffff0000u)); }
            *(u32x4*)((bf16_t*)rt + ((size_t)l * 2 * 32 + e) * 1024 + k0) = (u32x4){hi[0], hi[1], hi[2], hi[3]};
            *(u32x4*)((bf16_t*)rt + ((size_t)(l * 2 + 1) * 32 + e) * 1024 + k0) = (u32x4){lo[0], lo[1], lo[2], lo[3]};
        }
    }
}

template <bool ROUTER>
__device__ __forceinline__ void ph_norm(const Args& A, int l, int row_lo, LAS unsigned char* lds, int bid, int nb) {
    unsigned char* ws = opq(A.ws); const float* const* IN = (const float* const*)(ws + WS_PTRS); (void)IN;
    const int tid = tid_opaque(), lane = tid & 63, wid = tid >> 6;
    const bf16_t* H = (const bf16_t*)(ws + WS_H);
    const float* mod = (const float*)(ws + WS_MOD);
    bf16_t* abf = (bf16_t*)(ws + WS_ABF);
    const float* gp = INP(ROUTER ? I_N2G : I_N1G) + l * 1024;
    const int c_shift = ROUTER ? 3 : 0, c_scale = ROUTER ? 4 : 1;
    LAS float* rtl = (LAS float*)lds;
    LAS int* hist = (LAS int*)(lds + 131072);
    float rtb = 0.f;
    if constexpr (ROUTER) {
        const f32x4* rt4 = (const f32x4*)((const float*)(ws + WS_RTWT) + (size_t)l * 32 * 1024);
        for (int i = tid; i < 32 * 1024 / 4; i += NTHREADS) ((LAS f32x4*)rtl)[i] = rt4[i];
        if (tid < 32) hist[tid] = 0;
        rtb = INP(I_RTB)[l * 32 + (lane >> 1)];
        __syncthreads();
    }
    for (int row = row_lo + bid * NWAVES + wid; row < NTOK; row += nb * NWAVES) {
        const Tok tk = tokinfo(row);
        const float* mrow = mod + ((size_t)l * 17 + tk.modrow) * 6144;
        f32x4 v[4]; float ss = 0.f;
#pragma unroll
        for (int j = 0; j < 4; ++j) { const u32x2 hq = *(const u32x2*)(H + (size_t)row * DM + j * 256 + lane * 4); v[j] = (f32x4){bflo(hq.x), bfhi(hq.x), bflo(hq.y), bfhi(hq.y)}; ss += (v[j].x * v[j].x + v[j].y * v[j].y) + (v[j].z * v[j].z + v[j].w * v[j].w); }
        const float rstd = rsqrtf(wave_sum(ss) * (1.0f / DM) + 1e-6f);
#pragma unroll
        for (int j = 0; j < 4; ++j) {
            const int col = j * 256 + lane * 4;
            const f32x4 g = *(const f32x4*)(gp + col), sc = *(const f32x4*)(mrow + c_scale * 1024 + col), sh = *(const f32x4*)(mrow + c_shift * 1024 + col);
            v[j] = (v[j] * rstd * g) * (sc + 1.0f) + sh;
            u32x2 o; o.x = pk2(v[j].x, v[j].y); o.y = pk2(v[j].z, v[j].w);
            *(u32x2*)(abf + (size_t)row * DM + col) = o;
        }
        if constexpr (ROUTER) {
            float p[32];
#pragma unroll
            for (int e = 0; e < 32; ++e) {
                float acc = 0.f;
#pragma unroll
                for (int j = 0; j < 4; ++j) { const f32x4 w = *(const LAS f32x4*)(rtl + e * 1024 + j * 256 + lane * 4); acc += (v[j].x * w.x + v[j].y * w.y) + (v[j].z * w.z + v[j].w * w.w); }
                p[e] = acc;
            }
#define RS_STEP(N, OFF) _Pragma("unroll") for (int i = 0; i < (N); ++i) { const bool up = (lane & (OFF)) != 0; const float send = up ? p[i] : p[i + (N)], keep = up ? p[i + (N)] : p[i]; p[i] = keep + __shfl_xor(send, (OFF)); }
            RS_STEP(16, 32) RS_STEP(8, 16) RS_STEP(4, 8) RS_STEP(2, 4) RS_STEP(1, 2)
#undef RS_STEP
            const float mylg = p[0] + __shfl_xor(p[0], 1) + rtb;
            float tv[4] = {-3.0e38f, -3.0e38f, -3.0e38f, -3.0e38f}; int ti[4] = {0, 0, 0, 0};
#pragma unroll
            for (int e = 0; e < 32; ++e) {
                const float lgv = rdl(mylg, 2 * e);
                if (lgv > tv[3]) {
                    tv[3] = lgv; ti[3] = e;
                    if (tv[3] > tv[2]) { const float a = tv[2]; tv[2] = tv[3]; tv[3] = a; const int b = ti[2]; ti[2] = ti[3]; ti[3] = b; }
                    if (tv[2] > tv[1]) { const float a = tv[1]; tv[1] = tv[2]; tv[2] = a; const int b = ti[1]; ti[1] = ti[2]; ti[2] = b; }
                    if (tv[1] > tv[0]) { const float a = tv[0]; tv[0] = tv[1]; tv[1] = a; const int b = ti[0]; ti[0] = ti[1]; ti[1] = b; }
                }
            }
            const float e1 = __expf(tv[1] - tv[0]), e2 = __expf(tv[2] - tv[0]), e3 = __expf(tv[3] - tv[0]);
            const float inv = 1.0f / (1.0f + e1 + e2 + e3);
            if (lane == 0) {
                int* te = (int*)(ws + WS_TOKE) + (size_t)row * 4; float* tg = (float*)(ws + WS_TOKG) + (size_t)row * 4; int* tr = (int*)(ws + WS_TOKR) + (size_t)row * 4;
                te[0] = ti[0]; te[1] = ti[1]; te[2] = ti[2]; te[3] = ti[3];
                tg[0] = inv; tg[1] = e1 * inv; tg[2] = e2 * inv; tg[3] = e3 * inv;
#pragma unroll
                for (int k = 0; k < 4; ++k) tr[k] = __hip_atomic_fetch_add(hist + ti[k], 1, __ATOMIC_RELAXED, __HIP_MEMORY_SCOPE_WORKGROUP);
            }
        }
    }
    if constexpr (ROUTER) {
        __syncthreads();
        if (tid < 32) ((int*)(ws + WS_BCNT))[((size_t)l * 256 + bid) * 32 + tid] = hist[tid];
    }
}


constexpr int RT_LS = 2064;
__device__ __forceinline__ void ph_norm2_router(const Args& A, int l, int row_lo, LAS unsigned char* lds, int bid, int nb) {
    unsigned char* ws = opq(A.ws); const float* const* IN = (const float* const*)(ws + WS_PTRS);
    const int tid = tid_opaque(), lane = tid & 63, wid = tid >> 6, c16 = lane & 15, g4 = lane >> 4;
    const bf16_t* H = (const bf16_t*)(ws + WS_H); const float* mod = (const float*)(ws + WS_MOD); bf16_t* abf = (bf16_t*)(ws + WS_ABF);
    const float* gp = INP(I_N2G) + l * 1024;
    LAS unsigned char* rth = lds; LAS unsigned char* rtl = lds + 32 * RT_LS;
    LAS int* hist = (LAS int*)(lds + 64 * RT_LS);
    LAS float* lgs = (LAS float*)(lds + 64 * RT_LS + 256) + wid * 544;
    {
        const u32x4* src = (const u32x4*)((const bf16_t*)(ws + WS_RTWT) + (size_t)l * 2 * 32 * 1024);
        for (int i = tid; i < 64 * 128; i += NTHREADS) { const int row = i >> 7, ch = i & 127; *(LAS u32x4*)(lds + row * RT_LS + ch * 16) = src[i]; }
        if (tid < 32) hist[tid] = 0;
        __syncthreads();
    }
    const float rtb0 = INP(I_RTB)[l * 32 + c16], rtb1 = INP(I_RTB)[l * 32 + 16 + c16];
    const int ngroups = (NTOK - row_lo) / 16;
    for (int u = bid * NWAVES + wid; u < ngroups; u += nb * NWAVES) {
        const int row = row_lo + 16 * u + c16;
        const Tok tk = tokinfo(row_lo + 16 * u);
        const float* mrow = mod + ((size_t)l * 17 + tk.modrow) * 6144;
        const bf16_t* hrow = H + (size_t)row * DM + 8 * g4;
        float ss = 0.f;
#pragma unroll 8
        for (int ks = 0; ks < 32; ++ks) { const u32x4 hq = *(const u32x4*)(hrow + 32 * ks); const f32x4 a = {bflo(hq.x), bfhi(hq.x), bflo(hq.y), bfhi(hq.y)}, b = {bflo(hq.z), bfhi(hq.z), bflo(hq.w), bfhi(hq.w)};
            ss += (a.x * a.x + a.y * a.y) + (a.z * a.z + a.w * a.w) + (b.x * b.x + b.y * b.y) + (b.z * b.z + b.w * b.w); }
        ss += __shfl_xor(ss, 16); ss += __shfl_xor(ss, 32);
        const float rstd = rsqrtf(ss * (1.0f / DM) + 1e-6f);
        f32x4 acc0 = {0.f, 0.f, 0.f, 0.f}, acc1 = acc0;
#pragma unroll 2
        for (int ks = 0; ks < 32; ++ks) {
            const int col = 32 * ks + 8 * g4;
            float f[8];
            { const u32x4 hq = *(const u32x4*)(hrow + 32 * ks); const f32x4 xa = {bflo(hq.x), bfhi(hq.x), bflo(hq.y), bfhi(hq.y)}, xb = {bflo(hq.z), bfhi(hq.z), bflo(hq.w), bfhi(hq.w)};
              const f32x4 ga = *(const f32x4*)(gp + col), gb = *(const f32x4*)(gp + col + 4), sa = *(const f32x4*)(mrow + 4 * 1024 + col), sb = *(const f32x4*)(mrow + 4 * 1024 + col + 4);
              const f32x4 ha = *(const f32x4*)(mrow + 3 * 1024 + col), hb = *(const f32x4*)(mrow + 3 * 1024 + col + 4);
              const f32x4 fa = (xa * rstd * ga) * (sa + 1.0f) + ha, fb = (xb * rstd * gb) * (sb + 1.0f) + hb;
              f[0] = fa.x; f[1] = fa.y; f[2] = fa.z; f[3] = fa.w; f[4] = fb.x; f[5] = fb.y; f[6] = fb.z; f[7] = fb.w; }
            unsigned hi[4], lo[4];
#pragma unroll
            for (int e = 0; e < 4; ++e) { hi[e] = pk2(f[2 * e], f[2 * e + 1]);
                lo[e] = pk2(f[2 * e] - __builtin_bit_cast(float, hi[e] << 16), f[2 * e + 1] - __builtin_bit_cast(float, hi[e] & 0xffff0000u)); }
            const u32x4 hv = {hi[0], hi[1], hi[2], hi[3]}, lv = {lo[0], lo[1], lo[2], lo[3]};
            { int w0 = __builtin_amdgcn_cvt_pk_fp8_f32(f[0], f[1], 0, false); w0 = __builtin_amdgcn_cvt_pk_fp8_f32(f[2], f[3], w0, true);
              int w1 = __builtin_amdgcn_cvt_pk_fp8_f32(f[4], f[5], 0, false); w1 = __builtin_amdgcn_cvt_pk_fp8_f32(f[6], f[7], w1, true);
              *(u32x2*)((unsigned char*)abf + (size_t)row * DM + col) = (u32x2){(unsigned)w0, (unsigned)w1}; }
            const bf16x8 fh = __builtin_bit_cast(bf16x8, hv), fl = __builtin_bit_cast(bf16x8, lv);
            const int wo = c16 * RT_LS + col * 2;
            const bf16x8 wh0 = *(const LAS bf16x8*)(rth + wo), wh1 = *(const LAS bf16x8*)(rth + 16 * RT_LS + wo), wl0 = *(const LAS bf16x8*)(rtl + wo), wl1 = *(const LAS bf16x8*)(rtl + 16 * RT_LS + wo);
            acc0 = __builtin_amdgcn_mfma_f32_16x16x32_bf16(fh, wh0, acc0, 0, 0, 0); acc1 = __builtin_amdgcn_mfma_f32_16x16x32_bf16(fh, wh1, acc1, 0, 0, 0);
            acc0 = __builtin_amdgcn_mfma_f32_16x16x32_bf16(fl, wh0, acc0, 0, 0, 0); acc1 = __builtin_amdgcn_mfma_f32_16x16x32_bf16(fl, wh1, acc1, 0, 0, 0);
            acc0 = __builtin_amdgcn_mfma_f32_16x16x32_bf16(fh, wl0, acc0, 0, 0, 0); acc1 = __builtin_amdgcn_mfma_f32_16x16x32_bf16(fh, wl1, acc1, 0, 0, 0);
        }
#pragma unroll
        for (int r = 0; r < 4; ++r) { lgs[(4 * g4 + r) * 34 + c16] = acc0[r] + rtb0; lgs[(4 * g4 + r) * 34 + 16 + c16] = acc1[r] + rtb1; }
        asm volatile("s_waitcnt lgkmcnt(0)" ::: "memory");
        if (lane < 16) {
            float tv[4] = {-3.0e38f, -3.0e38f, -3.0e38f, -3.0e38f}; int ti[4] = {0, 0, 0, 0};
#pragma unroll
            for (int e = 0; e < 32; ++e) {
                const float lgv = lgs[lane * 34 + e];
                if (lgv > tv[3]) {
                    tv[3] = lgv; ti[3] = e;
                    if (tv[3] > tv[2]) { const float a = tv[2]; tv[2] = tv[3]; tv[3] = a; const int b = ti[2]; ti[2] = ti[3]; ti[3] = b; }
                    if (tv[2] > tv[1]) { const float a = tv[1]; tv[1] = tv[2]; tv[2] = a; const int b = ti[1]; ti[1] = ti[2]; ti[2] = b; }
                    if (tv[1] > tv[0]) { const float a = tv[0]; tv[0] = tv[1]; tv[1] = a; const int b = ti[0]; ti[0] = ti[1]; ti[1] = b; }
                }
            }
            const float e1 = __expf(tv[1] - tv[0]), e2 = __expf(tv[2] - tv[0]), e3 = __expf(tv[3] - tv[0]);
            const float inv = 1.0f / (1.0f + e1 + e2 + e3);
            const size_t r4 = (size_t)(row_lo + 16 * u + lane) * 4;
            *(int4*)((int*)(ws + WS_TOKE) + r4) = make_int4(ti[0], ti[1], ti[2], ti[3]);
            *(f32x4*)((float*)(ws + WS_TOKG) + r4) = (f32x4){inv, e1 * inv, e2 * inv, e3 * inv};
            int rk[4];
#pragma unroll
            for (int k = 0; k < 4; ++k) rk[k] = __hip_atomic_fetch_add(hist + ti[k], 1, __ATOMIC_RELAXED, __HIP_MEMORY_SCOPE_WORKGROUP);
            *(int4*)((int*)(ws + WS_TOKR) + r4) = make_int4(rk[0], rk[1], rk[2], rk[3]);
        }
        asm volatile("s_waitcnt lgkmcnt(0)" ::: "memory");
    }
    __syncthreads();
    if (tid < 32) ((int*)(ws + WS_BCNT))[((size_t)l * 256 + bid) * 32 + tid] = hist[tid];
}

typedef pg8::f32x4 (&AccRef)[2][2][4][2];
struct EpiStoreBf16 {
    static constexpr bool PERM = true, AFTER_DRAIN = false;
    bf16_t* O; int ldc;
    __device__ __forceinline__ void operator()(const pg8::f32x4 (&acc)[2][2][4][2], const pg8::Unit& u, int wr, int wc, int fr, int fq) const {
        const int row0 = u.pm * 256 + wr * 64 + fr, col0 = u.pn * 256 + wc * 32 + 8 * fq;
#pragma unroll
        for (int ai = 0; ai < 2; ++ai)
#pragma unroll
            for (int m = 0; m < 4; ++m) { bf16_t* rowp = O + (size_t)(row0 + ai * 128 + m * 16) * ldc + col0;
#pragma unroll
                for (int bj = 0; bj < 2; ++bj) { const pg8::f32x4 v0 = acc[ai][bj][m][0], v1 = acc[ai][bj][m][1];
                    u32x4 w; w.x = cvtpk_s(v0[0], v0[1]); w.y = cvtpk_s(v0[2], v0[3]); w.z = cvtpk_s(v1[0], v1[1]); w.w = cvtpk_s(v1[2], v1[3]);
                    *(u32x4*)(rowp + bj * 128) = w; } }
    }
};
struct EpiGeluBf16 {
    static constexpr bool PERM = true, AFTER_DRAIN = false;
    bf16_t* O; int ldc; const float* bias;
    __device__ __forceinline__ void operator()(const pg8::f32x4 (&acc)[2][2][4][2], const pg8::Unit& u, int wr, int wc, int fr, int fq) const {
        const int row0 = u.pm * 256 + wr * 64 + fr, col0 = u.pn * 256 + wc * 32 + 8 * fq;
        pg8::f32x4 bv[2][2];
#pragma unroll
        for (int bj = 0; bj < 2; ++bj)
#pragma unroll
            for (int n = 0; n < 2; ++n) bv[bj][n] = *(const pg8::f32x4*)(bias + col0 + bj * 128 + 4 * n);
#pragma unroll
        for (int ai = 0; ai < 2; ++ai)
#pragma unroll
            for (int m = 0; m < 4; ++m) { bf16_t* rowp = O + (size_t)(row0 + ai * 128 + m * 16) * ldc + col0;
#pragma unroll
                for (int bj = 0; bj < 2; ++bj) { pg8::f32x4 v0 = acc[ai][bj][m][0] + bv[bj][0], v1 = acc[ai][bj][m][1] + bv[bj][1];
                    const pg8::f32x2 a = pg8::gelu_pk((pg8::f32x2){v0[0], v0[1]}), b = pg8::gelu_pk((pg8::f32x2){v0[2], v0[3]}), c = pg8::gelu_pk((pg8::f32x2){v1[0], v1[1]}), d = pg8::gelu_pk((pg8::f32x2){v1[2], v1[3]});
                    u32x4 w; w.x = cvtpk_s(a.x, a.y); w.y = cvtpk_s(b.x, b.y); w.z = cvtpk_s(c.x, c.y); w.w = cvtpk_s(d.x, d.y);
                    *(u32x4*)(rowp + bj * 128) = w; } }
    }
};
struct EpiResidual {
    static constexpr bool PERM = true, AFTER_DRAIN = false;
    bf16_t* H; const float* gate0; int row_base;
    __device__ __forceinline__ void operator()(const pg8::f32x4 (&acc)[2][2][4][2], const pg8::Unit& u, int wr, int wc, int fr, int fq) const {
        const int row0 = u.pm * 256 + wr * 64 + fr, col0 = u.pn * 256 + wc * 32 + 8 * fq;
        const Tok tk = tokinfo(row_base + u.pm * 256);
        const float* gate = gate0 + (size_t)tk.modrow * 6144 + col0;
        pg8::f32x4 gv[2][2];
#pragma unroll
        for (int bj = 0; bj < 2; ++bj)
#pragma unroll
            for (int n = 0; n < 2; ++n) gv[bj][n] = *(const pg8::f32x4*)(gate + bj * 128 + n * 4);
#pragma unroll
        for (int ai = 0; ai < 2; ++ai)
#pragma unroll
            for (int m = 0; m < 4; ++m) { bf16_t* rowp = H + (size_t)(row0 + ai * 128 + m * 16) * DM + col0;
#pragma unroll
                for (int bj = 0; bj < 2; ++bj) { u32x4* p = (u32x4*)(rowp + bj * 128); const u32x4 h = *p;
                    const pg8::f32x4 v0 = (pg8::f32x4){bflo(h.x), bfhi(h.x), bflo(h.y), bfhi(h.y)} + gv[bj][0] * acc[ai][bj][m][0], v1 = (pg8::f32x4){bflo(h.z), bfhi(h.z), bflo(h.w), bfhi(h.w)} + gv[bj][1] * acc[ai][bj][m][1];
                    *p = (u32x4){cvtpk_s(v0[0], v0[1]), cvtpk_s(v0[2], v0[3]), cvtpk_s(v1[0], v1[1]), cvtpk_s(v1[2], v1[3])}; } }
    }
};
struct ListOrder {
    const LAS int* list; int n; const LAS unsigned* rowtab;
    __device__ __forceinline__ bool next(int i, pg8::Unit& u) const {
        if (i >= n) return false;
        u.pm = __builtin_amdgcn_readfirstlane(list[2 * i]); u.pn = __builtin_amdgcn_readfirstlane(list[2 * i + 1]); u.ui = i; return true;
    }
    __device__ __forceinline__ void a_ready(const pg8::Unit&) const {}
    __device__ __forceinline__ void done(const pg8::Unit&) const {}
};
struct EpiLora {
    static constexpr bool PERM = true, AFTER_DRAIN = false;
    bf16_t* O; const float* bias; int row_base;
    __device__ __forceinline__ void operator()(const pg8::f32x4 (&acc)[2][2][4][2], const pg8::Unit& u, int wr, int wc, int fr, int fq) const {
        const int seg = u.pn >> 1, row0 = row_base + u.pm * 256 + wr * 64 + fr, cs0 = (u.pn & 1) * 256 + wc * 32 + 8 * fq;
        const float ksig = seg < 2 ? -0.60653065971f : 1.0f; const bool lin = seg == 4;
        bf16_t* Os = O + (size_t)seg * NTOK * 512;
#pragma unroll
        for (int bj = 0; bj < 2; ++bj) {
            const int cs = cs0 + bj * 128;
            const pg8::f32x4 b0 = *(const pg8::f32x4*)(bias + seg * 512 + cs), b1 = *(const pg8::f32x4*)(bias + seg * 512 + cs + 4);
#pragma unroll
            for (int ai = 0; ai < 2; ++ai)
#pragma unroll
                for (int m = 0; m < 4; ++m) {
                    pg8::f32x4 v0 = acc[ai][bj][m][0] + b0, v1 = acc[ai][bj][m][1] + b1;
#pragma unroll
                    for (int r = 0; r < 4; ++r) {
                        const float t0 = ksig * __builtin_amdgcn_rcpf(1.0f + __expf(-v0[r])), t1 = ksig * __builtin_amdgcn_rcpf(1.0f + __expf(-v1[r]));
                        v0[r] = lin ? v0[r] : t0; v1[r] = lin ? v1[r] : t1;
                    }
                    u32x4 w; w.x = cvtpk_s(v0[0], v0[1]); w.y = cvtpk_s(v0[2], v0[3]); w.z = cvtpk_s(v1[0], v1[1]); w.w = cvtpk_s(v1[2], v1[3]);
                    *(u32x4*)(Os + (size_t)(row0 + ai * 128 + m * 16) * 512 + cs) = w;
                }
        }
    }
};
constexpr int LDS_TAB = 131072;
constexpr int LDS_LIST = LDS_TAB + 4096;
constexpr int LDS_ROWTAB = LDS_LIST + 1024;
__device__ __forceinline__ ListOrder build_units(LAS unsigned char* lds, int nM, int nN, int G, int c, const LAS int* tile_e, int ncol) {
    LAS int* list = (LAS int*)(lds + LDS_LIST);
    pg8::StaticOrder S; S.nM = nM; S.nN = nN; S.nwg = nM * nN; S.G = G; S.c = c;
    const int tid = tid_opaque();
    if (tid < 64) { pg8::Unit u; if (S.next(tid, u)) { if (tile_e) u.pn = tile_e[u.pm] * ncol + u.pn; list[2 * tid] = u.pm; list[2 * tid + 1] = u.pn; } }
    __syncthreads();
    ListOrder L; L.list = list; L.n = (c < S.nwg) ? (S.nwg - c + G - 1) / G : 0; L.rowtab = (const LAS unsigned*)(lds + LDS_ROWTAB);
    return L;
}
struct EpiMoe1 {
    static constexpr bool PERM = true, AFTER_DRAIN = false;
    bf16_t* O; const float* b1;
    __device__ __forceinline__ void operator()(const pg8::f32x4 (&acc)[2][2][4][2], const pg8::Unit& u, int wr, int wc, int fr, int fq) const {
        const int e = u.pn >> 3, pn = u.pn & 7;
        const int row0 = u.pm * 256 + wr * 64 + fr, ci = pn * 128 + wc * 32 + 8 * fq;
        const float* be = b1 + (size_t)e * 2048 + ci;
        unsigned char* bp = (unsigned char*)O + (size_t)u.pm * 262144 + (size_t)(pn * 4 + wc) * 8192 + (wr * 64 + fr) * 32 + 8 * fq; (void)row0;
        const pg8::f32x4 bg0 = *(const pg8::f32x4*)(be), bg1 = *(const pg8::f32x4*)(be + 4), bl0 = *(const pg8::f32x4*)(be + 1024), bl1 = *(const pg8::f32x4*)(be + 1028);
#pragma unroll
        for (int ai = 0; ai < 2; ++ai)
#pragma unroll
            for (int m = 0; m < 4; ++m) {
                const pg8::f32x4 g0 = acc[ai][0][m][0] + bg0, g1 = acc[ai][0][m][1] + bg1, l0 = acc[ai][1][m][0] + bl0, l1 = acc[ai][1][m][1] + bl1;
                float o[8];
#pragma unroll
                for (int r = 0; r < 4; r += 2) {
#pragma unroll
                    for (int hlf = 0; hlf < 2; ++hlf) {
                        const pg8::f32x4 gv = hlf ? g1 : g0, lv = hlf ? l1 : l0;
                        pg8::f32x2 ga = {fminf(gv[r], 7.0f), fminf(gv[r + 1], 7.0f)};
                        const pg8::f32x2 la = {__builtin_amdgcn_fmed3f(lv[r], -7.0f, 7.0f), __builtin_amdgcn_fmed3f(lv[r + 1], -7.0f, 7.0f)};
                        const pg8::f32x2 t = ga * la + ga, x = ga * (-1.702f * 1.4426950408889634f);
                        pg8::f32x2 e; e.x = __builtin_amdgcn_exp2f(x.x); e.y = __builtin_amdgcn_exp2f(x.y);
                        const pg8::f32x2 d = e * 0.25f + 0.25f;
                        o[4 * hlf + r] = t.x * __builtin_amdgcn_rcpf(d.x); o[4 * hlf + r + 1] = t.y * __builtin_amdgcn_rcpf(d.y);
                    }
                }
                int w0 = __builtin_amdgcn_cvt_pk_fp8_f32(o[0], o[1], 0, false); w0 = __builtin_amdgcn_cvt_pk_fp8_f32(o[2], o[3], w0, true);
                int w1 = __builtin_amdgcn_cvt_pk_fp8_f32(o[4], o[5], 0, false); w1 = __builtin_amdgcn_cvt_pk_fp8_f32(o[6], o[7], w1, true);
                *(u32x2*)(bp + (ai * 128 + m * 16) * 32) = (u32x2){(unsigned)w0, (unsigned)w1};
            }
    }
};
struct EpiMoe2 {
    static constexpr bool PERM = true, AFTER_DRAIN = false, WIDE = true;
    unsigned char* O; const LAS float* btab;
    __device__ __forceinline__ void operator()(const pg8::f32x4 (&acc)[2][2][4][2], const pg8::Unit& u, int wr, int wc, int fr, int fq) const {
        const int pn = u.pn & 3;
        const int row0 = u.pm * 256 + wr * 64 + fr, col0 = pn * 256 + wc * 64 + 16 * fq;
        const LAS float* be = btab + u.ui * 256 + wc * 64 + 16 * fq;
        pg8::f32x4 bv[2][2];
#pragma unroll
        for (int bj = 0; bj < 2; ++bj)
#pragma unroll
            for (int n = 0; n < 2; ++n) bv[bj][n] = *(const LAS pg8::f32x4*)(be + bj * 8 + 4 * n);
#pragma unroll
        for (int ai = 0; ai < 2; ++ai)
#pragma unroll
            for (int m = 0; m < 4; ++m) { unsigned char* rowp = O + (size_t)(row0 + ai * 128 + m * 16) * DM + col0;
                int w[4];
#pragma unroll
                for (int bj = 0; bj < 2; ++bj) { const pg8::f32x4 v0 = (acc[ai][bj][m][0] + bv[bj][0]) * 16.0f, v1 = (acc[ai][bj][m][1] + bv[bj][1]) * 16.0f;
                    int w0 = __builtin_amdgcn_cvt_pk_fp8_f32(v0[0], v0[1], 0, false); w0 = __builtin_amdgcn_cvt_pk_fp8_f32(v0[2], v0[3], w0, true);
                    int w1 = __builtin_amdgcn_cvt_pk_fp8_f32(v1[0], v1[1], 0, false); w1 = __builtin_amdgcn_cvt_pk_fp8_f32(v1[2], v1[3], w1, true);
                    w[2 * bj] = w0; w[2 * bj + 1] = w1; }
                *(u32x4*)rowp = (u32x4){(unsigned)w[0], (unsigned)w[1], (unsigned)w[2], (unsigned)w[3]}; }
    }
};

namespace att {
typedef float f32x16 __attribute__((ext_vector_type(16)));
typedef short s16x4 __attribute__((ext_vector_type(4)));
constexpr int KVBLK = 64, LDR = 512;
constexpr float QSCALE = 0.125f * 1.4426950408889634f;
constexpr int SHM_V = KVBLK * 128 * 2, SHM_K = KVBLK * 64 * 2, SHM_ATTN = 2 * SHM_V + 2 * SHM_K + NWAVES * 64 * 4;
#define ATT_KSWZ(row, colB) ((row) * 128 + ((colB) ^ ((((row) >> 1) & 7) << 4)))
#define ATT_SBAR() __builtin_amdgcn_sched_barrier(0)
__device__ __forceinline__ int crow(int r, int hi) { return (r & 3) + 8 * (r >> 2) + 4 * hi; }
__device__ __forceinline__ unsigned cvtpk(float lo, float hi) { unsigned r; asm volatile("v_cvt_pk_bf16_f32 %0, %1, %2" : "=v"(r) : "v"(lo), "v"(hi)); return r; }
constexpr float SHIFT = -12.0f;
__device__ __forceinline__ void partialSM(f32x16& p0) {
#pragma unroll
    for (int r = 0; r < 16; ++r) p0[r] = __builtin_amdgcn_exp2f(p0[r]);
}
__device__ __forceinline__ void finishSM(f32x16& p0, f32x16& p1, float& l_reg, bf16x8& pa0, bf16x8& pa1, bf16x8& pa2, bf16x8& pa3) {
#pragma unroll
    for (int r = 0; r < 16; ++r) p1[r] = __builtin_amdgcn_exp2f(p1[r]);
    float ps = 0;
#pragma unroll
    for (int r = 0; r < 16; ++r) ps += p0[r];
#pragma unroll
    for (int r = 0; r < 16; ++r) ps += p1[r];
    l_reg += ps;
#define ATT_PK4(P, BASE, OUT) do { unsigned a0 = cvtpk(P[BASE + 0], P[BASE + 1]), a1 = cvtpk(P[BASE + 2], P[BASE + 3]);   \
    unsigned b0 = cvtpk(P[BASE + 4], P[BASE + 5]), b1 = cvtpk(P[BASE + 6], P[BASE + 7]);                              \
    auto r0 = __builtin_amdgcn_permlane32_swap(a0, b0, false, false); auto r1 = __builtin_amdgcn_permlane32_swap(a1, b1, false, false); \
    u32x4 w = {r0[0], r1[0], r0[1], r1[1]}; OUT = __builtin_bit_cast(bf16x8, w); } while (0)
    ATT_PK4(p0, 0, pa0); ATT_PK4(p0, 8, pa1); ATT_PK4(p1, 0, pa2); ATT_PK4(p1, 8, pa3);
#undef ATT_PK4
}
__device__ __forceinline__ void qkt(f32x16& p0, f32x16& p1, const LAS unsigned char* Ks, int qaddr, int r32, int hi) {
    asm volatile("" : "+v"(qaddr)); const LAS unsigned char* qp = (const LAS unsigned char*)(uintptr_t)qaddr;
    bf16x8 qr[4];
#pragma unroll
    for (int d0 = 0; d0 < 4; ++d0) qr[d0] = *(const LAS bf16x8*)(qp + d0 * 1024);
#pragma unroll
    for (int r = 0; r < 16; ++r) { p0[r] = SHIFT; p1[r] = SHIFT; }
#pragma unroll
    for (int d0 = 0; d0 < 4; ++d0) { const int cb = (d0 * 16 + hi * 8) * 2;
        const bf16x8 b0 = *(const LAS bf16x8*)(Ks + ATT_KSWZ(r32, cb));
        const bf16x8 b1 = *(const LAS bf16x8*)(Ks + ATT_KSWZ(32 + r32, cb));
        p0 = __builtin_amdgcn_mfma_f32_32x32x16_bf16(b0, qr[d0], p0, 0, 0, 0);
        p1 = __builtin_amdgcn_mfma_f32_32x32x16_bf16(b1, qr[d0], p1, 0, 0, 0); }
}
__device__ __forceinline__ int v_st(int k, int c) { const int kk = (k & ~0xC) | ((k & 4) << 1) | ((k & 8) >> 1); return ((kk >> 3) * 4 + (c >> 5)) * 512 + ((kk & 7) * 32 + (c & 31)) * 2; }
__device__ __forceinline__ int v_rd_base(int lane) { return ((lane & 3) << 3) | (((lane >> 2) & 3) << 6) | (((lane >> 4) & 1) << 5) | (((lane >> 5) & 1) << 8); }
constexpr int v_rd_off(int d0, int ks, int half) { return d0 * 512 + ks * 4096 + half * 2048; }
template <int OFF> __device__ __forceinline__ s16x4 tr_read(int vb) { s16x4 r; asm volatile("ds_read_b64_tr_b16 %0, %1 offset:%2" : "=&v"(r) : "v"(vb), "i"(OFF) : "memory"); return r; }
template <int D0> __device__ __forceinline__ void pv_one(f32x16& od, int vb, bf16x8 pa0, bf16x8 pa1, bf16x8 pa2, bf16x8 pa3) {
    const s16x4 l0 = tr_read<v_rd_off(D0, 0, 0)>(vb), h0 = tr_read<v_rd_off(D0, 0, 1)>(vb), l1 = tr_read<v_rd_off(D0, 1, 0)>(vb), h1 = tr_read<v_rd_off(D0, 1, 1)>(vb);
    const s16x4 l2 = tr_read<v_rd_off(D0, 2, 0)>(vb), h2 = tr_read<v_rd_off(D0, 2, 1)>(vb), l3 = tr_read<v_rd_off(D0, 3, 0)>(vb), h3 = tr_read<v_rd_off(D0, 3, 1)>(vb);
    asm volatile("s_waitcnt lgkmcnt(0)" ::: "memory"); ATT_SBAR();
#define ATT_PK(L, H) (bf16x8){L[0], L[1], L[2], L[3], H[0], H[1], H[2], H[3]}
    od = __builtin_amdgcn_mfma_f32_32x32x16_bf16(pa0, ATT_PK(l0, h0), od, 0, 0, 0);
    od = __builtin_amdgcn_mfma_f32_32x32x16_bf16(pa1, ATT_PK(l1, h1), od, 0, 0, 0);
    od = __builtin_amdgcn_mfma_f32_32x32x16_bf16(pa2, ATT_PK(l2, h2), od, 0, 0, 0);
    od = __builtin_amdgcn_mfma_f32_32x32x16_bf16(pa3, ATT_PK(l3, h3), od, 0, 0, 0);
#undef ATT_PK
}
__device__ __forceinline__ void pv_d0(f32x16 (&o)[4], int vb, bf16x8 pa0, bf16x8 pa1, bf16x8 pa2, bf16x8 pa3) {
    pv_one<0>(o[0], vb, pa0, pa1, pa2, pa3); pv_one<1>(o[1], vb, pa0, pa1, pa2, pa3); pv_one<2>(o[2], vb, pa0, pa1, pa2, pa3); pv_one<3>(o[3], vb, pa0, pa1, pa2, pa3);
}
__device__ __forceinline__ void attn_body(const bf16_t* Qb, const bf16_t* Kh, const bf16_t* Vh, bf16_t* Ob, int seq, LAS unsigned char* lds) {
    const int tid = tid_opaque(), wid = tid >> 6, lane = tid & 63, r32 = lane & 31, hi = lane >> 5;
    LAS unsigned char* V_lds = lds; LAS unsigned char* K_lds = lds + 2 * SHM_V;
    LAS float* wsl = (LAS float*)(lds + 2 * SHM_V + 2 * SHM_K) + wid * 64; LAS float* li_l = wsl; LAS float* al_l = wsl + 32;
    float l_reg = 0; f32x16 o[4] = {};
    const bf16_t* Qw = Qb + (size_t)(wid * 32 + r32) * LDR + hi * 8;
    LAS unsigned char* qlds = lds + SHM_ATTN + wid * 4096 + lane * 16;
#pragma unroll
    for (int d0 = 0; d0 < 4; ++d0) *(LAS bf16x8*)(qlds + d0 * 1024) = *(const bf16x8*)(Qw + d0 * 16);
    const int qr = (int)(uintptr_t)qlds;
    const int sr = tid >> 4, sc = (tid & 15) * 8, vst0 = v_st(sr, sc), vst1 = v_st(32 + sr, sc);
    const int kr = tid >> 3, kc = (tid & 7) * 8, kst = ATT_KSWZ(kr, kc * 2);
    const int vb0 = (int)(uintptr_t)V_lds + v_rd_base(lane);
    bf16x8 vsA0, vsA1, ksA, vsB0, vsB1, ksB;
#define ATT_SLOAD(V0, V1, K0, k0) do { V0 = *(const bf16x8*)(Vh + (size_t)((k0) + sr) * LDR + sc); V1 = *(const bf16x8*)(Vh + (size_t)((k0) + 32 + sr) * LDR + sc); \
    K0 = *(const bf16x8*)(Kh + (size_t)((k0) + kr) * LDR + kc); } while (0)
#define ATT_SWRITE(b, V0, V1, K0) do { *(LAS bf16x8*)(V_lds + (b) * SHM_V + vst0) = V0; *(LAS bf16x8*)(V_lds + (b) * SHM_V + vst1) = V1; \
    *(LAS bf16x8*)(K_lds + (b) * SHM_K + kst) = K0; } while (0)
#define ATT_SWAIT() asm volatile("s_waitcnt vmcnt(3)" ::: "memory")
    f32x16 p0, p1; bf16x8 pa0, pa1, pa2, pa3; const int NT = seq / KVBLK;
    ATT_SLOAD(vsA0, vsA1, ksA, 0); asm volatile("s_waitcnt vmcnt(0)" ::: "memory"); ATT_SWRITE(0, vsA0, vsA1, ksA);
    ATT_SLOAD(vsB0, vsB1, ksB, KVBLK); if (2 < NT) ATT_SLOAD(vsA0, vsA1, ksA, 2 * KVBLK);
    ATT_SWAIT(); ATT_SWRITE(1, vsB0, vsB1, ksB); __syncthreads();
    for (int j = 0; j < NT; j += 2) {
        ATT_SBAR(); qkt(p0, p1, K_lds, qr, r32, hi); partialSM(p0);
        finishSM(p0, p1, l_reg, pa0, pa1, pa2, pa3); ATT_SBAR();
        if (j + 3 < NT) ATT_SLOAD(vsB0, vsB1, ksB, (j + 3) * KVBLK); ATT_SBAR();
        pv_d0(o, vb0, pa0, pa1, pa2, pa3); ATT_SBAR();
        __syncthreads();
        if (j + 2 < NT) { ATT_SWAIT(); ATT_SWRITE(0, vsA0, vsA1, ksA); }
        asm volatile("" : "+v"(o[0]), "+v"(o[1]), "+v"(o[2]), "+v"(o[3]));
        __syncthreads();
        ATT_SBAR(); qkt(p0, p1, K_lds + SHM_K, qr, r32, hi); partialSM(p0);
        finishSM(p0, p1, l_reg, pa0, pa1, pa2, pa3); ATT_SBAR();
        if (j + 4 < NT) ATT_SLOAD(vsA0, vsA1, ksA, (j + 4) * KVBLK); ATT_SBAR();
        pv_d0(o, vb0 + SHM_V, pa0, pa1, pa2, pa3); ATT_SBAR();
        __syncthreads();
        if (j + 3 < NT) { ATT_SWAIT(); ATT_SWRITE(1, vsB0, vsB1, ksB); }
        asm volatile("" : "+v"(o[0]), "+v"(o[1]), "+v"(o[2]), "+v"(o[3]));
        __syncthreads();
    }
    { auto rr = __builtin_amdgcn_permlane32_swap(__float_as_uint(l_reg), __float_as_uint(l_reg), false, false); l_reg = __uint_as_float(rr[0]) + __uint_as_float(rr[1]); }
    if (hi == 0) li_l[r32] = l_reg; asm volatile("s_waitcnt lgkmcnt(0)" ::: "memory");
    float rli[16];
#pragma unroll
    for (int r = 0; r < 16; ++r) rli[r] = __builtin_amdgcn_rcpf(li_l[crow(r, hi)]);
    bf16_t* Ow = Ob + (size_t)(wid * 32) * LDR;
    const bool oddl = (r32 & 1) != 0;
#pragma unroll
    for (int rp = 0; rp < 8; ++rp) {
        const int orow = oddl ? crow(2 * rp + 1, hi) : crow(2 * rp, hi);
#pragma unroll
        for (int d0 = 0; d0 < 4; ++d0) {
            const float va = o[d0][2 * rp] * rli[2 * rp], vb = o[d0][2 * rp + 1] * rli[2 * rp + 1];
            const float send = oddl ? va : vb, mine = oddl ? vb : va;
            const float recv = __builtin_bit_cast(float, __builtin_amdgcn_update_dpp(0, __builtin_bit_cast(int, send), 0xB1, 0xF, 0xF, false));
            *(unsigned*)(Ow + (size_t)orow * LDR + d0 * 32 + (r32 & ~1)) = oddl ? cvtpk_s(recv, mine) : cvtpk_s(mine, recv);
        }
    }
#undef ATT_SLOAD
#undef ATT_SWRITE
#undef ATT_SWAIT
}
}

__device__ __forceinline__ void ph_gemm_win(const Args& A, int j, int row_lo, LAS unsigned char* lds, int bid, int nb) {
    unsigned char* ws = opq(A.ws); const float* const* IN = (const float* const*)(ws + WS_PTRS); (void)IN;
    pg8::Gemm g{(const bf16_t*)(ws + WS_ABF) + (size_t)row_lo * DM, (const bf16_t*)(ws + WS_WIN) + (size_t)j * ZLD * DM, NTOK - row_lo, ZLD, DM};
    const ListOrder S = build_units(lds, (NTOK - row_lo) / 256, ZLD / 256, nb, bid, nullptr, 0);
    EpiStoreBf16 E{(bf16_t*)(ws + WS_Z) + (size_t)row_lo * ZLD, ZLD};
    pg8::gemm_phase<EpiStoreBf16, ListOrder, true, true>(lds, g, S, E);
}

__device__ __forceinline__ void ph_rwkv_pre(const Args& A, int j, int row_lo, int bid, int nb) {
    unsigned char* ws = opq(A.ws); const float* const* IN = (const float* const*)(ws + WS_PTRS);
    const int tid = tid_opaque(), lane = tid & 63, wid = tid >> 6;
    const bf16_t* Z = (const bf16_t*)(ws + WS_Z);
    const float* mu = INP(I_RWMU) + (size_t)j * 2 * RWC; const float* kkw = INP(I_RWKK) + j * 512;
    bf16_t* RB = (bf16_t*)(ws + WS_RB); bf16_t* KS = (bf16_t*)(ws + WS_KS); bf16_t* VS = (bf16_t*)(ws + WS_VS); bf16_t* KKN = (bf16_t*)(ws + WS_KKN); bf16_t* LIN = (bf16_t*)(ws + WS_LIN);
#define UNPK8(dst, raw) do { _Pragma("unroll") for (int _i = 0; _i < 4; ++_i) { dst[2 * _i] = __builtin_bit_cast(float, raw[_i] << 16); dst[2 * _i + 1] = __builtin_bit_cast(float, raw[_i] & 0xffff0000u); } } while (0)
#define PK8(v) (u32x4){pk2(v[0], v[1]), pk2(v[2], v[3]), pk2(v[4], v[5]), pk2(v[6], v[7])}
    for (int g = row_lo + bid * NWAVES + wid; g < NTOK; g += nb * NWAVES) {
        const Tok tk = tokinfo(g);
        const bool hp = tk.t > 0, hn = tk.t < tk.T - 1;
        const bf16_t* zc = Z + (size_t)g * ZLD;
#pragma unroll
        for (int i = 0; i < 4; ++i) {
            const int ch = i * 64 + lane, col = ch * 8;
            if (ch < 240) {
                const u32x4 zero = {0u, 0u, 0u, 0u};
                const u32x4 cr = *(const u32x4*)(zc + col), pr = hp ? *(const u32x4*)(zc - ZLD + col) : zero, nr = hn ? *(const u32x4*)(zc + ZLD + col) : zero;
                float z[8], p[8], n[8], s8[8];
                UNPK8(z, cr); UNPK8(p, pr); UNPK8(n, nr);
                const f32x4 m0a = *(const f32x4*)(mu + col), m0b = *(const f32x4*)(mu + col + 4), m1a = *(const f32x4*)(mu + RWC + col), m1b = *(const f32x4*)(mu + RWC + col + 4);
#pragma unroll
                for (int e = 0; e < 4; ++e) { s8[e] = z[e] + m0a[e] * (p[e] - z[e]) + m1a[e] * (n[e] - z[e]); s8[4 + e] = z[4 + e] + m0b[e] * (p[4 + e] - z[4 + e]) + m1b[e] * (n[4 + e] - z[4 + e]); }
                if (col < 512) *(u32x4*)(RB + (size_t)g * 512 + col) = PK8(s8);
                else if (col < 1024) {
                    const int ck = col - 512;
                    *(u32x4*)(KS + (size_t)g * 512 + ck) = PK8(s8);
                    const f32x4 kwa = *(const f32x4*)(kkw + ck), kwb = *(const f32x4*)(kkw + ck + 4);
                    float kk[8]; float ss = 0.f;
#pragma unroll
                    for (int e = 0; e < 4; ++e) { kk[e] = s8[e] * kwa[e]; kk[4 + e] = s8[4 + e] * kwb[e]; ss += kk[e] * kk[e] + kk[4 + e] * kk[4 + e]; }
                    ss += __shfl_xor(ss, 1); ss += __shfl_xor(ss, 2); ss += __shfl_xor(ss, 4);
                    const float inv = 1.0f / fmaxf(sqrtf(ss), 1e-12f);
#pragma unroll
                    for (int e = 0; e < 8; ++e) kk[e] *= inv;
                    *(u32x4*)(KKN + (size_t)g * 512 + ck) = PK8(kk);
                }
                else if (col < 1536) *(u32x4*)(VS + (size_t)g * 512 + (col - 1024)) = PK8(s8);
                else {
                    float t8[8];
#pragma unroll
                    for (int e = 0; e < 8; ++e) t8[e] = col < 1664 ? tanhf(s8[e]) : (col < 1792 ? s8[e] : sigmoidf_(s8[e]));
                    *(u32x4*)(LIN + (size_t)g * 384 + (col - 1536)) = PK8(t8);
                }
            }
        }
    }
#undef UNPK8
#undef PK8
}
__device__ __forceinline__ void ph_gemm_lora(const Args& A, int j, int row_lo, LAS unsigned char* lds, int bid, int nb) {
    unsigned char* ws = opq(A.ws);
    int Kq = LORA_K; asm volatile("" : "+s"(Kq));
    pg8::Gemm g{(const bf16_t*)(ws + WS_LIN) + (size_t)row_lo * LORA_K, (const bf16_t*)(ws + WS_WLORA) + (size_t)j * LORA_N * LORA_K, NTOK - row_lo, LORA_N, Kq};
    const ListOrder S = build_units(lds, (NTOK - row_lo) / 256, LORA_N / 256, nb, bid, nullptr, 0);
    EpiLora E{(bf16_t*)(ws + WS_LO), (const float*)(ws + WS_LBIAS) + (size_t)j * LORA_N, row_lo};
    pg8::gemm_phase<EpiLora, ListOrder, true, true>(lds, g, S, E);
}

constexpr int R_A2 = 0, R_RT = 2048, R_BT = 4096, R_KT = 6144, R_VT = 8192, R_MBR = 10240, R_MKR = 10752, R_G = 11264, R_P = 11776;
__device__ __forceinline__ bf16x8 frag4(u32x2 lo) { const u32x4 w = {lo.x, lo.y, 0u, 0u}; return __builtin_bit_cast(bf16x8, w); }
__device__ __forceinline__ bf16x8 frag8(u32x2 lo, u32x2 hi) { const u32x4 w = {lo.x, lo.y, hi.x, hi.y}; return __builtin_bit_cast(bf16x8, w); }
__device__ __forceinline__ u32x2 pack4(f32x4 v) { u32x2 o; o.x = cvtpk_s(v[0], v[1]); o.y = cvtpk_s(v[2], v[3]); return o; }
__device__ __forceinline__ int wkv_token(int b, int dir, int s) {
    if (s < TC) return b * TC + (dir ? (TC - 1 - s) : s);
    const int q = s - TC; return NCTX + b * TL + (dir ? (TL - 1 - q) : q);
}
__device__ __forceinline__ float dpp_row_shr(float x, const int n) {
    switch (n) {
        case 1: return __builtin_bit_cast(float, __builtin_amdgcn_update_dpp(0, __builtin_bit_cast(int, x), 0x111, 0xF, 0xF, false));
        case 2: return __builtin_bit_cast(float, __builtin_amdgcn_update_dpp(0, __builtin_bit_cast(int, x), 0x112, 0xF, 0xF, false));
        case 4: return __builtin_bit_cast(float, __builtin_amdgcn_update_dpp(0, __builtin_bit_cast(int, x), 0x114, 0xF, 0xF, false));
        default: return __builtin_bit_cast(float, __builtin_amdgcn_update_dpp(0, __builtin_bit_cast(int, x), 0x118, 0xF, 0xF, false));
    }
}
#define WKV_TR(dst, addr) asm volatile("ds_read_b64_tr_b16 %0, %1" : "=&v"(dst) : "v"(addr) : "memory")
__device__ __forceinline__ void wkv_produce(unsigned char* ws, const float* const* IN, int j, int b, int h, int dir, int c, LAS unsigned char* wl, LAS unsigned char* rec, int lane) {
    const int c16 = lane & 15, g4 = lane >> 4;
    constexpr int RS = 144;
    LAS unsigned char* Lat = wl; LAS unsigned char* Lbt = wl + 2304; LAS unsigned char* Lkt = wl + 4608; LAS unsigned char* Lrt = wl + 6912; LAS unsigned char* Lvt = wl + 9216;
    LAS float* Lnf = (LAS float*)(wl + 11520);
    LAS unsigned char* Lx = wl + 12608;
    const size_t FS = (size_t)NTOK * 512;
    const bf16_t* RB = (const bf16_t*)(ws + WS_RB); const bf16_t* KS = (const bf16_t*)(ws + WS_KS); const bf16_t* VS = (const bf16_t*)(ws + WS_VS); const bf16_t* KKN = (const bf16_t*)(ws + WS_KKN);
#define UNPK16(dst, p) do { const u32x4 _a = *(const u32x4*)(p), _b = *(const u32x4*)((p) + 8); _Pragma("unroll") for (int _i = 0; _i < 4; ++_i) { \
        dst[2 * _i] = __builtin_bit_cast(float, _a[_i] << 16); dst[2 * _i + 1] = __builtin_bit_cast(float, _a[_i] & 0xffff0000u); \
        dst[8 + 2 * _i] = __builtin_bit_cast(float, _b[_i] << 16); dst[9 + 2 * _i] = __builtin_bit_cast(float, _b[_i] & 0xffff0000u); } } while (0)
#define PK16ST(base, v) do { *(LAS u32x4*)(base) = (u32x4){pk2(v[0], v[1]), pk2(v[2], v[3]), pk2(v[4], v[5]), pk2(v[6], v[7])}; \
        *(LAS u32x4*)((base) + 16) = (u32x4){pk2(v[8], v[9]), pk2(v[10], v[11]), pk2(v[12], v[13]), pk2(v[14], v[15])}; } while (0)
    {
        const int g0 = wkv_token(b, dir, c * 16), gstep = dir ? -1 : 1;
        {
            const size_t o = (size_t)(g0 + gstep * c16) * 512 + h * 64 + 16 * g4;
            float lw[16], av[16], kv[16], kn[16], rv[16];
            UNPK16(lw, (const bf16_t*)(ws + WS_LO) + dir * FS + o); UNPK16(av, (const bf16_t*)(ws + WS_AB) + dir * FS + o);
            UNPK16(kv, KS + o); UNPK16(kn, KKN + o); UNPK16(rv, RB + o);
            { const u32x4 v0 = *(const u32x4*)(VS + o), v1 = *(const u32x4*)(VS + o + 8); *(LAS u32x4*)(Lvt + c16 * RS + 32 * g4) = v0; *(LAS u32x4*)(Lvt + c16 * RS + 32 * g4 + 16) = v1; }
            const float* kap = INP(I_RWKA) + j * 512 + h * 64 + 16 * g4;
            float at[16], bt[16], kt[16], rt[16], ecl[16];
#pragma unroll
            for (int i = 0; i < 16; ++i) {
                float cs = lw[i];
                cs += dpp_row_shr(cs, 1); cs += dpp_row_shr(cs, 2); cs += dpp_row_shr(cs, 4); cs += dpp_row_shr(cs, 8);
                const float ep = __expf(cs - lw[i]), ec = __expf(cs), em = __builtin_amdgcn_rcpf(ec);
                at[i] = -kn[i] * ep; bt[i] = kn[i] * av[i] * em; kt[i] = kv[i] * (1.0f + (av[i] - 1.0f) * kap[i]) * em; rt[i] = rv[i] * ec; ecl[i] = ec;
            }
            PK16ST(Lat + c16 * RS + 32 * g4, at); PK16ST(Lbt + c16 * RS + 32 * g4, bt); PK16ST(Lkt + c16 * RS + 32 * g4, kt); PK16ST(Lrt + c16 * RS + 32 * g4, rt);
            if (c16 == 15) {
#pragma unroll
                for (int q = 0; q < 4; ++q) *(LAS f32x4*)(rec + R_P + (16 * g4 + 4 * q) * 4) = (f32x4){ecl[4 * q], ecl[4 * q + 1], ecl[4 * q + 2], ecl[4 * q + 3]};
            }
        }
        asm volatile("s_waitcnt lgkmcnt(0)" ::: "memory");
        f32x4 nD = {0.f, 0.f, 0.f, 0.f}, makD = nD, mbrD = nD, mkrD = nD;
#pragma unroll
        for (int ks = 0; ks < 2; ++ks) {
            const int off = c16 * RS + (32 * ks + 8 * g4) * 2;
            const bf16x8 fa = *(const LAS bf16x8*)(Lat + off), fb = *(const LAS bf16x8*)(Lbt + off), fk = *(const LAS bf16x8*)(Lkt + off), fr = *(const LAS bf16x8*)(Lrt + off);
            nD = __builtin_amdgcn_mfma_f32_16x16x32_bf16(fa, fb, nD, 0, 0, 0);
            makD = __builtin_amdgcn_mfma_f32_16x16x32_bf16(fa, fk, makD, 0, 0, 0);
            mbrD = __builtin_amdgcn_mfma_f32_16x16x32_bf16(fb, fr, mbrD, 0, 0, 0);
            mkrD = __builtin_amdgcn_mfma_f32_16x16x32_bf16(fk, fr, mkrD, 0, 0, 0);
        }
#pragma unroll
        for (int r = 0; r < 4; ++r) {
            const int row = 4 * g4 + r;
            nD[r] = (c16 < row) ? nD[r] : 0.f; makD[r] = (c16 < row) ? makD[r] : 0.f;
            mbrD[r] = (row <= c16) ? mbrD[r] : 0.f; mkrD[r] = (row <= c16) ? mkrD[r] : 0.f;
            Lnf[row * 17 + c16] = nD[r];
        }
        asm volatile("s_waitcnt lgkmcnt(0)" ::: "memory");
        float x[16];
#pragma unroll
        for (int t = 0; t < 16; ++t) {
            float acc = (t == c16) ? 1.f : 0.f;
#pragma unroll
            for (int i = 0; i < t; ++i) acc += Lnf[t * 17 + i] * x[i];
            x[t] = acc;
        }
        if (g4 == 0) {
#pragma unroll
            for (int t = 0; t < 16; ++t) *(LAS bf16_t*)(Lx + t * 32 + c16 * 2) = (bf16_t)f2bf(x[t]);
        }
        asm volatile("s_waitcnt lgkmcnt(0)" ::: "memory");
        const bf16x8 xB = frag4(*(const LAS u32x2*)(Lx + c16 * 32 + g4 * 8));
        const f32x4 z4 = {0.f, 0.f, 0.f, 0.f};
        const f32x4 gD = __builtin_amdgcn_mfma_f32_16x16x32_bf16(frag4(pack4(makD)), xB, z4, 0, 0, 0);
        *(LAS u32x2*)(rec + R_G + (c16 * 16 + 4 * g4) * 2) = pack4(gD);
        *(LAS u32x2*)(rec + R_MBR + (c16 * 16 + 4 * g4) * 2) = pack4(mbrD);
        *(LAS u32x2*)(rec + R_MKR + (c16 * 16 + 4 * g4) * 2) = pack4(mkrD);
        {
            const int trow = c16 >> 2, tcol = 4 * (c16 & 3);
            u32x2 ta[4], tb[4], tk[4], tv[4];
#pragma unroll
            for (int m = 0; m < 4; ++m) {
                const int aA = (int)(uintptr_t)(Lat + (4 * g4 + trow) * RS + (16 * m + tcol) * 2);
                const int offr = (4 * m + trow) * RS + (16 * g4 + tcol) * 2;
                const int aB = (int)(uintptr_t)(Lbt + offr), aK = (int)(uintptr_t)(Lkt + offr), aV = (int)(uintptr_t)(Lvt + offr);
                WKV_TR(ta[m], aA); WKV_TR(tb[m], aB); WKV_TR(tk[m], aK); WKV_TR(tv[m], aV);
            }
            asm volatile("s_waitcnt lgkmcnt(0)" ::: "memory"); __builtin_amdgcn_sched_barrier(0);
#pragma unroll
            for (int m = 0; m < 4; ++m) {
                const f32x4 d = __builtin_amdgcn_mfma_f32_16x16x32_bf16(frag4(ta[m]), xB, z4, 0, 0, 0);
                *(LAS u32x2*)(rec + R_A2 + (c16 * 64 + 16 * m + 4 * g4) * 2) = pack4(d);
            }
            const int kch = 16 * g4 + c16;
            *(LAS u32x4*)(rec + R_BT + kch * 32) = (u32x4){tb[0].x, tb[0].y, tb[1].x, tb[1].y}; *(LAS u32x4*)(rec + R_BT + kch * 32 + 16) = (u32x4){tb[2].x, tb[2].y, tb[3].x, tb[3].y};
            *(LAS u32x4*)(rec + R_KT + kch * 32) = (u32x4){tk[0].x, tk[0].y, tk[1].x, tk[1].y}; *(LAS u32x4*)(rec + R_KT + kch * 32 + 16) = (u32x4){tk[2].x, tk[2].y, tk[3].x, tk[3].y};
            *(LAS u32x4*)(rec + R_VT + kch * 32) = (u32x4){tv[0].x, tv[0].y, tv[1].x, tv[1].y}; *(LAS u32x4*)(rec + R_VT + kch * 32 + 16) = (u32x4){tv[2].x, tv[2].y, tv[3].x, tv[3].y};
        }
        { const int row = lane >> 2, cb = (lane & 3) * 16;
          const u32x4 r0 = *(const LAS u32x4*)(Lrt + row * RS + cb * 2), r1 = *(const LAS u32x4*)(Lrt + row * RS + cb * 2 + 16);
          *(LAS u32x4*)(rec + R_RT + (row * 64 + cb) * 2) = r0; *(LAS u32x4*)(rec + R_RT + (row * 64 + cb) * 2 + 16) = r1; }
        asm volatile("s_waitcnt lgkmcnt(0)" ::: "memory");
    }
#undef UNPK16
#undef PK16ST
}

struct QkC { float qn[8], kn[8], invf[8]; bool upper, colaxis; };
__device__ __forceinline__ void qk_init(QkC& q, const float* const* IN, int j, int lane) {
    const int d0 = (lane & 7) * 8;
#pragma unroll
    for (int i = 0; i < 8; ++i) { q.qn[i] = INP(I_QN)[j * 64 + d0 + i]; q.kn[i] = INP(I_KN)[j * 64 + d0 + i]; q.invf[i] = __powf(10000.0f, -(float)((d0 + i) & 15) / 16.0f); }
    q.upper = (d0 & 16) != 0; q.colaxis = (d0 & 32) != 0;
}
__device__ __forceinline__ void qk_token(const QkC& q, unsigned char* ws, int g, int lane) {
    const bf16_t* Z = (const bf16_t*)(ws + WS_Z);
    bf16_t* QB = (bf16_t*)(ws + WS_QB); bf16_t* KB = (bf16_t*)(ws + WS_KB); bf16_t* VB = (bf16_t*)(ws + WS_VB);
    const bool upper = q.upper, colaxis = q.colaxis;
    {
        const Tok tk = tokinfo(g);
        const size_t krow = (size_t)tk.b * (TC + TL) + (tk.T == TL ? TC + tk.t : tk.t);
        const bf16_t* zr = Z + (size_t)g * ZLD + RWC;
        *(u32x4*)(VB + krow * 512 + lane * 8) = *(const u32x4*)(zr + 1024 + lane * 8);
        float cs[8], sn[8];
        if (tk.T == TL) {
            const float pos = (float)(colaxis ? (tk.t & 63) : (tk.t >> 6));
#pragma unroll
            for (int i = 0; i < 8; ++i) __sincosf(pos * q.invf[i], &sn[i], &cs[i]);
        }
#pragma unroll
        for (int isk = 0; isk < 2; ++isk) {
            const u32x4 raw = *(const u32x4*)(zr + isk * 512 + lane * 8);
            float x[8];
#pragma unroll
            for (int i = 0; i < 4; ++i) { x[2 * i] = __builtin_bit_cast(float, raw[i] << 16); x[2 * i + 1] = __builtin_bit_cast(float, raw[i] & 0xffff0000u); }
            float ss = 0.f;
#pragma unroll
            for (int i = 0; i < 8; ++i) ss += x[i] * x[i];
            ss += __shfl_xor(ss, 1); ss += __shfl_xor(ss, 2); ss += __shfl_xor(ss, 4);
            const float rs = rsqrtf(ss * (1.0f / 64.0f) + 1e-6f);
#pragma unroll
            for (int i = 0; i < 8; ++i) x[i] = x[i] * rs * (isk ? q.kn[i] : q.qn[i] * att::QSCALE);
            if (tk.T == TL) {
#pragma unroll
                for (int i = 0; i < 8; ++i) { const float other = __shfl_xor(x[i], 2); x[i] = upper ? (x[i] * cs[i] + other * sn[i]) : (x[i] * cs[i] - other * sn[i]); }
            }
            u32x4 o; o.x = pk2(x[0], x[1]); o.y = pk2(x[2], x[3]); o.z = pk2(x[4], x[5]); o.w = pk2(x[6], x[7]);
            if (isk) *(u32x4*)(KB + krow * 512 + lane * 8) = o; else *(u32x4*)(QB + (size_t)g * 512 + lane * 8) = o;
        }
    }
}
__device__ __forceinline__ void ph_wkv_fused(const Args& A, int j, int row_lo, LAS unsigned char* lds, int bid, int nb) {
    unsigned char* ws = opq(A.ws); const float* const* IN = (const float* const*)(ws + WS_PTRS);
    const int tid = tid_opaque(), lane = tid & 63, wid = __builtin_amdgcn_readfirstlane(tid >> 6), c16 = lane & 15, g4 = lane >> 4;
    bf16_t* YS = (bf16_t*)(ws + WS_YS); const size_t FS = (size_t)NTOK * 512;
    constexpr int RING = 8 * WKV_REC, NRND = WKV_NCH / 4;
    static_assert(WKV_NCH % 4 == 0, "four chunks per round");
#define WKV_WGBAR() do { asm volatile("s_waitcnt lgkmcnt(0)" ::: "memory"); __builtin_amdgcn_s_barrier(); asm volatile("" ::: "memory"); } while (0)
    for (int inst = bid; inst < 256; inst += nb) {
        const int dir = inst & 1, h = (inst >> 1) & 7, b = inst >> 4;
        WKV_WGBAR();
        if (wid >= 4) {
            LAS unsigned char* wl = lds + RING + (wid - 4) * 13824;
            for (int r = 0; r < NRND; ++r) {
                wkv_produce(ws, IN, j, b, h, dir, 4 * r + (wid - 4), wl, lds + ((r & 1) * 4 + (wid - 4)) * WKV_REC, lane);
                WKV_WGBAR();
            }
            WKV_WGBAR();
        } else {
            const int v0 = wid * 16;
            bf16_t* Y = YS + dir * FS + h * 64 + v0 + (c16 & ~1); const bool oddl = (c16 & 1) != 0;
            f32x4 S[4];
#pragma unroll
            for (int mt = 0; mt < 4; ++mt) S[mt] = (f32x4){0.f, 0.f, 0.f, 0.f};
            QkC qc; qk_init(qc, IN, j, lane);
            WKV_WGBAR();
            for (int r = 0; r < NRND; ++r) {
                for (int k = 0; k < 4; ++k) {
                    const int c = 4 * r + k;
                    const LAS unsigned char* rec = lds + ((r & 1) * 4 + k) * WKV_REC;
                    u32x2 a2[4], rt[4], bt[4], kt[4]; f32x4 p[4];
    #pragma unroll
                    for (int q = 0; q < 4; ++q) {
                        a2[q] = *(const LAS u32x2*)(rec + R_A2 + (c16 * 64 + 16 * q + 4 * g4) * 2);
                        rt[q] = *(const LAS u32x2*)(rec + R_RT + (c16 * 64 + 16 * q + 4 * g4) * 2);
                        bt[q] = *(const LAS u32x2*)(rec + R_BT + ((16 * q + c16) * 16 + 4 * g4) * 2);
                        kt[q] = *(const LAS u32x2*)(rec + R_KT + ((16 * q + c16) * 16 + 4 * g4) * 2);
                        p[q] = *(const LAS f32x4*)(rec + R_P + (16 * q + 4 * g4) * 4);
                    }
                    const u32x2 gq = *(const LAS u32x2*)(rec + R_G + (c16 * 16 + 4 * g4) * 2), mkr = *(const LAS u32x2*)(rec + R_MKR + (c16 * 16 + 4 * g4) * 2), mbr = *(const LAS u32x2*)(rec + R_MBR + (c16 * 16 + 4 * g4) * 2);
                    const u32x2 vt = *(const LAS u32x2*)(rec + R_VT + ((v0 + c16) * 16 + 4 * g4) * 2);
                    const f32x4 z4 = {0.f, 0.f, 0.f, 0.f};
                    const bf16x8 sb0 = frag8(pack4(S[0]), pack4(S[1])), sb1 = frag8(pack4(S[2]), pack4(S[3]));
                    const bf16x8 vb = frag4(vt);
                    f32x4 U = __builtin_amdgcn_mfma_f32_16x16x32_bf16(frag4(gq), vb, z4, 0, 0, 0);
                    U = __builtin_amdgcn_mfma_f32_16x16x32_bf16(frag8(a2[0], a2[1]), sb0, U, 0, 0, 0);
                    U = __builtin_amdgcn_mfma_f32_16x16x32_bf16(frag8(a2[2], a2[3]), sb1, U, 0, 0, 0);
                    f32x4 Yt = __builtin_amdgcn_mfma_f32_16x16x32_bf16(frag4(mkr), vb, z4, 0, 0, 0);
                    Yt = __builtin_amdgcn_mfma_f32_16x16x32_bf16(frag8(rt[0], rt[1]), sb0, Yt, 0, 0, 0);
                    Yt = __builtin_amdgcn_mfma_f32_16x16x32_bf16(frag8(rt[2], rt[3]), sb1, Yt, 0, 0, 0);
                    const bf16x8 ub = frag4(pack4(U));
                    Yt = __builtin_amdgcn_mfma_f32_16x16x32_bf16(frag4(mbr), ub, Yt, 0, 0, 0);
    #pragma unroll
                    for (int mt = 0; mt < 4; ++mt) {
                        f32x4 sn = __builtin_amdgcn_mfma_f32_16x16x32_bf16(frag4(kt[mt]), vb, S[mt], 0, 0, 0);
                        sn = __builtin_amdgcn_mfma_f32_16x16x32_bf16(frag4(bt[mt]), ub, sn, 0, 0, 0);
                        S[mt] = sn * p[mt];
                    }
    #pragma unroll
                    for (int q = 0; q < 2; ++q) {
                        const float send = oddl ? Yt[q] : Yt[2 + q], mine = oddl ? Yt[2 + q] : Yt[q];
                        const float recv = __builtin_bit_cast(float, __builtin_amdgcn_update_dpp(0, __builtin_bit_cast(int, send), 0xB1, 0xF, 0xF, false));
                        *(unsigned*)(Y + (size_t)wkv_token(b, dir, c * 16 + 4 * g4 + (oddl ? 2 + q : q)) * 512) = oddl ? cvtpk_s(recv, mine) : cvtpk_s(mine, recv);
                    }
                }
                if (inst == bid) {
                    for (int g = row_lo + bid * 4 + wid + r * (nb * 4); g < NTOK; g += nb * 4 * NRND) qk_token(qc, ws, g, lane);
                }
                WKV_WGBAR();
            }
        }
    }
#undef WKV_WGBAR
}

__device__ __forceinline__ void ph_attn(const Args& A, bool want_ctx, LAS unsigned char* lds, int bid, int nb) {
    unsigned char* ws = opq(A.ws);
    const bf16_t* QB = (const bf16_t*)(ws + WS_QB); const bf16_t* KB = (const bf16_t*)(ws + WS_KB); const bf16_t* VB = (const bf16_t*)(ws + WS_VB);
    bf16_t* OP = (bf16_t*)(ws + WS_OP);
    const int vcu = (nb % 8 == 0) ? (bid % 8) * (nb / 8) + bid / 8 : bid;
    const int nunits = 1024 + (want_ctx ? 128 : 0);
    for (int u = vcu; u < nunits; u += nb) {
        int b, h, m, q0, seq;
        if (u < 1024) { const int qb = u & 7; m = (u >> 3) & 1; h = (u >> 4) & 3; b = u >> 6; q0 = NCTX + b * TL + qb * 256; seq = TC + TL; }
        else { const int v = u - 1024; m = v & 1; h = (v >> 1) & 3; b = v >> 3; q0 = b * TC; seq = TC; }
        const int s = h * 2 + m;
        att::attn_body(QB + (size_t)q0 * 512 + s * 64, KB + (size_t)b * (TC + TL) * 512 + s * 64, VB + (size_t)b * (TC + TL) * 512 + h * 128,
                       OP + (size_t)m * NTOK * 512 + (size_t)q0 * 512 + h * 128, seq, lds);
    }
}

__device__ __forceinline__ void ph_merge(const Args& A, int l, int row_lo, int bid, int nb) {
    unsigned char* ws = opq(A.ws); const float* const* IN = (const float* const*)(ws + WS_PTRS);
    const int j = l >> 1;
    const int tid = tid_opaque(), lane = tid & 63, wid = tid >> 6, c0 = lane * 8;
    const float lam_init = 0.8f - 0.6f * __expf(-0.3f * (float)l);
    const float* lp = INP(I_LAM) + j * 4 * 64;
    const float lam = __expf(wave_sum(lp[lane] * lp[64 + lane])) - __expf(wave_sum(lp[128 + lane] * lp[192 + lane])) + lam_init;
    const size_t FS = (size_t)NTOK * 512;
    const bf16_t* RB = (const bf16_t*)(ws + WS_RB); const bf16_t* KS = (const bf16_t*)(ws + WS_KS); const bf16_t* VS = (const bf16_t*)(ws + WS_VS);
    const bf16_t* AB = (const bf16_t*)(ws + WS_AB); const bf16_t* GB = (const bf16_t*)(ws + WS_GB);
    const bf16_t* YS = (const bf16_t*)(ws + WS_YS); const bf16_t* OP = (const bf16_t*)(ws + WS_OP);
    bf16_t* CAT = (bf16_t*)(ws + WS_CAT);
    float gnw[8], gnb[8], kaw[8], rkw[8], sub[8];
#pragma unroll
    for (int i = 0; i < 8; ++i) { gnw[i] = INP(I_GNW)[j * 512 + c0 + i]; gnb[i] = INP(I_GNB)[j * 512 + c0 + i]; kaw[i] = INP(I_RWKA)[j * 512 + c0 + i]; rkw[i] = INP(I_RWRK)[j * 512 + c0 + i];
        sub[i] = INP(I_SUBLN)[j * 128 + ((c0 + i) & 127)] * (1.0f - lam_init); }
#define LD8BF(dst, ptr) do { const u32x4 _t = *(const u32x4*)(ptr); _Pragma("unroll") for (int _i = 0; _i < 4; ++_i) { dst[2 * _i] = __builtin_bit_cast(float, _t[_i] << 16); dst[2 * _i + 1] = __builtin_bit_cast(float, _t[_i] & 0xffff0000u); } } while (0)
#define CV8BF(dst, _t) do { _Pragma("unroll") for (int _i = 0; _i < 4; ++_i) { dst[2 * _i] = __builtin_bit_cast(float, _t[_i] << 16); dst[2 * _i + 1] = __builtin_bit_cast(float, _t[_i] & 0xffff0000u); } } while (0)
#define MLOAD(P, gi) do { const size_t _o = (size_t)(gi) * 512 + c0; \
        P##y = *(const u32x4*)(YS + _o); P##z = *(const u32x4*)(YS + FS + _o); \
        P##r = *(const u32x4*)(RB + _o); P##k = *(const u32x4*)(KS + _o); P##v = *(const u32x4*)(VS + _o); P##a0 = *(const u32x4*)(AB + _o); P##a1 = *(const u32x4*)(AB + FS + _o); P##g = *(const u32x4*)(GB + _o); \
        P##p = *(const u32x4*)(OP + _o); P##q = *(const u32x4*)(OP + FS + _o); } while (0)
    const int gstep = nb * NWAVES;
    int g = row_lo + bid * NWAVES + wid;
    u32x4 c_y, c_z, c_p, c_q, c_r, c_k, c_v, c_a0, c_a1, c_g;
    if (g < NTOK) MLOAD(c_, g);
    for (; g < NTOK; g += gstep) {
        u32x4 n_y, n_z, n_p, n_q, n_r, n_k, n_v, n_a0, n_a1, n_g;
        { const int gn = (g + gstep < NTOK) ? g + gstep : g; MLOAD(n_, gn); }
        float y[8], r_[8], k_[8], v_[8], a0[8], a1[8], gg[8];
        { float yb[8]; CV8BF(y, c_y); CV8BF(yb, c_z);
#pragma unroll
          for (int i = 0; i < 8; ++i) y[i] += yb[i]; }
        CV8BF(r_, c_r); CV8BF(k_, c_k); CV8BF(v_, c_v); CV8BF(a0, c_a0); CV8BF(a1, c_a1); CV8BF(gg, c_g);
        float sy = 0.f, sb = 0.f;
#pragma unroll
        for (int i = 0; i < 8; ++i) { sy += y[i]; sb += r_[i] * k_[i] * (2.0f + (a0[i] + a1[i] - 2.0f) * kaw[i]) * rkw[i]; }
        sy += __shfl_xor(sy, 1); sy += __shfl_xor(sy, 2); sy += __shfl_xor(sy, 4);
        sb += __shfl_xor(sb, 1); sb += __shfl_xor(sb, 2); sb += __shfl_xor(sb, 4);
        const float mu = sy * (1.0f / 64.0f);
        float sv = 0.f;
#pragma unroll
        for (int i = 0; i < 8; ++i) { y[i] -= mu; sv += y[i] * y[i]; }
        sv += __shfl_xor(sv, 1); sv += __shfl_xor(sv, 2); sv += __shfl_xor(sv, 4);
        const float rstd = rsqrtf(sv * (1.0f / 64.0f) + 64e-5f);
        float ya[8];
#pragma unroll
        for (int i = 0; i < 8; ++i) ya[i] = (y[i] * rstd * gnw[i] + gnb[i] + sb * v_[i]) * gg[i];
        { u32x4 w; w.x = pk2(ya[0], ya[1]); w.y = pk2(ya[2], ya[3]); w.z = pk2(ya[4], ya[5]); w.w = pk2(ya[6], ya[7]); *(u32x4*)(CAT + (size_t)g * DM + c0) = w; }
        float od[8];
        { float ob[8]; CV8BF(od, c_p); CV8BF(ob, c_q);
#pragma unroll
          for (int i = 0; i < 8; ++i) od[i] -= lam * ob[i]; }
        float so = 0.f;
#pragma unroll
        for (int i = 0; i < 8; ++i) so += od[i] * od[i];
        so += __shfl_xor(so, 1); so += __shfl_xor(so, 2); so += __shfl_xor(so, 4); so += __shfl_xor(so, 8);
        const float ro = rsqrtf(so * (1.0f / 128.0f) + 1e-6f);
        { u32x4 w; w.x = pk2(od[0] * ro * sub[0], od[1] * ro * sub[1]); w.y = pk2(od[2] * ro * sub[2], od[3] * ro * sub[3]);
          w.z = pk2(od[4] * ro * sub[4], od[5] * ro * sub[5]); w.w = pk2(od[6] * ro * sub[6], od[7] * ro * sub[7]); *(u32x4*)(CAT + (size_t)g * DM + 512 + c0) = w; }
        c_y = n_y; c_z = n_z; c_p = n_p; c_q = n_q;
        c_r = n_r; c_k = n_k; c_v = n_v; c_a0 = n_a0; c_a1 = n_a1; c_g = n_g;
    }
#undef MLOAD
#undef CV8BF
#undef LD8BF
}

__device__ __forceinline__ void ph_gemm_out(const Args& A, int l, size_t x_off, size_t wt_off, int row_lo, LAS unsigned char* lds, int bid, int nb) {
    unsigned char* ws = opq(A.ws); const float* const* IN = (const float* const*)(ws + WS_PTRS); (void)IN;
    pg8::Gemm g{(const bf16_t*)(ws + x_off) + (size_t)row_lo * DM, (const bf16_t*)(ws + wt_off), NTOK - row_lo, DM, DM};
    const ListOrder S = build_units(lds, (NTOK - row_lo) / 256, DM / 256, nb, bid, nullptr, 0);
    EpiResidual E{(bf16_t*)(ws + WS_H) + (size_t)row_lo * DM, (const float*)(ws + WS_MOD) + (size_t)l * 17 * 6144 + 2 * 1024, row_lo};
    pg8::gemm_phase<EpiResidual, ListOrder, true, true>(lds, g, S, E);
}

__device__ __forceinline__ void ph_gemm_sgin(const Args& A, int j, int row_lo, LAS unsigned char* lds, int bid, int nb) {
    unsigned char* ws = opq(A.ws); const float* const* IN = (const float* const*)(ws + WS_PTRS); (void)IN;
    pg8::Gemm g{(const bf16_t*)(ws + WS_ABF) + (size_t)row_lo * DM, (const bf16_t*)(ws + WS_SGIN) + (size_t)j * 2048 * DM, NTOK - row_lo, 2048, DM};
    const ListOrder S = build_units(lds, (NTOK - row_lo) / 256, 2048 / 256, nb, bid, nullptr, 0);
    EpiGeluBf16 E{(bf16_t*)(ws + WS_Z2) + (size_t)row_lo * 2048, 2048, INP(I_SGBIN) + j * 2048};
    pg8::gemm_phase<EpiGeluBf16, ListOrder, true, true>(lds, g, S, E);
}
__device__ __forceinline__ void ph_sgu_stats(const Args& A, int row_lo, int bid, int nb) {
    unsigned char* ws = opq(A.ws);
    const int tid = tid_opaque(), lane = tid & 63, wid = tid >> 6;
    const bf16_t* Z2 = (const bf16_t*)(ws + WS_Z2); float* ST = (float*)(ws + WS_VST);
    for (int row = row_lo + bid * NWAVES + wid; row < NTOK; row += nb * NWAVES) {
        const u32x4 t0 = *(const u32x4*)(Z2 + (size_t)row * 2048 + 1024 + lane * 8), t1 = *(const u32x4*)(Z2 + (size_t)row * 2048 + 1536 + lane * 8);
        float v[16]; float s = 0.f;
#pragma unroll
        for (int i = 0; i < 4; ++i) { v[2 * i] = __builtin_bit_cast(float, t0[i] << 16); v[2 * i + 1] = __builtin_bit_cast(float, t0[i] & 0xffff0000u);
            v[8 + 2 * i] = __builtin_bit_cast(float, t1[i] << 16); v[9 + 2 * i] = __builtin_bit_cast(float, t1[i] & 0xffff0000u); }
#pragma unroll
        for (int i = 0; i < 16; ++i) s += v[i];
        const float mean = wave_sum(s) * (1.0f / 1024.0f); float s2 = 0.f;
#pragma unroll
        for (int i = 0; i < 16; ++i) { const float d = v[i] - mean; s2 += d * d; }
        const float rstd = rsqrtf(wave_sum(s2) * (1.0f / 1024.0f) + 1e-5f);
        if (lane == 0) { ST[(size_t)row * 2] = mean; ST[(size_t)row * 2 + 1] = rstd; }
    }
}
__device__ __forceinline__ void ph_sgu_spatial(const Args& A, int j, int row_lo, LAS unsigned char* lds, int bid, int nb) {
    unsigned char* ws = opq(A.ws); const float* const* IN = (const float* const*)(ws + WS_PTRS);
    const int tid = tid_opaque(), lane = tid & 63, wid = tid >> 6, c16 = lane & 15, g4 = lane >> 4;
    const bf16_t* Z2 = (const bf16_t*)(ws + WS_Z2); const float* ST = (const float*)(ws + WS_VST); bf16_t* G = (bf16_t*)(ws + WS_G);
    constexpr int VS = 272;
    LAS unsigned char* vt = lds;
    LAS float* stl = (LAS float*)(lds + 36864);
    const int ch0 = row_lo / 128, nch = NTOK / 128 - ch0;
    for (int u = bid; u < nch * 8; u += nb) {
        const int ci = ch0 + u / 8, g = u % 8;
        const size_t r0 = (size_t)ci * 128;
        __syncthreads();
#pragma unroll
        for (int i = 0; i < 4; ++i) {
            const int idx = tid + NTHREADS * i, q = idx >> 4, jc = idx & 15;
            const u32x4 t = *(const u32x4*)(Z2 + (r0 + q) * 2048 + 1024 + g * 128 + jc * 8);
#pragma unroll
            for (int e = 0; e < 4; ++e) {
                const int c = jc * 8 + 2 * e, w = c & 31, rho = 16 * (2 * (c >> 5) + ((w >> 2) & 1)) + 4 * (w >> 3) + (w & 3);
                *(LAS bf16_t*)(vt + rho * VS + q * 2) = (bf16_t)(t[e] & 0xffffu); *(LAS bf16_t*)(vt + (rho + 1) * VS + q * 2) = (bf16_t)(t[e] >> 16); }
        }
        if (tid < 256) stl[tid] = ST[r0 * 2 + tid];
        __syncthreads();
        const float* wrow = INP(I_SGWS) + (((size_t)j * 8 + g) * 128 + 16 * wid + c16) * 128;
        bf16x8 af[4]; float wm = 0.f, rs = 0.f;
#pragma unroll
        for (int ks = 0; ks < 4; ++ks) {
            const int q0 = 32 * ks + 8 * g4;
            const f32x4 w0 = *(const f32x4*)(wrow + q0), w1 = *(const f32x4*)(wrow + q0 + 4);
            float wv[8] = {w0[0], w0[1], w0[2], w0[3], w1[0], w1[1], w1[2], w1[3]};
#pragma unroll
            for (int e = 0; e < 8; ++e) { rs += wv[e]; wv[e] *= stl[(q0 + e) * 2 + 1]; wm += wv[e] * stl[(q0 + e) * 2]; }
            const u32x4 pk = {pk2(wv[0], wv[1]), pk2(wv[2], wv[3]), pk2(wv[4], wv[5]), pk2(wv[6], wv[7])};
            af[ks] = __builtin_bit_cast(bf16x8, pk);
        }
        wm += __shfl_xor(wm, 16); wm += __shfl_xor(wm, 32); rs += __shfl_xor(rs, 16); rs += __shfl_xor(rs, 32);
        f32x4 acc[8];
#pragma unroll
        for (int nt = 0; nt < 8; ++nt) acc[nt] = (f32x4){0.f, 0.f, 0.f, 0.f};
#pragma unroll
        for (int ks = 0; ks < 4; ++ks)
#pragma unroll
            for (int nt = 0; nt < 8; ++nt) {
                const bf16x8 bfr = *(const LAS bf16x8*)(vt + (16 * nt + c16) * VS + (32 * ks + 8 * g4) * 2);
                acc[nt] = __builtin_amdgcn_mfma_f32_16x16x32_bf16(bfr, af[ks], acc[nt], 0, 0, 0);
            }
        const float bs = INP(I_SGBS)[((size_t)j * 8 + g) * 128 + 16 * wid + c16];
        const size_t row = r0 + 16 * wid + c16;
#pragma unroll
        for (int k = 0; k < 4; ++k) {
            const int c = g * 128 + 32 * k + 8 * g4;
            const f32x4 lg0 = *(const f32x4*)(INP(I_SGLNG) + j * 1024 + c), lg1 = *(const f32x4*)(INP(I_SGLNG) + j * 1024 + c + 4), lb0 = *(const f32x4*)(INP(I_SGLNB) + j * 1024 + c), lb1 = *(const f32x4*)(INP(I_SGLNB) + j * 1024 + c + 4);
            const u32x4 uu = *(const u32x4*)(Z2 + row * 2048 + c);
            const f32x4 s0 = lg0 * (acc[2 * k] - wm) + lb0 * rs + bs, s1 = lg1 * (acc[2 * k + 1] - wm) + lb1 * rs + bs;
            u32x4 o;
            o.x = cvtpk_s(bflo(uu.x) * s0[0], bfhi(uu.x) * s0[1]); o.y = cvtpk_s(bflo(uu.y) * s0[2], bfhi(uu.y) * s0[3]);
            o.z = cvtpk_s(bflo(uu.z) * s1[0], bfhi(uu.z) * s1[1]); o.w = cvtpk_s(bflo(uu.w) * s1[2], bfhi(uu.w) * s1[3]);
            *(u32x4*)(G + row * DM + c) = o;
        }
    }
}

__device__ __forceinline__ int moe_layout(const Args& A, int l, int bid, int nb, LAS int* off  , LAS int* cntl  , LAS int* tile_e  , LAS int* base  ) {
    const int tid = tid_opaque();
    const int* bc = (const int*)(opq(A.ws) + WS_BCNT) + (size_t)l * 256 * 32;
    if (tid < 64) {
        int n = 0, pre = 0;
        if (tid < 32) {
#pragma unroll 8
            for (int b = 0; b < nb; ++b) { const int c = bc[b * 32 + tid]; n += c; pre += (b < bid) ? c : 0; }
        }
        const int nt = (n + 255) >> 8;
        int x = nt;
#pragma unroll
        for (int o = 1; o < 32; o <<= 1) { const int y = __shfl_up(x, o); if (tid >= o) x += y; }
        const int start = x - nt;
        if (tid < 32) {
            cntl[tid] = n; off[tid] = start * 256; base[tid] = start * 256 + pre;
#pragma unroll 1
            for (int t = 0; t < nt; ++t) tile_e[start + t] = tid;
        }
        if (tid == 31) off[32] = x * 256;
    }
    __syncthreads();
    return off[32] >> 8;
}
__device__ __forceinline__ void ph_moe_scatter(const Args& A, int l, int row_lo, LAS unsigned char* lds, int bid, int nb) {
    unsigned char* ws = opq(A.ws);
    const int tid = tid_opaque();
    LAS int* off = (LAS int*)(lds + LDS_TAB); LAS int* cntl = off + 64; LAS int* tile_e = off + 128; LAS int* base = off + 800;
    moe_layout(A, l, bid, nb, off, cntl, tile_e, base);
    const int* te = (const int*)(ws + WS_TOKE); const int* tr = (const int*)(ws + WS_TOKR); int* rowof = (int*)(ws + WS_ROWOF); int* srcrow = (int*)(ws + WS_SRCROW);
    const int ngroups = (NTOK - row_lo) / 16, per = nb * NWAVES;
    const int nmine = (ngroups - bid * NWAVES + per - 1) / per * NWAVES;
    for (int q = tid; q < nmine * 64; q += NTHREADS) {
        const int slot = q >> 6, r = (q >> 2) & 15, k = q & 3, i = slot >> 3, w = slot & 7;
        const int u = i * per + bid * NWAVES + w;
        if (u < ngroups) {
            const int row = row_lo + 16 * u + r;
            const int e = te[(size_t)row * 4 + k];
            const int pos = base[e] + tr[(size_t)row * 4 + k];
            rowof[(size_t)row * 4 + k] = pos; srcrow[pos] = row;
        }
    }
    for (int e = bid; e < 32; e += nb) {
        const int r0 = off[e] + cntl[e], r1 = off[e + 1];
        for (int i = r0 + tid; i < r1; i += NTHREADS) srcrow[i] = NCTX;
    }
}
__device__ __forceinline__ void ph_moe_gemm1(const Args& A, int l, LAS unsigned char* lds, int bid, int nb) {
    unsigned char* ws = opq(A.ws); const float* const* IN = (const float* const*)(ws + WS_PTRS); (void)IN;
    LAS int* off = (LAS int*)(lds + LDS_TAB); LAS int* cntl = off + 64; LAS int* tile_e = off + 128; LAS int* base = off + 800;
    const int T = moe_layout(A, l, bid, nb, off, cntl, tile_e, base);
    int Kq = DM / 2; asm volatile("" : "+s"(Kq));
    pg8::Gemm g{(const bf16_t*)(ws + WS_ABF), (const bf16_t*)(ws + WS_W1 + (size_t)l * NE * 2048 * DM), T * 256, 2048, Kq};
    const ListOrder S = build_units(lds, T, 8, nb, bid, tile_e, 8);
    { LAS unsigned* rowtab = (LAS unsigned*)(lds + LDS_ROWTAB); const int* srcrow = (const int*)(ws + WS_SRCROW); const int tid = tid_opaque();
      for (int q = tid; q < S.n * 256; q += NTHREADS) rowtab[q] = (unsigned)srcrow[S.list[2 * (q >> 8)] * 256 + (q & 255)] * (unsigned)DM;
      __syncthreads(); }
    EpiMoe1 E{(bf16_t*)(ws + WS_ACT), INP(I_B1) + (size_t)l * NE * 2048};
    pg8::gemm_phase<EpiMoe1, ListOrder, true, true, true, true>(lds, g, S, E);
}
__device__ __forceinline__ void ph_moe_gemm2(const Args& A, int l, LAS unsigned char* lds, int bid, int nb) {
    unsigned char* ws = opq(A.ws); const float* const* IN = (const float* const*)(ws + WS_PTRS); (void)IN;
    LAS int* off = (LAS int*)(lds + LDS_TAB); LAS int* cntl = off + 64; LAS int* tile_e = off + 128; LAS int* base = off + 800;
    const int T = moe_layout(A, l, bid, nb, off, cntl, tile_e, base);
    int Kq = DM / 2; asm volatile("" : "+s"(Kq));
    pg8::Gemm g{(const bf16_t*)(ws + WS_ACT), (const bf16_t*)(ws + WS_W2 + (size_t)l * NE * DM * DM), T * 256, DM, Kq, 0x77777777, 0x7d7d7d7d};
    const ListOrder S = build_units(lds, T, 4, nb, bid, tile_e, 4);
    LAS float* btab = (LAS float*)(lds + LDS_ROWTAB);
    { const float* b2 = INP(I_B2) + (size_t)l * NE * DM; const int tid = tid_opaque();
      for (int q = tid; q < S.n * 256; q += NTHREADS) { const int png = S.list[2 * (q >> 8) + 1]; btab[q] = b2[(size_t)(png >> 2) * DM + (png & 3) * 256 + (q & 255)]; }
      __syncthreads(); }
    EpiMoe2 E{ws + WS_YM, btab};
    pg8::gemm_phase<EpiMoe2, ListOrder, true, true, false, true, true>(lds, g, S, E);
}
__device__ __forceinline__ void ph_moe_combine(const Args& A, int l, int row_lo, bool last, int bid, int nb, bool dry = false) {
    unsigned char* ws = opq(A.ws); const float* const* IN = (const float* const*)(ws + WS_PTRS);
    const int tid = tid_opaque(), lane = tid & 63, wid = tid >> 6;
    bf16_t* H = (bf16_t*)(ws + WS_H); const float* mod = (const float*)(ws + WS_MOD); const bf16_t* YM = (const bf16_t*)(ws + WS_YM);
    bf16_t* Hw = dry ? (bf16_t*)(ws + WS_XP) : H;
    const int* rowof = (const int*)(ws + WS_ROWOF); const float* tg = (const float*)(ws + WS_TOKG);
    bf16_t* abf = dry ? (bf16_t*)(ws + WS_XP + (size_t)NTOK * DM * 4) : (bf16_t*)(ws + WS_ABF);
    const int ln = last ? l : l + 1;
    const float* gp = INP(I_N1G) + ln * 1024;
    for (int row = row_lo + bid * NWAVES + wid; row < NTOK; row += nb * NWAVES) {
        const Tok tk = tokinfo(row);
        const float* gate = mod + ((size_t)l * 17 + tk.modrow) * 6144 + 5 * 1024;
        int r[4]; float gk[4];
#pragma unroll
        for (int k = 0; k < 4; ++k) { r[k] = rowof[(size_t)row * 4 + k]; gk[k] = tg[(size_t)row * 4 + k]; }
        const unsigned char* YM8 = (const unsigned char*)YM;
        u32x4 y[4];
#pragma unroll
        for (int k = 0; k < 4; ++k) { y[k] = *(const u32x4*)(YM8 + (size_t)r[k] * DM + lane * 16); gk[k] *= (1.0f / 16.0f); }
        const int col = lane * 16;
        f32x4 hv[4]; float ss = 0.f;
        const u32x4 hb0 = *(const u32x4*)(H + (size_t)row * DM + col), hb1 = *(const u32x4*)(H + (size_t)row * DM + col + 8);
#pragma unroll
        for (int q = 0; q < 4; ++q) {
            f32x4 m = (f32x4){0.f, 0.f, 0.f, 0.f};
#pragma unroll
            for (int k = 0; k < 4; ++k) { const auto lo2 = __builtin_amdgcn_cvt_pk_f32_fp8((int)y[k][q], false), hi2 = __builtin_amdgcn_cvt_pk_f32_fp8((int)y[k][q], true);
                m = m + (f32x4){lo2[0], lo2[1], hi2[0], hi2[1]} * gk[k]; }
            { const unsigned h0 = (q >> 1) ? hb1[2 * (q & 1)] : hb0[2 * (q & 1)], h1 = (q >> 1) ? hb1[2 * (q & 1) + 1] : hb0[2 * (q & 1) + 1];
              hv[q] = (f32x4){bflo(h0), bfhi(h0), bflo(h1), bfhi(h1)} + *(const f32x4*)(gate + col + 4 * q) * m; }
            if (last && !dry) *(f32x4*)(as_global(((float* const*)IN)[38]) + (size_t)(row - NCTX) * DM + col + 4 * q) = hv[q];
            ss += (hv[q].x * hv[q].x + hv[q].y * hv[q].y) + (hv[q].z * hv[q].z + hv[q].w * hv[q].w);
        }
        if (!last || dry) { *(u32x4*)(Hw + (size_t)row * DM + col) = (u32x4){pk2(hv[0].x, hv[0].y), pk2(hv[0].z, hv[0].w), pk2(hv[1].x, hv[1].y), pk2(hv[1].z, hv[1].w)};
                            *(u32x4*)(Hw + (size_t)row * DM + col + 8) = (u32x4){pk2(hv[2].x, hv[2].y), pk2(hv[2].z, hv[2].w), pk2(hv[3].x, hv[3].y), pk2(hv[3].z, hv[3].w)}; }
        if (!last) {
            const float rstd = rsqrtf(wave_sum(ss) * (1.0f / DM) + 1e-6f);
            const float* mrow = mod + ((size_t)ln * 17 + tk.modrow) * 6144;
            u32x4 o[2];
#pragma unroll
            for (int q = 0; q < 4; ++q) {
                const f32x4 g = *(const f32x4*)(gp + col + 4 * q), sc = *(const f32x4*)(mrow + 1024 + col + 4 * q), sh = *(const f32x4*)(mrow + col + 4 * q);
                const f32x4 v = (hv[q] * rstd * g) * (sc + 1.0f) + sh;
                o[q >> 1][2 * (q & 1)] = pk2(v.x, v.y); o[q >> 1][2 * (q & 1) + 1] = pk2(v.z, v.w);
            }
            *(u32x4*)(abf + (size_t)row * DM + col) = o[0]; *(u32x4*)(abf + (size_t)row * DM + col + 8) = o[1];
        }
    }
}

__global__ void __launch_bounds__(NTHREADS, 2) fwd_kernel(Args A) {
    extern __shared__ __attribute__((aligned(16))) unsigned char lds_raw[];
    LAS unsigned char* lds = (LAS unsigned char*)lds_raw;
    volatile LAS unsigned* misc = (volatile LAS unsigned*)(lds + LDS_MISC);
    const int tid = threadIdx.x, bid = blockIdx.x, nb = gridDim.x;
    if (tid < 64) misc[tid] = 0u;
    __syncthreads();
    XcdBarrier bar = xcd_barrier_post((unsigned*)(A.ws + WS_CTL) + CW_BAR, misc + 8);
    const int lo = A.ph_lo, hi = A.ph_hi;
    int pc = 0;
#ifndef PHSEL
#define PHSEL -1
#endif
#define SEL(k) (PHSEL < 0 || PHSEL == (k))
#ifndef REPEAT_MASK
#define REPEAT_MASK 0
#endif
#define RUN(k, call) do { if (SEL(k)) { call; if ((REPEAT_MASK >> (k)) & 1) { xcd_barrier(bar); call; } } } while (0)
#define PH_BEGIN if (pc >= lo && pc < hi) {
#define PH_END } if (pc >= lo && pc + 1 < hi) xcd_barrier(bar); ++pc;

    PH_BEGIN RUN(0, ph_prologue(A, lds, bid, nb)); PH_END

    for (int l = 0; l < 4; ++l) {
        const int j = l >> 1;
        const bool ctx_out = (l < 2), ctx_in = (l < 3);
        const int rin = ctx_in ? 0 : NCTX, rout = ctx_out ? 0 : NCTX;
        if (l == 0) { PH_BEGIN RUN(1, ph_norm<false>(A, l, rin, lds, bid, nb)); PH_END }
        if ((l & 1) == 0) {
            PH_BEGIN RUN(2, ph_gemm_win(A, j, rin, lds, bid, nb)); PH_END
            PH_BEGIN RUN(3, ph_rwkv_pre(A, j, rin, bid, nb)); PH_END
            PH_BEGIN RUN(19, ph_gemm_lora(A, j, rin, lds, bid, nb)); PH_END
            PH_BEGIN RUN(5, ph_wkv_fused(A, j, rin, lds, bid, nb)); PH_END
            PH_BEGIN RUN(6, ph_attn(A, ctx_out, lds, bid, nb)); PH_END
            PH_BEGIN RUN(7, ph_merge(A, l, rout, bid, nb)); PH_END
            PH_BEGIN RUN(8, ph_gemm_out(A, l, WS_CAT, WS_WOUT + (size_t)j * DM * DM * 2, rout, lds, bid, nb)); PH_END
        } else {
            PH_BEGIN RUN(9, ph_gemm_sgin(A, j, rin, lds, bid, nb)); PH_END
            PH_BEGIN RUN(10, ph_sgu_stats(A, rin, bid, nb)); PH_END
            PH_BEGIN RUN(11, ph_sgu_spatial(A, j, rout, lds, bid, nb)); PH_END
            PH_BEGIN RUN(12, ph_gemm_out(A, l, WS_G, WS_SGOUT + (size_t)j * DM * DM * 2, rout, lds, bid, nb)); PH_END
        }
        PH_BEGIN RUN(13, ph_norm2_router(A, l, rout, lds, bid, nb)); PH_END
        PH_BEGIN RUN(14, ph_moe_scatter(A, l, rout, lds, bid, nb)); PH_END
        PH_BEGIN RUN(15, ph_moe_gemm1(A, l, lds, bid, nb)); PH_END
        PH_BEGIN RUN(16, ph_moe_gemm2(A, l, lds, bid, nb)); PH_END
        PH_BEGIN if (SEL(17)) { if ((REPEAT_MASK >> 17) & 1) { ph_moe_combine(A, l, rout, l == 3, bid, nb, true); xcd_barrier(bar); } ph_moe_combine(A, l, rout, l == 3, bid, nb); } PH_END
    }
}

extern "C" void kernel_launch(void* const* d_in, const int* in_sizes, int n_in, void* d_out, int out_size, void* d_ws, size_t ws_size, hipStream_t stream) {
    static int grid = 0;
    if (grid == 0) {
        if (n_in != 38 || out_size != NLAT * DM || ws_size < WS_END) { fprintf(stderr, "kernel_launch: unexpected shapes: n_in %d out %d ws %zu (need %zu)\n", n_in, out_size, ws_size, (size_t)WS_END); grid = -1; return; }
        int dev = 0, cus = 0, per_cu = 0;
        if (hipGetDevice(&dev) != hipSuccess || hipDeviceGetAttribute(&cus, hipDeviceAttributeMultiprocessorCount, dev) != hipSuccess) { grid = -1; return; }
        if (hipFuncSetAttribute((const void*)fwd_kernel, hipFuncAttributeMaxDynamicSharedMemorySize, LDS_BYTES) != hipSuccess) { fprintf(stderr, "kernel_launch: hipFuncSetAttribute failed\n"); grid = -1; return; }
        if (hipOccupancyMaxActiveBlocksPerMultiprocessor(&per_cu, (const void*)fwd_kernel, NTHREADS, LDS_BYTES) != hipSuccess || per_cu < 1)
            fprintf(stderr, "kernel_launch: occupancy query reports %d workgroups per CU\n", per_cu);
        (void)hipGetLastError();
        grid = cus;
    }
    if (grid < 0) return;
    if (hipMemsetAsync((char*)d_ws + WS_CTL, 0, CTL_ZERO_BYTES, stream) != hipSuccess) { fprintf(stderr, "kernel_launch: memset failed\n"); return; }
    Args a{};
    for (int i = 0; i < 38; ++i) a.in[i] = (const float*)d_in[i];
    a.out = (float*)d_out; a.ws = (unsigned char*)d_ws; a.ph_lo = 0; a.ph_hi = 1 << 20;
    hipLaunchKernelGGL(fwd_kernel, dim3(grid), dim3(NTHREADS), LDS_BYTES, stream, a);
    const hipError_t le = hipPeekAtLastError();
    if (le != hipSuccess) fprintf(stderr, "kernel_launch: launch failed: %s\n", hipGetErrorName(le));
}
```

```cpp
#include <hip/hip_runtime.h>
#include <cstdio>
#include <cstdint>

#define LAS __attribute__((address_space(3)))
typedef unsigned short bf16_t;
typedef short bf16x8 __attribute__((ext_vector_type(8)));
typedef float f32x4 __attribute__((ext_vector_type(4)));
typedef unsigned u32x4 __attribute__((ext_vector_type(4)));
typedef unsigned u32x2 __attribute__((ext_vector_type(2)));

constexpr int DM = 1024, NB = 16, TL = 2048, TC = 256;
constexpr int NCTX = NB * TC, NLAT = NB * TL, NTOK = NCTX + NLAT;
constexpr int RWC = 1920, EVC = 3456, ZLD = 3584;
constexpr int NE = 32;
constexpr int XPROWS = NTOK * 4 + NE * 256;
constexpr int NTHREADS = 512, NWAVES = 8;

constexpr size_t MiB = 1u << 20;
constexpr size_t al256(size_t x) { return (x + 255) & ~(size_t)255; }
constexpr size_t WS_CTL = 0, CTL_ZERO_BYTES = 1 * MiB - 4096;
constexpr size_t WS_PTRS = 1 * MiB - 4096;
constexpr size_t WS_MOD = 1 * MiB;
constexpr size_t WS_RTWT = al256(WS_MOD + (size_t)4 * 17 * 6144 * 4);
constexpr size_t WS_WIN = al256(WS_RTWT + (size_t)4 * 32 * 1024 * 4);
constexpr size_t WS_WOUT = al256(WS_WIN + (size_t)2 * ZLD * DM * 2);
constexpr size_t WS_SGIN = al256(WS_WOUT + (size_t)2 * DM * DM * 2);
constexpr size_t WS_SGOUT = al256(WS_SGIN + (size_t)2 * 2048 * DM * 2);
constexpr int LORA_N = 2560, LORA_K = 384;
constexpr size_t WS_WLORA = al256(WS_SGOUT + (size_t)2 * DM * DM * 2);
constexpr size_t WS_LBIAS = al256(WS_WLORA + (size_t)2 * LORA_N * LORA_K * 2);
constexpr size_t WS_W1 = al256(WS_LBIAS + (size_t)2 * LORA_N * 4);
constexpr size_t WS_W2 = al256(WS_W1 + (size_t)4 * NE * 2048 * DM * 2);
constexpr size_t WS_H = al256(WS_W2 + (size_t)4 * NE * DM * DM * 2);
constexpr size_t WS_ABF = al256(WS_H + (size_t)NTOK * DM * 4);
constexpr size_t WS_TOKE = al256(WS_ABF + (size_t)NTOK * DM * 2);
constexpr size_t WS_TOKG = al256(WS_TOKE + (size_t)NTOK * 4 * 4);
constexpr size_t WS_ROWOF = al256(WS_TOKG + (size_t)NTOK * 4 * 4);
constexpr size_t WS_TOKR = al256(WS_ROWOF + (size_t)NTOK * 4 * 4);
constexpr size_t WS_BCNT = al256(WS_TOKR + (size_t)NTOK * 4 * 4);
constexpr size_t WS_SRCROW = al256(WS_BCNT + (size_t)4 * 256 * 32 * 4);
constexpr size_t WS_R = al256(WS_SRCROW + (size_t)XPROWS * 4);
constexpr size_t FSZ = (size_t)NTOK * 512 * 4;
constexpr size_t WS_Z = WS_R;
constexpr size_t HSZ = (size_t)NTOK * 512 * 2;
constexpr size_t WS_RB = al256(WS_Z + (size_t)NTOK * ZLD * 2);
constexpr size_t WS_KS = WS_RB + HSZ, WS_VS = WS_KS + HSZ, WS_KKN = WS_VS + HSZ;
constexpr size_t WS_LIN = WS_KKN + HSZ;
constexpr size_t WS_LO = al256(WS_LIN + (size_t)NTOK * 384 * 2);
constexpr size_t WS_AB = WS_LO + 2 * HSZ;
constexpr size_t WS_GB = WS_LO + 4 * HSZ;
constexpr size_t WS_YS = WS_LO + 5 * HSZ;
constexpr size_t WS_QB = WS_YS + 2 * FSZ;
constexpr size_t WS_KB = WS_QB + FSZ / 2;
constexpr size_t WS_VB = WS_KB + FSZ / 2;
constexpr size_t WS_OP = WS_VB + FSZ / 2;
constexpr size_t WS_CAT = WS_OP + 2 * FSZ;
constexpr int WKV_REC = 12288, WKV_NCH = (TC + TL) / 16;
constexpr size_t WS_WKV = al256(WS_CAT + (size_t)NTOK * DM * 2);
constexpr size_t WS_EVEN_END = WS_WKV + (size_t)256 * WKV_NCH * WKV_REC;
constexpr size_t WS_Z2 = WS_R;
constexpr size_t WS_VST = al256(WS_Z2 + (size_t)NTOK * 2048 * 2);
constexpr size_t WS_G = al256(WS_VST + (size_t)NTOK * 2 * 4);
constexpr size_t WS_ODD_END = WS_G + (size_t)NTOK * DM * 2;
constexpr size_t WS_XP = WS_R;
constexpr size_t WS_ACT = al256(WS_XP + (size_t)XPROWS * DM * 2);
constexpr size_t WS_YM = al256(WS_ACT + (size_t)XPROWS * DM * 2);
constexpr size_t WS_MOE_END = WS_YM + (size_t)XPROWS * DM * 2;
constexpr size_t WS_END = (WS_EVEN_END > WS_MOE_END ? (WS_EVEN_END > WS_ODD_END ? WS_EVEN_END : WS_ODD_END) : (WS_MOE_END > WS_ODD_END ? WS_MOE_END : WS_ODD_END));

constexpr int CW_BAR = 4096;
constexpr int CW_CNT = 16384;
constexpr int CW_CUR = 16384 + 256;

constexpr int LDS_BYTES = 163840;
constexpr int LDS_MISC = 160 * 1024 - 256;

__device__ __forceinline__ unsigned f2bf(float f) { unsigned u = __builtin_bit_cast(unsigned, f); return (u + 0x7fffu + ((u >> 16) & 1u)) >> 16; }
typedef float f32x2_t __attribute__((ext_vector_type(2))); typedef __bf16 bf16x2_t __attribute__((ext_vector_type(2)));
__device__ __forceinline__ unsigned pk2(float lo, float hi) { f32x2_t v = {lo, hi}; bf16x2_t b = __builtin_convertvector(v, bf16x2_t); return __builtin_bit_cast(unsigned, b); }
__device__ __forceinline__ unsigned cvtpk_s(float lo, float hi) { f32x2_t v = {lo, hi}; bf16x2_t b = __builtin_convertvector(v, bf16x2_t); return __builtin_bit_cast(unsigned, b); }
__device__ __forceinline__ float bf2f(bf16_t b) { return __builtin_bit_cast(float, (unsigned)b << 16); }
__device__ __forceinline__ float bflo(unsigned p) { return __builtin_bit_cast(float, p << 16); }
__device__ __forceinline__ float bfhi(unsigned p) { return __builtin_bit_cast(float, p & 0xffff0000u); }
__device__ __forceinline__ float wave_sum(float v) {
#pragma unroll
    for (int o = 1; o < 64; o <<= 1) v += __shfl_xor(v, o);
    return v;
}
__device__ __forceinline__ int tid_opaque() { int t = threadIdx.x; asm volatile("" : "+v"(t)); return t; }
#define GAS __attribute__((address_space(1)))
template <class T> __device__ __forceinline__ T* as_global(T* p) { return (T*)(GAS T*)p; }
__device__ __forceinline__ unsigned char* opq(unsigned char* p) { GAS unsigned char* g = (GAS unsigned char*)p; asm volatile("" : "+s"(g)); return (unsigned char*)g; }
__device__ __forceinline__ float rdl(float v, int k) { return __builtin_bit_cast(float, __builtin_amdgcn_readlane(__builtin_bit_cast(int, v), k)); }
__device__ __forceinline__ float sigmoidf_(float x) { return 1.0f / (1.0f + __expf(-x)); }

#define XB_TMO      128
#define XB_XCNT(j)  (256  + 64 * (j))
#define XB_XSUB(j)  (1280 + 64 * (j))
#define XB_XGEN(j)  (2304 + 64 * (j))
#define XB_TOP      3328
#define XB_TOPGEN   3392
#define XCD_BAR_WORDS 3456
#define XB_SPIN_CAP (1u << 22)
__device__ __forceinline__ unsigned xb_ld(unsigned* p)              { return __hip_atomic_load(p, __ATOMIC_RELAXED, __HIP_MEMORY_SCOPE_AGENT); }
__device__ __forceinline__ unsigned xb_add(unsigned* p, unsigned v) { return __hip_atomic_fetch_add(p, v, __ATOMIC_RELAXED, __HIP_MEMORY_SCOPE_AGENT); }
__device__ __forceinline__ unsigned xb_xcc_id() { return (unsigned)__builtin_amdgcn_s_getreg((3 << 11) | 20) & 0xFu; }
#define XB_SPIN(cond, bar) do { unsigned _sp = 0; while (cond) { __builtin_amdgcn_s_sleep(1); \
    if ((++_sp & 255u) == 0u) { if (xb_ld(&(bar)[XB_TMO])) break; if (_sp > XB_SPIN_CAP) { atomicAdd(&(bar)[XB_TMO], 1u); break; } } } } while (0)
struct XcdBarrier { unsigned* bar; unsigned x; volatile LAS unsigned* st; };
__device__ __forceinline__ XcdBarrier xcd_barrier_post(unsigned* bar, volatile LAS unsigned* st) {
    XcdBarrier b; b.bar = bar; b.x = xb_xcc_id(); b.st = st;
    if (threadIdx.x == 0) (void)xb_add(&bar[XB_XCNT(b.x)], 1u);
    return b;
}
__device__ __forceinline__ void xcd_barrier_complete(unsigned* bar, unsigned x, unsigned& nloc, unsigned& nx) {
    const unsigned G = gridDim.x * gridDim.y * gridDim.z;
    unsigned sum, cnt, mine, sp = 0u;
    for (;;) {
        sum = 0u; cnt = 0u; mine = 0u;
#pragma unroll
        for (unsigned j = 0; j < 16; ++j) { const unsigned c = xb_ld(&bar[XB_XCNT(j)]); sum += c; cnt += (c > 0u) ? 1u : 0u; mine = (j == x) ? c : mine; }
        if (sum == G) break;
        __builtin_amdgcn_s_sleep(1);
        if ((++sp & 255u) == 0u) { if (xb_ld(&bar[XB_TMO])) break; if (sp > XB_SPIN_CAP) { atomicAdd(&bar[XB_TMO], 1u); break; } }
    }
    nloc = mine > 0u ? mine : 1u; nx = cnt > 0u ? cnt : 1u;
}
__device__ __forceinline__ void xcd_barrier(const XcdBarrier& b) {
    asm volatile("s_waitcnt vmcnt(0)" ::: "memory");
    __syncthreads();
    if (threadIdx.x == 0) {
        unsigned* bar = b.bar; asm volatile("" : "+s"(bar));
        __builtin_amdgcn_s_waitcnt(0);
        unsigned nloc = b.st[0], nx = b.st[1];
        if (nloc == 0u) { xcd_barrier_complete(bar, b.x, nloc, nx); b.st[0] = nloc; b.st[1] = nx; }
        const unsigned old = xb_add(&bar[XB_XSUB(b.x)], 1u);
        const unsigned gen = old / nloc;
        if (old + 1u == (gen + 1u) * nloc) {
            __builtin_amdgcn_fence(__ATOMIC_RELEASE, "agent");
            asm volatile("s_waitcnt vmcnt(0)" ::: "memory");
            const unsigned og = xb_add(&bar[XB_TOP], 1u);
            const unsigned tg = og / nx;
            if (og + 1u == (tg + 1u) * nx) xb_add(&bar[XB_TOPGEN], 1u);
            else XB_SPIN(xb_ld(&bar[XB_TOPGEN]) == tg, bar);
            __builtin_amdgcn_fence(__ATOMIC_ACQUIRE, "agent");
            xb_add(&bar[XB_XGEN(b.x)], 1u);
            asm volatile("s_waitcnt vmcnt(0)" ::: "memory");
        } else {
            XB_SPIN(xb_ld(&bar[XB_XGEN(b.x)]) == gen, bar);
            __builtin_amdgcn_fence(__ATOMIC_ACQUIRE, "agent");
            asm volatile("s_waitcnt vmcnt(0)" ::: "memory");
        }
    }
    __syncthreads();
}

namespace pg8 {
#define PG8_LAS __attribute__((address_space(3)))
typedef unsigned short bf16_t;
typedef short bf16x8 __attribute__((ext_vector_type(8)));
typedef float f32x4 __attribute__((ext_vector_type(4)));
typedef unsigned u32x4 __attribute__((ext_vector_type(4)));
constexpr int BM = 256, BK = 64, HALF = 128, HTB = HALF * BK * 2  , STAGE_BYTES = 8 * HTB, NXCD = 8, WGM = 8;

__host__ __device__ __forceinline__ int lds_byte(int r, int c) { const int st = (r >> 4) * 2 + (c >> 5), rr = r & 15, cc = c & 31, ob = rr * 64 + cc * 2; return st * 1024 + (ob ^ (((ob >> 9) & 1) << 5)); }
__host__ __device__ __forceinline__ void stage_rc(int b, int& R, int& C) { const int st = b / 1024, sb = b % 1024, swz = sb ^ (((sb >> 9) & 1) << 5); R = (st >> 1) * 16 + swz / 64; C = (st & 1) * 32 + (swz % 64) / 2; }
__host__ __device__ __forceinline__ int perm32(int rho) { const int n = rho >> 4, i = rho & 15; return 8 * (i >> 2) + 4 * n + (i & 3); }

struct Unit { int pm, pn, ui; };
struct Gemm { const bf16_t* A; const bf16_t* Bt; int M, N, K; int sb_w = 0x77777777, sb_a = 0x7f7f7f7f; };

struct StaticOrder {
    int nM, nN, nwg, G, c;
    __host__ __device__ void init(int M, int N, int G_, int c_) { nM = M / BM; nN = N / BM; nwg = nM * nN; G = G_; c = c_; }
    __host__ __device__ bool next(int i, Unit& u) const {
        const long L = (long)i * G + c; if (L >= nwg) return false;
        int wgid = (int)L; { const int q = nwg / NXCD, r = nwg % NXCD, xcd = wgid % NXCD, off = wgid / NXCD; wgid = (xcd < r ? xcd * (q + 1) : r * (q + 1) + (xcd - r) * q) + off; }
        const int nig = WGM * nN, gid = wgid / nig, fm = gid * WGM, gsz = (nM - fm) < WGM ? (nM - fm) : WGM;
        u.pm = fm + ((wgid % nig) % gsz); u.pn = (wgid % nig) / gsz; return true;
    }
    __device__ __forceinline__ void a_ready(const Unit&) const {}
    __device__ __forceinline__ void done(const Unit&) const {}
};

__device__ __forceinline__ unsigned cvt_pk_bf16(float lo, float hi) { unsigned r; asm volatile("v_cvt_pk_bf16_f32 %0, %1, %2" : "=v"(r) : "v"(lo), "v"(hi)); return r; }
typedef float f32x2 __attribute__((ext_vector_type(2)));
__device__ __forceinline__ f32x2 gelu_pk(f32x2 v) {
    const f32x2 av = __builtin_elementwise_abs(v), d = av * 0.2316418882f + 1.0f;
    f32x2 t; t.x = __builtin_amdgcn_rcpf(d.x); t.y = __builtin_amdgcn_rcpf(d.y);
    f32x2 q = t * 0.5307027145f + (-0.7265760135f); q = q * t + 0.7107068705f; q = q * t + (-0.142248368f); q = q * t + 0.127414796f; q = q * t;
    const f32x2 s = (v * v) * (-0.72134752044f);
    f32x2 e; e.x = __builtin_amdgcn_exp2f(s.x); e.y = __builtin_amdgcn_exp2f(s.y);
    const f32x2 m = v * (q * e), r = v - m;
    f32x2 o; o.x = v.x < 0.f ? m.x : r.x; o.y = v.y < 0.f ? m.y : r.y; return o;
}

typedef int v8i32 __attribute__((ext_vector_type(8)));
typedef int v4i32 __attribute__((ext_vector_type(4)));
__device__ __forceinline__ v8i32 cat8(v4i32 a, v4i32 b) { return __builtin_shufflevector(a, b, 0, 1, 2, 3, 4, 5, 6, 7); }
template <class E> constexpr auto pg8_wide(int) -> decltype(E::WIDE) { return E::WIDE; }
template <class E> constexpr bool pg8_wide(long) { return false; }
template <class Epi, class Sched, bool ALIGN_EPI = false, bool SP2 = false, bool GATHER = false, bool FP8 = false, bool ABLK = false>
__device__ __forceinline__ void gemm_phase(PG8_LAS unsigned char* lds, const Gemm g, const Sched& S, const Epi& E) {
    const int tid = tid_opaque(), wid = __builtin_amdgcn_readfirstlane(tid >> 6), lane = tid & 63, wr = wid >> 2, wc = wid & 3, fr = lane & 15, fq = lane >> 4;
    static_assert(!GATHER || SP2, "GATHER is wired into the SP2 loop only");
    const int K = g.K, nt = K / BK;
    unsigned voffA[2], voffB[2];
#pragma unroll
    for (int i = 0; i < 2; ++i) { int R, C; stage_rc(tid * 16 + i * 8192, R, C); const int Pw = perm32(R & 31);
        const int Rb = pg8_wide<Epi>(0) ? ((R >> 5) * 64 + (Pw >> 3) * 16 + (Pw & 7)) : Epi::PERM ? ((R & ~31) + Pw) : R;
        voffA[i] = ABLK ? (unsigned)(((C * 2) >> 5) * 8192 + R * 32 + ((C * 2) & 31)) : (unsigned)(R * K + C) * 2u; voffB[i] = (unsigned)(Rb * K + C) * 2u; }
    unsigned gAc[2][2] = {{0u, 0u}, {0u, 0u}}, gAn[2][2] = {{0u, 0u}, {0u, 0u}};
    int gR[2] = {0, 0}; unsigned gC[2] = {0u, 0u};
    if constexpr (GATHER) {
#pragma unroll
        for (int i = 0; i < 2; ++i) { int R, C; stage_rc(tid * 16 + i * 8192, R, C); gR[i] = R; gC[i] = (unsigned)C * 2u; }
    }
#define PG8_GROWS(dst, ui_) do { _Pragma("unroll") for (int _h = 0; _h < 2; ++_h) _Pragma("unroll") for (int _i = 0; _i < 2; ++_i) dst[_h][_i] = S.rowtab[(ui_) * 256 + _h * 128 + gR[_i]] + gC[_i]; } while (0)
    const size_t kstep = (size_t)(BK * 2);
    const size_t hstep = (size_t)HALF * K * 2;
    const size_t hstepB = pg8_wide<Epi>(0) ? (size_t)8 * K * 2 : hstep;
    const size_t kstepA = ABLK ? (size_t)32768 : kstep, hstepA = ABLK ? (size_t)4096 : hstep;
    const size_t tstep = 2 * hstep;
    const unsigned ldsw = (unsigned)wid * 1024u;
    const int aoff = lds_byte(wr * 64 + fr, fq * 8), boff = lds_byte(wc * 32 + fr, fq * 8);
#define PG8_SA(b, h) (((b) * 2 + (h)) * HTB)
#define PG8_SB(b, h) ((4 + (b) * 2 + (h)) * HTB)
#define PG8_STAGE(bufoff, gbase, voff) do { _Pragma("unroll") for (int _i = 0; _i < 2; ++_i) \
        __builtin_amdgcn_global_load_lds((const unsigned*)((const char*)(gbase) + (voff)[_i]), (PG8_LAS unsigned*)(lds + (bufoff) + ldsw + _i * 8192), 16, 0, 0); } while (0)
#define PG8_STAGE_A(bufoff, kptr, h, vsel) do { if constexpr (GATHER) { PG8_STAGE(bufoff, kptr, vsel[h]); } else { PG8_STAGE(bufoff, (kptr) + (h) * hstepA, voffA); } } while (0)
#define PG8_LDA(dst, b, h) do { if constexpr (FP8) { _Pragma("unroll") for (int m = 0; m < 4; ++m) dst##8[m] = cat8(*(const PG8_LAS v4i32*)(lds + PG8_SA(b, h) + aoff + m * 2048), *(const PG8_LAS v4i32*)(lds + PG8_SA(b, h) + aoff + m * 2048 + 1024)); } \
        else { _Pragma("unroll") for (int m = 0; m < 4; ++m) _Pragma("unroll") for (int k = 0; k < 2; ++k) dst[m][k] = *(const PG8_LAS bf16x8*)(lds + PG8_SA(b, h) + aoff + m * 2048 + k * 1024); } } while (0)
#define PG8_LDB(dst, b, h) do { if constexpr (FP8) { _Pragma("unroll") for (int n = 0; n < 2; ++n) dst##8[n] = cat8(*(const PG8_LAS v4i32*)(lds + PG8_SB(b, h) + boff + n * 2048), *(const PG8_LAS v4i32*)(lds + PG8_SB(b, h) + boff + n * 2048 + 1024)); } \
        else { _Pragma("unroll") for (int n = 0; n < 2; ++n) _Pragma("unroll") for (int k = 0; k < 2; ++k) dst[n][k] = *(const PG8_LAS bf16x8*)(lds + PG8_SB(b, h) + boff + n * 2048 + k * 1024); } } while (0)
#define PG8_MMA(ai, bj, At, Bt) do { __builtin_amdgcn_s_setprio(1); if constexpr (FP8) { _Pragma("unroll") for (int m = 0; m < 4; ++m) _Pragma("unroll") for (int n = 0; n < 2; ++n) \
        asm volatile("s_nop 1\n\tv_mfma_scale_f32_16x16x128_f8f6f4 %0, %1, %2, %0, %3, %4 op_sel_hi:[0,0,0]" : "+v"(acc[ai][bj][m][n]) : "v"(Bt##8[n]), "v"(At##8[m]), "v"(fp8_sa), "v"(fp8_sb)); } else { \
        _Pragma("unroll") for (int m = 0; m < 4; ++m) _Pragma("unroll") for (int n = 0; n < 2; ++n) _Pragma("unroll") for (int k = 0; k < 2; ++k) \
        acc[ai][bj][m][n] = __builtin_amdgcn_mfma_f32_16x16x32_bf16(Bt[n][k], At[m][k], acc[ai][bj][m][n], 0, 0, 0); } __builtin_amdgcn_s_setprio(0); } while (0)
#define PG8_WAIT_V(n) asm volatile("s_waitcnt vmcnt(" #n ")" ::: "memory")
#define PG8_WAIT_L(n) asm volatile("s_waitcnt lgkmcnt(" #n ")" ::: "memory")
#define PG8_BAR __builtin_amdgcn_s_barrier()
#define PG8_SCHED __builtin_amdgcn_sched_barrier(0)
    Unit cur, nxt; int ui = 0;
    if (!S.next(0, cur)) return;
    f32x4 acc[2][2][4][2];
#pragma unroll
    for (int a = 0; a < 2; ++a)
#pragma unroll
        for (int b = 0; b < 2; ++b)
#pragma unroll
            for (int m = 0; m < 4; ++m)
#pragma unroll
                for (int n = 0; n < 2; ++n) acc[a][b][m][n] = (f32x4){0.f, 0.f, 0.f, 0.f};
    const int fp8_sa = g.sb_w, fp8_sb = g.sb_a;
    bf16x8 At[4][2], B0[2][2], B1[2][2]; v8i32 At8[4], B08[2], B18[2];
    const char* cA = GATHER ? (const char*)g.A : (const char*)g.A + (size_t)cur.pm * tstep; const char* cB = (const char*)g.Bt + (size_t)cur.pn * tstep;
    if constexpr (GATHER) { PG8_GROWS(gAc, 0); }
    S.a_ready(cur);
    if constexpr (SP2) {
        PG8_STAGE(PG8_SB(0, 0), cB, voffB); PG8_STAGE(PG8_SB(0, 1), cB + hstepB, voffB); PG8_STAGE_A(PG8_SA(0, 0), cA, 0, gAc); PG8_STAGE_A(PG8_SA(0, 1), cA, 1, gAc);
        if (wr == 1) PG8_BAR;
        PG8_WAIT_V(2); PG8_BAR;
        PG8_STAGE(PG8_SB(1, 0), cB + kstep, voffB); PG8_STAGE_A(PG8_SA(1, 0), cA + kstepA, 0, gAc); PG8_STAGE(PG8_SB(1, 1), cB + hstepB + kstep, voffB);
        PG8_WAIT_V(6); PG8_BAR;
    } else {
        PG8_STAGE(PG8_SB(0, 0), cB, voffB); PG8_STAGE(PG8_SA(0, 0), cA, voffA); PG8_STAGE(PG8_SB(0, 1), cB + hstepB, voffB); PG8_STAGE(PG8_SA(0, 1), cA + hstep, voffA);
        if (wr == 1) PG8_BAR;
        PG8_WAIT_V(4); PG8_BAR;
        PG8_STAGE(PG8_SB(1, 0), cB + kstep, voffB); PG8_STAGE(PG8_SA(1, 0), cA + kstep, voffA); PG8_STAGE(PG8_SB(1, 1), cB + hstepB + kstep, voffB);
        PG8_WAIT_V(6); PG8_BAR;
    }
    for (;;) {
        const bool has_next = S.next(ui + 1, nxt);
        if constexpr (GATHER) { if (has_next) { PG8_GROWS(gAn, ui + 1); } else { _Pragma("unroll") for (int _h = 0; _h < 2; ++_h) _Pragma("unroll") for (int _i = 0; _i < 2; ++_i) gAn[_h][_i] = gAc[_h][_i]; } }
        const char* nA = GATHER ? (const char*)g.A : (has_next ? (const char*)g.A + (size_t)nxt.pm * tstep : cA); const char* nB = has_next ? (const char*)g.Bt + (size_t)nxt.pn * tstep : cB;
        for (int t = 0; t < nt; t += 2) {
            const bool last = (t == nt - 2);
            const char* a1 = cA + (size_t)(t + 1) * kstepA;
            const char* a2 = last ? nA : cA + (size_t)(t + 2) * kstepA; const char* b2 = last ? nB : cB + (size_t)(t + 2) * kstep;
            const char* a3 = a2 + kstepA; const char* b3 = b2 + kstep;
            if (last && has_next) S.a_ready(nxt);
            unsigned gA2[2][2];
            if constexpr (GATHER) { _Pragma("unroll") for (int _h = 0; _h < 2; ++_h) _Pragma("unroll") for (int _i = 0; _i < 2; ++_i) gA2[_h][_i] = last ? gAn[_h][_i] : gAc[_h][_i]; }
            if constexpr (SP2) {
            PG8_LDB(B0, 0, 0); PG8_LDB(B1, 0, 1); PG8_SCHED; PG8_LDA(At, 0, 0); PG8_STAGE_A(PG8_SA(1, 1), a1, 1, gAc);
            PG8_WAIT_V(8); PG8_WAIT_L(0); PG8_BAR; PG8_MMA(0, 0, At, B0); PG8_MMA(0, 1, At, B1); PG8_BAR; PG8_SCHED;
            PG8_LDA(At, 0, 1); PG8_STAGE(PG8_SB(0, 0), b2, voffB); PG8_STAGE(PG8_SB(0, 1), b2 + hstepB, voffB); PG8_STAGE_A(PG8_SA(0, 0), a2, 0, gA2);
            PG8_WAIT_V(8); PG8_WAIT_L(0); PG8_BAR; PG8_MMA(1, 0, At, B0); PG8_MMA(1, 1, At, B1); PG8_BAR; PG8_SCHED;
            PG8_LDB(B0, 1, 0); PG8_LDB(B1, 1, 1); PG8_SCHED; PG8_LDA(At, 1, 0); PG8_STAGE_A(PG8_SA(0, 1), a2, 1, gA2);
            PG8_WAIT_V(8); PG8_WAIT_L(0); PG8_BAR; PG8_MMA(0, 0, At, B0); PG8_MMA(0, 1, At, B1); PG8_BAR; PG8_SCHED;
            PG8_LDA(At, 1, 1); PG8_STAGE(PG8_SB(1, 0), b3, voffB); PG8_STAGE(PG8_SB(1, 1), b3 + hstepB, voffB); PG8_STAGE_A(PG8_SA(1, 0), a3, 0, gA2);
            PG8_WAIT_V(8); PG8_WAIT_L(0); PG8_BAR; PG8_MMA(1, 0, At, B0); PG8_MMA(1, 1, At, B1); PG8_BAR; PG8_SCHED;
            } else {
            PG8_LDB(B0, 0, 0); PG8_SCHED; PG8_LDA(At, 0, 0); PG8_STAGE(PG8_SA(1, 1), a1 + hstep, voffA);
            PG8_WAIT_L(8); PG8_BAR; PG8_WAIT_L(0); PG8_MMA(0, 0, At, B0); PG8_BAR; PG8_SCHED;
            PG8_LDB(B1, 0, 1); PG8_STAGE(PG8_SB(0, 0), b2, voffB);
            PG8_BAR; PG8_WAIT_L(0); PG8_MMA(0, 1, At, B1); PG8_BAR;
            PG8_LDA(At, 0, 1); PG8_STAGE(PG8_SA(0, 0), a2, voffA);
            PG8_BAR; PG8_WAIT_L(0); PG8_MMA(1, 0, At, B0); PG8_BAR; PG8_SCHED;
            PG8_STAGE(PG8_SB(0, 1), b2 + hstepB, voffB);
            PG8_WAIT_V(6); PG8_BAR; PG8_MMA(1, 1, At, B1); PG8_BAR;
            PG8_LDB(B0, 1, 0); PG8_SCHED; PG8_LDA(At, 1, 0); PG8_STAGE(PG8_SA(0, 1), a2 + hstep, voffA);
            PG8_WAIT_L(8); PG8_BAR; PG8_WAIT_L(0); PG8_MMA(0, 0, At, B0); PG8_BAR; PG8_SCHED;
            PG8_LDB(B1, 1, 1); PG8_STAGE(PG8_SB(1, 0), b3, voffB);
            PG8_BAR; PG8_WAIT_L(0); PG8_MMA(0, 1, At, B1); PG8_BAR;
            PG8_LDA(At, 1, 1); PG8_STAGE(PG8_SA(1, 0), a3, voffA);
            PG8_BAR; PG8_WAIT_L(0); PG8_MMA(1, 0, At, B0); PG8_BAR; PG8_SCHED;
            PG8_STAGE(PG8_SB(1, 1), b3 + hstepB, voffB);
            PG8_WAIT_V(6); PG8_BAR; PG8_MMA(1, 1, At, B1); PG8_BAR;
            }
        }
        if constexpr (ALIGN_EPI) { if (wr == 0) PG8_BAR; }
        if constexpr (FP8) { asm volatile("s_nop 15\n\ts_nop 15" ::: "memory"); __builtin_amdgcn_sched_barrier(0); }
        if constexpr (!Epi::AFTER_DRAIN) { E(acc, cur, wr, wc, fr, fq); S.done(cur); }
        if (!has_next) break;
#pragma unroll
        for (int a = 0; a < 2; ++a)
#pragma unroll
            for (int b = 0; b < 2; ++b)
#pragma unroll
                for (int m = 0; m < 4; ++m)
#pragma unroll
                    for (int n = 0; n < 2; ++n) acc[a][b][m][n] = (f32x4){0.f, 0.f, 0.f, 0.f};
        cur = nxt; cA = nA; cB = nB; ++ui;
        if constexpr (GATHER) { _Pragma("unroll") for (int _h = 0; _h < 2; ++_h) _Pragma("unroll") for (int _i = 0; _i < 2; ++_i) gAc[_h][_i] = gAn[_h][_i]; }
        if constexpr (ALIGN_EPI) { if (wr == 1) PG8_BAR; }
    }
    PG8_WAIT_V(0);
    if constexpr (!ALIGN_EPI) { if (wr == 0) PG8_BAR; }
    PG8_BAR;
    if constexpr (Epi::AFTER_DRAIN) { E.fused(acc, cur, wr, wc, fr, fq, lds, wid, lane); S.done(cur); }
#undef PG8_SA
#undef PG8_SB
#undef PG8_STAGE
#undef PG8_STAGE_A
#undef PG8_GROWS
#undef PG8_LDA
#undef PG8_LDB
#undef PG8_MMA
#undef PG8_WAIT_V
#undef PG8_WAIT_L
#undef PG8_BAR
#undef PG8_SCHED
}
}

struct Args { const float* in[38]; float* out; unsigned char* ws; int ph_lo, ph_hi; };
#define INP(k) as_global(IN[k])
#define AIN(k) as_global(A.in[k])
enum { I_X = 0, I_C, I_CTX, I_CCTX, I_N1G, I_N2G, I_ADAW, I_ADAB, I_EVWIN, I_EVWOUT, I_RWMU, I_RWW0, I_RWW2, I_RWA0, I_RWA2, I_RWG2, I_RWKK, I_RWKA, I_RWRK,
       I_GNW, I_GNB, I_QN, I_KN, I_LAM, I_SUBLN, I_SGWIN, I_SGBIN, I_SGLNG, I_SGLNB, I_SGWS, I_SGBS, I_SGWOUT, I_RTW, I_RTB, I_W1, I_B1, I_W2, I_B2 };

struct Tok { int b, t, T, modrow; };
__device__ __forceinline__ Tok tokinfo(int g) {
    Tok k;
    if (g < NCTX) { k.b = g >> 8; k.t = g & 255; k.T = TC; k.modrow = 16; }
    else { const int q = g - NCTX; k.b = q >> 11; k.t = q & 2047; k.T = TL; k.modrow = k.b; }
    return k;
}

template <int MAP>
__device__ __forceinline__ void p0_transpose_item(const float* W, int K, int N, bf16_t* WT, LAS float* scr, int item, int lane) {
    const int nblk = N / 32, kb = item / nblk, nb = item % nblk, k0 = 64 * kb, n0 = 32 * nb;
    const int d0 = MAP ? (256 * ((n0 & 1023) >> 7) + 128 * (n0 >> 10) + (n0 & 127)) : n0;
#pragma unroll 8
    for (int i = 0; i < 32; ++i) { const int kk = 2 * i + (lane >> 5); scr[kk * 33 + (lane & 31)] = W[(size_t)(k0 + kk) * N + n0 + (lane & 31)]; }
    asm volatile("s_waitcnt lgkmcnt(0)" ::: "memory");
    const int c = lane & 7;
#pragma unroll
    for (int j = 0; j < 4; ++j) { const int n = (lane >> 3) + 8 * j; const LAS float* s = scr + (8 * c) * 33 + n;
        u32x4 o; o.x = pk2(s[0 * 33], s[1 * 33]); o.y = pk2(s[2 * 33], s[3 * 33]); o.z = pk2(s[4 * 33], s[5 * 33]); o.w = pk2(s[6 * 33], s[7 * 33]);
        *(u32x4*)(WT + (size_t)(d0 + n) * K + k0 + 8 * c) = o; }
    asm volatile("s_waitcnt lgkmcnt(0)" ::: "memory");
}

template <int MAP>
__device__ __forceinline__ void p0_transpose_item_fp8w(const float* W, int K, int N, unsigned char* WT, LAS float* scr, int item, int lane) {
    const int nblk = N / 32, kb = item / nblk, nb = item % nblk, k0 = 128 * kb, n0 = 32 * nb;
    const int d0 = MAP ? (256 * ((n0 & 1023) >> 7) + 128 * (n0 >> 10) + (n0 & 127)) : n0;
    {
        f32x4 ld[16];
#pragma unroll
        for (int i = 0; i < 16; ++i) ld[i] = *(const f32x4*)(W + (size_t)(k0 + 8 * i + (lane >> 3)) * N + n0 + 4 * (lane & 7));
#pragma unroll
        for (int i = 0; i < 16; ++i) { LAS float* d = scr + (8 * i + (lane >> 3)) * 33 + 4 * (lane & 7); d[0] = ld[i].x; d[1] = ld[i].y; d[2] = ld[i].z; d[3] = ld[i].w; }
    }
    asm volatile("s_waitcnt lgkmcnt(0)" ::: "memory");
    const int c = lane & 7;
#pragma unroll
    for (int j = 0; j < 4; ++j) { const int n = (lane >> 3) + 8 * j; const LAS float* sp = scr + (16 * c) * 33 + n;
        u32x4 o;
#pragma unroll
        for (int d = 0; d < 4; ++d) { int w = __builtin_amdgcn_cvt_pk_fp8_f32(sp[(4 * d) * 33] * 256.0f, sp[(4 * d + 1) * 33] * 256.0f, 0, false);
            w = __builtin_amdgcn_cvt_pk_fp8_f32(sp[(4 * d + 2) * 33] * 256.0f, sp[(4 * d + 3) * 33] * 256.0f, w, true); o[d] = (unsigned)w; }
        *(u32x4*)(WT + (size_t)(d0 + n) * K + k0 + 16 * c) = o; }
    asm volatile("s_waitcnt lgkmcnt(0)" ::: "memory");
}

__device__ __forceinline__ void ph_prologue(const Args& A, LAS unsigned char* lds, int bid, int nb) {
    const int tid = tid_opaque(), lane = tid & 63, wid = tid >> 6;
    unsigned char* ws = opq(A.ws);
    if (bid == 0 && tid < 39) ((const float**)(ws + WS_PTRS))[tid] = (tid < 38) ? A.in[tid] : (const float*)A.out;
    {
        LAS float* s = (LAS float*)lds;
        LAS float* red = (LAS float*)(lds + 17 * 1024 * 4);
        for (int i = tid; i < 17 * 1024; i += NTHREADS) {
            const int r = i >> 10, k = i & 1023;
            const float x = (r < 16) ? AIN(I_C)[r * 1024 + k] : AIN(I_CCTX)[k];
            s[i] = x / (1.0f + __expf(-x));
        }
        __syncthreads();
        float* mod = (float*)(ws + WS_MOD);
        for (int u = bid; u < 4 * 96; u += nb) {
            const int l = u / 96, cg = u % 96, col = cg * 64 + lane;
            float acc[17];
#pragma unroll
            for (int r = 0; r < 17; ++r) acc[r] = 0.f;
            const float* wp = AIN(I_ADAW) + (size_t)l * 1024 * 6144 + col;
            for (int k = wid * 128; k < wid * 128 + 128; ++k) {
                const float wv = wp[(size_t)k * 6144];
#pragma unroll
                for (int r = 0; r < 17; ++r) acc[r] += s[r * 1024 + k] * wv;
            }
#pragma unroll
            for (int r = 0; r < 17; ++r) red[(wid * 17 + r) * 64 + lane] = acc[r];
            __syncthreads();
            for (int i = tid; i < 17 * 64; i += NTHREADS) {
                const int r = i >> 6, ln = i & 63; float v = 0.f;
#pragma unroll
                for (int w = 0; w < 8; ++w) v += red[(w * 17 + r) * 64 + ln];
                const int cc = cg * 64 + ln;
                mod[((size_t)l * 17 + r) * 6144 + cc] = v + AIN(I_ADAB)[l * 6144 + cc];
            }
            __syncthreads();
        }
    }
    __syncthreads();
    {
        LAS float* scr = (LAS float*)(lds + wid * 17408);
        const int gw = bid * NWAVES + wid, NGW = nb * NWAVES;
        constexpr int IT_WIN = 16 * (EVC / 32), IT_SQ = 16 * 32, IT_SGIN = 16 * 64, IT_W1 = 8 * 64, IT_W2 = 8 * 32;
        constexpr int N0 = 2 * IT_WIN, N1 = N0 + 2 * IT_SQ, N2 = N1 + 2 * IT_SGIN, N3 = N2 + 2 * IT_SQ, N4 = N3 + 128 * IT_W1, N5 = N4 + 128 * IT_W2;
        for (int it = gw; it < N5; it += NGW) {
            if (it < N0) { const int m = it / IT_WIN, r = it % IT_WIN; p0_transpose_item<0>(AIN(I_EVWIN) + (size_t)m * DM * EVC, DM, EVC, (bf16_t*)(ws + WS_WIN) + (size_t)m * ZLD * DM, scr, r, lane); }
            else if (it < N1) { const int q = it - N0, m = q / IT_SQ, r = q % IT_SQ; p0_transpose_item<0>(AIN(I_EVWOUT) + (size_t)m * DM * DM, DM, DM, (bf16_t*)(ws + WS_WOUT) + (size_t)m * DM * DM, scr, r, lane); }
            else if (it < N2) { const int q = it - N1, m = q / IT_SGIN, r = q % IT_SGIN; p0_transpose_item<0>(AIN(I_SGWIN) + (size_t)m * DM * 2048, DM, 2048, (bf16_t*)(ws + WS_SGIN) + (size_t)m * 2048 * DM, scr, r, lane); }
            else if (it < N3) { const int q = it - N2, m = q / IT_SQ, r = q % IT_SQ; p0_transpose_item<0>(AIN(I_SGWOUT) + (size_t)m * DM * DM, DM, DM, (bf16_t*)(ws + WS_SGOUT) + (size_t)m * DM * DM, scr, r, lane); }
            else if (it < N4) { const int q = it - N3, m = q / IT_W1, r = q % IT_W1; p0_transpose_item_fp8w<1>(AIN(I_W1) + (size_t)m * DM * 2048, DM, 2048, ws + WS_W1 + (size_t)m * 2048 * DM, scr, r, lane); }
            else { const int q = it - N4, m = q / IT_W2, r = q % IT_W2; p0_transpose_item_fp8w<0>(AIN(I_W2) + (size_t)m * DM * DM, DM, DM, ws + WS_W2 + (size_t)m * DM * DM, scr, r, lane); }
        }
    }
    {
        const size_t gt = (size_t)bid * NTHREADS + tid, GT = (size_t)nb * NTHREADS;
        u32x4* H8 = (u32x4*)(ws + WS_H);
        const f32x4* c4 = (const f32x4*)AIN(I_CTX); const f32x4* x4 = (const f32x4*)AIN(I_X);
        constexpr size_t NC8 = (size_t)NCTX * DM / 8, NT8 = (size_t)NTOK * DM / 8;
        for (size_t i = gt; i < NT8; i += GT) { const f32x4* s = (i < NC8) ? c4 + 2 * i : x4 + 2 * (i - NC8); const f32x4 a = s[0], b = s[1];
            H8[i] = (u32x4){pk2(a.x, a.y), pk2(a.z, a.w), pk2(b.x, b.y), pk2(b.z, b.w)}; }
        for (size_t i = gt; i < (size_t)2 * 128 * DM / 8; i += GT) { const size_t m = i / (128 * DM / 8), r = i % (128 * DM / 8); ((u32x4*)((bf16_t*)(ws + WS_WIN) + (m * ZLD + EVC) * DM))[r] = (u32x4){0u, 0u, 0u, 0u}; }
        bf16_t* wl = (bf16_t*)(ws + WS_WLORA);
        for (size_t i = gt; i < (size_t)2 * LORA_N * (LORA_K / 8); i += GT) {
            const int n = (int)(i % LORA_N), kc = (int)((i / LORA_N) % (LORA_K / 8)), jj = (int)(i / ((size_t)LORA_N * (LORA_K / 8))), seg = n >> 9, c = n & 511, k0 = kc * 8;
            float v[8];
#pragma unroll
            for (int e = 0; e < 8; ++e) v[e] = 0.f;
            if (seg < 2) { if ((k0 >> 6) == seg) {
#pragma unroll
                for (int e = 0; e < 8; ++e) v[e] = AIN(I_RWW2)[(((size_t)jj * 2 + seg) * 64 + (k0 & 63) + e) * 512 + c]; } }
            else if (seg < 4) { if ((k0 >> 6) == seg) {
#pragma unroll
                for (int e = 0; e < 8; ++e) v[e] = AIN(I_RWA2)[(((size_t)jj * 2 + (seg - 2)) * 64 + (k0 & 63) + e) * 512 + c]; } }
            else if (k0 >= 256) {
#pragma unroll
                for (int e = 0; e < 8; ++e) v[e] = AIN(I_RWG2)[((size_t)jj * 128 + (k0 - 256) + e) * 512 + c]; }
            *(u32x4*)(wl + ((size_t)jj * LORA_N + n) * LORA_K + k0) = (u32x4){pk2(v[0], v[1]), pk2(v[2], v[3]), pk2(v[4], v[5]), pk2(v[6], v[7])};
        }
        for (size_t i = gt; i < (size_t)2 * LORA_N; i += GT) { const int jj = (int)(i / LORA_N), n = (int)(i % LORA_N), seg = n >> 9, c = n & 511;
            ((float*)(ws + WS_LBIAS))[i] = seg < 2 ? AIN(I_RWW0)[((size_t)jj * 2 + seg) * 512 + c] : (seg < 4 ? AIN(I_RWA0)[((size_t)jj * 2 + (seg - 2)) * 512 + c] : 0.f); }
        float* rt = (float*)(ws + WS_RTWT);
        for (size_t i = gt; i < (size_t)4 * 128 * 32; i += GT) {
            const int e = (int)i & 31, k0 = ((int)(i >> 5) & 127) * 8, l = (int)(i >> 12);
            unsigned hi[4], lo[4]; float w[8];
#pragma unroll
            for (int q = 0; q < 8; ++q) w[q] = AIN(I_RTW)[((size_t)l * 1024 + k0 + q) * 32 + e];
#pragma unroll
            for (int q = 0; q < 4; ++q) { hi[q] = pk2(w[2 * q], w[2 * q + 1]); lo[q] = pk2(w[2 * q] - __builtin_bit_cast(float, hi[q] << 16), w[2 * q + 1] - __builtin_bit_cast(float, hi[q] & 0xffff0000u)); }
            *(u32x4*)((bf16_t*)rt + ((size_t)l * 2 * 32 + e) * 1024 + k0) = (u32x4){hi[0], hi[1], hi[2], hi[3]};
            *(u32x4*)((bf16_t*)rt + ((size_t)(l * 2 + 1) * 32 + e) * 1024 + k0) = (u32x4){lo[0], lo[1], lo[2], lo[3]};
        }
    }
}

template <bool ROUTER>
__device__ __forceinline__ void ph_norm(const Args& A, int l, int row_lo, LAS unsigned char* lds, int bid, int nb) {
    unsigned char* ws = opq(A.ws); const float* const* IN = (const float* const*)(ws + WS_PTRS); (void)IN;
    const int tid = tid_opaque(), lane = tid & 63, wid = tid >> 6;
    const bf16_t* H = (const bf16_t*)(ws + WS_H);
    const float* mod = (const float*)(ws + WS_MOD);
    bf16_t* abf = (bf16_t*)(ws + WS_ABF);
    const float* gp = INP(ROUTER ? I_N2G : I_N1G) + l * 1024;
    const int c_shift = ROUTER ? 3 : 0, c_scale = ROUTER ? 4 : 1;
    LAS float* rtl = (LAS float*)lds;
    LAS int* hist = (LAS int*)(lds + 131072);
    float rtb = 0.f;
    if constexpr (ROUTER) {
        const f32x4* rt4 = (const f32x4*)((const float*)(ws + WS_RTWT) + (size_t)l * 32 * 1024);
        for (int i = tid; i < 32 * 1024 / 4; i += NTHREADS) ((LAS f32x4*)rtl)[i] = rt4[i];
        if (tid < 32) hist[tid] = 0;
        rtb = INP(I_RTB)[l * 32 + (lane >> 1)];
        __syncthreads();
    }
    for (int row = row_lo + bid * NWAVES + wid; row < NTOK; row += nb * NWAVES) {
        const Tok tk = tokinfo(row);
        const float* mrow = mod + ((size_t)l * 17 + tk.modrow) * 6144;
        f32x4 v[4]; float ss = 0.f;
#pragma unroll
        for (int j = 0; j < 4; ++j) { const u32x2 hq = *(const u32x2*)(H + (size_t)row * DM + j * 256 + lane * 4); v[j] = (f32x4){bflo(hq.x), bfhi(hq.x), bflo(hq.y), bfhi(hq.y)}; ss += (v[j].x * v[j].x + v[j].y * v[j].y) + (v[j].z * v[j].z + v[j].w * v[j].w); }
        const float rstd = rsqrtf(wave_sum(ss) * (1.0f / DM) + 1e-6f);
#pragma unroll
        for (int j = 0; j < 4; ++j) {
            const int col = j * 256 + lane * 4;
            const f32x4 g = *(const f32x4*)(gp + col), sc = *(const f32x4*)(mrow + c_scale * 1024 + col), sh = *(const f32x4*)(mrow + c_shift * 1024 + col);
            v[j] = (v[j] * rstd * g) * (sc + 1.0f) + sh;
            u32x2 o; o.x = pk2(v[j].x, v[j].y); o.y = pk2(v[j].z, v[j].w);
            *(u32x2*)(abf + (size_t)row * DM + col) = o;
        }
        if constexpr (ROUTER) {
            float p[32];
#pragma unroll
            for (int e = 0; e < 32; ++e) {
                float acc = 0.f;
#pragma unroll
                for (int j = 0; j < 4; ++j) { const f32x4 w = *(const LAS f32x4*)(rtl + e * 1024 + j * 256 + lane * 4); acc += (v[j].x * w.x + v[j].y * w.y) + (v[j].z * w.z + v[j].w * w.w); }
                p[e] = acc;
            }
#define RS_STEP(N, OFF) _Pragma("unroll") for (int i = 0; i < (N); ++i) { const bool up = (lane & (OFF)) != 0; const float send = up ? p[i] : p[i + (N)], keep = up ? p[i + (N)] : p[i]; p[i] = keep + __shfl_xor(send, (OFF)); }
            RS_STEP(16, 32) RS_STEP(8, 16) RS_STEP(4, 8) RS_STEP(2, 4) RS_STEP(1, 2)
#undef RS_STEP
            const float mylg = p[0] + __shfl_xor(p[0], 1) + rtb;
            float tv[4] = {-3.0e38f, -3.0e38f, -3.0e38f, -3.0e38f}; int ti[4] = {0, 0, 0, 0};
#pragma unroll
            for (int e = 0; e < 32; ++e) {
                const float lgv = rdl(mylg, 2 * e);
                if (lgv > tv[3]) {
                    tv[3] = lgv; ti[3] = e;
                    if (tv[3] > tv[2]) { const float a = tv[2]; tv[2] = tv[3]; tv[3] = a; const int b = ti[2]; ti[2] = ti[3]; ti[3] = b; }
                    if (tv[2] > tv[1]) { const float a = tv[1]; tv[1] = tv[2]; tv[2] = a; const int b = ti[1]; ti[1] = ti[2]; ti[2] = b; }
                    if (tv[1] > tv[0]) { const float a = tv[0]; tv[0] = tv[1]; tv[1] = a; const int b = ti[0]; ti[0] = ti[1]; ti[1] = b; }
                }
            }
            const float e1 = __expf(tv[1] - tv[0]), e2 = __expf(tv[2] - tv[0]), e3 = __expf(tv[3] - tv[0]);
            const float inv = 1.0f / (1.0f + e1 + e2 + e3);
            if (lane == 0) {
                int* te = (int*)(ws + WS_TOKE) + (size_t)row * 4; float* tg = (float*)(ws + WS_TOKG) + (size_t)row * 4; int* tr = (int*)(ws + WS_TOKR) + (size_t)row * 4;
                te[0] = ti[0]; te[1] = ti[1]; te[2] = ti[2]; te[3] = ti[3];
                tg[0] = inv; tg[1] = e1 * inv; tg[2] = e2 * inv; tg[3] = e3 * inv;
#pragma unroll
                for (int k = 0; k < 4; ++k) tr[k] = __hip_atomic_fetch_add(hist + ti[k], 1, __ATOMIC_RELAXED, __HIP_MEMORY_SCOPE_WORKGROUP);
            }
        }
    }
    if constexpr (ROUTER) {
        __syncthreads();
        if (tid < 32) ((int*)(ws + WS_BCNT))[((size_t)l * 256 + bid) * 32 + tid] = hist[tid];
    }
}


constexpr int RT_LS = 2064;
__device__ __forceinline__ void ph_norm2_router(const Args& A, int l, int row_lo, LAS unsigned char* lds, int bid, int nb) {
    unsigned char* ws = opq(A.ws); const float* const* IN = (const float* const*)(ws + WS_PTRS);
    const int tid = tid_opaque(), lane = tid & 63, wid = tid >> 6, c16 = lane & 15, g4 = lane >> 4;
    const bf16_t* H = (const bf16_t*)(ws + WS_H); const float* mod = (const float*)(ws + WS_MOD); bf16_t* abf = (bf16_t*)(ws + WS_ABF);
    const float* gp = INP(I_N2G) + l * 1024;
    LAS unsigned char* rth = lds; LAS unsigned char* rtl = lds + 32 * RT_LS;
    LAS int* hist = (LAS int*)(lds + 64 * RT_LS);
    LAS float* lgs = (LAS float*)(lds + 64 * RT_LS + 256) + wid * 544;
    {
        const u32x4* src = (const u32x4*)((const bf16_t*)(ws + WS_RTWT) + (size_t)l * 2 * 32 * 1024);
        for (int i = tid; i < 64 * 128; i += NTHREADS) { const int row = i >> 7, ch = i & 127; *(LAS u32x4*)(lds + row * RT_LS + ch * 16) = src[i]; }
        if (tid < 32) hist[tid] = 0;
        __syncthreads();
    }
    const float rtb0 = INP(I_RTB)[l * 32 + c16], rtb1 = INP(I_RTB)[l * 32 + 16 + c16];
    const int ngroups = (NTOK - row_lo) / 16;
    for (int u = bid * NWAVES + wid; u < ngroups; u += nb * NWAVES) {
        const int row = row_lo + 16 * u + c16;
        const Tok tk = tokinfo(row_lo + 16 * u);
        const float* mrow = mod + ((size_t)l * 17 + tk.modrow) * 6144;
        const bf16_t* hrow = H + (size_t)row * DM + 8 * g4;
        float ss = 0.f;
#pragma unroll 8
        for (int ks = 0; ks < 32; ++ks) { const u32x4 hq = *(const u32x4*)(hrow + 32 * ks); const f32x4 a = {bflo(hq.x), bfhi(hq.x), bflo(hq.y), bfhi(hq.y)}, b = {bflo(hq.z), bfhi(hq.z), bflo(hq.w), bfhi(hq.w)};
            ss += (a.x * a.x + a.y * a.y) + (a.z * a.z + a.w * a.w) + (b.x * b.x + b.y * b.y) + (b.z * b.z + b.w * b.w); }
        ss += __shfl_xor(ss, 16); ss += __shfl_xor(ss, 32);
        const float rstd = rsqrtf(ss * (1.0f / DM) + 1e-6f);
        f32x4 acc0 = {0.f, 0.f, 0.f, 0.f}, acc1 = acc0;
#pragma unroll 2
        for (int ks = 0; ks < 32; ++ks) {
            const int col = 32 * ks + 8 * g4;
            float f[8];
            { const u32x4 hq = *(const u32x4*)(hrow + 32 * ks); const f32x4 xa = {bflo(hq.x), bfhi(hq.x), bflo(hq.y), bfhi(hq.y)}, xb = {bflo(hq.z), bfhi(hq.z), bflo(hq.w), bfhi(hq.w)};
              const f32x4 ga = *(const f32x4*)(gp + col), gb = *(const f32x4*)(gp + col + 4), sa = *(const f32x4*)(mrow + 4 * 1024 + col), sb = *(const f32x4*)(mrow + 4 * 1024 + col + 4);
              const f32x4 ha = *(const f32x4*)(mrow + 3 * 1024 + col), hb = *(const f32x4*)(mrow + 3 * 1024 + col + 4);
              const f32x4 fa = (xa * rstd * ga) * (sa + 1.0f) + ha, fb = (xb * rstd * gb) * (sb + 1.0f) + hb;
              f[0] = fa.x; f[1] = fa.y; f[2] = fa.z; f[3] = fa.w; f[4] = fb.x; f[5] = fb.y; f[6] = fb.z; f[7] = fb.w; }
            unsigned hi[4], lo[4];
#pragma unroll
            for (int e = 0; e < 4; ++e) { hi[e] = pk2(f[2 * e], f[2 * e + 1]);
                lo[e] = pk2(f[2 * e] - __builtin_bit_cast(float, hi[e] << 16), f[2 * e + 1] - __builtin_bit_cast(float, hi[e] & 0xffff0000u)); }
            const u32x4 hv = {hi[0], hi[1], hi[2], hi[3]}, lv = {lo[0], lo[1], lo[2], lo[3]};
            { int w0 = __builtin_amdgcn_cvt_pk_fp8_f32(f[0], f[1], 0, false); w0 = __builtin_amdgcn_cvt_pk_fp8_f32(f[2], f[3], w0, true);
              int w1 = __builtin_amdgcn_cvt_pk_fp8_f32(f[4], f[5], 0, false); w1 = __builtin_amdgcn_cvt_pk_fp8_f32(f[6], f[7], w1, true);
              *(u32x2*)((unsigned char*)abf + (size_t)row * DM + col) = (u32x2){(unsigned)w0, (unsigned)w1}; }
            const bf16x8 fh = __builtin_bit_cast(bf16x8, hv), fl = __builtin_bit_cast(bf16x8, lv);
            const int wo = c16 * RT_LS + col * 2;
            const bf16x8 wh0 = *(const LAS bf16x8*)(rth + wo), wh1 = *(const LAS bf16x8*)(rth + 16 * RT_LS + wo), wl0 = *(const LAS bf16x8*)(rtl + wo), wl1 = *(const LAS bf16x8*)(rtl + 16 * RT_LS + wo);
            acc0 = __builtin_amdgcn_mfma_f32_16x16x32_bf16(fh, wh0, acc0, 0, 0, 0); acc1 = __builtin_amdgcn_mfma_f32_16x16x32_bf16(fh, wh1, acc1, 0, 0, 0);
            acc0 = __builtin_amdgcn_mfma_f32_16x16x32_bf16(fl, wh0, acc0, 0, 0, 0); acc1 = __builtin_amdgcn_mfma_f32_16x16x32_bf16(fl, wh1, acc1, 0, 0, 0);
            acc0 = __builtin_amdgcn_mfma_f32_16x16x32_bf16(fh, wl0, acc0, 0, 0, 0); acc1 = __builtin_amdgcn_mfma_f32_16x16x32_bf16(fh, wl1, acc1, 0, 0, 0);
        }
#pragma unroll
        for (int r = 0; r < 4; ++r) { lgs[(4 * g4 + r) * 34 + c16] = acc0[r] + rtb0; lgs[(4 * g4 + r) * 34 + 16 + c16] = acc1[r] + rtb1; }
        asm volatile("s_waitcnt lgkmcnt(0)" ::: "memory");
        if (lane < 16) {
            float tv[4] = {-3.0e38f, -3.0e38f, -3.0e38f, -3.0e38f}; int ti[4] = {0, 0, 0, 0};
#pragma unroll
            for (int e = 0; e < 32; ++e) {
                const float lgv = lgs[lane * 34 + e];
                if (lgv > tv[3]) {
                    tv[3] = lgv; ti[3] = e;
                    if (tv[3] > tv[2]) { const float a = tv[2]; tv[2] = tv[3]; tv[3] = a; const int b = ti[2]; ti[2] = ti[3]; ti[3] = b; }
                    if (tv[2] > tv[1]) { const float a = tv[1]; tv[1] = tv[2]; tv[2] = a; const int b = ti[1]; ti[1] = ti[2]; ti[2] = b; }
                    if (tv[1] > tv[0]) { const float a = tv[0]; tv[0] = tv[1]; tv[1] = a; const int b = ti[0]; ti[0] = ti[1]; ti[1] = b; }
                }
            }
            const float e1 = __expf(tv[1] - tv[0]), e2 = __expf(tv[2] - tv[0]), e3 = __expf(tv[3] - tv[0]);
            const float inv = 1.0f / (1.0f + e1 + e2 + e3);
            const size_t r4 = (size_t)(row_lo + 16 * u + lane) * 4;
            *(int4*)((int*)(ws + WS_TOKE) + r4) = make_int4(ti[0], ti[1], ti[2], ti[3]);
            *(f32x4*)((float*)(ws + WS_TOKG) + r4) = (f32x4){inv, e1 * inv, e2 * inv, e3 * inv};
            int rk[4];
#pragma unroll
            for (int k = 0; k < 4; ++k) rk[k] = __hip_atomic_fetch_add(hist + ti[k], 1, __ATOMIC_RELAXED, __HIP_MEMORY_SCOPE_WORKGROUP);
            *(int4*)((int*)(ws + WS_TOKR) + r4) = make_int4(rk[0], rk[1], rk[2], rk[3]);
        }
        asm volatile("s_waitcnt lgkmcnt(0)" ::: "memory");
    }
    __syncthreads();
    if (tid < 32) ((int*)(ws + WS_BCNT))[((size_t)l * 256 + bid) * 32 + tid] = hist[tid];
}

typedef pg8::f32x4 (&AccRef)[2][2][4][2];
struct EpiStoreBf16 {
    static constexpr bool PERM = true, AFTER_DRAIN = false;
    bf16_t* O; int ldc;
    __device__ __forceinline__ void operator()(const pg8::f32x4 (&acc)[2][2][4][2], const pg8::Unit& u, int wr, int wc, int fr, int fq) const {
        const int row0 = u.pm * 256 + wr * 64 + fr, col0 = u.pn * 256 + wc * 32 + 8 * fq;
#pragma unroll
        for (int ai = 0; ai < 2; ++ai)
#pragma unroll
            for (int m = 0; m < 4; ++m) { bf16_t* rowp = O + (size_t)(row0 + ai * 128 + m * 16) * ldc + col0;
#pragma unroll
                for (int bj = 0; bj < 2; ++bj) { const pg8::f32x4 v0 = acc[ai][bj][m][0], v1 = acc[ai][bj][m][1];
                    u32x4 w; w.x = cvtpk_s(v0[0], v0[1]); w.y = cvtpk_s(v0[2], v0[3]); w.z = cvtpk_s(v1[0], v1[1]); w.w = cvtpk_s(v1[2], v1[3]);
                    *(u32x4*)(rowp + bj * 128) = w; } }
    }
};
struct EpiGeluBf16 {
    static constexpr bool PERM = true, AFTER_DRAIN = false;
    bf16_t* O; int ldc; const float* bias;
    __device__ __forceinline__ void operator()(const pg8::f32x4 (&acc)[2][2][4][2], const pg8::Unit& u, int wr, int wc, int fr, int fq) const {
        const int row0 = u.pm * 256 + wr * 64 + fr, col0 = u.pn * 256 + wc * 32 + 8 * fq;
        pg8::f32x4 bv[2][2];
#pragma unroll
        for (int bj = 0; bj < 2; ++bj)
#pragma unroll
            for (int n = 0; n < 2; ++n) bv[bj][n] = *(const pg8::f32x4*)(bias + col0 + bj * 128 + 4 * n);
#pragma unroll
        for (int ai = 0; ai < 2; ++ai)
#pragma unroll
            for (int m = 0; m < 4; ++m) { bf16_t* rowp = O + (size_t)(row0 + ai * 128 + m * 16) * ldc + col0;
#pragma unroll
                for (int bj = 0; bj < 2; ++bj) { pg8::f32x4 v0 = acc[ai][bj][m][0] + bv[bj][0], v1 = acc[ai][bj][m][1] + bv[bj][1];
                    const pg8::f32x2 a = pg8::gelu_pk((pg8::f32x2){v0[0], v0[1]}), b = pg8::gelu_pk((pg8::f32x2){v0[2], v0[3]}), c = pg8::gelu_pk((pg8::f32x2){v1[0], v1[1]}), d = pg8::gelu_pk((pg8::f32x2){v1[2], v1[3]});
                    u32x4 w; w.x = cvtpk_s(a.x, a.y); w.y = cvtpk_s(b.x, b.y); w.z = cvtpk_s(c.x, c.y); w.w = cvtpk_s(d.x, d.y);
                    *(u32x4*)(rowp + bj * 128) = w; } }
    }
};
struct EpiResidual {
    static constexpr bool PERM = true, AFTER_DRAIN = false;
    bf16_t* H; const float* gate0; int row_base;
    __device__ __forceinline__ void operator()(const pg8::f32x4 (&acc)[2][2][4][2], const pg8::Unit& u, int wr, int wc, int fr, int fq) const {
        const int row0 = u.pm * 256 + wr * 64 + fr, col0 = u.pn * 256 + wc * 32 + 8 * fq;
        const Tok tk = tokinfo(row_base + u.pm * 256);
        const float* gate = gate0 + (size_t)tk.modrow * 6144 + col0;
        pg8::f32x4 gv[2][2];
#pragma unroll
        for (int bj = 0; bj < 2; ++bj)
#pragma unroll
            for (int n = 0; n < 2; ++n) gv[bj][n] = *(const pg8::f32x4*)(gate + bj * 128 + n * 4);
#pragma unroll
        for (int ai = 0; ai < 2; ++ai)
#pragma unroll
            for (int m = 0; m < 4; ++m) { bf16_t* rowp = H + (size_t)(row0 + ai * 128 + m * 16) * DM + col0;
#pragma unroll
                for (int bj = 0; bj < 2; ++bj) { u32x4* p = (u32x4*)(rowp + bj * 128); const u32x4 h = *p;
                    const pg8::f32x4 v0 = (pg8::f32x4){bflo(h.x), bfhi(h.x), bflo(h.y), bfhi(h.y)} + gv[bj][0] * acc[ai][bj][m][0], v1 = (pg8::f32x4){bflo(h.z), bfhi(h.z), bflo(h.w), bfhi(h.w)} + gv[bj][1] * acc[ai][bj][m][1];
                    *p = (u32x4){cvtpk_s(v0[0], v0[1]), cvtpk_s(v0[2], v0[3]), cvtpk_s(v1[0], v1[1]), cvtpk_s(v1[2], v1[3])}; } }
    }
};
struct ListOrder {
    const LAS int* list; int n; const LAS unsigned* rowtab;
    __device__ __forceinline__ bool next(int i, pg8::Unit& u) const {
        if (i >= n) return false;
        u.pm = __builtin_amdgcn_readfirstlane(list[2 * i]); u.pn = __builtin_amdgcn_readfirstlane(list[2 * i + 1]); u.ui = i; return true;
    }
    __device__ __forceinline__ void a_ready(const pg8::Unit&) const {}
    __device__ __forceinline__ void done(const pg8::Unit&) const {}
};
struct EpiLora {
    static constexpr bool PERM = true, AFTER_DRAIN = false;
    bf16_t* O; const float* bias; int row_base;
    __device__ __forceinline__ void operator()(const pg8::f32x4 (&acc)[2][2][4][2], const pg8::Unit& u, int wr, int wc, int fr, int fq) const {
        const int seg = u.pn >> 1, row0 = row_base + u.pm * 256 + wr * 64 + fr, cs0 = (u.pn & 1) * 256 + wc * 32 + 8 * fq;
        const float ksig = seg < 2 ? -0.60653065971f : 1.0f; const bool lin = seg == 4;
        bf16_t* Os = O + (size_t)seg * NTOK * 512;
#pragma unroll
        for (int bj = 0; bj < 2; ++bj) {
            const int cs = cs0 + bj * 128;
            const pg8::f32x4 b0 = *(const pg8::f32x4*)(bias + seg * 512 + cs), b1 = *(const pg8::f32x4*)(bias + seg * 512 + cs + 4);
#pragma unroll
            for (int ai = 0; ai < 2; ++ai)
#pragma unroll
                for (int m = 0; m < 4; ++m) {
                    pg8::f32x4 v0 = acc[ai][bj][m][0] + b0, v1 = acc[ai][bj][m][1] + b1;
#pragma unroll
                    for (int r = 0; r < 4; ++r) {
                        const float t0 = ksig * __builtin_amdgcn_rcpf(1.0f + __expf(-v0[r])), t1 = ksig * __builtin_amdgcn_rcpf(1.0f + __expf(-v1[r]));
                        v0[r] = lin ? v0[r] : t0; v1[r] = lin ? v1[r] : t1;
                    }
                    u32x4 w; w.x = cvtpk_s(v0[0], v0[1]); w.y = cvtpk_s(v0[2], v0[3]); w.z = cvtpk_s(v1[0], v1[1]); w.w = cvtpk_s(v1[2], v1[3]);
                    *(u32x4*)(Os + (size_t)(row0 + ai * 128 + m * 16) * 512 + cs) = w;
                }
        }
    }
};
constexpr int LDS_TAB = 131072;
constexpr int LDS_LIST = LDS_TAB + 4096;
constexpr int LDS_ROWTAB = LDS_LIST + 1024;
__device__ __forceinline__ ListOrder build_units(LAS unsigned char* lds, int nM, int nN, int G, int c, const LAS int* tile_e, int ncol) {
    LAS int* list = (LAS int*)(lds + LDS_LIST);
    pg8::StaticOrder S; S.nM = nM; S.nN = nN; S.nwg = nM * nN; S.G = G; S.c = c;
    const int tid = tid_opaque();
    if (tid < 64) { pg8::Unit u; if (S.next(tid, u)) { if (tile_e) u.pn = tile_e[u.pm] * ncol + u.pn; list[2 * tid] = u.pm; list[2 * tid + 1] = u.pn; } }
    __syncthreads();
    ListOrder L; L.list = list; L.n = (c < S.nwg) ? (S.nwg - c + G - 1) / G : 0; L.rowtab = (const LAS unsigned*)(lds + LDS_ROWTAB);
    return L;
}
struct EpiMoe1 {
    static constexpr bool PERM = true, AFTER_DRAIN = false;
    bf16_t* O; const float* b1;
    __device__ __forceinline__ void operator()(const pg8::f32x4 (&acc)[2][2][4][2], const pg8::Unit& u, int wr, int wc, int fr, int fq) const {
        const int e = u.pn >> 3, pn = u.pn & 7;
        const int row0 = u.pm * 256 + wr * 64 + fr, ci = pn * 128 + wc * 32 + 8 * fq;
        const float* be = b1 + (size_t)e * 2048 + ci;
        unsigned char* bp = (unsigned char*)O + (size_t)u.pm * 262144 + (size_t)(pn * 4 + wc) * 8192 + (wr * 64 + fr) * 32 + 8 * fq; (void)row0;
        const pg8::f32x4 bg0 = *(const pg8::f32x4*)(be), bg1 = *(const pg8::f32x4*)(be + 4), bl0 = *(const pg8::f32x4*)(be + 1024), bl1 = *(const pg8::f32x4*)(be + 1028);
#pragma unroll
        for (int ai = 0; ai < 2; ++ai)
#pragma unroll
            for (int m = 0; m < 4; ++m) {
                const pg8::f32x4 g0 = acc[ai][0][m][0] + bg0, g1 = acc[ai][0][m][1] + bg1, l0 = acc[ai][1][m][0] + bl0, l1 = acc[ai][1][m][1] + bl1;
                float o[8];
#pragma unroll
                for (int r = 0; r < 4; r += 2) {
#pragma unroll
                    for (int hlf = 0; hlf < 2; ++hlf) {
                        const pg8::f32x4 gv = hlf ? g1 : g0, lv = hlf ? l1 : l0;
                        pg8::f32x2 ga = {fminf(gv[r], 7.0f), fminf(gv[r + 1], 7.0f)};
                        const pg8::f32x2 la = {__builtin_amdgcn_fmed3f(lv[r], -7.0f, 7.0f), __builtin_amdgcn_fmed3f(lv[r + 1], -7.0f, 7.0f)};
                        const pg8::f32x2 t = ga * la + ga, x = ga * (-1.702f * 1.4426950408889634f);
                        pg8::f32x2 e; e.x = __builtin_amdgcn_exp2f(x.x); e.y = __builtin_amdgcn_exp2f(x.y);
                        const pg8::f32x2 d = e * 0.25f + 0.25f;
                        o[4 * hlf + r] = t.x * __builtin_amdgcn_rcpf(d.x); o[4 * hlf + r + 1] = t.y * __builtin_amdgcn_rcpf(d.y);
                    }
                }
                int w0 = __builtin_amdgcn_cvt_pk_fp8_f32(o[0], o[1], 0, false); w0 = __builtin_amdgcn_cvt_pk_fp8_f32(o[2], o[3], w0, true);
                int w1 = __builtin_amdgcn_cvt_pk_fp8_f32(o[4], o[5], 0, false); w1 = __builtin_amdgcn_cvt_pk_fp8_f32(o[6], o[7], w1, true);
                *(u32x2*)(bp + (ai * 128 + m * 16) * 32) = (u32x2){(unsigned)w0, (unsigned)w1};
            }
    }
};
struct EpiMoe2 {
    static constexpr bool PERM = true, AFTER_DRAIN = false, WIDE = true;
    unsigned char* O; const LAS float* btab;
    __device__ __forceinline__ void operator()(const pg8::f32x4 (&acc)[2][2][4][2], const pg8::Unit& u, int wr, int wc, int fr, int fq) const {
        const int pn = u.pn & 3;
        const int row0 = u.pm * 256 + wr * 64 + fr, col0 = pn * 256 + wc * 64 + 16 * fq;
        const LAS float* be = btab + u.ui * 256 + wc * 64 + 16 * fq;
        pg8::f32x4 bv[2][2];
#pragma unroll
        for (int bj = 0; bj < 2; ++bj)
#pragma unroll
            for (int n = 0; n < 2; ++n) bv[bj][n] = *(const LAS pg8::f32x4*)(be + bj * 8 + 4 * n);
#pragma unroll
        for (int ai = 0; ai < 2; ++ai)
#pragma unroll
            for (int m = 0; m < 4; ++m) { unsigned char* rowp = O + (size_t)(row0 + ai * 128 + m * 16) * DM + col0;
                int w[4];
#pragma unroll
                for (int bj = 0; bj < 2; ++bj) { const pg8::f32x4 v0 = (acc[ai][bj][m][0] + bv[bj][0]) * 16.0f, v1 = (acc[ai][bj][m][1] + bv[bj][1]) * 16.0f;
                    int w0 = __builtin_amdgcn_cvt_pk_fp8_f32(v0[0], v0[1], 0, false); w0 = __builtin_amdgcn_cvt_pk_fp8_f32(v0[2], v0[3], w0, true);
                    int w1 = __builtin_amdgcn_cvt_pk_fp8_f32(v1[0], v1[1], 0, false); w1 = __builtin_amdgcn_cvt_pk_fp8_f32(v1[2], v1[3], w1, true);
                    w[2 * bj] = w0; w[2 * bj + 1] = w1; }
                *(u32x4*)rowp = (u32x4){(unsigned)w[0], (unsigned)w[1], (unsigned)w[2], (unsigned)w[3]}; }
    }
};

namespace att {
typedef float f32x16 __attribute__((ext_vector_type(16)));
typedef short s16x4 __attribute__((ext_vector_type(4)));
constexpr int KVBLK = 64, LDR = 512;
constexpr float QSCALE = 0.125f * 1.4426950408889634f;
constexpr int SHM_V = KVBLK * 128 * 2, SHM_K = KVBLK * 64 * 2, SHM_ATTN = 2 * SHM_V + 2 * SHM_K + NWAVES * 64 * 4;
#define ATT_KSWZ(row, colB) ((row) * 128 + ((colB) ^ ((((row) >> 1) & 7) << 4)))
#define ATT_SBAR() __builtin_amdgcn_sched_barrier(0)
__device__ __forceinline__ int crow(int r, int hi) { return (r & 3) + 8 * (r >> 2) + 4 * hi; }
__device__ __forceinline__ unsigned cvtpk(float lo, float hi) { unsigned r; asm volatile("v_cvt_pk_bf16_f32 %0, %1, %2" : "=v"(r) : "v"(lo), "v"(hi)); return r; }
constexpr float SHIFT = -12.0f;
__device__ __forceinline__ void partialSM(f32x16& p0) {
#pragma unroll
    for (int r = 0; r < 16; ++r) p0[r] = __builtin_amdgcn_exp2f(p0[r]);
}
__device__ __forceinline__ void finishSM(f32x16& p0, f32x16& p1, float& l_reg, bf16x8& pa0, bf16x8& pa1, bf16x8& pa2, bf16x8& pa3) {
#pragma unroll
    for (int r = 0; r < 16; ++r) p1[r] = __builtin_amdgcn_exp2f(p1[r]);
    float ps = 0;
#pragma unroll
    for (int r = 0; r < 16; ++r) ps += p0[r];
#pragma unroll
    for (int r = 0; r < 16; ++r) ps += p1[r];
    l_reg += ps;
#define ATT_PK4(P, BASE, OUT) do { unsigned a0 = cvtpk(P[BASE + 0], P[BASE + 1]), a1 = cvtpk(P[BASE + 2], P[BASE + 3]);   \
    unsigned b0 = cvtpk(P[BASE + 4], P[BASE + 5]), b1 = cvtpk(P[BASE + 6], P[BASE + 7]);                              \
    auto r0 = __builtin_amdgcn_permlane32_swap(a0, b0, false, false); auto r1 = __builtin_amdgcn_permlane32_swap(a1, b1, false, false); \
    u32x4 w = {r0[0], r1[0], r0[1], r1[1]}; OUT = __builtin_bit_cast(bf16x8, w); } while (0)
    ATT_PK4(p0, 0, pa0); ATT_PK4(p0, 8, pa1); ATT_PK4(p1, 0, pa2); ATT_PK4(p1, 8, pa3);
#undef ATT_PK4
}
__device__ __forceinline__ void qkt(f32x16& p0, f32x16& p1, const LAS unsigned char* Ks, int qaddr, int r32, int hi) {
    asm volatile("" : "+v"(qaddr)); const LAS unsigned char* qp = (const LAS unsigned char*)(uintptr_t)qaddr;
    bf16x8 qr[4];
#pragma unroll
    for (int d0 = 0; d0 < 4; ++d0) qr[d0] = *(const LAS bf16x8*)(qp + d0 * 1024);
#pragma unroll
    for (int r = 0; r < 16; ++r) { p0[r] = SHIFT; p1[r] = SHIFT; }
#pragma unroll
    for (int d0 = 0; d0 < 4; ++d0) { const int cb = (d0 * 16 + hi * 8) * 2;
        const bf16x8 b0 = *(const LAS bf16x8*)(Ks + ATT_KSWZ(r32, cb));
        const bf16x8 b1 = *(const LAS bf16x8*)(Ks + ATT_KSWZ(32 + r32, cb));
        p0 = __builtin_amdgcn_mfma_f32_32x32x16_bf16(b0, qr[d0], p0, 0, 0, 0);
        p1 = __builtin_amdgcn_mfma_f32_32x32x16_bf16(b1, qr[d0], p1, 0, 0, 0); }
}
__device__ __forceinline__ int v_st(int k, int c) { const int kk = (k & ~0xC) | ((k & 4) << 1) | ((k & 8) >> 1); return ((kk >> 3) * 4 + (c >> 5)) * 512 + ((kk & 7) * 32 + (c & 31)) * 2; }
__device__ __forceinline__ int v_rd_base(int lane) { return ((lane & 3) << 3) | (((lane >> 2) & 3) << 6) | (((lane >> 4) & 1) << 5) | (((lane >> 5) & 1) << 8); }
constexpr int v_rd_off(int d0, int ks, int half) { return d0 * 512 + ks * 4096 + half * 2048; }
template <int OFF> __device__ __forceinline__ s16x4 tr_read(int vb) { s16x4 r; asm volatile("ds_read_b64_tr_b16 %0, %1 offset:%2" : "=&v"(r) : "v"(vb), "i"(OFF) : "memory"); return r; }
template <int D0> __device__ __forceinline__ void pv_one(f32x16& od, int vb, bf16x8 pa0, bf16x8 pa1, bf16x8 pa2, bf16x8 pa3) {
    const s16x4 l0 = tr_read<v_rd_off(D0, 0, 0)>(vb), h0 = tr_read<v_rd_off(D0, 0, 1)>(vb), l1 = tr_read<v_rd_off(D0, 1, 0)>(vb), h1 = tr_read<v_rd_off(D0, 1, 1)>(vb);
    const s16x4 l2 = tr_read<v_rd_off(D0, 2, 0)>(vb), h2 = tr_read<v_rd_off(D0, 2, 1)>(vb), l3 = tr_read<v_rd_off(D0, 3, 0)>(vb), h3 = tr_read<v_rd_off(D0, 3, 1)>(vb);
    asm volatile("s_waitcnt lgkmcnt(0)" ::: "memory"); ATT_SBAR();
#define ATT_PK(L, H) (bf16x8){L[0], L[1], L[2], L[3], H[0], H[1], H[2], H[3]}
    od = __builtin_amdgcn_mfma_f32_32x32x16_bf16(pa0, ATT_PK(l0, h0), od, 0, 0, 0);
    od = __builtin_amdgcn_mfma_f32_32x32x16_bf16(pa1, ATT_PK(l1, h1), od, 0, 0, 0);
    od = __builtin_amdgcn_mfma_f32_32x32x16_bf16(pa2, ATT_PK(l2, h2), od, 0, 0, 0);
    od = __builtin_amdgcn_mfma_f32_32x32x16_bf16(pa3, ATT_PK(l3, h3), od, 0, 0, 0);
#undef ATT_PK
}
__device__ __forceinline__ void pv_d0(f32x16 (&o)[4], int vb, bf16x8 pa0, bf16x8 pa1, bf16x8 pa2, bf16x8 pa3) {
    pv_one<0>(o[0], vb, pa0, pa1, pa2, pa3); pv_one<1>(o[1], vb, pa0, pa1, pa2, pa3); pv_one<2>(o[2], vb, pa0, pa1, pa2, pa3); pv_one<3>(o[3], vb, pa0, pa1, pa2, pa3);
}
__device__ __forceinline__ void attn_body(const bf16_t* Qb, const bf16_t* Kh, const bf16_t* Vh, bf16_t* Ob, int seq, LAS unsigned char* lds) {
    const int tid = tid_opaque(), wid = tid >> 6, lane = tid & 63, r32 = lane & 31, hi = lane >> 5;
    LAS unsigned char* V_lds = lds; LAS unsigned char* K_lds = lds + 2 * SHM_V;
    LAS float* wsl = (LAS float*)(lds + 2 * SHM_V + 2 * SHM_K) + wid * 64; LAS float* li_l = wsl; LAS float* al_l = wsl + 32;
    float l_reg = 0; f32x16 o[4] = {};
    const bf16_t* Qw = Qb + (size_t)(wid * 32 + r32) * LDR + hi * 8;
    LAS unsigned char* qlds = lds + SHM_ATTN + wid * 4096 + lane * 16;
#pragma unroll
    for (int d0 = 0; d0 < 4; ++d0) *(LAS bf16x8*)(qlds + d0 * 1024) = *(const bf16x8*)(Qw + d0 * 16);
    const int qr = (int)(uintptr_t)qlds;
    const int sr = tid >> 4, sc = (tid & 15) * 8, vst0 = v_st(sr, sc), vst1 = v_st(32 + sr, sc);
    const int kr = tid >> 3, kc = (tid & 7) * 8, kst = ATT_KSWZ(kr, kc * 2);
    const int vb0 = (int)(uintptr_t)V_lds + v_rd_base(lane);
    bf16x8 vsA0, vsA1, ksA, vsB0, vsB1, ksB;
#define ATT_SLOAD(V0, V1, K0, k0) do { V0 = *(const bf16x8*)(Vh + (size_t)((k0) + sr) * LDR + sc); V1 = *(const bf16x8*)(Vh + (size_t)((k0) + 32 + sr) * LDR + sc); \
    K0 = *(const bf16x8*)(Kh + (size_t)((k0) + kr) * LDR + kc); } while (0)
#define ATT_SWRITE(b, V0, V1, K0) do { *(LAS bf16x8*)(V_lds + (b) * SHM_V + vst0) = V0; *(LAS bf16x8*)(V_lds + (b) * SHM_V + vst1) = V1; \
    *(LAS bf16x8*)(K_lds + (b) * SHM_K + kst) = K0; } while (0)
#define ATT_SWAIT() asm volatile("s_waitcnt vmcnt(3)" ::: "memory")
    f32x16 p0, p1; bf16x8 pa0, pa1, pa2, pa3; const int NT = seq / KVBLK;
    ATT_SLOAD(vsA0, vsA1, ksA, 0); asm volatile("s_waitcnt vmcnt(0)" ::: "memory"); ATT_SWRITE(0, vsA0, vsA1, ksA);
    ATT_SLOAD(vsB0, vsB1, ksB, KVBLK); if (2 < NT) ATT_SLOAD(vsA0, vsA1, ksA, 2 * KVBLK);
    ATT_SWAIT(); ATT_SWRITE(1, vsB0, vsB1, ksB); __syncthreads();
    for (int j = 0; j < NT; j += 2) {
        ATT_SBAR(); qkt(p0, p1, K_lds, qr, r32, hi); partialSM(p0);
        finishSM(p0, p1, l_reg, pa0, pa1, pa2, pa3); ATT_SBAR();
        if (j + 3 < NT) ATT_SLOAD(vsB0, vsB1, ksB, (j + 3) * KVBLK); ATT_SBAR();
        pv_d0(o, vb0, pa0, pa1, pa2, pa3); ATT_SBAR();
        __syncthreads();
        if (j + 2 < NT) { ATT_SWAIT(); ATT_SWRITE(0, vsA0, vsA1, ksA); }
        asm volatile("" : "+v"(o[0]), "+v"(o[1]), "+v"(o[2]), "+v"(o[3]));
        __syncthreads();
        ATT_SBAR(); qkt(p0, p1, K_lds + SHM_K, qr, r32, hi); partialSM(p0);
        finishSM(p0, p1, l_reg, pa0, pa1, pa2, pa3); ATT_SBAR();
        if (j + 4 < NT) ATT_SLOAD(vsA0, vsA1, ksA, (j + 4) * KVBLK); ATT_SBAR();
        pv_d0(o, vb0 + SHM_V, pa0, pa1, pa2, pa3); ATT_SBAR();
        __syncthreads();
        if (j + 3 < NT) { ATT_SWAIT(); ATT_SWRITE(1, vsB0, vsB1, ksB); }
        asm volatile("" : "+v"(o[0]), "+v"(o[1]), "+v"(o[2]), "+v"(o[3]));
        __syncthreads();
    }
    { auto rr = __builtin_amdgcn_permlane32_swap(__float_as_uint(l_reg), __float_as_uint(l_reg), false, false); l_reg = __uint_as_float(rr[0]) + __uint_as_float(rr[1]); }
    if (hi == 0) li_l[r32] = l_reg; asm volatile("s_waitcnt lgkmcnt(0)" ::: "memory");
    float rli[16];
#pragma unroll
    for (int r = 0; r < 16; ++r) rli[r] = __builtin_amdgcn_rcpf(li_l[crow(r, hi)]);
    bf16_t* Ow = Ob + (size_t)(wid * 32) * LDR;
    const bool oddl = (r32 & 1) != 0;
#pragma unroll
    for (int rp = 0; rp < 8; ++rp) {
        const int orow = oddl ? crow(2 * rp + 1, hi) : crow(2 * rp, hi);
#pragma unroll
        for (int d0 = 0; d0 < 4; ++d0) {
            const float va = o[d0][2 * rp] * rli[2 * rp], vb = o[d0][2 * rp + 1] * rli[2 * rp + 1];
            const float send = oddl ? va : vb, mine = oddl ? vb : va;
            const float recv = __builtin_bit_cast(float, __builtin_amdgcn_update_dpp(0, __builtin_bit_cast(int, send), 0xB1, 0xF, 0xF, false));
            *(unsigned*)(Ow + (size_t)orow * LDR + d0 * 32 + (r32 & ~1)) = oddl ? cvtpk_s(recv, mine) : cvtpk_s(mine, recv);
        }
    }
#undef ATT_SLOAD
#undef ATT_SWRITE
#undef ATT_SWAIT
}
}

__device__ __forceinline__ void ph_gemm_win(const Args& A, int j, int row_lo, LAS unsigned char* lds, int bid, int nb) {
    unsigned char* ws = opq(A.ws); const float* const* IN = (const float* const*)(ws + WS_PTRS); (void)IN;
    pg8::Gemm g{(const bf16_t*)(ws + WS_ABF) + (size_t)row_lo * DM, (const bf16_t*)(ws + WS_WIN) + (size_t)j * ZLD * DM, NTOK - row_lo, ZLD, DM};
    const ListOrder S = build_units(lds, (NTOK - row_lo) / 256, ZLD / 256, nb, bid, nullptr, 0);
    EpiStoreBf16 E{(bf16_t*)(ws + WS_Z) + (size_t)row_lo * ZLD, ZLD};
    pg8::gemm_phase<EpiStoreBf16, ListOrder, true, true>(lds, g, S, E);
}

__device__ __forceinline__ void ph_rwkv_pre(const Args& A, int j, int row_lo, int bid, int nb) {
    unsigned char* ws = opq(A.ws); const float* const* IN = (const float* const*)(ws + WS_PTRS);
    const int tid = tid_opaque(), lane = tid & 63, wid = tid >> 6;
    const bf16_t* Z = (const bf16_t*)(ws + WS_Z);
    const float* mu = INP(I_RWMU) + (size_t)j * 2 * RWC; const float* kkw = INP(I_RWKK) + j * 512;
    bf16_t* RB = (bf16_t*)(ws + WS_RB); bf16_t* KS = (bf16_t*)(ws + WS_KS); bf16_t* VS = (bf16_t*)(ws + WS_VS); bf16_t* KKN = (bf16_t*)(ws + WS_KKN); bf16_t* LIN = (bf16_t*)(ws + WS_LIN);
#define UNPK8(dst, raw) do { _Pragma("unroll") for (int _i = 0; _i < 4; ++_i) { dst[2 * _i] = __builtin_bit_cast(float, raw[_i] << 16); dst[2 * _i + 1] = __builtin_bit_cast(float, raw[_i] & 0xffff0000u); } } while (0)
#define PK8(v) (u32x4){pk2(v[0], v[1]), pk2(v[2], v[3]), pk2(v[4], v[5]), pk2(v[6], v[7])}
    for (int g = row_lo + bid * NWAVES + wid; g < NTOK; g += nb * NWAVES) {
        const Tok tk = tokinfo(g);
        const bool hp = tk.t > 0, hn = tk.t < tk.T - 1;
        const bf16_t* zc = Z + (size_t)g * ZLD;
#pragma unroll
        for (int i = 0; i < 4; ++i) {
            const int ch = i * 64 + lane, col = ch * 8;
            if (ch < 240) {
                const u32x4 zero = {0u, 0u, 0u, 0u};
                const u32x4 cr = *(const u32x4*)(zc + col), pr = hp ? *(const u32x4*)(zc - ZLD + col) : zero, nr = hn ? *(const u32x4*)(zc + ZLD + col) : zero;
                float z[8], p[8], n[8], s8[8];
                UNPK8(z, cr); UNPK8(p, pr); UNPK8(n, nr);
                const f32x4 m0a = *(const f32x4*)(mu + col), m0b = *(const f32x4*)(mu + col + 4), m1a = *(const f32x4*)(mu + RWC + col), m1b = *(const f32x4*)(mu + RWC + col + 4);
#pragma unroll
                for (int e = 0; e < 4; ++e) { s8[e] = z[e] + m0a[e] * (p[e] - z[e]) + m1a[e] * (n[e] - z[e]); s8[4 + e] = z[4 + e] + m0b[e] * (p[4 + e] - z[4 + e]) + m1b[e] * (n[4 + e] - z[4 + e]); }
                if (col < 512) *(u32x4*)(RB + (size_t)g * 512 + col) = PK8(s8);
                else if (col < 1024) {
                    const int ck = col - 512;
                    *(u32x4*)(KS + (size_t)g * 512 + ck) = PK8(s8);
                    const f32x4 kwa = *(const f32x4*)(kkw + ck), kwb = *(const f32x4*)(kkw + ck + 4);
                    float kk[8]; float ss = 0.f;
#pragma unroll
                    for (int e = 0; e < 4; ++e) { kk[e] = s8[e] * kwa[e]; kk[4 + e] = s8[4 + e] * kwb[e]; ss += kk[e] * kk[e] + kk[4 + e] * kk[4 + e]; }
                    ss += __shfl_xor(ss, 1); ss += __shfl_xor(ss, 2); ss += __shfl_xor(ss, 4);
                    const float inv = 1.0f / fmaxf(sqrtf(ss), 1e-12f);
#pragma unroll
                    for (int e = 0; e < 8; ++e) kk[e] *= inv;
                    *(u32x4*)(KKN + (size_t)g * 512 + ck) = PK8(kk);
                }
                else if (col < 1536) *(u32x4*)(VS + (size_t)g * 512 + (col - 1024)) = PK8(s8);
                else {
                    float t8[8];
#pragma unroll
                    for (int e = 0; e < 8; ++e) t8[e] = col < 1664 ? tanhf(s8[e]) : (col < 1792 ? s8[e] : sigmoidf_(s8[e]));
                    *(u32x4*)(LIN + (size_t)g * 384 + (col - 1536)) = PK8(t8);
                }
            }
        }
    }
#undef UNPK8
#undef PK8
}
__device__ __forceinline__ void ph_gemm_lora(const Args& A, int j, int row_lo, LAS unsigned char* lds, int bid, int nb) {
    unsigned char* ws = opq(A.ws);
    int Kq = LORA_K; asm volatile("" : "+s"(Kq));
    pg8::Gemm g{(const bf16_t*)(ws + WS_LIN) + (size_t)row_lo * LORA_K, (const bf16_t*)(ws + WS_WLORA) + (size_t)j * LORA_N * LORA_K, NTOK - row_lo, LORA_N, Kq};
    const ListOrder S = build_units(lds, (NTOK - row_lo) / 256, LORA_N / 256, nb, bid, nullptr, 0);
    EpiLora E{(bf16_t*)(ws + WS_LO), (const float*)(ws + WS_LBIAS) + (size_t)j * LORA_N, row_lo};
    pg8::gemm_phase<EpiLora, ListOrder, true, true>(lds, g, S, E);
}

constexpr int R_A2 = 0, R_RT = 2048, R_BT = 4096, R_KT = 6144, R_VT = 8192, R_MBR = 10240, R_MKR = 10752, R_G = 11264, R_P = 11776;
__device__ __forceinline__ bf16x8 frag4(u32x2 lo) { const u32x4 w = {lo.x, lo.y, 0u, 0u}; return __builtin_bit_cast(bf16x8, w); }
__device__ __forceinline__ bf16x8 frag8(u32x2 lo, u32x2 hi) { const u32x4 w = {lo.x, lo.y, hi.x, hi.y}; return __builtin_bit_cast(bf16x8, w); }
__device__ __forceinline__ u32x2 pack4(f32x4 v) { u32x2 o; o.x = cvtpk_s(v[0], v[1]); o.y = cvtpk_s(v[2], v[3]); return o; }
__device__ __forceinline__ int wkv_token(int b, int dir, int s) {
    if (s < TC) return b * TC + (dir ? (TC - 1 - s) : s);
    const int q = s - TC; return NCTX + b * TL + (dir ? (TL - 1 - q) : q);
}
__device__ __forceinline__ float dpp_row_shr(float x, const int n) {
    switch (n) {
        case 1: return __builtin_bit_cast(float, __builtin_amdgcn_update_dpp(0, __builtin_bit_cast(int, x), 0x111, 0xF, 0xF, false));
        case 2: return __builtin_bit_cast(float, __builtin_amdgcn_update_dpp(0, __builtin_bit_cast(int, x), 0x112, 0xF, 0xF, false));
        case 4: return __builtin_bit_cast(float, __builtin_amdgcn_update_dpp(0, __builtin_bit_cast(int, x), 0x114, 0xF, 0xF, false));
        default: return __builtin_bit_cast(float, __builtin_amdgcn_update_dpp(0, __builtin_bit_cast(int, x), 0x118, 0xF, 0xF, false));
    }
}
#define WKV_TR(dst, addr) asm volatile("ds_read_b64_tr_b16 %0, %1" : "=&v"(dst) : "v"(addr) : "memory")
__device__ __forceinline__ void wkv_produce(unsigned char* ws, const float* const* IN, int j, int b, int h, int dir, int c, LAS unsigned char* wl, LAS unsigned char* rec, int lane) {
    const int c16 = lane & 15, g4 = lane >> 4;
    constexpr int RS = 144;
    LAS unsigned char* Lat = wl; LAS unsigned char* Lbt = wl + 2304; LAS unsigned char* Lkt = wl + 4608; LAS unsigned char* Lrt = wl + 6912; LAS unsigned char* Lvt = wl + 9216;
    LAS float* Lnf = (LAS float*)(wl + 11520);
    LAS unsigned char* Lx = wl + 12608;
    const size_t FS = (size_t)NTOK * 512;
    const bf16_t* RB = (const bf16_t*)(ws + WS_RB); const bf16_t* KS = (const bf16_t*)(ws + WS_KS); const bf16_t* VS = (const bf16_t*)(ws + WS_VS); const bf16_t* KKN = (const bf16_t*)(ws + WS_KKN);
#define UNPK16(dst, p) do { const u32x4 _a = *(const u32x4*)(p), _b = *(const u32x4*)((p) + 8); _Pragma("unroll") for (int _i = 0; _i < 4; ++_i) { \
        dst[2 * _i] = __builtin_bit_cast(float, _a[_i] << 16); dst[2 * _i + 1] = __builtin_bit_cast(float, _a[_i] & 0xffff0000u); \
        dst[8 + 2 * _i] = __builtin_bit_cast(float, _b[_i] << 16); dst[9 + 2 * _i] = __builtin_bit_cast(float, _b[_i] & 0xffff0000u); } } while (0)
#define PK16ST(base, v) do { *(LAS u32x4*)(base) = (u32x4){pk2(v[0], v[1]), pk2(v[2], v[3]), pk2(v[4], v[5]), pk2(v[6], v[7])}; \
        *(LAS u32x4*)((base) + 16) = (u32x4){pk2(v[8], v[9]), pk2(v[10], v[11]), pk2(v[12], v[13]), pk2(v[14], v[15])}; } while (0)
    {
        const int g0 = wkv_token(b, dir, c * 16), gstep = dir ? -1 : 1;
        {
            const size_t o = (size_t)(g0 + gstep * c16) * 512 + h * 64 + 16 * g4;
            float lw[16], av[16], kv[16], kn[16], rv[16];
            UNPK16(lw, (const bf16_t*)(ws + WS_LO) + dir * FS + o); UNPK16(av, (const bf16_t*)(ws + WS_AB) + dir * FS + o);
            UNPK16(kv, KS + o); UNPK16(kn, KKN + o); UNPK16(rv, RB + o);
            { const u32x4 v0 = *(const u32x4*)(VS + o), v1 = *(const u32x4*)(VS + o + 8); *(LAS u32x4*)(Lvt + c16 * RS + 32 * g4) = v0; *(LAS u32x4*)(Lvt + c16 * RS + 32 * g4 + 16) = v1; }
            const float* kap = INP(I_RWKA) + j * 512 + h * 64 + 16 * g4;
            float at[16], bt[16], kt[16], rt[16], ecl[16];
#pragma unroll
            for (int i = 0; i < 16; ++i) {
                float cs = lw[i];
                cs += dpp_row_shr(cs, 1); cs += dpp_row_shr(cs, 2); cs += dpp_row_shr(cs, 4); cs += dpp_row_shr(cs, 8);
                const float ep = __expf(cs - lw[i]), ec = __expf(cs), em = __builtin_amdgcn_rcpf(ec);
                at[i] = -kn[i] * ep; bt[i] = kn[i] * av[i] * em; kt[i] = kv[i] * (1.0f + (av[i] - 1.0f) * kap[i]) * em; rt[i] = rv[i] * ec; ecl[i] = ec;
            }
            PK16ST(Lat + c16 * RS + 32 * g4, at); PK16ST(Lbt + c16 * RS + 32 * g4, bt); PK16ST(Lkt + c16 * RS + 32 * g4, kt); PK16ST(Lrt + c16 * RS + 32 * g4, rt);
            if (c16 == 15) {
#pragma unroll
                for (int q = 0; q < 4; ++q) *(LAS f32x4*)(rec + R_P + (16 * g4 + 4 * q) * 4) = (f32x4){ecl[4 * q], ecl[4 * q + 1], ecl[4 * q + 2], ecl[4 * q + 3]};
            }
        }
        asm volatile("s_waitcnt lgkmcnt(0)" ::: "memory");
        f32x4 nD = {0.f, 0.f, 0.f, 0.f}, makD = nD, mbrD = nD, mkrD = nD;
#pragma unroll
        for (int ks = 0; ks < 2; ++ks) {
            const int off = c16 * RS + (32 * ks + 8 * g4) * 2;
            const bf16x8 fa = *(const LAS bf16x8*)(Lat + off), fb = *(const LAS bf16x8*)(Lbt + off), fk = *(const LAS bf16x8*)(Lkt + off), fr = *(const LAS bf16x8*)(Lrt + off);
            nD = __builtin_amdgcn_mfma_f32_16x16x32_bf16(fa, fb, nD, 0, 0, 0);
            makD = __builtin_amdgcn_mfma_f32_16x16x32_bf16(fa, fk, makD, 0, 0, 0);
            mbrD = __builtin_amdgcn_mfma_f32_16x16x32_bf16(fb, fr, mbrD, 0, 0, 0);
            mkrD = __builtin_amdgcn_mfma_f32_16x16x32_bf16(fk, fr, mkrD, 0, 0, 0);
        }
#pragma unroll
        for (int r = 0; r < 4; ++r) {
            const int row = 4 * g4 + r;
            nD[r] = (c16 < row) ? nD[r] : 0.f; makD[r] = (c16 < row) ? makD[r] : 0.f;
            mbrD[r] = (row <= c16) ? mbrD[r] : 0.f; mkrD[r] = (row <= c16) ? mkrD[r] : 0.f;
            Lnf[row * 17 + c16] = nD[r];
        }
        asm volatile("s_waitcnt lgkmcnt(0)" ::: "memory");
        float x[16];
#pragma unroll
        for (int t = 0; t < 16; ++t) {
            float acc = (t == c16) ? 1.f : 0.f;
#pragma unroll
            for (int i = 0; i < t; ++i) acc += Lnf[t * 17 + i] * x[i];
            x[t] = acc;
        }
        if (g4 == 0) {
#pragma unroll
            for (int t = 0; t < 16; ++t) *(LAS bf16_t*)(Lx + t * 32 + c16 * 2) = (bf16_t)f2bf(x[t]);
        }
        asm volatile("s_waitcnt lgkmcnt(0)" ::: "memory");
        const bf16x8 xB = frag4(*(const LAS u32x2*)(Lx + c16 * 32 + g4 * 8));
        const f32x4 z4 = {0.f, 0.f, 0.f, 0.f};
        const f32x4 gD = __builtin_amdgcn_mfma_f32_16x16x32_bf16(frag4(pack4(makD)), xB, z4, 0, 0, 0);
        *(LAS u32x2*)(rec + R_G + (c16 * 16 + 4 * g4) * 2) = pack4(gD);
        *(LAS u32x2*)(rec + R_MBR + (c16 * 16 + 4 * g4) * 2) = pack4(mbrD);
        *(LAS u32x2*)(rec + R_MKR + (c16 * 16 + 4 * g4) * 2) = pack4(mkrD);
        {
            const int trow = c16 >> 2, tcol = 4 * (c16 & 3);
            u32x2 ta[4], tb[4], tk[4], tv[4];
#pragma unroll
            for (int m = 0; m < 4; ++m) {
                const int aA = (int)(uintptr_t)(Lat + (4 * g4 + trow) * RS + (16 * m + tcol) * 2);
                const int offr = (4 * m + trow) * RS + (16 * g4 + tcol) * 2;
                const int aB = (int)(uintptr_t)(Lbt + offr), aK = (int)(uintptr_t)(Lkt + offr), aV = (int)(uintptr_t)(Lvt + offr);
                WKV_TR(ta[m], aA); WKV_TR(tb[m], aB); WKV_TR(tk[m], aK); WKV_TR(tv[m], aV);
            }
            asm volatile("s_waitcnt lgkmcnt(0)" ::: "memory"); __builtin_amdgcn_sched_barrier(0);
#pragma unroll
            for (int m = 0; m < 4; ++m) {
                const f32x4 d = __builtin_amdgcn_mfma_f32_16x16x32_bf16(frag4(ta[m]), xB, z4, 0, 0, 0);
                *(LAS u32x2*)(rec + R_A2 + (c16 * 64 + 16 * m + 4 * g4) * 2) = pack4(d);
            }
            const int kch = 16 * g4 + c16;
            *(LAS u32x4*)(rec + R_BT + kch * 32) = (u32x4){tb[0].x, tb[0].y, tb[1].x, tb[1].y}; *(LAS u32x4*)(rec + R_BT + kch * 32 + 16) = (u32x4){tb[2].x, tb[2].y, tb[3].x, tb[3].y};
            *(LAS u32x4*)(rec + R_KT + kch * 32) = (u32x4){tk[0].x, tk[0].y, tk[1].x, tk[1].y}; *(LAS u32x4*)(rec + R_KT + kch * 32 + 16) = (u32x4){tk[2].x, tk[2].y, tk[3].x, tk[3].y};
            *(LAS u32x4*)(rec + R_VT + kch * 32) = (u32x4){tv[0].x, tv[0].y, tv[1].x, tv[1].y}; *(LAS u32x4*)(rec + R_VT + kch * 32 + 16) = (u32x4){tv[2].x, tv[2].y, tv[3].x, tv[3].y};
        }
        { const int row = lane >> 2, cb = (lane & 3) * 16;
          const u32x4 r0 = *(const LAS u32x4*)(Lrt + row * RS + cb * 2), r1 = *(const LAS u32x4*)(Lrt + row * RS + cb * 2 + 16);
          *(LAS u32x4*)(rec + R_RT + (row * 64 + cb) * 2) = r0; *(LAS u32x4*)(rec + R_RT + (row * 64 + cb) * 2 + 16) = r1; }
        asm volatile("s_waitcnt lgkmcnt(0)" ::: "memory");
    }
#undef UNPK16
#undef PK16ST
}

struct QkC { float qn[8], kn[8], invf[8]; bool upper, colaxis; };
__device__ __forceinline__ void qk_init(QkC& q, const float* const* IN, int j, int lane) {
    const int d0 = (lane & 7) * 8;
#pragma unroll
    for (int i = 0; i < 8; ++i) { q.qn[i] = INP(I_QN)[j * 64 + d0 + i]; q.kn[i] = INP(I_KN)[j * 64 + d0 + i]; q.invf[i] = __powf(10000.0f, -(float)((d0 + i) & 15) / 16.0f); }
    q.upper = (d0 & 16) != 0; q.colaxis = (d0 & 32) != 0;
}
__device__ __forceinline__ void qk_token(const QkC& q, unsigned char* ws, int g, int lane) {
    const bf16_t* Z = (const bf16_t*)(ws + WS_Z);
    bf16_t* QB = (bf16_t*)(ws + WS_QB); bf16_t* KB = (bf16_t*)(ws + WS_KB); bf16_t* VB = (bf16_t*)(ws + WS_VB);
    const bool upper = q.upper, colaxis = q.colaxis;
    {
        const Tok tk = tokinfo(g);
        const size_t krow = (size_t)tk.b * (TC + TL) + (tk.T == TL ? TC + tk.t : tk.t);
        const bf16_t* zr = Z + (size_t)g * ZLD + RWC;
        *(u32x4*)(VB + krow * 512 + lane * 8) = *(const u32x4*)(zr + 1024 + lane * 8);
        float cs[8], sn[8];
        if (tk.T == TL) {
            const float pos = (float)(colaxis ? (tk.t & 63) : (tk.t >> 6));
#pragma unroll
            for (int i = 0; i < 8; ++i) __sincosf(pos * q.invf[i], &sn[i], &cs[i]);
        }
#pragma unroll
        for (int isk = 0; isk < 2; ++isk) {
            const u32x4 raw = *(const u32x4*)(zr + isk * 512 + lane * 8);
            float x[8];
#pragma unroll
            for (int i = 0; i < 4; ++i) { x[2 * i] = __builtin_bit_cast(float, raw[i] << 16); x[2 * i + 1] = __builtin_bit_cast(float, raw[i] & 0xffff0000u); }
            float ss = 0.f;
#pragma unroll
            for (int i = 0; i < 8; ++i) ss += x[i] * x[i];
            ss += __shfl_xor(ss, 1); ss += __shfl_xor(ss, 2); ss += __shfl_xor(ss, 4);
            const float rs = rsqrtf(ss * (1.0f / 64.0f) + 1e-6f);
#pragma unroll
            for (int i = 0; i < 8; ++i) x[i] = x[i] * rs * (isk ? q.kn[i] : q.qn[i] * att::QSCALE);
            if (tk.T == TL) {
#pragma unroll
                for (int i = 0; i < 8; ++i) { const float other = __shfl_xor(x[i], 2); x[i] = upper ? (x[i] * cs[i] + other * sn[i]) : (x[i] * cs[i] - other * sn[i]); }
            }
            u32x4 o; o.x = pk2(x[0], x[1]); o.y = pk2(x[2], x[3]); o.z = pk2(x[4], x[5]); o.w = pk2(x[6], x[7]);
            if (isk) *(u32x4*)(KB + krow * 512 + lane * 8) = o; else *(u32x4*)(QB + (size_t)g * 512 + lane * 8) = o;
        }
    }
}
__device__ __forceinline__ void ph_wkv_fused(const Args& A, int j, int row_lo, LAS unsigned char* lds, int bid, int nb) {
    unsigned char* ws = opq(A.ws); const float* const* IN = (const float* const*)(ws + WS_PTRS);
    const int tid = tid_opaque(), lane = tid & 63, wid = __builtin_amdgcn_readfirstlane(tid >> 6), c16 = lane & 15, g4 = lane >> 4;
    bf16_t* YS = (bf16_t*)(ws + WS_YS); const size_t FS = (size_t)NTOK * 512;
    constexpr int RING = 8 * WKV_REC, NRND = WKV_NCH / 4;
    static_assert(WKV_NCH % 4 == 0, "four chunks per round");
#define WKV_WGBAR() do { asm volatile("s_waitcnt lgkmcnt(0)" ::: "memory"); __builtin_amdgcn_s_barrier(); asm volatile("" ::: "memory"); } while (0)
    for (int inst = bid; inst < 256; inst += nb) {
        const int dir = inst & 1, h = (inst >> 1) & 7, b = inst >> 4;
        WKV_WGBAR();
        if (wid >= 4) {
            LAS unsigned char* wl = lds + RING + (wid - 4) * 13824;
            for (int r = 0; r < NRND; ++r) {
                wkv_produce(ws, IN, j, b, h, dir, 4 * r + (wid - 4), wl, lds + ((r & 1) * 4 + (wid - 4)) * WKV_REC, lane);
                WKV_WGBAR();
            }
            WKV_WGBAR();
        } else {
            const int v0 = wid * 16;
            bf16_t* Y = YS + dir * FS + h * 64 + v0 + (c16 & ~1); const bool oddl = (c16 & 1) != 0;
            f32x4 S[4];
#pragma unroll
            for (int mt = 0; mt < 4; ++mt) S[mt] = (f32x4){0.f, 0.f, 0.f, 0.f};
            QkC qc; qk_init(qc, IN, j, lane);
            WKV_WGBAR();
            for (int r = 0; r < NRND; ++r) {
                for (int k = 0; k < 4; ++k) {
                    const int c = 4 * r + k;
                    const LAS unsigned char* rec = lds + ((r & 1) * 4 + k) * WKV_REC;
                    u32x2 a2[4], rt[4], bt[4], kt[4]; f32x4 p[4];
    #pragma unroll
                    for (int q = 0; q < 4; ++q) {
                        a2[q] = *(const LAS u32x2*)(rec + R_A2 + (c16 * 64 + 16 * q + 4 * g4) * 2);
                        rt[q] = *(const LAS u32x2*)(rec + R_RT + (c16 * 64 + 16 * q + 4 * g4) * 2);
                        bt[q] = *(const LAS u32x2*)(rec + R_BT + ((16 * q + c16) * 16 + 4 * g4) * 2);
                        kt[q] = *(const LAS u32x2*)(rec + R_KT + ((16 * q + c16) * 16 + 4 * g4) * 2);
                        p[q] = *(const LAS f32x4*)(rec + R_P + (16 * q + 4 * g4) * 4);
                    }
                    const u32x2 gq = *(const LAS u32x2*)(rec + R_G + (c16 * 16 + 4 * g4) * 2), mkr = *(const LAS u32x2*)(rec + R_MKR + (c16 * 16 + 4 * g4) * 2), mbr = *(const LAS u32x2*)(rec + R_MBR + (c16 * 16 + 4 * g4) * 2);
                    const u32x2 vt = *(const LAS u32x2*)(rec + R_VT + ((v0 + c16) * 16 + 4 * g4) * 2);
                    const f32x4 z4 = {0.f, 0.f, 0.f, 0.f};
                    const bf16x8 sb0 = frag8(pack4(S[0]), pack4(S[1])), sb1 = frag8(pack4(S[2]), pack4(S[3]));
                    const bf16x8 vb = frag4(vt);
                    f32x4 U = __builtin_amdgcn_mfma_f32_16x16x32_bf16(frag4(gq), vb, z4, 0, 0, 0);
                    U = __builtin_amdgcn_mfma_f32_16x16x32_bf16(frag8(a2[0], a2[1]), sb0, U, 0, 0, 0);
                    U = __builtin_amdgcn_mfma_f32_16x16x32_bf16(frag8(a2[2], a2[3]), sb1, U, 0, 0, 0);
                    f32x4 Yt = __builtin_amdgcn_mfma_f32_16x16x32_bf16(frag4(mkr), vb, z4, 0, 0, 0);
                    Yt = __builtin_amdgcn_mfma_f32_16x16x32_bf16(frag8(rt[0], rt[1]), sb0, Yt, 0, 0, 0);
                    Yt = __builtin_amdgcn_mfma_f32_16x16x32_bf16(frag8(rt[2], rt[3]), sb1, Yt, 0, 0, 0);
                    const bf16x8 ub = frag4(pack4(U));
                    Yt = __builtin_amdgcn_mfma_f32_16x16x32_bf16(frag4(mbr), ub, Yt, 0, 0, 0);
    #pragma unroll
                    for (int mt = 0; mt < 4; ++mt) {
                        f32x4 sn = __builtin_amdgcn_mfma_f32_16x16x32_bf16(frag4(kt[mt]), vb, S[mt], 0, 0, 0);
                        sn = __builtin_amdgcn_mfma_f32_16x16x32_bf16(frag4(bt[mt]), ub, sn, 0, 0, 0);
                        S[mt] = sn * p[mt];
                    }
    #pragma unroll
                    for (int q = 0; q < 2; ++q) {
                        const float send = oddl ? Yt[q] : Yt[2 + q], mine = oddl ? Yt[2 + q] : Yt[q];
                        const float recv = __builtin_bit_cast(float, __builtin_amdgcn_update_dpp(0, __builtin_bit_cast(int, send), 0xB1, 0xF, 0xF, false));
                        *(unsigned*)(Y + (size_t)wkv_token(b, dir, c * 16 + 4 * g4 + (oddl ? 2 + q : q)) * 512) = oddl ? cvtpk_s(recv, mine) : cvtpk_s(mine, recv);
                    }
                }
                if (inst == bid) {
                    for (int g = row_lo + bid * 4 + wid + r * (nb * 4); g < NTOK; g += nb * 4 * NRND) qk_token(qc, ws, g, lane);
                }
                WKV_WGBAR();
            }
        }
    }
#undef WKV_WGBAR
}

__device__ __forceinline__ void ph_attn(const Args& A, bool want_ctx, LAS unsigned char* lds, int bid, int nb) {
    unsigned char* ws = opq(A.ws);
    const bf16_t* QB = (const bf16_t*)(ws + WS_QB); const bf16_t* KB = (const bf16_t*)(ws + WS_KB); const bf16_t* VB = (const bf16_t*)(ws + WS_VB);
    bf16_t* OP = (bf16_t*)(ws + WS_OP);
    const int vcu = (nb % 8 == 0) ? (bid % 8) * (nb / 8) + bid / 8 : bid;
    const int nunits = 1024 + (want_ctx ? 128 : 0);
    for (int u = vcu; u < nunits; u += nb) {
        int b, h, m, q0, seq;
        if (u < 1024) { const int qb = u & 7; m = (u >> 3) & 1; h = (u >> 4) & 3; b = u >> 6; q0 = NCTX + b * TL + qb * 256; seq = TC + TL; }
        else { const int v = u - 1024; m = v & 1; h = (v >> 1) & 3; b = v >> 3; q0 = b * TC; seq = TC; }
        const int s = h * 2 + m;
        att::attn_body(QB + (size_t)q0 * 512 + s * 64, KB + (size_t)b * (TC + TL) * 512 + s * 64, VB + (size_t)b * (TC + TL) * 512 + h * 128,
                       OP + (size_t)m * NTOK * 512 + (size_t)q0 * 512 + h * 128, seq, lds);
    }
}

__device__ __forceinline__ void ph_merge(const Args& A, int l, int row_lo, int bid, int nb) {
    unsigned char* ws = opq(A.ws); const float* const* IN = (const float* const*)(ws + WS_PTRS);
    const int j = l >> 1;
    const int tid = tid_opaque(), lane = tid & 63, wid = tid >> 6, c0 = lane * 8;
    const float lam_init = 0.8f - 0.6f * __expf(-0.3f * (float)l);
    const float* lp = INP(I_LAM) + j * 4 * 64;
    const float lam = __expf(wave_sum(lp[lane] * lp[64 + lane])) - __expf(wave_sum(lp[128 + lane] * lp[192 + lane])) + lam_init;
    const size_t FS = (size_t)NTOK * 512;
    const bf16_t* RB = (const bf16_t*)(ws + WS_RB); const bf16_t* KS = (const bf16_t*)(ws + WS_KS); const bf16_t* VS = (const bf16_t*)(ws + WS_VS);
    const bf16_t* AB = (const bf16_t*)(ws + WS_AB); const bf16_t* GB = (const bf16_t*)(ws + WS_GB);
    const bf16_t* YS = (const bf16_t*)(ws + WS_YS); const bf16_t* OP = (const bf16_t*)(ws + WS_OP);
    bf16_t* CAT = (bf16_t*)(ws + WS_CAT);
    float gnw[8], gnb[8], kaw[8], rkw[8], sub[8];
#pragma unroll
    for (int i = 0; i < 8; ++i) { gnw[i] = INP(I_GNW)[j * 512 + c0 + i]; gnb[i] = INP(I_GNB)[j * 512 + c0 + i]; kaw[i] = INP(I_RWKA)[j * 512 + c0 + i]; rkw[i] = INP(I_RWRK)[j * 512 + c0 + i];
        sub[i] = INP(I_SUBLN)[j * 128 + ((c0 + i) & 127)] * (1.0f - lam_init); }
#define LD8BF(dst, ptr) do { const u32x4 _t = *(const u32x4*)(ptr); _Pragma("unroll") for (int _i = 0; _i < 4; ++_i) { dst[2 * _i] = __builtin_bit_cast(float, _t[_i] << 16); dst[2 * _i + 1] = __builtin_bit_cast(float, _t[_i] & 0xffff0000u); } } while (0)
#define CV8BF(dst, _t) do { _Pragma("unroll") for (int _i = 0; _i < 4; ++_i) { dst[2 * _i] = __builtin_bit_cast(float, _t[_i] << 16); dst[2 * _i + 1] = __builtin_bit_cast(float, _t[_i] & 0xffff0000u); } } while (0)
#define MLOAD(P, gi) do { const size_t _o = (size_t)(gi) * 512 + c0; \
        P##y = *(const u32x4*)(YS + _o); P##z = *(const u32x4*)(YS + FS + _o); \
        P##r = *(const u32x4*)(RB + _o); P##k = *(const u32x4*)(KS + _o); P##v = *(const u32x4*)(VS + _o); P##a0 = *(const u32x4*)(AB + _o); P##a1 = *(const u32x4*)(AB + FS + _o); P##g = *(const u32x4*)(GB + _o); \
        P##p = *(const u32x4*)(OP + _o); P##q = *(const u32x4*)(OP + FS + _o); } while (0)
    const int gstep = nb * NWAVES;
    int g = row_lo + bid * NWAVES + wid;
    u32x4 c_y, c_z, c_p, c_q, c_r, c_k, c_v, c_a0, c_a1, c_g;
    if (g < NTOK) MLOAD(c_, g);
    for (; g < NTOK; g += gstep) {
        u32x4 n_y, n_z, n_p, n_q, n_r, n_k, n_v, n_a0, n_a1, n_g;
        { const int gn = (g + gstep < NTOK) ? g + gstep : g; MLOAD(n_, gn); }
        float y[8], r_[8], k_[8], v_[8], a0[8], a1[8], gg[8];
        { float yb[8]; CV8BF(y, c_y); CV8BF(yb, c_z);
#pragma unroll
          for (int i = 0; i < 8; ++i) y[i] += yb[i]; }
        CV8BF(r_, c_r); CV8BF(k_, c_k); CV8BF(v_, c_v); CV8BF(a0, c_a0); CV8BF(a1, c_a1); CV8BF(gg, c_g);
        float sy = 0.f, sb = 0.f;
#pragma unroll
        for (int i = 0; i < 8; ++i) { sy += y[i]; sb += r_[i] * k_[i] * (2.0f + (a0[i] + a1[i] - 2.0f) * kaw[i]) * rkw[i]; }
        sy += __shfl_xor(sy, 1); sy += __shfl_xor(sy, 2); sy += __shfl_xor(sy, 4);
        sb += __shfl_xor(sb, 1); sb += __shfl_xor(sb, 2); sb += __shfl_xor(sb, 4);
        const float mu = sy * (1.0f / 64.0f);
        float sv = 0.f;
#pragma unroll
        for (int i = 0; i < 8; ++i) { y[i] -= mu; sv += y[i] * y[i]; }
        sv += __shfl_xor(sv, 1); sv += __shfl_xor(sv, 2); sv += __shfl_xor(sv, 4);
        const float rstd = rsqrtf(sv * (1.0f / 64.0f) + 64e-5f);
        float ya[8];
#pragma unroll
        for (int i = 0; i < 8; ++i) ya[i] = (y[i] * rstd * gnw[i] + gnb[i] + sb * v_[i]) * gg[i];
        { u32x4 w; w.x = pk2(ya[0], ya[1]); w.y = pk2(ya[2], ya[3]); w.z = pk2(ya[4], ya[5]); w.w = pk2(ya[6], ya[7]); *(u32x4*)(CAT + (size_t)g * DM + c0) = w; }
        float od[8];
        { float ob[8]; CV8BF(od, c_p); CV8BF(ob, c_q);
#pragma unroll
          for (int i = 0; i < 8; ++i) od[i] -= lam * ob[i]; }
        float so = 0.f;
#pragma unroll
        for (int i = 0; i < 8; ++i) so += od[i] * od[i];
        so += __shfl_xor(so, 1); so += __shfl_xor(so, 2); so += __shfl_xor(so, 4); so += __shfl_xor(so, 8);
        const float ro = rsqrtf(so * (1.0f / 128.0f) + 1e-6f);
        { u32x4 w; w.x = pk2(od[0] * ro * sub[0], od[1] * ro * sub[1]); w.y = pk2(od[2] * ro * sub[2], od[3] * ro * sub[3]);
          w.z = pk2(od[4] * ro * sub[4], od[5] * ro * sub[5]); w.w = pk2(od[6] * ro * sub[6], od[7] * ro * sub[7]); *(u32x4*)(CAT + (size_t)g * DM + 512 + c0) = w; }
        c_y = n_y; c_z = n_z; c_p = n_p; c_q = n_q;
        c_r = n_r; c_k = n_k; c_v = n_v; c_a0 = n_a0; c_a1 = n_a1; c_g = n_g;
    }
#undef MLOAD
#undef CV8BF
#undef LD8BF
}

__device__ __forceinline__ void ph_gemm_out(const Args& A, int l, size_t x_off, size_t wt_off, int row_lo, LAS unsigned char* lds, int bid, int nb) {
    unsigned char* ws = opq(A.ws); const float* const* IN = (const float* const*)(ws + WS_PTRS); (void)IN;
    pg8::Gemm g{(const bf16_t*)(ws + x_off) + (size_t)row_lo * DM, (const bf16_t*)(ws + wt_off), NTOK - row_lo, DM, DM};
    const ListOrder S = build_units(lds, (NTOK - row_lo) / 256, DM / 256, nb, bid, nullptr, 0);
    EpiResidual E{(bf16_t*)(ws + WS_H) + (size_t)row_lo * DM, (const float*)(ws + WS_MOD) + (size_t)l * 17 * 6144 + 2 * 1024, row_lo};
    pg8::gemm_phase<EpiResidual, ListOrder, true, true>(lds, g, S, E);
}

__device__ __forceinline__ void ph_gemm_sgin(const Args& A, int j, int row_lo, LAS unsigned char* lds, int bid, int nb) {
    unsigned char* ws = opq(A.ws); const float* const* IN = (const float* const*)(ws + WS_PTRS); (void)IN;
    pg8::Gemm g{(const bf16_t*)(ws + WS_ABF) + (size_t)row_lo * DM, (const bf16_t*)(ws + WS_SGIN) + (size_t)j * 2048 * DM, NTOK - row_lo, 2048, DM};
    const ListOrder S = build_units(lds, (NTOK - row_lo) / 256, 2048 / 256, nb, bid, nullptr, 0);
    EpiGeluBf16 E{(bf16_t*)(ws + WS_Z2) + (size_t)row_lo * 2048, 2048, INP(I_SGBIN) + j * 2048};
    pg8::gemm_phase<EpiGeluBf16, ListOrder, true, true>(lds, g, S, E);
}
__device__ __forceinline__ void ph_sgu_stats(const Args& A, int row_lo, int bid, int nb) {
    unsigned char* ws = opq(A.ws);
    const int tid = tid_opaque(), lane = tid & 63, wid = tid >> 6;
    const bf16_t* Z2 = (const bf16_t*)(ws + WS_Z2); float* ST = (float*)(ws + WS_VST);
    for (int row = row_lo + bid * NWAVES + wid; row < NTOK; row += nb * NWAVES) {
        const u32x4 t0 = *(const u32x4*)(Z2 + (size_t)row * 2048 + 1024 + lane * 8), t1 = *(const u32x4*)(Z2 + (size_t)row * 2048 + 1536 + lane * 8);
        float v[16]; float s = 0.f;
#pragma unroll
        for (int i = 0; i < 4; ++i) { v[2 * i] = __builtin_bit_cast(float, t0[i] << 16); v[2 * i + 1] = __builtin_bit_cast(float, t0[i] & 0xffff0000u);
            v[8 + 2 * i] = __builtin_bit_cast(float, t1[i] << 16); v[9 + 2 * i] = __builtin_bit_cast(float, t1[i] & 0xffff0000u); }
#pragma unroll
        for (int i = 0; i < 16; ++i) s += v[i];
        const float mean = wave_sum(s) * (1.0f / 1024.0f); float s2 = 0.f;
#pragma unroll
        for (int i = 0; i < 16; ++i) { const float d = v[i] - mean; s2 += d * d; }
        const float rstd = rsqrtf(wave_sum(s2) * (1.0f / 1024.0f) + 1e-5f);
        if (lane == 0) { ST[(size_t)row * 2] = mean; ST[(size_t)row * 2 + 1] = rstd; }
    }
}
__device__ __forceinline__ void ph_sgu_spatial(const Args& A, int j, int row_lo, LAS unsigned char* lds, int bid, int nb) {
    unsigned char* ws = opq(A.ws); const float* const* IN = (const float* const*)(ws + WS_PTRS);
    const int tid = tid_opaque(), lane = tid & 63, wid = tid >> 6, c16 = lane & 15, g4 = lane >> 4;
    const bf16_t* Z2 = (const bf16_t*)(ws + WS_Z2); const float* ST = (const float*)(ws + WS_VST); bf16_t* G = (bf16_t*)(ws + WS_G);
    constexpr int VS = 272;
    LAS unsigned char* vt = lds;
    LAS float* stl = (LAS float*)(lds + 36864);
    const int ch0 = row_lo / 128, nch = NTOK / 128 - ch0;
    for (int u = bid; u < nch * 8; u += nb) {
        const int ci = ch0 + u / 8, g = u % 8;
        const size_t r0 = (size_t)ci * 128;
        __syncthreads();
#pragma unroll
        for (int i = 0; i < 4; ++i) {
            const int idx = tid + NTHREADS * i, q = idx >> 4, jc = idx & 15;
            const u32x4 t = *(const u32x4*)(Z2 + (r0 + q) * 2048 + 1024 + g * 128 + jc * 8);
#pragma unroll
            for (int e = 0; e < 4; ++e) {
                const int c = jc * 8 + 2 * e, w = c & 31, rho = 16 * (2 * (c >> 5) + ((w >> 2) & 1)) + 4 * (w >> 3) + (w & 3);
                *(LAS bf16_t*)(vt + rho * VS + q * 2) = (bf16_t)(t[e] & 0xffffu); *(LAS bf16_t*)(vt + (rho + 1) * VS + q * 2) = (bf16_t)(t[e] >> 16); }
        }
        if (tid < 256) stl[tid] = ST[r0 * 2 + tid];
        __syncthreads();
        const float* wrow = INP(I_SGWS) + (((size_t)j * 8 + g) * 128 + 16 * wid + c16) * 128;
        bf16x8 af[4]; float wm = 0.f, rs = 0.f;
#pragma unroll
        for (int ks = 0; ks < 4; ++ks) {
            const int q0 = 32 * ks + 8 * g4;
            const f32x4 w0 = *(const f32x4*)(wrow + q0), w1 = *(const f32x4*)(wrow + q0 + 4);
            float wv[8] = {w0[0], w0[1], w0[2], w0[3], w1[0], w1[1], w1[2], w1[3]};
#pragma unroll
            for (int e = 0; e < 8; ++e) { rs += wv[e]; wv[e] *= stl[(q0 + e) * 2 + 1]; wm += wv[e] * stl[(q0 + e) * 2]; }
            const u32x4 pk = {pk2(wv[0], wv[1]), pk2(wv[2], wv[3]), pk2(wv[4], wv[5]), pk2(wv[6], wv[7])};
            af[ks] = __builtin_bit_cast(bf16x8, pk);
        }
        wm += __shfl_xor(wm, 16); wm += __shfl_xor(wm, 32); rs += __shfl_xor(rs, 16); rs += __shfl_xor(rs, 32);
        f32x4 acc[8];
#pragma unroll
        for (int nt = 0; nt < 8; ++nt) acc[nt] = (f32x4){0.f, 0.f, 0.f, 0.f};
#pragma unroll
        for (int ks = 0; ks < 4; ++ks)
#pragma unroll
            for (int nt = 0; nt < 8; ++nt) {
                const bf16x8 bfr = *(const LAS bf16x8*)(vt + (16 * nt + c16) * VS + (32 * ks + 8 * g4) * 2);
                acc[nt] = __builtin_amdgcn_mfma_f32_16x16x32_bf16(bfr, af[ks], acc[nt], 0, 0, 0);
            }
        const float bs = INP(I_SGBS)[((size_t)j * 8 + g) * 128 + 16 * wid + c16];
        const size_t row = r0 + 16 * wid + c16;
#pragma unroll
        for (int k = 0; k < 4; ++k) {
            const int c = g * 128 + 32 * k + 8 * g4;
            const f32x4 lg0 = *(const f32x4*)(INP(I_SGLNG) + j * 1024 + c), lg1 = *(const f32x4*)(INP(I_SGLNG) + j * 1024 + c + 4), lb0 = *(const f32x4*)(INP(I_SGLNB) + j * 1024 + c), lb1 = *(const f32x4*)(INP(I_SGLNB) + j * 1024 + c + 4);
            const u32x4 uu = *(const u32x4*)(Z2 + row * 2048 + c);
            const f32x4 s0 = lg0 * (acc[2 * k] - wm) + lb0 * rs + bs, s1 = lg1 * (acc[2 * k + 1] - wm) + lb1 * rs + bs;
            u32x4 o;
            o.x = cvtpk_s(bflo(uu.x) * s0[0], bfhi(uu.x) * s0[1]); o.y = cvtpk_s(bflo(uu.y) * s0[2], bfhi(uu.y) * s0[3]);
            o.z = cvtpk_s(bflo(uu.z) * s1[0], bfhi(uu.z) * s1[1]); o.w = cvtpk_s(bflo(uu.w) * s1[2], bfhi(uu.w) * s1[3]);
            *(u32x4*)(G + row * DM + c) = o;
        }
    }
}

__device__ __forceinline__ int moe_layout(const Args& A, int l, int bid, int nb, LAS int* off  , LAS int* cntl  , LAS int* tile_e  , LAS int* base  ) {
    const int tid = tid_opaque();
    const int* bc = (const int*)(opq(A.ws) + WS_BCNT) + (size_t)l * 256 * 32;
    if (tid < 32) { cntl[tid] = 0; base[tid] = 0; }
    __syncthreads();
    {
        const int e = tid & 31, g = tid >> 5, per = (nb + 15) >> 4, b0 = g * per, b1 = (b0 + per < nb) ? b0 + per : nb;
        int n = 0, pre = 0;
#pragma unroll 16
        for (int b = b0; b < b1; ++b) { const int c = bc[b * 32 + e]; n += c; pre += (b < bid) ? c : 0; }
        __hip_atomic_fetch_add(cntl + e, n, __ATOMIC_RELAXED, __HIP_MEMORY_SCOPE_WORKGROUP);
        __hip_atomic_fetch_add(base + e, pre, __ATOMIC_RELAXED, __HIP_MEMORY_SCOPE_WORKGROUP);
    }
    __syncthreads();
    if (tid < 64) {
        int n = 0, pre = 0;
        if (tid < 32) { n = cntl[tid]; pre = base[tid]; }
        const int nt = (n + 255) >> 8;
        int x = nt;
#pragma unroll
        for (int o = 1; o < 32; o <<= 1) { const int y = __shfl_up(x, o); if (tid >= o) x += y; }
        const int start = x - nt;
        if (tid < 32) {
            cntl[tid] = n; off[tid] = start * 256; base[tid] = start * 256 + pre;
#pragma unroll 1
            for (int t = 0; t < nt; ++t) tile_e[start + t] = tid;
        }
        if (tid == 31) off[32] = x * 256;
    }
    __syncthreads();
    return off[32] >> 8;
}
__device__ __forceinline__ void ph_moe_scatter(const Args& A, int l, int row_lo, LAS unsigned char* lds, int bid, int nb) {
    unsigned char* ws = opq(A.ws);
    const int tid = tid_opaque();
    LAS int* off = (LAS int*)(lds + LDS_TAB); LAS int* cntl = off + 64; LAS int* tile_e = off + 128; LAS int* base = off + 800;
    moe_layout(A, l, bid, nb, off, cntl, tile_e, base);
    const int* te = (const int*)(ws + WS_TOKE); const int* tr = (const int*)(ws + WS_TOKR); int* rowof = (int*)(ws + WS_ROWOF); int* srcrow = (int*)(ws + WS_SRCROW);
    const int ngroups = (NTOK - row_lo) / 16, per = nb * NWAVES;
    const int nmine = (ngroups - bid * NWAVES + per - 1) / per * NWAVES;
    for (int q = tid; q < nmine * 64; q += NTHREADS) {
        const int slot = q >> 6, r = (q >> 2) & 15, k = q & 3, i = slot >> 3, w = slot & 7;
        const int u = i * per + bid * NWAVES + w;
        if (u < ngroups) {
            const int row = row_lo + 16 * u + r;
            const int e = te[(size_t)row * 4 + k];
            const int pos = base[e] + tr[(size_t)row * 4 + k];
            rowof[(size_t)row * 4 + k] = pos; srcrow[pos] = row;
        }
    }
    for (int e = bid; e < 32; e += nb) {
        const int r0 = off[e] + cntl[e], r1 = off[e + 1];
        for (int i = r0 + tid; i < r1; i += NTHREADS) srcrow[i] = NCTX;
    }
}
__device__ __forceinline__ void ph_moe_gemm1(const Args& A, int l, LAS unsigned char* lds, int bid, int nb) {
    unsigned char* ws = opq(A.ws); const float* const* IN = (const float* const*)(ws + WS_PTRS); (void)IN;
    LAS int* off = (LAS int*)(lds + LDS_TAB); LAS int* cntl = off + 64; LAS int* tile_e = off + 128; LAS int* base = off + 800;
    const int T = moe_layout(A, l, bid, nb, off, cntl, tile_e, base);
    int Kq = DM / 2; asm volatile("" : "+s"(Kq));
    pg8::Gemm g{(const bf16_t*)(ws + WS_ABF), (const bf16_t*)(ws + WS_W1 + (size_t)l * NE * 2048 * DM), T * 256, 2048, Kq};
    const ListOrder S = build_units(lds, T, 8, nb, bid, tile_e, 8);
    { LAS unsigned* rowtab = (LAS unsigned*)(lds + LDS_ROWTAB); const int* srcrow = (const int*)(ws + WS_SRCROW); const int tid = tid_opaque();
      for (int q = tid; q < S.n * 256; q += NTHREADS) rowtab[q] = (unsigned)srcrow[S.list[2 * (q >> 8)] * 256 + (q & 255)] * (unsigned)DM;
      __syncthreads(); }
    EpiMoe1 E{(bf16_t*)(ws + WS_ACT), INP(I_B1) + (size_t)l * NE * 2048};
    pg8::gemm_phase<EpiMoe1, ListOrder, true, true, true, true>(lds, g, S, E);
}
__device__ __forceinline__ void ph_moe_gemm2(const Args& A, int l, LAS unsigned char* lds, int bid, int nb) {
    unsigned char* ws = opq(A.ws); const float* const* IN = (const float* const*)(ws + WS_PTRS); (void)IN;
    LAS int* off = (LAS int*)(lds + LDS_TAB); LAS int* cntl = off + 64; LAS int* tile_e = off + 128; LAS int* base = off + 800;
    const int T = moe_layout(A, l, bid, nb, off, cntl, tile_e, base);
    int Kq = DM / 2; asm volatile("" : "+s"(Kq));
    pg8::Gemm g{(const bf16_t*)(ws + WS_ACT), (const bf16_t*)(ws + WS_W2 + (size_t)l * NE * DM * DM), T * 256, DM, Kq, 0x77777777, 0x7d7d7d7d};
    const ListOrder S = build_units(lds, T, 4, nb, bid, tile_e, 4);
    LAS float* btab = (LAS float*)(lds + LDS_ROWTAB);
    { const float* b2 = INP(I_B2) + (size_t)l * NE * DM; const int tid = tid_opaque();
      for (int q = tid; q < S.n * 256; q += NTHREADS) { const int png = S.list[2 * (q >> 8) + 1]; btab[q] = b2[(size_t)(png >> 2) * DM + (png & 3) * 256 + (q & 255)]; }
      __syncthreads(); }
    EpiMoe2 E{ws + WS_YM, btab};
    pg8::gemm_phase<EpiMoe2, ListOrder, true, true, false, true, true>(lds, g, S, E);
}
__device__ __forceinline__ void ph_moe_combine(const Args& A, int l, int row_lo, bool last, int bid, int nb, bool dry = false) {
    unsigned char* ws = opq(A.ws); const float* const* IN = (const float* const*)(ws + WS_PTRS);
    const int tid = tid_opaque(), lane = tid & 63, wid = tid >> 6;
    bf16_t* H = (bf16_t*)(ws + WS_H); const float* mod = (const float*)(ws + WS_MOD); const bf16_t* YM = (const bf16_t*)(ws + WS_YM);
    bf16_t* Hw = dry ? (bf16_t*)(ws + WS_XP) : H;
    const int* rowof = (const int*)(ws + WS_ROWOF); const float* tg = (const float*)(ws + WS_TOKG);
    bf16_t* abf = dry ? (bf16_t*)(ws + WS_XP + (size_t)NTOK * DM * 4) : (bf16_t*)(ws + WS_ABF);
    const int ln = last ? l : l + 1;
    const float* gp = INP(I_N1G) + ln * 1024;
    for (int row = row_lo + bid * NWAVES + wid; row < NTOK; row += nb * NWAVES) {
        const Tok tk = tokinfo(row);
        const float* gate = mod + ((size_t)l * 17 + tk.modrow) * 6144 + 5 * 1024;
        int r[4]; float gk[4];
#pragma unroll
        for (int k = 0; k < 4; ++k) { r[k] = rowof[(size_t)row * 4 + k]; gk[k] = tg[(size_t)row * 4 + k]; }
        const unsigned char* YM8 = (const unsigned char*)YM;
        u32x4 y[4];
#pragma unroll
        for (int k = 0; k < 4; ++k) { y[k] = *(const u32x4*)(YM8 + (size_t)r[k] * DM + lane * 16); gk[k] *= (1.0f / 16.0f); }
        const int col = lane * 16;
        f32x4 hv[4]; float ss = 0.f;
        const u32x4 hb0 = *(const u32x4*)(H + (size_t)row * DM + col), hb1 = *(const u32x4*)(H + (size_t)row * DM + col + 8);
#pragma unroll
        for (int q = 0; q < 4; ++q) {
            f32x4 m = (f32x4){0.f, 0.f, 0.f, 0.f};
#pragma unroll
            for (int k = 0; k < 4; ++k) { const auto lo2 = __builtin_amdgcn_cvt_pk_f32_fp8((int)y[k][q], false), hi2 = __builtin_amdgcn_cvt_pk_f32_fp8((int)y[k][q], true);
                m = m + (f32x4){lo2[0], lo2[1], hi2[0], hi2[1]} * gk[k]; }
            { const unsigned h0 = (q >> 1) ? hb1[2 * (q & 1)] : hb0[2 * (q & 1)], h1 = (q >> 1) ? hb1[2 * (q & 1) + 1] : hb0[2 * (q & 1) + 1];
              hv[q] = (f32x4){bflo(h0), bfhi(h0), bflo(h1), bfhi(h1)} + *(const f32x4*)(gate + col + 4 * q) * m; }
            if (last && !dry) *(f32x4*)(as_global(((float* const*)IN)[38]) + (size_t)(row - NCTX) * DM + col + 4 * q) = hv[q];
            ss += (hv[q].x * hv[q].x + hv[q].y * hv[q].y) + (hv[q].z * hv[q].z + hv[q].w * hv[q].w);
        }
        if (!last || dry) { *(u32x4*)(Hw + (size_t)row * DM + col) = (u32x4){pk2(hv[0].x, hv[0].y), pk2(hv[0].z, hv[0].w), pk2(hv[1].x, hv[1].y), pk2(hv[1].z, hv[1].w)};
                            *(u32x4*)(Hw + (size_t)row * DM + col + 8) = (u32x4){pk2(hv[2].x, hv[2].y), pk2(hv[2].z, hv[2].w), pk2(hv[3].x, hv[3].y), pk2(hv[3].z, hv[3].w)}; }
        if (!last) {
            const float rstd = rsqrtf(wave_sum(ss) * (1.0f / DM) + 1e-6f);
            const float* mrow = mod + ((size_t)ln * 17 + tk.modrow) * 6144;
            u32x4 o[2];
#pragma unroll
            for (int q = 0; q < 4; ++q) {
                const f32x4 g = *(const f32x4*)(gp + col + 4 * q), sc = *(const f32x4*)(mrow + 1024 + col + 4 * q), sh = *(const f32x4*)(mrow + col + 4 * q);
                const f32x4 v = (hv[q] * rstd * g) * (sc + 1.0f) + sh;
                o[q >> 1][2 * (q & 1)] = pk2(v.x, v.y); o[q >> 1][2 * (q & 1) + 1] = pk2(v.z, v.w);
            }
            *(u32x4*)(abf + (size_t)row * DM + col) = o[0]; *(u32x4*)(abf + (size_t)row * DM + col + 8) = o[1];
        }
    }
}

__global__ void __launch_bounds__(NTHREADS, 2) fwd_kernel(Args A) {
    extern __shared__ __attribute__((aligned(16))) unsigned char lds_raw[];
    LAS unsigned char* lds = (LAS unsigned char*)lds_raw;
    volatile LAS unsigned* misc = (volatile LAS unsigned*)(lds + LDS_MISC);
    const int tid = threadIdx.x, bid = blockIdx.x, nb = gridDim.x;
    if (tid < 64) misc[tid] = 0u;
    __syncthreads();
    XcdBarrier bar = xcd_barrier_post((unsigned*)(A.ws + WS_CTL) + CW_BAR, misc + 8);
    const int lo = A.ph_lo, hi = A.ph_hi;
    int pc = 0;
#ifndef PHSEL
#define PHSEL -1
#endif
#define SEL(k) (PHSEL < 0 || PHSEL == (k))
#ifndef REPEAT_MASK
#define REPEAT_MASK 0
#endif
#define RUN(k, call) do { if (SEL(k)) { call; if ((REPEAT_MASK >> (k)) & 1) { xcd_barrier(bar); call; } } } while (0)
#define PH_BEGIN if (pc >= lo && pc < hi) {
#define PH_END } if (pc >= lo && pc + 1 < hi) xcd_barrier(bar); ++pc;

    PH_BEGIN RUN(0, ph_prologue(A, lds, bid, nb)); PH_END

    for (int l = 0; l < 4; ++l) {
        const int j = l >> 1;
        const bool ctx_out = (l < 2), ctx_in = (l < 3);
        const int rin = ctx_in ? 0 : NCTX, rout = ctx_out ? 0 : NCTX;
        if (l == 0) { PH_BEGIN RUN(1, ph_norm<false>(A, l, rin, lds, bid, nb)); PH_END }
        if ((l & 1) == 0) {
            PH_BEGIN RUN(2, ph_gemm_win(A, j, rin, lds, bid, nb)); PH_END
            PH_BEGIN RUN(3, ph_rwkv_pre(A, j, rin, bid, nb)); PH_END
            PH_BEGIN RUN(19, ph_gemm_lora(A, j, rin, lds, bid, nb)); PH_END
            PH_BEGIN RUN(5, ph_wkv_fused(A, j, rin, lds, bid, nb)); PH_END
            PH_BEGIN RUN(6, ph_attn(A, ctx_out, lds, bid, nb)); PH_END
            PH_BEGIN RUN(7, ph_merge(A, l, rout, bid, nb)); PH_END
            PH_BEGIN RUN(8, ph_gemm_out(A, l, WS_CAT, WS_WOUT + (size_t)j * DM * DM * 2, rout, lds, bid, nb)); PH_END
        } else {
            PH_BEGIN RUN(9, ph_gemm_sgin(A, j, rin, lds, bid, nb)); PH_END
            PH_BEGIN RUN(10, ph_sgu_stats(A, rin, bid, nb)); PH_END
            PH_BEGIN RUN(11, ph_sgu_spatial(A, j, rout, lds, bid, nb)); PH_END
            PH_BEGIN RUN(12, ph_gemm_out(A, l, WS_G, WS_SGOUT + (size_t)j * DM * DM * 2, rout, lds, bid, nb)); PH_END
        }
        PH_BEGIN RUN(13, ph_norm2_router(A, l, rout, lds, bid, nb)); PH_END
        PH_BEGIN RUN(14, ph_moe_scatter(A, l, rout, lds, bid, nb)); PH_END
        PH_BEGIN RUN(15, ph_moe_gemm1(A, l, lds, bid, nb)); PH_END
        PH_BEGIN RUN(16, ph_moe_gemm2(A, l, lds, bid, nb)); PH_END
        PH_BEGIN if (SEL(17)) { if ((REPEAT_MASK >> 17) & 1) { ph_moe_combine(A, l, rout, l == 3, bid, nb, true); xcd_barrier(bar); } ph_moe_combine(A, l, rout, l == 3, bid, nb); } PH_END
    }
}

extern "C" void kernel_launch(void* const* d_in, const int* in_sizes, int n_in, void* d_out, int out_size, void* d_ws, size_t ws_size, hipStream_t stream) {
    static int grid = 0;
    if (grid == 0) {
        if (n_in != 38 || out_size != NLAT * DM || ws_size < WS_END) { fprintf(stderr, "kernel_launch: unexpected shapes: n_in %d out %d ws %zu (need %zu)\n", n_in, out_size, ws_size, (size_t)WS_END); grid = -1; return; }
        int dev = 0, cus = 0, per_cu = 0;
        if (hipGetDevice(&dev) != hipSuccess || hipDeviceGetAttribute(&cus, hipDeviceAttributeMultiprocessorCount, dev) != hipSuccess) { grid = -1; return; }
        if (hipFuncSetAttribute((const void*)fwd_kernel, hipFuncAttributeMaxDynamicSharedMemorySize, LDS_BYTES) != hipSuccess) { fprintf(stderr, "kernel_launch: hipFuncSetAttribute failed\n"); grid = -1; return; }
        if (hipOccupancyMaxActiveBlocksPerMultiprocessor(&per_cu, (const void*)fwd_kernel, NTHREADS, LDS_BYTES) != hipSuccess || per_cu < 1)
            fprintf(stderr, "kernel_launch: occupancy query reports %d workgroups per CU\n", per_cu);
        (void)hipGetLastError();
        grid = cus;
    }
    if (grid < 0) return;
    if (hipMemsetAsync((char*)d_ws + WS_CTL, 0, CTL_ZERO_BYTES, stream) != hipSuccess) { fprintf(stderr, "kernel_launch: memset failed\n"); return; }
    Args a{};
    for (int i = 0; i < 38; ++i) a.in[i] = (const float*)d_in[i];
    a.out = (float*)d_out; a.ws = (unsigned char*)d_ws; a.ph_lo = 0; a.ph_hi = 1 << 20;
    hipLaunchKernelGGL(fwd_kernel, dim3(grid), dim3(NTHREADS), LDS_BYTES, stream, a);
    const hipError_t le = hipPeekAtLastError();
    if (le != hipSuccess) fprintf(stderr, "kernel_launch: launch failed: %s\n", hipGetErrorName(le));
}
```

```cpp
#include <hip/hip_runtime.h>
#include <cstdio>
#include <cstdint>

#define LAS __attribute__((address_space(3)))
typedef unsigned short bf16_t;
typedef short bf16x8 __attribute__((ext_vector_type(8)));
typedef float f32x4 __attribute__((ext_vector_type(4)));
typedef unsigned u32x4 __attribute__((ext_vector_type(4)));
typedef unsigned u32x2 __attribute__((ext_vector_type(2)));

constexpr int DM = 1024, NB = 16, TL = 2048, TC = 256;
constexpr int NCTX = NB * TC, NLAT = NB * TL, NTOK = NCTX + NLAT;
constexpr int RWC = 1920, EVC = 3456, ZLD = 3584;
constexpr int NE = 32;
constexpr int XPROWS = NTOK * 4 + NE * 256;
constexpr int NTHREADS = 512, NWAVES = 8;

constexpr size_t MiB = 1u << 20;
constexpr size_t al256(size_t x) { return (x + 255) & ~(size_t)255; }
constexpr size_t WS_CTL = 0, CTL_ZERO_BYTES = 1 * MiB - 4096;
constexpr size_t WS_PTRS = 1 * MiB - 4096;
constexpr size_t WS_MOD = 1 * MiB;
constexpr size_t WS_RTWT = al256(WS_MOD + (size_t)4 * 17 * 6144 * 4);
constexpr size_t WS_WIN = al256(WS_RTWT + (size_t)4 * 32 * 1024 * 4);
constexpr size_t WS_WOUT = al256(WS_WIN + (size_t)2 * ZLD * DM * 2);
constexpr size_t WS_SGIN = al256(WS_WOUT + (size_t)2 * DM * DM * 2);
constexpr size_t WS_SGOUT = al256(WS_SGIN + (size_t)2 * 2048 * DM * 2);
constexpr int LORA_N = 2560, LORA_K = 384;
constexpr size_t WS_WLORA = al256(WS_SGOUT + (size_t)2 * DM * DM * 2);
constexpr size_t WS_LBIAS = al256(WS_WLORA + (size_t)2 * LORA_N * LORA_K * 2);
constexpr size_t WS_W1 = al256(WS_LBIAS + (size_t)2 * LORA_N * 4);
constexpr size_t WS_W2 = al256(WS_W1 + (size_t)4 * NE * 2048 * DM * 2);
constexpr size_t WS_H = al256(WS_W2 + (size_t)4 * NE * DM * DM * 2);
constexpr size_t WS_ABF = al256(WS_H + (size_t)NTOK * DM * 4);
constexpr size_t WS_TOKE = al256(WS_ABF + (size_t)NTOK * DM * 2);
constexpr size_t WS_TOKG = al256(WS_TOKE + (size_t)NTOK * 4 * 4);
constexpr size_t WS_ROWOF = al256(WS_TOKG + (size_t)NTOK * 4 * 4);
constexpr size_t WS_TOKR = al256(WS_ROWOF + (size_t)NTOK * 4 * 4);
constexpr size_t WS_BCNT = al256(WS_TOKR + (size_t)NTOK * 4 * 4);
constexpr size_t WS_SRCROW = al256(WS_BCNT + (size_t)4 * 256 * 32 * 4);
constexpr size_t WS_R = al256(WS_SRCROW + (size_t)XPROWS * 4);
constexpr size_t FSZ = (size_t)NTOK * 512 * 4;
constexpr size_t WS_Z = WS_R;
constexpr size_t HSZ = (size_t)NTOK * 512 * 2;
constexpr size_t WS_RB = al256(WS_Z + (size_t)NTOK * ZLD * 2);
constexpr size_t WS_KS = WS_RB + HSZ, WS_VS = WS_KS + HSZ, WS_KKN = WS_VS + HSZ;
constexpr size_t WS_LIN = WS_KKN + HSZ;
constexpr size_t WS_LO = al256(WS_LIN + (size_t)NTOK * 384 * 2);
constexpr size_t WS_AB = WS_LO + 2 * HSZ;
constexpr size_t WS_GB = WS_LO + 4 * HSZ;
constexpr size_t WS_YS = WS_LO + 5 * HSZ;
constexpr size_t WS_QB = WS_YS + 2 * FSZ;
constexpr size_t WS_KB = WS_QB + FSZ / 2;
constexpr size_t WS_VB = WS_KB + FSZ / 2;
constexpr size_t WS_OP = WS_VB + FSZ / 2;
constexpr size_t WS_CAT = WS_OP + 2 * FSZ;
constexpr int WKV_REC = 12288, WKV_NCH = (TC + TL) / 16;
constexpr size_t WS_WKV = al256(WS_CAT + (size_t)NTOK * DM * 2);
constexpr size_t WS_EVEN_END = WS_WKV + (size_t)256 * WKV_NCH * WKV_REC;
constexpr size_t WS_Z2 = WS_R;
constexpr size_t WS_VST = al256(WS_Z2 + (size_t)NTOK * 2048 * 2);
constexpr size_t WS_G = al256(WS_VST + (size_t)NTOK * 2 * 4);
constexpr size_t WS_ODD_END = WS_G + (size_t)NTOK * DM * 2;
constexpr size_t WS_XP = WS_R;
constexpr size_t WS_ACT = al256(WS_XP + (size_t)XPROWS * DM * 2);
constexpr size_t WS_YM = al256(WS_ACT + (size_t)XPROWS * DM * 2);
constexpr size_t WS_MOE_END = WS_YM + (size_t)XPROWS * DM * 2;
constexpr size_t WS_END = (WS_EVEN_END > WS_MOE_END ? (WS_EVEN_END > WS_ODD_END ? WS_EVEN_END : WS_ODD_END) : (WS_MOE_END > WS_ODD_END ? WS_MOE_END : WS_ODD_END));

constexpr int CW_BAR = 4096;
constexpr int CW_CNT = 16384;
constexpr int CW_CUR = 16384 + 256;

constexpr int LDS_BYTES = 163840;
constexpr int LDS_MISC = 160 * 1024 - 256;

__device__ __forceinline__ unsigned f2bf(float f) { unsigned u = __builtin_bit_cast(unsigned, f); return (u + 0x7fffu + ((u >> 16) & 1u)) >> 16; }
typedef float f32x2_t __attribute__((ext_vector_type(2))); typedef __bf16 bf16x2_t __attribute__((ext_vector_type(2)));
__device__ __forceinline__ unsigned pk2(float lo, float hi) { f32x2_t v = {lo, hi}; bf16x2_t b = __builtin_convertvector(v, bf16x2_t); return __builtin_bit_cast(unsigned, b); }
__device__ __forceinline__ unsigned cvtpk_s(float lo, float hi) { f32x2_t v = {lo, hi}; bf16x2_t b = __builtin_convertvector(v, bf16x2_t); return __builtin_bit_cast(unsigned, b); }
__device__ __forceinline__ float bf2f(bf16_t b) { return __builtin_bit_cast(float, (unsigned)b << 16); }
__device__ __forceinline__ float bflo(unsigned p) { return __builtin_bit_cast(float, p << 16); }
__device__ __forceinline__ float bfhi(unsigned p) { return __builtin_bit_cast(float, p & 0xffff0000u); }
__device__ __forceinline__ float wave_sum(float v) {
#pragma unroll
    for (int o = 1; o < 64; o <<= 1) v += __shfl_xor(v, o);
    return v;
}
__device__ __forceinline__ int tid_opaque() { int t = threadIdx.x; asm volatile("" : "+v"(t)); return t; }
#define GAS __attribute__((address_space(1)))
template <class T> __device__ __forceinline__ T* as_global(T* p) { return (T*)(GAS T*)p; }
__device__ __forceinline__ unsigned char* opq(unsigned char* p) { GAS unsigned char* g = (GAS unsigned char*)p; asm volatile("" : "+s"(g)); return (unsigned char*)g; }
__device__ __forceinline__ float rdl(float v, int k) { return __builtin_bit_cast(float, __builtin_amdgcn_readlane(__builtin_bit_cast(int, v), k)); }
__device__ __forceinline__ float sigmoidf_(float x) { return 1.0f / (1.0f + __expf(-x)); }

#define XB_TMO      128
#define XB_XCNT(j)  (256  + 64 * (j))
#define XB_XSUB(j)  (1280 + 64 * (j))
#define XB_XGEN(j)  (2304 + 64 * (j))
#define XB_TOP      3328
#define XB_TOPGEN   3392
#define XCD_BAR_WORDS 3456
#define XB_SPIN_CAP (1u << 22)
__device__ __forceinline__ unsigned xb_ld(unsigned* p)              { return __hip_atomic_load(p, __ATOMIC_RELAXED, __HIP_MEMORY_SCOPE_AGENT); }
__device__ __forceinline__ unsigned xb_add(unsigned* p, unsigned v) { return __hip_atomic_fetch_add(p, v, __ATOMIC_RELAXED, __HIP_MEMORY_SCOPE_AGENT); }
__device__ __forceinline__ unsigned xb_xcc_id() { return (unsigned)__builtin_amdgcn_s_getreg((3 << 11) | 20) & 0xFu; }
#define XB_SPIN(cond, bar) do { unsigned _sp = 0; while (cond) { __builtin_amdgcn_s_sleep(1); \
    if ((++_sp & 255u) == 0u) { if (xb_ld(&(bar)[XB_TMO])) break; if (_sp > XB_SPIN_CAP) { atomicAdd(&(bar)[XB_TMO], 1u); break; } } } } while (0)
struct XcdBarrier { unsigned* bar; unsigned x; volatile LAS unsigned* st; };
__device__ __forceinline__ XcdBarrier xcd_barrier_post(unsigned* bar, volatile LAS unsigned* st) {
    XcdBarrier b; b.bar = bar; b.x = xb_xcc_id(); b.st = st;
    if (threadIdx.x == 0) (void)xb_add(&bar[XB_XCNT(b.x)], 1u);
    return b;
}
__device__ __forceinline__ void xcd_barrier_complete(unsigned* bar, unsigned x, unsigned& nloc, unsigned& nx) {
    const unsigned G = gridDim.x * gridDim.y * gridDim.z;
    unsigned sum, cnt, mine, sp = 0u;
    for (;;) {
        sum = 0u; cnt = 0u; mine = 0u;
#pragma unroll
        for (unsigned j = 0; j < 16; ++j) { const unsigned c = xb_ld(&bar[XB_XCNT(j)]); sum += c; cnt += (c > 0u) ? 1u : 0u; mine = (j == x) ? c : mine; }
        if (sum == G) break;
        __builtin_amdgcn_s_sleep(1);
        if ((++sp & 255u) == 0u) { if (xb_ld(&bar[XB_TMO])) break; if (sp > XB_SPIN_CAP) { atomicAdd(&bar[XB_TMO], 1u); break; } }
    }
    nloc = mine > 0u ? mine : 1u; nx = cnt > 0u ? cnt : 1u;
}
__device__ __forceinline__ void xcd_barrier(const XcdBarrier& b) {
    asm volatile("s_waitcnt vmcnt(0)" ::: "memory");
    __syncthreads();
    if (threadIdx.x == 0) {
        unsigned* bar = b.bar; asm volatile("" : "+s"(bar));
        __builtin_amdgcn_s_waitcnt(0);
        unsigned nloc = b.st[0], nx = b.st[1];
        if (nloc == 0u) { xcd_barrier_complete(bar, b.x, nloc, nx); b.st[0] = nloc; b.st[1] = nx; }
        const unsigned old = xb_add(&bar[XB_XSUB(b.x)], 1u);
        const unsigned gen = old / nloc;
        if (old + 1u == (gen + 1u) * nloc) {
            __builtin_amdgcn_fence(__ATOMIC_RELEASE, "agent");
            asm volatile("s_waitcnt vmcnt(0)" ::: "memory");
            const unsigned og = xb_add(&bar[XB_TOP], 1u);
            const unsigned tg = og / nx;
            if (og + 1u == (tg + 1u) * nx) xb_add(&bar[XB_TOPGEN], 1u);
            else XB_SPIN(xb_ld(&bar[XB_TOPGEN]) == tg, bar);
            __builtin_amdgcn_fence(__ATOMIC_ACQUIRE, "agent");
            xb_add(&bar[XB_XGEN(b.x)], 1u);
            asm volatile("s_waitcnt vmcnt(0)" ::: "memory");
        } else {
            XB_SPIN(xb_ld(&bar[XB_XGEN(b.x)]) == gen, bar);
            __builtin_amdgcn_fence(__ATOMIC_ACQUIRE, "agent");
            asm volatile("s_waitcnt vmcnt(0)" ::: "memory");
        }
    }
    __syncthreads();
}

namespace pg8 {
#define PG8_LAS __attribute__((address_space(3)))
typedef unsigned short bf16_t;
typedef short bf16x8 __attribute__((ext_vector_type(8)));
typedef float f32x4 __attribute__((ext_vector_type(4)));
typedef unsigned u32x4 __attribute__((ext_vector_type(4)));
constexpr int BM = 256, BK = 64, HALF = 128, HTB = HALF * BK * 2  , STAGE_BYTES = 8 * HTB, NXCD = 8, WGM = 8;

__host__ __device__ __forceinline__ int lds_byte(int r, int c) { const int st = (r >> 4) * 2 + (c >> 5), rr = r & 15, cc = c & 31, ob = rr * 64 + cc * 2; return st * 1024 + (ob ^ (((ob >> 9) & 1) << 5)); }
__host__ __device__ __forceinline__ void stage_rc(int b, int& R, int& C) { const int st = b / 1024, sb = b % 1024, swz = sb ^ (((sb >> 9) & 1) << 5); R = (st >> 1) * 16 + swz / 64; C = (st & 1) * 32 + (swz % 64) / 2; }
__host__ __device__ __forceinline__ int perm32(int rho) { const int n = rho >> 4, i = rho & 15; return 8 * (i >> 2) + 4 * n + (i & 3); }

struct Unit { int pm, pn, ui; };
struct Gemm { const bf16_t* A; const bf16_t* Bt; int M, N, K; int sb_w = 0x77777777, sb_a = 0x7f7f7f7f; };

struct StaticOrder {
    int nM, nN, nwg, G, c;
    __host__ __device__ void init(int M, int N, int G_, int c_) { nM = M / BM; nN = N / BM; nwg = nM * nN; G = G_; c = c_; }
    __host__ __device__ bool next(int i, Unit& u) const {
        const long L = (long)i * G + c; if (L >= nwg) return false;
        int wgid = (int)L; { const int q = nwg / NXCD, r = nwg % NXCD, xcd = wgid % NXCD, off = wgid / NXCD; wgid = (xcd < r ? xcd * (q + 1) : r * (q + 1) + (xcd - r) * q) + off; }
        const int nig = WGM * nN, gid = wgid / nig, fm = gid * WGM, gsz = (nM - fm) < WGM ? (nM - fm) : WGM;
        u.pm = fm + ((wgid % nig) % gsz); u.pn = (wgid % nig) / gsz; return true;
    }
    __device__ __forceinline__ void a_ready(const Unit&) const {}
    __device__ __forceinline__ void done(const Unit&) const {}
};

__device__ __forceinline__ unsigned cvt_pk_bf16(float lo, float hi) { unsigned r; asm volatile("v_cvt_pk_bf16_f32 %0, %1, %2" : "=v"(r) : "v"(lo), "v"(hi)); return r; }
typedef float f32x2 __attribute__((ext_vector_type(2)));
__device__ __forceinline__ f32x2 gelu_pk(f32x2 v) {
    const f32x2 av = __builtin_elementwise_abs(v), d = av * 0.2316418882f + 1.0f;
    f32x2 t; t.x = __builtin_amdgcn_rcpf(d.x); t.y = __builtin_amdgcn_rcpf(d.y);
    f32x2 q = t * 0.5307027145f + (-0.7265760135f); q = q * t + 0.7107068705f; q = q * t + (-0.142248368f); q = q * t + 0.127414796f; q = q * t;
    const f32x2 s = (v * v) * (-0.72134752044f);
    f32x2 e; e.x = __builtin_amdgcn_exp2f(s.x); e.y = __builtin_amdgcn_exp2f(s.y);
    const f32x2 m = v * (q * e), r = v - m;
    f32x2 o; o.x = v.x < 0.f ? m.x : r.x; o.y = v.y < 0.f ? m.y : r.y; return o;
}

typedef int v8i32 __attribute__((ext_vector_type(8)));
typedef int v4i32 __attribute__((ext_vector_type(4)));
__device__ __forceinline__ v8i32 cat8(v4i32 a, v4i32 b) { return __builtin_shufflevector(a, b, 0, 1, 2, 3, 4, 5, 6, 7); }
template <class E> constexpr auto pg8_wide(int) -> decltype(E::WIDE) { return E::WIDE; }
template <class E> constexpr bool pg8_wide(long) { return false; }
template <class Epi, class Sched, bool ALIGN_EPI = false, bool SP2 = false, bool GATHER = false, bool FP8 = false, bool ABLK = false>
__device__ __forceinline__ void gemm_phase(PG8_LAS unsigned char* lds, const Gemm g, const Sched& S, const Epi& E) {
    const int tid = tid_opaque(), wid = __builtin_amdgcn_readfirstlane(tid >> 6), lane = tid & 63, wr = wid >> 2, wc = wid & 3, fr = lane & 15, fq = lane >> 4;
    static_assert(!GATHER || SP2, "GATHER is wired into the SP2 loop only");
    const int K = g.K, nt = K / BK;
    unsigned voffA[2], voffB[2];
#pragma unroll
    for (int i = 0; i < 2; ++i) { int R, C; stage_rc(tid * 16 + i * 8192, R, C); const int Pw = perm32(R & 31);
        const int Rb = pg8_wide<Epi>(0) ? ((R >> 5) * 64 + (Pw >> 3) * 16 + (Pw & 7)) : Epi::PERM ? ((R & ~31) + Pw) : R;
        voffA[i] = ABLK ? (unsigned)(((C * 2) >> 5) * 8192 + R * 32 + ((C * 2) & 31)) : (unsigned)(R * K + C) * 2u; voffB[i] = (unsigned)(Rb * K + C) * 2u; }
    unsigned gAc[2][2] = {{0u, 0u}, {0u, 0u}}, gAn[2][2] = {{0u, 0u}, {0u, 0u}};
    int gR[2] = {0, 0}; unsigned gC[2] = {0u, 0u};
    if constexpr (GATHER) {
#pragma unroll
        for (int i = 0; i < 2; ++i) { int R, C; stage_rc(tid * 16 + i * 8192, R, C); gR[i] = R; gC[i] = (unsigned)C * 2u; }
    }
#define PG8_GROWS(dst, ui_) do { _Pragma("unroll") for (int _h = 0; _h < 2; ++_h) _Pragma("unroll") for (int _i = 0; _i < 2; ++_i) dst[_h][_i] = S.rowtab[(ui_) * 256 + _h * 128 + gR[_i]] + gC[_i]; } while (0)
    const size_t kstep = (size_t)(BK * 2);
    const size_t hstep = (size_t)HALF * K * 2;
    const size_t hstepB = pg8_wide<Epi>(0) ? (size_t)8 * K * 2 : hstep;
    const size_t kstepA = ABLK ? (size_t)32768 : kstep, hstepA = ABLK ? (size_t)4096 : hstep;
    const size_t tstep = 2 * hstep;
    const unsigned ldsw = (unsigned)wid * 1024u;
    const int aoff = lds_byte(wr * 64 + fr, fq * 8), boff = lds_byte(wc * 32 + fr, fq * 8);
#define PG8_SA(b, h) (((b) * 2 + (h)) * HTB)
#define PG8_SB(b, h) ((4 + (b) * 2 + (h)) * HTB)
#define PG8_STAGE(bufoff, gbase, voff) do { _Pragma("unroll") for (int _i = 0; _i < 2; ++_i) \
        __builtin_amdgcn_global_load_lds((const unsigned*)((const char*)(gbase) + (voff)[_i]), (PG8_LAS unsigned*)(lds + (bufoff) + ldsw + _i * 8192), 16, 0, 0); } while (0)
#define PG8_STAGE_A(bufoff, kptr, h, vsel) do { if constexpr (GATHER) { PG8_STAGE(bufoff, kptr, vsel[h]); } else { PG8_STAGE(bufoff, (kptr) + (h) * hstepA, voffA); } } while (0)
#define PG8_LDA(dst, b, h) do { if constexpr (FP8) { _Pragma("unroll") for (int m = 0; m < 4; ++m) dst##8[m] = cat8(*(const PG8_LAS v4i32*)(lds + PG8_SA(b, h) + aoff + m * 2048), *(const PG8_LAS v4i32*)(lds + PG8_SA(b, h) + aoff + m * 2048 + 1024)); } \
        else { _Pragma("unroll") for (int m = 0; m < 4; ++m) _Pragma("unroll") for (int k = 0; k < 2; ++k) dst[m][k] = *(const PG8_LAS bf16x8*)(lds + PG8_SA(b, h) + aoff + m * 2048 + k * 1024); } } while (0)
#define PG8_LDB(dst, b, h) do { if constexpr (FP8) { _Pragma("unroll") for (int n = 0; n < 2; ++n) dst##8[n] = cat8(*(const PG8_LAS v4i32*)(lds + PG8_SB(b, h) + boff + n * 2048), *(const PG8_LAS v4i32*)(lds + PG8_SB(b, h) + boff + n * 2048 + 1024)); } \
        else { _Pragma("unroll") for (int n = 0; n < 2; ++n) _Pragma("unroll") for (int k = 0; k < 2; ++k) dst[n][k] = *(const PG8_LAS bf16x8*)(lds + PG8_SB(b, h) + boff + n * 2048 + k * 1024); } } while (0)
#define PG8_MMA(ai, bj, At, Bt) do { __builtin_amdgcn_s_setprio(1); if constexpr (FP8) { _Pragma("unroll") for (int m = 0; m < 4; ++m) _Pragma("unroll") for (int n = 0; n < 2; ++n) \
        asm volatile("s_nop 1\n\tv_mfma_scale_f32_16x16x128_f8f6f4 %0, %1, %2, %0, %3, %4 op_sel_hi:[0,0,0]" : "+v"(acc[ai][bj][m][n]) : "v"(Bt##8[n]), "v"(At##8[m]), "v"(fp8_sa), "v"(fp8_sb)); } else { \
        _Pragma("unroll") for (int m = 0; m < 4; ++m) _Pragma("unroll") for (int n = 0; n < 2; ++n) _Pragma("unroll") for (int k = 0; k < 2; ++k) \
        acc[ai][bj][m][n] = __builtin_amdgcn_mfma_f32_16x16x32_bf16(Bt[n][k], At[m][k], acc[ai][bj][m][n], 0, 0, 0); } __builtin_amdgcn_s_setprio(0); } while (0)
#define PG8_WAIT_V(n) asm volatile("s_waitcnt vmcnt(" #n ")" ::: "memory")
#define PG8_WAIT_L(n) asm volatile("s_waitcnt lgkmcnt(" #n ")" ::: "memory")
#define PG8_BAR __builtin_amdgcn_s_barrier()
#define PG8_SCHED __builtin_amdgcn_sched_barrier(0)
    Unit cur, nxt; int ui = 0;
    if (!S.next(0, cur)) return;
    f32x4 acc[2][2][4][2];
#pragma unroll
    for (int a = 0; a < 2; ++a)
#pragma unroll
        for (int b = 0; b < 2; ++b)
#pragma unroll
            for (int m = 0; m < 4; ++m)
#pragma unroll
                for (int n = 0; n < 2; ++n) acc[a][b][m][n] = (f32x4){0.f, 0.f, 0.f, 0.f};
    const int fp8_sa = g.sb_w, fp8_sb = g.sb_a;
    bf16x8 At[4][2], B0[2][2], B1[2][2]; v8i32 At8[4], B08[2], B18[2];
    const char* cA = GATHER ? (const char*)g.A : (const char*)g.A + (size_t)cur.pm * tstep; const char* cB = (const char*)g.Bt + (size_t)cur.pn * tstep;
    if constexpr (GATHER) { PG8_GROWS(gAc, 0); }
    S.a_ready(cur);
    if constexpr (SP2) {
        PG8_STAGE(PG8_SB(0, 0), cB, voffB); PG8_STAGE(PG8_SB(0, 1), cB + hstepB, voffB); PG8_STAGE_A(PG8_SA(0, 0), cA, 0, gAc); PG8_STAGE_A(PG8_SA(0, 1), cA, 1, gAc);
        if (wr == 1) PG8_BAR;
        PG8_WAIT_V(2); PG8_BAR;
        PG8_STAGE(PG8_SB(1, 0), cB + kstep, voffB); PG8_STAGE_A(PG8_SA(1, 0), cA + kstepA, 0, gAc); PG8_STAGE(PG8_SB(1, 1), cB + hstepB + kstep, voffB);
        PG8_WAIT_V(6); PG8_BAR;
    } else {
        PG8_STAGE(PG8_SB(0, 0), cB, voffB); PG8_STAGE(PG8_SA(0, 0), cA, voffA); PG8_STAGE(PG8_SB(0, 1), cB + hstepB, voffB); PG8_STAGE(PG8_SA(0, 1), cA + hstep, voffA);
        if (wr == 1) PG8_BAR;
        PG8_WAIT_V(4); PG8_BAR;
        PG8_STAGE(PG8_SB(1, 0), cB + kstep, voffB); PG8_STAGE(PG8_SA(1, 0), cA + kstep, voffA); PG8_STAGE(PG8_SB(1, 1), cB + hstepB + kstep, voffB);
        PG8_WAIT_V(6); PG8_BAR;
    }
    for (;;) {
        const bool has_next = S.next(ui + 1, nxt);
        if constexpr (GATHER) { if (has_next) { PG8_GROWS(gAn, ui + 1); } else { _Pragma("unroll") for (int _h = 0; _h < 2; ++_h) _Pragma("unroll") for (int _i = 0; _i < 2; ++_i) gAn[_h][_i] = gAc[_h][_i]; } }
        const char* nA = GATHER ? (const char*)g.A : (has_next ? (const char*)g.A + (size_t)nxt.pm * tstep : cA); const char* nB = has_next ? (const char*)g.Bt + (size_t)nxt.pn * tstep : cB;
        for (int t = 0; t < nt; t += 2) {
            const bool last = (t == nt - 2);
            const char* a1 = cA + (size_t)(t + 1) * kstepA;
            const char* a2 = last ? nA : cA + (size_t)(t + 2) * kstepA; const char* b2 = last ? nB : cB + (size_t)(t + 2) * kstep;
            const char* a3 = a2 + kstepA; const char* b3 = b2 + kstep;
            if (last && has_next) S.a_ready(nxt);
            unsigned gA2[2][2];
            if constexpr (GATHER) { _Pragma("unroll") for (int _h = 0; _h < 2; ++_h) _Pragma("unroll") for (int _i = 0; _i < 2; ++_i) gA2[_h][_i] = last ? gAn[_h][_i] : gAc[_h][_i]; }
            if constexpr (SP2) {
            PG8_LDB(B0, 0, 0); PG8_LDB(B1, 0, 1); PG8_SCHED; PG8_LDA(At, 0, 0); PG8_STAGE_A(PG8_SA(1, 1), a1, 1, gAc);
            PG8_WAIT_V(8); PG8_WAIT_L(0); PG8_BAR; PG8_MMA(0, 0, At, B0); PG8_MMA(0, 1, At, B1); PG8_BAR; PG8_SCHED;
            PG8_LDA(At, 0, 1); PG8_STAGE(PG8_SB(0, 0), b2, voffB); PG8_STAGE(PG8_SB(0, 1), b2 + hstepB, voffB); PG8_STAGE_A(PG8_SA(0, 0), a2, 0, gA2);
            PG8_WAIT_V(8); PG8_WAIT_L(0); PG8_BAR; PG8_MMA(1, 0, At, B0); PG8_MMA(1, 1, At, B1); PG8_BAR; PG8_SCHED;
            PG8_LDB(B0, 1, 0); PG8_LDB(B1, 1, 1); PG8_SCHED; PG8_LDA(At, 1, 0); PG8_STAGE_A(PG8_SA(0, 1), a2, 1, gA2);
            PG8_WAIT_V(8); PG8_WAIT_L(0); PG8_BAR; PG8_MMA(0, 0, At, B0); PG8_MMA(0, 1, At, B1); PG8_BAR; PG8_SCHED;
            PG8_LDA(At, 1, 1); PG8_STAGE(PG8_SB(1, 0), b3, voffB); PG8_STAGE(PG8_SB(1, 1), b3 + hstepB, voffB); PG8_STAGE_A(PG8_SA(1, 0), a3, 0, gA2);
            PG8_WAIT_V(8); PG8_WAIT_L(0); PG8_BAR; PG8_MMA(1, 0, At, B0); PG8_MMA(1, 1, At, B1); PG8_BAR; PG8_SCHED;
            } else {
            PG8_LDB(B0, 0, 0); PG8_SCHED; PG8_LDA(At, 0, 0); PG8_STAGE(PG8_SA(1, 1), a1 + hstep, voffA);
            PG8_WAIT_L(8); PG8_BAR; PG8_WAIT_L(0); PG8_MMA(0, 0, At, B0); PG8_BAR; PG8_SCHED;
            PG8_LDB(B1, 0, 1); PG8_STAGE(PG8_SB(0, 0), b2, voffB);
            PG8_BAR; PG8_WAIT_L(0); PG8_MMA(0, 1, At, B1); PG8_BAR;
            PG8_LDA(At, 0, 1); PG8_STAGE(PG8_SA(0, 0), a2, voffA);
            PG8_BAR; PG8_WAIT_L(0); PG8_MMA(1, 0, At, B0); PG8_BAR; PG8_SCHED;
            PG8_STAGE(PG8_SB(0, 1), b2 + hstepB, voffB);
            PG8_WAIT_V(6); PG8_BAR; PG8_MMA(1, 1, At, B1); PG8_BAR;
            PG8_LDB(B0, 1, 0); PG8_SCHED; PG8_LDA(At, 1, 0); PG8_STAGE(PG8_SA(0, 1), a2 + hstep, voffA);
            PG8_WAIT_L(8); PG8_BAR; PG8_WAIT_L(0); PG8_MMA(0, 0, At, B0); PG8_BAR; PG8_SCHED;
            PG8_LDB(B1, 1, 1); PG8_STAGE(PG8_SB(1, 0), b3, voffB);
            PG8_BAR; PG8_WAIT_L(0); PG8_MMA(0, 1, At, B1); PG8_BAR;
            PG8_LDA(At, 1, 1); PG8_STAGE(PG8_SA(1, 0), a3, voffA);
            PG8_BAR; PG8_WAIT_L(0); PG8_MMA(1, 0, At, B0); PG8_BAR; PG8_SCHED;
            PG8_STAGE(PG8_SB(1, 1), b3 + hstepB, voffB);
            PG8_WAIT_V(6); PG8_BAR; PG8_MMA(1, 1, At, B1); PG8_BAR;
            }
        }
        if constexpr (ALIGN_EPI) { if (wr == 0) PG8_BAR; }
        if constexpr (FP8) { asm volatile("s_nop 15\n\ts_nop 15" ::: "memory"); __builtin_amdgcn_sched_barrier(0); }
        if constexpr (!Epi::AFTER_DRAIN) { E(acc, cur, wr, wc, fr, fq); S.done(cur); }
        if (!has_next) break;
#pragma unroll
        for (int a = 0; a < 2; ++a)
#pragma unroll
            for (int b = 0; b < 2; ++b)
#pragma unroll
                for (int m = 0; m < 4; ++m)
#pragma unroll
                    for (int n = 0; n < 2; ++n) acc[a][b][m][n] = (f32x4){0.f, 0.f, 0.f, 0.f};
        cur = nxt; cA = nA; cB = nB; ++ui;
        if constexpr (GATHER) { _Pragma("unroll") for (int _h = 0; _h < 2; ++_h) _Pragma("unroll") for (int _i = 0; _i < 2; ++_i) gAc[_h][_i] = gAn[_h][_i]; }
        if constexpr (ALIGN_EPI) { if (wr == 1) PG8_BAR; }
    }
    PG8_WAIT_V(0);
    if constexpr (!ALIGN_EPI) { if (wr == 0) PG8_BAR; }
    PG8_BAR;
    if constexpr (Epi::AFTER_DRAIN) { E.fused(acc, cur, wr, wc, fr, fq, lds, wid, lane); S.done(cur); }
#undef PG8_SA
#undef PG8_SB
#undef PG8_STAGE
#undef PG8_STAGE_A
#undef PG8_GROWS
#undef PG8_LDA
#undef PG8_LDB
#undef PG8_MMA
#undef PG8_WAIT_V
#undef PG8_WAIT_L
#undef PG8_BAR
#undef PG8_SCHED
}
}

struct Args { const float* in[38]; float* out; unsigned char* ws; int ph_lo, ph_hi; };
#define INP(k) as_global(IN[k])
#define AIN(k) as_global(A.in[k])
enum { I_X = 0, I_C, I_CTX, I_CCTX, I_N1G, I_N2G, I_ADAW, I_ADAB, I_EVWIN, I_EVWOUT, I_RWMU, I_RWW0, I_RWW2, I_RWA0, I_RWA2, I_RWG2, I_RWKK, I_RWKA, I_RWRK,
       I_GNW, I_GNB, I_QN, I_KN, I_LAM, I_SUBLN, I_SGWIN, I_SGBIN, I_SGLNG, I_SGLNB, I_SGWS, I_SGBS, I_SGWOUT, I_RTW, I_RTB, I_W1, I_B1, I_W2, I_B2 };

struct Tok { int b, t, T, modrow; };
__device__ __forceinline__ Tok tokinfo(int g) {
    Tok k;
    if (g < NCTX) { k.b = g >> 8; k.t = g & 255; k.T = TC; k.modrow = 16; }
    else { const int q = g - NCTX; k.b = q >> 11; k.t = q & 2047; k.T = TL; k.modrow = k.b; }
    return k;
}

template <int MAP>
__device__ __forceinline__ void p0_transpose_item(const float* W, int K, int N, bf16_t* WT, LAS float* scr, int item, int lane) {
    const int nblk = N / 32, kb = item / nblk, nb = item % nblk, k0 = 64 * kb, n0 = 32 * nb;
    const int d0 = MAP ? (256 * ((n0 & 1023) >> 7) + 128 * (n0 >> 10) + (n0 & 127)) : n0;
#pragma unroll 8
    for (int i = 0; i < 32; ++i) { const int kk = 2 * i + (lane >> 5); scr[kk * 33 + (lane & 31)] = W[(size_t)(k0 + kk) * N + n0 + (lane & 31)]; }
    asm volatile("s_waitcnt lgkmcnt(0)" ::: "memory");
    const int c = lane & 7;
#pragma unroll
    for (int j = 0; j < 4; ++j) { const int n = (lane >> 3) + 8 * j; const LAS float* s = scr + (8 * c) * 33 + n;
        u32x4 o; o.x = pk2(s[0 * 33], s[1 * 33]); o.y = pk2(s[2 * 33], s[3 * 33]); o.z = pk2(s[4 * 33], s[5 * 33]); o.w = pk2(s[6 * 33], s[7 * 33]);
        *(u32x4*)(WT + (size_t)(d0 + n) * K + k0 + 8 * c) = o; }
    asm volatile("s_waitcnt lgkmcnt(0)" ::: "memory");
}

template <int MAP>
__device__ __forceinline__ void p0_transpose_item_fp8w(const float* W, int K, int N, unsigned char* WT, LAS float* scr, int item, int lane) {
    const int nblk = N / 32, kb = item / nblk, nb = item % nblk, k0 = 128 * kb, n0 = 32 * nb;
    const int d0 = MAP ? (256 * ((n0 & 1023) >> 7) + 128 * (n0 >> 10) + (n0 & 127)) : n0;
    {
        f32x4 ld[16];
#pragma unroll
        for (int i = 0; i < 16; ++i) ld[i] = *(const f32x4*)(W + (size_t)(k0 + 8 * i + (lane >> 3)) * N + n0 + 4 * (lane & 7));
#pragma unroll
        for (int i = 0; i < 16; ++i) { LAS float* d = scr + (8 * i + (lane >> 3)) * 33 + 4 * (lane & 7); d[0] = ld[i].x; d[1] = ld[i].y; d[2] = ld[i].z; d[3] = ld[i].w; }
    }
    asm volatile("s_waitcnt lgkmcnt(0)" ::: "memory");
    const int c = lane & 7;
#pragma unroll
    for (int j = 0; j < 4; ++j) { const int n = (lane >> 3) + 8 * j; const LAS float* sp = scr + (16 * c) * 33 + n;
        u32x4 o;
#pragma unroll
        for (int d = 0; d < 4; ++d) { int w = __builtin_amdgcn_cvt_pk_fp8_f32(sp[(4 * d) * 33] * 256.0f, sp[(4 * d + 1) * 33] * 256.0f, 0, false);
            w = __builtin_amdgcn_cvt_pk_fp8_f32(sp[(4 * d + 2) * 33] * 256.0f, sp[(4 * d + 3) * 33] * 256.0f, w, true); o[d] = (unsigned)w; }
        *(u32x4*)(WT + (size_t)(d0 + n) * K + k0 + 16 * c) = o; }
    asm volatile("s_waitcnt lgkmcnt(0)" ::: "memory");
}

__device__ __forceinline__ void ph_prologue(const Args& A, LAS unsigned char* lds, int bid, int nb) {
    const int tid = tid_opaque(), lane = tid & 63, wid = tid >> 6;
    unsigned char* ws = opq(A.ws);
    if (bid == 0 && tid < 39) ((const float**)(ws + WS_PTRS))[tid] = (tid < 38) ? A.in[tid] : (const float*)A.out;
    {
        LAS float* s = (LAS float*)lds;
        LAS float* red = (LAS float*)(lds + 17 * 1024 * 4);
        for (int i = tid; i < 17 * 1024; i += NTHREADS) {
            const int r = i >> 10, k = i & 1023;
            const float x = (r < 16) ? AIN(I_C)[r * 1024 + k] : AIN(I_CCTX)[k];
            s[i] = x / (1.0f + __expf(-x));
        }
        __syncthreads();
        float* mod = (float*)(ws + WS_MOD);
        for (int u = bid; u < 4 * 96; u += nb) {
            const int l = u / 96, cg = u % 96, col = cg * 64 + lane;
            float acc[17];
#pragma unroll
            for (int r = 0; r < 17; ++r) acc[r] = 0.f;
            const float* wp = AIN(I_ADAW) + (size_t)l * 1024 * 6144 + col;
            for (int k = wid * 128; k < wid * 128 + 128; ++k) {
                const float wv = wp[(size_t)k * 6144];
#pragma unroll
                for (int r = 0; r < 17; ++r) acc[r] += s[r * 1024 + k] * wv;
            }
#pragma unroll
            for (int r = 0; r < 17; ++r) red[(wid * 17 + r) * 64 + lane] = acc[r];
            __syncthreads();
            for (int i = tid; i < 17 * 64; i += NTHREADS) {
                const int r = i >> 6, ln = i & 63; float v = 0.f;
#pragma unroll
                for (int w = 0; w < 8; ++w) v += red[(w * 17 + r) * 64 + ln];
                const int cc = cg * 64 + ln;
                mod[((size_t)l * 17 + r) * 6144 + cc] = v + AIN(I_ADAB)[l * 6144 + cc];
            }
            __syncthreads();
        }
    }
    __syncthreads();
    {
        LAS float* scr = (LAS float*)(lds + wid * 17408);
        const int gw = bid * NWAVES + wid, NGW = nb * NWAVES;
        constexpr int IT_WIN = 16 * (EVC / 32), IT_SQ = 16 * 32, IT_SGIN = 16 * 64, IT_W1 = 8 * 64, IT_W2 = 8 * 32;
        constexpr int N0 = 2 * IT_WIN, N1 = N0 + 2 * IT_SQ, N2 = N1 + 2 * IT_SGIN, N3 = N2 + 2 * IT_SQ, N4 = N3 + 128 * IT_W1, N5 = N4 + 128 * IT_W2;
        for (int it = gw; it < N5; it += NGW) {
            if (it < N0) { const int m = it / IT_WIN, r = it % IT_WIN; p0_transpose_item<0>(AIN(I_EVWIN) + (size_t)m * DM * EVC, DM, EVC, (bf16_t*)(ws + WS_WIN) + (size_t)m * ZLD * DM, scr, r, lane); }
            else if (it < N1) { const int q = it - N0, m = q / IT_SQ, r = q % IT_SQ; p0_transpose_item<0>(AIN(I_EVWOUT) + (size_t)m * DM * DM, DM, DM, (bf16_t*)(ws + WS_WOUT) + (size_t)m * DM * DM, scr, r, lane); }
            else if (it < N2) { const int q = it - N1, m = q / IT_SGIN, r = q % IT_SGIN; p0_transpose_item<0>(AIN(I_SGWIN) + (size_t)m * DM * 2048, DM, 2048, (bf16_t*)(ws + WS_SGIN) + (size_t)m * 2048 * DM, scr, r, lane); }
            else if (it < N3) { const int q = it - N2, m = q / IT_SQ, r = q % IT_SQ; p0_transpose_item<0>(AIN(I_SGWOUT) + (size_t)m * DM * DM, DM, DM, (bf16_t*)(ws + WS_SGOUT) + (size_t)m * DM * DM, scr, r, lane); }
            else if (it < N4) { const int q = it - N3, m = q / IT_W1, r = q % IT_W1; p0_transpose_item_fp8w<1>(AIN(I_W1) + (size_t)m * DM * 2048, DM, 2048, ws + WS_W1 + (size_t)m * 2048 * DM, scr, r, lane); }
            else { const int q = it - N4, m = q / IT_W2, r = q % IT_W2; p0_transpose_item_fp8w<0>(AIN(I_W2) + (size_t)m * DM * DM, DM, DM, ws + WS_W2 + (size_t)m * DM * DM, scr, r, lane); }
        }
    }
    {
        const size_t gt = (size_t)bid * NTHREADS + tid, GT = (size_t)nb * NTHREADS;
        u32x4* H8 = (u32x4*)(ws + WS_H);
        const f32x4* c4 = (const f32x4*)AIN(I_CTX); const f32x4* x4 = (const f32x4*)AIN(I_X);
        constexpr size_t NC8 = (size_t)NCTX * DM / 8, NT8 = (size_t)NTOK * DM / 8;
        for (size_t i = gt; i < NT8; i += GT) { const f32x4* s = (i < NC8) ? c4 + 2 * i : x4 + 2 * (i - NC8); const f32x4 a = s[0], b = s[1];
            H8[i] = (u32x4){pk2(a.x, a.y), pk2(a.z, a.w), pk2(b.x, b.y), pk2(b.z, b.w)}; }
        for (size_t i = gt; i < (size_t)2 * 128 * DM / 8; i += GT) { const size_t m = i / (128 * DM / 8), r = i % (128 * DM / 8); ((u32x4*)((bf16_t*)(ws + WS_WIN) + (m * ZLD + EVC) * DM))[r] = (u32x4){0u, 0u, 0u, 0u}; }
        bf16_t* wl = (bf16_t*)(ws + WS_WLORA);
        for (size_t i = gt; i < (size_t)2 * LORA_N * (LORA_K / 8); i += GT) {
            const int n = (int)(i % LORA_N), kc = (int)((i / LORA_N) % (LORA_K / 8)), jj = (int)(i / ((size_t)LORA_N * (LORA_K / 8))), seg = n >> 9, c = n & 511, k0 = kc * 8;
            float v[8];
#pragma unroll
            for (int e = 0; e < 8; ++e) v[e] = 0.f;
            if (seg < 2) { if ((k0 >> 6) == seg) {
#pragma unroll
                for (int e = 0; e < 8; ++e) v[e] = AIN(I_RWW2)[(((size_t)jj * 2 + seg) * 64 + (k0 & 63) + e) * 512 + c]; } }
            else if (seg < 4) { if ((k0 >> 6) == seg) {
#pragma unroll
                for (int e = 0; e < 8; ++e) v[e] = AIN(I_RWA2)[(((size_t)jj * 2 + (seg - 2)) * 64 + (k0 & 63) + e) * 512 + c]; } }
            else if (k0 >= 256) {
#pragma unroll
                for (int e = 0; e < 8; ++e) v[e] = AIN(I_RWG2)[((size_t)jj * 128 + (k0 - 256) + e) * 512 + c]; }
            *(u32x4*)(wl + ((size_t)jj * LORA_N + n) * LORA_K + k0) = (u32x4){pk2(v[0], v[1]), pk2(v[2], v[3]), pk2(v[4], v[5]), pk2(v[6], v[7])};
        }
        for (size_t i = gt; i < (size_t)2 * LORA_N; i += GT) { const int jj = (int)(i / LORA_N), n = (int)(i % LORA_N), seg = n >> 9, c = n & 511;
            ((float*)(ws + WS_LBIAS))[i] = seg < 2 ? AIN(I_RWW0)[((size_t)jj * 2 + seg) * 512 + c] : (seg < 4 ? AIN(I_RWA0)[((size_t)jj * 2 + (seg - 2)) * 512 + c] : 0.f); }
        float* rt = (float*)(ws + WS_RTWT);
        for (size_t i = gt; i < (size_t)4 * 128 * 32; i += GT) {
            const int e = (int)i & 31, k0 = ((int)(i >> 5) & 127) * 8, l = (int)(i >> 12);
            unsigned hi[4], lo[4]; float w[8];
#pragma unroll
            for (int q = 0; q < 8; ++q) w[q] = AIN(I_RTW)[((size_t)l * 1024 + k0 + q) * 32 + e];
#pragma unroll
            for (int q = 0; q < 4; ++q) { hi[q] = pk2(w[2 * q], w[2 * q + 1]); lo[q] = pk2(w[2 * q] - __builtin_bit_cast(float, hi[q] << 16), w[2 * q + 1] - __builtin_bit_cast(float, hi[q] & 0xffff0000u)); }
            *(u32x4*)((bf16_t*)rt + ((size_t)l * 2 * 32 + e) * 1024 + k0) = (u32x4){hi[0], hi[1], hi[2], hi[3]};
            *(u32x4*)((bf16_t*)rt + ((size_t)(l * 2 + 1) * 32 + e) * 1024 + k0) = (u32x4){lo[0], lo[1], lo[2], lo[3]};
        }
    }
}

template <bool ROUTER>
__device__ __forceinline__ void ph_norm(const Args& A, int l, int row_lo, LAS unsigned char* lds, int bid, int nb) {
    unsigned char* ws = opq(A.ws); const float* const* IN = (const float* const*)(ws + WS_PTRS); (void)IN;
    const int tid = tid_opaque(), lane = tid & 63, wid = tid >> 6;
    const bf16_t* H = (const bf16_t*)(ws + WS_H);
    const float* mod = (const float*)(ws + WS_MOD);
    bf16_t* abf = (bf16_t*)(ws + WS_ABF);
    const float* gp = INP(ROUTER ? I_N2G : I_N1G) + l * 1024;
    const int c_shift = ROUTER ? 3 : 0, c_scale = ROUTER ? 4 : 1;
    LAS float* rtl = (LAS float*)lds;
    LAS int* hist = (LAS int*)(lds + 131072);
    float rtb = 0.f;
    if constexpr (ROUTER) {
        const f32x4* rt4 = (const f32x4*)((const float*)(ws + WS_RTWT) + (size_t)l * 32 * 1024);
        for (int i = tid; i < 32 * 1024 / 4; i += NTHREADS) ((LAS f32x4*)rtl)[i] = rt4[i];
        if (tid < 32) hist[tid] = 0;
        rtb = INP(I_RTB)[l * 32 + (lane >> 1)];
        __syncthreads();
    }
    for (int row = row_lo + bid * NWAVES + wid; row < NTOK; row += nb * NWAVES) {
        const Tok tk = tokinfo(row);
        const float* mrow = mod + ((size_t)l * 17 + tk.modrow) * 6144;
        f32x4 v[4]; float ss = 0.f;
#pragma unroll
        for (int j = 0; j < 4; ++j) { const u32x2 hq = *(const u32x2*)(H + (size_t)row * DM + j * 256 + lane * 4); v[j] = (f32x4){bflo(hq.x), bfhi(hq.x), bflo(hq.y), bfhi(hq.y)}; ss += (v[j].x * v[j].x + v[j].y * v[j].y) + (v[j].z * v[j].z + v[j].w * v[j].w); }
        const float rstd = rsqrtf(wave_sum(ss) * (1.0f / DM) + 1e-6f);
#pragma unroll
        for (int j = 0; j < 4; ++j) {
            const int col = j * 256 + lane * 4;
            const f32x4 g = *(const f32x4*)(gp + col), sc = *(const f32x4*)(mrow + c_scale * 1024 + col), sh = *(const f32x4*)(mrow + c_shift * 1024 + col);
            v[j] = (v[j] * rstd * g) * (sc + 1.0f) + sh;
            u32x2 o; o.x = pk2(v[j].x, v[j].y); o.y = pk2(v[j].z, v[j].w);
            *(u32x2*)(abf + (size_t)row * DM + col) = o;
        }
        if constexpr (ROUTER) {
            float p[32];
#pragma unroll
            for (int e = 0; e < 32; ++e) {
                float acc = 0.f;
#pragma unroll
                for (int j = 0; j < 4; ++j) { const f32x4 w = *(const LAS f32x4*)(rtl + e * 1024 + j * 256 + lane * 4); acc += (v[j].x * w.x + v[j].y * w.y) + (v[j].z * w.z + v[j].w * w.w); }
                p[e] = acc;
            }
#define RS_STEP(N, OFF) _Pragma("unroll") for (int i = 0; i < (N); ++i) { const bool up = (lane & (OFF)) != 0; const float send = up ? p[i] : p[i + (N)], keep = up ? p[i + (N)] : p[i]; p[i] = keep + __shfl_xor(send, (OFF)); }
            RS_STEP(16, 32) RS_STEP(8, 16) RS_STEP(4, 8) RS_STEP(2, 4) RS_STEP(1, 2)
#undef RS_STEP
            const float mylg = p[0] + __shfl_xor(p[0], 1) + rtb;
            float tv[4] = {-3.0e38f, -3.0e38f, -3.0e38f, -3.0e38f}; int ti[4] = {0, 0, 0, 0};
#pragma unroll
            for (int e = 0; e < 32; ++e) {
                const float lgv = rdl(mylg, 2 * e);
                if (lgv > tv[3]) {
                    tv[3] = lgv; ti[3] = e;
                    if (tv[3] > tv[2]) { const float a = tv[2]; tv[2] = tv[3]; tv[3] = a; const int b = ti[2]; ti[2] = ti[3]; ti[3] = b; }
                    if (tv[2] > tv[1]) { const float a = tv[1]; tv[1] = tv[2]; tv[2] = a; const int b = ti[1]; ti[1] = ti[2]; ti[2] = b; }
                    if (tv[1] > tv[0]) { const float a = tv[0]; tv[0] = tv[1]; tv[1] = a; const int b = ti[0]; ti[0] = ti[1]; ti[1] = b; }
                }
            }
            const float e1 = __expf(tv[1] - tv[0]), e2 = __expf(tv[2] - tv[0]), e3 = __expf(tv[3] - tv[0]);
            const float inv = 1.0f / (1.0f + e1 + e2 + e3);
            if (lane == 0) {
                int* te = (int*)(ws + WS_TOKE) + (size_t)row * 4; float* tg = (float*)(ws + WS_TOKG) + (size_t)row * 4; int* tr = (int*)(ws + WS_TOKR) + (size_t)row * 4;
                te[0] = ti[0]; te[1] = ti[1]; te[2] = ti[2]; te[3] = ti[3];
                tg[0] = inv; tg[1] = e1 * inv; tg[2] = e2 * inv; tg[3] = e3 * inv;
#pragma unroll
                for (int k = 0; k < 4; ++k) tr[k] = __hip_atomic_fetch_add(hist + ti[k], 1, __ATOMIC_RELAXED, __HIP_MEMORY_SCOPE_WORKGROUP);
            }
        }
    }
    if constexpr (ROUTER) {
        __syncthreads();
        if (tid < 32) ((int*)(ws + WS_BCNT))[((size_t)l * 256 + bid) * 32 + tid] = hist[tid];
    }
}


constexpr int RT_LS = 2064;
__device__ __forceinline__ void ph_norm2_router(const Args& A, int l, int row_lo, LAS unsigned char* lds, int bid, int nb) {
    unsigned char* ws = opq(A.ws); const float* const* IN = (const float* const*)(ws + WS_PTRS);
    const int tid = tid_opaque(), lane = tid & 63, wid = tid >> 6, c16 = lane & 15, g4 = lane >> 4;
    const bf16_t* H = (const bf16_t*)(ws + WS_H); const float* mod = (const float*)(ws + WS_MOD); bf16_t* abf = (bf16_t*)(ws + WS_ABF);
    const float* gp = INP(I_N2G) + l * 1024;
    LAS unsigned char* rth = lds; LAS unsigned char* rtl = lds + 32 * RT_LS;
    LAS int* hist = (LAS int*)(lds + 64 * RT_LS);
    LAS float* lgs = (LAS float*)(lds + 64 * RT_LS + 256) + wid * 544;
    {
        const u32x4* src = (const u32x4*)((const bf16_t*)(ws + WS_RTWT) + (size_t)l * 2 * 32 * 1024);
        for (int i = tid; i < 64 * 128; i += NTHREADS) { const int row = i >> 7, ch = i & 127; *(LAS u32x4*)(lds + row * RT_LS + ch * 16) = src[i]; }
        if (tid < 32) hist[tid] = 0;
        __syncthreads();
    }
    const float rtb0 = INP(I_RTB)[l * 32 + c16], rtb1 = INP(I_RTB)[l * 32 + 16 + c16];
    const int ngroups = (NTOK - row_lo) / 16;
    LAS float* lgs0 = (LAS float*)(lds + 64 * RT_LS + 256);
    auto group = [&](const int u, const int k0, const int k1, const bool coop) {
        const int row = row_lo + 16 * u + c16;
        const Tok tk = tokinfo(row_lo + 16 * u);
        const float* mrow = mod + ((size_t)l * 17 + tk.modrow) * 6144;
        const bf16_t* hrow = H + (size_t)row * DM + 8 * g4;
        float ss = 0.f;
#pragma unroll 8
        for (int ks = 0; ks < 32; ++ks) { const u32x4 hq = *(const u32x4*)(hrow + 32 * ks); const f32x4 a = {bflo(hq.x), bfhi(hq.x), bflo(hq.y), bfhi(hq.y)}, b = {bflo(hq.z), bfhi(hq.z), bflo(hq.w), bfhi(hq.w)};
            ss += (a.x * a.x + a.y * a.y) + (a.z * a.z + a.w * a.w) + (b.x * b.x + b.y * b.y) + (b.z * b.z + b.w * b.w); }
        ss += __shfl_xor(ss, 16); ss += __shfl_xor(ss, 32);
        const float rstd = rsqrtf(ss * (1.0f / DM) + 1e-6f);
        f32x4 acc0 = {0.f, 0.f, 0.f, 0.f}, acc1 = acc0;
#pragma unroll 2
        for (int ks = k0; ks < k1; ++ks) {
            const int col = 32 * ks + 8 * g4;
            float f[8];
            { const u32x4 hq = *(const u32x4*)(hrow + 32 * ks); const f32x4 xa = {bflo(hq.x), bfhi(hq.x), bflo(hq.y), bfhi(hq.y)}, xb = {bflo(hq.z), bfhi(hq.z), bflo(hq.w), bfhi(hq.w)};
              const f32x4 ga = *(const f32x4*)(gp + col), gb = *(const f32x4*)(gp + col + 4), sa = *(const f32x4*)(mrow + 4 * 1024 + col), sb = *(const f32x4*)(mrow + 4 * 1024 + col + 4);
              const f32x4 ha = *(const f32x4*)(mrow + 3 * 1024 + col), hb = *(const f32x4*)(mrow + 3 * 1024 + col + 4);
              const f32x4 fa = (xa * rstd * ga) * (sa + 1.0f) + ha, fb = (xb * rstd * gb) * (sb + 1.0f) + hb;
              f[0] = fa.x; f[1] = fa.y; f[2] = fa.z; f[3] = fa.w; f[4] = fb.x; f[5] = fb.y; f[6] = fb.z; f[7] = fb.w; }
            unsigned hi[4], lo[4];
#pragma unroll
            for (int e = 0; e < 4; ++e) { hi[e] = pk2(f[2 * e], f[2 * e + 1]);
                lo[e] = pk2(f[2 * e] - __builtin_bit_cast(float, hi[e] << 16), f[2 * e + 1] - __builtin_bit_cast(float, hi[e] & 0xffff0000u)); }
            const u32x4 hv = {hi[0], hi[1], hi[2], hi[3]}, lv = {lo[0], lo[1], lo[2], lo[3]};
            { int w0 = __builtin_amdgcn_cvt_pk_fp8_f32(f[0], f[1], 0, false); w0 = __builtin_amdgcn_cvt_pk_fp8_f32(f[2], f[3], w0, true);
              int w1 = __builtin_amdgcn_cvt_pk_fp8_f32(f[4], f[5], 0, false); w1 = __builtin_amdgcn_cvt_pk_fp8_f32(f[6], f[7], w1, true);
              *(u32x2*)((unsigned char*)abf + (size_t)row * DM + col) = (u32x2){(unsigned)w0, (unsigned)w1}; }
            const bf16x8 fh = __builtin_bit_cast(bf16x8, hv), fl = __builtin_bit_cast(bf16x8, lv);
            const int wo = c16 * RT_LS + col * 2;
            const bf16x8 wh0 = *(const LAS bf16x8*)(rth + wo), wh1 = *(const LAS bf16x8*)(rth + 16 * RT_LS + wo), wl0 = *(const LAS bf16x8*)(rtl + wo), wl1 = *(const LAS bf16x8*)(rtl + 16 * RT_LS + wo);
            acc0 = __builtin_amdgcn_mfma_f32_16x16x32_bf16(fh, wh0, acc0, 0, 0, 0); acc1 = __builtin_amdgcn_mfma_f32_16x16x32_bf16(fh, wh1, acc1, 0, 0, 0);
            acc0 = __builtin_amdgcn_mfma_f32_16x16x32_bf16(fl, wh0, acc0, 0, 0, 0); acc1 = __builtin_amdgcn_mfma_f32_16x16x32_bf16(fl, wh1, acc1, 0, 0, 0);
            acc0 = __builtin_amdgcn_mfma_f32_16x16x32_bf16(fh, wl0, acc0, 0, 0, 0); acc1 = __builtin_amdgcn_mfma_f32_16x16x32_bf16(fh, wl1, acc1, 0, 0, 0);
        }
#pragma unroll
        for (int r = 0; r < 4; ++r) { lgs[(4 * g4 + r) * 34 + c16] = acc0[r] + (coop ? 0.f : rtb0); lgs[(4 * g4 + r) * 34 + 16 + c16] = acc1[r] + (coop ? 0.f : rtb1); }
        asm volatile("s_waitcnt lgkmcnt(0)" ::: "memory");
        if (coop) {
            __syncthreads();
            if (wid == 0) {
#pragma unroll
                for (int r = 0; r < 4; ++r) { float s0 = rtb0, s1 = rtb1;
#pragma unroll
                    for (int w = 0; w < NWAVES; ++w) { s0 += lgs0[w * 544 + (4 * g4 + r) * 34 + c16]; s1 += lgs0[w * 544 + (4 * g4 + r) * 34 + 16 + c16]; }
                    lgs[(4 * g4 + r) * 34 + c16] = s0; lgs[(4 * g4 + r) * 34 + 16 + c16] = s1; }
                asm volatile("s_waitcnt lgkmcnt(0)" ::: "memory");
            }
        }
        if ((!coop || wid == 0) && lane < 16) {
            float tv[4] = {-3.0e38f, -3.0e38f, -3.0e38f, -3.0e38f}; int ti[4] = {0, 0, 0, 0};
#pragma unroll
            for (int e = 0; e < 32; ++e) {
                const float lgv = lgs[lane * 34 + e];
                if (lgv > tv[3]) {
                    tv[3] = lgv; ti[3] = e;
                    if (tv[3] > tv[2]) { const float a = tv[2]; tv[2] = tv[3]; tv[3] = a; const int b = ti[2]; ti[2] = ti[3]; ti[3] = b; }
                    if (tv[2] > tv[1]) { const float a = tv[1]; tv[1] = tv[2]; tv[2] = a; const int b = ti[1]; ti[1] = ti[2]; ti[2] = b; }
                    if (tv[1] > tv[0]) { const float a = tv[0]; tv[0] = tv[1]; tv[1] = a; const int b = ti[0]; ti[0] = ti[1]; ti[1] = b; }
                }
            }
            const float e1 = __expf(tv[1] - tv[0]), e2 = __expf(tv[2] - tv[0]), e3 = __expf(tv[3] - tv[0]);
            const float inv = 1.0f / (1.0f + e1 + e2 + e3);
            const size_t r4 = (size_t)(row_lo + 16 * u + lane) * 4;
            *(int4*)((int*)(ws + WS_TOKE) + r4) = make_int4(ti[0], ti[1], ti[2], ti[3]);
            *(f32x4*)((float*)(ws + WS_TOKG) + r4) = (f32x4){inv, e1 * inv, e2 * inv, e3 * inv};
            int rk[4];
#pragma unroll
            for (int k = 0; k < 4; ++k) rk[k] = __hip_atomic_fetch_add(hist + ti[k], 1, __ATOMIC_RELAXED, __HIP_MEMORY_SCOPE_WORKGROUP);
            *(int4*)((int*)(ws + WS_TOKR) + r4) = make_int4(rk[0], rk[1], rk[2], rk[3]);
        }
        asm volatile("s_waitcnt lgkmcnt(0)" ::: "memory");
        if (coop) __syncthreads();
    };
    { const int u = bid * NWAVES + wid; if (u < ngroups && u < nb * NWAVES) group(u, 0, 32, false); }
    for (int u = nb * NWAVES + bid; u < ngroups; u += nb) group(u, 4 * wid, 4 * wid + 4, true);
    __syncthreads();
    if (tid < 32) ((int*)(ws + WS_BCNT))[((size_t)l * 256 + bid) * 32 + tid] = hist[tid];
}

typedef pg8::f32x4 (&AccRef)[2][2][4][2];
struct EpiStoreBf16 {
    static constexpr bool PERM = true, AFTER_DRAIN = false;
    bf16_t* O; int ldc;
    __device__ __forceinline__ void operator()(const pg8::f32x4 (&acc)[2][2][4][2], const pg8::Unit& u, int wr, int wc, int fr, int fq) const {
        const int row0 = u.pm * 256 + wr * 64 + fr, col0 = u.pn * 256 + wc * 32 + 8 * fq;
#pragma unroll
        for (int ai = 0; ai < 2; ++ai)
#pragma unroll
            for (int m = 0; m < 4; ++m) { bf16_t* rowp = O + (size_t)(row0 + ai * 128 + m * 16) * ldc + col0;
#pragma unroll
                for (int bj = 0; bj < 2; ++bj) { const pg8::f32x4 v0 = acc[ai][bj][m][0], v1 = acc[ai][bj][m][1];
                    u32x4 w; w.x = cvtpk_s(v0[0], v0[1]); w.y = cvtpk_s(v0[2], v0[3]); w.z = cvtpk_s(v1[0], v1[1]); w.w = cvtpk_s(v1[2], v1[3]);
                    *(u32x4*)(rowp + bj * 128) = w; } }
    }
};
struct EpiGeluBf16 {
    static constexpr bool PERM = true, AFTER_DRAIN = false;
    bf16_t* O; int ldc; const float* bias;
    __device__ __forceinline__ void operator()(const pg8::f32x4 (&acc)[2][2][4][2], const pg8::Unit& u, int wr, int wc, int fr, int fq) const {
        const int row0 = u.pm * 256 + wr * 64 + fr, col0 = u.pn * 256 + wc * 32 + 8 * fq;
        pg8::f32x4 bv[2][2];
#pragma unroll
        for (int bj = 0; bj < 2; ++bj)
#pragma unroll
            for (int n = 0; n < 2; ++n) bv[bj][n] = *(const pg8::f32x4*)(bias + col0 + bj * 128 + 4 * n);
#pragma unroll
        for (int ai = 0; ai < 2; ++ai)
#pragma unroll
            for (int m = 0; m < 4; ++m) { bf16_t* rowp = O + (size_t)(row0 + ai * 128 + m * 16) * ldc + col0;
#pragma unroll
                for (int bj = 0; bj < 2; ++bj) { pg8::f32x4 v0 = acc[ai][bj][m][0] + bv[bj][0], v1 = acc[ai][bj][m][1] + bv[bj][1];
                    const pg8::f32x2 a = pg8::gelu_pk((pg8::f32x2){v0[0], v0[1]}), b = pg8::gelu_pk((pg8::f32x2){v0[2], v0[3]}), c = pg8::gelu_pk((pg8::f32x2){v1[0], v1[1]}), d = pg8::gelu_pk((pg8::f32x2){v1[2], v1[3]});
                    u32x4 w; w.x = cvtpk_s(a.x, a.y); w.y = cvtpk_s(b.x, b.y); w.z = cvtpk_s(c.x, c.y); w.w = cvtpk_s(d.x, d.y);
                    *(u32x4*)(rowp + bj * 128) = w; } }
    }
};
struct EpiResidual {
    static constexpr bool PERM = true, AFTER_DRAIN = false;
    bf16_t* H; const float* gate0; int row_base;
    __device__ __forceinline__ void operator()(const pg8::f32x4 (&acc)[2][2][4][2], const pg8::Unit& u, int wr, int wc, int fr, int fq) const {
        const int row0 = u.pm * 256 + wr * 64 + fr, col0 = u.pn * 256 + wc * 32 + 8 * fq;
        const Tok tk = tokinfo(row_base + u.pm * 256);
        const float* gate = gate0 + (size_t)tk.modrow * 6144 + col0;
        pg8::f32x4 gv[2][2];
#pragma unroll
        for (int bj = 0; bj < 2; ++bj)
#pragma unroll
            for (int n = 0; n < 2; ++n) gv[bj][n] = *(const pg8::f32x4*)(gate + bj * 128 + n * 4);
#pragma unroll
        for (int ai = 0; ai < 2; ++ai)
#pragma unroll
            for (int m = 0; m < 4; ++m) { bf16_t* rowp = H + (size_t)(row0 + ai * 128 + m * 16) * DM + col0;
#pragma unroll
                for (int bj = 0; bj < 2; ++bj) { u32x4* p = (u32x4*)(rowp + bj * 128); const u32x4 h = *p;
                    const pg8::f32x4 v0 = (pg8::f32x4){bflo(h.x), bfhi(h.x), bflo(h.y), bfhi(h.y)} + gv[bj][0] * acc[ai][bj][m][0], v1 = (pg8::f32x4){bflo(h.z), bfhi(h.z), bflo(h.w), bfhi(h.w)} + gv[bj][1] * acc[ai][bj][m][1];
                    *p = (u32x4){cvtpk_s(v0[0], v0[1]), cvtpk_s(v0[2], v0[3]), cvtpk_s(v1[0], v1[1]), cvtpk_s(v1[2], v1[3])}; } }
    }
};
struct ListOrder {
    const LAS int* list; int n; const LAS unsigned* rowtab;
    __device__ __forceinline__ bool next(int i, pg8::Unit& u) const {
        if (i >= n) return false;
        u.pm = __builtin_amdgcn_readfirstlane(list[2 * i]); u.pn = __builtin_amdgcn_readfirstlane(list[2 * i + 1]); u.ui = i; return true;
    }
    __device__ __forceinline__ void a_ready(const pg8::Unit&) const {}
    __device__ __forceinline__ void done(const pg8::Unit&) const {}
};
struct EpiLora {
    static constexpr bool PERM = true, AFTER_DRAIN = false;
    bf16_t* O; const float* bias; int row_base;
    __device__ __forceinline__ void operator()(const pg8::f32x4 (&acc)[2][2][4][2], const pg8::Unit& u, int wr, int wc, int fr, int fq) const {
        const int seg = u.pn >> 1, row0 = row_base + u.pm * 256 + wr * 64 + fr, cs0 = (u.pn & 1) * 256 + wc * 32 + 8 * fq;
        const float ksig = seg < 2 ? -0.60653065971f : 1.0f; const bool lin = seg == 4;
        bf16_t* Os = O + (size_t)seg * NTOK * 512;
#pragma unroll
        for (int bj = 0; bj < 2; ++bj) {
            const int cs = cs0 + bj * 128;
            const pg8::f32x4 b0 = *(const pg8::f32x4*)(bias + seg * 512 + cs), b1 = *(const pg8::f32x4*)(bias + seg * 512 + cs + 4);
#pragma unroll
            for (int ai = 0; ai < 2; ++ai)
#pragma unroll
                for (int m = 0; m < 4; ++m) {
                    pg8::f32x4 v0 = acc[ai][bj][m][0] + b0, v1 = acc[ai][bj][m][1] + b1;
#pragma unroll
                    for (int r = 0; r < 4; ++r) {
                        const float t0 = ksig * __builtin_amdgcn_rcpf(1.0f + __expf(-v0[r])), t1 = ksig * __builtin_amdgcn_rcpf(1.0f + __expf(-v1[r]));
                        v0[r] = lin ? v0[r] : t0; v1[r] = lin ? v1[r] : t1;
                    }
                    u32x4 w; w.x = cvtpk_s(v0[0], v0[1]); w.y = cvtpk_s(v0[2], v0[3]); w.z = cvtpk_s(v1[0], v1[1]); w.w = cvtpk_s(v1[2], v1[3]);
                    *(u32x4*)(Os + (size_t)(row0 + ai * 128 + m * 16) * 512 + cs) = w;
                }
        }
    }
};
constexpr int LDS_TAB = 131072;
constexpr int LDS_LIST = LDS_TAB + 4096;
constexpr int LDS_ROWTAB = LDS_LIST + 1024;
__device__ __forceinline__ ListOrder build_units(LAS unsigned char* lds, int nM, int nN, int G, int c, const LAS int* tile_e, int ncol) {
    LAS int* list = (LAS int*)(lds + LDS_LIST);
    pg8::StaticOrder S; S.nM = nM; S.nN = nN; S.nwg = nM * nN; S.G = G; S.c = c;
    const int tid = tid_opaque();
    if (tid < 64) { pg8::Unit u; if (S.next(tid, u)) { if (tile_e) u.pn = tile_e[u.pm] * ncol + u.pn; list[2 * tid] = u.pm; list[2 * tid + 1] = u.pn; } }
    __syncthreads();
    ListOrder L; L.list = list; L.n = (c < S.nwg) ? (S.nwg - c + G - 1) / G : 0; L.rowtab = (const LAS unsigned*)(lds + LDS_ROWTAB);
    return L;
}
struct EpiMoe1 {
    static constexpr bool PERM = true, AFTER_DRAIN = false;
    bf16_t* O; const float* b1;
    __device__ __forceinline__ void operator()(const pg8::f32x4 (&acc)[2][2][4][2], const pg8::Unit& u, int wr, int wc, int fr, int fq) const {
        const int e = u.pn >> 3, pn = u.pn & 7;
        const int row0 = u.pm * 256 + wr * 64 + fr, ci = pn * 128 + wc * 32 + 8 * fq;
        const float* be = b1 + (size_t)e * 2048 + ci;
        unsigned char* bp = (unsigned char*)O + (size_t)u.pm * 262144 + (size_t)(pn * 4 + wc) * 8192 + (wr * 64 + fr) * 32 + 8 * fq; (void)row0;
        const pg8::f32x4 bg0 = *(const pg8::f32x4*)(be), bg1 = *(const pg8::f32x4*)(be + 4), bl0 = *(const pg8::f32x4*)(be + 1024), bl1 = *(const pg8::f32x4*)(be + 1028);
#pragma unroll
        for (int ai = 0; ai < 2; ++ai)
#pragma unroll
            for (int m = 0; m < 4; ++m) {
                const pg8::f32x4 g0 = acc[ai][0][m][0] + bg0, g1 = acc[ai][0][m][1] + bg1, l0 = acc[ai][1][m][0] + bl0, l1 = acc[ai][1][m][1] + bl1;
                float o[8];
#pragma unroll
                for (int r = 0; r < 4; r += 2) {
#pragma unroll
                    for (int hlf = 0; hlf < 2; ++hlf) {
                        const pg8::f32x4 gv = hlf ? g1 : g0, lv = hlf ? l1 : l0;
                        pg8::f32x2 ga = {fminf(gv[r], 7.0f), fminf(gv[r + 1], 7.0f)};
                        const pg8::f32x2 la = {__builtin_amdgcn_fmed3f(lv[r], -7.0f, 7.0f), __builtin_amdgcn_fmed3f(lv[r + 1], -7.0f, 7.0f)};
                        const pg8::f32x2 t = ga * la + ga, x = ga * (-1.702f * 1.4426950408889634f);
                        pg8::f32x2 e; e.x = __builtin_amdgcn_exp2f(x.x); e.y = __builtin_amdgcn_exp2f(x.y);
                        const pg8::f32x2 d = e * 0.25f + 0.25f;
                        o[4 * hlf + r] = t.x * __builtin_amdgcn_rcpf(d.x); o[4 * hlf + r + 1] = t.y * __builtin_amdgcn_rcpf(d.y);
                    }
                }
                int w0 = __builtin_amdgcn_cvt_pk_fp8_f32(o[0], o[1], 0, false); w0 = __builtin_amdgcn_cvt_pk_fp8_f32(o[2], o[3], w0, true);
                int w1 = __builtin_amdgcn_cvt_pk_fp8_f32(o[4], o[5], 0, false); w1 = __builtin_amdgcn_cvt_pk_fp8_f32(o[6], o[7], w1, true);
                *(u32x2*)(bp + (ai * 128 + m * 16) * 32) = (u32x2){(unsigned)w0, (unsigned)w1};
            }
    }
};
struct EpiMoe2 {
    static constexpr bool PERM = true, AFTER_DRAIN = false, WIDE = true;
    unsigned char* O; const LAS float* btab;
    __device__ __forceinline__ void operator()(const pg8::f32x4 (&acc)[2][2][4][2], const pg8::Unit& u, int wr, int wc, int fr, int fq) const {
        const int pn = u.pn & 3;
        const int row0 = u.pm * 256 + wr * 64 + fr, col0 = pn * 256 + wc * 64 + 16 * fq;
        const LAS float* be = btab + u.ui * 256 + wc * 64 + 16 * fq;
        pg8::f32x4 bv[2][2];
#pragma unroll
        for (int bj = 0; bj < 2; ++bj)
#pragma unroll
            for (int n = 0; n < 2; ++n) bv[bj][n] = *(const LAS pg8::f32x4*)(be + bj * 8 + 4 * n);
#pragma unroll
        for (int ai = 0; ai < 2; ++ai)
#pragma unroll
            for (int m = 0; m < 4; ++m) { unsigned char* rowp = O + (size_t)(row0 + ai * 128 + m * 16) * DM + col0;
                int w[4];
#pragma unroll
                for (int bj = 0; bj < 2; ++bj) { const pg8::f32x4 v0 = (acc[ai][bj][m][0] + bv[bj][0]) * 16.0f, v1 = (acc[ai][bj][m][1] + bv[bj][1]) * 16.0f;
                    int w0 = __builtin_amdgcn_cvt_pk_fp8_f32(v0[0], v0[1], 0, false); w0 = __builtin_amdgcn_cvt_pk_fp8_f32(v0[2], v0[3], w0, true);
                    int w1 = __builtin_amdgcn_cvt_pk_fp8_f32(v1[0], v1[1], 0, false); w1 = __builtin_amdgcn_cvt_pk_fp8_f32(v1[2], v1[3], w1, true);
                    w[2 * bj] = w0; w[2 * bj + 1] = w1; }
                *(u32x4*)rowp = (u32x4){(unsigned)w[0], (unsigned)w[1], (unsigned)w[2], (unsigned)w[3]}; }
    }
};

namespace att {
typedef float f32x16 __attribute__((ext_vector_type(16)));
typedef short s16x4 __attribute__((ext_vector_type(4)));
constexpr int KVBLK = 64, LDR = 512;
constexpr float QSCALE = 0.125f * 1.4426950408889634f;
constexpr int SHM_V = KVBLK * 128 * 2, SHM_K = KVBLK * 64 * 2, SHM_ATTN = 2 * SHM_V + 2 * SHM_K + NWAVES * 64 * 4;
#define ATT_KSWZ(row, colB) ((row) * 128 + ((colB) ^ ((((row) >> 1) & 7) << 4)))
#define ATT_SBAR() __builtin_amdgcn_sched_barrier(0)
__device__ __forceinline__ int crow(int r, int hi) { return (r & 3) + 8 * (r >> 2) + 4 * hi; }
__device__ __forceinline__ unsigned cvtpk(float lo, float hi) { unsigned r; asm volatile("v_cvt_pk_bf16_f32 %0, %1, %2" : "=v"(r) : "v"(lo), "v"(hi)); return r; }
constexpr float SHIFT = -12.0f;
__device__ __forceinline__ void partialSM(f32x16& p0) {
#pragma unroll
    for (int r = 0; r < 16; ++r) p0[r] = __builtin_amdgcn_exp2f(p0[r]);
}
__device__ __forceinline__ void finishSM(f32x16& p0, f32x16& p1, float& l_reg, bf16x8& pa0, bf16x8& pa1, bf16x8& pa2, bf16x8& pa3) {
#pragma unroll
    for (int r = 0; r < 16; ++r) p1[r] = __builtin_amdgcn_exp2f(p1[r]);
    float ps = 0;
#pragma unroll
    for (int r = 0; r < 16; ++r) ps += p0[r];
#pragma unroll
    for (int r = 0; r < 16; ++r) ps += p1[r];
    l_reg += ps;
#define ATT_PK4(P, BASE, OUT) do { unsigned a0 = cvtpk(P[BASE + 0], P[BASE + 1]), a1 = cvtpk(P[BASE + 2], P[BASE + 3]);   \
    unsigned b0 = cvtpk(P[BASE + 4], P[BASE + 5]), b1 = cvtpk(P[BASE + 6], P[BASE + 7]);                              \
    auto r0 = __builtin_amdgcn_permlane32_swap(a0, b0, false, false); auto r1 = __builtin_amdgcn_permlane32_swap(a1, b1, false, false); \
    u32x4 w = {r0[0], r1[0], r0[1], r1[1]}; OUT = __builtin_bit_cast(bf16x8, w); } while (0)
    ATT_PK4(p0, 0, pa0); ATT_PK4(p0, 8, pa1); ATT_PK4(p1, 0, pa2); ATT_PK4(p1, 8, pa3);
#undef ATT_PK4
}
__device__ __forceinline__ void qkt(f32x16& p0, f32x16& p1, const LAS unsigned char* Ks, int qaddr, int r32, int hi) {
    asm volatile("" : "+v"(qaddr)); const LAS unsigned char* qp = (const LAS unsigned char*)(uintptr_t)qaddr;
    bf16x8 qr[4];
#pragma unroll
    for (int d0 = 0; d0 < 4; ++d0) qr[d0] = *(const LAS bf16x8*)(qp + d0 * 1024);
#pragma unroll
    for (int r = 0; r < 16; ++r) { p0[r] = SHIFT; p1[r] = SHIFT; }
#pragma unroll
    for (int d0 = 0; d0 < 4; ++d0) { const int cb = (d0 * 16 + hi * 8) * 2;
        const bf16x8 b0 = *(const LAS bf16x8*)(Ks + ATT_KSWZ(r32, cb));
        const bf16x8 b1 = *(const LAS bf16x8*)(Ks + ATT_KSWZ(32 + r32, cb));
        p0 = __builtin_amdgcn_mfma_f32_32x32x16_bf16(b0, qr[d0], p0, 0, 0, 0);
        p1 = __builtin_amdgcn_mfma_f32_32x32x16_bf16(b1, qr[d0], p1, 0, 0, 0); }
}
__device__ __forceinline__ int v_st(int k, int c) { const int kk = (k & ~0xC) | ((k & 4) << 1) | ((k & 8) >> 1); return ((kk >> 3) * 4 + (c >> 5)) * 512 + ((kk & 7) * 32 + (c & 31)) * 2; }
__device__ __forceinline__ int v_rd_base(int lane) { return ((lane & 3) << 3) | (((lane >> 2) & 3) << 6) | (((lane >> 4) & 1) << 5) | (((lane >> 5) & 1) << 8); }
constexpr int v_rd_off(int d0, int ks, int half) { return d0 * 512 + ks * 4096 + half * 2048; }
template <int OFF> __device__ __forceinline__ s16x4 tr_read(int vb) { s16x4 r; asm volatile("ds_read_b64_tr_b16 %0, %1 offset:%2" : "=&v"(r) : "v"(vb), "i"(OFF) : "memory"); return r; }
template <int D0> __device__ __forceinline__ void pv_one(f32x16& od, int vb, bf16x8 pa0, bf16x8 pa1, bf16x8 pa2, bf16x8 pa3) {
    const s16x4 l0 = tr_read<v_rd_off(D0, 0, 0)>(vb), h0 = tr_read<v_rd_off(D0, 0, 1)>(vb), l1 = tr_read<v_rd_off(D0, 1, 0)>(vb), h1 = tr_read<v_rd_off(D0, 1, 1)>(vb);
    const s16x4 l2 = tr_read<v_rd_off(D0, 2, 0)>(vb), h2 = tr_read<v_rd_off(D0, 2, 1)>(vb), l3 = tr_read<v_rd_off(D0, 3, 0)>(vb), h3 = tr_read<v_rd_off(D0, 3, 1)>(vb);
    asm volatile("s_waitcnt lgkmcnt(0)" ::: "memory"); ATT_SBAR();
#define ATT_PK(L, H) (bf16x8){L[0], L[1], L[2], L[3], H[0], H[1], H[2], H[3]}
    od = __builtin_amdgcn_mfma_f32_32x32x16_bf16(pa0, ATT_PK(l0, h0), od, 0, 0, 0);
    od = __builtin_amdgcn_mfma_f32_32x32x16_bf16(pa1, ATT_PK(l1, h1), od, 0, 0, 0);
    od = __builtin_amdgcn_mfma_f32_32x32x16_bf16(pa2, ATT_PK(l2, h2), od, 0, 0, 0);
    od = __builtin_amdgcn_mfma_f32_32x32x16_bf16(pa3, ATT_PK(l3, h3), od, 0, 0, 0);
#undef ATT_PK
}
__device__ __forceinline__ void pv_d0(f32x16 (&o)[4], int vb, bf16x8 pa0, bf16x8 pa1, bf16x8 pa2, bf16x8 pa3) {
    pv_one<0>(o[0], vb, pa0, pa1, pa2, pa3); pv_one<1>(o[1], vb, pa0, pa1, pa2, pa3); pv_one<2>(o[2], vb, pa0, pa1, pa2, pa3); pv_one<3>(o[3], vb, pa0, pa1, pa2, pa3);
}
__device__ __forceinline__ void attn_body(const bf16_t* Qb, const bf16_t* Kh, const bf16_t* Vh, bf16_t* Ob, int seq, LAS unsigned char* lds) {
    const int tid = tid_opaque(), wid = tid >> 6, lane = tid & 63, r32 = lane & 31, hi = lane >> 5;
    LAS unsigned char* V_lds = lds; LAS unsigned char* K_lds = lds + 2 * SHM_V;
    LAS float* wsl = (LAS float*)(lds + 2 * SHM_V + 2 * SHM_K) + wid * 64; LAS float* li_l = wsl; LAS float* al_l = wsl + 32;
    float l_reg = 0; f32x16 o[4] = {};
    const bf16_t* Qw = Qb + (size_t)(wid * 32 + r32) * LDR + hi * 8;
    LAS unsigned char* qlds = lds + SHM_ATTN + wid * 4096 + lane * 16;
#pragma unroll
    for (int d0 = 0; d0 < 4; ++d0) *(LAS bf16x8*)(qlds + d0 * 1024) = *(const bf16x8*)(Qw + d0 * 16);
    const int qr = (int)(uintptr_t)qlds;
    const int sr = tid >> 4, sc = (tid & 15) * 8, vst0 = v_st(sr, sc), vst1 = v_st(32 + sr, sc);
    const int kr = tid >> 3, kc = (tid & 7) * 8, kst = ATT_KSWZ(kr, kc * 2);
    const int vb0 = (int)(uintptr_t)V_lds + v_rd_base(lane);
    bf16x8 vsA0, vsA1, ksA, vsB0, vsB1, ksB;
#define ATT_SLOAD(V0, V1, K0, k0) do { V0 = *(const bf16x8*)(Vh + (size_t)((k0) + sr) * LDR + sc); V1 = *(const bf16x8*)(Vh + (size_t)((k0) + 32 + sr) * LDR + sc); \
    K0 = *(const bf16x8*)(Kh + (size_t)((k0) + kr) * LDR + kc); } while (0)
#define ATT_SWRITE(b, V0, V1, K0) do { *(LAS bf16x8*)(V_lds + (b) * SHM_V + vst0) = V0; *(LAS bf16x8*)(V_lds + (b) * SHM_V + vst1) = V1; \
    *(LAS bf16x8*)(K_lds + (b) * SHM_K + kst) = K0; } while (0)
#define ATT_SWAIT() asm volatile("s_waitcnt vmcnt(3)" ::: "memory")
    f32x16 p0, p1; bf16x8 pa0, pa1, pa2, pa3; const int NT = seq / KVBLK;
    ATT_SLOAD(vsA0, vsA1, ksA, 0); asm volatile("s_waitcnt vmcnt(0)" ::: "memory"); ATT_SWRITE(0, vsA0, vsA1, ksA);
    ATT_SLOAD(vsB0, vsB1, ksB, KVBLK); if (2 < NT) ATT_SLOAD(vsA0, vsA1, ksA, 2 * KVBLK);
    ATT_SWAIT(); ATT_SWRITE(1, vsB0, vsB1, ksB); __syncthreads();
    for (int j = 0; j < NT; j += 2) {
        ATT_SBAR(); qkt(p0, p1, K_lds, qr, r32, hi); partialSM(p0);
        finishSM(p0, p1, l_reg, pa0, pa1, pa2, pa3); ATT_SBAR();
        if (j + 3 < NT) ATT_SLOAD(vsB0, vsB1, ksB, (j + 3) * KVBLK); ATT_SBAR();
        pv_d0(o, vb0, pa0, pa1, pa2, pa3); ATT_SBAR();
        __syncthreads();
        if (j + 2 < NT) { ATT_SWAIT(); ATT_SWRITE(0, vsA0, vsA1, ksA); }
        asm volatile("" : "+v"(o[0]), "+v"(o[1]), "+v"(o[2]), "+v"(o[3]));
        __syncthreads();
        ATT_SBAR(); qkt(p0, p1, K_lds + SHM_K, qr, r32, hi); partialSM(p0);
        finishSM(p0, p1, l_reg, pa0, pa1, pa2, pa3); ATT_SBAR();
        if (j + 4 < NT) ATT_SLOAD(vsA0, vsA1, ksA, (j + 4) * KVBLK); ATT_SBAR();
        pv_d0(o, vb0 + SHM_V, pa0, pa1, pa2, pa3); ATT_SBAR();
        __syncthreads();
        if (j + 3 < NT) { ATT_SWAIT(); ATT_SWRITE(1, vsB0, vsB1, ksB); }
        asm volatile("" : "+v"(o[0]), "+v"(o[1]), "+v"(o[2]), "+v"(o[3]));
        __syncthreads();
    }
    { auto rr = __builtin_amdgcn_permlane32_swap(__float_as_uint(l_reg), __float_as_uint(l_reg), false, false); l_reg = __uint_as_float(rr[0]) + __uint_as_float(rr[1]); }
    if (hi == 0) li_l[r32] = l_reg; asm volatile("s_waitcnt lgkmcnt(0)" ::: "memory");
    float rli[16];
#pragma unroll
    for (int r = 0; r < 16; ++r) rli[r] = __builtin_amdgcn_rcpf(li_l[crow(r, hi)]);
    bf16_t* Ow = Ob + (size_t)(wid * 32) * LDR;
    const bool oddl = (r32 & 1) != 0;
#pragma unroll
    for (int rp = 0; rp < 8; ++rp) {
        const int orow = oddl ? crow(2 * rp + 1, hi) : crow(2 * rp, hi);
#pragma unroll
        for (int d0 = 0; d0 < 4; ++d0) {
            const float va = o[d0][2 * rp] * rli[2 * rp], vb = o[d0][2 * rp + 1] * rli[2 * rp + 1];
            const float send = oddl ? va : vb, mine = oddl ? vb : va;
            const float recv = __builtin_bit_cast(float, __builtin_amdgcn_update_dpp(0, __builtin_bit_cast(int, send), 0xB1, 0xF, 0xF, false));
            *(unsigned*)(Ow + (size_t)orow * LDR + d0 * 32 + (r32 & ~1)) = oddl ? cvtpk_s(recv, mine) : cvtpk_s(mine, recv);
        }
    }
#undef ATT_SLOAD
#undef ATT_SWRITE
#undef ATT_SWAIT
}
}

__device__ __forceinline__ void ph_gemm_win(const Args& A, int j, int row_lo, LAS unsigned char* lds, int bid, int nb) {
    unsigned char* ws = opq(A.ws); const float* const* IN = (const float* const*)(ws + WS_PTRS); (void)IN;
    pg8::Gemm g{(const bf16_t*)(ws + WS_ABF) + (size_t)row_lo * DM, (const bf16_t*)(ws + WS_WIN) + (size_t)j * ZLD * DM, NTOK - row_lo, ZLD, DM};
    const ListOrder S = build_units(lds, (NTOK - row_lo) / 256, ZLD / 256, nb, bid, nullptr, 0);
    EpiStoreBf16 E{(bf16_t*)(ws + WS_Z) + (size_t)row_lo * ZLD, ZLD};
    pg8::gemm_phase<EpiStoreBf16, ListOrder, true, true>(lds, g, S, E);
}

__device__ __forceinline__ void ph_rwkv_pre(const Args& A, int j, int row_lo, int bid, int nb) {
    unsigned char* ws = opq(A.ws); const float* const* IN = (const float* const*)(ws + WS_PTRS);
    const int tid = tid_opaque(), lane = tid & 63, wid = tid >> 6;
    const bf16_t* Z = (const bf16_t*)(ws + WS_Z);
    const float* mu = INP(I_RWMU) + (size_t)j * 2 * RWC; const float* kkw = INP(I_RWKK) + j * 512;
    bf16_t* RB = (bf16_t*)(ws + WS_RB); bf16_t* KS = (bf16_t*)(ws + WS_KS); bf16_t* VS = (bf16_t*)(ws + WS_VS); bf16_t* KKN = (bf16_t*)(ws + WS_KKN); bf16_t* LIN = (bf16_t*)(ws + WS_LIN);
#define UNPK8(dst, raw) do { _Pragma("unroll") for (int _i = 0; _i < 4; ++_i) { dst[2 * _i] = __builtin_bit_cast(float, raw[_i] << 16); dst[2 * _i + 1] = __builtin_bit_cast(float, raw[_i] & 0xffff0000u); } } while (0)
#define PK8(v) (u32x4){pk2(v[0], v[1]), pk2(v[2], v[3]), pk2(v[4], v[5]), pk2(v[6], v[7])}
    for (int g = row_lo + bid * NWAVES + wid; g < NTOK; g += nb * NWAVES) {
        const Tok tk = tokinfo(g);
        const bool hp = tk.t > 0, hn = tk.t < tk.T - 1;
        const bf16_t* zc = Z + (size_t)g * ZLD;
#pragma unroll
        for (int i = 0; i < 4; ++i) {
            const int ch = i * 64 + lane, col = ch * 8;
            if (ch < 240) {
                const u32x4 zero = {0u, 0u, 0u, 0u};
                const u32x4 cr = *(const u32x4*)(zc + col), pr = hp ? *(const u32x4*)(zc - ZLD + col) : zero, nr = hn ? *(const u32x4*)(zc + ZLD + col) : zero;
                float z[8], p[8], n[8], s8[8];
                UNPK8(z, cr); UNPK8(p, pr); UNPK8(n, nr);
                const f32x4 m0a = *(const f32x4*)(mu + col), m0b = *(const f32x4*)(mu + col + 4), m1a = *(const f32x4*)(mu + RWC + col), m1b = *(const f32x4*)(mu + RWC + col + 4);
#pragma unroll
                for (int e = 0; e < 4; ++e) { s8[e] = z[e] + m0a[e] * (p[e] - z[e]) + m1a[e] * (n[e] - z[e]); s8[4 + e] = z[4 + e] + m0b[e] * (p[4 + e] - z[4 + e]) + m1b[e] * (n[4 + e] - z[4 + e]); }
                if (col < 512) *(u32x4*)(RB + (size_t)g * 512 + col) = PK8(s8);
                else if (col < 1024) {
                    const int ck = col - 512;
                    *(u32x4*)(KS + (size_t)g * 512 + ck) = PK8(s8);
                    const f32x4 kwa = *(const f32x4*)(kkw + ck), kwb = *(const f32x4*)(kkw + ck + 4);
                    float kk[8]; float ss = 0.f;
#pragma unroll
                    for (int e = 0; e < 4; ++e) { kk[e] = s8[e] * kwa[e]; kk[4 + e] = s8[4 + e] * kwb[e]; ss += kk[e] * kk[e] + kk[4 + e] * kk[4 + e]; }
                    ss += __shfl_xor(ss, 1); ss += __shfl_xor(ss, 2); ss += __shfl_xor(ss, 4);
                    const float inv = 1.0f / fmaxf(sqrtf(ss), 1e-12f);
#pragma unroll
                    for (int e = 0; e < 8; ++e) kk[e] *= inv;
                    *(u32x4*)(KKN + (size_t)g * 512 + ck) = PK8(kk);
                }
                else if (col < 1536) *(u32x4*)(VS + (size_t)g * 512 + (col - 1024)) = PK8(s8);
                else {
                    float t8[8];
#pragma unroll
                    for (int e = 0; e < 8; ++e) t8[e] = col < 1664 ? tanhf(s8[e]) : (col < 1792 ? s8[e] : sigmoidf_(s8[e]));
                    *(u32x4*)(LIN + (size_t)g * 384 + (col - 1536)) = PK8(t8);
                }
            }
        }
    }
#undef UNPK8
#undef PK8
}
__device__ __forceinline__ void ph_gemm_lora(const Args& A, int j, int row_lo, LAS unsigned char* lds, int bid, int nb) {
    unsigned char* ws = opq(A.ws);
    int Kq = LORA_K; asm volatile("" : "+s"(Kq));
    pg8::Gemm g{(const bf16_t*)(ws + WS_LIN) + (size_t)row_lo * LORA_K, (const bf16_t*)(ws + WS_WLORA) + (size_t)j * LORA_N * LORA_K, NTOK - row_lo, LORA_N, Kq};
    const ListOrder S = build_units(lds, (NTOK - row_lo) / 256, LORA_N / 256, nb, bid, nullptr, 0);
    EpiLora E{(bf16_t*)(ws + WS_LO), (const float*)(ws + WS_LBIAS) + (size_t)j * LORA_N, row_lo};
    pg8::gemm_phase<EpiLora, ListOrder, true, true>(lds, g, S, E);
}

constexpr int R_A2 = 0, R_RT = 2048, R_BT = 4096, R_KT = 6144, R_VT = 8192, R_MBR = 10240, R_MKR = 10752, R_G = 11264, R_P = 11776;
__device__ __forceinline__ bf16x8 frag4(u32x2 lo) { const u32x4 w = {lo.x, lo.y, 0u, 0u}; return __builtin_bit_cast(bf16x8, w); }
__device__ __forceinline__ bf16x8 frag8(u32x2 lo, u32x2 hi) { const u32x4 w = {lo.x, lo.y, hi.x, hi.y}; return __builtin_bit_cast(bf16x8, w); }
__device__ __forceinline__ u32x2 pack4(f32x4 v) { u32x2 o; o.x = cvtpk_s(v[0], v[1]); o.y = cvtpk_s(v[2], v[3]); return o; }
__device__ __forceinline__ int wkv_token(int b, int dir, int s) {
    if (s < TC) return b * TC + (dir ? (TC - 1 - s) : s);
    const int q = s - TC; return NCTX + b * TL + (dir ? (TL - 1 - q) : q);
}
__device__ __forceinline__ float dpp_row_shr(float x, const int n) {
    switch (n) {
        case 1: return __builtin_bit_cast(float, __builtin_amdgcn_update_dpp(0, __builtin_bit_cast(int, x), 0x111, 0xF, 0xF, false));
        case 2: return __builtin_bit_cast(float, __builtin_amdgcn_update_dpp(0, __builtin_bit_cast(int, x), 0x112, 0xF, 0xF, false));
        case 4: return __builtin_bit_cast(float, __builtin_amdgcn_update_dpp(0, __builtin_bit_cast(int, x), 0x114, 0xF, 0xF, false));
        default: return __builtin_bit_cast(float, __builtin_amdgcn_update_dpp(0, __builtin_bit_cast(int, x), 0x118, 0xF, 0xF, false));
    }
}
#define WKV_TR(dst, addr) asm volatile("ds_read_b64_tr_b16 %0, %1" : "=&v"(dst) : "v"(addr) : "memory")
__device__ __forceinline__ void wkv_produce(unsigned char* ws, const float* const* IN, int j, int b, int h, int dir, int c, LAS unsigned char* wl, LAS unsigned char* rec, int lane) {
    const int c16 = lane & 15, g4 = lane >> 4;
    constexpr int RS = 144;
    LAS unsigned char* Lat = wl; LAS unsigned char* Lbt = wl + 2304; LAS unsigned char* Lkt = wl + 4608; LAS unsigned char* Lrt = wl + 6912; LAS unsigned char* Lvt = wl + 9216;
    LAS float* Lnf = (LAS float*)(wl + 11520);
    LAS unsigned char* Lx = wl + 12608;
    const size_t FS = (size_t)NTOK * 512;
    const bf16_t* RB = (const bf16_t*)(ws + WS_RB); const bf16_t* KS = (const bf16_t*)(ws + WS_KS); const bf16_t* VS = (const bf16_t*)(ws + WS_VS); const bf16_t* KKN = (const bf16_t*)(ws + WS_KKN);
#define UNPK16(dst, p) do { const u32x4 _a = *(const u32x4*)(p), _b = *(const u32x4*)((p) + 8); _Pragma("unroll") for (int _i = 0; _i < 4; ++_i) { \
        dst[2 * _i] = __builtin_bit_cast(float, _a[_i] << 16); dst[2 * _i + 1] = __builtin_bit_cast(float, _a[_i] & 0xffff0000u); \
        dst[8 + 2 * _i] = __builtin_bit_cast(float, _b[_i] << 16); dst[9 + 2 * _i] = __builtin_bit_cast(float, _b[_i] & 0xffff0000u); } } while (0)
#define PK16ST(base, v) do { *(LAS u32x4*)(base) = (u32x4){pk2(v[0], v[1]), pk2(v[2], v[3]), pk2(v[4], v[5]), pk2(v[6], v[7])}; \
        *(LAS u32x4*)((base) + 16) = (u32x4){pk2(v[8], v[9]), pk2(v[10], v[11]), pk2(v[12], v[13]), pk2(v[14], v[15])}; } while (0)
    {
        const int g0 = wkv_token(b, dir, c * 16), gstep = dir ? -1 : 1;
        {
            const size_t o = (size_t)(g0 + gstep * c16) * 512 + h * 64 + 16 * g4;
            float lw[16], av[16], kv[16], kn[16], rv[16];
            UNPK16(lw, (const bf16_t*)(ws + WS_LO) + dir * FS + o); UNPK16(av, (const bf16_t*)(ws + WS_AB) + dir * FS + o);
            UNPK16(kv, KS + o); UNPK16(kn, KKN + o); UNPK16(rv, RB + o);
            { const u32x4 v0 = *(const u32x4*)(VS + o), v1 = *(const u32x4*)(VS + o + 8); *(LAS u32x4*)(Lvt + c16 * RS + 32 * g4) = v0; *(LAS u32x4*)(Lvt + c16 * RS + 32 * g4 + 16) = v1; }
            const float* kap = INP(I_RWKA) + j * 512 + h * 64 + 16 * g4;
            float at[16], bt[16], kt[16], rt[16], ecl[16];
#pragma unroll
            for (int i = 0; i < 16; ++i) {
                float cs = lw[i];
                cs += dpp_row_shr(cs, 1); cs += dpp_row_shr(cs, 2); cs += dpp_row_shr(cs, 4); cs += dpp_row_shr(cs, 8);
                const float ep = __expf(cs - lw[i]), ec = __expf(cs), em = __builtin_amdgcn_rcpf(ec);
                at[i] = -kn[i] * ep; bt[i] = kn[i] * av[i] * em; kt[i] = kv[i] * (1.0f + (av[i] - 1.0f) * kap[i]) * em; rt[i] = rv[i] * ec; ecl[i] = ec;
            }
            PK16ST(Lat + c16 * RS + 32 * g4, at); PK16ST(Lbt + c16 * RS + 32 * g4, bt); PK16ST(Lkt + c16 * RS + 32 * g4, kt); PK16ST(Lrt + c16 * RS + 32 * g4, rt);
            if (c16 == 15) {
#pragma unroll
                for (int q = 0; q < 4; ++q) *(LAS f32x4*)(rec + R_P + (16 * g4 + 4 * q) * 4) = (f32x4){ecl[4 * q], ecl[4 * q + 1], ecl[4 * q + 2], ecl[4 * q + 3]};
            }
        }
        asm volatile("s_waitcnt lgkmcnt(0)" ::: "memory");
        f32x4 nD = {0.f, 0.f, 0.f, 0.f}, makD = nD, mbrD = nD, mkrD = nD;
#pragma unroll
        for (int ks = 0; ks < 2; ++ks) {
            const int off = c16 * RS + (32 * ks + 8 * g4) * 2;
            const bf16x8 fa = *(const LAS bf16x8*)(Lat + off), fb = *(const LAS bf16x8*)(Lbt + off), fk = *(const LAS bf16x8*)(Lkt + off), fr = *(const LAS bf16x8*)(Lrt + off);
            nD = __builtin_amdgcn_mfma_f32_16x16x32_bf16(fa, fb, nD, 0, 0, 0);
            makD = __builtin_amdgcn_mfma_f32_16x16x32_bf16(fa, fk, makD, 0, 0, 0);
            mbrD = __builtin_amdgcn_mfma_f32_16x16x32_bf16(fb, fr, mbrD, 0, 0, 0);
            mkrD = __builtin_amdgcn_mfma_f32_16x16x32_bf16(fk, fr, mkrD, 0, 0, 0);
        }
#pragma unroll
        for (int r = 0; r < 4; ++r) {
            const int row = 4 * g4 + r;
            nD[r] = (c16 < row) ? nD[r] : 0.f; makD[r] = (c16 < row) ? makD[r] : 0.f;
            mbrD[r] = (row <= c16) ? mbrD[r] : 0.f; mkrD[r] = (row <= c16) ? mkrD[r] : 0.f;
            Lnf[row * 17 + c16] = nD[r];
        }
        asm volatile("s_waitcnt lgkmcnt(0)" ::: "memory");
        float x[16];
#pragma unroll
        for (int t = 0; t < 16; ++t) {
            float acc = (t == c16) ? 1.f : 0.f;
#pragma unroll
            for (int i = 0; i < t; ++i) acc += Lnf[t * 17 + i] * x[i];
            x[t] = acc;
        }
        if (g4 == 0) {
#pragma unroll
            for (int t = 0; t < 16; ++t) *(LAS bf16_t*)(Lx + t * 32 + c16 * 2) = (bf16_t)f2bf(x[t]);
        }
        asm volatile("s_waitcnt lgkmcnt(0)" ::: "memory");
        const bf16x8 xB = frag4(*(const LAS u32x2*)(Lx + c16 * 32 + g4 * 8));
        const f32x4 z4 = {0.f, 0.f, 0.f, 0.f};
        const f32x4 gD = __builtin_amdgcn_mfma_f32_16x16x32_bf16(frag4(pack4(makD)), xB, z4, 0, 0, 0);
        *(LAS u32x2*)(rec + R_G + (c16 * 16 + 4 * g4) * 2) = pack4(gD);
        *(LAS u32x2*)(rec + R_MBR + (c16 * 16 + 4 * g4) * 2) = pack4(mbrD);
        *(LAS u32x2*)(rec + R_MKR + (c16 * 16 + 4 * g4) * 2) = pack4(mkrD);
        {
            const int trow = c16 >> 2, tcol = 4 * (c16 & 3);
            u32x2 ta[4], tb[4], tk[4], tv[4];
#pragma unroll
            for (int m = 0; m < 4; ++m) {
                const int aA = (int)(uintptr_t)(Lat + (4 * g4 + trow) * RS + (16 * m + tcol) * 2);
                const int offr = (4 * m + trow) * RS + (16 * g4 + tcol) * 2;
                const int aB = (int)(uintptr_t)(Lbt + offr), aK = (int)(uintptr_t)(Lkt + offr), aV = (int)(uintptr_t)(Lvt + offr);
                WKV_TR(ta[m], aA); WKV_TR(tb[m], aB); WKV_TR(tk[m], aK); WKV_TR(tv[m], aV);
            }
            asm volatile("s_waitcnt lgkmcnt(0)" ::: "memory"); __builtin_amdgcn_sched_barrier(0);
#pragma unroll
            for (int m = 0; m < 4; ++m) {
                const f32x4 d = __builtin_amdgcn_mfma_f32_16x16x32_bf16(frag4(ta[m]), xB, z4, 0, 0, 0);
                *(LAS u32x2*)(rec + R_A2 + (c16 * 64 + 16 * m + 4 * g4) * 2) = pack4(d);
            }
            const int kch = 16 * g4 + c16;
            *(LAS u32x4*)(rec + R_BT + kch * 32) = (u32x4){tb[0].x, tb[0].y, tb[1].x, tb[1].y}; *(LAS u32x4*)(rec + R_BT + kch * 32 + 16) = (u32x4){tb[2].x, tb[2].y, tb[3].x, tb[3].y};
            *(LAS u32x4*)(rec + R_KT + kch * 32) = (u32x4){tk[0].x, tk[0].y, tk[1].x, tk[1].y}; *(LAS u32x4*)(rec + R_KT + kch * 32 + 16) = (u32x4){tk[2].x, tk[2].y, tk[3].x, tk[3].y};
            *(LAS u32x4*)(rec + R_VT + kch * 32) = (u32x4){tv[0].x, tv[0].y, tv[1].x, tv[1].y}; *(LAS u32x4*)(rec + R_VT + kch * 32 + 16) = (u32x4){tv[2].x, tv[2].y, tv[3].x, tv[3].y};
        }
        { const int row = lane >> 2, cb = (lane & 3) * 16;
          const u32x4 r0 = *(const LAS u32x4*)(Lrt + row * RS + cb * 2), r1 = *(const LAS u32x4*)(Lrt + row * RS + cb * 2 + 16);
          *(LAS u32x4*)(rec + R_RT + (row * 64 + cb) * 2) = r0; *(LAS u32x4*)(rec + R_RT + (row * 64 + cb) * 2 + 16) = r1; }
        asm volatile("s_waitcnt lgkmcnt(0)" ::: "memory");
    }
#undef UNPK16
#undef PK16ST
}

struct QkC { float qn[8], kn[8], invf[8]; bool upper, colaxis; };
__device__ __forceinline__ void qk_init(QkC& q, const float* const* IN, int j, int lane) {
    const int d0 = (lane & 7) * 8;
#pragma unroll
    for (int i = 0; i < 8; ++i) { q.qn[i] = INP(I_QN)[j * 64 + d0 + i]; q.kn[i] = INP(I_KN)[j * 64 + d0 + i]; q.invf[i] = __powf(10000.0f, -(float)((d0 + i) & 15) / 16.0f); }
    q.upper = (d0 & 16) != 0; q.colaxis = (d0 & 32) != 0;
}
__device__ __forceinline__ void qk_token(const QkC& q, unsigned char* ws, int g, int lane) {
    const bf16_t* Z = (const bf16_t*)(ws + WS_Z);
    bf16_t* QB = (bf16_t*)(ws + WS_QB); bf16_t* KB = (bf16_t*)(ws + WS_KB); bf16_t* VB = (bf16_t*)(ws + WS_VB);
    const bool upper = q.upper, colaxis = q.colaxis;
    {
        const Tok tk = tokinfo(g);
        const size_t krow = (size_t)tk.b * (TC + TL) + (tk.T == TL ? TC + tk.t : tk.t);
        const bf16_t* zr = Z + (size_t)g * ZLD + RWC;
        *(u32x4*)(VB + krow * 512 + lane * 8) = *(const u32x4*)(zr + 1024 + lane * 8);
        float cs[8], sn[8];
        if (tk.T == TL) {
            const float pos = (float)(colaxis ? (tk.t & 63) : (tk.t >> 6));
#pragma unroll
            for (int i = 0; i < 8; ++i) __sincosf(pos * q.invf[i], &sn[i], &cs[i]);
        }
#pragma unroll
        for (int isk = 0; isk < 2; ++isk) {
            const u32x4 raw = *(const u32x4*)(zr + isk * 512 + lane * 8);
            float x[8];
#pragma unroll
            for (int i = 0; i < 4; ++i) { x[2 * i] = __builtin_bit_cast(float, raw[i] << 16); x[2 * i + 1] = __builtin_bit_cast(float, raw[i] & 0xffff0000u); }
            float ss = 0.f;
#pragma unroll
            for (int i = 0; i < 8; ++i) ss += x[i] * x[i];
            ss += __shfl_xor(ss, 1); ss += __shfl_xor(ss, 2); ss += __shfl_xor(ss, 4);
            const float rs = rsqrtf(ss * (1.0f / 64.0f) + 1e-6f);
#pragma unroll
            for (int i = 0; i < 8; ++i) x[i] = x[i] * rs * (isk ? q.kn[i] : q.qn[i] * att::QSCALE);
            if (tk.T == TL) {
#pragma unroll
                for (int i = 0; i < 8; ++i) { const float other = __shfl_xor(x[i], 2); x[i] = upper ? (x[i] * cs[i] + other * sn[i]) : (x[i] * cs[i] - other * sn[i]); }
            }
            u32x4 o; o.x = pk2(x[0], x[1]); o.y = pk2(x[2], x[3]); o.z = pk2(x[4], x[5]); o.w = pk2(x[6], x[7]);
            if (isk) *(u32x4*)(KB + krow * 512 + lane * 8) = o; else *(u32x4*)(QB + (size_t)g * 512 + lane * 8) = o;
        }
    }
}
__device__ __forceinline__ void ph_wkv_fused(const Args& A, int j, int row_lo, LAS unsigned char* lds, int bid, int nb) {
    unsigned char* ws = opq(A.ws); const float* const* IN = (const float* const*)(ws + WS_PTRS);
    const int tid = tid_opaque(), lane = tid & 63, wid = __builtin_amdgcn_readfirstlane(tid >> 6), c16 = lane & 15, g4 = lane >> 4;
    bf16_t* YS = (bf16_t*)(ws + WS_YS); const size_t FS = (size_t)NTOK * 512;
    constexpr int RING = 8 * WKV_REC, NRND = WKV_NCH / 4;
    static_assert(WKV_NCH % 4 == 0, "four chunks per round");
#define WKV_WGBAR() do { asm volatile("s_waitcnt lgkmcnt(0)" ::: "memory"); __builtin_amdgcn_s_barrier(); asm volatile("" ::: "memory"); } while (0)
    for (int inst = bid; inst < 256; inst += nb) {
        const int dir = inst & 1, h = (inst >> 1) & 7, b = inst >> 4;
        WKV_WGBAR();
        if (wid >= 4) {
            LAS unsigned char* wl = lds + RING + (wid - 4) * 13824;
            for (int r = 0; r < NRND; ++r) {
                wkv_produce(ws, IN, j, b, h, dir, 4 * r + (wid - 4), wl, lds + ((r & 1) * 4 + (wid - 4)) * WKV_REC, lane);
                WKV_WGBAR();
            }
            WKV_WGBAR();
        } else {
            const int v0 = wid * 16;
            bf16_t* Y = YS + dir * FS + h * 64 + v0 + (c16 & ~1); const bool oddl = (c16 & 1) != 0;
            f32x4 S[4];
#pragma unroll
            for (int mt = 0; mt < 4; ++mt) S[mt] = (f32x4){0.f, 0.f, 0.f, 0.f};
            QkC qc; qk_init(qc, IN, j, lane);
            WKV_WGBAR();
            for (int r = 0; r < NRND; ++r) {
                for (int k = 0; k < 4; ++k) {
                    const int c = 4 * r + k;
                    const LAS unsigned char* rec = lds + ((r & 1) * 4 + k) * WKV_REC;
                    u32x2 a2[4], rt[4], bt[4], kt[4]; f32x4 p[4];
    #pragma unroll
                    for (int q = 0; q < 4; ++q) {
                        a2[q] = *(const LAS u32x2*)(rec + R_A2 + (c16 * 64 + 16 * q + 4 * g4) * 2);
                        rt[q] = *(const LAS u32x2*)(rec + R_RT + (c16 * 64 + 16 * q + 4 * g4) * 2);
                        bt[q] = *(const LAS u32x2*)(rec + R_BT + ((16 * q + c16) * 16 + 4 * g4) * 2);
                        kt[q] = *(const LAS u32x2*)(rec + R_KT + ((16 * q + c16) * 16 + 4 * g4) * 2);
                        p[q] = *(const LAS f32x4*)(rec + R_P + (16 * q + 4 * g4) * 4);
                    }
                    const u32x2 gq = *(const LAS u32x2*)(rec + R_G + (c16 * 16 + 4 * g4) * 2), mkr = *(const LAS u32x2*)(rec + R_MKR + (c16 * 16 + 4 * g4) * 2), mbr = *(const LAS u32x2*)(rec + R_MBR + (c16 * 16 + 4 * g4) * 2);
                    const u32x2 vt = *(const LAS u32x2*)(rec + R_VT + ((v0 + c16) * 16 + 4 * g4) * 2);
                    const f32x4 z4 = {0.f, 0.f, 0.f, 0.f};
                    const bf16x8 sb0 = frag8(pack4(S[0]), pack4(S[1])), sb1 = frag8(pack4(S[2]), pack4(S[3]));
                    const bf16x8 vb = frag4(vt);
                    f32x4 U = __builtin_amdgcn_mfma_f32_16x16x32_bf16(frag4(gq), vb, z4, 0, 0, 0);
                    U = __builtin_amdgcn_mfma_f32_16x16x32_bf16(frag8(a2[0], a2[1]), sb0, U, 0, 0, 0);
                    U = __builtin_amdgcn_mfma_f32_16x16x32_bf16(frag8(a2[2], a2[3]), sb1, U, 0, 0, 0);
                    f32x4 Yt = __builtin_amdgcn_mfma_f32_16x16x32_bf16(frag4(mkr), vb, z4, 0, 0, 0);
                    Yt = __builtin_amdgcn_mfma_f32_16x16x32_bf16(frag8(rt[0], rt[1]), sb0, Yt, 0, 0, 0);
                    Yt = __builtin_amdgcn_mfma_f32_16x16x32_bf16(frag8(rt[2], rt[3]), sb1, Yt, 0, 0, 0);
                    const bf16x8 ub = frag4(pack4(U));
                    Yt = __builtin_amdgcn_mfma_f32_16x16x32_bf16(frag4(mbr), ub, Yt, 0, 0, 0);
    #pragma unroll
                    for (int mt = 0; mt < 4; ++mt) {
                        f32x4 sn = __builtin_amdgcn_mfma_f32_16x16x32_bf16(frag4(kt[mt]), vb, S[mt], 0, 0, 0);
                        sn = __builtin_amdgcn_mfma_f32_16x16x32_bf16(frag4(bt[mt]), ub, sn, 0, 0, 0);
                        S[mt] = sn * p[mt];
                    }
    #pragma unroll
                    for (int q = 0; q < 2; ++q) {
                        const float send = oddl ? Yt[q] : Yt[2 + q], mine = oddl ? Yt[2 + q] : Yt[q];
                        const float recv = __builtin_bit_cast(float, __builtin_amdgcn_update_dpp(0, __builtin_bit_cast(int, send), 0xB1, 0xF, 0xF, false));
                        *(unsigned*)(Y + (size_t)wkv_token(b, dir, c * 16 + 4 * g4 + (oddl ? 2 + q : q)) * 512) = oddl ? cvtpk_s(recv, mine) : cvtpk_s(mine, recv);
                    }
                }
                if (inst == bid) {
                    for (int g = row_lo + bid * 4 + wid + r * (nb * 4); g < NTOK; g += nb * 4 * NRND) qk_token(qc, ws, g, lane);
                }
                WKV_WGBAR();
            }
        }
    }
#undef WKV_WGBAR
}

__device__ __forceinline__ void ph_attn(const Args& A, bool want_ctx, LAS unsigned char* lds, int bid, int nb) {
    unsigned char* ws = opq(A.ws);
    const bf16_t* QB = (const bf16_t*)(ws + WS_QB); const bf16_t* KB = (const bf16_t*)(ws + WS_KB); const bf16_t* VB = (const bf16_t*)(ws + WS_VB);
    bf16_t* OP = (bf16_t*)(ws + WS_OP);
    const int vcu = (nb % 8 == 0) ? (bid % 8) * (nb / 8) + bid / 8 : bid;
    const int nunits = 1024 + (want_ctx ? 128 : 0);
    for (int u = vcu; u < nunits; u += nb) {
        int b, h, m, q0, seq;
        if (u < 1024) { const int qb = u & 7; m = (u >> 3) & 1; h = (u >> 4) & 3; b = u >> 6; q0 = NCTX + b * TL + qb * 256; seq = TC + TL; }
        else { const int v = u - 1024; m = v & 1; h = (v >> 1) & 3; b = v >> 3; q0 = b * TC; seq = TC; }
        const int s = h * 2 + m;
        att::attn_body(QB + (size_t)q0 * 512 + s * 64, KB + (size_t)b * (TC + TL) * 512 + s * 64, VB + (size_t)b * (TC + TL) * 512 + h * 128,
                       OP + (size_t)m * NTOK * 512 + (size_t)q0 * 512 + h * 128, seq, lds);
    }
}

__device__ __forceinline__ void ph_merge(const Args& A, int l, int row_lo, int bid, int nb) {
    unsigned char* ws = opq(A.ws); const float* const* IN = (const float* const*)(ws + WS_PTRS);
    const int j = l >> 1;
    const int tid = tid_opaque(), lane = tid & 63, wid = tid >> 6, c0 = lane * 8;
    const float lam_init = 0.8f - 0.6f * __expf(-0.3f * (float)l);
    const float* lp = INP(I_LAM) + j * 4 * 64;
    const float lam = __expf(wave_sum(lp[lane] * lp[64 + lane])) - __expf(wave_sum(lp[128 + lane] * lp[192 + lane])) + lam_init;
    const size_t FS = (size_t)NTOK * 512;
    const bf16_t* RB = (const bf16_t*)(ws + WS_RB); const bf16_t* KS = (const bf16_t*)(ws + WS_KS); const bf16_t* VS = (const bf16_t*)(ws + WS_VS);
    const bf16_t* AB = (const bf16_t*)(ws + WS_AB); const bf16_t* GB = (const bf16_t*)(ws + WS_GB);
    const bf16_t* YS = (const bf16_t*)(ws + WS_YS); const bf16_t* OP = (const bf16_t*)(ws + WS_OP);
    bf16_t* CAT = (bf16_t*)(ws + WS_CAT);
    float gnw[8], gnb[8], kaw[8], rkw[8], sub[8];
#pragma unroll
    for (int i = 0; i < 8; ++i) { gnw[i] = INP(I_GNW)[j * 512 + c0 + i]; gnb[i] = INP(I_GNB)[j * 512 + c0 + i]; kaw[i] = INP(I_RWKA)[j * 512 + c0 + i]; rkw[i] = INP(I_RWRK)[j * 512 + c0 + i];
        sub[i] = INP(I_SUBLN)[j * 128 + ((c0 + i) & 127)] * (1.0f - lam_init); }
#define LD8BF(dst, ptr) do { const u32x4 _t = *(const u32x4*)(ptr); _Pragma("unroll") for (int _i = 0; _i < 4; ++_i) { dst[2 * _i] = __builtin_bit_cast(float, _t[_i] << 16); dst[2 * _i + 1] = __builtin_bit_cast(float, _t[_i] & 0xffff0000u); } } while (0)
#define CV8BF(dst, _t) do { _Pragma("unroll") for (int _i = 0; _i < 4; ++_i) { dst[2 * _i] = __builtin_bit_cast(float, _t[_i] << 16); dst[2 * _i + 1] = __builtin_bit_cast(float, _t[_i] & 0xffff0000u); } } while (0)
#define MLOAD(P, gi) do { const size_t _o = (size_t)(gi) * 512 + c0; \
        P##y = *(const u32x4*)(YS + _o); P##z = *(const u32x4*)(YS + FS + _o); \
        P##r = *(const u32x4*)(RB + _o); P##k = *(const u32x4*)(KS + _o); P##v = *(const u32x4*)(VS + _o); P##a0 = *(const u32x4*)(AB + _o); P##a1 = *(const u32x4*)(AB + FS + _o); P##g = *(const u32x4*)(GB + _o); \
        P##p = *(const u32x4*)(OP + _o); P##q = *(const u32x4*)(OP + FS + _o); } while (0)
    const int gstep = nb * NWAVES;
    int g = row_lo + bid * NWAVES + wid;
    u32x4 c_y, c_z, c_p, c_q, c_r, c_k, c_v, c_a0, c_a1, c_g;
    if (g < NTOK) MLOAD(c_, g);
    for (; g < NTOK; g += gstep) {
        u32x4 n_y, n_z, n_p, n_q, n_r, n_k, n_v, n_a0, n_a1, n_g;
        { const int gn = (g + gstep < NTOK) ? g + gstep : g; MLOAD(n_, gn); }
        float y[8], r_[8], k_[8], v_[8], a0[8], a1[8], gg[8];
        { float yb[8]; CV8BF(y, c_y); CV8BF(yb, c_z);
#pragma unroll
          for (int i = 0; i < 8; ++i) y[i] += yb[i]; }
        CV8BF(r_, c_r); CV8BF(k_, c_k); CV8BF(v_, c_v); CV8BF(a0, c_a0); CV8BF(a1, c_a1); CV8BF(gg, c_g);
        float sy = 0.f, sb = 0.f;
#pragma unroll
        for (int i = 0; i < 8; ++i) { sy += y[i]; sb += r_[i] * k_[i] * (2.0f + (a0[i] + a1[i] - 2.0f) * kaw[i]) * rkw[i]; }
        sy += __shfl_xor(sy, 1); sy += __shfl_xor(sy, 2); sy += __shfl_xor(sy, 4);
        sb += __shfl_xor(sb, 1); sb += __shfl_xor(sb, 2); sb += __shfl_xor(sb, 4);
        const float mu = sy * (1.0f / 64.0f);
        float sv = 0.f;
#pragma unroll
        for (int i = 0; i < 8; ++i) { y[i] -= mu; sv += y[i] * y[i]; }
        sv += __shfl_xor(sv, 1); sv += __shfl_xor(sv, 2); sv += __shfl_xor(sv, 4);
        const float rstd = rsqrtf(sv * (1.0f / 64.0f) + 64e-5f);
        float ya[8];
#pragma unroll
        for (int i = 0; i < 8; ++i) ya[i] = (y[i] * rstd * gnw[i] + gnb[i] + sb * v_[i]) * gg[i];
        { u32x4 w; w.x = pk2(ya[0], ya[1]); w.y = pk2(ya[2], ya[3]); w.z = pk2(ya[4], ya[5]); w.w = pk2(ya[6], ya[7]); *(u32x4*)(CAT + (size_t)g * DM + c0) = w; }
        float od[8];
        { float ob[8]; CV8BF(od, c_p); CV8BF(ob, c_q);
#pragma unroll
          for (int i = 0; i < 8; ++i) od[i] -= lam * ob[i]; }
        float so = 0.f;
#pragma unroll
        for (int i = 0; i < 8; ++i) so += od[i] * od[i];
        so += __shfl_xor(so, 1); so += __shfl_xor(so, 2); so += __shfl_xor(so, 4); so += __shfl_xor(so, 8);
        const float ro = rsqrtf(so * (1.0f / 128.0f) + 1e-6f);
        { u32x4 w; w.x = pk2(od[0] * ro * sub[0], od[1] * ro * sub[1]); w.y = pk2(od[2] * ro * sub[2], od[3] * ro * sub[3]);
          w.z = pk2(od[4] * ro * sub[4], od[5] * ro * sub[5]); w.w = pk2(od[6] * ro * sub[6], od[7] * ro * sub[7]); *(u32x4*)(CAT + (size_t)g * DM + 512 + c0) = w; }
        c_y = n_y; c_z = n_z; c_p = n_p; c_q = n_q;
        c_r = n_r; c_k = n_k; c_v = n_v; c_a0 = n_a0; c_a1 = n_a1; c_g = n_g;
    }
#undef MLOAD
#undef CV8BF
#undef LD8BF
}

__device__ __forceinline__ void ph_gemm_out(const Args& A, int l, size_t x_off, size_t wt_off, int row_lo, LAS unsigned char* lds, int bid, int nb) {
    unsigned char* ws = opq(A.ws); const float* const* IN = (const float* const*)(ws + WS_PTRS); (void)IN;
    pg8::Gemm g{(const bf16_t*)(ws + x_off) + (size_t)row_lo * DM, (const bf16_t*)(ws + wt_off), NTOK - row_lo, DM, DM};
    const ListOrder S = build_units(lds, (NTOK - row_lo) / 256, DM / 256, nb, bid, nullptr, 0);
    EpiResidual E{(bf16_t*)(ws + WS_H) + (size_t)row_lo * DM, (const float*)(ws + WS_MOD) + (size_t)l * 17 * 6144 + 2 * 1024, row_lo};
    pg8::gemm_phase<EpiResidual, ListOrder, true, true>(lds, g, S, E);
}

__device__ __forceinline__ void ph_gemm_sgin(const Args& A, int j, int row_lo, LAS unsigned char* lds, int bid, int nb) {
    unsigned char* ws = opq(A.ws); const float* const* IN = (const float* const*)(ws + WS_PTRS); (void)IN;
    pg8::Gemm g{(const bf16_t*)(ws + WS_ABF) + (size_t)row_lo * DM, (const bf16_t*)(ws + WS_SGIN) + (size_t)j * 2048 * DM, NTOK - row_lo, 2048, DM};
    const ListOrder S = build_units(lds, (NTOK - row_lo) / 256, 2048 / 256, nb, bid, nullptr, 0);
    EpiGeluBf16 E{(bf16_t*)(ws + WS_Z2) + (size_t)row_lo * 2048, 2048, INP(I_SGBIN) + j * 2048};
    pg8::gemm_phase<EpiGeluBf16, ListOrder, true, true>(lds, g, S, E);
}
__device__ __forceinline__ void ph_sgu_stats(const Args& A, int row_lo, int bid, int nb) {
    unsigned char* ws = opq(A.ws);
    const int tid = tid_opaque(), lane = tid & 63, wid = tid >> 6;
    const bf16_t* Z2 = (const bf16_t*)(ws + WS_Z2); float* ST = (float*)(ws + WS_VST);
    for (int row = row_lo + bid * NWAVES + wid; row < NTOK; row += nb * NWAVES) {
        const u32x4 t0 = *(const u32x4*)(Z2 + (size_t)row * 2048 + 1024 + lane * 8), t1 = *(const u32x4*)(Z2 + (size_t)row * 2048 + 1536 + lane * 8);
        float v[16]; float s = 0.f;
#pragma unroll
        for (int i = 0; i < 4; ++i) { v[2 * i] = __builtin_bit_cast(float, t0[i] << 16); v[2 * i + 1] = __builtin_bit_cast(float, t0[i] & 0xffff0000u);
            v[8 + 2 * i] = __builtin_bit_cast(float, t1[i] << 16); v[9 + 2 * i] = __builtin_bit_cast(float, t1[i] & 0xffff0000u); }
#pragma unroll
        for (int i = 0; i < 16; ++i) s += v[i];
        const float mean = wave_sum(s) * (1.0f / 1024.0f); float s2 = 0.f;
#pragma unroll
        for (int i = 0; i < 16; ++i) { const float d = v[i] - mean; s2 += d * d; }
        const float rstd = rsqrtf(wave_sum(s2) * (1.0f / 1024.0f) + 1e-5f);
        if (lane == 0) { ST[(size_t)row * 2] = mean; ST[(size_t)row * 2 + 1] = rstd; }
    }
}
__device__ __forceinline__ void ph_sgu_spatial(const Args& A, int j, int row_lo, LAS unsigned char* lds, int bid, int nb) {
    unsigned char* ws = opq(A.ws); const float* const* IN = (const float* const*)(ws + WS_PTRS);
    const int tid = tid_opaque(), lane = tid & 63, wid = tid >> 6, c16 = lane & 15, g4 = lane >> 4;
    const bf16_t* Z2 = (const bf16_t*)(ws + WS_Z2); const float* ST = (const float*)(ws + WS_VST); bf16_t* G = (bf16_t*)(ws + WS_G);
    constexpr int VS = 272;
    LAS unsigned char* vt = lds;
    LAS float* stl = (LAS float*)(lds + 36864);
    const int ch0 = row_lo / 128, nch = NTOK / 128 - ch0;
    for (int u = bid; u < nch * 8; u += nb) {
        const int ci = ch0 + u / 8, g = u % 8;
        const size_t r0 = (size_t)ci * 128;
        __syncthreads();
#pragma unroll
        for (int i = 0; i < 4; ++i) {
            const int idx = tid + NTHREADS * i, q = idx >> 4, jc = idx & 15;
            const u32x4 t = *(const u32x4*)(Z2 + (r0 + q) * 2048 + 1024 + g * 128 + jc * 8);
#pragma unroll
            for (int e = 0; e < 4; ++e) {
                const int c = jc * 8 + 2 * e, w = c & 31, rho = 16 * (2 * (c >> 5) + ((w >> 2) & 1)) + 4 * (w >> 3) + (w & 3);
                *(LAS bf16_t*)(vt + rho * VS + q * 2) = (bf16_t)(t[e] & 0xffffu); *(LAS bf16_t*)(vt + (rho + 1) * VS + q * 2) = (bf16_t)(t[e] >> 16); }
        }
        if (tid < 256) stl[tid] = ST[r0 * 2 + tid];
        __syncthreads();
        const float* wrow = INP(I_SGWS) + (((size_t)j * 8 + g) * 128 + 16 * wid + c16) * 128;
        bf16x8 af[4]; float wm = 0.f, rs = 0.f;
#pragma unroll
        for (int ks = 0; ks < 4; ++ks) {
            const int q0 = 32 * ks + 8 * g4;
            const f32x4 w0 = *(const f32x4*)(wrow + q0), w1 = *(const f32x4*)(wrow + q0 + 4);
            float wv[8] = {w0[0], w0[1], w0[2], w0[3], w1[0], w1[1], w1[2], w1[3]};
#pragma unroll
            for (int e = 0; e < 8; ++e) { rs += wv[e]; wv[e] *= stl[(q0 + e) * 2 + 1]; wm += wv[e] * stl[(q0 + e) * 2]; }
            const u32x4 pk = {pk2(wv[0], wv[1]), pk2(wv[2], wv[3]), pk2(wv[4], wv[5]), pk2(wv[6], wv[7])};
            af[ks] = __builtin_bit_cast(bf16x8, pk);
        }
        wm += __shfl_xor(wm, 16); wm += __shfl_xor(wm, 32); rs += __shfl_xor(rs, 16); rs += __shfl_xor(rs, 32);
        f32x4 acc[8];
#pragma unroll
        for (int nt = 0; nt < 8; ++nt) acc[nt] = (f32x4){0.f, 0.f, 0.f, 0.f};
#pragma unroll
        for (int ks = 0; ks < 4; ++ks)
#pragma unroll
            for (int nt = 0; nt < 8; ++nt) {
                const bf16x8 bfr = *(const LAS bf16x8*)(vt + (16 * nt + c16) * VS + (32 * ks + 8 * g4) * 2);
                acc[nt] = __builtin_amdgcn_mfma_f32_16x16x32_bf16(bfr, af[ks], acc[nt], 0, 0, 0);
            }
        const float bs = INP(I_SGBS)[((size_t)j * 8 + g) * 128 + 16 * wid + c16];
        const size_t row = r0 + 16 * wid + c16;
#pragma unroll
        for (int k = 0; k < 4; ++k) {
            const int c = g * 128 + 32 * k + 8 * g4;
            const f32x4 lg0 = *(const f32x4*)(INP(I_SGLNG) + j * 1024 + c), lg1 = *(const f32x4*)(INP(I_SGLNG) + j * 1024 + c + 4), lb0 = *(const f32x4*)(INP(I_SGLNB) + j * 1024 + c), lb1 = *(const f32x4*)(INP(I_SGLNB) + j * 1024 + c + 4);
            const u32x4 uu = *(const u32x4*)(Z2 + row * 2048 + c);
            const f32x4 s0 = lg0 * (acc[2 * k] - wm) + lb0 * rs + bs, s1 = lg1 * (acc[2 * k + 1] - wm) + lb1 * rs + bs;
            u32x4 o;
            o.x = cvtpk_s(bflo(uu.x) * s0[0], bfhi(uu.x) * s0[1]); o.y = cvtpk_s(bflo(uu.y) * s0[2], bfhi(uu.y) * s0[3]);
            o.z = cvtpk_s(bflo(uu.z) * s1[0], bfhi(uu.z) * s1[1]); o.w = cvtpk_s(bflo(uu.w) * s1[2], bfhi(uu.w) * s1[3]);
            *(u32x4*)(G + row * DM + c) = o;
        }
    }
}

__device__ __forceinline__ int moe_layout(const Args& A, int l, int bid, int nb, LAS int* off  , LAS int* cntl  , LAS int* tile_e  , LAS int* base  ) {
    const int tid = tid_opaque();
    const int* bc = (const int*)(opq(A.ws) + WS_BCNT) + (size_t)l * 256 * 32;
    if (tid < 32) { cntl[tid] = 0; base[tid] = 0; }
    __syncthreads();
    {
        const int e = tid & 31, g = tid >> 5, per = (nb + 15) >> 4, b0 = g * per, b1 = (b0 + per < nb) ? b0 + per : nb;
        int n = 0, pre = 0;
#pragma unroll 16
        for (int b = b0; b < b1; ++b) { const int c = bc[b * 32 + e]; n += c; pre += (b < bid) ? c : 0; }
        __hip_atomic_fetch_add(cntl + e, n, __ATOMIC_RELAXED, __HIP_MEMORY_SCOPE_WORKGROUP);
        __hip_atomic_fetch_add(base + e, pre, __ATOMIC_RELAXED, __HIP_MEMORY_SCOPE_WORKGROUP);
    }
    __syncthreads();
    if (tid < 64) {
        int n = 0, pre = 0;
        if (tid < 32) { n = cntl[tid]; pre = base[tid]; }
        const int nt = (n + 255) >> 8;
        int x = nt;
#pragma unroll
        for (int o = 1; o < 32; o <<= 1) { const int y = __shfl_up(x, o); if (tid >= o) x += y; }
        const int start = x - nt;
        if (tid < 32) {
            cntl[tid] = n; off[tid] = start * 256; base[tid] = start * 256 + pre;
#pragma unroll 1
            for (int t = 0; t < nt; ++t) tile_e[start + t] = tid;
        }
        if (tid == 31) off[32] = x * 256;
    }
    __syncthreads();
    return off[32] >> 8;
}
__device__ __forceinline__ void ph_moe_scatter(const Args& A, int l, int row_lo, LAS unsigned char* lds, int bid, int nb) {
    unsigned char* ws = opq(A.ws);
    const int tid = tid_opaque();
    LAS int* off = (LAS int*)(lds + LDS_TAB); LAS int* cntl = off + 64; LAS int* tile_e = off + 128; LAS int* base = off + 800;
    moe_layout(A, l, bid, nb, off, cntl, tile_e, base);
    const int* te = (const int*)(ws + WS_TOKE); const int* tr = (const int*)(ws + WS_TOKR); int* rowof = (int*)(ws + WS_ROWOF); int* srcrow = (int*)(ws + WS_SRCROW);
    const int ngroups = (NTOK - row_lo) / 16, per = nb * NWAVES;
    const int nextra = (ngroups > per + bid) ? (ngroups - per - bid + nb - 1) / nb : 0;
    for (int q = tid; q < (NWAVES + nextra) * 64; q += NTHREADS) {
        const int slot = q >> 6, r = (q >> 2) & 15, k = q & 3;
        const int u = slot < NWAVES ? bid * NWAVES + slot : per + bid + (slot - NWAVES) * nb;
        if (u < ngroups && (slot >= NWAVES || u < per)) {
            const int row = row_lo + 16 * u + r;
            const int e = te[(size_t)row * 4 + k];
            const int pos = base[e] + tr[(size_t)row * 4 + k];
            rowof[(size_t)row * 4 + k] = pos; srcrow[pos] = row;
        }
    }
    for (int e = bid; e < 32; e += nb) {
        const int r0 = off[e] + cntl[e], r1 = off[e + 1];
        for (int i = r0 + tid; i < r1; i += NTHREADS) srcrow[i] = NCTX;
    }
}
__device__ __forceinline__ void ph_moe_gemm1(const Args& A, int l, LAS unsigned char* lds, int bid, int nb) {
    unsigned char* ws = opq(A.ws); const float* const* IN = (const float* const*)(ws + WS_PTRS); (void)IN;
    LAS int* off = (LAS int*)(lds + LDS_TAB); LAS int* cntl = off + 64; LAS int* tile_e = off + 128; LAS int* base = off + 800;
    const int T = moe_layout(A, l, bid, nb, off, cntl, tile_e, base);
    int Kq = DM / 2; asm volatile("" : "+s"(Kq));
    pg8::Gemm g{(const bf16_t*)(ws + WS_ABF), (const bf16_t*)(ws + WS_W1 + (size_t)l * NE * 2048 * DM), T * 256, 2048, Kq};
    const ListOrder S = build_units(lds, T, 8, nb, bid, tile_e, 8);
    { LAS unsigned* rowtab = (LAS unsigned*)(lds + LDS_ROWTAB); const int* srcrow = (const int*)(ws + WS_SRCROW); const int tid = tid_opaque();
      for (int q = tid; q < S.n * 256; q += NTHREADS) rowtab[q] = (unsigned)srcrow[S.list[2 * (q >> 8)] * 256 + (q & 255)] * (unsigned)DM;
      __syncthreads(); }
    EpiMoe1 E{(bf16_t*)(ws + WS_ACT), INP(I_B1) + (size_t)l * NE * 2048};
    pg8::gemm_phase<EpiMoe1, ListOrder, true, true, true, true>(lds, g, S, E);
}
__device__ __forceinline__ void ph_moe_gemm2(const Args& A, int l, LAS unsigned char* lds, int bid, int nb) {
    unsigned char* ws = opq(A.ws); const float* const* IN = (const float* const*)(ws + WS_PTRS); (void)IN;
    LAS int* off = (LAS int*)(lds + LDS_TAB); LAS int* cntl = off + 64; LAS int* tile_e = off + 128; LAS int* base = off + 800;
    const int T = moe_layout(A, l, bid, nb, off, cntl, tile_e, base);
    int Kq = DM / 2; asm volatile("" : "+s"(Kq));
    pg8::Gemm g{(const bf16_t*)(ws + WS_ACT), (const bf16_t*)(ws + WS_W2 + (size_t)l * NE * DM * DM), T * 256, DM, Kq, 0x77777777, 0x7d7d7d7d};
    const ListOrder S = build_units(lds, T, 4, nb, bid, tile_e, 4);
    LAS float* btab = (LAS float*)(lds + LDS_ROWTAB);
    { const float* b2 = INP(I_B2) + (size_t)l * NE * DM; const int tid = tid_opaque();
      for (int q = tid; q < S.n * 256; q += NTHREADS) { const int png = S.list[2 * (q >> 8) + 1]; btab[q] = b2[(size_t)(png >> 2) * DM + (png & 3) * 256 + (q & 255)]; }
      __syncthreads(); }
    EpiMoe2 E{ws + WS_YM, btab};
    pg8::gemm_phase<EpiMoe2, ListOrder, true, true, false, true, true>(lds, g, S, E);
}
__device__ __forceinline__ void ph_moe_combine(const Args& A, int l, int row_lo, bool last, int bid, int nb, bool dry = false) {
    unsigned char* ws = opq(A.ws); const float* const* IN = (const float* const*)(ws + WS_PTRS);
    const int tid = tid_opaque(), lane = tid & 63, wid = tid >> 6;
    bf16_t* H = (bf16_t*)(ws + WS_H); const float* mod = (const float*)(ws + WS_MOD); const bf16_t* YM = (const bf16_t*)(ws + WS_YM);
    bf16_t* Hw = dry ? (bf16_t*)(ws + WS_XP) : H;
    const int* rowof = (const int*)(ws + WS_ROWOF); const float* tg = (const float*)(ws + WS_TOKG);
    bf16_t* abf = dry ? (bf16_t*)(ws + WS_XP + (size_t)NTOK * DM * 4) : (bf16_t*)(ws + WS_ABF);
    const int ln = last ? l : l + 1;
    const float* gp = INP(I_N1G) + ln * 1024;
    for (int row = row_lo + bid * NWAVES + wid; row < NTOK; row += nb * NWAVES) {
        const Tok tk = tokinfo(row);
        const float* gate = mod + ((size_t)l * 17 + tk.modrow) * 6144 + 5 * 1024;
        int r[4]; float gk[4];
#pragma unroll
        for (int k = 0; k < 4; ++k) { r[k] = rowof[(size_t)row * 4 + k]; gk[k] = tg[(size_t)row * 4 + k]; }
        const unsigned char* YM8 = (const unsigned char*)YM;
        u32x4 y[4];
#pragma unroll
        for (int k = 0; k < 4; ++k) { y[k] = *(const u32x4*)(YM8 + (size_t)r[k] * DM + lane * 16); gk[k] *= (1.0f / 16.0f); }
        const int col = lane * 16;
        f32x4 hv[4]; float ss = 0.f;
        const u32x4 hb0 = *(const u32x4*)(H + (size_t)row * DM + col), hb1 = *(const u32x4*)(H + (size_t)row * DM + col + 8);
#pragma unroll
        for (int q = 0; q < 4; ++q) {
            f32x4 m = (f32x4){0.f, 0.f, 0.f, 0.f};
#pragma unroll
            for (int k = 0; k < 4; ++k) { const auto lo2 = __builtin_amdgcn_cvt_pk_f32_fp8((int)y[k][q], false), hi2 = __builtin_amdgcn_cvt_pk_f32_fp8((int)y[k][q], true);
                m = m + (f32x4){lo2[0], lo2[1], hi2[0], hi2[1]} * gk[k]; }
            { const unsigned h0 = (q >> 1) ? hb1[2 * (q & 1)] : hb0[2 * (q & 1)], h1 = (q >> 1) ? hb1[2 * (q & 1) + 1] : hb0[2 * (q & 1) + 1];
              hv[q] = (f32x4){bflo(h0), bfhi(h0), bflo(h1), bfhi(h1)} + *(const f32x4*)(gate + col + 4 * q) * m; }
            if (last && !dry) *(f32x4*)(as_global(((float* const*)IN)[38]) + (size_t)(row - NCTX) * DM + col + 4 * q) = hv[q];
            ss += (hv[q].x * hv[q].x + hv[q].y * hv[q].y) + (hv[q].z * hv[q].z + hv[q].w * hv[q].w);
        }
        if (!last || dry) { *(u32x4*)(Hw + (size_t)row * DM + col) = (u32x4){pk2(hv[0].x, hv[0].y), pk2(hv[0].z, hv[0].w), pk2(hv[1].x, hv[1].y), pk2(hv[1].z, hv[1].w)};
                            *(u32x4*)(Hw + (size_t)row * DM + col + 8) = (u32x4){pk2(hv[2].x, hv[2].y), pk2(hv[2].z, hv[2].w), pk2(hv[3].x, hv[3].y), pk2(hv[3].z, hv[3].w)}; }
        if (!last) {
            const float rstd = rsqrtf(wave_sum(ss) * (1.0f / DM) + 1e-6f);
            const float* mrow = mod + ((size_t)ln * 17 + tk.modrow) * 6144;
            u32x4 o[2];
#pragma unroll
            for (int q = 0; q < 4; ++q) {
                const f32x4 g = *(const f32x4*)(gp + col + 4 * q), sc = *(const f32x4*)(mrow + 1024 + col + 4 * q), sh = *(const f32x4*)(mrow + col + 4 * q);
                const f32x4 v = (hv[q] * rstd * g) * (sc + 1.0f) + sh;
                o[q >> 1][2 * (q & 1)] = pk2(v.x, v.y); o[q >> 1][2 * (q & 1) + 1] = pk2(v.z, v.w);
            }
            *(u32x4*)(abf + (size_t)row * DM + col) = o[0]; *(u32x4*)(abf + (size_t)row * DM + col + 8) = o[1];
        }
    }
}

__global__ void __launch_bounds__(NTHREADS, 2) fwd_kernel(Args A) {
    extern __shared__ __attribute__((aligned(16))) unsigned char lds_raw[];
    LAS unsigned char* lds = (LAS unsigned char*)lds_raw;
    volatile LAS unsigned* misc = (volatile LAS unsigned*)(lds + LDS_MISC);
    const int tid = threadIdx.x, bid = blockIdx.x, nb = gridDim.x;
    if (tid < 64) misc[tid] = 0u;
    __syncthreads();
    XcdBarrier bar = xcd_barrier_post((unsigned*)(A.ws + WS_CTL) + CW_BAR, misc + 8);
    const int lo = A.ph_lo, hi = A.ph_hi;
    int pc = 0;
#ifndef PHSEL
#define PHSEL -1
#endif
#define SEL(k) (PHSEL < 0 || PHSEL == (k))
#ifndef REPEAT_MASK
#define REPEAT_MASK 0
#endif
#define RUN(k, call) do { if (SEL(k)) { call; if ((REPEAT_MASK >> (k)) & 1) { xcd_barrier(bar); call; } } } while (0)
#define PH_BEGIN if (pc >= lo && pc < hi) {
#define PH_END } if (pc >= lo && pc + 1 < hi) xcd_barrier(bar); ++pc;

    PH_BEGIN RUN(0, ph_prologue(A, lds, bid, nb)); PH_END

    for (int l = 0; l < 4; ++l) {
        const int j = l >> 1;
        const bool ctx_out = (l < 2), ctx_in = (l < 3);
        const int rin = ctx_in ? 0 : NCTX, rout = ctx_out ? 0 : NCTX;
        if (l == 0) { PH_BEGIN RUN(1, ph_norm<false>(A, l, rin, lds, bid, nb)); PH_END }
        if ((l & 1) == 0) {
            PH_BEGIN RUN(2, ph_gemm_win(A, j, rin, lds, bid, nb)); PH_END
            PH_BEGIN RUN(3, ph_rwkv_pre(A, j, rin, bid, nb)); PH_END
            PH_BEGIN RUN(19, ph_gemm_lora(A, j, rin, lds, bid, nb)); PH_END
            PH_BEGIN RUN(5, ph_wkv_fused(A, j, rin, lds, bid, nb)); PH_END
            PH_BEGIN RUN(6, ph_attn(A, ctx_out, lds, bid, nb)); PH_END
            PH_BEGIN RUN(7, ph_merge(A, l, rout, bid, nb)); PH_END
            PH_BEGIN RUN(8, ph_gemm_out(A, l, WS_CAT, WS_WOUT + (size_t)j * DM * DM * 2, rout, lds, bid, nb)); PH_END
        } else {
            PH_BEGIN RUN(9, ph_gemm_sgin(A, j, rin, lds, bid, nb)); PH_END
            PH_BEGIN RUN(10, ph_sgu_stats(A, rin, bid, nb)); PH_END
            PH_BEGIN RUN(11, ph_sgu_spatial(A, j, rout, lds, bid, nb)); PH_END
            PH_BEGIN RUN(12, ph_gemm_out(A, l, WS_G, WS_SGOUT + (size_t)j * DM * DM * 2, rout, lds, bid, nb)); PH_END
        }
        PH_BEGIN RUN(13, ph_norm2_router(A, l, rout, lds, bid, nb)); PH_END
        PH_BEGIN RUN(14, ph_moe_scatter(A, l, rout, lds, bid, nb)); PH_END
        PH_BEGIN RUN(15, ph_moe_gemm1(A, l, lds, bid, nb)); PH_END
        PH_BEGIN RUN(16, ph_moe_gemm2(A, l, lds, bid, nb)); PH_END
        PH_BEGIN if (SEL(17)) { if ((REPEAT_MASK >> 17) & 1) { ph_moe_combine(A, l, rout, l == 3, bid, nb, true); xcd_barrier(bar); } ph_moe_combine(A, l, rout, l == 3, bid, nb); } PH_END
    }
}

extern "C" void kernel_launch(void* const* d_in, const int* in_sizes, int n_in, void* d_out, int out_size, void* d_ws, size_t ws_size, hipStream_t stream) {
    static int grid = 0;
    if (grid == 0) {
        if (n_in != 38 || out_size != NLAT * DM || ws_size < WS_END) { fprintf(stderr, "kernel_launch: unexpected shapes: n_in %d out %d ws %zu (need %zu)\n", n_in, out_size, ws_size, (size_t)WS_END); grid = -1; return; }
        int dev = 0, cus = 0, per_cu = 0;
        if (hipGetDevice(&dev) != hipSuccess || hipDeviceGetAttribute(&cus, hipDeviceAttributeMultiprocessorCount, dev) != hipSuccess) { grid = -1; return; }
        if (hipFuncSetAttribute((const void*)fwd_kernel, hipFuncAttributeMaxDynamicSharedMemorySize, LDS_BYTES) != hipSuccess) { fprintf(stderr, "kernel_launch: hipFuncSetAttribute failed\n"); grid = -1; return; }
        if (hipOccupancyMaxActiveBlocksPerMultiprocessor(&per_cu, (const void*)fwd_kernel, NTHREADS, LDS_BYTES) != hipSuccess || per_cu < 1)
            fprintf(stderr, "kernel_launch: occupancy query reports %d workgroups per CU\n", per_cu);
        (void)hipGetLastError();
        grid = cus;
    }
    if (grid < 0) return;
    if (hipMemsetAsync((char*)d_ws + WS_CTL, 0, CTL_ZERO_BYTES, stream) != hipSuccess) { fprintf(stderr, "kernel_launch: memset failed\n"); return; }
    Args a{};
    for (int i = 0; i < 38; ++i) a.in[i] = (const float*)d_in[i];
    a.out = (float*)d_out; a.ws = (unsigned char*)d_ws; a.ph_lo = 0; a.ph_hi = 1 << 20;
    hipLaunchKernelGGL(fwd_kernel, dim3(grid), dim3(NTHREADS), LDS_BYTES, stream, a);
    const hipError_t le = hipPeekAtLastError();
    if (le != hipSuccess) fprintf(stderr, "kernel_launch: launch failed: %s\n", hipGetErrorName(le));
}
```

```cpp
#include <hip/hip_runtime.h>
#include <cstdio>
#include <cstdint>

#define LAS __attribute__((address_space(3)))
typedef unsigned short bf16_t;
typedef short bf16x8 __attribute__((ext_vector_type(8)));
typedef float f32x4 __attribute__((ext_vector_type(4)));
typedef unsigned u32x4 __attribute__((ext_vector_type(4)));
typedef unsigned u32x2 __attribute__((ext_vector_type(2)));

constexpr int DM = 1024, NB = 16, TL = 2048, TC = 256;
constexpr int NCTX = NB * TC, NLAT = NB * TL, NTOK = NCTX + NLAT;
constexpr int RWC = 1920, EVC = 3456, ZLD = 3584;
constexpr int NE = 32;
constexpr int XPROWS = NTOK * 4 + NE * 256;
constexpr int NTHREADS = 512, NWAVES = 8;

constexpr size_t MiB = 1u << 20;
constexpr size_t al256(size_t x) { return (x + 255) & ~(size_t)255; }
constexpr size_t WS_CTL = 0, CTL_ZERO_BYTES = 1 * MiB - 4096;
constexpr size_t WS_PTRS = 1 * MiB - 4096;
constexpr size_t WS_MOD = 1 * MiB;
constexpr size_t WS_RTWT = al256(WS_MOD + (size_t)4 * 17 * 6144 * 4);
constexpr size_t WS_WIN = al256(WS_RTWT + (size_t)4 * 32 * 1024 * 4);
constexpr size_t WS_WOUT = al256(WS_WIN + (size_t)2 * ZLD * DM * 2);
constexpr size_t WS_SGIN = al256(WS_WOUT + (size_t)2 * DM * DM * 2);
constexpr size_t WS_SGOUT = al256(WS_SGIN + (size_t)2 * 2048 * DM * 2);
constexpr int LORA_N = 2560, LORA_K = 384;
constexpr size_t WS_WLORA = al256(WS_SGOUT + (size_t)2 * DM * DM * 2);
constexpr size_t WS_LBIAS = al256(WS_WLORA + (size_t)2 * LORA_N * LORA_K * 2);
constexpr size_t WS_W1 = al256(WS_LBIAS + (size_t)2 * LORA_N * 4);
constexpr size_t WS_W2 = al256(WS_W1 + (size_t)4 * NE * 2048 * DM * 2);
constexpr size_t WS_H = al256(WS_W2 + (size_t)4 * NE * DM * DM * 2);
constexpr size_t WS_ABF = al256(WS_H + (size_t)NTOK * DM * 4);
constexpr size_t WS_TOKE = al256(WS_ABF + (size_t)NTOK * DM * 2);
constexpr size_t WS_TOKG = al256(WS_TOKE + (size_t)NTOK * 4 * 4);
constexpr size_t WS_ROWOF = al256(WS_TOKG + (size_t)NTOK * 4 * 4);
constexpr size_t WS_TOKR = al256(WS_ROWOF + (size_t)NTOK * 4 * 4);
constexpr size_t WS_BCNT = al256(WS_TOKR + (size_t)NTOK * 4 * 4);
constexpr size_t WS_SRCROW = al256(WS_BCNT + (size_t)4 * 256 * 32 * 4);
constexpr size_t WS_R = al256(WS_SRCROW + (size_t)XPROWS * 4);
constexpr size_t FSZ = (size_t)NTOK * 512 * 4;
constexpr size_t WS_Z = WS_R;
constexpr size_t HSZ = (size_t)NTOK * 512 * 2;
constexpr size_t WS_RB = al256(WS_Z + (size_t)NTOK * ZLD * 2);
constexpr size_t WS_KS = WS_RB + HSZ, WS_VS = WS_KS + HSZ, WS_KKN = WS_VS + HSZ;
constexpr size_t WS_LIN = WS_KKN + HSZ;
constexpr size_t WS_LO = al256(WS_LIN + (size_t)NTOK * 384 * 2);
constexpr size_t WS_AB = WS_LO + 2 * HSZ;
constexpr size_t WS_GB = WS_LO + 4 * HSZ;
constexpr size_t WS_YS = WS_LO + 5 * HSZ;
constexpr size_t WS_QB = WS_YS + 2 * FSZ;
constexpr size_t WS_KB = WS_QB + FSZ / 2;
constexpr size_t WS_VB = WS_KB + FSZ / 2;
constexpr size_t WS_OP = WS_VB + FSZ / 2;
constexpr size_t WS_CAT = WS_OP + 2 * FSZ;
constexpr int WKV_REC = 12288, WKV_NCH = (TC + TL) / 16;
constexpr size_t WS_WKV = al256(WS_CAT + (size_t)NTOK * DM * 2);
constexpr size_t WS_EVEN_END = WS_WKV + (size_t)256 * WKV_NCH * WKV_REC;
constexpr size_t WS_Z2 = WS_R;
constexpr size_t WS_VST = al256(WS_Z2 + (size_t)NTOK * 2048 * 2);
constexpr size_t WS_G = al256(WS_VST + (size_t)NTOK * 2 * 4);
constexpr size_t WS_ODD_END = WS_G + (size_t)NTOK * DM * 2;
constexpr size_t WS_XP = WS_R;
constexpr size_t WS_ACT = al256(WS_XP + (size_t)XPROWS * DM * 2);
constexpr size_t WS_YM = al256(WS_ACT + (size_t)XPROWS * DM * 2);
constexpr size_t WS_MOE_END = WS_YM + (size_t)XPROWS * DM * 2;
constexpr size_t WS_END = (WS_EVEN_END > WS_MOE_END ? (WS_EVEN_END > WS_ODD_END ? WS_EVEN_END : WS_ODD_END) : (WS_MOE_END > WS_ODD_END ? WS_MOE_END : WS_ODD_END));

constexpr int CW_BAR = 4096;
constexpr int CW_CNT = 16384;
constexpr int CW_CUR = 16384 + 256;

constexpr int LDS_BYTES = 163840;
constexpr int LDS_MISC = 160 * 1024 - 256;

__device__ __forceinline__ unsigned f2bf(float f) { unsigned u = __builtin_bit_cast(unsigned, f); return (u + 0x7fffu + ((u >> 16) & 1u)) >> 16; }
typedef float f32x2_t __attribute__((ext_vector_type(2))); typedef __bf16 bf16x2_t __attribute__((ext_vector_type(2)));
__device__ __forceinline__ unsigned pk2(float lo, float hi) { f32x2_t v = {lo, hi}; bf16x2_t b = __builtin_convertvector(v, bf16x2_t); return __builtin_bit_cast(unsigned, b); }
__device__ __forceinline__ unsigned cvtpk_s(float lo, float hi) { f32x2_t v = {lo, hi}; bf16x2_t b = __builtin_convertvector(v, bf16x2_t); return __builtin_bit_cast(unsigned, b); }
__device__ __forceinline__ float bf2f(bf16_t b) { return __builtin_bit_cast(float, (unsigned)b << 16); }
__device__ __forceinline__ float bflo(unsigned p) { return __builtin_bit_cast(float, p << 16); }
__device__ __forceinline__ float bfhi(unsigned p) { return __builtin_bit_cast(float, p & 0xffff0000u); }
__device__ __forceinline__ float wave_sum(float v) {
#pragma unroll
    for (int o = 1; o < 64; o <<= 1) v += __shfl_xor(v, o);
    return v;
}
__device__ __forceinline__ int tid_opaque() { int t = threadIdx.x; asm volatile("" : "+v"(t)); return t; }
#define GAS __attribute__((address_space(1)))
template <class T> __device__ __forceinline__ T* as_global(T* p) { return (T*)(GAS T*)p; }
__device__ __forceinline__ unsigned char* opq(unsigned char* p) { GAS unsigned char* g = (GAS unsigned char*)p; asm volatile("" : "+s"(g)); return (unsigned char*)g; }
__device__ __forceinline__ float rdl(float v, int k) { return __builtin_bit_cast(float, __builtin_amdgcn_readlane(__builtin_bit_cast(int, v), k)); }
__device__ __forceinline__ float sigmoidf_(float x) { return 1.0f / (1.0f + __expf(-x)); }

#define XB_TMO      128
#define XB_XCNT(j)  (256  + 64 * (j))
#define XB_XSUB(j)  (1280 + 64 * (j))
#define XB_XGEN(j)  (2304 + 64 * (j))
#define XB_TOP      3328
#define XB_TOPGEN   3392
#define XCD_BAR_WORDS 3456
#define XB_SPIN_CAP (1u << 22)
__device__ __forceinline__ unsigned xb_ld(unsigned* p)              { return __hip_atomic_load(p, __ATOMIC_RELAXED, __HIP_MEMORY_SCOPE_AGENT); }
__device__ __forceinline__ unsigned xb_add(unsigned* p, unsigned v) { return __hip_atomic_fetch_add(p, v, __ATOMIC_RELAXED, __HIP_MEMORY_SCOPE_AGENT); }
__device__ __forceinline__ unsigned xb_xcc_id() { return (unsigned)__builtin_amdgcn_s_getreg((3 << 11) | 20) & 0xFu; }
#define XB_SPIN(cond, bar) do { unsigned _sp = 0; while (cond) { __builtin_amdgcn_s_sleep(1); \
    if ((++_sp & 255u) == 0u) { if (xb_ld(&(bar)[XB_TMO])) break; if (_sp > XB_SPIN_CAP) { atomicAdd(&(bar)[XB_TMO], 1u); break; } } } } while (0)
struct XcdBarrier { unsigned* bar; unsigned x; volatile LAS unsigned* st; };
__device__ __forceinline__ XcdBarrier xcd_barrier_post(unsigned* bar, volatile LAS unsigned* st) {
    XcdBarrier b; b.bar = bar; b.x = xb_xcc_id(); b.st = st;
    if (threadIdx.x == 0) (void)xb_add(&bar[XB_XCNT(b.x)], 1u);
    return b;
}
__device__ __forceinline__ void xcd_barrier_complete(unsigned* bar, unsigned x, unsigned& nloc, unsigned& nx) {
    const unsigned G = gridDim.x * gridDim.y * gridDim.z;
    unsigned sum, cnt, mine, sp = 0u;
    for (;;) {
        sum = 0u; cnt = 0u; mine = 0u;
#pragma unroll
        for (unsigned j = 0; j < 16; ++j) { const unsigned c = xb_ld(&bar[XB_XCNT(j)]); sum += c; cnt += (c > 0u) ? 1u : 0u; mine = (j == x) ? c : mine; }
        if (sum == G) break;
        __builtin_amdgcn_s_sleep(1);
        if ((++sp & 255u) == 0u) { if (xb_ld(&bar[XB_TMO])) break; if (sp > XB_SPIN_CAP) { atomicAdd(&bar[XB_TMO], 1u); break; } }
    }
    nloc = mine > 0u ? mine : 1u; nx = cnt > 0u ? cnt : 1u;
}
__device__ __forceinline__ void xcd_barrier(const XcdBarrier& b) {
    asm volatile("s_waitcnt vmcnt(0)" ::: "memory");
    __syncthreads();
    if (threadIdx.x == 0) {
        unsigned* bar = b.bar; asm volatile("" : "+s"(bar));
        __builtin_amdgcn_s_waitcnt(0);
        unsigned nloc = b.st[0], nx = b.st[1];
        if (nloc == 0u) { xcd_barrier_complete(bar, b.x, nloc, nx); b.st[0] = nloc; b.st[1] = nx; }
        const unsigned old = xb_add(&bar[XB_XSUB(b.x)], 1u);
        const unsigned gen = old / nloc;
        if (old + 1u == (gen + 1u) * nloc) {
            __builtin_amdgcn_fence(__ATOMIC_RELEASE, "agent");
            asm volatile("s_waitcnt vmcnt(0)" ::: "memory");
            const unsigned og = xb_add(&bar[XB_TOP], 1u);
            const unsigned tg = og / nx;
            if (og + 1u == (tg + 1u) * nx) xb_add(&bar[XB_TOPGEN], 1u);
            else XB_SPIN(xb_ld(&bar[XB_TOPGEN]) == tg, bar);
            __builtin_amdgcn_fence(__ATOMIC_ACQUIRE, "agent");
            xb_add(&bar[XB_XGEN(b.x)], 1u);
            asm volatile("s_waitcnt vmcnt(0)" ::: "memory");
        } else {
            XB_SPIN(xb_ld(&bar[XB_XGEN(b.x)]) == gen, bar);
            __builtin_amdgcn_fence(__ATOMIC_ACQUIRE, "agent");
            asm volatile("s_waitcnt vmcnt(0)" ::: "memory");
        }
    }
    __syncthreads();
}

namespace pg8 {
#define PG8_LAS __attribute__((address_space(3)))
typedef unsigned short bf16_t;
typedef short bf16x8 __attribute__((ext_vector_type(8)));
typedef float f32x4 __attribute__((ext_vector_type(4)));
typedef unsigned u32x4 __attribute__((ext_vector_type(4)));
constexpr int BM = 256, BK = 64, HALF = 128, HTB = HALF * BK * 2  , STAGE_BYTES = 8 * HTB, NXCD = 8, WGM = 8;

__host__ __device__ __forceinline__ int lds_byte(int r, int c) { const int st = (r >> 4) * 2 + (c >> 5), rr = r & 15, cc = c & 31, ob = rr * 64 + cc * 2; return st * 1024 + (ob ^ (((ob >> 9) & 1) << 5)); }
__host__ __device__ __forceinline__ void stage_rc(int b, int& R, int& C) { const int st = b / 1024, sb = b % 1024, swz = sb ^ (((sb >> 9) & 1) << 5); R = (st >> 1) * 16 + swz / 64; C = (st & 1) * 32 + (swz % 64) / 2; }
__host__ __device__ __forceinline__ int perm32(int rho) { const int n = rho >> 4, i = rho & 15; return 8 * (i >> 2) + 4 * n + (i & 3); }

struct Unit { int pm, pn, ui; };
struct Gemm { const bf16_t* A; const bf16_t* Bt; int M, N, K; int sb_w = 0x77777777, sb_a = 0x7f7f7f7f; };

struct StaticOrder {
    int nM, nN, nwg, G, c;
    __host__ __device__ void init(int M, int N, int G_, int c_) { nM = M / BM; nN = N / BM; nwg = nM * nN; G = G_; c = c_; }
    __host__ __device__ bool next(int i, Unit& u) const {
        const long L = (long)i * G + c; if (L >= nwg) return false;
        int wgid = (int)L; { const int q = nwg / NXCD, r = nwg % NXCD, xcd = wgid % NXCD, off = wgid / NXCD; wgid = (xcd < r ? xcd * (q + 1) : r * (q + 1) + (xcd - r) * q) + off; }
        const int nig = WGM * nN, gid = wgid / nig, fm = gid * WGM, gsz = (nM - fm) < WGM ? (nM - fm) : WGM;
        u.pm = fm + ((wgid % nig) % gsz); u.pn = (wgid % nig) / gsz; return true;
    }
    __device__ __forceinline__ void a_ready(const Unit&) const {}
    __device__ __forceinline__ void done(const Unit&) const {}
};

__device__ __forceinline__ unsigned cvt_pk_bf16(float lo, float hi) { unsigned r; asm volatile("v_cvt_pk_bf16_f32 %0, %1, %2" : "=v"(r) : "v"(lo), "v"(hi)); return r; }
typedef float f32x2 __attribute__((ext_vector_type(2)));
__device__ __forceinline__ f32x2 gelu_pk(f32x2 v) {
    const f32x2 av = __builtin_elementwise_abs(v), d = av * 0.2316418882f + 1.0f;
    f32x2 t; t.x = __builtin_amdgcn_rcpf(d.x); t.y = __builtin_amdgcn_rcpf(d.y);
    f32x2 q = t * 0.5307027145f + (-0.7265760135f); q = q * t + 0.7107068705f; q = q * t + (-0.142248368f); q = q * t + 0.127414796f; q = q * t;
    const f32x2 s = (v * v) * (-0.72134752044f);
    f32x2 e; e.x = __builtin_amdgcn_exp2f(s.x); e.y = __builtin_amdgcn_exp2f(s.y);
    const f32x2 m = v * (q * e), r = v - m;
    f32x2 o; o.x = v.x < 0.f ? m.x : r.x; o.y = v.y < 0.f ? m.y : r.y; return o;
}

typedef int v8i32 __attribute__((ext_vector_type(8)));
typedef int v4i32 __attribute__((ext_vector_type(4)));
__device__ __forceinline__ v8i32 cat8(v4i32 a, v4i32 b) { return __builtin_shufflevector(a, b, 0, 1, 2, 3, 4, 5, 6, 7); }
template <class E> constexpr auto pg8_wide(int) -> decltype(E::WIDE) { return E::WIDE; }
template <class E> constexpr bool pg8_wide(long) { return false; }
template <class Epi, class Sched, bool ALIGN_EPI = false, bool SP2 = false, bool GATHER = false, bool FP8 = false, bool ABLK = false, bool KSLICE = false>
__device__ __forceinline__ void gemm_phase(PG8_LAS unsigned char* lds, const Gemm g, const Sched& S, const Epi& E) {
    const int tid = tid_opaque(), wid = __builtin_amdgcn_readfirstlane(tid >> 6), lane = tid & 63, wr = wid >> 2, wc = wid & 3, fr = lane & 15, fq = lane >> 4;
    static_assert(!GATHER || SP2, "GATHER is wired into the SP2 loop only");
    const int K = g.K; int nt_ = KSLICE ? 2 : K / BK; if constexpr (KSLICE) asm volatile("" : "+s"(nt_));
    const int nt = nt_;
#define PG8_KB(pn_) (KSLICE ? (size_t)(((pn_) >= 8 ? 256 : ((pn_) >> 2) * 128) * 2) : (size_t)0)
    unsigned voffA[2], voffB[2];
#pragma unroll
    for (int i = 0; i < 2; ++i) { int R, C; stage_rc(tid * 16 + i * 8192, R, C); const int Pw = perm32(R & 31);
        const int Rb = pg8_wide<Epi>(0) ? ((R >> 5) * 64 + (Pw >> 3) * 16 + (Pw & 7)) : Epi::PERM ? ((R & ~31) + Pw) : R;
        voffA[i] = ABLK ? (unsigned)(((C * 2) >> 5) * 8192 + R * 32 + ((C * 2) & 31)) : (unsigned)(R * K + C) * 2u; voffB[i] = (unsigned)(Rb * K + C) * 2u; }
    unsigned gAc[2][2] = {{0u, 0u}, {0u, 0u}}, gAn[2][2] = {{0u, 0u}, {0u, 0u}};
    int gR[2] = {0, 0}; unsigned gC[2] = {0u, 0u};
    if constexpr (GATHER) {
#pragma unroll
        for (int i = 0; i < 2; ++i) { int R, C; stage_rc(tid * 16 + i * 8192, R, C); gR[i] = R; gC[i] = (unsigned)C * 2u; }
    }
#define PG8_GROWS(dst, ui_) do { _Pragma("unroll") for (int _h = 0; _h < 2; ++_h) _Pragma("unroll") for (int _i = 0; _i < 2; ++_i) dst[_h][_i] = S.rowtab[(ui_) * 256 + _h * 128 + gR[_i]] + gC[_i]; } while (0)
    const size_t kstep = (size_t)(BK * 2);
    const size_t hstep = (size_t)HALF * K * 2;
    const size_t hstepB = pg8_wide<Epi>(0) ? (size_t)8 * K * 2 : hstep;
    const size_t kstepA = ABLK ? (size_t)32768 : kstep, hstepA = ABLK ? (size_t)4096 : hstep;
    const size_t tstep = 2 * hstep;
    const unsigned ldsw = (unsigned)wid * 1024u;
    const int aoff = lds_byte(wr * 64 + fr, fq * 8), boff = lds_byte(wc * 32 + fr, fq * 8);
#define PG8_SA(b, h) (((b) * 2 + (h)) * HTB)
#define PG8_SB(b, h) ((4 + (b) * 2 + (h)) * HTB)
#define PG8_STAGE(bufoff, gbase, voff) do { _Pragma("unroll") for (int _i = 0; _i < 2; ++_i) \
        __builtin_amdgcn_global_load_lds((const unsigned*)((const char*)(gbase) + (voff)[_i]), (PG8_LAS unsigned*)(lds + (bufoff) + ldsw + _i * 8192), 16, 0, 0); } while (0)
#define PG8_STAGE_A(bufoff, kptr, h, vsel) do { if constexpr (GATHER) { PG8_STAGE(bufoff, kptr, vsel[h]); } else { PG8_STAGE(bufoff, (kptr) + (h) * hstepA, voffA); } } while (0)
#define PG8_LDA(dst, b, h) do { if constexpr (FP8) { _Pragma("unroll") for (int m = 0; m < 4; ++m) dst##8[m] = cat8(*(const PG8_LAS v4i32*)(lds + PG8_SA(b, h) + aoff + m * 2048), *(const PG8_LAS v4i32*)(lds + PG8_SA(b, h) + aoff + m * 2048 + 1024)); } \
        else { _Pragma("unroll") for (int m = 0; m < 4; ++m) _Pragma("unroll") for (int k = 0; k < 2; ++k) dst[m][k] = *(const PG8_LAS bf16x8*)(lds + PG8_SA(b, h) + aoff + m * 2048 + k * 1024); } } while (0)
#define PG8_LDB(dst, b, h) do { if constexpr (FP8) { _Pragma("unroll") for (int n = 0; n < 2; ++n) dst##8[n] = cat8(*(const PG8_LAS v4i32*)(lds + PG8_SB(b, h) + boff + n * 2048), *(const PG8_LAS v4i32*)(lds + PG8_SB(b, h) + boff + n * 2048 + 1024)); } \
        else { _Pragma("unroll") for (int n = 0; n < 2; ++n) _Pragma("unroll") for (int k = 0; k < 2; ++k) dst[n][k] = *(const PG8_LAS bf16x8*)(lds + PG8_SB(b, h) + boff + n * 2048 + k * 1024); } } while (0)
#define PG8_MMA(ai, bj, At, Bt) do { __builtin_amdgcn_s_setprio(1); if constexpr (FP8) { _Pragma("unroll") for (int m = 0; m < 4; ++m) _Pragma("unroll") for (int n = 0; n < 2; ++n) \
        asm volatile("s_nop 1\n\tv_mfma_scale_f32_16x16x128_f8f6f4 %0, %1, %2, %0, %3, %4 op_sel_hi:[0,0,0]" : "+v"(acc[ai][bj][m][n]) : "v"(Bt##8[n]), "v"(At##8[m]), "v"(fp8_sa), "v"(fp8_sb)); } else { \
        _Pragma("unroll") for (int m = 0; m < 4; ++m) _Pragma("unroll") for (int n = 0; n < 2; ++n) _Pragma("unroll") for (int k = 0; k < 2; ++k) \
        acc[ai][bj][m][n] = __builtin_amdgcn_mfma_f32_16x16x32_bf16(Bt[n][k], At[m][k], acc[ai][bj][m][n], 0, 0, 0); } __builtin_amdgcn_s_setprio(0); } while (0)
#define PG8_WAIT_V(n) asm volatile("s_waitcnt vmcnt(" #n ")" ::: "memory")
#define PG8_WAIT_L(n) asm volatile("s_waitcnt lgkmcnt(" #n ")" ::: "memory")
#define PG8_BAR __builtin_amdgcn_s_barrier()
#define PG8_SCHED __builtin_amdgcn_sched_barrier(0)
    Unit cur, nxt; int ui = 0;
    if (!S.next(0, cur)) return;
    f32x4 acc[2][2][4][2];
#pragma unroll
    for (int a = 0; a < 2; ++a)
#pragma unroll
        for (int b = 0; b < 2; ++b)
#pragma unroll
            for (int m = 0; m < 4; ++m)
#pragma unroll
                for (int n = 0; n < 2; ++n) acc[a][b][m][n] = (f32x4){0.f, 0.f, 0.f, 0.f};
    const int fp8_sa = g.sb_w, fp8_sb = g.sb_a;
    bf16x8 At[4][2], B0[2][2], B1[2][2]; v8i32 At8[4], B08[2], B18[2];
    const char* cA = GATHER ? (const char*)g.A : (const char*)g.A + (size_t)cur.pm * tstep + PG8_KB(cur.pn); const char* cB = (const char*)g.Bt + (size_t)cur.pn * tstep + PG8_KB(cur.pn);
    if constexpr (GATHER) { PG8_GROWS(gAc, 0); }
    S.a_ready(cur);
    if constexpr (SP2) {
        PG8_STAGE(PG8_SB(0, 0), cB, voffB); PG8_STAGE(PG8_SB(0, 1), cB + hstepB, voffB); PG8_STAGE_A(PG8_SA(0, 0), cA, 0, gAc); PG8_STAGE_A(PG8_SA(0, 1), cA, 1, gAc);
        if (wr == 1) PG8_BAR;
        PG8_WAIT_V(2); PG8_BAR;
        PG8_STAGE(PG8_SB(1, 0), cB + kstep, voffB); PG8_STAGE_A(PG8_SA(1, 0), cA + kstepA, 0, gAc); PG8_STAGE(PG8_SB(1, 1), cB + hstepB + kstep, voffB);
        PG8_WAIT_V(6); PG8_BAR;
    } else {
        PG8_STAGE(PG8_SB(0, 0), cB, voffB); PG8_STAGE(PG8_SA(0, 0), cA, voffA); PG8_STAGE(PG8_SB(0, 1), cB + hstepB, voffB); PG8_STAGE(PG8_SA(0, 1), cA + hstep, voffA);
        if (wr == 1) PG8_BAR;
        PG8_WAIT_V(4); PG8_BAR;
        PG8_STAGE(PG8_SB(1, 0), cB + kstep, voffB); PG8_STAGE(PG8_SA(1, 0), cA + kstep, voffA); PG8_STAGE(PG8_SB(1, 1), cB + hstepB + kstep, voffB);
        PG8_WAIT_V(6); PG8_BAR;
    }
    for (;;) {
        const bool has_next = S.next(ui + 1, nxt);
        if constexpr (GATHER) { if (has_next) { PG8_GROWS(gAn, ui + 1); } else { _Pragma("unroll") for (int _h = 0; _h < 2; ++_h) _Pragma("unroll") for (int _i = 0; _i < 2; ++_i) gAn[_h][_i] = gAc[_h][_i]; } }
        const char* nA = GATHER ? (const char*)g.A : (has_next ? (const char*)g.A + (size_t)nxt.pm * tstep + PG8_KB(nxt.pn) : cA); const char* nB = has_next ? (const char*)g.Bt + (size_t)nxt.pn * tstep + PG8_KB(nxt.pn) : cB;
        for (int t = 0; t < nt; t += 2) {
            const bool last = (t == nt - 2);
            const char* a1 = cA + (size_t)(t + 1) * kstepA;
            const char* a2 = last ? nA : cA + (size_t)(t + 2) * kstepA; const char* b2 = last ? nB : cB + (size_t)(t + 2) * kstep;
            const char* a3 = a2 + kstepA; const char* b3 = b2 + kstep;
            if (last && has_next) S.a_ready(nxt);
            unsigned gA2[2][2];
            if constexpr (GATHER) { _Pragma("unroll") for (int _h = 0; _h < 2; ++_h) _Pragma("unroll") for (int _i = 0; _i < 2; ++_i) gA2[_h][_i] = last ? gAn[_h][_i] : gAc[_h][_i]; }
            if constexpr (SP2) {
            PG8_LDB(B0, 0, 0); PG8_LDB(B1, 0, 1); PG8_SCHED; PG8_LDA(At, 0, 0); PG8_STAGE_A(PG8_SA(1, 1), a1, 1, gAc);
            PG8_WAIT_V(8); PG8_WAIT_L(0); PG8_BAR; PG8_MMA(0, 0, At, B0); PG8_MMA(0, 1, At, B1); PG8_BAR; PG8_SCHED;
            PG8_LDA(At, 0, 1); PG8_STAGE(PG8_SB(0, 0), b2, voffB); PG8_STAGE(PG8_SB(0, 1), b2 + hstepB, voffB); PG8_STAGE_A(PG8_SA(0, 0), a2, 0, gA2);
            PG8_WAIT_V(8); PG8_WAIT_L(0); PG8_BAR; PG8_MMA(1, 0, At, B0); PG8_MMA(1, 1, At, B1); PG8_BAR; PG8_SCHED;
            PG8_LDB(B0, 1, 0); PG8_LDB(B1, 1, 1); PG8_SCHED; PG8_LDA(At, 1, 0); PG8_STAGE_A(PG8_SA(0, 1), a2, 1, gA2);
            PG8_WAIT_V(8); PG8_WAIT_L(0); PG8_BAR; PG8_MMA(0, 0, At, B0); PG8_MMA(0, 1, At, B1); PG8_BAR; PG8_SCHED;
            PG8_LDA(At, 1, 1); PG8_STAGE(PG8_SB(1, 0), b3, voffB); PG8_STAGE(PG8_SB(1, 1), b3 + hstepB, voffB); PG8_STAGE_A(PG8_SA(1, 0), a3, 0, gA2);
            PG8_WAIT_V(8); PG8_WAIT_L(0); PG8_BAR; PG8_MMA(1, 0, At, B0); PG8_MMA(1, 1, At, B1); PG8_BAR; PG8_SCHED;
            } else {
            PG8_LDB(B0, 0, 0); PG8_SCHED; PG8_LDA(At, 0, 0); PG8_STAGE(PG8_SA(1, 1), a1 + hstep, voffA);
            PG8_WAIT_L(8); PG8_BAR; PG8_WAIT_L(0); PG8_MMA(0, 0, At, B0); PG8_BAR; PG8_SCHED;
            PG8_LDB(B1, 0, 1); PG8_STAGE(PG8_SB(0, 0), b2, voffB);
            PG8_BAR; PG8_WAIT_L(0); PG8_MMA(0, 1, At, B1); PG8_BAR;
            PG8_LDA(At, 0, 1); PG8_STAGE(PG8_SA(0, 0), a2, voffA);
            PG8_BAR; PG8_WAIT_L(0); PG8_MMA(1, 0, At, B0); PG8_BAR; PG8_SCHED;
            PG8_STAGE(PG8_SB(0, 1), b2 + hstepB, voffB);
            PG8_WAIT_V(6); PG8_BAR; PG8_MMA(1, 1, At, B1); PG8_BAR;
            PG8_LDB(B0, 1, 0); PG8_SCHED; PG8_LDA(At, 1, 0); PG8_STAGE(PG8_SA(0, 1), a2 + hstep, voffA);
            PG8_WAIT_L(8); PG8_BAR; PG8_WAIT_L(0); PG8_MMA(0, 0, At, B0); PG8_BAR; PG8_SCHED;
            PG8_LDB(B1, 1, 1); PG8_STAGE(PG8_SB(1, 0), b3, voffB);
            PG8_BAR; PG8_WAIT_L(0); PG8_MMA(0, 1, At, B1); PG8_BAR;
            PG8_LDA(At, 1, 1); PG8_STAGE(PG8_SA(1, 0), a3, voffA);
            PG8_BAR; PG8_WAIT_L(0); PG8_MMA(1, 0, At, B0); PG8_BAR; PG8_SCHED;
            PG8_STAGE(PG8_SB(1, 1), b3 + hstepB, voffB);
            PG8_WAIT_V(6); PG8_BAR; PG8_MMA(1, 1, At, B1); PG8_BAR;
            }
        }
        if constexpr (ALIGN_EPI) { if (wr == 0) PG8_BAR; }
        if constexpr (FP8) { asm volatile("s_nop 15\n\ts_nop 15" ::: "memory"); __builtin_amdgcn_sched_barrier(0); }
        if constexpr (!Epi::AFTER_DRAIN) { E(acc, cur, wr, wc, fr, fq); S.done(cur); }
        if (!has_next) break;
#pragma unroll
        for (int a = 0; a < 2; ++a)
#pragma unroll
            for (int b = 0; b < 2; ++b)
#pragma unroll
                for (int m = 0; m < 4; ++m)
#pragma unroll
                    for (int n = 0; n < 2; ++n) acc[a][b][m][n] = (f32x4){0.f, 0.f, 0.f, 0.f};
        cur = nxt; cA = nA; cB = nB; ++ui;
        if constexpr (GATHER) { _Pragma("unroll") for (int _h = 0; _h < 2; ++_h) _Pragma("unroll") for (int _i = 0; _i < 2; ++_i) gAc[_h][_i] = gAn[_h][_i]; }
        if constexpr (ALIGN_EPI) { if (wr == 1) PG8_BAR; }
    }
    PG8_WAIT_V(0);
    if constexpr (!ALIGN_EPI) { if (wr == 0) PG8_BAR; }
    PG8_BAR;
    if constexpr (Epi::AFTER_DRAIN) { E.fused(acc, cur, wr, wc, fr, fq, lds, wid, lane); S.done(cur); }
#undef PG8_KB
#undef PG8_SA
#undef PG8_SB
#undef PG8_STAGE
#undef PG8_STAGE_A
#undef PG8_GROWS
#undef PG8_LDA
#undef PG8_LDB
#undef PG8_MMA
#undef PG8_WAIT_V
#undef PG8_WAIT_L
#undef PG8_BAR
#undef PG8_SCHED
}
}

struct Args { const float* in[38]; float* out; unsigned char* ws; int ph_lo, ph_hi; };
#define INP(k) as_global(IN[k])
#define AIN(k) as_global(A.in[k])
enum { I_X = 0, I_C, I_CTX, I_CCTX, I_N1G, I_N2G, I_ADAW, I_ADAB, I_EVWIN, I_EVWOUT, I_RWMU, I_RWW0, I_RWW2, I_RWA0, I_RWA2, I_RWG2, I_RWKK, I_RWKA, I_RWRK,
       I_GNW, I_GNB, I_QN, I_KN, I_LAM, I_SUBLN, I_SGWIN, I_SGBIN, I_SGLNG, I_SGLNB, I_SGWS, I_SGBS, I_SGWOUT, I_RTW, I_RTB, I_W1, I_B1, I_W2, I_B2 };

struct Tok { int b, t, T, modrow; };
__device__ __forceinline__ Tok tokinfo(int g) {
    Tok k;
    if (g < NCTX) { k.b = g >> 8; k.t = g & 255; k.T = TC; k.modrow = 16; }
    else { const int q = g - NCTX; k.b = q >> 11; k.t = q & 2047; k.T = TL; k.modrow = k.b; }
    return k;
}

template <int MAP>
__device__ __forceinline__ void p0_transpose_item(const float* W, int K, int N, bf16_t* WT, LAS float* scr, int item, int lane) {
    const int nblk = N / 32, kb = item / nblk, nb = item % nblk, k0 = 64 * kb, n0 = 32 * nb;
    const int d0 = MAP ? (256 * ((n0 & 1023) >> 7) + 128 * (n0 >> 10) + (n0 & 127)) : n0;
#pragma unroll 8
    for (int i = 0; i < 32; ++i) { const int kk = 2 * i + (lane >> 5); scr[kk * 33 + (lane & 31)] = W[(size_t)(k0 + kk) * N + n0 + (lane & 31)]; }
    asm volatile("s_waitcnt lgkmcnt(0)" ::: "memory");
    const int c = lane & 7;
#pragma unroll
    for (int j = 0; j < 4; ++j) { const int n = (lane >> 3) + 8 * j; const LAS float* s = scr + (8 * c) * 33 + n;
        u32x4 o; o.x = pk2(s[0 * 33], s[1 * 33]); o.y = pk2(s[2 * 33], s[3 * 33]); o.z = pk2(s[4 * 33], s[5 * 33]); o.w = pk2(s[6 * 33], s[7 * 33]);
        *(u32x4*)(WT + (size_t)(d0 + n) * K + k0 + 8 * c) = o; }
    asm volatile("s_waitcnt lgkmcnt(0)" ::: "memory");
}

template <int MAP>
__device__ __forceinline__ void p0_transpose_item_fp8w(const float* W, int K, int N, unsigned char* WT, LAS float* scr, int item, int lane) {
    const int nblk = N / 32, kb = item / nblk, nb = item % nblk, k0 = 128 * kb, n0 = 32 * nb;
    const int d0 = MAP ? (256 * ((n0 & 1023) >> 7) + 128 * (n0 >> 10) + (n0 & 127)) : n0;
    {
        f32x4 ld[16];
#pragma unroll
        for (int i = 0; i < 16; ++i) ld[i] = __builtin_nontemporal_load((const f32x4*)(W + (size_t)(k0 + 8 * i + (lane >> 3)) * N + n0 + 4 * (lane & 7)));
#pragma unroll
        for (int i = 0; i < 16; ++i) { LAS float* d = scr + (8 * i + (lane >> 3)) * 33 + 4 * (lane & 7); d[0] = ld[i].x; d[1] = ld[i].y; d[2] = ld[i].z; d[3] = ld[i].w; }
    }
    asm volatile("s_waitcnt lgkmcnt(0)" ::: "memory");
    const int c = lane & 7;
#pragma unroll
    for (int j = 0; j < 4; ++j) { const int n = (lane >> 3) + 8 * j; const LAS float* sp = scr + (16 * c) * 33 + n;
        u32x4 o;
#pragma unroll
        for (int d = 0; d < 4; ++d) { int w = __builtin_amdgcn_cvt_pk_fp8_f32(sp[(4 * d) * 33] * 256.0f, sp[(4 * d + 1) * 33] * 256.0f, 0, false);
            w = __builtin_amdgcn_cvt_pk_fp8_f32(sp[(4 * d + 2) * 33] * 256.0f, sp[(4 * d + 3) * 33] * 256.0f, w, true); o[d] = (unsigned)w; }
        *(u32x4*)(WT + (size_t)(d0 + n) * K + k0 + 16 * c) = o; }
    asm volatile("s_waitcnt lgkmcnt(0)" ::: "memory");
}

__device__ __forceinline__ void ph_prologue(const Args& A, LAS unsigned char* lds, int bid, int nb) {
    const int tid = tid_opaque(), lane = tid & 63, wid = tid >> 6;
    unsigned char* ws = opq(A.ws);
    if (bid == 0 && tid < 39) ((const float**)(ws + WS_PTRS))[tid] = (tid < 38) ? A.in[tid] : (const float*)A.out;
    {
        LAS float* s = (LAS float*)lds;
        LAS float* red = (LAS float*)(lds + 17 * 1024 * 4);
        for (int i = tid; i < 17 * 1024; i += NTHREADS) {
            const int r = i >> 10, k = i & 1023;
            const float x = (r < 16) ? AIN(I_C)[r * 1024 + k] : AIN(I_CCTX)[k];
            s[i] = x / (1.0f + __expf(-x));
        }
        __syncthreads();
        float* mod = (float*)(ws + WS_MOD);
        for (int u = bid; u < 4 * 96; u += nb) {
            const int l = u / 96, cg = u % 96, col = cg * 64 + lane;
            float acc[17];
#pragma unroll
            for (int r = 0; r < 17; ++r) acc[r] = 0.f;
            const float* wp = AIN(I_ADAW) + (size_t)l * 1024 * 6144 + col;
            for (int k = wid * 128; k < wid * 128 + 128; ++k) {
                const float wv = __builtin_nontemporal_load(wp + (size_t)k * 6144);
#pragma unroll
                for (int r = 0; r < 17; ++r) acc[r] += s[r * 1024 + k] * wv;
            }
#pragma unroll
            for (int r = 0; r < 17; ++r) red[(wid * 17 + r) * 64 + lane] = acc[r];
            __syncthreads();
            for (int i = tid; i < 17 * 64; i += NTHREADS) {
                const int r = i >> 6, ln = i & 63; float v = 0.f;
#pragma unroll
                for (int w = 0; w < 8; ++w) v += red[(w * 17 + r) * 64 + ln];
                const int cc = cg * 64 + ln;
                mod[((size_t)l * 17 + r) * 6144 + cc] = v + AIN(I_ADAB)[l * 6144 + cc];
            }
            __syncthreads();
        }
    }
    __syncthreads();
    {
        LAS float* scr = (LAS float*)(lds + wid * 17408);
        const int gw = bid * NWAVES + wid, NGW = nb * NWAVES;
        constexpr int IT_WIN = 16 * (EVC / 32), IT_SQ = 16 * 32, IT_SGIN = 16 * 64, IT_W1 = 8 * 64, IT_W2 = 8 * 32;
        constexpr int N0 = 2 * IT_WIN, N1 = N0 + 2 * IT_SQ, N2 = N1 + 2 * IT_SGIN, N3 = N2 + 2 * IT_SQ, N4 = N3 + 128 * IT_W1, N5 = N4 + 128 * IT_W2;
        for (int it = gw; it < N5; it += NGW) {
            if (it < N0) { const int m = it / IT_WIN, r = it % IT_WIN; p0_transpose_item<0>(AIN(I_EVWIN) + (size_t)m * DM * EVC, DM, EVC, (bf16_t*)(ws + WS_WIN) + (size_t)m * ZLD * DM, scr, r, lane); }
            else if (it < N1) { const int q = it - N0, m = q / IT_SQ, r = q % IT_SQ; p0_transpose_item<0>(AIN(I_EVWOUT) + (size_t)m * DM * DM, DM, DM, (bf16_t*)(ws + WS_WOUT) + (size_t)m * DM * DM, scr, r, lane); }
            else if (it < N2) { const int q = it - N1, m = q / IT_SGIN, r = q % IT_SGIN; p0_transpose_item<0>(AIN(I_SGWIN) + (size_t)m * DM * 2048, DM, 2048, (bf16_t*)(ws + WS_SGIN) + (size_t)m * 2048 * DM, scr, r, lane); }
            else if (it < N3) { const int q = it - N2, m = q / IT_SQ, r = q % IT_SQ; p0_transpose_item<0>(AIN(I_SGWOUT) + (size_t)m * DM * DM, DM, DM, (bf16_t*)(ws + WS_SGOUT) + (size_t)m * DM * DM, scr, r, lane); }
            else if (it < N4) { const int q = it - N3, m = q / IT_W1, r = q % IT_W1; p0_transpose_item_fp8w<1>(AIN(I_W1) + (size_t)m * DM * 2048, DM, 2048, ws + WS_W1 + (size_t)m * 2048 * DM, scr, r, lane); }
            else { const int q = it - N4, m = q / IT_W2, r = q % IT_W2; p0_transpose_item_fp8w<0>(AIN(I_W2) + (size_t)m * DM * DM, DM, DM, ws + WS_W2 + (size_t)m * DM * DM, scr, r, lane); }
        }
    }
    {
        const size_t gt = (size_t)bid * NTHREADS + tid, GT = (size_t)nb * NTHREADS;
        u32x4* H8 = (u32x4*)(ws + WS_H);
        const f32x4* c4 = (const f32x4*)AIN(I_CTX); const f32x4* x4 = (const f32x4*)AIN(I_X);
        constexpr size_t NC8 = (size_t)NCTX * DM / 8, NT8 = (size_t)NTOK * DM / 8;
        for (size_t i = gt; i < NT8; i += GT) { const f32x4* s = (i < NC8) ? c4 + 2 * i : x4 + 2 * (i - NC8); const f32x4 a = __builtin_nontemporal_load(s), b = __builtin_nontemporal_load(s + 1);
            H8[i] = (u32x4){pk2(a.x, a.y), pk2(a.z, a.w), pk2(b.x, b.y), pk2(b.z, b.w)}; }
        for (size_t i = gt; i < (size_t)2 * 128 * DM / 8; i += GT) { const size_t m = i / (128 * DM / 8), r = i % (128 * DM / 8); ((u32x4*)((bf16_t*)(ws + WS_WIN) + (m * ZLD + EVC) * DM))[r] = (u32x4){0u, 0u, 0u, 0u}; }
        bf16_t* wl = (bf16_t*)(ws + WS_WLORA);
        for (size_t i = gt; i < (size_t)2 * LORA_N * (LORA_K / 8); i += GT) {
            const int n = (int)(i % LORA_N), kc = (int)((i / LORA_N) % (LORA_K / 8)), jj = (int)(i / ((size_t)LORA_N * (LORA_K / 8))), seg = n >> 9, c = n & 511, k0 = kc * 8;
            float v[8];
#pragma unroll
            for (int e = 0; e < 8; ++e) v[e] = 0.f;
            if (seg < 2) { if ((k0 >> 6) == seg) {
#pragma unroll
                for (int e = 0; e < 8; ++e) v[e] = AIN(I_RWW2)[(((size_t)jj * 2 + seg) * 64 + (k0 & 63) + e) * 512 + c]; } }
            else if (seg < 4) { if ((k0 >> 6) == seg) {
#pragma unroll
                for (int e = 0; e < 8; ++e) v[e] = AIN(I_RWA2)[(((size_t)jj * 2 + (seg - 2)) * 64 + (k0 & 63) + e) * 512 + c]; } }
            else if (k0 >= 256) {
#pragma unroll
                for (int e = 0; e < 8; ++e) v[e] = AIN(I_RWG2)[((size_t)jj * 128 + (k0 - 256) + e) * 512 + c]; }
            *(u32x4*)(wl + ((size_t)jj * LORA_N + n) * LORA_K + k0) = (u32x4){pk2(v[0], v[1]), pk2(v[2], v[3]), pk2(v[4], v[5]), pk2(v[6], v[7])};
        }
        for (size_t i = gt; i < (size_t)2 * LORA_N; i += GT) { const int jj = (int)(i / LORA_N), n = (int)(i % LORA_N), seg = n >> 9, c = n & 511;
            ((float*)(ws + WS_LBIAS))[i] = seg < 2 ? AIN(I_RWW0)[((size_t)jj * 2 + seg) * 512 + c] : (seg < 4 ? AIN(I_RWA0)[((size_t)jj * 2 + (seg - 2)) * 512 + c] : 0.f); }
        float* rt = (float*)(ws + WS_RTWT);
        for (size_t i = gt; i < (size_t)4 * 128 * 32; i += GT) {
            const int e = (int)i & 31, k0 = ((int)(i >> 5) & 127) * 8, l = (int)(i >> 12);
            unsigned hi[4], lo[4]; float w[8];
#pragma unroll
            for (int q = 0; q < 8; ++q) w[q] = AIN(I_RTW)[((size_t)l * 1024 + k0 + q) * 32 + e];
#pragma unroll
            for (int q = 0; q < 4; ++q) { hi[q] = pk2(w[2 * q], w[2 * q + 1]); lo[q] = pk2(w[2 * q] - __builtin_bit_cast(float, hi[q] << 16), w[2 * q + 1] - __builtin_bit_cast(float, hi[q] & 0xffff0000u)); }
            *(u32x4*)((bf16_t*)rt + ((size_t)l * 2 * 32 + e) * 1024 + k0) = (u32x4){hi[0], hi[1], hi[2], hi[3]};
            *(u32x4*)((bf16_t*)rt + ((size_t)(l * 2 + 1) * 32 + e) * 1024 + k0) = (u32x4){lo[0], lo[1], lo[2], lo[3]};
        }
    }
}

template <bool ROUTER>
__device__ __forceinline__ void ph_norm(const Args& A, int l, int row_lo, LAS unsigned char* lds, int bid, int nb) {
    unsigned char* ws = opq(A.ws); const float* const* IN = (const float* const*)(ws + WS_PTRS); (void)IN;
    const int tid = tid_opaque(), lane = tid & 63, wid = tid >> 6;
    const bf16_t* H = (const bf16_t*)(ws + WS_H);
    const float* mod = (const float*)(ws + WS_MOD);
    bf16_t* abf = (bf16_t*)(ws + WS_ABF);
    const float* gp = INP(ROUTER ? I_N2G : I_N1G) + l * 1024;
    const int c_shift = ROUTER ? 3 : 0, c_scale = ROUTER ? 4 : 1;
    LAS float* rtl = (LAS float*)lds;
    LAS int* hist = (LAS int*)(lds + 131072);
    float rtb = 0.f;
    if constexpr (ROUTER) {
        const f32x4* rt4 = (const f32x4*)((const float*)(ws + WS_RTWT) + (size_t)l * 32 * 1024);
        for (int i = tid; i < 32 * 1024 / 4; i += NTHREADS) ((LAS f32x4*)rtl)[i] = rt4[i];
        if (tid < 32) hist[tid] = 0;
        rtb = INP(I_RTB)[l * 32 + (lane >> 1)];
        __syncthreads();
    }
    for (int row = row_lo + bid * NWAVES + wid; row < NTOK; row += nb * NWAVES) {
        const Tok tk = tokinfo(row);
        const float* mrow = mod + ((size_t)l * 17 + tk.modrow) * 6144;
        f32x4 v[4]; float ss = 0.f;
#pragma unroll
        for (int j = 0; j < 4; ++j) { const u32x2 hq = *(const u32x2*)(H + (size_t)row * DM + j * 256 + lane * 4); v[j] = (f32x4){bflo(hq.x), bfhi(hq.x), bflo(hq.y), bfhi(hq.y)}; ss += (v[j].x * v[j].x + v[j].y * v[j].y) + (v[j].z * v[j].z + v[j].w * v[j].w); }
        const float rstd = rsqrtf(wave_sum(ss) * (1.0f / DM) + 1e-6f);
#pragma unroll
        for (int j = 0; j < 4; ++j) {
            const int col = j * 256 + lane * 4;
            const f32x4 g = *(const f32x4*)(gp + col), sc = *(const f32x4*)(mrow + c_scale * 1024 + col), sh = *(const f32x4*)(mrow + c_shift * 1024 + col);
            v[j] = (v[j] * rstd * g) * (sc + 1.0f) + sh;
            u32x2 o; o.x = pk2(v[j].x, v[j].y); o.y = pk2(v[j].z, v[j].w);
            *(u32x2*)(abf + (size_t)row * DM + col) = o;
        }
        if constexpr (ROUTER) {
            float p[32];
#pragma unroll
            for (int e = 0; e < 32; ++e) {
                float acc = 0.f;
#pragma unroll
                for (int j = 0; j < 4; ++j) { const f32x4 w = *(const LAS f32x4*)(rtl + e * 1024 + j * 256 + lane * 4); acc += (v[j].x * w.x + v[j].y * w.y) + (v[j].z * w.z + v[j].w * w.w); }
                p[e] = acc;
            }
#define RS_STEP(N, OFF) _Pragma("unroll") for (int i = 0; i < (N); ++i) { const bool up = (lane & (OFF)) != 0; const float send = up ? p[i] : p[i + (N)], keep = up ? p[i + (N)] : p[i]; p[i] = keep + __shfl_xor(send, (OFF)); }
            RS_STEP(16, 32) RS_STEP(8, 16) RS_STEP(4, 8) RS_STEP(2, 4) RS_STEP(1, 2)
#undef RS_STEP
            const float mylg = p[0] + __shfl_xor(p[0], 1) + rtb;
            float tv[4] = {-3.0e38f, -3.0e38f, -3.0e38f, -3.0e38f}; int ti[4] = {0, 0, 0, 0};
#pragma unroll
            for (int e = 0; e < 32; ++e) {
                const float lgv = rdl(mylg, 2 * e);
                if (lgv > tv[3]) {
                    tv[3] = lgv; ti[3] = e;
                    if (tv[3] > tv[2]) { const float a = tv[2]; tv[2] = tv[3]; tv[3] = a; const int b = ti[2]; ti[2] = ti[3]; ti[3] = b; }
                    if (tv[2] > tv[1]) { const float a = tv[1]; tv[1] = tv[2]; tv[2] = a; const int b = ti[1]; ti[1] = ti[2]; ti[2] = b; }
                    if (tv[1] > tv[0]) { const float a = tv[0]; tv[0] = tv[1]; tv[1] = a; const int b = ti[0]; ti[0] = ti[1]; ti[1] = b; }
                }
            }
            const float e1 = __expf(tv[1] - tv[0]), e2 = __expf(tv[2] - tv[0]), e3 = __expf(tv[3] - tv[0]);
            const float inv = 1.0f / (1.0f + e1 + e2 + e3);
            if (lane == 0) {
                int* te = (int*)(ws + WS_TOKE) + (size_t)row * 4; float* tg = (float*)(ws + WS_TOKG) + (size_t)row * 4; int* tr = (int*)(ws + WS_TOKR) + (size_t)row * 4;
                te[0] = ti[0]; te[1] = ti[1]; te[2] = ti[2]; te[3] = ti[3];
                tg[0] = inv; tg[1] = e1 * inv; tg[2] = e2 * inv; tg[3] = e3 * inv;
#pragma unroll
                for (int k = 0; k < 4; ++k) tr[k] = __hip_atomic_fetch_add(hist + ti[k], 1, __ATOMIC_RELAXED, __HIP_MEMORY_SCOPE_WORKGROUP);
            }
        }
    }
    if constexpr (ROUTER) {
        __syncthreads();
        if (tid < 32) ((int*)(ws + WS_BCNT))[((size_t)l * 256 + bid) * 32 + tid] = hist[tid];
    }
}


constexpr int RT_LS = 2064;
__device__ __forceinline__ void ph_norm2_router(const Args& A, int l, int row_lo, LAS unsigned char* lds, int bid, int nb) {
    unsigned char* ws = opq(A.ws); const float* const* IN = (const float* const*)(ws + WS_PTRS);
    const int tid = tid_opaque(), lane = tid & 63, wid = tid >> 6, c16 = lane & 15, g4 = lane >> 4;
    const bf16_t* H = (const bf16_t*)(ws + WS_H); const float* mod = (const float*)(ws + WS_MOD); bf16_t* abf = (bf16_t*)(ws + WS_ABF);
    const float* gp = INP(I_N2G) + l * 1024;
    LAS unsigned char* rth = lds; LAS unsigned char* rtl = lds + 32 * RT_LS;
    LAS int* hist = (LAS int*)(lds + 64 * RT_LS);
    LAS float* lgs = (LAS float*)(lds + 64 * RT_LS + 256) + wid * 544;
    {
        const u32x4* src = (const u32x4*)((const bf16_t*)(ws + WS_RTWT) + (size_t)l * 2 * 32 * 1024);
        for (int i = tid; i < 64 * 128; i += NTHREADS) { const int row = i >> 7, ch = i & 127; *(LAS u32x4*)(lds + row * RT_LS + ch * 16) = src[i]; }
        if (tid < 32) hist[tid] = 0;
    }
    LAS float* modl = (LAS float*)(lds + 64 * RT_LS + 256 + NWAVES * 544 * 4);
    {
        const int r0 = row_lo + 128 * bid;
        const Tok tk0 = tokinfo(r0 < NTOK ? r0 : NTOK - 1);
        const float* mr0 = mod + ((size_t)l * 17 + tk0.modrow) * 6144;
        for (int i = tid; i < 1024; i += NTHREADS) { modl[i] = gp[i] * (1.0f + mr0[4 * 1024 + i]); modl[1024 + i] = mr0[3 * 1024 + i]; }
        __syncthreads();
    }
    const float rtb0 = INP(I_RTB)[l * 32 + c16], rtb1 = INP(I_RTB)[l * 32 + 16 + c16];
    const int ngroups = (NTOK - row_lo) / 16;
    LAS float* lgs0 = (LAS float*)(lds + 64 * RT_LS + 256);
    auto group = [&](const int u, const int k0, const int k1, const bool coop) {
        const int row = row_lo + 16 * u + c16;
        const Tok tk = tokinfo(row_lo + 16 * u);
        const float* mrow = mod + ((size_t)l * 17 + tk.modrow) * 6144;
        const bf16_t* hrow = H + (size_t)row * DM + 8 * g4;
        float ss = 0.f;
#pragma unroll 8
        for (int ks = 0; ks < 32; ++ks) { const u32x4 hq = *(const u32x4*)(hrow + 32 * ks); const f32x4 a = {bflo(hq.x), bfhi(hq.x), bflo(hq.y), bfhi(hq.y)}, b = {bflo(hq.z), bfhi(hq.z), bflo(hq.w), bfhi(hq.w)};
            ss += (a.x * a.x + a.y * a.y) + (a.z * a.z + a.w * a.w) + (b.x * b.x + b.y * b.y) + (b.z * b.z + b.w * b.w); }
        ss += __shfl_xor(ss, 16); ss += __shfl_xor(ss, 32);
        const float rstd = rsqrtf(ss * (1.0f / DM) + 1e-6f);
        f32x4 acc0 = {0.f, 0.f, 0.f, 0.f}, acc1 = acc0;
#pragma unroll 2
        for (int ks = k0; ks < k1; ++ks) {
            const int col = 32 * ks + 8 * g4;
            float f[8];
            { const u32x4 hq = *(const u32x4*)(hrow + 32 * ks); const f32x4 xa = {bflo(hq.x), bfhi(hq.x), bflo(hq.y), bfhi(hq.y)}, xb = {bflo(hq.z), bfhi(hq.z), bflo(hq.w), bfhi(hq.w)};
              f32x4 fa, fb;
              if (!coop) { const f32x4 Aa = *(const LAS f32x4*)(modl + col), Ab = *(const LAS f32x4*)(modl + col + 4), Ba = *(const LAS f32x4*)(modl + 1024 + col), Bb = *(const LAS f32x4*)(modl + 1024 + col + 4);
                  fa = (xa * rstd) * Aa + Ba; fb = (xb * rstd) * Ab + Bb; }
              else { const f32x4 ga = *(const f32x4*)(gp + col), gb = *(const f32x4*)(gp + col + 4), sa = *(const f32x4*)(mrow + 4 * 1024 + col), sb = *(const f32x4*)(mrow + 4 * 1024 + col + 4);
                  const f32x4 ha = *(const f32x4*)(mrow + 3 * 1024 + col), hb = *(const f32x4*)(mrow + 3 * 1024 + col + 4);
                  fa = (xa * rstd * ga) * (sa + 1.0f) + ha; fb = (xb * rstd * gb) * (sb + 1.0f) + hb; }
              f[0] = fa.x; f[1] = fa.y; f[2] = fa.z; f[3] = fa.w; f[4] = fb.x; f[5] = fb.y; f[6] = fb.z; f[7] = fb.w; }
            unsigned hi[4], lo[4];
#pragma unroll
            for (int e = 0; e < 4; ++e) { hi[e] = pk2(f[2 * e], f[2 * e + 1]);
                lo[e] = pk2(f[2 * e] - __builtin_bit_cast(float, hi[e] << 16), f[2 * e + 1] - __builtin_bit_cast(float, hi[e] & 0xffff0000u)); }
            const u32x4 hv = {hi[0], hi[1], hi[2], hi[3]}, lv = {lo[0], lo[1], lo[2], lo[3]};
            { int w0 = __builtin_amdgcn_cvt_pk_fp8_f32(f[0], f[1], 0, false); w0 = __builtin_amdgcn_cvt_pk_fp8_f32(f[2], f[3], w0, true);
              int w1 = __builtin_amdgcn_cvt_pk_fp8_f32(f[4], f[5], 0, false); w1 = __builtin_amdgcn_cvt_pk_fp8_f32(f[6], f[7], w1, true);
              *(u32x2*)((unsigned char*)abf + (size_t)row * DM + col) = (u32x2){(unsigned)w0, (unsigned)w1}; }
            const bf16x8 fh = __builtin_bit_cast(bf16x8, hv), fl = __builtin_bit_cast(bf16x8, lv);
            const int wo = c16 * RT_LS + col * 2;
            const bf16x8 wh0 = *(const LAS bf16x8*)(rth + wo), wh1 = *(const LAS bf16x8*)(rth + 16 * RT_LS + wo), wl0 = *(const LAS bf16x8*)(rtl + wo), wl1 = *(const LAS bf16x8*)(rtl + 16 * RT_LS + wo);
            acc0 = __builtin_amdgcn_mfma_f32_16x16x32_bf16(fh, wh0, acc0, 0, 0, 0); acc1 = __builtin_amdgcn_mfma_f32_16x16x32_bf16(fh, wh1, acc1, 0, 0, 0);
            acc0 = __builtin_amdgcn_mfma_f32_16x16x32_bf16(fl, wh0, acc0, 0, 0, 0); acc1 = __builtin_amdgcn_mfma_f32_16x16x32_bf16(fl, wh1, acc1, 0, 0, 0);
            acc0 = __builtin_amdgcn_mfma_f32_16x16x32_bf16(fh, wl0, acc0, 0, 0, 0); acc1 = __builtin_amdgcn_mfma_f32_16x16x32_bf16(fh, wl1, acc1, 0, 0, 0);
        }
#pragma unroll
        for (int r = 0; r < 4; ++r) { lgs[(4 * g4 + r) * 34 + c16] = acc0[r] + (coop ? 0.f : rtb0); lgs[(4 * g4 + r) * 34 + 16 + c16] = acc1[r] + (coop ? 0.f : rtb1); }
        asm volatile("s_waitcnt lgkmcnt(0)" ::: "memory");
        if (coop) {
            __syncthreads();
            if (wid == 0) {
#pragma unroll
                for (int r = 0; r < 4; ++r) { float s0 = rtb0, s1 = rtb1;
#pragma unroll
                    for (int w = 0; w < NWAVES; ++w) { s0 += lgs0[w * 544 + (4 * g4 + r) * 34 + c16]; s1 += lgs0[w * 544 + (4 * g4 + r) * 34 + 16 + c16]; }
                    lgs[(4 * g4 + r) * 34 + c16] = s0; lgs[(4 * g4 + r) * 34 + 16 + c16] = s1; }
                asm volatile("s_waitcnt lgkmcnt(0)" ::: "memory");
            }
        }
        if ((!coop || wid == 0) && lane < 16) {
            float tv[4] = {-3.0e38f, -3.0e38f, -3.0e38f, -3.0e38f}; int ti[4] = {0, 0, 0, 0};
#pragma unroll
            for (int e = 0; e < 32; ++e) {
                const float lgv = lgs[lane * 34 + e];
                if (lgv > tv[3]) {
                    tv[3] = lgv; ti[3] = e;
                    if (tv[3] > tv[2]) { const float a = tv[2]; tv[2] = tv[3]; tv[3] = a; const int b = ti[2]; ti[2] = ti[3]; ti[3] = b; }
                    if (tv[2] > tv[1]) { const float a = tv[1]; tv[1] = tv[2]; tv[2] = a; const int b = ti[1]; ti[1] = ti[2]; ti[2] = b; }
                    if (tv[1] > tv[0]) { const float a = tv[0]; tv[0] = tv[1]; tv[1] = a; const int b = ti[0]; ti[0] = ti[1]; ti[1] = b; }
                }
            }
            const float e1 = __expf(tv[1] - tv[0]), e2 = __expf(tv[2] - tv[0]), e3 = __expf(tv[3] - tv[0]);
            const float inv = 1.0f / (1.0f + e1 + e2 + e3);
            const size_t r4 = (size_t)(row_lo + 16 * u + lane) * 4;
            *(int4*)((int*)(ws + WS_TOKE) + r4) = make_int4(ti[0], ti[1], ti[2], ti[3]);
            *(f32x4*)((float*)(ws + WS_TOKG) + r4) = (f32x4){inv, e1 * inv, e2 * inv, e3 * inv};
            int rk[4];
#pragma unroll
            for (int k = 0; k < 4; ++k) rk[k] = __hip_atomic_fetch_add(hist + ti[k], 1, __ATOMIC_RELAXED, __HIP_MEMORY_SCOPE_WORKGROUP);
            *(int4*)((int*)(ws + WS_TOKR) + r4) = make_int4(rk[0], rk[1], rk[2], rk[3]);
        }
        asm volatile("s_waitcnt lgkmcnt(0)" ::: "memory");
        if (coop) __syncthreads();
    };
    { const int u = bid * NWAVES + wid; if (u < ngroups && u < nb * NWAVES) group(u, 0, 32, false); }
    for (int u = nb * NWAVES + bid; u < ngroups; u += nb) group(u, 4 * wid, 4 * wid + 4, true);
    __syncthreads();
    if (tid < 32) ((int*)(ws + WS_BCNT))[((size_t)l * 256 + bid) * 32 + tid] = hist[tid];
}

typedef pg8::f32x4 (&AccRef)[2][2][4][2];
struct EpiStoreBf16 {
    static constexpr bool PERM = true, AFTER_DRAIN = false;
    bf16_t* O; int ldc;
    __device__ __forceinline__ void operator()(const pg8::f32x4 (&acc)[2][2][4][2], const pg8::Unit& u, int wr, int wc, int fr, int fq) const {
        const int row0 = u.pm * 256 + wr * 64 + fr, col0 = u.pn * 256 + wc * 32 + 8 * fq;
#pragma unroll
        for (int ai = 0; ai < 2; ++ai)
#pragma unroll
            for (int m = 0; m < 4; ++m) { bf16_t* rowp = O + (size_t)(row0 + ai * 128 + m * 16) * ldc + col0;
#pragma unroll
                for (int bj = 0; bj < 2; ++bj) { const pg8::f32x4 v0 = acc[ai][bj][m][0], v1 = acc[ai][bj][m][1];
                    u32x4 w; w.x = cvtpk_s(v0[0], v0[1]); w.y = cvtpk_s(v0[2], v0[3]); w.z = cvtpk_s(v1[0], v1[1]); w.w = cvtpk_s(v1[2], v1[3]);
                    *(u32x4*)(rowp + bj * 128) = w; } }
    }
};
struct EpiGeluBf16 {
    static constexpr bool PERM = true, AFTER_DRAIN = false;
    bf16_t* O; int ldc; const float* bias;
    __device__ __forceinline__ void operator()(const pg8::f32x4 (&acc)[2][2][4][2], const pg8::Unit& u, int wr, int wc, int fr, int fq) const {
        const int row0 = u.pm * 256 + wr * 64 + fr, col0 = u.pn * 256 + wc * 32 + 8 * fq;
        pg8::f32x4 bv[2][2];
#pragma unroll
        for (int bj = 0; bj < 2; ++bj)
#pragma unroll
            for (int n = 0; n < 2; ++n) bv[bj][n] = *(const pg8::f32x4*)(bias + col0 + bj * 128 + 4 * n);
#pragma unroll
        for (int ai = 0; ai < 2; ++ai)
#pragma unroll
            for (int m = 0; m < 4; ++m) { bf16_t* rowp = O + (size_t)(row0 + ai * 128 + m * 16) * ldc + col0;
#pragma unroll
                for (int bj = 0; bj < 2; ++bj) { pg8::f32x4 v0 = acc[ai][bj][m][0] + bv[bj][0], v1 = acc[ai][bj][m][1] + bv[bj][1];
                    const pg8::f32x2 a = pg8::gelu_pk((pg8::f32x2){v0[0], v0[1]}), b = pg8::gelu_pk((pg8::f32x2){v0[2], v0[3]}), c = pg8::gelu_pk((pg8::f32x2){v1[0], v1[1]}), d = pg8::gelu_pk((pg8::f32x2){v1[2], v1[3]});
                    u32x4 w; w.x = cvtpk_s(a.x, a.y); w.y = cvtpk_s(b.x, b.y); w.z = cvtpk_s(c.x, c.y); w.w = cvtpk_s(d.x, d.y);
                    *(u32x4*)(rowp + bj * 128) = w; } }
    }
};
struct EpiResidual {
    static constexpr bool PERM = true, AFTER_DRAIN = false;
    bf16_t* H; const float* gate0; int row_base;
    __device__ __forceinline__ void operator()(const pg8::f32x4 (&acc)[2][2][4][2], const pg8::Unit& u, int wr, int wc, int fr, int fq) const {
        const int row0 = u.pm * 256 + wr * 64 + fr, col0 = u.pn * 256 + wc * 32 + 8 * fq;
        const Tok tk = tokinfo(row_base + u.pm * 256);
        const float* gate = gate0 + (size_t)tk.modrow * 6144 + col0;
        pg8::f32x4 gv[2][2];
#pragma unroll
        for (int bj = 0; bj < 2; ++bj)
#pragma unroll
            for (int n = 0; n < 2; ++n) gv[bj][n] = *(const pg8::f32x4*)(gate + bj * 128 + n * 4);
#pragma unroll
        for (int ai = 0; ai < 2; ++ai)
#pragma unroll
            for (int m = 0; m < 4; ++m) { bf16_t* rowp = H + (size_t)(row0 + ai * 128 + m * 16) * DM + col0;
#pragma unroll
                for (int bj = 0; bj < 2; ++bj) { u32x4* p = (u32x4*)(rowp + bj * 128); const u32x4 h = *p;
                    const pg8::f32x4 v0 = (pg8::f32x4){bflo(h.x), bfhi(h.x), bflo(h.y), bfhi(h.y)} + gv[bj][0] * acc[ai][bj][m][0], v1 = (pg8::f32x4){bflo(h.z), bfhi(h.z), bflo(h.w), bfhi(h.w)} + gv[bj][1] * acc[ai][bj][m][1];
                    *p = (u32x4){cvtpk_s(v0[0], v0[1]), cvtpk_s(v0[2], v0[3]), cvtpk_s(v1[0], v1[1]), cvtpk_s(v1[2], v1[3])}; } }
    }
};
struct ListOrder {
    const LAS int* list; int n; const LAS unsigned* rowtab;
    __device__ __forceinline__ bool next(int i, pg8::Unit& u) const {
        if (i >= n) return false;
        u.pm = __builtin_amdgcn_readfirstlane(list[2 * i]); u.pn = __builtin_amdgcn_readfirstlane(list[2 * i + 1]); u.ui = i; return true;
    }
    __device__ __forceinline__ void a_ready(const pg8::Unit&) const {}
    __device__ __forceinline__ void done(const pg8::Unit&) const {}
};
struct EpiLora {
    static constexpr bool PERM = true, AFTER_DRAIN = false;
    bf16_t* O; const float* bias; int row_base;
    __device__ __forceinline__ void operator()(const pg8::f32x4 (&acc)[2][2][4][2], const pg8::Unit& u, int wr, int wc, int fr, int fq) const {
        const int seg = u.pn >> 1, row0 = row_base + u.pm * 256 + wr * 64 + fr, cs0 = (u.pn & 1) * 256 + wc * 32 + 8 * fq;
        const float ksig = seg < 2 ? -0.60653065971f : 1.0f; const bool lin = seg == 4;
        bf16_t* Os = O + (size_t)seg * NTOK * 512;
#pragma unroll
        for (int bj = 0; bj < 2; ++bj) {
            const int cs = cs0 + bj * 128;
            const pg8::f32x4 b0 = *(const pg8::f32x4*)(bias + seg * 512 + cs), b1 = *(const pg8::f32x4*)(bias + seg * 512 + cs + 4);
#pragma unroll
            for (int ai = 0; ai < 2; ++ai)
#pragma unroll
                for (int m = 0; m < 4; ++m) {
                    pg8::f32x4 v0 = acc[ai][bj][m][0] + b0, v1 = acc[ai][bj][m][1] + b1;
#pragma unroll
                    for (int r = 0; r < 4; ++r) {
                        const float t0 = ksig * __builtin_amdgcn_rcpf(1.0f + __expf(-v0[r])), t1 = ksig * __builtin_amdgcn_rcpf(1.0f + __expf(-v1[r]));
                        v0[r] = lin ? v0[r] : t0; v1[r] = lin ? v1[r] : t1;
                    }
                    u32x4 w; w.x = cvtpk_s(v0[0], v0[1]); w.y = cvtpk_s(v0[2], v0[3]); w.z = cvtpk_s(v1[0], v1[1]); w.w = cvtpk_s(v1[2], v1[3]);
                    *(u32x4*)(Os + (size_t)(row0 + ai * 128 + m * 16) * 512 + cs) = w;
                }
        }
    }
};
constexpr int LDS_TAB = 131072;
constexpr int LDS_LIST = LDS_TAB + 4096;
constexpr int LDS_ROWTAB = LDS_LIST + 1024;
__device__ __forceinline__ ListOrder build_units(LAS unsigned char* lds, int nM, int nN, int G, int c, const LAS int* tile_e, int ncol) {
    LAS int* list = (LAS int*)(lds + LDS_LIST);
    pg8::StaticOrder S; S.nM = nM; S.nN = nN; S.nwg = nM * nN; S.G = G; S.c = c;
    const int tid = tid_opaque();
    if (tid < 64) { pg8::Unit u; if (S.next(tid, u)) { if (tile_e) u.pn = tile_e[u.pm] * ncol + u.pn; list[2 * tid] = u.pm; list[2 * tid + 1] = u.pn; } }
    __syncthreads();
    ListOrder L; L.list = list; L.n = (c < S.nwg) ? (S.nwg - c + G - 1) / G : 0; L.rowtab = (const LAS unsigned*)(lds + LDS_ROWTAB);
    return L;
}
struct EpiMoe1 {
    static constexpr bool PERM = true, AFTER_DRAIN = false;
    bf16_t* O; const float* b1;
    __device__ __forceinline__ void operator()(const pg8::f32x4 (&acc)[2][2][4][2], const pg8::Unit& u, int wr, int wc, int fr, int fq) const {
        const int e = u.pn >> 3, pn = u.pn & 7;
        const int row0 = u.pm * 256 + wr * 64 + fr, ci = pn * 128 + wc * 32 + 8 * fq;
        const float* be = b1 + (size_t)e * 2048 + ci;
        unsigned char* bp = (unsigned char*)O + (size_t)u.pm * 262144 + (size_t)(pn * 4 + wc) * 8192 + (wr * 64 + fr) * 32 + 8 * fq; (void)row0;
        const pg8::f32x4 bg0 = *(const pg8::f32x4*)(be), bg1 = *(const pg8::f32x4*)(be + 4), bl0 = *(const pg8::f32x4*)(be + 1024), bl1 = *(const pg8::f32x4*)(be + 1028);
#pragma unroll
        for (int ai = 0; ai < 2; ++ai)
#pragma unroll
            for (int m = 0; m < 4; ++m) {
                const pg8::f32x4 g0 = acc[ai][0][m][0] + bg0, g1 = acc[ai][0][m][1] + bg1, l0 = acc[ai][1][m][0] + bl0, l1 = acc[ai][1][m][1] + bl1;
                float o[8];
#pragma unroll
                for (int r = 0; r < 4; r += 2) {
#pragma unroll
                    for (int hlf = 0; hlf < 2; ++hlf) {
                        const pg8::f32x4 gv = hlf ? g1 : g0, lv = hlf ? l1 : l0;
                        pg8::f32x2 ga = {fminf(gv[r], 7.0f), fminf(gv[r + 1], 7.0f)};
                        const pg8::f32x2 la = {__builtin_amdgcn_fmed3f(lv[r], -7.0f, 7.0f), __builtin_amdgcn_fmed3f(lv[r + 1], -7.0f, 7.0f)};
                        const pg8::f32x2 t = ga * la + ga, x = ga * (-1.702f * 1.4426950408889634f);
                        pg8::f32x2 e; e.x = __builtin_amdgcn_exp2f(x.x); e.y = __builtin_amdgcn_exp2f(x.y);
                        const pg8::f32x2 d = e * 0.25f + 0.25f;
                        o[4 * hlf + r] = t.x * __builtin_amdgcn_rcpf(d.x); o[4 * hlf + r + 1] = t.y * __builtin_amdgcn_rcpf(d.y);
                    }
                }
                int w0 = __builtin_amdgcn_cvt_pk_fp8_f32(o[0], o[1], 0, false); w0 = __builtin_amdgcn_cvt_pk_fp8_f32(o[2], o[3], w0, true);
                int w1 = __builtin_amdgcn_cvt_pk_fp8_f32(o[4], o[5], 0, false); w1 = __builtin_amdgcn_cvt_pk_fp8_f32(o[6], o[7], w1, true);
                *(u32x2*)(bp + (ai * 128 + m * 16) * 32) = (u32x2){(unsigned)w0, (unsigned)w1};
            }
    }
};
struct EpiMoe2 {
    static constexpr bool PERM = true, AFTER_DRAIN = false, WIDE = true;
    unsigned char* O; const LAS float* btab;
    __device__ __forceinline__ void operator()(const pg8::f32x4 (&acc)[2][2][4][2], const pg8::Unit& u, int wr, int wc, int fr, int fq) const {
        const int pn = u.pn & 3;
        const int row0 = u.pm * 256 + wr * 64 + fr, col0 = pn * 256 + wc * 64 + 16 * fq;
        const LAS float* be = btab + u.ui * 256 + wc * 64 + 16 * fq;
        pg8::f32x4 bv[2][2];
#pragma unroll
        for (int bj = 0; bj < 2; ++bj)
#pragma unroll
            for (int n = 0; n < 2; ++n) bv[bj][n] = *(const LAS pg8::f32x4*)(be + bj * 8 + 4 * n);
#pragma unroll
        for (int ai = 0; ai < 2; ++ai)
#pragma unroll
            for (int m = 0; m < 4; ++m) { unsigned char* rowp = O + (size_t)(row0 + ai * 128 + m * 16) * DM + col0;
                int w[4];
#pragma unroll
                for (int bj = 0; bj < 2; ++bj) { const pg8::f32x4 v0 = acc[ai][bj][m][0] + bv[bj][0], v1 = acc[ai][bj][m][1] + bv[bj][1];
                    int w0 = __builtin_amdgcn_cvt_pk_fp8_f32(v0[0], v0[1], 0, false); w0 = __builtin_amdgcn_cvt_pk_fp8_f32(v0[2], v0[3], w0, true);
                    int w1 = __builtin_amdgcn_cvt_pk_fp8_f32(v1[0], v1[1], 0, false); w1 = __builtin_amdgcn_cvt_pk_fp8_f32(v1[2], v1[3], w1, true);
                    w[2 * bj] = w0; w[2 * bj + 1] = w1; }
                *(u32x4*)rowp = (u32x4){(unsigned)w[0], (unsigned)w[1], (unsigned)w[2], (unsigned)w[3]}; }
    }
};

namespace att {
typedef float f32x16 __attribute__((ext_vector_type(16)));
typedef short s16x4 __attribute__((ext_vector_type(4)));
constexpr int KVBLK = 64, LDR = 512;
constexpr float QSCALE = 0.125f * 1.4426950408889634f;
constexpr int SHM_V = KVBLK * 128 * 2, SHM_K = KVBLK * 64 * 2, SHM_ATTN = 2 * SHM_V + 2 * SHM_K + NWAVES * 64 * 4;
#define ATT_KSWZ(row, colB) ((row) * 128 + ((colB) ^ ((((row) >> 1) & 7) << 4)))
#define ATT_SBAR() __builtin_amdgcn_sched_barrier(0)
__device__ __forceinline__ int crow(int r, int hi) { return (r & 3) + 8 * (r >> 2) + 4 * hi; }
__device__ __forceinline__ unsigned cvtpk(float lo, float hi) { unsigned r; asm volatile("v_cvt_pk_bf16_f32 %0, %1, %2" : "=v"(r) : "v"(lo), "v"(hi)); return r; }
constexpr float SHIFT = -12.0f;
__device__ __forceinline__ void partialSM(f32x16& p0) {
#pragma unroll
    for (int r = 0; r < 16; ++r) p0[r] = __builtin_amdgcn_exp2f(p0[r]);
}
__device__ __forceinline__ void finishSM(f32x16& p0, f32x16& p1, float& l_reg, bf16x8& pa0, bf16x8& pa1, bf16x8& pa2, bf16x8& pa3) {
#pragma unroll
    for (int r = 0; r < 16; ++r) p1[r] = __builtin_amdgcn_exp2f(p1[r]);
    float ps = 0;
#pragma unroll
    for (int r = 0; r < 16; ++r) ps += p0[r];
#pragma unroll
    for (int r = 0; r < 16; ++r) ps += p1[r];
    l_reg += ps;
#define ATT_PK4(P, BASE, OUT) do { unsigned a0 = cvtpk(P[BASE + 0], P[BASE + 1]), a1 = cvtpk(P[BASE + 2], P[BASE + 3]);   \
    unsigned b0 = cvtpk(P[BASE + 4], P[BASE + 5]), b1 = cvtpk(P[BASE + 6], P[BASE + 7]);                              \
    auto r0 = __builtin_amdgcn_permlane32_swap(a0, b0, false, false); auto r1 = __builtin_amdgcn_permlane32_swap(a1, b1, false, false); \
    u32x4 w = {r0[0], r1[0], r0[1], r1[1]}; OUT = __builtin_bit_cast(bf16x8, w); } while (0)
    ATT_PK4(p0, 0, pa0); ATT_PK4(p0, 8, pa1); ATT_PK4(p1, 0, pa2); ATT_PK4(p1, 8, pa3);
#undef ATT_PK4
}
__device__ __forceinline__ void qkt(f32x16& p0, f32x16& p1, const LAS unsigned char* Ks, int qaddr, int r32, int hi) {
    asm volatile("" : "+v"(qaddr)); const LAS unsigned char* qp = (const LAS unsigned char*)(uintptr_t)qaddr;
    bf16x8 qr[4];
#pragma unroll
    for (int d0 = 0; d0 < 4; ++d0) qr[d0] = *(const LAS bf16x8*)(qp + d0 * 1024);
#pragma unroll
    for (int r = 0; r < 16; ++r) { p0[r] = SHIFT; p1[r] = SHIFT; }
#pragma unroll
    for (int d0 = 0; d0 < 4; ++d0) { const int cb = (d0 * 16 + hi * 8) * 2;
        const bf16x8 b0 = *(const LAS bf16x8*)(Ks + ATT_KSWZ(r32, cb));
        const bf16x8 b1 = *(const LAS bf16x8*)(Ks + ATT_KSWZ(32 + r32, cb));
        p0 = __builtin_amdgcn_mfma_f32_32x32x16_bf16(b0, qr[d0], p0, 0, 0, 0);
        p1 = __builtin_amdgcn_mfma_f32_32x32x16_bf16(b1, qr[d0], p1, 0, 0, 0); }
}
__device__ __forceinline__ int v_st(int k, int c) { const int kk = (k & ~0xC) | ((k & 4) << 1) | ((k & 8) >> 1); return ((kk >> 3) * 4 + (c >> 5)) * 512 + ((kk & 7) * 32 + (c & 31)) * 2; }
__device__ __forceinline__ int v_rd_base(int lane) { return ((lane & 3) << 3) | (((lane >> 2) & 3) << 6) | (((lane >> 4) & 1) << 5) | (((lane >> 5) & 1) << 8); }
constexpr int v_rd_off(int d0, int ks, int half) { return d0 * 512 + ks * 4096 + half * 2048; }
template <int OFF> __device__ __forceinline__ s16x4 tr_read(int vb) { s16x4 r; asm volatile("ds_read_b64_tr_b16 %0, %1 offset:%2" : "=&v"(r) : "v"(vb), "i"(OFF) : "memory"); return r; }
template <int D0> __device__ __forceinline__ void pv_one(f32x16& od, int vb, bf16x8 pa0, bf16x8 pa1, bf16x8 pa2, bf16x8 pa3) {
    const s16x4 l0 = tr_read<v_rd_off(D0, 0, 0)>(vb), h0 = tr_read<v_rd_off(D0, 0, 1)>(vb), l1 = tr_read<v_rd_off(D0, 1, 0)>(vb), h1 = tr_read<v_rd_off(D0, 1, 1)>(vb);
    const s16x4 l2 = tr_read<v_rd_off(D0, 2, 0)>(vb), h2 = tr_read<v_rd_off(D0, 2, 1)>(vb), l3 = tr_read<v_rd_off(D0, 3, 0)>(vb), h3 = tr_read<v_rd_off(D0, 3, 1)>(vb);
    asm volatile("s_waitcnt lgkmcnt(0)" ::: "memory"); ATT_SBAR();
#define ATT_PK(L, H) (bf16x8){L[0], L[1], L[2], L[3], H[0], H[1], H[2], H[3]}
    od = __builtin_amdgcn_mfma_f32_32x32x16_bf16(pa0, ATT_PK(l0, h0), od, 0, 0, 0);
    od = __builtin_amdgcn_mfma_f32_32x32x16_bf16(pa1, ATT_PK(l1, h1), od, 0, 0, 0);
    od = __builtin_amdgcn_mfma_f32_32x32x16_bf16(pa2, ATT_PK(l2, h2), od, 0, 0, 0);
    od = __builtin_amdgcn_mfma_f32_32x32x16_bf16(pa3, ATT_PK(l3, h3), od, 0, 0, 0);
#undef ATT_PK
}
__device__ __forceinline__ void pv_d0(f32x16 (&o)[4], int vb, bf16x8 pa0, bf16x8 pa1, bf16x8 pa2, bf16x8 pa3) {
    pv_one<0>(o[0], vb, pa0, pa1, pa2, pa3); pv_one<1>(o[1], vb, pa0, pa1, pa2, pa3); pv_one<2>(o[2], vb, pa0, pa1, pa2, pa3); pv_one<3>(o[3], vb, pa0, pa1, pa2, pa3);
}
__device__ __forceinline__ void attn_body(const bf16_t* Qb, const bf16_t* Kh, const bf16_t* Vh, bf16_t* Ob, int seq, LAS unsigned char* lds) {
    const int tid = tid_opaque(), wid = tid >> 6, lane = tid & 63, r32 = lane & 31, hi = lane >> 5;
    LAS unsigned char* V_lds = lds; LAS unsigned char* K_lds = lds + 2 * SHM_V;
    LAS float* wsl = (LAS float*)(lds + 2 * SHM_V + 2 * SHM_K) + wid * 64; LAS float* li_l = wsl; LAS float* al_l = wsl + 32;
    float l_reg = 0; f32x16 o[4] = {};
    const bf16_t* Qw = Qb + (size_t)(wid * 32 + r32) * LDR + hi * 8;
    LAS unsigned char* qlds = lds + SHM_ATTN + wid * 4096 + lane * 16;
#pragma unroll
    for (int d0 = 0; d0 < 4; ++d0) *(LAS bf16x8*)(qlds + d0 * 1024) = *(const bf16x8*)(Qw + d0 * 16);
    const int qr = (int)(uintptr_t)qlds;
    const int sr = tid >> 4, sc = (tid & 15) * 8, vst0 = v_st(sr, sc), vst1 = v_st(32 + sr, sc);
    const int kr = tid >> 3, kc = (tid & 7) * 8, kst = ATT_KSWZ(kr, kc * 2);
    const int vb0 = (int)(uintptr_t)V_lds + v_rd_base(lane);
    bf16x8 vsA0, vsA1, ksA, vsB0, vsB1, ksB;
#define ATT_SLOAD(V0, V1, K0, k0) do { V0 = *(const bf16x8*)(Vh + (size_t)((k0) + sr) * LDR + sc); V1 = *(const bf16x8*)(Vh + (size_t)((k0) + 32 + sr) * LDR + sc); \
    K0 = *(const bf16x8*)(Kh + (size_t)((k0) + kr) * LDR + kc); } while (0)
#define ATT_SWRITE(b, V0, V1, K0) do { *(LAS bf16x8*)(V_lds + (b) * SHM_V + vst0) = V0; *(LAS bf16x8*)(V_lds + (b) * SHM_V + vst1) = V1; \
    *(LAS bf16x8*)(K_lds + (b) * SHM_K + kst) = K0; } while (0)
#define ATT_SWAIT() asm volatile("s_waitcnt vmcnt(3)" ::: "memory")
    f32x16 p0, p1; bf16x8 pa0, pa1, pa2, pa3; const int NT = seq / KVBLK;
    ATT_SLOAD(vsA0, vsA1, ksA, 0); asm volatile("s_waitcnt vmcnt(0)" ::: "memory"); ATT_SWRITE(0, vsA0, vsA1, ksA);
    ATT_SLOAD(vsB0, vsB1, ksB, KVBLK); if (2 < NT) ATT_SLOAD(vsA0, vsA1, ksA, 2 * KVBLK);
    ATT_SWAIT(); ATT_SWRITE(1, vsB0, vsB1, ksB); __syncthreads();
    for (int j = 0; j < NT; j += 2) {
        ATT_SBAR(); qkt(p0, p1, K_lds, qr, r32, hi); partialSM(p0);
        finishSM(p0, p1, l_reg, pa0, pa1, pa2, pa3); ATT_SBAR();
        if (j + 3 < NT) ATT_SLOAD(vsB0, vsB1, ksB, (j + 3) * KVBLK); ATT_SBAR();
        pv_d0(o, vb0, pa0, pa1, pa2, pa3); ATT_SBAR();
        __syncthreads();
        if (j + 2 < NT) { ATT_SWAIT(); ATT_SWRITE(0, vsA0, vsA1, ksA); }
        asm volatile("" : "+v"(o[0]), "+v"(o[1]), "+v"(o[2]), "+v"(o[3]));
        __syncthreads();
        ATT_SBAR(); qkt(p0, p1, K_lds + SHM_K, qr, r32, hi); partialSM(p0);
        finishSM(p0, p1, l_reg, pa0, pa1, pa2, pa3); ATT_SBAR();
        if (j + 4 < NT) ATT_SLOAD(vsA0, vsA1, ksA, (j + 4) * KVBLK); ATT_SBAR();
        pv_d0(o, vb0 + SHM_V, pa0, pa1, pa2, pa3); ATT_SBAR();
        __syncthreads();
        if (j + 3 < NT) { ATT_SWAIT(); ATT_SWRITE(1, vsB0, vsB1, ksB); }
        asm volatile("" : "+v"(o[0]), "+v"(o[1]), "+v"(o[2]), "+v"(o[3]));
        __syncthreads();
    }
    { auto rr = __builtin_amdgcn_permlane32_swap(__float_as_uint(l_reg), __float_as_uint(l_reg), false, false); l_reg = __uint_as_float(rr[0]) + __uint_as_float(rr[1]); }
    if (hi == 0) li_l[r32] = l_reg; asm volatile("s_waitcnt lgkmcnt(0)" ::: "memory");
    float rli[16];
#pragma unroll
    for (int r = 0; r < 16; ++r) rli[r] = __builtin_amdgcn_rcpf(li_l[crow(r, hi)]);
    bf16_t* Ow = Ob + (size_t)(wid * 32) * LDR;
    const bool oddl = (r32 & 1) != 0;
#pragma unroll
    for (int rp = 0; rp < 8; ++rp) {
        const int orow = oddl ? crow(2 * rp + 1, hi) : crow(2 * rp, hi);
#pragma unroll
        for (int d0 = 0; d0 < 4; ++d0) {
            const float va = o[d0][2 * rp] * rli[2 * rp], vb = o[d0][2 * rp + 1] * rli[2 * rp + 1];
            const float send = oddl ? va : vb, mine = oddl ? vb : va;
            const float recv = __builtin_bit_cast(float, __builtin_amdgcn_update_dpp(0, __builtin_bit_cast(int, send), 0xB1, 0xF, 0xF, false));
            *(unsigned*)(Ow + (size_t)orow * LDR + d0 * 32 + (r32 & ~1)) = oddl ? cvtpk_s(recv, mine) : cvtpk_s(mine, recv);
        }
    }
#undef ATT_SLOAD
#undef ATT_SWRITE
#undef ATT_SWAIT
}
}

__device__ __forceinline__ void ph_gemm_win(const Args& A, int j, int row_lo, LAS unsigned char* lds, int bid, int nb) {
    unsigned char* ws = opq(A.ws); const float* const* IN = (const float* const*)(ws + WS_PTRS); (void)IN;
    pg8::Gemm g{(const bf16_t*)(ws + WS_ABF) + (size_t)row_lo * DM, (const bf16_t*)(ws + WS_WIN) + (size_t)j * ZLD * DM, NTOK - row_lo, ZLD, DM};
    const ListOrder S = build_units(lds, (NTOK - row_lo) / 256, ZLD / 256, nb, bid, nullptr, 0);
    EpiStoreBf16 E{(bf16_t*)(ws + WS_Z) + (size_t)row_lo * ZLD, ZLD};
    pg8::gemm_phase<EpiStoreBf16, ListOrder, true, true>(lds, g, S, E);
}

__device__ __forceinline__ void ph_rwkv_pre(const Args& A, int j, int row_lo, int bid, int nb) {
    unsigned char* ws = opq(A.ws); const float* const* IN = (const float* const*)(ws + WS_PTRS);
    const int tid = tid_opaque(), lane = tid & 63, wid = tid >> 6;
    const bf16_t* Z = (const bf16_t*)(ws + WS_Z);
    const float* mu = INP(I_RWMU) + (size_t)j * 2 * RWC; const float* kkw = INP(I_RWKK) + j * 512;
    bf16_t* RB = (bf16_t*)(ws + WS_RB); bf16_t* KS = (bf16_t*)(ws + WS_KS); bf16_t* VS = (bf16_t*)(ws + WS_VS); bf16_t* KKN = (bf16_t*)(ws + WS_KKN); bf16_t* LIN = (bf16_t*)(ws + WS_LIN);
#define UNPK8(dst, raw) do { _Pragma("unroll") for (int _i = 0; _i < 4; ++_i) { dst[2 * _i] = __builtin_bit_cast(float, raw[_i] << 16); dst[2 * _i + 1] = __builtin_bit_cast(float, raw[_i] & 0xffff0000u); } } while (0)
#define PK8(v) (u32x4){pk2(v[0], v[1]), pk2(v[2], v[3]), pk2(v[4], v[5]), pk2(v[6], v[7])}
    f32x4 mu0a[4], mu0b[4], mu1a[4], mu1b[4];
#pragma unroll
    for (int i = 0; i < 4; ++i) { const int ch = i * 64 + lane, col = (ch < 240 ? ch : 0) * 8;
        mu0a[i] = *(const f32x4*)(mu + col); mu0b[i] = *(const f32x4*)(mu + col + 4); mu1a[i] = *(const f32x4*)(mu + RWC + col); mu1b[i] = *(const f32x4*)(mu + RWC + col + 4); }
    for (int g = row_lo + bid * NWAVES + wid; g < NTOK; g += nb * NWAVES) {
        const Tok tk = tokinfo(g);
        const bool hp = tk.t > 0, hn = tk.t < tk.T - 1;
        const bf16_t* zc = Z + (size_t)g * ZLD;
#pragma unroll
        for (int i = 0; i < 4; ++i) {
            const int ch = i * 64 + lane, col = ch * 8;
            if (ch < 240) {
                const u32x4 zero = {0u, 0u, 0u, 0u};
                const u32x4 cr = *(const u32x4*)(zc + col), pr = hp ? *(const u32x4*)(zc - ZLD + col) : zero, nr = hn ? *(const u32x4*)(zc + ZLD + col) : zero;
                float z[8], p[8], n[8], s8[8];
                UNPK8(z, cr); UNPK8(p, pr); UNPK8(n, nr);
                const f32x4 m0a = mu0a[i], m0b = mu0b[i], m1a = mu1a[i], m1b = mu1b[i];
#pragma unroll
                for (int e = 0; e < 4; ++e) { s8[e] = z[e] + m0a[e] * (p[e] - z[e]) + m1a[e] * (n[e] - z[e]); s8[4 + e] = z[4 + e] + m0b[e] * (p[4 + e] - z[4 + e]) + m1b[e] * (n[4 + e] - z[4 + e]); }
                if (col < 512) *(u32x4*)(RB + (size_t)g * 512 + col) = PK8(s8);
                else if (col < 1024) {
                    const int ck = col - 512;
                    *(u32x4*)(KS + (size_t)g * 512 + ck) = PK8(s8);
                    const f32x4 kwa = *(const f32x4*)(kkw + ck), kwb = *(const f32x4*)(kkw + ck + 4);
                    float kk[8]; float ss = 0.f;
#pragma unroll
                    for (int e = 0; e < 4; ++e) { kk[e] = s8[e] * kwa[e]; kk[4 + e] = s8[4 + e] * kwb[e]; ss += kk[e] * kk[e] + kk[4 + e] * kk[4 + e]; }
                    ss += __shfl_xor(ss, 1); ss += __shfl_xor(ss, 2); ss += __shfl_xor(ss, 4);
                    const float inv = 1.0f / fmaxf(sqrtf(ss), 1e-12f);
#pragma unroll
                    for (int e = 0; e < 8; ++e) kk[e] *= inv;
                    *(u32x4*)(KKN + (size_t)g * 512 + ck) = PK8(kk);
                }
                else if (col < 1536) *(u32x4*)(VS + (size_t)g * 512 + (col - 1024)) = PK8(s8);
                else {
                    float t8[8];
#pragma unroll
                    for (int e = 0; e < 8; ++e) t8[e] = col < 1664 ? tanhf(s8[e]) : (col < 1792 ? s8[e] : sigmoidf_(s8[e]));
                    *(u32x4*)(LIN + (size_t)g * 384 + (col - 1536)) = PK8(t8);
                }
            }
        }
    }
#undef UNPK8
#undef PK8
}
__device__ __forceinline__ void ph_gemm_lora(const Args& A, int j, int row_lo, LAS unsigned char* lds, int bid, int nb) {
    unsigned char* ws = opq(A.ws);
    int Kq = LORA_K; asm volatile("" : "+s"(Kq));
    pg8::Gemm g{(const bf16_t*)(ws + WS_LIN) + (size_t)row_lo * LORA_K, (const bf16_t*)(ws + WS_WLORA) + (size_t)j * LORA_N * LORA_K, NTOK - row_lo, LORA_N, Kq};
    const ListOrder S = build_units(lds, (NTOK - row_lo) / 256, LORA_N / 256, nb, bid, nullptr, 0);
    EpiLora E{(bf16_t*)(ws + WS_LO), (const float*)(ws + WS_LBIAS) + (size_t)j * LORA_N, row_lo};
    pg8::gemm_phase<EpiLora, ListOrder, true, true, false, false, false, true>(lds, g, S, E);
}

constexpr int R_A2 = 0, R_RT = 2048, R_BT = 4096, R_KT = 6144, R_VT = 8192, R_MBR = 10240, R_MKR = 10752, R_G = 11264, R_P = 11776;
__device__ __forceinline__ bf16x8 frag4(u32x2 lo) { const u32x4 w = {lo.x, lo.y, 0u, 0u}; return __builtin_bit_cast(bf16x8, w); }
__device__ __forceinline__ bf16x8 frag8(u32x2 lo, u32x2 hi) { const u32x4 w = {lo.x, lo.y, hi.x, hi.y}; return __builtin_bit_cast(bf16x8, w); }
__device__ __forceinline__ u32x2 pack4(f32x4 v) { u32x2 o; o.x = cvtpk_s(v[0], v[1]); o.y = cvtpk_s(v[2], v[3]); return o; }
__device__ __forceinline__ int wkv_token(int b, int dir, int s) {
    if (s < TC) return b * TC + (dir ? (TC - 1 - s) : s);
    const int q = s - TC; return NCTX + b * TL + (dir ? (TL - 1 - q) : q);
}
__device__ __forceinline__ float dpp_row_shr(float x, const int n) {
    switch (n) {
        case 1: return __builtin_bit_cast(float, __builtin_amdgcn_update_dpp(0, __builtin_bit_cast(int, x), 0x111, 0xF, 0xF, false));
        case 2: return __builtin_bit_cast(float, __builtin_amdgcn_update_dpp(0, __builtin_bit_cast(int, x), 0x112, 0xF, 0xF, false));
        case 4: return __builtin_bit_cast(float, __builtin_amdgcn_update_dpp(0, __builtin_bit_cast(int, x), 0x114, 0xF, 0xF, false));
        default: return __builtin_bit_cast(float, __builtin_amdgcn_update_dpp(0, __builtin_bit_cast(int, x), 0x118, 0xF, 0xF, false));
    }
}
#define WKV_TR(dst, addr) asm volatile("ds_read_b64_tr_b16 %0, %1" : "=&v"(dst) : "v"(addr) : "memory")
__device__ __forceinline__ void wkv_produce(unsigned char* ws, const float (&kap)[16], int b, int h, int dir, int c, LAS unsigned char* wl, LAS unsigned char* rec, int lane) {
    const int c16 = lane & 15, g4 = lane >> 4;
    constexpr int RS = 144;
    LAS unsigned char* Lat = wl; LAS unsigned char* Lbt = wl + 2304; LAS unsigned char* Lkt = wl + 4608; LAS unsigned char* Lrt = wl + 6912; LAS unsigned char* Lvt = wl + 9216;
    LAS float* Lnf = (LAS float*)(wl + 11520);
    LAS unsigned char* Lx = wl + 12800;
    const size_t FS = (size_t)NTOK * 512;
    const bf16_t* RB = (const bf16_t*)(ws + WS_RB); const bf16_t* KS = (const bf16_t*)(ws + WS_KS); const bf16_t* VS = (const bf16_t*)(ws + WS_VS); const bf16_t* KKN = (const bf16_t*)(ws + WS_KKN);
#define UNPK16(dst, p) do { const u32x4 _a = *(const u32x4*)(p), _b = *(const u32x4*)((p) + 8); _Pragma("unroll") for (int _i = 0; _i < 4; ++_i) { \
        dst[2 * _i] = __builtin_bit_cast(float, _a[_i] << 16); dst[2 * _i + 1] = __builtin_bit_cast(float, _a[_i] & 0xffff0000u); \
        dst[8 + 2 * _i] = __builtin_bit_cast(float, _b[_i] << 16); dst[9 + 2 * _i] = __builtin_bit_cast(float, _b[_i] & 0xffff0000u); } } while (0)
#define PK16ST(base, v) do { *(LAS u32x4*)(base) = (u32x4){pk2(v[0], v[1]), pk2(v[2], v[3]), pk2(v[4], v[5]), pk2(v[6], v[7])}; \
        *(LAS u32x4*)((base) + 16) = (u32x4){pk2(v[8], v[9]), pk2(v[10], v[11]), pk2(v[12], v[13]), pk2(v[14], v[15])}; } while (0)
    {
        const int g0 = wkv_token(b, dir, c * 16), gstep = dir ? -1 : 1;
        {
            const size_t o = (size_t)(g0 + gstep * c16) * 512 + h * 64 + 16 * g4;
            float lw[16], av[16], kv[16], kn[16], rv[16];
            UNPK16(lw, (const bf16_t*)(ws + WS_LO) + dir * FS + o); UNPK16(av, (const bf16_t*)(ws + WS_AB) + dir * FS + o);
            UNPK16(kv, KS + o); UNPK16(kn, KKN + o); UNPK16(rv, RB + o);
            { const u32x4 v0 = *(const u32x4*)(VS + o), v1 = *(const u32x4*)(VS + o + 8); *(LAS u32x4*)(Lvt + c16 * RS + 32 * g4) = v0; *(LAS u32x4*)(Lvt + c16 * RS + 32 * g4 + 16) = v1; }
            float at[16], bt[16], kt[16], rt[16], ecl[16];
#pragma unroll
            for (int i = 0; i < 16; ++i) {
                float cs = lw[i];
                cs += dpp_row_shr(cs, 1); cs += dpp_row_shr(cs, 2); cs += dpp_row_shr(cs, 4); cs += dpp_row_shr(cs, 8);
                const float ep = __expf(cs - lw[i]), ec = __expf(cs), em = __builtin_amdgcn_rcpf(ec);
                at[i] = -kn[i] * ep; bt[i] = kn[i] * av[i] * em; kt[i] = kv[i] * (1.0f + (av[i] - 1.0f) * kap[i]) * em; rt[i] = rv[i] * ec; ecl[i] = ec;
            }
            PK16ST(Lat + c16 * RS + 32 * g4, at); PK16ST(Lbt + c16 * RS + 32 * g4, bt); PK16ST(Lkt + c16 * RS + 32 * g4, kt); PK16ST(Lrt + c16 * RS + 32 * g4, rt);
            if (c16 == 15) {
#pragma unroll
                for (int q = 0; q < 4; ++q) *(LAS f32x4*)(rec + R_P + (16 * g4 + 4 * q) * 4) = (f32x4){ecl[4 * q], ecl[4 * q + 1], ecl[4 * q + 2], ecl[4 * q + 3]};
            }
        }
        asm volatile("s_waitcnt lgkmcnt(0)" ::: "memory");
        f32x4 nD = {0.f, 0.f, 0.f, 0.f}, makD = nD, mbrD = nD, mkrD = nD;
#pragma unroll
        for (int ks = 0; ks < 2; ++ks) {
            const int off = c16 * RS + (32 * ks + 8 * g4) * 2;
            const bf16x8 fa = *(const LAS bf16x8*)(Lat + off), fb = *(const LAS bf16x8*)(Lbt + off), fk = *(const LAS bf16x8*)(Lkt + off), fr = *(const LAS bf16x8*)(Lrt + off);
            nD = __builtin_amdgcn_mfma_f32_16x16x32_bf16(fa, fb, nD, 0, 0, 0);
            makD = __builtin_amdgcn_mfma_f32_16x16x32_bf16(fa, fk, makD, 0, 0, 0);
            mbrD = __builtin_amdgcn_mfma_f32_16x16x32_bf16(fb, fr, mbrD, 0, 0, 0);
            mkrD = __builtin_amdgcn_mfma_f32_16x16x32_bf16(fk, fr, mkrD, 0, 0, 0);
        }
#pragma unroll
        for (int r = 0; r < 4; ++r) {
            const int row = 4 * g4 + r;
            nD[r] = (c16 < row) ? nD[r] : 0.f; makD[r] = (c16 < row) ? makD[r] : 0.f;
            mbrD[r] = (row <= c16) ? mbrD[r] : 0.f; mkrD[r] = (row <= c16) ? mkrD[r] : 0.f;
            Lnf[row * 20 + c16] = nD[r];
        }
        asm volatile("s_waitcnt lgkmcnt(0)" ::: "memory");
        float x[16];
#pragma unroll
        for (int t = 0; t < 16; ++t) {
            float acc = (t == c16) ? 1.f : 0.f;
            f32x4 nr[4];
#pragma unroll
            for (int q = 0; q < 4; ++q) if (4 * q < t) nr[q] = *(const LAS f32x4*)(Lnf + t * 20 + 4 * q);
#pragma unroll
            for (int i = 0; i < t; ++i) acc += nr[i >> 2][i & 3] * x[i];
            x[t] = acc;
        }
        if (g4 == 0) {
#pragma unroll
            for (int t = 0; t < 16; t += 2) { const unsigned pr = cvtpk_s(x[t], x[t + 1]);
                *(LAS bf16_t*)(Lx + t * 32 + c16 * 2) = (bf16_t)(pr & 0xffffu); *(LAS bf16_t*)(Lx + (t + 1) * 32 + c16 * 2) = (bf16_t)(pr >> 16); }
        }
        asm volatile("s_waitcnt lgkmcnt(0)" ::: "memory");
        const bf16x8 xB = frag4(*(const LAS u32x2*)(Lx + c16 * 32 + g4 * 8));
        const f32x4 z4 = {0.f, 0.f, 0.f, 0.f};
        const f32x4 gD = __builtin_amdgcn_mfma_f32_16x16x32_bf16(frag4(pack4(makD)), xB, z4, 0, 0, 0);
        *(LAS u32x2*)(rec + R_G + (c16 * 16 + 4 * g4) * 2) = pack4(gD);
        *(LAS u32x2*)(rec + R_MBR + (c16 * 16 + 4 * g4) * 2) = pack4(mbrD);
        *(LAS u32x2*)(rec + R_MKR + (c16 * 16 + 4 * g4) * 2) = pack4(mkrD);
        {
            const int trow = c16 >> 2, tcol = 4 * (c16 & 3);
            u32x2 ta[4], tb[4], tk[4], tv[4];
#pragma unroll
            for (int m = 0; m < 4; ++m) {
                const int aA = (int)(uintptr_t)(Lat + (4 * g4 + trow) * RS + (16 * m + tcol) * 2);
                const int offr = (4 * m + trow) * RS + (16 * g4 + tcol) * 2;
                const int aB = (int)(uintptr_t)(Lbt + offr), aK = (int)(uintptr_t)(Lkt + offr), aV = (int)(uintptr_t)(Lvt + offr);
                WKV_TR(ta[m], aA); WKV_TR(tb[m], aB); WKV_TR(tk[m], aK); WKV_TR(tv[m], aV);
            }
            asm volatile("s_waitcnt lgkmcnt(0)" ::: "memory"); __builtin_amdgcn_sched_barrier(0);
#pragma unroll
            for (int m = 0; m < 4; ++m) {
                const f32x4 d = __builtin_amdgcn_mfma_f32_16x16x32_bf16(frag4(ta[m]), xB, z4, 0, 0, 0);
                *(LAS u32x2*)(rec + R_A2 + (c16 * 64 + 16 * m + 4 * g4) * 2) = pack4(d);
            }
            const int kch = 16 * g4 + c16;
            *(LAS u32x4*)(rec + R_BT + kch * 32) = (u32x4){tb[0].x, tb[0].y, tb[1].x, tb[1].y}; *(LAS u32x4*)(rec + R_BT + kch * 32 + 16) = (u32x4){tb[2].x, tb[2].y, tb[3].x, tb[3].y};
            *(LAS u32x4*)(rec + R_KT + kch * 32) = (u32x4){tk[0].x, tk[0].y, tk[1].x, tk[1].y}; *(LAS u32x4*)(rec + R_KT + kch * 32 + 16) = (u32x4){tk[2].x, tk[2].y, tk[3].x, tk[3].y};
            *(LAS u32x4*)(rec + R_VT + kch * 32) = (u32x4){tv[0].x, tv[0].y, tv[1].x, tv[1].y}; *(LAS u32x4*)(rec + R_VT + kch * 32 + 16) = (u32x4){tv[2].x, tv[2].y, tv[3].x, tv[3].y};
        }
        { const int row = lane >> 2, cb = (lane & 3) * 16;
          const u32x4 r0 = *(const LAS u32x4*)(Lrt + row * RS + cb * 2), r1 = *(const LAS u32x4*)(Lrt + row * RS + cb * 2 + 16);
          *(LAS u32x4*)(rec + R_RT + (row * 64 + cb) * 2) = r0; *(LAS u32x4*)(rec + R_RT + (row * 64 + cb) * 2 + 16) = r1; }
        asm volatile("s_waitcnt lgkmcnt(0)" ::: "memory");
    }
#undef UNPK16
#undef PK16ST
}

struct QkC { float qn[8], kn[8], invf[8]; bool upper, colaxis; };
__device__ __forceinline__ void qk_init(QkC& q, const float* const* IN, int j, int lane) {
    const int d0 = (lane & 7) * 8;
#pragma unroll
    for (int i = 0; i < 8; ++i) { q.qn[i] = INP(I_QN)[j * 64 + d0 + i]; q.kn[i] = INP(I_KN)[j * 64 + d0 + i]; q.invf[i] = __powf(10000.0f, -(float)((d0 + i) & 15) / 16.0f); }
    q.upper = (d0 & 16) != 0; q.colaxis = (d0 & 32) != 0;
}
__device__ __forceinline__ void qk_token(const QkC& q, unsigned char* ws, int g, int lane) {
    const bf16_t* Z = (const bf16_t*)(ws + WS_Z);
    bf16_t* QB = (bf16_t*)(ws + WS_QB); bf16_t* KB = (bf16_t*)(ws + WS_KB); bf16_t* VB = (bf16_t*)(ws + WS_VB);
    const bool upper = q.upper, colaxis = q.colaxis;
    {
        const Tok tk = tokinfo(g);
        const size_t krow = (size_t)tk.b * (TC + TL) + (tk.T == TL ? TC + tk.t : tk.t);
        const bf16_t* zr = Z + (size_t)g * ZLD + RWC;
        *(u32x4*)(VB + krow * 512 + lane * 8) = *(const u32x4*)(zr + 1024 + lane * 8);
        float cs[8], sn[8];
        if (tk.T == TL) {
            const float pos = (float)(colaxis ? (tk.t & 63) : (tk.t >> 6));
#pragma unroll
            for (int i = 0; i < 8; ++i) __sincosf(pos * q.invf[i], &sn[i], &cs[i]);
        }
#pragma unroll
        for (int isk = 0; isk < 2; ++isk) {
            const u32x4 raw = *(const u32x4*)(zr + isk * 512 + lane * 8);
            float x[8];
#pragma unroll
            for (int i = 0; i < 4; ++i) { x[2 * i] = __builtin_bit_cast(float, raw[i] << 16); x[2 * i + 1] = __builtin_bit_cast(float, raw[i] & 0xffff0000u); }
            float ss = 0.f;
#pragma unroll
            for (int i = 0; i < 8; ++i) ss += x[i] * x[i];
            ss += __shfl_xor(ss, 1); ss += __shfl_xor(ss, 2); ss += __shfl_xor(ss, 4);
            const float rs = rsqrtf(ss * (1.0f / 64.0f) + 1e-6f);
#pragma unroll
            for (int i = 0; i < 8; ++i) x[i] = x[i] * rs * (isk ? q.kn[i] : q.qn[i] * att::QSCALE);
            if (tk.T == TL) {
#pragma unroll
                for (int i = 0; i < 8; ++i) { const float other = __shfl_xor(x[i], 2); x[i] = upper ? (x[i] * cs[i] + other * sn[i]) : (x[i] * cs[i] - other * sn[i]); }
            }
            u32x4 o; o.x = pk2(x[0], x[1]); o.y = pk2(x[2], x[3]); o.z = pk2(x[4], x[5]); o.w = pk2(x[6], x[7]);
            if (isk) *(u32x4*)(KB + krow * 512 + lane * 8) = o; else *(u32x4*)(QB + (size_t)g * 512 + lane * 8) = o;
        }
    }
}
__device__ __forceinline__ void ph_wkv_fused(const Args& A, int j, int row_lo, LAS unsigned char* lds, int bid, int nb) {
    unsigned char* ws = opq(A.ws); const float* const* IN = (const float* const*)(ws + WS_PTRS);
    const int tid = tid_opaque(), lane = tid & 63, wid = __builtin_amdgcn_readfirstlane(tid >> 6), c16 = lane & 15, g4 = lane >> 4;
    bf16_t* YS = (bf16_t*)(ws + WS_YS); const size_t FS = (size_t)NTOK * 512;
    constexpr int RING = 8 * WKV_REC, NRND = WKV_NCH / 4;
    static_assert(WKV_NCH % 4 == 0, "four chunks per round");
#define WKV_WGBAR() do { asm volatile("s_waitcnt lgkmcnt(0)" ::: "memory"); __builtin_amdgcn_s_barrier(); asm volatile("" ::: "memory"); } while (0)
    for (int inst = bid; inst < 256; inst += nb) {
        const int dir = inst & 1, h = (inst >> 1) & 7, b = inst >> 4;
        WKV_WGBAR();
        if (wid >= 4) {
            LAS unsigned char* wl = lds + RING + (wid - 4) * 13824;
            float kap[16];
            { const float* kp = INP(I_RWKA) + j * 512 + h * 64 + 16 * g4;
#pragma unroll
              for (int i = 0; i < 16; ++i) kap[i] = kp[i]; }
            for (int r = 0; r < NRND; ++r) {
                wkv_produce(ws, kap, b, h, dir, 4 * r + (wid - 4), wl, lds + ((r & 1) * 4 + (wid - 4)) * WKV_REC, lane);
                WKV_WGBAR();
            }
            WKV_WGBAR();
        } else {
            const int v0 = wid * 16;
            bf16_t* Y = YS + dir * FS + h * 64 + v0 + (c16 & ~1); const bool oddl = (c16 & 1) != 0;
            f32x4 S[4];
#pragma unroll
            for (int mt = 0; mt < 4; ++mt) S[mt] = (f32x4){0.f, 0.f, 0.f, 0.f};
            QkC qc; qk_init(qc, IN, j, lane);
            WKV_WGBAR();
            for (int r = 0; r < NRND; ++r) {
                for (int k = 0; k < 4; ++k) {
                    const int c = 4 * r + k;
                    const LAS unsigned char* rec = lds + ((r & 1) * 4 + k) * WKV_REC;
                    u32x2 a2[4], rt[4], bt[4], kt[4]; f32x4 p[4];
    #pragma unroll
                    for (int q = 0; q < 4; ++q) {
                        a2[q] = *(const LAS u32x2*)(rec + R_A2 + (c16 * 64 + 16 * q + 4 * g4) * 2);
                        rt[q] = *(const LAS u32x2*)(rec + R_RT + (c16 * 64 + 16 * q + 4 * g4) * 2);
                        bt[q] = *(const LAS u32x2*)(rec + R_BT + ((16 * q + c16) * 16 + 4 * g4) * 2);
                        kt[q] = *(const LAS u32x2*)(rec + R_KT + ((16 * q + c16) * 16 + 4 * g4) * 2);
                        p[q] = *(const LAS f32x4*)(rec + R_P + (16 * q + 4 * g4) * 4);
                    }
                    const u32x2 gq = *(const LAS u32x2*)(rec + R_G + (c16 * 16 + 4 * g4) * 2), mkr = *(const LAS u32x2*)(rec + R_MKR + (c16 * 16 + 4 * g4) * 2), mbr = *(const LAS u32x2*)(rec + R_MBR + (c16 * 16 + 4 * g4) * 2);
                    const u32x2 vt = *(const LAS u32x2*)(rec + R_VT + ((v0 + c16) * 16 + 4 * g4) * 2);
                    const f32x4 z4 = {0.f, 0.f, 0.f, 0.f};
                    const bf16x8 sb0 = frag8(pack4(S[0]), pack4(S[1])), sb1 = frag8(pack4(S[2]), pack4(S[3]));
                    const bf16x8 vb = frag4(vt);
                    f32x4 U = __builtin_amdgcn_mfma_f32_16x16x32_bf16(frag4(gq), vb, z4, 0, 0, 0);
                    U = __builtin_amdgcn_mfma_f32_16x16x32_bf16(frag8(a2[0], a2[1]), sb0, U, 0, 0, 0);
                    U = __builtin_amdgcn_mfma_f32_16x16x32_bf16(frag8(a2[2], a2[3]), sb1, U, 0, 0, 0);
                    f32x4 Yt = __builtin_amdgcn_mfma_f32_16x16x32_bf16(frag4(mkr), vb, z4, 0, 0, 0);
                    Yt = __builtin_amdgcn_mfma_f32_16x16x32_bf16(frag8(rt[0], rt[1]), sb0, Yt, 0, 0, 0);
                    Yt = __builtin_amdgcn_mfma_f32_16x16x32_bf16(frag8(rt[2], rt[3]), sb1, Yt, 0, 0, 0);
                    const bf16x8 ub = frag4(pack4(U));
                    Yt = __builtin_amdgcn_mfma_f32_16x16x32_bf16(frag4(mbr), ub, Yt, 0, 0, 0);
    #pragma unroll
                    for (int mt = 0; mt < 4; ++mt) {
                        f32x4 sn = __builtin_amdgcn_mfma_f32_16x16x32_bf16(frag4(kt[mt]), vb, S[mt], 0, 0, 0);
                        sn = __builtin_amdgcn_mfma_f32_16x16x32_bf16(frag4(bt[mt]), ub, sn, 0, 0, 0);
                        S[mt] = sn * p[mt];
                    }
    #pragma unroll
                    for (int q = 0; q < 2; ++q) {
                        const float send = oddl ? Yt[q] : Yt[2 + q], mine = oddl ? Yt[2 + q] : Yt[q];
                        const float recv = __builtin_bit_cast(float, __builtin_amdgcn_update_dpp(0, __builtin_bit_cast(int, send), 0xB1, 0xF, 0xF, false));
                        *(unsigned*)(Y + (size_t)wkv_token(b, dir, c * 16 + 4 * g4 + (oddl ? 2 + q : q)) * 512) = oddl ? cvtpk_s(recv, mine) : cvtpk_s(mine, recv);
                    }
                }
                if (inst == bid) {
                    for (int g = row_lo + bid * 4 + wid + r * (nb * 4); g < NTOK; g += nb * 4 * NRND) qk_token(qc, ws, g, lane);
                }
                WKV_WGBAR();
            }
        }
    }
#undef WKV_WGBAR
}

__device__ __forceinline__ void ph_attn(const Args& A, bool want_ctx, LAS unsigned char* lds, int bid, int nb) {
    unsigned char* ws = opq(A.ws);
    const bf16_t* QB = (const bf16_t*)(ws + WS_QB); const bf16_t* KB = (const bf16_t*)(ws + WS_KB); const bf16_t* VB = (const bf16_t*)(ws + WS_VB);
    bf16_t* OP = (bf16_t*)(ws + WS_OP);
    const int vcu = (nb % 8 == 0) ? (bid % 8) * (nb / 8) + bid / 8 : bid;
    const int nunits = 1024 + (want_ctx ? 128 : 0);
    for (int u = vcu; u < nunits; u += nb) {
        int b, h, m, q0, seq;
        if (u < 1024) { const int qb = u & 7; m = (u >> 3) & 1; h = (u >> 4) & 3; b = u >> 6; q0 = NCTX + b * TL + qb * 256; seq = TC + TL; }
        else { const int v = u - 1024; m = v & 1; h = (v >> 1) & 3; b = v >> 3; q0 = b * TC; seq = TC; }
        const int s = h * 2 + m;
        att::attn_body(QB + (size_t)q0 * 512 + s * 64, KB + (size_t)b * (TC + TL) * 512 + s * 64, VB + (size_t)b * (TC + TL) * 512 + h * 128,
                       OP + (size_t)m * NTOK * 512 + (size_t)q0 * 512 + h * 128, seq, lds);
    }
}

__device__ __forceinline__ void ph_merge(const Args& A, int l, int row_lo, int bid, int nb) {
    unsigned char* ws = opq(A.ws); const float* const* IN = (const float* const*)(ws + WS_PTRS);
    const int j = l >> 1;
    const int tid = tid_opaque(), lane = tid & 63, wid = tid >> 6, c0 = lane * 8;
    const float lam_init = 0.8f - 0.6f * __expf(-0.3f * (float)l);
    const float* lp = INP(I_LAM) + j * 4 * 64;
    const float lam = __expf(wave_sum(lp[lane] * lp[64 + lane])) - __expf(wave_sum(lp[128 + lane] * lp[192 + lane])) + lam_init;
    const size_t FS = (size_t)NTOK * 512;
    const bf16_t* RB = (const bf16_t*)(ws + WS_RB); const bf16_t* KS = (const bf16_t*)(ws + WS_KS); const bf16_t* VS = (const bf16_t*)(ws + WS_VS);
    const bf16_t* AB = (const bf16_t*)(ws + WS_AB); const bf16_t* GB = (const bf16_t*)(ws + WS_GB);
    const bf16_t* YS = (const bf16_t*)(ws + WS_YS); const bf16_t* OP = (const bf16_t*)(ws + WS_OP);
    bf16_t* CAT = (bf16_t*)(ws + WS_CAT);
    float gnw[8], gnb[8], kaw[8], rkw[8], sub[8];
#pragma unroll
    for (int i = 0; i < 8; ++i) { gnw[i] = INP(I_GNW)[j * 512 + c0 + i]; gnb[i] = INP(I_GNB)[j * 512 + c0 + i]; kaw[i] = INP(I_RWKA)[j * 512 + c0 + i]; rkw[i] = INP(I_RWRK)[j * 512 + c0 + i];
        sub[i] = INP(I_SUBLN)[j * 128 + ((c0 + i) & 127)] * (1.0f - lam_init); }
#define LD8BF(dst, ptr) do { const u32x4 _t = *(const u32x4*)(ptr); _Pragma("unroll") for (int _i = 0; _i < 4; ++_i) { dst[2 * _i] = __builtin_bit_cast(float, _t[_i] << 16); dst[2 * _i + 1] = __builtin_bit_cast(float, _t[_i] & 0xffff0000u); } } while (0)
#define CV8BF(dst, _t) do { _Pragma("unroll") for (int _i = 0; _i < 4; ++_i) { dst[2 * _i] = __builtin_bit_cast(float, _t[_i] << 16); dst[2 * _i + 1] = __builtin_bit_cast(float, _t[_i] & 0xffff0000u); } } while (0)
#define MLOAD(P, gi) do { const size_t _o = (size_t)(gi) * 512 + c0; \
        P##y = __builtin_nontemporal_load((const u32x4*)(YS + _o)); P##z = __builtin_nontemporal_load((const u32x4*)(YS + FS + _o)); \
        P##r = __builtin_nontemporal_load((const u32x4*)(RB + _o)); P##k = __builtin_nontemporal_load((const u32x4*)(KS + _o)); P##v = __builtin_nontemporal_load((const u32x4*)(VS + _o)); P##a0 = __builtin_nontemporal_load((const u32x4*)(AB + _o)); P##a1 = __builtin_nontemporal_load((const u32x4*)(AB + FS + _o)); P##g = __builtin_nontemporal_load((const u32x4*)(GB + _o)); \
        P##p = __builtin_nontemporal_load((const u32x4*)(OP + _o)); P##q = __builtin_nontemporal_load((const u32x4*)(OP + FS + _o)); } while (0)
    const int gstep = nb * NWAVES;
    int g = row_lo + bid * NWAVES + wid;
    u32x4 c_y, c_z, c_p, c_q, c_r, c_k, c_v, c_a0, c_a1, c_g;
    if (g < NTOK) MLOAD(c_, g);
    for (; g < NTOK; g += gstep) {
        u32x4 n_y, n_z, n_p, n_q, n_r, n_k, n_v, n_a0, n_a1, n_g;
        { const int gn = (g + gstep < NTOK) ? g + gstep : g; MLOAD(n_, gn); }
        float y[8], r_[8], k_[8], v_[8], a0[8], a1[8], gg[8];
        { float yb[8]; CV8BF(y, c_y); CV8BF(yb, c_z);
#pragma unroll
          for (int i = 0; i < 8; ++i) y[i] += yb[i]; }
        CV8BF(r_, c_r); CV8BF(k_, c_k); CV8BF(v_, c_v); CV8BF(a0, c_a0); CV8BF(a1, c_a1); CV8BF(gg, c_g);
        float sy = 0.f, sb = 0.f;
#pragma unroll
        for (int i = 0; i < 8; ++i) { sy += y[i]; sb += r_[i] * k_[i] * (2.0f + (a0[i] + a1[i] - 2.0f) * kaw[i]) * rkw[i]; }
        sy += __shfl_xor(sy, 1); sy += __shfl_xor(sy, 2); sy += __shfl_xor(sy, 4);
        sb += __shfl_xor(sb, 1); sb += __shfl_xor(sb, 2); sb += __shfl_xor(sb, 4);
        const float mu = sy * (1.0f / 64.0f);
        float sv = 0.f;
#pragma unroll
        for (int i = 0; i < 8; ++i) { y[i] -= mu; sv += y[i] * y[i]; }
        sv += __shfl_xor(sv, 1); sv += __shfl_xor(sv, 2); sv += __shfl_xor(sv, 4);
        const float rstd = rsqrtf(sv * (1.0f / 64.0f) + 64e-5f);
        float ya[8];
#pragma unroll
        for (int i = 0; i < 8; ++i) ya[i] = (y[i] * rstd * gnw[i] + gnb[i] + sb * v_[i]) * gg[i];
        { u32x4 w; w.x = pk2(ya[0], ya[1]); w.y = pk2(ya[2], ya[3]); w.z = pk2(ya[4], ya[5]); w.w = pk2(ya[6], ya[7]); *(u32x4*)(CAT + (size_t)g * DM + c0) = w; }
        float od[8];
        { float ob[8]; CV8BF(od, c_p); CV8BF(ob, c_q);
#pragma unroll
          for (int i = 0; i < 8; ++i) od[i] -= lam * ob[i]; }
        float so = 0.f;
#pragma unroll
        for (int i = 0; i < 8; ++i) so += od[i] * od[i];
        so += __shfl_xor(so, 1); so += __shfl_xor(so, 2); so += __shfl_xor(so, 4); so += __shfl_xor(so, 8);
        const float ro = rsqrtf(so * (1.0f / 128.0f) + 1e-6f);
        { u32x4 w; w.x = pk2(od[0] * ro * sub[0], od[1] * ro * sub[1]); w.y = pk2(od[2] * ro * sub[2], od[3] * ro * sub[3]);
          w.z = pk2(od[4] * ro * sub[4], od[5] * ro * sub[5]); w.w = pk2(od[6] * ro * sub[6], od[7] * ro * sub[7]); *(u32x4*)(CAT + (size_t)g * DM + 512 + c0) = w; }
        c_y = n_y; c_z = n_z; c_p = n_p; c_q = n_q;
        c_r = n_r; c_k = n_k; c_v = n_v; c_a0 = n_a0; c_a1 = n_a1; c_g = n_g;
    }
#undef MLOAD
#undef CV8BF
#undef LD8BF
}

__device__ __forceinline__ void ph_gemm_out(const Args& A, int l, size_t x_off, size_t wt_off, int row_lo, LAS unsigned char* lds, int bid, int nb) {
    unsigned char* ws = opq(A.ws); const float* const* IN = (const float* const*)(ws + WS_PTRS); (void)IN;
    pg8::Gemm g{(const bf16_t*)(ws + x_off) + (size_t)row_lo * DM, (const bf16_t*)(ws + wt_off), NTOK - row_lo, DM, DM};
    const ListOrder S = build_units(lds, (NTOK - row_lo) / 256, DM / 256, nb, bid, nullptr, 0);
    EpiResidual E{(bf16_t*)(ws + WS_H) + (size_t)row_lo * DM, (const float*)(ws + WS_MOD) + (size_t)l * 17 * 6144 + 2 * 1024, row_lo};
    pg8::gemm_phase<EpiResidual, ListOrder, true, true>(lds, g, S, E);
}

__device__ __forceinline__ void ph_gemm_sgin(const Args& A, int j, int row_lo, LAS unsigned char* lds, int bid, int nb) {
    unsigned char* ws = opq(A.ws); const float* const* IN = (const float* const*)(ws + WS_PTRS); (void)IN;
    pg8::Gemm g{(const bf16_t*)(ws + WS_ABF) + (size_t)row_lo * DM, (const bf16_t*)(ws + WS_SGIN) + (size_t)j * 2048 * DM, NTOK - row_lo, 2048, DM};
    const ListOrder S = build_units(lds, (NTOK - row_lo) / 256, 2048 / 256, nb, bid, nullptr, 0);
    EpiGeluBf16 E{(bf16_t*)(ws + WS_Z2) + (size_t)row_lo * 2048, 2048, INP(I_SGBIN) + j * 2048};
    pg8::gemm_phase<EpiGeluBf16, ListOrder, true, true>(lds, g, S, E);
}
__device__ __forceinline__ void ph_sgu_stats(const Args& A, int row_lo, int bid, int nb) {
    unsigned char* ws = opq(A.ws);
    const int tid = tid_opaque(), lane = tid & 63, wid = tid >> 6;
    const bf16_t* Z2 = (const bf16_t*)(ws + WS_Z2); float* ST = (float*)(ws + WS_VST);
    for (int row = row_lo + bid * NWAVES + wid; row < NTOK; row += nb * NWAVES) {
        const u32x4 t0 = *(const u32x4*)(Z2 + (size_t)row * 2048 + 1024 + lane * 8), t1 = *(const u32x4*)(Z2 + (size_t)row * 2048 + 1536 + lane * 8);
        float v[16]; float s = 0.f;
#pragma unroll
        for (int i = 0; i < 4; ++i) { v[2 * i] = __builtin_bit_cast(float, t0[i] << 16); v[2 * i + 1] = __builtin_bit_cast(float, t0[i] & 0xffff0000u);
            v[8 + 2 * i] = __builtin_bit_cast(float, t1[i] << 16); v[9 + 2 * i] = __builtin_bit_cast(float, t1[i] & 0xffff0000u); }
#pragma unroll
        for (int i = 0; i < 16; ++i) s += v[i];
        const float mean = wave_sum(s) * (1.0f / 1024.0f); float s2 = 0.f;
#pragma unroll
        for (int i = 0; i < 16; ++i) { const float d = v[i] - mean; s2 += d * d; }
        const float rstd = rsqrtf(wave_sum(s2) * (1.0f / 1024.0f) + 1e-5f);
        if (lane == 0) { ST[(size_t)row * 2] = mean; ST[(size_t)row * 2 + 1] = rstd; }
    }
}
__device__ __forceinline__ void ph_sgu_spatial(const Args& A, int j, int row_lo, LAS unsigned char* lds, int bid, int nb) {
    unsigned char* ws = opq(A.ws); const float* const* IN = (const float* const*)(ws + WS_PTRS);
    const int tid = tid_opaque(), lane = tid & 63, wid = tid >> 6, c16 = lane & 15, g4 = lane >> 4;
    const bf16_t* Z2 = (const bf16_t*)(ws + WS_Z2); const float* ST = (const float*)(ws + WS_VST); bf16_t* G = (bf16_t*)(ws + WS_G);
    constexpr int VS = 272;
    LAS unsigned char* vt = lds;
    LAS float* stl = (LAS float*)(lds + 36864);
    const int ch0 = row_lo / 128, nch = NTOK / 128 - ch0;
    for (int u = bid; u < nch * 8; u += nb) {
        const int ci = ch0 + u / 8, g = u % 8;
        const size_t r0 = (size_t)ci * 128;
        __syncthreads();
#pragma unroll
        for (int i = 0; i < 4; ++i) {
            const int idx = tid + NTHREADS * i, q = idx >> 4, jc = idx & 15;
            const u32x4 t = *(const u32x4*)(Z2 + (r0 + q) * 2048 + 1024 + g * 128 + jc * 8);
#pragma unroll
            for (int e = 0; e < 4; ++e) {
                const int c = jc * 8 + 2 * e, w = c & 31, rho = 16 * (2 * (c >> 5) + ((w >> 2) & 1)) + 4 * (w >> 3) + (w & 3);
                *(LAS bf16_t*)(vt + rho * VS + q * 2) = (bf16_t)(t[e] & 0xffffu); *(LAS bf16_t*)(vt + (rho + 1) * VS + q * 2) = (bf16_t)(t[e] >> 16); }
        }
        if (tid < 256) stl[tid] = ST[r0 * 2 + tid];
        __syncthreads();
        const float* wrow = INP(I_SGWS) + (((size_t)j * 8 + g) * 128 + 16 * wid + c16) * 128;
        bf16x8 af[4]; float wm = 0.f, rs = 0.f;
#pragma unroll
        for (int ks = 0; ks < 4; ++ks) {
            const int q0 = 32 * ks + 8 * g4;
            const f32x4 w0 = *(const f32x4*)(wrow + q0), w1 = *(const f32x4*)(wrow + q0 + 4);
            float wv[8] = {w0[0], w0[1], w0[2], w0[3], w1[0], w1[1], w1[2], w1[3]};
#pragma unroll
            for (int e = 0; e < 8; ++e) { rs += wv[e]; wv[e] *= stl[(q0 + e) * 2 + 1]; wm += wv[e] * stl[(q0 + e) * 2]; }
            const u32x4 pk = {pk2(wv[0], wv[1]), pk2(wv[2], wv[3]), pk2(wv[4], wv[5]), pk2(wv[6], wv[7])};
            af[ks] = __builtin_bit_cast(bf16x8, pk);
        }
        wm += __shfl_xor(wm, 16); wm += __shfl_xor(wm, 32); rs += __shfl_xor(rs, 16); rs += __shfl_xor(rs, 32);
        f32x4 acc[8];
#pragma unroll
        for (int nt = 0; nt < 8; ++nt) acc[nt] = (f32x4){0.f, 0.f, 0.f, 0.f};
#pragma unroll
        for (int ks = 0; ks < 4; ++ks)
#pragma unroll
            for (int nt = 0; nt < 8; ++nt) {
                const bf16x8 bfr = *(const LAS bf16x8*)(vt + (16 * nt + c16) * VS + (32 * ks + 8 * g4) * 2);
                acc[nt] = __builtin_amdgcn_mfma_f32_16x16x32_bf16(bfr, af[ks], acc[nt], 0, 0, 0);
            }
        const float bs = INP(I_SGBS)[((size_t)j * 8 + g) * 128 + 16 * wid + c16];
        const size_t row = r0 + 16 * wid + c16;
#pragma unroll
        for (int k = 0; k < 4; ++k) {
            const int c = g * 128 + 32 * k + 8 * g4;
            const f32x4 lg0 = *(const f32x4*)(INP(I_SGLNG) + j * 1024 + c), lg1 = *(const f32x4*)(INP(I_SGLNG) + j * 1024 + c + 4), lb0 = *(const f32x4*)(INP(I_SGLNB) + j * 1024 + c), lb1 = *(const f32x4*)(INP(I_SGLNB) + j * 1024 + c + 4);
            const u32x4 uu = *(const u32x4*)(Z2 + row * 2048 + c);
            const f32x4 s0 = lg0 * (acc[2 * k] - wm) + lb0 * rs + bs, s1 = lg1 * (acc[2 * k + 1] - wm) + lb1 * rs + bs;
            u32x4 o;
            o.x = cvtpk_s(bflo(uu.x) * s0[0], bfhi(uu.x) * s0[1]); o.y = cvtpk_s(bflo(uu.y) * s0[2], bfhi(uu.y) * s0[3]);
            o.z = cvtpk_s(bflo(uu.z) * s1[0], bfhi(uu.z) * s1[1]); o.w = cvtpk_s(bflo(uu.w) * s1[2], bfhi(uu.w) * s1[3]);
            *(u32x4*)(G + row * DM + c) = o;
        }
    }
}

__device__ __forceinline__ int moe_layout(const Args& A, int l, int bid, int nb, LAS int* off  , LAS int* cntl  , LAS int* tile_e  , LAS int* base  ) {
    const int tid = tid_opaque();
    const int* bc = (const int*)(opq(A.ws) + WS_BCNT) + (size_t)l * 256 * 32;
    if (tid < 32) { cntl[tid] = 0; base[tid] = 0; }
    __syncthreads();
    {
        const int e = tid & 31, g = tid >> 5, per = (nb + 15) >> 4, b0 = g * per, b1 = (b0 + per < nb) ? b0 + per : nb;
        int n = 0, pre = 0;
#pragma unroll 16
        for (int b = b0; b < b1; ++b) { const int c = bc[b * 32 + e]; n += c; pre += (b < bid) ? c : 0; }
        __hip_atomic_fetch_add(cntl + e, n, __ATOMIC_RELAXED, __HIP_MEMORY_SCOPE_WORKGROUP);
        __hip_atomic_fetch_add(base + e, pre, __ATOMIC_RELAXED, __HIP_MEMORY_SCOPE_WORKGROUP);
    }
    __syncthreads();
    if (tid < 64) {
        int n = 0, pre = 0;
        if (tid < 32) { n = cntl[tid]; pre = base[tid]; }
        const int nt = (n + 255) >> 8;
        int x = nt;
#pragma unroll
        for (int o = 1; o < 32; o <<= 1) { const int y = __shfl_up(x, o); if (tid >= o) x += y; }
        const int start = x - nt;
        if (tid < 32) {
            cntl[tid] = n; off[tid] = start * 256; base[tid] = start * 256 + pre;
#pragma unroll 1
            for (int t = 0; t < nt; ++t) tile_e[start + t] = tid;
        }
        if (tid == 31) off[32] = x * 256;
    }
    __syncthreads();
    return off[32] >> 8;
}
__device__ __forceinline__ void ph_moe_scatter(const Args& A, int l, int row_lo, LAS unsigned char* lds, int bid, int nb) {
    unsigned char* ws = opq(A.ws);
    const int tid = tid_opaque();
    LAS int* off = (LAS int*)(lds + LDS_TAB); LAS int* cntl = off + 64; LAS int* tile_e = off + 128; LAS int* base = off + 800;
    moe_layout(A, l, bid, nb, off, cntl, tile_e, base);
    const int* te = (const int*)(ws + WS_TOKE); const int* tr = (const int*)(ws + WS_TOKR); int* rowof = (int*)(ws + WS_ROWOF); int* srcrow = (int*)(ws + WS_SRCROW);
    const int ngroups = (NTOK - row_lo) / 16, per = nb * NWAVES;
    const int nextra = (ngroups > per + bid) ? (ngroups - per - bid + nb - 1) / nb : 0;
    for (int q = tid; q < (NWAVES + nextra) * 64; q += NTHREADS) {
        const int slot = q >> 6, r = (q >> 2) & 15, k = q & 3;
        const int u = slot < NWAVES ? bid * NWAVES + slot : per + bid + (slot - NWAVES) * nb;
        if (u < ngroups && (slot >= NWAVES || u < per)) {
            const int row = row_lo + 16 * u + r;
            const int e = te[(size_t)row * 4 + k];
            const int pos = base[e] + tr[(size_t)row * 4 + k];
            rowof[(size_t)row * 4 + k] = pos; srcrow[pos] = row;
        }
    }
    for (int e = bid; e < 32; e += nb) {
        const int r0 = off[e] + cntl[e], r1 = off[e + 1];
        for (int i = r0 + tid; i < r1; i += NTHREADS) srcrow[i] = NCTX;
    }
}
__device__ __forceinline__ void ph_moe_gemm1(const Args& A, int l, LAS unsigned char* lds, int bid, int nb) {
    unsigned char* ws = opq(A.ws); const float* const* IN = (const float* const*)(ws + WS_PTRS); (void)IN;
    LAS int* off = (LAS int*)(lds + LDS_TAB); LAS int* cntl = off + 64; LAS int* tile_e = off + 128; LAS int* base = off + 800;
    const int T = moe_layout(A, l, bid, nb, off, cntl, tile_e, base);
    int Kq = DM / 2; asm volatile("" : "+s"(Kq));
    pg8::Gemm g{(const bf16_t*)(ws + WS_ABF), (const bf16_t*)(ws + WS_W1 + (size_t)l * NE * 2048 * DM), T * 256, 2048, Kq};
    const ListOrder S = build_units(lds, T, 8, nb, bid, tile_e, 8);
    { LAS unsigned* rowtab = (LAS unsigned*)(lds + LDS_ROWTAB); const int* srcrow = (const int*)(ws + WS_SRCROW); const int tid = tid_opaque();
      for (int q = tid; q < S.n * 256; q += NTHREADS) rowtab[q] = (unsigned)srcrow[S.list[2 * (q >> 8)] * 256 + (q & 255)] * (unsigned)DM;
      __syncthreads(); }
    EpiMoe1 E{(bf16_t*)(ws + WS_ACT), INP(I_B1) + (size_t)l * NE * 2048};
    pg8::gemm_phase<EpiMoe1, ListOrder, true, true, true, true>(lds, g, S, E);
}
__device__ __forceinline__ void ph_moe_gemm2(const Args& A, int l, LAS unsigned char* lds, int bid, int nb) {
    unsigned char* ws = opq(A.ws); const float* const* IN = (const float* const*)(ws + WS_PTRS); (void)IN;
    LAS int* off = (LAS int*)(lds + LDS_TAB); LAS int* cntl = off + 64; LAS int* tile_e = off + 128; LAS int* base = off + 800;
    const int T = moe_layout(A, l, bid, nb, off, cntl, tile_e, base);
    int Kq = DM / 2; asm volatile("" : "+s"(Kq));
    pg8::Gemm g{(const bf16_t*)(ws + WS_ACT), (const bf16_t*)(ws + WS_W2 + (size_t)l * NE * DM * DM), T * 256, DM, Kq, 0x77777777, (int)0x81818181u};
    const ListOrder S = build_units(lds, T, 4, nb, bid, tile_e, 4);
    LAS float* btab = (LAS float*)(lds + LDS_ROWTAB);
    { const float* b2 = INP(I_B2) + (size_t)l * NE * DM; const int tid = tid_opaque();
      for (int q = tid; q < S.n * 256; q += NTHREADS) { const int png = S.list[2 * (q >> 8) + 1]; btab[q] = 16.0f * b2[(size_t)(png >> 2) * DM + (png & 3) * 256 + (q & 255)]; }
      __syncthreads(); }
    EpiMoe2 E{ws + WS_YM, btab};
    pg8::gemm_phase<EpiMoe2, ListOrder, true, true, false, true, true>(lds, g, S, E);
}
__device__ __forceinline__ void ph_moe_combine(const Args& A, int l, int row_lo, bool last, int bid, int nb, bool dry = false) {
    unsigned char* ws = opq(A.ws); const float* const* IN = (const float* const*)(ws + WS_PTRS);
    const int tid = tid_opaque(), lane = tid & 63, wid = tid >> 6;
    bf16_t* H = (bf16_t*)(ws + WS_H); const float* mod = (const float*)(ws + WS_MOD); const bf16_t* YM = (const bf16_t*)(ws + WS_YM);
    bf16_t* Hw = dry ? (bf16_t*)(ws + WS_XP) : H;
    const int* rowof = (const int*)(ws + WS_ROWOF); const float* tg = (const float*)(ws + WS_TOKG);
    bf16_t* abf = dry ? (bf16_t*)(ws + WS_XP + (size_t)NTOK * DM * 4) : (bf16_t*)(ws + WS_ABF);
    const int ln = last ? l : l + 1;
    const float* gp = INP(I_N1G) + ln * 1024;
    for (int row = row_lo + bid * NWAVES + wid; row < NTOK; row += nb * NWAVES) {
        const Tok tk = tokinfo(row);
        const float* gate = mod + ((size_t)l * 17 + tk.modrow) * 6144 + 5 * 1024;
        int r[4]; float gk[4];
#pragma unroll
        for (int k = 0; k < 4; ++k) { r[k] = rowof[(size_t)row * 4 + k]; gk[k] = tg[(size_t)row * 4 + k]; }
        const unsigned char* YM8 = (const unsigned char*)YM;
        u32x4 y[4];
#pragma unroll
        for (int k = 0; k < 4; ++k) { y[k] = *(const u32x4*)(YM8 + (size_t)r[k] * DM + lane * 16); gk[k] *= (1.0f / 16.0f); }
        const int col = lane * 16;
        f32x4 hv[4]; float ss = 0.f;
        const u32x4 hb0 = *(const u32x4*)(H + (size_t)row * DM + col), hb1 = *(const u32x4*)(H + (size_t)row * DM + col + 8);
#pragma unroll
        for (int q = 0; q < 4; ++q) {
            f32x4 m = (f32x4){0.f, 0.f, 0.f, 0.f};
#pragma unroll
            for (int k = 0; k < 4; ++k) { const auto lo2 = __builtin_amdgcn_cvt_pk_f32_fp8((int)y[k][q], false), hi2 = __builtin_amdgcn_cvt_pk_f32_fp8((int)y[k][q], true);
                m = m + (f32x4){lo2[0], lo2[1], hi2[0], hi2[1]} * gk[k]; }
            { const unsigned h0 = (q >> 1) ? hb1[2 * (q & 1)] : hb0[2 * (q & 1)], h1 = (q >> 1) ? hb1[2 * (q & 1) + 1] : hb0[2 * (q & 1) + 1];
              hv[q] = (f32x4){bflo(h0), bfhi(h0), bflo(h1), bfhi(h1)} + *(const f32x4*)(gate + col + 4 * q) * m; }
            if (last && !dry) *(f32x4*)(as_global(((float* const*)IN)[38]) + (size_t)(row - NCTX) * DM + col + 4 * q) = hv[q];
            ss += (hv[q].x * hv[q].x + hv[q].y * hv[q].y) + (hv[q].z * hv[q].z + hv[q].w * hv[q].w);
        }
        if (!last || dry) { *(u32x4*)(Hw + (size_t)row * DM + col) = (u32x4){pk2(hv[0].x, hv[0].y), pk2(hv[0].z, hv[0].w), pk2(hv[1].x, hv[1].y), pk2(hv[1].z, hv[1].w)};
                            *(u32x4*)(Hw + (size_t)row * DM + col + 8) = (u32x4){pk2(hv[2].x, hv[2].y), pk2(hv[2].z, hv[2].w), pk2(hv[3].x, hv[3].y), pk2(hv[3].z, hv[3].w)}; }
        if (!last) {
            const float rstd = rsqrtf(wave_sum(ss) * (1.0f / DM) + 1e-6f);
            const float* mrow = mod + ((size_t)ln * 17 + tk.modrow) * 6144;
            u32x4 o[2];
#pragma unroll
            for (int q = 0; q < 4; ++q) {
                const f32x4 g = *(const f32x4*)(gp + col + 4 * q), sc = *(const f32x4*)(mrow + 1024 + col + 4 * q), sh = *(const f32x4*)(mrow + col + 4 * q);
                const f32x4 v = (hv[q] * rstd * g) * (sc + 1.0f) + sh;
                o[q >> 1][2 * (q & 1)] = pk2(v.x, v.y); o[q >> 1][2 * (q & 1) + 1] = pk2(v.z, v.w);
            }
            *(u32x4*)(abf + (size_t)row * DM + col) = o[0]; *(u32x4*)(abf + (size_t)row * DM + col + 8) = o[1];
        }
    }
}

__global__ void __launch_bounds__(NTHREADS, 2) fwd_kernel(Args A) {
    extern __shared__ __attribute__((aligned(16))) unsigned char lds_raw[];
    LAS unsigned char* lds = (LAS unsigned char*)lds_raw;
    volatile LAS unsigned* misc = (volatile LAS unsigned*)(lds + LDS_MISC);
    const int tid = threadIdx.x, bid = blockIdx.x, nb = gridDim.x;
    if (tid < 64) misc[tid] = 0u;
    __syncthreads();
    XcdBarrier bar = xcd_barrier_post((unsigned*)(A.ws + WS_CTL) + CW_BAR, misc + 8);
    const int lo = A.ph_lo, hi = A.ph_hi;
    int pc = 0;
#ifndef PHSEL
#define PHSEL -1
#endif
#define SEL(k) (PHSEL < 0 || PHSEL == (k))
#ifndef REPEAT_MASK
#define REPEAT_MASK 0
#endif
#define RUN(k, call) do { if (SEL(k)) { call; if ((REPEAT_MASK >> (k)) & 1) { xcd_barrier(bar); call; } } } while (0)
#define PH_BEGIN if (pc >= lo && pc < hi) {
#define PH_END } if (pc >= lo && pc + 1 < hi) xcd_barrier(bar); ++pc;

    PH_BEGIN RUN(0, ph_prologue(A, lds, bid, nb)); PH_END

    for (int l = 0; l < 4; ++l) {
        const int j = l >> 1;
        const bool ctx_out = (l < 2), ctx_in = (l < 3);
        const int rin = ctx_in ? 0 : NCTX, rout = ctx_out ? 0 : NCTX;
        if (l == 0) { PH_BEGIN RUN(1, ph_norm<false>(A, l, rin, lds, bid, nb)); PH_END }
        if ((l & 1) == 0) {
            PH_BEGIN RUN(2, ph_gemm_win(A, j, rin, lds, bid, nb)); PH_END
            PH_BEGIN RUN(3, ph_rwkv_pre(A, j, rin, bid, nb)); PH_END
            PH_BEGIN RUN(19, ph_gemm_lora(A, j, rin, lds, bid, nb)); PH_END
            PH_BEGIN RUN(5, ph_wkv_fused(A, j, rin, lds, bid, nb)); PH_END
            PH_BEGIN RUN(6, ph_attn(A, ctx_out, lds, bid, nb)); PH_END
            PH_BEGIN RUN(7, ph_merge(A, l, rout, bid, nb)); PH_END
            PH_BEGIN RUN(8, ph_gemm_out(A, l, WS_CAT, WS_WOUT + (size_t)j * DM * DM * 2, rout, lds, bid, nb)); PH_END
        } else {
            PH_BEGIN RUN(9, ph_gemm_sgin(A, j, rin, lds, bid, nb)); PH_END
            PH_BEGIN RUN(10, ph_sgu_stats(A, rin, bid, nb)); PH_END
            PH_BEGIN RUN(11, ph_sgu_spatial(A, j, rout, lds, bid, nb)); PH_END
            PH_BEGIN RUN(12, ph_gemm_out(A, l, WS_G, WS_SGOUT + (size_t)j * DM * DM * 2, rout, lds, bid, nb)); PH_END
        }
        PH_BEGIN RUN(13, ph_norm2_router(A, l, rout, lds, bid, nb)); PH_END
        PH_BEGIN RUN(14, ph_moe_scatter(A, l, rout, lds, bid, nb)); PH_END
        PH_BEGIN RUN(15, ph_moe_gemm1(A, l, lds, bid, nb)); PH_END
        PH_BEGIN RUN(16, ph_moe_gemm2(A, l, lds, bid, nb)); PH_END
        PH_BEGIN if (SEL(17)) { if ((REPEAT_MASK >> 17) & 1) { ph_moe_combine(A, l, rout, l == 3, bid, nb, true); xcd_barrier(bar); } ph_moe_combine(A, l, rout, l == 3, bid, nb); } PH_END
    }
}

extern "C" void kernel_launch(void* const* d_in, const int* in_sizes, int n_in, void* d_out, int out_size, void* d_ws, size_t ws_size, hipStream_t stream) {
    static int grid = 0;
    if (grid == 0) {
        if (n_in != 38 || out_size != NLAT * DM || ws_size < WS_END) { fprintf(stderr, "kernel_launch: unexpected shapes: n_in %d out %d ws %zu (need %zu)\n", n_in, out_size, ws_size, (size_t)WS_END); grid = -1; return; }
        int dev = 0, cus = 0, per_cu = 0;
        if (hipGetDevice(&dev) != hipSuccess || hipDeviceGetAttribute(&cus, hipDeviceAttributeMultiprocessorCount, dev) != hipSuccess) { grid = -1; return; }
        if (hipFuncSetAttribute((const void*)fwd_kernel, hipFuncAttributeMaxDynamicSharedMemorySize, LDS_BYTES) != hipSuccess) { fprintf(stderr, "kernel_launch: hipFuncSetAttribute failed\n"); grid = -1; return; }
        if (hipOccupancyMaxActiveBlocksPerMultiprocessor(&per_cu, (const void*)fwd_kernel, NTHREADS, LDS_BYTES) != hipSuccess || per_cu < 1)
            fprintf(stderr, "kernel_launch: occupancy query reports %d workgroups per CU\n", per_cu);
        (void)hipGetLastError();
        grid = cus;
    }
    if (grid < 0) return;
    if (hipMemsetAsync((char*)d_ws + WS_CTL, 0, CTL_ZERO_BYTES, stream) != hipSuccess) { fprintf(stderr, "kernel_launch: memset failed\n"); return; }
    Args a{};
    for (int i = 0; i < 38; ++i) a.in[i] = (const float*)d_in[i];
    a.out = (float*)d_out; a.ws = (unsigned char*)d_ws; a.ph_lo = 0; a.ph_hi = 1 << 20;
    hipLaunchKernelGGL(fwd_kernel, dim3(grid), dim3(NTHREADS), LDS_BYTES, stream, a);
    const hipError_t le = hipPeekAtLastError();
    if (le != hipSuccess) fprintf(stderr, "kernel_launch: launch failed: %s\n", hipGetErrorName(le));
}
```
